# Optimizing an MI355X kernel written in HIP

```python
import jax, jax.numpy as jnp
from jax import lax
import numpy as np

D_MODEL = 1024
BATCH = 2
SEQ = 8192
DEPTH = 1
DEC_BATCH = 128
DEC_SEQ = 8
PAST_LEN = 2048
PAGE_SIZE = 128

H_FOX = 8
DH_FOX = 64
FOX_BLOCK = 128
FOX_BIAS_CENTER = 2.0
H_GLA = 4
DK_GLA = 64
DV_GLA = 128
GLA_GATE_RANK = 16
GLA_TAU = 16.0
GLA_CHUNK = 64
N_MEM = 256
H_MEM = 4
DH_MEM = D_MODEL // H_MEM
N_KEYS = 128
N_EXPERTS = N_KEYS * N_KEYS
H_PEER = 8
D_KEY = 256
PEER_TOPK = 16
PEER_BLOCK = 256

EPS = 1e-6
NEG_INF = -1e30
FOX_W = H_FOX * DH_FOX
GLA_KW = H_GLA * DK_GLA
GLA_VW = H_GLA * DV_GLA
MIX_W = FOX_W + GLA_VW
IN_SIZES = (FOX_W, FOX_W, FOX_W, H_FOX, GLA_KW, GLA_KW, GLA_VW, GLA_GATE_RANK, GLA_VW)
D_IN = sum(IN_SIZES)

kernel_name = 'hybrid_fox_gla_peer_decoder_step'


def rmsnorm(x, g):
    xf = x.astype(jnp.float32)
    y = xf * lax.rsqrt(jnp.mean(xf * xf, axis=-1, keepdims=True) + EPS)
    return (y * g.astype(jnp.float32)).astype(x.dtype)


def mixer_inputs(h, w_in, b_fox_f, w_gla_gate2, b_gla_gate):
    B, L, _ = h.shape
    splits = [int(s) for s in np.cumsum(IN_SIZES)[:-1]]
    fq, fk, fv, ff, gq, gk, gv, gg, gr = jnp.split(h @ w_in, splits, axis=-1)
    fq = fq.reshape(B, L, H_FOX, DH_FOX)
    fk = fk.reshape(B, L, H_FOX, DH_FOX)
    fv = fv.reshape(B, L, H_FOX, DH_FOX)
    logf = jax.nn.log_sigmoid((ff + b_fox_f).astype(jnp.float32))
    gq = gq.reshape(B, L, H_GLA, DK_GLA) * (DK_GLA ** -0.5)
    gk = gk.reshape(B, L, H_GLA, DK_GLA)
    gv = gv.reshape(B, L, H_GLA, DV_GLA)
    z = (gg @ w_gla_gate2 + b_gla_gate).astype(jnp.float32)
    log_a = (jax.nn.log_sigmoid(z) / GLA_TAU).reshape(B, L, H_GLA, DK_GLA)
    return fq, fk, fv, logf, gq, gk, gv, log_a, gr


def fox_prompt(q, k, v, logf):
    B, L, H, Dh = q.shape
    scale = Dh ** -0.5
    c_t = jnp.cumsum(logf, axis=1).transpose(0, 2, 1)
    nb = L // FOX_BLOCK
    qb = q.reshape(B, nb, FOX_BLOCK, H, Dh).transpose(1, 0, 2, 3, 4)
    cb = c_t.reshape(B, H, nb, FOX_BLOCK).transpose(2, 0, 1, 3)
    starts = jnp.arange(nb, dtype=jnp.int32) * FOX_BLOCK
    k_pos = jnp.arange(L, dtype=jnp.int32)

    def block(args):
        qi, ci, s0 = args
        s = jnp.einsum('bqhd,bkhd->bhqk', qi, k).astype(jnp.float32) * scale
        s = s + ci[..., :, None] - c_t[:, :, None, :]
        q_pos = s0 + jnp.arange(FOX_BLOCK, dtype=jnp.int32)
        s = jnp.where(k_pos[None, :] <= q_pos[:, None], s, NEG_INF)
        p = jax.nn.softmax(s, axis=-1).astype(v.dtype)
        return jnp.einsum('bhqk,bkhd->bqhd', p, v)

    o = lax.map(block, (qb, cb, starts))
    return o.transpose(1, 0, 2, 3, 4).reshape(B, L, H * Dh)


def fox_sample(q, k, v, logf, k_past, v_past, logf_past):
    B, L, H, Dh = q.shape
    P = k_past.shape[1]
    scale = Dh ** -0.5
    c_past = jnp.cumsum(logf_past.astype(jnp.float32), axis=1).transpose(0, 2, 1)
    c_new = c_past[:, :, -1:] + jnp.cumsum(logf, axis=1).transpose(0, 2, 1)
    s_past = jnp.einsum('bqhd,bkhd->bhqk', q, k_past).astype(jnp.float32) * scale
    s_past = s_past + c_new[..., :, None] - c_past[:, :, None, :]
    s_new = jnp.einsum('bqhd,bkhd->bhqk', q, k).astype(jnp.float32) * scale
    s_new = s_new + c_new[..., :, None] - c_new[:, :, None, :]
    s_new = jnp.where(jnp.tril(jnp.ones((L, L), dtype=bool)), s_new, NEG_INF)
    p = jax.nn.softmax(jnp.concatenate([s_past, s_new], axis=-1), axis=-1).astype(v.dtype)
    o = jnp.einsum('bhqk,bkhd->bqhd', p[..., :P], v_past) + jnp.einsum('bhqk,bkhd->bqhd', p[..., P:], v)
    return o.reshape(B, L, H * Dh)


def gla_chunk_size(L):
    return GLA_CHUNK if L % GLA_CHUNK == 0 else L


def gla_chunked(q, k, v, log_a, s0, chunk):
    B, L, H, dk = q.shape
    dv = v.shape[-1]
    n = L // chunk

    def blk(t):
        return t.astype(jnp.float32).reshape(B, n, chunk, H, t.shape[-1]).transpose(0, 3, 1, 2, 4)

    q, k, v, la = blk(q), blk(k), blk(v), blk(log_a)
    b = jnp.cumsum(la, axis=3)
    b_last = b[:, :, :, -1:, :]
    q_dec = q * jnp.exp(b)
    att = jnp.einsum('bhncd,bhnsd->bhncs', q_dec, k * jnp.exp(-b))
    att = jnp.where(jnp.tril(jnp.ones((chunk, chunk), dtype=bool)), att, 0.0)
    o_intra = jnp.einsum('bhncs,bhnse->bhnce', att, v)
    chunk_kv = jnp.einsum('bhnsd,bhnse->nbhde', k * jnp.exp(b_last - b), v)
    decay = jnp.exp(b_last[:, :, :, 0, :]).transpose(2, 0, 1, 3)

    def step(S, inp):
        dec, kv = inp
        return dec[..., None] * S + kv, S

    s_final, s_prev = lax.scan(step, s0.astype(jnp.float32), (decay, chunk_kv))
    o_inter = jnp.einsum('bhncd,nbhde->bhnce', q_dec, s_prev)
    o = (o_intra + o_inter).transpose(0, 2, 3, 1, 4).reshape(B, L, H, dv)
    return o, s_final


def mix_out(fox_o, gla_o, gr, g_gla_out, w_out):
    B, L = fox_o.shape[:2]
    gla_n = rmsnorm(gla_o, g_gla_out.reshape(H_GLA, DV_GLA)).reshape(B, L, GLA_VW)
    gla_n = gla_n * jax.nn.silu(gr.astype(jnp.float32))
    merged = jnp.concatenate([fox_o, gla_n.astype(fox_o.dtype)], axis=-1)
    return merged @ w_out


def memory_kv(mem, g_mem, w_mem_k, w_mem_v):
    B, M, _ = mem.shape
    m = rmsnorm(mem, g_mem)
    return (m @ w_mem_k).reshape(B, M, H_MEM, DH_MEM), (m @ w_mem_v).reshape(B, M, H_MEM, DH_MEM)


def cross_attn(h, mk, mv, w_q, w_o):
    B, L, _ = h.shape
    q = (h @ w_q).reshape(B, L, H_MEM, DH_MEM)
    s = jnp.einsum('blhd,bmhd->bhlm', q, mk).astype(jnp.float32) * (DH_MEM ** -0.5)
    p = jax.nn.softmax(s, axis=-1).astype(mv.dtype)
    o = jnp.einsum('bhlm,bmhd->blhd', p, mv).reshape(B, L, H_MEM * DH_MEM)
    return o @ w_o


def peer_ffn(h, w_q, subkeys, u, v):
    shp = h.shape
    hf = h.reshape(-1, shp[-1])
    T = hf.shape[0]
    pad = (-T) % PEER_BLOCK
    hp = jnp.pad(hf, ((0, pad), (0, 0))).reshape(-1, PEER_BLOCK, shp[-1])

    def block(hb):
        q = (hb @ w_q).reshape(PEER_BLOCK, H_PEER, 2, D_KEY // 2)
        s1 = jnp.einsum('thd,kd->thk', q[:, :, 0], subkeys[0]).astype(jnp.float32)
        s2 = jnp.einsum('thd,kd->thk', q[:, :, 1], subkeys[1]).astype(jnp.float32)
        v1, i1 = lax.top_k(s1, PEER_TOPK)
        v2, i2 = lax.top_k(s2, PEER_TOPK)
        cand = (v1[..., :, None] + v2[..., None, :]).reshape(PEER_BLOCK, H_PEER, PEER_TOPK * PEER_TOPK)
        sc, ci = lax.top_k(cand, PEER_TOPK)
        e = (jnp.take_along_axis(i1, ci // PEER_TOPK, axis=-1) * N_KEYS
             + jnp.take_along_axis(i2, ci % PEER_TOPK, axis=-1))
        g = jax.nn.softmax(sc, axis=-1)
        a = jax.nn.gelu(jnp.einsum('thkd,td->thk', u[e], hb).astype(jnp.float32))
        w = (g * a).astype(hb.dtype)
        return jnp.einsum('thk,thkd->td', w, v[e])

    out = lax.map(block, hp).reshape(-1, shp[-1])[:T]
    return out.reshape(shp)


def setup_inputs(seed: int = 0) -> dict:
    key = jax.random.key(seed)
    ks = iter(jax.random.split(key, 32))

    def nrm(shape, scale):
        return jax.random.normal(next(ks), shape, jnp.float32) * scale

    def gain(shape):
        return 1.0 + nrm(shape, 0.02)

    n_pages = PAST_LEN // PAGE_SIZE
    n_pool = (DEC_BATCH * n_pages * 5) // 4
    x_prompt = nrm((BATCH, SEQ, D_MODEL), 1.0)
    x_sample = nrm((DEC_BATCH, DEC_SEQ, D_MODEL), 1.0)
    cache_fox_k = nrm((DEPTH, n_pool, PAGE_SIZE, H_FOX, DH_FOX), 1.0)
    cache_fox_v = nrm((DEPTH, n_pool, PAGE_SIZE, H_FOX, DH_FOX), 1.0)
    cache_fox_logf = jax.nn.log_sigmoid(FOX_BIAS_CENTER + nrm((DEPTH, n_pool, PAGE_SIZE, H_FOX), 1.0))
    state_gla = nrm((DEPTH, DEC_BATCH, H_GLA, DK_GLA, DV_GLA), 1.0)
    cache_mem_k = nrm((DEPTH, DEC_BATCH, N_MEM, H_MEM, DH_MEM), 1.0)
    cache_mem_v = nrm((DEPTH, DEC_BATCH, N_MEM, H_MEM, DH_MEM), 1.0)
    page_table = jax.random.permutation(next(ks), n_pool)[:DEC_BATCH * n_pages]
    page_table = page_table.reshape(DEC_BATCH, n_pages).astype(jnp.int32)
    mem_prompt = nrm((BATCH, N_MEM, D_MODEL), 1.0)
    return {
        'x_prompt': x_prompt,
        'x_sample': x_sample,
        'cache_fox_k': cache_fox_k,
        'cache_fox_v': cache_fox_v,
        'cache_fox_logf': cache_fox_logf,
        'state_gla': state_gla,
        'cache_mem_k': cache_mem_k,
        'cache_mem_v': cache_mem_v,
        'page_table': page_table,
        'mem_prompt': mem_prompt,
        'g_mix': gain((DEPTH, D_MODEL)),
        'w_in': nrm((DEPTH, D_MODEL, D_IN), D_MODEL ** -0.5),
        'b_fox_f': FOX_BIAS_CENTER + nrm((DEPTH, H_FOX), 0.1),
        'w_gla_gate2': nrm((DEPTH, GLA_GATE_RANK, GLA_KW), GLA_GATE_RANK ** -0.5),
        'b_gla_gate': nrm((DEPTH, GLA_KW), 0.1),
        'g_gla_out': gain((DEPTH, GLA_VW)),
        'w_out': nrm((DEPTH, MIX_W, D_MODEL), MIX_W ** -0.5),
        'g_cross': gain((DEPTH, D_MODEL)),
        'g_mem': gain((DEPTH, D_MODEL)),
        'w_mem_k': nrm((DEPTH, D_MODEL, H_MEM * DH_MEM), D_MODEL ** -0.5),
        'w_mem_v': nrm((DEPTH, D_MODEL, H_MEM * DH_MEM), D_MODEL ** -0.5),
        'w_cross_q': nrm((DEPTH, D_MODEL, H_MEM * DH_MEM), D_MODEL ** -0.5),
        'w_cross_o': nrm((DEPTH, H_MEM * DH_MEM, D_MODEL), D_MODEL ** -0.5),
        'g_ffn': gain((DEPTH, D_MODEL)),
        'peer_w_q': nrm((DEPTH, D_MODEL, H_PEER * D_KEY), D_MODEL ** -0.5),
        'peer_subkeys': nrm((DEPTH, 2, N_KEYS, D_KEY // 2), (D_KEY // 2) ** -0.5),
        'peer_u': nrm((DEPTH, N_EXPERTS, D_MODEL), D_MODEL ** -0.5),
        'peer_v': nrm((DEPTH, N_EXPERTS, D_MODEL), D_MODEL ** -0.5),
        'g_final': gain((D_MODEL,)),
    }


def reference(x_prompt, x_sample, cache_fox_k, cache_fox_v, cache_fox_logf, state_gla,
              cache_mem_k, cache_mem_v, page_table, mem_prompt, g_mix, w_in, b_fox_f,
              w_gla_gate2, b_gla_gate, g_gla_out, w_out, g_cross, g_mem, w_mem_k, w_mem_v,
              w_cross_q, w_cross_o, g_ffn, peer_w_q, peer_subkeys, peer_u, peer_v, g_final):
    xp, xs = x_prompt, x_sample
    Bp, Lp = xp.shape[:2]
    Bs, Ls = xs.shape[:2]
    fk_p, fv_p, fl_p, gs_p, mk_p, mv_p = [], [], [], [], [], []
    fk_s, fv_s, fl_s, gs_s = [], [], [], []
    for l in range(DEPTH):
        h = rmsnorm(xp, g_mix[l])
        fq, fk, fv, logf, gq, gk, gv, log_a, gr = mixer_inputs(h, w_in[l], b_fox_f[l], w_gla_gate2[l], b_gla_gate[l])
        fox_o = fox_prompt(fq, fk, fv, logf)
        s0 = jnp.zeros((Bp, H_GLA, DK_GLA, DV_GLA), jnp.float32)
        gla_o, s_fin = gla_chunked(gq, gk, gv, log_a, s0, gla_chunk_size(Lp))
        xp = xp + mix_out(fox_o, gla_o, gr, g_gla_out[l], w_out[l])
        mk, mv = memory_kv(mem_prompt, g_mem[l], w_mem_k[l], w_mem_v[l])
        xp = xp + cross_attn(rmsnorm(xp, g_cross[l]), mk, mv, w_cross_q[l], w_cross_o[l])
        xp = xp + peer_ffn(rmsnorm(xp, g_ffn[l]), peer_w_q[l], peer_subkeys[l], peer_u[l], peer_v[l])
        fk_p.append(fk)
        fv_p.append(fv)
        fl_p.append(logf)
        gs_p.append(s_fin)
        mk_p.append(mk)
        mv_p.append(mv)
        h = rmsnorm(xs, g_mix[l])
        fq, fk, fv, logf, gq, gk, gv, log_a, gr = mixer_inputs(h, w_in[l], b_fox_f[l], w_gla_gate2[l], b_gla_gate[l])
        k_past = cache_fox_k[l][page_table].reshape(Bs, -1, H_FOX, DH_FOX)
        v_past = cache_fox_v[l][page_table].reshape(Bs, -1, H_FOX, DH_FOX)
        lf_past = cache_fox_logf[l][page_table].reshape(Bs, -1, H_FOX)
        fox_o = fox_sample(fq, fk, fv, logf, k_past, v_past, lf_past)
        gla_o, s_new = gla_chunked(gq, gk, gv, log_a, state_gla[l], gla_chunk_size(Ls))
        xs = xs + mix_out(fox_o, gla_o, gr, g_gla_out[l], w_out[l])
        xs = xs + cross_attn(rmsnorm(xs, g_cross[l]), cache_mem_k[l], cache_mem_v[l], w_cross_q[l], w_cross_o[l])
        xs = xs + peer_ffn(rmsnorm(xs, g_ffn[l]), peer_w_q[l], peer_subkeys[l], peer_u[l], peer_v[l])
        fk_s.append(fk)
        fv_s.append(fv)
        fl_s.append(logf)
        gs_s.append(s_new)
    y_prompt = rmsnorm(xp, g_final)
    y_sample = rmsnorm(xs, g_final)
    return (y_prompt, y_sample,
            jnp.stack(fk_p, axis=0), jnp.stack(fv_p, axis=0), jnp.stack(fl_p, axis=0),
            jnp.stack(gs_p, axis=0), jnp.stack(mk_p, axis=0), jnp.stack(mv_p, axis=0),
            jnp.stack(fk_s, axis=0), jnp.stack(fv_s, axis=0), jnp.stack(fl_s, axis=0),
            jnp.stack(gs_s, axis=0))
```

```cpp
#define PH_MAX 13
#include <hip/hip_runtime.h>
#include <cstdio>
#include <cstdint>

namespace pg8 {
#define PG8_LAS __attribute__((address_space(3)))
typedef unsigned short bf16_t;
typedef short bf16x8 __attribute__((ext_vector_type(8)));
typedef float f32x4 __attribute__((ext_vector_type(4)));
typedef unsigned u32x4 __attribute__((ext_vector_type(4)));
typedef unsigned u32x2 __attribute__((ext_vector_type(2)));
constexpr int BM = 256, BK = 64, HALF = 128, HTB = HALF * BK * 2  , STAGE_BYTES = 8 * HTB, NXCD = 8, WGM = 8;

__host__ __device__ __forceinline__ int lds_byte(int r, int c) { const int st = (r >> 4) * 2 + (c >> 5), rr = r & 15, cc = c & 31, ob = rr * 64 + cc * 2; return st * 1024 + (ob ^ (((ob >> 9) & 1) << 5)); }
__host__ __device__ __forceinline__ void stage_rc(int b, int& R, int& C) { const int st = b / 1024, sb = b % 1024, swz = sb ^ (((sb >> 9) & 1) << 5); R = (st >> 1) * 16 + swz / 64; C = (st & 1) * 32 + (swz % 64) / 2; }

struct Unit { int pm, pn; };
struct Gemm { const bf16_t* A; const bf16_t* Bt; int lda, ldb, K; };

struct StaticOrder {
    int nM, nN, nwg, G, c;
    __host__ __device__ void init(int M, int N, int G_, int c_) { nM = M / BM; nN = N / BM; nwg = nM * nN; G = G_; c = c_; }
    __host__ __device__ bool next(int i, Unit& u) const {
        const long L = (long)i * G + c; if (L >= nwg) return false;
        int wgid = (int)L; { const int q = nwg / NXCD, r = nwg % NXCD, xcd = wgid % NXCD, off = wgid / NXCD; wgid = (xcd < r ? xcd * (q + 1) : r * (q + 1) + (xcd - r) * q) + off; }
        const int nig = WGM * nN, gid = wgid / nig, fm = gid * WGM, gsz = (nM - fm) < WGM ? (nM - fm) : WGM;
        u.pm = fm + ((wgid % nig) % gsz); u.pn = (wgid % nig) / gsz; return true;
    }
};
struct SingleUnit {
    int has; Unit u0;
    __host__ __device__ bool next(int i, Unit& u) const { if (i != 0 || !has) return false; u = u0; return true; }
};

__device__ __forceinline__ unsigned cvt_pk_bf16(float lo, float hi) { unsigned r; asm volatile("v_cvt_pk_bf16_f32 %0, %1, %2" : "=v"(r) : "v"(lo), "v"(hi)); return r; }

template <class Epi, class Sched>
__device__ __forceinline__ void gemm_phase(PG8_LAS unsigned char* lds, const Gemm g, const Sched& S, const Epi& E) {
    int tid = threadIdx.x; asm volatile("" : "+v"(tid));
    const int wid = __builtin_amdgcn_readfirstlane(tid >> 6), lane = tid & 63, wr = wid >> 2, wc = wid & 3, fr = lane & 15, fq = lane >> 4;
    const int K = g.K, nt = K / BK;
    unsigned voffA[2], voffB[2];
#pragma unroll
    for (int i = 0; i < 2; ++i) { int R, C; stage_rc(tid * 16 + i * 8192, R, C);
        voffA[i] = (unsigned)(R * g.lda + C) * 2u; voffB[i] = (unsigned)(R * g.ldb + C) * 2u; }
    const size_t kstep = (size_t)(BK * 2);
    const size_t hstepA = (size_t)HALF * g.lda * 2, hstepB = (size_t)HALF * g.ldb * 2;
    const size_t tstepA = 2 * hstepA, tstepB = 2 * hstepB;
    const unsigned ldsw = (unsigned)wid * 1024u;
    const int aoff = lds_byte(wr * 64 + fr, fq * 8), boff = lds_byte(wc * 32 + fr, fq * 8);
#define PG8_SA(b, h) (((b) * 2 + (h)) * HTB)
#define PG8_SB(b, h) ((4 + (b) * 2 + (h)) * HTB)
#define PG8_STAGE(bufoff, gbase, voff) do { _Pragma("unroll") for (int _i = 0; _i < 2; ++_i) \
        __builtin_amdgcn_global_load_lds((const unsigned*)((const char*)(gbase) + (voff)[_i]), (PG8_LAS unsigned*)(lds + (bufoff) + ldsw + _i * 8192), 16, 0, 0); } while (0)
#define PG8_LDA(dst, b, h) do { _Pragma("unroll") for (int m = 0; m < 4; ++m) _Pragma("unroll") for (int k = 0; k < 2; ++k) dst[m][k] = *(const PG8_LAS bf16x8*)(lds + PG8_SA(b, h) + aoff + m * 2048 + k * 1024); } while (0)
#define PG8_LDB(dst, b, h) do { _Pragma("unroll") for (int n = 0; n < 2; ++n) _Pragma("unroll") for (int k = 0; k < 2; ++k) dst[n][k] = *(const PG8_LAS bf16x8*)(lds + PG8_SB(b, h) + boff + n * 2048 + k * 1024); } while (0)
#define PG8_MMA(ai, bj, At, Bt) do { __builtin_amdgcn_s_setprio(1); _Pragma("unroll") for (int m = 0; m < 4; ++m) _Pragma("unroll") for (int n = 0; n < 2; ++n) _Pragma("unroll") for (int k = 0; k < 2; ++k) \
        acc[ai][bj][m][n] = __builtin_amdgcn_mfma_f32_16x16x32_bf16(Bt[n][k], At[m][k], acc[ai][bj][m][n], 0, 0, 0); __builtin_amdgcn_s_setprio(0); } while (0)
#define PG8_WAIT_V(n) asm volatile("s_waitcnt vmcnt(" #n ")" ::: "memory")
#define PG8_WAIT_L(n) asm volatile("s_waitcnt lgkmcnt(" #n ")" ::: "memory")
#define PG8_BAR __builtin_amdgcn_s_barrier()
#define PG8_SCHED __builtin_amdgcn_sched_barrier(0)
    Unit cur, nxt; int ui = 0;
    if (!S.next(0, cur)) return;
    f32x4 acc[2][2][4][2];
#pragma unroll
    for (int a = 0; a < 2; ++a)
#pragma unroll
        for (int b = 0; b < 2; ++b)
#pragma unroll
            for (int m = 0; m < 4; ++m)
#pragma unroll
                for (int n = 0; n < 2; ++n) acc[a][b][m][n] = (f32x4){0.f, 0.f, 0.f, 0.f};
    bf16x8 At[4][2], B0[2][2], B1[2][2];
    const char* cA = (const char*)g.A + (size_t)cur.pm * tstepA; const char* cB = (const char*)g.Bt + (size_t)cur.pn * tstepB;
    PG8_STAGE(PG8_SB(0, 0), cB, voffB); PG8_STAGE(PG8_SB(0, 1), cB + hstepB, voffB); PG8_STAGE(PG8_SA(0, 0), cA, voffA); PG8_STAGE(PG8_SA(0, 1), cA + hstepA, voffA);
    if (wr == 1) PG8_BAR;
    PG8_WAIT_V(2); PG8_BAR;
    PG8_STAGE(PG8_SB(1, 0), cB + kstep, voffB); PG8_STAGE(PG8_SA(1, 0), cA + kstep, voffA); PG8_STAGE(PG8_SB(1, 1), cB + hstepB + kstep, voffB);
    PG8_WAIT_V(6); PG8_BAR;
    for (;;) {
        const bool has_next = S.next(ui + 1, nxt);
        const char* nA = has_next ? (const char*)g.A + (size_t)nxt.pm * tstepA : cA; const char* nB = has_next ? (const char*)g.Bt + (size_t)nxt.pn * tstepB : cB;
        for (int t = 0; t < nt; t += 2) {
            const bool last = (t == nt - 2);
            const char* a1 = cA + (size_t)(t + 1) * kstep;
            const char* a2 = last ? nA : cA + (size_t)(t + 2) * kstep; const char* b2 = last ? nB : cB + (size_t)(t + 2) * kstep;
            const char* a3 = a2 + kstep; const char* b3 = b2 + kstep;
            PG8_LDB(B0, 0, 0); PG8_LDB(B1, 0, 1); PG8_SCHED; PG8_LDA(At, 0, 0); PG8_STAGE(PG8_SA(1, 1), a1 + hstepA, voffA);
            PG8_WAIT_V(8); PG8_WAIT_L(0); PG8_BAR; PG8_MMA(0, 0, At, B0); PG8_MMA(0, 1, At, B1); PG8_BAR; PG8_SCHED;
            PG8_LDA(At, 0, 1); PG8_STAGE(PG8_SB(0, 0), b2, voffB); PG8_STAGE(PG8_SB(0, 1), b2 + hstepB, voffB); PG8_STAGE(PG8_SA(0, 0), a2, voffA);
            PG8_WAIT_V(8); PG8_WAIT_L(0); PG8_BAR; PG8_MMA(1, 0, At, B0); PG8_MMA(1, 1, At, B1); PG8_BAR; PG8_SCHED;
            PG8_LDB(B0, 1, 0); PG8_LDB(B1, 1, 1); PG8_SCHED; PG8_LDA(At, 1, 0); PG8_STAGE(PG8_SA(0, 1), a2 + hstepA, voffA);
            PG8_WAIT_V(8); PG8_WAIT_L(0); PG8_BAR; PG8_MMA(0, 0, At, B0); PG8_MMA(0, 1, At, B1); PG8_BAR; PG8_SCHED;
            PG8_LDA(At, 1, 1); PG8_STAGE(PG8_SB(1, 0), b3, voffB); PG8_STAGE(PG8_SB(1, 1), b3 + hstepB, voffB); PG8_STAGE(PG8_SA(1, 0), a3, voffA);
            PG8_WAIT_V(8); PG8_WAIT_L(0); PG8_BAR; PG8_MMA(1, 0, At, B0); PG8_MMA(1, 1, At, B1); PG8_BAR; PG8_SCHED;
        }
        if (wr == 0) PG8_BAR;
        if constexpr (!Epi::AFTER_DRAIN) { E(acc, cur, wr, wc, fr, fq); }
        if (!has_next) break;
#pragma unroll
        for (int a = 0; a < 2; ++a)
#pragma unroll
            for (int b = 0; b < 2; ++b)
#pragma unroll
                for (int m = 0; m < 4; ++m)
#pragma unroll
                    for (int n = 0; n < 2; ++n) acc[a][b][m][n] = (f32x4){0.f, 0.f, 0.f, 0.f};
        cur = nxt; cA = nA; cB = nB; ++ui;
        if (wr == 1) PG8_BAR;
    }
    PG8_WAIT_V(0);
    PG8_BAR;
    if constexpr (Epi::AFTER_DRAIN) { E.fused(acc, cur, wr, wc, fr, fq, lds, wid, lane); }
#undef PG8_SA
#undef PG8_SB
#undef PG8_STAGE
#undef PG8_LDA
#undef PG8_LDB
#undef PG8_MMA
#undef PG8_WAIT_V
#undef PG8_WAIT_L
#undef PG8_BAR
#undef PG8_SCHED
}
}

#define GAS __attribute__((address_space(1)))
#define LAS __attribute__((address_space(3)))
typedef unsigned short bf16;
typedef unsigned v4u __attribute__((ext_vector_type(4)));
typedef unsigned v2u __attribute__((ext_vector_type(2)));
typedef float f32x4 __attribute__((ext_vector_type(4)));
typedef float f32x2 __attribute__((ext_vector_type(2)));
typedef float f32x16 __attribute__((ext_vector_type(16)));
typedef short bf16x8 __attribute__((ext_vector_type(8)));
typedef short s16x4 __attribute__((ext_vector_type(4)));
typedef GAS unsigned gu32;
#define RLX_AGENT __ATOMIC_RELAXED, __HIP_MEMORY_SCOPE_AGENT
#define LDS_WAIT() asm volatile("s_waitcnt lgkmcnt(0)" ::: "memory")
#define VM_WAIT() asm volatile("s_waitcnt vmcnt(0)" ::: "memory")
__device__ __forceinline__ unsigned f2bf(float f) { unsigned u = __builtin_bit_cast(unsigned, f); return (u + 0x7fffu + ((u >> 16) & 1u)) >> 16; }
__device__ __forceinline__ unsigned pk2(float lo, float hi) { return f2bf(lo) | (f2bf(hi) << 16); }
__device__ __forceinline__ float bf2f(unsigned short b) { return __builtin_bit_cast(float, (unsigned)b << 16); }
__device__ __forceinline__ float bflo(unsigned u) { return __builtin_bit_cast(float, u << 16); }
__device__ __forceinline__ float bfhi(unsigned u) { return __builtin_bit_cast(float, u & 0xffff0000u); }

#define XB_TMO      128
#define XB_XCNT(j)  (256  + 64 * (j))
#define XB_XSUB(j)  (1280 + 64 * (j))
#define XB_XGEN(j)  (2304 + 64 * (j))
#define XB_TOP      3328
#define XB_TOPGEN   3392
#define XCD_BAR_WORDS 3456
#define XB_SPIN_CAP (1u << 18)

__device__ __forceinline__ unsigned xb_ld(unsigned* p)              { return __hip_atomic_load(p, __ATOMIC_RELAXED, __HIP_MEMORY_SCOPE_AGENT); }
__device__ __forceinline__ unsigned xb_add(unsigned* p, unsigned v) { return __hip_atomic_fetch_add(p, v, __ATOMIC_RELAXED, __HIP_MEMORY_SCOPE_AGENT); }
__device__ __forceinline__ unsigned xb_xcc_id() { return (unsigned)__builtin_amdgcn_s_getreg((3 << 11) | 20) & 0xFu; }
#define XB_SPIN(cond, bar) do { unsigned _sp = 0; while (cond) { __builtin_amdgcn_s_sleep(1); \
    if ((++_sp & 255u) == 0u) { if (xb_ld(&(bar)[XB_TMO])) break; if (_sp > XB_SPIN_CAP) { atomicAdd(&(bar)[XB_TMO], 1u); break; } } } } while (0)

struct XcdBarrier {
    unsigned* bar; unsigned x;
    volatile LAS unsigned* st;
};

__device__ __forceinline__ XcdBarrier xcd_barrier_post(unsigned* bar, volatile LAS unsigned* st) {
    XcdBarrier b; b.bar = bar; b.x = xb_xcc_id(); b.st = st;
    if (threadIdx.x == 0) (void)xb_add(&bar[XB_XCNT(b.x)], 1u);
    return b;
}
__device__ __forceinline__ void xcd_barrier_complete(unsigned* bar, unsigned x, unsigned& nloc, unsigned& nx) {
    const unsigned G = gridDim.x * gridDim.y * gridDim.z;
    unsigned sum, cnt, mine, sp = 0u;
    for (;;) {
        sum = 0u; cnt = 0u; mine = 0u;
#pragma unroll
        for (unsigned j = 0; j < 16; ++j) { const unsigned c = xb_ld(&bar[XB_XCNT(j)]); sum += c; cnt += (c > 0u) ? 1u : 0u; mine = (j == x) ? c : mine; }
        if (sum == G) break;
        __builtin_amdgcn_s_sleep(1);
        if ((++sp & 255u) == 0u) { if (xb_ld(&bar[XB_TMO])) break; if (sp > XB_SPIN_CAP) { atomicAdd(&bar[XB_TMO], 1u); break; } }
    }
    nloc = mine > 0u ? mine : 1u; nx = cnt > 0u ? cnt : 1u;
}

__device__ __forceinline__ void xcd_barrier(const XcdBarrier& b) {
    asm volatile("s_waitcnt vmcnt(0)" ::: "memory");
    __syncthreads();
    if (threadIdx.x == 0) {
        unsigned* bar = b.bar;
        __builtin_amdgcn_s_waitcnt(0);
        unsigned nloc = b.st[0], nx = b.st[1];
        if (nloc == 0u) { xcd_barrier_complete(bar, b.x, nloc, nx); b.st[0] = nloc; b.st[1] = nx; }
        const unsigned old = xb_add(&bar[XB_XSUB(b.x)], 1u);
        const unsigned gen = old / nloc;
        if (old + 1u == (gen + 1u) * nloc) {
            __builtin_amdgcn_fence(__ATOMIC_RELEASE, "agent");
            asm volatile("s_waitcnt vmcnt(0)" ::: "memory");
            const unsigned og = xb_add(&bar[XB_TOP], 1u);
            const unsigned tg = og / nx;
            if (og + 1u == (tg + 1u) * nx) xb_add(&bar[XB_TOPGEN], 1u);
            else XB_SPIN(xb_ld(&bar[XB_TOPGEN]) == tg, bar);
            __builtin_amdgcn_fence(__ATOMIC_ACQUIRE, "agent");
            xb_add(&bar[XB_XGEN(b.x)], 1u);
            asm volatile("s_waitcnt vmcnt(0)" ::: "memory");
        } else {
            XB_SPIN(xb_ld(&bar[XB_XGEN(b.x)]) == gen, bar);
            __builtin_amdgcn_fence(__ATOMIC_ACQUIRE, "agent");
            asm volatile("s_waitcnt vmcnt(0)" ::: "memory");
        }
    }
    __syncthreads();
}


constexpr int NWAVES = 8, NTHR = 512;
constexpr int DM = 1024, TP = 16384, TS = 1024, TA = TP + TS, SEQ = 8192, NB_P = 2, NB_S = 128, LS = 8;
constexpr int N_IN = 3328;
constexpr int PASTL = 2048, PAGE = 128, NPAGES = 16;
constexpr float EPS = 1e-6f;
constexpr float LOG2E = 1.4426950408889634f;
constexpr float C2F = 0.125f * LOG2E;
constexpr float C2C = 0.0625f * LOG2E;

enum { I_XP = 0, I_XS, I_CFK, I_CFV, I_CFL, I_SGLA, I_CMK, I_CMV, I_PT, I_MEMP, I_GMIX, I_WIN, I_BFF, I_WG2, I_BG, I_GGO, I_WOUT, I_GCROSS, I_GMEM,
       I_WMK, I_WMV, I_WCQ, I_WCO, I_GFFN, I_PWQ, I_PSK, I_PU, I_PV, I_GFIN, N_INPUTS };
constexpr size_t O_YP = 0, O_YS = 16777216, O_FKP = 17825792, O_FVP = 26214400, O_LFP = 34603008, O_GSP = 34734080, O_MKP = 34799616, O_MVP = 35323904,
                 O_FKS = 35848192, O_FVS = 36372480, O_LFS = 36896768, O_GSS = 36904960, O_TOTAL = 41099264;

constexpr size_t MiB = 1u << 20;
constexpr size_t WS_CTL = 0, CTL_ZERO_BYTES = 1 * MiB;
constexpr size_t WS_WIN = 2 * MiB, WS_WOUT = 10 * MiB, WS_WMK = 12 * MiB, WS_WMV = 14 * MiB, WS_WCQ = 16 * MiB, WS_WCO = 18 * MiB, WS_WPK = 20 * MiB;
constexpr size_t WS_MB = 24 * MiB, WS_MK16 = 25 * MiB, WS_MVT16 = 26 * MiB, WS_KBIAS = 27 * MiB, WS_GDEC = 28 * MiB, WS_GG = 29 * MiB;
constexpr size_t WS_U16 = 32 * MiB, WS_V16 = 64 * MiB, WS_HB = 96 * MiB, WS_QF = 132 * MiB, WS_KF = 150 * MiB, WS_VF = 168 * MiB;
constexpr size_t WS_GQ = 186 * MiB, WS_GK = 204 * MiB, WS_GV = 222 * MiB, WS_GR = 256 * MiB, WS_SUF = 290 * MiB, WS_GKV = 298 * MiB;
constexpr size_t WS_MERGED = 330 * MiB, WS_X1 = 364 * MiB, WS_X2 = 432 * MiB, WS_QC = 500 * MiB, WS_PC = 534 * MiB, WS_OC = 566 * MiB, WS_SC = 600 * MiB;
constexpr size_t WS_MISC = 736 * MiB, WS_END = 800 * MiB;
constexpr int CW_BAR = 4096;

constexpr int RING_BYTES = 131072;
constexpr int LDSCTL_OFF = RING_BYTES, MISC_OFF = LDSCTL_OFF + 320;
constexpr int ARGS_OFF = MISC_OFF + 128;
constexpr int LDS_BYTES = 147456;

struct Args { const void* in[N_INPUTS]; float* out; unsigned char* ws; };

__device__ __forceinline__ const void* ld_ptr(const LAS unsigned long long* p) { const unsigned long long v = *p; const unsigned lo = __builtin_amdgcn_readfirstlane((unsigned)v), hi = __builtin_amdgcn_readfirstlane((unsigned)(v >> 32)); return (const void*)(((unsigned long long)hi << 32) | lo); }
__device__ __forceinline__ Args load_args(const LAS unsigned long long* ARGP) { Args A;
    A.in[0] = ld_ptr(ARGP + 0);
    A.in[1] = ld_ptr(ARGP + 1);
    A.in[2] = ld_ptr(ARGP + 2);
    A.in[3] = ld_ptr(ARGP + 3);
    A.in[4] = ld_ptr(ARGP + 4);
    A.in[5] = ld_ptr(ARGP + 5);
    A.in[6] = ld_ptr(ARGP + 6);
    A.in[7] = ld_ptr(ARGP + 7);
    A.in[8] = ld_ptr(ARGP + 8);
    A.in[9] = ld_ptr(ARGP + 9);
    A.in[10] = ld_ptr(ARGP + 10);
    A.in[11] = ld_ptr(ARGP + 11);
    A.in[12] = ld_ptr(ARGP + 12);
    A.in[13] = ld_ptr(ARGP + 13);
    A.in[14] = ld_ptr(ARGP + 14);
    A.in[15] = ld_ptr(ARGP + 15);
    A.in[16] = ld_ptr(ARGP + 16);
    A.in[17] = ld_ptr(ARGP + 17);
    A.in[18] = ld_ptr(ARGP + 18);
    A.in[19] = ld_ptr(ARGP + 19);
    A.in[20] = ld_ptr(ARGP + 20);
    A.in[21] = ld_ptr(ARGP + 21);
    A.in[22] = ld_ptr(ARGP + 22);
    A.in[23] = ld_ptr(ARGP + 23);
    A.in[24] = ld_ptr(ARGP + 24);
    A.in[25] = ld_ptr(ARGP + 25);
    A.in[26] = ld_ptr(ARGP + 26);
    A.in[27] = ld_ptr(ARGP + 27);
    A.in[28] = ld_ptr(ARGP + 28);
    A.out = (float*)ld_ptr(ARGP + N_INPUTS); A.ws = (unsigned char*)ld_ptr(ARGP + N_INPUTS + 1); return A; }
struct Frame {
    LAS unsigned char* lds;
    int tid, lane, wave, vcu, G;
};

__device__ __forceinline__ float wave_sum(float v) {
#pragma unroll
    for (int o = 1; o < 64; o <<= 1) v += __shfl_xor(v, o);
    return v;
}
__device__ __forceinline__ float log_sigmoid(float x) { return fminf(x, 0.f) - log1pf(__expf(-fabsf(x))); }

__device__ __forceinline__ int win_src_col(int r) {
    if (r < 1536) return r;
    if (r < 1792) return 1544 + (r - 1536);
    if (r < 2048) return 1800 + (r - 1792);
    if (r < 2560) return 2056 + (r - 2048);
    if (r < 3072) return 2584 + (r - 2560);
    if (r < 3080) return 1536 + (r - 3072);
    if (r < 3096) return 2568 + (r - 3080);
    return -1;
}
template <bool WIN>
__device__ __forceinline__ void p0_transpose_item(const float* W, int ldw, int K, int nblk, bf16* WT, LAS float* scr, int item, int lane) {
    const int kb = item / nblk, nb = item % nblk, k0 = 64 * kb, n0 = 32 * nb;
    const int dr = n0 + (lane & 31); const int sc = WIN ? win_src_col(dr) : dr;
#pragma unroll 8
    for (int i = 0; i < 32; ++i) { const int kk = 2 * i + (lane >> 5); scr[kk * 33 + (lane & 31)] = (sc >= 0) ? W[(size_t)(k0 + kk) * ldw + sc] : 0.f; }
    LDS_WAIT(); asm volatile("" ::: "memory");
    const int c = lane & 7;
#pragma unroll
    for (int j = 0; j < 4; ++j) { const int n = (lane >> 3) + 8 * j; const LAS float* s = scr + (8 * c) * 33 + n;
        v4u o; o.x = pk2(s[0 * 33], s[1 * 33]); o.y = pk2(s[2 * 33], s[3 * 33]); o.z = pk2(s[4 * 33], s[5 * 33]); o.w = pk2(s[6 * 33], s[7 * 33]);
        *(GAS v4u*)(WT + (size_t)(n0 + n) * K + k0 + 8 * c) = o; }
    LDS_WAIT(); asm volatile("" ::: "memory");
}
__device__ __forceinline__ void rms_row_bf16(const float* xrow, const float* g, bf16* orow, int lane) {
    const f32x4* xr = (const f32x4*)xrow + lane; const f32x4* gr = (const f32x4*)g + lane;
    f32x4 v[4]; float s = 0.f;
#pragma unroll
    for (int j = 0; j < 4; ++j) { v[j] = xr[64 * j]; s += (v[j].x * v[j].x + v[j].y * v[j].y) + (v[j].z * v[j].z + v[j].w * v[j].w); }
    const float r = rsqrtf(wave_sum(s) * (1.f / DM) + EPS);
    v2u* o8 = (v2u*)orow + lane;
#pragma unroll
    for (int j = 0; j < 4; ++j) { const f32x4 gg = gr[64 * j]; v2u o; o.x = pk2(v[j].x * r * gg.x, v[j].y * r * gg.y); o.y = pk2(v[j].z * r * gg.z, v[j].w * r * gg.w); o8[64 * j] = o; }
}

using pg8::Unit;
struct EpiGen {
    static constexpr bool PERM = false, AFTER_DRAIN = false;
    float* d32; int ld32; bf16* d16; int ld16; float sc16;
    const float* r0; const float* r1; int rsplit; int ldr;
    __device__ __forceinline__ void operator()(const f32x4 (&acc)[2][2][4][2], const Unit& u, int wr, int wc, int fr, int fq) const {
        int row0 = u.pm * 256 + wr * 64 + fr, col0 = u.pn * 256 + wc * 32 + fq * 4;
        asm volatile("" : "+v"(row0), "+v"(col0));
#pragma unroll
        for (int ai = 0; ai < 2; ++ai)
#pragma unroll
            for (int m = 0; m < 4; ++m) { const int row = row0 + ai * 128 + m * 16;
                const float* rp = nullptr; if (r0) rp = (row < rsplit) ? r0 + (size_t)row * ldr : r1 + (size_t)(row - rsplit) * ldr;
#pragma unroll
                for (int bj = 0; bj < 2; ++bj)
#pragma unroll
                    for (int n = 0; n < 2; ++n) { const int col = col0 + bj * 128 + n * 16; f32x4 v = acc[ai][bj][m][n];
                        if (r0) v += *(const f32x4*)(rp + col);
                        if (d32) *(f32x4*)(d32 + (size_t)row * ld32 + col) = v;
                        if (d16) { v2u o; o.x = pg8::cvt_pk_bf16(v[0] * sc16, v[1] * sc16); o.y = pg8::cvt_pk_bf16(v[2] * sc16, v[3] * sc16); *(v2u*)(d16 + (size_t)row * ld16 + col) = o; } } }
    }
};
struct EpiInProj {
    static constexpr bool PERM = false, AFTER_DRAIN = false;
    float* out; unsigned char* ws; const float* bff;
    __device__ __forceinline__ void operator()(const f32x4 (&acc)[2][2][4][2], const Unit& u, int wr, int wc, int fr, int fq) const {
        const int pn = u.pn; const bool smp = u.pm >= 64;
        int row0 = u.pm * 256 + wr * 64 + fr;
        int orow0 = (smp ? (u.pm - 64) * 256 : u.pm * 256) + wr * 64 + fr;
        asm volatile("" : "+v"(row0), "+v"(orow0));
        float* d32 = nullptr; int ld32 = 0; bool d32_grp = false; bf16* d16 = nullptr; int ld16 = 0; float s32 = 1.f, s16 = 1.f; int cb = 0;
        if (pn < 2) { d16 = (bf16*)(ws + WS_QF); ld16 = 512; s16 = C2F; cb = pn * 256; }
        else if (pn < 4) { d32 = out + (smp ? O_FKS : O_FKP); ld32 = 512; d32_grp = true; d16 = (bf16*)(ws + WS_KF); ld16 = 512; cb = (pn - 2) * 256; }
        else if (pn < 6) { d32 = out + (smp ? O_FVS : O_FVP); ld32 = 512; d32_grp = true; d16 = (bf16*)(ws + WS_VF); ld16 = 512; cb = (pn - 4) * 256; }
        else if (pn == 6) { d32 = (float*)(ws + WS_GQ); ld32 = 256; s32 = 0.125f; }
        else if (pn == 7) { d32 = (float*)(ws + WS_GK); ld32 = 256; }
        else if (pn < 10) { d32 = (float*)(ws + WS_GV); ld32 = 512; cb = (pn - 8) * 256; }
        else if (pn < 12) { d32 = (float*)(ws + WS_GR); ld32 = 512; cb = (pn - 10) * 256; }
        if (pn < 12) {
#pragma unroll
            for (int ai = 0; ai < 2; ++ai)
#pragma unroll
                for (int m = 0; m < 4; ++m) { const int row = row0 + ai * 128 + m * 16, orow = orow0 + ai * 128 + m * 16;
#pragma unroll
                    for (int bj = 0; bj < 2; ++bj)
#pragma unroll
                        for (int n = 0; n < 2; ++n) { const int col = cb + wc * 32 + fq * 4 + bj * 128 + n * 16; const f32x4 v = acc[ai][bj][m][n];
                            if (d32) *(f32x4*)(d32 + (size_t)(d32_grp ? orow : row) * ld32 + col) = v * s32;
                            if (d16) { v2u o; o.x = pg8::cvt_pk_bf16(v[0] * s16, v[1] * s16); o.y = pg8::cvt_pk_bf16(v[2] * s16, v[3] * s16); *(v2u*)(d16 + (size_t)row * ld16 + col) = o; } } }
        } else {
            if (wc == 0) {
                float* lf = out + (smp ? O_LFS : O_LFP); float* ggp = (float*)(ws + WS_GG);
#pragma unroll
                for (int ai = 0; ai < 2; ++ai)
#pragma unroll
                    for (int m = 0; m < 4; ++m) { const int row = row0 + ai * 128 + m * 16, orow = orow0 + ai * 128 + m * 16;
#pragma unroll
                        for (int n = 0; n < 2; ++n) { const int col = n * 16 + fq * 4; const f32x4 v = acc[ai][0][m][n];
                            if (col < 8) { f32x4 o; const f32x4 b = *(const f32x4*)(bff + col);
                                o[0] = log_sigmoid(v[0] + b[0]); o[1] = log_sigmoid(v[1] + b[1]); o[2] = log_sigmoid(v[2] + b[2]); o[3] = log_sigmoid(v[3] + b[3]);
                                *(f32x4*)(lf + (size_t)orow * 8 + col) = o; }
                            else if (col < 24) *(f32x4*)(ggp + (size_t)row * 16 + (col - 8)) = v; } }
            }
        }
    }
};


__device__ __forceinline__ void p0_prologue(const Frame& F, const Args& a) {
    unsigned char* ws = a.ws;
    LAS float* scr = (LAS float*)(F.lds + F.wave * 16384);
    const int gw = F.vcu * NWAVES + F.wave, NGW = F.G * NWAVES;
    constexpr int I_WINN = 16 * (N_IN / 32), I_SQ = 16 * 32;
    constexpr int NITEMS = I_WINN + 5 * I_SQ;
    for (int it = gw; it < NITEMS; it += NGW) {
        int r = it;
        if (r < I_WINN) { p0_transpose_item<true>((const float*)a.in[I_WIN], 3096, DM, N_IN / 32, (bf16*)(ws + WS_WIN), scr, r, F.lane); continue; } r -= I_WINN;
        const int which = r / I_SQ; r -= which * I_SQ;
        const float* src = (const float*)(which == 0 ? a.in[I_WOUT] : which == 1 ? a.in[I_WMK] : which == 2 ? a.in[I_WMV] : which == 3 ? a.in[I_WCQ] : a.in[I_WCO]);
        bf16* dst = (bf16*)(ws + (which == 0 ? WS_WOUT : which == 1 ? WS_WMK : which == 2 ? WS_WMV : which == 3 ? WS_WCQ : WS_WCO));
        p0_transpose_item<false>(src, DM, DM, 32, dst, scr, r, F.lane);
    }
    for (int m = gw; m < TA + 512; m += NGW) {
        if (m < TP) rms_row_bf16((const float*)a.in[I_XP] + (size_t)m * DM, (const float*)a.in[I_GMIX], (bf16*)(ws + WS_HB) + (size_t)m * DM, F.lane);
        else if (m < TA) rms_row_bf16((const float*)a.in[I_XS] + (size_t)(m - TP) * DM, (const float*)a.in[I_GMIX], (bf16*)(ws + WS_HB) + (size_t)m * DM, F.lane);
        else rms_row_bf16((const float*)a.in[I_MEMP] + (size_t)(m - TA) * DM, (const float*)a.in[I_GMEM], (bf16*)(ws + WS_MB) + (size_t)(m - TA) * DM, F.lane);
    }
    {
        const size_t n8 = (size_t)16384 * 1024 / 8; const size_t gt = (size_t)F.vcu * NTHR + F.tid, NGT = (size_t)F.G * NTHR;
        const f32x4* su = (const f32x4*)a.in[I_PU]; const f32x4* sv = (const f32x4*)a.in[I_PV]; v4u* du = (v4u*)(ws + WS_U16); v4u* dv = (v4u*)(ws + WS_V16);
        for (size_t i = gt; i < 2 * n8; i += NGT) {
            const bool isv = i >= n8; const size_t j = isv ? i - n8 : i; const f32x4* s = (isv ? sv : su) + 2 * j;
            const f32x4 x0 = __builtin_nontemporal_load(s), x1 = __builtin_nontemporal_load(s + 1);
            v4u o; o.x = pk2(x0.x, x0.y); o.y = pk2(x0.z, x0.w); o.z = pk2(x1.x, x1.y); o.w = pk2(x1.z, x1.w);
            (isv ? dv : du)[j] = o;
        }
    }
    __syncthreads();
    for (int it = blockIdx.x; it < 256; it += F.G) {
        const int c = it >> 4, kt = it & 15, half = c & 1;
        LAS float* SK = (LAS float*)F.lds; LAS float* WT = (LAS float*)(F.lds + 128 * 129 * 4);
        const float* sk = (const float*)a.in[I_PSK] + (size_t)half * 128 * 128; const float* wq = (const float*)a.in[I_PWQ] + (size_t)(kt * 64) * 2048 + c * 128;
#pragma unroll 4
        for (int i = 0; i < 32; ++i) { const int idx = F.tid + 512 * i; SK[(idx >> 7) * 129 + (idx & 127)] = sk[idx]; }
#pragma unroll 4
        for (int i = 0; i < 16; ++i) { const int idx = F.tid + 512 * i; WT[(idx >> 7) * 129 + (idx & 127)] = wq[(size_t)(idx >> 7) * 2048 + (idx & 127)]; }
        __syncthreads();
        const int tk = F.tid & 15, tkey = F.tid >> 4;
        float acc[4][4];
#pragma unroll
        for (int i = 0; i < 4; ++i)
#pragma unroll
            for (int j = 0; j < 4; ++j) acc[i][j] = 0.f;
        for (int j = 0; j < 128; ++j) {
            float av[4], bv[4];
#pragma unroll
            for (int i = 0; i < 4; ++i) { av[i] = SK[(4 * tkey + i) * 129 + j]; bv[i] = WT[(4 * tk + i) * 129 + j]; }
#pragma unroll
            for (int i = 0; i < 4; ++i)
#pragma unroll
                for (int i2 = 0; i2 < 4; ++i2) acc[i][i2] += av[i] * bv[i2];
        }
        bf16* wp = (bf16*)(ws + WS_WPK);
#pragma unroll
        for (int i = 0; i < 4; ++i) { v2u o; o.x = pk2(acc[i][0], acc[i][1]); o.y = pk2(acc[i][2], acc[i][3]); *(v2u*)(wp + (size_t)(c * 128 + 4 * tkey + i) * DM + kt * 64 + 4 * tk) = o; }
        __syncthreads();
    }
}


__device__ __forceinline__ void fox_prompt_cumsum(const Frame& F, const float* logf  , float* kbias, int b) {
    LAS float* WT = (LAS float*)F.lds;
    const int t0 = F.wave * 1024 + F.lane * 16;
    const f32x4* src = (const f32x4*)(logf + ((size_t)b * SEQ + t0) * 8);
    float s[8];
#pragma unroll
    for (int h = 0; h < 8; ++h) s[h] = 0.f;
#pragma unroll 4
    for (int i = 0; i < 16; ++i) { const f32x4 a = src[2 * i], c = src[2 * i + 1]; s[0] += a.x; s[1] += a.y; s[2] += a.z; s[3] += a.w; s[4] += c.x; s[5] += c.y; s[6] += c.z; s[7] += c.w; }
    float ex[8];
#pragma unroll
    for (int h = 0; h < 8; ++h) { float v = s[h];
#pragma unroll
        for (int o = 1; o < 64; o <<= 1) { const float t = __shfl_up(v, o); if (F.lane >= o) v += t; }
        ex[h] = v - s[h];
        if (F.lane == 63) WT[F.wave * 8 + h] = v; }
    __syncthreads();
#pragma unroll
    for (int h = 0; h < 8; ++h) { float c = 0.f; for (int w = 0; w < F.wave; ++w) c += WT[w * 8 + h]; ex[h] += c; }
    float* dst = kbias + (size_t)(b * 8) * SEQ + t0;
#pragma unroll 4
    for (int i = 0; i < 16; ++i) { const f32x4 a = src[2 * i], c = src[2 * i + 1];
        ex[0] += a.x; ex[1] += a.y; ex[2] += a.z; ex[3] += a.w; ex[4] += c.x; ex[5] += c.y; ex[6] += c.z; ex[7] += c.w;
#pragma unroll
        for (int h = 0; h < 8; ++h) dst[(size_t)h * SEQ + i] = -ex[h] * LOG2E; }
    __syncthreads();
}
__device__ __forceinline__ void fox_sample_suffix(const Frame& F, const float* cfl, const int* pt, float* suf, int bs) {
    float carry[8];
#pragma unroll
    for (int h = 0; h < 8; ++h) carry[h] = 0.f;
    for (int p = NPAGES - 1; p >= 0; --p) {
        const int pg = pt[bs * NPAGES + p];
        const f32x4* src = (const f32x4*)(cfl + ((size_t)pg * PAGE + 2 * F.lane) * 8);
        const f32x4 a0 = src[0], a1 = src[1], b0 = src[2], b1 = src[3];
        const float ra[8] = {a0.x, a0.y, a0.z, a0.w, a1.x, a1.y, a1.z, a1.w}, rb[8] = {b0.x, b0.y, b0.z, b0.w, b1.x, b1.y, b1.z, b1.w};
#pragma unroll
        for (int h = 0; h < 8; ++h) {
            const float ps = ra[h] + rb[h]; float v = ps;
#pragma unroll
            for (int o = 1; o < 64; o <<= 1) { const float t = __shfl_down(v, o); if (F.lane + o < 64) v += t; }
            const float exs = v - ps;
            float* d = suf + (size_t)(bs * 8 + h) * PASTL + p * PAGE + 2 * F.lane;
            d[1] = (carry[h] + exs) * LOG2E; d[0] = (carry[h] + exs + rb[h]) * LOG2E;
            carry[h] += __shfl(v, 0);
        }
    }
}

__device__ __forceinline__ void gla_gate_tile(const Frame& F, const float* gg, const float* w2, const float* bg, int row0, int h, int nt, LAS float* LA) {
    for (int e = F.tid; e < nt * 64; e += NTHR) { const int t = e >> 6, dk = e & 63; const float* g = gg + (size_t)(row0 + t) * 16; float z = bg[h * 64 + dk];
#pragma unroll
        for (int r = 0; r < 16; ++r) z += g[r] * w2[r * 256 + h * 64 + dk];
        LA[t * 64 + dk] = log_sigmoid(z) * (1.f / 16.f); }
}
__device__ __forceinline__ void gla_g1_unit(const Frame& F, const Args& a, int u) {
    unsigned char* ws = a.ws;
    const int b = u >> 9, h = (u >> 7) & 3, n = u & 127; const int row0 = b * SEQ + n * 64;
    LAS float* LA = (LAS float*)F.lds; LAS float* KR = LA + 4096; LAS float* BL = KR + 4096;
    gla_gate_tile(F, (const float*)(ws + WS_GG), (const float*)a.in[I_WG2], (const float*)a.in[I_BG], row0, h, 64, LA);
    __syncthreads();
    if (F.tid < 64) { float run = 0.f; for (int t = 0; t < 64; ++t) { run += LA[t * 64 + F.tid]; LA[t * 64 + F.tid] = run; } BL[F.tid] = run;
        ((float*)(ws + WS_GDEC))[(size_t)((b * 4 + h) * 128 + n) * 64 + F.tid] = __expf(run); }
    __syncthreads();
    const float* gk = (const float*)(ws + WS_GK);
    for (int e = F.tid; e < 4096; e += NTHR) { const int t = e >> 6, dk = e & 63; KR[e] = gk[(size_t)(row0 + t) * 256 + h * 64 + dk] * __expf(BL[dk] - LA[e]); }
    __syncthreads();
    const int dv = F.tid & 127, dkg = F.tid >> 7;
    float acc[16];
#pragma unroll
    for (int i = 0; i < 16; ++i) acc[i] = 0.f;
    const float* gv = (const float*)(ws + WS_GV) + (size_t)row0 * 512 + h * 128 + dv;
#pragma unroll 4
    for (int t = 0; t < 64; ++t) { const float v = gv[(size_t)t * 512]; const LAS f32x4* kr = (const LAS f32x4*)(KR + t * 64 + dkg * 16);
#pragma unroll
        for (int q = 0; q < 4; ++q) { const f32x4 k4 = kr[q]; acc[4 * q] += k4.x * v; acc[4 * q + 1] += k4.y * v; acc[4 * q + 2] += k4.z * v; acc[4 * q + 3] += k4.w * v; } }
    float* kv = (float*)(ws + WS_GKV) + ((size_t)((b * 4 + h) * 128 + n) * 64 + dkg * 16) * 128 + dv;
#pragma unroll
    for (int i = 0; i < 16; ++i) kv[(size_t)i * 128] = acc[i];
    __syncthreads();
}
__device__ __forceinline__ void gla_scan(const Frame& F, const Args& a) {
    if (F.tid >= 256) return;
    for (int e = F.vcu * 256 + F.tid; e < 65536; e += F.G * 256) {
    const int bh = e >> 13, dk = (e >> 7) & 63, dv = e & 127;
    float* kv = (float*)(a.ws + WS_GKV) + ((size_t)bh * 128 * 64 + dk) * 128 + dv; const float* dc = (const float*)(a.ws + WS_GDEC) + (size_t)bh * 128 * 64 + dk;
    float S = 0.f;
    for (int n0 = 0; n0 < 128; n0 += 8) { float kvv[8], dd[8];
#pragma unroll
        for (int j = 0; j < 8; ++j) { kvv[j] = kv[(size_t)(n0 + j) * 8192]; dd[j] = dc[(size_t)(n0 + j) * 64]; }
#pragma unroll
        for (int j = 0; j < 8; ++j) { kv[(size_t)(n0 + j) * 8192] = S; S = dd[j] * S + kvv[j]; } }
    a.out[O_GSP + (size_t)bh * 8192 + dk * 128 + dv] = S;
    }
}
__device__ __forceinline__ float silu(float x) { return x / (1.f + __expf(-x)); }
__device__ __forceinline__ void gla_sample_unit(const Frame& F, const Args& a, int u) {
    unsigned char* ws = a.ws;
    const int bs = u >> 2, h = u & 3; const int row0 = TP + bs * LS;
    LAS float* LA = (LAS float*)F.lds; LAS float* BL = LA + 512; LAS float* QD = BL + 64; LAS float* KI = QD + 512; LAS float* KR = KI + 512; LAS float* ATT = KR + 512; LAS float* OP = ATT + 64; LAS float* VS = OP + 4096;
    gla_gate_tile(F, (const float*)(ws + WS_GG), (const float*)a.in[I_WG2], (const float*)a.in[I_BG], row0, h, 8, LA);
    for (int e = F.tid; e < 1024; e += NTHR) VS[e] = ((const float*)(ws + WS_GV))[(size_t)(row0 + (e >> 7)) * 512 + h * 128 + (e & 127)];
    __syncthreads();
    if (F.tid < 64) { float run = 0.f;
#pragma unroll
        for (int t = 0; t < 8; ++t) { run += LA[t * 64 + F.tid]; LA[t * 64 + F.tid] = run; } BL[F.tid] = run; }
    __syncthreads();
    { const int e = F.tid, t = e >> 6, dk = e & 63; const float bb = LA[e];
      const float q = ((const float*)(ws + WS_GQ))[(size_t)(row0 + t) * 256 + h * 64 + dk], k = ((const float*)(ws + WS_GK))[(size_t)(row0 + t) * 256 + h * 64 + dk];
      QD[e] = q * __expf(bb); KI[e] = k * __expf(-bb); KR[e] = k * __expf(BL[dk] - bb); }
    __syncthreads();
    if (F.tid < 64) { const int t = F.tid >> 3, s = F.tid & 7; float acc = 0.f;
        if (s <= t) { for (int dk = 0; dk < 64; ++dk) acc += QD[t * 64 + dk] * KI[s * 64 + dk]; }
        ATT[F.tid] = acc; }
    const int dv = F.tid & 127, dkg = F.tid >> 7;
    {
        const float* st = (const float*)a.in[I_SGLA] + ((size_t)(bs * 4 + h) * 64 + dkg * 16) * 128 + dv;
        float S0[16];
#pragma unroll
        for (int i = 0; i < 16; ++i) S0[i] = st[(size_t)i * 128];
#pragma unroll
        for (int t = 0; t < 8; ++t) { float o = 0.f;
#pragma unroll
            for (int i = 0; i < 16; ++i) o += QD[t * 64 + dkg * 16 + i] * S0[i];
            OP[(dkg * 8 + t) * 128 + dv] = o; }
        float* so = a.out + O_GSS + ((size_t)(bs * 4 + h) * 64 + dkg * 16) * 128 + dv;
#pragma unroll
        for (int i = 0; i < 16; ++i) { float sn = __expf(BL[dkg * 16 + i]) * S0[i];
#pragma unroll
            for (int t = 0; t < 8; ++t) sn += KR[t * 64 + dkg * 16 + i] * VS[t * 128 + dv];
            so[(size_t)i * 128] = sn; }
    }
    __syncthreads();
    {
        const int t = F.wave; float o[2]; float ss = 0.f;
#pragma unroll
        for (int j = 0; j < 2; ++j) { const int d = 2 * F.lane + j; float v = OP[(0 * 8 + t) * 128 + d] + OP[(1 * 8 + t) * 128 + d] + OP[(2 * 8 + t) * 128 + d] + OP[(3 * 8 + t) * 128 + d];
            for (int s = 0; s <= t; ++s) v += ATT[t * 8 + s] * VS[s * 128 + d];
            o[j] = v; ss += v * v; }
        const float r = rsqrtf(wave_sum(ss) * (1.f / 128.f) + EPS);
        const float* ggo = (const float*)a.in[I_GGO] + h * 128 + 2 * F.lane; const float* gr = (const float*)(ws + WS_GR) + (size_t)(row0 + t) * 512 + h * 128 + 2 * F.lane;
        const float y0 = o[0] * r * ggo[0] * silu(gr[0]), y1 = o[1] * r * ggo[1] * silu(gr[1]);
        *(unsigned*)((bf16*)(ws + WS_MERGED) + (size_t)(row0 + t) * DM + 512 + h * 128 + 2 * F.lane) = pk2(y0, y1);
    }
    __syncthreads();
}


typedef short v4i16_t __attribute__((ext_vector_type(4)));
__device__ __forceinline__ s16x4 lds_tr16(LAS unsigned char* p) { return __builtin_bit_cast(s16x4, __builtin_amdgcn_ds_read_tr16_b64_v4i16((LAS v4i16_t*)p)); }
__device__ __forceinline__ int crow(int r, int hi) { return (r & 3) + 8 * (r >> 2) + 4 * hi; }
__device__ __forceinline__ float fexp2(float x) { return __builtin_amdgcn_exp2f(x); }

__device__ __forceinline__ void fox_attn_unit(const Frame& F, const bf16* QF, const bf16* KF, const bf16* VF, const float* kbias, bf16* merged, int b, int h, int qb) {
    const int lane = F.lane, r32 = lane & 31, hi = lane >> 5, wid = F.wave, tid = F.tid;
    const size_t rowbase = (size_t)b * SEQ; const int q0 = qb * 256;
    LAS unsigned char* Ks = F.lds; LAS unsigned char* Vs = F.lds + 8192; LAS float* KBs = (LAS float*)(F.lds + 20480); LAS float* WSF = (LAS float*)(F.lds + 20736) + wid * 32;
    const bf16* Qw = QF + (rowbase + q0 + wid * 32 + r32) * 512 + h * 64;
    bf16x8 qr[4];
#pragma unroll
    for (int d0 = 0; d0 < 4; ++d0) qr[d0] = *(const bf16x8*)(Qw + d0 * 16 + hi * 8);
    const float* kbp = kbias + (size_t)(b * 8 + h) * SEQ; const float kbref = kbp[q0];
    const int NT = (q0 + 256) / 64;
    const int kkey = tid & 63, kch = tid >> 6, vkey = tid >> 3, vch = tid & 7;
    const bf16* ksrc = KF + (rowbase + kkey) * 512 + h * 64 + kch * 8;
    const bf16* vsrc = VF + (rowbase + vkey) * 512 + h * 64 + vch * 8;
    v4u kreg = *(const v4u*)ksrc, vreg = *(const v4u*)vsrc; float kbreg = (tid < 64) ? kbp[tid] - kbref : 0.f;
    float m_run = -INFINITY, l_run = 0.f; f32x16 o0 = {}, o1 = {};
    const int qpos = q0 + wid * 32 + r32;
    const int vbase = (4 * hi + ((lane & 15) >> 2)) * 192 + (16 * ((lane >> 4) & 1) + 4 * (lane & 3)) * 2;
    for (int t = 0; t < NT; ++t) {
        __syncthreads();
        *(LAS v4u*)(Ks + kch * 1024 + kkey * 16) = kreg; *(LAS v4u*)(Vs + vkey * 192 + vch * 16) = vreg; if (tid < 64) KBs[tid] = kbreg;
        __syncthreads();
        if (t + 1 < NT) { kreg = *(const v4u*)(ksrc + (size_t)(t + 1) * 64 * 512); vreg = *(const v4u*)(vsrc + (size_t)(t + 1) * 64 * 512); if (tid < 64) kbreg = kbp[(t + 1) * 64 + tid] - kbref; }
        const int k0 = t * 64;
        if (k0 > q0 + wid * 32 + 31) continue;
        f32x16 p0 = {}, p1 = {};
#pragma unroll
        for (int d0 = 0; d0 < 4; ++d0) {
            const bf16x8 a0 = *(const LAS bf16x8*)(Ks + (2 * d0 + hi) * 1024 + r32 * 16), a1 = *(const LAS bf16x8*)(Ks + (2 * d0 + hi) * 1024 + r32 * 16 + 512);
            p0 = __builtin_amdgcn_mfma_f32_32x32x16_bf16(a0, qr[d0], p0, 0, 0, 0); p1 = __builtin_amdgcn_mfma_f32_32x32x16_bf16(a1, qr[d0], p1, 0, 0, 0);
        }
#pragma unroll
        for (int g = 0; g < 4; ++g) { const f32x4 ba = *(const LAS f32x4*)(KBs + 8 * g + 4 * hi), bb = *(const LAS f32x4*)(KBs + 32 + 8 * g + 4 * hi);
#pragma unroll
            for (int i = 0; i < 4; ++i) { p0[4 * g + i] += ba[i]; p1[4 * g + i] += bb[i]; } }
        if (k0 + 63 > q0 + wid * 32) {
#pragma unroll
            for (int r = 0; r < 16; ++r) { const int key = k0 + crow(r, hi); if (key > qpos) p0[r] = -INFINITY; if (key + 32 > qpos) p1[r] = -INFINITY; }
        }
        float mx = fmaxf(p0[0], p1[0]);
#pragma unroll
        for (int r = 1; r < 16; ++r) mx = fmaxf(mx, fmaxf(p0[r], p1[r]));
        mx = fmaxf(mx, __shfl_xor(mx, 32));
        const float m_new = fmaxf(m_run, mx), alpha = fexp2(m_run - m_new); m_run = m_new;
        float ls = 0.f;
#pragma unroll
        for (int r = 0; r < 16; ++r) { p0[r] = fexp2(p0[r] - m_new); p1[r] = fexp2(p1[r] - m_new); ls += p0[r] + p1[r]; }
        l_run = l_run * alpha + ls;
        if (hi == 0) WSF[r32] = alpha;
#pragma unroll
        for (int g = 0; g < 4; ++g) { const f32x4 al = *(const LAS f32x4*)(WSF + 8 * g + 4 * hi);
#pragma unroll
            for (int i = 0; i < 4; ++i) { o0[4 * g + i] *= al[i]; o1[4 * g + i] *= al[i]; } }
        v4u pw[4];
#pragma unroll
        for (int j = 0; j < 4; ++j) { pw[0][j] = pg8::cvt_pk_bf16(p0[2 * j], p0[2 * j + 1]); pw[1][j] = pg8::cvt_pk_bf16(p0[8 + 2 * j], p0[8 + 2 * j + 1]);
                                      pw[2][j] = pg8::cvt_pk_bf16(p1[2 * j], p1[2 * j + 1]); pw[3][j] = pg8::cvt_pk_bf16(p1[8 + 2 * j], p1[8 + 2 * j + 1]); }
#pragma unroll
        for (int ks = 0; ks < 4; ++ks) {
            const bf16x8 pa = __builtin_bit_cast(bf16x8, pw[ks]);
#pragma unroll
            for (int d0 = 0; d0 < 2; ++d0) {
                const s16x4 lo = lds_tr16(Vs + vbase + ks * 16 * 192 + d0 * 64), hi4 = lds_tr16(Vs + vbase + ks * 16 * 192 + 8 * 192 + d0 * 64);
                const bf16x8 vb = (bf16x8){lo[0], lo[1], lo[2], lo[3], hi4[0], hi4[1], hi4[2], hi4[3]};
                if (d0 == 0) o0 = __builtin_amdgcn_mfma_f32_32x32x16_bf16(pa, vb, o0, 0, 0, 0); else o1 = __builtin_amdgcn_mfma_f32_32x32x16_bf16(pa, vb, o1, 0, 0, 0);
            }
        }
    }
    l_run += __shfl_xor(l_run, 32);
    if (hi == 0) WSF[r32] = 1.f / l_run;
    bf16* Ow = merged + (rowbase + q0 + wid * 32) * DM + h * 64 + r32;
#pragma unroll
    for (int g = 0; g < 4; ++g) { const f32x4 rl = *(const LAS f32x4*)(WSF + 8 * g + 4 * hi);
#pragma unroll
        for (int i = 0; i < 4; ++i) { const int r = 4 * g + i; const int row = crow(r, hi);
            Ow[(size_t)row * DM] = (bf16)f2bf(o0[r] * rl[i]); Ow[(size_t)row * DM + 32] = (bf16)f2bf(o1[r] * rl[i]); } }
    __syncthreads();
}

template <int D> struct DecW {
    static constexpr int KS = D / 32;
    static constexpr int LPK = D / 4;
    static constexpr int KPI = 64 / LPK;
    float m[4], l[4]; float o[8][4];
};
template <int D>
__device__ __forceinline__ void dec_init(DecW<D>& w) {
#pragma unroll
    for (int i = 0; i < 4; ++i) { w.m[i] = -INFINITY; w.l[i] = 0.f; }
#pragma unroll
    for (int q = 0; q < 8; ++q)
#pragma unroll
        for (int j = 0; j < 4; ++j) w.o[q][j] = 0.f;
}
template <int D, int NTILE, int MODE>
__device__ __forceinline__ void dec_chunk(DecW<D>& w, const bf16x8 (&qa)[D / 32], const float* Kb, const float* Vb, int stride, const float* bias, float nb, LAS float* PL, int lane) {
    constexpr int KS = D / 32, LPK = D / 4, KPI = 64 / LPK;
    const int key = lane & 15, kq = lane >> 4;
    f32x4 s[NTILE];
#pragma unroll
    for (int t = 0; t < NTILE; ++t) {
        const float* kp = Kb + (size_t)(t * 16 + key) * stride + 8 * kq;
        f32x4 acc = {0.f, 0.f, 0.f, 0.f};
#pragma unroll
        for (int ks = 0; ks < KS; ++ks) { const f32x4 x0 = *(const f32x4*)(kp + 32 * ks), x1 = *(const f32x4*)(kp + 32 * ks + 4);
            v4u kb; kb.x = pg8::cvt_pk_bf16(x0.x, x0.y); kb.y = pg8::cvt_pk_bf16(x0.z, x0.w); kb.z = pg8::cvt_pk_bf16(x1.x, x1.y); kb.w = pg8::cvt_pk_bf16(x1.z, x1.w);
            acc = __builtin_amdgcn_mfma_f32_16x16x32_bf16(qa[ks], __builtin_bit_cast(bf16x8, kb), acc, 0, 0, 0); }
        if (MODE == 0) { if (bias) { const float bv = bias[t * 16 + key]; acc += bv; } }
        else { acc += nb;
#pragma unroll
            for (int i = 0; i < 4; ++i) if (key > 4 * kq + i || key >= 8) acc[i] = -INFINITY; }
        s[t] = acc;
    }
    f32x4 mc = s[0];
#pragma unroll
    for (int t = 1; t < NTILE; ++t) { mc.x = fmaxf(mc.x, s[t].x); mc.y = fmaxf(mc.y, s[t].y); mc.z = fmaxf(mc.z, s[t].z); mc.w = fmaxf(mc.w, s[t].w); }
#pragma unroll
    for (int o = 1; o < 16; o <<= 1) { mc.x = fmaxf(mc.x, __shfl_xor(mc.x, o)); mc.y = fmaxf(mc.y, __shfl_xor(mc.y, o)); mc.z = fmaxf(mc.z, __shfl_xor(mc.z, o)); mc.w = fmaxf(mc.w, __shfl_xor(mc.w, o)); }
    float al[4];
#pragma unroll
    for (int i = 0; i < 4; ++i) { const float mn = fmaxf(w.m[i], mc[i]); al[i] = (mn == -INFINITY) ? 1.f : fexp2(w.m[i] - mn); w.m[i] = mn; w.l[i] *= al[i]; }
#pragma unroll
    for (int t = 0; t < NTILE; ++t) { f32x4 p;
#pragma unroll
        for (int i = 0; i < 4; ++i) { p[i] = (w.m[i] == -INFINITY) ? 0.f : fexp2(s[t][i] - w.m[i]); w.l[i] += p[i]; }
        if (kq < 2) *(LAS f32x4*)(PL + (t * 16 + key) * 8 + 4 * kq) = p; }
    if (key == 0 && kq < 2) *(LAS f32x4*)(PL + 1024 + 4 * kq) = (f32x4){al[0], al[1], al[2], al[3]};
    const int d4 = lane % LPK, ksub = lane / LPK;
    { const f32x4 a0 = *(const LAS f32x4*)(PL + 1024), a1 = *(const LAS f32x4*)(PL + 1028);
#pragma unroll
      for (int j = 0; j < 4; ++j) { w.o[0][j] *= a0.x; w.o[1][j] *= a0.y; w.o[2][j] *= a0.z; w.o[3][j] *= a0.w; w.o[4][j] *= a1.x; w.o[5][j] *= a1.y; w.o[6][j] *= a1.z; w.o[7][j] *= a1.w; } }
    constexpr int NK = (MODE == 1) ? 8 : NTILE * 16;
#pragma unroll 8
    for (int kk = 0; kk < NK / KPI; ++kk) { const int k = kk * KPI + ksub;
        const f32x4 v = *(const f32x4*)(Vb + (size_t)k * stride + 4 * d4);
        const f32x4 pa = *(const LAS f32x4*)(PL + k * 8), pb = *(const LAS f32x4*)(PL + k * 8 + 4);
#pragma unroll
        for (int j = 0; j < 4; ++j) { w.o[0][j] += pa.x * v[j]; w.o[1][j] += pa.y * v[j]; w.o[2][j] += pa.z * v[j]; w.o[3][j] += pa.w * v[j];
                                      w.o[4][j] += pb.x * v[j]; w.o[5][j] += pb.y * v[j]; w.o[6][j] += pb.z * v[j]; w.o[7][j] += pb.w * v[j]; } }
}
template <int D>
__device__ __forceinline__ void dec_park(DecW<D>& w, LAS float* CBw, int lane) {
    constexpr int LPK = D / 4;
    const int key = lane & 15, kq = lane >> 4, d4 = lane % LPK, ksub = lane / LPK;
#pragma unroll
    for (int i = 0; i < 4; ++i) { float l = w.l[i];
#pragma unroll
        for (int o = 1; o < 16; o <<= 1) l += __shfl_xor(l, o);
        w.l[i] = l; }
    if (key == 0 && kq < 2) { *(LAS f32x4*)(CBw + 4 * kq) = (f32x4){w.m[0], w.m[1], w.m[2], w.m[3]}; *(LAS f32x4*)(CBw + 8 + 4 * kq) = (f32x4){w.l[0], w.l[1], w.l[2], w.l[3]}; }
#pragma unroll
    for (int q = 0; q < 8; ++q) { f32x4 v = (f32x4){w.o[q][0], w.o[q][1], w.o[q][2], w.o[q][3]};
        if (LPK < 64) {
#pragma unroll
            for (int o = LPK; o < 64; o <<= 1) { v.x += __shfl_xor(v.x, o); v.y += __shfl_xor(v.y, o); v.z += __shfl_xor(v.z, o); v.w += __shfl_xor(v.w, o); } }
        if (ksub == 0) *(LAS f32x4*)(CBw + 16 + q * D + 4 * d4) = v; }
}
template <int D>
__device__ __forceinline__ void dec_combine(const Frame& F, LAS float* CB, bf16* dst, int ldd) {
    constexpr int WSTR = 16 + 8 * D;
    for (int e = F.tid; e < 8 * D; e += NTHR) { const int q = e / D, d = e % D;
        float mt = -INFINITY;
#pragma unroll
        for (int w = 0; w < 8; ++w) mt = fmaxf(mt, CB[w * WSTR + q]);
        float num = 0.f, den = 0.f;
#pragma unroll
        for (int w = 0; w < 8; ++w) { const float mw = CB[w * WSTR + q]; const float f = (mw == -INFINITY) ? 0.f : fexp2(mw - mt); num += f * CB[w * WSTR + 16 + q * D + d]; den += f * CB[w * WSTR + 8 + q]; }
        dst[(size_t)q * ldd + d] = (bf16)f2bf(num / den); }
}
template <int D>
__device__ __forceinline__ void dec_load_q(bf16x8 (&qa)[D / 32], const bf16* Q, int ldq, int lane) {
    const int row = lane & 15, kq = lane >> 4;
#pragma unroll
    for (int ks = 0; ks < D / 32; ++ks) { v4u z = {0u, 0u, 0u, 0u}; if (row < 8) z = *(const v4u*)(Q + (size_t)row * ldq + 32 * ks + 8 * kq); qa[ks] = __builtin_bit_cast(bf16x8, z); }
}
constexpr int DEC_PL = 1040;
__device__ __forceinline__ void fox_sample_unit(const Frame& F, const Args& a, int u) {
    unsigned char* ws = a.ws; const int bs = u >> 3, h = u & 7;
    LAS float* PL = (LAS float*)F.lds + F.wave * DEC_PL; LAS float* CB = (LAS float*)F.lds + 8 * DEC_PL; constexpr int WSTR = 16 + 8 * 64;
    bf16x8 qa[2]; dec_load_q<64>(qa, (const bf16*)(ws + WS_QF) + (size_t)(TP + bs * LS) * 512 + h * 64, 512, F.lane);
    DecW<64> w; dec_init(w);
    const int* pt = (const int*)a.in[I_PT];
#pragma unroll 1
    for (int pp = 0; pp < 2; ++pp) { const int p = F.wave * 2 + pp; const int pg = pt[bs * NPAGES + p];
        const float* Kb = (const float*)a.in[I_CFK] + ((size_t)pg * PAGE * 8 + h) * 64; const float* Vb = (const float*)a.in[I_CFV] + ((size_t)pg * PAGE * 8 + h) * 64;
        dec_chunk<64, 8, 0>(w, qa, Kb, Vb, 512, (const float*)(ws + WS_SUF) + (size_t)(bs * 8 + h) * PASTL + p * PAGE, 0.f, PL, F.lane); }
    if (F.wave == 0) {
        const int key = F.lane & 15; const float* lf = a.out + O_LFS + (size_t)(bs * LS) * 8 + h; float cn = 0.f;
        for (int j = 0; j < 8; ++j) if (j <= key) cn += lf[j * 8];
        const float* Kb = a.out + O_FKS + (size_t)(bs * LS) * 512 + h * 64; const float* Vb = a.out + O_FVS + (size_t)(bs * LS) * 512 + h * 64;
        dec_chunk<64, 1, 1>(w, qa, Kb, Vb, 512, nullptr, -cn * LOG2E, PL, F.lane);
    }
    dec_park<64>(w, CB + F.wave * WSTR, F.lane);
    __syncthreads();
    dec_combine<64>(F, CB, (bf16*)(ws + WS_MERGED) + (size_t)(TP + bs * LS) * DM + h * 64, DM);
    __syncthreads();
}
__device__ __forceinline__ void cross_sample_unit(const Frame& F, const Args& a, int u) {
    unsigned char* ws = a.ws; const int bs = u >> 2, h = u & 3;
    LAS float* PL = (LAS float*)F.lds + F.wave * DEC_PL; LAS float* CB = (LAS float*)F.lds + 8 * DEC_PL; constexpr int WSTR = 16 + 8 * 256;
    bf16x8 qa[8]; dec_load_q<256>(qa, (const bf16*)(ws + WS_QC) + (size_t)(TP + bs * LS) * DM + h * 256, DM, F.lane);
    DecW<256> w; dec_init(w);
    const float* Kb = (const float*)a.in[I_CMK] + ((size_t)(bs * 256 + F.wave * 32) * 4 + h) * 256; const float* Vb = (const float*)a.in[I_CMV] + ((size_t)(bs * 256 + F.wave * 32) * 4 + h) * 256;
    dec_chunk<256, 2, 0>(w, qa, Kb, Vb, 1024, nullptr, 0.f, PL, F.lane);
    dec_park<256>(w, CB + F.wave * WSTR, F.lane);
    __syncthreads();
    dec_combine<256>(F, CB, (bf16*)(ws + WS_OC) + (size_t)(TP + bs * LS) * DM + h * 256, DM);
    __syncthreads();
}


__device__ __forceinline__ void gla_g3_unit(const Frame& F, const Args& a, int u) {
    unsigned char* ws = a.ws;
    const int b = u >> 9, h = (u >> 7) & 3, n = u & 127; const int row0 = b * SEQ + n * 64;
    LAS float* QDT = (LAS float*)F.lds; LAS float* KIT = QDT + 4352; LAS float* LA = KIT + 4352; LAS float* ATT = LA; LAS float* VS = LA + 4352; LAS float* SP = VS + 8192;
    gla_gate_tile(F, (const float*)(ws + WS_GG), (const float*)a.in[I_WG2], (const float*)a.in[I_BG], row0, h, 64, LA);
    for (int e = F.tid; e < 8192; e += NTHR) { VS[e] = ((const float*)(ws + WS_GV))[(size_t)(row0 + (e >> 7)) * 512 + h * 128 + (e & 127)];
        SP[e] = ((const float*)(ws + WS_GKV))[((size_t)((b * 4 + h) * 128 + n) * 64) * 128 + e]; }
    __syncthreads();
    if (F.tid < 64) { float run = 0.f; for (int t = 0; t < 64; ++t) { run += LA[t * 64 + F.tid]; LA[t * 64 + F.tid] = run; } }
    __syncthreads();
    float qv[8], kvv[8];
#pragma unroll
    for (int i = 0; i < 8; ++i) { const int e = F.tid + NTHR * i, t = e >> 6, dk = e & 63; const float bb = LA[e];
        qv[i] = ((const float*)(ws + WS_GQ))[(size_t)(row0 + t) * 256 + h * 64 + dk] * __expf(bb); kvv[i] = ((const float*)(ws + WS_GK))[(size_t)(row0 + t) * 256 + h * 64 + dk] * __expf(-bb); }
    __syncthreads();
#pragma unroll
    for (int i = 0; i < 8; ++i) { const int e = F.tid + NTHR * i, t = e >> 6, dk = e & 63; QDT[dk * 68 + t] = qv[i]; KIT[dk * 68 + t] = kvv[i]; }
    __syncthreads();
    {
        const int tp = F.tid & 31, sq = F.tid >> 5; float acc[2][4];
#pragma unroll
        for (int i = 0; i < 2; ++i)
#pragma unroll
            for (int j = 0; j < 4; ++j) acc[i][j] = 0.f;
        if (4 * sq <= 2 * tp + 1) {
#pragma unroll 8
            for (int dk = 0; dk < 64; ++dk) { const f32x2 q2 = *(const LAS f32x2*)(QDT + dk * 68 + 2 * tp); const f32x4 k4 = *(const LAS f32x4*)(KIT + dk * 68 + 4 * sq);
#pragma unroll
                for (int j = 0; j < 4; ++j) { acc[0][j] += q2.x * k4[j]; acc[1][j] += q2.y * k4[j]; } }
        }
#pragma unroll
        for (int j = 0; j < 4; ++j) { const int s = 4 * sq + j; f32x2 o; o.x = (s <= 2 * tp) ? acc[0][j] : 0.f; o.y = (s <= 2 * tp + 1) ? acc[1][j] : 0.f; *(LAS f32x2*)(ATT + s * 68 + 2 * tp) = o; }
    }
    __syncthreads();
    const int dv = F.tid & 127, tg = F.tid >> 7;
    float acc[16];
#pragma unroll
    for (int i = 0; i < 16; ++i) acc[i] = 0.f;
#pragma unroll 4
    for (int s = 0; s < 64; ++s) { const float v = VS[s * 128 + dv];
#pragma unroll
        for (int j = 0; j < 4; ++j) { const f32x4 a4 = *(const LAS f32x4*)(ATT + s * 68 + 16 * tg + 4 * j); acc[4 * j] += a4.x * v; acc[4 * j + 1] += a4.y * v; acc[4 * j + 2] += a4.z * v; acc[4 * j + 3] += a4.w * v; } }
#pragma unroll 4
    for (int dk = 0; dk < 64; ++dk) { const float v = SP[dk * 128 + dv];
#pragma unroll
        for (int j = 0; j < 4; ++j) { const f32x4 a4 = *(const LAS f32x4*)(QDT + dk * 68 + 16 * tg + 4 * j); acc[4 * j] += a4.x * v; acc[4 * j + 1] += a4.y * v; acc[4 * j + 2] += a4.z * v; acc[4 * j + 3] += a4.w * v; } }
    __syncthreads();
#pragma unroll
    for (int i = 0; i < 16; ++i) VS[(16 * tg + i) * 128 + dv] = acc[i];
    __syncthreads();
#pragma unroll 1
    for (int rr = 0; rr < 8; ++rr) { const int t = F.wave * 8 + rr; const float v0 = VS[t * 128 + F.lane], v1 = VS[t * 128 + 64 + F.lane];
        const float r = rsqrtf(wave_sum(v0 * v0 + v1 * v1) * (1.f / 128.f) + EPS);
        const float* ggo = (const float*)a.in[I_GGO] + h * 128; const float* gr = (const float*)(ws + WS_GR) + (size_t)(row0 + t) * 512 + h * 128;
        bf16* mo = (bf16*)(ws + WS_MERGED) + (size_t)(row0 + t) * DM + 512 + h * 128;
        mo[F.lane] = (bf16)f2bf(v0 * r * ggo[F.lane] * silu(gr[F.lane])); mo[64 + F.lane] = (bf16)f2bf(v1 * r * ggo[64 + F.lane] * silu(gr[64 + F.lane])); }
    __syncthreads();
}

struct EpiSoftmaxP {
    static constexpr bool PERM = false, AFTER_DRAIN = true;
    const LAS unsigned long long* argp;
    __device__ __forceinline__ void fused(f32x4 (&acc)[2][2][4][2], const Unit&, int wr, int wc, int fr, int fq, PG8_LAS unsigned char* lds, int wid, int lane) const {
        LAS float* PM = (LAS float*)lds; LAS float* PS = PM + 1024;
        const int ub = (int)blockIdx.x; const int ldp = DM;
        bf16* P = (bf16*)((unsigned char*)ld_ptr(argp + N_INPUTS + 1) + WS_PC) + ((size_t)((ub >> 7) & 1) * SEQ + (ub & 31) * 256) * DM + ((ub >> 5) & 3) * 256;
        { int t2 = threadIdx.x; asm volatile("" : "+v"(t2)); fr = t2 & 15; fq = (t2 >> 4) & 3; }
#pragma unroll
        for (int ai = 0; ai < 2; ++ai)
#pragma unroll
            for (int m = 0; m < 4; ++m) { float mx = -INFINITY;
#pragma unroll
                for (int bj = 0; bj < 2; ++bj)
#pragma unroll
                    for (int n = 0; n < 2; ++n) { const f32x4 x = acc[ai][bj][m][n]; mx = fmaxf(mx, fmaxf(fmaxf(x[0], x[1]), fmaxf(x[2], x[3]))); }
                mx = fmaxf(mx, __shfl_xor(mx, 16)); mx = fmaxf(mx, __shfl_xor(mx, 32));
                if (fq == 0) PM[(ai * 128 + wr * 64 + m * 16 + fr) * 4 + wc] = mx; }
        asm volatile("s_waitcnt lgkmcnt(0)" ::: "memory"); __builtin_amdgcn_s_barrier(); asm volatile("" ::: "memory");
#pragma unroll
        for (int ai = 0; ai < 2; ++ai)
#pragma unroll
            for (int m = 0; m < 4; ++m) { const int r = ai * 128 + wr * 64 + m * 16 + fr; const f32x4 pm = *(const LAS f32x4*)(PM + r * 4);
                const float M = fmaxf(fmaxf(pm[0], pm[1]), fmaxf(pm[2], pm[3])); float s = 0.f;
#pragma unroll
                for (int bj = 0; bj < 2; ++bj)
#pragma unroll
                    for (int n = 0; n < 2; ++n) { f32x4 x = acc[ai][bj][m][n]; x[0] = fexp2(x[0] - M); x[1] = fexp2(x[1] - M); x[2] = fexp2(x[2] - M); x[3] = fexp2(x[3] - M); acc[ai][bj][m][n] = x; s += (x[0] + x[1]) + (x[2] + x[3]); }
                s += __shfl_xor(s, 16); s += __shfl_xor(s, 32);
                if (fq == 0) PS[r * 4 + wc] = s; }
        asm volatile("s_waitcnt lgkmcnt(0)" ::: "memory"); __builtin_amdgcn_s_barrier(); asm volatile("" ::: "memory");
#pragma unroll
        for (int ai = 0; ai < 2; ++ai)
#pragma unroll
            for (int m = 0; m < 4; ++m) { const int r = ai * 128 + wr * 64 + m * 16 + fr; const f32x4 ps = *(const LAS f32x4*)(PS + r * 4); const float inv = 1.f / ((ps[0] + ps[1]) + (ps[2] + ps[3]));
#pragma unroll
                for (int bj = 0; bj < 2; ++bj)
#pragma unroll
                    for (int n = 0; n < 2; ++n) { const f32x4 x = acc[ai][bj][m][n]; v2u o; o.x = pg8::cvt_pk_bf16(x[0] * inv, x[1] * inv); o.y = pg8::cvt_pk_bf16(x[2] * inv, x[3] * inv);
                        *(v2u*)(P + (size_t)r * ldp + bj * 128 + wc * 32 + n * 16 + fq * 4) = o; } }
        asm volatile("s_waitcnt lgkmcnt(0)" ::: "memory"); __builtin_amdgcn_s_barrier(); asm volatile("" ::: "memory");
    }
};

__device__ __forceinline__ void rms_rows_phase(const Frame& F, const float* X, const float* g, bf16* H) {
    const int gw = F.vcu * NWAVES + F.wave, NGW = F.G * NWAVES;
    for (int m = gw; m < TA; m += NGW) rms_row_bf16(X + (size_t)m * DM, g, H + (size_t)m * DM, F.lane);
}

__device__ __forceinline__ unsigned f2sort(float f) { const unsigned u = __builtin_bit_cast(unsigned, f); return u ^ ((u >> 31) ? 0xFFFFFFFFu : 0x80000000u); }
__device__ __forceinline__ float sort2f(unsigned s) { const unsigned u = s ^ ((s >> 31) ? 0x80000000u : 0xFFFFFFFFu); return __builtin_bit_cast(float, u); }
__device__ __forceinline__ float gelu_tanh(float x) { const float y = 0.7978845608028654f * (x + 0.044715f * x * x * x); const float e = __expf(2.f * y); return 0.5f * x * (1.f + (1.f - 2.f / (e + 1.f))); }
__device__ __forceinline__ unsigned gmax16(unsigned v) {
#pragma unroll
    for (int o = 1; o < 16; o <<= 1) { const unsigned t = (unsigned)__shfl_xor((int)v, o); v = v > t ? v : t; }
    return v;
}
typedef __bf16 bf16x2_t __attribute__((ext_vector_type(2)));
__device__ __forceinline__ float dot2bf(unsigned a, unsigned b, float c) {
#if __has_builtin(__builtin_amdgcn_fdot2_f32_bf16)
    return __builtin_amdgcn_fdot2_f32_bf16(__builtin_bit_cast(bf16x2_t, a), __builtin_bit_cast(bf16x2_t, b), c, false);
#else
    return c + bflo(a) * bflo(b) + bfhi(a) * bfhi(b);
#endif
}
__device__ __forceinline__ void peer_token(const Frame& F, const Args& a, int row, LAS unsigned* TOPS, int ci0, int cj0, int ci1, int cj1, int ci2, int cj2, int ci3, int cj3, bool cv3) {
    unsigned char* ws = a.ws; const int lane = F.lane, grp = lane >> 4, j16 = lane & 15;
    const float* sc = (const float*)(ws + WS_SC) + (size_t)row * 2048;
#pragma unroll 1
    for (int bt = 0; bt < 4; ++bt) {
        const f32x4 x0 = *(const f32x4*)(sc + (bt * 4 + grp) * 128 + 8 * j16), x1 = *(const f32x4*)(sc + (bt * 4 + grp) * 128 + 8 * j16 + 4);
        unsigned k[8]; const float xs[8] = {x0.x, x0.y, x0.z, x0.w, x1.x, x1.y, x1.z, x1.w};
#pragma unroll
        for (int e = 0; e < 8; ++e) k[e] = (f2sort(xs[e]) & ~127u) | (unsigned)(127 - (8 * j16 + e));
        unsigned mine = 0u;
#pragma unroll 1
        for (int r = 0; r < 16; ++r) {
            unsigned m = k[0];
#pragma unroll
            for (int e = 1; e < 8; ++e) m = m > k[e] ? m : k[e];
            m = gmax16(m);
            if (j16 == r) mine = m;
#pragma unroll
            for (int e = 0; e < 8; ++e) k[e] = (k[e] == m) ? 0u : k[e];
        }
        TOPS[(bt * 4 + grp) * 16 + j16] = mine;
    }
    int ex[2]; float gx[2];
#pragma unroll
    for (int ps = 0; ps < 2; ++ps) {
        const int hd = ps * 4 + grp; const LAS unsigned* T1 = TOPS + (2 * hd) * 16; const LAS unsigned* T2 = T1 + 16;
        unsigned k[4];
        { const float s0 = sort2f(T1[ci0] & ~127u) + sort2f(T2[cj0] & ~127u), s1 = sort2f(T1[ci1] & ~127u) + sort2f(T2[cj1] & ~127u),
                      s2 = sort2f(T1[ci2] & ~127u) + sort2f(T2[cj2] & ~127u), s3 = sort2f(T1[ci3] & ~127u) + sort2f(T2[cj3] & ~127u);
          k[0] = (f2sort(s0) & ~127u) | (unsigned)(127 - j16); k[1] = (f2sort(s1) & ~127u) | (unsigned)(127 - (j16 + 16)); k[2] = (f2sort(s2) & ~127u) | (unsigned)(127 - (j16 + 32));
          k[3] = cv3 ? ((f2sort(s3) & ~127u) | (unsigned)(127 - (j16 + 48))) : 0u; }
        unsigned mine = 0u;
#pragma unroll 1
        for (int r = 0; r < 16; ++r) {
            unsigned m = k[0] > k[1] ? k[0] : k[1]; const unsigned m2 = k[2] > k[3] ? k[2] : k[3]; m = m > m2 ? m : m2;
            m = gmax16(m);
            if (j16 == r) mine = m;
#pragma unroll
            for (int e = 0; e < 4; ++e) k[e] = (k[e] == m) ? 0u : k[e];
        }
        const int c = 127 - (int)(mine & 127u);
        int ci, cj;
        if (c < 16) { ci = 0; cj = c; } else if (c < 24) { ci = 1; cj = c - 16; } else if (c < 29) { ci = 2; cj = c - 24; } else if (c < 33) { ci = 3; cj = c - 29; }
        else if (c < 36) { ci = 4; cj = c - 33; } else if (c < 38) { ci = 5; cj = c - 36; } else if (c < 40) { ci = 6; cj = c - 38; } else if (c < 42) { ci = 7; cj = c - 40; } else { ci = c - 34; cj = 0; }
        const int i1 = 127 - (int)(T1[ci] & 127u), i2 = 127 - (int)(T2[cj] & 127u);
        ex[ps] = i1 * 128 + i2;
        const float sv = sort2f(mine & ~127u); const float s0 = __shfl(sv, lane & 48);
        float ee = __expf(sv - s0); float es = ee;
#pragma unroll
        for (int o = 1; o < 16; o <<= 1) es += __shfl_xor(es, o);
        gx[ps] = ee / es;
    }
    v4u hq[2]; { const v4u* hp = (const v4u*)((const bf16*)(ws + WS_HB) + (size_t)row * DM + 16 * lane); hq[0] = hp[0]; hq[1] = hp[1]; }
    float oacc[16];
#pragma unroll
    for (int i = 0; i < 16; ++i) oacc[i] = 0.f;
    const bf16* U = (const bf16*)(ws + WS_U16); const bf16* V = (const bf16*)(ws + WS_V16);
    v4u ub[4][2], vb[4][2];
#pragma unroll
    for (int i = 0; i < 4; ++i) { const int e = __builtin_amdgcn_readlane(ex[0], i); const v4u* p = (const v4u*)(U + (size_t)e * DM + 16 * lane); ub[i][0] = p[0]; ub[i][1] = p[1]; }
#pragma unroll 1
    for (int g4 = 0; g4 < 32; ++g4) {
        const int kb = g4 * 4; const int exs = (kb < 64) ? ex[0] : ex[1]; const float gxs = (kb < 64) ? gx[0] : gx[1];
#pragma unroll
        for (int i = 0; i < 4; ++i) { const int e = __builtin_amdgcn_readlane(exs, (kb & 63) + i); const v4u* p = (const v4u*)(V + (size_t)e * DM + 16 * lane); vb[i][0] = p[0]; vb[i][1] = p[1]; }
        float av[4];
#pragma unroll
        for (int i = 0; i < 4; ++i) { float s = 0.f;
#pragma unroll
            for (int q = 0; q < 4; ++q) { s = dot2bf(ub[i][0][q], hq[0][q], s); s = dot2bf(ub[i][1][q], hq[1][q], s); }
            av[i] = s; }
#pragma unroll
        for (int i = 0; i < 4; ++i) av[i] = wave_sum(av[i]);
        if (g4 < 31) { const int kn = kb + 4; const int exn = (kn < 64) ? ex[0] : ex[1];
#pragma unroll
            for (int i = 0; i < 4; ++i) { const int e = __builtin_amdgcn_readlane(exn, (kn & 63) + i); const v4u* p = (const v4u*)(U + (size_t)e * DM + 16 * lane); ub[i][0] = p[0]; ub[i][1] = p[1]; } }
#pragma unroll
        for (int i = 0; i < 4; ++i) { const float gg = __builtin_bit_cast(float, __builtin_amdgcn_readlane(__builtin_bit_cast(int, gxs), (kb & 63) + i));
            const float w = gg * gelu_tanh(av[i]);
#pragma unroll
            for (int q = 0; q < 4; ++q) { oacc[2 * q] += w * bflo(vb[i][0][q]); oacc[2 * q + 1] += w * bfhi(vb[i][0][q]); oacc[8 + 2 * q] += w * bflo(vb[i][1][q]); oacc[8 + 2 * q + 1] += w * bfhi(vb[i][1][q]); } }
    }
    const f32x4* x2 = (const f32x4*)((const float*)(ws + WS_X2) + (size_t)row * DM + 16 * lane);
    f32x4 xv[4]; float ss = 0.f;
#pragma unroll
    for (int q = 0; q < 4; ++q) { xv[q] = x2[q]; xv[q].x += oacc[4 * q]; xv[q].y += oacc[4 * q + 1]; xv[q].z += oacc[4 * q + 2]; xv[q].w += oacc[4 * q + 3]; ss += (xv[q].x * xv[q].x + xv[q].y * xv[q].y) + (xv[q].z * xv[q].z + xv[q].w * xv[q].w); }
    const float r = rsqrtf(wave_sum(ss) * (1.f / DM) + EPS);
    const f32x4* gf = (const f32x4*)((const float*)a.in[I_GFIN] + 16 * lane);
    f32x4* y = (f32x4*)((row < TP ? a.out + O_YP + (size_t)row * DM : a.out + O_YS + (size_t)(row - TP) * DM) + 16 * lane);
#pragma unroll
    for (int q = 0; q < 4; ++q) { const f32x4 g4 = gf[q]; f32x4 o; o.x = xv[q].x * r * g4.x; o.y = xv[q].y * r * g4.y; o.z = xv[q].z * r * g4.z; o.w = xv[q].w * r * g4.w; y[q] = o; }
}
__device__ __forceinline__ void cand_ij(int c, int& ci, int& cj) {
    if (c < 16) { ci = 0; cj = c; } else if (c < 24) { ci = 1; cj = c - 16; } else if (c < 29) { ci = 2; cj = c - 24; } else if (c < 33) { ci = 3; cj = c - 29; }
    else if (c < 36) { ci = 4; cj = c - 33; } else if (c < 38) { ci = 5; cj = c - 36; } else if (c < 40) { ci = 6; cj = c - 38; } else if (c < 42) { ci = 7; cj = c - 40; } else if (c < 50) { ci = c - 34; cj = 0; } else { ci = 0; cj = 0; }
}
__device__ __forceinline__ void peer_phase(const Frame& F, const Args& a) {
    LAS unsigned* TOPS = (LAS unsigned*)F.lds + F.wave * 256;
    const int j16 = F.lane & 15; int ci0, cj0, ci1, cj1, ci2, cj2, ci3, cj3;
    cand_ij(j16, ci0, cj0); cand_ij(j16 + 16, ci1, cj1); cand_ij(j16 + 32, ci2, cj2); cand_ij(j16 + 48, ci3, cj3);
    const bool cv3 = (j16 + 48) < 50;
    const int gw = F.vcu * NWAVES + F.wave, NGW = F.G * NWAVES;
#pragma unroll 1
    for (int row = gw; row < TA; row += NGW) peer_token(F, a, row, TOPS, ci0, cj0, ci1, cj1, ci2, cj2, ci3, cj3, cv3);
}


#ifndef PH_MAX
#define PH_MAX 99
#endif
__global__ void __launch_bounds__(NTHR, 2) mega_fwd(Args args) {
    extern __shared__ __attribute__((aligned(16))) unsigned char lds_raw[];
    Frame F;
    F.lds = (LAS unsigned char*)lds_raw;
    F.tid = threadIdx.x; F.lane = F.tid & 63; F.wave = __builtin_amdgcn_readfirstlane(F.tid >> 6);
    F.G = gridDim.x; { const int bx = blockIdx.x; F.vcu = (F.G % 8 == 0) ? (bx % 8) * (F.G / 8) + bx / 8 : bx; }
    volatile LAS unsigned* MISC = (volatile LAS unsigned*)(F.lds + MISC_OFF);
    LAS unsigned long long* ARGP = (LAS unsigned long long*)(F.lds + ARGS_OFF);
    for (int u = F.tid; u < (LDS_BYTES - LDSCTL_OFF) / 4; u += NTHR) ((LAS unsigned*)(F.lds + LDSCTL_OFF))[u] = 0u;
    __syncthreads();
    if (F.tid == 0) {
        ARGP[0] = (unsigned long long)args.in[0];
        ARGP[1] = (unsigned long long)args.in[1];
        ARGP[2] = (unsigned long long)args.in[2];
        ARGP[3] = (unsigned long long)args.in[3];
        ARGP[4] = (unsigned long long)args.in[4];
        ARGP[5] = (unsigned long long)args.in[5];
        ARGP[6] = (unsigned long long)args.in[6];
        ARGP[7] = (unsigned long long)args.in[7];
        ARGP[8] = (unsigned long long)args.in[8];
        ARGP[9] = (unsigned long long)args.in[9];
        ARGP[10] = (unsigned long long)args.in[10];
        ARGP[11] = (unsigned long long)args.in[11];
        ARGP[12] = (unsigned long long)args.in[12];
        ARGP[13] = (unsigned long long)args.in[13];
        ARGP[14] = (unsigned long long)args.in[14];
        ARGP[15] = (unsigned long long)args.in[15];
        ARGP[16] = (unsigned long long)args.in[16];
        ARGP[17] = (unsigned long long)args.in[17];
        ARGP[18] = (unsigned long long)args.in[18];
        ARGP[19] = (unsigned long long)args.in[19];
        ARGP[20] = (unsigned long long)args.in[20];
        ARGP[21] = (unsigned long long)args.in[21];
        ARGP[22] = (unsigned long long)args.in[22];
        ARGP[23] = (unsigned long long)args.in[23];
        ARGP[24] = (unsigned long long)args.in[24];
        ARGP[25] = (unsigned long long)args.in[25];
        ARGP[26] = (unsigned long long)args.in[26];
        ARGP[27] = (unsigned long long)args.in[27];
        ARGP[28] = (unsigned long long)args.in[28];
        ARGP[N_INPUTS] = (unsigned long long)args.out; ARGP[N_INPUTS + 1] = (unsigned long long)args.ws;
    }
    __syncthreads();
    { const XcdBarrier bar0 = xcd_barrier_post((unsigned*)((gu32*)(args.ws + WS_CTL) + CW_BAR), MISC + 8); if (F.tid == 0) MISC[10] = bar0.x; }
    __syncthreads();
#define GRID_BAR() do { XcdBarrier bar_; bar_.bar = (unsigned*)((gu32*)((unsigned char*)ld_ptr(ARGP + N_INPUTS + 1) + WS_CTL) + CW_BAR); bar_.x = MISC[10]; bar_.st = MISC + 8; xcd_barrier(bar_); } while (0)
#define PHASE_ARGS const Args A = load_args(ARGP); unsigned char* const ws = A.ws; float* const out = A.out; (void)ws; (void)out

    { PHASE_ARGS; p0_prologue(F, A); }
    GRID_BAR();
#if PH_MAX >= 1
    { PHASE_ARGS;
    {
        pg8::Gemm g{(const bf16*)(ws + WS_HB), (const bf16*)(ws + WS_WIN), DM, DM, DM};
        pg8::StaticOrder S; S.init(TA, N_IN, F.G, (int)blockIdx.x);
        EpiInProj E{out, ws, (const float*)A.in[I_BFF]};
        pg8::gemm_phase(F.lds, g, S, E);
    }
    {
        const int off = (TA / 256) * (N_IN / 256) % F.G;
        pg8::Gemm g{(const bf16*)(ws + WS_MB), (const bf16*)(ws + WS_WMK), DM, DM, DM};
        pg8::StaticOrder S; S.init(512, DM, F.G, ((int)blockIdx.x + F.G - off) % F.G);
        EpiGen E{out + O_MKP, DM, (bf16*)(ws + WS_MK16), DM, 1.f, nullptr, nullptr, 0, 0};
        pg8::gemm_phase(F.lds, g, S, E);
    }
    {
        const int off = ((TA / 256) * (N_IN / 256) + 8) % F.G;
        pg8::Gemm g{(const bf16*)(ws + WS_MB), (const bf16*)(ws + WS_WMV), DM, DM, DM};
        pg8::StaticOrder S; S.init(512, DM, F.G, ((int)blockIdx.x + F.G - off) % F.G);
        EpiGen E{out + O_MVP, DM, nullptr, 0, 1.f, nullptr, nullptr, 0, 0};
        pg8::gemm_phase(F.lds, g, S, E);
    }
    {
        const int off = ((TA / 256) * (N_IN / 256) + 16) % F.G;
        pg8::Gemm g{(const bf16*)(ws + WS_WMV), (const bf16*)(ws + WS_MB), DM, DM, DM};
        pg8::StaticOrder S; S.init(DM, 512, F.G, ((int)blockIdx.x + F.G - off) % F.G);
        EpiGen E{nullptr, 0, (bf16*)(ws + WS_MVT16), 512, 1.f, nullptr, nullptr, 0, 0};
        pg8::gemm_phase(F.lds, g, S, E);
    }
    }
    GRID_BAR();
#endif
#if PH_MAX >= 2
    asm volatile("; ===PHASE 2===");
    { PHASE_ARGS;
    {
        if (blockIdx.x < NB_P) fox_prompt_cumsum(F, out + O_LFP, (float*)(ws + WS_KBIAS), (int)blockIdx.x);
        const int gw = F.vcu * NWAVES + F.wave, NGW = F.G * NWAVES;
        for (int bs = gw; bs < NB_S; bs += NGW) fox_sample_suffix(F, (const float*)A.in[I_CFL], (const int*)A.in[I_PT], (float*)(ws + WS_SUF), bs);
        __syncthreads();
        for (int u = F.vcu; u < 1024; u += F.G) gla_g1_unit(F, A, u);
        for (int u = F.vcu; u < 512; u += F.G) gla_sample_unit(F, A, u);
    }
    }
    GRID_BAR();
#endif
#if PH_MAX >= 3
    asm volatile("; ===PHASE 3===");
    { PHASE_ARGS;
    gla_scan(F, A);
    __syncthreads();
    for (int i = F.vcu; i < 256; i += F.G) { const int bh = i >> 4, s = i & 15;
        fox_attn_unit(F, (const bf16*)(ws + WS_QF), (const bf16*)(ws + WS_KF), (const bf16*)(ws + WS_VF), (const float*)(ws + WS_KBIAS), (bf16*)(ws + WS_MERGED), bh >> 3, bh & 7, s);
        fox_attn_unit(F, (const bf16*)(ws + WS_QF), (const bf16*)(ws + WS_KF), (const bf16*)(ws + WS_VF), (const float*)(ws + WS_KBIAS), (bf16*)(ws + WS_MERGED), bh >> 3, bh & 7, 31 - s); }
    for (int u = F.vcu; u < 1024; u += F.G) fox_sample_unit(F, A, u);
    }
    GRID_BAR();
#endif
#if PH_MAX >= 4
    asm volatile("; ===PHASE 4===");
    { PHASE_ARGS;
    for (int u = F.vcu; u < 1024; u += F.G) gla_g3_unit(F, A, u);
    }
    GRID_BAR();
#endif
#if PH_MAX >= 5
    asm volatile("; ===PHASE 5===");
    { PHASE_ARGS;
    {
        pg8::Gemm g{(const bf16*)(ws + WS_MERGED), (const bf16*)(ws + WS_WOUT), DM, DM, DM};
        pg8::StaticOrder S; S.init(TA, DM, F.G, (int)blockIdx.x);
        EpiGen E{(float*)(ws + WS_X1), DM, nullptr, 0, 1.f, (const float*)A.in[I_XP], (const float*)A.in[I_XS], TP, DM};
        pg8::gemm_phase(F.lds, g, S, E);
    }
    }
    GRID_BAR();
#endif
#if PH_MAX >= 6
    asm volatile("; ===PHASE 6===");
    { PHASE_ARGS;
    rms_rows_phase(F, (const float*)(ws + WS_X1), (const float*)A.in[I_GCROSS], (bf16*)(ws + WS_HB));
    }
    GRID_BAR();
#endif
#if PH_MAX >= 7
    asm volatile("; ===PHASE 7===");
    { PHASE_ARGS;
    {
        pg8::Gemm g{(const bf16*)(ws + WS_HB), (const bf16*)(ws + WS_WCQ), DM, DM, DM};
        pg8::StaticOrder S; S.init(TA, DM, F.G, (int)blockIdx.x);
        EpiGen E{nullptr, 0, (bf16*)(ws + WS_QC), DM, C2C, nullptr, nullptr, 0, 0};
        pg8::gemm_phase(F.lds, g, S, E);
    }
    }
    GRID_BAR();
#endif
#if PH_MAX >= 8
    asm volatile("; ===PHASE 8===");
    { PHASE_ARGS;
    {
        const int u = (int)blockIdx.x, b = (u >> 7) & 1, h = (u >> 5) & 3, pnl = u & 31;
        const size_t roff = ((size_t)b * SEQ + pnl * 256) * DM + h * 256;
        pg8::Gemm g{(const bf16*)(ws + WS_QC) + roff, (const bf16*)(ws + WS_MK16) + (size_t)(b * 256) * DM + h * 256, DM, DM, 256};
        pg8::SingleUnit S{u < 256 ? 1 : 0, {0, 0}};
        EpiSoftmaxP E{ARGP};
        pg8::gemm_phase(F.lds, g, S, E);
        __syncthreads();
        for (int v = F.vcu; v < 512; v += F.G) cross_sample_unit(F, A, v);
    }
    }
    GRID_BAR();
#endif
#if PH_MAX >= 9
    asm volatile("; ===PHASE 9===");
    { PHASE_ARGS;
    {
        const int u = (int)blockIdx.x, b = (u >> 7) & 1, h = (u >> 5) & 3, pnl = u & 31;
        const size_t roff = ((size_t)b * SEQ + pnl * 256) * DM + h * 256;
        pg8::Gemm g{(const bf16*)(ws + WS_PC) + roff, (const bf16*)(ws + WS_MVT16) + (size_t)(h * 256) * 512 + b * 256, DM, 512, 256};
        pg8::SingleUnit S{u < 256 ? 1 : 0, {0, 0}};
        EpiGen E{nullptr, 0, (bf16*)(ws + WS_OC) + roff, DM, 1.f, nullptr, nullptr, 0, 0};
        pg8::gemm_phase(F.lds, g, S, E);
    }
    }
    GRID_BAR();
#endif
#if PH_MAX >= 10
    asm volatile("; ===PHASE 10===");
    { PHASE_ARGS;
    {
        pg8::Gemm g{(const bf16*)(ws + WS_OC), (const bf16*)(ws + WS_WCO), DM, DM, DM};
        pg8::StaticOrder S; S.init(TA, DM, F.G, (int)blockIdx.x);
        EpiGen E{(float*)(ws + WS_X2), DM, nullptr, 0, 1.f, (const float*)(ws + WS_X1), (const float*)(ws + WS_X1), TA, DM};
        pg8::gemm_phase(F.lds, g, S, E);
    }
    }
    GRID_BAR();
#endif
#if PH_MAX >= 11
    asm volatile("; ===PHASE 11===");
    { PHASE_ARGS;
    rms_rows_phase(F, (const float*)(ws + WS_X2), (const float*)A.in[I_GFFN], (bf16*)(ws + WS_HB));
    }
    GRID_BAR();
#endif
#if PH_MAX >= 12
    asm volatile("; ===PHASE 12===");
    { PHASE_ARGS;
    {
        pg8::Gemm g{(const bf16*)(ws + WS_HB), (const bf16*)(ws + WS_WPK), DM, DM, DM};
        pg8::StaticOrder S; S.init(TA, 2048, F.G, (int)blockIdx.x);
        EpiGen E{(float*)(ws + WS_SC), 2048, nullptr, 0, 1.f, nullptr, nullptr, 0, 0};
        pg8::gemm_phase(F.lds, g, S, E);
    }
    }
    GRID_BAR();
#endif
#if PH_MAX >= 13
    asm volatile("; ===PHASE 13===");
    { PHASE_ARGS;
    peer_phase(F, A);
    }
#endif
#if PH_MAX < 13
    {   PHASE_ARGS;
        const int gw = F.vcu * NWAVES + F.wave, NGW = F.G * NWAVES;
        for (int m = gw; m < TA; m += NGW) {
            const float* x = m < TP ? (const float*)A.in[I_XP] + (size_t)m * DM : (const float*)A.in[I_XS] + (size_t)(m - TP) * DM;
            float* y = m < TP ? out + O_YP + (size_t)m * DM : out + O_YS + (size_t)(m - TP) * DM;
            for (int j = 0; j < 4; ++j) ((f32x4*)y)[F.lane + 64 * j] = ((const f32x4*)x)[F.lane + 64 * j];
        }
    }
#endif

}

extern "C" void kernel_launch(void* const* d_in, const int* in_sizes, int n_in, void* d_out, int out_size, void* d_ws, size_t ws_size, hipStream_t stream) {
    static int grid = 0;
    if (grid == 0) {
        if (n_in != N_INPUTS || (size_t)out_size != O_TOTAL || ws_size < WS_END) { fprintf(stderr, "kernel_launch: unexpected shapes (n_in %d out %d ws %zu)\n", n_in, out_size, ws_size); grid = -1; return; }
        int dev = 0, cus = 0, per_cu = 0;
        if (hipGetDevice(&dev) != hipSuccess || hipDeviceGetAttribute(&cus, hipDeviceAttributeMultiprocessorCount, dev) != hipSuccess) { grid = -1; return; }
        if (hipFuncSetAttribute((const void*)mega_fwd, hipFuncAttributeMaxDynamicSharedMemorySize, LDS_BYTES) != hipSuccess) { fprintf(stderr, "kernel_launch: hipFuncSetAttribute failed\n"); grid = -1; return; }
        if (hipOccupancyMaxActiveBlocksPerMultiprocessor(&per_cu, (const void*)mega_fwd, NTHR, LDS_BYTES) != hipSuccess || per_cu < 1)
            fprintf(stderr, "kernel_launch: occupancy query reports %d workgroups per CU\n", per_cu);
        (void)hipGetLastError();
        grid = cus;
        if (grid > 256) grid = 256;
    }
    if (grid < 0) return;
    if (hipMemsetAsync((char*)d_ws + WS_CTL, 0, CTL_ZERO_BYTES, stream) != hipSuccess) return;
    Args a{};
    for (int i = 0; i < N_INPUTS; ++i) a.in[i] = d_in[i];
    a.out = (float*)d_out; a.ws = (unsigned char*)d_ws;
    hipLaunchKernelGGL(mega_fwd, dim3(grid), dim3(NTHR), LDS_BYTES, stream, a);
    const hipError_t le = hipPeekAtLastError();
    if (le != hipSuccess) fprintf(stderr, "kernel_launch: launch failed: %s\n", hipGetErrorName(le));
}
```

```cpp
#define PH_MAX 13
#include <hip/hip_runtime.h>
#include <cstdio>
#include <cstdint>

namespace pg8 {
#define PG8_LAS __attribute__((address_space(3)))
typedef unsigned short bf16_t;
typedef short bf16x8 __attribute__((ext_vector_type(8)));
typedef float f32x4 __attribute__((ext_vector_type(4)));
typedef unsigned u32x4 __attribute__((ext_vector_type(4)));
typedef unsigned u32x2 __attribute__((ext_vector_type(2)));
constexpr int BM = 256, BK = 64, HALF = 128, HTB = HALF * BK * 2  , STAGE_BYTES = 8 * HTB, NXCD = 8, WGM = 8;

__host__ __device__ __forceinline__ int lds_byte(int r, int c) { const int st = (r >> 4) * 2 + (c >> 5), rr = r & 15, cc = c & 31, ob = rr * 64 + cc * 2; return st * 1024 + (ob ^ (((ob >> 9) & 1) << 5)); }
__host__ __device__ __forceinline__ void stage_rc(int b, int& R, int& C) { const int st = b / 1024, sb = b % 1024, swz = sb ^ (((sb >> 9) & 1) << 5); R = (st >> 1) * 16 + swz / 64; C = (st & 1) * 32 + (swz % 64) / 2; }

struct Unit { int pm, pn; };
struct Gemm { const bf16_t* A; const bf16_t* Bt; int lda, ldb, K; };

struct StaticOrder {
    int nM, nN, nwg, G, c;
    __host__ __device__ void init(int M, int N, int G_, int c_) { nM = M / BM; nN = N / BM; nwg = nM * nN; G = G_; c = c_; }
    __host__ __device__ bool next(int i, Unit& u) const {
        const long L = (long)i * G + c; if (L >= nwg) return false;
        int wgid = (int)L; { const int q = nwg / NXCD, r = nwg % NXCD, xcd = wgid % NXCD, off = wgid / NXCD; wgid = (xcd < r ? xcd * (q + 1) : r * (q + 1) + (xcd - r) * q) + off; }
        const int nig = WGM * nN, gid = wgid / nig, fm = gid * WGM, gsz = (nM - fm) < WGM ? (nM - fm) : WGM;
        u.pm = fm + ((wgid % nig) % gsz); u.pn = (wgid % nig) / gsz; return true;
    }
};
struct SingleUnit {
    int has; Unit u0;
    __host__ __device__ bool next(int i, Unit& u) const { if (i != 0 || !has) return false; u = u0; return true; }
};

__device__ __forceinline__ unsigned cvt_pk_bf16(float lo, float hi) { unsigned r; asm volatile("v_cvt_pk_bf16_f32 %0, %1, %2" : "=v"(r) : "v"(lo), "v"(hi)); return r; }

template <class Epi, class Sched>
__device__ __forceinline__ void gemm_phase(PG8_LAS unsigned char* lds, const Gemm g, const Sched& S, const Epi& E) {
    int tid = threadIdx.x; asm volatile("" : "+v"(tid));
    const int wid = __builtin_amdgcn_readfirstlane(tid >> 6), lane = tid & 63, wr = wid >> 2, wc = wid & 3, fr = lane & 15, fq = lane >> 4;
    const int K = g.K, nt = K / BK;
    unsigned voffA[2], voffB[2];
#pragma unroll
    for (int i = 0; i < 2; ++i) { int R, C; stage_rc(tid * 16 + i * 8192, R, C);
        voffA[i] = (unsigned)(R * g.lda + C) * 2u; voffB[i] = (unsigned)(R * g.ldb + C) * 2u; }
    const size_t kstep = (size_t)(BK * 2);
    const size_t hstepA = (size_t)HALF * g.lda * 2, hstepB = (size_t)HALF * g.ldb * 2;
    const size_t tstepA = 2 * hstepA, tstepB = 2 * hstepB;
    const unsigned ldsw = (unsigned)wid * 1024u;
    const int aoff = lds_byte(wr * 64 + fr, fq * 8), boff = lds_byte(wc * 32 + fr, fq * 8);
#define PG8_SA(b, h) (((b) * 2 + (h)) * HTB)
#define PG8_SB(b, h) ((4 + (b) * 2 + (h)) * HTB)
#define PG8_STAGE(bufoff, gbase, voff) do { _Pragma("unroll") for (int _i = 0; _i < 2; ++_i) \
        __builtin_amdgcn_global_load_lds((const unsigned*)((const char*)(gbase) + (voff)[_i]), (PG8_LAS unsigned*)(lds + (bufoff) + ldsw + _i * 8192), 16, 0, 0); } while (0)
#define PG8_LDA(dst, b, h) do { _Pragma("unroll") for (int m = 0; m < 4; ++m) _Pragma("unroll") for (int k = 0; k < 2; ++k) dst[m][k] = *(const PG8_LAS bf16x8*)(lds + PG8_SA(b, h) + aoff + m * 2048 + k * 1024); } while (0)
#define PG8_LDB(dst, b, h) do { _Pragma("unroll") for (int n = 0; n < 2; ++n) _Pragma("unroll") for (int k = 0; k < 2; ++k) dst[n][k] = *(const PG8_LAS bf16x8*)(lds + PG8_SB(b, h) + boff + n * 2048 + k * 1024); } while (0)
#define PG8_MMA(ai, bj, At, Bt) do { __builtin_amdgcn_s_setprio(1); _Pragma("unroll") for (int m = 0; m < 4; ++m) _Pragma("unroll") for (int n = 0; n < 2; ++n) _Pragma("unroll") for (int k = 0; k < 2; ++k) \
        acc[ai][bj][m][n] = __builtin_amdgcn_mfma_f32_16x16x32_bf16(Bt[n][k], At[m][k], acc[ai][bj][m][n], 0, 0, 0); __builtin_amdgcn_s_setprio(0); } while (0)
#define PG8_WAIT_V(n) asm volatile("s_waitcnt vmcnt(" #n ")" ::: "memory")
#define PG8_WAIT_L(n) asm volatile("s_waitcnt lgkmcnt(" #n ")" ::: "memory")
#define PG8_BAR __builtin_amdgcn_s_barrier()
#define PG8_SCHED __builtin_amdgcn_sched_barrier(0)
    Unit cur, nxt; int ui = 0;
    if (!S.next(0, cur)) return;
    f32x4 acc[2][2][4][2];
#pragma unroll
    for (int a = 0; a < 2; ++a)
#pragma unroll
        for (int b = 0; b < 2; ++b)
#pragma unroll
            for (int m = 0; m < 4; ++m)
#pragma unroll
                for (int n = 0; n < 2; ++n) acc[a][b][m][n] = (f32x4){0.f, 0.f, 0.f, 0.f};
    bf16x8 At[4][2], B0[2][2], B1[2][2];
    const char* cA = (const char*)g.A + (size_t)cur.pm * tstepA; const char* cB = (const char*)g.Bt + (size_t)cur.pn * tstepB;
    PG8_STAGE(PG8_SB(0, 0), cB, voffB); PG8_STAGE(PG8_SB(0, 1), cB + hstepB, voffB); PG8_STAGE(PG8_SA(0, 0), cA, voffA); PG8_STAGE(PG8_SA(0, 1), cA + hstepA, voffA);
    if (wr == 1) PG8_BAR;
    PG8_WAIT_V(2); PG8_BAR;
    PG8_STAGE(PG8_SB(1, 0), cB + kstep, voffB); PG8_STAGE(PG8_SA(1, 0), cA + kstep, voffA); PG8_STAGE(PG8_SB(1, 1), cB + hstepB + kstep, voffB);
    PG8_WAIT_V(6); PG8_BAR;
    for (;;) {
        const bool has_next = S.next(ui + 1, nxt);
        const char* nA = has_next ? (const char*)g.A + (size_t)nxt.pm * tstepA : cA; const char* nB = has_next ? (const char*)g.Bt + (size_t)nxt.pn * tstepB : cB;
        for (int t = 0; t < nt; t += 2) {
            const bool last = (t == nt - 2);
            const char* a1 = cA + (size_t)(t + 1) * kstep;
            const char* a2 = last ? nA : cA + (size_t)(t + 2) * kstep; const char* b2 = last ? nB : cB + (size_t)(t + 2) * kstep;
            const char* a3 = a2 + kstep; const char* b3 = b2 + kstep;
            PG8_LDB(B0, 0, 0); PG8_LDB(B1, 0, 1); PG8_SCHED; PG8_LDA(At, 0, 0); PG8_STAGE(PG8_SA(1, 1), a1 + hstepA, voffA);
            PG8_WAIT_V(8); PG8_WAIT_L(0); PG8_BAR; PG8_MMA(0, 0, At, B0); PG8_MMA(0, 1, At, B1); PG8_BAR; PG8_SCHED;
            PG8_LDA(At, 0, 1); PG8_STAGE(PG8_SB(0, 0), b2, voffB); PG8_STAGE(PG8_SB(0, 1), b2 + hstepB, voffB); PG8_STAGE(PG8_SA(0, 0), a2, voffA);
            PG8_WAIT_V(8); PG8_WAIT_L(0); PG8_BAR; PG8_MMA(1, 0, At, B0); PG8_MMA(1, 1, At, B1); PG8_BAR; PG8_SCHED;
            PG8_LDB(B0, 1, 0); PG8_LDB(B1, 1, 1); PG8_SCHED; PG8_LDA(At, 1, 0); PG8_STAGE(PG8_SA(0, 1), a2 + hstepA, voffA);
            PG8_WAIT_V(8); PG8_WAIT_L(0); PG8_BAR; PG8_MMA(0, 0, At, B0); PG8_MMA(0, 1, At, B1); PG8_BAR; PG8_SCHED;
            PG8_LDA(At, 1, 1); PG8_STAGE(PG8_SB(1, 0), b3, voffB); PG8_STAGE(PG8_SB(1, 1), b3 + hstepB, voffB); PG8_STAGE(PG8_SA(1, 0), a3, voffA);
            PG8_WAIT_V(8); PG8_WAIT_L(0); PG8_BAR; PG8_MMA(1, 0, At, B0); PG8_MMA(1, 1, At, B1); PG8_BAR; PG8_SCHED;
        }
        if (wr == 0) PG8_BAR;
        if constexpr (!Epi::AFTER_DRAIN) { E(acc, cur, wr, wc, fr, fq); }
        if (!has_next) break;
#pragma unroll
        for (int a = 0; a < 2; ++a)
#pragma unroll
            for (int b = 0; b < 2; ++b)
#pragma unroll
                for (int m = 0; m < 4; ++m)
#pragma unroll
                    for (int n = 0; n < 2; ++n) acc[a][b][m][n] = (f32x4){0.f, 0.f, 0.f, 0.f};
        cur = nxt; cA = nA; cB = nB; ++ui;
        if (wr == 1) PG8_BAR;
    }
    PG8_WAIT_V(0);
    PG8_BAR;
    if constexpr (Epi::AFTER_DRAIN) { E.fused(acc, cur, wr, wc, fr, fq, lds, wid, lane); }
#undef PG8_SA
#undef PG8_SB
#undef PG8_STAGE
#undef PG8_LDA
#undef PG8_LDB
#undef PG8_MMA
#undef PG8_WAIT_V
#undef PG8_WAIT_L
#undef PG8_BAR
#undef PG8_SCHED
}
}

#define GAS __attribute__((address_space(1)))
#define LAS __attribute__((address_space(3)))
typedef unsigned short bf16;
typedef unsigned v4u __attribute__((ext_vector_type(4)));
typedef unsigned v2u __attribute__((ext_vector_type(2)));
typedef float f32x4 __attribute__((ext_vector_type(4)));
typedef float f32x2 __attribute__((ext_vector_type(2)));
typedef float f32x16 __attribute__((ext_vector_type(16)));
typedef short bf16x8 __attribute__((ext_vector_type(8)));
typedef short s16x4 __attribute__((ext_vector_type(4)));
typedef GAS unsigned gu32;
#define RLX_AGENT __ATOMIC_RELAXED, __HIP_MEMORY_SCOPE_AGENT
#define LDS_WAIT() asm volatile("s_waitcnt lgkmcnt(0)" ::: "memory")
#define VM_WAIT() asm volatile("s_waitcnt vmcnt(0)" ::: "memory")
__device__ __forceinline__ unsigned f2bf(float f) { unsigned u = __builtin_bit_cast(unsigned, f); return (u + 0x7fffu + ((u >> 16) & 1u)) >> 16; }
__device__ __forceinline__ unsigned pk2(float lo, float hi) { return f2bf(lo) | (f2bf(hi) << 16); }
__device__ __forceinline__ float bf2f(unsigned short b) { return __builtin_bit_cast(float, (unsigned)b << 16); }
__device__ __forceinline__ float bflo(unsigned u) { return __builtin_bit_cast(float, u << 16); }
__device__ __forceinline__ float bfhi(unsigned u) { return __builtin_bit_cast(float, u & 0xffff0000u); }

#define XB_TMO      128
#define XB_XCNT(j)  (256  + 64 * (j))
#define XB_XSUB(j)  (1280 + 64 * (j))
#define XB_XGEN(j)  (2304 + 64 * (j))
#define XB_TOP      3328
#define XB_TOPGEN   3392
#define XCD_BAR_WORDS 3456
#define XB_SPIN_CAP (1u << 18)

__device__ __forceinline__ unsigned xb_ld(unsigned* p)              { return __hip_atomic_load(p, __ATOMIC_RELAXED, __HIP_MEMORY_SCOPE_AGENT); }
__device__ __forceinline__ unsigned xb_add(unsigned* p, unsigned v) { return __hip_atomic_fetch_add(p, v, __ATOMIC_RELAXED, __HIP_MEMORY_SCOPE_AGENT); }
__device__ __forceinline__ unsigned xb_xcc_id() { return (unsigned)__builtin_amdgcn_s_getreg((3 << 11) | 20) & 0xFu; }
#define XB_SPIN(cond, bar) do { unsigned _sp = 0; while (cond) { __builtin_amdgcn_s_sleep(1); \
    if ((++_sp & 255u) == 0u) { if (xb_ld(&(bar)[XB_TMO])) break; if (_sp > XB_SPIN_CAP) { atomicAdd(&(bar)[XB_TMO], 1u); break; } } } } while (0)

struct XcdBarrier {
    unsigned* bar; unsigned x;
    volatile LAS unsigned* st;
};

__device__ __forceinline__ XcdBarrier xcd_barrier_post(unsigned* bar, volatile LAS unsigned* st) {
    XcdBarrier b; b.bar = bar; b.x = xb_xcc_id(); b.st = st;
    if (threadIdx.x == 0) (void)xb_add(&bar[XB_XCNT(b.x)], 1u);
    return b;
}
__device__ __forceinline__ void xcd_barrier_complete(unsigned* bar, unsigned x, unsigned& nloc, unsigned& nx) {
    const unsigned G = gridDim.x * gridDim.y * gridDim.z;
    unsigned sum, cnt, mine, sp = 0u;
    for (;;) {
        sum = 0u; cnt = 0u; mine = 0u;
#pragma unroll
        for (unsigned j = 0; j < 16; ++j) { const unsigned c = xb_ld(&bar[XB_XCNT(j)]); sum += c; cnt += (c > 0u) ? 1u : 0u; mine = (j == x) ? c : mine; }
        if (sum == G) break;
        __builtin_amdgcn_s_sleep(1);
        if ((++sp & 255u) == 0u) { if (xb_ld(&bar[XB_TMO])) break; if (sp > XB_SPIN_CAP) { atomicAdd(&bar[XB_TMO], 1u); break; } }
    }
    nloc = mine > 0u ? mine : 1u; nx = cnt > 0u ? cnt : 1u;
}

__device__ __forceinline__ void xcd_barrier(const XcdBarrier& b) {
    asm volatile("s_waitcnt vmcnt(0)" ::: "memory");
    __syncthreads();
    if (threadIdx.x == 0) {
        unsigned* bar = b.bar;
        __builtin_amdgcn_s_waitcnt(0);
        unsigned nloc = b.st[0], nx = b.st[1];
        if (nloc == 0u) { xcd_barrier_complete(bar, b.x, nloc, nx); b.st[0] = nloc; b.st[1] = nx; }
        const unsigned old = xb_add(&bar[XB_XSUB(b.x)], 1u);
        const unsigned gen = old / nloc;
        if (old + 1u == (gen + 1u) * nloc) {
            __builtin_amdgcn_fence(__ATOMIC_RELEASE, "agent");
            asm volatile("s_waitcnt vmcnt(0)" ::: "memory");
            const unsigned og = xb_add(&bar[XB_TOP], 1u);
            const unsigned tg = og / nx;
            if (og + 1u == (tg + 1u) * nx) xb_add(&bar[XB_TOPGEN], 1u);
            else XB_SPIN(xb_ld(&bar[XB_TOPGEN]) == tg, bar);
            __builtin_amdgcn_fence(__ATOMIC_ACQUIRE, "agent");
            xb_add(&bar[XB_XGEN(b.x)], 1u);
            asm volatile("s_waitcnt vmcnt(0)" ::: "memory");
        } else {
            XB_SPIN(xb_ld(&bar[XB_XGEN(b.x)]) == gen, bar);
            __builtin_amdgcn_fence(__ATOMIC_ACQUIRE, "agent");
            asm volatile("s_waitcnt vmcnt(0)" ::: "memory");
        }
    }
    __syncthreads();
}


constexpr int NWAVES = 8, NTHR = 512;
constexpr int DM = 1024, TP = 16384, TS = 1024, TA = TP + TS, SEQ = 8192, NB_P = 2, NB_S = 128, LS = 8;
constexpr int N_IN = 3328;
constexpr int PASTL = 2048, PAGE = 128, NPAGES = 16;
constexpr float EPS = 1e-6f;
constexpr float LOG2E = 1.4426950408889634f;
constexpr float C2F = 0.125f * LOG2E;
constexpr float C2C = 0.0625f * LOG2E;

enum { I_XP = 0, I_XS, I_CFK, I_CFV, I_CFL, I_SGLA, I_CMK, I_CMV, I_PT, I_MEMP, I_GMIX, I_WIN, I_BFF, I_WG2, I_BG, I_GGO, I_WOUT, I_GCROSS, I_GMEM,
       I_WMK, I_WMV, I_WCQ, I_WCO, I_GFFN, I_PWQ, I_PSK, I_PU, I_PV, I_GFIN, N_INPUTS };
constexpr size_t O_YP = 0, O_YS = 16777216, O_FKP = 17825792, O_FVP = 26214400, O_LFP = 34603008, O_GSP = 34734080, O_MKP = 34799616, O_MVP = 35323904,
                 O_FKS = 35848192, O_FVS = 36372480, O_LFS = 36896768, O_GSS = 36904960, O_TOTAL = 41099264;

constexpr size_t MiB = 1u << 20;
constexpr size_t WS_CTL = 0, CTL_ZERO_BYTES = 1 * MiB;
constexpr size_t WS_WIN = 2 * MiB, WS_WOUT = 10 * MiB, WS_WMK = 12 * MiB, WS_WMV = 14 * MiB, WS_WCQ = 16 * MiB, WS_WCO = 18 * MiB, WS_WPK = 20 * MiB;
constexpr size_t WS_MB = 24 * MiB, WS_MK16 = 25 * MiB, WS_MVT16 = 26 * MiB, WS_KBIAS = 27 * MiB, WS_GDEC = 28 * MiB, WS_GG = 29 * MiB;
constexpr size_t WS_U16 = 32 * MiB, WS_V16 = 64 * MiB, WS_HB = 96 * MiB, WS_QF = 132 * MiB, WS_KF = 150 * MiB, WS_VF = 168 * MiB;
constexpr size_t WS_GQ = 186 * MiB, WS_GK = 204 * MiB, WS_GV = 222 * MiB, WS_GR = 256 * MiB, WS_SUF = 290 * MiB, WS_GKV = 298 * MiB;
constexpr size_t WS_MERGED = 330 * MiB, WS_X1 = 364 * MiB, WS_X2 = 432 * MiB, WS_QC = 500 * MiB, WS_PC = 534 * MiB, WS_OC = 566 * MiB, WS_SC = 600 * MiB;
constexpr size_t WS_MISC = 736 * MiB, WS_END = 800 * MiB;
constexpr int CW_BAR = 4096;

constexpr int RING_BYTES = 131072;
constexpr int LDSCTL_OFF = RING_BYTES, MISC_OFF = LDSCTL_OFF + 320;
constexpr int ARGS_OFF = MISC_OFF + 128;
constexpr int LDS_BYTES = 147456;

struct Args { const void* in[N_INPUTS]; float* out; unsigned char* ws; };

__device__ __forceinline__ const void* ld_ptr(const LAS unsigned long long* p) { const unsigned long long v = *p; const unsigned lo = __builtin_amdgcn_readfirstlane((unsigned)v), hi = __builtin_amdgcn_readfirstlane((unsigned)(v >> 32)); return (const void*)(const GAS char*)(((unsigned long long)hi << 32) | lo); }
__device__ __forceinline__ Args load_args(const LAS unsigned long long* ARGP) { Args A;
    A.in[0] = ld_ptr(ARGP + 0);
    A.in[1] = ld_ptr(ARGP + 1);
    A.in[2] = ld_ptr(ARGP + 2);
    A.in[3] = ld_ptr(ARGP + 3);
    A.in[4] = ld_ptr(ARGP + 4);
    A.in[5] = ld_ptr(ARGP + 5);
    A.in[6] = ld_ptr(ARGP + 6);
    A.in[7] = ld_ptr(ARGP + 7);
    A.in[8] = ld_ptr(ARGP + 8);
    A.in[9] = ld_ptr(ARGP + 9);
    A.in[10] = ld_ptr(ARGP + 10);
    A.in[11] = ld_ptr(ARGP + 11);
    A.in[12] = ld_ptr(ARGP + 12);
    A.in[13] = ld_ptr(ARGP + 13);
    A.in[14] = ld_ptr(ARGP + 14);
    A.in[15] = ld_ptr(ARGP + 15);
    A.in[16] = ld_ptr(ARGP + 16);
    A.in[17] = ld_ptr(ARGP + 17);
    A.in[18] = ld_ptr(ARGP + 18);
    A.in[19] = ld_ptr(ARGP + 19);
    A.in[20] = ld_ptr(ARGP + 20);
    A.in[21] = ld_ptr(ARGP + 21);
    A.in[22] = ld_ptr(ARGP + 22);
    A.in[23] = ld_ptr(ARGP + 23);
    A.in[24] = ld_ptr(ARGP + 24);
    A.in[25] = ld_ptr(ARGP + 25);
    A.in[26] = ld_ptr(ARGP + 26);
    A.in[27] = ld_ptr(ARGP + 27);
    A.in[28] = ld_ptr(ARGP + 28);
    A.out = (float*)ld_ptr(ARGP + N_INPUTS); A.ws = (unsigned char*)ld_ptr(ARGP + N_INPUTS + 1); return A; }
struct Frame {
    LAS unsigned char* lds;
    int tid, lane, wave, vcu, G;
};

__device__ __forceinline__ float wave_sum(float v) {
#pragma unroll
    for (int o = 1; o < 64; o <<= 1) v += __shfl_xor(v, o);
    return v;
}
__device__ __forceinline__ float log_sigmoid(float x) { return fminf(x, 0.f) - log1pf(__expf(-fabsf(x))); }

__device__ __forceinline__ int win_src_col(int r) {
    if (r < 1536) return r;
    if (r < 1792) return 1544 + (r - 1536);
    if (r < 2048) return 1800 + (r - 1792);
    if (r < 2560) return 2056 + (r - 2048);
    if (r < 3072) return 2584 + (r - 2560);
    if (r < 3080) return 1536 + (r - 3072);
    if (r < 3096) return 2568 + (r - 3080);
    return -1;
}
template <bool WIN>
__device__ __forceinline__ void p0_transpose_item(const float* W, int ldw, int K, int nblk, bf16* WT, LAS float* scr, int item, int lane) {
    const int kb = item / nblk, nb = item % nblk, k0 = 64 * kb, n0 = 32 * nb;
    const int dr = n0 + (lane & 31); const int sc = WIN ? win_src_col(dr) : dr;
#pragma unroll 8
    for (int i = 0; i < 32; ++i) { const int kk = 2 * i + (lane >> 5); scr[kk * 33 + (lane & 31)] = (sc >= 0) ? W[(size_t)(k0 + kk) * ldw + sc] : 0.f; }
    LDS_WAIT(); asm volatile("" ::: "memory");
    const int c = lane & 7;
#pragma unroll
    for (int j = 0; j < 4; ++j) { const int n = (lane >> 3) + 8 * j; const LAS float* s = scr + (8 * c) * 33 + n;
        v4u o; o.x = pk2(s[0 * 33], s[1 * 33]); o.y = pk2(s[2 * 33], s[3 * 33]); o.z = pk2(s[4 * 33], s[5 * 33]); o.w = pk2(s[6 * 33], s[7 * 33]);
        *(GAS v4u*)(WT + (size_t)(n0 + n) * K + k0 + 8 * c) = o; }
    LDS_WAIT(); asm volatile("" ::: "memory");
}
__device__ __forceinline__ void rms_row_bf16(const float* xrow, const float* g, bf16* orow, int lane) {
    const f32x4* xr = (const f32x4*)xrow + lane; const f32x4* gr = (const f32x4*)g + lane;
    f32x4 v[4]; float s = 0.f;
#pragma unroll
    for (int j = 0; j < 4; ++j) { v[j] = xr[64 * j]; s += (v[j].x * v[j].x + v[j].y * v[j].y) + (v[j].z * v[j].z + v[j].w * v[j].w); }
    const float r = rsqrtf(wave_sum(s) * (1.f / DM) + EPS);
    v2u* o8 = (v2u*)orow + lane;
#pragma unroll
    for (int j = 0; j < 4; ++j) { const f32x4 gg = gr[64 * j]; v2u o; o.x = pk2(v[j].x * r * gg.x, v[j].y * r * gg.y); o.y = pk2(v[j].z * r * gg.z, v[j].w * r * gg.w); o8[64 * j] = o; }
}

using pg8::Unit;
struct EpiGen {
    static constexpr bool PERM = false, AFTER_DRAIN = false;
    float* d32; int ld32; bf16* d16; int ld16; float sc16;
    const float* r0; const float* r1; int rsplit; int ldr;
    __device__ __forceinline__ void operator()(const f32x4 (&acc)[2][2][4][2], const Unit& u, int wr, int wc, int fr, int fq) const {
        int row0 = u.pm * 256 + wr * 64 + fr, col0 = u.pn * 256 + wc * 32 + fq * 4;
        asm volatile("" : "+v"(row0), "+v"(col0));
#pragma unroll
        for (int ai = 0; ai < 2; ++ai)
#pragma unroll
            for (int m = 0; m < 4; ++m) { const int row = row0 + ai * 128 + m * 16;
                const float* rp = nullptr; if (r0) rp = (row < rsplit) ? r0 + (size_t)row * ldr : r1 + (size_t)(row - rsplit) * ldr;
#pragma unroll
                for (int bj = 0; bj < 2; ++bj)
#pragma unroll
                    for (int n = 0; n < 2; ++n) { const int col = col0 + bj * 128 + n * 16; f32x4 v = acc[ai][bj][m][n];
                        if (r0) v += *(const f32x4*)(rp + col);
                        if (d32) *(f32x4*)(d32 + (size_t)row * ld32 + col) = v;
                        if (d16) { v2u o; o.x = pg8::cvt_pk_bf16(v[0] * sc16, v[1] * sc16); o.y = pg8::cvt_pk_bf16(v[2] * sc16, v[3] * sc16); *(v2u*)(d16 + (size_t)row * ld16 + col) = o; } } }
    }
};
struct EpiInProj {
    static constexpr bool PERM = false, AFTER_DRAIN = false;
    float* out; unsigned char* ws; const float* bff;
    __device__ __forceinline__ void operator()(const f32x4 (&acc)[2][2][4][2], const Unit& u, int wr, int wc, int fr, int fq) const {
        const int pn = u.pn; const bool smp = u.pm >= 64;
        int row0 = u.pm * 256 + wr * 64 + fr;
        int orow0 = (smp ? (u.pm - 64) * 256 : u.pm * 256) + wr * 64 + fr;
        asm volatile("" : "+v"(row0), "+v"(orow0));
        float* d32 = nullptr; int ld32 = 0; bool d32_grp = false; bf16* d16 = nullptr; int ld16 = 0; float s32 = 1.f, s16 = 1.f; int cb = 0;
        if (pn < 2) { d16 = (bf16*)(ws + WS_QF); ld16 = 512; s16 = C2F; cb = pn * 256; }
        else if (pn < 4) { d32 = out + (smp ? O_FKS : O_FKP); ld32 = 512; d32_grp = true; d16 = (bf16*)(ws + WS_KF); ld16 = 512; cb = (pn - 2) * 256; }
        else if (pn < 6) { d32 = out + (smp ? O_FVS : O_FVP); ld32 = 512; d32_grp = true; d16 = (bf16*)(ws + WS_VF); ld16 = 512; cb = (pn - 4) * 256; }
        else if (pn == 6) { d32 = (float*)(ws + WS_GQ); ld32 = 256; s32 = 0.125f; }
        else if (pn == 7) { d32 = (float*)(ws + WS_GK); ld32 = 256; }
        else if (pn < 10) { d32 = (float*)(ws + WS_GV); ld32 = 512; cb = (pn - 8) * 256; }
        else if (pn < 12) { d32 = (float*)(ws + WS_GR); ld32 = 512; cb = (pn - 10) * 256; }
        if (pn < 12) {
#pragma unroll
            for (int ai = 0; ai < 2; ++ai)
#pragma unroll
                for (int m = 0; m < 4; ++m) { const int row = row0 + ai * 128 + m * 16, orow = orow0 + ai * 128 + m * 16;
#pragma unroll
                    for (int bj = 0; bj < 2; ++bj)
#pragma unroll
                        for (int n = 0; n < 2; ++n) { const int col = cb + wc * 32 + fq * 4 + bj * 128 + n * 16; const f32x4 v = acc[ai][bj][m][n];
                            if (d32) *(f32x4*)(d32 + (size_t)(d32_grp ? orow : row) * ld32 + col) = v * s32;
                            if (d16) { v2u o; o.x = pg8::cvt_pk_bf16(v[0] * s16, v[1] * s16); o.y = pg8::cvt_pk_bf16(v[2] * s16, v[3] * s16); *(v2u*)(d16 + (size_t)row * ld16 + col) = o; } } }
        } else {
            if (wc == 0) {
                float* lf = out + (smp ? O_LFS : O_LFP); float* ggp = (float*)(ws + WS_GG);
#pragma unroll
                for (int ai = 0; ai < 2; ++ai)
#pragma unroll
                    for (int m = 0; m < 4; ++m) { const int row = row0 + ai * 128 + m * 16, orow = orow0 + ai * 128 + m * 16;
#pragma unroll
                        for (int n = 0; n < 2; ++n) { const int col = n * 16 + fq * 4; const f32x4 v = acc[ai][0][m][n];
                            if (col < 8) { f32x4 o; const f32x4 b = *(const f32x4*)(bff + col);
                                o[0] = log_sigmoid(v[0] + b[0]); o[1] = log_sigmoid(v[1] + b[1]); o[2] = log_sigmoid(v[2] + b[2]); o[3] = log_sigmoid(v[3] + b[3]);
                                *(f32x4*)(lf + (size_t)orow * 8 + col) = o; }
                            else if (col < 24) *(f32x4*)(ggp + (size_t)row * 16 + (col - 8)) = v; } }
            }
        }
    }
};


__device__ __forceinline__ void p0_prologue(const Frame& F, const Args& a) {
    unsigned char* ws = a.ws;
    LAS float* scr = (LAS float*)(F.lds + F.wave * 16384);
    const int gw = F.vcu * NWAVES + F.wave, NGW = F.G * NWAVES;
    constexpr int I_WINN = 16 * (N_IN / 32), I_SQ = 16 * 32;
    constexpr int NITEMS = I_WINN + 5 * I_SQ;
    for (int it = gw; it < NITEMS; it += NGW) {
        int r = it;
        if (r < I_WINN) { p0_transpose_item<true>((const float*)a.in[I_WIN], 3096, DM, N_IN / 32, (bf16*)(ws + WS_WIN), scr, r, F.lane); continue; } r -= I_WINN;
        const int which = r / I_SQ; r -= which * I_SQ;
        const float* src = (const float*)(which == 0 ? a.in[I_WOUT] : which == 1 ? a.in[I_WMK] : which == 2 ? a.in[I_WMV] : which == 3 ? a.in[I_WCQ] : a.in[I_WCO]);
        bf16* dst = (bf16*)(ws + (which == 0 ? WS_WOUT : which == 1 ? WS_WMK : which == 2 ? WS_WMV : which == 3 ? WS_WCQ : WS_WCO));
        p0_transpose_item<false>(src, DM, DM, 32, dst, scr, r, F.lane);
    }
    for (int m = gw; m < TA + 512; m += NGW) {
        if (m < TP) rms_row_bf16((const float*)a.in[I_XP] + (size_t)m * DM, (const float*)a.in[I_GMIX], (bf16*)(ws + WS_HB) + (size_t)m * DM, F.lane);
        else if (m < TA) rms_row_bf16((const float*)a.in[I_XS] + (size_t)(m - TP) * DM, (const float*)a.in[I_GMIX], (bf16*)(ws + WS_HB) + (size_t)m * DM, F.lane);
        else rms_row_bf16((const float*)a.in[I_MEMP] + (size_t)(m - TA) * DM, (const float*)a.in[I_GMEM], (bf16*)(ws + WS_MB) + (size_t)(m - TA) * DM, F.lane);
    }
    {
        for (int r = gw; r < 2 * 16384; r += NGW) {
            const bool isv = r >= 16384; const int e = isv ? r - 16384 : r;
            const f32x4* s = (const f32x4*)((const float*)(isv ? a.in[I_PV] : a.in[I_PU]) + (size_t)e * DM + 16 * F.lane);
            f32x4 x[4]; float am = 0.f;
#pragma unroll
            for (int q = 0; q < 4; ++q) { x[q] = __builtin_nontemporal_load(s + q); am = fmaxf(am, fmaxf(fmaxf(fabsf(x[q].x), fabsf(x[q].y)), fmaxf(fabsf(x[q].z), fabsf(x[q].w)))); }
#pragma unroll
            for (int o = 1; o < 64; o <<= 1) am = fmaxf(am, __shfl_xor(am, o));
            const float inv = am > 0.f ? 448.f / am : 0.f;
            v4u o4;
#pragma unroll
            for (int q = 0; q < 4; ++q) { int pk = __builtin_amdgcn_cvt_pk_fp8_f32(x[q].x * inv, x[q].y * inv, 0, false); pk = __builtin_amdgcn_cvt_pk_fp8_f32(x[q].z * inv, x[q].w * inv, pk, true); o4[q] = (unsigned)pk; }
            *(v4u*)(ws + (isv ? WS_V16 : WS_U16) + (size_t)e * DM + 16 * F.lane) = o4;
            if (F.lane == 0) ((float*)(ws + WS_MISC))[r] = am * (1.f / 448.f);
        }
    }
    __syncthreads();
    for (int it = blockIdx.x; it < 256; it += F.G) {
        const int c = it >> 4, kt = it & 15, half = c & 1;
        LAS float* SK = (LAS float*)F.lds; LAS float* WT = (LAS float*)(F.lds + 128 * 129 * 4);
        const float* sk = (const float*)a.in[I_PSK] + (size_t)half * 128 * 128; const float* wq = (const float*)a.in[I_PWQ] + (size_t)(kt * 64) * 2048 + c * 128;
#pragma unroll 4
        for (int i = 0; i < 32; ++i) { const int idx = F.tid + 512 * i; SK[(idx >> 7) * 129 + (idx & 127)] = sk[idx]; }
#pragma unroll 4
        for (int i = 0; i < 16; ++i) { const int idx = F.tid + 512 * i; WT[(idx >> 7) * 129 + (idx & 127)] = wq[(size_t)(idx >> 7) * 2048 + (idx & 127)]; }
        __syncthreads();
        const int tk = F.tid & 15, tkey = F.tid >> 4;
        float acc[4][4];
#pragma unroll
        for (int i = 0; i < 4; ++i)
#pragma unroll
            for (int j = 0; j < 4; ++j) acc[i][j] = 0.f;
        for (int j = 0; j < 128; ++j) {
            float av[4], bv[4];
#pragma unroll
            for (int i = 0; i < 4; ++i) { av[i] = SK[(4 * tkey + i) * 129 + j]; bv[i] = WT[(4 * tk + i) * 129 + j]; }
#pragma unroll
            for (int i = 0; i < 4; ++i)
#pragma unroll
                for (int i2 = 0; i2 < 4; ++i2) acc[i][i2] += av[i] * bv[i2];
        }
        bf16* wp = (bf16*)(ws + WS_WPK);
#pragma unroll
        for (int i = 0; i < 4; ++i) { v2u o; o.x = pk2(acc[i][0], acc[i][1]); o.y = pk2(acc[i][2], acc[i][3]); *(v2u*)(wp + (size_t)(c * 128 + 4 * tkey + i) * DM + kt * 64 + 4 * tk) = o; }
        __syncthreads();
    }
}


__device__ __forceinline__ void fox_prompt_cumsum(const Frame& F, const float* logf  , float* kbias, int b) {
    LAS float* WT = (LAS float*)F.lds;
    const int t0 = F.wave * 1024 + F.lane * 16;
    const f32x4* src = (const f32x4*)(logf + ((size_t)b * SEQ + t0) * 8);
    float s[8];
#pragma unroll
    for (int h = 0; h < 8; ++h) s[h] = 0.f;
#pragma unroll 4
    for (int i = 0; i < 16; ++i) { const f32x4 a = src[2 * i], c = src[2 * i + 1]; s[0] += a.x; s[1] += a.y; s[2] += a.z; s[3] += a.w; s[4] += c.x; s[5] += c.y; s[6] += c.z; s[7] += c.w; }
    float ex[8];
#pragma unroll
    for (int h = 0; h < 8; ++h) { float v = s[h];
#pragma unroll
        for (int o = 1; o < 64; o <<= 1) { const float t = __shfl_up(v, o); if (F.lane >= o) v += t; }
        ex[h] = v - s[h];
        if (F.lane == 63) WT[F.wave * 8 + h] = v; }
    __syncthreads();
#pragma unroll
    for (int h = 0; h < 8; ++h) { float c = 0.f; for (int w = 0; w < F.wave; ++w) c += WT[w * 8 + h]; ex[h] += c; }
    float* dst = kbias + (size_t)(b * 8) * SEQ + t0;
#pragma unroll 4
    for (int i = 0; i < 16; ++i) { const f32x4 a = src[2 * i], c = src[2 * i + 1];
        ex[0] += a.x; ex[1] += a.y; ex[2] += a.z; ex[3] += a.w; ex[4] += c.x; ex[5] += c.y; ex[6] += c.z; ex[7] += c.w;
#pragma unroll
        for (int h = 0; h < 8; ++h) dst[(size_t)h * SEQ + i] = -ex[h] * LOG2E; }
    __syncthreads();
}
__device__ __forceinline__ void fox_sample_suffix(const Frame& F, const float* cfl, const int* pt, float* suf, int bs) {
    float carry[8];
#pragma unroll
    for (int h = 0; h < 8; ++h) carry[h] = 0.f;
    for (int p = NPAGES - 1; p >= 0; --p) {
        const int pg = pt[bs * NPAGES + p];
        const f32x4* src = (const f32x4*)(cfl + ((size_t)pg * PAGE + 2 * F.lane) * 8);
        const f32x4 a0 = src[0], a1 = src[1], b0 = src[2], b1 = src[3];
        const float ra[8] = {a0.x, a0.y, a0.z, a0.w, a1.x, a1.y, a1.z, a1.w}, rb[8] = {b0.x, b0.y, b0.z, b0.w, b1.x, b1.y, b1.z, b1.w};
#pragma unroll
        for (int h = 0; h < 8; ++h) {
            const float ps = ra[h] + rb[h]; float v = ps;
#pragma unroll
            for (int o = 1; o < 64; o <<= 1) { const float t = __shfl_down(v, o); if (F.lane + o < 64) v += t; }
            const float exs = v - ps;
            float* d = suf + (size_t)(bs * 8 + h) * PASTL + p * PAGE + 2 * F.lane;
            d[1] = (carry[h] + exs) * LOG2E; d[0] = (carry[h] + exs + rb[h]) * LOG2E;
            carry[h] += __shfl(v, 0);
        }
    }
}

__device__ __forceinline__ void gla_gate_tile(const Frame& F, const float* gg, const float* w2, const float* bg, int row0, int h, int nt, LAS float* LA) {
    for (int e = F.tid; e < nt * 64; e += NTHR) { const int t = e >> 6, dk = e & 63; const float* g = gg + (size_t)(row0 + t) * 16; float z = bg[h * 64 + dk];
#pragma unroll
        for (int r = 0; r < 16; ++r) z += g[r] * w2[r * 256 + h * 64 + dk];
        LA[t * 64 + dk] = log_sigmoid(z) * (1.f / 16.f); }
}
__device__ __forceinline__ void gla_g1_unit(const Frame& F, const Args& a, int u) {
    unsigned char* ws = a.ws;
    const int b = u >> 9, h = (u >> 7) & 3, n = u & 127; const int row0 = b * SEQ + n * 64;
    LAS float* LA = (LAS float*)F.lds; LAS float* KR = LA + 4096; LAS float* BL = KR + 4096;
    gla_gate_tile(F, (const float*)(ws + WS_GG), (const float*)a.in[I_WG2], (const float*)a.in[I_BG], row0, h, 64, LA);
    __syncthreads();
    if (F.tid < 64) { float run = 0.f; for (int t = 0; t < 64; ++t) { run += LA[t * 64 + F.tid]; LA[t * 64 + F.tid] = run; } BL[F.tid] = run;
        ((float*)(ws + WS_GDEC))[(size_t)((b * 4 + h) * 128 + n) * 64 + F.tid] = __expf(run); }
    __syncthreads();
    const float* gk = (const float*)(ws + WS_GK);
    for (int e = F.tid; e < 4096; e += NTHR) { const int t = e >> 6, dk = e & 63; KR[e] = gk[(size_t)(row0 + t) * 256 + h * 64 + dk] * __expf(BL[dk] - LA[e]); }
    __syncthreads();
    const int dv = F.tid & 127, dkg = F.tid >> 7;
    float acc[16];
#pragma unroll
    for (int i = 0; i < 16; ++i) acc[i] = 0.f;
    const float* gv = (const float*)(ws + WS_GV) + (size_t)row0 * 512 + h * 128 + dv;
#pragma unroll 4
    for (int t = 0; t < 64; ++t) { const float v = gv[(size_t)t * 512]; const LAS f32x4* kr = (const LAS f32x4*)(KR + t * 64 + dkg * 16);
#pragma unroll
        for (int q = 0; q < 4; ++q) { const f32x4 k4 = kr[q]; acc[4 * q] += k4.x * v; acc[4 * q + 1] += k4.y * v; acc[4 * q + 2] += k4.z * v; acc[4 * q + 3] += k4.w * v; } }
    float* kv = (float*)(ws + WS_GKV) + ((size_t)((b * 4 + h) * 128 + n) * 64 + dkg * 16) * 128 + dv;
#pragma unroll
    for (int i = 0; i < 16; ++i) kv[(size_t)i * 128] = acc[i];
    __syncthreads();
}
__device__ __forceinline__ void gla_scan(const Frame& F, const Args& a) {
    if (F.tid >= 256) return;
    for (int e = F.vcu * 256 + F.tid; e < 65536; e += F.G * 256) {
    const int bh = e >> 13, dk = (e >> 7) & 63, dv = e & 127;
    float* kv = (float*)(a.ws + WS_GKV) + ((size_t)bh * 128 * 64 + dk) * 128 + dv; const float* dc = (const float*)(a.ws + WS_GDEC) + (size_t)bh * 128 * 64 + dk;
    float S = 0.f;
    for (int n0 = 0; n0 < 128; n0 += 8) { float kvv[8], dd[8];
#pragma unroll
        for (int j = 0; j < 8; ++j) { kvv[j] = kv[(size_t)(n0 + j) * 8192]; dd[j] = dc[(size_t)(n0 + j) * 64]; }
#pragma unroll
        for (int j = 0; j < 8; ++j) { kv[(size_t)(n0 + j) * 8192] = S; S = dd[j] * S + kvv[j]; } }
    a.out[O_GSP + (size_t)bh * 8192 + dk * 128 + dv] = S;
    }
}
__device__ __forceinline__ float silu(float x) { return x / (1.f + __expf(-x)); }
__device__ __forceinline__ void gla_sample_unit(const Frame& F, const Args& a, int u) {
    unsigned char* ws = a.ws;
    const int bs = u >> 2, h = u & 3; const int row0 = TP + bs * LS;
    LAS float* LA = (LAS float*)F.lds; LAS float* BL = LA + 512; LAS float* QD = BL + 64; LAS float* KI = QD + 512; LAS float* KR = KI + 512; LAS float* ATT = KR + 512; LAS float* OP = ATT + 64; LAS float* VS = OP + 4096;
    gla_gate_tile(F, (const float*)(ws + WS_GG), (const float*)a.in[I_WG2], (const float*)a.in[I_BG], row0, h, 8, LA);
    for (int e = F.tid; e < 1024; e += NTHR) VS[e] = ((const float*)(ws + WS_GV))[(size_t)(row0 + (e >> 7)) * 512 + h * 128 + (e & 127)];
    __syncthreads();
    if (F.tid < 64) { float run = 0.f;
#pragma unroll
        for (int t = 0; t < 8; ++t) { run += LA[t * 64 + F.tid]; LA[t * 64 + F.tid] = run; } BL[F.tid] = run; }
    __syncthreads();
    { const int e = F.tid, t = e >> 6, dk = e & 63; const float bb = LA[e];
      const float q = ((const float*)(ws + WS_GQ))[(size_t)(row0 + t) * 256 + h * 64 + dk], k = ((const float*)(ws + WS_GK))[(size_t)(row0 + t) * 256 + h * 64 + dk];
      QD[e] = q * __expf(bb); KI[e] = k * __expf(-bb); KR[e] = k * __expf(BL[dk] - bb); }
    __syncthreads();
    if (F.tid < 64) { const int t = F.tid >> 3, s = F.tid & 7; float acc = 0.f;
        if (s <= t) { for (int dk = 0; dk < 64; ++dk) acc += QD[t * 64 + dk] * KI[s * 64 + dk]; }
        ATT[F.tid] = acc; }
    const int dv = F.tid & 127, dkg = F.tid >> 7;
    {
        const float* st = (const float*)a.in[I_SGLA] + ((size_t)(bs * 4 + h) * 64 + dkg * 16) * 128 + dv;
        float S0[16];
#pragma unroll
        for (int i = 0; i < 16; ++i) S0[i] = st[(size_t)i * 128];
#pragma unroll
        for (int t = 0; t < 8; ++t) { float o = 0.f;
#pragma unroll
            for (int i = 0; i < 16; ++i) o += QD[t * 64 + dkg * 16 + i] * S0[i];
            OP[(dkg * 8 + t) * 128 + dv] = o; }
        float* so = a.out + O_GSS + ((size_t)(bs * 4 + h) * 64 + dkg * 16) * 128 + dv;
#pragma unroll
        for (int i = 0; i < 16; ++i) { float sn = __expf(BL[dkg * 16 + i]) * S0[i];
#pragma unroll
            for (int t = 0; t < 8; ++t) sn += KR[t * 64 + dkg * 16 + i] * VS[t * 128 + dv];
            so[(size_t)i * 128] = sn; }
    }
    __syncthreads();
    {
        const int t = F.wave; float o[2]; float ss = 0.f;
#pragma unroll
        for (int j = 0; j < 2; ++j) { const int d = 2 * F.lane + j; float v = OP[(0 * 8 + t) * 128 + d] + OP[(1 * 8 + t) * 128 + d] + OP[(2 * 8 + t) * 128 + d] + OP[(3 * 8 + t) * 128 + d];
            for (int s = 0; s <= t; ++s) v += ATT[t * 8 + s] * VS[s * 128 + d];
            o[j] = v; ss += v * v; }
        const float r = rsqrtf(wave_sum(ss) * (1.f / 128.f) + EPS);
        const float* ggo = (const float*)a.in[I_GGO] + h * 128 + 2 * F.lane; const float* gr = (const float*)(ws + WS_GR) + (size_t)(row0 + t) * 512 + h * 128 + 2 * F.lane;
        const float y0 = o[0] * r * ggo[0] * silu(gr[0]), y1 = o[1] * r * ggo[1] * silu(gr[1]);
        *(unsigned*)((bf16*)(ws + WS_MERGED) + (size_t)(row0 + t) * DM + 512 + h * 128 + 2 * F.lane) = pk2(y0, y1);
    }
    __syncthreads();
}


typedef short v4i16_t __attribute__((ext_vector_type(4)));
__device__ __forceinline__ s16x4 lds_tr16(LAS unsigned char* p) { return __builtin_bit_cast(s16x4, __builtin_amdgcn_ds_read_tr16_b64_v4i16((LAS v4i16_t*)p)); }
__device__ __forceinline__ int crow(int r, int hi) { return (r & 3) + 8 * (r >> 2) + 4 * hi; }
__device__ __forceinline__ float fexp2(float x) { return __builtin_amdgcn_exp2f(x); }
constexpr float FOX_SKIP = 160.f;


__device__ __forceinline__ void fox_norms_item(const Frame& F, const bf16* QF, const bf16* KF, float* FN, int item) {
    const int bh = item >> 5, qb = item & 31, b = bh >> 3, h = bh & 7;
    float qm = 0.f, km = 0.f;
#pragma unroll 1
    for (int i = 0; i < 4; ++i) { const size_t row = (size_t)b * SEQ + qb * 256 + i * 64 + F.lane;
        const v4u* qp = (const v4u*)(QF + row * 512 + h * 64); const v4u* kp = (const v4u*)(KF + row * 512 + h * 64); float qs = 0.f, ks = 0.f;
#pragma unroll
        for (int c = 0; c < 8; ++c) { const v4u q = qp[c], k = kp[c];
#pragma unroll
            for (int j = 0; j < 4; ++j) { qs += bflo(q[j]) * bflo(q[j]) + bfhi(q[j]) * bfhi(q[j]); ks += bflo(k[j]) * bflo(k[j]) + bfhi(k[j]) * bfhi(k[j]); } }
        qm = fmaxf(qm, qs); km = fmaxf(km, ks); }
#pragma unroll
    for (int o = 1; o < 64; o <<= 1) { qm = fmaxf(qm, __shfl_xor(qm, o)); km = fmaxf(km, __shfl_xor(km, o)); }
    if (F.lane == 0) { FN[item * 2] = qm; FN[item * 2 + 1] = km; }
}
__device__ __forceinline__ void fox_attn_unit(const Frame& F, const bf16* QF, const bf16* KF, const bf16* VF, const float* kbias, const float* FN, bf16* merged, int b, int h, int qb) {
    const int lane = F.lane, r32 = lane & 31, hi = lane >> 5, wid = F.wave, tid = F.tid;
    const size_t rowbase = (size_t)b * SEQ; const int q0 = qb * 256;
    LAS unsigned char* Ks = F.lds; LAS unsigned char* Vs = F.lds + 8192; LAS float* KBs = (LAS float*)(F.lds + 20480); LAS float* WSF = (LAS float*)(F.lds + 20736) + wid * 32;
    const bf16* Qw = QF + (rowbase + q0 + wid * 32 + r32) * 512 + h * 64;
    bf16x8 qr[4];
#pragma unroll
    for (int d0 = 0; d0 < 4; ++d0) qr[d0] = *(const bf16x8*)(Qw + d0 * 16 + hi * 8);
    const float* kbp = kbias + (size_t)(b * 8 + h) * SEQ; const float kbref = kbp[q0];
    const int NT = (q0 + 256) / 64;
    int t0 = 0;
    {
        float kn = (lane < 32) ? FN[((b * 8 + h) * 32 + lane) * 2 + 1] : 0.f;
#pragma unroll
        for (int o = 1; o < 64; o <<= 1) kn = fmaxf(kn, __shfl_xor(kn, o));
        const float qk2 = 2.f * sqrtf(FN[((b * 8 + h) * 32 + qb) * 2]) * sqrtf(kn) * 1.01f;
        const int nbefore = q0 / 64;
        int found = -1;
        for (int base = 0; base < nbefore && found < 0; base += 64) {
            const int tl = nbefore - 1 - base - lane;
            const bool dead = (tl >= 0) && (qk2 + (kbp[tl * 64 + 63] - kbref) < -FOX_SKIP);
            const unsigned long long bm = __ballot(dead);
            if (bm) found = nbefore - 1 - base - (int)__builtin_ctzll(bm);
        }
        t0 = found + 1;
        t0 = __builtin_amdgcn_readfirstlane(t0);
    }
    const int kkey = tid & 63, kch = tid >> 6, vkey = tid >> 3, vch = tid & 7;
    const bf16* ksrc = KF + (rowbase + kkey) * 512 + h * 64 + kch * 8;
    const bf16* vsrc = VF + (rowbase + vkey) * 512 + h * 64 + vch * 8;
    v4u kreg = *(const v4u*)(ksrc + (size_t)t0 * 64 * 512), vreg = *(const v4u*)(vsrc + (size_t)t0 * 64 * 512); float kbreg = (tid < 64) ? kbp[t0 * 64 + tid] - kbref : 0.f;
    float m_run = -INFINITY, l_run = 0.f; f32x16 o0 = {}, o1 = {};
    const int qpos = q0 + wid * 32 + r32;
    const int vbase = (4 * hi + ((lane & 15) >> 2)) * 192 + (16 * ((lane >> 4) & 1) + 4 * (lane & 3)) * 2;
    for (int t = t0; t < NT; ++t) {
        __syncthreads();
        *(LAS v4u*)(Ks + kch * 1024 + kkey * 16) = kreg; *(LAS v4u*)(Vs + vkey * 192 + vch * 16) = vreg; if (tid < 64) KBs[tid] = kbreg;
        __syncthreads();
        if (t + 1 < NT) { kreg = *(const v4u*)(ksrc + (size_t)(t + 1) * 64 * 512); vreg = *(const v4u*)(vsrc + (size_t)(t + 1) * 64 * 512); if (tid < 64) kbreg = kbp[(t + 1) * 64 + tid] - kbref; }
        const int k0 = t * 64;
        if (k0 > q0 + wid * 32 + 31) continue;
        f32x16 p0 = {}, p1 = {};
#pragma unroll
        for (int d0 = 0; d0 < 4; ++d0) {
            const bf16x8 a0 = *(const LAS bf16x8*)(Ks + (2 * d0 + hi) * 1024 + r32 * 16), a1 = *(const LAS bf16x8*)(Ks + (2 * d0 + hi) * 1024 + r32 * 16 + 512);
            p0 = __builtin_amdgcn_mfma_f32_32x32x16_bf16(a0, qr[d0], p0, 0, 0, 0); p1 = __builtin_amdgcn_mfma_f32_32x32x16_bf16(a1, qr[d0], p1, 0, 0, 0);
        }
#pragma unroll
        for (int g = 0; g < 4; ++g) { const f32x4 ba = *(const LAS f32x4*)(KBs + 8 * g + 4 * hi), bb = *(const LAS f32x4*)(KBs + 32 + 8 * g + 4 * hi);
#pragma unroll
            for (int i = 0; i < 4; ++i) { p0[4 * g + i] += ba[i]; p1[4 * g + i] += bb[i]; } }
        if (k0 + 63 > q0 + wid * 32) {
#pragma unroll
            for (int r = 0; r < 16; ++r) { const int key = k0 + crow(r, hi); if (key > qpos) p0[r] = -INFINITY; if (key + 32 > qpos) p1[r] = -INFINITY; }
        }
        float mx = fmaxf(p0[0], p1[0]);
#pragma unroll
        for (int r = 1; r < 16; ++r) mx = fmaxf(mx, fmaxf(p0[r], p1[r]));
        mx = fmaxf(mx, __shfl_xor(mx, 32));
        const float m_new = fmaxf(m_run, mx), alpha = fexp2(m_run - m_new); m_run = m_new;
        float ls = 0.f;
#pragma unroll
        for (int r = 0; r < 16; ++r) { p0[r] = fexp2(p0[r] - m_new); p1[r] = fexp2(p1[r] - m_new); ls += p0[r] + p1[r]; }
        l_run = l_run * alpha + ls;
        if (hi == 0) WSF[r32] = alpha;
#pragma unroll
        for (int g = 0; g < 4; ++g) { const f32x4 al = *(const LAS f32x4*)(WSF + 8 * g + 4 * hi);
#pragma unroll
            for (int i = 0; i < 4; ++i) { o0[4 * g + i] *= al[i]; o1[4 * g + i] *= al[i]; } }
        v4u pw[4];
#pragma unroll
        for (int j = 0; j < 4; ++j) { pw[0][j] = pg8::cvt_pk_bf16(p0[2 * j], p0[2 * j + 1]); pw[1][j] = pg8::cvt_pk_bf16(p0[8 + 2 * j], p0[8 + 2 * j + 1]);
                                      pw[2][j] = pg8::cvt_pk_bf16(p1[2 * j], p1[2 * j + 1]); pw[3][j] = pg8::cvt_pk_bf16(p1[8 + 2 * j], p1[8 + 2 * j + 1]); }
#pragma unroll
        for (int ks = 0; ks < 4; ++ks) {
            const bf16x8 pa = __builtin_bit_cast(bf16x8, pw[ks]);
#pragma unroll
            for (int d0 = 0; d0 < 2; ++d0) {
                const s16x4 lo = lds_tr16(Vs + vbase + ks * 16 * 192 + d0 * 64), hi4 = lds_tr16(Vs + vbase + ks * 16 * 192 + 8 * 192 + d0 * 64);
                const bf16x8 vb = (bf16x8){lo[0], lo[1], lo[2], lo[3], hi4[0], hi4[1], hi4[2], hi4[3]};
                if (d0 == 0) o0 = __builtin_amdgcn_mfma_f32_32x32x16_bf16(pa, vb, o0, 0, 0, 0); else o1 = __builtin_amdgcn_mfma_f32_32x32x16_bf16(pa, vb, o1, 0, 0, 0);
            }
        }
    }
    l_run += __shfl_xor(l_run, 32);
    if (hi == 0) WSF[r32] = 1.f / l_run;
    bf16* Ow = merged + (rowbase + q0 + wid * 32) * DM + h * 64 + r32;
#pragma unroll
    for (int g = 0; g < 4; ++g) { const f32x4 rl = *(const LAS f32x4*)(WSF + 8 * g + 4 * hi);
#pragma unroll
        for (int i = 0; i < 4; ++i) { const int r = 4 * g + i; const int row = crow(r, hi);
            Ow[(size_t)row * DM] = (bf16)f2bf(o0[r] * rl[i]); Ow[(size_t)row * DM + 32] = (bf16)f2bf(o1[r] * rl[i]); } }
    __syncthreads();
}

template <int D> struct DecW {
    static constexpr int KS = D / 32;
    static constexpr int LPK = D / 4;
    static constexpr int KPI = 64 / LPK;
    float m[4], l[4]; float o[8][4];
};
template <int D>
__device__ __forceinline__ void dec_init(DecW<D>& w) {
#pragma unroll
    for (int i = 0; i < 4; ++i) { w.m[i] = -INFINITY; w.l[i] = 0.f; }
#pragma unroll
    for (int q = 0; q < 8; ++q)
#pragma unroll
        for (int j = 0; j < 4; ++j) w.o[q][j] = 0.f;
}
template <int D, int NTILE, int MODE>
__device__ __forceinline__ void dec_chunk(DecW<D>& w, const bf16x8 (&qa)[D / 32], const float* Kb, const float* Vb, int stride, const float* bias, float nb, LAS float* PL, int lane) {
    constexpr int KS = D / 32, LPK = D / 4, KPI = 64 / LPK;
    constexpr int NK = (MODE == 1) ? 8 : NTILE * 16, NV = NK / KPI;
    const int key = lane & 15, kq = lane >> 4;
    const unsigned koff = (unsigned)(key * stride + 8 * kq) * 4u;
    const int d4 = lane % LPK, ksub = lane / LPK;
    const unsigned voff = (unsigned)(ksub * stride + 4 * d4) * 4u;
    f32x4 kx[NTILE][2 * KS], vx[NV];
#pragma unroll
    for (int t = 0; t < NTILE; ++t) { const char* kp = (const char*)(Kb + (size_t)t * 16 * stride) + koff;
#pragma unroll
        for (int ks = 0; ks < KS; ++ks) { kx[t][2 * ks] = *(const f32x4*)(kp + 128 * ks); kx[t][2 * ks + 1] = *(const f32x4*)(kp + 128 * ks + 16); } }
    constexpr int NVA = (NV >= 8) ? NV / 2 : NV;
#pragma unroll
    for (int kk = 0; kk < NVA; ++kk) vx[kk] = *(const f32x4*)((const char*)(Vb + (size_t)kk * KPI * stride) + voff);
    f32x4 s[NTILE];
#pragma unroll
    for (int t = 0; t < NTILE; ++t) {
        f32x4 acc = {0.f, 0.f, 0.f, 0.f};
#pragma unroll
        for (int ks = 0; ks < KS; ++ks) { const f32x4 x0 = kx[t][2 * ks], x1 = kx[t][2 * ks + 1];
            v4u kb; kb.x = pg8::cvt_pk_bf16(x0.x, x0.y); kb.y = pg8::cvt_pk_bf16(x0.z, x0.w); kb.z = pg8::cvt_pk_bf16(x1.x, x1.y); kb.w = pg8::cvt_pk_bf16(x1.z, x1.w);
            acc = __builtin_amdgcn_mfma_f32_16x16x32_bf16(qa[ks], __builtin_bit_cast(bf16x8, kb), acc, 0, 0, 0); }
        if (MODE == 0) { if (bias) { const float bv = bias[t * 16 + key]; acc += bv; } }
        else { acc += nb;
#pragma unroll
            for (int i = 0; i < 4; ++i) if (key > 4 * kq + i || key >= 8) acc[i] = -INFINITY; }
        s[t] = acc;
    }
#pragma unroll
    for (int kk = NVA; kk < NV; ++kk) vx[kk] = *(const f32x4*)((const char*)(Vb + (size_t)kk * KPI * stride) + voff);
    f32x4 mc = s[0];
#pragma unroll
    for (int t = 1; t < NTILE; ++t) { mc.x = fmaxf(mc.x, s[t].x); mc.y = fmaxf(mc.y, s[t].y); mc.z = fmaxf(mc.z, s[t].z); mc.w = fmaxf(mc.w, s[t].w); }
#pragma unroll
    for (int o = 1; o < 16; o <<= 1) { mc.x = fmaxf(mc.x, __shfl_xor(mc.x, o)); mc.y = fmaxf(mc.y, __shfl_xor(mc.y, o)); mc.z = fmaxf(mc.z, __shfl_xor(mc.z, o)); mc.w = fmaxf(mc.w, __shfl_xor(mc.w, o)); }
    float al[4];
#pragma unroll
    for (int i = 0; i < 4; ++i) { const float mn = fmaxf(w.m[i], mc[i]); al[i] = (mn == -INFINITY) ? 1.f : fexp2(w.m[i] - mn); w.m[i] = mn; w.l[i] *= al[i]; }
#pragma unroll
    for (int t = 0; t < NTILE; ++t) { f32x4 p;
#pragma unroll
        for (int i = 0; i < 4; ++i) { p[i] = (w.m[i] == -INFINITY) ? 0.f : fexp2(s[t][i] - w.m[i]); w.l[i] += p[i]; }
        if (kq < 2) *(LAS f32x4*)(PL + (t * 16 + key) * 8 + 4 * kq) = p; }
    if (key == 0 && kq < 2) *(LAS f32x4*)(PL + 1024 + 4 * kq) = (f32x4){al[0], al[1], al[2], al[3]};
    { const f32x4 a0 = *(const LAS f32x4*)(PL + 1024), a1 = *(const LAS f32x4*)(PL + 1028);
#pragma unroll
      for (int j = 0; j < 4; ++j) { w.o[0][j] *= a0.x; w.o[1][j] *= a0.y; w.o[2][j] *= a0.z; w.o[3][j] *= a0.w; w.o[4][j] *= a1.x; w.o[5][j] *= a1.y; w.o[6][j] *= a1.z; w.o[7][j] *= a1.w; } }
#pragma unroll
    for (int kk = 0; kk < NV; ++kk) { const int k = kk * KPI + ksub;
        const f32x4 v = vx[kk];
        const f32x4 pa = *(const LAS f32x4*)(PL + k * 8), pb = *(const LAS f32x4*)(PL + k * 8 + 4);
#pragma unroll
        for (int j = 0; j < 4; ++j) { w.o[0][j] += pa.x * v[j]; w.o[1][j] += pa.y * v[j]; w.o[2][j] += pa.z * v[j]; w.o[3][j] += pa.w * v[j];
                                      w.o[4][j] += pb.x * v[j]; w.o[5][j] += pb.y * v[j]; w.o[6][j] += pb.z * v[j]; w.o[7][j] += pb.w * v[j]; } }
}
template <int D>
__device__ __forceinline__ void dec_park(DecW<D>& w, LAS float* CBw, int lane) {
    constexpr int LPK = D / 4;
    const int key = lane & 15, kq = lane >> 4, d4 = lane % LPK, ksub = lane / LPK;
#pragma unroll
    for (int i = 0; i < 4; ++i) { float l = w.l[i];
#pragma unroll
        for (int o = 1; o < 16; o <<= 1) l += __shfl_xor(l, o);
        w.l[i] = l; }
    if (key == 0 && kq < 2) { *(LAS f32x4*)(CBw + 4 * kq) = (f32x4){w.m[0], w.m[1], w.m[2], w.m[3]}; *(LAS f32x4*)(CBw + 8 + 4 * kq) = (f32x4){w.l[0], w.l[1], w.l[2], w.l[3]}; }
#pragma unroll
    for (int q = 0; q < 8; ++q) { f32x4 v = (f32x4){w.o[q][0], w.o[q][1], w.o[q][2], w.o[q][3]};
        if (LPK < 64) {
#pragma unroll
            for (int o = LPK; o < 64; o <<= 1) { v.x += __shfl_xor(v.x, o); v.y += __shfl_xor(v.y, o); v.z += __shfl_xor(v.z, o); v.w += __shfl_xor(v.w, o); } }
        if (ksub == 0) *(LAS f32x4*)(CBw + 16 + q * D + 4 * d4) = v; }
}
template <int D>
__device__ __forceinline__ void dec_combine(const Frame& F, LAS float* CB, bf16* dst, int ldd) {
    constexpr int WSTR = 16 + 8 * D;
    for (int e = F.tid; e < 8 * D; e += NTHR) { const int q = e / D, d = e % D;
        float mt = -INFINITY;
#pragma unroll
        for (int w = 0; w < 8; ++w) mt = fmaxf(mt, CB[w * WSTR + q]);
        float num = 0.f, den = 0.f;
#pragma unroll
        for (int w = 0; w < 8; ++w) { const float mw = CB[w * WSTR + q]; const float f = (mw == -INFINITY) ? 0.f : fexp2(mw - mt); num += f * CB[w * WSTR + 16 + q * D + d]; den += f * CB[w * WSTR + 8 + q]; }
        dst[(size_t)q * ldd + d] = (bf16)f2bf(num / den); }
}
template <int D>
__device__ __forceinline__ void dec_load_q(bf16x8 (&qa)[D / 32], const bf16* Q, int ldq, int lane) {
    const int row = lane & 15, kq = lane >> 4;
#pragma unroll
    for (int ks = 0; ks < D / 32; ++ks) { v4u z = {0u, 0u, 0u, 0u}; if (row < 8) z = *(const v4u*)(Q + (size_t)row * ldq + 32 * ks + 8 * kq); qa[ks] = __builtin_bit_cast(bf16x8, z); }
}
constexpr int DEC_PL = 1040;
__device__ __forceinline__ void fox_sample_unit(const Frame& F, const Args& a, int u) {
    unsigned char* ws = a.ws; const int bs = u >> 3, h = u & 7;
    LAS float* PL = (LAS float*)F.lds + F.wave * DEC_PL; LAS float* CB = (LAS float*)F.lds + 8 * DEC_PL; constexpr int WSTR = 16 + 8 * 64;
    bf16x8 qa[2]; dec_load_q<64>(qa, (const bf16*)(ws + WS_QF) + (size_t)(TP + bs * LS) * 512 + h * 64, 512, F.lane);
    DecW<64> w; dec_init(w);
    const int* pt = (const int*)a.in[I_PT];
#pragma unroll 1
    for (int pp = 0; pp < 4; ++pp) { const int p = F.wave * 2 + (pp >> 1), hf = pp & 1; const int pg = __builtin_amdgcn_readfirstlane(pt[bs * NPAGES + p]);
        const float* Kb = (const float*)a.in[I_CFK] + (((size_t)pg * PAGE + hf * 64) * 8 + h) * 64; const float* Vb = (const float*)a.in[I_CFV] + (((size_t)pg * PAGE + hf * 64) * 8 + h) * 64;
        dec_chunk<64, 4, 0>(w, qa, Kb, Vb, 512, (const float*)(ws + WS_SUF) + (size_t)(bs * 8 + h) * PASTL + p * PAGE + hf * 64, 0.f, PL, F.lane); }
    if (F.wave == 0) {
        const int key = F.lane & 15; const float* lf = a.out + O_LFS + (size_t)(bs * LS) * 8 + h; float cn = 0.f;
        for (int j = 0; j < 8; ++j) if (j <= key) cn += lf[j * 8];
        const float* Kb = a.out + O_FKS + (size_t)(bs * LS) * 512 + h * 64; const float* Vb = a.out + O_FVS + (size_t)(bs * LS) * 512 + h * 64;
        dec_chunk<64, 1, 1>(w, qa, Kb, Vb, 512, nullptr, -cn * LOG2E, PL, F.lane);
    }
    dec_park<64>(w, CB + F.wave * WSTR, F.lane);
    __syncthreads();
    dec_combine<64>(F, CB, (bf16*)(ws + WS_MERGED) + (size_t)(TP + bs * LS) * DM + h * 64, DM);
    __syncthreads();
}
__device__ __forceinline__ void cross_sample_unit(const Frame& F, const Args& a, int u) {
    unsigned char* ws = a.ws; const int bs = u >> 2, h = u & 3;
    LAS float* PL = (LAS float*)F.lds + F.wave * DEC_PL; LAS float* CB = (LAS float*)F.lds + 8 * DEC_PL; constexpr int WSTR = 16 + 8 * 256;
    bf16x8 qa[8]; dec_load_q<256>(qa, (const bf16*)(ws + WS_QC) + (size_t)(TP + bs * LS) * DM + h * 256, DM, F.lane);
    DecW<256> w; dec_init(w);
    const float* Kb = (const float*)a.in[I_CMK] + ((size_t)(bs * 256 + F.wave * 32) * 4 + h) * 256; const float* Vb = (const float*)a.in[I_CMV] + ((size_t)(bs * 256 + F.wave * 32) * 4 + h) * 256;
#pragma unroll 1
    for (int c = 0; c < 2; ++c) dec_chunk<256, 1, 0>(w, qa, Kb + (size_t)c * 16 * 1024, Vb + (size_t)c * 16 * 1024, 1024, nullptr, 0.f, PL, F.lane);
    dec_park<256>(w, CB + F.wave * WSTR, F.lane);
    __syncthreads();
    dec_combine<256>(F, CB, (bf16*)(ws + WS_OC) + (size_t)(TP + bs * LS) * DM + h * 256, DM);
    __syncthreads();
}


__device__ __forceinline__ void gla_g3_unit(const Frame& F, const Args& a, int u) {
    unsigned char* ws = a.ws;
    const int b = u >> 9, h = (u >> 7) & 3, n = u & 127; const int row0 = b * SEQ + n * 64;
    LAS float* QDT = (LAS float*)F.lds; LAS float* KIT = QDT + 4352; LAS float* LA = KIT + 4352; LAS float* ATT = LA; LAS float* VS = LA + 4352; LAS float* SP = VS + 8192;
    gla_gate_tile(F, (const float*)(ws + WS_GG), (const float*)a.in[I_WG2], (const float*)a.in[I_BG], row0, h, 64, LA);
    for (int e = F.tid; e < 8192; e += NTHR) { VS[e] = ((const float*)(ws + WS_GV))[(size_t)(row0 + (e >> 7)) * 512 + h * 128 + (e & 127)];
        SP[e] = ((const float*)(ws + WS_GKV))[((size_t)((b * 4 + h) * 128 + n) * 64) * 128 + e]; }
    __syncthreads();
    if (F.tid < 64) { float run = 0.f; for (int t = 0; t < 64; ++t) { run += LA[t * 64 + F.tid]; LA[t * 64 + F.tid] = run; } }
    __syncthreads();
    float qv[8], kvv[8];
#pragma unroll
    for (int i = 0; i < 8; ++i) { const int e = F.tid + NTHR * i, t = e >> 6, dk = e & 63; const float bb = LA[e];
        qv[i] = ((const float*)(ws + WS_GQ))[(size_t)(row0 + t) * 256 + h * 64 + dk] * __expf(bb); kvv[i] = ((const float*)(ws + WS_GK))[(size_t)(row0 + t) * 256 + h * 64 + dk] * __expf(-bb); }
    __syncthreads();
#pragma unroll
    for (int i = 0; i < 8; ++i) { const int e = F.tid + NTHR * i, t = e >> 6, dk = e & 63; QDT[dk * 68 + t] = qv[i]; KIT[dk * 68 + t] = kvv[i]; }
    __syncthreads();
    {
        const int tp = F.tid & 31, sq = F.tid >> 5; float acc[2][4];
#pragma unroll
        for (int i = 0; i < 2; ++i)
#pragma unroll
            for (int j = 0; j < 4; ++j) acc[i][j] = 0.f;
        if (4 * sq <= 2 * tp + 1) {
#pragma unroll 8
            for (int dk = 0; dk < 64; ++dk) { const f32x2 q2 = *(const LAS f32x2*)(QDT + dk * 68 + 2 * tp); const f32x4 k4 = *(const LAS f32x4*)(KIT + dk * 68 + 4 * sq);
#pragma unroll
                for (int j = 0; j < 4; ++j) { acc[0][j] += q2.x * k4[j]; acc[1][j] += q2.y * k4[j]; } }
        }
#pragma unroll
        for (int j = 0; j < 4; ++j) { const int s = 4 * sq + j; f32x2 o; o.x = (s <= 2 * tp) ? acc[0][j] : 0.f; o.y = (s <= 2 * tp + 1) ? acc[1][j] : 0.f; *(LAS f32x2*)(ATT + s * 68 + 2 * tp) = o; }
    }
    __syncthreads();
    const int dv = F.tid & 127, tg = F.tid >> 7;
    float acc[16];
#pragma unroll
    for (int i = 0; i < 16; ++i) acc[i] = 0.f;
#pragma unroll 4
    for (int s = 0; s < 64; ++s) { const float v = VS[s * 128 + dv];
#pragma unroll
        for (int j = 0; j < 4; ++j) { const f32x4 a4 = *(const LAS f32x4*)(ATT + s * 68 + 16 * tg + 4 * j); acc[4 * j] += a4.x * v; acc[4 * j + 1] += a4.y * v; acc[4 * j + 2] += a4.z * v; acc[4 * j + 3] += a4.w * v; } }
#pragma unroll 4
    for (int dk = 0; dk < 64; ++dk) { const float v = SP[dk * 128 + dv];
#pragma unroll
        for (int j = 0; j < 4; ++j) { const f32x4 a4 = *(const LAS f32x4*)(QDT + dk * 68 + 16 * tg + 4 * j); acc[4 * j] += a4.x * v; acc[4 * j + 1] += a4.y * v; acc[4 * j + 2] += a4.z * v; acc[4 * j + 3] += a4.w * v; } }
    __syncthreads();
#pragma unroll
    for (int i = 0; i < 16; ++i) VS[(16 * tg + i) * 128 + dv] = acc[i];
    __syncthreads();
#pragma unroll 1
    for (int rr = 0; rr < 8; ++rr) { const int t = F.wave * 8 + rr; const float v0 = VS[t * 128 + F.lane], v1 = VS[t * 128 + 64 + F.lane];
        const float r = rsqrtf(wave_sum(v0 * v0 + v1 * v1) * (1.f / 128.f) + EPS);
        const float* ggo = (const float*)a.in[I_GGO] + h * 128; const float* gr = (const float*)(ws + WS_GR) + (size_t)(row0 + t) * 512 + h * 128;
        bf16* mo = (bf16*)(ws + WS_MERGED) + (size_t)(row0 + t) * DM + 512 + h * 128;
        mo[F.lane] = (bf16)f2bf(v0 * r * ggo[F.lane] * silu(gr[F.lane])); mo[64 + F.lane] = (bf16)f2bf(v1 * r * ggo[64 + F.lane] * silu(gr[64 + F.lane])); }
    __syncthreads();
}

struct EpiSoftmaxP {
    static constexpr bool PERM = false, AFTER_DRAIN = true;
    const LAS unsigned long long* argp;
    __device__ __forceinline__ void fused(f32x4 (&acc)[2][2][4][2], const Unit&, int wr, int wc, int fr, int fq, PG8_LAS unsigned char* lds, int wid, int lane) const {
        LAS float* PM = (LAS float*)lds; LAS float* PS = PM + 1024;
        const int ub = (int)blockIdx.x; const int ldp = DM;
        bf16* P = (bf16*)((unsigned char*)ld_ptr(argp + N_INPUTS + 1) + WS_PC) + ((size_t)((ub >> 7) & 1) * SEQ + (ub & 31) * 256) * DM + ((ub >> 5) & 3) * 256;
        { int t2 = threadIdx.x; asm volatile("" : "+v"(t2)); fr = t2 & 15; fq = (t2 >> 4) & 3; }
#pragma unroll
        for (int ai = 0; ai < 2; ++ai)
#pragma unroll
            for (int m = 0; m < 4; ++m) { float mx = -INFINITY;
#pragma unroll
                for (int bj = 0; bj < 2; ++bj)
#pragma unroll
                    for (int n = 0; n < 2; ++n) { const f32x4 x = acc[ai][bj][m][n]; mx = fmaxf(mx, fmaxf(fmaxf(x[0], x[1]), fmaxf(x[2], x[3]))); }
                mx = fmaxf(mx, __shfl_xor(mx, 16)); mx = fmaxf(mx, __shfl_xor(mx, 32));
                if (fq == 0) PM[(ai * 128 + wr * 64 + m * 16 + fr) * 4 + wc] = mx; }
        asm volatile("s_waitcnt lgkmcnt(0)" ::: "memory"); __builtin_amdgcn_s_barrier(); asm volatile("" ::: "memory");
#pragma unroll
        for (int ai = 0; ai < 2; ++ai)
#pragma unroll
            for (int m = 0; m < 4; ++m) { const int r = ai * 128 + wr * 64 + m * 16 + fr; const f32x4 pm = *(const LAS f32x4*)(PM + r * 4);
                const float M = fmaxf(fmaxf(pm[0], pm[1]), fmaxf(pm[2], pm[3])); float s = 0.f;
#pragma unroll
                for (int bj = 0; bj < 2; ++bj)
#pragma unroll
                    for (int n = 0; n < 2; ++n) { f32x4 x = acc[ai][bj][m][n]; x[0] = fexp2(x[0] - M); x[1] = fexp2(x[1] - M); x[2] = fexp2(x[2] - M); x[3] = fexp2(x[3] - M); acc[ai][bj][m][n] = x; s += (x[0] + x[1]) + (x[2] + x[3]); }
                s += __shfl_xor(s, 16); s += __shfl_xor(s, 32);
                if (fq == 0) PS[r * 4 + wc] = s; }
        asm volatile("s_waitcnt lgkmcnt(0)" ::: "memory"); __builtin_amdgcn_s_barrier(); asm volatile("" ::: "memory");
#pragma unroll
        for (int ai = 0; ai < 2; ++ai)
#pragma unroll
            for (int m = 0; m < 4; ++m) { const int r = ai * 128 + wr * 64 + m * 16 + fr; const f32x4 ps = *(const LAS f32x4*)(PS + r * 4); const float inv = 1.f / ((ps[0] + ps[1]) + (ps[2] + ps[3]));
#pragma unroll
                for (int bj = 0; bj < 2; ++bj)
#pragma unroll
                    for (int n = 0; n < 2; ++n) { const f32x4 x = acc[ai][bj][m][n]; v2u o; o.x = pg8::cvt_pk_bf16(x[0] * inv, x[1] * inv); o.y = pg8::cvt_pk_bf16(x[2] * inv, x[3] * inv);
                        *(v2u*)(P + (size_t)r * ldp + bj * 128 + wc * 32 + n * 16 + fq * 4) = o; } }
        asm volatile("s_waitcnt lgkmcnt(0)" ::: "memory"); __builtin_amdgcn_s_barrier(); asm volatile("" ::: "memory");
    }
};

__device__ __forceinline__ void rms_rows_phase(const Frame& F, const float* X, const float* g, bf16* H) {
    const int gw = F.vcu * NWAVES + F.wave, NGW = F.G * NWAVES;
    for (int m = gw; m < TA; m += NGW) rms_row_bf16(X + (size_t)m * DM, g, H + (size_t)m * DM, F.lane);
}

__device__ __forceinline__ unsigned f2sort(float f) { const unsigned u = __builtin_bit_cast(unsigned, f); return u ^ ((u >> 31) ? 0xFFFFFFFFu : 0x80000000u); }
__device__ __forceinline__ float sort2f(unsigned s) { const unsigned u = s ^ ((s >> 31) ? 0x80000000u : 0xFFFFFFFFu); return __builtin_bit_cast(float, u); }
__device__ __forceinline__ float gelu_tanh(float x) { const float y = 0.7978845608028654f * (x + 0.044715f * x * x * x); const float e = __expf(2.f * y); return 0.5f * x * (1.f + (1.f - 2.f / (e + 1.f))); }
__device__ __forceinline__ unsigned gmax16(unsigned v) {
#pragma unroll
    for (int o = 1; o < 16; o <<= 1) { const unsigned t = (unsigned)__shfl_xor((int)v, o); v = v > t ? v : t; }
    return v;
}
typedef __bf16 bf16x2_t __attribute__((ext_vector_type(2)));
__device__ __forceinline__ float dot2bf(unsigned a, unsigned b, float c) {
#if __has_builtin(__builtin_amdgcn_fdot2_f32_bf16)
    return __builtin_amdgcn_fdot2_f32_bf16(__builtin_bit_cast(bf16x2_t, a), __builtin_bit_cast(bf16x2_t, b), c, false);
#else
    return c + bflo(a) * bflo(b) + bfhi(a) * bfhi(b);
#endif
}
__device__ __forceinline__ void peer_token(const Frame& F, const Args& a, int row, LAS unsigned* TOPS, int ci0, int cj0, int ci1, int cj1, int ci2, int cj2, int ci3, int cj3, bool cv3) {
    unsigned char* ws = a.ws; const int lane = F.lane, grp = lane >> 4, j16 = lane & 15;
    const float* sc = (const float*)(ws + WS_SC) + (size_t)row * 2048;
#pragma unroll 1
    for (int bt = 0; bt < 4; ++bt) {
        const f32x4 x0 = *(const f32x4*)(sc + (bt * 4 + grp) * 128 + 8 * j16), x1 = *(const f32x4*)(sc + (bt * 4 + grp) * 128 + 8 * j16 + 4);
        unsigned k[8]; const float xs[8] = {x0.x, x0.y, x0.z, x0.w, x1.x, x1.y, x1.z, x1.w};
#pragma unroll
        for (int e = 0; e < 8; ++e) k[e] = (f2sort(xs[e]) & ~127u) | (unsigned)(127 - (8 * j16 + e));
        unsigned mine = 0u;
#pragma unroll 1
        for (int r = 0; r < 16; ++r) {
            unsigned m = k[0];
#pragma unroll
            for (int e = 1; e < 8; ++e) m = m > k[e] ? m : k[e];
            m = gmax16(m);
            if (j16 == r) mine = m;
#pragma unroll
            for (int e = 0; e < 8; ++e) k[e] = (k[e] == m) ? 0u : k[e];
        }
        TOPS[(bt * 4 + grp) * 16 + j16] = mine;
    }
    int ex[2]; float gx[2], sux[2];
#pragma unroll
    for (int ps = 0; ps < 2; ++ps) {
        const int hd = ps * 4 + grp; const LAS unsigned* T1 = TOPS + (2 * hd) * 16; const LAS unsigned* T2 = T1 + 16;
        unsigned k[4];
        { const float s0 = sort2f(T1[ci0] & ~127u) + sort2f(T2[cj0] & ~127u), s1 = sort2f(T1[ci1] & ~127u) + sort2f(T2[cj1] & ~127u),
                      s2 = sort2f(T1[ci2] & ~127u) + sort2f(T2[cj2] & ~127u), s3 = sort2f(T1[ci3] & ~127u) + sort2f(T2[cj3] & ~127u);
          k[0] = (f2sort(s0) & ~127u) | (unsigned)(127 - j16); k[1] = (f2sort(s1) & ~127u) | (unsigned)(127 - (j16 + 16)); k[2] = (f2sort(s2) & ~127u) | (unsigned)(127 - (j16 + 32));
          k[3] = cv3 ? ((f2sort(s3) & ~127u) | (unsigned)(127 - (j16 + 48))) : 0u; }
        unsigned mine = 0u;
#pragma unroll 1
        for (int r = 0; r < 16; ++r) {
            unsigned m = k[0] > k[1] ? k[0] : k[1]; const unsigned m2 = k[2] > k[3] ? k[2] : k[3]; m = m > m2 ? m : m2;
            m = gmax16(m);
            if (j16 == r) mine = m;
#pragma unroll
            for (int e = 0; e < 4; ++e) k[e] = (k[e] == m) ? 0u : k[e];
        }
        const int c = 127 - (int)(mine & 127u);
        int ci, cj;
        if (c < 16) { ci = 0; cj = c; } else if (c < 24) { ci = 1; cj = c - 16; } else if (c < 29) { ci = 2; cj = c - 24; } else if (c < 33) { ci = 3; cj = c - 29; }
        else if (c < 36) { ci = 4; cj = c - 33; } else if (c < 38) { ci = 5; cj = c - 36; } else if (c < 40) { ci = 6; cj = c - 38; } else if (c < 42) { ci = 7; cj = c - 40; } else { ci = c - 34; cj = 0; }
        const int i1 = 127 - (int)(T1[ci] & 127u), i2 = 127 - (int)(T2[cj] & 127u);
        ex[ps] = i1 * 128 + i2;
        const float sv = sort2f(mine & ~127u); const float s0 = __shfl(sv, lane & 48);
        float ee = __expf(sv - s0); float es = ee;
#pragma unroll
        for (int o = 1; o < 16; o <<= 1) es += __shfl_xor(es, o);
        const float* rsc = (const float*)(ws + WS_MISC);
        sux[ps] = rsc[ex[ps]]; gx[ps] = ee / es * rsc[16384 + ex[ps]];
    }
    float hf[16];
    { const v4u* hp = (const v4u*)((const bf16*)(ws + WS_HB) + (size_t)row * DM + 16 * lane); const v4u h0 = hp[0], h1 = hp[1];
#pragma unroll
      for (int q = 0; q < 4; ++q) { hf[2 * q] = bflo(h0[q]); hf[2 * q + 1] = bfhi(h0[q]); hf[8 + 2 * q] = bflo(h1[q]); hf[8 + 2 * q + 1] = bfhi(h1[q]); } }
    float oacc[16];
#pragma unroll
    for (int i = 0; i < 16; ++i) oacc[i] = 0.f;
    const unsigned char* U = ws + WS_U16; const unsigned char* V = ws + WS_V16;
    v4u ub[8], vb[8];
#pragma unroll
    for (int i = 0; i < 8; ++i) { const int e = __builtin_amdgcn_readlane(ex[0], i); ub[i] = *(const v4u*)(U + (size_t)e * DM + 16 * lane); }
#pragma unroll 1
    for (int g8 = 0; g8 < 16; ++g8) {
        const int kb = g8 * 8; const int exs = (kb < 64) ? ex[0] : ex[1]; const float gxs = (kb < 64) ? gx[0] : gx[1]; const float sus = (kb < 64) ? sux[0] : sux[1];
#pragma unroll
        for (int i = 0; i < 8; ++i) { const int e = __builtin_amdgcn_readlane(exs, (kb & 63) + i); vb[i] = *(const v4u*)(V + (size_t)e * DM + 16 * lane); }
        float av[8];
#pragma unroll
        for (int i = 0; i < 8; ++i) { float s = 0.f;
#pragma unroll
            for (int q = 0; q < 4; ++q) { const f32x2 lo = __builtin_amdgcn_cvt_pk_f32_fp8((int)ub[i][q], false), hi = __builtin_amdgcn_cvt_pk_f32_fp8((int)ub[i][q], true);
                s += lo.x * hf[4 * q]; s += lo.y * hf[4 * q + 1]; s += hi.x * hf[4 * q + 2]; s += hi.y * hf[4 * q + 3]; }
            av[i] = s; }
        const bool b5 = lane & 32, b4 = lane & 16, b3 = lane & 8;
        float bq[4], cq[2], dq;
#pragma unroll
        for (int i = 0; i < 4; ++i) bq[i] = (b5 ? av[4 + i] : av[i]) + __shfl_xor(b5 ? av[i] : av[4 + i], 32);
#pragma unroll
        for (int i = 0; i < 2; ++i) cq[i] = (b4 ? bq[2 + i] : bq[i]) + __shfl_xor(b4 ? bq[i] : bq[2 + i], 16);
        dq = (b3 ? cq[1] : cq[0]) + __shfl_xor(b3 ? cq[0] : cq[1], 8);
        dq += __shfl_xor(dq, 4); dq += __shfl_xor(dq, 2); dq += __shfl_xor(dq, 1);
        const int src = (kb & 63) + (lane >> 3);
#if defined(PROBE_NOPEER)
        const float wmine = 0.f * __shfl(gxs, src) * gelu_tanh(dq * __shfl(sus, src));
#else
        const float wmine = __shfl(gxs, src) * gelu_tanh(dq * __shfl(sus, src));
#endif
        if (g8 < 15) { const int kn = kb + 8; const int exn = (kn < 64) ? ex[0] : ex[1];
#pragma unroll
            for (int i = 0; i < 8; ++i) { const int e = __builtin_amdgcn_readlane(exn, (kn & 63) + i); ub[i] = *(const v4u*)(U + (size_t)e * DM + 16 * lane); } }
#pragma unroll
        for (int i = 0; i < 8; ++i) { const float w = __builtin_bit_cast(float, __builtin_amdgcn_readlane(__builtin_bit_cast(int, wmine), 8 * i));
#pragma unroll
            for (int q = 0; q < 4; ++q) { const f32x2 lo = __builtin_amdgcn_cvt_pk_f32_fp8((int)vb[i][q], false), hi = __builtin_amdgcn_cvt_pk_f32_fp8((int)vb[i][q], true);
                oacc[4 * q] += w * lo.x; oacc[4 * q + 1] += w * lo.y; oacc[4 * q + 2] += w * hi.x; oacc[4 * q + 3] += w * hi.y; } }
    }
    const f32x4* x2 = (const f32x4*)((const float*)(ws + WS_X2) + (size_t)row * DM + 16 * lane);
    f32x4 xv[4]; float ss = 0.f;
#pragma unroll
    for (int q = 0; q < 4; ++q) { xv[q] = x2[q]; xv[q].x += oacc[4 * q]; xv[q].y += oacc[4 * q + 1]; xv[q].z += oacc[4 * q + 2]; xv[q].w += oacc[4 * q + 3]; ss += (xv[q].x * xv[q].x + xv[q].y * xv[q].y) + (xv[q].z * xv[q].z + xv[q].w * xv[q].w); }
    const float r = rsqrtf(wave_sum(ss) * (1.f / DM) + EPS);
    const f32x4* gf = (const f32x4*)((const float*)a.in[I_GFIN] + 16 * lane);
    f32x4* y = (f32x4*)((row < TP ? a.out + O_YP + (size_t)row * DM : a.out + O_YS + (size_t)(row - TP) * DM) + 16 * lane);
#pragma unroll
    for (int q = 0; q < 4; ++q) { const f32x4 g4 = gf[q]; f32x4 o; o.x = xv[q].x * r * g4.x; o.y = xv[q].y * r * g4.y; o.z = xv[q].z * r * g4.z; o.w = xv[q].w * r * g4.w; y[q] = o; }
}
__device__ __forceinline__ void cand_ij(int c, int& ci, int& cj) {
    if (c < 16) { ci = 0; cj = c; } else if (c < 24) { ci = 1; cj = c - 16; } else if (c < 29) { ci = 2; cj = c - 24; } else if (c < 33) { ci = 3; cj = c - 29; }
    else if (c < 36) { ci = 4; cj = c - 33; } else if (c < 38) { ci = 5; cj = c - 36; } else if (c < 40) { ci = 6; cj = c - 38; } else if (c < 42) { ci = 7; cj = c - 40; } else if (c < 50) { ci = c - 34; cj = 0; } else { ci = 0; cj = 0; }
}
__device__ __forceinline__ void peer_phase(const Frame& F, const Args& a) {
    LAS unsigned* TOPS = (LAS unsigned*)F.lds + F.wave * 256;
    const int j16 = F.lane & 15; int ci0, cj0, ci1, cj1, ci2, cj2, ci3, cj3;
    cand_ij(j16, ci0, cj0); cand_ij(j16 + 16, ci1, cj1); cand_ij(j16 + 32, ci2, cj2); cand_ij(j16 + 48, ci3, cj3);
    const bool cv3 = (j16 + 48) < 50;
    const int gw = F.vcu * NWAVES + F.wave, NGW = F.G * NWAVES;
#pragma unroll 1
    for (int row = gw; row < TA; row += NGW) peer_token(F, a, row, TOPS, ci0, cj0, ci1, cj1, ci2, cj2, ci3, cj3, cv3);
}


#ifndef PH_MAX
#define PH_MAX 99
#endif
__global__ void __launch_bounds__(NTHR, 2) mega_fwd(Args args) {
    extern __shared__ __attribute__((aligned(16))) unsigned char lds_raw[];
    Frame F;
    F.lds = (LAS unsigned char*)lds_raw;
    F.tid = threadIdx.x; F.lane = F.tid & 63; F.wave = __builtin_amdgcn_readfirstlane(F.tid >> 6);
    F.G = gridDim.x; { const int bx = blockIdx.x; F.vcu = (F.G % 8 == 0) ? (bx % 8) * (F.G / 8) + bx / 8 : bx; }
    volatile LAS unsigned* MISC = (volatile LAS unsigned*)(F.lds + MISC_OFF);
    LAS unsigned long long* ARGP = (LAS unsigned long long*)(F.lds + ARGS_OFF);
    for (int u = F.tid; u < (LDS_BYTES - LDSCTL_OFF) / 4; u += NTHR) ((LAS unsigned*)(F.lds + LDSCTL_OFF))[u] = 0u;
    __syncthreads();
    if (F.tid == 0) {
        ARGP[0] = (unsigned long long)args.in[0];
        ARGP[1] = (unsigned long long)args.in[1];
        ARGP[2] = (unsigned long long)args.in[2];
        ARGP[3] = (unsigned long long)args.in[3];
        ARGP[4] = (unsigned long long)args.in[4];
        ARGP[5] = (unsigned long long)args.in[5];
        ARGP[6] = (unsigned long long)args.in[6];
        ARGP[7] = (unsigned long long)args.in[7];
        ARGP[8] = (unsigned long long)args.in[8];
        ARGP[9] = (unsigned long long)args.in[9];
        ARGP[10] = (unsigned long long)args.in[10];
        ARGP[11] = (unsigned long long)args.in[11];
        ARGP[12] = (unsigned long long)args.in[12];
        ARGP[13] = (unsigned long long)args.in[13];
        ARGP[14] = (unsigned long long)args.in[14];
        ARGP[15] = (unsigned long long)args.in[15];
        ARGP[16] = (unsigned long long)args.in[16];
        ARGP[17] = (unsigned long long)args.in[17];
        ARGP[18] = (unsigned long long)args.in[18];
        ARGP[19] = (unsigned long long)args.in[19];
        ARGP[20] = (unsigned long long)args.in[20];
        ARGP[21] = (unsigned long long)args.in[21];
        ARGP[22] = (unsigned long long)args.in[22];
        ARGP[23] = (unsigned long long)args.in[23];
        ARGP[24] = (unsigned long long)args.in[24];
        ARGP[25] = (unsigned long long)args.in[25];
        ARGP[26] = (unsigned long long)args.in[26];
        ARGP[27] = (unsigned long long)args.in[27];
        ARGP[28] = (unsigned long long)args.in[28];
        ARGP[N_INPUTS] = (unsigned long long)args.out; ARGP[N_INPUTS + 1] = (unsigned long long)args.ws;
    }
    __syncthreads();
    { const XcdBarrier bar0 = xcd_barrier_post((unsigned*)((gu32*)(args.ws + WS_CTL) + CW_BAR), MISC + 8); if (F.tid == 0) MISC[10] = bar0.x; }
    __syncthreads();
#define GRID_BAR() do { XcdBarrier bar_; bar_.bar = (unsigned*)((gu32*)((unsigned char*)ld_ptr(ARGP + N_INPUTS + 1) + WS_CTL) + CW_BAR); bar_.x = MISC[10]; bar_.st = MISC + 8; xcd_barrier(bar_); } while (0)
#define PHASE_ARGS const Args A = load_args(ARGP); unsigned char* const ws = A.ws; float* const out = A.out; (void)ws; (void)out; { int t_ = threadIdx.x; asm volatile("" : "+v"(t_)); F.tid = t_; F.lane = t_ & 63; }

    { PHASE_ARGS;
    p0_prologue(F, A);
    }
    GRID_BAR();
#if PH_MAX >= 1
    { PHASE_ARGS;
    {
        pg8::Gemm g{(const bf16*)(ws + WS_HB), (const bf16*)(ws + WS_WIN), DM, DM, DM};
        pg8::StaticOrder S; S.init(TA, N_IN, F.G, (int)blockIdx.x);
        EpiInProj E{out, ws, (const float*)A.in[I_BFF]};
        pg8::gemm_phase(F.lds, g, S, E);
    }
    {
        const int off = (TA / 256) * (N_IN / 256) % F.G;
        pg8::Gemm g{(const bf16*)(ws + WS_MB), (const bf16*)(ws + WS_WMK), DM, DM, DM};
        pg8::StaticOrder S; S.init(512, DM, F.G, ((int)blockIdx.x + F.G - off) % F.G);
        EpiGen E{out + O_MKP, DM, (bf16*)(ws + WS_MK16), DM, 1.f, nullptr, nullptr, 0, 0};
        pg8::gemm_phase(F.lds, g, S, E);
    }
    {
        const int off = ((TA / 256) * (N_IN / 256) + 8) % F.G;
        pg8::Gemm g{(const bf16*)(ws + WS_MB), (const bf16*)(ws + WS_WMV), DM, DM, DM};
        pg8::StaticOrder S; S.init(512, DM, F.G, ((int)blockIdx.x + F.G - off) % F.G);
        EpiGen E{out + O_MVP, DM, nullptr, 0, 1.f, nullptr, nullptr, 0, 0};
        pg8::gemm_phase(F.lds, g, S, E);
    }
    {
        const int off = ((TA / 256) * (N_IN / 256) + 16) % F.G;
        pg8::Gemm g{(const bf16*)(ws + WS_WMV), (const bf16*)(ws + WS_MB), DM, DM, DM};
        pg8::StaticOrder S; S.init(DM, 512, F.G, ((int)blockIdx.x + F.G - off) % F.G);
        EpiGen E{nullptr, 0, (bf16*)(ws + WS_MVT16), 512, 1.f, nullptr, nullptr, 0, 0};
        pg8::gemm_phase(F.lds, g, S, E);
    }
    }
    GRID_BAR();
#endif
#if PH_MAX >= 2
    asm volatile("; ===PHASE 2===");
    { PHASE_ARGS;
    {
        if (blockIdx.x < NB_P) fox_prompt_cumsum(F, out + O_LFP, (float*)(ws + WS_KBIAS), (int)blockIdx.x);
        const int gw = F.vcu * NWAVES + F.wave, NGW = F.G * NWAVES;
        for (int bs = gw; bs < NB_S; bs += NGW) fox_sample_suffix(F, (const float*)A.in[I_CFL], (const int*)A.in[I_PT], (float*)(ws + WS_SUF), bs);
        __syncthreads();
        for (int it = gw; it < 512; it += NGW) fox_norms_item(F, (const bf16*)(ws + WS_QF), (const bf16*)(ws + WS_KF), (float*)(ws + WS_MISC + MiB), it);
        for (int u = F.vcu; u < 1024; u += F.G) gla_g1_unit(F, A, u);
        for (int u = F.vcu; u < 512; u += F.G) gla_sample_unit(F, A, u);
    }
    }
    GRID_BAR();
#endif
#if PH_MAX >= 3
    asm volatile("; ===PHASE 3===");
    { PHASE_ARGS;
    gla_scan(F, A);
    __syncthreads();
    for (int i = F.vcu; i < 256; i += F.G) { const int bh = i >> 4, s = i & 15;
        fox_attn_unit(F, (const bf16*)(ws + WS_QF), (const bf16*)(ws + WS_KF), (const bf16*)(ws + WS_VF), (const float*)(ws + WS_KBIAS), (const float*)(ws + WS_MISC + MiB), (bf16*)(ws + WS_MERGED), bh >> 3, bh & 7, s);
        fox_attn_unit(F, (const bf16*)(ws + WS_QF), (const bf16*)(ws + WS_KF), (const bf16*)(ws + WS_VF), (const float*)(ws + WS_KBIAS), (const float*)(ws + WS_MISC + MiB), (bf16*)(ws + WS_MERGED), bh >> 3, bh & 7, 31 - s); }
    for (int u = F.vcu; u < 1024; u += F.G) fox_sample_unit(F, A, u);
    }
    GRID_BAR();
#endif
#if PH_MAX >= 4
    asm volatile("; ===PHASE 4===");
    { PHASE_ARGS;
    for (int u = F.vcu; u < 1024; u += F.G) gla_g3_unit(F, A, u);
    }
    GRID_BAR();
#endif
#if PH_MAX >= 5
    asm volatile("; ===PHASE 5===");
    { PHASE_ARGS;
    {
        pg8::Gemm g{(const bf16*)(ws + WS_MERGED), (const bf16*)(ws + WS_WOUT), DM, DM, DM};
        pg8::StaticOrder S; S.init(TA, DM, F.G, (int)blockIdx.x);
        EpiGen E{(float*)(ws + WS_X1), DM, nullptr, 0, 1.f, (const float*)A.in[I_XP], (const float*)A.in[I_XS], TP, DM};
        pg8::gemm_phase(F.lds, g, S, E);
    }
    }
    GRID_BAR();
#endif
#if PH_MAX >= 6
    asm volatile("; ===PHASE 6===");
    { PHASE_ARGS;
    rms_rows_phase(F, (const float*)(ws + WS_X1), (const float*)A.in[I_GCROSS], (bf16*)(ws + WS_HB));
    }
    GRID_BAR();
#endif
#if PH_MAX >= 7
    asm volatile("; ===PHASE 7===");
    { PHASE_ARGS;
    {
        pg8::Gemm g{(const bf16*)(ws + WS_HB), (const bf16*)(ws + WS_WCQ), DM, DM, DM};
        pg8::StaticOrder S; S.init(TA, DM, F.G, (int)blockIdx.x);
        EpiGen E{nullptr, 0, (bf16*)(ws + WS_QC), DM, C2C, nullptr, nullptr, 0, 0};
        pg8::gemm_phase(F.lds, g, S, E);
    }
    }
    GRID_BAR();
#endif
#if PH_MAX >= 8
    asm volatile("; ===PHASE 8===");
    { PHASE_ARGS;
    {
        const int u = (int)blockIdx.x, b = (u >> 7) & 1, h = (u >> 5) & 3, pnl = u & 31;
        const size_t roff = ((size_t)b * SEQ + pnl * 256) * DM + h * 256;
        pg8::Gemm g{(const bf16*)(ws + WS_QC) + roff, (const bf16*)(ws + WS_MK16) + (size_t)(b * 256) * DM + h * 256, DM, DM, 256};
        pg8::SingleUnit S{u < 256 ? 1 : 0, {0, 0}};
        EpiSoftmaxP E{ARGP};
        pg8::gemm_phase(F.lds, g, S, E);
        __syncthreads();
        for (int v = F.vcu; v < 512; v += F.G) cross_sample_unit(F, A, v);
    }
    }
    GRID_BAR();
#endif
#if PH_MAX >= 9
    asm volatile("; ===PHASE 9===");
    { PHASE_ARGS;
    {
        const int u = (int)blockIdx.x, b = (u >> 7) & 1, h = (u >> 5) & 3, pnl = u & 31;
        const size_t roff = ((size_t)b * SEQ + pnl * 256) * DM + h * 256;
        pg8::Gemm g{(const bf16*)(ws + WS_PC) + roff, (const bf16*)(ws + WS_MVT16) + (size_t)(h * 256) * 512 + b * 256, DM, 512, 256};
        pg8::SingleUnit S{u < 256 ? 1 : 0, {0, 0}};
        EpiGen E{nullptr, 0, (bf16*)(ws + WS_OC) + roff, DM, 1.f, nullptr, nullptr, 0, 0};
        pg8::gemm_phase(F.lds, g, S, E);
    }
    }
    GRID_BAR();
#endif
#if PH_MAX >= 10
    asm volatile("; ===PHASE 10===");
    { PHASE_ARGS;
    {
        pg8::Gemm g{(const bf16*)(ws + WS_OC), (const bf16*)(ws + WS_WCO), DM, DM, DM};
        pg8::StaticOrder S; S.init(TA, DM, F.G, (int)blockIdx.x);
        EpiGen E{(float*)(ws + WS_X2), DM, nullptr, 0, 1.f, (const float*)(ws + WS_X1), (const float*)(ws + WS_X1), TA, DM};
        pg8::gemm_phase(F.lds, g, S, E);
    }
    }
    GRID_BAR();
#endif
#if PH_MAX >= 11
    asm volatile("; ===PHASE 11===");
    { PHASE_ARGS;
    rms_rows_phase(F, (const float*)(ws + WS_X2), (const float*)A.in[I_GFFN], (bf16*)(ws + WS_HB));
    }
    GRID_BAR();
#endif
#if PH_MAX >= 12
    asm volatile("; ===PHASE 12===");
    { PHASE_ARGS;
    {
        pg8::Gemm g{(const bf16*)(ws + WS_HB), (const bf16*)(ws + WS_WPK), DM, DM, DM};
        pg8::StaticOrder S; S.init(TA, 2048, F.G, (int)blockIdx.x);
        EpiGen E{(float*)(ws + WS_SC), 2048, nullptr, 0, 1.f, nullptr, nullptr, 0, 0};
        pg8::gemm_phase(F.lds, g, S, E);
    }
    }
    GRID_BAR();
#endif
#if PH_MAX >= 13
    asm volatile("; ===PHASE 13===");
    { PHASE_ARGS;
    peer_phase(F, A);
    }
#endif
#if PH_MAX < 13
    {   PHASE_ARGS;
        const int gw = F.vcu * NWAVES + F.wave, NGW = F.G * NWAVES;
        for (int m = gw; m < TA; m += NGW) {
            const float* x = m < TP ? (const float*)A.in[I_XP] + (size_t)m * DM : (const float*)A.in[I_XS] + (size_t)(m - TP) * DM;
            float* y = m < TP ? out + O_YP + (size_t)m * DM : out + O_YS + (size_t)(m - TP) * DM;
            for (int j = 0; j < 4; ++j) ((f32x4*)y)[F.lane + 64 * j] = ((const f32x4*)x)[F.lane + 64 * j];
        }
    }
#endif

}

extern "C" void kernel_launch(void* const* d_in, const int* in_sizes, int n_in, void* d_out, int out_size, void* d_ws, size_t ws_size, hipStream_t stream) {
    static int grid = 0;
    if (grid == 0) {
        if (n_in != N_INPUTS || (size_t)out_size != O_TOTAL || ws_size < WS_END) { fprintf(stderr, "kernel_launch: unexpected shapes (n_in %d out %d ws %zu)\n", n_in, out_size, ws_size); grid = -1; return; }
        int dev = 0, cus = 0, per_cu = 0;
        if (hipGetDevice(&dev) != hipSuccess || hipDeviceGetAttribute(&cus, hipDeviceAttributeMultiprocessorCount, dev) != hipSuccess) { grid = -1; return; }
        if (hipFuncSetAttribute((const void*)mega_fwd, hipFuncAttributeMaxDynamicSharedMemorySize, LDS_BYTES) != hipSuccess) { fprintf(stderr, "kernel_launch: hipFuncSetAttribute failed\n"); grid = -1; return; }
        if (hipOccupancyMaxActiveBlocksPerMultiprocessor(&per_cu, (const void*)mega_fwd, NTHR, LDS_BYTES) != hipSuccess || per_cu < 1)
            fprintf(stderr, "kernel_launch: occupancy query reports %d workgroups per CU\n", per_cu);
        (void)hipGetLastError();
        grid = cus;
        if (grid > 256) grid = 256;
    }
    if (grid < 0) return;
    if (hipMemsetAsync((char*)d_ws + WS_CTL, 0, CTL_ZERO_BYTES, stream) != hipSuccess) return;
    Args a{};
    for (int i = 0; i < N_INPUTS; ++i) a.in[i] = d_in[i];
    a.out = (float*)d_out; a.ws = (unsigned char*)d_ws;
    hipLaunchKernelGGL(mega_fwd, dim3(grid), dim3(NTHR), LDS_BYTES, stream, a);
    const hipError_t le = hipPeekAtLastError();
    if (le != hipSuccess) fprintf(stderr, "kernel_launch: launch failed: %s\n", hipGetErrorName(le));
}
```

```cpp
#define PH_MAX 13
#include <hip/hip_runtime.h>
#include <cstdio>
#include <cstdint>

namespace pg8 {
#define PG8_LAS __attribute__((address_space(3)))
typedef unsigned short bf16_t;
typedef short bf16x8 __attribute__((ext_vector_type(8)));
typedef float f32x4 __attribute__((ext_vector_type(4)));
typedef unsigned u32x4 __attribute__((ext_vector_type(4)));
typedef unsigned u32x2 __attribute__((ext_vector_type(2)));
constexpr int BM = 256, BK = 64, HALF = 128, HTB = HALF * BK * 2  , STAGE_BYTES = 8 * HTB, NXCD = 8, WGM = 8;

__host__ __device__ __forceinline__ int lds_byte(int r, int c) { const int st = (r >> 4) * 2 + (c >> 5), rr = r & 15, cc = c & 31, ob = rr * 64 + cc * 2; return st * 1024 + (ob ^ (((ob >> 9) & 1) << 5)); }
__host__ __device__ __forceinline__ void stage_rc(int b, int& R, int& C) { const int st = b / 1024, sb = b % 1024, swz = sb ^ (((sb >> 9) & 1) << 5); R = (st >> 1) * 16 + swz / 64; C = (st & 1) * 32 + (swz % 64) / 2; }

struct Unit { int pm, pn; };
struct Gemm { const bf16_t* A; const bf16_t* Bt; int lda, ldb, K; };

struct StaticOrder {
    int nM, nN, nwg, G, c;
    __host__ __device__ void init(int M, int N, int G_, int c_) { nM = M / BM; nN = N / BM; nwg = nM * nN; G = G_; c = c_; }
    __host__ __device__ bool next(int i, Unit& u) const {
        const long L = (long)i * G + c; if (L >= nwg) return false;
        int wgid = (int)L; { const int q = nwg / NXCD, r = nwg % NXCD, xcd = wgid % NXCD, off = wgid / NXCD; wgid = (xcd < r ? xcd * (q + 1) : r * (q + 1) + (xcd - r) * q) + off; }
        const int nig = WGM * nN, gid = wgid / nig, fm = gid * WGM, gsz = (nM - fm) < WGM ? (nM - fm) : WGM;
        u.pm = fm + ((wgid % nig) % gsz); u.pn = (wgid % nig) / gsz; return true;
    }
};
struct SingleUnit {
    int has; Unit u0;
    __host__ __device__ bool next(int i, Unit& u) const { if (i != 0 || !has) return false; u = u0; return true; }
};

__device__ __forceinline__ unsigned cvt_pk_bf16(float lo, float hi) { unsigned r; asm volatile("v_cvt_pk_bf16_f32 %0, %1, %2" : "=v"(r) : "v"(lo), "v"(hi)); return r; }

template <class Epi, class Sched>
__device__ __forceinline__ void gemm_phase(PG8_LAS unsigned char* lds, const Gemm g, const Sched& S, const Epi& E) {
    int tid = threadIdx.x; asm volatile("" : "+v"(tid));
    const int wid = __builtin_amdgcn_readfirstlane(tid >> 6), lane = tid & 63, wr = wid >> 2, wc = wid & 3, fr = lane & 15, fq = lane >> 4;
    const int K = g.K, nt = K / BK;
    unsigned voffA[2], voffB[2];
#pragma unroll
    for (int i = 0; i < 2; ++i) { int R, C; stage_rc(tid * 16 + i * 8192, R, C);
        voffA[i] = (unsigned)(R * g.lda + C) * 2u; voffB[i] = (unsigned)(R * g.ldb + C) * 2u; }
    const size_t kstep = (size_t)(BK * 2);
    const size_t hstepA = (size_t)HALF * g.lda * 2, hstepB = (size_t)HALF * g.ldb * 2;
    const size_t tstepA = 2 * hstepA, tstepB = 2 * hstepB;
    const unsigned ldsw = (unsigned)wid * 1024u;
    const int aoff = lds_byte(wr * 64 + fr, fq * 8), boff = lds_byte(wc * 32 + fr, fq * 8);
#define PG8_SA(b, h) (((b) * 2 + (h)) * HTB)
#define PG8_SB(b, h) ((4 + (b) * 2 + (h)) * HTB)
#define PG8_STAGE(bufoff, gbase, voff) do { _Pragma("unroll") for (int _i = 0; _i < 2; ++_i) \
        __builtin_amdgcn_global_load_lds((const unsigned*)((const char*)(gbase) + (voff)[_i]), (PG8_LAS unsigned*)(lds + (bufoff) + ldsw + _i * 8192), 16, 0, 0); } while (0)
#define PG8_LDA(dst, b, h) do { _Pragma("unroll") for (int m = 0; m < 4; ++m) _Pragma("unroll") for (int k = 0; k < 2; ++k) dst[m][k] = *(const PG8_LAS bf16x8*)(lds + PG8_SA(b, h) + aoff + m * 2048 + k * 1024); } while (0)
#define PG8_LDB(dst, b, h) do { _Pragma("unroll") for (int n = 0; n < 2; ++n) _Pragma("unroll") for (int k = 0; k < 2; ++k) dst[n][k] = *(const PG8_LAS bf16x8*)(lds + PG8_SB(b, h) + boff + n * 2048 + k * 1024); } while (0)
#define PG8_MMA(ai, bj, At, Bt) do { __builtin_amdgcn_s_setprio(1); _Pragma("unroll") for (int m = 0; m < 4; ++m) _Pragma("unroll") for (int n = 0; n < 2; ++n) _Pragma("unroll") for (int k = 0; k < 2; ++k) \
        acc[ai][bj][m][n] = __builtin_amdgcn_mfma_f32_16x16x32_bf16(Bt[n][k], At[m][k], acc[ai][bj][m][n], 0, 0, 0); __builtin_amdgcn_s_setprio(0); } while (0)
#define PG8_WAIT_V(n) asm volatile("s_waitcnt vmcnt(" #n ")" ::: "memory")
#define PG8_WAIT_L(n) asm volatile("s_waitcnt lgkmcnt(" #n ")" ::: "memory")
#define PG8_BAR __builtin_amdgcn_s_barrier()
#define PG8_SCHED __builtin_amdgcn_sched_barrier(0)
    Unit cur, nxt; int ui = 0;
    if (!S.next(0, cur)) return;
    f32x4 acc[2][2][4][2];
#pragma unroll
    for (int a = 0; a < 2; ++a)
#pragma unroll
        for (int b = 0; b < 2; ++b)
#pragma unroll
            for (int m = 0; m < 4; ++m)
#pragma unroll
                for (int n = 0; n < 2; ++n) acc[a][b][m][n] = (f32x4){0.f, 0.f, 0.f, 0.f};
    bf16x8 At[4][2], B0[2][2], B1[2][2];
    const char* cA = (const char*)g.A + (size_t)cur.pm * tstepA; const char* cB = (const char*)g.Bt + (size_t)cur.pn * tstepB;
    PG8_STAGE(PG8_SB(0, 0), cB, voffB); PG8_STAGE(PG8_SB(0, 1), cB + hstepB, voffB); PG8_STAGE(PG8_SA(0, 0), cA, voffA); PG8_STAGE(PG8_SA(0, 1), cA + hstepA, voffA);
    if (wr == 1) PG8_BAR;
    PG8_WAIT_V(2); PG8_BAR;
    PG8_STAGE(PG8_SB(1, 0), cB + kstep, voffB); PG8_STAGE(PG8_SA(1, 0), cA + kstep, voffA); PG8_STAGE(PG8_SB(1, 1), cB + hstepB + kstep, voffB);
    PG8_WAIT_V(6); PG8_BAR;
    for (;;) {
        const bool has_next = S.next(ui + 1, nxt);
        const char* nA = has_next ? (const char*)g.A + (size_t)nxt.pm * tstepA : cA; const char* nB = has_next ? (const char*)g.Bt + (size_t)nxt.pn * tstepB : cB;
        for (int t = 0; t < nt; t += 2) {
            const bool last = (t == nt - 2);
            const char* a1 = cA + (size_t)(t + 1) * kstep;
            const char* a2 = last ? nA : cA + (size_t)(t + 2) * kstep; const char* b2 = last ? nB : cB + (size_t)(t + 2) * kstep;
            const char* a3 = a2 + kstep; const char* b3 = b2 + kstep;
            PG8_LDB(B0, 0, 0); PG8_LDB(B1, 0, 1); PG8_SCHED; PG8_LDA(At, 0, 0); PG8_STAGE(PG8_SA(1, 1), a1 + hstepA, voffA);
            PG8_WAIT_V(8); PG8_WAIT_L(0); PG8_BAR; PG8_MMA(0, 0, At, B0); PG8_MMA(0, 1, At, B1); PG8_BAR; PG8_SCHED;
            PG8_LDA(At, 0, 1); PG8_STAGE(PG8_SB(0, 0), b2, voffB); PG8_STAGE(PG8_SB(0, 1), b2 + hstepB, voffB); PG8_STAGE(PG8_SA(0, 0), a2, voffA);
            PG8_WAIT_V(8); PG8_WAIT_L(0); PG8_BAR; PG8_MMA(1, 0, At, B0); PG8_MMA(1, 1, At, B1); PG8_BAR; PG8_SCHED;
            PG8_LDB(B0, 1, 0); PG8_LDB(B1, 1, 1); PG8_SCHED; PG8_LDA(At, 1, 0); PG8_STAGE(PG8_SA(0, 1), a2 + hstepA, voffA);
            PG8_WAIT_V(8); PG8_WAIT_L(0); PG8_BAR; PG8_MMA(0, 0, At, B0); PG8_MMA(0, 1, At, B1); PG8_BAR; PG8_SCHED;
            PG8_LDA(At, 1, 1); PG8_STAGE(PG8_SB(1, 0), b3, voffB); PG8_STAGE(PG8_SB(1, 1), b3 + hstepB, voffB); PG8_STAGE(PG8_SA(1, 0), a3, voffA);
            PG8_WAIT_V(8); PG8_WAIT_L(0); PG8_BAR; PG8_MMA(1, 0, At, B0); PG8_MMA(1, 1, At, B1); PG8_BAR; PG8_SCHED;
        }
        if (wr == 0) PG8_BAR;
        if constexpr (!Epi::AFTER_DRAIN) { E(acc, cur, wr, wc, fr, fq); }
        if (!has_next) break;
#pragma unroll
        for (int a = 0; a < 2; ++a)
#pragma unroll
            for (int b = 0; b < 2; ++b)
#pragma unroll
                for (int m = 0; m < 4; ++m)
#pragma unroll
                    for (int n = 0; n < 2; ++n) acc[a][b][m][n] = (f32x4){0.f, 0.f, 0.f, 0.f};
        cur = nxt; cA = nA; cB = nB; ++ui;
        if (wr == 1) PG8_BAR;
    }
    PG8_WAIT_V(0);
    PG8_BAR;
    if constexpr (Epi::AFTER_DRAIN) { E.fused(acc, cur, wr, wc, fr, fq, lds, wid, lane); }
#undef PG8_SA
#undef PG8_SB
#undef PG8_STAGE
#undef PG8_LDA
#undef PG8_LDB
#undef PG8_MMA
#undef PG8_WAIT_V
#undef PG8_WAIT_L
#undef PG8_BAR
#undef PG8_SCHED
}
}

#define GAS __attribute__((address_space(1)))
#define LAS __attribute__((address_space(3)))
typedef unsigned short bf16;
typedef unsigned v4u __attribute__((ext_vector_type(4)));
typedef unsigned v2u __attribute__((ext_vector_type(2)));
typedef float f32x4 __attribute__((ext_vector_type(4)));
typedef float f32x2 __attribute__((ext_vector_type(2)));
typedef float f32x16 __attribute__((ext_vector_type(16)));
typedef short bf16x8 __attribute__((ext_vector_type(8)));
typedef short s16x4 __attribute__((ext_vector_type(4)));
typedef GAS unsigned gu32;
#define RLX_AGENT __ATOMIC_RELAXED, __HIP_MEMORY_SCOPE_AGENT
#define LDS_WAIT() asm volatile("s_waitcnt lgkmcnt(0)" ::: "memory")
#define VM_WAIT() asm volatile("s_waitcnt vmcnt(0)" ::: "memory")
__device__ __forceinline__ unsigned f2bf(float f) { unsigned u = __builtin_bit_cast(unsigned, f); return (u + 0x7fffu + ((u >> 16) & 1u)) >> 16; }
__device__ __forceinline__ unsigned pk2(float lo, float hi) { return f2bf(lo) | (f2bf(hi) << 16); }
__device__ __forceinline__ float bf2f(unsigned short b) { return __builtin_bit_cast(float, (unsigned)b << 16); }
__device__ __forceinline__ float bflo(unsigned u) { return __builtin_bit_cast(float, u << 16); }
__device__ __forceinline__ float bfhi(unsigned u) { return __builtin_bit_cast(float, u & 0xffff0000u); }

#define XB_TMO      128
#define XB_XCNT(j)  (256  + 64 * (j))
#define XB_XSUB(j)  (1280 + 64 * (j))
#define XB_XGEN(j)  (2304 + 64 * (j))
#define XB_TOP      3328
#define XB_TOPGEN   3392
#define XCD_BAR_WORDS 3456
#define XB_SPIN_CAP (1u << 18)

__device__ __forceinline__ unsigned xb_ld(unsigned* p)              { return __hip_atomic_load(p, __ATOMIC_RELAXED, __HIP_MEMORY_SCOPE_AGENT); }
__device__ __forceinline__ unsigned xb_add(unsigned* p, unsigned v) { return __hip_atomic_fetch_add(p, v, __ATOMIC_RELAXED, __HIP_MEMORY_SCOPE_AGENT); }
__device__ __forceinline__ unsigned xb_xcc_id() { return (unsigned)__builtin_amdgcn_s_getreg((3 << 11) | 20) & 0xFu; }
#define XB_SPIN(cond, bar) do { unsigned _sp = 0; while (cond) { __builtin_amdgcn_s_sleep(1); \
    if ((++_sp & 255u) == 0u) { if (xb_ld(&(bar)[XB_TMO])) break; if (_sp > XB_SPIN_CAP) { atomicAdd(&(bar)[XB_TMO], 1u); break; } } } } while (0)

struct XcdBarrier {
    unsigned* bar; unsigned x;
    volatile LAS unsigned* st;
};

__device__ __forceinline__ XcdBarrier xcd_barrier_post(unsigned* bar, volatile LAS unsigned* st) {
    XcdBarrier b; b.bar = bar; b.x = xb_xcc_id(); b.st = st;
    if (threadIdx.x == 0) (void)xb_add(&bar[XB_XCNT(b.x)], 1u);
    return b;
}
__device__ __forceinline__ void xcd_barrier_complete(unsigned* bar, unsigned x, unsigned& nloc, unsigned& nx) {
    const unsigned G = gridDim.x * gridDim.y * gridDim.z;
    unsigned sum, cnt, mine, sp = 0u;
    for (;;) {
        sum = 0u; cnt = 0u; mine = 0u;
#pragma unroll
        for (unsigned j = 0; j < 16; ++j) { const unsigned c = xb_ld(&bar[XB_XCNT(j)]); sum += c; cnt += (c > 0u) ? 1u : 0u; mine = (j == x) ? c : mine; }
        if (sum == G) break;
        __builtin_amdgcn_s_sleep(1);
        if ((++sp & 255u) == 0u) { if (xb_ld(&bar[XB_TMO])) break; if (sp > XB_SPIN_CAP) { atomicAdd(&bar[XB_TMO], 1u); break; } }
    }
    nloc = mine > 0u ? mine : 1u; nx = cnt > 0u ? cnt : 1u;
}

__device__ __forceinline__ void xcd_barrier(const XcdBarrier& b) {
    asm volatile("s_waitcnt vmcnt(0)" ::: "memory");
    __syncthreads();
    if (threadIdx.x == 0) {
        unsigned* bar = b.bar;
        __builtin_amdgcn_s_waitcnt(0);
        unsigned nloc = b.st[0], nx = b.st[1];
        if (nloc == 0u) { xcd_barrier_complete(bar, b.x, nloc, nx); b.st[0] = nloc; b.st[1] = nx; }
        const unsigned old = xb_add(&bar[XB_XSUB(b.x)], 1u);
        const unsigned gen = old / nloc;
        if (old + 1u == (gen + 1u) * nloc) {
            __builtin_amdgcn_fence(__ATOMIC_RELEASE, "agent");
            asm volatile("s_waitcnt vmcnt(0)" ::: "memory");
            const unsigned og = xb_add(&bar[XB_TOP], 1u);
            const unsigned tg = og / nx;
            if (og + 1u == (tg + 1u) * nx) xb_add(&bar[XB_TOPGEN], 1u);
            else XB_SPIN(xb_ld(&bar[XB_TOPGEN]) == tg, bar);
            __builtin_amdgcn_fence(__ATOMIC_ACQUIRE, "agent");
            xb_add(&bar[XB_XGEN(b.x)], 1u);
            asm volatile("s_waitcnt vmcnt(0)" ::: "memory");
        } else {
            XB_SPIN(xb_ld(&bar[XB_XGEN(b.x)]) == gen, bar);
            __builtin_amdgcn_fence(__ATOMIC_ACQUIRE, "agent");
            asm volatile("s_waitcnt vmcnt(0)" ::: "memory");
        }
    }
    __syncthreads();
}


constexpr int NWAVES = 8, NTHR = 512;
constexpr int DM = 1024, TP = 16384, TS = 1024, TA = TP + TS, SEQ = 8192, NB_P = 2, NB_S = 128, LS = 8;
constexpr int N_IN = 3328;
constexpr int PASTL = 2048, PAGE = 128, NPAGES = 16;
constexpr float EPS = 1e-6f;
constexpr float LOG2E = 1.4426950408889634f;
constexpr float C2F = 0.125f * LOG2E;
constexpr float C2C = 0.0625f * LOG2E;

enum { I_XP = 0, I_XS, I_CFK, I_CFV, I_CFL, I_SGLA, I_CMK, I_CMV, I_PT, I_MEMP, I_GMIX, I_WIN, I_BFF, I_WG2, I_BG, I_GGO, I_WOUT, I_GCROSS, I_GMEM,
       I_WMK, I_WMV, I_WCQ, I_WCO, I_GFFN, I_PWQ, I_PSK, I_PU, I_PV, I_GFIN, N_INPUTS };
constexpr size_t O_YP = 0, O_YS = 16777216, O_FKP = 17825792, O_FVP = 26214400, O_LFP = 34603008, O_GSP = 34734080, O_MKP = 34799616, O_MVP = 35323904,
                 O_FKS = 35848192, O_FVS = 36372480, O_LFS = 36896768, O_GSS = 36904960, O_TOTAL = 41099264;

constexpr size_t MiB = 1u << 20;
constexpr size_t WS_CTL = 0, CTL_ZERO_BYTES = 1 * MiB;
constexpr size_t WS_WIN = 2 * MiB, WS_WOUT = 10 * MiB, WS_WMK = 12 * MiB, WS_WMV = 14 * MiB, WS_WCQ = 16 * MiB, WS_WCO = 18 * MiB, WS_WPK = 20 * MiB;
constexpr size_t WS_MB = 24 * MiB, WS_MK16 = 25 * MiB, WS_MVT16 = 26 * MiB, WS_KBIAS = 27 * MiB, WS_GDEC = 28 * MiB, WS_GG = 29 * MiB;
constexpr size_t WS_U16 = 32 * MiB, WS_V16 = 64 * MiB, WS_HB = 96 * MiB, WS_QF = 132 * MiB, WS_KF = 150 * MiB, WS_VF = 168 * MiB;
constexpr size_t WS_GQ = 186 * MiB, WS_GK = 204 * MiB, WS_GV = 222 * MiB, WS_GR = 256 * MiB, WS_SUF = 290 * MiB, WS_GKV = 298 * MiB;
constexpr size_t WS_MERGED = 330 * MiB, WS_X1 = 364 * MiB, WS_X2 = 432 * MiB, WS_QC = 500 * MiB, WS_PC = 534 * MiB, WS_OC = 566 * MiB, WS_SC = 600 * MiB;
constexpr size_t WS_MISC = 736 * MiB, WS_SS = 740 * MiB  , WS_BB = 744 * MiB, WS_END = 800 * MiB;
constexpr int CW_BAR = 4096;

constexpr int RING_BYTES = 131072;
constexpr int LDSCTL_OFF = RING_BYTES, MISC_OFF = LDSCTL_OFF + 320;
constexpr int ARGS_OFF = MISC_OFF + 128;
constexpr int LDS_BYTES = 147456;

struct Args { const void* in[N_INPUTS]; float* out; unsigned char* ws; };

__device__ __forceinline__ const void* ld_ptr(const LAS unsigned long long* p) { const unsigned long long v = *p; const unsigned lo = __builtin_amdgcn_readfirstlane((unsigned)v), hi = __builtin_amdgcn_readfirstlane((unsigned)(v >> 32)); return (const void*)(const GAS char*)(((unsigned long long)hi << 32) | lo); }
__device__ __forceinline__ Args load_args(const LAS unsigned long long* ARGP) { Args A;
    A.in[0] = ld_ptr(ARGP + 0);
    A.in[1] = ld_ptr(ARGP + 1);
    A.in[2] = ld_ptr(ARGP + 2);
    A.in[3] = ld_ptr(ARGP + 3);
    A.in[4] = ld_ptr(ARGP + 4);
    A.in[5] = ld_ptr(ARGP + 5);
    A.in[6] = ld_ptr(ARGP + 6);
    A.in[7] = ld_ptr(ARGP + 7);
    A.in[8] = ld_ptr(ARGP + 8);
    A.in[9] = ld_ptr(ARGP + 9);
    A.in[10] = ld_ptr(ARGP + 10);
    A.in[11] = ld_ptr(ARGP + 11);
    A.in[12] = ld_ptr(ARGP + 12);
    A.in[13] = ld_ptr(ARGP + 13);
    A.in[14] = ld_ptr(ARGP + 14);
    A.in[15] = ld_ptr(ARGP + 15);
    A.in[16] = ld_ptr(ARGP + 16);
    A.in[17] = ld_ptr(ARGP + 17);
    A.in[18] = ld_ptr(ARGP + 18);
    A.in[19] = ld_ptr(ARGP + 19);
    A.in[20] = ld_ptr(ARGP + 20);
    A.in[21] = ld_ptr(ARGP + 21);
    A.in[22] = ld_ptr(ARGP + 22);
    A.in[23] = ld_ptr(ARGP + 23);
    A.in[24] = ld_ptr(ARGP + 24);
    A.in[25] = ld_ptr(ARGP + 25);
    A.in[26] = ld_ptr(ARGP + 26);
    A.in[27] = ld_ptr(ARGP + 27);
    A.in[28] = ld_ptr(ARGP + 28);
    A.out = (float*)ld_ptr(ARGP + N_INPUTS); A.ws = (unsigned char*)ld_ptr(ARGP + N_INPUTS + 1); return A; }
struct Frame {
    LAS unsigned char* lds;
    int tid, lane, wave, vcu, G;
};

__device__ __forceinline__ float wave_sum(float v) {
#pragma unroll
    for (int o = 1; o < 64; o <<= 1) v += __shfl_xor(v, o);
    return v;
}
__device__ __forceinline__ float log_sigmoid(float x) { return fminf(x, 0.f) - log1pf(__expf(-fabsf(x))); }

__device__ __forceinline__ int win_src_col(int r) {
    if (r < 1536) return r;
    if (r < 1792) return 1544 + (r - 1536);
    if (r < 2048) return 1800 + (r - 1792);
    if (r < 2560) return 2056 + (r - 2048);
    if (r < 3072) return 2584 + (r - 2560);
    if (r < 3080) return 1536 + (r - 3072);
    if (r < 3096) return 2568 + (r - 3080);
    return -1;
}
template <bool WIN>
__device__ __forceinline__ void p0_transpose_item(const float* W, int ldw, int K, int nblk, bf16* WT, LAS float* scr, int item, int lane) {
    const int kb = item / nblk, nb = item % nblk, k0 = 64 * kb, n0 = 32 * nb;
    const int dr = n0 + (lane & 31); const int sc = WIN ? win_src_col(dr) : dr;
#pragma unroll 8
    for (int i = 0; i < 32; ++i) { const int kk = 2 * i + (lane >> 5); scr[kk * 33 + (lane & 31)] = (sc >= 0) ? W[(size_t)(k0 + kk) * ldw + sc] : 0.f; }
    LDS_WAIT(); asm volatile("" ::: "memory");
    const int c = lane & 7;
#pragma unroll
    for (int j = 0; j < 4; ++j) { const int n = (lane >> 3) + 8 * j; const LAS float* s = scr + (8 * c) * 33 + n;
        v4u o; o.x = pk2(s[0 * 33], s[1 * 33]); o.y = pk2(s[2 * 33], s[3 * 33]); o.z = pk2(s[4 * 33], s[5 * 33]); o.w = pk2(s[6 * 33], s[7 * 33]);
        *(GAS v4u*)(WT + (size_t)(n0 + n) * K + k0 + 8 * c) = o; }
    LDS_WAIT(); asm volatile("" ::: "memory");
}
__device__ __forceinline__ void rms_row_bf16(const float* xrow, const float* g, bf16* orow, int lane) {
    const f32x4* xr = (const f32x4*)xrow + lane; const f32x4* gr = (const f32x4*)g + lane;
    f32x4 v[4]; float s = 0.f;
#pragma unroll
    for (int j = 0; j < 4; ++j) { v[j] = xr[64 * j]; s += (v[j].x * v[j].x + v[j].y * v[j].y) + (v[j].z * v[j].z + v[j].w * v[j].w); }
    const float r = rsqrtf(wave_sum(s) * (1.f / DM) + EPS);
    v2u* o8 = (v2u*)orow + lane;
#pragma unroll
    for (int j = 0; j < 4; ++j) { const f32x4 gg = gr[64 * j]; v2u o; o.x = pk2(v[j].x * r * gg.x, v[j].y * r * gg.y); o.y = pk2(v[j].z * r * gg.z, v[j].w * r * gg.w); o8[64 * j] = o; }
}

using pg8::Unit;
struct EpiGen {
    static constexpr bool PERM = false, AFTER_DRAIN = false;
    float* d32; int ld32; bf16* d16; int ld16; float sc16;
    const float* r0; const float* r1; int rsplit; int ldr;
    const float* gcol;
    float* ssq;
    const float* rsq;
    __device__ __forceinline__ void operator()(const f32x4 (&acc)[2][2][4][2], const Unit& u, int wr, int wc, int fr, int fq) const {
        int row0 = u.pm * 256 + wr * 64 + fr, col0 = u.pn * 256 + wc * 32 + fq * 4;
        asm volatile("" : "+v"(row0), "+v"(col0));
#pragma unroll
        for (int ai = 0; ai < 2; ++ai)
#pragma unroll
            for (int m = 0; m < 4; ++m) { const int row = row0 + ai * 128 + m * 16;
                const float* rp = nullptr; if (r0) rp = (row < rsplit) ? r0 + (size_t)row * ldr : r1 + (size_t)(row - rsplit) * ldr;
                float rs = 1.f; if (rsq) rs = rsqrtf(rsq[row] * (1.f / 1024.f) + EPS);
                float ss = 0.f;
#pragma unroll
                for (int bj = 0; bj < 2; ++bj)
#pragma unroll
                    for (int n = 0; n < 2; ++n) { const int col = col0 + bj * 128 + n * 16; f32x4 v = acc[ai][bj][m][n];
                        if (rsq) { v[0] *= rs; v[1] *= rs; v[2] *= rs; v[3] *= rs; }
                        if (r0) v += *(const f32x4*)(rp + col);
                        if (d32) *(f32x4*)(d32 + (size_t)row * ld32 + col) = v;
                        if (ssq) ss += (v[0] * v[0] + v[1] * v[1]) + (v[2] * v[2] + v[3] * v[3]);
                        if (d16) { f32x4 w = v; if (gcol) w = w * *(const f32x4*)(gcol + col);
                            v2u o; o.x = pg8::cvt_pk_bf16(w[0] * sc16, w[1] * sc16); o.y = pg8::cvt_pk_bf16(w[2] * sc16, w[3] * sc16); *(v2u*)(d16 + (size_t)row * ld16 + col) = o; } }
                if (ssq) { ss += __shfl_xor(ss, 16); ss += __shfl_xor(ss, 32); if (fq == 0) atomicAdd(ssq + row, ss); } }
    }
};
struct EpiInProj {
    static constexpr bool PERM = false, AFTER_DRAIN = false;
    float* out; unsigned char* ws; const float* bff;
    __device__ __forceinline__ void operator()(const f32x4 (&acc)[2][2][4][2], const Unit& u, int wr, int wc, int fr, int fq) const {
        const int pn = u.pn; const bool smp = u.pm >= 64;
        int row0 = u.pm * 256 + wr * 64 + fr;
        int orow0 = (smp ? (u.pm - 64) * 256 : u.pm * 256) + wr * 64 + fr;
        asm volatile("" : "+v"(row0), "+v"(orow0));
        float* d32 = nullptr; int ld32 = 0; bool d32_grp = false; bf16* d16 = nullptr; int ld16 = 0; float s32 = 1.f, s16 = 1.f; int cb = 0;
        if (pn < 2) { d16 = (bf16*)(ws + WS_QF); ld16 = 512; s16 = C2F; cb = pn * 256; }
        else if (pn < 4) { d32 = out + (smp ? O_FKS : O_FKP); ld32 = 512; d32_grp = true; d16 = (bf16*)(ws + WS_KF); ld16 = 512; cb = (pn - 2) * 256; }
        else if (pn < 6) { d32 = out + (smp ? O_FVS : O_FVP); ld32 = 512; d32_grp = true; d16 = (bf16*)(ws + WS_VF); ld16 = 512; cb = (pn - 4) * 256; }
        else if (pn == 6) { d32 = (float*)(ws + WS_GQ); ld32 = 256; s32 = 0.125f; }
        else if (pn == 7) { d32 = (float*)(ws + WS_GK); ld32 = 256; }
        else if (pn < 10) { d32 = (float*)(ws + WS_GV); ld32 = 512; cb = (pn - 8) * 256; }
        else if (pn < 12) { d32 = (float*)(ws + WS_GR); ld32 = 512; cb = (pn - 10) * 256; }
        if (pn < 12) {
#pragma unroll
            for (int ai = 0; ai < 2; ++ai)
#pragma unroll
                for (int m = 0; m < 4; ++m) { const int row = row0 + ai * 128 + m * 16, orow = orow0 + ai * 128 + m * 16;
#pragma unroll
                    for (int bj = 0; bj < 2; ++bj)
#pragma unroll
                        for (int n = 0; n < 2; ++n) { const int col = cb + wc * 32 + fq * 4 + bj * 128 + n * 16; const f32x4 v = acc[ai][bj][m][n];
                            if (d32) *(f32x4*)(d32 + (size_t)(d32_grp ? orow : row) * ld32 + col) = v * s32;
                            if (d16) { v2u o; o.x = pg8::cvt_pk_bf16(v[0] * s16, v[1] * s16); o.y = pg8::cvt_pk_bf16(v[2] * s16, v[3] * s16); *(v2u*)(d16 + (size_t)row * ld16 + col) = o; } } }
        } else {
            if (wc == 0) {
                float* lf = out + (smp ? O_LFS : O_LFP); float* ggp = (float*)(ws + WS_GG);
#pragma unroll
                for (int ai = 0; ai < 2; ++ai)
#pragma unroll
                    for (int m = 0; m < 4; ++m) { const int row = row0 + ai * 128 + m * 16, orow = orow0 + ai * 128 + m * 16;
#pragma unroll
                        for (int n = 0; n < 2; ++n) { const int col = n * 16 + fq * 4; const f32x4 v = acc[ai][0][m][n];
                            if (col < 8) { f32x4 o; const f32x4 b = *(const f32x4*)(bff + col);
                                o[0] = log_sigmoid(v[0] + b[0]); o[1] = log_sigmoid(v[1] + b[1]); o[2] = log_sigmoid(v[2] + b[2]); o[3] = log_sigmoid(v[3] + b[3]);
                                *(f32x4*)(lf + (size_t)orow * 8 + col) = o; }
                            else if (col < 24) *(f32x4*)(ggp + (size_t)row * 16 + (col - 8)) = v; } }
            }
        }
    }
};


__device__ __forceinline__ void p0_prologue(const Frame& F, const Args& a) {
    unsigned char* ws = a.ws;
    LAS float* scr = (LAS float*)(F.lds + F.wave * 16384);
    const int gw = F.vcu * NWAVES + F.wave, NGW = F.G * NWAVES;
    constexpr int I_WINN = 16 * (N_IN / 32), I_SQ = 16 * 32;
    constexpr int NITEMS = I_WINN + 5 * I_SQ;
    for (int it = gw; it < NITEMS; it += NGW) {
        int r = it;
        if (r < I_WINN) { p0_transpose_item<true>((const float*)a.in[I_WIN], 3096, DM, N_IN / 32, (bf16*)(ws + WS_WIN), scr, r, F.lane); continue; } r -= I_WINN;
        const int which = r / I_SQ; r -= which * I_SQ;
        const float* src = (const float*)(which == 0 ? a.in[I_WOUT] : which == 1 ? a.in[I_WMK] : which == 2 ? a.in[I_WMV] : which == 3 ? a.in[I_WCQ] : a.in[I_WCO]);
        bf16* dst = (bf16*)(ws + (which == 0 ? WS_WOUT : which == 1 ? WS_WMK : which == 2 ? WS_WMV : which == 3 ? WS_WCQ : WS_WCO));
        p0_transpose_item<false>(src, DM, DM, 32, dst, scr, r, F.lane);
    }
    { float* ssz = (float*)(ws + WS_SS); for (int i = F.vcu * NTHR + F.tid; i < 2 * TA; i += F.G * NTHR) ssz[i] = 0.f; }
    for (int m = gw; m < TA + 512; m += NGW) {
        if (m < TP) rms_row_bf16((const float*)a.in[I_XP] + (size_t)m * DM, (const float*)a.in[I_GMIX], (bf16*)(ws + WS_HB) + (size_t)m * DM, F.lane);
        else if (m < TA) rms_row_bf16((const float*)a.in[I_XS] + (size_t)(m - TP) * DM, (const float*)a.in[I_GMIX], (bf16*)(ws + WS_HB) + (size_t)m * DM, F.lane);
        else rms_row_bf16((const float*)a.in[I_MEMP] + (size_t)(m - TA) * DM, (const float*)a.in[I_GMEM], (bf16*)(ws + WS_MB) + (size_t)(m - TA) * DM, F.lane);
    }
    {
        for (int r = gw; r < 2 * 16384; r += NGW) {
            const bool isv = r >= 16384; const int e = isv ? r - 16384 : r;
            const f32x4* s = (const f32x4*)((const float*)(isv ? a.in[I_PV] : a.in[I_PU]) + (size_t)e * DM + 16 * F.lane);
            f32x4 x[4]; float am = 0.f;
#pragma unroll
            for (int q = 0; q < 4; ++q) { x[q] = __builtin_nontemporal_load(s + q); am = fmaxf(am, fmaxf(fmaxf(fabsf(x[q].x), fabsf(x[q].y)), fmaxf(fabsf(x[q].z), fabsf(x[q].w)))); }
#pragma unroll
            for (int o = 1; o < 64; o <<= 1) am = fmaxf(am, __shfl_xor(am, o));
            const float inv = am > 0.f ? 448.f / am : 0.f;
            v4u o4;
#pragma unroll
            for (int q = 0; q < 4; ++q) { int pk = __builtin_amdgcn_cvt_pk_fp8_f32(x[q].x * inv, x[q].y * inv, 0, false); pk = __builtin_amdgcn_cvt_pk_fp8_f32(x[q].z * inv, x[q].w * inv, pk, true); o4[q] = (unsigned)pk; }
            *(v4u*)(ws + (isv ? WS_V16 : WS_U16) + (size_t)e * DM + 16 * F.lane) = o4;
            if (F.lane == 0) ((float*)(ws + WS_MISC))[r] = am * (1.f / 448.f);
        }
    }
    __syncthreads();
    for (int it = blockIdx.x; it < 256; it += F.G) {
        const int c = it >> 4, kt = it & 15, half = c & 1;
        LAS float* SK = (LAS float*)F.lds; LAS float* WT = (LAS float*)(F.lds + 128 * 129 * 4);
        const float* sk = (const float*)a.in[I_PSK] + (size_t)half * 128 * 128; const float* wq = (const float*)a.in[I_PWQ] + (size_t)(kt * 64) * 2048 + c * 128;
#pragma unroll 4
        for (int i = 0; i < 32; ++i) { const int idx = F.tid + 512 * i; SK[(idx >> 7) * 129 + (idx & 127)] = sk[idx]; }
#pragma unroll 4
        for (int i = 0; i < 16; ++i) { const int idx = F.tid + 512 * i; WT[(idx >> 7) * 129 + (idx & 127)] = wq[(size_t)(idx >> 7) * 2048 + (idx & 127)]; }
        __syncthreads();
        const int tk = F.tid & 15, tkey = F.tid >> 4;
        float acc[4][4];
#pragma unroll
        for (int i = 0; i < 4; ++i)
#pragma unroll
            for (int j = 0; j < 4; ++j) acc[i][j] = 0.f;
        for (int j = 0; j < 128; ++j) {
            float av[4], bv[4];
#pragma unroll
            for (int i = 0; i < 4; ++i) { av[i] = SK[(4 * tkey + i) * 129 + j]; bv[i] = WT[(4 * tk + i) * 129 + j]; }
#pragma unroll
            for (int i = 0; i < 4; ++i)
#pragma unroll
                for (int i2 = 0; i2 < 4; ++i2) acc[i][i2] += av[i] * bv[i2];
        }
        bf16* wp = (bf16*)(ws + WS_WPK);
#pragma unroll
        for (int i = 0; i < 4; ++i) { v2u o; o.x = pk2(acc[i][0], acc[i][1]); o.y = pk2(acc[i][2], acc[i][3]); *(v2u*)(wp + (size_t)(c * 128 + 4 * tkey + i) * DM + kt * 64 + 4 * tk) = o; }
        __syncthreads();
    }
}


__device__ __forceinline__ void fox_prompt_cumsum(const Frame& F, const float* logf  , float* kbias, int b) {
    LAS float* WT = (LAS float*)F.lds;
    const int t0 = F.wave * 1024 + F.lane * 16;
    const f32x4* src = (const f32x4*)(logf + ((size_t)b * SEQ + t0) * 8);
    float s[8];
#pragma unroll
    for (int h = 0; h < 8; ++h) s[h] = 0.f;
#pragma unroll 4
    for (int i = 0; i < 16; ++i) { const f32x4 a = src[2 * i], c = src[2 * i + 1]; s[0] += a.x; s[1] += a.y; s[2] += a.z; s[3] += a.w; s[4] += c.x; s[5] += c.y; s[6] += c.z; s[7] += c.w; }
    float ex[8];
#pragma unroll
    for (int h = 0; h < 8; ++h) { float v = s[h];
#pragma unroll
        for (int o = 1; o < 64; o <<= 1) { const float t = __shfl_up(v, o); if (F.lane >= o) v += t; }
        ex[h] = v - s[h];
        if (F.lane == 63) WT[F.wave * 8 + h] = v; }
    __syncthreads();
#pragma unroll
    for (int h = 0; h < 8; ++h) { float c = 0.f; for (int w = 0; w < F.wave; ++w) c += WT[w * 8 + h]; ex[h] += c; }
    float* dst = kbias + (size_t)(b * 8) * SEQ + t0;
#pragma unroll 4
    for (int i = 0; i < 16; ++i) { const f32x4 a = src[2 * i], c = src[2 * i + 1];
        ex[0] += a.x; ex[1] += a.y; ex[2] += a.z; ex[3] += a.w; ex[4] += c.x; ex[5] += c.y; ex[6] += c.z; ex[7] += c.w;
#pragma unroll
        for (int h = 0; h < 8; ++h) dst[(size_t)h * SEQ + i] = -ex[h] * LOG2E; }
    __syncthreads();
}
__device__ __forceinline__ void fox_sample_suffix(const Frame& F, const float* cfl, const int* pt, float* suf, int bs) {
    float carry[8];
#pragma unroll
    for (int h = 0; h < 8; ++h) carry[h] = 0.f;
    const int mypg = pt[bs * NPAGES + (F.lane & 15)];
#pragma unroll 1
    for (int pb = NPAGES - 4; pb >= 0; pb -= 4) {
        f32x4 x[4][4];
#pragma unroll
        for (int j = 0; j < 4; ++j) { const int pg = __builtin_amdgcn_readlane(mypg, 0) * 0 + __shfl(mypg, pb + j); const f32x4* src = (const f32x4*)(cfl + ((size_t)pg * PAGE + 2 * F.lane) * 8);
            x[j][0] = src[0]; x[j][1] = src[1]; x[j][2] = src[2]; x[j][3] = src[3]; }
#pragma unroll
        for (int j = 3; j >= 0; --j) { const int p = pb + j;
            const float ra[8] = {x[j][0].x, x[j][0].y, x[j][0].z, x[j][0].w, x[j][1].x, x[j][1].y, x[j][1].z, x[j][1].w}, rb[8] = {x[j][2].x, x[j][2].y, x[j][2].z, x[j][2].w, x[j][3].x, x[j][3].y, x[j][3].z, x[j][3].w};
#pragma unroll
            for (int h = 0; h < 8; ++h) {
                const float ps = ra[h] + rb[h]; float v = ps;
#pragma unroll
                for (int o = 1; o < 64; o <<= 1) { const float t = __shfl_down(v, o); if (F.lane + o < 64) v += t; }
                const float exs = v - ps;
                float* d = suf + (size_t)(bs * 8 + h) * PASTL + p * PAGE + 2 * F.lane;
                *(f32x2*)d = (f32x2){(carry[h] + exs + rb[h]) * LOG2E, (carry[h] + exs) * LOG2E};
                carry[h] += __shfl(v, 0);
            }
        }
    }
}

__device__ __forceinline__ void gla_gate_tile(const Frame& F, const float* gg, const float* w2, const float* bg, int row0, int h, int nt, LAS float* LA, LAS float* GGS) {
    for (int e = F.tid; e < nt * 16; e += NTHR) GGS[e] = gg[(size_t)row0 * 16 + e];
    const int dk = F.tid & 63; float wc[16];
#pragma unroll
    for (int r = 0; r < 16; ++r) wc[r] = w2[r * 256 + h * 64 + dk];
    const float bb = bg[h * 64 + dk];
    __syncthreads();
    for (int t = F.tid >> 6; t < nt; t += 8) { float z = bb;
#pragma unroll
        for (int q = 0; q < 4; ++q) { const f32x4 g4 = *(const LAS f32x4*)(GGS + t * 16 + 4 * q); z += g4.x * wc[4 * q] + g4.y * wc[4 * q + 1] + g4.z * wc[4 * q + 2] + g4.w * wc[4 * q + 3]; }
        LA[t * 64 + dk] = log_sigmoid(z) * (1.f / 16.f); }
}
__device__ __forceinline__ void gla_cumsum64(const Frame& F, LAS float* LA, LAS float* SEG) {
    const int dk = F.lane, w = F.wave; float v[8]; float run = 0.f;
#pragma unroll
    for (int i = 0; i < 8; ++i) { run += LA[(8 * w + i) * 64 + dk]; v[i] = run; }
    SEG[w * 64 + dk] = run;
    __syncthreads();
    float pre = 0.f;
    for (int j = 0; j < w; ++j) pre += SEG[j * 64 + dk];
#pragma unroll
    for (int i = 0; i < 8; ++i) LA[(8 * w + i) * 64 + dk] = v[i] + pre;
    __syncthreads();
}
__device__ __forceinline__ void gla_g1_unit(const Frame& F, const Args& a, int u) {
    unsigned char* ws = a.ws;
    const int b = u >> 9, h = (u >> 7) & 3, n = u & 127; const int row0 = b * SEQ + n * 64;
    LAS float* LA = (LAS float*)F.lds; LAS float* KR = LA + 4096; LAS float* SEG = KR + 4096; LAS float* GGS = SEG + 512; LAS float* VS = GGS + 1024;
#pragma unroll
    for (int i = 0; i < 16; ++i) { const int e = F.tid + NTHR * i; VS[e] = ((const float*)(ws + WS_GV))[(size_t)(row0 + (e >> 7)) * 512 + h * 128 + (e & 127)]; }
    gla_gate_tile(F, (const float*)(ws + WS_GG), (const float*)a.in[I_WG2], (const float*)a.in[I_BG], row0, h, 64, LA, GGS);
    __syncthreads();
    gla_cumsum64(F, LA, SEG);
    if (F.tid < 64) ((float*)(ws + WS_GDEC))[(size_t)((b * 4 + h) * 128 + n) * 64 + F.tid] = __expf(LA[63 * 64 + F.tid]);
    const float* gk = (const float*)(ws + WS_GK); float* bbuf = (float*)(ws + WS_BB);
#pragma unroll
    for (int i = 0; i < 8; ++i) { const int e = F.tid + NTHR * i; const int t = e >> 6, dk = e & 63; const float bb = LA[e]; bbuf[(size_t)(row0 + t) * 256 + h * 64 + dk] = bb;
        KR[e] = gk[(size_t)(row0 + t) * 256 + h * 64 + dk] * __expf(LA[63 * 64 + dk] - bb); }
    __syncthreads();
    {
        const int dvq = F.tid & 31, dkq = F.tid >> 5; float acc[4][4];
#pragma unroll
        for (int i = 0; i < 4; ++i)
#pragma unroll
            for (int j = 0; j < 4; ++j) acc[i][j] = 0.f;
#pragma unroll 8
        for (int t = 0; t < 64; ++t) { const f32x4 v4 = *(const LAS f32x4*)(VS + t * 128 + 4 * dvq), k4 = *(const LAS f32x4*)(KR + t * 64 + 4 * dkq);
#pragma unroll
            for (int i = 0; i < 4; ++i)
#pragma unroll
                for (int j = 0; j < 4; ++j) acc[i][j] += k4[i] * v4[j]; }
        float* kv = (float*)(ws + WS_GKV) + ((size_t)((b * 4 + h) * 128 + n) * 64 + 4 * dkq) * 128 + 4 * dvq;
#pragma unroll
        for (int i = 0; i < 4; ++i) *(f32x4*)(kv + (size_t)i * 128) = (f32x4){acc[i][0], acc[i][1], acc[i][2], acc[i][3]};
    }
    __syncthreads();
}
__device__ __forceinline__ void gla_scan(const Frame& F, const Args& a) {
    if (F.tid >= 256) return;
    for (int e = F.vcu * 256 + F.tid; e < 65536; e += F.G * 256) {
    const int bh = e >> 13, dk = (e >> 7) & 63, dv = e & 127;
    float* kv = (float*)(a.ws + WS_GKV) + ((size_t)bh * 128 * 64 + dk) * 128 + dv; const float* dc = (const float*)(a.ws + WS_GDEC) + (size_t)bh * 128 * 64 + dk;
    float S = 0.f;
    for (int n0 = 0; n0 < 128; n0 += 8) { float kvv[8], dd[8];
#pragma unroll
        for (int j = 0; j < 8; ++j) { kvv[j] = kv[(size_t)(n0 + j) * 8192]; dd[j] = dc[(size_t)(n0 + j) * 64]; }
#pragma unroll
        for (int j = 0; j < 8; ++j) { kv[(size_t)(n0 + j) * 8192] = S; S = dd[j] * S + kvv[j]; } }
    a.out[O_GSP + (size_t)bh * 8192 + dk * 128 + dv] = S;
    }
}
__device__ __forceinline__ float silu(float x) { return x / (1.f + __expf(-x)); }
__device__ __forceinline__ void gla_sample_unit(const Frame& F, const Args& a, int u) {
    unsigned char* ws = a.ws;
    const int bs = u >> 2, h = u & 3; const int row0 = TP + bs * LS;
    LAS float* LA = (LAS float*)F.lds; LAS float* BL = LA + 512; LAS float* QD = BL + 64; LAS float* KI = QD + 512; LAS float* KR = KI + 512; LAS float* ATT = KR + 512; LAS float* OP = ATT + 64; LAS float* VS = OP + 4096;
    gla_gate_tile(F, (const float*)(ws + WS_GG), (const float*)a.in[I_WG2], (const float*)a.in[I_BG], row0, h, 8, LA, VS + 1024);
#pragma unroll
    for (int i = 0; i < 2; ++i) { const int e = F.tid + NTHR * i; VS[e] = ((const float*)(ws + WS_GV))[(size_t)(row0 + (e >> 7)) * 512 + h * 128 + (e & 127)]; }
    __syncthreads();
    if (F.tid < 64) { float run = 0.f;
#pragma unroll
        for (int t = 0; t < 8; ++t) { run += LA[t * 64 + F.tid]; LA[t * 64 + F.tid] = run; } BL[F.tid] = run; }
    __syncthreads();
    { const int e = F.tid, t = e >> 6, dk = e & 63; const float bb = LA[e];
      const float q = ((const float*)(ws + WS_GQ))[(size_t)(row0 + t) * 256 + h * 64 + dk], k = ((const float*)(ws + WS_GK))[(size_t)(row0 + t) * 256 + h * 64 + dk];
      QD[e] = q * __expf(bb); KI[e] = k * __expf(-bb); KR[e] = k * __expf(BL[dk] - bb); }
    __syncthreads();
    if (F.tid < 64) { const int t = F.tid >> 3, s = F.tid & 7; float acc = 0.f;
        if (s <= t) { for (int dk = 0; dk < 64; ++dk) acc += QD[t * 64 + dk] * KI[s * 64 + dk]; }
        ATT[F.tid] = acc; }
    const int dv = F.tid & 127, dkg = F.tid >> 7;
    {
        const float* st = (const float*)a.in[I_SGLA] + ((size_t)(bs * 4 + h) * 64 + dkg * 16) * 128 + dv;
        float S0[16];
#pragma unroll
        for (int i = 0; i < 16; ++i) S0[i] = st[(size_t)i * 128];
#pragma unroll
        for (int t = 0; t < 8; ++t) { float o = 0.f;
#pragma unroll
            for (int i = 0; i < 16; ++i) o += QD[t * 64 + dkg * 16 + i] * S0[i];
            OP[(dkg * 8 + t) * 128 + dv] = o; }
        float* so = a.out + O_GSS + ((size_t)(bs * 4 + h) * 64 + dkg * 16) * 128 + dv;
#pragma unroll
        for (int i = 0; i < 16; ++i) { float sn = __expf(BL[dkg * 16 + i]) * S0[i];
#pragma unroll
            for (int t = 0; t < 8; ++t) sn += KR[t * 64 + dkg * 16 + i] * VS[t * 128 + dv];
            so[(size_t)i * 128] = sn; }
    }
    __syncthreads();
    {
        const int t = F.wave; float o[2]; float ss = 0.f;
#pragma unroll
        for (int j = 0; j < 2; ++j) { const int d = 2 * F.lane + j; float v = OP[(0 * 8 + t) * 128 + d] + OP[(1 * 8 + t) * 128 + d] + OP[(2 * 8 + t) * 128 + d] + OP[(3 * 8 + t) * 128 + d];
            for (int s = 0; s <= t; ++s) v += ATT[t * 8 + s] * VS[s * 128 + d];
            o[j] = v; ss += v * v; }
        const float r = rsqrtf(wave_sum(ss) * (1.f / 128.f) + EPS);
        const float* ggo = (const float*)a.in[I_GGO] + h * 128 + 2 * F.lane; const float* gr = (const float*)(ws + WS_GR) + (size_t)(row0 + t) * 512 + h * 128 + 2 * F.lane;
        const float y0 = o[0] * r * ggo[0] * silu(gr[0]), y1 = o[1] * r * ggo[1] * silu(gr[1]);
        *(unsigned*)((bf16*)(ws + WS_MERGED) + (size_t)(row0 + t) * DM + 512 + h * 128 + 2 * F.lane) = pk2(y0, y1);
    }
    __syncthreads();
}


typedef short v4i16_t __attribute__((ext_vector_type(4)));
__device__ __forceinline__ s16x4 lds_tr16(LAS unsigned char* p) { return __builtin_bit_cast(s16x4, __builtin_amdgcn_ds_read_tr16_b64_v4i16((LAS v4i16_t*)p)); }
__device__ __forceinline__ int crow(int r, int hi) { return (r & 3) + 8 * (r >> 2) + 4 * hi; }
__device__ __forceinline__ float fexp2(float x) { return __builtin_amdgcn_exp2f(x); }
constexpr float FOX_SKIP = 160.f;


__device__ __forceinline__ void fox_norms_item(const Frame& F, const bf16* QF, const bf16* KF, const float* logf, float* FN, float* LC, float* BT, int item) {
    const int bh = item >> 5, qb = item & 31, b = bh >> 3, h = bh & 7;
    float qm = 0.f, km = 0.f;
    const float* lp = logf + ((size_t)b * SEQ + qb * 256 + 4 * F.lane) * 8 + h;
    const float l0 = lp[0], l1 = lp[8], l2 = lp[16], l3 = lp[24];
#pragma unroll
    for (int i = 0; i < 4; ++i) { const size_t row = (size_t)b * SEQ + qb * 256 + i * 64 + F.lane;
        const v4u* qp = (const v4u*)(QF + row * 512 + h * 64); const v4u* kp = (const v4u*)(KF + row * 512 + h * 64); float qs = 0.f, ks = 0.f;
#pragma unroll
        for (int c = 0; c < 8; ++c) { const v4u q = qp[c], k = kp[c];
#pragma unroll
            for (int j = 0; j < 4; ++j) { qs += bflo(q[j]) * bflo(q[j]) + bfhi(q[j]) * bfhi(q[j]); ks += bflo(k[j]) * bflo(k[j]) + bfhi(k[j]) * bfhi(k[j]); } }
        qm = fmaxf(qm, qs); km = fmaxf(km, ks); }
#pragma unroll
    for (int o = 1; o < 64; o <<= 1) { qm = fmaxf(qm, __shfl_xor(qm, o)); km = fmaxf(km, __shfl_xor(km, o)); }
    const float c0 = l0, c1 = c0 + l1, c2 = c1 + l2, c3 = c2 + l3; float v = c3;
#pragma unroll
    for (int o = 1; o < 64; o <<= 1) { const float t = __shfl_up(v, o); if (F.lane >= o) v += t; }
    const float ex = v - c3;
    *(f32x4*)(LC + (size_t)bh * SEQ + qb * 256 + 4 * F.lane) = (f32x4){ex + c0, ex + c1, ex + c2, ex + c3};
    if (F.lane == 63) BT[item] = v;
    if (F.lane == 0) { FN[item * 2] = qm; FN[item * 2 + 1] = km; }
}
__device__ __forceinline__ void fox_suffix_item(const Frame& F, const float* cfl, const int* pt, float* SW, float* PTOT, int item) {
    const int bs = item >> 4, p = item & 15; const int pg = __builtin_amdgcn_readfirstlane(pt[item]);
    const f32x4* src = (const f32x4*)(cfl + ((size_t)pg * PAGE + 2 * F.lane) * 8);
    const f32x4 a0 = src[0], a1 = src[1], b0 = src[2], b1 = src[3];
    const float ra[8] = {a0.x, a0.y, a0.z, a0.w, a1.x, a1.y, a1.z, a1.w}, rb[8] = {b0.x, b0.y, b0.z, b0.w, b1.x, b1.y, b1.z, b1.w};
#pragma unroll
    for (int h = 0; h < 8; ++h) {
        const float ps = ra[h] + rb[h]; float v = ps;
#pragma unroll
        for (int o = 1; o < 64; o <<= 1) { const float t = __shfl_down(v, o); if (F.lane + o < 64) v += t; }
        const float exs = v - ps;
        *(f32x2*)(SW + (size_t)(bs * 8 + h) * PASTL + p * PAGE + 2 * F.lane) = (f32x2){exs + rb[h], exs};
        if (F.lane == 0) PTOT[(bs * 8 + h) * NPAGES + p] = v;
    }
}
__device__ __forceinline__ void fox_attn_unit(const Frame& F, const bf16* QF, const bf16* KF, const bf16* VF, const float* LC, const float* BT, const float* FN, bf16* merged, int b, int h, int qb) {
    const int lane = F.lane, r32 = lane & 31, hi = lane >> 5, wid = F.wave, tid = F.tid;
    const size_t rowbase = (size_t)b * SEQ; const int q0 = qb * 256;
    LAS unsigned char* Ks = F.lds; LAS unsigned char* Vs = F.lds + 8192; LAS float* KBs = (LAS float*)(F.lds + 20480); LAS float* WSF = (LAS float*)(F.lds + 20736) + wid * 32;
    const bf16* Qw = QF + (rowbase + q0 + wid * 32 + r32) * 512 + h * 64;
    bf16x8 qr[4];
#pragma unroll
    for (int d0 = 0; d0 < 4; ++d0) qr[d0] = *(const bf16x8*)(Qw + d0 * 16 + hi * 8);
    const float* lcp = LC + (size_t)(b * 8 + h) * SEQ;
    float pbx; { const float btv = (lane < 32) ? BT[(b * 8 + h) * 32 + lane] : 0.f; float v = btv;
#pragma unroll
        for (int o = 1; o < 64; o <<= 1) { const float t = __shfl_up(v, o); if (lane >= o) v += t; }
        pbx = v - btv; }
    const float cref = lcp[q0] + __shfl(pbx, qb);
#define FOX_KB(t_, pos_) (-LOG2E * ((lcp[pos_] + __shfl(pbx, (t_) >> 2)) - cref))
    const int NT = (q0 + 256) / 64;
    int t0 = 0;
    {
        float kn = (lane < 32) ? FN[((b * 8 + h) * 32 + lane) * 2 + 1] : 0.f;
#pragma unroll
        for (int o = 1; o < 64; o <<= 1) kn = fmaxf(kn, __shfl_xor(kn, o));
        const float qk2 = 2.f * sqrtf(FN[((b * 8 + h) * 32 + qb) * 2]) * sqrtf(kn) * 1.01f;
        const int nbefore = q0 / 64;
        int found = -1;
        for (int base = 0; base < nbefore && found < 0; base += 64) {
            const int tl = nbefore - 1 - base - lane;
            const int tlc = tl < 0 ? 0 : tl; const float kbl = -LOG2E * ((lcp[tlc * 64 + 63] + __shfl(pbx, tlc >> 2)) - cref);
            const bool dead = (tl >= 0) && (qk2 + kbl < -FOX_SKIP);
            const unsigned long long bm = __ballot(dead);
            if (bm) found = nbefore - 1 - base - (int)__builtin_ctzll(bm);
        }
        t0 = found + 1;
        t0 = __builtin_amdgcn_readfirstlane(t0);
    }
    const int kkey = tid & 63, kch = tid >> 6, vkey = tid >> 3, vch = tid & 7;
    const bf16* ksrc = KF + (rowbase + kkey) * 512 + h * 64 + kch * 8;
    const bf16* vsrc = VF + (rowbase + vkey) * 512 + h * 64 + vch * 8;
    v4u kreg = *(const v4u*)(ksrc + (size_t)t0 * 64 * 512), vreg = *(const v4u*)(vsrc + (size_t)t0 * 64 * 512); float kbreg = FOX_KB(t0, t0 * 64 + (tid & 63));
    float m_run = -INFINITY, l_run = 0.f; f32x16 o0 = {}, o1 = {};
    const int qpos = q0 + wid * 32 + r32;
    const int vbase = (4 * hi + ((lane & 15) >> 2)) * 192 + (16 * ((lane >> 4) & 1) + 4 * (lane & 3)) * 2;
    for (int t = t0; t < NT; ++t) {
        __syncthreads();
        *(LAS v4u*)(Ks + kch * 1024 + kkey * 16) = kreg; *(LAS v4u*)(Vs + vkey * 192 + vch * 16) = vreg; if (tid < 64) KBs[tid] = kbreg;
        __syncthreads();
        if (t + 1 < NT) { kreg = *(const v4u*)(ksrc + (size_t)(t + 1) * 64 * 512); vreg = *(const v4u*)(vsrc + (size_t)(t + 1) * 64 * 512); kbreg = FOX_KB(t + 1, (t + 1) * 64 + (tid & 63)); }
        const int k0 = t * 64;
        if (k0 > q0 + wid * 32 + 31) continue;
        f32x16 p0 = {}, p1 = {};
#pragma unroll
        for (int d0 = 0; d0 < 4; ++d0) {
            const bf16x8 a0 = *(const LAS bf16x8*)(Ks + (2 * d0 + hi) * 1024 + r32 * 16), a1 = *(const LAS bf16x8*)(Ks + (2 * d0 + hi) * 1024 + r32 * 16 + 512);
            p0 = __builtin_amdgcn_mfma_f32_32x32x16_bf16(a0, qr[d0], p0, 0, 0, 0); p1 = __builtin_amdgcn_mfma_f32_32x32x16_bf16(a1, qr[d0], p1, 0, 0, 0);
        }
#pragma unroll
        for (int g = 0; g < 4; ++g) { const f32x4 ba = *(const LAS f32x4*)(KBs + 8 * g + 4 * hi), bb = *(const LAS f32x4*)(KBs + 32 + 8 * g + 4 * hi);
#pragma unroll
            for (int i = 0; i < 4; ++i) { p0[4 * g + i] += ba[i]; p1[4 * g + i] += bb[i]; } }
        if (k0 + 63 > q0 + wid * 32) {
#pragma unroll
            for (int r = 0; r < 16; ++r) { const int key = k0 + crow(r, hi); if (key > qpos) p0[r] = -INFINITY; if (key + 32 > qpos) p1[r] = -INFINITY; }
        }
        float mx = fmaxf(p0[0], p1[0]);
#pragma unroll
        for (int r = 1; r < 16; ++r) mx = fmaxf(mx, fmaxf(p0[r], p1[r]));
        mx = fmaxf(mx, __shfl_xor(mx, 32));
        const float m_new = fmaxf(m_run, mx), alpha = fexp2(m_run - m_new); m_run = m_new;
        float ls = 0.f;
#pragma unroll
        for (int r = 0; r < 16; ++r) { p0[r] = fexp2(p0[r] - m_new); p1[r] = fexp2(p1[r] - m_new); ls += p0[r] + p1[r]; }
        l_run = l_run * alpha + ls;
        if (hi == 0) WSF[r32] = alpha;
#pragma unroll
        for (int g = 0; g < 4; ++g) { const f32x4 al = *(const LAS f32x4*)(WSF + 8 * g + 4 * hi);
#pragma unroll
            for (int i = 0; i < 4; ++i) { o0[4 * g + i] *= al[i]; o1[4 * g + i] *= al[i]; } }
        v4u pw[4];
#pragma unroll
        for (int j = 0; j < 4; ++j) { pw[0][j] = pg8::cvt_pk_bf16(p0[2 * j], p0[2 * j + 1]); pw[1][j] = pg8::cvt_pk_bf16(p0[8 + 2 * j], p0[8 + 2 * j + 1]);
                                      pw[2][j] = pg8::cvt_pk_bf16(p1[2 * j], p1[2 * j + 1]); pw[3][j] = pg8::cvt_pk_bf16(p1[8 + 2 * j], p1[8 + 2 * j + 1]); }
#pragma unroll
        for (int ks = 0; ks < 4; ++ks) {
            const bf16x8 pa = __builtin_bit_cast(bf16x8, pw[ks]);
#pragma unroll
            for (int d0 = 0; d0 < 2; ++d0) {
                const s16x4 lo = lds_tr16(Vs + vbase + ks * 16 * 192 + d0 * 64), hi4 = lds_tr16(Vs + vbase + ks * 16 * 192 + 8 * 192 + d0 * 64);
                const bf16x8 vb = (bf16x8){lo[0], lo[1], lo[2], lo[3], hi4[0], hi4[1], hi4[2], hi4[3]};
                if (d0 == 0) o0 = __builtin_amdgcn_mfma_f32_32x32x16_bf16(pa, vb, o0, 0, 0, 0); else o1 = __builtin_amdgcn_mfma_f32_32x32x16_bf16(pa, vb, o1, 0, 0, 0);
            }
        }
    }
    l_run += __shfl_xor(l_run, 32);
    if (hi == 0) WSF[r32] = 1.f / l_run;
    bf16* Ow = merged + (rowbase + q0 + wid * 32) * DM + h * 64 + r32;
#pragma unroll
    for (int g = 0; g < 4; ++g) { const f32x4 rl = *(const LAS f32x4*)(WSF + 8 * g + 4 * hi);
#pragma unroll
        for (int i = 0; i < 4; ++i) { const int r = 4 * g + i; const int row = crow(r, hi);
            Ow[(size_t)row * DM] = (bf16)f2bf(o0[r] * rl[i]); Ow[(size_t)row * DM + 32] = (bf16)f2bf(o1[r] * rl[i]); } }
    __syncthreads();
#undef FOX_KB
}

template <int D> struct DecW {
    static constexpr int KS = D / 32;
    static constexpr int LPK = D / 4;
    static constexpr int KPI = 64 / LPK;
    float m[4], l[4]; float o[8][4];
};
template <int D>
__device__ __forceinline__ void dec_init(DecW<D>& w) {
#pragma unroll
    for (int i = 0; i < 4; ++i) { w.m[i] = -INFINITY; w.l[i] = 0.f; }
#pragma unroll
    for (int q = 0; q < 8; ++q)
#pragma unroll
        for (int j = 0; j < 4; ++j) w.o[q][j] = 0.f;
}
template <int D, int NTILE, int MODE>
__device__ __forceinline__ void dec_chunk(DecW<D>& w, const bf16x8 (&qa)[D / 32], const float* Kb, const float* Vb, int stride, const float* bias, float nb, LAS float* PL, int lane) {
    constexpr int KS = D / 32, LPK = D / 4, KPI = 64 / LPK;
    constexpr int NK = (MODE == 1) ? 8 : NTILE * 16, NV = NK / KPI;
    const int key = lane & 15, kq = lane >> 4;
    const unsigned koff = (unsigned)(key * stride + 8 * kq) * 4u;
    const int d4 = lane % LPK, ksub = lane / LPK;
    const unsigned voff = (unsigned)(ksub * stride + 4 * d4) * 4u;
    f32x4 kx[NTILE][2 * KS], vx[NV];
#pragma unroll
    for (int t = 0; t < NTILE; ++t) { const char* kp = (const char*)(Kb + (size_t)t * 16 * stride) + koff;
#pragma unroll
        for (int ks = 0; ks < KS; ++ks) { kx[t][2 * ks] = *(const f32x4*)(kp + 128 * ks); kx[t][2 * ks + 1] = *(const f32x4*)(kp + 128 * ks + 16); } }
    constexpr int NVA = (NV >= 8) ? NV / 2 : NV;
#pragma unroll
    for (int kk = 0; kk < NVA; ++kk) vx[kk] = *(const f32x4*)((const char*)(Vb + (size_t)kk * KPI * stride) + voff);
    f32x4 s[NTILE];
#pragma unroll
    for (int t = 0; t < NTILE; ++t) {
        f32x4 acc = {0.f, 0.f, 0.f, 0.f};
#pragma unroll
        for (int ks = 0; ks < KS; ++ks) { const f32x4 x0 = kx[t][2 * ks], x1 = kx[t][2 * ks + 1];
            v4u kb; kb.x = pg8::cvt_pk_bf16(x0.x, x0.y); kb.y = pg8::cvt_pk_bf16(x0.z, x0.w); kb.z = pg8::cvt_pk_bf16(x1.x, x1.y); kb.w = pg8::cvt_pk_bf16(x1.z, x1.w);
            acc = __builtin_amdgcn_mfma_f32_16x16x32_bf16(qa[ks], __builtin_bit_cast(bf16x8, kb), acc, 0, 0, 0); }
        if (MODE == 0) { if (bias) { const float bv = (bias[t * 16 + key] + nb) * LOG2E; acc += bv; } }
        else { acc += nb;
#pragma unroll
            for (int i = 0; i < 4; ++i) if (key > 4 * kq + i || key >= 8) acc[i] = -INFINITY; }
        s[t] = acc;
    }
#pragma unroll
    for (int kk = NVA; kk < NV; ++kk) vx[kk] = *(const f32x4*)((const char*)(Vb + (size_t)kk * KPI * stride) + voff);
    f32x4 mc = s[0];
#pragma unroll
    for (int t = 1; t < NTILE; ++t) { mc.x = fmaxf(mc.x, s[t].x); mc.y = fmaxf(mc.y, s[t].y); mc.z = fmaxf(mc.z, s[t].z); mc.w = fmaxf(mc.w, s[t].w); }
#pragma unroll
    for (int o = 1; o < 16; o <<= 1) { mc.x = fmaxf(mc.x, __shfl_xor(mc.x, o)); mc.y = fmaxf(mc.y, __shfl_xor(mc.y, o)); mc.z = fmaxf(mc.z, __shfl_xor(mc.z, o)); mc.w = fmaxf(mc.w, __shfl_xor(mc.w, o)); }
    float al[4];
#pragma unroll
    for (int i = 0; i < 4; ++i) { const float mn = fmaxf(w.m[i], mc[i]); al[i] = (mn == -INFINITY) ? 1.f : fexp2(w.m[i] - mn); w.m[i] = mn; w.l[i] *= al[i]; }
#pragma unroll
    for (int t = 0; t < NTILE; ++t) { f32x4 p;
#pragma unroll
        for (int i = 0; i < 4; ++i) { p[i] = (w.m[i] == -INFINITY) ? 0.f : fexp2(s[t][i] - w.m[i]); w.l[i] += p[i]; }
        if (kq < 2) *(LAS f32x4*)(PL + (t * 16 + key) * 8 + 4 * kq) = p; }
    if (key == 0 && kq < 2) *(LAS f32x4*)(PL + 1024 + 4 * kq) = (f32x4){al[0], al[1], al[2], al[3]};
    { const f32x4 a0 = *(const LAS f32x4*)(PL + 1024), a1 = *(const LAS f32x4*)(PL + 1028);
#pragma unroll
      for (int j = 0; j < 4; ++j) { w.o[0][j] *= a0.x; w.o[1][j] *= a0.y; w.o[2][j] *= a0.z; w.o[3][j] *= a0.w; w.o[4][j] *= a1.x; w.o[5][j] *= a1.y; w.o[6][j] *= a1.z; w.o[7][j] *= a1.w; } }
#pragma unroll
    for (int kk = 0; kk < NV; ++kk) { const int k = kk * KPI + ksub;
        const f32x4 v = vx[kk];
        const f32x4 pa = *(const LAS f32x4*)(PL + k * 8), pb = *(const LAS f32x4*)(PL + k * 8 + 4);
#pragma unroll
        for (int j = 0; j < 4; ++j) { w.o[0][j] += pa.x * v[j]; w.o[1][j] += pa.y * v[j]; w.o[2][j] += pa.z * v[j]; w.o[3][j] += pa.w * v[j];
                                      w.o[4][j] += pb.x * v[j]; w.o[5][j] += pb.y * v[j]; w.o[6][j] += pb.z * v[j]; w.o[7][j] += pb.w * v[j]; } }
}
template <int D>
__device__ __forceinline__ void dec_park(DecW<D>& w, LAS float* CBw, int lane) {
    constexpr int LPK = D / 4;
    const int key = lane & 15, kq = lane >> 4, d4 = lane % LPK, ksub = lane / LPK;
#pragma unroll
    for (int i = 0; i < 4; ++i) { float l = w.l[i];
#pragma unroll
        for (int o = 1; o < 16; o <<= 1) l += __shfl_xor(l, o);
        w.l[i] = l; }
    if (key == 0 && kq < 2) { *(LAS f32x4*)(CBw + 4 * kq) = (f32x4){w.m[0], w.m[1], w.m[2], w.m[3]}; *(LAS f32x4*)(CBw + 8 + 4 * kq) = (f32x4){w.l[0], w.l[1], w.l[2], w.l[3]}; }
#pragma unroll
    for (int q = 0; q < 8; ++q) { f32x4 v = (f32x4){w.o[q][0], w.o[q][1], w.o[q][2], w.o[q][3]};
        if (LPK < 64) {
#pragma unroll
            for (int o = LPK; o < 64; o <<= 1) { v.x += __shfl_xor(v.x, o); v.y += __shfl_xor(v.y, o); v.z += __shfl_xor(v.z, o); v.w += __shfl_xor(v.w, o); } }
        if (ksub == 0) *(LAS f32x4*)(CBw + 16 + q * D + 4 * d4) = v; }
}
template <int D>
__device__ __forceinline__ void dec_combine(const Frame& F, LAS float* CB, bf16* dst, int ldd) {
    constexpr int WSTR = 16 + 8 * D;
    for (int e = F.tid; e < 8 * D; e += NTHR) { const int q = e / D, d = e % D;
        float mt = -INFINITY;
#pragma unroll
        for (int w = 0; w < 8; ++w) mt = fmaxf(mt, CB[w * WSTR + q]);
        float num = 0.f, den = 0.f;
#pragma unroll
        for (int w = 0; w < 8; ++w) { const float mw = CB[w * WSTR + q]; const float f = (mw == -INFINITY) ? 0.f : fexp2(mw - mt); num += f * CB[w * WSTR + 16 + q * D + d]; den += f * CB[w * WSTR + 8 + q]; }
        dst[(size_t)q * ldd + d] = (bf16)f2bf(num / den); }
}
template <int D>
__device__ __forceinline__ void dec_load_q(bf16x8 (&qa)[D / 32], const bf16* Q, int ldq, int lane) {
    const int row = lane & 15, kq = lane >> 4;
#pragma unroll
    for (int ks = 0; ks < D / 32; ++ks) { v4u z = {0u, 0u, 0u, 0u}; if (row < 8) z = *(const v4u*)(Q + (size_t)row * ldq + 32 * ks + 8 * kq); qa[ks] = __builtin_bit_cast(bf16x8, z); }
}
constexpr int DEC_PL = 1040;
__device__ __forceinline__ void fox_sample_unit(const Frame& F, const Args& a, int u) {
    unsigned char* ws = a.ws; const int bs = u >> 3, h = u & 7;
    LAS float* PL = (LAS float*)F.lds + F.wave * DEC_PL; LAS float* CB = (LAS float*)F.lds + 8 * DEC_PL; constexpr int WSTR = 16 + 8 * 64;
    bf16x8 qa[2]; dec_load_q<64>(qa, (const bf16*)(ws + WS_QF) + (size_t)(TP + bs * LS) * 512 + h * 64, 512, F.lane);
    DecW<64> w; dec_init(w);
    if (F.wave == 0) {
        const int key = F.lane & 15; const float* lf = a.out + O_LFS + (size_t)(bs * LS) * 8 + h; float cn = 0.f;
        for (int j = 0; j < 8; ++j) if (j <= key) cn += lf[j * 8];
        const float* Kb = a.out + O_FKS + (size_t)(bs * LS) * 512 + h * 64; const float* Vb = a.out + O_FVS + (size_t)(bs * LS) * 512 + h * 64;
        dec_chunk<64, 1, 1>(w, qa, Kb, Vb, 512, nullptr, -cn * LOG2E, PL, F.lane);
    }
    const int* pt = (const int*)a.in[I_PT];
    float spx; { const float ptv = (F.lane < 16) ? ((const float*)(ws + WS_MISC + 2 * MiB))[(bs * 8 + h) * NPAGES + F.lane] : 0.f; float v = ptv;
#pragma unroll
        for (int o = 1; o < 64; o <<= 1) { const float t = __shfl_down(v, o); if (F.lane + o < 64) v += t; }
        spx = v - ptv; }
#pragma unroll 1
    for (int pp = 0; pp < 4; ++pp) { const int p = F.wave * 2 + (pp >> 1), hf = pp & 1; const int pg = __builtin_amdgcn_readfirstlane(pt[bs * NPAGES + p]);
        const float* Kb = (const float*)a.in[I_CFK] + (((size_t)pg * PAGE + hf * 64) * 8 + h) * 64; const float* Vb = (const float*)a.in[I_CFV] + (((size_t)pg * PAGE + hf * 64) * 8 + h) * 64;
        dec_chunk<64, 4, 0>(w, qa, Kb, Vb, 512, (const float*)(ws + WS_SUF) + (size_t)(bs * 8 + h) * PASTL + p * PAGE + hf * 64, __shfl(spx, p), PL, F.lane); }
    dec_park<64>(w, CB + F.wave * WSTR, F.lane);
    __syncthreads();
    dec_combine<64>(F, CB, (bf16*)(ws + WS_MERGED) + (size_t)(TP + bs * LS) * DM + h * 64, DM);
    __syncthreads();
}
__device__ __forceinline__ void cross_sample_unit(const Frame& F, const Args& a, int u) {
    unsigned char* ws = a.ws; const int bs = u >> 2, h = u & 3;
    LAS float* PL = (LAS float*)F.lds + F.wave * DEC_PL; LAS float* CB = (LAS float*)F.lds + 8 * DEC_PL; constexpr int WSTR = 16 + 8 * 256;
    bf16x8 qa[8]; dec_load_q<256>(qa, (const bf16*)(ws + WS_QC) + (size_t)(TP + bs * LS) * DM + h * 256, DM, F.lane);
    DecW<256> w; dec_init(w);
    const float* Kb = (const float*)a.in[I_CMK] + ((size_t)(bs * 256 + F.wave * 32) * 4 + h) * 256; const float* Vb = (const float*)a.in[I_CMV] + ((size_t)(bs * 256 + F.wave * 32) * 4 + h) * 256;
#pragma unroll 1
    for (int c = 0; c < 2; ++c) dec_chunk<256, 1, 0>(w, qa, Kb + (size_t)c * 16 * 1024, Vb + (size_t)c * 16 * 1024, 1024, nullptr, 0.f, PL, F.lane);
    dec_park<256>(w, CB + F.wave * WSTR, F.lane);
    __syncthreads();
    dec_combine<256>(F, CB, (bf16*)(ws + WS_OC) + (size_t)(TP + bs * LS) * DM + h * 256, DM);
    __syncthreads();
}


__device__ __forceinline__ void gla_g3_unit(const Frame& F, const Args& a, int u) {
    unsigned char* ws = a.ws;
    const int b = u >> 9, h = (u >> 7) & 3, n = u & 127; const int row0 = b * SEQ + n * 64;
    LAS float* QDT = (LAS float*)F.lds; LAS float* KIT = QDT + 4352; LAS float* LA = KIT + 4352; LAS float* ATT = LA; LAS float* VS = LA + 4352; LAS float* SP = VS + 8192;
#pragma unroll
    for (int i = 0; i < 16; ++i) { const int e = F.tid + NTHR * i; VS[e] = ((const float*)(ws + WS_GV))[(size_t)(row0 + (e >> 7)) * 512 + h * 128 + (e & 127)];
        SP[e] = ((const float*)(ws + WS_GKV))[((size_t)((b * 4 + h) * 128 + n) * 64) * 128 + e]; }
#pragma unroll
    for (int i = 0; i < 8; ++i) { const int e = F.tid + NTHR * i, t = e >> 6, dk = e & 63; const size_t gi = (size_t)(row0 + t) * 256 + h * 64 + dk;
        const float bb = ((const float*)(ws + WS_BB))[gi];
        QDT[dk * 68 + t] = ((const float*)(ws + WS_GQ))[gi] * __expf(bb); KIT[dk * 68 + t] = ((const float*)(ws + WS_GK))[gi] * __expf(-bb); }
    __syncthreads();
    {
        const int tp = F.tid & 31, sq = F.tid >> 5; float acc[2][4];
#pragma unroll
        for (int i = 0; i < 2; ++i)
#pragma unroll
            for (int j = 0; j < 4; ++j) acc[i][j] = 0.f;
        if (4 * sq <= 2 * tp + 1) {
#pragma unroll 8
            for (int dk = 0; dk < 64; ++dk) { const f32x2 q2 = *(const LAS f32x2*)(QDT + dk * 68 + 2 * tp); const f32x4 k4 = *(const LAS f32x4*)(KIT + dk * 68 + 4 * sq);
#pragma unroll
                for (int j = 0; j < 4; ++j) { acc[0][j] += q2.x * k4[j]; acc[1][j] += q2.y * k4[j]; } }
        }
#pragma unroll
        for (int j = 0; j < 4; ++j) { const int s = 4 * sq + j; f32x2 o; o.x = (s <= 2 * tp) ? acc[0][j] : 0.f; o.y = (s <= 2 * tp + 1) ? acc[1][j] : 0.f; *(LAS f32x2*)(ATT + s * 68 + 2 * tp) = o; }
    }
    __syncthreads();
    {
        const int dvq = F.tid & 31, tq = F.tid >> 5; float acc[4][4];
#pragma unroll
        for (int i = 0; i < 4; ++i)
#pragma unroll
            for (int j = 0; j < 4; ++j) acc[i][j] = 0.f;
#pragma unroll 8
        for (int s = 0; s < 64; ++s) { const f32x4 v4 = *(const LAS f32x4*)(VS + s * 128 + 4 * dvq), a4 = *(const LAS f32x4*)(ATT + s * 68 + 4 * tq);
#pragma unroll
            for (int i = 0; i < 4; ++i)
#pragma unroll
                for (int j = 0; j < 4; ++j) acc[i][j] += a4[i] * v4[j]; }
#pragma unroll 8
        for (int dk = 0; dk < 64; ++dk) { const f32x4 v4 = *(const LAS f32x4*)(SP + dk * 128 + 4 * dvq), a4 = *(const LAS f32x4*)(QDT + dk * 68 + 4 * tq);
#pragma unroll
            for (int i = 0; i < 4; ++i)
#pragma unroll
                for (int j = 0; j < 4; ++j) acc[i][j] += a4[i] * v4[j]; }
        __syncthreads();
#pragma unroll
        for (int i = 0; i < 4; ++i) *(LAS f32x4*)(VS + (4 * tq + i) * 128 + 4 * dvq) = (f32x4){acc[i][0], acc[i][1], acc[i][2], acc[i][3]};
    }
    __syncthreads();
#pragma unroll 1
    for (int rr = 0; rr < 8; ++rr) { const int t = F.wave * 8 + rr; const float v0 = VS[t * 128 + F.lane], v1 = VS[t * 128 + 64 + F.lane];
        const float r = rsqrtf(wave_sum(v0 * v0 + v1 * v1) * (1.f / 128.f) + EPS);
        const float* ggo = (const float*)a.in[I_GGO] + h * 128; const float* gr = (const float*)(ws + WS_GR) + (size_t)(row0 + t) * 512 + h * 128;
        bf16* mo = (bf16*)(ws + WS_MERGED) + (size_t)(row0 + t) * DM + 512 + h * 128;
        mo[F.lane] = (bf16)f2bf(v0 * r * ggo[F.lane] * silu(gr[F.lane])); mo[64 + F.lane] = (bf16)f2bf(v1 * r * ggo[64 + F.lane] * silu(gr[64 + F.lane])); }
    __syncthreads();
}

struct EpiSoftmaxP {
    static constexpr bool PERM = false, AFTER_DRAIN = true;
    const LAS unsigned long long* argp;
    __device__ __forceinline__ void fused(f32x4 (&acc)[2][2][4][2], const Unit&, int wr, int wc, int fr, int fq, PG8_LAS unsigned char* lds, int wid, int lane) const {
        LAS float* PM = (LAS float*)lds; LAS float* PS = PM + 1024;
        const int ub = (int)blockIdx.x; const int ldp = DM;
        bf16* P = (bf16*)((unsigned char*)ld_ptr(argp + N_INPUTS + 1) + WS_PC) + ((size_t)((ub >> 7) & 1) * SEQ + (ub & 31) * 256) * DM + ((ub >> 5) & 3) * 256;
        { int t2 = threadIdx.x; asm volatile("" : "+v"(t2)); fr = t2 & 15; fq = (t2 >> 4) & 3; }
#pragma unroll
        for (int ai = 0; ai < 2; ++ai)
#pragma unroll
            for (int m = 0; m < 4; ++m) { float mx = -INFINITY;
#pragma unroll
                for (int bj = 0; bj < 2; ++bj)
#pragma unroll
                    for (int n = 0; n < 2; ++n) { const f32x4 x = acc[ai][bj][m][n]; mx = fmaxf(mx, fmaxf(fmaxf(x[0], x[1]), fmaxf(x[2], x[3]))); }
                mx = fmaxf(mx, __shfl_xor(mx, 16)); mx = fmaxf(mx, __shfl_xor(mx, 32));
                if (fq == 0) PM[(ai * 128 + wr * 64 + m * 16 + fr) * 4 + wc] = mx; }
        asm volatile("s_waitcnt lgkmcnt(0)" ::: "memory"); __builtin_amdgcn_s_barrier(); asm volatile("" ::: "memory");
#pragma unroll
        for (int ai = 0; ai < 2; ++ai)
#pragma unroll
            for (int m = 0; m < 4; ++m) { const int r = ai * 128 + wr * 64 + m * 16 + fr; const f32x4 pm = *(const LAS f32x4*)(PM + r * 4);
                const float M = fmaxf(fmaxf(pm[0], pm[1]), fmaxf(pm[2], pm[3])); float s = 0.f;
#pragma unroll
                for (int bj = 0; bj < 2; ++bj)
#pragma unroll
                    for (int n = 0; n < 2; ++n) { f32x4 x = acc[ai][bj][m][n]; x[0] = fexp2(x[0] - M); x[1] = fexp2(x[1] - M); x[2] = fexp2(x[2] - M); x[3] = fexp2(x[3] - M); acc[ai][bj][m][n] = x; s += (x[0] + x[1]) + (x[2] + x[3]); }
                s += __shfl_xor(s, 16); s += __shfl_xor(s, 32);
                if (fq == 0) PS[r * 4 + wc] = s; }
        asm volatile("s_waitcnt lgkmcnt(0)" ::: "memory"); __builtin_amdgcn_s_barrier(); asm volatile("" ::: "memory");
#pragma unroll
        for (int ai = 0; ai < 2; ++ai)
#pragma unroll
            for (int m = 0; m < 4; ++m) { const int r = ai * 128 + wr * 64 + m * 16 + fr; const f32x4 ps = *(const LAS f32x4*)(PS + r * 4); const float inv = 1.f / ((ps[0] + ps[1]) + (ps[2] + ps[3]));
#pragma unroll
                for (int bj = 0; bj < 2; ++bj)
#pragma unroll
                    for (int n = 0; n < 2; ++n) { const f32x4 x = acc[ai][bj][m][n]; v2u o; o.x = pg8::cvt_pk_bf16(x[0] * inv, x[1] * inv); o.y = pg8::cvt_pk_bf16(x[2] * inv, x[3] * inv);
                        *(v2u*)(P + (size_t)r * ldp + bj * 128 + wc * 32 + n * 16 + fq * 4) = o; } }
        asm volatile("s_waitcnt lgkmcnt(0)" ::: "memory"); __builtin_amdgcn_s_barrier(); asm volatile("" ::: "memory");
    }
};

__device__ __forceinline__ void rms_rows_phase(const Frame& F, const float* X, const float* g, bf16* H) {
    const int gw = F.vcu * NWAVES + F.wave, NGW = F.G * NWAVES;
    for (int m = gw; m < TA; m += NGW) rms_row_bf16(X + (size_t)m * DM, g, H + (size_t)m * DM, F.lane);
}

__device__ __forceinline__ unsigned f2sort(float f) { const unsigned u = __builtin_bit_cast(unsigned, f); return u ^ ((u >> 31) ? 0xFFFFFFFFu : 0x80000000u); }
__device__ __forceinline__ float sort2f(unsigned s) { const unsigned u = s ^ ((s >> 31) ? 0x80000000u : 0xFFFFFFFFu); return __builtin_bit_cast(float, u); }
__device__ __forceinline__ float gelu_tanh(float x) { const float y = 0.7978845608028654f * (x + 0.044715f * x * x * x); const float e = __expf(2.f * y); return 0.5f * x * (1.f + (1.f - 2.f / (e + 1.f))); }
__device__ __forceinline__ unsigned gmax16(unsigned v) {
#pragma unroll
    for (int o = 1; o < 16; o <<= 1) { const unsigned t = (unsigned)__shfl_xor((int)v, o); v = v > t ? v : t; }
    return v;
}
typedef __bf16 bf16x2_t __attribute__((ext_vector_type(2)));
__device__ __forceinline__ float dot2bf(unsigned a, unsigned b, float c) {
#if __has_builtin(__builtin_amdgcn_fdot2_f32_bf16)
    return __builtin_amdgcn_fdot2_f32_bf16(__builtin_bit_cast(bf16x2_t, a), __builtin_bit_cast(bf16x2_t, b), c, false);
#else
    return c + bflo(a) * bflo(b) + bfhi(a) * bfhi(b);
#endif
}
__device__ __forceinline__ void peer_token(const Frame& F, const Args& a, int row, LAS unsigned* TOPS, int ci0, int cj0, int ci1, int cj1, int ci2, int cj2, int ci3, int cj3, bool cv3) {
    unsigned char* ws = a.ws; const int lane = F.lane, grp = lane >> 4, j16 = lane & 15;
    const float* sc = (const float*)(ws + WS_SC) + (size_t)row * 2048;
#pragma unroll 1
    for (int bt = 0; bt < 4; ++bt) {
        const f32x4 x0 = *(const f32x4*)(sc + (bt * 4 + grp) * 128 + 8 * j16), x1 = *(const f32x4*)(sc + (bt * 4 + grp) * 128 + 8 * j16 + 4);
        unsigned k[8]; const float xs[8] = {x0.x, x0.y, x0.z, x0.w, x1.x, x1.y, x1.z, x1.w};
#pragma unroll
        for (int e = 0; e < 8; ++e) k[e] = (f2sort(xs[e]) & ~127u) | (unsigned)(127 - (8 * j16 + e));
        unsigned mine = 0u;
#pragma unroll 1
        for (int r = 0; r < 16; ++r) {
            unsigned m = k[0];
#pragma unroll
            for (int e = 1; e < 8; ++e) m = m > k[e] ? m : k[e];
            m = gmax16(m);
            if (j16 == r) mine = m;
#pragma unroll
            for (int e = 0; e < 8; ++e) k[e] = (k[e] == m) ? 0u : k[e];
        }
        TOPS[(bt * 4 + grp) * 16 + j16] = mine;
    }
    int ex[2]; float gx[2], sux[2];
#pragma unroll
    for (int ps = 0; ps < 2; ++ps) {
        const int hd = ps * 4 + grp; const LAS unsigned* T1 = TOPS + (2 * hd) * 16; const LAS unsigned* T2 = T1 + 16;
        unsigned k[4];
        { const float s0 = sort2f(T1[ci0] & ~127u) + sort2f(T2[cj0] & ~127u), s1 = sort2f(T1[ci1] & ~127u) + sort2f(T2[cj1] & ~127u),
                      s2 = sort2f(T1[ci2] & ~127u) + sort2f(T2[cj2] & ~127u), s3 = sort2f(T1[ci3] & ~127u) + sort2f(T2[cj3] & ~127u);
          k[0] = (f2sort(s0) & ~127u) | (unsigned)(127 - j16); k[1] = (f2sort(s1) & ~127u) | (unsigned)(127 - (j16 + 16)); k[2] = (f2sort(s2) & ~127u) | (unsigned)(127 - (j16 + 32));
          k[3] = cv3 ? ((f2sort(s3) & ~127u) | (unsigned)(127 - (j16 + 48))) : 0u; }
        unsigned mine = 0u;
#pragma unroll 1
        for (int r = 0; r < 16; ++r) {
            unsigned m = k[0] > k[1] ? k[0] : k[1]; const unsigned m2 = k[2] > k[3] ? k[2] : k[3]; m = m > m2 ? m : m2;
            m = gmax16(m);
            if (j16 == r) mine = m;
#pragma unroll
            for (int e = 0; e < 4; ++e) k[e] = (k[e] == m) ? 0u : k[e];
        }
        const int c = 127 - (int)(mine & 127u);
        int ci, cj;
        if (c < 16) { ci = 0; cj = c; } else if (c < 24) { ci = 1; cj = c - 16; } else if (c < 29) { ci = 2; cj = c - 24; } else if (c < 33) { ci = 3; cj = c - 29; }
        else if (c < 36) { ci = 4; cj = c - 33; } else if (c < 38) { ci = 5; cj = c - 36; } else if (c < 40) { ci = 6; cj = c - 38; } else if (c < 42) { ci = 7; cj = c - 40; } else { ci = c - 34; cj = 0; }
        const int i1 = 127 - (int)(T1[ci] & 127u), i2 = 127 - (int)(T2[cj] & 127u);
        ex[ps] = i1 * 128 + i2;
        const float sv = sort2f(mine & ~127u); const float s0 = __shfl(sv, lane & 48);
        float ee = __expf(sv - s0); float es = ee;
#pragma unroll
        for (int o = 1; o < 16; o <<= 1) es += __shfl_xor(es, o);
        const float* rsc = (const float*)(ws + WS_MISC);
        sux[ps] = rsc[ex[ps]]; gx[ps] = ee / es * rsc[16384 + ex[ps]];
    }
    const float rstd2 = rsqrtf(((const float*)(ws + WS_SS))[TA + row] * (1.f / 1024.f) + EPS);
    float hf[16];
    { const v4u* hp = (const v4u*)((const bf16*)(ws + WS_HB) + (size_t)row * DM + 16 * lane); const v4u h0 = hp[0], h1 = hp[1];
#pragma unroll
      for (int q = 0; q < 4; ++q) { hf[2 * q] = bflo(h0[q]); hf[2 * q + 1] = bfhi(h0[q]); hf[8 + 2 * q] = bflo(h1[q]); hf[8 + 2 * q + 1] = bfhi(h1[q]); } }
    float oacc[16];
#pragma unroll
    for (int i = 0; i < 16; ++i) oacc[i] = 0.f;
    const unsigned char* U = ws + WS_U16; const unsigned char* V = ws + WS_V16;
    v4u ub[8], vb[8];
#pragma unroll
    for (int i = 0; i < 8; ++i) { const int e = __builtin_amdgcn_readlane(ex[0], i); ub[i] = *(const v4u*)(U + (size_t)e * DM + 16 * lane); }
#pragma unroll 1
    for (int g8 = 0; g8 < 16; ++g8) {
        const int kb = g8 * 8; const int exs = (kb < 64) ? ex[0] : ex[1]; const float gxs = (kb < 64) ? gx[0] : gx[1]; const float sus = (kb < 64) ? sux[0] : sux[1];
#pragma unroll
        for (int i = 0; i < 8; ++i) { const int e = __builtin_amdgcn_readlane(exs, (kb & 63) + i); vb[i] = *(const v4u*)(V + (size_t)e * DM + 16 * lane); }
        float av[8];
#pragma unroll
        for (int i = 0; i < 8; ++i) { float s = 0.f;
#pragma unroll
            for (int q = 0; q < 4; ++q) { const f32x2 lo = __builtin_amdgcn_cvt_pk_f32_fp8((int)ub[i][q], false), hi = __builtin_amdgcn_cvt_pk_f32_fp8((int)ub[i][q], true);
                s += lo.x * hf[4 * q]; s += lo.y * hf[4 * q + 1]; s += hi.x * hf[4 * q + 2]; s += hi.y * hf[4 * q + 3]; }
            av[i] = s; }
        const bool b5 = lane & 32, b4 = lane & 16, b3 = lane & 8;
        float bq[4], cq[2], dq;
#pragma unroll
        for (int i = 0; i < 4; ++i) bq[i] = (b5 ? av[4 + i] : av[i]) + __shfl_xor(b5 ? av[i] : av[4 + i], 32);
#pragma unroll
        for (int i = 0; i < 2; ++i) cq[i] = (b4 ? bq[2 + i] : bq[i]) + __shfl_xor(b4 ? bq[i] : bq[2 + i], 16);
        dq = (b3 ? cq[1] : cq[0]) + __shfl_xor(b3 ? cq[0] : cq[1], 8);
        dq += __shfl_xor(dq, 4); dq += __shfl_xor(dq, 2); dq += __shfl_xor(dq, 1);
        const int src = (kb & 63) + (lane >> 3);
#if defined(PROBE_NOPEER)
        const float wmine = 0.f * __shfl(gxs, src) * gelu_tanh(dq * __shfl(sus, src));
#else
        const float wmine = __shfl(gxs, src) * gelu_tanh(dq * __shfl(sus, src) * rstd2);
#endif
        if (g8 < 15) { const int kn = kb + 8; const int exn = (kn < 64) ? ex[0] : ex[1];
#pragma unroll
            for (int i = 0; i < 8; ++i) { const int e = __builtin_amdgcn_readlane(exn, (kn & 63) + i); ub[i] = *(const v4u*)(U + (size_t)e * DM + 16 * lane); } }
#pragma unroll
        for (int i = 0; i < 8; ++i) { const float w = __builtin_bit_cast(float, __builtin_amdgcn_readlane(__builtin_bit_cast(int, wmine), 8 * i));
#pragma unroll
            for (int q = 0; q < 4; ++q) { const f32x2 lo = __builtin_amdgcn_cvt_pk_f32_fp8((int)vb[i][q], false), hi = __builtin_amdgcn_cvt_pk_f32_fp8((int)vb[i][q], true);
                oacc[4 * q] += w * lo.x; oacc[4 * q + 1] += w * lo.y; oacc[4 * q + 2] += w * hi.x; oacc[4 * q + 3] += w * hi.y; } }
    }
    const f32x4* x2 = (const f32x4*)((const float*)(ws + WS_X2) + (size_t)row * DM + 16 * lane);
    f32x4 xv[4]; float ss = 0.f;
#pragma unroll
    for (int q = 0; q < 4; ++q) { xv[q] = x2[q]; xv[q].x += oacc[4 * q]; xv[q].y += oacc[4 * q + 1]; xv[q].z += oacc[4 * q + 2]; xv[q].w += oacc[4 * q + 3]; ss += (xv[q].x * xv[q].x + xv[q].y * xv[q].y) + (xv[q].z * xv[q].z + xv[q].w * xv[q].w); }
    const float r = rsqrtf(wave_sum(ss) * (1.f / DM) + EPS);
    const f32x4* gf = (const f32x4*)((const float*)a.in[I_GFIN] + 16 * lane);
    f32x4* y = (f32x4*)((row < TP ? a.out + O_YP + (size_t)row * DM : a.out + O_YS + (size_t)(row - TP) * DM) + 16 * lane);
#pragma unroll
    for (int q = 0; q < 4; ++q) { const f32x4 g4 = gf[q]; f32x4 o; o.x = xv[q].x * r * g4.x; o.y = xv[q].y * r * g4.y; o.z = xv[q].z * r * g4.z; o.w = xv[q].w * r * g4.w; y[q] = o; }
}
__device__ __forceinline__ void cand_ij(int c, int& ci, int& cj) {
    if (c < 16) { ci = 0; cj = c; } else if (c < 24) { ci = 1; cj = c - 16; } else if (c < 29) { ci = 2; cj = c - 24; } else if (c < 33) { ci = 3; cj = c - 29; }
    else if (c < 36) { ci = 4; cj = c - 33; } else if (c < 38) { ci = 5; cj = c - 36; } else if (c < 40) { ci = 6; cj = c - 38; } else if (c < 42) { ci = 7; cj = c - 40; } else if (c < 50) { ci = c - 34; cj = 0; } else { ci = 0; cj = 0; }
}
__device__ __forceinline__ void peer_phase(const Frame& F, const Args& a) {
    LAS unsigned* TOPS = (LAS unsigned*)F.lds + F.wave * 256;
    const int j16 = F.lane & 15; int ci0, cj0, ci1, cj1, ci2, cj2, ci3, cj3;
    cand_ij(j16, ci0, cj0); cand_ij(j16 + 16, ci1, cj1); cand_ij(j16 + 32, ci2, cj2); cand_ij(j16 + 48, ci3, cj3);
    const bool cv3 = (j16 + 48) < 50;
    const int gw = F.vcu * NWAVES + F.wave, NGW = F.G * NWAVES;
#pragma unroll 1
    for (int row = gw; row < TA; row += NGW) peer_token(F, a, row, TOPS, ci0, cj0, ci1, cj1, ci2, cj2, ci3, cj3, cv3);
}


#ifndef PH_MAX
#define PH_MAX 99
#endif
__global__ void __launch_bounds__(NTHR, 2) mega_fwd(Args args) {
    extern __shared__ __attribute__((aligned(16))) unsigned char lds_raw[];
    Frame F;
    F.lds = (LAS unsigned char*)lds_raw;
    F.tid = threadIdx.x; F.lane = F.tid & 63; F.wave = __builtin_amdgcn_readfirstlane(F.tid >> 6);
    F.G = gridDim.x; { const int bx = blockIdx.x; F.vcu = (F.G % 8 == 0) ? (bx % 8) * (F.G / 8) + bx / 8 : bx; }
    volatile LAS unsigned* MISC = (volatile LAS unsigned*)(F.lds + MISC_OFF);
    LAS unsigned long long* ARGP = (LAS unsigned long long*)(F.lds + ARGS_OFF);
    for (int u = F.tid; u < (LDS_BYTES - LDSCTL_OFF) / 4; u += NTHR) ((LAS unsigned*)(F.lds + LDSCTL_OFF))[u] = 0u;
    __syncthreads();
    if (F.tid == 0) {
        ARGP[0] = (unsigned long long)args.in[0];
        ARGP[1] = (unsigned long long)args.in[1];
        ARGP[2] = (unsigned long long)args.in[2];
        ARGP[3] = (unsigned long long)args.in[3];
        ARGP[4] = (unsigned long long)args.in[4];
        ARGP[5] = (unsigned long long)args.in[5];
        ARGP[6] = (unsigned long long)args.in[6];
        ARGP[7] = (unsigned long long)args.in[7];
        ARGP[8] = (unsigned long long)args.in[8];
        ARGP[9] = (unsigned long long)args.in[9];
        ARGP[10] = (unsigned long long)args.in[10];
        ARGP[11] = (unsigned long long)args.in[11];
        ARGP[12] = (unsigned long long)args.in[12];
        ARGP[13] = (unsigned long long)args.in[13];
        ARGP[14] = (unsigned long long)args.in[14];
        ARGP[15] = (unsigned long long)args.in[15];
        ARGP[16] = (unsigned long long)args.in[16];
        ARGP[17] = (unsigned long long)args.in[17];
        ARGP[18] = (unsigned long long)args.in[18];
        ARGP[19] = (unsigned long long)args.in[19];
        ARGP[20] = (unsigned long long)args.in[20];
        ARGP[21] = (unsigned long long)args.in[21];
        ARGP[22] = (unsigned long long)args.in[22];
        ARGP[23] = (unsigned long long)args.in[23];
        ARGP[24] = (unsigned long long)args.in[24];
        ARGP[25] = (unsigned long long)args.in[25];
        ARGP[26] = (unsigned long long)args.in[26];
        ARGP[27] = (unsigned long long)args.in[27];
        ARGP[28] = (unsigned long long)args.in[28];
        ARGP[N_INPUTS] = (unsigned long long)args.out; ARGP[N_INPUTS + 1] = (unsigned long long)args.ws;
    }
    __syncthreads();
    { const XcdBarrier bar0 = xcd_barrier_post((unsigned*)((gu32*)(args.ws + WS_CTL) + CW_BAR), MISC + 8); if (F.tid == 0) MISC[10] = bar0.x; }
    __syncthreads();
#define GRID_BAR() do { XcdBarrier bar_; bar_.bar = (unsigned*)((gu32*)((unsigned char*)ld_ptr(ARGP + N_INPUTS + 1) + WS_CTL) + CW_BAR); bar_.x = MISC[10]; bar_.st = MISC + 8; xcd_barrier(bar_); } while (0)
#define PHASE_ARGS const Args A = load_args(ARGP); unsigned char* const ws = A.ws; float* const out = A.out; (void)ws; (void)out; { int t_ = threadIdx.x; asm volatile("" : "+v"(t_)); F.tid = t_; F.lane = t_ & 63; }

    { PHASE_ARGS;
    p0_prologue(F, A);
    }
    GRID_BAR();
#if PH_MAX >= 1
    { PHASE_ARGS;
    {
        pg8::Gemm g{(const bf16*)(ws + WS_HB), (const bf16*)(ws + WS_WIN), DM, DM, DM};
        pg8::StaticOrder S; S.init(TA, N_IN, F.G, (int)blockIdx.x);
        EpiInProj E{out, ws, (const float*)A.in[I_BFF]};
        pg8::gemm_phase(F.lds, g, S, E);
    }
    {
        const int off = (TA / 256) * (N_IN / 256) % F.G;
        pg8::Gemm g{(const bf16*)(ws + WS_MB), (const bf16*)(ws + WS_WMK), DM, DM, DM};
        pg8::StaticOrder S; S.init(512, DM, F.G, ((int)blockIdx.x + F.G - off) % F.G);
        EpiGen E{out + O_MKP, DM, (bf16*)(ws + WS_MK16), DM, 1.f, nullptr, nullptr, 0, 0, nullptr, nullptr, nullptr};
        pg8::gemm_phase(F.lds, g, S, E);
    }
    {
        const int off = ((TA / 256) * (N_IN / 256) + 8) % F.G;
        pg8::Gemm g{(const bf16*)(ws + WS_MB), (const bf16*)(ws + WS_WMV), DM, DM, DM};
        pg8::StaticOrder S; S.init(512, DM, F.G, ((int)blockIdx.x + F.G - off) % F.G);
        EpiGen E{out + O_MVP, DM, nullptr, 0, 1.f, nullptr, nullptr, 0, 0, nullptr, nullptr, nullptr};
        pg8::gemm_phase(F.lds, g, S, E);
    }
    {
        const int off = ((TA / 256) * (N_IN / 256) + 16) % F.G;
        pg8::Gemm g{(const bf16*)(ws + WS_WMV), (const bf16*)(ws + WS_MB), DM, DM, DM};
        pg8::StaticOrder S; S.init(DM, 512, F.G, ((int)blockIdx.x + F.G - off) % F.G);
        EpiGen E{nullptr, 0, (bf16*)(ws + WS_MVT16), 512, 1.f, nullptr, nullptr, 0, 0, nullptr, nullptr, nullptr};
        pg8::gemm_phase(F.lds, g, S, E);
    }
    }
    GRID_BAR();
#endif
#if PH_MAX >= 2
    asm volatile("; ===PHASE 2===");
    { PHASE_ARGS;
    {
        const int gw = F.vcu * NWAVES + F.wave, NGW = F.G * NWAVES;
        for (int it = gw; it < 512; it += NGW) fox_norms_item(F, (const bf16*)(ws + WS_QF), (const bf16*)(ws + WS_KF), out + O_LFP, (float*)(ws + WS_MISC + MiB), (float*)(ws + WS_KBIAS), (float*)(ws + WS_MISC + MiB + 65536), it);
        for (int it = gw; it < NB_S * NPAGES; it += NGW) fox_suffix_item(F, (const float*)A.in[I_CFL], (const int*)A.in[I_PT], (float*)(ws + WS_SUF), (float*)(ws + WS_MISC + 2 * MiB), it);
        for (int u = F.vcu; u < 1024; u += F.G) gla_g1_unit(F, A, u);
        for (int u = F.vcu; u < 512; u += F.G) gla_sample_unit(F, A, u);
    }
    }
    GRID_BAR();
#endif
#if PH_MAX >= 3
    asm volatile("; ===PHASE 3===");
    { PHASE_ARGS;
    gla_scan(F, A);
    __syncthreads();
    for (int i = F.vcu; i < 256; i += F.G) { const int bh = i >> 4, s = i & 15;
        fox_attn_unit(F, (const bf16*)(ws + WS_QF), (const bf16*)(ws + WS_KF), (const bf16*)(ws + WS_VF), (const float*)(ws + WS_KBIAS), (const float*)(ws + WS_MISC + MiB + 65536), (const float*)(ws + WS_MISC + MiB), (bf16*)(ws + WS_MERGED), bh >> 3, bh & 7, s);
        fox_attn_unit(F, (const bf16*)(ws + WS_QF), (const bf16*)(ws + WS_KF), (const bf16*)(ws + WS_VF), (const float*)(ws + WS_KBIAS), (const float*)(ws + WS_MISC + MiB + 65536), (const float*)(ws + WS_MISC + MiB), (bf16*)(ws + WS_MERGED), bh >> 3, bh & 7, 31 - s); }
    for (int u = F.vcu; u < 1024; u += F.G) fox_sample_unit(F, A, u);
    }
    GRID_BAR();
#endif
#if PH_MAX >= 4
    asm volatile("; ===PHASE 4===");
    { PHASE_ARGS;
    for (int u = F.vcu; u < 1024; u += F.G) gla_g3_unit(F, A, u);
    }
    GRID_BAR();
#endif
#if PH_MAX >= 5
    asm volatile("; ===PHASE 5===");
    { PHASE_ARGS;
    {
        pg8::Gemm g{(const bf16*)(ws + WS_MERGED), (const bf16*)(ws + WS_WOUT), DM, DM, DM};
        pg8::StaticOrder S; S.init(TA, DM, F.G, (int)blockIdx.x);
        EpiGen E{(float*)(ws + WS_X1), DM, (bf16*)(ws + WS_HB), DM, 1.f, (const float*)A.in[I_XP], (const float*)A.in[I_XS], TP, DM, (const float*)A.in[I_GCROSS], (float*)(ws + WS_SS), nullptr};
        pg8::gemm_phase(F.lds, g, S, E);
    }
    }
    GRID_BAR();
#endif
#if PH_MAX >= 7
    asm volatile("; ===PHASE 7===");
    { PHASE_ARGS;
    {
        pg8::Gemm g{(const bf16*)(ws + WS_HB), (const bf16*)(ws + WS_WCQ), DM, DM, DM};
        pg8::StaticOrder S; S.init(TA, DM, F.G, (int)blockIdx.x);
        EpiGen E{nullptr, 0, (bf16*)(ws + WS_QC), DM, C2C, nullptr, nullptr, 0, 0, nullptr, nullptr, (const float*)(ws + WS_SS)};
        pg8::gemm_phase(F.lds, g, S, E);
    }
    }
    GRID_BAR();
#endif
#if PH_MAX >= 8
    asm volatile("; ===PHASE 8===");
    { PHASE_ARGS;
    {
        const int u = (int)blockIdx.x, b = (u >> 7) & 1, h = (u >> 5) & 3, pnl = u & 31;
        const size_t roff = ((size_t)b * SEQ + pnl * 256) * DM + h * 256;
        pg8::Gemm g{(const bf16*)(ws + WS_QC) + roff, (const bf16*)(ws + WS_MK16) + (size_t)(b * 256) * DM + h * 256, DM, DM, 256};
        pg8::SingleUnit S{u < 256 ? 1 : 0, {0, 0}};
        EpiSoftmaxP E{ARGP};
        pg8::gemm_phase(F.lds, g, S, E);
        VM_WAIT(); __syncthreads();
        {
            pg8::Gemm g2{(const bf16*)(ws + WS_PC) + roff, (const bf16*)(ws + WS_MVT16) + (size_t)(h * 256) * 512 + b * 256, DM, 512, 256};
            EpiGen E2{nullptr, 0, (bf16*)(ws + WS_OC) + roff, DM, 1.f, nullptr, nullptr, 0, 0, nullptr, nullptr, nullptr};
            pg8::gemm_phase(F.lds, g2, S, E2);
        }
        __syncthreads();
        for (int v = F.vcu; v < 512; v += F.G) cross_sample_unit(F, A, v);
    }
    }
    GRID_BAR();
#endif
#if PH_MAX >= 10
    asm volatile("; ===PHASE 10===");
    { PHASE_ARGS;
    {
        pg8::Gemm g{(const bf16*)(ws + WS_OC), (const bf16*)(ws + WS_WCO), DM, DM, DM};
        pg8::StaticOrder S; S.init(TA, DM, F.G, (int)blockIdx.x);
        EpiGen E{(float*)(ws + WS_X2), DM, (bf16*)(ws + WS_HB), DM, 1.f, (const float*)(ws + WS_X1), (const float*)(ws + WS_X1), TA, DM, (const float*)A.in[I_GFFN], (float*)(ws + WS_SS) + TA, nullptr};
        pg8::gemm_phase(F.lds, g, S, E);
    }
    }
    GRID_BAR();
#endif
#if PH_MAX >= 12
    asm volatile("; ===PHASE 12===");
    { PHASE_ARGS;
    {
        pg8::Gemm g{(const bf16*)(ws + WS_HB), (const bf16*)(ws + WS_WPK), DM, DM, DM};
        pg8::StaticOrder S; S.init(TA, 2048, F.G, (int)blockIdx.x);
        EpiGen E{(float*)(ws + WS_SC), 2048, nullptr, 0, 1.f, nullptr, nullptr, 0, 0, nullptr, nullptr, (const float*)(ws + WS_SS) + TA};
        pg8::gemm_phase(F.lds, g, S, E);
    }
    }
    GRID_BAR();
#endif
#if PH_MAX >= 13
    asm volatile("; ===PHASE 13===");
    { PHASE_ARGS;
    peer_phase(F, A);
    }
#endif
#if PH_MAX < 13
    {   PHASE_ARGS;
        const int gw = F.vcu * NWAVES + F.wave, NGW = F.G * NWAVES;
        for (int m = gw; m < TA; m += NGW) {
            const float* x = m < TP ? (const float*)A.in[I_XP] + (size_t)m * DM : (const float*)A.in[I_XS] + (size_t)(m - TP) * DM;
            float* y = m < TP ? out + O_YP + (size_t)m * DM : out + O_YS + (size_t)(m - TP) * DM;
            for (int j = 0; j < 4; ++j) ((f32x4*)y)[F.lane + 64 * j] = ((const f32x4*)x)[F.lane + 64 * j];
        }
    }
#endif

}

extern "C" void kernel_launch(void* const* d_in, const int* in_sizes, int n_in, void* d_out, int out_size, void* d_ws, size_t ws_size, hipStream_t stream) {
    static int grid = 0;
    if (grid == 0) {
        if (n_in != N_INPUTS || (size_t)out_size != O_TOTAL || ws_size < WS_END) { fprintf(stderr, "kernel_launch: unexpected shapes (n_in %d out %d ws %zu)\n", n_in, out_size, ws_size); grid = -1; return; }
        int dev = 0, cus = 0, per_cu = 0;
        if (hipGetDevice(&dev) != hipSuccess || hipDeviceGetAttribute(&cus, hipDeviceAttributeMultiprocessorCount, dev) != hipSuccess) { grid = -1; return; }
        if (hipFuncSetAttribute((const void*)mega_fwd, hipFuncAttributeMaxDynamicSharedMemorySize, LDS_BYTES) != hipSuccess) { fprintf(stderr, "kernel_launch: hipFuncSetAttribute failed\n"); grid = -1; return; }
        if (hipOccupancyMaxActiveBlocksPerMultiprocessor(&per_cu, (const void*)mega_fwd, NTHR, LDS_BYTES) != hipSuccess || per_cu < 1)
            fprintf(stderr, "kernel_launch: occupancy query reports %d workgroups per CU\n", per_cu);
        (void)hipGetLastError();
        grid = cus;
        if (grid > 256) grid = 256;
    }
    if (grid < 0) return;
    if (hipMemsetAsync((char*)d_ws + WS_CTL, 0, CTL_ZERO_BYTES, stream) != hipSuccess) return;
    Args a{};
    for (int i = 0; i < N_INPUTS; ++i) a.in[i] = d_in[i];
    a.out = (float*)d_out; a.ws = (unsigned char*)d_ws;
    hipLaunchKernelGGL(mega_fwd, dim3(grid), dim3(NTHR), LDS_BYTES, stream, a);
    const hipError_t le = hipPeekAtLastError();
    if (le != hipSuccess) fprintf(stderr, "kernel_launch: launch failed: %s\n", hipGetErrorName(le));
}
```

```cpp
#define PH_MAX 13
#include <hip/hip_runtime.h>
#include <cstdio>
#include <cstdint>

namespace pg8 {
#define PG8_LAS __attribute__((address_space(3)))
typedef unsigned short bf16_t;
typedef short bf16x8 __attribute__((ext_vector_type(8)));
typedef float f32x4 __attribute__((ext_vector_type(4)));
typedef unsigned u32x4 __attribute__((ext_vector_type(4)));
typedef unsigned u32x2 __attribute__((ext_vector_type(2)));
constexpr int BM = 256, BK = 64, HALF = 128, HTB = HALF * BK * 2  , STAGE_BYTES = 8 * HTB, NXCD = 8, WGM = 8;

__host__ __device__ __forceinline__ int lds_byte(int r, int c) { const int st = (r >> 4) * 2 + (c >> 5), rr = r & 15, cc = c & 31, ob = rr * 64 + cc * 2; return st * 1024 + (ob ^ (((ob >> 9) & 1) << 5)); }
__host__ __device__ __forceinline__ void stage_rc(int b, int& R, int& C) { const int st = b / 1024, sb = b % 1024, swz = sb ^ (((sb >> 9) & 1) << 5); R = (st >> 1) * 16 + swz / 64; C = (st & 1) * 32 + (swz % 64) / 2; }

struct Unit { int pm, pn; };
struct Gemm { const bf16_t* A; const bf16_t* Bt; int lda, ldb, K; };

struct StaticOrder {
    int nM, nN, nwg, G, c;
    __host__ __device__ void init(int M, int N, int G_, int c_) { nM = M / BM; nN = N / BM; nwg = nM * nN; G = G_; c = c_; }
    __host__ __device__ bool next(int i, Unit& u) const {
        const long L = (long)i * G + c; if (L >= nwg) return false;
        int wgid = (int)L; { const int q = nwg / NXCD, r = nwg % NXCD, xcd = wgid % NXCD, off = wgid / NXCD; wgid = (xcd < r ? xcd * (q + 1) : r * (q + 1) + (xcd - r) * q) + off; }
        const int nig = WGM * nN, gid = wgid / nig, fm = gid * WGM, gsz = (nM - fm) < WGM ? (nM - fm) : WGM;
        u.pm = fm + ((wgid % nig) % gsz); u.pn = (wgid % nig) / gsz; return true;
    }
};
struct SingleUnit {
    int has; Unit u0;
    __host__ __device__ bool next(int i, Unit& u) const { if (i != 0 || !has) return false; u = u0; return true; }
};

__device__ __forceinline__ unsigned cvt_pk_bf16(float lo, float hi) { unsigned r; asm volatile("v_cvt_pk_bf16_f32 %0, %1, %2" : "=v"(r) : "v"(lo), "v"(hi)); return r; }

template <class Epi, class Sched>
__device__ __forceinline__ void gemm_phase(PG8_LAS unsigned char* lds, const Gemm g, const Sched& S, const Epi& E) {
    int tid = threadIdx.x; asm volatile("" : "+v"(tid));
    const int wid = __builtin_amdgcn_readfirstlane(tid >> 6), lane = tid & 63, wr = wid >> 2, wc = wid & 3, fr = lane & 15, fq = lane >> 4;
    const int K = g.K, nt = K / BK;
    unsigned voffA[2], voffB[2];
#pragma unroll
    for (int i = 0; i < 2; ++i) { int R, C; stage_rc(tid * 16 + i * 8192, R, C);
        voffA[i] = (unsigned)(R * g.lda + C) * 2u; voffB[i] = (unsigned)(R * g.ldb + C) * 2u; }
    const size_t kstep = (size_t)(BK * 2);
    const size_t hstepA = (size_t)HALF * g.lda * 2, hstepB = (size_t)HALF * g.ldb * 2;
    const size_t tstepA = 2 * hstepA, tstepB = 2 * hstepB;
    const unsigned ldsw = (unsigned)wid * 1024u;
    const int aoff = lds_byte(wr * 64 + fr, fq * 8), boff = lds_byte(wc * 32 + fr, fq * 8);
#define PG8_SA(b, h) (((b) * 2 + (h)) * HTB)
#define PG8_SB(b, h) ((4 + (b) * 2 + (h)) * HTB)
#define PG8_STAGE(bufoff, gbase, voff) do { _Pragma("unroll") for (int _i = 0; _i < 2; ++_i) \
        __builtin_amdgcn_global_load_lds((const unsigned*)((const char*)(gbase) + (voff)[_i]), (PG8_LAS unsigned*)(lds + (bufoff) + ldsw + _i * 8192), 16, 0, 0); } while (0)
#define PG8_LDA(dst, b, h) do { _Pragma("unroll") for (int m = 0; m < 4; ++m) _Pragma("unroll") for (int k = 0; k < 2; ++k) dst[m][k] = *(const PG8_LAS bf16x8*)(lds + PG8_SA(b, h) + aoff + m * 2048 + k * 1024); } while (0)
#define PG8_LDB(dst, b, h) do { _Pragma("unroll") for (int n = 0; n < 2; ++n) _Pragma("unroll") for (int k = 0; k < 2; ++k) dst[n][k] = *(const PG8_LAS bf16x8*)(lds + PG8_SB(b, h) + boff + n * 2048 + k * 1024); } while (0)
#define PG8_MMA(ai, bj, At, Bt) do { __builtin_amdgcn_s_setprio(1); _Pragma("unroll") for (int m = 0; m < 4; ++m) _Pragma("unroll") for (int n = 0; n < 2; ++n) _Pragma("unroll") for (int k = 0; k < 2; ++k) \
        acc[ai][bj][m][n] = __builtin_amdgcn_mfma_f32_16x16x32_bf16(Bt[n][k], At[m][k], acc[ai][bj][m][n], 0, 0, 0); __builtin_amdgcn_s_setprio(0); } while (0)
#define PG8_WAIT_V(n) asm volatile("s_waitcnt vmcnt(" #n ")" ::: "memory")
#define PG8_WAIT_L(n) asm volatile("s_waitcnt lgkmcnt(" #n ")" ::: "memory")
#define PG8_BAR __builtin_amdgcn_s_barrier()
#define PG8_SCHED __builtin_amdgcn_sched_barrier(0)
    Unit cur, nxt; int ui = 0;
    if (!S.next(0, cur)) return;
    f32x4 acc[2][2][4][2];
#pragma unroll
    for (int a = 0; a < 2; ++a)
#pragma unroll
        for (int b = 0; b < 2; ++b)
#pragma unroll
            for (int m = 0; m < 4; ++m)
#pragma unroll
                for (int n = 0; n < 2; ++n) acc[a][b][m][n] = (f32x4){0.f, 0.f, 0.f, 0.f};
    bf16x8 At[4][2], B0[2][2], B1[2][2];
    const char* cA = (const char*)g.A + (size_t)cur.pm * tstepA; const char* cB = (const char*)g.Bt + (size_t)cur.pn * tstepB;
    PG8_STAGE(PG8_SB(0, 0), cB, voffB); PG8_STAGE(PG8_SB(0, 1), cB + hstepB, voffB); PG8_STAGE(PG8_SA(0, 0), cA, voffA); PG8_STAGE(PG8_SA(0, 1), cA + hstepA, voffA);
    if (wr == 1) PG8_BAR;
    PG8_WAIT_V(2); PG8_BAR;
    PG8_STAGE(PG8_SB(1, 0), cB + kstep, voffB); PG8_STAGE(PG8_SA(1, 0), cA + kstep, voffA); PG8_STAGE(PG8_SB(1, 1), cB + hstepB + kstep, voffB);
    PG8_WAIT_V(6); PG8_BAR;
    for (;;) {
        const bool has_next = S.next(ui + 1, nxt);
        const char* nA = has_next ? (const char*)g.A + (size_t)nxt.pm * tstepA : cA; const char* nB = has_next ? (const char*)g.Bt + (size_t)nxt.pn * tstepB : cB;
        for (int t = 0; t < nt; t += 2) {
            const bool last = (t == nt - 2);
            const char* a1 = cA + (size_t)(t + 1) * kstep;
            const char* a2 = last ? nA : cA + (size_t)(t + 2) * kstep; const char* b2 = last ? nB : cB + (size_t)(t + 2) * kstep;
            const char* a3 = a2 + kstep; const char* b3 = b2 + kstep;
            PG8_LDB(B0, 0, 0); PG8_LDB(B1, 0, 1); PG8_SCHED; PG8_LDA(At, 0, 0); PG8_STAGE(PG8_SA(1, 1), a1 + hstepA, voffA);
            PG8_WAIT_V(8); PG8_WAIT_L(0); PG8_BAR; PG8_MMA(0, 0, At, B0); PG8_MMA(0, 1, At, B1); PG8_BAR; PG8_SCHED;
            PG8_LDA(At, 0, 1); PG8_STAGE(PG8_SB(0, 0), b2, voffB); PG8_STAGE(PG8_SB(0, 1), b2 + hstepB, voffB); PG8_STAGE(PG8_SA(0, 0), a2, voffA);
            PG8_WAIT_V(8); PG8_WAIT_L(0); PG8_BAR; PG8_MMA(1, 0, At, B0); PG8_MMA(1, 1, At, B1); PG8_BAR; PG8_SCHED;
            PG8_LDB(B0, 1, 0); PG8_LDB(B1, 1, 1); PG8_SCHED; PG8_LDA(At, 1, 0); PG8_STAGE(PG8_SA(0, 1), a2 + hstepA, voffA);
            PG8_WAIT_V(8); PG8_WAIT_L(0); PG8_BAR; PG8_MMA(0, 0, At, B0); PG8_MMA(0, 1, At, B1); PG8_BAR; PG8_SCHED;
            PG8_LDA(At, 1, 1); PG8_STAGE(PG8_SB(1, 0), b3, voffB); PG8_STAGE(PG8_SB(1, 1), b3 + hstepB, voffB); PG8_STAGE(PG8_SA(1, 0), a3, voffA);
            PG8_WAIT_V(8); PG8_WAIT_L(0); PG8_BAR; PG8_MMA(1, 0, At, B0); PG8_MMA(1, 1, At, B1); PG8_BAR; PG8_SCHED;
        }
        if (wr == 0) PG8_BAR;
        if constexpr (!Epi::AFTER_DRAIN) { E(acc, cur, wr, wc, fr, fq); }
        if (!has_next) break;
#pragma unroll
        for (int a = 0; a < 2; ++a)
#pragma unroll
            for (int b = 0; b < 2; ++b)
#pragma unroll
                for (int m = 0; m < 4; ++m)
#pragma unroll
                    for (int n = 0; n < 2; ++n) acc[a][b][m][n] = (f32x4){0.f, 0.f, 0.f, 0.f};
        cur = nxt; cA = nA; cB = nB; ++ui;
        if (wr == 1) PG8_BAR;
    }
    PG8_WAIT_V(0);
    PG8_BAR;
    if constexpr (Epi::AFTER_DRAIN) { E.fused(acc, cur, wr, wc, fr, fq, lds, wid, lane); }
#undef PG8_SA
#undef PG8_SB
#undef PG8_STAGE
#undef PG8_LDA
#undef PG8_LDB
#undef PG8_MMA
#undef PG8_WAIT_V
#undef PG8_WAIT_L
#undef PG8_BAR
#undef PG8_SCHED
}
}

#define GAS __attribute__((address_space(1)))
#define LAS __attribute__((address_space(3)))
typedef unsigned short bf16;
typedef unsigned v4u __attribute__((ext_vector_type(4)));
typedef unsigned v2u __attribute__((ext_vector_type(2)));
typedef float f32x4 __attribute__((ext_vector_type(4)));
typedef float f32x2 __attribute__((ext_vector_type(2)));
typedef float f32x16 __attribute__((ext_vector_type(16)));
typedef short bf16x8 __attribute__((ext_vector_type(8)));
typedef short s16x4 __attribute__((ext_vector_type(4)));
typedef GAS unsigned gu32;
#define RLX_AGENT __ATOMIC_RELAXED, __HIP_MEMORY_SCOPE_AGENT
#define LDS_WAIT() asm volatile("s_waitcnt lgkmcnt(0)" ::: "memory")
#define VM_WAIT() asm volatile("s_waitcnt vmcnt(0)" ::: "memory")
__device__ __forceinline__ unsigned f2bf(float f) { unsigned u = __builtin_bit_cast(unsigned, f); return (u + 0x7fffu + ((u >> 16) & 1u)) >> 16; }
__device__ __forceinline__ unsigned pk2(float lo, float hi) { return f2bf(lo) | (f2bf(hi) << 16); }
__device__ __forceinline__ float bf2f(unsigned short b) { return __builtin_bit_cast(float, (unsigned)b << 16); }
__device__ __forceinline__ float bflo(unsigned u) { return __builtin_bit_cast(float, u << 16); }
__device__ __forceinline__ float bfhi(unsigned u) { return __builtin_bit_cast(float, u & 0xffff0000u); }

#define XB_TMO      128
#define XB_XCNT(j)  (256  + 64 * (j))
#define XB_XSUB(j)  (1280 + 64 * (j))
#define XB_XGEN(j)  (2304 + 64 * (j))
#define XB_TOP      3328
#define XB_TOPGEN   3392
#define XCD_BAR_WORDS 3456
#define XB_SPIN_CAP (1u << 18)

__device__ __forceinline__ unsigned xb_ld(unsigned* p)              { return __hip_atomic_load(p, __ATOMIC_RELAXED, __HIP_MEMORY_SCOPE_AGENT); }
__device__ __forceinline__ unsigned xb_add(unsigned* p, unsigned v) { return __hip_atomic_fetch_add(p, v, __ATOMIC_RELAXED, __HIP_MEMORY_SCOPE_AGENT); }
__device__ __forceinline__ unsigned xb_xcc_id() { return (unsigned)__builtin_amdgcn_s_getreg((3 << 11) | 20) & 0xFu; }
#define XB_SPIN(cond, bar) do { unsigned _sp = 0; while (cond) { __builtin_amdgcn_s_sleep(1); \
    if ((++_sp & 255u) == 0u) { if (xb_ld(&(bar)[XB_TMO])) break; if (_sp > XB_SPIN_CAP) { atomicAdd(&(bar)[XB_TMO], 1u); break; } } } } while (0)

struct XcdBarrier {
    unsigned* bar; unsigned x;
    volatile LAS unsigned* st;
};

__device__ __forceinline__ XcdBarrier xcd_barrier_post(unsigned* bar, volatile LAS unsigned* st) {
    XcdBarrier b; b.bar = bar; b.x = xb_xcc_id(); b.st = st;
    if (threadIdx.x == 0) (void)xb_add(&bar[XB_XCNT(b.x)], 1u);
    return b;
}
__device__ __forceinline__ void xcd_barrier_complete(unsigned* bar, unsigned x, unsigned& nloc, unsigned& nx) {
    const unsigned G = gridDim.x * gridDim.y * gridDim.z;
    unsigned sum, cnt, mine, sp = 0u;
    for (;;) {
        sum = 0u; cnt = 0u; mine = 0u;
#pragma unroll
        for (unsigned j = 0; j < 16; ++j) { const unsigned c = xb_ld(&bar[XB_XCNT(j)]); sum += c; cnt += (c > 0u) ? 1u : 0u; mine = (j == x) ? c : mine; }
        if (sum == G) break;
        __builtin_amdgcn_s_sleep(1);
        if ((++sp & 255u) == 0u) { if (xb_ld(&bar[XB_TMO])) break; if (sp > XB_SPIN_CAP) { atomicAdd(&bar[XB_TMO], 1u); break; } }
    }
    nloc = mine > 0u ? mine : 1u; nx = cnt > 0u ? cnt : 1u;
}

__device__ __forceinline__ void xcd_barrier(const XcdBarrier& b) {
    asm volatile("s_waitcnt vmcnt(0)" ::: "memory");
    __syncthreads();
    if (threadIdx.x == 0) {
        unsigned* bar = b.bar;
        __builtin_amdgcn_s_waitcnt(0);
        unsigned nloc = b.st[0], nx = b.st[1];
        if (nloc == 0u) { xcd_barrier_complete(bar, b.x, nloc, nx); b.st[0] = nloc; b.st[1] = nx; }
        const unsigned old = xb_add(&bar[XB_XSUB(b.x)], 1u);
        const unsigned gen = old / nloc;
        if (old + 1u == (gen + 1u) * nloc) {
            __builtin_amdgcn_fence(__ATOMIC_RELEASE, "agent");
            asm volatile("s_waitcnt vmcnt(0)" ::: "memory");
            const unsigned og = xb_add(&bar[XB_TOP], 1u);
            const unsigned tg = og / nx;
            if (og + 1u == (tg + 1u) * nx) xb_add(&bar[XB_TOPGEN], 1u);
            else XB_SPIN(xb_ld(&bar[XB_TOPGEN]) == tg, bar);
            __builtin_amdgcn_fence(__ATOMIC_ACQUIRE, "agent");
            xb_add(&bar[XB_XGEN(b.x)], 1u);
            asm volatile("s_waitcnt vmcnt(0)" ::: "memory");
        } else {
            XB_SPIN(xb_ld(&bar[XB_XGEN(b.x)]) == gen, bar);
            __builtin_amdgcn_fence(__ATOMIC_ACQUIRE, "agent");
            asm volatile("s_waitcnt vmcnt(0)" ::: "memory");
        }
    }
    __syncthreads();
}


constexpr int NWAVES = 8, NTHR = 512;
constexpr int DM = 1024, TP = 16384, TS = 1024, TA = TP + TS, SEQ = 8192, NB_P = 2, NB_S = 128, LS = 8;
constexpr int N_IN = 3328;
constexpr int PASTL = 2048, PAGE = 128, NPAGES = 16;
constexpr float EPS = 1e-6f;
constexpr float LOG2E = 1.4426950408889634f;
constexpr float C2F = 0.125f * LOG2E;
constexpr float C2C = 0.0625f * LOG2E;

enum { I_XP = 0, I_XS, I_CFK, I_CFV, I_CFL, I_SGLA, I_CMK, I_CMV, I_PT, I_MEMP, I_GMIX, I_WIN, I_BFF, I_WG2, I_BG, I_GGO, I_WOUT, I_GCROSS, I_GMEM,
       I_WMK, I_WMV, I_WCQ, I_WCO, I_GFFN, I_PWQ, I_PSK, I_PU, I_PV, I_GFIN, N_INPUTS };
constexpr size_t O_YP = 0, O_YS = 16777216, O_FKP = 17825792, O_FVP = 26214400, O_LFP = 34603008, O_GSP = 34734080, O_MKP = 34799616, O_MVP = 35323904,
                 O_FKS = 35848192, O_FVS = 36372480, O_LFS = 36896768, O_GSS = 36904960, O_TOTAL = 41099264;

constexpr size_t MiB = 1u << 20;
constexpr size_t WS_CTL = 0, CTL_ZERO_BYTES = 1 * MiB;
constexpr size_t WS_WIN = 2 * MiB, WS_WOUT = 10 * MiB, WS_WMK = 12 * MiB, WS_WMV = 14 * MiB, WS_WCQ = 16 * MiB, WS_WCO = 18 * MiB, WS_WPK = 20 * MiB;
constexpr size_t WS_MB = 24 * MiB, WS_MK16 = 25 * MiB, WS_MVT16 = 26 * MiB, WS_KBIAS = 27 * MiB, WS_GDEC = 28 * MiB, WS_GG = 29 * MiB;
constexpr size_t WS_U16 = 32 * MiB, WS_V16 = 64 * MiB, WS_HB = 96 * MiB, WS_QF = 132 * MiB, WS_KF = 150 * MiB, WS_VF = 168 * MiB;
constexpr size_t WS_GQ = 186 * MiB, WS_GK = 204 * MiB, WS_GV = 222 * MiB, WS_GR = 256 * MiB, WS_SUF = 290 * MiB, WS_GKV = 298 * MiB;
constexpr size_t WS_MERGED = 330 * MiB, WS_X1 = 364 * MiB, WS_X2 = 432 * MiB, WS_QC = 500 * MiB, WS_PC = 534 * MiB, WS_OC = 566 * MiB, WS_SC = 600 * MiB;
constexpr size_t WS_MISC = 736 * MiB, WS_SS = 740 * MiB  , WS_BB = 744 * MiB, WS_END = 800 * MiB;
constexpr int CW_BAR = 4096;

constexpr int RING_BYTES = 131072;
constexpr int LDSCTL_OFF = RING_BYTES, MISC_OFF = LDSCTL_OFF + 320;
constexpr int ARGS_OFF = MISC_OFF + 128;
constexpr int LDS_BYTES = 147456;

struct Args { const void* in[N_INPUTS]; float* out; unsigned char* ws; };

__device__ __forceinline__ const void* ld_ptr(const LAS unsigned long long* p) { const unsigned long long v = *p; const unsigned lo = __builtin_amdgcn_readfirstlane((unsigned)v), hi = __builtin_amdgcn_readfirstlane((unsigned)(v >> 32)); return (const void*)(const GAS char*)(((unsigned long long)hi << 32) | lo); }
__device__ __forceinline__ Args load_args(const LAS unsigned long long* ARGP) { Args A;
    A.in[0] = ld_ptr(ARGP + 0);
    A.in[1] = ld_ptr(ARGP + 1);
    A.in[2] = ld_ptr(ARGP + 2);
    A.in[3] = ld_ptr(ARGP + 3);
    A.in[4] = ld_ptr(ARGP + 4);
    A.in[5] = ld_ptr(ARGP + 5);
    A.in[6] = ld_ptr(ARGP + 6);
    A.in[7] = ld_ptr(ARGP + 7);
    A.in[8] = ld_ptr(ARGP + 8);
    A.in[9] = ld_ptr(ARGP + 9);
    A.in[10] = ld_ptr(ARGP + 10);
    A.in[11] = ld_ptr(ARGP + 11);
    A.in[12] = ld_ptr(ARGP + 12);
    A.in[13] = ld_ptr(ARGP + 13);
    A.in[14] = ld_ptr(ARGP + 14);
    A.in[15] = ld_ptr(ARGP + 15);
    A.in[16] = ld_ptr(ARGP + 16);
    A.in[17] = ld_ptr(ARGP + 17);
    A.in[18] = ld_ptr(ARGP + 18);
    A.in[19] = ld_ptr(ARGP + 19);
    A.in[20] = ld_ptr(ARGP + 20);
    A.in[21] = ld_ptr(ARGP + 21);
    A.in[22] = ld_ptr(ARGP + 22);
    A.in[23] = ld_ptr(ARGP + 23);
    A.in[24] = ld_ptr(ARGP + 24);
    A.in[25] = ld_ptr(ARGP + 25);
    A.in[26] = ld_ptr(ARGP + 26);
    A.in[27] = ld_ptr(ARGP + 27);
    A.in[28] = ld_ptr(ARGP + 28);
    A.out = (float*)ld_ptr(ARGP + N_INPUTS); A.ws = (unsigned char*)ld_ptr(ARGP + N_INPUTS + 1); return A; }
struct Frame {
    LAS unsigned char* lds;
    int tid, lane, wave, vcu, G;
};

__device__ __forceinline__ float wave_sum(float v) {
#pragma unroll
    for (int o = 1; o < 64; o <<= 1) v += __shfl_xor(v, o);
    return v;
}
__device__ __forceinline__ float log_sigmoid(float x) { return fminf(x, 0.f) - log1pf(__expf(-fabsf(x))); }

__device__ __forceinline__ int win_src_col(int r) {
    if (r < 1536) return r;
    if (r < 1792) return 1544 + (r - 1536);
    if (r < 2048) return 1800 + (r - 1792);
    if (r < 2560) return 2056 + (r - 2048);
    if (r < 3072) return 2584 + (r - 2560);
    if (r < 3080) return 1536 + (r - 3072);
    if (r < 3096) return 2568 + (r - 3080);
    return -1;
}
template <bool WIN>
__device__ __forceinline__ void p0_transpose_item(const float* W, int ldw, int K, int nblk, bf16* WT, LAS float* scr, int item, int lane) {
    const int kb = item / nblk, nb = item % nblk, k0 = 64 * kb, n0 = 32 * nb;
    const int dr = n0 + (lane & 31); const int sc = WIN ? win_src_col(dr) : dr;
#pragma unroll 8
    for (int i = 0; i < 32; ++i) { const int kk = 2 * i + (lane >> 5); scr[kk * 33 + (lane & 31)] = (sc >= 0) ? W[(size_t)(k0 + kk) * ldw + sc] : 0.f; }
    LDS_WAIT(); asm volatile("" ::: "memory");
    const int c = lane & 7;
#pragma unroll
    for (int j = 0; j < 4; ++j) { const int n = (lane >> 3) + 8 * j; const LAS float* s = scr + (8 * c) * 33 + n;
        v4u o; o.x = pk2(s[0 * 33], s[1 * 33]); o.y = pk2(s[2 * 33], s[3 * 33]); o.z = pk2(s[4 * 33], s[5 * 33]); o.w = pk2(s[6 * 33], s[7 * 33]);
        *(GAS v4u*)(WT + (size_t)(n0 + n) * K + k0 + 8 * c) = o; }
    LDS_WAIT(); asm volatile("" ::: "memory");
}
__device__ __forceinline__ void rms_row_bf16(const float* xrow, const float* g, bf16* orow, int lane) {
    const f32x4* xr = (const f32x4*)xrow + lane; const f32x4* gr = (const f32x4*)g + lane;
    f32x4 v[4]; float s = 0.f;
#pragma unroll
    for (int j = 0; j < 4; ++j) { v[j] = xr[64 * j]; s += (v[j].x * v[j].x + v[j].y * v[j].y) + (v[j].z * v[j].z + v[j].w * v[j].w); }
    const float r = rsqrtf(wave_sum(s) * (1.f / DM) + EPS);
    v2u* o8 = (v2u*)orow + lane;
#pragma unroll
    for (int j = 0; j < 4; ++j) { const f32x4 gg = gr[64 * j]; v2u o; o.x = pk2(v[j].x * r * gg.x, v[j].y * r * gg.y); o.y = pk2(v[j].z * r * gg.z, v[j].w * r * gg.w); o8[64 * j] = o; }
}

using pg8::Unit;
struct EpiGen {
    static constexpr bool PERM = false, AFTER_DRAIN = false;
    float* d32; int ld32; bf16* d16; int ld16; float sc16;
    const float* r0; const float* r1; int rsplit; int ldr;
    const float* gcol;
    float* ssq;
    const float* rsq;
    __device__ __forceinline__ void operator()(const f32x4 (&acc)[2][2][4][2], const Unit& u, int wr, int wc, int fr, int fq) const {
        int row0 = u.pm * 256 + wr * 64 + fr, col0 = u.pn * 256 + wc * 32 + fq * 4;
        asm volatile("" : "+v"(row0), "+v"(col0));
#pragma unroll
        for (int ai = 0; ai < 2; ++ai)
#pragma unroll
            for (int m = 0; m < 4; ++m) { const int row = row0 + ai * 128 + m * 16;
                const float* rp = nullptr; if (r0) rp = (row < rsplit) ? r0 + (size_t)row * ldr : r1 + (size_t)(row - rsplit) * ldr;
                float rs = 1.f; if (rsq) rs = rsqrtf(rsq[row] * (1.f / 1024.f) + EPS);
                float ss = 0.f;
#pragma unroll
                for (int bj = 0; bj < 2; ++bj)
#pragma unroll
                    for (int n = 0; n < 2; ++n) { const int col = col0 + bj * 128 + n * 16; f32x4 v = acc[ai][bj][m][n];
                        if (rsq) { v[0] *= rs; v[1] *= rs; v[2] *= rs; v[3] *= rs; }
                        if (r0) v += *(const f32x4*)(rp + col);
                        if (d32) *(f32x4*)(d32 + (size_t)row * ld32 + col) = v;
                        if (ssq) ss += (v[0] * v[0] + v[1] * v[1]) + (v[2] * v[2] + v[3] * v[3]);
                        if (d16) { f32x4 w = v; if (gcol) w = w * *(const f32x4*)(gcol + col);
                            v2u o; o.x = pg8::cvt_pk_bf16(w[0] * sc16, w[1] * sc16); o.y = pg8::cvt_pk_bf16(w[2] * sc16, w[3] * sc16); *(v2u*)(d16 + (size_t)row * ld16 + col) = o; } }
                if (ssq) { ss += __shfl_xor(ss, 16); ss += __shfl_xor(ss, 32); if (fq == 0) atomicAdd(ssq + row, ss); } }
    }
};
struct EpiInProj {
    static constexpr bool PERM = false, AFTER_DRAIN = false;
    float* out; unsigned char* ws; const float* bff;
    __device__ __forceinline__ void operator()(const f32x4 (&acc)[2][2][4][2], const Unit& u, int wr, int wc, int fr, int fq) const {
        const int pn = u.pn; const bool smp = u.pm >= 64;
        int row0 = u.pm * 256 + wr * 64 + fr;
        int orow0 = (smp ? (u.pm - 64) * 256 : u.pm * 256) + wr * 64 + fr;
        asm volatile("" : "+v"(row0), "+v"(orow0));
        float* d32 = nullptr; int ld32 = 0; bool d32_grp = false; bf16* d16 = nullptr; int ld16 = 0; float s32 = 1.f, s16 = 1.f; int cb = 0;
        if (pn < 2) { d16 = (bf16*)(ws + WS_QF); ld16 = 512; s16 = C2F; cb = pn * 256; }
        else if (pn < 4) { d32 = out + (smp ? O_FKS : O_FKP); ld32 = 512; d32_grp = true; d16 = (bf16*)(ws + WS_KF); ld16 = 512; cb = (pn - 2) * 256; }
        else if (pn < 6) { d32 = out + (smp ? O_FVS : O_FVP); ld32 = 512; d32_grp = true; d16 = (bf16*)(ws + WS_VF); ld16 = 512; cb = (pn - 4) * 256; }
        else if (pn == 6) { d32 = (float*)(ws + WS_GQ); ld32 = 256; s32 = 0.125f; }
        else if (pn == 7) { d32 = (float*)(ws + WS_GK); ld32 = 256; }
        else if (pn < 10) { d32 = (float*)(ws + WS_GV); ld32 = 512; cb = (pn - 8) * 256; }
        else if (pn < 12) { d32 = (float*)(ws + WS_GR); ld32 = 512; cb = (pn - 10) * 256; }
        if (pn < 12) {
#pragma unroll
            for (int ai = 0; ai < 2; ++ai)
#pragma unroll
                for (int m = 0; m < 4; ++m) { const int row = row0 + ai * 128 + m * 16, orow = orow0 + ai * 128 + m * 16;
#pragma unroll
                    for (int bj = 0; bj < 2; ++bj)
#pragma unroll
                        for (int n = 0; n < 2; ++n) { const int col = cb + wc * 32 + fq * 4 + bj * 128 + n * 16; const f32x4 v = acc[ai][bj][m][n];
                            if (d32) *(f32x4*)(d32 + (size_t)(d32_grp ? orow : row) * ld32 + col) = v * s32;
                            if (d16) { v2u o; o.x = pg8::cvt_pk_bf16(v[0] * s16, v[1] * s16); o.y = pg8::cvt_pk_bf16(v[2] * s16, v[3] * s16); *(v2u*)(d16 + (size_t)row * ld16 + col) = o; } } }
        } else {
            if (wc == 0) {
                float* lf = out + (smp ? O_LFS : O_LFP); float* ggp = (float*)(ws + WS_GG);
#pragma unroll
                for (int ai = 0; ai < 2; ++ai)
#pragma unroll
                    for (int m = 0; m < 4; ++m) { const int row = row0 + ai * 128 + m * 16, orow = orow0 + ai * 128 + m * 16;
#pragma unroll
                        for (int n = 0; n < 2; ++n) { const int col = n * 16 + fq * 4; const f32x4 v = acc[ai][0][m][n];
                            if (col < 8) { f32x4 o; const f32x4 b = *(const f32x4*)(bff + col);
                                o[0] = log_sigmoid(v[0] + b[0]); o[1] = log_sigmoid(v[1] + b[1]); o[2] = log_sigmoid(v[2] + b[2]); o[3] = log_sigmoid(v[3] + b[3]);
                                *(f32x4*)(lf + (size_t)orow * 8 + col) = o; }
                            else if (col < 24) *(f32x4*)(ggp + (size_t)row * 16 + (col - 8)) = v; } }
            }
        }
    }
};


__device__ __forceinline__ void p0_prologue(const Frame& F, const Args& a) {
    unsigned char* ws = a.ws;
    LAS float* scr = (LAS float*)(F.lds + F.wave * 16384);
    const int gw = F.vcu * NWAVES + F.wave, NGW = F.G * NWAVES;
    constexpr int I_WINN = 16 * (N_IN / 32), I_SQ = 16 * 32;
    constexpr int NITEMS = I_WINN + 5 * I_SQ;
    for (int it = gw; it < NITEMS; it += NGW) {
        int r = it;
        if (r < I_WINN) { p0_transpose_item<true>((const float*)a.in[I_WIN], 3096, DM, N_IN / 32, (bf16*)(ws + WS_WIN), scr, r, F.lane); continue; } r -= I_WINN;
        const int which = r / I_SQ; r -= which * I_SQ;
        const float* src = (const float*)(which == 0 ? a.in[I_WOUT] : which == 1 ? a.in[I_WMK] : which == 2 ? a.in[I_WMV] : which == 3 ? a.in[I_WCQ] : a.in[I_WCO]);
        bf16* dst = (bf16*)(ws + (which == 0 ? WS_WOUT : which == 1 ? WS_WMK : which == 2 ? WS_WMV : which == 3 ? WS_WCQ : WS_WCO));
        p0_transpose_item<false>(src, DM, DM, 32, dst, scr, r, F.lane);
    }
    { float* ssz = (float*)(ws + WS_SS); for (int i = F.vcu * NTHR + F.tid; i < 2 * TA; i += F.G * NTHR) ssz[i] = 0.f; }
    for (int m0 = gw * 2; m0 < TA + 512; m0 += NGW * 2) {
        const float* xr[2]; const float* gr[2]; bf16* orow[2];
#pragma unroll
        for (int j = 0; j < 2; ++j) { const int m = m0 + j;
            if (m < TP) { xr[j] = (const float*)a.in[I_XP] + (size_t)m * DM; gr[j] = (const float*)a.in[I_GMIX]; orow[j] = (bf16*)(ws + WS_HB) + (size_t)m * DM; }
            else if (m < TA) { xr[j] = (const float*)a.in[I_XS] + (size_t)(m - TP) * DM; gr[j] = (const float*)a.in[I_GMIX]; orow[j] = (bf16*)(ws + WS_HB) + (size_t)m * DM; }
            else { xr[j] = (const float*)a.in[I_MEMP] + (size_t)(m - TA) * DM; gr[j] = (const float*)a.in[I_GMEM]; orow[j] = (bf16*)(ws + WS_MB) + (size_t)(m - TA) * DM; } }
        f32x4 v[2][4]; float s[2];
#pragma unroll
        for (int j = 0; j < 2; ++j) { s[j] = 0.f;
#pragma unroll
            for (int q = 0; q < 4; ++q) v[j][q] = ((const f32x4*)xr[j])[F.lane + 64 * q]; }
#pragma unroll
        for (int j = 0; j < 2; ++j) {
#pragma unroll
            for (int q = 0; q < 4; ++q) s[j] += (v[j][q].x * v[j][q].x + v[j][q].y * v[j][q].y) + (v[j][q].z * v[j][q].z + v[j][q].w * v[j][q].w);
            const float r = rsqrtf(wave_sum(s[j]) * (1.f / DM) + EPS);
#pragma unroll
            for (int q = 0; q < 4; ++q) { const f32x4 gg = ((const f32x4*)gr[j])[F.lane + 64 * q]; v2u o; o.x = pk2(v[j][q].x * r * gg.x, v[j][q].y * r * gg.y); o.y = pk2(v[j][q].z * r * gg.z, v[j][q].w * r * gg.w); ((v2u*)orow[j])[F.lane + 64 * q] = o; } }
    }
    {
        for (int r0 = gw * 4; r0 < 2 * 16384; r0 += NGW * 4) {
            f32x4 x[4][4];
#pragma unroll
            for (int j = 0; j < 4; ++j) { const int r = r0 + j; const bool isv = r >= 16384; const int e = isv ? r - 16384 : r;
                const f32x4* s = (const f32x4*)((const float*)(isv ? a.in[I_PV] : a.in[I_PU]) + (size_t)e * DM + 16 * F.lane);
#pragma unroll
                for (int q = 0; q < 4; ++q) x[j][q] = __builtin_nontemporal_load(s + q); }
#pragma unroll
            for (int j = 0; j < 4; ++j) { const int r = r0 + j; const bool isv = r >= 16384; const int e = isv ? r - 16384 : r; float am = 0.f;
#pragma unroll
                for (int q = 0; q < 4; ++q) am = fmaxf(am, fmaxf(fmaxf(fabsf(x[j][q].x), fabsf(x[j][q].y)), fmaxf(fabsf(x[j][q].z), fabsf(x[j][q].w))));
#pragma unroll
                for (int o = 1; o < 64; o <<= 1) am = fmaxf(am, __shfl_xor(am, o));
                const float inv = am > 0.f ? 448.f / am : 0.f;
                v4u o4;
#pragma unroll
                for (int q = 0; q < 4; ++q) { int pk = __builtin_amdgcn_cvt_pk_fp8_f32(x[j][q].x * inv, x[j][q].y * inv, 0, false); pk = __builtin_amdgcn_cvt_pk_fp8_f32(x[j][q].z * inv, x[j][q].w * inv, pk, true); o4[q] = (unsigned)pk; }
                *(v4u*)(ws + (isv ? WS_V16 : WS_U16) + (size_t)e * DM + 16 * F.lane) = o4;
                if (F.lane == 0) ((float*)(ws + WS_MISC))[r] = am * (1.f / 448.f); }
        }
    }
    __syncthreads();
    for (int it = blockIdx.x; it < 256; it += F.G) {
        const int c = it >> 4, kt = it & 15, half = c & 1;
        LAS float* SK = (LAS float*)F.lds; LAS float* WT = (LAS float*)(F.lds + 128 * 129 * 4);
        const float* sk = (const float*)a.in[I_PSK] + (size_t)half * 128 * 128; const float* wq = (const float*)a.in[I_PWQ] + (size_t)(kt * 64) * 2048 + c * 128;
#pragma unroll 4
        for (int i = 0; i < 32; ++i) { const int idx = F.tid + 512 * i; SK[(idx >> 7) * 129 + (idx & 127)] = sk[idx]; }
#pragma unroll 4
        for (int i = 0; i < 16; ++i) { const int idx = F.tid + 512 * i; WT[(idx >> 7) * 129 + (idx & 127)] = wq[(size_t)(idx >> 7) * 2048 + (idx & 127)]; }
        __syncthreads();
        const int tk = F.tid & 15, tkey = F.tid >> 4;
        float acc[4][4];
#pragma unroll
        for (int i = 0; i < 4; ++i)
#pragma unroll
            for (int j = 0; j < 4; ++j) acc[i][j] = 0.f;
        for (int j = 0; j < 128; ++j) {
            float av[4], bv[4];
#pragma unroll
            for (int i = 0; i < 4; ++i) { av[i] = SK[(4 * tkey + i) * 129 + j]; bv[i] = WT[(4 * tk + i) * 129 + j]; }
#pragma unroll
            for (int i = 0; i < 4; ++i)
#pragma unroll
                for (int i2 = 0; i2 < 4; ++i2) acc[i][i2] += av[i] * bv[i2];
        }
        bf16* wp = (bf16*)(ws + WS_WPK);
#pragma unroll
        for (int i = 0; i < 4; ++i) { v2u o; o.x = pk2(acc[i][0], acc[i][1]); o.y = pk2(acc[i][2], acc[i][3]); *(v2u*)(wp + (size_t)(c * 128 + 4 * tkey + i) * DM + kt * 64 + 4 * tk) = o; }
        __syncthreads();
    }
}


__device__ __forceinline__ void fox_prompt_cumsum(const Frame& F, const float* logf  , float* kbias, int b) {
    LAS float* WT = (LAS float*)F.lds;
    const int t0 = F.wave * 1024 + F.lane * 16;
    const f32x4* src = (const f32x4*)(logf + ((size_t)b * SEQ + t0) * 8);
    float s[8];
#pragma unroll
    for (int h = 0; h < 8; ++h) s[h] = 0.f;
#pragma unroll 4
    for (int i = 0; i < 16; ++i) { const f32x4 a = src[2 * i], c = src[2 * i + 1]; s[0] += a.x; s[1] += a.y; s[2] += a.z; s[3] += a.w; s[4] += c.x; s[5] += c.y; s[6] += c.z; s[7] += c.w; }
    float ex[8];
#pragma unroll
    for (int h = 0; h < 8; ++h) { float v = s[h];
#pragma unroll
        for (int o = 1; o < 64; o <<= 1) { const float t = __shfl_up(v, o); if (F.lane >= o) v += t; }
        ex[h] = v - s[h];
        if (F.lane == 63) WT[F.wave * 8 + h] = v; }
    __syncthreads();
#pragma unroll
    for (int h = 0; h < 8; ++h) { float c = 0.f; for (int w = 0; w < F.wave; ++w) c += WT[w * 8 + h]; ex[h] += c; }
    float* dst = kbias + (size_t)(b * 8) * SEQ + t0;
#pragma unroll 4
    for (int i = 0; i < 16; ++i) { const f32x4 a = src[2 * i], c = src[2 * i + 1];
        ex[0] += a.x; ex[1] += a.y; ex[2] += a.z; ex[3] += a.w; ex[4] += c.x; ex[5] += c.y; ex[6] += c.z; ex[7] += c.w;
#pragma unroll
        for (int h = 0; h < 8; ++h) dst[(size_t)h * SEQ + i] = -ex[h] * LOG2E; }
    __syncthreads();
}
__device__ __forceinline__ void fox_sample_suffix(const Frame& F, const float* cfl, const int* pt, float* suf, int bs) {
    float carry[8];
#pragma unroll
    for (int h = 0; h < 8; ++h) carry[h] = 0.f;
    const int mypg = pt[bs * NPAGES + (F.lane & 15)];
#pragma unroll 1
    for (int pb = NPAGES - 4; pb >= 0; pb -= 4) {
        f32x4 x[4][4];
#pragma unroll
        for (int j = 0; j < 4; ++j) { const int pg = __builtin_amdgcn_readlane(mypg, 0) * 0 + __shfl(mypg, pb + j); const f32x4* src = (const f32x4*)(cfl + ((size_t)pg * PAGE + 2 * F.lane) * 8);
            x[j][0] = src[0]; x[j][1] = src[1]; x[j][2] = src[2]; x[j][3] = src[3]; }
#pragma unroll
        for (int j = 3; j >= 0; --j) { const int p = pb + j;
            const float ra[8] = {x[j][0].x, x[j][0].y, x[j][0].z, x[j][0].w, x[j][1].x, x[j][1].y, x[j][1].z, x[j][1].w}, rb[8] = {x[j][2].x, x[j][2].y, x[j][2].z, x[j][2].w, x[j][3].x, x[j][3].y, x[j][3].z, x[j][3].w};
#pragma unroll
            for (int h = 0; h < 8; ++h) {
                const float ps = ra[h] + rb[h]; float v = ps;
#pragma unroll
                for (int o = 1; o < 64; o <<= 1) { const float t = __shfl_down(v, o); if (F.lane + o < 64) v += t; }
                const float exs = v - ps;
                float* d = suf + (size_t)(bs * 8 + h) * PASTL + p * PAGE + 2 * F.lane;
                *(f32x2*)d = (f32x2){(carry[h] + exs + rb[h]) * LOG2E, (carry[h] + exs) * LOG2E};
                carry[h] += __shfl(v, 0);
            }
        }
    }
}

__device__ __forceinline__ void gla_gate_tile(const Frame& F, const float* gg, const float* w2, const float* bg, int row0, int h, int nt, LAS float* LA, LAS float* GGS) {
    for (int e = F.tid; e < nt * 16; e += NTHR) GGS[e] = gg[(size_t)row0 * 16 + e];
    const int dk = F.tid & 63; float wc[16];
#pragma unroll
    for (int r = 0; r < 16; ++r) wc[r] = w2[r * 256 + h * 64 + dk];
    const float bb = bg[h * 64 + dk];
    __syncthreads();
    for (int t = F.tid >> 6; t < nt; t += 8) { float z = bb;
#pragma unroll
        for (int q = 0; q < 4; ++q) { const f32x4 g4 = *(const LAS f32x4*)(GGS + t * 16 + 4 * q); z += g4.x * wc[4 * q] + g4.y * wc[4 * q + 1] + g4.z * wc[4 * q + 2] + g4.w * wc[4 * q + 3]; }
        LA[t * 64 + dk] = log_sigmoid(z) * (1.f / 16.f); }
}
__device__ __forceinline__ void gla_cumsum64(const Frame& F, LAS float* LA, LAS float* SEG) {
    const int dk = F.lane, w = F.wave; float v[8]; float run = 0.f;
#pragma unroll
    for (int i = 0; i < 8; ++i) { run += LA[(8 * w + i) * 64 + dk]; v[i] = run; }
    SEG[w * 64 + dk] = run;
    __syncthreads();
    float pre = 0.f;
    for (int j = 0; j < w; ++j) pre += SEG[j * 64 + dk];
#pragma unroll
    for (int i = 0; i < 8; ++i) LA[(8 * w + i) * 64 + dk] = v[i] + pre;
    __syncthreads();
}
__device__ __forceinline__ void gla_g1_unit(const Frame& F, const Args& a, int u) {
    unsigned char* ws = a.ws;
    const int b = u >> 9, h = (u >> 7) & 3, n = u & 127; const int row0 = b * SEQ + n * 64;
    LAS float* LA = (LAS float*)F.lds; LAS float* KR = LA + 4096; LAS float* SEG = KR + 4096; LAS float* GGS = SEG + 512; LAS float* VS = GGS + 1024;
#pragma unroll
    for (int i = 0; i < 16; ++i) { const int e = F.tid + NTHR * i; VS[e] = ((const float*)(ws + WS_GV))[(size_t)(row0 + (e >> 7)) * 512 + h * 128 + (e & 127)]; }
    gla_gate_tile(F, (const float*)(ws + WS_GG), (const float*)a.in[I_WG2], (const float*)a.in[I_BG], row0, h, 64, LA, GGS);
    __syncthreads();
    gla_cumsum64(F, LA, SEG);
    if (F.tid < 64) ((float*)(ws + WS_GDEC))[(size_t)((b * 4 + h) * 128 + n) * 64 + F.tid] = __expf(LA[63 * 64 + F.tid]);
    const float* gk = (const float*)(ws + WS_GK); float* bbuf = (float*)(ws + WS_BB);
#pragma unroll
    for (int i = 0; i < 8; ++i) { const int e = F.tid + NTHR * i; const int t = e >> 6, dk = e & 63; const float bb = LA[e]; bbuf[(size_t)(row0 + t) * 256 + h * 64 + dk] = bb;
        KR[e] = gk[(size_t)(row0 + t) * 256 + h * 64 + dk] * __expf(LA[63 * 64 + dk] - bb); }
    __syncthreads();
    {
        const int dvq = F.tid & 31, dkq = F.tid >> 5; float acc[4][4];
#pragma unroll
        for (int i = 0; i < 4; ++i)
#pragma unroll
            for (int j = 0; j < 4; ++j) acc[i][j] = 0.f;
#pragma unroll 8
        for (int t = 0; t < 64; ++t) { const f32x4 v4 = *(const LAS f32x4*)(VS + t * 128 + 4 * dvq), k4 = *(const LAS f32x4*)(KR + t * 64 + 4 * dkq);
#pragma unroll
            for (int i = 0; i < 4; ++i)
#pragma unroll
                for (int j = 0; j < 4; ++j) acc[i][j] += k4[i] * v4[j]; }
        float* kv = (float*)(ws + WS_GKV) + ((size_t)((b * 4 + h) * 128 + n) * 64 + 4 * dkq) * 128 + 4 * dvq;
#pragma unroll
        for (int i = 0; i < 4; ++i) *(f32x4*)(kv + (size_t)i * 128) = (f32x4){acc[i][0], acc[i][1], acc[i][2], acc[i][3]};
    }
    __syncthreads();
}
__device__ __forceinline__ void gla_scan(const Frame& F, const Args& a) {
    if (F.tid >= 256) return;
    for (int e = F.vcu * 256 + F.tid; e < 65536; e += F.G * 256) {
    const int bh = e >> 13, dk = (e >> 7) & 63, dv = e & 127;
    float* kv = (float*)(a.ws + WS_GKV) + ((size_t)bh * 128 * 64 + dk) * 128 + dv; const float* dc = (const float*)(a.ws + WS_GDEC) + (size_t)bh * 128 * 64 + dk;
    float S = 0.f;
    for (int n0 = 0; n0 < 128; n0 += 8) { float kvv[8], dd[8];
#pragma unroll
        for (int j = 0; j < 8; ++j) { kvv[j] = kv[(size_t)(n0 + j) * 8192]; dd[j] = dc[(size_t)(n0 + j) * 64]; }
#pragma unroll
        for (int j = 0; j < 8; ++j) { kv[(size_t)(n0 + j) * 8192] = S; S = dd[j] * S + kvv[j]; } }
    a.out[O_GSP + (size_t)bh * 8192 + dk * 128 + dv] = S;
    }
}
__device__ __forceinline__ float silu(float x) { return x / (1.f + __expf(-x)); }
__device__ __forceinline__ void gla_sample_unit(const Frame& F, const Args& a, int u) {
    unsigned char* ws = a.ws;
    const int bs = u >> 2, h = u & 3; const int row0 = TP + bs * LS;
    LAS float* LA = (LAS float*)F.lds; LAS float* BL = LA + 512; LAS float* QD = BL + 64; LAS float* KI = QD + 512; LAS float* KR = KI + 512; LAS float* ATT = KR + 512; LAS float* OP = ATT + 64; LAS float* VS = OP + 4096;
    gla_gate_tile(F, (const float*)(ws + WS_GG), (const float*)a.in[I_WG2], (const float*)a.in[I_BG], row0, h, 8, LA, VS + 1024);
#pragma unroll
    for (int i = 0; i < 2; ++i) { const int e = F.tid + NTHR * i; VS[e] = ((const float*)(ws + WS_GV))[(size_t)(row0 + (e >> 7)) * 512 + h * 128 + (e & 127)]; }
    __syncthreads();
    if (F.tid < 64) { float run = 0.f;
#pragma unroll
        for (int t = 0; t < 8; ++t) { run += LA[t * 64 + F.tid]; LA[t * 64 + F.tid] = run; } BL[F.tid] = run; }
    __syncthreads();
    { const int e = F.tid, t = e >> 6, dk = e & 63; const float bb = LA[e];
      const float q = ((const float*)(ws + WS_GQ))[(size_t)(row0 + t) * 256 + h * 64 + dk], k = ((const float*)(ws + WS_GK))[(size_t)(row0 + t) * 256 + h * 64 + dk];
      QD[e] = q * __expf(bb); KI[e] = k * __expf(-bb); KR[e] = k * __expf(BL[dk] - bb); }
    __syncthreads();
    if (F.tid < 64) { const int t = F.tid >> 3, s = F.tid & 7; float acc = 0.f;
        if (s <= t) { for (int dk = 0; dk < 64; ++dk) acc += QD[t * 64 + dk] * KI[s * 64 + dk]; }
        ATT[F.tid] = acc; }
    const int dv = F.tid & 127, dkg = F.tid >> 7;
    {
        const float* st = (const float*)a.in[I_SGLA] + ((size_t)(bs * 4 + h) * 64 + dkg * 16) * 128 + dv;
        float S0[16];
#pragma unroll
        for (int i = 0; i < 16; ++i) S0[i] = st[(size_t)i * 128];
#pragma unroll
        for (int t = 0; t < 8; ++t) { float o = 0.f;
#pragma unroll
            for (int i = 0; i < 16; ++i) o += QD[t * 64 + dkg * 16 + i] * S0[i];
            OP[(dkg * 8 + t) * 128 + dv] = o; }
        float* so = a.out + O_GSS + ((size_t)(bs * 4 + h) * 64 + dkg * 16) * 128 + dv;
#pragma unroll
        for (int i = 0; i < 16; ++i) { float sn = __expf(BL[dkg * 16 + i]) * S0[i];
#pragma unroll
            for (int t = 0; t < 8; ++t) sn += KR[t * 64 + dkg * 16 + i] * VS[t * 128 + dv];
            so[(size_t)i * 128] = sn; }
    }
    __syncthreads();
    {
        const int t = F.wave; float o[2]; float ss = 0.f;
#pragma unroll
        for (int j = 0; j < 2; ++j) { const int d = 2 * F.lane + j; float v = OP[(0 * 8 + t) * 128 + d] + OP[(1 * 8 + t) * 128 + d] + OP[(2 * 8 + t) * 128 + d] + OP[(3 * 8 + t) * 128 + d];
            for (int s = 0; s <= t; ++s) v += ATT[t * 8 + s] * VS[s * 128 + d];
            o[j] = v; ss += v * v; }
        const float r = rsqrtf(wave_sum(ss) * (1.f / 128.f) + EPS);
        const float* ggo = (const float*)a.in[I_GGO] + h * 128 + 2 * F.lane; const float* gr = (const float*)(ws + WS_GR) + (size_t)(row0 + t) * 512 + h * 128 + 2 * F.lane;
        const float y0 = o[0] * r * ggo[0] * silu(gr[0]), y1 = o[1] * r * ggo[1] * silu(gr[1]);
        *(unsigned*)((bf16*)(ws + WS_MERGED) + (size_t)(row0 + t) * DM + 512 + h * 128 + 2 * F.lane) = pk2(y0, y1);
    }
    __syncthreads();
}


typedef short v4i16_t __attribute__((ext_vector_type(4)));
__device__ __forceinline__ s16x4 lds_tr16(LAS unsigned char* p) { return __builtin_bit_cast(s16x4, __builtin_amdgcn_ds_read_tr16_b64_v4i16((LAS v4i16_t*)p)); }
__device__ __forceinline__ int crow(int r, int hi) { return (r & 3) + 8 * (r >> 2) + 4 * hi; }
__device__ __forceinline__ float fexp2(float x) { return __builtin_amdgcn_exp2f(x); }
constexpr float FOX_SKIP = 160.f;


__device__ __forceinline__ void fox_norms_item(const Frame& F, const bf16* QF, const bf16* KF, const float* logf, float* FN, float* LC, float* BT, int item) {
    const int bh = item >> 5, qb = item & 31, b = bh >> 3, h = bh & 7;
    float qm = 0.f, km = 0.f;
    const float* lp = logf + ((size_t)b * SEQ + qb * 256 + 4 * F.lane) * 8 + h;
    const float l0 = lp[0], l1 = lp[8], l2 = lp[16], l3 = lp[24];
#pragma unroll
    for (int i = 0; i < 4; ++i) { const size_t row = (size_t)b * SEQ + qb * 256 + i * 64 + F.lane;
        const v4u* qp = (const v4u*)(QF + row * 512 + h * 64); const v4u* kp = (const v4u*)(KF + row * 512 + h * 64); float qs = 0.f, ks = 0.f;
#pragma unroll
        for (int c = 0; c < 8; ++c) { const v4u q = qp[c], k = kp[c];
#pragma unroll
            for (int j = 0; j < 4; ++j) { qs += bflo(q[j]) * bflo(q[j]) + bfhi(q[j]) * bfhi(q[j]); ks += bflo(k[j]) * bflo(k[j]) + bfhi(k[j]) * bfhi(k[j]); } }
        qm = fmaxf(qm, qs); km = fmaxf(km, ks); }
#pragma unroll
    for (int o = 1; o < 64; o <<= 1) { qm = fmaxf(qm, __shfl_xor(qm, o)); km = fmaxf(km, __shfl_xor(km, o)); }
    const float c0 = l0, c1 = c0 + l1, c2 = c1 + l2, c3 = c2 + l3; float v = c3;
#pragma unroll
    for (int o = 1; o < 64; o <<= 1) { const float t = __shfl_up(v, o); if (F.lane >= o) v += t; }
    const float ex = v - c3;
    *(f32x4*)(LC + (size_t)bh * SEQ + qb * 256 + 4 * F.lane) = (f32x4){ex + c0, ex + c1, ex + c2, ex + c3};
    if (F.lane == 63) BT[item] = v;
    if (F.lane == 0) { FN[item * 2] = qm; FN[item * 2 + 1] = km; }
}
__device__ __forceinline__ void fox_suffix_item(const Frame& F, const float* cfl, const int* pt, float* SW, float* PTOT, int item) {
    const int bs = item >> 4, p = item & 15; const int pg = __builtin_amdgcn_readfirstlane(pt[item]);
    const f32x4* src = (const f32x4*)(cfl + ((size_t)pg * PAGE + 2 * F.lane) * 8);
    const f32x4 a0 = src[0], a1 = src[1], b0 = src[2], b1 = src[3];
    const float ra[8] = {a0.x, a0.y, a0.z, a0.w, a1.x, a1.y, a1.z, a1.w}, rb[8] = {b0.x, b0.y, b0.z, b0.w, b1.x, b1.y, b1.z, b1.w};
#pragma unroll
    for (int h = 0; h < 8; ++h) {
        const float ps = ra[h] + rb[h]; float v = ps;
#pragma unroll
        for (int o = 1; o < 64; o <<= 1) { const float t = __shfl_down(v, o); if (F.lane + o < 64) v += t; }
        const float exs = v - ps;
        *(f32x2*)(SW + (size_t)(bs * 8 + h) * PASTL + p * PAGE + 2 * F.lane) = (f32x2){exs + rb[h], exs};
        if (F.lane == 0) PTOT[(bs * 8 + h) * NPAGES + p] = v;
    }
}
__device__ __forceinline__ void fox_attn_unit(const Frame& F, const bf16* QF, const bf16* KF, const bf16* VF, const float* LC, const float* BT, const float* FN, bf16* merged, int b, int h, int qb) {
    const int lane = F.lane, r32 = lane & 31, hi = lane >> 5, wid = F.wave, tid = F.tid;
    const size_t rowbase = (size_t)b * SEQ; const int q0 = qb * 256;
    LAS unsigned char* Ks = F.lds; LAS unsigned char* Vs = F.lds + 8192; LAS float* KBs = (LAS float*)(F.lds + 20480); LAS float* WSF = (LAS float*)(F.lds + 20736) + wid * 32;
    const bf16* Qw = QF + (rowbase + q0 + wid * 32 + r32) * 512 + h * 64;
    bf16x8 qr[4];
#pragma unroll
    for (int d0 = 0; d0 < 4; ++d0) qr[d0] = *(const bf16x8*)(Qw + d0 * 16 + hi * 8);
    const float* lcp = LC + (size_t)(b * 8 + h) * SEQ;
    float pbx; { const float btv = (lane < 32) ? BT[(b * 8 + h) * 32 + lane] : 0.f; float v = btv;
#pragma unroll
        for (int o = 1; o < 64; o <<= 1) { const float t = __shfl_up(v, o); if (lane >= o) v += t; }
        pbx = v - btv; }
    const float cref = lcp[q0] + __shfl(pbx, qb);
#define FOX_KB(t_, pos_) (-LOG2E * ((lcp[pos_] + __shfl(pbx, (t_) >> 2)) - cref))
    const int NT = (q0 + 256) / 64;
    int t0 = 0;
    {
        float kn = (lane < 32) ? FN[((b * 8 + h) * 32 + lane) * 2 + 1] : 0.f;
#pragma unroll
        for (int o = 1; o < 64; o <<= 1) kn = fmaxf(kn, __shfl_xor(kn, o));
        const float qk2 = 2.f * sqrtf(FN[((b * 8 + h) * 32 + qb) * 2]) * sqrtf(kn) * 1.01f;
        const int nbefore = q0 / 64;
        int found = -1;
        for (int base = 0; base < nbefore && found < 0; base += 64) {
            const int tl = nbefore - 1 - base - lane;
            const int tlc = tl < 0 ? 0 : tl; const float kbl = -LOG2E * ((lcp[tlc * 64 + 63] + __shfl(pbx, tlc >> 2)) - cref);
            const bool dead = (tl >= 0) && (qk2 + kbl < -FOX_SKIP);
            const unsigned long long bm = __ballot(dead);
            if (bm) found = nbefore - 1 - base - (int)__builtin_ctzll(bm);
        }
        t0 = found + 1;
        t0 = __builtin_amdgcn_readfirstlane(t0);
    }
    const int kkey = tid & 63, kch = tid >> 6, vkey = tid >> 3, vch = tid & 7;
    const bf16* ksrc = KF + (rowbase + kkey) * 512 + h * 64 + kch * 8;
    const bf16* vsrc = VF + (rowbase + vkey) * 512 + h * 64 + vch * 8;
    v4u kreg = *(const v4u*)(ksrc + (size_t)t0 * 64 * 512), vreg = *(const v4u*)(vsrc + (size_t)t0 * 64 * 512); float kbreg = FOX_KB(t0, t0 * 64 + (tid & 63));
    float m_run = -INFINITY, l_run = 0.f; f32x16 o0 = {}, o1 = {};
    const int qpos = q0 + wid * 32 + r32;
    const int vbase = (4 * hi + ((lane & 15) >> 2)) * 192 + (16 * ((lane >> 4) & 1) + 4 * (lane & 3)) * 2;
    for (int t = t0; t < NT; ++t) {
        __syncthreads();
        *(LAS v4u*)(Ks + kch * 1024 + kkey * 16) = kreg; *(LAS v4u*)(Vs + vkey * 192 + vch * 16) = vreg; if (tid < 64) KBs[tid] = kbreg;
        __syncthreads();
        if (t + 1 < NT) { kreg = *(const v4u*)(ksrc + (size_t)(t + 1) * 64 * 512); vreg = *(const v4u*)(vsrc + (size_t)(t + 1) * 64 * 512); kbreg = FOX_KB(t + 1, (t + 1) * 64 + (tid & 63)); }
        const int k0 = t * 64;
        if (k0 > q0 + wid * 32 + 31) continue;
        f32x16 p0 = {}, p1 = {};
#pragma unroll
        for (int d0 = 0; d0 < 4; ++d0) {
            const bf16x8 a0 = *(const LAS bf16x8*)(Ks + (2 * d0 + hi) * 1024 + r32 * 16), a1 = *(const LAS bf16x8*)(Ks + (2 * d0 + hi) * 1024 + r32 * 16 + 512);
            p0 = __builtin_amdgcn_mfma_f32_32x32x16_bf16(a0, qr[d0], p0, 0, 0, 0); p1 = __builtin_amdgcn_mfma_f32_32x32x16_bf16(a1, qr[d0], p1, 0, 0, 0);
        }
#pragma unroll
        for (int g = 0; g < 4; ++g) { const f32x4 ba = *(const LAS f32x4*)(KBs + 8 * g + 4 * hi), bb = *(const LAS f32x4*)(KBs + 32 + 8 * g + 4 * hi);
#pragma unroll
            for (int i = 0; i < 4; ++i) { p0[4 * g + i] += ba[i]; p1[4 * g + i] += bb[i]; } }
        if (k0 + 63 > q0 + wid * 32) {
#pragma unroll
            for (int r = 0; r < 16; ++r) { const int key = k0 + crow(r, hi); if (key > qpos) p0[r] = -INFINITY; if (key + 32 > qpos) p1[r] = -INFINITY; }
        }
        float mx = fmaxf(p0[0], p1[0]);
#pragma unroll
        for (int r = 1; r < 16; ++r) mx = fmaxf(mx, fmaxf(p0[r], p1[r]));
        mx = fmaxf(mx, __shfl_xor(mx, 32));
        const float m_new = fmaxf(m_run, mx), alpha = fexp2(m_run - m_new); m_run = m_new;
        float ls = 0.f;
#pragma unroll
        for (int r = 0; r < 16; ++r) { p0[r] = fexp2(p0[r] - m_new); p1[r] = fexp2(p1[r] - m_new); ls += p0[r] + p1[r]; }
        l_run = l_run * alpha + ls;
        if (hi == 0) WSF[r32] = alpha;
#pragma unroll
        for (int g = 0; g < 4; ++g) { const f32x4 al = *(const LAS f32x4*)(WSF + 8 * g + 4 * hi);
#pragma unroll
            for (int i = 0; i < 4; ++i) { o0[4 * g + i] *= al[i]; o1[4 * g + i] *= al[i]; } }
        v4u pw[4];
#pragma unroll
        for (int j = 0; j < 4; ++j) { pw[0][j] = pg8::cvt_pk_bf16(p0[2 * j], p0[2 * j + 1]); pw[1][j] = pg8::cvt_pk_bf16(p0[8 + 2 * j], p0[8 + 2 * j + 1]);
                                      pw[2][j] = pg8::cvt_pk_bf16(p1[2 * j], p1[2 * j + 1]); pw[3][j] = pg8::cvt_pk_bf16(p1[8 + 2 * j], p1[8 + 2 * j + 1]); }
#pragma unroll
        for (int ks = 0; ks < 4; ++ks) {
            const bf16x8 pa = __builtin_bit_cast(bf16x8, pw[ks]);
#pragma unroll
            for (int d0 = 0; d0 < 2; ++d0) {
                const s16x4 lo = lds_tr16(Vs + vbase + ks * 16 * 192 + d0 * 64), hi4 = lds_tr16(Vs + vbase + ks * 16 * 192 + 8 * 192 + d0 * 64);
                const bf16x8 vb = (bf16x8){lo[0], lo[1], lo[2], lo[3], hi4[0], hi4[1], hi4[2], hi4[3]};
                if (d0 == 0) o0 = __builtin_amdgcn_mfma_f32_32x32x16_bf16(pa, vb, o0, 0, 0, 0); else o1 = __builtin_amdgcn_mfma_f32_32x32x16_bf16(pa, vb, o1, 0, 0, 0);
            }
        }
    }
    l_run += __shfl_xor(l_run, 32);
    if (hi == 0) WSF[r32] = 1.f / l_run;
    bf16* Ow = merged + (rowbase + q0 + wid * 32) * DM + h * 64 + r32;
#pragma unroll
    for (int g = 0; g < 4; ++g) { const f32x4 rl = *(const LAS f32x4*)(WSF + 8 * g + 4 * hi);
#pragma unroll
        for (int i = 0; i < 4; ++i) { const int r = 4 * g + i; const int row = crow(r, hi);
            Ow[(size_t)row * DM] = (bf16)f2bf(o0[r] * rl[i]); Ow[(size_t)row * DM + 32] = (bf16)f2bf(o1[r] * rl[i]); } }
    __syncthreads();
#undef FOX_KB
}

template <int D> struct DecW {
    static constexpr int KS = D / 32;
    static constexpr int LPK = D / 4;
    static constexpr int KPI = 64 / LPK;
    float m[4], l[4]; float o[8][4];
};
template <int D>
__device__ __forceinline__ void dec_init(DecW<D>& w) {
#pragma unroll
    for (int i = 0; i < 4; ++i) { w.m[i] = -INFINITY; w.l[i] = 0.f; }
#pragma unroll
    for (int q = 0; q < 8; ++q)
#pragma unroll
        for (int j = 0; j < 4; ++j) w.o[q][j] = 0.f;
}
template <int D, int NTILE, int MODE>
__device__ __forceinline__ void dec_chunk(DecW<D>& w, const bf16x8 (&qa)[D / 32], const float* Kb, const float* Vb, int stride, const float* bias, float nb, LAS float* PL, int lane) {
    constexpr int KS = D / 32, LPK = D / 4, KPI = 64 / LPK;
    constexpr int NK = (MODE == 1) ? 8 : NTILE * 16, NV = NK / KPI;
    const int key = lane & 15, kq = lane >> 4;
    const unsigned koff = (unsigned)(key * stride + 8 * kq) * 4u;
    const int d4 = lane % LPK, ksub = lane / LPK;
    const unsigned voff = (unsigned)(ksub * stride + 4 * d4) * 4u;
    f32x4 kx[NTILE][2 * KS], vx[NV];
#pragma unroll
    for (int t = 0; t < NTILE; ++t) { const char* kp = (const char*)(Kb + (size_t)t * 16 * stride) + koff;
#pragma unroll
        for (int ks = 0; ks < KS; ++ks) { kx[t][2 * ks] = *(const f32x4*)(kp + 128 * ks); kx[t][2 * ks + 1] = *(const f32x4*)(kp + 128 * ks + 16); } }
    constexpr int NVA = (NV >= 8) ? NV / 2 : NV;
#pragma unroll
    for (int kk = 0; kk < NVA; ++kk) vx[kk] = *(const f32x4*)((const char*)(Vb + (size_t)kk * KPI * stride) + voff);
    f32x4 s[NTILE];
#pragma unroll
    for (int t = 0; t < NTILE; ++t) {
        f32x4 acc = {0.f, 0.f, 0.f, 0.f};
#pragma unroll
        for (int ks = 0; ks < KS; ++ks) { const f32x4 x0 = kx[t][2 * ks], x1 = kx[t][2 * ks + 1];
            v4u kb; kb.x = pg8::cvt_pk_bf16(x0.x, x0.y); kb.y = pg8::cvt_pk_bf16(x0.z, x0.w); kb.z = pg8::cvt_pk_bf16(x1.x, x1.y); kb.w = pg8::cvt_pk_bf16(x1.z, x1.w);
            acc = __builtin_amdgcn_mfma_f32_16x16x32_bf16(qa[ks], __builtin_bit_cast(bf16x8, kb), acc, 0, 0, 0); }
        if (MODE == 0) { if (bias) { const float bv = (bias[t * 16 + key] + nb) * LOG2E; acc += bv; } }
        else { acc += nb;
#pragma unroll
            for (int i = 0; i < 4; ++i) if (key > 4 * kq + i || key >= 8) acc[i] = -INFINITY; }
        s[t] = acc;
    }
#pragma unroll
    for (int kk = NVA; kk < NV; ++kk) vx[kk] = *(const f32x4*)((const char*)(Vb + (size_t)kk * KPI * stride) + voff);
    f32x4 mc = s[0];
#pragma unroll
    for (int t = 1; t < NTILE; ++t) { mc.x = fmaxf(mc.x, s[t].x); mc.y = fmaxf(mc.y, s[t].y); mc.z = fmaxf(mc.z, s[t].z); mc.w = fmaxf(mc.w, s[t].w); }
#pragma unroll
    for (int o = 1; o < 16; o <<= 1) { mc.x = fmaxf(mc.x, __shfl_xor(mc.x, o)); mc.y = fmaxf(mc.y, __shfl_xor(mc.y, o)); mc.z = fmaxf(mc.z, __shfl_xor(mc.z, o)); mc.w = fmaxf(mc.w, __shfl_xor(mc.w, o)); }
    float al[4];
#pragma unroll
    for (int i = 0; i < 4; ++i) { const float mn = fmaxf(w.m[i], mc[i]); al[i] = (mn == -INFINITY) ? 1.f : fexp2(w.m[i] - mn); w.m[i] = mn; w.l[i] *= al[i]; }
#pragma unroll
    for (int t = 0; t < NTILE; ++t) { f32x4 p;
#pragma unroll
        for (int i = 0; i < 4; ++i) { p[i] = (w.m[i] == -INFINITY) ? 0.f : fexp2(s[t][i] - w.m[i]); w.l[i] += p[i]; }
        if (kq < 2) *(LAS f32x4*)(PL + (t * 16 + key) * 8 + 4 * kq) = p; }
    if (key == 0 && kq < 2) *(LAS f32x4*)(PL + 1024 + 4 * kq) = (f32x4){al[0], al[1], al[2], al[3]};
    { const f32x4 a0 = *(const LAS f32x4*)(PL + 1024), a1 = *(const LAS f32x4*)(PL + 1028);
#pragma unroll
      for (int j = 0; j < 4; ++j) { w.o[0][j] *= a0.x; w.o[1][j] *= a0.y; w.o[2][j] *= a0.z; w.o[3][j] *= a0.w; w.o[4][j] *= a1.x; w.o[5][j] *= a1.y; w.o[6][j] *= a1.z; w.o[7][j] *= a1.w; } }
#pragma unroll
    for (int kk = 0; kk < NV; ++kk) { const int k = kk * KPI + ksub;
        const f32x4 v = vx[kk];
        const f32x4 pa = *(const LAS f32x4*)(PL + k * 8), pb = *(const LAS f32x4*)(PL + k * 8 + 4);
#pragma unroll
        for (int j = 0; j < 4; ++j) { w.o[0][j] += pa.x * v[j]; w.o[1][j] += pa.y * v[j]; w.o[2][j] += pa.z * v[j]; w.o[3][j] += pa.w * v[j];
                                      w.o[4][j] += pb.x * v[j]; w.o[5][j] += pb.y * v[j]; w.o[6][j] += pb.z * v[j]; w.o[7][j] += pb.w * v[j]; } }
}
template <int D>
__device__ __forceinline__ void dec_park(DecW<D>& w, LAS float* CBw, int lane) {
    constexpr int LPK = D / 4;
    const int key = lane & 15, kq = lane >> 4, d4 = lane % LPK, ksub = lane / LPK;
#pragma unroll
    for (int i = 0; i < 4; ++i) { float l = w.l[i];
#pragma unroll
        for (int o = 1; o < 16; o <<= 1) l += __shfl_xor(l, o);
        w.l[i] = l; }
    if (key == 0 && kq < 2) { *(LAS f32x4*)(CBw + 4 * kq) = (f32x4){w.m[0], w.m[1], w.m[2], w.m[3]}; *(LAS f32x4*)(CBw + 8 + 4 * kq) = (f32x4){w.l[0], w.l[1], w.l[2], w.l[3]}; }
#pragma unroll
    for (int q = 0; q < 8; ++q) { f32x4 v = (f32x4){w.o[q][0], w.o[q][1], w.o[q][2], w.o[q][3]};
        if (LPK < 64) {
#pragma unroll
            for (int o = LPK; o < 64; o <<= 1) { v.x += __shfl_xor(v.x, o); v.y += __shfl_xor(v.y, o); v.z += __shfl_xor(v.z, o); v.w += __shfl_xor(v.w, o); } }
        if (ksub == 0) *(LAS f32x4*)(CBw + 16 + q * D + 4 * d4) = v; }
}
template <int D>
__device__ __forceinline__ void dec_combine(const Frame& F, LAS float* CB, bf16* dst, int ldd) {
    constexpr int WSTR = 16 + 8 * D;
    for (int e = F.tid; e < 8 * D; e += NTHR) { const int q = e / D, d = e % D;
        float mt = -INFINITY;
#pragma unroll
        for (int w = 0; w < 8; ++w) mt = fmaxf(mt, CB[w * WSTR + q]);
        float num = 0.f, den = 0.f;
#pragma unroll
        for (int w = 0; w < 8; ++w) { const float mw = CB[w * WSTR + q]; const float f = (mw == -INFINITY) ? 0.f : fexp2(mw - mt); num += f * CB[w * WSTR + 16 + q * D + d]; den += f * CB[w * WSTR + 8 + q]; }
        dst[(size_t)q * ldd + d] = (bf16)f2bf(num / den); }
}
template <int D>
__device__ __forceinline__ void dec_load_q(bf16x8 (&qa)[D / 32], const bf16* Q, int ldq, int lane) {
    const int row = lane & 15, kq = lane >> 4;
#pragma unroll
    for (int ks = 0; ks < D / 32; ++ks) { v4u z = {0u, 0u, 0u, 0u}; if (row < 8) z = *(const v4u*)(Q + (size_t)row * ldq + 32 * ks + 8 * kq); qa[ks] = __builtin_bit_cast(bf16x8, z); }
}
constexpr int DEC_PL = 1040;
__device__ __forceinline__ void fox_sample_unit(const Frame& F, const Args& a, int u) {
    unsigned char* ws = a.ws; const int bs = u >> 3, h = u & 7;
    LAS float* PL = (LAS float*)F.lds + F.wave * DEC_PL; LAS float* CB = (LAS float*)F.lds + 8 * DEC_PL; constexpr int WSTR = 16 + 8 * 64;
    bf16x8 qa[2]; dec_load_q<64>(qa, (const bf16*)(ws + WS_QF) + (size_t)(TP + bs * LS) * 512 + h * 64, 512, F.lane);
    DecW<64> w; dec_init(w);
    if (F.wave == 0) {
        const int key = F.lane & 15; const float* lf = a.out + O_LFS + (size_t)(bs * LS) * 8 + h; float cn = 0.f;
        for (int j = 0; j < 8; ++j) if (j <= key) cn += lf[j * 8];
        const float* Kb = a.out + O_FKS + (size_t)(bs * LS) * 512 + h * 64; const float* Vb = a.out + O_FVS + (size_t)(bs * LS) * 512 + h * 64;
        dec_chunk<64, 1, 1>(w, qa, Kb, Vb, 512, nullptr, -cn * LOG2E, PL, F.lane);
    }
    const int* pt = (const int*)a.in[I_PT];
    float spx; { const float ptv = (F.lane < 16) ? ((const float*)(ws + WS_MISC + 2 * MiB))[(bs * 8 + h) * NPAGES + F.lane] : 0.f; float v = ptv;
#pragma unroll
        for (int o = 1; o < 64; o <<= 1) { const float t = __shfl_down(v, o); if (F.lane + o < 64) v += t; }
        spx = v - ptv; }
#pragma unroll 1
    for (int pp = 0; pp < 4; ++pp) { const int p = F.wave * 2 + (pp >> 1), hf = pp & 1; const int pg = __builtin_amdgcn_readfirstlane(pt[bs * NPAGES + p]);
        const float* Kb = (const float*)a.in[I_CFK] + (((size_t)pg * PAGE + hf * 64) * 8 + h) * 64; const float* Vb = (const float*)a.in[I_CFV] + (((size_t)pg * PAGE + hf * 64) * 8 + h) * 64;
        dec_chunk<64, 4, 0>(w, qa, Kb, Vb, 512, (const float*)(ws + WS_SUF) + (size_t)(bs * 8 + h) * PASTL + p * PAGE + hf * 64, __shfl(spx, p), PL, F.lane); }
    dec_park<64>(w, CB + F.wave * WSTR, F.lane);
    __syncthreads();
    dec_combine<64>(F, CB, (bf16*)(ws + WS_MERGED) + (size_t)(TP + bs * LS) * DM + h * 64, DM);
    __syncthreads();
}
__device__ __forceinline__ void cross_sample_unit(const Frame& F, const Args& a, int u) {
    unsigned char* ws = a.ws; const int bs = u >> 2, h = u & 3;
    LAS float* PL = (LAS float*)F.lds + F.wave * DEC_PL; LAS float* CB = (LAS float*)F.lds + 8 * DEC_PL; constexpr int WSTR = 16 + 8 * 256;
    bf16x8 qa[8]; dec_load_q<256>(qa, (const bf16*)(ws + WS_QC) + (size_t)(TP + bs * LS) * DM + h * 256, DM, F.lane);
    DecW<256> w; dec_init(w);
    const float* Kb = (const float*)a.in[I_CMK] + ((size_t)(bs * 256 + F.wave * 32) * 4 + h) * 256; const float* Vb = (const float*)a.in[I_CMV] + ((size_t)(bs * 256 + F.wave * 32) * 4 + h) * 256;
#pragma unroll 1
    for (int c = 0; c < 2; ++c) dec_chunk<256, 1, 0>(w, qa, Kb + (size_t)c * 16 * 1024, Vb + (size_t)c * 16 * 1024, 1024, nullptr, 0.f, PL, F.lane);
    dec_park<256>(w, CB + F.wave * WSTR, F.lane);
    __syncthreads();
    dec_combine<256>(F, CB, (bf16*)(ws + WS_OC) + (size_t)(TP + bs * LS) * DM + h * 256, DM);
    __syncthreads();
}


__device__ __forceinline__ void gla_g3_unit(const Frame& F, const Args& a, int u) {
    unsigned char* ws = a.ws;
    const int b = u >> 9, h = (u >> 7) & 3, n = u & 127; const int row0 = b * SEQ + n * 64;
    LAS float* QDT = (LAS float*)F.lds; LAS float* KIT = QDT + 4352; LAS float* LA = KIT + 4352; LAS float* ATT = LA; LAS float* VS = LA + 4352; LAS float* SP = VS + 8192;
#pragma unroll
    for (int i = 0; i < 16; ++i) { const int e = F.tid + NTHR * i; VS[e] = ((const float*)(ws + WS_GV))[(size_t)(row0 + (e >> 7)) * 512 + h * 128 + (e & 127)];
        SP[e] = ((const float*)(ws + WS_GKV))[((size_t)((b * 4 + h) * 128 + n) * 64) * 128 + e]; }
#pragma unroll
    for (int i = 0; i < 8; ++i) { const int e = F.tid + NTHR * i, t = e >> 6, dk = e & 63; const size_t gi = (size_t)(row0 + t) * 256 + h * 64 + dk;
        const float bb = ((const float*)(ws + WS_BB))[gi];
        QDT[dk * 68 + t] = ((const float*)(ws + WS_GQ))[gi] * __expf(bb); KIT[dk * 68 + t] = ((const float*)(ws + WS_GK))[gi] * __expf(-bb); }
    __syncthreads();
    {
        const int tp = F.tid & 31, sq = F.tid >> 5; float acc[2][4];
#pragma unroll
        for (int i = 0; i < 2; ++i)
#pragma unroll
            for (int j = 0; j < 4; ++j) acc[i][j] = 0.f;
        if (4 * sq <= 2 * tp + 1) {
#pragma unroll 8
            for (int dk = 0; dk < 64; ++dk) { const f32x2 q2 = *(const LAS f32x2*)(QDT + dk * 68 + 2 * tp); const f32x4 k4 = *(const LAS f32x4*)(KIT + dk * 68 + 4 * sq);
#pragma unroll
                for (int j = 0; j < 4; ++j) { acc[0][j] += q2.x * k4[j]; acc[1][j] += q2.y * k4[j]; } }
        }
#pragma unroll
        for (int j = 0; j < 4; ++j) { const int s = 4 * sq + j; f32x2 o; o.x = (s <= 2 * tp) ? acc[0][j] : 0.f; o.y = (s <= 2 * tp + 1) ? acc[1][j] : 0.f; *(LAS f32x2*)(ATT + s * 68 + 2 * tp) = o; }
    }
    __syncthreads();
    {
        const int dvq = F.tid & 31, tq = F.tid >> 5; float acc[4][4];
#pragma unroll
        for (int i = 0; i < 4; ++i)
#pragma unroll
            for (int j = 0; j < 4; ++j) acc[i][j] = 0.f;
#pragma unroll 8
        for (int s = 0; s < 64; ++s) { const f32x4 v4 = *(const LAS f32x4*)(VS + s * 128 + 4 * dvq), a4 = *(const LAS f32x4*)(ATT + s * 68 + 4 * tq);
#pragma unroll
            for (int i = 0; i < 4; ++i)
#pragma unroll
                for (int j = 0; j < 4; ++j) acc[i][j] += a4[i] * v4[j]; }
#pragma unroll 8
        for (int dk = 0; dk < 64; ++dk) { const f32x4 v4 = *(const LAS f32x4*)(SP + dk * 128 + 4 * dvq), a4 = *(const LAS f32x4*)(QDT + dk * 68 + 4 * tq);
#pragma unroll
            for (int i = 0; i < 4; ++i)
#pragma unroll
                for (int j = 0; j < 4; ++j) acc[i][j] += a4[i] * v4[j]; }
        __syncthreads();
#pragma unroll
        for (int i = 0; i < 4; ++i) *(LAS f32x4*)(VS + (4 * tq + i) * 128 + 4 * dvq) = (f32x4){acc[i][0], acc[i][1], acc[i][2], acc[i][3]};
    }
    __syncthreads();
#pragma unroll
    for (int rr = 0; rr < 8; ++rr) { const int t = F.wave * 8 + rr; const float v0 = VS[t * 128 + F.lane], v1 = VS[t * 128 + 64 + F.lane];
        const float r = rsqrtf(wave_sum(v0 * v0 + v1 * v1) * (1.f / 128.f) + EPS);
        const float* ggo = (const float*)a.in[I_GGO] + h * 128; const float* gr = (const float*)(ws + WS_GR) + (size_t)(row0 + t) * 512 + h * 128;
        bf16* mo = (bf16*)(ws + WS_MERGED) + (size_t)(row0 + t) * DM + 512 + h * 128;
        mo[F.lane] = (bf16)f2bf(v0 * r * ggo[F.lane] * silu(gr[F.lane])); mo[64 + F.lane] = (bf16)f2bf(v1 * r * ggo[64 + F.lane] * silu(gr[64 + F.lane])); }
    __syncthreads();
}

struct EpiSoftmaxP {
    static constexpr bool PERM = false, AFTER_DRAIN = true;
    const LAS unsigned long long* argp;
    __device__ __forceinline__ void fused(f32x4 (&acc)[2][2][4][2], const Unit&, int wr, int wc, int fr, int fq, PG8_LAS unsigned char* lds, int wid, int lane) const {
        LAS float* PM = (LAS float*)lds; LAS float* PS = PM + 1024;
        const int ub = (int)blockIdx.x; const int ldp = DM;
        bf16* P = (bf16*)((unsigned char*)ld_ptr(argp + N_INPUTS + 1) + WS_PC) + ((size_t)((ub >> 7) & 1) * SEQ + (ub & 31) * 256) * DM + ((ub >> 5) & 3) * 256;
        { int t2 = threadIdx.x; asm volatile("" : "+v"(t2)); fr = t2 & 15; fq = (t2 >> 4) & 3; }
#pragma unroll
        for (int ai = 0; ai < 2; ++ai)
#pragma unroll
            for (int m = 0; m < 4; ++m) { float mx = -INFINITY;
#pragma unroll
                for (int bj = 0; bj < 2; ++bj)
#pragma unroll
                    for (int n = 0; n < 2; ++n) { const f32x4 x = acc[ai][bj][m][n]; mx = fmaxf(mx, fmaxf(fmaxf(x[0], x[1]), fmaxf(x[2], x[3]))); }
                mx = fmaxf(mx, __shfl_xor(mx, 16)); mx = fmaxf(mx, __shfl_xor(mx, 32));
                if (fq == 0) PM[(ai * 128 + wr * 64 + m * 16 + fr) * 4 + wc] = mx; }
        asm volatile("s_waitcnt lgkmcnt(0)" ::: "memory"); __builtin_amdgcn_s_barrier(); asm volatile("" ::: "memory");
#pragma unroll
        for (int ai = 0; ai < 2; ++ai)
#pragma unroll
            for (int m = 0; m < 4; ++m) { const int r = ai * 128 + wr * 64 + m * 16 + fr; const f32x4 pm = *(const LAS f32x4*)(PM + r * 4);
                const float M = fmaxf(fmaxf(pm[0], pm[1]), fmaxf(pm[2], pm[3])); float s = 0.f;
#pragma unroll
                for (int bj = 0; bj < 2; ++bj)
#pragma unroll
                    for (int n = 0; n < 2; ++n) { f32x4 x = acc[ai][bj][m][n]; x[0] = fexp2(x[0] - M); x[1] = fexp2(x[1] - M); x[2] = fexp2(x[2] - M); x[3] = fexp2(x[3] - M); acc[ai][bj][m][n] = x; s += (x[0] + x[1]) + (x[2] + x[3]); }
                s += __shfl_xor(s, 16); s += __shfl_xor(s, 32);
                if (fq == 0) PS[r * 4 + wc] = s; }
        asm volatile("s_waitcnt lgkmcnt(0)" ::: "memory"); __builtin_amdgcn_s_barrier(); asm volatile("" ::: "memory");
#pragma unroll
        for (int ai = 0; ai < 2; ++ai)
#pragma unroll
            for (int m = 0; m < 4; ++m) { const int r = ai * 128 + wr * 64 + m * 16 + fr; const f32x4 ps = *(const LAS f32x4*)(PS + r * 4); const float inv = 1.f / ((ps[0] + ps[1]) + (ps[2] + ps[3]));
#pragma unroll
                for (int bj = 0; bj < 2; ++bj)
#pragma unroll
                    for (int n = 0; n < 2; ++n) { const f32x4 x = acc[ai][bj][m][n]; v2u o; o.x = pg8::cvt_pk_bf16(x[0] * inv, x[1] * inv); o.y = pg8::cvt_pk_bf16(x[2] * inv, x[3] * inv);
                        *(v2u*)(P + (size_t)r * ldp + bj * 128 + wc * 32 + n * 16 + fq * 4) = o; } }
        asm volatile("s_waitcnt lgkmcnt(0)" ::: "memory"); __builtin_amdgcn_s_barrier(); asm volatile("" ::: "memory");
    }
};

__device__ __forceinline__ void rms_rows_phase(const Frame& F, const float* X, const float* g, bf16* H) {
    const int gw = F.vcu * NWAVES + F.wave, NGW = F.G * NWAVES;
    for (int m = gw; m < TA; m += NGW) rms_row_bf16(X + (size_t)m * DM, g, H + (size_t)m * DM, F.lane);
}

__device__ __forceinline__ unsigned f2sort(float f) { const unsigned u = __builtin_bit_cast(unsigned, f); return u ^ ((u >> 31) ? 0xFFFFFFFFu : 0x80000000u); }
__device__ __forceinline__ float sort2f(unsigned s) { const unsigned u = s ^ ((s >> 31) ? 0x80000000u : 0xFFFFFFFFu); return __builtin_bit_cast(float, u); }
__device__ __forceinline__ float gelu_tanh(float x) { const float y = 0.7978845608028654f * (x + 0.044715f * x * x * x); const float e = __expf(2.f * y); return 0.5f * x * (1.f + (1.f - 2.f / (e + 1.f))); }
__device__ __forceinline__ unsigned gmax16(unsigned v) {
#pragma unroll
    for (int o = 1; o < 16; o <<= 1) { const unsigned t = (unsigned)__shfl_xor((int)v, o); v = v > t ? v : t; }
    return v;
}
typedef __bf16 bf16x2_t __attribute__((ext_vector_type(2)));
__device__ __forceinline__ float dot2bf(unsigned a, unsigned b, float c) {
#if __has_builtin(__builtin_amdgcn_fdot2_f32_bf16)
    return __builtin_amdgcn_fdot2_f32_bf16(__builtin_bit_cast(bf16x2_t, a), __builtin_bit_cast(bf16x2_t, b), c, false);
#else
    return c + bflo(a) * bflo(b) + bfhi(a) * bfhi(b);
#endif
}
__device__ __forceinline__ void peer_token(const Frame& F, const Args& a, int row, LAS unsigned* TOPS, int ci0, int cj0, int ci1, int cj1, int ci2, int cj2, int ci3, int cj3, bool cv3) {
    unsigned char* ws = a.ws; const int lane = F.lane, grp = lane >> 4, j16 = lane & 15;
    const float* sc = (const float*)(ws + WS_SC) + (size_t)row * 2048;
#pragma unroll 1
    for (int bt = 0; bt < 4; ++bt) {
        const f32x4 x0 = *(const f32x4*)(sc + (bt * 4 + grp) * 128 + 8 * j16), x1 = *(const f32x4*)(sc + (bt * 4 + grp) * 128 + 8 * j16 + 4);
        unsigned k[8]; const float xs[8] = {x0.x, x0.y, x0.z, x0.w, x1.x, x1.y, x1.z, x1.w};
#pragma unroll
        for (int e = 0; e < 8; ++e) k[e] = (f2sort(xs[e]) & ~127u) | (unsigned)(127 - (8 * j16 + e));
        unsigned mine = 0u;
#pragma unroll 1
        for (int r = 0; r < 16; ++r) {
            unsigned m = k[0];
#pragma unroll
            for (int e = 1; e < 8; ++e) m = m > k[e] ? m : k[e];
            m = gmax16(m);
            if (j16 == r) mine = m;
#pragma unroll
            for (int e = 0; e < 8; ++e) k[e] = (k[e] == m) ? 0u : k[e];
        }
        TOPS[(bt * 4 + grp) * 16 + j16] = mine;
    }
    int ex[2]; float gx[2], sux[2];
#pragma unroll
    for (int ps = 0; ps < 2; ++ps) {
        const int hd = ps * 4 + grp; const LAS unsigned* T1 = TOPS + (2 * hd) * 16; const LAS unsigned* T2 = T1 + 16;
        unsigned k[4];
        { const float s0 = sort2f(T1[ci0] & ~127u) + sort2f(T2[cj0] & ~127u), s1 = sort2f(T1[ci1] & ~127u) + sort2f(T2[cj1] & ~127u),
                      s2 = sort2f(T1[ci2] & ~127u) + sort2f(T2[cj2] & ~127u), s3 = sort2f(T1[ci3] & ~127u) + sort2f(T2[cj3] & ~127u);
          k[0] = (f2sort(s0) & ~127u) | (unsigned)(127 - j16); k[1] = (f2sort(s1) & ~127u) | (unsigned)(127 - (j16 + 16)); k[2] = (f2sort(s2) & ~127u) | (unsigned)(127 - (j16 + 32));
          k[3] = cv3 ? ((f2sort(s3) & ~127u) | (unsigned)(127 - (j16 + 48))) : 0u; }
        unsigned mine = 0u;
#pragma unroll 1
        for (int r = 0; r < 16; ++r) {
            unsigned m = k[0] > k[1] ? k[0] : k[1]; const unsigned m2 = k[2] > k[3] ? k[2] : k[3]; m = m > m2 ? m : m2;
            m = gmax16(m);
            if (j16 == r) mine = m;
#pragma unroll
            for (int e = 0; e < 4; ++e) k[e] = (k[e] == m) ? 0u : k[e];
        }
        const int c = 127 - (int)(mine & 127u);
        int ci, cj;
        if (c < 16) { ci = 0; cj = c; } else if (c < 24) { ci = 1; cj = c - 16; } else if (c < 29) { ci = 2; cj = c - 24; } else if (c < 33) { ci = 3; cj = c - 29; }
        else if (c < 36) { ci = 4; cj = c - 33; } else if (c < 38) { ci = 5; cj = c - 36; } else if (c < 40) { ci = 6; cj = c - 38; } else if (c < 42) { ci = 7; cj = c - 40; } else { ci = c - 34; cj = 0; }
        const int i1 = 127 - (int)(T1[ci] & 127u), i2 = 127 - (int)(T2[cj] & 127u);
        ex[ps] = i1 * 128 + i2;
        const float sv = sort2f(mine & ~127u); const float s0 = __shfl(sv, lane & 48);
        float ee = __expf(sv - s0); float es = ee;
#pragma unroll
        for (int o = 1; o < 16; o <<= 1) es += __shfl_xor(es, o);
        const float* rsc = (const float*)(ws + WS_MISC);
        sux[ps] = rsc[ex[ps]]; gx[ps] = ee / es * rsc[16384 + ex[ps]];
    }
    {
        unsigned k0 = ((unsigned)ex[0] << 7) | (unsigned)lane, k1 = ((unsigned)ex[1] << 7) | (unsigned)(64 + lane);
#pragma unroll
        for (int k = 2; k <= 128; k <<= 1) {
#pragma unroll
            for (int j = k >> 1; j > 0; j >>= 1) {
                if (j == 64) { const unsigned lo = k0 < k1 ? k0 : k1, hi = k0 < k1 ? k1 : k0; k0 = lo; k1 = hi; }
                else {
                    const unsigned p0 = (unsigned)__shfl_xor((int)k0, j), p1 = (unsigned)__shfl_xor((int)k1, j);
                    const bool low = (lane & j) == 0; const bool asc0 = (lane & k) == 0, asc1 = ((64 + lane) & k) == 0;
                    const unsigned mn0 = k0 < p0 ? k0 : p0, mx0 = k0 < p0 ? p0 : k0, mn1 = k1 < p1 ? k1 : p1, mx1 = k1 < p1 ? p1 : k1;
                    k0 = (low == asc0) ? mn0 : mx0; k1 = (low == asc1) ? mn1 : mx1;
                }
            }
        }
        const int o0 = (int)(k0 & 127u), o1 = (int)(k1 & 127u);
        const float g0a = __shfl(gx[0], o0 & 63), g0b = __shfl(gx[1], o0 & 63), g1a = __shfl(gx[0], o1 & 63), g1b = __shfl(gx[1], o1 & 63);
        const float s0a = __shfl(sux[0], o0 & 63), s0b = __shfl(sux[1], o0 & 63), s1a = __shfl(sux[0], o1 & 63), s1b = __shfl(sux[1], o1 & 63);
        gx[0] = (o0 & 64) ? g0b : g0a; gx[1] = (o1 & 64) ? g1b : g1a; sux[0] = (o0 & 64) ? s0b : s0a; sux[1] = (o1 & 64) ? s1b : s1a;
        ex[0] = (int)(k0 >> 7); ex[1] = (int)(k1 >> 7);
    }
    const float rstd2 = rsqrtf(((const float*)(ws + WS_SS))[TA + row] * (1.f / 1024.f) + EPS);
    float hf[16];
    { const v4u* hp = (const v4u*)((const bf16*)(ws + WS_HB) + (size_t)row * DM + 16 * lane); const v4u h0 = hp[0], h1 = hp[1];
#pragma unroll
      for (int q = 0; q < 4; ++q) { hf[2 * q] = bflo(h0[q]); hf[2 * q + 1] = bfhi(h0[q]); hf[8 + 2 * q] = bflo(h1[q]); hf[8 + 2 * q + 1] = bfhi(h1[q]); } }
    float oacc[16];
#pragma unroll
    for (int i = 0; i < 16; ++i) oacc[i] = 0.f;
    const unsigned char* U = ws + WS_U16; const unsigned char* V = ws + WS_V16;
    v4u ub[8], vb[8];
#pragma unroll
    for (int i = 0; i < 8; ++i) { const int e = __builtin_amdgcn_readlane(ex[0], i); ub[i] = *(const v4u*)(U + (size_t)e * DM + 16 * lane); }
#pragma unroll 1
    for (int g8 = 0; g8 < 16; ++g8) {
        const int kb = g8 * 8; const int exs = (kb < 64) ? ex[0] : ex[1]; const float gxs = (kb < 64) ? gx[0] : gx[1]; const float sus = (kb < 64) ? sux[0] : sux[1];
#pragma unroll
        for (int i = 0; i < 8; ++i) { const int e = __builtin_amdgcn_readlane(exs, (kb & 63) + i); vb[i] = *(const v4u*)(V + (size_t)e * DM + 16 * lane); }
        float av[8];
#pragma unroll
        for (int i = 0; i < 8; ++i) { float s = 0.f;
#pragma unroll
            for (int q = 0; q < 4; ++q) { const f32x2 lo = __builtin_amdgcn_cvt_pk_f32_fp8((int)ub[i][q], false), hi = __builtin_amdgcn_cvt_pk_f32_fp8((int)ub[i][q], true);
                s += lo.x * hf[4 * q]; s += lo.y * hf[4 * q + 1]; s += hi.x * hf[4 * q + 2]; s += hi.y * hf[4 * q + 3]; }
            av[i] = s; }
        const bool b5 = lane & 32, b4 = lane & 16, b3 = lane & 8;
        float bq[4], cq[2], dq;
#pragma unroll
        for (int i = 0; i < 4; ++i) bq[i] = (b5 ? av[4 + i] : av[i]) + __shfl_xor(b5 ? av[i] : av[4 + i], 32);
#pragma unroll
        for (int i = 0; i < 2; ++i) cq[i] = (b4 ? bq[2 + i] : bq[i]) + __shfl_xor(b4 ? bq[i] : bq[2 + i], 16);
        dq = (b3 ? cq[1] : cq[0]) + __shfl_xor(b3 ? cq[0] : cq[1], 8);
        dq += __shfl_xor(dq, 4); dq += __shfl_xor(dq, 2); dq += __shfl_xor(dq, 1);
        const int src = (kb & 63) + (lane >> 3);
#if defined(PROBE_NOPEER)
        const float wmine = 0.f * __shfl(gxs, src) * gelu_tanh(dq * __shfl(sus, src));
#else
        const float wmine = __shfl(gxs, src) * gelu_tanh(dq * __shfl(sus, src) * rstd2);
#endif
        if (g8 < 15) { const int kn = kb + 8; const int exn = (kn < 64) ? ex[0] : ex[1];
#pragma unroll
            for (int i = 0; i < 8; ++i) { const int e = __builtin_amdgcn_readlane(exn, (kn & 63) + i); ub[i] = *(const v4u*)(U + (size_t)e * DM + 16 * lane); } }
#pragma unroll
        for (int i = 0; i < 8; ++i) { const float w = __builtin_bit_cast(float, __builtin_amdgcn_readlane(__builtin_bit_cast(int, wmine), 8 * i));
#pragma unroll
            for (int q = 0; q < 4; ++q) { const f32x2 lo = __builtin_amdgcn_cvt_pk_f32_fp8((int)vb[i][q], false), hi = __builtin_amdgcn_cvt_pk_f32_fp8((int)vb[i][q], true);
                oacc[4 * q] += w * lo.x; oacc[4 * q + 1] += w * lo.y; oacc[4 * q + 2] += w * hi.x; oacc[4 * q + 3] += w * hi.y; } }
    }
    const f32x4* x2 = (const f32x4*)((const float*)(ws + WS_X2) + (size_t)row * DM + 16 * lane);
    f32x4 xv[4]; float ss = 0.f;
#pragma unroll
    for (int q = 0; q < 4; ++q) { xv[q] = x2[q]; xv[q].x += oacc[4 * q]; xv[q].y += oacc[4 * q + 1]; xv[q].z += oacc[4 * q + 2]; xv[q].w += oacc[4 * q + 3]; ss += (xv[q].x * xv[q].x + xv[q].y * xv[q].y) + (xv[q].z * xv[q].z + xv[q].w * xv[q].w); }
    const float r = rsqrtf(wave_sum(ss) * (1.f / DM) + EPS);
    const f32x4* gf = (const f32x4*)((const float*)a.in[I_GFIN] + 16 * lane);
    f32x4* y = (f32x4*)((row < TP ? a.out + O_YP + (size_t)row * DM : a.out + O_YS + (size_t)(row - TP) * DM) + 16 * lane);
#pragma unroll
    for (int q = 0; q < 4; ++q) { const f32x4 g4 = gf[q]; f32x4 o; o.x = xv[q].x * r * g4.x; o.y = xv[q].y * r * g4.y; o.z = xv[q].z * r * g4.z; o.w = xv[q].w * r * g4.w; y[q] = o; }
}
__device__ __forceinline__ void cand_ij(int c, int& ci, int& cj) {
    if (c < 16) { ci = 0; cj = c; } else if (c < 24) { ci = 1; cj = c - 16; } else if (c < 29) { ci = 2; cj = c - 24; } else if (c < 33) { ci = 3; cj = c - 29; }
    else if (c < 36) { ci = 4; cj = c - 33; } else if (c < 38) { ci = 5; cj = c - 36; } else if (c < 40) { ci = 6; cj = c - 38; } else if (c < 42) { ci = 7; cj = c - 40; } else if (c < 50) { ci = c - 34; cj = 0; } else { ci = 0; cj = 0; }
}
__device__ __forceinline__ void peer_phase(const Frame& F, const Args& a) {
    LAS unsigned* TOPS = (LAS unsigned*)F.lds + F.wave * 256;
    const int j16 = F.lane & 15; int ci0, cj0, ci1, cj1, ci2, cj2, ci3, cj3;
    cand_ij(j16, ci0, cj0); cand_ij(j16 + 16, ci1, cj1); cand_ij(j16 + 32, ci2, cj2); cand_ij(j16 + 48, ci3, cj3);
    const bool cv3 = (j16 + 48) < 50;
    const int gw = F.vcu * NWAVES + F.wave, NGW = F.G * NWAVES;
#pragma unroll 1
    for (int row = gw; row < TA; row += NGW) peer_token(F, a, row, TOPS, ci0, cj0, ci1, cj1, ci2, cj2, ci3, cj3, cv3);
}


template <class EpiS>
__device__ __forceinline__ void skinny_tile(const Frame& F, const bf16* A, int lda, const bf16* Bt, int ldb, int tm, int tn, const EpiS& E) {
    const int lane = F.lane, r32 = lane & 31, hi = lane >> 5, w = F.wave;
    const bf16* ap = A + (size_t)(tm * 64 + r32) * lda + w * 128 + 8 * hi;
    const bf16* bp = Bt + (size_t)(tn * 64 + r32) * ldb + w * 128 + 8 * hi;
    v4u af[2][8], bfr[2][8];
#pragma unroll
    for (int ks = 0; ks < 8; ++ks) {
        af[0][ks] = *(const v4u*)(ap + ks * 16); af[1][ks] = *(const v4u*)(ap + (size_t)32 * lda + ks * 16);
        bfr[0][ks] = *(const v4u*)(bp + ks * 16); bfr[1][ks] = *(const v4u*)(bp + (size_t)32 * ldb + ks * 16); }
    f32x16 acc[2][2];
#pragma unroll
    for (int i = 0; i < 2; ++i)
#pragma unroll
        for (int j = 0; j < 2; ++j) acc[i][j] = f32x16{};
#pragma unroll
    for (int ks = 0; ks < 8; ++ks)
#pragma unroll
        for (int i = 0; i < 2; ++i)
#pragma unroll
            for (int j = 0; j < 2; ++j) acc[i][j] = __builtin_amdgcn_mfma_f32_32x32x16_bf16(__builtin_bit_cast(bf16x8, af[i][ks]), __builtin_bit_cast(bf16x8, bfr[j][ks]), acc[i][j], 0, 0, 0);
    LAS float* PS = (LAS float*)F.lds + w * 4096;
#pragma unroll
    for (int i = 0; i < 2; ++i)
#pragma unroll
        for (int j = 0; j < 2; ++j)
#pragma unroll
            for (int r = 0; r < 16; ++r) PS[(32 * i + crow(r, hi)) * 64 + 32 * j + r32] = acc[i][j][r];
    __syncthreads();
    {
        const int row = F.tid >> 3, c8 = (F.tid & 7) * 8; const LAS float* P0 = (const LAS float*)F.lds + row * 64 + c8;
        f32x4 s0 = *(const LAS f32x4*)P0, s1 = *(const LAS f32x4*)(P0 + 4);
#pragma unroll
        for (int ww = 1; ww < 8; ++ww) { s0 += *(const LAS f32x4*)(P0 + ww * 4096); s1 += *(const LAS f32x4*)(P0 + ww * 4096 + 4); }
        float v[8] = {s0.x, s0.y, s0.z, s0.w, s1.x, s1.y, s1.z, s1.w};
        E(tm * 64 + row, tn * 64 + c8, v, F.tid);
    }
    __syncthreads();
}
struct EpiSk {
    float* d32; int ld32; bf16* d16; int ld16; float sc16;
    const float* res; int ldr;
    const float* gcol; float* ssq; const float* rsq;
    __device__ __forceinline__ void operator()(int row, int col, float (&v)[8], int tid) const {
        if (rsq) { const float rs = rsqrtf(rsq[row] * (1.f / 1024.f) + EPS);
#pragma unroll
            for (int i = 0; i < 8; ++i) v[i] *= rs; }
        if (res) { const f32x4 a = *(const f32x4*)(res + (size_t)row * ldr + col), b = *(const f32x4*)(res + (size_t)row * ldr + col + 4);
            v[0] += a.x; v[1] += a.y; v[2] += a.z; v[3] += a.w; v[4] += b.x; v[5] += b.y; v[6] += b.z; v[7] += b.w; }
        if (d32) { *(f32x4*)(d32 + (size_t)row * ld32 + col) = (f32x4){v[0], v[1], v[2], v[3]}; *(f32x4*)(d32 + (size_t)row * ld32 + col + 4) = (f32x4){v[4], v[5], v[6], v[7]}; }
        if (ssq) { float ss = 0.f;
#pragma unroll
            for (int i = 0; i < 8; ++i) ss += v[i] * v[i];
            ss += __shfl_xor(ss, 1); ss += __shfl_xor(ss, 2); ss += __shfl_xor(ss, 4);
            if ((tid & 7) == 0) atomicAdd(ssq + row, ss); }
        if (d16) { float w8[8];
#pragma unroll
            for (int i = 0; i < 8; ++i) w8[i] = v[i];
            if (gcol) { const f32x4 a = *(const f32x4*)(gcol + col), b = *(const f32x4*)(gcol + col + 4); w8[0] *= a.x; w8[1] *= a.y; w8[2] *= a.z; w8[3] *= a.w; w8[4] *= b.x; w8[5] *= b.y; w8[6] *= b.z; w8[7] *= b.w; }
            v4u o; o.x = pg8::cvt_pk_bf16(w8[0] * sc16, w8[1] * sc16); o.y = pg8::cvt_pk_bf16(w8[2] * sc16, w8[3] * sc16); o.z = pg8::cvt_pk_bf16(w8[4] * sc16, w8[5] * sc16); o.w = pg8::cvt_pk_bf16(w8[6] * sc16, w8[7] * sc16);
            *(v4u*)(d16 + (size_t)row * ld16 + col) = o; }
    }
};


#ifndef PH_MAX
#define PH_MAX 99
#endif
__global__ void __launch_bounds__(NTHR, 2) mega_fwd(Args args) {
    extern __shared__ __attribute__((aligned(16))) unsigned char lds_raw[];
    Frame F;
    F.lds = (LAS unsigned char*)lds_raw;
    F.tid = threadIdx.x; F.lane = F.tid & 63; F.wave = __builtin_amdgcn_readfirstlane(F.tid >> 6);
    F.G = gridDim.x; { const int bx = blockIdx.x; F.vcu = (F.G % 8 == 0) ? (bx % 8) * (F.G / 8) + bx / 8 : bx; }
    volatile LAS unsigned* MISC = (volatile LAS unsigned*)(F.lds + MISC_OFF);
    LAS unsigned long long* ARGP = (LAS unsigned long long*)(F.lds + ARGS_OFF);
    for (int u = F.tid; u < (LDS_BYTES - LDSCTL_OFF) / 4; u += NTHR) ((LAS unsigned*)(F.lds + LDSCTL_OFF))[u] = 0u;
    __syncthreads();
    if (F.tid == 0) {
        ARGP[0] = (unsigned long long)args.in[0];
        ARGP[1] = (unsigned long long)args.in[1];
        ARGP[2] = (unsigned long long)args.in[2];
        ARGP[3] = (unsigned long long)args.in[3];
        ARGP[4] = (unsigned long long)args.in[4];
        ARGP[5] = (unsigned long long)args.in[5];
        ARGP[6] = (unsigned long long)args.in[6];
        ARGP[7] = (unsigned long long)args.in[7];
        ARGP[8] = (unsigned long long)args.in[8];
        ARGP[9] = (unsigned long long)args.in[9];
        ARGP[10] = (unsigned long long)args.in[10];
        ARGP[11] = (unsigned long long)args.in[11];
        ARGP[12] = (unsigned long long)args.in[12];
        ARGP[13] = (unsigned long long)args.in[13];
        ARGP[14] = (unsigned long long)args.in[14];
        ARGP[15] = (unsigned long long)args.in[15];
        ARGP[16] = (unsigned long long)args.in[16];
        ARGP[17] = (unsigned long long)args.in[17];
        ARGP[18] = (unsigned long long)args.in[18];
        ARGP[19] = (unsigned long long)args.in[19];
        ARGP[20] = (unsigned long long)args.in[20];
        ARGP[21] = (unsigned long long)args.in[21];
        ARGP[22] = (unsigned long long)args.in[22];
        ARGP[23] = (unsigned long long)args.in[23];
        ARGP[24] = (unsigned long long)args.in[24];
        ARGP[25] = (unsigned long long)args.in[25];
        ARGP[26] = (unsigned long long)args.in[26];
        ARGP[27] = (unsigned long long)args.in[27];
        ARGP[28] = (unsigned long long)args.in[28];
        ARGP[N_INPUTS] = (unsigned long long)args.out; ARGP[N_INPUTS + 1] = (unsigned long long)args.ws;
    }
    __syncthreads();
    { const XcdBarrier bar0 = xcd_barrier_post((unsigned*)((gu32*)(args.ws + WS_CTL) + CW_BAR), MISC + 8); if (F.tid == 0) MISC[10] = bar0.x; }
    __syncthreads();
#define GRID_BAR() do { XcdBarrier bar_; bar_.bar = (unsigned*)((gu32*)((unsigned char*)ld_ptr(ARGP + N_INPUTS + 1) + WS_CTL) + CW_BAR); bar_.x = MISC[10]; bar_.st = MISC + 8; xcd_barrier(bar_); } while (0)
#define PHASE_ARGS const Args A = load_args(ARGP); unsigned char* const ws = A.ws; float* const out = A.out; (void)ws; (void)out; { int t_ = threadIdx.x; asm volatile("" : "+v"(t_)); F.tid = t_; F.lane = t_ & 63; }

    { PHASE_ARGS;
    p0_prologue(F, A);
    }
    GRID_BAR();
#if defined(PROBE_BAR8)
    GRID_BAR(); GRID_BAR(); GRID_BAR(); GRID_BAR(); GRID_BAR(); GRID_BAR(); GRID_BAR(); GRID_BAR();
#endif
#if PH_MAX >= 1
    { PHASE_ARGS;
    {
        pg8::Gemm g{(const bf16*)(ws + WS_HB), (const bf16*)(ws + WS_WIN), DM, DM, DM};
        pg8::StaticOrder S; S.init(TA, N_IN, F.G, (int)blockIdx.x);
        EpiInProj E{out, ws, (const float*)A.in[I_BFF]};
        pg8::gemm_phase(F.lds, g, S, E);
    }
    {
        const int off = (TA / 256) * (N_IN / 256) % F.G;
        pg8::Gemm g{(const bf16*)(ws + WS_MB), (const bf16*)(ws + WS_WMK), DM, DM, DM};
        pg8::StaticOrder S; S.init(512, DM, F.G, ((int)blockIdx.x + F.G - off) % F.G);
        EpiGen E{out + O_MKP, DM, (bf16*)(ws + WS_MK16), DM, 1.f, nullptr, nullptr, 0, 0, nullptr, nullptr, nullptr};
        pg8::gemm_phase(F.lds, g, S, E);
    }
    {
        const int off = ((TA / 256) * (N_IN / 256) + 8) % F.G;
        pg8::Gemm g{(const bf16*)(ws + WS_MB), (const bf16*)(ws + WS_WMV), DM, DM, DM};
        pg8::StaticOrder S; S.init(512, DM, F.G, ((int)blockIdx.x + F.G - off) % F.G);
        EpiGen E{out + O_MVP, DM, nullptr, 0, 1.f, nullptr, nullptr, 0, 0, nullptr, nullptr, nullptr};
        pg8::gemm_phase(F.lds, g, S, E);
    }
    {
        const int off = ((TA / 256) * (N_IN / 256) + 16) % F.G;
        pg8::Gemm g{(const bf16*)(ws + WS_WMV), (const bf16*)(ws + WS_MB), DM, DM, DM};
        pg8::StaticOrder S; S.init(DM, 512, F.G, ((int)blockIdx.x + F.G - off) % F.G);
        EpiGen E{nullptr, 0, (bf16*)(ws + WS_MVT16), 512, 1.f, nullptr, nullptr, 0, 0, nullptr, nullptr, nullptr};
        pg8::gemm_phase(F.lds, g, S, E);
    }
    }
    GRID_BAR();
#endif
#if PH_MAX >= 2
    asm volatile("; ===PHASE 2===");
    { PHASE_ARGS;
    {
        const int gw = F.vcu * NWAVES + F.wave, NGW = F.G * NWAVES;
        for (int it = gw; it < 512; it += NGW) fox_norms_item(F, (const bf16*)(ws + WS_QF), (const bf16*)(ws + WS_KF), out + O_LFP, (float*)(ws + WS_MISC + MiB), (float*)(ws + WS_KBIAS), (float*)(ws + WS_MISC + MiB + 65536), it);
        for (int it = gw; it < NB_S * NPAGES; it += NGW) fox_suffix_item(F, (const float*)A.in[I_CFL], (const int*)A.in[I_PT], (float*)(ws + WS_SUF), (float*)(ws + WS_MISC + 2 * MiB), it);
        for (int u = F.vcu; u < 1024; u += F.G) gla_g1_unit(F, A, u);
        for (int u = F.vcu; u < 512; u += F.G) gla_sample_unit(F, A, u);
    }
    }
    GRID_BAR();
#endif
#if PH_MAX >= 3
    asm volatile("; ===PHASE 3===");
    { PHASE_ARGS;
    gla_scan(F, A);
    __syncthreads();
    for (int i = F.vcu; i < 256; i += F.G) { const int bh = i >> 4, s = i & 15;
        fox_attn_unit(F, (const bf16*)(ws + WS_QF), (const bf16*)(ws + WS_KF), (const bf16*)(ws + WS_VF), (const float*)(ws + WS_KBIAS), (const float*)(ws + WS_MISC + MiB + 65536), (const float*)(ws + WS_MISC + MiB), (bf16*)(ws + WS_MERGED), bh >> 3, bh & 7, s);
        fox_attn_unit(F, (const bf16*)(ws + WS_QF), (const bf16*)(ws + WS_KF), (const bf16*)(ws + WS_VF), (const float*)(ws + WS_KBIAS), (const float*)(ws + WS_MISC + MiB + 65536), (const float*)(ws + WS_MISC + MiB), (bf16*)(ws + WS_MERGED), bh >> 3, bh & 7, 31 - s); }
    for (int u = F.vcu; u < 1024; u += F.G) fox_sample_unit(F, A, u);
    }
    GRID_BAR();
#endif
#if PH_MAX >= 4
    asm volatile("; ===PHASE 4===");
    { PHASE_ARGS;
    for (int u = F.vcu; u < 1024; u += F.G) gla_g3_unit(F, A, u);
    }
    GRID_BAR();
#endif
#if PH_MAX >= 5
    asm volatile("; ===PHASE 5===");
    { PHASE_ARGS;
    {
        pg8::Gemm g{(const bf16*)(ws + WS_MERGED), (const bf16*)(ws + WS_WOUT), DM, DM, DM};
        pg8::StaticOrder S; S.init(TP, DM, F.G, (int)blockIdx.x);
        EpiGen E{(float*)(ws + WS_X1), DM, (bf16*)(ws + WS_HB), DM, 1.f, (const float*)A.in[I_XP], (const float*)A.in[I_XS], TP, DM, (const float*)A.in[I_GCROSS], (float*)(ws + WS_SS), nullptr};
        pg8::gemm_phase(F.lds, g, S, E);
        __syncthreads();
        EpiSk Es{(float*)(ws + WS_X1) + (size_t)TP * DM, DM, (bf16*)(ws + WS_HB) + (size_t)TP * DM, DM, 1.f, (const float*)A.in[I_XS], DM, (const float*)A.in[I_GCROSS], (float*)(ws + WS_SS) + TP, nullptr};
        for (int t = F.vcu; t < 256; t += F.G) skinny_tile(F, (const bf16*)(ws + WS_MERGED) + (size_t)TP * DM, DM, (const bf16*)(ws + WS_WOUT), DM, t >> 4, t & 15, Es);
    }
    }
    GRID_BAR();
#endif
#if PH_MAX >= 7
    asm volatile("; ===PHASE 7===");
    { PHASE_ARGS;
    {
        pg8::Gemm g{(const bf16*)(ws + WS_HB), (const bf16*)(ws + WS_WCQ), DM, DM, DM};
        pg8::StaticOrder S; S.init(TP, DM, F.G, (int)blockIdx.x);
        EpiGen E{nullptr, 0, (bf16*)(ws + WS_QC), DM, C2C, nullptr, nullptr, 0, 0, nullptr, nullptr, (const float*)(ws + WS_SS)};
        pg8::gemm_phase(F.lds, g, S, E);
        __syncthreads();
        EpiSk Es{nullptr, 0, (bf16*)(ws + WS_QC) + (size_t)TP * DM, DM, C2C, nullptr, 0, nullptr, nullptr, (const float*)(ws + WS_SS) + TP};
        for (int t = F.vcu; t < 256; t += F.G) skinny_tile(F, (const bf16*)(ws + WS_HB) + (size_t)TP * DM, DM, (const bf16*)(ws + WS_WCQ), DM, t >> 4, t & 15, Es);
    }
    }
    GRID_BAR();
#endif
#if PH_MAX >= 8
    asm volatile("; ===PHASE 8===");
    { PHASE_ARGS;
    {
        const int u = (int)blockIdx.x, b = (u >> 7) & 1, h = (u >> 5) & 3, pnl = u & 31;
        const size_t roff = ((size_t)b * SEQ + pnl * 256) * DM + h * 256;
        pg8::Gemm g{(const bf16*)(ws + WS_QC) + roff, (const bf16*)(ws + WS_MK16) + (size_t)(b * 256) * DM + h * 256, DM, DM, 256};
        pg8::SingleUnit S{u < 256 ? 1 : 0, {0, 0}};
        EpiSoftmaxP E{ARGP};
        pg8::gemm_phase(F.lds, g, S, E);
        VM_WAIT(); __syncthreads();
        {
            pg8::Gemm g2{(const bf16*)(ws + WS_PC) + roff, (const bf16*)(ws + WS_MVT16) + (size_t)(h * 256) * 512 + b * 256, DM, 512, 256};
            EpiGen E2{nullptr, 0, (bf16*)(ws + WS_OC) + roff, DM, 1.f, nullptr, nullptr, 0, 0, nullptr, nullptr, nullptr};
            pg8::gemm_phase(F.lds, g2, S, E2);
        }
        __syncthreads();
        for (int v = F.vcu; v < 512; v += F.G) cross_sample_unit(F, A, v);
    }
    }
    GRID_BAR();
#endif
#if PH_MAX >= 10
    asm volatile("; ===PHASE 10===");
    { PHASE_ARGS;
    {
        pg8::Gemm g{(const bf16*)(ws + WS_OC), (const bf16*)(ws + WS_WCO), DM, DM, DM};
        pg8::StaticOrder S; S.init(TP, DM, F.G, (int)blockIdx.x);
        EpiGen E{(float*)(ws + WS_X2), DM, (bf16*)(ws + WS_HB), DM, 1.f, (const float*)(ws + WS_X1), (const float*)(ws + WS_X1), TA, DM, (const float*)A.in[I_GFFN], (float*)(ws + WS_SS) + TA, nullptr};
        pg8::gemm_phase(F.lds, g, S, E);
        __syncthreads();
        EpiSk Es{(float*)(ws + WS_X2) + (size_t)TP * DM, DM, (bf16*)(ws + WS_HB) + (size_t)TP * DM, DM, 1.f, (const float*)(ws + WS_X1) + (size_t)TP * DM, DM, (const float*)A.in[I_GFFN], (float*)(ws + WS_SS) + TA + TP, nullptr};
        for (int t = F.vcu; t < 256; t += F.G) skinny_tile(F, (const bf16*)(ws + WS_OC) + (size_t)TP * DM, DM, (const bf16*)(ws + WS_WCO), DM, t >> 4, t & 15, Es);
    }
    }
    GRID_BAR();
#endif
#if PH_MAX >= 12
    asm volatile("; ===PHASE 12===");
    { PHASE_ARGS;
    {
        pg8::Gemm g{(const bf16*)(ws + WS_HB), (const bf16*)(ws + WS_WPK), DM, DM, DM};
        pg8::StaticOrder S; S.init(TP, 2048, F.G, (int)blockIdx.x);
        EpiGen E{(float*)(ws + WS_SC), 2048, nullptr, 0, 1.f, nullptr, nullptr, 0, 0, nullptr, nullptr, (const float*)(ws + WS_SS) + TA};
        pg8::gemm_phase(F.lds, g, S, E);
        __syncthreads();
        EpiSk Es{(float*)(ws + WS_SC) + (size_t)TP * 2048, 2048, nullptr, 0, 1.f, nullptr, 0, nullptr, nullptr, (const float*)(ws + WS_SS) + TA + TP};
        for (int t = F.vcu; t < 512; t += F.G) skinny_tile(F, (const bf16*)(ws + WS_HB) + (size_t)TP * DM, DM, (const bf16*)(ws + WS_WPK), DM, t >> 5, t & 31, Es);
    }
    }
    GRID_BAR();
#endif
#if PH_MAX >= 13
    asm volatile("; ===PHASE 13===");
    { PHASE_ARGS;
    peer_phase(F, A);
    }
#endif
#if PH_MAX < 13
    {   PHASE_ARGS;
        const int gw = F.vcu * NWAVES + F.wave, NGW = F.G * NWAVES;
        for (int m = gw; m < TA; m += NGW) {
            const float* x = m < TP ? (const float*)A.in[I_XP] + (size_t)m * DM : (const float*)A.in[I_XS] + (size_t)(m - TP) * DM;
            float* y = m < TP ? out + O_YP + (size_t)m * DM : out + O_YS + (size_t)(m - TP) * DM;
            for (int j = 0; j < 4; ++j) ((f32x4*)y)[F.lane + 64 * j] = ((const f32x4*)x)[F.lane + 64 * j];
        }
    }
#endif

}

extern "C" void kernel_launch(void* const* d_in, const int* in_sizes, int n_in, void* d_out, int out_size, void* d_ws, size_t ws_size, hipStream_t stream) {
    static int grid = 0;
    if (grid == 0) {
        if (n_in != N_INPUTS || (size_t)out_size != O_TOTAL || ws_size < WS_END) { fprintf(stderr, "kernel_launch: unexpected shapes (n_in %d out %d ws %zu)\n", n_in, out_size, ws_size); grid = -1; return; }
        int dev = 0, cus = 0, per_cu = 0;
        if (hipGetDevice(&dev) != hipSuccess || hipDeviceGetAttribute(&cus, hipDeviceAttributeMultiprocessorCount, dev) != hipSuccess) { grid = -1; return; }
        if (hipFuncSetAttribute((const void*)mega_fwd, hipFuncAttributeMaxDynamicSharedMemorySize, LDS_BYTES) != hipSuccess) { fprintf(stderr, "kernel_launch: hipFuncSetAttribute failed\n"); grid = -1; return; }
        if (hipOccupancyMaxActiveBlocksPerMultiprocessor(&per_cu, (const void*)mega_fwd, NTHR, LDS_BYTES) != hipSuccess || per_cu < 1)
            fprintf(stderr, "kernel_launch: occupancy query reports %d workgroups per CU\n", per_cu);
        (void)hipGetLastError();
        grid = cus;
        if (grid > 256) grid = 256;
    }
    if (grid < 0) return;
    if (hipMemsetAsync((char*)d_ws + WS_CTL, 0, CTL_ZERO_BYTES, stream) != hipSuccess) return;
    Args a{};
    for (int i = 0; i < N_INPUTS; ++i) a.in[i] = d_in[i];
    a.out = (float*)d_out; a.ws = (unsigned char*)d_ws;
    hipLaunchKernelGGL(mega_fwd, dim3(grid), dim3(NTHR), LDS_BYTES, stream, a);
    const hipError_t le = hipPeekAtLastError();
    if (le != hipSuccess) fprintf(stderr, "kernel_launch: launch failed: %s\n", hipGetErrorName(le));
}
```

```cpp
#define PH_MAX 13
#include <hip/hip_runtime.h>
#include <cstdio>
#include <cstdint>

namespace pg8 {
#define PG8_LAS __attribute__((address_space(3)))
typedef unsigned short bf16_t;
typedef short bf16x8 __attribute__((ext_vector_type(8)));
typedef float f32x4 __attribute__((ext_vector_type(4)));
typedef unsigned u32x4 __attribute__((ext_vector_type(4)));
typedef unsigned u32x2 __attribute__((ext_vector_type(2)));
constexpr int BM = 256, BK = 64, HALF = 128, HTB = HALF * BK * 2  , STAGE_BYTES = 8 * HTB, NXCD = 8, WGM = 8;

__host__ __device__ __forceinline__ int lds_byte(int r, int c) { const int st = (r >> 4) * 2 + (c >> 5), rr = r & 15, cc = c & 31, ob = rr * 64 + cc * 2; return st * 1024 + (ob ^ (((ob >> 9) & 1) << 5)); }
__host__ __device__ __forceinline__ void stage_rc(int b, int& R, int& C) { const int st = b / 1024, sb = b % 1024, swz = sb ^ (((sb >> 9) & 1) << 5); R = (st >> 1) * 16 + swz / 64; C = (st & 1) * 32 + (swz % 64) / 2; }

struct Unit { int pm, pn; };
struct Gemm { const bf16_t* A; const bf16_t* Bt; int lda, ldb, K; };

struct StaticOrder {
    int nM, nN, nwg, G, c;
    __host__ __device__ void init(int M, int N, int G_, int c_) { nM = M / BM; nN = N / BM; nwg = nM * nN; G = G_; c = c_; }
    __host__ __device__ bool next(int i, Unit& u) const {
        const long L = (long)i * G + c; if (L >= nwg) return false;
        int wgid = (int)L; { const int q = nwg / NXCD, r = nwg % NXCD, xcd = wgid % NXCD, off = wgid / NXCD; wgid = (xcd < r ? xcd * (q + 1) : r * (q + 1) + (xcd - r) * q) + off; }
        const int nig = WGM * nN, gid = wgid / nig, fm = gid * WGM, gsz = (nM - fm) < WGM ? (nM - fm) : WGM;
        u.pm = fm + ((wgid % nig) % gsz); u.pn = (wgid % nig) / gsz; return true;
    }
};
struct SingleUnit {
    int has; Unit u0;
    __host__ __device__ bool next(int i, Unit& u) const { if (i != 0 || !has) return false; u = u0; return true; }
};

__device__ __forceinline__ unsigned cvt_pk_bf16(float lo, float hi) { unsigned r; asm volatile("v_cvt_pk_bf16_f32 %0, %1, %2" : "=v"(r) : "v"(lo), "v"(hi)); return r; }

template <class Epi, class Sched>
__device__ __forceinline__ void gemm_phase(PG8_LAS unsigned char* lds, const Gemm g, const Sched& S, const Epi& E, int wave_id) {
    int lane; asm volatile("v_mbcnt_lo_u32_b32 %0, -1, 0\n\tv_mbcnt_hi_u32_b32 %0, -1, %0" : "=v"(lane));
    const int wid = wave_id; const int tid = wid * 64 + lane; const int wr = wid >> 2, wc = wid & 3, fr = lane & 15, fq = lane >> 4;
    const int K = g.K, nt = K / BK;
    unsigned voffA[2], voffB[2];
#pragma unroll
    for (int i = 0; i < 2; ++i) { int R, C; stage_rc(tid * 16 + i * 8192, R, C);
        voffA[i] = (unsigned)(R * g.lda + C) * 2u; voffB[i] = (unsigned)(R * g.ldb + C) * 2u; }
    const size_t kstep = (size_t)(BK * 2);
    const size_t hstepA = (size_t)HALF * g.lda * 2, hstepB = (size_t)HALF * g.ldb * 2;
    const size_t tstepA = 2 * hstepA, tstepB = 2 * hstepB;
    const unsigned ldsw = (unsigned)wid * 1024u;
    const int aoff = lds_byte(wr * 64 + fr, fq * 8), boff = lds_byte(wc * 32 + fr, fq * 8);
#define PG8_SA(b, h) (((b) * 2 + (h)) * HTB)
#define PG8_SB(b, h) ((4 + (b) * 2 + (h)) * HTB)
#define PG8_STAGE(bufoff, gbase, voff) do { _Pragma("unroll") for (int _i = 0; _i < 2; ++_i) \
        __builtin_amdgcn_global_load_lds((const unsigned*)((const char*)(gbase) + (voff)[_i]), (PG8_LAS unsigned*)(lds + (bufoff) + ldsw + _i * 8192), 16, 0, 0); } while (0)
#define PG8_LDA(dst, b, h) do { _Pragma("unroll") for (int m = 0; m < 4; ++m) _Pragma("unroll") for (int k = 0; k < 2; ++k) dst[m][k] = *(const PG8_LAS bf16x8*)(lds + PG8_SA(b, h) + aoff + m * 2048 + k * 1024); } while (0)
#define PG8_LDB(dst, b, h) do { _Pragma("unroll") for (int n = 0; n < 2; ++n) _Pragma("unroll") for (int k = 0; k < 2; ++k) dst[n][k] = *(const PG8_LAS bf16x8*)(lds + PG8_SB(b, h) + boff + n * 2048 + k * 1024); } while (0)
#define PG8_MMA(ai, bj, At, Bt) do { __builtin_amdgcn_s_setprio(1); _Pragma("unroll") for (int m = 0; m < 4; ++m) _Pragma("unroll") for (int n = 0; n < 2; ++n) _Pragma("unroll") for (int k = 0; k < 2; ++k) \
        acc[ai][bj][m][n] = __builtin_amdgcn_mfma_f32_16x16x32_bf16(Bt[n][k], At[m][k], acc[ai][bj][m][n], 0, 0, 0); __builtin_amdgcn_s_setprio(0); } while (0)
#define PG8_WAIT_V(n) asm volatile("s_waitcnt vmcnt(" #n ")" ::: "memory")
#define PG8_WAIT_L(n) asm volatile("s_waitcnt lgkmcnt(" #n ")" ::: "memory")
#define PG8_BAR __builtin_amdgcn_s_barrier()
#define PG8_SCHED __builtin_amdgcn_sched_barrier(0)
    Unit cur, nxt; int ui = 0;
    if (!S.next(0, cur)) return;
    f32x4 acc[2][2][4][2];
#pragma unroll
    for (int a = 0; a < 2; ++a)
#pragma unroll
        for (int b = 0; b < 2; ++b)
#pragma unroll
            for (int m = 0; m < 4; ++m)
#pragma unroll
                for (int n = 0; n < 2; ++n) acc[a][b][m][n] = (f32x4){0.f, 0.f, 0.f, 0.f};
    bf16x8 At[4][2], B0[2][2], B1[2][2];
    const char* cA = (const char*)g.A + (size_t)cur.pm * tstepA; const char* cB = (const char*)g.Bt + (size_t)cur.pn * tstepB;
    PG8_STAGE(PG8_SB(0, 0), cB, voffB); PG8_STAGE(PG8_SB(0, 1), cB + hstepB, voffB); PG8_STAGE(PG8_SA(0, 0), cA, voffA); PG8_STAGE(PG8_SA(0, 1), cA + hstepA, voffA);
    if (wr == 1) PG8_BAR;
    PG8_WAIT_V(2); PG8_BAR;
    PG8_STAGE(PG8_SB(1, 0), cB + kstep, voffB); PG8_STAGE(PG8_SA(1, 0), cA + kstep, voffA); PG8_STAGE(PG8_SB(1, 1), cB + hstepB + kstep, voffB);
    PG8_WAIT_V(6); PG8_BAR;
    for (;;) {
        const bool has_next = S.next(ui + 1, nxt);
        const char* nA = has_next ? (const char*)g.A + (size_t)nxt.pm * tstepA : cA; const char* nB = has_next ? (const char*)g.Bt + (size_t)nxt.pn * tstepB : cB;
        for (int t = 0; t < nt; t += 2) {
            const bool last = (t == nt - 2);
            const char* a1 = cA + (size_t)(t + 1) * kstep;
            const char* a2 = last ? nA : cA + (size_t)(t + 2) * kstep; const char* b2 = last ? nB : cB + (size_t)(t + 2) * kstep;
            const char* a3 = a2 + kstep; const char* b3 = b2 + kstep;
            PG8_LDB(B0, 0, 0); PG8_LDB(B1, 0, 1); PG8_SCHED; PG8_LDA(At, 0, 0); PG8_STAGE(PG8_SA(1, 1), a1 + hstepA, voffA);
            PG8_WAIT_V(8); PG8_WAIT_L(0); PG8_BAR; PG8_MMA(0, 0, At, B0); PG8_MMA(0, 1, At, B1); PG8_BAR; PG8_SCHED;
            PG8_LDA(At, 0, 1); PG8_STAGE(PG8_SB(0, 0), b2, voffB); PG8_STAGE(PG8_SB(0, 1), b2 + hstepB, voffB); PG8_STAGE(PG8_SA(0, 0), a2, voffA);
            PG8_WAIT_V(8); PG8_WAIT_L(0); PG8_BAR; PG8_MMA(1, 0, At, B0); PG8_MMA(1, 1, At, B1); PG8_BAR; PG8_SCHED;
            PG8_LDB(B0, 1, 0); PG8_LDB(B1, 1, 1); PG8_SCHED; PG8_LDA(At, 1, 0); PG8_STAGE(PG8_SA(0, 1), a2 + hstepA, voffA);
            PG8_WAIT_V(8); PG8_WAIT_L(0); PG8_BAR; PG8_MMA(0, 0, At, B0); PG8_MMA(0, 1, At, B1); PG8_BAR; PG8_SCHED;
            PG8_LDA(At, 1, 1); PG8_STAGE(PG8_SB(1, 0), b3, voffB); PG8_STAGE(PG8_SB(1, 1), b3 + hstepB, voffB); PG8_STAGE(PG8_SA(1, 0), a3, voffA);
            PG8_WAIT_V(8); PG8_WAIT_L(0); PG8_BAR; PG8_MMA(1, 0, At, B0); PG8_MMA(1, 1, At, B1); PG8_BAR; PG8_SCHED;
        }
        if (wr == 0) PG8_BAR;
        if constexpr (!Epi::AFTER_DRAIN) { E(acc, cur, wr, wc, fr, fq); }
        if (!has_next) break;
#pragma unroll
        for (int a = 0; a < 2; ++a)
#pragma unroll
            for (int b = 0; b < 2; ++b)
#pragma unroll
                for (int m = 0; m < 4; ++m)
#pragma unroll
                    for (int n = 0; n < 2; ++n) acc[a][b][m][n] = (f32x4){0.f, 0.f, 0.f, 0.f};
        cur = nxt; cA = nA; cB = nB; ++ui;
        if (wr == 1) PG8_BAR;
    }
    PG8_WAIT_V(0);
    PG8_BAR;
    if constexpr (Epi::AFTER_DRAIN) { E.fused(acc, cur, wr, wc, fr, fq, lds, wid, lane); }
#undef PG8_SA
#undef PG8_SB
#undef PG8_STAGE
#undef PG8_LDA
#undef PG8_LDB
#undef PG8_MMA
#undef PG8_WAIT_V
#undef PG8_WAIT_L
#undef PG8_BAR
#undef PG8_SCHED
}
}

#define GAS __attribute__((address_space(1)))
#define LAS __attribute__((address_space(3)))
typedef unsigned short bf16;
typedef unsigned v4u __attribute__((ext_vector_type(4)));
typedef unsigned v2u __attribute__((ext_vector_type(2)));
typedef float f32x4 __attribute__((ext_vector_type(4)));
typedef float f32x2 __attribute__((ext_vector_type(2)));
typedef float f32x16 __attribute__((ext_vector_type(16)));
typedef short bf16x8 __attribute__((ext_vector_type(8)));
typedef short s16x4 __attribute__((ext_vector_type(4)));
typedef GAS unsigned gu32;
#define RLX_AGENT __ATOMIC_RELAXED, __HIP_MEMORY_SCOPE_AGENT
#define LDS_WAIT() asm volatile("s_waitcnt lgkmcnt(0)" ::: "memory")
#define VM_WAIT() asm volatile("s_waitcnt vmcnt(0)" ::: "memory")
__device__ __forceinline__ unsigned f2bf(float f) { unsigned u = __builtin_bit_cast(unsigned, f); return (u + 0x7fffu + ((u >> 16) & 1u)) >> 16; }
__device__ __forceinline__ unsigned pk2(float lo, float hi) { return f2bf(lo) | (f2bf(hi) << 16); }
__device__ __forceinline__ float bf2f(unsigned short b) { return __builtin_bit_cast(float, (unsigned)b << 16); }
__device__ __forceinline__ float bflo(unsigned u) { return __builtin_bit_cast(float, u << 16); }
__device__ __forceinline__ float bfhi(unsigned u) { return __builtin_bit_cast(float, u & 0xffff0000u); }


__device__ __forceinline__ int lane_id() { int r; asm volatile("v_mbcnt_lo_u32_b32 %0, -1, 0\n\tv_mbcnt_hi_u32_b32 %0, -1, %0" : "=v"(r)); return r; }
#define TID_IS_ZERO(wave_) ((wave_) == 0 && lane_id() == 0)
#define XB_TMO      128
#define XB_XCNT(j)  (256  + 64 * (j))
#define XB_XSUB(j)  (1280 + 64 * (j))
#define XB_XGEN(j)  (2304 + 64 * (j))
#define XB_TOP      3328
#define XB_TOPGEN   3392
#define XCD_BAR_WORDS 3456
#define XB_SPIN_CAP (1u << 18)

__device__ __forceinline__ unsigned xb_ld(unsigned* p)              { return __hip_atomic_load(p, __ATOMIC_RELAXED, __HIP_MEMORY_SCOPE_AGENT); }
__device__ __forceinline__ unsigned xb_add(unsigned* p, unsigned v) { return __hip_atomic_fetch_add(p, v, __ATOMIC_RELAXED, __HIP_MEMORY_SCOPE_AGENT); }
__device__ __forceinline__ unsigned xb_xcc_id() { return (unsigned)__builtin_amdgcn_s_getreg((3 << 11) | 20) & 0xFu; }
#define XB_SPIN(cond, bar) do { unsigned _sp = 0; while (cond) { __builtin_amdgcn_s_sleep(1); \
    if ((++_sp & 255u) == 0u) { if (xb_ld(&(bar)[XB_TMO])) break; if (_sp > XB_SPIN_CAP) { atomicAdd(&(bar)[XB_TMO], 1u); break; } } } } while (0)

struct XcdBarrier {
    unsigned* bar; unsigned x; int wave;
    volatile LAS unsigned* st;
};

__device__ __forceinline__ XcdBarrier xcd_barrier_post(unsigned* bar, volatile LAS unsigned* st, int wave) {
    XcdBarrier b; b.bar = bar; b.x = xb_xcc_id(); b.st = st; b.wave = wave;
    if (TID_IS_ZERO(wave)) (void)xb_add(&bar[XB_XCNT(b.x)], 1u);
    return b;
}
__device__ __forceinline__ void xcd_barrier_complete(unsigned* bar, unsigned x, unsigned& nloc, unsigned& nx) {
    const unsigned G = gridDim.x * gridDim.y * gridDim.z;
    unsigned sum, cnt, mine, sp = 0u;
    for (;;) {
        sum = 0u; cnt = 0u; mine = 0u;
#pragma unroll
        for (unsigned j = 0; j < 16; ++j) { const unsigned c = xb_ld(&bar[XB_XCNT(j)]); sum += c; cnt += (c > 0u) ? 1u : 0u; mine = (j == x) ? c : mine; }
        if (sum == G) break;
        __builtin_amdgcn_s_sleep(1);
        if ((++sp & 255u) == 0u) { if (xb_ld(&bar[XB_TMO])) break; if (sp > XB_SPIN_CAP) { atomicAdd(&bar[XB_TMO], 1u); break; } }
    }
    nloc = mine > 0u ? mine : 1u; nx = cnt > 0u ? cnt : 1u;
}

__device__ __forceinline__ void xcd_barrier(const XcdBarrier& b) {
    asm volatile("s_waitcnt vmcnt(0)" ::: "memory");
    __syncthreads();
    if (TID_IS_ZERO(b.wave)) {
        unsigned* bar = b.bar;
        __builtin_amdgcn_s_waitcnt(0);
        unsigned nloc = b.st[0], nx = b.st[1];
        if (nloc == 0u) { xcd_barrier_complete(bar, b.x, nloc, nx); b.st[0] = nloc; b.st[1] = nx; }
        const unsigned old = xb_add(&bar[XB_XSUB(b.x)], 1u);
        const unsigned gen = old / nloc;
        if (old + 1u == (gen + 1u) * nloc) {
            __builtin_amdgcn_fence(__ATOMIC_RELEASE, "agent");
            asm volatile("s_waitcnt vmcnt(0)" ::: "memory");
            const unsigned og = xb_add(&bar[XB_TOP], 1u);
            const unsigned tg = og / nx;
            if (og + 1u == (tg + 1u) * nx) xb_add(&bar[XB_TOPGEN], 1u);
            else XB_SPIN(xb_ld(&bar[XB_TOPGEN]) == tg, bar);
            __builtin_amdgcn_fence(__ATOMIC_ACQUIRE, "agent");
            xb_add(&bar[XB_XGEN(b.x)], 1u);
            asm volatile("s_waitcnt vmcnt(0)" ::: "memory");
        } else {
            XB_SPIN(xb_ld(&bar[XB_XGEN(b.x)]) == gen, bar);
            __builtin_amdgcn_fence(__ATOMIC_ACQUIRE, "agent");
            asm volatile("s_waitcnt vmcnt(0)" ::: "memory");
        }
    }
    __syncthreads();
}


constexpr int NWAVES = 8, NTHR = 512;
constexpr int DM = 1024, TP = 16384, TS = 1024, TA = TP + TS, SEQ = 8192, NB_P = 2, NB_S = 128, LS = 8;
constexpr int N_IN = 3328;
constexpr int PASTL = 2048, PAGE = 128, NPAGES = 16;
constexpr float EPS = 1e-6f;
constexpr float LOG2E = 1.4426950408889634f;
constexpr float C2F = 0.125f * LOG2E;
constexpr float C2C = 0.0625f * LOG2E;

enum { I_XP = 0, I_XS, I_CFK, I_CFV, I_CFL, I_SGLA, I_CMK, I_CMV, I_PT, I_MEMP, I_GMIX, I_WIN, I_BFF, I_WG2, I_BG, I_GGO, I_WOUT, I_GCROSS, I_GMEM,
       I_WMK, I_WMV, I_WCQ, I_WCO, I_GFFN, I_PWQ, I_PSK, I_PU, I_PV, I_GFIN, N_INPUTS };
constexpr size_t O_YP = 0, O_YS = 16777216, O_FKP = 17825792, O_FVP = 26214400, O_LFP = 34603008, O_GSP = 34734080, O_MKP = 34799616, O_MVP = 35323904,
                 O_FKS = 35848192, O_FVS = 36372480, O_LFS = 36896768, O_GSS = 36904960, O_TOTAL = 41099264;

constexpr size_t MiB = 1u << 20;
constexpr size_t WS_CTL = 0, CTL_ZERO_BYTES = 1 * MiB;
constexpr size_t WS_WIN = 2 * MiB, WS_WOUT = 10 * MiB, WS_WMK = 12 * MiB, WS_WMV = 14 * MiB, WS_WCQ = 16 * MiB, WS_WCO = 18 * MiB, WS_WPK = 20 * MiB;
constexpr size_t WS_MB = 24 * MiB, WS_MK16 = 25 * MiB, WS_MVT16 = 26 * MiB, WS_KBIAS = 27 * MiB, WS_GDEC = 28 * MiB, WS_GG = 29 * MiB;
constexpr size_t WS_U16 = 32 * MiB, WS_V16 = 64 * MiB, WS_HB = 96 * MiB, WS_QF = 132 * MiB, WS_KF = 150 * MiB, WS_VF = 168 * MiB;
constexpr size_t WS_GQ = 186 * MiB, WS_GK = 204 * MiB, WS_GV = 222 * MiB, WS_GR = 256 * MiB, WS_SUF = 290 * MiB, WS_GKV = 298 * MiB;
constexpr size_t WS_MERGED = 330 * MiB, WS_X1 = 364 * MiB, WS_X2 = 432 * MiB, WS_QC = 500 * MiB, WS_PC = 534 * MiB, WS_OC = 566 * MiB, WS_SC = 600 * MiB;
constexpr size_t WS_MISC = 736 * MiB, WS_SS = 740 * MiB  , WS_BB = 744 * MiB, WS_END = 800 * MiB;
constexpr int CW_BAR = 4096;

constexpr int RING_BYTES = 131072;
constexpr int LDSCTL_OFF = RING_BYTES, MISC_OFF = LDSCTL_OFF + 320;
constexpr int ARGS_OFF = MISC_OFF + 128;
constexpr int LDS_BYTES = 147456;

struct Args { const void* in[N_INPUTS]; float* out; unsigned char* ws; };

__device__ __forceinline__ const void* ld_ptr(const LAS unsigned long long* p) { const unsigned long long v = *p; const unsigned lo = __builtin_amdgcn_readfirstlane((unsigned)v), hi = __builtin_amdgcn_readfirstlane((unsigned)(v >> 32)); return (const void*)(const GAS char*)(((unsigned long long)hi << 32) | lo); }
__device__ __forceinline__ Args load_args(const LAS unsigned long long* ARGP) { Args A;
    A.in[0] = ld_ptr(ARGP + 0);
    A.in[1] = ld_ptr(ARGP + 1);
    A.in[2] = ld_ptr(ARGP + 2);
    A.in[3] = ld_ptr(ARGP + 3);
    A.in[4] = ld_ptr(ARGP + 4);
    A.in[5] = ld_ptr(ARGP + 5);
    A.in[6] = ld_ptr(ARGP + 6);
    A.in[7] = ld_ptr(ARGP + 7);
    A.in[8] = ld_ptr(ARGP + 8);
    A.in[9] = ld_ptr(ARGP + 9);
    A.in[10] = ld_ptr(ARGP + 10);
    A.in[11] = ld_ptr(ARGP + 11);
    A.in[12] = ld_ptr(ARGP + 12);
    A.in[13] = ld_ptr(ARGP + 13);
    A.in[14] = ld_ptr(ARGP + 14);
    A.in[15] = ld_ptr(ARGP + 15);
    A.in[16] = ld_ptr(ARGP + 16);
    A.in[17] = ld_ptr(ARGP + 17);
    A.in[18] = ld_ptr(ARGP + 18);
    A.in[19] = ld_ptr(ARGP + 19);
    A.in[20] = ld_ptr(ARGP + 20);
    A.in[21] = ld_ptr(ARGP + 21);
    A.in[22] = ld_ptr(ARGP + 22);
    A.in[23] = ld_ptr(ARGP + 23);
    A.in[24] = ld_ptr(ARGP + 24);
    A.in[25] = ld_ptr(ARGP + 25);
    A.in[26] = ld_ptr(ARGP + 26);
    A.in[27] = ld_ptr(ARGP + 27);
    A.in[28] = ld_ptr(ARGP + 28);
    A.out = (float*)ld_ptr(ARGP + N_INPUTS); A.ws = (unsigned char*)ld_ptr(ARGP + N_INPUTS + 1); return A; }
struct Frame {
    LAS unsigned char* lds;
    int tid, lane, wave, vcu, G;
};

__device__ __forceinline__ float wave_sum(float v) {
#pragma unroll
    for (int o = 1; o < 64; o <<= 1) v += __shfl_xor(v, o);
    return v;
}
__device__ __forceinline__ float log_sigmoid(float x) { return fminf(x, 0.f) - log1pf(__expf(-fabsf(x))); }

__device__ __forceinline__ int win_src_col(int r) {
    if (r < 1536) return r;
    if (r < 1792) return 1544 + (r - 1536);
    if (r < 2048) return 1800 + (r - 1792);
    if (r < 2560) return 2056 + (r - 2048);
    if (r < 3072) return 2584 + (r - 2560);
    if (r < 3080) return 1536 + (r - 3072);
    if (r < 3096) return 2568 + (r - 3080);
    return -1;
}
template <bool WIN>
__device__ __forceinline__ void p0_transpose_item(const float* W, int ldw, int K, int nblk, bf16* WT, LAS float* scr, int item, int lane) {
    const int kb = item / nblk, nb = item % nblk, k0 = 64 * kb, n0 = 32 * nb;
    const int dr = n0 + (lane & 31); const int sc = WIN ? win_src_col(dr) : dr;
#pragma unroll 8
    for (int i = 0; i < 32; ++i) { const int kk = 2 * i + (lane >> 5); scr[kk * 33 + (lane & 31)] = (sc >= 0) ? W[(size_t)(k0 + kk) * ldw + sc] : 0.f; }
    LDS_WAIT(); asm volatile("" ::: "memory");
    const int c = lane & 7;
#pragma unroll
    for (int j = 0; j < 4; ++j) { const int n = (lane >> 3) + 8 * j; const LAS float* s = scr + (8 * c) * 33 + n;
        v4u o; o.x = pk2(s[0 * 33], s[1 * 33]); o.y = pk2(s[2 * 33], s[3 * 33]); o.z = pk2(s[4 * 33], s[5 * 33]); o.w = pk2(s[6 * 33], s[7 * 33]);
        *(GAS v4u*)(WT + (size_t)(n0 + n) * K + k0 + 8 * c) = o; }
    LDS_WAIT(); asm volatile("" ::: "memory");
}
__device__ __forceinline__ void rms_row_bf16(const float* xrow, const float* g, bf16* orow, int lane) {
    const f32x4* xr = (const f32x4*)xrow + lane; const f32x4* gr = (const f32x4*)g + lane;
    f32x4 v[4]; float s = 0.f;
#pragma unroll
    for (int j = 0; j < 4; ++j) { v[j] = xr[64 * j]; s += (v[j].x * v[j].x + v[j].y * v[j].y) + (v[j].z * v[j].z + v[j].w * v[j].w); }
    const float r = rsqrtf(wave_sum(s) * (1.f / DM) + EPS);
    v2u* o8 = (v2u*)orow + lane;
#pragma unroll
    for (int j = 0; j < 4; ++j) { const f32x4 gg = gr[64 * j]; v2u o; o.x = pk2(v[j].x * r * gg.x, v[j].y * r * gg.y); o.y = pk2(v[j].z * r * gg.z, v[j].w * r * gg.w); o8[64 * j] = o; }
}

using pg8::Unit;
struct EpiGen {
    static constexpr bool PERM = false, AFTER_DRAIN = false;
    float* d32; int ld32; bf16* d16; int ld16; float sc16;
    const float* r0; const float* r1; int rsplit; int ldr;
    const float* gcol;
    float* ssq;
    const float* rsq;
    __device__ __forceinline__ void operator()(const f32x4 (&acc)[2][2][4][2], const Unit& u, int wr, int wc, int fr, int fq) const {
        int row0 = u.pm * 256 + wr * 64 + fr, col0 = u.pn * 256 + wc * 32 + fq * 4;
        asm volatile("" : "+v"(row0), "+v"(col0));
#pragma unroll
        for (int ai = 0; ai < 2; ++ai)
#pragma unroll
            for (int m = 0; m < 4; ++m) { const int row = row0 + ai * 128 + m * 16;
                const float* rp = nullptr; if (r0) rp = (row < rsplit) ? r0 + (size_t)row * ldr : r1 + (size_t)(row - rsplit) * ldr;
                float rs = 1.f; if (rsq) rs = rsqrtf(rsq[row] * (1.f / 1024.f) + EPS);
                float ss = 0.f;
#pragma unroll
                for (int bj = 0; bj < 2; ++bj)
#pragma unroll
                    for (int n = 0; n < 2; ++n) { const int col = col0 + bj * 128 + n * 16; f32x4 v = acc[ai][bj][m][n];
                        if (rsq) { v[0] *= rs; v[1] *= rs; v[2] *= rs; v[3] *= rs; }
                        if (r0) v += *(const f32x4*)(rp + col);
                        if (d32) *(f32x4*)(d32 + (size_t)row * ld32 + col) = v;
                        if (ssq) ss += (v[0] * v[0] + v[1] * v[1]) + (v[2] * v[2] + v[3] * v[3]);
                        if (d16) { f32x4 w = v; if (gcol) w = w * *(const f32x4*)(gcol + col);
                            v2u o; o.x = pg8::cvt_pk_bf16(w[0] * sc16, w[1] * sc16); o.y = pg8::cvt_pk_bf16(w[2] * sc16, w[3] * sc16); *(v2u*)(d16 + (size_t)row * ld16 + col) = o; } }
                if (ssq) { ss += __shfl_xor(ss, 16); ss += __shfl_xor(ss, 32); if (fq == 0) atomicAdd(ssq + row, ss); } }
    }
};
struct EpiInProj {
    static constexpr bool PERM = false, AFTER_DRAIN = false;
    float* out; unsigned char* ws; const float* bff;
    __device__ __forceinline__ void operator()(const f32x4 (&acc)[2][2][4][2], const Unit& u, int wr, int wc, int fr, int fq) const {
        const int pn = u.pn; const bool smp = u.pm >= 64;
        int row0 = u.pm * 256 + wr * 64 + fr;
        int orow0 = (smp ? (u.pm - 64) * 256 : u.pm * 256) + wr * 64 + fr;
        asm volatile("" : "+v"(row0), "+v"(orow0));
        float* d32 = nullptr; int ld32 = 0; bool d32_grp = false; bf16* d16 = nullptr; int ld16 = 0; float s32 = 1.f, s16 = 1.f; int cb = 0;
        if (pn < 2) { d16 = (bf16*)(ws + WS_QF); ld16 = 512; s16 = C2F; cb = pn * 256; }
        else if (pn < 4) { d32 = out + (smp ? O_FKS : O_FKP); ld32 = 512; d32_grp = true; d16 = (bf16*)(ws + WS_KF); ld16 = 512; cb = (pn - 2) * 256; }
        else if (pn < 6) { d32 = out + (smp ? O_FVS : O_FVP); ld32 = 512; d32_grp = true; d16 = (bf16*)(ws + WS_VF); ld16 = 512; cb = (pn - 4) * 256; }
        else if (pn == 6) { d32 = (float*)(ws + WS_GQ); ld32 = 256; s32 = 0.125f; }
        else if (pn == 7) { d32 = (float*)(ws + WS_GK); ld32 = 256; }
        else if (pn < 10) { d32 = (float*)(ws + WS_GV); ld32 = 512; cb = (pn - 8) * 256; }
        else if (pn < 12) { d32 = (float*)(ws + WS_GR); ld32 = 512; cb = (pn - 10) * 256; }
        if (pn < 12) {
#pragma unroll
            for (int ai = 0; ai < 2; ++ai)
#pragma unroll
                for (int m = 0; m < 4; ++m) { const int row = row0 + ai * 128 + m * 16, orow = orow0 + ai * 128 + m * 16;
#pragma unroll
                    for (int bj = 0; bj < 2; ++bj)
#pragma unroll
                        for (int n = 0; n < 2; ++n) { const int col = cb + wc * 32 + fq * 4 + bj * 128 + n * 16; const f32x4 v = acc[ai][bj][m][n];
                            if (d32) *(f32x4*)(d32 + (size_t)(d32_grp ? orow : row) * ld32 + col) = v * s32;
                            if (d16) { v2u o; o.x = pg8::cvt_pk_bf16(v[0] * s16, v[1] * s16); o.y = pg8::cvt_pk_bf16(v[2] * s16, v[3] * s16); *(v2u*)(d16 + (size_t)row * ld16 + col) = o; } } }
        } else {
            if (wc == 0) {
                float* lf = out + (smp ? O_LFS : O_LFP); float* ggp = (float*)(ws + WS_GG);
#pragma unroll
                for (int ai = 0; ai < 2; ++ai)
#pragma unroll
                    for (int m = 0; m < 4; ++m) { const int row = row0 + ai * 128 + m * 16, orow = orow0 + ai * 128 + m * 16;
#pragma unroll
                        for (int n = 0; n < 2; ++n) { const int col = n * 16 + fq * 4; const f32x4 v = acc[ai][0][m][n];
                            if (col < 8) { f32x4 o; const f32x4 b = *(const f32x4*)(bff + col);
                                o[0] = log_sigmoid(v[0] + b[0]); o[1] = log_sigmoid(v[1] + b[1]); o[2] = log_sigmoid(v[2] + b[2]); o[3] = log_sigmoid(v[3] + b[3]);
                                *(f32x4*)(lf + (size_t)orow * 8 + col) = o; }
                            else if (col < 24) *(f32x4*)(ggp + (size_t)row * 16 + (col - 8)) = v; } }
            }
        }
    }
};


__device__ __forceinline__ void p0_prologue(const Frame& F, const Args& a) {
    unsigned char* ws = a.ws;
    LAS float* scr = (LAS float*)(F.lds + F.wave * 16384);
    const int gw = F.vcu * NWAVES + F.wave, NGW = F.G * NWAVES;
    constexpr int I_WINN = 16 * (N_IN / 32), I_SQ = 16 * 32;
    constexpr int NITEMS = I_WINN + 5 * I_SQ;
    for (int it = gw; it < NITEMS; it += NGW) {
        int r = it;
        if (r < I_WINN) { p0_transpose_item<true>((const float*)a.in[I_WIN], 3096, DM, N_IN / 32, (bf16*)(ws + WS_WIN), scr, r, F.lane); continue; } r -= I_WINN;
        const int which = r / I_SQ; r -= which * I_SQ;
        const float* src = (const float*)(which == 0 ? a.in[I_WOUT] : which == 1 ? a.in[I_WMK] : which == 2 ? a.in[I_WMV] : which == 3 ? a.in[I_WCQ] : a.in[I_WCO]);
        bf16* dst = (bf16*)(ws + (which == 0 ? WS_WOUT : which == 1 ? WS_WMK : which == 2 ? WS_WMV : which == 3 ? WS_WCQ : WS_WCO));
        p0_transpose_item<false>(src, DM, DM, 32, dst, scr, r, F.lane);
    }
    { float* ssz = (float*)(ws + WS_SS); for (int i = F.vcu * NTHR + F.tid; i < 2 * TA; i += F.G * NTHR) ssz[i] = 0.f; }
    for (int m0 = gw * 2; m0 < TA + 512; m0 += NGW * 2) {
        const float* xr[2]; const float* gr[2]; bf16* orow[2];
#pragma unroll
        for (int j = 0; j < 2; ++j) { const int m = m0 + j;
            if (m < TP) { xr[j] = (const float*)a.in[I_XP] + (size_t)m * DM; gr[j] = (const float*)a.in[I_GMIX]; orow[j] = (bf16*)(ws + WS_HB) + (size_t)m * DM; }
            else if (m < TA) { xr[j] = (const float*)a.in[I_XS] + (size_t)(m - TP) * DM; gr[j] = (const float*)a.in[I_GMIX]; orow[j] = (bf16*)(ws + WS_HB) + (size_t)m * DM; }
            else { xr[j] = (const float*)a.in[I_MEMP] + (size_t)(m - TA) * DM; gr[j] = (const float*)a.in[I_GMEM]; orow[j] = (bf16*)(ws + WS_MB) + (size_t)(m - TA) * DM; } }
        f32x4 v[2][4]; float s[2];
#pragma unroll
        for (int j = 0; j < 2; ++j) { s[j] = 0.f;
#pragma unroll
            for (int q = 0; q < 4; ++q) v[j][q] = ((const f32x4*)xr[j])[F.lane + 64 * q]; }
#pragma unroll
        for (int j = 0; j < 2; ++j) {
#pragma unroll
            for (int q = 0; q < 4; ++q) s[j] += (v[j][q].x * v[j][q].x + v[j][q].y * v[j][q].y) + (v[j][q].z * v[j][q].z + v[j][q].w * v[j][q].w);
            const float r = rsqrtf(wave_sum(s[j]) * (1.f / DM) + EPS);
#pragma unroll
            for (int q = 0; q < 4; ++q) { const f32x4 gg = ((const f32x4*)gr[j])[F.lane + 64 * q]; v2u o; o.x = pk2(v[j][q].x * r * gg.x, v[j][q].y * r * gg.y); o.y = pk2(v[j][q].z * r * gg.z, v[j][q].w * r * gg.w); ((v2u*)orow[j])[F.lane + 64 * q] = o; } }
    }
    {
        for (int r0 = gw * 4; r0 < 2 * 16384; r0 += NGW * 4) {
            f32x4 x[4][4];
#pragma unroll
            for (int j = 0; j < 4; ++j) { const int r = r0 + j; const bool isv = r >= 16384; const int e = isv ? r - 16384 : r;
                const f32x4* s = (const f32x4*)((const float*)(isv ? a.in[I_PV] : a.in[I_PU]) + (size_t)e * DM + 16 * F.lane);
#pragma unroll
                for (int q = 0; q < 4; ++q) x[j][q] = __builtin_nontemporal_load(s + q); }
#pragma unroll
            for (int j = 0; j < 4; ++j) { const int r = r0 + j; const bool isv = r >= 16384; const int e = isv ? r - 16384 : r; float am = 0.f;
#pragma unroll
                for (int q = 0; q < 4; ++q) am = fmaxf(am, fmaxf(fmaxf(fabsf(x[j][q].x), fabsf(x[j][q].y)), fmaxf(fabsf(x[j][q].z), fabsf(x[j][q].w))));
#pragma unroll
                for (int o = 1; o < 64; o <<= 1) am = fmaxf(am, __shfl_xor(am, o));
                const float inv = am > 0.f ? 448.f / am : 0.f;
                v4u o4;
#pragma unroll
                for (int q = 0; q < 4; ++q) { int pk = __builtin_amdgcn_cvt_pk_fp8_f32(x[j][q].x * inv, x[j][q].y * inv, 0, false); pk = __builtin_amdgcn_cvt_pk_fp8_f32(x[j][q].z * inv, x[j][q].w * inv, pk, true); o4[q] = (unsigned)pk; }
                *(v4u*)(ws + (isv ? WS_V16 : WS_U16) + (size_t)e * DM + 16 * F.lane) = o4;
                if (F.lane == 0) ((float*)(ws + WS_MISC))[r] = am * (1.f / 448.f); }
        }
    }
    __syncthreads();
    for (int it = blockIdx.x; it < 256; it += F.G) {
        const int c = it >> 4, kt = it & 15, half = c & 1;
        LAS float* SK = (LAS float*)F.lds; LAS float* WT = (LAS float*)(F.lds + 128 * 129 * 4);
        const float* sk = (const float*)a.in[I_PSK] + (size_t)half * 128 * 128; const float* wq = (const float*)a.in[I_PWQ] + (size_t)(kt * 64) * 2048 + c * 128;
#pragma unroll 4
        for (int i = 0; i < 32; ++i) { const int idx = F.tid + 512 * i; SK[(idx >> 7) * 129 + (idx & 127)] = sk[idx]; }
#pragma unroll 4
        for (int i = 0; i < 16; ++i) { const int idx = F.tid + 512 * i; WT[(idx >> 7) * 129 + (idx & 127)] = wq[(size_t)(idx >> 7) * 2048 + (idx & 127)]; }
        __syncthreads();
        const int tk = F.tid & 15, tkey = F.tid >> 4;
        float acc[4][4];
#pragma unroll
        for (int i = 0; i < 4; ++i)
#pragma unroll
            for (int j = 0; j < 4; ++j) acc[i][j] = 0.f;
        for (int j = 0; j < 128; ++j) {
            float av[4], bv[4];
#pragma unroll
            for (int i = 0; i < 4; ++i) { av[i] = SK[(4 * tkey + i) * 129 + j]; bv[i] = WT[(4 * tk + i) * 129 + j]; }
#pragma unroll
            for (int i = 0; i < 4; ++i)
#pragma unroll
                for (int i2 = 0; i2 < 4; ++i2) acc[i][i2] += av[i] * bv[i2];
        }
        bf16* wp = (bf16*)(ws + WS_WPK);
#pragma unroll
        for (int i = 0; i < 4; ++i) { v2u o; o.x = pk2(acc[i][0], acc[i][1]); o.y = pk2(acc[i][2], acc[i][3]); *(v2u*)(wp + (size_t)(c * 128 + 4 * tkey + i) * DM + kt * 64 + 4 * tk) = o; }
        __syncthreads();
    }
}


__device__ __forceinline__ void fox_prompt_cumsum(const Frame& F, const float* logf  , float* kbias, int b) {
    LAS float* WT = (LAS float*)F.lds;
    const int t0 = F.wave * 1024 + F.lane * 16;
    const f32x4* src = (const f32x4*)(logf + ((size_t)b * SEQ + t0) * 8);
    float s[8];
#pragma unroll
    for (int h = 0; h < 8; ++h) s[h] = 0.f;
#pragma unroll 4
    for (int i = 0; i < 16; ++i) { const f32x4 a = src[2 * i], c = src[2 * i + 1]; s[0] += a.x; s[1] += a.y; s[2] += a.z; s[3] += a.w; s[4] += c.x; s[5] += c.y; s[6] += c.z; s[7] += c.w; }
    float ex[8];
#pragma unroll
    for (int h = 0; h < 8; ++h) { float v = s[h];
#pragma unroll
        for (int o = 1; o < 64; o <<= 1) { const float t = __shfl_up(v, o); if (F.lane >= o) v += t; }
        ex[h] = v - s[h];
        if (F.lane == 63) WT[F.wave * 8 + h] = v; }
    __syncthreads();
#pragma unroll
    for (int h = 0; h < 8; ++h) { float c = 0.f; for (int w = 0; w < F.wave; ++w) c += WT[w * 8 + h]; ex[h] += c; }
    float* dst = kbias + (size_t)(b * 8) * SEQ + t0;
#pragma unroll 4
    for (int i = 0; i < 16; ++i) { const f32x4 a = src[2 * i], c = src[2 * i + 1];
        ex[0] += a.x; ex[1] += a.y; ex[2] += a.z; ex[3] += a.w; ex[4] += c.x; ex[5] += c.y; ex[6] += c.z; ex[7] += c.w;
#pragma unroll
        for (int h = 0; h < 8; ++h) dst[(size_t)h * SEQ + i] = -ex[h] * LOG2E; }
    __syncthreads();
}
__device__ __forceinline__ void fox_sample_suffix(const Frame& F, const float* cfl, const int* pt, float* suf, int bs) {
    float carry[8];
#pragma unroll
    for (int h = 0; h < 8; ++h) carry[h] = 0.f;
    const int mypg = pt[bs * NPAGES + (F.lane & 15)];
#pragma unroll 1
    for (int pb = NPAGES - 4; pb >= 0; pb -= 4) {
        f32x4 x[4][4];
#pragma unroll
        for (int j = 0; j < 4; ++j) { const int pg = __builtin_amdgcn_readlane(mypg, 0) * 0 + __shfl(mypg, pb + j); const f32x4* src = (const f32x4*)(cfl + ((size_t)pg * PAGE + 2 * F.lane) * 8);
            x[j][0] = src[0]; x[j][1] = src[1]; x[j][2] = src[2]; x[j][3] = src[3]; }
#pragma unroll
        for (int j = 3; j >= 0; --j) { const int p = pb + j;
            const float ra[8] = {x[j][0].x, x[j][0].y, x[j][0].z, x[j][0].w, x[j][1].x, x[j][1].y, x[j][1].z, x[j][1].w}, rb[8] = {x[j][2].x, x[j][2].y, x[j][2].z, x[j][2].w, x[j][3].x, x[j][3].y, x[j][3].z, x[j][3].w};
#pragma unroll
            for (int h = 0; h < 8; ++h) {
                const float ps = ra[h] + rb[h]; float v = ps;
#pragma unroll
                for (int o = 1; o < 64; o <<= 1) { const float t = __shfl_down(v, o); if (F.lane + o < 64) v += t; }
                const float exs = v - ps;
                float* d = suf + (size_t)(bs * 8 + h) * PASTL + p * PAGE + 2 * F.lane;
                *(f32x2*)d = (f32x2){(carry[h] + exs + rb[h]) * LOG2E, (carry[h] + exs) * LOG2E};
                carry[h] += __shfl(v, 0);
            }
        }
    }
}

__device__ __forceinline__ void gla_gate_tile(const Frame& F, const float* gg, const float* w2, const float* bg, int row0, int h, int nt, LAS float* LA, LAS float* GGS) {
    for (int e = F.tid; e < nt * 16; e += NTHR) GGS[e] = gg[(size_t)row0 * 16 + e];
    const int dk = F.tid & 63; float wc[16];
#pragma unroll
    for (int r = 0; r < 16; ++r) wc[r] = w2[r * 256 + h * 64 + dk];
    const float bb = bg[h * 64 + dk];
    __syncthreads();
    for (int t = F.tid >> 6; t < nt; t += 8) { float z = bb;
#pragma unroll
        for (int q = 0; q < 4; ++q) { const f32x4 g4 = *(const LAS f32x4*)(GGS + t * 16 + 4 * q); z += g4.x * wc[4 * q] + g4.y * wc[4 * q + 1] + g4.z * wc[4 * q + 2] + g4.w * wc[4 * q + 3]; }
        LA[t * 64 + dk] = log_sigmoid(z) * (1.f / 16.f); }
}
__device__ __forceinline__ void gla_cumsum64(const Frame& F, LAS float* LA, LAS float* SEG) {
    const int dk = F.lane, w = F.wave; float v[8]; float run = 0.f;
#pragma unroll
    for (int i = 0; i < 8; ++i) { run += LA[(8 * w + i) * 64 + dk]; v[i] = run; }
    SEG[w * 64 + dk] = run;
    __syncthreads();
    float pre = 0.f;
    for (int j = 0; j < w; ++j) pre += SEG[j * 64 + dk];
#pragma unroll
    for (int i = 0; i < 8; ++i) LA[(8 * w + i) * 64 + dk] = v[i] + pre;
    __syncthreads();
}
__device__ __forceinline__ void gla_g1_unit(const Frame& F, const Args& a, int u) {
    unsigned char* ws = a.ws;
    const int b = u >> 9, h = (u >> 7) & 3, n = u & 127; const int row0 = b * SEQ + n * 64;
    LAS float* LA = (LAS float*)F.lds; LAS float* KR = LA + 4096; LAS float* SEG = KR + 4096; LAS float* GGS = SEG + 512; LAS float* VS = GGS + 1024;
#pragma unroll
    for (int i = 0; i < 16; ++i) { const int e = F.tid + NTHR * i; VS[e] = ((const float*)(ws + WS_GV))[(size_t)(row0 + (e >> 7)) * 512 + h * 128 + (e & 127)]; }
    gla_gate_tile(F, (const float*)(ws + WS_GG), (const float*)a.in[I_WG2], (const float*)a.in[I_BG], row0, h, 64, LA, GGS);
    __syncthreads();
    gla_cumsum64(F, LA, SEG);
    if (F.tid < 64) ((float*)(ws + WS_GDEC))[(size_t)((b * 4 + h) * 128 + n) * 64 + F.tid] = __expf(LA[63 * 64 + F.tid]);
    const float* gk = (const float*)(ws + WS_GK); float* bbuf = (float*)(ws + WS_BB);
#pragma unroll
    for (int i = 0; i < 8; ++i) { const int e = F.tid + NTHR * i; const int t = e >> 6, dk = e & 63; const float bb = LA[e]; bbuf[(size_t)(row0 + t) * 256 + h * 64 + dk] = bb;
        KR[e] = gk[(size_t)(row0 + t) * 256 + h * 64 + dk] * __expf(LA[63 * 64 + dk] - bb); }
    __syncthreads();
    {
        const int dvq = F.tid & 31, dkq = F.tid >> 5; float acc[4][4];
#pragma unroll
        for (int i = 0; i < 4; ++i)
#pragma unroll
            for (int j = 0; j < 4; ++j) acc[i][j] = 0.f;
#pragma unroll 8
        for (int t = 0; t < 64; ++t) { const f32x4 v4 = *(const LAS f32x4*)(VS + t * 128 + 4 * dvq), k4 = *(const LAS f32x4*)(KR + t * 64 + 4 * dkq);
#pragma unroll
            for (int i = 0; i < 4; ++i)
#pragma unroll
                for (int j = 0; j < 4; ++j) acc[i][j] += k4[i] * v4[j]; }
        float* kv = (float*)(ws + WS_GKV) + ((size_t)((b * 4 + h) * 128 + n) * 64 + 4 * dkq) * 128 + 4 * dvq;
#pragma unroll
        for (int i = 0; i < 4; ++i) *(f32x4*)(kv + (size_t)i * 128) = (f32x4){acc[i][0], acc[i][1], acc[i][2], acc[i][3]};
    }
    __syncthreads();
}
__device__ __forceinline__ void gla_scan(const Frame& F, const Args& a) {
    int tid = F.wave * 64 + lane_id(); asm volatile("" : "+v"(tid));
    if (tid >= 256) return;
    for (int e = F.vcu * 256 + tid; e < 65536; e += F.G * 256) {
    const int bh = e >> 13, dk = (e >> 7) & 63, dv = e & 127;
    float* kv = (float*)(a.ws + WS_GKV) + ((size_t)bh * 128 * 64 + dk) * 128 + dv; const float* dc = (const float*)(a.ws + WS_GDEC) + (size_t)bh * 128 * 64 + dk;
    float S = 0.f;
    for (int n0 = 0; n0 < 128; n0 += 8) { float kvv[8], dd[8];
#pragma unroll
        for (int j = 0; j < 8; ++j) { kvv[j] = kv[(size_t)(n0 + j) * 8192]; dd[j] = dc[(size_t)(n0 + j) * 64]; }
#pragma unroll
        for (int j = 0; j < 8; ++j) { kv[(size_t)(n0 + j) * 8192] = S; S = dd[j] * S + kvv[j]; } }
    a.out[O_GSP + (size_t)bh * 8192 + dk * 128 + dv] = S;
    }
}
__device__ __forceinline__ float silu(float x) { return x / (1.f + __expf(-x)); }
__device__ __forceinline__ void gla_sample_unit(const Frame& F, const Args& a, int u) {
    unsigned char* ws = a.ws;
    const int bs = u >> 2, h = u & 3; const int row0 = TP + bs * LS;
    LAS float* LA = (LAS float*)F.lds; LAS float* BL = LA + 512; LAS float* QD = BL + 64; LAS float* KI = QD + 512; LAS float* KR = KI + 512; LAS float* ATT = KR + 512; LAS float* OP = ATT + 64; LAS float* VS = OP + 4096;
    gla_gate_tile(F, (const float*)(ws + WS_GG), (const float*)a.in[I_WG2], (const float*)a.in[I_BG], row0, h, 8, LA, VS + 1024);
#pragma unroll
    for (int i = 0; i < 2; ++i) { const int e = F.tid + NTHR * i; VS[e] = ((const float*)(ws + WS_GV))[(size_t)(row0 + (e >> 7)) * 512 + h * 128 + (e & 127)]; }
    __syncthreads();
    if (F.tid < 64) { float run = 0.f;
#pragma unroll
        for (int t = 0; t < 8; ++t) { run += LA[t * 64 + F.tid]; LA[t * 64 + F.tid] = run; } BL[F.tid] = run; }
    __syncthreads();
    { const int e = F.tid, t = e >> 6, dk = e & 63; const float bb = LA[e];
      const float q = ((const float*)(ws + WS_GQ))[(size_t)(row0 + t) * 256 + h * 64 + dk], k = ((const float*)(ws + WS_GK))[(size_t)(row0 + t) * 256 + h * 64 + dk];
      QD[e] = q * __expf(bb); KI[e] = k * __expf(-bb); KR[e] = k * __expf(BL[dk] - bb); }
    __syncthreads();
    if (F.tid < 64) { const int t = F.tid >> 3, s = F.tid & 7; float acc = 0.f;
        if (s <= t) { for (int dk = 0; dk < 64; ++dk) acc += QD[t * 64 + dk] * KI[s * 64 + dk]; }
        ATT[F.tid] = acc; }
    const int dv = F.tid & 127, dkg = F.tid >> 7;
    {
        const float* st = (const float*)a.in[I_SGLA] + ((size_t)(bs * 4 + h) * 64 + dkg * 16) * 128 + dv;
        float S0[16];
#pragma unroll
        for (int i = 0; i < 16; ++i) S0[i] = st[(size_t)i * 128];
#pragma unroll
        for (int t = 0; t < 8; ++t) { float o = 0.f;
#pragma unroll
            for (int i = 0; i < 16; ++i) o += QD[t * 64 + dkg * 16 + i] * S0[i];
            OP[(dkg * 8 + t) * 128 + dv] = o; }
        float* so = a.out + O_GSS + ((size_t)(bs * 4 + h) * 64 + dkg * 16) * 128 + dv;
#pragma unroll
        for (int i = 0; i < 16; ++i) { float sn = __expf(BL[dkg * 16 + i]) * S0[i];
#pragma unroll
            for (int t = 0; t < 8; ++t) sn += KR[t * 64 + dkg * 16 + i] * VS[t * 128 + dv];
            so[(size_t)i * 128] = sn; }
    }
    __syncthreads();
    {
        const int t = F.wave; float o[2]; float ss = 0.f;
#pragma unroll
        for (int j = 0; j < 2; ++j) { const int d = 2 * F.lane + j; float v = OP[(0 * 8 + t) * 128 + d] + OP[(1 * 8 + t) * 128 + d] + OP[(2 * 8 + t) * 128 + d] + OP[(3 * 8 + t) * 128 + d];
            for (int s = 0; s <= t; ++s) v += ATT[t * 8 + s] * VS[s * 128 + d];
            o[j] = v; ss += v * v; }
        const float r = rsqrtf(wave_sum(ss) * (1.f / 128.f) + EPS);
        const float* ggo = (const float*)a.in[I_GGO] + h * 128 + 2 * F.lane; const float* gr = (const float*)(ws + WS_GR) + (size_t)(row0 + t) * 512 + h * 128 + 2 * F.lane;
        const float y0 = o[0] * r * ggo[0] * silu(gr[0]), y1 = o[1] * r * ggo[1] * silu(gr[1]);
        *(unsigned*)((bf16*)(ws + WS_MERGED) + (size_t)(row0 + t) * DM + 512 + h * 128 + 2 * F.lane) = pk2(y0, y1);
    }
    __syncthreads();
}


typedef short v4i16_t __attribute__((ext_vector_type(4)));
__device__ __forceinline__ s16x4 lds_tr16(LAS unsigned char* p) { return __builtin_bit_cast(s16x4, __builtin_amdgcn_ds_read_tr16_b64_v4i16((LAS v4i16_t*)p)); }
__device__ __forceinline__ int crow(int r, int hi) { return (r & 3) + 8 * (r >> 2) + 4 * hi; }
__device__ __forceinline__ float fexp2(float x) { return __builtin_amdgcn_exp2f(x); }
constexpr float FOX_SKIP = 160.f;


__device__ __forceinline__ void fox_norms_item(const Frame& F, const bf16* QF, const bf16* KF, const float* logf, float* FN, float* LC, float* BT, int item) {
    const int bh = item >> 5, qb = item & 31, b = bh >> 3, h = bh & 7;
    float qm = 0.f, km = 0.f;
    const float* lp = logf + ((size_t)b * SEQ + qb * 256 + 4 * F.lane) * 8 + h;
    const float l0 = lp[0], l1 = lp[8], l2 = lp[16], l3 = lp[24];
#pragma unroll
    for (int i = 0; i < 4; ++i) { const size_t row = (size_t)b * SEQ + qb * 256 + i * 64 + F.lane;
        const v4u* qp = (const v4u*)(QF + row * 512 + h * 64); const v4u* kp = (const v4u*)(KF + row * 512 + h * 64); float qs = 0.f, ks = 0.f;
#pragma unroll
        for (int c = 0; c < 8; ++c) { const v4u q = qp[c], k = kp[c];
#pragma unroll
            for (int j = 0; j < 4; ++j) { qs += bflo(q[j]) * bflo(q[j]) + bfhi(q[j]) * bfhi(q[j]); ks += bflo(k[j]) * bflo(k[j]) + bfhi(k[j]) * bfhi(k[j]); } }
        qm = fmaxf(qm, qs); km = fmaxf(km, ks); }
#pragma unroll
    for (int o = 1; o < 64; o <<= 1) { qm = fmaxf(qm, __shfl_xor(qm, o)); km = fmaxf(km, __shfl_xor(km, o)); }
    const float c0 = l0, c1 = c0 + l1, c2 = c1 + l2, c3 = c2 + l3; float v = c3;
#pragma unroll
    for (int o = 1; o < 64; o <<= 1) { const float t = __shfl_up(v, o); if (F.lane >= o) v += t; }
    const float ex = v - c3;
    *(f32x4*)(LC + (size_t)bh * SEQ + qb * 256 + 4 * F.lane) = (f32x4){ex + c0, ex + c1, ex + c2, ex + c3};
    if (F.lane == 63) BT[item] = v;
    if (F.lane == 0) { FN[item * 2] = qm; FN[item * 2 + 1] = km; }
}
__device__ __forceinline__ void fox_suffix_item(const Frame& F, const float* cfl, const int* pt, float* SW, float* PTOT, int item) {
    const int bs = item >> 4, p = item & 15; const int pg = __builtin_amdgcn_readfirstlane(pt[item]);
    const f32x4* src = (const f32x4*)(cfl + ((size_t)pg * PAGE + 2 * F.lane) * 8);
    const f32x4 a0 = src[0], a1 = src[1], b0 = src[2], b1 = src[3];
    const float ra[8] = {a0.x, a0.y, a0.z, a0.w, a1.x, a1.y, a1.z, a1.w}, rb[8] = {b0.x, b0.y, b0.z, b0.w, b1.x, b1.y, b1.z, b1.w};
#pragma unroll
    for (int h = 0; h < 8; ++h) {
        const float ps = ra[h] + rb[h]; float v = ps;
#pragma unroll
        for (int o = 1; o < 64; o <<= 1) { const float t = __shfl_down(v, o); if (F.lane + o < 64) v += t; }
        const float exs = v - ps;
        *(f32x2*)(SW + (size_t)(bs * 8 + h) * PASTL + p * PAGE + 2 * F.lane) = (f32x2){exs + rb[h], exs};
        if (F.lane == 0) PTOT[(bs * 8 + h) * NPAGES + p] = v;
    }
}
__device__ __forceinline__ void fox_attn_unit(const Frame& F, const bf16* QF, const bf16* KF, const bf16* VF, const float* LC, const float* BT, const float* FN, bf16* merged, int b, int h, int qb) {
    int tid = F.wave * 64 + lane_id(); asm volatile("" : "+v"(tid));
    const int lane = tid & 63, r32 = lane & 31, hi = lane >> 5, wid = F.wave;
    const size_t rowbase = (size_t)b * SEQ; const int q0 = qb * 256;
    LAS unsigned char* Ks = F.lds; LAS unsigned char* Vs = F.lds + 8192; LAS float* KBs = (LAS float*)(F.lds + 20480); LAS float* WSF = (LAS float*)(F.lds + 20736) + wid * 32;
    const bf16* Qw = QF + (rowbase + q0 + wid * 32 + r32) * 512 + h * 64;
    bf16x8 qr[4];
#pragma unroll
    for (int d0 = 0; d0 < 4; ++d0) qr[d0] = *(const bf16x8*)(Qw + d0 * 16 + hi * 8);
    const float* lcp = LC + (size_t)(b * 8 + h) * SEQ;
    float pbx; { const float btv = (lane < 32) ? BT[(b * 8 + h) * 32 + lane] : 0.f; float v = btv;
#pragma unroll
        for (int o = 1; o < 64; o <<= 1) { const float t = __shfl_up(v, o); if (lane >= o) v += t; }
        pbx = v - btv; }
    const float cref = lcp[q0] + __shfl(pbx, qb);
#define FOX_KB(t_, pos_) (-LOG2E * ((lcp[pos_] + __shfl(pbx, (t_) >> 2)) - cref))
    const int NT = (q0 + 256) / 64;
    int t0 = 0;
    {
        float kn = (lane < 32) ? FN[((b * 8 + h) * 32 + lane) * 2 + 1] : 0.f;
#pragma unroll
        for (int o = 1; o < 64; o <<= 1) kn = fmaxf(kn, __shfl_xor(kn, o));
        const float qk2 = 2.f * sqrtf(FN[((b * 8 + h) * 32 + qb) * 2]) * sqrtf(kn) * 1.01f;
        const int nbefore = q0 / 64;
        int found = -1;
        for (int base = 0; base < nbefore && found < 0; base += 64) {
            const int tl = nbefore - 1 - base - lane;
            const int tlc = tl < 0 ? 0 : tl; const float kbl = -LOG2E * ((lcp[tlc * 64 + 63] + __shfl(pbx, tlc >> 2)) - cref);
            const bool dead = (tl >= 0) && (qk2 + kbl < -FOX_SKIP);
            const unsigned long long bm = __ballot(dead);
            if (bm) found = nbefore - 1 - base - (int)__builtin_ctzll(bm);
        }
        t0 = found + 1;
        t0 = __builtin_amdgcn_readfirstlane(t0);
    }
    const int kkey = tid & 63, kch = tid >> 6, vkey = tid >> 3, vch = tid & 7;
    const bf16* ksrc = KF + (rowbase + kkey) * 512 + h * 64 + kch * 8;
    const bf16* vsrc = VF + (rowbase + vkey) * 512 + h * 64 + vch * 8;
    v4u kreg = *(const v4u*)(ksrc + (size_t)t0 * 64 * 512), vreg = *(const v4u*)(vsrc + (size_t)t0 * 64 * 512); float kbreg = FOX_KB(t0, t0 * 64 + (tid & 63));
    float m_run = -INFINITY, l_run = 0.f; f32x16 o0 = {}, o1 = {};
    const int qpos = q0 + wid * 32 + r32;
    const int vbase = (4 * hi + ((lane & 15) >> 2)) * 192 + (16 * ((lane >> 4) & 1) + 4 * (lane & 3)) * 2;
    for (int t = t0; t < NT; ++t) {
        __syncthreads();
        *(LAS v4u*)(Ks + kch * 1024 + kkey * 16) = kreg; *(LAS v4u*)(Vs + vkey * 192 + vch * 16) = vreg; if (tid < 64) KBs[tid] = kbreg;
        __syncthreads();
        if (t + 1 < NT) { kreg = *(const v4u*)(ksrc + (size_t)(t + 1) * 64 * 512); vreg = *(const v4u*)(vsrc + (size_t)(t + 1) * 64 * 512); kbreg = FOX_KB(t + 1, (t + 1) * 64 + (tid & 63)); }
        const int k0 = t * 64;
        if (k0 > q0 + wid * 32 + 31) continue;
        f32x16 p0 = {}, p1 = {};
#pragma unroll
        for (int d0 = 0; d0 < 4; ++d0) {
            const bf16x8 a0 = *(const LAS bf16x8*)(Ks + (2 * d0 + hi) * 1024 + r32 * 16), a1 = *(const LAS bf16x8*)(Ks + (2 * d0 + hi) * 1024 + r32 * 16 + 512);
            p0 = __builtin_amdgcn_mfma_f32_32x32x16_bf16(a0, qr[d0], p0, 0, 0, 0); p1 = __builtin_amdgcn_mfma_f32_32x32x16_bf16(a1, qr[d0], p1, 0, 0, 0);
        }
#pragma unroll
        for (int g = 0; g < 4; ++g) { const f32x4 ba = *(const LAS f32x4*)(KBs + 8 * g + 4 * hi), bb = *(const LAS f32x4*)(KBs + 32 + 8 * g + 4 * hi);
#pragma unroll
            for (int i = 0; i < 4; ++i) { p0[4 * g + i] += ba[i]; p1[4 * g + i] += bb[i]; } }
        if (k0 + 63 > q0 + wid * 32) {
#pragma unroll
            for (int r = 0; r < 16; ++r) { const int key = k0 + crow(r, hi); if (key > qpos) p0[r] = -INFINITY; if (key + 32 > qpos) p1[r] = -INFINITY; }
        }
        float mx = fmaxf(p0[0], p1[0]);
#pragma unroll
        for (int r = 1; r < 16; ++r) mx = fmaxf(mx, fmaxf(p0[r], p1[r]));
        mx = fmaxf(mx, __shfl_xor(mx, 32));
        const float m_new = fmaxf(m_run, mx), alpha = fexp2(m_run - m_new); m_run = m_new;
        float ls = 0.f;
#pragma unroll
        for (int r = 0; r < 16; ++r) { p0[r] = fexp2(p0[r] - m_new); p1[r] = fexp2(p1[r] - m_new); ls += p0[r] + p1[r]; }
        l_run = l_run * alpha + ls;
        if (hi == 0) WSF[r32] = alpha;
#pragma unroll
        for (int g = 0; g < 4; ++g) { const f32x4 al = *(const LAS f32x4*)(WSF + 8 * g + 4 * hi);
#pragma unroll
            for (int i = 0; i < 4; ++i) { o0[4 * g + i] *= al[i]; o1[4 * g + i] *= al[i]; } }
        v4u pw[4];
#pragma unroll
        for (int j = 0; j < 4; ++j) { pw[0][j] = pg8::cvt_pk_bf16(p0[2 * j], p0[2 * j + 1]); pw[1][j] = pg8::cvt_pk_bf16(p0[8 + 2 * j], p0[8 + 2 * j + 1]);
                                      pw[2][j] = pg8::cvt_pk_bf16(p1[2 * j], p1[2 * j + 1]); pw[3][j] = pg8::cvt_pk_bf16(p1[8 + 2 * j], p1[8 + 2 * j + 1]); }
#pragma unroll
        for (int ks = 0; ks < 4; ++ks) {
            const bf16x8 pa = __builtin_bit_cast(bf16x8, pw[ks]);
#pragma unroll
            for (int d0 = 0; d0 < 2; ++d0) {
                const s16x4 lo = lds_tr16(Vs + vbase + ks * 16 * 192 + d0 * 64), hi4 = lds_tr16(Vs + vbase + ks * 16 * 192 + 8 * 192 + d0 * 64);
                const bf16x8 vb = (bf16x8){lo[0], lo[1], lo[2], lo[3], hi4[0], hi4[1], hi4[2], hi4[3]};
                if (d0 == 0) o0 = __builtin_amdgcn_mfma_f32_32x32x16_bf16(pa, vb, o0, 0, 0, 0); else o1 = __builtin_amdgcn_mfma_f32_32x32x16_bf16(pa, vb, o1, 0, 0, 0);
            }
        }
    }
    l_run += __shfl_xor(l_run, 32);
    if (hi == 0) WSF[r32] = 1.f / l_run;
    bf16* Ow = merged + (rowbase + q0 + wid * 32) * DM + h * 64 + r32;
#pragma unroll
    for (int g = 0; g < 4; ++g) { const f32x4 rl = *(const LAS f32x4*)(WSF + 8 * g + 4 * hi);
#pragma unroll
        for (int i = 0; i < 4; ++i) { const int r = 4 * g + i; const int row = crow(r, hi);
            Ow[(size_t)row * DM] = (bf16)f2bf(o0[r] * rl[i]); Ow[(size_t)row * DM + 32] = (bf16)f2bf(o1[r] * rl[i]); } }
    __syncthreads();
#undef FOX_KB
}

template <int D> struct DecW {
    static constexpr int KS = D / 32;
    static constexpr int LPK = D / 4;
    static constexpr int KPI = 64 / LPK;
    float m[4], l[4]; float o[8][4];
};
template <int D>
__device__ __forceinline__ void dec_init(DecW<D>& w) {
#pragma unroll
    for (int i = 0; i < 4; ++i) { w.m[i] = -INFINITY; w.l[i] = 0.f; }
#pragma unroll
    for (int q = 0; q < 8; ++q)
#pragma unroll
        for (int j = 0; j < 4; ++j) w.o[q][j] = 0.f;
}
template <int D, int NTILE, int MODE>
__device__ __forceinline__ void dec_chunk(DecW<D>& w, const bf16x8 (&qa)[D / 32], const float* Kb, const float* Vb, int stride, const float* bias, float nb, LAS float* PL, int lane) {
    constexpr int KS = D / 32, LPK = D / 4, KPI = 64 / LPK;
    constexpr int NK = (MODE == 1) ? 8 : NTILE * 16, NV = NK / KPI;
    const int key = lane & 15, kq = lane >> 4;
    const unsigned koff = (unsigned)(key * stride + 8 * kq) * 4u;
    const int d4 = lane % LPK, ksub = lane / LPK;
    const unsigned voff = (unsigned)(ksub * stride + 4 * d4) * 4u;
    f32x4 kx[NTILE][2 * KS], vx[NV];
#pragma unroll
    for (int t = 0; t < NTILE; ++t) { const char* kp = (const char*)(Kb + (size_t)t * 16 * stride) + koff;
#pragma unroll
        for (int ks = 0; ks < KS; ++ks) { kx[t][2 * ks] = *(const f32x4*)(kp + 128 * ks); kx[t][2 * ks + 1] = *(const f32x4*)(kp + 128 * ks + 16); } }
    constexpr int NVA = (NV >= 8) ? NV / 2 : NV;
#pragma unroll
    for (int kk = 0; kk < NVA; ++kk) vx[kk] = *(const f32x4*)((const char*)(Vb + (size_t)kk * KPI * stride) + voff);
    f32x4 s[NTILE];
#pragma unroll
    for (int t = 0; t < NTILE; ++t) {
        f32x4 acc = {0.f, 0.f, 0.f, 0.f};
#pragma unroll
        for (int ks = 0; ks < KS; ++ks) { const f32x4 x0 = kx[t][2 * ks], x1 = kx[t][2 * ks + 1];
            v4u kb; kb.x = pg8::cvt_pk_bf16(x0.x, x0.y); kb.y = pg8::cvt_pk_bf16(x0.z, x0.w); kb.z = pg8::cvt_pk_bf16(x1.x, x1.y); kb.w = pg8::cvt_pk_bf16(x1.z, x1.w);
            acc = __builtin_amdgcn_mfma_f32_16x16x32_bf16(qa[ks], __builtin_bit_cast(bf16x8, kb), acc, 0, 0, 0); }
        if (MODE == 0) { if (bias) { const float bv = (bias[t * 16 + key] + nb) * LOG2E; acc += bv; } }
        else { acc += nb;
#pragma unroll
            for (int i = 0; i < 4; ++i) if (key > 4 * kq + i || key >= 8) acc[i] = -INFINITY; }
        s[t] = acc;
    }
#pragma unroll
    for (int kk = NVA; kk < NV; ++kk) vx[kk] = *(const f32x4*)((const char*)(Vb + (size_t)kk * KPI * stride) + voff);
    f32x4 mc = s[0];
#pragma unroll
    for (int t = 1; t < NTILE; ++t) { mc.x = fmaxf(mc.x, s[t].x); mc.y = fmaxf(mc.y, s[t].y); mc.z = fmaxf(mc.z, s[t].z); mc.w = fmaxf(mc.w, s[t].w); }
#pragma unroll
    for (int o = 1; o < 16; o <<= 1) { mc.x = fmaxf(mc.x, __shfl_xor(mc.x, o)); mc.y = fmaxf(mc.y, __shfl_xor(mc.y, o)); mc.z = fmaxf(mc.z, __shfl_xor(mc.z, o)); mc.w = fmaxf(mc.w, __shfl_xor(mc.w, o)); }
    float al[4];
#pragma unroll
    for (int i = 0; i < 4; ++i) { const float mn = fmaxf(w.m[i], mc[i]); al[i] = (mn == -INFINITY) ? 1.f : fexp2(w.m[i] - mn); w.m[i] = mn; w.l[i] *= al[i]; }
#pragma unroll
    for (int t = 0; t < NTILE; ++t) { f32x4 p;
#pragma unroll
        for (int i = 0; i < 4; ++i) { p[i] = (w.m[i] == -INFINITY) ? 0.f : fexp2(s[t][i] - w.m[i]); w.l[i] += p[i]; }
        if (kq < 2) *(LAS f32x4*)(PL + (t * 16 + key) * 8 + 4 * kq) = p; }
    if (key == 0 && kq < 2) *(LAS f32x4*)(PL + 1024 + 4 * kq) = (f32x4){al[0], al[1], al[2], al[3]};
    { const f32x4 a0 = *(const LAS f32x4*)(PL + 1024), a1 = *(const LAS f32x4*)(PL + 1028);
#pragma unroll
      for (int j = 0; j < 4; ++j) { w.o[0][j] *= a0.x; w.o[1][j] *= a0.y; w.o[2][j] *= a0.z; w.o[3][j] *= a0.w; w.o[4][j] *= a1.x; w.o[5][j] *= a1.y; w.o[6][j] *= a1.z; w.o[7][j] *= a1.w; } }
#pragma unroll
    for (int kk = 0; kk < NV; ++kk) { const int k = kk * KPI + ksub;
        const f32x4 v = vx[kk];
        const f32x4 pa = *(const LAS f32x4*)(PL + k * 8), pb = *(const LAS f32x4*)(PL + k * 8 + 4);
#pragma unroll
        for (int j = 0; j < 4; ++j) { w.o[0][j] += pa.x * v[j]; w.o[1][j] += pa.y * v[j]; w.o[2][j] += pa.z * v[j]; w.o[3][j] += pa.w * v[j];
                                      w.o[4][j] += pb.x * v[j]; w.o[5][j] += pb.y * v[j]; w.o[6][j] += pb.z * v[j]; w.o[7][j] += pb.w * v[j]; } }
}
__device__ __forceinline__ void dec_page_fox(DecW<64>& w, const bf16x8 (&qa)[2], const float* Kb, const float* Vb, const float* bias, float boff, LAS float* PL, int lane) {
    constexpr int stride = 512;
    const int key = lane & 15, kq = lane >> 4;
    const unsigned koff = (unsigned)(key * stride + 8 * kq) * 4u;
    const int d4 = lane & 15, ksub = lane >> 4;
    const unsigned voff = (unsigned)(ksub * stride + 4 * d4) * 4u;
    const __amdgpu_buffer_rsrc_t krs = __builtin_amdgcn_make_buffer_rsrc((void*)Kb, 0, 0x7fffffff, 0x00020000);
    const __amdgpu_buffer_rsrc_t vrs = __builtin_amdgcn_make_buffer_rsrc((void*)Vb, 0, 0x7fffffff, 0x00020000);
    const __amdgpu_buffer_rsrc_t brs = __builtin_amdgcn_make_buffer_rsrc((void*)bias, 0, 0x7fffffff, 0x00020000);
    f32x4 s[8];
#pragma unroll
    for (int hb = 0; hb < 2; ++hb) {
        f32x4 kx[4][4];
#pragma unroll
        for (int t = 0; t < 4; ++t) { const int so = (hb * 4 + t) * 16 * stride * 4;
            kx[t][0] = __builtin_bit_cast(f32x4, __builtin_amdgcn_raw_buffer_load_b128(krs, (int)koff, so, 0)); kx[t][1] = __builtin_bit_cast(f32x4, __builtin_amdgcn_raw_buffer_load_b128(krs, (int)koff + 16, so, 0));
            kx[t][2] = __builtin_bit_cast(f32x4, __builtin_amdgcn_raw_buffer_load_b128(krs, (int)koff + 128, so, 0)); kx[t][3] = __builtin_bit_cast(f32x4, __builtin_amdgcn_raw_buffer_load_b128(krs, (int)koff + 144, so, 0)); }
#pragma unroll
        for (int t = 0; t < 4; ++t) {
            f32x4 acc = {0.f, 0.f, 0.f, 0.f};
#pragma unroll
            for (int ks = 0; ks < 2; ++ks) { const f32x4 x0 = kx[t][2 * ks], x1 = kx[t][2 * ks + 1];
                v4u kb; kb.x = pg8::cvt_pk_bf16(x0.x, x0.y); kb.y = pg8::cvt_pk_bf16(x0.z, x0.w); kb.z = pg8::cvt_pk_bf16(x1.x, x1.y); kb.w = pg8::cvt_pk_bf16(x1.z, x1.w);
                acc = __builtin_amdgcn_mfma_f32_16x16x32_bf16(qa[ks], __builtin_bit_cast(bf16x8, kb), acc, 0, 0, 0); }
            acc += (__builtin_bit_cast(float, __builtin_amdgcn_raw_buffer_load_b32(brs, key * 4, (hb * 4 + t) * 64, 0)) + boff) * LOG2E;
            s[hb * 4 + t] = acc;
        }
        asm volatile("" ::: "memory");
    }
    f32x4 mc = s[0];
#pragma unroll
    for (int t = 1; t < 8; ++t) { mc.x = fmaxf(mc.x, s[t].x); mc.y = fmaxf(mc.y, s[t].y); mc.z = fmaxf(mc.z, s[t].z); mc.w = fmaxf(mc.w, s[t].w); }
#pragma unroll
    for (int o = 1; o < 16; o <<= 1) { mc.x = fmaxf(mc.x, __shfl_xor(mc.x, o)); mc.y = fmaxf(mc.y, __shfl_xor(mc.y, o)); mc.z = fmaxf(mc.z, __shfl_xor(mc.z, o)); mc.w = fmaxf(mc.w, __shfl_xor(mc.w, o)); }
    float al[4];
#pragma unroll
    for (int i = 0; i < 4; ++i) { const float mn = fmaxf(w.m[i], mc[i]); al[i] = fexp2(w.m[i] - mn); w.m[i] = mn; w.l[i] *= al[i]; }
    bool nz = false;
#pragma unroll
    for (int t = 0; t < 8; ++t) { f32x4 p;
#pragma unroll
        for (int i = 0; i < 4; ++i) { p[i] = fexp2(s[t][i] - w.m[i]); w.l[i] += p[i]; nz = nz || (p[i] != 0.f); }
        if (kq < 2) *(LAS f32x4*)(PL + (t * 16 + key) * 8 + 4 * kq) = p; }
    if (__ballot(nz && kq < 2) == 0ull) return;
    if (key == 0 && kq < 2) *(LAS f32x4*)(PL + 1024 + 4 * kq) = (f32x4){al[0], al[1], al[2], al[3]};
    { const f32x4 a0 = *(const LAS f32x4*)(PL + 1024), a1 = *(const LAS f32x4*)(PL + 1028);
#pragma unroll
      for (int j = 0; j < 4; ++j) { w.o[0][j] *= a0.x; w.o[1][j] *= a0.y; w.o[2][j] *= a0.z; w.o[3][j] *= a0.w; w.o[4][j] *= a1.x; w.o[5][j] *= a1.y; w.o[6][j] *= a1.z; w.o[7][j] *= a1.w; } }
#pragma unroll 1
    for (int vh = 0; vh < 2; ++vh) {
    f32x4 vx[16];
#pragma unroll
    for (int kk = 0; kk < 16; ++kk) vx[kk] = __builtin_bit_cast(f32x4, __builtin_amdgcn_raw_buffer_load_b128(vrs, (int)voff, (vh * 16 + kk) * 4 * stride * 4, 0));
#pragma unroll
    for (int kk = 0; kk < 16; ++kk) { const int k = (vh * 16 + kk) * 4 + ksub;
        const f32x4 v = vx[kk];
        const f32x4 pa = *(const LAS f32x4*)(PL + k * 8), pb = *(const LAS f32x4*)(PL + k * 8 + 4);
#pragma unroll
        for (int j = 0; j < 4; ++j) { w.o[0][j] += pa.x * v[j]; w.o[1][j] += pa.y * v[j]; w.o[2][j] += pa.z * v[j]; w.o[3][j] += pa.w * v[j];
                                      w.o[4][j] += pb.x * v[j]; w.o[5][j] += pb.y * v[j]; w.o[6][j] += pb.z * v[j]; w.o[7][j] += pb.w * v[j]; } }
    }
}
template <int D>
__device__ __forceinline__ void dec_park(DecW<D>& w, LAS float* CBw, int lane) {
    constexpr int LPK = D / 4;
    const int key = lane & 15, kq = lane >> 4, d4 = lane % LPK, ksub = lane / LPK;
#pragma unroll
    for (int i = 0; i < 4; ++i) { float l = w.l[i];
#pragma unroll
        for (int o = 1; o < 16; o <<= 1) l += __shfl_xor(l, o);
        w.l[i] = l; }
    if (key == 0 && kq < 2) { *(LAS f32x4*)(CBw + 4 * kq) = (f32x4){w.m[0], w.m[1], w.m[2], w.m[3]}; *(LAS f32x4*)(CBw + 8 + 4 * kq) = (f32x4){w.l[0], w.l[1], w.l[2], w.l[3]}; }
#pragma unroll
    for (int q = 0; q < 8; ++q) { f32x4 v = (f32x4){w.o[q][0], w.o[q][1], w.o[q][2], w.o[q][3]};
        if (LPK < 64) {
#pragma unroll
            for (int o = LPK; o < 64; o <<= 1) { v.x += __shfl_xor(v.x, o); v.y += __shfl_xor(v.y, o); v.z += __shfl_xor(v.z, o); v.w += __shfl_xor(v.w, o); } }
        if (ksub == 0) *(LAS f32x4*)(CBw + 16 + q * D + 4 * d4) = v; }
}
template <int D>
__device__ __forceinline__ void dec_combine(int tid, LAS float* CB, bf16* dst, int ldd) {
    constexpr int WSTR = 16 + 8 * D;
    for (int e = tid; e < 8 * D; e += NTHR) { const int q = e / D, d = e % D;
        float mt = -INFINITY;
#pragma unroll
        for (int w = 0; w < 8; ++w) mt = fmaxf(mt, CB[w * WSTR + q]);
        float num = 0.f, den = 0.f;
#pragma unroll
        for (int w = 0; w < 8; ++w) { const float mw = CB[w * WSTR + q]; const float f = (mw == -INFINITY) ? 0.f : fexp2(mw - mt); num += f * CB[w * WSTR + 16 + q * D + d]; den += f * CB[w * WSTR + 8 + q]; }
        dst[(size_t)q * ldd + d] = (bf16)f2bf(num / den); }
}
template <int D>
__device__ __forceinline__ void dec_load_q(bf16x8 (&qa)[D / 32], const bf16* Q, int ldq, int lane) {
    const int row = lane & 15, kq = lane >> 4;
#pragma unroll
    for (int ks = 0; ks < D / 32; ++ks) { v4u z = {0u, 0u, 0u, 0u}; if (row < 8) z = *(const v4u*)(Q + (size_t)row * ldq + 32 * ks + 8 * kq); qa[ks] = __builtin_bit_cast(bf16x8, z); }
}
constexpr int DEC_PL = 1040;
__device__ __forceinline__ void fox_sample_unit(const Frame& F, const Args& a, int u) {
    unsigned char* ws = a.ws; const int bs = u >> 3, h = u & 7;
    int ln = lane_id(); asm volatile("" : "+v"(ln));
    LAS float* PL = (LAS float*)F.lds + F.wave * DEC_PL; LAS float* CB = (LAS float*)F.lds + 8 * DEC_PL; constexpr int WSTR = 16 + 8 * 64;
    bf16x8 qa[2]; dec_load_q<64>(qa, (const bf16*)(ws + WS_QF) + (size_t)(TP + bs * LS) * 512 + h * 64, 512, ln);
    DecW<64> w; dec_init(w);
    {
        const int key = ln & 15; const float* lf = a.out + O_LFS + (size_t)(bs * LS) * 8 + h; float cn = 0.f;
#pragma unroll
        for (int j = 0; j < 8; ++j) { const float x = lf[j * 8]; cn += (j <= key) ? x : 0.f; }
        const float* Kb = a.out + O_FKS + (size_t)(bs * LS) * 512 + h * 64; const float* Vb = a.out + O_FVS + (size_t)(bs * LS) * 512 + h * 64;
        dec_chunk<64, 1, 1>(w, qa, Kb, Vb, 512, nullptr, -cn * LOG2E, PL, ln);
        if (F.wave != 0) {
#pragma unroll
            for (int i = 0; i < 4; ++i) w.l[i] = 0.f;
#pragma unroll
            for (int q = 0; q < 8; ++q)
#pragma unroll
                for (int j = 0; j < 4; ++j) w.o[q][j] = 0.f; }
    }
    const int* pt = (const int*)a.in[I_PT];
    float spx; { const float ptv = (ln < 16) ? ((const float*)(ws + WS_MISC + 2 * MiB))[(bs * 8 + h) * NPAGES + ln] : 0.f; float v = ptv;
#pragma unroll
        for (int o = 1; o < 16; o <<= 1) { const float t = __builtin_bit_cast(float, __builtin_amdgcn_ds_bpermute((ln + o) << 2, __builtin_bit_cast(int, v))); if (ln + o < 16) v += t; }
        spx = v - ptv; }
#if defined(OLD_FOXS)
#pragma unroll 1
    for (int pp = 0; pp < 4; ++pp) { const int p = F.wave * 2 + (pp >> 1), hf = pp & 1; const int pg = __builtin_amdgcn_readfirstlane(pt[bs * NPAGES + p]);
        const float* Kb = (const float*)a.in[I_CFK] + (((size_t)pg * PAGE + hf * 64) * 8 + h) * 64; const float* Vb = (const float*)a.in[I_CFV] + (((size_t)pg * PAGE + hf * 64) * 8 + h) * 64;
        dec_chunk<64, 4, 0>(w, qa, Kb, Vb, 512, (const float*)(ws + WS_SUF) + (size_t)(bs * 8 + h) * PASTL + p * PAGE + hf * 64, __builtin_bit_cast(float, __builtin_amdgcn_ds_bpermute(p << 2, __builtin_bit_cast(int, spx))), PL, ln); }
#else
#pragma unroll 1
    for (int pp = 1; pp >= 0; --pp) { const int p = F.wave * 2 + pp; const int pg = __builtin_amdgcn_readfirstlane(pt[bs * NPAGES + p]);
        const float* Kb = (const float*)a.in[I_CFK] + ((size_t)pg * PAGE * 8 + h) * 64; const float* Vb = (const float*)a.in[I_CFV] + ((size_t)pg * PAGE * 8 + h) * 64;
        dec_page_fox(w, qa, Kb, Vb, (const float*)(ws + WS_SUF) + (size_t)(bs * 8 + h) * PASTL + p * PAGE, __builtin_bit_cast(float, __builtin_amdgcn_ds_bpermute(p << 2, __builtin_bit_cast(int, spx))), PL, ln); }
#endif
    dec_park<64>(w, CB + F.wave * WSTR, ln);
    __syncthreads();
    dec_combine<64>(F.wave * 64 + ln, CB, (bf16*)(ws + WS_MERGED) + (size_t)(TP + bs * LS) * DM + h * 64, DM);
    __syncthreads();
}
__device__ __forceinline__ void cross_sample_unit(const Frame& F, const Args& a, int u) {
    unsigned char* ws = a.ws; const int bs = u >> 2, h = u & 3;
    LAS float* PL = (LAS float*)F.lds + F.wave * DEC_PL; LAS float* CB = (LAS float*)F.lds + 8 * DEC_PL; constexpr int WSTR = 16 + 8 * 256;
    bf16x8 qa[8]; dec_load_q<256>(qa, (const bf16*)(ws + WS_QC) + (size_t)(TP + bs * LS) * DM + h * 256, DM, F.lane);
    DecW<256> w; dec_init(w);
    const float* Kb = (const float*)a.in[I_CMK] + ((size_t)(bs * 256 + F.wave * 32) * 4 + h) * 256; const float* Vb = (const float*)a.in[I_CMV] + ((size_t)(bs * 256 + F.wave * 32) * 4 + h) * 256;
#pragma unroll 1
    for (int c = 0; c < 2; ++c) dec_chunk<256, 1, 0>(w, qa, Kb + (size_t)c * 16 * 1024, Vb + (size_t)c * 16 * 1024, 1024, nullptr, 0.f, PL, F.lane);
    dec_park<256>(w, CB + F.wave * WSTR, F.lane);
    __syncthreads();
    dec_combine<256>(F.tid, CB, (bf16*)(ws + WS_OC) + (size_t)(TP + bs * LS) * DM + h * 256, DM);
    __syncthreads();
}


__device__ __forceinline__ void gla_g3_unit(const Frame& F, const Args& a, int u) {
    unsigned char* ws = a.ws;
    const int b = u >> 9, h = (u >> 7) & 3, n = u & 127; const int row0 = b * SEQ + n * 64;
    LAS float* QDT = (LAS float*)F.lds; LAS float* KIT = QDT + 4352; LAS float* LA = KIT + 4352; LAS float* ATT = LA; LAS float* VS = LA + 4352; LAS float* SP = VS + 8192;
#pragma unroll
    for (int i = 0; i < 16; ++i) { const int e = F.tid + NTHR * i; VS[e] = ((const float*)(ws + WS_GV))[(size_t)(row0 + (e >> 7)) * 512 + h * 128 + (e & 127)];
        SP[e] = ((const float*)(ws + WS_GKV))[((size_t)((b * 4 + h) * 128 + n) * 64) * 128 + e]; }
#pragma unroll
    for (int i = 0; i < 8; ++i) { const int e = F.tid + NTHR * i, t = e >> 6, dk = e & 63; const size_t gi = (size_t)(row0 + t) * 256 + h * 64 + dk;
        const float bb = ((const float*)(ws + WS_BB))[gi];
        QDT[dk * 68 + t] = ((const float*)(ws + WS_GQ))[gi] * __expf(bb); KIT[dk * 68 + t] = ((const float*)(ws + WS_GK))[gi] * __expf(-bb); }
    __syncthreads();
    {
        const int tp = F.tid & 31, sq = F.tid >> 5; float acc[2][4];
#pragma unroll
        for (int i = 0; i < 2; ++i)
#pragma unroll
            for (int j = 0; j < 4; ++j) acc[i][j] = 0.f;
        if (4 * sq <= 2 * tp + 1) {
#pragma unroll 8
            for (int dk = 0; dk < 64; ++dk) { const f32x2 q2 = *(const LAS f32x2*)(QDT + dk * 68 + 2 * tp); const f32x4 k4 = *(const LAS f32x4*)(KIT + dk * 68 + 4 * sq);
#pragma unroll
                for (int j = 0; j < 4; ++j) { acc[0][j] += q2.x * k4[j]; acc[1][j] += q2.y * k4[j]; } }
        }
#pragma unroll
        for (int j = 0; j < 4; ++j) { const int s = 4 * sq + j; f32x2 o; o.x = (s <= 2 * tp) ? acc[0][j] : 0.f; o.y = (s <= 2 * tp + 1) ? acc[1][j] : 0.f; *(LAS f32x2*)(ATT + s * 68 + 2 * tp) = o; }
    }
    __syncthreads();
    {
        const int dvq = F.tid & 31, tq = F.tid >> 5; float acc[4][4];
#pragma unroll
        for (int i = 0; i < 4; ++i)
#pragma unroll
            for (int j = 0; j < 4; ++j) acc[i][j] = 0.f;
#pragma unroll 8
        for (int s = 0; s < 64; ++s) { const f32x4 v4 = *(const LAS f32x4*)(VS + s * 128 + 4 * dvq), a4 = *(const LAS f32x4*)(ATT + s * 68 + 4 * tq);
#pragma unroll
            for (int i = 0; i < 4; ++i)
#pragma unroll
                for (int j = 0; j < 4; ++j) acc[i][j] += a4[i] * v4[j]; }
#pragma unroll 8
        for (int dk = 0; dk < 64; ++dk) { const f32x4 v4 = *(const LAS f32x4*)(SP + dk * 128 + 4 * dvq), a4 = *(const LAS f32x4*)(QDT + dk * 68 + 4 * tq);
#pragma unroll
            for (int i = 0; i < 4; ++i)
#pragma unroll
                for (int j = 0; j < 4; ++j) acc[i][j] += a4[i] * v4[j]; }
        __syncthreads();
#pragma unroll
        for (int i = 0; i < 4; ++i) *(LAS f32x4*)(VS + (4 * tq + i) * 128 + 4 * dvq) = (f32x4){acc[i][0], acc[i][1], acc[i][2], acc[i][3]};
    }
    __syncthreads();
#pragma unroll
    for (int rr = 0; rr < 8; ++rr) { const int t = F.wave * 8 + rr; const float v0 = VS[t * 128 + F.lane], v1 = VS[t * 128 + 64 + F.lane];
        const float r = rsqrtf(wave_sum(v0 * v0 + v1 * v1) * (1.f / 128.f) + EPS);
        const float* ggo = (const float*)a.in[I_GGO] + h * 128; const float* gr = (const float*)(ws + WS_GR) + (size_t)(row0 + t) * 512 + h * 128;
        bf16* mo = (bf16*)(ws + WS_MERGED) + (size_t)(row0 + t) * DM + 512 + h * 128;
        mo[F.lane] = (bf16)f2bf(v0 * r * ggo[F.lane] * silu(gr[F.lane])); mo[64 + F.lane] = (bf16)f2bf(v1 * r * ggo[64 + F.lane] * silu(gr[64 + F.lane])); }
    __syncthreads();
}

struct EpiSoftmaxP {
    static constexpr bool PERM = false, AFTER_DRAIN = true;
    const LAS unsigned long long* argp;
    __device__ __forceinline__ void fused(f32x4 (&acc)[2][2][4][2], const Unit&, int wr, int wc, int fr, int fq, PG8_LAS unsigned char* lds, int wid, int lane) const {
        LAS float* PM = (LAS float*)lds; LAS float* PS = PM + 1024;
        const int ub = (int)blockIdx.x; const int ldp = DM;
        bf16* P = (bf16*)((unsigned char*)ld_ptr(argp + N_INPUTS + 1) + WS_PC) + ((size_t)((ub >> 7) & 1) * SEQ + (ub & 31) * 256) * DM + ((ub >> 5) & 3) * 256;
        { int t2 = lane_id(); asm volatile("" : "+v"(t2)); fr = t2 & 15; fq = (t2 >> 4) & 3; }
#pragma unroll
        for (int ai = 0; ai < 2; ++ai)
#pragma unroll
            for (int m = 0; m < 4; ++m) { float mx = -INFINITY;
#pragma unroll
                for (int bj = 0; bj < 2; ++bj)
#pragma unroll
                    for (int n = 0; n < 2; ++n) { const f32x4 x = acc[ai][bj][m][n]; mx = fmaxf(mx, fmaxf(fmaxf(x[0], x[1]), fmaxf(x[2], x[3]))); }
                mx = fmaxf(mx, __shfl_xor(mx, 16)); mx = fmaxf(mx, __shfl_xor(mx, 32));
                if (fq == 0) PM[(ai * 128 + wr * 64 + m * 16 + fr) * 4 + wc] = mx; }
        asm volatile("s_waitcnt lgkmcnt(0)" ::: "memory"); __builtin_amdgcn_s_barrier(); asm volatile("" ::: "memory");
#pragma unroll
        for (int ai = 0; ai < 2; ++ai)
#pragma unroll
            for (int m = 0; m < 4; ++m) { const int r = ai * 128 + wr * 64 + m * 16 + fr; const f32x4 pm = *(const LAS f32x4*)(PM + r * 4);
                const float M = fmaxf(fmaxf(pm[0], pm[1]), fmaxf(pm[2], pm[3])); float s = 0.f;
#pragma unroll
                for (int bj = 0; bj < 2; ++bj)
#pragma unroll
                    for (int n = 0; n < 2; ++n) { f32x4 x = acc[ai][bj][m][n]; x[0] = fexp2(x[0] - M); x[1] = fexp2(x[1] - M); x[2] = fexp2(x[2] - M); x[3] = fexp2(x[3] - M); acc[ai][bj][m][n] = x; s += (x[0] + x[1]) + (x[2] + x[3]); }
                s += __shfl_xor(s, 16); s += __shfl_xor(s, 32);
                if (fq == 0) PS[r * 4 + wc] = s; }
        asm volatile("s_waitcnt lgkmcnt(0)" ::: "memory"); __builtin_amdgcn_s_barrier(); asm volatile("" ::: "memory");
#pragma unroll
        for (int ai = 0; ai < 2; ++ai)
#pragma unroll
            for (int m = 0; m < 4; ++m) { const int r = ai * 128 + wr * 64 + m * 16 + fr; const f32x4 ps = *(const LAS f32x4*)(PS + r * 4); const float inv = 1.f / ((ps[0] + ps[1]) + (ps[2] + ps[3]));
#pragma unroll
                for (int bj = 0; bj < 2; ++bj)
#pragma unroll
                    for (int n = 0; n < 2; ++n) { const f32x4 x = acc[ai][bj][m][n]; v2u o; o.x = pg8::cvt_pk_bf16(x[0] * inv, x[1] * inv); o.y = pg8::cvt_pk_bf16(x[2] * inv, x[3] * inv);
                        *(v2u*)(P + (size_t)r * ldp + bj * 128 + wc * 32 + n * 16 + fq * 4) = o; } }
        asm volatile("s_waitcnt lgkmcnt(0)" ::: "memory"); __builtin_amdgcn_s_barrier(); asm volatile("" ::: "memory");
    }
};

__device__ __forceinline__ void rms_rows_phase(const Frame& F, const float* X, const float* g, bf16* H) {
    const int gw = F.vcu * NWAVES + F.wave, NGW = F.G * NWAVES;
    for (int m = gw; m < TA; m += NGW) rms_row_bf16(X + (size_t)m * DM, g, H + (size_t)m * DM, F.lane);
}

__device__ __forceinline__ unsigned f2sort(float f) { const unsigned u = __builtin_bit_cast(unsigned, f); return u ^ ((u >> 31) ? 0xFFFFFFFFu : 0x80000000u); }
__device__ __forceinline__ float sort2f(unsigned s) { const unsigned u = s ^ ((s >> 31) ? 0x80000000u : 0xFFFFFFFFu); return __builtin_bit_cast(float, u); }
__device__ __forceinline__ float gelu_tanh(float x) { const float y = 0.7978845608028654f * (x + 0.044715f * x * x * x); const float e = __expf(2.f * y); return 0.5f * x * (1.f + (1.f - 2.f / (e + 1.f))); }
__device__ __forceinline__ unsigned gmax16(unsigned v) {
#pragma unroll
    for (int o = 1; o < 16; o <<= 1) { const unsigned t = (unsigned)__shfl_xor((int)v, o); v = v > t ? v : t; }
    return v;
}
typedef __bf16 bf16x2_t __attribute__((ext_vector_type(2)));
__device__ __forceinline__ float dot2bf(unsigned a, unsigned b, float c) {
#if __has_builtin(__builtin_amdgcn_fdot2_f32_bf16)
    return __builtin_amdgcn_fdot2_f32_bf16(__builtin_bit_cast(bf16x2_t, a), __builtin_bit_cast(bf16x2_t, b), c, false);
#else
    return c + bflo(a) * bflo(b) + bfhi(a) * bfhi(b);
#endif
}
__device__ __forceinline__ void peer_token(const Frame& F, const Args& a, int row, LAS unsigned* TOPS, int ci0, int cj0, int ci1, int cj1, int ci2, int cj2, int ci3, int cj3, bool cv3) {
    unsigned char* ws = a.ws; const int lane = F.lane, grp = lane >> 4, j16 = lane & 15;
    const float* sc = (const float*)(ws + WS_SC) + (size_t)row * 2048;
#pragma unroll 1
    for (int bt = 0; bt < 4; ++bt) {
        const f32x4 x0 = *(const f32x4*)(sc + (bt * 4 + grp) * 128 + 8 * j16), x1 = *(const f32x4*)(sc + (bt * 4 + grp) * 128 + 8 * j16 + 4);
        unsigned k[8]; const float xs[8] = {x0.x, x0.y, x0.z, x0.w, x1.x, x1.y, x1.z, x1.w};
#pragma unroll
        for (int e = 0; e < 8; ++e) k[e] = (f2sort(xs[e]) & ~127u) | (unsigned)(127 - (8 * j16 + e));
        unsigned mine = 0u;
#pragma unroll 1
        for (int r = 0; r < 16; ++r) {
            unsigned m = k[0];
#pragma unroll
            for (int e = 1; e < 8; ++e) m = m > k[e] ? m : k[e];
            m = gmax16(m);
            if (j16 == r) mine = m;
#pragma unroll
            for (int e = 0; e < 8; ++e) k[e] = (k[e] == m) ? 0u : k[e];
        }
        TOPS[(bt * 4 + grp) * 16 + j16] = mine;
    }
    int ex[2]; float gx[2], sux[2];
#pragma unroll
    for (int ps = 0; ps < 2; ++ps) {
        const int hd = ps * 4 + grp; const LAS unsigned* T1 = TOPS + (2 * hd) * 16; const LAS unsigned* T2 = T1 + 16;
        unsigned k[4];
        { const float s0 = sort2f(T1[ci0] & ~127u) + sort2f(T2[cj0] & ~127u), s1 = sort2f(T1[ci1] & ~127u) + sort2f(T2[cj1] & ~127u),
                      s2 = sort2f(T1[ci2] & ~127u) + sort2f(T2[cj2] & ~127u), s3 = sort2f(T1[ci3] & ~127u) + sort2f(T2[cj3] & ~127u);
          k[0] = (f2sort(s0) & ~127u) | (unsigned)(127 - j16); k[1] = (f2sort(s1) & ~127u) | (unsigned)(127 - (j16 + 16)); k[2] = (f2sort(s2) & ~127u) | (unsigned)(127 - (j16 + 32));
          k[3] = cv3 ? ((f2sort(s3) & ~127u) | (unsigned)(127 - (j16 + 48))) : 0u; }
        unsigned mine = 0u;
#pragma unroll 1
        for (int r = 0; r < 16; ++r) {
            unsigned m = k[0] > k[1] ? k[0] : k[1]; const unsigned m2 = k[2] > k[3] ? k[2] : k[3]; m = m > m2 ? m : m2;
            m = gmax16(m);
            if (j16 == r) mine = m;
#pragma unroll
            for (int e = 0; e < 4; ++e) k[e] = (k[e] == m) ? 0u : k[e];
        }
        const int c = 127 - (int)(mine & 127u);
        int ci, cj;
        if (c < 16) { ci = 0; cj = c; } else if (c < 24) { ci = 1; cj = c - 16; } else if (c < 29) { ci = 2; cj = c - 24; } else if (c < 33) { ci = 3; cj = c - 29; }
        else if (c < 36) { ci = 4; cj = c - 33; } else if (c < 38) { ci = 5; cj = c - 36; } else if (c < 40) { ci = 6; cj = c - 38; } else if (c < 42) { ci = 7; cj = c - 40; } else { ci = c - 34; cj = 0; }
        const int i1 = 127 - (int)(T1[ci] & 127u), i2 = 127 - (int)(T2[cj] & 127u);
        ex[ps] = i1 * 128 + i2;
        const float sv = sort2f(mine & ~127u); const float s0 = __shfl(sv, lane & 48);
        float ee = __expf(sv - s0); float es = ee;
#pragma unroll
        for (int o = 1; o < 16; o <<= 1) es += __shfl_xor(es, o);
        const float* rsc = (const float*)(ws + WS_MISC);
        sux[ps] = rsc[ex[ps]]; gx[ps] = ee / es * rsc[16384 + ex[ps]];
    }
    {
        unsigned k0 = ((unsigned)ex[0] << 7) | (unsigned)lane, k1 = ((unsigned)ex[1] << 7) | (unsigned)(64 + lane);
#pragma unroll
        for (int k = 2; k <= 128; k <<= 1) {
#pragma unroll
            for (int j = k >> 1; j > 0; j >>= 1) {
                if (j == 64) { const unsigned lo = k0 < k1 ? k0 : k1, hi = k0 < k1 ? k1 : k0; k0 = lo; k1 = hi; }
                else {
                    const unsigned p0 = (unsigned)__shfl_xor((int)k0, j), p1 = (unsigned)__shfl_xor((int)k1, j);
                    const bool low = (lane & j) == 0; const bool asc0 = (lane & k) == 0, asc1 = ((64 + lane) & k) == 0;
                    const unsigned mn0 = k0 < p0 ? k0 : p0, mx0 = k0 < p0 ? p0 : k0, mn1 = k1 < p1 ? k1 : p1, mx1 = k1 < p1 ? p1 : k1;
                    k0 = (low == asc0) ? mn0 : mx0; k1 = (low == asc1) ? mn1 : mx1;
                }
            }
        }
        const int o0 = (int)(k0 & 127u), o1 = (int)(k1 & 127u);
        const float g0a = __shfl(gx[0], o0 & 63), g0b = __shfl(gx[1], o0 & 63), g1a = __shfl(gx[0], o1 & 63), g1b = __shfl(gx[1], o1 & 63);
        const float s0a = __shfl(sux[0], o0 & 63), s0b = __shfl(sux[1], o0 & 63), s1a = __shfl(sux[0], o1 & 63), s1b = __shfl(sux[1], o1 & 63);
        gx[0] = (o0 & 64) ? g0b : g0a; gx[1] = (o1 & 64) ? g1b : g1a; sux[0] = (o0 & 64) ? s0b : s0a; sux[1] = (o1 & 64) ? s1b : s1a;
        ex[0] = (int)(k0 >> 7); ex[1] = (int)(k1 >> 7);
    }
    const float rstd2 = rsqrtf(((const float*)(ws + WS_SS))[TA + row] * (1.f / 1024.f) + EPS);
    float hf[16];
    { const v4u* hp = (const v4u*)((const bf16*)(ws + WS_HB) + (size_t)row * DM + 16 * lane); const v4u h0 = hp[0], h1 = hp[1];
#pragma unroll
      for (int q = 0; q < 4; ++q) { hf[2 * q] = bflo(h0[q]); hf[2 * q + 1] = bfhi(h0[q]); hf[8 + 2 * q] = bflo(h1[q]); hf[8 + 2 * q + 1] = bfhi(h1[q]); } }
    float oacc[16];
#pragma unroll
    for (int i = 0; i < 16; ++i) oacc[i] = 0.f;
    const unsigned char* U = ws + WS_U16; const unsigned char* V = ws + WS_V16;
    v4u ub[8], vb[8];
#pragma unroll
    for (int i = 0; i < 8; ++i) { const int e = __builtin_amdgcn_readlane(ex[0], i); ub[i] = *(const v4u*)(U + (size_t)e * DM + 16 * lane); }
#pragma unroll 1
    for (int g8 = 0; g8 < 16; ++g8) {
        const int kb = g8 * 8; const int exs = (kb < 64) ? ex[0] : ex[1]; const float gxs = (kb < 64) ? gx[0] : gx[1]; const float sus = (kb < 64) ? sux[0] : sux[1];
#pragma unroll
        for (int i = 0; i < 8; ++i) { const int e = __builtin_amdgcn_readlane(exs, (kb & 63) + i); vb[i] = *(const v4u*)(V + (size_t)e * DM + 16 * lane); }
        float av[8];
#pragma unroll
        for (int i = 0; i < 8; ++i) { float s = 0.f;
#pragma unroll
            for (int q = 0; q < 4; ++q) { const f32x2 lo = __builtin_amdgcn_cvt_pk_f32_fp8((int)ub[i][q], false), hi = __builtin_amdgcn_cvt_pk_f32_fp8((int)ub[i][q], true);
                s += lo.x * hf[4 * q]; s += lo.y * hf[4 * q + 1]; s += hi.x * hf[4 * q + 2]; s += hi.y * hf[4 * q + 3]; }
            av[i] = s; }
        const bool b5 = lane & 32, b4 = lane & 16, b3 = lane & 8;
        float bq[4], cq[2], dq;
#pragma unroll
        for (int i = 0; i < 4; ++i) bq[i] = (b5 ? av[4 + i] : av[i]) + __shfl_xor(b5 ? av[i] : av[4 + i], 32);
#pragma unroll
        for (int i = 0; i < 2; ++i) cq[i] = (b4 ? bq[2 + i] : bq[i]) + __shfl_xor(b4 ? bq[i] : bq[2 + i], 16);
        dq = (b3 ? cq[1] : cq[0]) + __shfl_xor(b3 ? cq[0] : cq[1], 8);
        dq += __shfl_xor(dq, 4); dq += __shfl_xor(dq, 2); dq += __shfl_xor(dq, 1);
        const int src = (kb & 63) + (lane >> 3);
#if defined(PROBE_NOPEER)
        const float wmine = 0.f * __shfl(gxs, src) * gelu_tanh(dq * __shfl(sus, src));
#else
        const float wmine = __shfl(gxs, src) * gelu_tanh(dq * __shfl(sus, src) * rstd2);
#endif
        if (g8 < 15) { const int kn = kb + 8; const int exn = (kn < 64) ? ex[0] : ex[1];
#pragma unroll
            for (int i = 0; i < 8; ++i) { const int e = __builtin_amdgcn_readlane(exn, (kn & 63) + i); ub[i] = *(const v4u*)(U + (size_t)e * DM + 16 * lane); } }
#pragma unroll
        for (int i = 0; i < 8; ++i) { const float w = __builtin_bit_cast(float, __builtin_amdgcn_readlane(__builtin_bit_cast(int, wmine), 8 * i));
#pragma unroll
            for (int q = 0; q < 4; ++q) { const f32x2 lo = __builtin_amdgcn_cvt_pk_f32_fp8((int)vb[i][q], false), hi = __builtin_amdgcn_cvt_pk_f32_fp8((int)vb[i][q], true);
                oacc[4 * q] += w * lo.x; oacc[4 * q + 1] += w * lo.y; oacc[4 * q + 2] += w * hi.x; oacc[4 * q + 3] += w * hi.y; } }
    }
    const f32x4* x2 = (const f32x4*)((const float*)(ws + WS_X2) + (size_t)row * DM + 16 * lane);
    f32x4 xv[4]; float ss = 0.f;
#pragma unroll
    for (int q = 0; q < 4; ++q) { xv[q] = x2[q]; xv[q].x += oacc[4 * q]; xv[q].y += oacc[4 * q + 1]; xv[q].z += oacc[4 * q + 2]; xv[q].w += oacc[4 * q + 3]; ss += (xv[q].x * xv[q].x + xv[q].y * xv[q].y) + (xv[q].z * xv[q].z + xv[q].w * xv[q].w); }
    const float r = rsqrtf(wave_sum(ss) * (1.f / DM) + EPS);
    const f32x4* gf = (const f32x4*)((const float*)a.in[I_GFIN] + 16 * lane);
    f32x4* y = (f32x4*)((row < TP ? a.out + O_YP + (size_t)row * DM : a.out + O_YS + (size_t)(row - TP) * DM) + 16 * lane);
#pragma unroll
    for (int q = 0; q < 4; ++q) { const f32x4 g4 = gf[q]; f32x4 o; o.x = xv[q].x * r * g4.x; o.y = xv[q].y * r * g4.y; o.z = xv[q].z * r * g4.z; o.w = xv[q].w * r * g4.w; y[q] = o; }
}
__device__ __forceinline__ void cand_ij(int c, int& ci, int& cj) {
    if (c < 16) { ci = 0; cj = c; } else if (c < 24) { ci = 1; cj = c - 16; } else if (c < 29) { ci = 2; cj = c - 24; } else if (c < 33) { ci = 3; cj = c - 29; }
    else if (c < 36) { ci = 4; cj = c - 33; } else if (c < 38) { ci = 5; cj = c - 36; } else if (c < 40) { ci = 6; cj = c - 38; } else if (c < 42) { ci = 7; cj = c - 40; } else if (c < 50) { ci = c - 34; cj = 0; } else { ci = 0; cj = 0; }
}
__device__ __forceinline__ void peer_phase(const Frame& F, const Args& a) {
    LAS unsigned* TOPS = (LAS unsigned*)F.lds + F.wave * 256;
    const int j16 = F.lane & 15; int ci0, cj0, ci1, cj1, ci2, cj2, ci3, cj3;
    cand_ij(j16, ci0, cj0); cand_ij(j16 + 16, ci1, cj1); cand_ij(j16 + 32, ci2, cj2); cand_ij(j16 + 48, ci3, cj3);
    const bool cv3 = (j16 + 48) < 50;
    const int gw = F.vcu * NWAVES + F.wave, NGW = F.G * NWAVES;
#pragma unroll 1
    for (int row = gw; row < TA; row += NGW) peer_token(F, a, row, TOPS, ci0, cj0, ci1, cj1, ci2, cj2, ci3, cj3, cv3);
}


template <class EpiS>
__device__ __forceinline__ void skinny_tile(const Frame& F, const bf16* A, int lda, const bf16* Bt, int ldb, int tm, int tn, const EpiS& E) {
    const int lane = F.lane, r32 = lane & 31, hi = lane >> 5, w = F.wave;
    const bf16* ap = A + (size_t)(tm * 64 + r32) * lda + w * 128 + 8 * hi;
    const bf16* bp = Bt + (size_t)(tn * 64 + r32) * ldb + w * 128 + 8 * hi;
    v4u af[2][8], bfr[2][8];
#pragma unroll
    for (int ks = 0; ks < 8; ++ks) {
        af[0][ks] = *(const v4u*)(ap + ks * 16); af[1][ks] = *(const v4u*)(ap + (size_t)32 * lda + ks * 16);
        bfr[0][ks] = *(const v4u*)(bp + ks * 16); bfr[1][ks] = *(const v4u*)(bp + (size_t)32 * ldb + ks * 16); }
    f32x16 acc[2][2];
#pragma unroll
    for (int i = 0; i < 2; ++i)
#pragma unroll
        for (int j = 0; j < 2; ++j) acc[i][j] = f32x16{};
#pragma unroll
    for (int ks = 0; ks < 8; ++ks)
#pragma unroll
        for (int i = 0; i < 2; ++i)
#pragma unroll
            for (int j = 0; j < 2; ++j) acc[i][j] = __builtin_amdgcn_mfma_f32_32x32x16_bf16(__builtin_bit_cast(bf16x8, af[i][ks]), __builtin_bit_cast(bf16x8, bfr[j][ks]), acc[i][j], 0, 0, 0);
    LAS float* PS = (LAS float*)F.lds + w * 4096;
#pragma unroll
    for (int i = 0; i < 2; ++i)
#pragma unroll
        for (int j = 0; j < 2; ++j)
#pragma unroll
            for (int r = 0; r < 16; ++r) PS[(32 * i + crow(r, hi)) * 64 + 32 * j + r32] = acc[i][j][r];
    __syncthreads();
    {
        const int row = F.tid >> 3, c8 = (F.tid & 7) * 8; const LAS float* P0 = (const LAS float*)F.lds + row * 64 + c8;
        f32x4 s0 = *(const LAS f32x4*)P0, s1 = *(const LAS f32x4*)(P0 + 4);
#pragma unroll
        for (int ww = 1; ww < 8; ++ww) { s0 += *(const LAS f32x4*)(P0 + ww * 4096); s1 += *(const LAS f32x4*)(P0 + ww * 4096 + 4); }
        float v[8] = {s0.x, s0.y, s0.z, s0.w, s1.x, s1.y, s1.z, s1.w};
        E(tm * 64 + row, tn * 64 + c8, v, F.tid);
    }
    __syncthreads();
}
struct EpiSk {
    float* d32; int ld32; bf16* d16; int ld16; float sc16;
    const float* res; int ldr;
    const float* gcol; float* ssq; const float* rsq;
    __device__ __forceinline__ void operator()(int row, int col, float (&v)[8], int tid) const {
        if (rsq) { const float rs = rsqrtf(rsq[row] * (1.f / 1024.f) + EPS);
#pragma unroll
            for (int i = 0; i < 8; ++i) v[i] *= rs; }
        if (res) { const f32x4 a = *(const f32x4*)(res + (size_t)row * ldr + col), b = *(const f32x4*)(res + (size_t)row * ldr + col + 4);
            v[0] += a.x; v[1] += a.y; v[2] += a.z; v[3] += a.w; v[4] += b.x; v[5] += b.y; v[6] += b.z; v[7] += b.w; }
        if (d32) { *(f32x4*)(d32 + (size_t)row * ld32 + col) = (f32x4){v[0], v[1], v[2], v[3]}; *(f32x4*)(d32 + (size_t)row * ld32 + col + 4) = (f32x4){v[4], v[5], v[6], v[7]}; }
        if (ssq) { float ss = 0.f;
#pragma unroll
            for (int i = 0; i < 8; ++i) ss += v[i] * v[i];
            ss += __shfl_xor(ss, 1); ss += __shfl_xor(ss, 2); ss += __shfl_xor(ss, 4);
            if ((tid & 7) == 0) atomicAdd(ssq + row, ss); }
        if (d16) { float w8[8];
#pragma unroll
            for (int i = 0; i < 8; ++i) w8[i] = v[i];
            if (gcol) { const f32x4 a = *(const f32x4*)(gcol + col), b = *(const f32x4*)(gcol + col + 4); w8[0] *= a.x; w8[1] *= a.y; w8[2] *= a.z; w8[3] *= a.w; w8[4] *= b.x; w8[5] *= b.y; w8[6] *= b.z; w8[7] *= b.w; }
            v4u o; o.x = pg8::cvt_pk_bf16(w8[0] * sc16, w8[1] * sc16); o.y = pg8::cvt_pk_bf16(w8[2] * sc16, w8[3] * sc16); o.z = pg8::cvt_pk_bf16(w8[4] * sc16, w8[5] * sc16); o.w = pg8::cvt_pk_bf16(w8[6] * sc16, w8[7] * sc16);
            *(v4u*)(d16 + (size_t)row * ld16 + col) = o; }
    }
};


#ifndef PH_MAX
#define PH_MAX 99
#endif
__global__ void __launch_bounds__(NTHR, 2) mega_fwd(Args args) {
    extern __shared__ __attribute__((aligned(16))) unsigned char lds_raw[];
    Frame F;
    F.lds = (LAS unsigned char*)lds_raw;
    F.wave = __builtin_amdgcn_readfirstlane((int)threadIdx.x >> 6); F.lane = lane_id(); F.tid = F.wave * 64 + F.lane;
    F.G = gridDim.x; { const int bx = blockIdx.x; F.vcu = (F.G % 8 == 0) ? (bx % 8) * (F.G / 8) + bx / 8 : bx; }
    volatile LAS unsigned* MISC = (volatile LAS unsigned*)(F.lds + MISC_OFF);
    LAS unsigned long long* ARGP = (LAS unsigned long long*)(F.lds + ARGS_OFF);
    for (int u = F.tid; u < (LDS_BYTES - LDSCTL_OFF) / 4; u += NTHR) ((LAS unsigned*)(F.lds + LDSCTL_OFF))[u] = 0u;
    __syncthreads();
    if (F.tid == 0) {
        ARGP[0] = (unsigned long long)args.in[0];
        ARGP[1] = (unsigned long long)args.in[1];
        ARGP[2] = (unsigned long long)args.in[2];
        ARGP[3] = (unsigned long long)args.in[3];
        ARGP[4] = (unsigned long long)args.in[4];
        ARGP[5] = (unsigned long long)args.in[5];
        ARGP[6] = (unsigned long long)args.in[6];
        ARGP[7] = (unsigned long long)args.in[7];
        ARGP[8] = (unsigned long long)args.in[8];
        ARGP[9] = (unsigned long long)args.in[9];
        ARGP[10] = (unsigned long long)args.in[10];
        ARGP[11] = (unsigned long long)args.in[11];
        ARGP[12] = (unsigned long long)args.in[12];
        ARGP[13] = (unsigned long long)args.in[13];
        ARGP[14] = (unsigned long long)args.in[14];
        ARGP[15] = (unsigned long long)args.in[15];
        ARGP[16] = (unsigned long long)args.in[16];
        ARGP[17] = (unsigned long long)args.in[17];
        ARGP[18] = (unsigned long long)args.in[18];
        ARGP[19] = (unsigned long long)args.in[19];
        ARGP[20] = (unsigned long long)args.in[20];
        ARGP[21] = (unsigned long long)args.in[21];
        ARGP[22] = (unsigned long long)args.in[22];
        ARGP[23] = (unsigned long long)args.in[23];
        ARGP[24] = (unsigned long long)args.in[24];
        ARGP[25] = (unsigned long long)args.in[25];
        ARGP[26] = (unsigned long long)args.in[26];
        ARGP[27] = (unsigned long long)args.in[27];
        ARGP[28] = (unsigned long long)args.in[28];
        ARGP[N_INPUTS] = (unsigned long long)args.out; ARGP[N_INPUTS + 1] = (unsigned long long)args.ws;
    }
    __syncthreads();
    { const XcdBarrier bar0 = xcd_barrier_post((unsigned*)((gu32*)(args.ws + WS_CTL) + CW_BAR), MISC + 8, F.wave); if (F.tid == 0) MISC[10] = bar0.x; }
    __syncthreads();
#define GRID_BAR() do { XcdBarrier bar_; bar_.bar = (unsigned*)((gu32*)((unsigned char*)ld_ptr(ARGP + N_INPUTS + 1) + WS_CTL) + CW_BAR); bar_.x = MISC[10]; bar_.st = MISC + 8; bar_.wave = F.wave; xcd_barrier(bar_); } while (0)
#define PHASE_ARGS const Args A = load_args(ARGP); unsigned char* const ws = A.ws; float* const out = A.out; (void)ws; (void)out; { int l_ = lane_id(); asm volatile("" : "+v"(l_)); F.lane = l_; F.tid = F.wave * 64 + l_; }

    { PHASE_ARGS;
    p0_prologue(F, A);
    }
    GRID_BAR();
#if defined(PROBE_BAR8)
    GRID_BAR(); GRID_BAR(); GRID_BAR(); GRID_BAR(); GRID_BAR(); GRID_BAR(); GRID_BAR(); GRID_BAR();
#endif
#if PH_MAX >= 1
    { PHASE_ARGS;
    {
        pg8::Gemm g{(const bf16*)(ws + WS_HB), (const bf16*)(ws + WS_WIN), DM, DM, DM};
        pg8::StaticOrder S; S.init(TA, N_IN, F.G, (int)blockIdx.x);
        EpiInProj E{out, ws, (const float*)A.in[I_BFF]};
        pg8::gemm_phase(F.lds, g, S, E, F.wave);
    }
    {
        const int off = (TA / 256) * (N_IN / 256) % F.G;
        pg8::Gemm g{(const bf16*)(ws + WS_MB), (const bf16*)(ws + WS_WMK), DM, DM, DM};
        pg8::StaticOrder S; S.init(512, DM, F.G, ((int)blockIdx.x + F.G - off) % F.G);
        EpiGen E{out + O_MKP, DM, (bf16*)(ws + WS_MK16), DM, 1.f, nullptr, nullptr, 0, 0, nullptr, nullptr, nullptr};
        pg8::gemm_phase(F.lds, g, S, E, F.wave);
    }
    {
        const int off = ((TA / 256) * (N_IN / 256) + 8) % F.G;
        pg8::Gemm g{(const bf16*)(ws + WS_MB), (const bf16*)(ws + WS_WMV), DM, DM, DM};
        pg8::StaticOrder S; S.init(512, DM, F.G, ((int)blockIdx.x + F.G - off) % F.G);
        EpiGen E{out + O_MVP, DM, nullptr, 0, 1.f, nullptr, nullptr, 0, 0, nullptr, nullptr, nullptr};
        pg8::gemm_phase(F.lds, g, S, E, F.wave);
    }
    {
        const int off = ((TA / 256) * (N_IN / 256) + 16) % F.G;
        pg8::Gemm g{(const bf16*)(ws + WS_WMV), (const bf16*)(ws + WS_MB), DM, DM, DM};
        pg8::StaticOrder S; S.init(DM, 512, F.G, ((int)blockIdx.x + F.G - off) % F.G);
        EpiGen E{nullptr, 0, (bf16*)(ws + WS_MVT16), 512, 1.f, nullptr, nullptr, 0, 0, nullptr, nullptr, nullptr};
        pg8::gemm_phase(F.lds, g, S, E, F.wave);
    }
    }
    GRID_BAR();
#endif
#if PH_MAX >= 2
    asm volatile("; ===PHASE 2===");
    { PHASE_ARGS;
    {
        const int gw = F.vcu * NWAVES + F.wave, NGW = F.G * NWAVES;
        for (int it = gw; it < 512; it += NGW) fox_norms_item(F, (const bf16*)(ws + WS_QF), (const bf16*)(ws + WS_KF), out + O_LFP, (float*)(ws + WS_MISC + MiB), (float*)(ws + WS_KBIAS), (float*)(ws + WS_MISC + MiB + 65536), it);
        for (int it = gw; it < NB_S * NPAGES; it += NGW) fox_suffix_item(F, (const float*)A.in[I_CFL], (const int*)A.in[I_PT], (float*)(ws + WS_SUF), (float*)(ws + WS_MISC + 2 * MiB), it);
        for (int u = F.vcu; u < 1024; u += F.G) gla_g1_unit(F, A, u);
        for (int u = F.vcu; u < 512; u += F.G) gla_sample_unit(F, A, u);
    }
    }
    GRID_BAR();
#endif
#if PH_MAX >= 3
    asm volatile("; ===PHASE 3===");
    { PHASE_ARGS;
    gla_scan(F, A);
    __syncthreads();
    for (int i = F.vcu; i < 256; i += F.G) { const int bh = i >> 4, s = i & 15;
        fox_attn_unit(F, (const bf16*)(ws + WS_QF), (const bf16*)(ws + WS_KF), (const bf16*)(ws + WS_VF), (const float*)(ws + WS_KBIAS), (const float*)(ws + WS_MISC + MiB + 65536), (const float*)(ws + WS_MISC + MiB), (bf16*)(ws + WS_MERGED), bh >> 3, bh & 7, s);
        fox_attn_unit(F, (const bf16*)(ws + WS_QF), (const bf16*)(ws + WS_KF), (const bf16*)(ws + WS_VF), (const float*)(ws + WS_KBIAS), (const float*)(ws + WS_MISC + MiB + 65536), (const float*)(ws + WS_MISC + MiB), (bf16*)(ws + WS_MERGED), bh >> 3, bh & 7, 31 - s); }
    for (int u = F.vcu; u < 1024; u += F.G) fox_sample_unit(F, A, u);
    }
    GRID_BAR();
#endif
#if PH_MAX >= 4
    asm volatile("; ===PHASE 4===");
    { PHASE_ARGS;
    for (int u = F.vcu; u < 1024; u += F.G) gla_g3_unit(F, A, u);
    }
    GRID_BAR();
#endif
#if PH_MAX >= 5
    asm volatile("; ===PHASE 5===");
    { PHASE_ARGS;
    {
        pg8::Gemm g{(const bf16*)(ws + WS_MERGED), (const bf16*)(ws + WS_WOUT), DM, DM, DM};
        pg8::StaticOrder S; S.init(TP, DM, F.G, (int)blockIdx.x);
        EpiGen E{(float*)(ws + WS_X1), DM, (bf16*)(ws + WS_HB), DM, 1.f, (const float*)A.in[I_XP], (const float*)A.in[I_XS], TP, DM, (const float*)A.in[I_GCROSS], (float*)(ws + WS_SS), nullptr};
        pg8::gemm_phase(F.lds, g, S, E, F.wave);
        __syncthreads();
        EpiSk Es{(float*)(ws + WS_X1) + (size_t)TP * DM, DM, (bf16*)(ws + WS_HB) + (size_t)TP * DM, DM, 1.f, (const float*)A.in[I_XS], DM, (const float*)A.in[I_GCROSS], (float*)(ws + WS_SS) + TP, nullptr};
        for (int t = F.vcu; t < 256; t += F.G) skinny_tile(F, (const bf16*)(ws + WS_MERGED) + (size_t)TP * DM, DM, (const bf16*)(ws + WS_WOUT), DM, t >> 4, t & 15, Es);
    }
    }
    GRID_BAR();
#endif
#if PH_MAX >= 7
    asm volatile("; ===PHASE 7===");
    { PHASE_ARGS;
    {
        pg8::Gemm g{(const bf16*)(ws + WS_HB), (const bf16*)(ws + WS_WCQ), DM, DM, DM};
        pg8::StaticOrder S; S.init(TP, DM, F.G, (int)blockIdx.x);
        EpiGen E{nullptr, 0, (bf16*)(ws + WS_QC), DM, C2C, nullptr, nullptr, 0, 0, nullptr, nullptr, (const float*)(ws + WS_SS)};
        pg8::gemm_phase(F.lds, g, S, E, F.wave);
        __syncthreads();
        EpiSk Es{nullptr, 0, (bf16*)(ws + WS_QC) + (size_t)TP * DM, DM, C2C, nullptr, 0, nullptr, nullptr, (const float*)(ws + WS_SS) + TP};
        for (int t = F.vcu; t < 256; t += F.G) skinny_tile(F, (const bf16*)(ws + WS_HB) + (size_t)TP * DM, DM, (const bf16*)(ws + WS_WCQ), DM, t >> 4, t & 15, Es);
    }
    }
    GRID_BAR();
#endif
#if PH_MAX >= 8
    asm volatile("; ===PHASE 8===");
    { PHASE_ARGS;
    {
        const int u = (int)blockIdx.x, b = (u >> 7) & 1, h = (u >> 5) & 3, pnl = u & 31;
        const size_t roff = ((size_t)b * SEQ + pnl * 256) * DM + h * 256;
        pg8::Gemm g{(const bf16*)(ws + WS_QC) + roff, (const bf16*)(ws + WS_MK16) + (size_t)(b * 256) * DM + h * 256, DM, DM, 256};
        pg8::SingleUnit S{u < 256 ? 1 : 0, {0, 0}};
        EpiSoftmaxP E{ARGP};
        pg8::gemm_phase(F.lds, g, S, E, F.wave);
        VM_WAIT(); __syncthreads();
        {
            pg8::Gemm g2{(const bf16*)(ws + WS_PC) + roff, (const bf16*)(ws + WS_MVT16) + (size_t)(h * 256) * 512 + b * 256, DM, 512, 256};
            EpiGen E2{nullptr, 0, (bf16*)(ws + WS_OC) + roff, DM, 1.f, nullptr, nullptr, 0, 0, nullptr, nullptr, nullptr};
            pg8::gemm_phase(F.lds, g2, S, E2, F.wave);
        }
        __syncthreads();
        for (int v = F.vcu; v < 512; v += F.G) cross_sample_unit(F, A, v);
    }
    }
    GRID_BAR();
#endif
#if PH_MAX >= 10
    asm volatile("; ===PHASE 10===");
    { PHASE_ARGS;
    {
        pg8::Gemm g{(const bf16*)(ws + WS_OC), (const bf16*)(ws + WS_WCO), DM, DM, DM};
        pg8::StaticOrder S; S.init(TP, DM, F.G, (int)blockIdx.x);
        EpiGen E{(float*)(ws + WS_X2), DM, (bf16*)(ws + WS_HB), DM, 1.f, (const float*)(ws + WS_X1), (const float*)(ws + WS_X1), TA, DM, (const float*)A.in[I_GFFN], (float*)(ws + WS_SS) + TA, nullptr};
        pg8::gemm_phase(F.lds, g, S, E, F.wave);
        __syncthreads();
        EpiSk Es{(float*)(ws + WS_X2) + (size_t)TP * DM, DM, (bf16*)(ws + WS_HB) + (size_t)TP * DM, DM, 1.f, (const float*)(ws + WS_X1) + (size_t)TP * DM, DM, (const float*)A.in[I_GFFN], (float*)(ws + WS_SS) + TA + TP, nullptr};
        for (int t = F.vcu; t < 256; t += F.G) skinny_tile(F, (const bf16*)(ws + WS_OC) + (size_t)TP * DM, DM, (const bf16*)(ws + WS_WCO), DM, t >> 4, t & 15, Es);
    }
    }
    GRID_BAR();
#endif
#if PH_MAX >= 12
    asm volatile("; ===PHASE 12===");
    { PHASE_ARGS;
    {
        pg8::Gemm g{(const bf16*)(ws + WS_HB), (const bf16*)(ws + WS_WPK), DM, DM, DM};
        pg8::StaticOrder S; S.init(TP, 2048, F.G, (int)blockIdx.x);
        EpiGen E{(float*)(ws + WS_SC), 2048, nullptr, 0, 1.f, nullptr, nullptr, 0, 0, nullptr, nullptr, (const float*)(ws + WS_SS) + TA};
        pg8::gemm_phase(F.lds, g, S, E, F.wave);
        __syncthreads();
        EpiSk Es{(float*)(ws + WS_SC) + (size_t)TP * 2048, 2048, nullptr, 0, 1.f, nullptr, 0, nullptr, nullptr, (const float*)(ws + WS_SS) + TA + TP};
        for (int t = F.vcu; t < 512; t += F.G) skinny_tile(F, (const bf16*)(ws + WS_HB) + (size_t)TP * DM, DM, (const bf16*)(ws + WS_WPK), DM, t >> 5, t & 31, Es);
    }
    }
    GRID_BAR();
#endif
#if PH_MAX >= 13
    asm volatile("; ===PHASE 13===");
    { PHASE_ARGS;
    peer_phase(F, A);
    }
#endif
#if PH_MAX < 13
    {   PHASE_ARGS;
        const int gw = F.vcu * NWAVES + F.wave, NGW = F.G * NWAVES;
        for (int m = gw; m < TA; m += NGW) {
            const float* x = m < TP ? (const float*)A.in[I_XP] + (size_t)m * DM : (const float*)A.in[I_XS] + (size_t)(m - TP) * DM;
            float* y = m < TP ? out + O_YP + (size_t)m * DM : out + O_YS + (size_t)(m - TP) * DM;
            for (int j = 0; j < 4; ++j) ((f32x4*)y)[F.lane + 64 * j] = ((const f32x4*)x)[F.lane + 64 * j];
        }
    }
#endif

}

extern "C" void kernel_launch(void* const* d_in, const int* in_sizes, int n_in, void* d_out, int out_size, void* d_ws, size_t ws_size, hipStream_t stream) {
    static int grid = 0;
    if (grid == 0) {
        if (n_in != N_INPUTS || (size_t)out_size != O_TOTAL || ws_size < WS_END) { fprintf(stderr, "kernel_launch: unexpected shapes (n_in %d out %d ws %zu)\n", n_in, out_size, ws_size); grid = -1; return; }
        int dev = 0, cus = 0, per_cu = 0;
        if (hipGetDevice(&dev) != hipSuccess || hipDeviceGetAttribute(&cus, hipDeviceAttributeMultiprocessorCount, dev) != hipSuccess) { grid = -1; return; }
        if (hipFuncSetAttribute((const void*)mega_fwd, hipFuncAttributeMaxDynamicSharedMemorySize, LDS_BYTES) != hipSuccess) { fprintf(stderr, "kernel_launch: hipFuncSetAttribute failed\n"); grid = -1; return; }
        if (hipOccupancyMaxActiveBlocksPerMultiprocessor(&per_cu, (const void*)mega_fwd, NTHR, LDS_BYTES) != hipSuccess || per_cu < 1)
            fprintf(stderr, "kernel_launch: occupancy query reports %d workgroups per CU\n", per_cu);
        (void)hipGetLastError();
        grid = cus;
        if (grid > 256) grid = 256;
    }
    if (grid < 0) return;
    if (hipMemsetAsync((char*)d_ws + WS_CTL, 0, CTL_ZERO_BYTES, stream) != hipSuccess) return;
    Args a{};
    for (int i = 0; i < N_INPUTS; ++i) a.in[i] = d_in[i];
    a.out = (float*)d_out; a.ws = (unsigned char*)d_ws;
    hipLaunchKernelGGL(mega_fwd, dim3(grid), dim3(NTHR), LDS_BYTES, stream, a);
    const hipError_t le = hipPeekAtLastError();
    if (le != hipSuccess) fprintf(stderr, "kernel_launch: launch failed: %s\n", hipGetErrorName(le));
}
```

```cpp
#define PH_MAX 13
#include <hip/hip_runtime.h>
#include <cstdio>
#include <cstdint>

namespace pg8 {
#define PG8_LAS __attribute__((address_space(3)))
typedef unsigned short bf16_t;
typedef short bf16x8 __attribute__((ext_vector_type(8)));
typedef float f32x4 __attribute__((ext_vector_type(4)));
typedef unsigned u32x4 __attribute__((ext_vector_type(4)));
typedef unsigned u32x2 __attribute__((ext_vector_type(2)));
constexpr int BM = 256, BK = 64, HALF = 128, HTB = HALF * BK * 2  , STAGE_BYTES = 8 * HTB, NXCD = 8, WGM = 8;

__host__ __device__ __forceinline__ int lds_byte(int r, int c) { const int st = (r >> 4) * 2 + (c >> 5), rr = r & 15, cc = c & 31, ob = rr * 64 + cc * 2; return st * 1024 + (ob ^ (((ob >> 9) & 1) << 5)); }
__host__ __device__ __forceinline__ void stage_rc(int b, int& R, int& C) { const int st = b / 1024, sb = b % 1024, swz = sb ^ (((sb >> 9) & 1) << 5); R = (st >> 1) * 16 + swz / 64; C = (st & 1) * 32 + (swz % 64) / 2; }

struct Unit { int pm, pn; };
struct Gemm { const bf16_t* A; const bf16_t* Bt; int lda, ldb, K; };

struct StaticOrder {
    int nM, nN, nwg, G, c;
    __host__ __device__ void init(int M, int N, int G_, int c_) { nM = M / BM; nN = N / BM; nwg = nM * nN; G = G_; c = c_; }
    __host__ __device__ bool next(int i, Unit& u) const {
        const long L = (long)i * G + c; if (L >= nwg) return false;
        int wgid = (int)L; { const int q = nwg / NXCD, r = nwg % NXCD, xcd = wgid % NXCD, off = wgid / NXCD; wgid = (xcd < r ? xcd * (q + 1) : r * (q + 1) + (xcd - r) * q) + off; }
        const int nig = WGM * nN, gid = wgid / nig, fm = gid * WGM, gsz = (nM - fm) < WGM ? (nM - fm) : WGM;
        u.pm = fm + ((wgid % nig) % gsz); u.pn = (wgid % nig) / gsz; return true;
    }
};
struct SingleUnit {
    int has; Unit u0;
    __host__ __device__ bool next(int i, Unit& u) const { if (i != 0 || !has) return false; u = u0; return true; }
};

__device__ __forceinline__ unsigned cvt_pk_bf16(float lo, float hi) { unsigned r; asm volatile("v_cvt_pk_bf16_f32 %0, %1, %2" : "=v"(r) : "v"(lo), "v"(hi)); return r; }

template <class Epi, class Sched>
__device__ __forceinline__ void gemm_phase(PG8_LAS unsigned char* lds, const Gemm g, const Sched& S, const Epi& E, int wave_id) {
    int lane; asm volatile("v_mbcnt_lo_u32_b32 %0, -1, 0\n\tv_mbcnt_hi_u32_b32 %0, -1, %0" : "=v"(lane));
    const int wid = wave_id; const int tid = wid * 64 + lane; const int wr = wid >> 2, wc = wid & 3, fr = lane & 15, fq = lane >> 4;
    const int K = g.K, nt = K / BK;
    unsigned voffA[2], voffB[2];
#pragma unroll
    for (int i = 0; i < 2; ++i) { int R, C; stage_rc(tid * 16 + i * 8192, R, C);
        voffA[i] = (unsigned)(R * g.lda + C) * 2u; voffB[i] = (unsigned)(R * g.ldb + C) * 2u; }
    const size_t kstep = (size_t)(BK * 2);
    const size_t hstepA = (size_t)HALF * g.lda * 2, hstepB = (size_t)HALF * g.ldb * 2;
    const size_t tstepA = 2 * hstepA, tstepB = 2 * hstepB;
    const unsigned ldsw = (unsigned)wid * 1024u;
    const int aoff = lds_byte(wr * 64 + fr, fq * 8), boff = lds_byte(wc * 32 + fr, fq * 8);
#define PG8_SA(b, h) (((b) * 2 + (h)) * HTB)
#define PG8_SB(b, h) ((4 + (b) * 2 + (h)) * HTB)
#define PG8_STAGE(bufoff, gbase, voff) do { _Pragma("unroll") for (int _i = 0; _i < 2; ++_i) \
        __builtin_amdgcn_global_load_lds((const unsigned*)((const char*)(gbase) + (voff)[_i]), (PG8_LAS unsigned*)(lds + (bufoff) + ldsw + _i * 8192), 16, 0, 0); } while (0)
#define PG8_LDA(dst, b, h) do { _Pragma("unroll") for (int m = 0; m < 4; ++m) _Pragma("unroll") for (int k = 0; k < 2; ++k) dst[m][k] = *(const PG8_LAS bf16x8*)(lds + PG8_SA(b, h) + aoff + m * 2048 + k * 1024); } while (0)
#define PG8_LDB(dst, b, h) do { _Pragma("unroll") for (int n = 0; n < 2; ++n) _Pragma("unroll") for (int k = 0; k < 2; ++k) dst[n][k] = *(const PG8_LAS bf16x8*)(lds + PG8_SB(b, h) + boff + n * 2048 + k * 1024); } while (0)
#define PG8_MMA(ai, bj, At, Bt) do { __builtin_amdgcn_s_setprio(1); _Pragma("unroll") for (int m = 0; m < 4; ++m) _Pragma("unroll") for (int n = 0; n < 2; ++n) _Pragma("unroll") for (int k = 0; k < 2; ++k) \
        acc[ai][bj][m][n] = __builtin_amdgcn_mfma_f32_16x16x32_bf16(Bt[n][k], At[m][k], acc[ai][bj][m][n], 0, 0, 0); __builtin_amdgcn_s_setprio(0); } while (0)
#define PG8_WAIT_V(n) asm volatile("s_waitcnt vmcnt(" #n ")" ::: "memory")
#define PG8_WAIT_L(n) asm volatile("s_waitcnt lgkmcnt(" #n ")" ::: "memory")
#define PG8_BAR __builtin_amdgcn_s_barrier()
#define PG8_SCHED __builtin_amdgcn_sched_barrier(0)
    Unit cur, nxt; int ui = 0;
    if (!S.next(0, cur)) return;
    f32x4 acc[2][2][4][2];
#pragma unroll
    for (int a = 0; a < 2; ++a)
#pragma unroll
        for (int b = 0; b < 2; ++b)
#pragma unroll
            for (int m = 0; m < 4; ++m)
#pragma unroll
                for (int n = 0; n < 2; ++n) acc[a][b][m][n] = (f32x4){0.f, 0.f, 0.f, 0.f};
    bf16x8 At[4][2], B0[2][2], B1[2][2];
    const char* cA = (const char*)g.A + (size_t)cur.pm * tstepA; const char* cB = (const char*)g.Bt + (size_t)cur.pn * tstepB;
    PG8_STAGE(PG8_SB(0, 0), cB, voffB); PG8_STAGE(PG8_SB(0, 1), cB + hstepB, voffB); PG8_STAGE(PG8_SA(0, 0), cA, voffA); PG8_STAGE(PG8_SA(0, 1), cA + hstepA, voffA);
    if (wr == 1) PG8_BAR;
    PG8_WAIT_V(2); PG8_BAR;
    PG8_STAGE(PG8_SB(1, 0), cB + kstep, voffB); PG8_STAGE(PG8_SA(1, 0), cA + kstep, voffA); PG8_STAGE(PG8_SB(1, 1), cB + hstepB + kstep, voffB);
    PG8_WAIT_V(6); PG8_BAR;
    for (;;) {
        const bool has_next = S.next(ui + 1, nxt);
        const char* nA = has_next ? (const char*)g.A + (size_t)nxt.pm * tstepA : cA; const char* nB = has_next ? (const char*)g.Bt + (size_t)nxt.pn * tstepB : cB;
        for (int t = 0; t < nt; t += 2) {
            const bool last = (t == nt - 2);
            const char* a1 = cA + (size_t)(t + 1) * kstep;
            const char* a2 = last ? nA : cA + (size_t)(t + 2) * kstep; const char* b2 = last ? nB : cB + (size_t)(t + 2) * kstep;
            const char* a3 = a2 + kstep; const char* b3 = b2 + kstep;
            PG8_LDB(B0, 0, 0); PG8_LDB(B1, 0, 1); PG8_SCHED; PG8_LDA(At, 0, 0); PG8_STAGE(PG8_SA(1, 1), a1 + hstepA, voffA);
            PG8_WAIT_V(8); PG8_WAIT_L(0); PG8_BAR; PG8_MMA(0, 0, At, B0); PG8_MMA(0, 1, At, B1); PG8_BAR; PG8_SCHED;
            PG8_LDA(At, 0, 1); PG8_STAGE(PG8_SB(0, 0), b2, voffB); PG8_STAGE(PG8_SB(0, 1), b2 + hstepB, voffB); PG8_STAGE(PG8_SA(0, 0), a2, voffA);
            PG8_WAIT_V(8); PG8_WAIT_L(0); PG8_BAR; PG8_MMA(1, 0, At, B0); PG8_MMA(1, 1, At, B1); PG8_BAR; PG8_SCHED;
            PG8_LDB(B0, 1, 0); PG8_LDB(B1, 1, 1); PG8_SCHED; PG8_LDA(At, 1, 0); PG8_STAGE(PG8_SA(0, 1), a2 + hstepA, voffA);
            PG8_WAIT_V(8); PG8_WAIT_L(0); PG8_BAR; PG8_MMA(0, 0, At, B0); PG8_MMA(0, 1, At, B1); PG8_BAR; PG8_SCHED;
            PG8_LDA(At, 1, 1); PG8_STAGE(PG8_SB(1, 0), b3, voffB); PG8_STAGE(PG8_SB(1, 1), b3 + hstepB, voffB); PG8_STAGE(PG8_SA(1, 0), a3, voffA);
            PG8_WAIT_V(8); PG8_WAIT_L(0); PG8_BAR; PG8_MMA(1, 0, At, B0); PG8_MMA(1, 1, At, B1); PG8_BAR; PG8_SCHED;
        }
        if (wr == 0) PG8_BAR;
        if constexpr (!Epi::AFTER_DRAIN) { E(acc, cur, wr, wc, fr, fq); }
        if (!has_next) break;
#pragma unroll
        for (int a = 0; a < 2; ++a)
#pragma unroll
            for (int b = 0; b < 2; ++b)
#pragma unroll
                for (int m = 0; m < 4; ++m)
#pragma unroll
                    for (int n = 0; n < 2; ++n) acc[a][b][m][n] = (f32x4){0.f, 0.f, 0.f, 0.f};
        cur = nxt; cA = nA; cB = nB; ++ui;
        if (wr == 1) PG8_BAR;
    }
    PG8_WAIT_V(0);
    PG8_BAR;
    if constexpr (Epi::AFTER_DRAIN) { E.fused(acc, cur, wr, wc, fr, fq, lds, wid, lane); }
#undef PG8_SA
#undef PG8_SB
#undef PG8_STAGE
#undef PG8_LDA
#undef PG8_LDB
#undef PG8_MMA
#undef PG8_WAIT_V
#undef PG8_WAIT_L
#undef PG8_BAR
#undef PG8_SCHED
}
}

#define GAS __attribute__((address_space(1)))
#define LAS __attribute__((address_space(3)))
typedef unsigned short bf16;
typedef unsigned v4u __attribute__((ext_vector_type(4)));
typedef unsigned v2u __attribute__((ext_vector_type(2)));
typedef float f32x4 __attribute__((ext_vector_type(4)));
typedef float f32x2 __attribute__((ext_vector_type(2)));
typedef float f32x16 __attribute__((ext_vector_type(16)));
typedef short bf16x8 __attribute__((ext_vector_type(8)));
typedef short s16x4 __attribute__((ext_vector_type(4)));
typedef GAS unsigned gu32;
#define RLX_AGENT __ATOMIC_RELAXED, __HIP_MEMORY_SCOPE_AGENT
#define LDS_WAIT() asm volatile("s_waitcnt lgkmcnt(0)" ::: "memory")
#define VM_WAIT() asm volatile("s_waitcnt vmcnt(0)" ::: "memory")
__device__ __forceinline__ unsigned f2bf(float f) { unsigned u = __builtin_bit_cast(unsigned, f); return (u + 0x7fffu + ((u >> 16) & 1u)) >> 16; }
__device__ __forceinline__ unsigned pk2(float lo, float hi) { return f2bf(lo) | (f2bf(hi) << 16); }
__device__ __forceinline__ float bf2f(unsigned short b) { return __builtin_bit_cast(float, (unsigned)b << 16); }
__device__ __forceinline__ float bflo(unsigned u) { return __builtin_bit_cast(float, u << 16); }
__device__ __forceinline__ float bfhi(unsigned u) { return __builtin_bit_cast(float, u & 0xffff0000u); }


__device__ __forceinline__ int lane_id() { int r; asm volatile("v_mbcnt_lo_u32_b32 %0, -1, 0\n\tv_mbcnt_hi_u32_b32 %0, -1, %0" : "=v"(r)); return r; }
#define TID_IS_ZERO(wave_) ((wave_) == 0 && lane_id() == 0)
#define XB_TMO      128
#define XB_XCNT(j)  (256  + 64 * (j))
#define XB_XSUB(j)  (1280 + 64 * (j))
#define XB_XGEN(j)  (2304 + 64 * (j))
#define XB_TOP      3328
#define XB_TOPGEN   3392
#define XCD_BAR_WORDS 3456
#define XB_SPIN_CAP (1u << 18)

__device__ __forceinline__ unsigned xb_ld(unsigned* p)              { return __hip_atomic_load(p, __ATOMIC_RELAXED, __HIP_MEMORY_SCOPE_AGENT); }
__device__ __forceinline__ unsigned xb_add(unsigned* p, unsigned v) { return __hip_atomic_fetch_add(p, v, __ATOMIC_RELAXED, __HIP_MEMORY_SCOPE_AGENT); }
__device__ __forceinline__ unsigned xb_xcc_id() { return (unsigned)__builtin_amdgcn_s_getreg((3 << 11) | 20) & 0xFu; }
#define XB_SPIN(cond, bar) do { unsigned _sp = 0; while (cond) { __builtin_amdgcn_s_sleep(1); \
    if ((++_sp & 255u) == 0u) { if (xb_ld(&(bar)[XB_TMO])) break; if (_sp > XB_SPIN_CAP) { atomicAdd(&(bar)[XB_TMO], 1u); break; } } } } while (0)

struct XcdBarrier {
    unsigned* bar; unsigned x; int wave;
    volatile LAS unsigned* st;
};

__device__ __forceinline__ XcdBarrier xcd_barrier_post(unsigned* bar, volatile LAS unsigned* st, int wave) {
    XcdBarrier b; b.bar = bar; b.x = xb_xcc_id(); b.st = st; b.wave = wave;
    if (TID_IS_ZERO(wave)) (void)xb_add(&bar[XB_XCNT(b.x)], 1u);
    return b;
}
__device__ __forceinline__ void xcd_barrier_complete(unsigned* bar, unsigned x, unsigned& nloc, unsigned& nx) {
    const unsigned G = gridDim.x * gridDim.y * gridDim.z;
    unsigned sum, cnt, mine, sp = 0u;
    for (;;) {
        sum = 0u; cnt = 0u; mine = 0u;
#pragma unroll
        for (unsigned j = 0; j < 16; ++j) { const unsigned c = xb_ld(&bar[XB_XCNT(j)]); sum += c; cnt += (c > 0u) ? 1u : 0u; mine = (j == x) ? c : mine; }
        if (sum == G) break;
        __builtin_amdgcn_s_sleep(1);
        if ((++sp & 255u) == 0u) { if (xb_ld(&bar[XB_TMO])) break; if (sp > XB_SPIN_CAP) { atomicAdd(&bar[XB_TMO], 1u); break; } }
    }
    nloc = mine > 0u ? mine : 1u; nx = cnt > 0u ? cnt : 1u;
}

__device__ __forceinline__ void xcd_barrier(const XcdBarrier& b) {
    asm volatile("s_waitcnt vmcnt(0)" ::: "memory");
    __syncthreads();
    if (TID_IS_ZERO(b.wave)) {
        unsigned* bar = b.bar;
        __builtin_amdgcn_s_waitcnt(0);
        unsigned nloc = b.st[0], nx = b.st[1];
        if (nloc == 0u) { xcd_barrier_complete(bar, b.x, nloc, nx); b.st[0] = nloc; b.st[1] = nx; }
        const unsigned old = xb_add(&bar[XB_XSUB(b.x)], 1u);
        const unsigned gen = old / nloc;
        if (old + 1u == (gen + 1u) * nloc) {
            __builtin_amdgcn_fence(__ATOMIC_RELEASE, "agent");
            asm volatile("s_waitcnt vmcnt(0)" ::: "memory");
            const unsigned og = xb_add(&bar[XB_TOP], 1u);
            const unsigned tg = og / nx;
            if (og + 1u == (tg + 1u) * nx) xb_add(&bar[XB_TOPGEN], 1u);
            else XB_SPIN(xb_ld(&bar[XB_TOPGEN]) == tg, bar);
            __builtin_amdgcn_fence(__ATOMIC_ACQUIRE, "agent");
            xb_add(&bar[XB_XGEN(b.x)], 1u);
            asm volatile("s_waitcnt vmcnt(0)" ::: "memory");
        } else {
            XB_SPIN(xb_ld(&bar[XB_XGEN(b.x)]) == gen, bar);
            __builtin_amdgcn_fence(__ATOMIC_ACQUIRE, "agent");
            asm volatile("s_waitcnt vmcnt(0)" ::: "memory");
        }
    }
    __syncthreads();
}


constexpr int NWAVES = 8, NTHR = 512;
constexpr int DM = 1024, TP = 16384, TS = 1024, TA = TP + TS, SEQ = 8192, NB_P = 2, NB_S = 128, LS = 8;
constexpr int N_IN = 3328;
constexpr int PASTL = 2048, PAGE = 128, NPAGES = 16;
constexpr float EPS = 1e-6f;
constexpr float LOG2E = 1.4426950408889634f;
constexpr float C2F = 0.125f * LOG2E;
constexpr float C2C = 0.0625f * LOG2E;

enum { I_XP = 0, I_XS, I_CFK, I_CFV, I_CFL, I_SGLA, I_CMK, I_CMV, I_PT, I_MEMP, I_GMIX, I_WIN, I_BFF, I_WG2, I_BG, I_GGO, I_WOUT, I_GCROSS, I_GMEM,
       I_WMK, I_WMV, I_WCQ, I_WCO, I_GFFN, I_PWQ, I_PSK, I_PU, I_PV, I_GFIN, N_INPUTS };
constexpr size_t O_YP = 0, O_YS = 16777216, O_FKP = 17825792, O_FVP = 26214400, O_LFP = 34603008, O_GSP = 34734080, O_MKP = 34799616, O_MVP = 35323904,
                 O_FKS = 35848192, O_FVS = 36372480, O_LFS = 36896768, O_GSS = 36904960, O_TOTAL = 41099264;

constexpr size_t MiB = 1u << 20;
constexpr size_t WS_CTL = 0, CTL_ZERO_BYTES = 1 * MiB;
constexpr size_t WS_WIN = 2 * MiB, WS_WOUT = 10 * MiB, WS_WMK = 12 * MiB, WS_WMV = 14 * MiB, WS_WCQ = 16 * MiB, WS_WCO = 18 * MiB, WS_WPK = 20 * MiB;
constexpr size_t WS_MB = 24 * MiB, WS_MK16 = 25 * MiB, WS_MVT16 = 26 * MiB, WS_KBIAS = 27 * MiB, WS_GDEC = 28 * MiB, WS_GG = 29 * MiB;
constexpr size_t WS_U16 = 32 * MiB, WS_V16 = 64 * MiB, WS_HB = 96 * MiB, WS_QF = 132 * MiB, WS_KF = 150 * MiB, WS_VF = 168 * MiB;
constexpr size_t WS_GQ = 186 * MiB, WS_GK = 204 * MiB, WS_GV = 222 * MiB, WS_GR = 256 * MiB, WS_SUF = 290 * MiB, WS_GKV = 298 * MiB;
constexpr size_t WS_MERGED = 330 * MiB, WS_X1 = 364 * MiB, WS_X2 = 432 * MiB, WS_QC = 500 * MiB, WS_PC = 534 * MiB, WS_OC = 566 * MiB, WS_SC = 600 * MiB;
constexpr size_t WS_MISC = 736 * MiB, WS_SS = 740 * MiB  , WS_BB = 744 * MiB, WS_END = 800 * MiB;
constexpr int CW_BAR = 4096;

constexpr int RING_BYTES = 131072;
constexpr int LDSCTL_OFF = RING_BYTES, MISC_OFF = LDSCTL_OFF + 320;
constexpr int ARGS_OFF = MISC_OFF + 128;
constexpr int LDS_BYTES = 147456;

struct Args { const void* in[N_INPUTS]; float* out; unsigned char* ws; };

__device__ __forceinline__ const void* ld_ptr(const LAS unsigned long long* p) { const unsigned long long v = *p; const unsigned lo = __builtin_amdgcn_readfirstlane((unsigned)v), hi = __builtin_amdgcn_readfirstlane((unsigned)(v >> 32)); return (const void*)(const GAS char*)(((unsigned long long)hi << 32) | lo); }
__device__ __forceinline__ Args load_args(const LAS unsigned long long* ARGP) { Args A;
    A.in[0] = ld_ptr(ARGP + 0);
    A.in[1] = ld_ptr(ARGP + 1);
    A.in[2] = ld_ptr(ARGP + 2);
    A.in[3] = ld_ptr(ARGP + 3);
    A.in[4] = ld_ptr(ARGP + 4);
    A.in[5] = ld_ptr(ARGP + 5);
    A.in[6] = ld_ptr(ARGP + 6);
    A.in[7] = ld_ptr(ARGP + 7);
    A.in[8] = ld_ptr(ARGP + 8);
    A.in[9] = ld_ptr(ARGP + 9);
    A.in[10] = ld_ptr(ARGP + 10);
    A.in[11] = ld_ptr(ARGP + 11);
    A.in[12] = ld_ptr(ARGP + 12);
    A.in[13] = ld_ptr(ARGP + 13);
    A.in[14] = ld_ptr(ARGP + 14);
    A.in[15] = ld_ptr(ARGP + 15);
    A.in[16] = ld_ptr(ARGP + 16);
    A.in[17] = ld_ptr(ARGP + 17);
    A.in[18] = ld_ptr(ARGP + 18);
    A.in[19] = ld_ptr(ARGP + 19);
    A.in[20] = ld_ptr(ARGP + 20);
    A.in[21] = ld_ptr(ARGP + 21);
    A.in[22] = ld_ptr(ARGP + 22);
    A.in[23] = ld_ptr(ARGP + 23);
    A.in[24] = ld_ptr(ARGP + 24);
    A.in[25] = ld_ptr(ARGP + 25);
    A.in[26] = ld_ptr(ARGP + 26);
    A.in[27] = ld_ptr(ARGP + 27);
    A.in[28] = ld_ptr(ARGP + 28);
    A.out = (float*)ld_ptr(ARGP + N_INPUTS); A.ws = (unsigned char*)ld_ptr(ARGP + N_INPUTS + 1); return A; }
struct Frame {
    LAS unsigned char* lds;
    int tid, lane, wave, vcu, G;
};

__device__ __forceinline__ float wave_sum(float v) {
#pragma unroll
    for (int o = 1; o < 64; o <<= 1) v += __shfl_xor(v, o);
    return v;
}
__device__ __forceinline__ float log_sigmoid(float x) { return fminf(x, 0.f) - log1pf(__expf(-fabsf(x))); }

__device__ __forceinline__ int win_src_col(int r) {
    if (r < 1536) return r;
    if (r < 1792) return 1544 + (r - 1536);
    if (r < 2048) return 1800 + (r - 1792);
    if (r < 2560) return 2056 + (r - 2048);
    if (r < 3072) return 2584 + (r - 2560);
    if (r < 3080) return 1536 + (r - 3072);
    if (r < 3096) return 2568 + (r - 3080);
    return -1;
}
template <bool WIN>
__device__ __forceinline__ void p0_transpose_item(const float* W, int ldw, int K, int nblk, bf16* WT, LAS float* scr, int item, int lane) {
    const int kb = item / nblk, nb = item % nblk, k0 = 64 * kb, n0 = 32 * nb;
    const int dr = n0 + (lane & 31); const int sc = WIN ? win_src_col(dr) : dr;
#pragma unroll 8
    for (int i = 0; i < 32; ++i) { const int kk = 2 * i + (lane >> 5); scr[kk * 33 + (lane & 31)] = (sc >= 0) ? W[(size_t)(k0 + kk) * ldw + sc] : 0.f; }
    LDS_WAIT(); asm volatile("" ::: "memory");
    const int c = lane & 7;
#pragma unroll
    for (int j = 0; j < 4; ++j) { const int n = (lane >> 3) + 8 * j; const LAS float* s = scr + (8 * c) * 33 + n;
        v4u o; o.x = pk2(s[0 * 33], s[1 * 33]); o.y = pk2(s[2 * 33], s[3 * 33]); o.z = pk2(s[4 * 33], s[5 * 33]); o.w = pk2(s[6 * 33], s[7 * 33]);
        *(GAS v4u*)(WT + (size_t)(n0 + n) * K + k0 + 8 * c) = o; }
    LDS_WAIT(); asm volatile("" ::: "memory");
}
__device__ __forceinline__ void rms_row_bf16(const float* xrow, const float* g, bf16* orow, int lane) {
    const f32x4* xr = (const f32x4*)xrow + lane; const f32x4* gr = (const f32x4*)g + lane;
    f32x4 v[4]; float s = 0.f;
#pragma unroll
    for (int j = 0; j < 4; ++j) { v[j] = xr[64 * j]; s += (v[j].x * v[j].x + v[j].y * v[j].y) + (v[j].z * v[j].z + v[j].w * v[j].w); }
    const float r = rsqrtf(wave_sum(s) * (1.f / DM) + EPS);
    v2u* o8 = (v2u*)orow + lane;
#pragma unroll
    for (int j = 0; j < 4; ++j) { const f32x4 gg = gr[64 * j]; v2u o; o.x = pk2(v[j].x * r * gg.x, v[j].y * r * gg.y); o.y = pk2(v[j].z * r * gg.z, v[j].w * r * gg.w); o8[64 * j] = o; }
}

using pg8::Unit;
struct EpiGen {
    static constexpr bool PERM = false, AFTER_DRAIN = false;
    float* d32; int ld32; bf16* d16; int ld16; float sc16;
    const float* r0; const float* r1; int rsplit; int ldr;
    const float* gcol;
    float* ssq;
    const float* rsq;
    __device__ __forceinline__ void operator()(const f32x4 (&acc)[2][2][4][2], const Unit& u, int wr, int wc, int fr, int fq) const {
        int row0 = u.pm * 256 + wr * 64 + fr, col0 = u.pn * 256 + wc * 32 + fq * 4;
        asm volatile("" : "+v"(row0), "+v"(col0));
#pragma unroll
        for (int ai = 0; ai < 2; ++ai)
#pragma unroll
            for (int m = 0; m < 4; ++m) { const int row = row0 + ai * 128 + m * 16;
                const float* rp = nullptr; if (r0) rp = (row < rsplit) ? r0 + (size_t)row * ldr : r1 + (size_t)(row - rsplit) * ldr;
                float rs = 1.f; if (rsq) rs = rsqrtf(rsq[row] * (1.f / 1024.f) + EPS);
                float ss = 0.f;
#pragma unroll
                for (int bj = 0; bj < 2; ++bj)
#pragma unroll
                    for (int n = 0; n < 2; ++n) { const int col = col0 + bj * 128 + n * 16; f32x4 v = acc[ai][bj][m][n];
                        if (rsq) { v[0] *= rs; v[1] *= rs; v[2] *= rs; v[3] *= rs; }
                        if (r0) v += *(const f32x4*)(rp + col);
                        if (d32) *(f32x4*)(d32 + (size_t)row * ld32 + col) = v;
                        if (ssq) ss += (v[0] * v[0] + v[1] * v[1]) + (v[2] * v[2] + v[3] * v[3]);
                        if (d16) { f32x4 w = v; if (gcol) w = w * *(const f32x4*)(gcol + col);
                            v2u o; o.x = pg8::cvt_pk_bf16(w[0] * sc16, w[1] * sc16); o.y = pg8::cvt_pk_bf16(w[2] * sc16, w[3] * sc16); *(v2u*)(d16 + (size_t)row * ld16 + col) = o; } }
                if (ssq) { ss += __shfl_xor(ss, 16); ss += __shfl_xor(ss, 32); if (fq == 0) atomicAdd(ssq + row, ss); } }
    }
};
struct EpiInProj {
    static constexpr bool PERM = false, AFTER_DRAIN = false;
    float* out; unsigned char* ws; const float* bff;
    __device__ __forceinline__ void operator()(const f32x4 (&acc)[2][2][4][2], const Unit& u, int wr, int wc, int fr, int fq) const {
        const int pn = u.pn; const bool smp = u.pm >= 64;
        int row0 = u.pm * 256 + wr * 64 + fr;
        int orow0 = (smp ? (u.pm - 64) * 256 : u.pm * 256) + wr * 64 + fr;
        asm volatile("" : "+v"(row0), "+v"(orow0));
        float* d32 = nullptr; int ld32 = 0; bool d32_grp = false; bf16* d16 = nullptr; int ld16 = 0; float s32 = 1.f, s16 = 1.f; int cb = 0;
        if (pn < 2) { d16 = (bf16*)(ws + WS_QF); ld16 = 512; s16 = C2F; cb = pn * 256; }
        else if (pn < 4) { d32 = out + (smp ? O_FKS : O_FKP); ld32 = 512; d32_grp = true; d16 = (bf16*)(ws + WS_KF); ld16 = 512; cb = (pn - 2) * 256; }
        else if (pn < 6) { d32 = out + (smp ? O_FVS : O_FVP); ld32 = 512; d32_grp = true; d16 = (bf16*)(ws + WS_VF); ld16 = 512; cb = (pn - 4) * 256; }
        else if (pn == 6) { d32 = (float*)(ws + WS_GQ); ld32 = 256; s32 = 0.125f; }
        else if (pn == 7) { d32 = (float*)(ws + WS_GK); ld32 = 256; }
        else if (pn < 10) { d32 = (float*)(ws + WS_GV); ld32 = 512; cb = (pn - 8) * 256; }
        else if (pn < 12) { d32 = (float*)(ws + WS_GR); ld32 = 512; cb = (pn - 10) * 256; }
        if (pn < 12) {
#pragma unroll
            for (int ai = 0; ai < 2; ++ai)
#pragma unroll
                for (int m = 0; m < 4; ++m) { const int row = row0 + ai * 128 + m * 16, orow = orow0 + ai * 128 + m * 16;
#pragma unroll
                    for (int bj = 0; bj < 2; ++bj)
#pragma unroll
                        for (int n = 0; n < 2; ++n) { const int col = cb + wc * 32 + fq * 4 + bj * 128 + n * 16; const f32x4 v = acc[ai][bj][m][n];
                            if (d32) *(f32x4*)(d32 + (size_t)(d32_grp ? orow : row) * ld32 + col) = v * s32;
                            if (d16) { v2u o; o.x = pg8::cvt_pk_bf16(v[0] * s16, v[1] * s16); o.y = pg8::cvt_pk_bf16(v[2] * s16, v[3] * s16); *(v2u*)(d16 + (size_t)row * ld16 + col) = o; } } }
        } else {
            if (wc == 0) {
                float* lf = out + (smp ? O_LFS : O_LFP); float* ggp = (float*)(ws + WS_GG);
#pragma unroll
                for (int ai = 0; ai < 2; ++ai)
#pragma unroll
                    for (int m = 0; m < 4; ++m) { const int row = row0 + ai * 128 + m * 16, orow = orow0 + ai * 128 + m * 16;
#pragma unroll
                        for (int n = 0; n < 2; ++n) { const int col = n * 16 + fq * 4; const f32x4 v = acc[ai][0][m][n];
                            if (col < 8) { f32x4 o; const f32x4 b = *(const f32x4*)(bff + col);
                                o[0] = log_sigmoid(v[0] + b[0]); o[1] = log_sigmoid(v[1] + b[1]); o[2] = log_sigmoid(v[2] + b[2]); o[3] = log_sigmoid(v[3] + b[3]);
                                *(f32x4*)(lf + (size_t)orow * 8 + col) = o; }
                            else if (col < 24) *(f32x4*)(ggp + (size_t)row * 16 + (col - 8)) = v; } }
            }
        }
    }
};


__device__ __forceinline__ void p0_prologue(const Frame& F, const Args& a) {
    unsigned char* ws = a.ws;
    LAS float* scr = (LAS float*)(F.lds + F.wave * 16384);
    const int gw = F.vcu * NWAVES + F.wave, NGW = F.G * NWAVES;
    constexpr int I_WINN = 16 * (N_IN / 32), I_SQ = 16 * 32;
    constexpr int NITEMS = I_WINN + 5 * I_SQ;
    for (int it = gw; it < NITEMS; it += NGW) {
        int r = it;
        if (r < I_WINN) { p0_transpose_item<true>((const float*)a.in[I_WIN], 3096, DM, N_IN / 32, (bf16*)(ws + WS_WIN), scr, r, F.lane); continue; } r -= I_WINN;
        const int which = r / I_SQ; r -= which * I_SQ;
        const float* src = (const float*)(which == 0 ? a.in[I_WOUT] : which == 1 ? a.in[I_WMK] : which == 2 ? a.in[I_WMV] : which == 3 ? a.in[I_WCQ] : a.in[I_WCO]);
        bf16* dst = (bf16*)(ws + (which == 0 ? WS_WOUT : which == 1 ? WS_WMK : which == 2 ? WS_WMV : which == 3 ? WS_WCQ : WS_WCO));
        p0_transpose_item<false>(src, DM, DM, 32, dst, scr, r, F.lane);
    }
    { float* ssz = (float*)(ws + WS_SS); for (int i = F.vcu * NTHR + F.tid; i < 2 * TA; i += F.G * NTHR) ssz[i] = 0.f; }
    for (int m0 = gw * 2; m0 < TA + 512; m0 += NGW * 2) {
        const float* xr[2]; const float* gr[2]; bf16* orow[2];
#pragma unroll
        for (int j = 0; j < 2; ++j) { const int m = m0 + j;
            if (m < TP) { xr[j] = (const float*)a.in[I_XP] + (size_t)m * DM; gr[j] = (const float*)a.in[I_GMIX]; orow[j] = (bf16*)(ws + WS_HB) + (size_t)m * DM; }
            else if (m < TA) { xr[j] = (const float*)a.in[I_XS] + (size_t)(m - TP) * DM; gr[j] = (const float*)a.in[I_GMIX]; orow[j] = (bf16*)(ws + WS_HB) + (size_t)m * DM; }
            else { xr[j] = (const float*)a.in[I_MEMP] + (size_t)(m - TA) * DM; gr[j] = (const float*)a.in[I_GMEM]; orow[j] = (bf16*)(ws + WS_MB) + (size_t)(m - TA) * DM; } }
        f32x4 v[2][4]; float s[2];
#pragma unroll
        for (int j = 0; j < 2; ++j) { s[j] = 0.f;
#pragma unroll
            for (int q = 0; q < 4; ++q) v[j][q] = ((const f32x4*)xr[j])[F.lane + 64 * q]; }
#pragma unroll
        for (int j = 0; j < 2; ++j) {
#pragma unroll
            for (int q = 0; q < 4; ++q) s[j] += (v[j][q].x * v[j][q].x + v[j][q].y * v[j][q].y) + (v[j][q].z * v[j][q].z + v[j][q].w * v[j][q].w);
            const float r = rsqrtf(wave_sum(s[j]) * (1.f / DM) + EPS);
#pragma unroll
            for (int q = 0; q < 4; ++q) { const f32x4 gg = ((const f32x4*)gr[j])[F.lane + 64 * q]; v2u o; o.x = pk2(v[j][q].x * r * gg.x, v[j][q].y * r * gg.y); o.y = pk2(v[j][q].z * r * gg.z, v[j][q].w * r * gg.w); ((v2u*)orow[j])[F.lane + 64 * q] = o; } }
    }
    {
        for (int r0 = gw * 4; r0 < 2 * 16384; r0 += NGW * 4) {
            f32x4 x[4][4];
#pragma unroll
            for (int j = 0; j < 4; ++j) { const int r = r0 + j; const bool isv = r >= 16384; const int e = isv ? r - 16384 : r;
                const f32x4* s = (const f32x4*)((const float*)(isv ? a.in[I_PV] : a.in[I_PU]) + (size_t)e * DM + 16 * F.lane);
#pragma unroll
                for (int q = 0; q < 4; ++q) x[j][q] = __builtin_nontemporal_load(s + q); }
#pragma unroll
            for (int j = 0; j < 4; ++j) { const int r = r0 + j; const bool isv = r >= 16384; const int e = isv ? r - 16384 : r; float am = 0.f;
#pragma unroll
                for (int q = 0; q < 4; ++q) am = fmaxf(am, fmaxf(fmaxf(fabsf(x[j][q].x), fabsf(x[j][q].y)), fmaxf(fabsf(x[j][q].z), fabsf(x[j][q].w))));
#pragma unroll
                for (int o = 1; o < 64; o <<= 1) am = fmaxf(am, __shfl_xor(am, o));
                const float inv = am > 0.f ? 448.f / am : 0.f;
                v4u o4;
#pragma unroll
                for (int q = 0; q < 4; ++q) { int pk = __builtin_amdgcn_cvt_pk_fp8_f32(x[j][q].x * inv, x[j][q].y * inv, 0, false); pk = __builtin_amdgcn_cvt_pk_fp8_f32(x[j][q].z * inv, x[j][q].w * inv, pk, true); o4[q] = (unsigned)pk; }
                *(v4u*)(ws + (isv ? WS_V16 : WS_U16) + (size_t)e * DM + 16 * F.lane) = o4;
                if (F.lane == 0) ((float*)(ws + WS_MISC))[r] = am * (1.f / 448.f); }
        }
    }
    __syncthreads();
    for (int it = blockIdx.x; it < 256; it += F.G) {
        const int c = it >> 4, kt = it & 15, half = c & 1;
        LAS float* SK = (LAS float*)F.lds; LAS float* WT = (LAS float*)(F.lds + 128 * 129 * 4);
        const float* sk = (const float*)a.in[I_PSK] + (size_t)half * 128 * 128; const float* wq = (const float*)a.in[I_PWQ] + (size_t)(kt * 64) * 2048 + c * 128;
#pragma unroll 4
        for (int i = 0; i < 32; ++i) { const int idx = F.tid + 512 * i; SK[(idx >> 7) * 129 + (idx & 127)] = sk[idx]; }
#pragma unroll 4
        for (int i = 0; i < 16; ++i) { const int idx = F.tid + 512 * i; WT[(idx >> 7) * 129 + (idx & 127)] = wq[(size_t)(idx >> 7) * 2048 + (idx & 127)]; }
        __syncthreads();
        const int tk = F.tid & 15, tkey = F.tid >> 4;
        float acc[4][4];
#pragma unroll
        for (int i = 0; i < 4; ++i)
#pragma unroll
            for (int j = 0; j < 4; ++j) acc[i][j] = 0.f;
        for (int j = 0; j < 128; ++j) {
            float av[4], bv[4];
#pragma unroll
            for (int i = 0; i < 4; ++i) { av[i] = SK[(4 * tkey + i) * 129 + j]; bv[i] = WT[(4 * tk + i) * 129 + j]; }
#pragma unroll
            for (int i = 0; i < 4; ++i)
#pragma unroll
                for (int i2 = 0; i2 < 4; ++i2) acc[i][i2] += av[i] * bv[i2];
        }
        bf16* wp = (bf16*)(ws + WS_WPK);
#pragma unroll
        for (int i = 0; i < 4; ++i) { v2u o; o.x = pk2(acc[i][0], acc[i][1]); o.y = pk2(acc[i][2], acc[i][3]); *(v2u*)(wp + (size_t)(c * 128 + 4 * tkey + i) * DM + kt * 64 + 4 * tk) = o; }
        __syncthreads();
    }
}


__device__ __forceinline__ void fox_prompt_cumsum(const Frame& F, const float* logf  , float* kbias, int b) {
    LAS float* WT = (LAS float*)F.lds;
    const int t0 = F.wave * 1024 + F.lane * 16;
    const f32x4* src = (const f32x4*)(logf + ((size_t)b * SEQ + t0) * 8);
    float s[8];
#pragma unroll
    for (int h = 0; h < 8; ++h) s[h] = 0.f;
#pragma unroll 4
    for (int i = 0; i < 16; ++i) { const f32x4 a = src[2 * i], c = src[2 * i + 1]; s[0] += a.x; s[1] += a.y; s[2] += a.z; s[3] += a.w; s[4] += c.x; s[5] += c.y; s[6] += c.z; s[7] += c.w; }
    float ex[8];
#pragma unroll
    for (int h = 0; h < 8; ++h) { float v = s[h];
#pragma unroll
        for (int o = 1; o < 64; o <<= 1) { const float t = __shfl_up(v, o); if (F.lane >= o) v += t; }
        ex[h] = v - s[h];
        if (F.lane == 63) WT[F.wave * 8 + h] = v; }
    __syncthreads();
#pragma unroll
    for (int h = 0; h < 8; ++h) { float c = 0.f; for (int w = 0; w < F.wave; ++w) c += WT[w * 8 + h]; ex[h] += c; }
    float* dst = kbias + (size_t)(b * 8) * SEQ + t0;
#pragma unroll 4
    for (int i = 0; i < 16; ++i) { const f32x4 a = src[2 * i], c = src[2 * i + 1];
        ex[0] += a.x; ex[1] += a.y; ex[2] += a.z; ex[3] += a.w; ex[4] += c.x; ex[5] += c.y; ex[6] += c.z; ex[7] += c.w;
#pragma unroll
        for (int h = 0; h < 8; ++h) dst[(size_t)h * SEQ + i] = -ex[h] * LOG2E; }
    __syncthreads();
}
__device__ __forceinline__ void fox_sample_suffix(const Frame& F, const float* cfl, const int* pt, float* suf, int bs) {
    float carry[8];
#pragma unroll
    for (int h = 0; h < 8; ++h) carry[h] = 0.f;
    const int mypg = pt[bs * NPAGES + (F.lane & 15)];
#pragma unroll 1
    for (int pb = NPAGES - 4; pb >= 0; pb -= 4) {
        f32x4 x[4][4];
#pragma unroll
        for (int j = 0; j < 4; ++j) { const int pg = __builtin_amdgcn_readlane(mypg, 0) * 0 + __shfl(mypg, pb + j); const f32x4* src = (const f32x4*)(cfl + ((size_t)pg * PAGE + 2 * F.lane) * 8);
            x[j][0] = src[0]; x[j][1] = src[1]; x[j][2] = src[2]; x[j][3] = src[3]; }
#pragma unroll
        for (int j = 3; j >= 0; --j) { const int p = pb + j;
            const float ra[8] = {x[j][0].x, x[j][0].y, x[j][0].z, x[j][0].w, x[j][1].x, x[j][1].y, x[j][1].z, x[j][1].w}, rb[8] = {x[j][2].x, x[j][2].y, x[j][2].z, x[j][2].w, x[j][3].x, x[j][3].y, x[j][3].z, x[j][3].w};
#pragma unroll
            for (int h = 0; h < 8; ++h) {
                const float ps = ra[h] + rb[h]; float v = ps;
#pragma unroll
                for (int o = 1; o < 64; o <<= 1) { const float t = __shfl_down(v, o); if (F.lane + o < 64) v += t; }
                const float exs = v - ps;
                float* d = suf + (size_t)(bs * 8 + h) * PASTL + p * PAGE + 2 * F.lane;
                *(f32x2*)d = (f32x2){(carry[h] + exs + rb[h]) * LOG2E, (carry[h] + exs) * LOG2E};
                carry[h] += __shfl(v, 0);
            }
        }
    }
}

__device__ __forceinline__ void gla_gate_tile(const Frame& F, const float* gg, const float* w2, const float* bg, int row0, int h, int nt, LAS float* LA, LAS float* GGS) {
    for (int e = F.tid; e < nt * 16; e += NTHR) GGS[e] = gg[(size_t)row0 * 16 + e];
    const int dk = F.tid & 63; float wc[16];
#pragma unroll
    for (int r = 0; r < 16; ++r) wc[r] = w2[r * 256 + h * 64 + dk];
    const float bb = bg[h * 64 + dk];
    __syncthreads();
    for (int t = F.tid >> 6; t < nt; t += 8) { float z = bb;
#pragma unroll
        for (int q = 0; q < 4; ++q) { const f32x4 g4 = *(const LAS f32x4*)(GGS + t * 16 + 4 * q); z += g4.x * wc[4 * q] + g4.y * wc[4 * q + 1] + g4.z * wc[4 * q + 2] + g4.w * wc[4 * q + 3]; }
        LA[t * 64 + dk] = log_sigmoid(z) * (1.f / 16.f); }
}
__device__ __forceinline__ void gla_cumsum64(const Frame& F, LAS float* LA, LAS float* SEG) {
    const int dk = F.lane, w = F.wave; float v[8]; float run = 0.f;
#pragma unroll
    for (int i = 0; i < 8; ++i) { run += LA[(8 * w + i) * 64 + dk]; v[i] = run; }
    SEG[w * 64 + dk] = run;
    __syncthreads();
    float pre = 0.f;
    for (int j = 0; j < w; ++j) pre += SEG[j * 64 + dk];
#pragma unroll
    for (int i = 0; i < 8; ++i) LA[(8 * w + i) * 64 + dk] = v[i] + pre;
    __syncthreads();
}
__device__ __forceinline__ void gla_g1_unit(const Frame& F, const Args& a, int u) {
    unsigned char* ws = a.ws;
    const int b = u >> 9, h = (u >> 7) & 3, n = u & 127; const int row0 = b * SEQ + n * 64;
    LAS float* LA = (LAS float*)F.lds; LAS float* KR = LA + 4096; LAS float* SEG = KR + 4096; LAS float* GGS = SEG + 512; LAS float* VS = GGS + 1024;
#pragma unroll
    for (int i = 0; i < 16; ++i) { const int e = F.tid + NTHR * i; VS[e] = ((const float*)(ws + WS_GV))[(size_t)(row0 + (e >> 7)) * 512 + h * 128 + (e & 127)]; }
    gla_gate_tile(F, (const float*)(ws + WS_GG), (const float*)a.in[I_WG2], (const float*)a.in[I_BG], row0, h, 64, LA, GGS);
    __syncthreads();
    gla_cumsum64(F, LA, SEG);
    if (F.tid < 64) ((float*)(ws + WS_GDEC))[(size_t)((b * 4 + h) * 128 + n) * 64 + F.tid] = __expf(LA[63 * 64 + F.tid]);
    const float* gk = (const float*)(ws + WS_GK); float* bbuf = (float*)(ws + WS_BB);
#pragma unroll
    for (int i = 0; i < 8; ++i) { const int e = F.tid + NTHR * i; const int t = e >> 6, dk = e & 63; const float bb = LA[e]; bbuf[(size_t)(row0 + t) * 256 + h * 64 + dk] = bb;
        KR[e] = gk[(size_t)(row0 + t) * 256 + h * 64 + dk] * __expf(LA[63 * 64 + dk] - bb); }
    __syncthreads();
    {
        const int dvq = F.tid & 31, dkq = F.tid >> 5; float acc[4][4];
#pragma unroll
        for (int i = 0; i < 4; ++i)
#pragma unroll
            for (int j = 0; j < 4; ++j) acc[i][j] = 0.f;
#pragma unroll 8
        for (int t = 0; t < 64; ++t) { const f32x4 v4 = *(const LAS f32x4*)(VS + t * 128 + 4 * dvq), k4 = *(const LAS f32x4*)(KR + t * 64 + 4 * dkq);
#pragma unroll
            for (int i = 0; i < 4; ++i)
#pragma unroll
                for (int j = 0; j < 4; ++j) acc[i][j] += k4[i] * v4[j]; }
        float* kv = (float*)(ws + WS_GKV) + ((size_t)((b * 4 + h) * 128 + n) * 64 + 4 * dkq) * 128 + 4 * dvq;
#pragma unroll
        for (int i = 0; i < 4; ++i) *(f32x4*)(kv + (size_t)i * 128) = (f32x4){acc[i][0], acc[i][1], acc[i][2], acc[i][3]};
    }
    __syncthreads();
}
__device__ __forceinline__ void gla_scan(const Frame& F, const Args& a) {
    int tid = F.wave * 64 + lane_id(); asm volatile("" : "+v"(tid));
    if (tid >= 256) return;
    for (int e = F.vcu * 256 + tid; e < 65536; e += F.G * 256) {
    const int bh = e >> 13, dk = (e >> 7) & 63, dv = e & 127;
    float* kv = (float*)(a.ws + WS_GKV) + ((size_t)bh * 128 * 64 + dk) * 128 + dv; const float* dc = (const float*)(a.ws + WS_GDEC) + (size_t)bh * 128 * 64 + dk;
    float S = 0.f;
    for (int n0 = 0; n0 < 128; n0 += 8) { float kvv[8], dd[8];
#pragma unroll
        for (int j = 0; j < 8; ++j) { kvv[j] = kv[(size_t)(n0 + j) * 8192]; dd[j] = dc[(size_t)(n0 + j) * 64]; }
#pragma unroll
        for (int j = 0; j < 8; ++j) { kv[(size_t)(n0 + j) * 8192] = S; S = dd[j] * S + kvv[j]; } }
    a.out[O_GSP + (size_t)bh * 8192 + dk * 128 + dv] = S;
    }
}
__device__ __forceinline__ float silu(float x) { return x / (1.f + __expf(-x)); }
__device__ __forceinline__ void gla_sample_unit(const Frame& F, const Args& a, int u) {
    unsigned char* ws = a.ws;
    const int bs = u >> 2, h = u & 3; const int row0 = TP + bs * LS;
    LAS float* LA = (LAS float*)F.lds; LAS float* BL = LA + 512; LAS float* QD = BL + 64; LAS float* KI = QD + 512; LAS float* KR = KI + 512; LAS float* ATT = KR + 512; LAS float* OP = ATT + 64; LAS float* VS = OP + 4096;
    gla_gate_tile(F, (const float*)(ws + WS_GG), (const float*)a.in[I_WG2], (const float*)a.in[I_BG], row0, h, 8, LA, VS + 1024);
#pragma unroll
    for (int i = 0; i < 2; ++i) { const int e = F.tid + NTHR * i; VS[e] = ((const float*)(ws + WS_GV))[(size_t)(row0 + (e >> 7)) * 512 + h * 128 + (e & 127)]; }
    __syncthreads();
    if (F.tid < 64) { float run = 0.f;
#pragma unroll
        for (int t = 0; t < 8; ++t) { run += LA[t * 64 + F.tid]; LA[t * 64 + F.tid] = run; } BL[F.tid] = run; }
    __syncthreads();
    { const int e = F.tid, t = e >> 6, dk = e & 63; const float bb = LA[e];
      const float q = ((const float*)(ws + WS_GQ))[(size_t)(row0 + t) * 256 + h * 64 + dk], k = ((const float*)(ws + WS_GK))[(size_t)(row0 + t) * 256 + h * 64 + dk];
      QD[e] = q * __expf(bb); KI[e] = k * __expf(-bb); KR[e] = k * __expf(BL[dk] - bb); }
    __syncthreads();
    if (F.tid < 64) { const int t = F.tid >> 3, s = F.tid & 7; float acc = 0.f;
        if (s <= t) { for (int dk = 0; dk < 64; ++dk) acc += QD[t * 64 + dk] * KI[s * 64 + dk]; }
        ATT[F.tid] = acc; }
    const int dv = F.tid & 127, dkg = F.tid >> 7;
    {
        const float* st = (const float*)a.in[I_SGLA] + ((size_t)(bs * 4 + h) * 64 + dkg * 16) * 128 + dv;
        float S0[16];
#pragma unroll
        for (int i = 0; i < 16; ++i) S0[i] = st[(size_t)i * 128];
#pragma unroll
        for (int t = 0; t < 8; ++t) { float o = 0.f;
#pragma unroll
            for (int i = 0; i < 16; ++i) o += QD[t * 64 + dkg * 16 + i] * S0[i];
            OP[(dkg * 8 + t) * 128 + dv] = o; }
        float* so = a.out + O_GSS + ((size_t)(bs * 4 + h) * 64 + dkg * 16) * 128 + dv;
#pragma unroll
        for (int i = 0; i < 16; ++i) { float sn = __expf(BL[dkg * 16 + i]) * S0[i];
#pragma unroll
            for (int t = 0; t < 8; ++t) sn += KR[t * 64 + dkg * 16 + i] * VS[t * 128 + dv];
            so[(size_t)i * 128] = sn; }
    }
    __syncthreads();
    {
        const int t = F.wave; float o[2]; float ss = 0.f;
#pragma unroll
        for (int j = 0; j < 2; ++j) { const int d = 2 * F.lane + j; float v = OP[(0 * 8 + t) * 128 + d] + OP[(1 * 8 + t) * 128 + d] + OP[(2 * 8 + t) * 128 + d] + OP[(3 * 8 + t) * 128 + d];
            for (int s = 0; s <= t; ++s) v += ATT[t * 8 + s] * VS[s * 128 + d];
            o[j] = v; ss += v * v; }
        const float r = rsqrtf(wave_sum(ss) * (1.f / 128.f) + EPS);
        const float* ggo = (const float*)a.in[I_GGO] + h * 128 + 2 * F.lane; const float* gr = (const float*)(ws + WS_GR) + (size_t)(row0 + t) * 512 + h * 128 + 2 * F.lane;
        const float y0 = o[0] * r * ggo[0] * silu(gr[0]), y1 = o[1] * r * ggo[1] * silu(gr[1]);
        *(unsigned*)((bf16*)(ws + WS_MERGED) + (size_t)(row0 + t) * DM + 512 + h * 128 + 2 * F.lane) = pk2(y0, y1);
    }
    __syncthreads();
}


typedef short v4i16_t __attribute__((ext_vector_type(4)));
__device__ __forceinline__ s16x4 lds_tr16(LAS unsigned char* p) { return __builtin_bit_cast(s16x4, __builtin_amdgcn_ds_read_tr16_b64_v4i16((LAS v4i16_t*)p)); }
__device__ __forceinline__ int crow(int r, int hi) { return (r & 3) + 8 * (r >> 2) + 4 * hi; }
__device__ __forceinline__ float fexp2(float x) { return __builtin_amdgcn_exp2f(x); }
constexpr float FOX_SKIP = 160.f;


__device__ __forceinline__ void fox_norms_item(const Frame& F, const bf16* QF, const bf16* KF, const float* logf, float* FN, float* LC, float* BT, int item) {
    const int bh = item >> 5, qb = item & 31, b = bh >> 3, h = bh & 7;
    float qm = 0.f, km = 0.f;
    const float* lp = logf + ((size_t)b * SEQ + qb * 256 + 4 * F.lane) * 8 + h;
    const float l0 = lp[0], l1 = lp[8], l2 = lp[16], l3 = lp[24];
#pragma unroll
    for (int i = 0; i < 4; ++i) { const size_t row = (size_t)b * SEQ + qb * 256 + i * 64 + F.lane;
        const v4u* qp = (const v4u*)(QF + row * 512 + h * 64); const v4u* kp = (const v4u*)(KF + row * 512 + h * 64); float qs = 0.f, ks = 0.f;
#pragma unroll
        for (int c = 0; c < 8; ++c) { const v4u q = qp[c], k = kp[c];
#pragma unroll
            for (int j = 0; j < 4; ++j) { qs += bflo(q[j]) * bflo(q[j]) + bfhi(q[j]) * bfhi(q[j]); ks += bflo(k[j]) * bflo(k[j]) + bfhi(k[j]) * bfhi(k[j]); } }
        qm = fmaxf(qm, qs); km = fmaxf(km, ks); }
#pragma unroll
    for (int o = 1; o < 64; o <<= 1) { qm = fmaxf(qm, __shfl_xor(qm, o)); km = fmaxf(km, __shfl_xor(km, o)); }
    const float c0 = l0, c1 = c0 + l1, c2 = c1 + l2, c3 = c2 + l3; float v = c3;
#pragma unroll
    for (int o = 1; o < 64; o <<= 1) { const float t = __shfl_up(v, o); if (F.lane >= o) v += t; }
    const float ex = v - c3;
    *(f32x4*)(LC + (size_t)bh * SEQ + qb * 256 + 4 * F.lane) = (f32x4){ex + c0, ex + c1, ex + c2, ex + c3};
    if (F.lane == 63) BT[item] = v;
    if (F.lane == 0) { FN[item * 2] = qm; FN[item * 2 + 1] = km; }
}
__device__ __forceinline__ void fox_suffix_item(const Frame& F, const float* cfl, const int* pt, float* SW, float* PTOT, int item) {
    const int bs = item >> 4, p = item & 15; const int pg = __builtin_amdgcn_readfirstlane(pt[item]);
    const f32x4* src = (const f32x4*)(cfl + ((size_t)pg * PAGE + 2 * F.lane) * 8);
    const f32x4 a0 = src[0], a1 = src[1], b0 = src[2], b1 = src[3];
    const float ra[8] = {a0.x, a0.y, a0.z, a0.w, a1.x, a1.y, a1.z, a1.w}, rb[8] = {b0.x, b0.y, b0.z, b0.w, b1.x, b1.y, b1.z, b1.w};
#pragma unroll
    for (int h = 0; h < 8; ++h) {
        const float ps = ra[h] + rb[h]; float v = ps;
#pragma unroll
        for (int o = 1; o < 64; o <<= 1) { const float t = __shfl_down(v, o); if (F.lane + o < 64) v += t; }
        const float exs = v - ps;
        *(f32x2*)(SW + (size_t)(bs * 8 + h) * PASTL + p * PAGE + 2 * F.lane) = (f32x2){exs + rb[h], exs};
        if (F.lane == 0) PTOT[(bs * 8 + h) * NPAGES + p] = v;
    }
}
__device__ __forceinline__ void fox_attn_unit(const Frame& F, const bf16* QF, const bf16* KF, const bf16* VF, const float* LC, const float* BT, const float* FN, bf16* merged, int b, int h, int qb) {
    int tid = F.wave * 64 + lane_id(); asm volatile("" : "+v"(tid));
    const int lane = tid & 63, r32 = lane & 31, hi = lane >> 5, wid = F.wave;
    const size_t rowbase = (size_t)b * SEQ; const int q0 = qb * 256;
    LAS unsigned char* Ks = F.lds; LAS unsigned char* Vs = F.lds + 8192; LAS float* KBs = (LAS float*)(F.lds + 20480); LAS float* WSF = (LAS float*)(F.lds + 20736) + wid * 32;
    const bf16* Qw = QF + (rowbase + q0 + wid * 32 + r32) * 512 + h * 64;
    bf16x8 qr[4];
#pragma unroll
    for (int d0 = 0; d0 < 4; ++d0) qr[d0] = *(const bf16x8*)(Qw + d0 * 16 + hi * 8);
    const float* lcp = LC + (size_t)(b * 8 + h) * SEQ;
    float pbx; { const float btv = (lane < 32) ? BT[(b * 8 + h) * 32 + lane] : 0.f; float v = btv;
#pragma unroll
        for (int o = 1; o < 64; o <<= 1) { const float t = __shfl_up(v, o); if (lane >= o) v += t; }
        pbx = v - btv; }
    const float cref = lcp[q0] + __shfl(pbx, qb);
#define FOX_KB(t_, pos_) (-LOG2E * ((lcp[pos_] + __shfl(pbx, (t_) >> 2)) - cref))
    const int NT = (q0 + 256) / 64;
    int t0 = 0;
    {
        float kn = (lane < 32) ? FN[((b * 8 + h) * 32 + lane) * 2 + 1] : 0.f;
#pragma unroll
        for (int o = 1; o < 64; o <<= 1) kn = fmaxf(kn, __shfl_xor(kn, o));
        const float qk2 = 2.f * sqrtf(FN[((b * 8 + h) * 32 + qb) * 2]) * sqrtf(kn) * 1.01f;
        const int nbefore = q0 / 64;
        int found = -1;
        for (int base = 0; base < nbefore && found < 0; base += 64) {
            const int tl = nbefore - 1 - base - lane;
            const int tlc = tl < 0 ? 0 : tl; const float kbl = -LOG2E * ((lcp[tlc * 64 + 63] + __shfl(pbx, tlc >> 2)) - cref);
            const bool dead = (tl >= 0) && (qk2 + kbl < -FOX_SKIP);
            const unsigned long long bm = __ballot(dead);
            if (bm) found = nbefore - 1 - base - (int)__builtin_ctzll(bm);
        }
        t0 = found + 1;
        t0 = __builtin_amdgcn_readfirstlane(t0);
    }
    const int kkey = tid & 63, kch = tid >> 6, vkey = tid >> 3, vch = tid & 7;
    const bf16* ksrc = KF + (rowbase + kkey) * 512 + h * 64 + kch * 8;
    const bf16* vsrc = VF + (rowbase + vkey) * 512 + h * 64 + vch * 8;
    v4u kreg = *(const v4u*)(ksrc + (size_t)t0 * 64 * 512), vreg = *(const v4u*)(vsrc + (size_t)t0 * 64 * 512); float kbreg = FOX_KB(t0, t0 * 64 + (tid & 63));
    float m_run = -INFINITY, l_run = 0.f; f32x16 o0 = {}, o1 = {};
    const int qpos = q0 + wid * 32 + r32;
    const int vbase = (4 * hi + ((lane & 15) >> 2)) * 192 + (16 * ((lane >> 4) & 1) + 4 * (lane & 3)) * 2;
    for (int t = t0; t < NT; ++t) {
        __syncthreads();
        *(LAS v4u*)(Ks + kch * 1024 + kkey * 16) = kreg; *(LAS v4u*)(Vs + vkey * 192 + vch * 16) = vreg; if (tid < 64) KBs[tid] = kbreg;
        __syncthreads();
        if (t + 1 < NT) { kreg = *(const v4u*)(ksrc + (size_t)(t + 1) * 64 * 512); vreg = *(const v4u*)(vsrc + (size_t)(t + 1) * 64 * 512); kbreg = FOX_KB(t + 1, (t + 1) * 64 + (tid & 63)); }
        const int k0 = t * 64;
        if (k0 > q0 + wid * 32 + 31) continue;
        f32x16 p0 = {}, p1 = {};
#pragma unroll
        for (int d0 = 0; d0 < 4; ++d0) {
            const bf16x8 a0 = *(const LAS bf16x8*)(Ks + (2 * d0 + hi) * 1024 + r32 * 16), a1 = *(const LAS bf16x8*)(Ks + (2 * d0 + hi) * 1024 + r32 * 16 + 512);
            p0 = __builtin_amdgcn_mfma_f32_32x32x16_bf16(a0, qr[d0], p0, 0, 0, 0); p1 = __builtin_amdgcn_mfma_f32_32x32x16_bf16(a1, qr[d0], p1, 0, 0, 0);
        }
#pragma unroll
        for (int g = 0; g < 4; ++g) { const f32x4 ba = *(const LAS f32x4*)(KBs + 8 * g + 4 * hi), bb = *(const LAS f32x4*)(KBs + 32 + 8 * g + 4 * hi);
#pragma unroll
            for (int i = 0; i < 4; ++i) { p0[4 * g + i] += ba[i]; p1[4 * g + i] += bb[i]; } }
        if (k0 + 63 > q0 + wid * 32) {
#pragma unroll
            for (int r = 0; r < 16; ++r) { const int key = k0 + crow(r, hi); if (key > qpos) p0[r] = -INFINITY; if (key + 32 > qpos) p1[r] = -INFINITY; }
        }
        float mx = fmaxf(p0[0], p1[0]);
#pragma unroll
        for (int r = 1; r < 16; ++r) mx = fmaxf(mx, fmaxf(p0[r], p1[r]));
        mx = fmaxf(mx, __shfl_xor(mx, 32));
        const float m_new = fmaxf(m_run, mx), alpha = fexp2(m_run - m_new); m_run = m_new;
        float ls = 0.f;
#pragma unroll
        for (int r = 0; r < 16; ++r) { p0[r] = fexp2(p0[r] - m_new); p1[r] = fexp2(p1[r] - m_new); ls += p0[r] + p1[r]; }
        l_run = l_run * alpha + ls;
        if (hi == 0) WSF[r32] = alpha;
#pragma unroll
        for (int g = 0; g < 4; ++g) { const f32x4 al = *(const LAS f32x4*)(WSF + 8 * g + 4 * hi);
#pragma unroll
            for (int i = 0; i < 4; ++i) { o0[4 * g + i] *= al[i]; o1[4 * g + i] *= al[i]; } }
        v4u pw[4];
#pragma unroll
        for (int j = 0; j < 4; ++j) { pw[0][j] = pg8::cvt_pk_bf16(p0[2 * j], p0[2 * j + 1]); pw[1][j] = pg8::cvt_pk_bf16(p0[8 + 2 * j], p0[8 + 2 * j + 1]);
                                      pw[2][j] = pg8::cvt_pk_bf16(p1[2 * j], p1[2 * j + 1]); pw[3][j] = pg8::cvt_pk_bf16(p1[8 + 2 * j], p1[8 + 2 * j + 1]); }
#pragma unroll
        for (int ks = 0; ks < 4; ++ks) {
            const bf16x8 pa = __builtin_bit_cast(bf16x8, pw[ks]);
#pragma unroll
            for (int d0 = 0; d0 < 2; ++d0) {
                const s16x4 lo = lds_tr16(Vs + vbase + ks * 16 * 192 + d0 * 64), hi4 = lds_tr16(Vs + vbase + ks * 16 * 192 + 8 * 192 + d0 * 64);
                const bf16x8 vb = (bf16x8){lo[0], lo[1], lo[2], lo[3], hi4[0], hi4[1], hi4[2], hi4[3]};
                if (d0 == 0) o0 = __builtin_amdgcn_mfma_f32_32x32x16_bf16(pa, vb, o0, 0, 0, 0); else o1 = __builtin_amdgcn_mfma_f32_32x32x16_bf16(pa, vb, o1, 0, 0, 0);
            }
        }
    }
    l_run += __shfl_xor(l_run, 32);
    if (hi == 0) WSF[r32] = 1.f / l_run;
    bf16* Ow = merged + (rowbase + q0 + wid * 32) * DM + h * 64 + r32;
#pragma unroll
    for (int g = 0; g < 4; ++g) { const f32x4 rl = *(const LAS f32x4*)(WSF + 8 * g + 4 * hi);
#pragma unroll
        for (int i = 0; i < 4; ++i) { const int r = 4 * g + i; const int row = crow(r, hi);
            Ow[(size_t)row * DM] = (bf16)f2bf(o0[r] * rl[i]); Ow[(size_t)row * DM + 32] = (bf16)f2bf(o1[r] * rl[i]); } }
    __syncthreads();
#undef FOX_KB
}

template <int D> struct DecW {
    static constexpr int KS = D / 32;
    static constexpr int LPK = D / 4;
    static constexpr int KPI = 64 / LPK;
    float m[4], l[4]; float o[8][4];
};
template <int D>
__device__ __forceinline__ void dec_init(DecW<D>& w) {
#pragma unroll
    for (int i = 0; i < 4; ++i) { w.m[i] = -INFINITY; w.l[i] = 0.f; }
#pragma unroll
    for (int q = 0; q < 8; ++q)
#pragma unroll
        for (int j = 0; j < 4; ++j) w.o[q][j] = 0.f;
}
template <int D, int NTILE, int MODE>
__device__ __forceinline__ void dec_chunk(DecW<D>& w, const bf16x8 (&qa)[D / 32], const float* Kb, const float* Vb, int stride, const float* bias, float nb, LAS float* PL, int lane) {
    constexpr int KS = D / 32, LPK = D / 4, KPI = 64 / LPK;
    constexpr int NK = (MODE == 1) ? 8 : NTILE * 16, NV = NK / KPI;
    const int key = lane & 15, kq = lane >> 4;
    const unsigned koff = (unsigned)(key * stride + 8 * kq) * 4u;
    const int d4 = lane % LPK, ksub = lane / LPK;
    const unsigned voff = (unsigned)(ksub * stride + 4 * d4) * 4u;
    f32x4 kx[NTILE][2 * KS], vx[NV];
#pragma unroll
    for (int t = 0; t < NTILE; ++t) { const char* kp = (const char*)(Kb + (size_t)t * 16 * stride) + koff;
#pragma unroll
        for (int ks = 0; ks < KS; ++ks) { kx[t][2 * ks] = *(const f32x4*)(kp + 128 * ks); kx[t][2 * ks + 1] = *(const f32x4*)(kp + 128 * ks + 16); } }
    constexpr int NVA = (NV >= 8) ? NV / 2 : NV;
#pragma unroll
    for (int kk = 0; kk < NVA; ++kk) vx[kk] = *(const f32x4*)((const char*)(Vb + (size_t)kk * KPI * stride) + voff);
    f32x4 s[NTILE];
#pragma unroll
    for (int t = 0; t < NTILE; ++t) {
        f32x4 acc = {0.f, 0.f, 0.f, 0.f};
#pragma unroll
        for (int ks = 0; ks < KS; ++ks) { const f32x4 x0 = kx[t][2 * ks], x1 = kx[t][2 * ks + 1];
            v4u kb; kb.x = pg8::cvt_pk_bf16(x0.x, x0.y); kb.y = pg8::cvt_pk_bf16(x0.z, x0.w); kb.z = pg8::cvt_pk_bf16(x1.x, x1.y); kb.w = pg8::cvt_pk_bf16(x1.z, x1.w);
            acc = __builtin_amdgcn_mfma_f32_16x16x32_bf16(qa[ks], __builtin_bit_cast(bf16x8, kb), acc, 0, 0, 0); }
        if (MODE == 0) { if (bias) { const float bv = (bias[t * 16 + key] + nb) * LOG2E; acc += bv; } }
        else { acc += nb;
#pragma unroll
            for (int i = 0; i < 4; ++i) if (key > 4 * kq + i || key >= 8) acc[i] = -INFINITY; }
        s[t] = acc;
    }
#pragma unroll
    for (int kk = NVA; kk < NV; ++kk) vx[kk] = *(const f32x4*)((const char*)(Vb + (size_t)kk * KPI * stride) + voff);
    f32x4 mc = s[0];
#pragma unroll
    for (int t = 1; t < NTILE; ++t) { mc.x = fmaxf(mc.x, s[t].x); mc.y = fmaxf(mc.y, s[t].y); mc.z = fmaxf(mc.z, s[t].z); mc.w = fmaxf(mc.w, s[t].w); }
#pragma unroll
    for (int o = 1; o < 16; o <<= 1) { mc.x = fmaxf(mc.x, __shfl_xor(mc.x, o)); mc.y = fmaxf(mc.y, __shfl_xor(mc.y, o)); mc.z = fmaxf(mc.z, __shfl_xor(mc.z, o)); mc.w = fmaxf(mc.w, __shfl_xor(mc.w, o)); }
    float al[4];
#pragma unroll
    for (int i = 0; i < 4; ++i) { const float mn = fmaxf(w.m[i], mc[i]); al[i] = (mn == -INFINITY) ? 1.f : fexp2(w.m[i] - mn); w.m[i] = mn; w.l[i] *= al[i]; }
#pragma unroll
    for (int t = 0; t < NTILE; ++t) { f32x4 p;
#pragma unroll
        for (int i = 0; i < 4; ++i) { p[i] = (w.m[i] == -INFINITY) ? 0.f : fexp2(s[t][i] - w.m[i]); w.l[i] += p[i]; }
        if (kq < 2) *(LAS f32x4*)(PL + (t * 16 + key) * 8 + 4 * kq) = p; }
    if (key == 0 && kq < 2) *(LAS f32x4*)(PL + 1024 + 4 * kq) = (f32x4){al[0], al[1], al[2], al[3]};
    { const f32x4 a0 = *(const LAS f32x4*)(PL + 1024), a1 = *(const LAS f32x4*)(PL + 1028);
#pragma unroll
      for (int j = 0; j < 4; ++j) { w.o[0][j] *= a0.x; w.o[1][j] *= a0.y; w.o[2][j] *= a0.z; w.o[3][j] *= a0.w; w.o[4][j] *= a1.x; w.o[5][j] *= a1.y; w.o[6][j] *= a1.z; w.o[7][j] *= a1.w; } }
#pragma unroll
    for (int kk = 0; kk < NV; ++kk) { const int k = kk * KPI + ksub;
        const f32x4 v = vx[kk];
        const f32x4 pa = *(const LAS f32x4*)(PL + k * 8), pb = *(const LAS f32x4*)(PL + k * 8 + 4);
#pragma unroll
        for (int j = 0; j < 4; ++j) { w.o[0][j] += pa.x * v[j]; w.o[1][j] += pa.y * v[j]; w.o[2][j] += pa.z * v[j]; w.o[3][j] += pa.w * v[j];
                                      w.o[4][j] += pb.x * v[j]; w.o[5][j] += pb.y * v[j]; w.o[6][j] += pb.z * v[j]; w.o[7][j] += pb.w * v[j]; } }
}
__device__ __forceinline__ void dec_page_fox(DecW<64>& w, const bf16x8 (&qa)[2], const float* Kb, const float* Vb, const float* bias, float boff, LAS float* PL, int lane) {
    constexpr int stride = 512;
    const int key = lane & 15, kq = lane >> 4;
    const unsigned koff = (unsigned)(key * stride + 8 * kq) * 4u;
    const int d4 = lane & 15, ksub = lane >> 4;
    const unsigned voff = (unsigned)(ksub * stride + 4 * d4) * 4u;
    const __amdgpu_buffer_rsrc_t krs = __builtin_amdgcn_make_buffer_rsrc((void*)Kb, 0, 0x7fffffff, 0x00020000);
    const __amdgpu_buffer_rsrc_t vrs = __builtin_amdgcn_make_buffer_rsrc((void*)Vb, 0, 0x7fffffff, 0x00020000);
    const __amdgpu_buffer_rsrc_t brs = __builtin_amdgcn_make_buffer_rsrc((void*)bias, 0, 0x7fffffff, 0x00020000);
    f32x4 s[8];
#pragma unroll
    for (int hb = 0; hb < 2; ++hb) {
        f32x4 kx[4][4];
#pragma unroll
        for (int t = 0; t < 4; ++t) { const int so = (hb * 4 + t) * 16 * stride * 4;
            kx[t][0] = __builtin_bit_cast(f32x4, __builtin_amdgcn_raw_buffer_load_b128(krs, (int)koff, so, 0)); kx[t][1] = __builtin_bit_cast(f32x4, __builtin_amdgcn_raw_buffer_load_b128(krs, (int)koff + 16, so, 0));
            kx[t][2] = __builtin_bit_cast(f32x4, __builtin_amdgcn_raw_buffer_load_b128(krs, (int)koff + 128, so, 0)); kx[t][3] = __builtin_bit_cast(f32x4, __builtin_amdgcn_raw_buffer_load_b128(krs, (int)koff + 144, so, 0)); }
#pragma unroll
        for (int t = 0; t < 4; ++t) {
            f32x4 acc = {0.f, 0.f, 0.f, 0.f};
#pragma unroll
            for (int ks = 0; ks < 2; ++ks) { const f32x4 x0 = kx[t][2 * ks], x1 = kx[t][2 * ks + 1];
                v4u kb; kb.x = pg8::cvt_pk_bf16(x0.x, x0.y); kb.y = pg8::cvt_pk_bf16(x0.z, x0.w); kb.z = pg8::cvt_pk_bf16(x1.x, x1.y); kb.w = pg8::cvt_pk_bf16(x1.z, x1.w);
                acc = __builtin_amdgcn_mfma_f32_16x16x32_bf16(qa[ks], __builtin_bit_cast(bf16x8, kb), acc, 0, 0, 0); }
            acc += (__builtin_bit_cast(float, __builtin_amdgcn_raw_buffer_load_b32(brs, key * 4, (hb * 4 + t) * 64, 0)) + boff) * LOG2E;
            s[hb * 4 + t] = acc;
        }
        asm volatile("" ::: "memory");
    }
    f32x4 mc = s[0];
#pragma unroll
    for (int t = 1; t < 8; ++t) { mc.x = fmaxf(mc.x, s[t].x); mc.y = fmaxf(mc.y, s[t].y); mc.z = fmaxf(mc.z, s[t].z); mc.w = fmaxf(mc.w, s[t].w); }
#pragma unroll
    for (int o = 1; o < 16; o <<= 1) { mc.x = fmaxf(mc.x, __shfl_xor(mc.x, o)); mc.y = fmaxf(mc.y, __shfl_xor(mc.y, o)); mc.z = fmaxf(mc.z, __shfl_xor(mc.z, o)); mc.w = fmaxf(mc.w, __shfl_xor(mc.w, o)); }
    float al[4];
#pragma unroll
    for (int i = 0; i < 4; ++i) { const float mn = fmaxf(w.m[i], mc[i]); al[i] = fexp2(w.m[i] - mn); w.m[i] = mn; w.l[i] *= al[i]; }
    bool nz = false;
#pragma unroll
    for (int t = 0; t < 8; ++t) { f32x4 p;
#pragma unroll
        for (int i = 0; i < 4; ++i) { p[i] = fexp2(s[t][i] - w.m[i]); w.l[i] += p[i]; nz = nz || (p[i] != 0.f); }
        if (kq < 2) *(LAS f32x4*)(PL + (t * 16 + key) * 8 + 4 * kq) = p; }
    if (__ballot(nz && kq < 2) == 0ull) return;
    if (key == 0 && kq < 2) *(LAS f32x4*)(PL + 1024 + 4 * kq) = (f32x4){al[0], al[1], al[2], al[3]};
    { const f32x4 a0 = *(const LAS f32x4*)(PL + 1024), a1 = *(const LAS f32x4*)(PL + 1028);
#pragma unroll
      for (int j = 0; j < 4; ++j) { w.o[0][j] *= a0.x; w.o[1][j] *= a0.y; w.o[2][j] *= a0.z; w.o[3][j] *= a0.w; w.o[4][j] *= a1.x; w.o[5][j] *= a1.y; w.o[6][j] *= a1.z; w.o[7][j] *= a1.w; } }
#pragma unroll 1
    for (int vh = 0; vh < 2; ++vh) {
    f32x4 vx[16];
#pragma unroll
    for (int kk = 0; kk < 16; ++kk) vx[kk] = __builtin_bit_cast(f32x4, __builtin_amdgcn_raw_buffer_load_b128(vrs, (int)voff, (vh * 16 + kk) * 4 * stride * 4, 0));
#pragma unroll
    for (int kk = 0; kk < 16; ++kk) { const int k = (vh * 16 + kk) * 4 + ksub;
        const f32x4 v = vx[kk];
        const f32x4 pa = *(const LAS f32x4*)(PL + k * 8), pb = *(const LAS f32x4*)(PL + k * 8 + 4);
#pragma unroll
        for (int j = 0; j < 4; ++j) { w.o[0][j] += pa.x * v[j]; w.o[1][j] += pa.y * v[j]; w.o[2][j] += pa.z * v[j]; w.o[3][j] += pa.w * v[j];
                                      w.o[4][j] += pb.x * v[j]; w.o[5][j] += pb.y * v[j]; w.o[6][j] += pb.z * v[j]; w.o[7][j] += pb.w * v[j]; } }
    }
}
template <int D>
__device__ __forceinline__ void dec_park(DecW<D>& w, LAS float* CBw, int lane) {
    constexpr int LPK = D / 4;
    const int key = lane & 15, kq = lane >> 4, d4 = lane % LPK, ksub = lane / LPK;
#pragma unroll
    for (int i = 0; i < 4; ++i) { float l = w.l[i];
#pragma unroll
        for (int o = 1; o < 16; o <<= 1) l += __shfl_xor(l, o);
        w.l[i] = l; }
    if (key == 0 && kq < 2) { *(LAS f32x4*)(CBw + 4 * kq) = (f32x4){w.m[0], w.m[1], w.m[2], w.m[3]}; *(LAS f32x4*)(CBw + 8 + 4 * kq) = (f32x4){w.l[0], w.l[1], w.l[2], w.l[3]}; }
#pragma unroll
    for (int q = 0; q < 8; ++q) { f32x4 v = (f32x4){w.o[q][0], w.o[q][1], w.o[q][2], w.o[q][3]};
        if (LPK < 64) {
#pragma unroll
            for (int o = LPK; o < 64; o <<= 1) { v.x += __shfl_xor(v.x, o); v.y += __shfl_xor(v.y, o); v.z += __shfl_xor(v.z, o); v.w += __shfl_xor(v.w, o); } }
        if (ksub == 0) *(LAS f32x4*)(CBw + 16 + q * D + 4 * d4) = v; }
}
template <int D>
__device__ __forceinline__ void dec_combine(int tid, LAS float* CB, bf16* dst, int ldd) {
    constexpr int WSTR = 16 + 8 * D;
    for (int e = tid; e < 8 * D; e += NTHR) { const int q = e / D, d = e % D;
        float mt = -INFINITY;
#pragma unroll
        for (int w = 0; w < 8; ++w) mt = fmaxf(mt, CB[w * WSTR + q]);
        float num = 0.f, den = 0.f;
#pragma unroll
        for (int w = 0; w < 8; ++w) { const float mw = CB[w * WSTR + q]; const float f = (mw == -INFINITY) ? 0.f : fexp2(mw - mt); num += f * CB[w * WSTR + 16 + q * D + d]; den += f * CB[w * WSTR + 8 + q]; }
        dst[(size_t)q * ldd + d] = (bf16)f2bf(num / den); }
}
template <int D>
__device__ __forceinline__ void dec_load_q(bf16x8 (&qa)[D / 32], const bf16* Q, int ldq, int lane) {
    const int row = lane & 15, kq = lane >> 4;
#pragma unroll
    for (int ks = 0; ks < D / 32; ++ks) { v4u z = {0u, 0u, 0u, 0u}; if (row < 8) z = *(const v4u*)(Q + (size_t)row * ldq + 32 * ks + 8 * kq); qa[ks] = __builtin_bit_cast(bf16x8, z); }
}
constexpr int DEC_PL = 1040;
__device__ __forceinline__ void fox_sample_unit(const Frame& F, const Args& a, int u) {
    unsigned char* ws = a.ws; const int bs = u >> 3, h = u & 7;
    int ln = lane_id(); asm volatile("" : "+v"(ln));
    LAS float* PL = (LAS float*)F.lds + F.wave * DEC_PL; LAS float* CB = (LAS float*)F.lds + 8 * DEC_PL; constexpr int WSTR = 16 + 8 * 64;
    bf16x8 qa[2]; dec_load_q<64>(qa, (const bf16*)(ws + WS_QF) + (size_t)(TP + bs * LS) * 512 + h * 64, 512, ln);
    DecW<64> w; dec_init(w);
    {
        const int key = ln & 15; const float* lf = a.out + O_LFS + (size_t)(bs * LS) * 8 + h; float cn = 0.f;
#pragma unroll
        for (int j = 0; j < 8; ++j) { const float x = lf[j * 8]; cn += (j <= key) ? x : 0.f; }
        const float* Kb = a.out + O_FKS + (size_t)(bs * LS) * 512 + h * 64; const float* Vb = a.out + O_FVS + (size_t)(bs * LS) * 512 + h * 64;
        dec_chunk<64, 1, 1>(w, qa, Kb, Vb, 512, nullptr, -cn * LOG2E, PL, ln);
        if (F.wave != 0) {
#pragma unroll
            for (int i = 0; i < 4; ++i) w.l[i] = 0.f;
#pragma unroll
            for (int q = 0; q < 8; ++q)
#pragma unroll
                for (int j = 0; j < 4; ++j) w.o[q][j] = 0.f; }
    }
    const int* pt = (const int*)a.in[I_PT];
    float spx; { const float ptv = (ln < 16) ? ((const float*)(ws + WS_MISC + 2 * MiB))[(bs * 8 + h) * NPAGES + ln] : 0.f; float v = ptv;
#pragma unroll
        for (int o = 1; o < 16; o <<= 1) { const float t = __builtin_bit_cast(float, __builtin_amdgcn_ds_bpermute((ln + o) << 2, __builtin_bit_cast(int, v))); if (ln + o < 16) v += t; }
        spx = v - ptv; }
#if defined(OLD_FOXS)
#pragma unroll 1
    for (int pp = 0; pp < 4; ++pp) { const int p = F.wave * 2 + (pp >> 1), hf = pp & 1; const int pg = __builtin_amdgcn_readfirstlane(pt[bs * NPAGES + p]);
        const float* Kb = (const float*)a.in[I_CFK] + (((size_t)pg * PAGE + hf * 64) * 8 + h) * 64; const float* Vb = (const float*)a.in[I_CFV] + (((size_t)pg * PAGE + hf * 64) * 8 + h) * 64;
        dec_chunk<64, 4, 0>(w, qa, Kb, Vb, 512, (const float*)(ws + WS_SUF) + (size_t)(bs * 8 + h) * PASTL + p * PAGE + hf * 64, __builtin_bit_cast(float, __builtin_amdgcn_ds_bpermute(p << 2, __builtin_bit_cast(int, spx))), PL, ln); }
#else
#pragma unroll 1
    for (int pp = 1; pp >= 0; --pp) { const int p = F.wave * 2 + pp; const int pg = __builtin_amdgcn_readfirstlane(pt[bs * NPAGES + p]);
        const float* Kb = (const float*)a.in[I_CFK] + ((size_t)pg * PAGE * 8 + h) * 64; const float* Vb = (const float*)a.in[I_CFV] + ((size_t)pg * PAGE * 8 + h) * 64;
        dec_page_fox(w, qa, Kb, Vb, (const float*)(ws + WS_SUF) + (size_t)(bs * 8 + h) * PASTL + p * PAGE, __builtin_bit_cast(float, __builtin_amdgcn_ds_bpermute(p << 2, __builtin_bit_cast(int, spx))), PL, ln); }
#endif
    dec_park<64>(w, CB + F.wave * WSTR, ln);
    __syncthreads();
    dec_combine<64>(F.wave * 64 + ln, CB, (bf16*)(ws + WS_MERGED) + (size_t)(TP + bs * LS) * DM + h * 64, DM);
    __syncthreads();
}
__device__ __forceinline__ void cross_sample_unit(const Frame& F, const Args& a, int u) {
    unsigned char* ws = a.ws; const int bs = u >> 2, h = u & 3;
    LAS float* PL = (LAS float*)F.lds + F.wave * DEC_PL; LAS float* CB = (LAS float*)F.lds + 8 * DEC_PL; constexpr int WSTR = 16 + 8 * 256;
    bf16x8 qa[8]; dec_load_q<256>(qa, (const bf16*)(ws + WS_QC) + (size_t)(TP + bs * LS) * DM + h * 256, DM, F.lane);
    DecW<256> w; dec_init(w);
    const float* Kb = (const float*)a.in[I_CMK] + ((size_t)(bs * 256 + F.wave * 32) * 4 + h) * 256; const float* Vb = (const float*)a.in[I_CMV] + ((size_t)(bs * 256 + F.wave * 32) * 4 + h) * 256;
#pragma unroll 1
    for (int c = 0; c < 2; ++c) dec_chunk<256, 1, 0>(w, qa, Kb + (size_t)c * 16 * 1024, Vb + (size_t)c * 16 * 1024, 1024, nullptr, 0.f, PL, F.lane);
    dec_park<256>(w, CB + F.wave * WSTR, F.lane);
    __syncthreads();
    dec_combine<256>(F.tid, CB, (bf16*)(ws + WS_OC) + (size_t)(TP + bs * LS) * DM + h * 256, DM);
    __syncthreads();
}


__device__ __forceinline__ void gla_g3_unit(const Frame& F, const Args& a, int u) {
    unsigned char* ws = a.ws;
    const int b = u >> 9, h = (u >> 7) & 3, n = u & 127; const int row0 = b * SEQ + n * 64;
    LAS float* QDT = (LAS float*)F.lds; LAS float* KIT = QDT + 4352; LAS float* LA = KIT + 4352; LAS float* ATT = LA; LAS float* VS = LA + 4352; LAS float* SP = VS + 8192;
#pragma unroll
    for (int i = 0; i < 16; ++i) { const int e = F.tid + NTHR * i; VS[e] = ((const float*)(ws + WS_GV))[(size_t)(row0 + (e >> 7)) * 512 + h * 128 + (e & 127)];
        SP[e] = ((const float*)(ws + WS_GKV))[((size_t)((b * 4 + h) * 128 + n) * 64) * 128 + e]; }
#pragma unroll
    for (int i = 0; i < 8; ++i) { const int e = F.tid + NTHR * i, t = e >> 6, dk = e & 63; const size_t gi = (size_t)(row0 + t) * 256 + h * 64 + dk;
        const float bb = ((const float*)(ws + WS_BB))[gi];
        QDT[dk * 68 + t] = ((const float*)(ws + WS_GQ))[gi] * __expf(bb); KIT[dk * 68 + t] = ((const float*)(ws + WS_GK))[gi] * __expf(-bb); }
    __syncthreads();
    {
        const int tp = F.tid & 31, sq = F.tid >> 5; float acc[2][4];
#pragma unroll
        for (int i = 0; i < 2; ++i)
#pragma unroll
            for (int j = 0; j < 4; ++j) acc[i][j] = 0.f;
        if (4 * sq <= 2 * tp + 1) {
#pragma unroll 8
            for (int dk = 0; dk < 64; ++dk) { const f32x2 q2 = *(const LAS f32x2*)(QDT + dk * 68 + 2 * tp); const f32x4 k4 = *(const LAS f32x4*)(KIT + dk * 68 + 4 * sq);
#pragma unroll
                for (int j = 0; j < 4; ++j) { acc[0][j] += q2.x * k4[j]; acc[1][j] += q2.y * k4[j]; } }
        }
#pragma unroll
        for (int j = 0; j < 4; ++j) { const int s = 4 * sq + j; f32x2 o; o.x = (s <= 2 * tp) ? acc[0][j] : 0.f; o.y = (s <= 2 * tp + 1) ? acc[1][j] : 0.f; *(LAS f32x2*)(ATT + s * 68 + 2 * tp) = o; }
    }
    __syncthreads();
    {
        const int dvq = F.tid & 31, tq = F.tid >> 5; float acc[4][4];
#pragma unroll
        for (int i = 0; i < 4; ++i)
#pragma unroll
            for (int j = 0; j < 4; ++j) acc[i][j] = 0.f;
#pragma unroll 8
        for (int s = 0; s < 64; ++s) { const f32x4 v4 = *(const LAS f32x4*)(VS + s * 128 + 4 * dvq), a4 = *(const LAS f32x4*)(ATT + s * 68 + 4 * tq);
#pragma unroll
            for (int i = 0; i < 4; ++i)
#pragma unroll
                for (int j = 0; j < 4; ++j) acc[i][j] += a4[i] * v4[j]; }
#pragma unroll 8
        for (int dk = 0; dk < 64; ++dk) { const f32x4 v4 = *(const LAS f32x4*)(SP + dk * 128 + 4 * dvq), a4 = *(const LAS f32x4*)(QDT + dk * 68 + 4 * tq);
#pragma unroll
            for (int i = 0; i < 4; ++i)
#pragma unroll
                for (int j = 0; j < 4; ++j) acc[i][j] += a4[i] * v4[j]; }
        __syncthreads();
#pragma unroll
        for (int i = 0; i < 4; ++i) *(LAS f32x4*)(VS + (4 * tq + i) * 128 + 4 * dvq) = (f32x4){acc[i][0], acc[i][1], acc[i][2], acc[i][3]};
    }
    __syncthreads();
#pragma unroll
    for (int rr = 0; rr < 8; ++rr) { const int t = F.wave * 8 + rr; const float v0 = VS[t * 128 + F.lane], v1 = VS[t * 128 + 64 + F.lane];
        const float r = rsqrtf(wave_sum(v0 * v0 + v1 * v1) * (1.f / 128.f) + EPS);
        const float* ggo = (const float*)a.in[I_GGO] + h * 128; const float* gr = (const float*)(ws + WS_GR) + (size_t)(row0 + t) * 512 + h * 128;
        bf16* mo = (bf16*)(ws + WS_MERGED) + (size_t)(row0 + t) * DM + 512 + h * 128;
        mo[F.lane] = (bf16)f2bf(v0 * r * ggo[F.lane] * silu(gr[F.lane])); mo[64 + F.lane] = (bf16)f2bf(v1 * r * ggo[64 + F.lane] * silu(gr[64 + F.lane])); }
    __syncthreads();
}

struct EpiSoftmaxP {
    static constexpr bool PERM = false, AFTER_DRAIN = true;
    const LAS unsigned long long* argp;
    __device__ __forceinline__ void fused(f32x4 (&acc)[2][2][4][2], const Unit&, int wr, int wc, int fr, int fq, PG8_LAS unsigned char* lds, int wid, int lane) const {
        LAS float* PM = (LAS float*)lds; LAS float* PS = PM + 1024;
        const int ub = (int)blockIdx.x; const int ldp = DM;
        bf16* P = (bf16*)((unsigned char*)ld_ptr(argp + N_INPUTS + 1) + WS_PC) + ((size_t)((ub >> 7) & 1) * SEQ + (ub & 31) * 256) * DM + ((ub >> 5) & 3) * 256;
        { int t2 = lane_id(); asm volatile("" : "+v"(t2)); fr = t2 & 15; fq = (t2 >> 4) & 3; }
#pragma unroll
        for (int ai = 0; ai < 2; ++ai)
#pragma unroll
            for (int m = 0; m < 4; ++m) { float mx = -INFINITY;
#pragma unroll
                for (int bj = 0; bj < 2; ++bj)
#pragma unroll
                    for (int n = 0; n < 2; ++n) { const f32x4 x = acc[ai][bj][m][n]; mx = fmaxf(mx, fmaxf(fmaxf(x[0], x[1]), fmaxf(x[2], x[3]))); }
                mx = fmaxf(mx, __shfl_xor(mx, 16)); mx = fmaxf(mx, __shfl_xor(mx, 32));
                if (fq == 0) PM[(ai * 128 + wr * 64 + m * 16 + fr) * 4 + wc] = mx; }
        asm volatile("s_waitcnt lgkmcnt(0)" ::: "memory"); __builtin_amdgcn_s_barrier(); asm volatile("" ::: "memory");
#pragma unroll
        for (int ai = 0; ai < 2; ++ai)
#pragma unroll
            for (int m = 0; m < 4; ++m) { const int r = ai * 128 + wr * 64 + m * 16 + fr; const f32x4 pm = *(const LAS f32x4*)(PM + r * 4);
                const float M = fmaxf(fmaxf(pm[0], pm[1]), fmaxf(pm[2], pm[3])); float s = 0.f;
#pragma unroll
                for (int bj = 0; bj < 2; ++bj)
#pragma unroll
                    for (int n = 0; n < 2; ++n) { f32x4 x = acc[ai][bj][m][n]; x[0] = fexp2(x[0] - M); x[1] = fexp2(x[1] - M); x[2] = fexp2(x[2] - M); x[3] = fexp2(x[3] - M); acc[ai][bj][m][n] = x; s += (x[0] + x[1]) + (x[2] + x[3]); }
                s += __shfl_xor(s, 16); s += __shfl_xor(s, 32);
                if (fq == 0) PS[r * 4 + wc] = s; }
        asm volatile("s_waitcnt lgkmcnt(0)" ::: "memory"); __builtin_amdgcn_s_barrier(); asm volatile("" ::: "memory");
#pragma unroll
        for (int ai = 0; ai < 2; ++ai)
#pragma unroll
            for (int m = 0; m < 4; ++m) { const int r = ai * 128 + wr * 64 + m * 16 + fr; const f32x4 ps = *(const LAS f32x4*)(PS + r * 4); const float inv = 1.f / ((ps[0] + ps[1]) + (ps[2] + ps[3]));
#pragma unroll
                for (int bj = 0; bj < 2; ++bj)
#pragma unroll
                    for (int n = 0; n < 2; ++n) { const f32x4 x = acc[ai][bj][m][n]; v2u o; o.x = pg8::cvt_pk_bf16(x[0] * inv, x[1] * inv); o.y = pg8::cvt_pk_bf16(x[2] * inv, x[3] * inv);
                        *(v2u*)(P + (size_t)r * ldp + bj * 128 + wc * 32 + n * 16 + fq * 4) = o; } }
        asm volatile("s_waitcnt lgkmcnt(0)" ::: "memory"); __builtin_amdgcn_s_barrier(); asm volatile("" ::: "memory");
    }
};

__device__ __forceinline__ void rms_rows_phase(const Frame& F, const float* X, const float* g, bf16* H) {
    const int gw = F.vcu * NWAVES + F.wave, NGW = F.G * NWAVES;
    for (int m = gw; m < TA; m += NGW) rms_row_bf16(X + (size_t)m * DM, g, H + (size_t)m * DM, F.lane);
}

__device__ __forceinline__ unsigned f2sort(float f) { const unsigned u = __builtin_bit_cast(unsigned, f); return u ^ ((u >> 31) ? 0xFFFFFFFFu : 0x80000000u); }
__device__ __forceinline__ float sort2f(unsigned s) { const unsigned u = s ^ ((s >> 31) ? 0x80000000u : 0xFFFFFFFFu); return __builtin_bit_cast(float, u); }
__device__ __forceinline__ float gelu_tanh(float x) { const float y = 0.7978845608028654f * (x + 0.044715f * x * x * x); const float e = __expf(2.f * y); return 0.5f * x * (1.f + (1.f - 2.f / (e + 1.f))); }
__device__ __forceinline__ unsigned gmax16(unsigned v) {
#pragma unroll
    for (int o = 1; o < 16; o <<= 1) { const unsigned t = (unsigned)__shfl_xor((int)v, o); v = v > t ? v : t; }
    return v;
}
typedef __bf16 bf16x2_t __attribute__((ext_vector_type(2)));
__device__ __forceinline__ float dot2bf(unsigned a, unsigned b, float c) {
#if __has_builtin(__builtin_amdgcn_fdot2_f32_bf16)
    return __builtin_amdgcn_fdot2_f32_bf16(__builtin_bit_cast(bf16x2_t, a), __builtin_bit_cast(bf16x2_t, b), c, false);
#else
    return c + bflo(a) * bflo(b) + bfhi(a) * bfhi(b);
#endif
}
template <bool SPLIT>
__device__ __forceinline__ void peer_token(const Frame& F, const Args& a, int row, LAS unsigned* TOPS, int ci0, int cj0, int ci1, int cj1, int ci2, int cj2, int ci3, int cj3, bool cv3, int half, LAS float* PART) {
    unsigned char* ws = a.ws; const int lane = F.lane, grp = lane >> 4, j16 = lane & 15;
    const bf16* sc = (const bf16*)(ws + WS_SC) + (size_t)row * 2048;
#pragma unroll 1
    for (int bt = 0; bt < 4; ++bt) {
        const v4u xq = *(const v4u*)(sc + (bt * 4 + grp) * 128 + 8 * j16);
        unsigned k[8]; const float xs[8] = {bflo(xq.x), bfhi(xq.x), bflo(xq.y), bfhi(xq.y), bflo(xq.z), bfhi(xq.z), bflo(xq.w), bfhi(xq.w)};
#pragma unroll
        for (int e = 0; e < 8; ++e) k[e] = (f2sort(xs[e]) & ~127u) | (unsigned)(127 - (8 * j16 + e));
        unsigned mine = 0u;
#pragma unroll 1
        for (int r = 0; r < 16; ++r) {
            unsigned m = k[0];
#pragma unroll
            for (int e = 1; e < 8; ++e) m = m > k[e] ? m : k[e];
            m = gmax16(m);
            if (j16 == r) mine = m;
#pragma unroll
            for (int e = 0; e < 8; ++e) k[e] = (k[e] == m) ? 0u : k[e];
        }
        TOPS[(bt * 4 + grp) * 16 + j16] = mine;
    }
    int ex[2]; float gx[2], sux[2];
#pragma unroll
    for (int ps = 0; ps < 2; ++ps) {
        const int hd = ps * 4 + grp; const LAS unsigned* T1 = TOPS + (2 * hd) * 16; const LAS unsigned* T2 = T1 + 16;
        unsigned k[4];
        { const float s0 = sort2f(T1[ci0] & ~127u) + sort2f(T2[cj0] & ~127u), s1 = sort2f(T1[ci1] & ~127u) + sort2f(T2[cj1] & ~127u),
                      s2 = sort2f(T1[ci2] & ~127u) + sort2f(T2[cj2] & ~127u), s3 = sort2f(T1[ci3] & ~127u) + sort2f(T2[cj3] & ~127u);
          k[0] = (f2sort(s0) & ~127u) | (unsigned)(127 - j16); k[1] = (f2sort(s1) & ~127u) | (unsigned)(127 - (j16 + 16)); k[2] = (f2sort(s2) & ~127u) | (unsigned)(127 - (j16 + 32));
          k[3] = cv3 ? ((f2sort(s3) & ~127u) | (unsigned)(127 - (j16 + 48))) : 0u; }
        unsigned mine = 0u;
#pragma unroll 1
        for (int r = 0; r < 16; ++r) {
            unsigned m = k[0] > k[1] ? k[0] : k[1]; const unsigned m2 = k[2] > k[3] ? k[2] : k[3]; m = m > m2 ? m : m2;
            m = gmax16(m);
            if (j16 == r) mine = m;
#pragma unroll
            for (int e = 0; e < 4; ++e) k[e] = (k[e] == m) ? 0u : k[e];
        }
        const int c = 127 - (int)(mine & 127u);
        int ci, cj;
        if (c < 16) { ci = 0; cj = c; } else if (c < 24) { ci = 1; cj = c - 16; } else if (c < 29) { ci = 2; cj = c - 24; } else if (c < 33) { ci = 3; cj = c - 29; }
        else if (c < 36) { ci = 4; cj = c - 33; } else if (c < 38) { ci = 5; cj = c - 36; } else if (c < 40) { ci = 6; cj = c - 38; } else if (c < 42) { ci = 7; cj = c - 40; } else { ci = c - 34; cj = 0; }
        const int i1 = 127 - (int)(T1[ci] & 127u), i2 = 127 - (int)(T2[cj] & 127u);
        ex[ps] = i1 * 128 + i2;
        const float sv = sort2f(mine & ~127u); const float s0 = __shfl(sv, lane & 48);
        float ee = __expf(sv - s0); float es = ee;
#pragma unroll
        for (int o = 1; o < 16; o <<= 1) es += __shfl_xor(es, o);
        const float* rsc = (const float*)(ws + WS_MISC);
        sux[ps] = rsc[ex[ps]]; gx[ps] = ee / es * rsc[16384 + ex[ps]];
    }
    {
        unsigned k0 = ((unsigned)ex[0] << 7) | (unsigned)lane, k1 = ((unsigned)ex[1] << 7) | (unsigned)(64 + lane);
#pragma unroll
        for (int k = 2; k <= 128; k <<= 1) {
#pragma unroll
            for (int j = k >> 1; j > 0; j >>= 1) {
                if (j == 64) { const unsigned lo = k0 < k1 ? k0 : k1, hi = k0 < k1 ? k1 : k0; k0 = lo; k1 = hi; }
                else {
                    const unsigned p0 = (unsigned)__shfl_xor((int)k0, j), p1 = (unsigned)__shfl_xor((int)k1, j);
                    const bool low = (lane & j) == 0; const bool asc0 = (lane & k) == 0, asc1 = ((64 + lane) & k) == 0;
                    const unsigned mn0 = k0 < p0 ? k0 : p0, mx0 = k0 < p0 ? p0 : k0, mn1 = k1 < p1 ? k1 : p1, mx1 = k1 < p1 ? p1 : k1;
                    k0 = (low == asc0) ? mn0 : mx0; k1 = (low == asc1) ? mn1 : mx1;
                }
            }
        }
        const int o0 = (int)(k0 & 127u), o1 = (int)(k1 & 127u);
        const float g0a = __shfl(gx[0], o0 & 63), g0b = __shfl(gx[1], o0 & 63), g1a = __shfl(gx[0], o1 & 63), g1b = __shfl(gx[1], o1 & 63);
        const float s0a = __shfl(sux[0], o0 & 63), s0b = __shfl(sux[1], o0 & 63), s1a = __shfl(sux[0], o1 & 63), s1b = __shfl(sux[1], o1 & 63);
        gx[0] = (o0 & 64) ? g0b : g0a; gx[1] = (o1 & 64) ? g1b : g1a; sux[0] = (o0 & 64) ? s0b : s0a; sux[1] = (o1 & 64) ? s1b : s1a;
        ex[0] = (int)(k0 >> 7); ex[1] = (int)(k1 >> 7);
    }
    const float rstd2 = rsqrtf(((const float*)(ws + WS_SS))[TA + row] * (1.f / 1024.f) + EPS);
    float hf[16];
    { const v4u* hp = (const v4u*)((const bf16*)(ws + WS_HB) + (size_t)row * DM + 16 * lane); const v4u h0 = hp[0], h1 = hp[1];
#pragma unroll
      for (int q = 0; q < 4; ++q) { hf[2 * q] = bflo(h0[q]); hf[2 * q + 1] = bfhi(h0[q]); hf[8 + 2 * q] = bflo(h1[q]); hf[8 + 2 * q + 1] = bfhi(h1[q]); } }
    float oacc[16];
#pragma unroll
    for (int i = 0; i < 16; ++i) oacc[i] = 0.f;
    const unsigned char* U = ws + WS_U16; const unsigned char* V = ws + WS_V16;
    v4u ub[8], vb[8];
    const int gbeg = SPLIT ? 8 * half : 0, gend = SPLIT ? 8 * half + 8 : 16;
    { const int ex0 = (gbeg < 8) ? ex[0] : ex[1];
#pragma unroll
      for (int i = 0; i < 8; ++i) { const int e = __builtin_amdgcn_readlane(ex0, i); ub[i] = *(const v4u*)(U + (size_t)e * DM + 16 * lane); } }
#pragma unroll 1
    for (int g8 = gbeg; g8 < gend; ++g8) {
        const int kb = g8 * 8; const int exs = (kb < 64) ? ex[0] : ex[1]; const float gxs = (kb < 64) ? gx[0] : gx[1]; const float sus = (kb < 64) ? sux[0] : sux[1];
#pragma unroll
        for (int i = 0; i < 8; ++i) { const int e = __builtin_amdgcn_readlane(exs, (kb & 63) + i); vb[i] = *(const v4u*)(V + (size_t)e * DM + 16 * lane); }
        float av[8];
#pragma unroll
        for (int i = 0; i < 8; ++i) { float s = 0.f;
#pragma unroll
            for (int q = 0; q < 4; ++q) { const f32x2 lo = __builtin_amdgcn_cvt_pk_f32_fp8((int)ub[i][q], false), hi = __builtin_amdgcn_cvt_pk_f32_fp8((int)ub[i][q], true);
                s += lo.x * hf[4 * q]; s += lo.y * hf[4 * q + 1]; s += hi.x * hf[4 * q + 2]; s += hi.y * hf[4 * q + 3]; }
            av[i] = s; }
        const bool b5 = lane & 32, b4 = lane & 16, b3 = lane & 8;
        float bq[4], cq[2], dq;
#pragma unroll
        for (int i = 0; i < 4; ++i) bq[i] = (b5 ? av[4 + i] : av[i]) + __shfl_xor(b5 ? av[i] : av[4 + i], 32);
#pragma unroll
        for (int i = 0; i < 2; ++i) cq[i] = (b4 ? bq[2 + i] : bq[i]) + __shfl_xor(b4 ? bq[i] : bq[2 + i], 16);
        dq = (b3 ? cq[1] : cq[0]) + __shfl_xor(b3 ? cq[0] : cq[1], 8);
        dq += __shfl_xor(dq, 4); dq += __shfl_xor(dq, 2); dq += __shfl_xor(dq, 1);
        const int src = (kb & 63) + (lane >> 3);
#if defined(PROBE_NOPEER)
        const float wmine = 0.f * __shfl(gxs, src) * gelu_tanh(dq * __shfl(sus, src));
#else
        const float wmine = __shfl(gxs, src) * gelu_tanh(dq * __shfl(sus, src) * rstd2);
#endif
        if (g8 + 1 < gend) { const int kn = kb + 8; const int exn = (kn < 64) ? ex[0] : ex[1];
#pragma unroll
            for (int i = 0; i < 8; ++i) { const int e = __builtin_amdgcn_readlane(exn, (kn & 63) + i); ub[i] = *(const v4u*)(U + (size_t)e * DM + 16 * lane); } }
#pragma unroll
        for (int i = 0; i < 8; ++i) { const float w = __builtin_bit_cast(float, __builtin_amdgcn_readlane(__builtin_bit_cast(int, wmine), 8 * i));
#pragma unroll
            for (int q = 0; q < 4; ++q) { const f32x2 lo = __builtin_amdgcn_cvt_pk_f32_fp8((int)vb[i][q], false), hi = __builtin_amdgcn_cvt_pk_f32_fp8((int)vb[i][q], true);
                oacc[4 * q] += w * lo.x; oacc[4 * q + 1] += w * lo.y; oacc[4 * q + 2] += w * hi.x; oacc[4 * q + 3] += w * hi.y; } }
    }
    if (SPLIT) {
        if (half == 1) {
#pragma unroll
            for (int q = 0; q < 4; ++q) *(LAS f32x4*)(PART + 16 * lane + 4 * q) = (f32x4){oacc[4 * q], oacc[4 * q + 1], oacc[4 * q + 2], oacc[4 * q + 3]}; }
        __syncthreads();
        if (half == 1) return;
#pragma unroll
        for (int q = 0; q < 4; ++q) { const f32x4 p = *(const LAS f32x4*)(PART + 16 * lane + 4 * q); oacc[4 * q] += p.x; oacc[4 * q + 1] += p.y; oacc[4 * q + 2] += p.z; oacc[4 * q + 3] += p.w; }
    }
    const f32x4* x2 = (const f32x4*)((const float*)(ws + WS_X2) + (size_t)row * DM + 16 * lane);
    f32x4 xv[4]; float ss = 0.f;
#pragma unroll
    for (int q = 0; q < 4; ++q) { xv[q] = x2[q]; xv[q].x += oacc[4 * q]; xv[q].y += oacc[4 * q + 1]; xv[q].z += oacc[4 * q + 2]; xv[q].w += oacc[4 * q + 3]; ss += (xv[q].x * xv[q].x + xv[q].y * xv[q].y) + (xv[q].z * xv[q].z + xv[q].w * xv[q].w); }
    const float r = rsqrtf(wave_sum(ss) * (1.f / DM) + EPS);
    const f32x4* gf = (const f32x4*)((const float*)a.in[I_GFIN] + 16 * lane);
    f32x4* y = (f32x4*)((row < TP ? a.out + O_YP + (size_t)row * DM : a.out + O_YS + (size_t)(row - TP) * DM) + 16 * lane);
#pragma unroll
    for (int q = 0; q < 4; ++q) { const f32x4 g4 = gf[q]; f32x4 o; o.x = xv[q].x * r * g4.x; o.y = xv[q].y * r * g4.y; o.z = xv[q].z * r * g4.z; o.w = xv[q].w * r * g4.w; y[q] = o; }
}
__device__ __forceinline__ void cand_ij(int c, int& ci, int& cj) {
    if (c < 16) { ci = 0; cj = c; } else if (c < 24) { ci = 1; cj = c - 16; } else if (c < 29) { ci = 2; cj = c - 24; } else if (c < 33) { ci = 3; cj = c - 29; }
    else if (c < 36) { ci = 4; cj = c - 33; } else if (c < 38) { ci = 5; cj = c - 36; } else if (c < 40) { ci = 6; cj = c - 38; } else if (c < 42) { ci = 7; cj = c - 40; } else if (c < 50) { ci = c - 34; cj = 0; } else { ci = 0; cj = 0; }
}
__device__ __forceinline__ void peer_phase(const Frame& F, const Args& a) {
    LAS unsigned* TOPS = (LAS unsigned*)F.lds + F.wave * 256;
    const int j16 = F.lane & 15; int ci0, cj0, ci1, cj1, ci2, cj2, ci3, cj3;
    cand_ij(j16, ci0, cj0); cand_ij(j16 + 16, ci1, cj1); cand_ij(j16 + 32, ci2, cj2); cand_ij(j16 + 48, ci3, cj3);
    const bool cv3 = (j16 + 48) < 50;
    const int gw = F.vcu * NWAVES + F.wave, NGW = F.G * NWAVES;
    const int nfull = TA / NGW, rem = TA - nfull * NGW;
#pragma unroll 1
    for (int i = 0; i < nfull; ++i) peer_token<false>(F, a, gw + i * NGW, TOPS, ci0, cj0, ci1, cj1, ci2, cj2, ci3, cj3, cv3, 0, nullptr);
    if (rem == 4 * F.G) {
        __syncthreads();
        peer_token<true>(F, a, nfull * NGW + F.vcu * 4 + (F.wave >> 1), TOPS, ci0, cj0, ci1, cj1, ci2, cj2, ci3, cj3, cv3, F.wave & 1, (LAS float*)F.lds + 8 * 256 + (F.wave >> 1) * 1024);
    } else {
        const int row = gw + nfull * NGW; if (row < TA) peer_token<false>(F, a, row, TOPS, ci0, cj0, ci1, cj1, ci2, cj2, ci3, cj3, cv3, 0, nullptr);
    }
}


template <class EpiS>
__device__ __forceinline__ void skinny_tile(const Frame& F, const bf16* A, int lda, const bf16* Bt, int ldb, int tm, int tn, const EpiS& E) {
    const int lane = F.lane, r32 = lane & 31, hi = lane >> 5, w = F.wave;
    const bf16* ap = A + (size_t)(tm * 64 + r32) * lda + w * 128 + 8 * hi;
    const bf16* bp = Bt + (size_t)(tn * 64 + r32) * ldb + w * 128 + 8 * hi;
    v4u af[2][8], bfr[2][8];
#pragma unroll
    for (int ks = 0; ks < 8; ++ks) {
        af[0][ks] = *(const v4u*)(ap + ks * 16); af[1][ks] = *(const v4u*)(ap + (size_t)32 * lda + ks * 16);
        bfr[0][ks] = *(const v4u*)(bp + ks * 16); bfr[1][ks] = *(const v4u*)(bp + (size_t)32 * ldb + ks * 16); }
    f32x16 acc[2][2];
#pragma unroll
    for (int i = 0; i < 2; ++i)
#pragma unroll
        for (int j = 0; j < 2; ++j) acc[i][j] = f32x16{};
#pragma unroll
    for (int ks = 0; ks < 8; ++ks)
#pragma unroll
        for (int i = 0; i < 2; ++i)
#pragma unroll
            for (int j = 0; j < 2; ++j) acc[i][j] = __builtin_amdgcn_mfma_f32_32x32x16_bf16(__builtin_bit_cast(bf16x8, af[i][ks]), __builtin_bit_cast(bf16x8, bfr[j][ks]), acc[i][j], 0, 0, 0);
    LAS float* PS = (LAS float*)F.lds + w * 4096;
#pragma unroll
    for (int i = 0; i < 2; ++i)
#pragma unroll
        for (int j = 0; j < 2; ++j)
#pragma unroll
            for (int r = 0; r < 16; ++r) PS[(32 * i + crow(r, hi)) * 64 + 32 * j + r32] = acc[i][j][r];
    __syncthreads();
    {
        const int row = F.tid >> 3, c8 = (F.tid & 7) * 8; const LAS float* P0 = (const LAS float*)F.lds + row * 64 + c8;
        f32x4 s0 = *(const LAS f32x4*)P0, s1 = *(const LAS f32x4*)(P0 + 4);
#pragma unroll
        for (int ww = 1; ww < 8; ++ww) { s0 += *(const LAS f32x4*)(P0 + ww * 4096); s1 += *(const LAS f32x4*)(P0 + ww * 4096 + 4); }
        float v[8] = {s0.x, s0.y, s0.z, s0.w, s1.x, s1.y, s1.z, s1.w};
        E(tm * 64 + row, tn * 64 + c8, v, F.tid);
    }
    __syncthreads();
}
struct EpiSk {
    float* d32; int ld32; bf16* d16; int ld16; float sc16;
    const float* res; int ldr;
    const float* gcol; float* ssq; const float* rsq;
    __device__ __forceinline__ void operator()(int row, int col, float (&v)[8], int tid) const {
        if (rsq) { const float rs = rsqrtf(rsq[row] * (1.f / 1024.f) + EPS);
#pragma unroll
            for (int i = 0; i < 8; ++i) v[i] *= rs; }
        if (res) { const f32x4 a = *(const f32x4*)(res + (size_t)row * ldr + col), b = *(const f32x4*)(res + (size_t)row * ldr + col + 4);
            v[0] += a.x; v[1] += a.y; v[2] += a.z; v[3] += a.w; v[4] += b.x; v[5] += b.y; v[6] += b.z; v[7] += b.w; }
        if (d32) { *(f32x4*)(d32 + (size_t)row * ld32 + col) = (f32x4){v[0], v[1], v[2], v[3]}; *(f32x4*)(d32 + (size_t)row * ld32 + col + 4) = (f32x4){v[4], v[5], v[6], v[7]}; }
        if (ssq) { float ss = 0.f;
#pragma unroll
            for (int i = 0; i < 8; ++i) ss += v[i] * v[i];
            ss += __shfl_xor(ss, 1); ss += __shfl_xor(ss, 2); ss += __shfl_xor(ss, 4);
            if ((tid & 7) == 0) atomicAdd(ssq + row, ss); }
        if (d16) { float w8[8];
#pragma unroll
            for (int i = 0; i < 8; ++i) w8[i] = v[i];
            if (gcol) { const f32x4 a = *(const f32x4*)(gcol + col), b = *(const f32x4*)(gcol + col + 4); w8[0] *= a.x; w8[1] *= a.y; w8[2] *= a.z; w8[3] *= a.w; w8[4] *= b.x; w8[5] *= b.y; w8[6] *= b.z; w8[7] *= b.w; }
            v4u o; o.x = pg8::cvt_pk_bf16(w8[0] * sc16, w8[1] * sc16); o.y = pg8::cvt_pk_bf16(w8[2] * sc16, w8[3] * sc16); o.z = pg8::cvt_pk_bf16(w8[4] * sc16, w8[5] * sc16); o.w = pg8::cvt_pk_bf16(w8[6] * sc16, w8[7] * sc16);
            *(v4u*)(d16 + (size_t)row * ld16 + col) = o; }
    }
};


#ifndef PH_MAX
#define PH_MAX 99
#endif
__global__ void __launch_bounds__(NTHR, 2) mega_fwd(Args args) {
    extern __shared__ __attribute__((aligned(16))) unsigned char lds_raw[];
    Frame F;
    F.lds = (LAS unsigned char*)lds_raw;
    F.wave = __builtin_amdgcn_readfirstlane((int)threadIdx.x >> 6); F.lane = lane_id(); F.tid = F.wave * 64 + F.lane;
    F.G = gridDim.x; { const int bx = blockIdx.x; F.vcu = (F.G % 8 == 0) ? (bx % 8) * (F.G / 8) + bx / 8 : bx; }
    volatile LAS unsigned* MISC = (volatile LAS unsigned*)(F.lds + MISC_OFF);
    LAS unsigned long long* ARGP = (LAS unsigned long long*)(F.lds + ARGS_OFF);
    for (int u = F.tid; u < (LDS_BYTES - LDSCTL_OFF) / 4; u += NTHR) ((LAS unsigned*)(F.lds + LDSCTL_OFF))[u] = 0u;
    __syncthreads();
    if (F.tid == 0) {
        ARGP[0] = (unsigned long long)args.in[0];
        ARGP[1] = (unsigned long long)args.in[1];
        ARGP[2] = (unsigned long long)args.in[2];
        ARGP[3] = (unsigned long long)args.in[3];
        ARGP[4] = (unsigned long long)args.in[4];
        ARGP[5] = (unsigned long long)args.in[5];
        ARGP[6] = (unsigned long long)args.in[6];
        ARGP[7] = (unsigned long long)args.in[7];
        ARGP[8] = (unsigned long long)args.in[8];
        ARGP[9] = (unsigned long long)args.in[9];
        ARGP[10] = (unsigned long long)args.in[10];
        ARGP[11] = (unsigned long long)args.in[11];
        ARGP[12] = (unsigned long long)args.in[12];
        ARGP[13] = (unsigned long long)args.in[13];
        ARGP[14] = (unsigned long long)args.in[14];
        ARGP[15] = (unsigned long long)args.in[15];
        ARGP[16] = (unsigned long long)args.in[16];
        ARGP[17] = (unsigned long long)args.in[17];
        ARGP[18] = (unsigned long long)args.in[18];
        ARGP[19] = (unsigned long long)args.in[19];
        ARGP[20] = (unsigned long long)args.in[20];
        ARGP[21] = (unsigned long long)args.in[21];
        ARGP[22] = (unsigned long long)args.in[22];
        ARGP[23] = (unsigned long long)args.in[23];
        ARGP[24] = (unsigned long long)args.in[24];
        ARGP[25] = (unsigned long long)args.in[25];
        ARGP[26] = (unsigned long long)args.in[26];
        ARGP[27] = (unsigned long long)args.in[27];
        ARGP[28] = (unsigned long long)args.in[28];
        ARGP[N_INPUTS] = (unsigned long long)args.out; ARGP[N_INPUTS + 1] = (unsigned long long)args.ws;
    }
    __syncthreads();
    { const XcdBarrier bar0 = xcd_barrier_post((unsigned*)((gu32*)(args.ws + WS_CTL) + CW_BAR), MISC + 8, F.wave); if (F.tid == 0) MISC[10] = bar0.x; }
    __syncthreads();
#define GRID_BAR() do { XcdBarrier bar_; bar_.bar = (unsigned*)((gu32*)((unsigned char*)ld_ptr(ARGP + N_INPUTS + 1) + WS_CTL) + CW_BAR); bar_.x = MISC[10]; bar_.st = MISC + 8; bar_.wave = F.wave; xcd_barrier(bar_); } while (0)
#define PHASE_ARGS const Args A = load_args(ARGP); unsigned char* const ws = A.ws; float* const out = A.out; (void)ws; (void)out; { int l_ = lane_id(); asm volatile("" : "+v"(l_)); F.lane = l_; F.tid = F.wave * 64 + l_; }

    { PHASE_ARGS;
    p0_prologue(F, A);
    }
    GRID_BAR();
#if defined(PROBE_BAR8)
    GRID_BAR(); GRID_BAR(); GRID_BAR(); GRID_BAR(); GRID_BAR(); GRID_BAR(); GRID_BAR(); GRID_BAR();
#endif
#if PH_MAX >= 1
    { PHASE_ARGS;
    {
        pg8::Gemm g{(const bf16*)(ws + WS_HB), (const bf16*)(ws + WS_WIN), DM, DM, DM};
        pg8::StaticOrder S; S.init(TA, N_IN, F.G, (int)blockIdx.x);
        EpiInProj E{out, ws, (const float*)A.in[I_BFF]};
        pg8::gemm_phase(F.lds, g, S, E, F.wave);
    }
    {
        const int off = (TA / 256) * (N_IN / 256) % F.G;
        pg8::Gemm g{(const bf16*)(ws + WS_MB), (const bf16*)(ws + WS_WMK), DM, DM, DM};
        pg8::StaticOrder S; S.init(512, DM, F.G, ((int)blockIdx.x + F.G - off) % F.G);
        EpiGen E{out + O_MKP, DM, (bf16*)(ws + WS_MK16), DM, 1.f, nullptr, nullptr, 0, 0, nullptr, nullptr, nullptr};
        pg8::gemm_phase(F.lds, g, S, E, F.wave);
    }
    {
        const int off = ((TA / 256) * (N_IN / 256) + 8) % F.G;
        pg8::Gemm g{(const bf16*)(ws + WS_MB), (const bf16*)(ws + WS_WMV), DM, DM, DM};
        pg8::StaticOrder S; S.init(512, DM, F.G, ((int)blockIdx.x + F.G - off) % F.G);
        EpiGen E{out + O_MVP, DM, nullptr, 0, 1.f, nullptr, nullptr, 0, 0, nullptr, nullptr, nullptr};
        pg8::gemm_phase(F.lds, g, S, E, F.wave);
    }
    {
        const int off = ((TA / 256) * (N_IN / 256) + 16) % F.G;
        pg8::Gemm g{(const bf16*)(ws + WS_WMV), (const bf16*)(ws + WS_MB), DM, DM, DM};
        pg8::StaticOrder S; S.init(DM, 512, F.G, ((int)blockIdx.x + F.G - off) % F.G);
        EpiGen E{nullptr, 0, (bf16*)(ws + WS_MVT16), 512, 1.f, nullptr, nullptr, 0, 0, nullptr, nullptr, nullptr};
        pg8::gemm_phase(F.lds, g, S, E, F.wave);
    }
    }
    GRID_BAR();
#endif
#if PH_MAX >= 2
    asm volatile("; ===PHASE 2===");
    { PHASE_ARGS;
    {
        const int gw = F.vcu * NWAVES + F.wave, NGW = F.G * NWAVES;
        for (int it = gw; it < 512; it += NGW) fox_norms_item(F, (const bf16*)(ws + WS_QF), (const bf16*)(ws + WS_KF), out + O_LFP, (float*)(ws + WS_MISC + MiB), (float*)(ws + WS_KBIAS), (float*)(ws + WS_MISC + MiB + 65536), it);
        for (int it = gw; it < NB_S * NPAGES; it += NGW) fox_suffix_item(F, (const float*)A.in[I_CFL], (const int*)A.in[I_PT], (float*)(ws + WS_SUF), (float*)(ws + WS_MISC + 2 * MiB), it);
        for (int u = F.vcu; u < 1024; u += F.G) gla_g1_unit(F, A, u);
        for (int u = F.vcu; u < 512; u += F.G) gla_sample_unit(F, A, u);
    }
    }
    GRID_BAR();
#endif
#if PH_MAX >= 3
    asm volatile("; ===PHASE 3===");
    { PHASE_ARGS;
    gla_scan(F, A);
    __syncthreads();
    for (int i = F.vcu; i < 256; i += F.G) { const int bh = i >> 4, s = i & 15;
        fox_attn_unit(F, (const bf16*)(ws + WS_QF), (const bf16*)(ws + WS_KF), (const bf16*)(ws + WS_VF), (const float*)(ws + WS_KBIAS), (const float*)(ws + WS_MISC + MiB + 65536), (const float*)(ws + WS_MISC + MiB), (bf16*)(ws + WS_MERGED), bh >> 3, bh & 7, s);
        fox_attn_unit(F, (const bf16*)(ws + WS_QF), (const bf16*)(ws + WS_KF), (const bf16*)(ws + WS_VF), (const float*)(ws + WS_KBIAS), (const float*)(ws + WS_MISC + MiB + 65536), (const float*)(ws + WS_MISC + MiB), (bf16*)(ws + WS_MERGED), bh >> 3, bh & 7, 31 - s); }
    for (int u = F.vcu; u < 1024; u += F.G) fox_sample_unit(F, A, u);
    }
    GRID_BAR();
#endif
#if PH_MAX >= 4
    asm volatile("; ===PHASE 4===");
    { PHASE_ARGS;
    for (int u = F.vcu; u < 1024; u += F.G) gla_g3_unit(F, A, u);
    }
    GRID_BAR();
#endif
#if PH_MAX >= 5
    asm volatile("; ===PHASE 5===");
    { PHASE_ARGS;
    {
        pg8::Gemm g{(const bf16*)(ws + WS_MERGED), (const bf16*)(ws + WS_WOUT), DM, DM, DM};
        pg8::StaticOrder S; S.init(TP, DM, F.G, (int)blockIdx.x);
        EpiGen E{(float*)(ws + WS_X1), DM, (bf16*)(ws + WS_HB), DM, 1.f, (const float*)A.in[I_XP], (const float*)A.in[I_XS], TP, DM, (const float*)A.in[I_GCROSS], (float*)(ws + WS_SS), nullptr};
        pg8::gemm_phase(F.lds, g, S, E, F.wave);
        __syncthreads();
        EpiSk Es{(float*)(ws + WS_X1) + (size_t)TP * DM, DM, (bf16*)(ws + WS_HB) + (size_t)TP * DM, DM, 1.f, (const float*)A.in[I_XS], DM, (const float*)A.in[I_GCROSS], (float*)(ws + WS_SS) + TP, nullptr};
        for (int t = F.vcu; t < 256; t += F.G) skinny_tile(F, (const bf16*)(ws + WS_MERGED) + (size_t)TP * DM, DM, (const bf16*)(ws + WS_WOUT), DM, t >> 4, t & 15, Es);
    }
    }
    GRID_BAR();
#endif
#if PH_MAX >= 7
    asm volatile("; ===PHASE 7===");
    { PHASE_ARGS;
    {
        pg8::Gemm g{(const bf16*)(ws + WS_HB), (const bf16*)(ws + WS_WCQ), DM, DM, DM};
        pg8::StaticOrder S; S.init(TP, DM, F.G, (int)blockIdx.x);
        EpiGen E{nullptr, 0, (bf16*)(ws + WS_QC), DM, C2C, nullptr, nullptr, 0, 0, nullptr, nullptr, (const float*)(ws + WS_SS)};
        pg8::gemm_phase(F.lds, g, S, E, F.wave);
        __syncthreads();
        EpiSk Es{nullptr, 0, (bf16*)(ws + WS_QC) + (size_t)TP * DM, DM, C2C, nullptr, 0, nullptr, nullptr, (const float*)(ws + WS_SS) + TP};
        for (int t = F.vcu; t < 256; t += F.G) skinny_tile(F, (const bf16*)(ws + WS_HB) + (size_t)TP * DM, DM, (const bf16*)(ws + WS_WCQ), DM, t >> 4, t & 15, Es);
    }
    }
    GRID_BAR();
#endif
#if PH_MAX >= 8
    asm volatile("; ===PHASE 8===");
    { PHASE_ARGS;
    {
        const int u = (int)blockIdx.x, b = (u >> 7) & 1, h = (u >> 5) & 3, pnl = u & 31;
        const size_t roff = ((size_t)b * SEQ + pnl * 256) * DM + h * 256;
        pg8::Gemm g{(const bf16*)(ws + WS_QC) + roff, (const bf16*)(ws + WS_MK16) + (size_t)(b * 256) * DM + h * 256, DM, DM, 256};
        pg8::SingleUnit S{u < 256 ? 1 : 0, {0, 0}};
        EpiSoftmaxP E{ARGP};
        pg8::gemm_phase(F.lds, g, S, E, F.wave);
        VM_WAIT(); __syncthreads();
        {
            pg8::Gemm g2{(const bf16*)(ws + WS_PC) + roff, (const bf16*)(ws + WS_MVT16) + (size_t)(h * 256) * 512 + b * 256, DM, 512, 256};
            EpiGen E2{nullptr, 0, (bf16*)(ws + WS_OC) + roff, DM, 1.f, nullptr, nullptr, 0, 0, nullptr, nullptr, nullptr};
            pg8::gemm_phase(F.lds, g2, S, E2, F.wave);
        }
        __syncthreads();
        for (int v = F.vcu; v < 512; v += F.G) cross_sample_unit(F, A, v);
    }
    }
    GRID_BAR();
#endif
#if PH_MAX >= 10
    asm volatile("; ===PHASE 10===");
    { PHASE_ARGS;
    {
        pg8::Gemm g{(const bf16*)(ws + WS_OC), (const bf16*)(ws + WS_WCO), DM, DM, DM};
        pg8::StaticOrder S; S.init(TP, DM, F.G, (int)blockIdx.x);
        EpiGen E{(float*)(ws + WS_X2), DM, (bf16*)(ws + WS_HB), DM, 1.f, (const float*)(ws + WS_X1), (const float*)(ws + WS_X1), TA, DM, (const float*)A.in[I_GFFN], (float*)(ws + WS_SS) + TA, nullptr};
        pg8::gemm_phase(F.lds, g, S, E, F.wave);
        __syncthreads();
        EpiSk Es{(float*)(ws + WS_X2) + (size_t)TP * DM, DM, (bf16*)(ws + WS_HB) + (size_t)TP * DM, DM, 1.f, (const float*)(ws + WS_X1) + (size_t)TP * DM, DM, (const float*)A.in[I_GFFN], (float*)(ws + WS_SS) + TA + TP, nullptr};
        for (int t = F.vcu; t < 256; t += F.G) skinny_tile(F, (const bf16*)(ws + WS_OC) + (size_t)TP * DM, DM, (const bf16*)(ws + WS_WCO), DM, t >> 4, t & 15, Es);
    }
    }
    GRID_BAR();
#endif
#if PH_MAX >= 12
    asm volatile("; ===PHASE 12===");
    { PHASE_ARGS;
    {
        pg8::Gemm g{(const bf16*)(ws + WS_HB), (const bf16*)(ws + WS_WPK), DM, DM, DM};
        pg8::StaticOrder S; S.init(TP, 2048, F.G, (int)blockIdx.x);
        EpiGen E{nullptr, 0, (bf16*)(ws + WS_SC), 2048, 1.f, nullptr, nullptr, 0, 0, nullptr, nullptr, (const float*)(ws + WS_SS) + TA};
        pg8::gemm_phase(F.lds, g, S, E, F.wave);
        __syncthreads();
        EpiSk Es{nullptr, 0, (bf16*)(ws + WS_SC) + (size_t)TP * 2048, 2048, 1.f, nullptr, 0, nullptr, nullptr, (const float*)(ws + WS_SS) + TA + TP};
        for (int t = F.vcu; t < 512; t += F.G) skinny_tile(F, (const bf16*)(ws + WS_HB) + (size_t)TP * DM, DM, (const bf16*)(ws + WS_WPK), DM, t >> 5, t & 31, Es);
    }
    }
    GRID_BAR();
#endif
#if PH_MAX >= 13
    asm volatile("; ===PHASE 13===");
    { PHASE_ARGS;
    peer_phase(F, A);
    }
#endif
#if PH_MAX < 13
    {   PHASE_ARGS;
        const int gw = F.vcu * NWAVES + F.wave, NGW = F.G * NWAVES;
        for (int m = gw; m < TA; m += NGW) {
            const float* x = m < TP ? (const float*)A.in[I_XP] + (size_t)m * DM : (const float*)A.in[I_XS] + (size_t)(m - TP) * DM;
            float* y = m < TP ? out + O_YP + (size_t)m * DM : out + O_YS + (size_t)(m - TP) * DM;
            for (int j = 0; j < 4; ++j) ((f32x4*)y)[F.lane + 64 * j] = ((const f32x4*)x)[F.lane + 64 * j];
        }
    }
#endif

}

extern "C" void kernel_launch(void* const* d_in, const int* in_sizes, int n_in, void* d_out, int out_size, void* d_ws, size_t ws_size, hipStream_t stream) {
    static int grid = 0;
    if (grid == 0) {
        if (n_in != N_INPUTS || (size_t)out_size != O_TOTAL || ws_size < WS_END) { fprintf(stderr, "kernel_launch: unexpected shapes (n_in %d out %d ws %zu)\n", n_in, out_size, ws_size); grid = -1; return; }
        int dev = 0, cus = 0, per_cu = 0;
        if (hipGetDevice(&dev) != hipSuccess || hipDeviceGetAttribute(&cus, hipDeviceAttributeMultiprocessorCount, dev) != hipSuccess) { grid = -1; return; }
        if (hipFuncSetAttribute((const void*)mega_fwd, hipFuncAttributeMaxDynamicSharedMemorySize, LDS_BYTES) != hipSuccess) { fprintf(stderr, "kernel_launch: hipFuncSetAttribute failed\n"); grid = -1; return; }
        if (hipOccupancyMaxActiveBlocksPerMultiprocessor(&per_cu, (const void*)mega_fwd, NTHR, LDS_BYTES) != hipSuccess || per_cu < 1)
            fprintf(stderr, "kernel_launch: occupancy query reports %d workgroups per CU\n", per_cu);
        (void)hipGetLastError();
        grid = cus;
        if (grid > 256) grid = 256;
    }
    if (grid < 0) return;
    if (hipMemsetAsync((char*)d_ws + WS_CTL, 0, CTL_ZERO_BYTES, stream) != hipSuccess) return;
    Args a{};
    for (int i = 0; i < N_INPUTS; ++i) a.in[i] = d_in[i];
    a.out = (float*)d_out; a.ws = (unsigned char*)d_ws;
    hipLaunchKernelGGL(mega_fwd, dim3(grid), dim3(NTHR), LDS_BYTES, stream, a);
    const hipError_t le = hipPeekAtLastError();
    if (le != hipSuccess) fprintf(stderr, "kernel_launch: launch failed: %s\n", hipGetErrorName(le));
}
```

```cpp
#define PH_MAX 13
#include <hip/hip_runtime.h>
#include <cstdio>
#include <cstdint>

namespace pg8 {
#define PG8_LAS __attribute__((address_space(3)))
typedef unsigned short bf16_t;
typedef short bf16x8 __attribute__((ext_vector_type(8)));
typedef float f32x4 __attribute__((ext_vector_type(4)));
typedef unsigned u32x4 __attribute__((ext_vector_type(4)));
typedef unsigned u32x2 __attribute__((ext_vector_type(2)));
constexpr int BM = 256, BK = 64, HALF = 128, HTB = HALF * BK * 2  , STAGE_BYTES = 8 * HTB, NXCD = 8, WGM = 8;

__host__ __device__ __forceinline__ int lds_byte(int r, int c) { const int st = (r >> 4) * 2 + (c >> 5), rr = r & 15, cc = c & 31, ob = rr * 64 + cc * 2; return st * 1024 + (ob ^ (((ob >> 9) & 1) << 5)); }
__host__ __device__ __forceinline__ void stage_rc(int b, int& R, int& C) { const int st = b / 1024, sb = b % 1024, swz = sb ^ (((sb >> 9) & 1) << 5); R = (st >> 1) * 16 + swz / 64; C = (st & 1) * 32 + (swz % 64) / 2; }

struct Unit { int pm, pn; };
struct Gemm { const bf16_t* A; const bf16_t* Bt; int lda, ldb, K; };

struct StaticOrder {
    int nM, nN, nwg, G, c;
    __host__ __device__ void init(int M, int N, int G_, int c_) { nM = M / BM; nN = N / BM; nwg = nM * nN; G = G_; c = c_; }
    __host__ __device__ bool next(int i, Unit& u) const {
        const long L = (long)i * G + c; if (L >= nwg) return false;
        int wgid = (int)L; { const int q = nwg / NXCD, r = nwg % NXCD, xcd = wgid % NXCD, off = wgid / NXCD; wgid = (xcd < r ? xcd * (q + 1) : r * (q + 1) + (xcd - r) * q) + off; }
        const int nig = WGM * nN, gid = wgid / nig, fm = gid * WGM, gsz = (nM - fm) < WGM ? (nM - fm) : WGM;
        u.pm = fm + ((wgid % nig) % gsz); u.pn = (wgid % nig) / gsz; return true;
    }
};
struct SingleUnit {
    int has; Unit u0;
    __host__ __device__ bool next(int i, Unit& u) const { if (i != 0 || !has) return false; u = u0; return true; }
};

__device__ __forceinline__ unsigned cvt_pk_bf16(float lo, float hi) { unsigned r; asm volatile("v_cvt_pk_bf16_f32 %0, %1, %2" : "=v"(r) : "v"(lo), "v"(hi)); return r; }

template <class Epi, class Sched>
__device__ __forceinline__ void gemm_phase(PG8_LAS unsigned char* lds, const Gemm g, const Sched& S, const Epi& E, int wave_id) {
    int lane; asm volatile("v_mbcnt_lo_u32_b32 %0, -1, 0\n\tv_mbcnt_hi_u32_b32 %0, -1, %0" : "=v"(lane));
    const int wid = wave_id; const int tid = wid * 64 + lane; const int wr = wid >> 2, wc = wid & 3, fr = lane & 15, fq = lane >> 4;
    const int K = g.K, nt = K / BK;
    unsigned voffA[2], voffB[2];
#pragma unroll
    for (int i = 0; i < 2; ++i) { int R, C; stage_rc(tid * 16 + i * 8192, R, C);
        voffA[i] = (unsigned)(R * g.lda + C) * 2u; voffB[i] = (unsigned)(R * g.ldb + C) * 2u; }
    const size_t kstep = (size_t)(BK * 2);
    const size_t hstepA = (size_t)HALF * g.lda * 2, hstepB = (size_t)HALF * g.ldb * 2;
    const size_t tstepA = 2 * hstepA, tstepB = 2 * hstepB;
    const unsigned ldsw = (unsigned)wid * 1024u;
    const int aoff = lds_byte(wr * 64 + fr, fq * 8), boff = lds_byte(wc * 32 + fr, fq * 8);
#define PG8_SA(b, h) (((b) * 2 + (h)) * HTB)
#define PG8_SB(b, h) ((4 + (b) * 2 + (h)) * HTB)
#define PG8_STAGE(bufoff, gbase, voff) do { _Pragma("unroll") for (int _i = 0; _i < 2; ++_i) \
        __builtin_amdgcn_global_load_lds((const unsigned*)((const char*)(gbase) + (voff)[_i]), (PG8_LAS unsigned*)(lds + (bufoff) + ldsw + _i * 8192), 16, 0, 0); } while (0)
#define PG8_LDA(dst, b, h) do { _Pragma("unroll") for (int m = 0; m < 4; ++m) _Pragma("unroll") for (int k = 0; k < 2; ++k) dst[m][k] = *(const PG8_LAS bf16x8*)(lds + PG8_SA(b, h) + aoff + m * 2048 + k * 1024); } while (0)
#define PG8_LDB(dst, b, h) do { _Pragma("unroll") for (int n = 0; n < 2; ++n) _Pragma("unroll") for (int k = 0; k < 2; ++k) dst[n][k] = *(const PG8_LAS bf16x8*)(lds + PG8_SB(b, h) + boff + n * 2048 + k * 1024); } while (0)
#define PG8_MMA(ai, bj, At, Bt) do { __builtin_amdgcn_s_setprio(1); _Pragma("unroll") for (int m = 0; m < 4; ++m) _Pragma("unroll") for (int n = 0; n < 2; ++n) _Pragma("unroll") for (int k = 0; k < 2; ++k) \
        acc[ai][bj][m][n] = __builtin_amdgcn_mfma_f32_16x16x32_bf16(Bt[n][k], At[m][k], acc[ai][bj][m][n], 0, 0, 0); __builtin_amdgcn_s_setprio(0); } while (0)
#define PG8_WAIT_V(n) asm volatile("s_waitcnt vmcnt(" #n ")" ::: "memory")
#define PG8_WAIT_L(n) asm volatile("s_waitcnt lgkmcnt(" #n ")" ::: "memory")
#define PG8_BAR __builtin_amdgcn_s_barrier()
#define PG8_SCHED __builtin_amdgcn_sched_barrier(0)
    Unit cur, nxt; int ui = 0;
    if (!S.next(0, cur)) return;
    f32x4 acc[2][2][4][2];
#pragma unroll
    for (int a = 0; a < 2; ++a)
#pragma unroll
        for (int b = 0; b < 2; ++b)
#pragma unroll
            for (int m = 0; m < 4; ++m)
#pragma unroll
                for (int n = 0; n < 2; ++n) acc[a][b][m][n] = (f32x4){0.f, 0.f, 0.f, 0.f};
    bf16x8 At[4][2], B0[2][2], B1[2][2];
    const char* cA = (const char*)g.A + (size_t)cur.pm * tstepA; const char* cB = (const char*)g.Bt + (size_t)cur.pn * tstepB;
    PG8_STAGE(PG8_SB(0, 0), cB, voffB); PG8_STAGE(PG8_SB(0, 1), cB + hstepB, voffB); PG8_STAGE(PG8_SA(0, 0), cA, voffA); PG8_STAGE(PG8_SA(0, 1), cA + hstepA, voffA);
    if (wr == 1) PG8_BAR;
    PG8_WAIT_V(2); PG8_BAR;
    PG8_STAGE(PG8_SB(1, 0), cB + kstep, voffB); PG8_STAGE(PG8_SA(1, 0), cA + kstep, voffA); PG8_STAGE(PG8_SB(1, 1), cB + hstepB + kstep, voffB);
    PG8_WAIT_V(6); PG8_BAR;
    for (;;) {
        const bool has_next = S.next(ui + 1, nxt);
        const char* nA = has_next ? (const char*)g.A + (size_t)nxt.pm * tstepA : cA; const char* nB = has_next ? (const char*)g.Bt + (size_t)nxt.pn * tstepB : cB;
        for (int t = 0; t < nt; t += 2) {
            const bool last = (t == nt - 2);
            const char* a1 = cA + (size_t)(t + 1) * kstep;
            const char* a2 = last ? nA : cA + (size_t)(t + 2) * kstep; const char* b2 = last ? nB : cB + (size_t)(t + 2) * kstep;
            const char* a3 = a2 + kstep; const char* b3 = b2 + kstep;
            PG8_LDB(B0, 0, 0); PG8_LDB(B1, 0, 1); PG8_SCHED; PG8_LDA(At, 0, 0); PG8_STAGE(PG8_SA(1, 1), a1 + hstepA, voffA);
            PG8_WAIT_V(8); PG8_WAIT_L(0); PG8_BAR; PG8_MMA(0, 0, At, B0); PG8_MMA(0, 1, At, B1); PG8_BAR; PG8_SCHED;
            PG8_LDA(At, 0, 1); PG8_STAGE(PG8_SB(0, 0), b2, voffB); PG8_STAGE(PG8_SB(0, 1), b2 + hstepB, voffB); PG8_STAGE(PG8_SA(0, 0), a2, voffA);
            PG8_WAIT_V(8); PG8_WAIT_L(0); PG8_BAR; PG8_MMA(1, 0, At, B0); PG8_MMA(1, 1, At, B1); PG8_BAR; PG8_SCHED;
            PG8_LDB(B0, 1, 0); PG8_LDB(B1, 1, 1); PG8_SCHED; PG8_LDA(At, 1, 0); PG8_STAGE(PG8_SA(0, 1), a2 + hstepA, voffA);
            PG8_WAIT_V(8); PG8_WAIT_L(0); PG8_BAR; PG8_MMA(0, 0, At, B0); PG8_MMA(0, 1, At, B1); PG8_BAR; PG8_SCHED;
            PG8_LDA(At, 1, 1); PG8_STAGE(PG8_SB(1, 0), b3, voffB); PG8_STAGE(PG8_SB(1, 1), b3 + hstepB, voffB); PG8_STAGE(PG8_SA(1, 0), a3, voffA);
            PG8_WAIT_V(8); PG8_WAIT_L(0); PG8_BAR; PG8_MMA(1, 0, At, B0); PG8_MMA(1, 1, At, B1); PG8_BAR; PG8_SCHED;
        }
        if (wr == 0) PG8_BAR;
        if constexpr (!Epi::AFTER_DRAIN) { E(acc, cur, wr, wc, fr, fq); }
        if (!has_next) break;
#pragma unroll
        for (int a = 0; a < 2; ++a)
#pragma unroll
            for (int b = 0; b < 2; ++b)
#pragma unroll
                for (int m = 0; m < 4; ++m)
#pragma unroll
                    for (int n = 0; n < 2; ++n) acc[a][b][m][n] = (f32x4){0.f, 0.f, 0.f, 0.f};
        cur = nxt; cA = nA; cB = nB; ++ui;
        if (wr == 1) PG8_BAR;
    }
    PG8_WAIT_V(0);
    PG8_BAR;
    if constexpr (Epi::AFTER_DRAIN) { E.fused(acc, cur, wr, wc, fr, fq, lds, wid, lane); }
#undef PG8_SA
#undef PG8_SB
#undef PG8_STAGE
#undef PG8_LDA
#undef PG8_LDB
#undef PG8_MMA
#undef PG8_WAIT_V
#undef PG8_WAIT_L
#undef PG8_BAR
#undef PG8_SCHED
}
}

#define GAS __attribute__((address_space(1)))
#define LAS __attribute__((address_space(3)))
typedef unsigned short bf16;
typedef unsigned v4u __attribute__((ext_vector_type(4)));
typedef unsigned v2u __attribute__((ext_vector_type(2)));
typedef float f32x4 __attribute__((ext_vector_type(4)));
typedef float f32x2 __attribute__((ext_vector_type(2)));
typedef float f32x16 __attribute__((ext_vector_type(16)));
typedef short bf16x8 __attribute__((ext_vector_type(8)));
typedef short s16x4 __attribute__((ext_vector_type(4)));
typedef GAS unsigned gu32;
#define RLX_AGENT __ATOMIC_RELAXED, __HIP_MEMORY_SCOPE_AGENT
#define LDS_WAIT() asm volatile("s_waitcnt lgkmcnt(0)" ::: "memory")
#define VM_WAIT() asm volatile("s_waitcnt vmcnt(0)" ::: "memory")
__device__ __forceinline__ unsigned f2bf(float f) { unsigned u = __builtin_bit_cast(unsigned, f); return (u + 0x7fffu + ((u >> 16) & 1u)) >> 16; }
__device__ __forceinline__ unsigned pk2(float lo, float hi) { return f2bf(lo) | (f2bf(hi) << 16); }
__device__ __forceinline__ float bf2f(unsigned short b) { return __builtin_bit_cast(float, (unsigned)b << 16); }
__device__ __forceinline__ float bflo(unsigned u) { return __builtin_bit_cast(float, u << 16); }
__device__ __forceinline__ float bfhi(unsigned u) { return __builtin_bit_cast(float, u & 0xffff0000u); }


__device__ __forceinline__ int lane_id() { int r; asm volatile("v_mbcnt_lo_u32_b32 %0, -1, 0\n\tv_mbcnt_hi_u32_b32 %0, -1, %0" : "=v"(r)); return r; }
#define TID_IS_ZERO(wave_) ((wave_) == 0 && lane_id() == 0)
#define XB_TMO      128
#define XB_XCNT(j)  (256  + 64 * (j))
#define XB_XSUB(j)  (1280 + 64 * (j))
#define XB_XGEN(j)  (2304 + 64 * (j))
#define XB_TOP      3328
#define XB_TOPGEN   3392
#define XCD_BAR_WORDS 3456
#define XB_SPIN_CAP (1u << 18)

__device__ __forceinline__ unsigned xb_ld(unsigned* p)              { return __hip_atomic_load(p, __ATOMIC_RELAXED, __HIP_MEMORY_SCOPE_AGENT); }
__device__ __forceinline__ unsigned xb_add(unsigned* p, unsigned v) { return __hip_atomic_fetch_add(p, v, __ATOMIC_RELAXED, __HIP_MEMORY_SCOPE_AGENT); }
__device__ __forceinline__ unsigned xb_xcc_id() { return (unsigned)__builtin_amdgcn_s_getreg((3 << 11) | 20) & 0xFu; }
#define XB_SPIN(cond, bar) do { unsigned _sp = 0; while (cond) { __builtin_amdgcn_s_sleep(1); \
    if ((++_sp & 255u) == 0u) { if (xb_ld(&(bar)[XB_TMO])) break; if (_sp > XB_SPIN_CAP) { atomicAdd(&(bar)[XB_TMO], 1u); break; } } } } while (0)

struct XcdBarrier {
    unsigned* bar; unsigned x; int wave;
    volatile LAS unsigned* st;
};

__device__ __forceinline__ XcdBarrier xcd_barrier_post(unsigned* bar, volatile LAS unsigned* st, int wave) {
    XcdBarrier b; b.bar = bar; b.x = xb_xcc_id(); b.st = st; b.wave = wave;
    if (TID_IS_ZERO(wave)) (void)xb_add(&bar[XB_XCNT(b.x)], 1u);
    return b;
}
__device__ __forceinline__ void xcd_barrier_complete(unsigned* bar, unsigned x, unsigned& nloc, unsigned& nx) {
    const unsigned G = gridDim.x * gridDim.y * gridDim.z;
    unsigned sum, cnt, mine, sp = 0u;
    for (;;) {
        sum = 0u; cnt = 0u; mine = 0u;
#pragma unroll
        for (unsigned j = 0; j < 16; ++j) { const unsigned c = xb_ld(&bar[XB_XCNT(j)]); sum += c; cnt += (c > 0u) ? 1u : 0u; mine = (j == x) ? c : mine; }
        if (sum == G) break;
        __builtin_amdgcn_s_sleep(1);
        if ((++sp & 255u) == 0u) { if (xb_ld(&bar[XB_TMO])) break; if (sp > XB_SPIN_CAP) { atomicAdd(&bar[XB_TMO], 1u); break; } }
    }
    nloc = mine > 0u ? mine : 1u; nx = cnt > 0u ? cnt : 1u;
}

__device__ __forceinline__ void xcd_barrier(const XcdBarrier& b) {
    asm volatile("s_waitcnt vmcnt(0)" ::: "memory");
    __syncthreads();
    if (TID_IS_ZERO(b.wave)) {
        unsigned* bar = b.bar;
        __builtin_amdgcn_s_waitcnt(0);
        unsigned nloc = b.st[0], nx = b.st[1];
        if (nloc == 0u) { xcd_barrier_complete(bar, b.x, nloc, nx); b.st[0] = nloc; b.st[1] = nx; }
        const unsigned old = xb_add(&bar[XB_XSUB(b.x)], 1u);
        const unsigned gen = old / nloc;
        if (old + 1u == (gen + 1u) * nloc) {
            __builtin_amdgcn_fence(__ATOMIC_RELEASE, "agent");
            asm volatile("s_waitcnt vmcnt(0)" ::: "memory");
            const unsigned og = xb_add(&bar[XB_TOP], 1u);
            const unsigned tg = og / nx;
            if (og + 1u == (tg + 1u) * nx) xb_add(&bar[XB_TOPGEN], 1u);
            else XB_SPIN(xb_ld(&bar[XB_TOPGEN]) == tg, bar);
            __builtin_amdgcn_fence(__ATOMIC_ACQUIRE, "agent");
            xb_add(&bar[XB_XGEN(b.x)], 1u);
            asm volatile("s_waitcnt vmcnt(0)" ::: "memory");
        } else {
            XB_SPIN(xb_ld(&bar[XB_XGEN(b.x)]) == gen, bar);
            __builtin_amdgcn_fence(__ATOMIC_ACQUIRE, "agent");
            asm volatile("s_waitcnt vmcnt(0)" ::: "memory");
        }
    }
    __syncthreads();
}


constexpr int NWAVES = 8, NTHR = 512;
constexpr int DM = 1024, TP = 16384, TS = 1024, TA = TP + TS, SEQ = 8192, NB_P = 2, NB_S = 128, LS = 8;
constexpr int N_IN = 3328;
constexpr int PASTL = 2048, PAGE = 128, NPAGES = 16;
constexpr float EPS = 1e-6f;
constexpr float LOG2E = 1.4426950408889634f;
constexpr float C2F = 0.125f * LOG2E;
constexpr float C2C = 0.0625f * LOG2E;

enum { I_XP = 0, I_XS, I_CFK, I_CFV, I_CFL, I_SGLA, I_CMK, I_CMV, I_PT, I_MEMP, I_GMIX, I_WIN, I_BFF, I_WG2, I_BG, I_GGO, I_WOUT, I_GCROSS, I_GMEM,
       I_WMK, I_WMV, I_WCQ, I_WCO, I_GFFN, I_PWQ, I_PSK, I_PU, I_PV, I_GFIN, N_INPUTS };
constexpr size_t O_YP = 0, O_YS = 16777216, O_FKP = 17825792, O_FVP = 26214400, O_LFP = 34603008, O_GSP = 34734080, O_MKP = 34799616, O_MVP = 35323904,
                 O_FKS = 35848192, O_FVS = 36372480, O_LFS = 36896768, O_GSS = 36904960, O_TOTAL = 41099264;

constexpr size_t MiB = 1u << 20;
constexpr size_t WS_CTL = 0, CTL_ZERO_BYTES = 1 * MiB;
constexpr size_t WS_WIN = 2 * MiB, WS_WOUT = 10 * MiB, WS_WMK = 12 * MiB, WS_WMV = 14 * MiB, WS_WCQ = 16 * MiB, WS_WCO = 18 * MiB, WS_WPK = 20 * MiB;
constexpr size_t WS_MB = 24 * MiB, WS_MK16 = 25 * MiB, WS_MVT16 = 26 * MiB, WS_KBIAS = 27 * MiB, WS_GDEC = 28 * MiB, WS_GG = 29 * MiB;
constexpr size_t WS_U16 = 32 * MiB, WS_V16 = 64 * MiB, WS_HB = 96 * MiB, WS_QF = 132 * MiB, WS_KF = 150 * MiB, WS_VF = 168 * MiB;
constexpr size_t WS_GQ = 186 * MiB, WS_GK = 204 * MiB, WS_GV = 222 * MiB, WS_GR = 256 * MiB, WS_SUF = 290 * MiB, WS_GKV = 298 * MiB;
constexpr size_t WS_MERGED = 330 * MiB, WS_X1 = 364 * MiB, WS_X2 = 432 * MiB, WS_QC = 500 * MiB, WS_PC = 534 * MiB, WS_OC = 566 * MiB, WS_SC = 600 * MiB;
constexpr size_t WS_MISC = 736 * MiB, WS_SS = 740 * MiB  , WS_BB = 744 * MiB, WS_END = 800 * MiB;
constexpr int CW_BAR = 4096;

constexpr int RING_BYTES = 131072;
constexpr int LDSCTL_OFF = RING_BYTES, MISC_OFF = LDSCTL_OFF + 320;
constexpr int ARGS_OFF = MISC_OFF + 128;
constexpr int LDS_BYTES = 147456;

struct Args { const void* in[N_INPUTS]; float* out; unsigned char* ws; };

__device__ __forceinline__ const void* ld_ptr(const LAS unsigned long long* p) { const unsigned long long v = *p; const unsigned lo = __builtin_amdgcn_readfirstlane((unsigned)v), hi = __builtin_amdgcn_readfirstlane((unsigned)(v >> 32)); return (const void*)(const GAS char*)(((unsigned long long)hi << 32) | lo); }
__device__ __forceinline__ Args load_args(const LAS unsigned long long* ARGP) { Args A;
    A.in[0] = ld_ptr(ARGP + 0);
    A.in[1] = ld_ptr(ARGP + 1);
    A.in[2] = ld_ptr(ARGP + 2);
    A.in[3] = ld_ptr(ARGP + 3);
    A.in[4] = ld_ptr(ARGP + 4);
    A.in[5] = ld_ptr(ARGP + 5);
    A.in[6] = ld_ptr(ARGP + 6);
    A.in[7] = ld_ptr(ARGP + 7);
    A.in[8] = ld_ptr(ARGP + 8);
    A.in[9] = ld_ptr(ARGP + 9);
    A.in[10] = ld_ptr(ARGP + 10);
    A.in[11] = ld_ptr(ARGP + 11);
    A.in[12] = ld_ptr(ARGP + 12);
    A.in[13] = ld_ptr(ARGP + 13);
    A.in[14] = ld_ptr(ARGP + 14);
    A.in[15] = ld_ptr(ARGP + 15);
    A.in[16] = ld_ptr(ARGP + 16);
    A.in[17] = ld_ptr(ARGP + 17);
    A.in[18] = ld_ptr(ARGP + 18);
    A.in[19] = ld_ptr(ARGP + 19);
    A.in[20] = ld_ptr(ARGP + 20);
    A.in[21] = ld_ptr(ARGP + 21);
    A.in[22] = ld_ptr(ARGP + 22);
    A.in[23] = ld_ptr(ARGP + 23);
    A.in[24] = ld_ptr(ARGP + 24);
    A.in[25] = ld_ptr(ARGP + 25);
    A.in[26] = ld_ptr(ARGP + 26);
    A.in[27] = ld_ptr(ARGP + 27);
    A.in[28] = ld_ptr(ARGP + 28);
    A.out = (float*)ld_ptr(ARGP + N_INPUTS); A.ws = (unsigned char*)ld_ptr(ARGP + N_INPUTS + 1); return A; }
struct Frame {
    LAS unsigned char* lds;
    int tid, lane, wave, vcu, G;
};

__device__ __forceinline__ float wave_sum(float v) {
#pragma unroll
    for (int o = 1; o < 64; o <<= 1) v += __shfl_xor(v, o);
    return v;
}
__device__ __forceinline__ float log_sigmoid(float x) { return fminf(x, 0.f) - log1pf(__expf(-fabsf(x))); }

__device__ __forceinline__ int win_src_col(int r) {
    if (r < 1536) return r;
    if (r < 1792) return 1544 + (r - 1536);
    if (r < 2048) return 1800 + (r - 1792);
    if (r < 2560) return 2056 + (r - 2048);
    if (r < 3072) return 2584 + (r - 2560);
    if (r < 3080) return 1536 + (r - 3072);
    if (r < 3096) return 2568 + (r - 3080);
    return -1;
}
template <bool WIN>
__device__ __forceinline__ void p0_transpose_item(const float* W, int ldw, int K, int nblk, bf16* WT, LAS float* scr, int item, int lane) {
    const int kb = item / nblk, nb = item % nblk, k0 = 64 * kb, n0 = 32 * nb;
    const int dr = n0 + (lane & 31); const int sc = WIN ? win_src_col(dr) : dr;
#pragma unroll 8
    for (int i = 0; i < 32; ++i) { const int kk = 2 * i + (lane >> 5); scr[kk * 33 + (lane & 31)] = (sc >= 0) ? W[(size_t)(k0 + kk) * ldw + sc] : 0.f; }
    LDS_WAIT(); asm volatile("" ::: "memory");
    const int c = lane & 7;
#pragma unroll
    for (int j = 0; j < 4; ++j) { const int n = (lane >> 3) + 8 * j; const LAS float* s = scr + (8 * c) * 33 + n;
        v4u o; o.x = pk2(s[0 * 33], s[1 * 33]); o.y = pk2(s[2 * 33], s[3 * 33]); o.z = pk2(s[4 * 33], s[5 * 33]); o.w = pk2(s[6 * 33], s[7 * 33]);
        *(GAS v4u*)(WT + (size_t)(n0 + n) * K + k0 + 8 * c) = o; }
    LDS_WAIT(); asm volatile("" ::: "memory");
}
__device__ __forceinline__ void rms_row_bf16(const float* xrow, const float* g, bf16* orow, int lane) {
    const f32x4* xr = (const f32x4*)xrow + lane; const f32x4* gr = (const f32x4*)g + lane;
    f32x4 v[4]; float s = 0.f;
#pragma unroll
    for (int j = 0; j < 4; ++j) { v[j] = xr[64 * j]; s += (v[j].x * v[j].x + v[j].y * v[j].y) + (v[j].z * v[j].z + v[j].w * v[j].w); }
    const float r = rsqrtf(wave_sum(s) * (1.f / DM) + EPS);
    v2u* o8 = (v2u*)orow + lane;
#pragma unroll
    for (int j = 0; j < 4; ++j) { const f32x4 gg = gr[64 * j]; v2u o; o.x = pk2(v[j].x * r * gg.x, v[j].y * r * gg.y); o.y = pk2(v[j].z * r * gg.z, v[j].w * r * gg.w); o8[64 * j] = o; }
}

using pg8::Unit;
struct EpiGen {
    static constexpr bool PERM = false, AFTER_DRAIN = false;
    float* d32; int ld32; bf16* d16; int ld16; float sc16;
    const float* r0; const float* r1; int rsplit; int ldr;
    const float* gcol;
    float* ssq;
    const float* rsq;
    __device__ __forceinline__ void operator()(const f32x4 (&acc)[2][2][4][2], const Unit& u, int wr, int wc, int fr, int fq) const {
        int row0 = u.pm * 256 + wr * 64 + fr, col0 = u.pn * 256 + wc * 32 + fq * 4;
        asm volatile("" : "+v"(row0), "+v"(col0));
#pragma unroll
        for (int ai = 0; ai < 2; ++ai)
#pragma unroll
            for (int m = 0; m < 4; ++m) { const int row = row0 + ai * 128 + m * 16;
                const float* rp = nullptr; if (r0) rp = (row < rsplit) ? r0 + (size_t)row * ldr : r1 + (size_t)(row - rsplit) * ldr;
                float rs = 1.f; if (rsq) rs = rsqrtf(rsq[row] * (1.f / 1024.f) + EPS);
                float ss = 0.f;
#pragma unroll
                for (int bj = 0; bj < 2; ++bj)
#pragma unroll
                    for (int n = 0; n < 2; ++n) { const int col = col0 + bj * 128 + n * 16; f32x4 v = acc[ai][bj][m][n];
                        if (rsq) { v[0] *= rs; v[1] *= rs; v[2] *= rs; v[3] *= rs; }
                        if (r0) v += *(const f32x4*)(rp + col);
                        if (d32) *(f32x4*)(d32 + (size_t)row * ld32 + col) = v;
                        if (ssq) ss += (v[0] * v[0] + v[1] * v[1]) + (v[2] * v[2] + v[3] * v[3]);
                        if (d16) { f32x4 w = v; if (gcol) w = w * *(const f32x4*)(gcol + col);
                            v2u o; o.x = pg8::cvt_pk_bf16(w[0] * sc16, w[1] * sc16); o.y = pg8::cvt_pk_bf16(w[2] * sc16, w[3] * sc16); *(v2u*)(d16 + (size_t)row * ld16 + col) = o; } }
                if (ssq) { ss += __shfl_xor(ss, 16); ss += __shfl_xor(ss, 32); if (fq == 0) atomicAdd(ssq + row, ss); } }
    }
};
struct EpiInProj {
    static constexpr bool PERM = false, AFTER_DRAIN = false;
    float* out; unsigned char* ws; const float* bff;
    __device__ __forceinline__ void operator()(const f32x4 (&acc)[2][2][4][2], const Unit& u, int wr, int wc, int fr, int fq) const {
        const int pn = u.pn; const bool smp = u.pm >= 64;
        int row0 = u.pm * 256 + wr * 64 + fr;
        int orow0 = (smp ? (u.pm - 64) * 256 : u.pm * 256) + wr * 64 + fr;
        asm volatile("" : "+v"(row0), "+v"(orow0));
        float* d32 = nullptr; int ld32 = 0; bool d32_grp = false; bf16* d16 = nullptr; int ld16 = 0; float s32 = 1.f, s16 = 1.f; int cb = 0;
        if (pn < 2) { d16 = (bf16*)(ws + WS_QF); ld16 = 512; s16 = C2F; cb = pn * 256; }
        else if (pn < 4) { d32 = out + (smp ? O_FKS : O_FKP); ld32 = 512; d32_grp = true; d16 = (bf16*)(ws + WS_KF); ld16 = 512; cb = (pn - 2) * 256; }
        else if (pn < 6) { d32 = out + (smp ? O_FVS : O_FVP); ld32 = 512; d32_grp = true; d16 = (bf16*)(ws + WS_VF); ld16 = 512; cb = (pn - 4) * 256; }
        else if (pn == 6) { d32 = (float*)(ws + WS_GQ); ld32 = 256; s32 = 0.125f; }
        else if (pn == 7) { d32 = (float*)(ws + WS_GK); ld32 = 256; }
        else if (pn < 10) { d32 = (float*)(ws + WS_GV); ld32 = 512; cb = (pn - 8) * 256; }
        else if (pn < 12) { d32 = (float*)(ws + WS_GR); ld32 = 512; cb = (pn - 10) * 256; }
        if (pn < 12) {
#pragma unroll
            for (int ai = 0; ai < 2; ++ai)
#pragma unroll
                for (int m = 0; m < 4; ++m) { const int row = row0 + ai * 128 + m * 16, orow = orow0 + ai * 128 + m * 16;
#pragma unroll
                    for (int bj = 0; bj < 2; ++bj)
#pragma unroll
                        for (int n = 0; n < 2; ++n) { const int col = cb + wc * 32 + fq * 4 + bj * 128 + n * 16; const f32x4 v = acc[ai][bj][m][n];
                            if (d32) *(f32x4*)(d32 + (size_t)(d32_grp ? orow : row) * ld32 + col) = v * s32;
                            if (d16) { v2u o; o.x = pg8::cvt_pk_bf16(v[0] * s16, v[1] * s16); o.y = pg8::cvt_pk_bf16(v[2] * s16, v[3] * s16); *(v2u*)(d16 + (size_t)row * ld16 + col) = o; } } }
        } else {
            if (wc == 0) {
                float* lf = out + (smp ? O_LFS : O_LFP); float* ggp = (float*)(ws + WS_GG);
#pragma unroll
                for (int ai = 0; ai < 2; ++ai)
#pragma unroll
                    for (int m = 0; m < 4; ++m) { const int row = row0 + ai * 128 + m * 16, orow = orow0 + ai * 128 + m * 16;
#pragma unroll
                        for (int n = 0; n < 2; ++n) { const int col = n * 16 + fq * 4; const f32x4 v = acc[ai][0][m][n];
                            if (col < 8) { f32x4 o; const f32x4 b = *(const f32x4*)(bff + col);
                                o[0] = log_sigmoid(v[0] + b[0]); o[1] = log_sigmoid(v[1] + b[1]); o[2] = log_sigmoid(v[2] + b[2]); o[3] = log_sigmoid(v[3] + b[3]);
                                *(f32x4*)(lf + (size_t)orow * 8 + col) = o; }
                            else if (col < 24) *(f32x4*)(ggp + (size_t)row * 16 + (col - 8)) = v; } }
            }
        }
    }
};


__device__ __forceinline__ void p0_prologue(const Frame& F, const Args& a) {
    unsigned char* ws = a.ws;
    LAS float* scr = (LAS float*)(F.lds + F.wave * 16384);
    const int gw = F.vcu * NWAVES + F.wave, NGW = F.G * NWAVES;
    constexpr int I_WINN = 16 * (N_IN / 32), I_SQ = 16 * 32;
    constexpr int NITEMS = I_WINN + 5 * I_SQ;
    for (int it = gw; it < NITEMS; it += NGW) {
        int r = it;
        if (r < I_WINN) { p0_transpose_item<true>((const float*)a.in[I_WIN], 3096, DM, N_IN / 32, (bf16*)(ws + WS_WIN), scr, r, F.lane); continue; } r -= I_WINN;
        const int which = r / I_SQ; r -= which * I_SQ;
        const float* src = (const float*)(which == 0 ? a.in[I_WOUT] : which == 1 ? a.in[I_WMK] : which == 2 ? a.in[I_WMV] : which == 3 ? a.in[I_WCQ] : a.in[I_WCO]);
        bf16* dst = (bf16*)(ws + (which == 0 ? WS_WOUT : which == 1 ? WS_WMK : which == 2 ? WS_WMV : which == 3 ? WS_WCQ : WS_WCO));
        p0_transpose_item<false>(src, DM, DM, 32, dst, scr, r, F.lane);
    }
    { float* ssz = (float*)(ws + WS_SS); for (int i = F.vcu * NTHR + F.tid; i < 2 * TA; i += F.G * NTHR) ssz[i] = 0.f; }
    for (int m0 = gw * 2; m0 < TA + 512; m0 += NGW * 2) {
        const float* xr[2]; const float* gr[2]; bf16* orow[2];
#pragma unroll
        for (int j = 0; j < 2; ++j) { const int m = m0 + j;
            if (m < TP) { xr[j] = (const float*)a.in[I_XP] + (size_t)m * DM; gr[j] = (const float*)a.in[I_GMIX]; orow[j] = (bf16*)(ws + WS_HB) + (size_t)m * DM; }
            else if (m < TA) { xr[j] = (const float*)a.in[I_XS] + (size_t)(m - TP) * DM; gr[j] = (const float*)a.in[I_GMIX]; orow[j] = (bf16*)(ws + WS_HB) + (size_t)m * DM; }
            else { xr[j] = (const float*)a.in[I_MEMP] + (size_t)(m - TA) * DM; gr[j] = (const float*)a.in[I_GMEM]; orow[j] = (bf16*)(ws + WS_MB) + (size_t)(m - TA) * DM; } }
        f32x4 v[2][4]; float s[2];
#pragma unroll
        for (int j = 0; j < 2; ++j) { s[j] = 0.f;
#pragma unroll
            for (int q = 0; q < 4; ++q) v[j][q] = ((const f32x4*)xr[j])[F.lane + 64 * q]; }
#pragma unroll
        for (int j = 0; j < 2; ++j) {
#pragma unroll
            for (int q = 0; q < 4; ++q) s[j] += (v[j][q].x * v[j][q].x + v[j][q].y * v[j][q].y) + (v[j][q].z * v[j][q].z + v[j][q].w * v[j][q].w);
            const float r = rsqrtf(wave_sum(s[j]) * (1.f / DM) + EPS);
#pragma unroll
            for (int q = 0; q < 4; ++q) { const f32x4 gg = ((const f32x4*)gr[j])[F.lane + 64 * q]; v2u o; o.x = pk2(v[j][q].x * r * gg.x, v[j][q].y * r * gg.y); o.y = pk2(v[j][q].z * r * gg.z, v[j][q].w * r * gg.w); ((v2u*)orow[j])[F.lane + 64 * q] = o; } }
    }
    {
        for (int r0 = gw * 4; r0 < 2 * 16384; r0 += NGW * 4) {
            f32x4 x[4][4];
#pragma unroll
            for (int j = 0; j < 4; ++j) { const int r = r0 + j; const bool isv = r >= 16384; const int e = isv ? r - 16384 : r;
                const f32x4* s = (const f32x4*)((const float*)(isv ? a.in[I_PV] : a.in[I_PU]) + (size_t)e * DM + 16 * F.lane);
#pragma unroll
                for (int q = 0; q < 4; ++q) x[j][q] = __builtin_nontemporal_load(s + q); }
#pragma unroll
            for (int j = 0; j < 4; ++j) { const int r = r0 + j; const bool isv = r >= 16384; const int e = isv ? r - 16384 : r; float am = 0.f;
#pragma unroll
                for (int q = 0; q < 4; ++q) am = fmaxf(am, fmaxf(fmaxf(fabsf(x[j][q].x), fabsf(x[j][q].y)), fmaxf(fabsf(x[j][q].z), fabsf(x[j][q].w))));
#pragma unroll
                for (int o = 1; o < 64; o <<= 1) am = fmaxf(am, __shfl_xor(am, o));
                const float inv = am > 0.f ? 448.f / am : 0.f;
                v4u o4;
#pragma unroll
                for (int q = 0; q < 4; ++q) { int pk = __builtin_amdgcn_cvt_pk_fp8_f32(x[j][q].x * inv, x[j][q].y * inv, 0, false); pk = __builtin_amdgcn_cvt_pk_fp8_f32(x[j][q].z * inv, x[j][q].w * inv, pk, true); o4[q] = (unsigned)pk; }
                *(v4u*)(ws + (isv ? WS_V16 : WS_U16) + (size_t)e * DM + 16 * F.lane) = o4;
                if (F.lane == 0) ((float*)(ws + WS_MISC))[r] = am * (1.f / 448.f); }
        }
    }
    __syncthreads();
    for (int it = blockIdx.x; it < 256; it += F.G) {
        const int c = it >> 4, kt = it & 15, half = c & 1;
        LAS float* SK = (LAS float*)F.lds; LAS float* WT = (LAS float*)(F.lds + 128 * 129 * 4);
        const float* sk = (const float*)a.in[I_PSK] + (size_t)half * 128 * 128; const float* wq = (const float*)a.in[I_PWQ] + (size_t)(kt * 64) * 2048 + c * 128;
#pragma unroll 4
        for (int i = 0; i < 32; ++i) { const int idx = F.tid + 512 * i; SK[(idx >> 7) * 129 + (idx & 127)] = sk[idx]; }
#pragma unroll 4
        for (int i = 0; i < 16; ++i) { const int idx = F.tid + 512 * i; WT[(idx >> 7) * 129 + (idx & 127)] = wq[(size_t)(idx >> 7) * 2048 + (idx & 127)]; }
        __syncthreads();
        const int tk = F.tid & 15, tkey = F.tid >> 4;
        float acc[4][4];
#pragma unroll
        for (int i = 0; i < 4; ++i)
#pragma unroll
            for (int j = 0; j < 4; ++j) acc[i][j] = 0.f;
        for (int j = 0; j < 128; ++j) {
            float av[4], bv[4];
#pragma unroll
            for (int i = 0; i < 4; ++i) { av[i] = SK[(4 * tkey + i) * 129 + j]; bv[i] = WT[(4 * tk + i) * 129 + j]; }
#pragma unroll
            for (int i = 0; i < 4; ++i)
#pragma unroll
                for (int i2 = 0; i2 < 4; ++i2) acc[i][i2] += av[i] * bv[i2];
        }
        bf16* wp = (bf16*)(ws + WS_WPK);
#pragma unroll
        for (int i = 0; i < 4; ++i) { v2u o; o.x = pk2(acc[i][0], acc[i][1]); o.y = pk2(acc[i][2], acc[i][3]); *(v2u*)(wp + (size_t)(c * 128 + 4 * tkey + i) * DM + kt * 64 + 4 * tk) = o; }
        __syncthreads();
    }
}


__device__ __forceinline__ void fox_prompt_cumsum(const Frame& F, const float* logf  , float* kbias, int b) {
    LAS float* WT = (LAS float*)F.lds;
    const int t0 = F.wave * 1024 + F.lane * 16;
    const f32x4* src = (const f32x4*)(logf + ((size_t)b * SEQ + t0) * 8);
    float s[8];
#pragma unroll
    for (int h = 0; h < 8; ++h) s[h] = 0.f;
#pragma unroll 4
    for (int i = 0; i < 16; ++i) { const f32x4 a = src[2 * i], c = src[2 * i + 1]; s[0] += a.x; s[1] += a.y; s[2] += a.z; s[3] += a.w; s[4] += c.x; s[5] += c.y; s[6] += c.z; s[7] += c.w; }
    float ex[8];
#pragma unroll
    for (int h = 0; h < 8; ++h) { float v = s[h];
#pragma unroll
        for (int o = 1; o < 64; o <<= 1) { const float t = __shfl_up(v, o); if (F.lane >= o) v += t; }
        ex[h] = v - s[h];
        if (F.lane == 63) WT[F.wave * 8 + h] = v; }
    __syncthreads();
#pragma unroll
    for (int h = 0; h < 8; ++h) { float c = 0.f; for (int w = 0; w < F.wave; ++w) c += WT[w * 8 + h]; ex[h] += c; }
    float* dst = kbias + (size_t)(b * 8) * SEQ + t0;
#pragma unroll 4
    for (int i = 0; i < 16; ++i) { const f32x4 a = src[2 * i], c = src[2 * i + 1];
        ex[0] += a.x; ex[1] += a.y; ex[2] += a.z; ex[3] += a.w; ex[4] += c.x; ex[5] += c.y; ex[6] += c.z; ex[7] += c.w;
#pragma unroll
        for (int h = 0; h < 8; ++h) dst[(size_t)h * SEQ + i] = -ex[h] * LOG2E; }
    __syncthreads();
}
__device__ __forceinline__ void fox_sample_suffix(const Frame& F, const float* cfl, const int* pt, float* suf, int bs) {
    float carry[8];
#pragma unroll
    for (int h = 0; h < 8; ++h) carry[h] = 0.f;
    const int mypg = pt[bs * NPAGES + (F.lane & 15)];
#pragma unroll 1
    for (int pb = NPAGES - 4; pb >= 0; pb -= 4) {
        f32x4 x[4][4];
#pragma unroll
        for (int j = 0; j < 4; ++j) { const int pg = __builtin_amdgcn_readlane(mypg, 0) * 0 + __shfl(mypg, pb + j); const f32x4* src = (const f32x4*)(cfl + ((size_t)pg * PAGE + 2 * F.lane) * 8);
            x[j][0] = src[0]; x[j][1] = src[1]; x[j][2] = src[2]; x[j][3] = src[3]; }
#pragma unroll
        for (int j = 3; j >= 0; --j) { const int p = pb + j;
            const float ra[8] = {x[j][0].x, x[j][0].y, x[j][0].z, x[j][0].w, x[j][1].x, x[j][1].y, x[j][1].z, x[j][1].w}, rb[8] = {x[j][2].x, x[j][2].y, x[j][2].z, x[j][2].w, x[j][3].x, x[j][3].y, x[j][3].z, x[j][3].w};
#pragma unroll
            for (int h = 0; h < 8; ++h) {
                const float ps = ra[h] + rb[h]; float v = ps;
#pragma unroll
                for (int o = 1; o < 64; o <<= 1) { const float t = __shfl_down(v, o); if (F.lane + o < 64) v += t; }
                const float exs = v - ps;
                float* d = suf + (size_t)(bs * 8 + h) * PASTL + p * PAGE + 2 * F.lane;
                *(f32x2*)d = (f32x2){(carry[h] + exs + rb[h]) * LOG2E, (carry[h] + exs) * LOG2E};
                carry[h] += __shfl(v, 0);
            }
        }
    }
}

__device__ __forceinline__ void gla_gate_tile(const Frame& F, const float* gg, const float* w2, const float* bg, int row0, int h, int nt, LAS float* LA, LAS float* GGS) {
    for (int e = F.tid; e < nt * 16; e += NTHR) GGS[e] = gg[(size_t)row0 * 16 + e];
    const int dk = F.tid & 63; float wc[16];
#pragma unroll
    for (int r = 0; r < 16; ++r) wc[r] = w2[r * 256 + h * 64 + dk];
    const float bb = bg[h * 64 + dk];
    __syncthreads();
    for (int t = F.tid >> 6; t < nt; t += 8) { float z = bb;
#pragma unroll
        for (int q = 0; q < 4; ++q) { const f32x4 g4 = *(const LAS f32x4*)(GGS + t * 16 + 4 * q); z += g4.x * wc[4 * q] + g4.y * wc[4 * q + 1] + g4.z * wc[4 * q + 2] + g4.w * wc[4 * q + 3]; }
        LA[t * 64 + dk] = log_sigmoid(z) * (1.f / 16.f); }
}
__device__ __forceinline__ void gla_cumsum64(const Frame& F, LAS float* LA, LAS float* SEG) {
    const int dk = F.lane, w = F.wave; float v[8]; float run = 0.f;
#pragma unroll
    for (int i = 0; i < 8; ++i) { run += LA[(8 * w + i) * 64 + dk]; v[i] = run; }
    SEG[w * 64 + dk] = run;
    __syncthreads();
    float pre = 0.f;
    for (int j = 0; j < w; ++j) pre += SEG[j * 64 + dk];
#pragma unroll
    for (int i = 0; i < 8; ++i) LA[(8 * w + i) * 64 + dk] = v[i] + pre;
    __syncthreads();
}
__device__ __forceinline__ void gla_g1_unit(const Frame& F, const Args& a, int u) {
    unsigned char* ws = a.ws;
    const int b = u >> 9, h = (u >> 7) & 3, n = u & 127; const int row0 = b * SEQ + n * 64;
    LAS float* LA = (LAS float*)F.lds; LAS float* KR = LA + 4096; LAS float* SEG = KR + 4096; LAS float* GGS = SEG + 512; LAS float* VS = GGS + 1024;
#pragma unroll
    for (int i = 0; i < 16; ++i) { const int e = F.tid + NTHR * i; VS[e] = ((const float*)(ws + WS_GV))[(size_t)(row0 + (e >> 7)) * 512 + h * 128 + (e & 127)]; }
    float gkv[8];
#pragma unroll
    for (int i = 0; i < 8; ++i) { const int e = F.tid + NTHR * i; gkv[i] = ((const float*)(ws + WS_GK))[(size_t)(row0 + (e >> 6)) * 256 + h * 64 + (e & 63)]; }
    gla_gate_tile(F, (const float*)(ws + WS_GG), (const float*)a.in[I_WG2], (const float*)a.in[I_BG], row0, h, 64, LA, GGS);
    __syncthreads();
    gla_cumsum64(F, LA, SEG);
    if (F.tid < 64) ((float*)(ws + WS_GDEC))[(size_t)((b * 4 + h) * 128 + n) * 64 + F.tid] = __expf(LA[63 * 64 + F.tid]);
    float* bbuf = (float*)(ws + WS_BB);
#pragma unroll
    for (int i = 0; i < 8; ++i) { const int e = F.tid + NTHR * i; const int t = e >> 6, dk = e & 63; const float bb = LA[e]; bbuf[(size_t)(row0 + t) * 256 + h * 64 + dk] = bb;
        KR[e] = gkv[i] * __expf(LA[63 * 64 + dk] - bb); }
    __syncthreads();
    {
        const int dvq = F.tid & 31, dkq = F.tid >> 5; float acc[4][4];
#pragma unroll
        for (int i = 0; i < 4; ++i)
#pragma unroll
            for (int j = 0; j < 4; ++j) acc[i][j] = 0.f;
#pragma unroll 8
        for (int t = 0; t < 64; ++t) { const f32x4 v4 = *(const LAS f32x4*)(VS + t * 128 + 4 * dvq), k4 = *(const LAS f32x4*)(KR + t * 64 + 4 * dkq);
#pragma unroll
            for (int i = 0; i < 4; ++i)
#pragma unroll
                for (int j = 0; j < 4; ++j) acc[i][j] += k4[i] * v4[j]; }
        float* kv = (float*)(ws + WS_GKV) + ((size_t)((b * 4 + h) * 128 + n) * 64 + 4 * dkq) * 128 + 4 * dvq;
#pragma unroll
        for (int i = 0; i < 4; ++i) *(f32x4*)(kv + (size_t)i * 128) = (f32x4){acc[i][0], acc[i][1], acc[i][2], acc[i][3]};
    }
    __syncthreads();
}
__device__ __forceinline__ void gla_scan(const Frame& F, const Args& a) {
    int tid = F.wave * 64 + lane_id(); asm volatile("" : "+v"(tid));
    if (tid >= 256) return;
    for (int e = F.vcu * 256 + tid; e < 65536; e += F.G * 256) {
    const int bh = e >> 13, dk = (e >> 7) & 63, dv = e & 127;
    float* kv = (float*)(a.ws + WS_GKV) + ((size_t)bh * 128 * 64 + dk) * 128 + dv; const float* dc = (const float*)(a.ws + WS_GDEC) + (size_t)bh * 128 * 64 + dk;
    float S = 0.f;
    for (int n0 = 0; n0 < 128; n0 += 8) { float kvv[8], dd[8];
#pragma unroll
        for (int j = 0; j < 8; ++j) { kvv[j] = kv[(size_t)(n0 + j) * 8192]; dd[j] = dc[(size_t)(n0 + j) * 64]; }
#pragma unroll
        for (int j = 0; j < 8; ++j) { kv[(size_t)(n0 + j) * 8192] = S; S = dd[j] * S + kvv[j]; } }
    a.out[O_GSP + (size_t)bh * 8192 + dk * 128 + dv] = S;
    }
}
__device__ __forceinline__ float silu(float x) { return x / (1.f + __expf(-x)); }
__device__ __forceinline__ void gla_sample_unit(const Frame& F, const Args& a, int u) {
    unsigned char* ws = a.ws;
    const int bs = u >> 2, h = u & 3; const int row0 = TP + bs * LS;
    LAS float* LA = (LAS float*)F.lds; LAS float* BL = LA + 512; LAS float* QD = BL + 64; LAS float* KI = QD + 512; LAS float* KR = KI + 512; LAS float* ATT = KR + 512; LAS float* OP = ATT + 64; LAS float* VS = OP + 4096;
    gla_gate_tile(F, (const float*)(ws + WS_GG), (const float*)a.in[I_WG2], (const float*)a.in[I_BG], row0, h, 8, LA, VS + 1024);
#pragma unroll
    for (int i = 0; i < 2; ++i) { const int e = F.tid + NTHR * i; VS[e] = ((const float*)(ws + WS_GV))[(size_t)(row0 + (e >> 7)) * 512 + h * 128 + (e & 127)]; }
    __syncthreads();
    if (F.tid < 64) { float run = 0.f;
#pragma unroll
        for (int t = 0; t < 8; ++t) { run += LA[t * 64 + F.tid]; LA[t * 64 + F.tid] = run; } BL[F.tid] = run; }
    __syncthreads();
    { const int e = F.tid, t = e >> 6, dk = e & 63; const float bb = LA[e];
      const float q = ((const float*)(ws + WS_GQ))[(size_t)(row0 + t) * 256 + h * 64 + dk], k = ((const float*)(ws + WS_GK))[(size_t)(row0 + t) * 256 + h * 64 + dk];
      QD[e] = q * __expf(bb); KI[e] = k * __expf(-bb); KR[e] = k * __expf(BL[dk] - bb); }
    __syncthreads();
    if (F.tid < 64) { const int t = F.tid >> 3, s = F.tid & 7; float acc = 0.f;
        if (s <= t) { for (int dk = 0; dk < 64; ++dk) acc += QD[t * 64 + dk] * KI[s * 64 + dk]; }
        ATT[F.tid] = acc; }
    const int dv = F.tid & 127, dkg = F.tid >> 7;
    {
        const float* st = (const float*)a.in[I_SGLA] + ((size_t)(bs * 4 + h) * 64 + dkg * 16) * 128 + dv;
        float S0[16];
#pragma unroll
        for (int i = 0; i < 16; ++i) S0[i] = st[(size_t)i * 128];
#pragma unroll
        for (int t = 0; t < 8; ++t) { float o = 0.f;
#pragma unroll
            for (int i = 0; i < 16; ++i) o += QD[t * 64 + dkg * 16 + i] * S0[i];
            OP[(dkg * 8 + t) * 128 + dv] = o; }
        float* so = a.out + O_GSS + ((size_t)(bs * 4 + h) * 64 + dkg * 16) * 128 + dv;
#pragma unroll
        for (int i = 0; i < 16; ++i) { float sn = __expf(BL[dkg * 16 + i]) * S0[i];
#pragma unroll
            for (int t = 0; t < 8; ++t) sn += KR[t * 64 + dkg * 16 + i] * VS[t * 128 + dv];
            so[(size_t)i * 128] = sn; }
    }
    __syncthreads();
    {
        const int t = F.wave; float o[2]; float ss = 0.f;
#pragma unroll
        for (int j = 0; j < 2; ++j) { const int d = 2 * F.lane + j; float v = OP[(0 * 8 + t) * 128 + d] + OP[(1 * 8 + t) * 128 + d] + OP[(2 * 8 + t) * 128 + d] + OP[(3 * 8 + t) * 128 + d];
            for (int s = 0; s <= t; ++s) v += ATT[t * 8 + s] * VS[s * 128 + d];
            o[j] = v; ss += v * v; }
        const float r = rsqrtf(wave_sum(ss) * (1.f / 128.f) + EPS);
        const float* ggo = (const float*)a.in[I_GGO] + h * 128 + 2 * F.lane; const float* gr = (const float*)(ws + WS_GR) + (size_t)(row0 + t) * 512 + h * 128 + 2 * F.lane;
        const float y0 = o[0] * r * ggo[0] * silu(gr[0]), y1 = o[1] * r * ggo[1] * silu(gr[1]);
        *(unsigned*)((bf16*)(ws + WS_MERGED) + (size_t)(row0 + t) * DM + 512 + h * 128 + 2 * F.lane) = pk2(y0, y1);
    }
    __syncthreads();
}


typedef short v4i16_t __attribute__((ext_vector_type(4)));
__device__ __forceinline__ s16x4 lds_tr16(LAS unsigned char* p) { return __builtin_bit_cast(s16x4, __builtin_amdgcn_ds_read_tr16_b64_v4i16((LAS v4i16_t*)p)); }
__device__ __forceinline__ int crow(int r, int hi) { return (r & 3) + 8 * (r >> 2) + 4 * hi; }
__device__ __forceinline__ float fexp2(float x) { return __builtin_amdgcn_exp2f(x); }
constexpr float FOX_SKIP = 160.f;


__device__ __forceinline__ void fox_norms_item(const Frame& F, const bf16* QF, const bf16* KF, const float* logf, float* FN, float* LC, float* BT, int item) {
    const int bh = item >> 5, qb = item & 31, b = bh >> 3, h = bh & 7;
    float qm = 0.f, km = 0.f;
    const float* lp = logf + ((size_t)b * SEQ + qb * 256 + 4 * F.lane) * 8 + h;
    const float l0 = lp[0], l1 = lp[8], l2 = lp[16], l3 = lp[24];
#pragma unroll
    for (int i = 0; i < 4; ++i) { const size_t row = (size_t)b * SEQ + qb * 256 + i * 64 + F.lane;
        const v4u* qp = (const v4u*)(QF + row * 512 + h * 64); const v4u* kp = (const v4u*)(KF + row * 512 + h * 64); float qs = 0.f, ks = 0.f;
#pragma unroll
        for (int c = 0; c < 8; ++c) { const v4u q = qp[c], k = kp[c];
#pragma unroll
            for (int j = 0; j < 4; ++j) { qs += bflo(q[j]) * bflo(q[j]) + bfhi(q[j]) * bfhi(q[j]); ks += bflo(k[j]) * bflo(k[j]) + bfhi(k[j]) * bfhi(k[j]); } }
        qm = fmaxf(qm, qs); km = fmaxf(km, ks); }
#pragma unroll
    for (int o = 1; o < 64; o <<= 1) { qm = fmaxf(qm, __shfl_xor(qm, o)); km = fmaxf(km, __shfl_xor(km, o)); }
    const float c0 = l0, c1 = c0 + l1, c2 = c1 + l2, c3 = c2 + l3; float v = c3;
#pragma unroll
    for (int o = 1; o < 64; o <<= 1) { const float t = __shfl_up(v, o); if (F.lane >= o) v += t; }
    const float ex = v - c3;
    *(f32x4*)(LC + (size_t)bh * SEQ + qb * 256 + 4 * F.lane) = (f32x4){ex + c0, ex + c1, ex + c2, ex + c3};
    if (F.lane == 63) BT[item] = v;
    if (F.lane == 0) { FN[item * 2] = qm; FN[item * 2 + 1] = km; }
}
__device__ __forceinline__ void fox_suffix_item(const Frame& F, const float* cfl, const int* pt, float* SW, float* PTOT, int item) {
    const int bs = item >> 4, p = item & 15; const int pg = __builtin_amdgcn_readfirstlane(pt[item]);
    const f32x4* src = (const f32x4*)(cfl + ((size_t)pg * PAGE + 2 * F.lane) * 8);
    const f32x4 a0 = src[0], a1 = src[1], b0 = src[2], b1 = src[3];
    const float ra[8] = {a0.x, a0.y, a0.z, a0.w, a1.x, a1.y, a1.z, a1.w}, rb[8] = {b0.x, b0.y, b0.z, b0.w, b1.x, b1.y, b1.z, b1.w};
#pragma unroll
    for (int h = 0; h < 8; ++h) {
        const float ps = ra[h] + rb[h]; float v = ps;
#pragma unroll
        for (int o = 1; o < 64; o <<= 1) { const float t = __shfl_down(v, o); if (F.lane + o < 64) v += t; }
        const float exs = v - ps;
        *(f32x2*)(SW + (size_t)(bs * 8 + h) * PASTL + p * PAGE + 2 * F.lane) = (f32x2){exs + rb[h], exs};
        if (F.lane == 0) PTOT[(bs * 8 + h) * NPAGES + p] = v;
    }
}
__device__ __forceinline__ void fox_attn_unit(const Frame& F, const bf16* QF, const bf16* KF, const bf16* VF, const float* LC, const float* BT, const float* FN, bf16* merged, int b, int h, int qb) {
    int tid = F.wave * 64 + lane_id(); asm volatile("" : "+v"(tid));
    const int lane = tid & 63, r32 = lane & 31, hi = lane >> 5, wid = F.wave;
    const size_t rowbase = (size_t)b * SEQ; const int q0 = qb * 256;
    LAS unsigned char* Ks = F.lds; LAS unsigned char* Vs = F.lds + 8192; LAS float* KBs = (LAS float*)(F.lds + 20480); LAS float* WSF = (LAS float*)(F.lds + 20736) + wid * 32;
    const bf16* Qw = QF + (rowbase + q0 + wid * 32 + r32) * 512 + h * 64;
    bf16x8 qr[4];
#pragma unroll
    for (int d0 = 0; d0 < 4; ++d0) qr[d0] = *(const bf16x8*)(Qw + d0 * 16 + hi * 8);
    const float* lcp = LC + (size_t)(b * 8 + h) * SEQ;
    float pbx; { const float btv = (lane < 32) ? BT[(b * 8 + h) * 32 + lane] : 0.f; float v = btv;
#pragma unroll
        for (int o = 1; o < 64; o <<= 1) { const float t = __shfl_up(v, o); if (lane >= o) v += t; }
        pbx = v - btv; }
    const float cref = lcp[q0] + __shfl(pbx, qb);
#define FOX_KB(t_, pos_) (-LOG2E * ((lcp[pos_] + __shfl(pbx, (t_) >> 2)) - cref))
    const int NT = (q0 + 256) / 64;
    int t0 = 0;
    {
        float kn = (lane < 32) ? FN[((b * 8 + h) * 32 + lane) * 2 + 1] : 0.f;
#pragma unroll
        for (int o = 1; o < 64; o <<= 1) kn = fmaxf(kn, __shfl_xor(kn, o));
        const float qk2 = 2.f * sqrtf(FN[((b * 8 + h) * 32 + qb) * 2]) * sqrtf(kn) * 1.01f;
        const int nbefore = q0 / 64;
        int found = -1;
        for (int base = 0; base < nbefore && found < 0; base += 64) {
            const int tl = nbefore - 1 - base - lane;
            const int tlc = tl < 0 ? 0 : tl; const float kbl = -LOG2E * ((lcp[tlc * 64 + 63] + __shfl(pbx, tlc >> 2)) - cref);
            const bool dead = (tl >= 0) && (qk2 + kbl < -FOX_SKIP);
            const unsigned long long bm = __ballot(dead);
            if (bm) found = nbefore - 1 - base - (int)__builtin_ctzll(bm);
        }
        t0 = found + 1;
        t0 = __builtin_amdgcn_readfirstlane(t0);
    }
    const int kkey = tid & 63, kch = tid >> 6, vkey = tid >> 3, vch = tid & 7;
    const bf16* ksrc = KF + (rowbase + kkey) * 512 + h * 64 + kch * 8;
    const bf16* vsrc = VF + (rowbase + vkey) * 512 + h * 64 + vch * 8;
    v4u kreg[2], vreg[2]; float kbreg[2];
#pragma unroll
    for (int hb = 0; hb < 2; ++hb) { const int tt = (t0 + hb < NT) ? t0 + hb : t0;
        kreg[hb] = *(const v4u*)(ksrc + (size_t)tt * 64 * 512); vreg[hb] = *(const v4u*)(vsrc + (size_t)tt * 64 * 512); kbreg[hb] = FOX_KB(tt, tt * 64 + (tid & 63)); }
    float m_run = -INFINITY, l_run = 0.f; f32x16 o0 = {}, o1 = {};
    const int qpos = q0 + wid * 32 + r32;
    const int vbase = (4 * hi + ((lane & 15) >> 2)) * 192 + (16 * ((lane >> 4) & 1) + 4 * (lane & 3)) * 2;
    LAS unsigned char* const Ks0 = Ks; LAS unsigned char* const Vs0 = Vs; LAS float* const KBs0 = KBs;
    __syncthreads();
    for (int t2 = t0; t2 < NT; t2 += 2) {
#pragma unroll
      for (int hb = 0; hb < 2; ++hb) {
        const int t = t2 + hb;
        if (t < NT) {
        LAS unsigned char* const Ks = Ks0 + hb * 28672; LAS unsigned char* const Vs = Vs0 + hb * 28672; LAS float* const KBs = (LAS float*)((LAS unsigned char*)KBs0 + hb * 28672);
        *(LAS v4u*)(Ks + kch * 1024 + kkey * 16) = kreg[hb]; *(LAS v4u*)(Vs + vkey * 192 + vch * 16) = vreg[hb]; if (tid < 64) KBs[tid] = kbreg[hb];
        __syncthreads();
        if (t + 2 < NT) { kreg[hb] = *(const v4u*)(ksrc + (size_t)(t + 2) * 64 * 512); vreg[hb] = *(const v4u*)(vsrc + (size_t)(t + 2) * 64 * 512); kbreg[hb] = FOX_KB(t + 2, (t + 2) * 64 + (tid & 63)); }
        const int k0 = t * 64;
        if (k0 <= q0 + wid * 32 + 31) {
        f32x16 p0, p1;
#pragma unroll
        for (int g = 0; g < 4; ++g) { const f32x4 ba = *(const LAS f32x4*)(KBs + 8 * g + 4 * hi), bb = *(const LAS f32x4*)(KBs + 32 + 8 * g + 4 * hi);
#pragma unroll
            for (int i = 0; i < 4; ++i) { p0[4 * g + i] = ba[i]; p1[4 * g + i] = bb[i]; } }
#pragma unroll
        for (int d0 = 0; d0 < 4; ++d0) {
            const bf16x8 a0 = *(const LAS bf16x8*)(Ks + (2 * d0 + hi) * 1024 + r32 * 16), a1 = *(const LAS bf16x8*)(Ks + (2 * d0 + hi) * 1024 + r32 * 16 + 512);
            p0 = __builtin_amdgcn_mfma_f32_32x32x16_bf16(a0, qr[d0], p0, 0, 0, 0); p1 = __builtin_amdgcn_mfma_f32_32x32x16_bf16(a1, qr[d0], p1, 0, 0, 0);
        }
        if (k0 + 63 > q0 + wid * 32) {
#pragma unroll
            for (int r = 0; r < 16; ++r) { const int key = k0 + crow(r, hi); if (key > qpos) p0[r] = -INFINITY; if (key + 32 > qpos) p1[r] = -INFINITY; }
        }
        float mx = fmaxf(p0[0], p1[0]);
#pragma unroll
        for (int r = 1; r < 16; ++r) mx = fmaxf(mx, fmaxf(p0[r], p1[r]));
        mx = fmaxf(mx, __shfl_xor(mx, 32));
        const float m_new = fmaxf(m_run, mx), alpha = fexp2(m_run - m_new); m_run = m_new;
        float ls = 0.f;
#pragma unroll
        for (int r = 0; r < 16; ++r) { p0[r] = fexp2(p0[r] - m_new); p1[r] = fexp2(p1[r] - m_new); ls += p0[r] + p1[r]; }
        l_run = l_run * alpha + ls;
        if (__ballot(alpha != 1.f) != 0ull) {
            if (hi == 0) WSF[r32] = alpha;
#pragma unroll
            for (int g = 0; g < 4; ++g) { const f32x4 al = *(const LAS f32x4*)(WSF + 8 * g + 4 * hi);
#pragma unroll
                for (int i = 0; i < 4; ++i) { o0[4 * g + i] *= al[i]; o1[4 * g + i] *= al[i]; } }
        }
        v4u pw[4];
#pragma unroll
        for (int j = 0; j < 4; ++j) { pw[0][j] = pg8::cvt_pk_bf16(p0[2 * j], p0[2 * j + 1]); pw[1][j] = pg8::cvt_pk_bf16(p0[8 + 2 * j], p0[8 + 2 * j + 1]);
                                      pw[2][j] = pg8::cvt_pk_bf16(p1[2 * j], p1[2 * j + 1]); pw[3][j] = pg8::cvt_pk_bf16(p1[8 + 2 * j], p1[8 + 2 * j + 1]); }
#pragma unroll
        for (int ks = 0; ks < 4; ++ks) {
            const bf16x8 pa = __builtin_bit_cast(bf16x8, pw[ks]);
#pragma unroll
            for (int d0 = 0; d0 < 2; ++d0) {
                const s16x4 lo = lds_tr16(Vs + vbase + ks * 16 * 192 + d0 * 64), hi4 = lds_tr16(Vs + vbase + ks * 16 * 192 + 8 * 192 + d0 * 64);
                const bf16x8 vb = (bf16x8){lo[0], lo[1], lo[2], lo[3], hi4[0], hi4[1], hi4[2], hi4[3]};
                if (d0 == 0) o0 = __builtin_amdgcn_mfma_f32_32x32x16_bf16(pa, vb, o0, 0, 0, 0); else o1 = __builtin_amdgcn_mfma_f32_32x32x16_bf16(pa, vb, o1, 0, 0, 0);
            }
        }
        }
        }
      }
    }
    l_run += __shfl_xor(l_run, 32);
    if (hi == 0) WSF[r32] = 1.f / l_run;
    bf16* Ow = merged + (rowbase + q0 + wid * 32) * DM + h * 64 + r32;
#pragma unroll
    for (int g = 0; g < 4; ++g) { const f32x4 rl = *(const LAS f32x4*)(WSF + 8 * g + 4 * hi);
#pragma unroll
        for (int i = 0; i < 4; ++i) { const int r = 4 * g + i; const int row = crow(r, hi);
            Ow[(size_t)row * DM] = (bf16)f2bf(o0[r] * rl[i]); Ow[(size_t)row * DM + 32] = (bf16)f2bf(o1[r] * rl[i]); } }
    __syncthreads();
#undef FOX_KB
}

template <int D> struct DecW {
    static constexpr int KS = D / 32;
    static constexpr int LPK = D / 4;
    static constexpr int KPI = 64 / LPK;
    float m[4], l[4]; float o[8][4];
};
template <int D>
__device__ __forceinline__ void dec_init(DecW<D>& w) {
#pragma unroll
    for (int i = 0; i < 4; ++i) { w.m[i] = -INFINITY; w.l[i] = 0.f; }
#pragma unroll
    for (int q = 0; q < 8; ++q)
#pragma unroll
        for (int j = 0; j < 4; ++j) w.o[q][j] = 0.f;
}
template <int D, int NTILE, int MODE>
__device__ __forceinline__ void dec_chunk(DecW<D>& w, const bf16x8 (&qa)[D / 32], const float* Kb, const float* Vb, int stride, const float* bias, float nb, LAS float* PL, int lane) {
    constexpr int KS = D / 32, LPK = D / 4, KPI = 64 / LPK;
    constexpr int NK = (MODE == 1) ? 8 : NTILE * 16, NV = NK / KPI;
    const int key = lane & 15, kq = lane >> 4;
    const unsigned koff = (unsigned)(key * stride + 8 * kq) * 4u;
    const int d4 = lane % LPK, ksub = lane / LPK;
    const unsigned voff = (unsigned)(ksub * stride + 4 * d4) * 4u;
    f32x4 kx[NTILE][2 * KS], vx[NV];
#pragma unroll
    for (int t = 0; t < NTILE; ++t) { const char* kp = (const char*)(Kb + (size_t)t * 16 * stride) + koff;
#pragma unroll
        for (int ks = 0; ks < KS; ++ks) { kx[t][2 * ks] = *(const f32x4*)(kp + 128 * ks); kx[t][2 * ks + 1] = *(const f32x4*)(kp + 128 * ks + 16); } }
    constexpr int NVA = (NV >= 8) ? NV / 2 : NV;
#pragma unroll
    for (int kk = 0; kk < NVA; ++kk) vx[kk] = *(const f32x4*)((const char*)(Vb + (size_t)kk * KPI * stride) + voff);
    f32x4 s[NTILE];
#pragma unroll
    for (int t = 0; t < NTILE; ++t) {
        f32x4 acc = {0.f, 0.f, 0.f, 0.f};
#pragma unroll
        for (int ks = 0; ks < KS; ++ks) { const f32x4 x0 = kx[t][2 * ks], x1 = kx[t][2 * ks + 1];
            v4u kb; kb.x = pg8::cvt_pk_bf16(x0.x, x0.y); kb.y = pg8::cvt_pk_bf16(x0.z, x0.w); kb.z = pg8::cvt_pk_bf16(x1.x, x1.y); kb.w = pg8::cvt_pk_bf16(x1.z, x1.w);
            acc = __builtin_amdgcn_mfma_f32_16x16x32_bf16(qa[ks], __builtin_bit_cast(bf16x8, kb), acc, 0, 0, 0); }
        if (MODE == 0) { if (bias) { const float bv = (bias[t * 16 + key] + nb) * LOG2E; acc += bv; } }
        else { acc += nb;
#pragma unroll
            for (int i = 0; i < 4; ++i) if (key > 4 * kq + i || key >= 8) acc[i] = -INFINITY; }
        s[t] = acc;
    }
#pragma unroll
    for (int kk = NVA; kk < NV; ++kk) vx[kk] = *(const f32x4*)((const char*)(Vb + (size_t)kk * KPI * stride) + voff);
    f32x4 mc = s[0];
#pragma unroll
    for (int t = 1; t < NTILE; ++t) { mc.x = fmaxf(mc.x, s[t].x); mc.y = fmaxf(mc.y, s[t].y); mc.z = fmaxf(mc.z, s[t].z); mc.w = fmaxf(mc.w, s[t].w); }
#pragma unroll
    for (int o = 1; o < 16; o <<= 1) { mc.x = fmaxf(mc.x, __shfl_xor(mc.x, o)); mc.y = fmaxf(mc.y, __shfl_xor(mc.y, o)); mc.z = fmaxf(mc.z, __shfl_xor(mc.z, o)); mc.w = fmaxf(mc.w, __shfl_xor(mc.w, o)); }
    float al[4];
#pragma unroll
    for (int i = 0; i < 4; ++i) { const float mn = fmaxf(w.m[i], mc[i]); al[i] = (mn == -INFINITY) ? 1.f : fexp2(w.m[i] - mn); w.m[i] = mn; w.l[i] *= al[i]; }
#pragma unroll
    for (int t = 0; t < NTILE; ++t) { f32x4 p;
#pragma unroll
        for (int i = 0; i < 4; ++i) { p[i] = (w.m[i] == -INFINITY) ? 0.f : fexp2(s[t][i] - w.m[i]); w.l[i] += p[i]; }
        if (kq < 2) *(LAS f32x4*)(PL + (t * 16 + key) * 8 + 4 * kq) = p; }
    if (key == 0 && kq < 2) *(LAS f32x4*)(PL + 1024 + 4 * kq) = (f32x4){al[0], al[1], al[2], al[3]};
    { const f32x4 a0 = *(const LAS f32x4*)(PL + 1024), a1 = *(const LAS f32x4*)(PL + 1028);
#pragma unroll
      for (int j = 0; j < 4; ++j) { w.o[0][j] *= a0.x; w.o[1][j] *= a0.y; w.o[2][j] *= a0.z; w.o[3][j] *= a0.w; w.o[4][j] *= a1.x; w.o[5][j] *= a1.y; w.o[6][j] *= a1.z; w.o[7][j] *= a1.w; } }
#pragma unroll
    for (int kk = 0; kk < NV; ++kk) { const int k = kk * KPI + ksub;
        const f32x4 v = vx[kk];
        const f32x4 pa = *(const LAS f32x4*)(PL + k * 8), pb = *(const LAS f32x4*)(PL + k * 8 + 4);
#pragma unroll
        for (int j = 0; j < 4; ++j) { w.o[0][j] += pa.x * v[j]; w.o[1][j] += pa.y * v[j]; w.o[2][j] += pa.z * v[j]; w.o[3][j] += pa.w * v[j];
                                      w.o[4][j] += pb.x * v[j]; w.o[5][j] += pb.y * v[j]; w.o[6][j] += pb.z * v[j]; w.o[7][j] += pb.w * v[j]; } }
}
__device__ __forceinline__ void dec_page_fox(DecW<64>& w, const bf16x8 (&qa)[2], const float* Kb, const float* Vb, const float* bias, float boff, LAS float* PL, int lane) {
    constexpr int stride = 512;
    const int key = lane & 15, kq = lane >> 4;
    const unsigned koff = (unsigned)(key * stride + 8 * kq) * 4u;
    const int d4 = lane & 15, ksub = lane >> 4;
    const unsigned voff = (unsigned)(ksub * stride + 4 * d4) * 4u;
    const __amdgpu_buffer_rsrc_t krs = __builtin_amdgcn_make_buffer_rsrc((void*)Kb, 0, 0x7fffffff, 0x00020000);
    const __amdgpu_buffer_rsrc_t vrs = __builtin_amdgcn_make_buffer_rsrc((void*)Vb, 0, 0x7fffffff, 0x00020000);
    const __amdgpu_buffer_rsrc_t brs = __builtin_amdgcn_make_buffer_rsrc((void*)bias, 0, 0x7fffffff, 0x00020000);
    f32x4 s[8];
#pragma unroll
    for (int hb = 0; hb < 2; ++hb) {
        f32x4 kx[4][4];
#pragma unroll
        for (int t = 0; t < 4; ++t) { const int so = (hb * 4 + t) * 16 * stride * 4;
            kx[t][0] = __builtin_bit_cast(f32x4, __builtin_amdgcn_raw_buffer_load_b128(krs, (int)koff, so, 0)); kx[t][1] = __builtin_bit_cast(f32x4, __builtin_amdgcn_raw_buffer_load_b128(krs, (int)koff + 16, so, 0));
            kx[t][2] = __builtin_bit_cast(f32x4, __builtin_amdgcn_raw_buffer_load_b128(krs, (int)koff + 128, so, 0)); kx[t][3] = __builtin_bit_cast(f32x4, __builtin_amdgcn_raw_buffer_load_b128(krs, (int)koff + 144, so, 0)); }
#pragma unroll
        for (int t = 0; t < 4; ++t) {
            f32x4 acc = {0.f, 0.f, 0.f, 0.f};
#pragma unroll
            for (int ks = 0; ks < 2; ++ks) { const f32x4 x0 = kx[t][2 * ks], x1 = kx[t][2 * ks + 1];
                v4u kb; kb.x = pg8::cvt_pk_bf16(x0.x, x0.y); kb.y = pg8::cvt_pk_bf16(x0.z, x0.w); kb.z = pg8::cvt_pk_bf16(x1.x, x1.y); kb.w = pg8::cvt_pk_bf16(x1.z, x1.w);
                acc = __builtin_amdgcn_mfma_f32_16x16x32_bf16(qa[ks], __builtin_bit_cast(bf16x8, kb), acc, 0, 0, 0); }
            acc += (__builtin_bit_cast(float, __builtin_amdgcn_raw_buffer_load_b32(brs, key * 4, (hb * 4 + t) * 64, 0)) + boff) * LOG2E;
            s[hb * 4 + t] = acc;
        }
        asm volatile("" ::: "memory");
    }
    f32x4 mc = s[0];
#pragma unroll
    for (int t = 1; t < 8; ++t) { mc.x = fmaxf(mc.x, s[t].x); mc.y = fmaxf(mc.y, s[t].y); mc.z = fmaxf(mc.z, s[t].z); mc.w = fmaxf(mc.w, s[t].w); }
#pragma unroll
    for (int o = 1; o < 16; o <<= 1) { mc.x = fmaxf(mc.x, __shfl_xor(mc.x, o)); mc.y = fmaxf(mc.y, __shfl_xor(mc.y, o)); mc.z = fmaxf(mc.z, __shfl_xor(mc.z, o)); mc.w = fmaxf(mc.w, __shfl_xor(mc.w, o)); }
    float al[4];
#pragma unroll
    for (int i = 0; i < 4; ++i) { const float mn = fmaxf(w.m[i], mc[i]); al[i] = fexp2(w.m[i] - mn); w.m[i] = mn; w.l[i] *= al[i]; }
    bool nz = false;
#pragma unroll
    for (int t = 0; t < 8; ++t) { f32x4 p;
#pragma unroll
        for (int i = 0; i < 4; ++i) { p[i] = fexp2(s[t][i] - w.m[i]); w.l[i] += p[i]; nz = nz || (p[i] != 0.f); }
        if (kq < 2) *(LAS f32x4*)(PL + (t * 16 + key) * 8 + 4 * kq) = p; }
    if (__ballot(nz && kq < 2) == 0ull) return;
    if (key == 0 && kq < 2) *(LAS f32x4*)(PL + 1024 + 4 * kq) = (f32x4){al[0], al[1], al[2], al[3]};
    { const f32x4 a0 = *(const LAS f32x4*)(PL + 1024), a1 = *(const LAS f32x4*)(PL + 1028);
#pragma unroll
      for (int j = 0; j < 4; ++j) { w.o[0][j] *= a0.x; w.o[1][j] *= a0.y; w.o[2][j] *= a0.z; w.o[3][j] *= a0.w; w.o[4][j] *= a1.x; w.o[5][j] *= a1.y; w.o[6][j] *= a1.z; w.o[7][j] *= a1.w; } }
#pragma unroll 1
    for (int vh = 0; vh < 2; ++vh) {
    f32x4 vx[16];
#pragma unroll
    for (int kk = 0; kk < 16; ++kk) vx[kk] = __builtin_bit_cast(f32x4, __builtin_amdgcn_raw_buffer_load_b128(vrs, (int)voff, (vh * 16 + kk) * 4 * stride * 4, 0));
#pragma unroll
    for (int kk = 0; kk < 16; ++kk) { const int k = (vh * 16 + kk) * 4 + ksub;
        const f32x4 v = vx[kk];
        const f32x4 pa = *(const LAS f32x4*)(PL + k * 8), pb = *(const LAS f32x4*)(PL + k * 8 + 4);
#pragma unroll
        for (int j = 0; j < 4; ++j) { w.o[0][j] += pa.x * v[j]; w.o[1][j] += pa.y * v[j]; w.o[2][j] += pa.z * v[j]; w.o[3][j] += pa.w * v[j];
                                      w.o[4][j] += pb.x * v[j]; w.o[5][j] += pb.y * v[j]; w.o[6][j] += pb.z * v[j]; w.o[7][j] += pb.w * v[j]; } }
    }
}
template <int D>
__device__ __forceinline__ void dec_park(DecW<D>& w, LAS float* CBw, int lane) {
    constexpr int LPK = D / 4;
    const int key = lane & 15, kq = lane >> 4, d4 = lane % LPK, ksub = lane / LPK;
#pragma unroll
    for (int i = 0; i < 4; ++i) { float l = w.l[i];
#pragma unroll
        for (int o = 1; o < 16; o <<= 1) l += __shfl_xor(l, o);
        w.l[i] = l; }
    if (key == 0 && kq < 2) { *(LAS f32x4*)(CBw + 4 * kq) = (f32x4){w.m[0], w.m[1], w.m[2], w.m[3]}; *(LAS f32x4*)(CBw + 8 + 4 * kq) = (f32x4){w.l[0], w.l[1], w.l[2], w.l[3]}; }
#pragma unroll
    for (int q = 0; q < 8; ++q) { f32x4 v = (f32x4){w.o[q][0], w.o[q][1], w.o[q][2], w.o[q][3]};
        if (LPK < 64) {
#pragma unroll
            for (int o = LPK; o < 64; o <<= 1) { v.x += __shfl_xor(v.x, o); v.y += __shfl_xor(v.y, o); v.z += __shfl_xor(v.z, o); v.w += __shfl_xor(v.w, o); } }
        if (ksub == 0) *(LAS f32x4*)(CBw + 16 + q * D + 4 * d4) = v; }
}
template <int D>
__device__ __forceinline__ void dec_combine(int tid, LAS float* CB, bf16* dst, int ldd) {
    constexpr int WSTR = 16 + 8 * D;
    for (int e = tid; e < 8 * D; e += NTHR) { const int q = e / D, d = e % D;
        float mt = -INFINITY;
#pragma unroll
        for (int w = 0; w < 8; ++w) mt = fmaxf(mt, CB[w * WSTR + q]);
        float num = 0.f, den = 0.f;
#pragma unroll
        for (int w = 0; w < 8; ++w) { const float mw = CB[w * WSTR + q]; const float f = (mw == -INFINITY) ? 0.f : fexp2(mw - mt); num += f * CB[w * WSTR + 16 + q * D + d]; den += f * CB[w * WSTR + 8 + q]; }
        dst[(size_t)q * ldd + d] = (bf16)f2bf(num / den); }
}
template <int D>
__device__ __forceinline__ void dec_load_q(bf16x8 (&qa)[D / 32], const bf16* Q, int ldq, int lane) {
    const int row = lane & 15, kq = lane >> 4;
#pragma unroll
    for (int ks = 0; ks < D / 32; ++ks) { v4u z = {0u, 0u, 0u, 0u}; if (row < 8) z = *(const v4u*)(Q + (size_t)row * ldq + 32 * ks + 8 * kq); qa[ks] = __builtin_bit_cast(bf16x8, z); }
}
constexpr int DEC_PL = 1040;
__device__ __forceinline__ void fox_sample_unit(const Frame& F, const Args& a, int u) {
    unsigned char* ws = a.ws; const int bs = u >> 3, h = u & 7;
    int ln = lane_id(); asm volatile("" : "+v"(ln));
    LAS float* PL = (LAS float*)F.lds + F.wave * DEC_PL; LAS float* CB = (LAS float*)F.lds + 8 * DEC_PL; constexpr int WSTR = 16 + 8 * 64;
    bf16x8 qa[2]; dec_load_q<64>(qa, (const bf16*)(ws + WS_QF) + (size_t)(TP + bs * LS) * 512 + h * 64, 512, ln);
    DecW<64> w; dec_init(w);
    {
        const int key = ln & 15; const float* lf = a.out + O_LFS + (size_t)(bs * LS) * 8 + h; float cn = 0.f;
#pragma unroll
        for (int j = 0; j < 8; ++j) { const float x = lf[j * 8]; cn += (j <= key) ? x : 0.f; }
        const float* Kb = a.out + O_FKS + (size_t)(bs * LS) * 512 + h * 64; const float* Vb = a.out + O_FVS + (size_t)(bs * LS) * 512 + h * 64;
        dec_chunk<64, 1, 1>(w, qa, Kb, Vb, 512, nullptr, -cn * LOG2E, PL, ln);
        if (F.wave != 0) {
#pragma unroll
            for (int i = 0; i < 4; ++i) w.l[i] = 0.f;
#pragma unroll
            for (int q = 0; q < 8; ++q)
#pragma unroll
                for (int j = 0; j < 4; ++j) w.o[q][j] = 0.f; }
    }
    const int* pt = (const int*)a.in[I_PT];
    float spx; { const float ptv = (ln < 16) ? ((const float*)(ws + WS_MISC + 2 * MiB))[(bs * 8 + h) * NPAGES + ln] : 0.f; float v = ptv;
#pragma unroll
        for (int o = 1; o < 16; o <<= 1) { const float t = __builtin_bit_cast(float, __builtin_amdgcn_ds_bpermute((ln + o) << 2, __builtin_bit_cast(int, v))); if (ln + o < 16) v += t; }
        spx = v - ptv; }
#if defined(OLD_FOXS)
#pragma unroll 1
    for (int pp = 0; pp < 4; ++pp) { const int p = F.wave * 2 + (pp >> 1), hf = pp & 1; const int pg = __builtin_amdgcn_readfirstlane(pt[bs * NPAGES + p]);
        const float* Kb = (const float*)a.in[I_CFK] + (((size_t)pg * PAGE + hf * 64) * 8 + h) * 64; const float* Vb = (const float*)a.in[I_CFV] + (((size_t)pg * PAGE + hf * 64) * 8 + h) * 64;
        dec_chunk<64, 4, 0>(w, qa, Kb, Vb, 512, (const float*)(ws + WS_SUF) + (size_t)(bs * 8 + h) * PASTL + p * PAGE + hf * 64, __builtin_bit_cast(float, __builtin_amdgcn_ds_bpermute(p << 2, __builtin_bit_cast(int, spx))), PL, ln); }
#else
#pragma unroll 1
    for (int pp = 1; pp >= 0; --pp) { const int p = pp ? (NPAGES - 1 - F.wave) : F.wave;
        const int pg = __builtin_amdgcn_readfirstlane(pt[bs * NPAGES + p]);
        const float* Kb = (const float*)a.in[I_CFK] + ((size_t)pg * PAGE * 8 + h) * 64; const float* Vb = (const float*)a.in[I_CFV] + ((size_t)pg * PAGE * 8 + h) * 64;
        dec_page_fox(w, qa, Kb, Vb, (const float*)(ws + WS_SUF) + (size_t)(bs * 8 + h) * PASTL + p * PAGE, __builtin_bit_cast(float, __builtin_amdgcn_ds_bpermute(p << 2, __builtin_bit_cast(int, spx))), PL, ln); }
#endif
    dec_park<64>(w, CB + F.wave * WSTR, ln);
    __syncthreads();
    dec_combine<64>(F.wave * 64 + ln, CB, (bf16*)(ws + WS_MERGED) + (size_t)(TP + bs * LS) * DM + h * 64, DM);
    __syncthreads();
}
__device__ __forceinline__ void cross_sample_unit(const Frame& F, const Args& a, int u) {
    unsigned char* ws = a.ws; const int bs = u >> 2, h = u & 3;
    LAS float* PL = (LAS float*)F.lds + F.wave * DEC_PL; LAS float* CB = (LAS float*)F.lds + 8 * DEC_PL; constexpr int WSTR = 16 + 8 * 256;
    bf16x8 qa[8]; dec_load_q<256>(qa, (const bf16*)(ws + WS_QC) + (size_t)(TP + bs * LS) * DM + h * 256, DM, F.lane);
    DecW<256> w; dec_init(w);
    const float* Kb = (const float*)a.in[I_CMK] + ((size_t)(bs * 256 + F.wave * 32) * 4 + h) * 256; const float* Vb = (const float*)a.in[I_CMV] + ((size_t)(bs * 256 + F.wave * 32) * 4 + h) * 256;
#pragma unroll 1
    for (int c = 0; c < 2; ++c) dec_chunk<256, 1, 0>(w, qa, Kb + (size_t)c * 16 * 1024, Vb + (size_t)c * 16 * 1024, 1024, nullptr, 0.f, PL, F.lane);
    dec_park<256>(w, CB + F.wave * WSTR, F.lane);
    __syncthreads();
    dec_combine<256>(F.tid, CB, (bf16*)(ws + WS_OC) + (size_t)(TP + bs * LS) * DM + h * 256, DM);
    __syncthreads();
}


__device__ __forceinline__ void gla_g3_unit(const Frame& F, const Args& a, int u) {
    unsigned char* ws = a.ws;
    const int b = u >> 9, h = (u >> 7) & 3, n = u & 127; const int row0 = b * SEQ + n * 64;
    LAS float* QDT = (LAS float*)F.lds; LAS float* KIT = QDT + 4352; LAS float* LA = KIT + 4352; LAS float* ATT = LA; LAS float* VS = LA + 4352; LAS float* SP = VS + 8192;
#pragma unroll
    for (int i = 0; i < 16; ++i) { const int e = F.tid + NTHR * i; VS[e] = ((const float*)(ws + WS_GV))[(size_t)(row0 + (e >> 7)) * 512 + h * 128 + (e & 127)];
        SP[e] = ((const float*)(ws + WS_GKV))[((size_t)((b * 4 + h) * 128 + n) * 64) * 128 + e]; }
#pragma unroll
    for (int i = 0; i < 8; ++i) { const int e = F.tid + NTHR * i, t = e >> 6, dk = e & 63; const size_t gi = (size_t)(row0 + t) * 256 + h * 64 + dk;
        const float bb = ((const float*)(ws + WS_BB))[gi];
        QDT[dk * 68 + t] = ((const float*)(ws + WS_GQ))[gi] * __expf(bb); KIT[dk * 68 + t] = ((const float*)(ws + WS_GK))[gi] * __expf(-bb); }
    __syncthreads();
    {
        const int tp = F.tid & 31, sq = F.tid >> 5; float acc[2][4];
#pragma unroll
        for (int i = 0; i < 2; ++i)
#pragma unroll
            for (int j = 0; j < 4; ++j) acc[i][j] = 0.f;
        if (4 * sq <= 2 * tp + 1) {
#pragma unroll 8
            for (int dk = 0; dk < 64; ++dk) { const f32x2 q2 = *(const LAS f32x2*)(QDT + dk * 68 + 2 * tp); const f32x4 k4 = *(const LAS f32x4*)(KIT + dk * 68 + 4 * sq);
#pragma unroll
                for (int j = 0; j < 4; ++j) { acc[0][j] += q2.x * k4[j]; acc[1][j] += q2.y * k4[j]; } }
        }
#pragma unroll
        for (int j = 0; j < 4; ++j) { const int s = 4 * sq + j; f32x2 o; o.x = (s <= 2 * tp) ? acc[0][j] : 0.f; o.y = (s <= 2 * tp + 1) ? acc[1][j] : 0.f; *(LAS f32x2*)(ATT + s * 68 + 2 * tp) = o; }
    }
    __syncthreads();
    {
        const int dvq = F.tid & 31, tq = F.tid >> 5; float acc[4][4];
#pragma unroll
        for (int i = 0; i < 4; ++i)
#pragma unroll
            for (int j = 0; j < 4; ++j) acc[i][j] = 0.f;
#pragma unroll 8
        for (int s = 0; s < 64; ++s) { const f32x4 v4 = *(const LAS f32x4*)(VS + s * 128 + 4 * dvq), a4 = *(const LAS f32x4*)(ATT + s * 68 + 4 * tq);
#pragma unroll
            for (int i = 0; i < 4; ++i)
#pragma unroll
                for (int j = 0; j < 4; ++j) acc[i][j] += a4[i] * v4[j]; }
#pragma unroll 8
        for (int dk = 0; dk < 64; ++dk) { const f32x4 v4 = *(const LAS f32x4*)(SP + dk * 128 + 4 * dvq), a4 = *(const LAS f32x4*)(QDT + dk * 68 + 4 * tq);
#pragma unroll
            for (int i = 0; i < 4; ++i)
#pragma unroll
                for (int j = 0; j < 4; ++j) acc[i][j] += a4[i] * v4[j]; }
        __syncthreads();
#pragma unroll
        for (int i = 0; i < 4; ++i) *(LAS f32x4*)(VS + (4 * tq + i) * 128 + 4 * dvq) = (f32x4){acc[i][0], acc[i][1], acc[i][2], acc[i][3]};
    }
    __syncthreads();
#pragma unroll
    for (int rr = 0; rr < 8; ++rr) { const int t = F.wave * 8 + rr; const float v0 = VS[t * 128 + F.lane], v1 = VS[t * 128 + 64 + F.lane];
        const float r = rsqrtf(wave_sum(v0 * v0 + v1 * v1) * (1.f / 128.f) + EPS);
        const float* ggo = (const float*)a.in[I_GGO] + h * 128; const float* gr = (const float*)(ws + WS_GR) + (size_t)(row0 + t) * 512 + h * 128;
        bf16* mo = (bf16*)(ws + WS_MERGED) + (size_t)(row0 + t) * DM + 512 + h * 128;
        mo[F.lane] = (bf16)f2bf(v0 * r * ggo[F.lane] * silu(gr[F.lane])); mo[64 + F.lane] = (bf16)f2bf(v1 * r * ggo[64 + F.lane] * silu(gr[64 + F.lane])); }
    __syncthreads();
}

struct EpiSoftmaxP {
    static constexpr bool PERM = false, AFTER_DRAIN = true;
    const LAS unsigned long long* argp;
    __device__ __forceinline__ void fused(f32x4 (&acc)[2][2][4][2], const Unit&, int wr, int wc, int fr, int fq, PG8_LAS unsigned char* lds, int wid, int lane) const {
        LAS float* PM = (LAS float*)lds; LAS float* PS = PM + 1024;
        const int ub = (int)blockIdx.x; const int ldp = DM;
        bf16* P = (bf16*)((unsigned char*)ld_ptr(argp + N_INPUTS + 1) + WS_PC) + ((size_t)((ub >> 7) & 1) * SEQ + (ub & 31) * 256) * DM + ((ub >> 5) & 3) * 256;
        { int t2 = lane_id(); asm volatile("" : "+v"(t2)); fr = t2 & 15; fq = (t2 >> 4) & 3; }
#pragma unroll
        for (int ai = 0; ai < 2; ++ai)
#pragma unroll
            for (int m = 0; m < 4; ++m) { float mx = -INFINITY;
#pragma unroll
                for (int bj = 0; bj < 2; ++bj)
#pragma unroll
                    for (int n = 0; n < 2; ++n) { const f32x4 x = acc[ai][bj][m][n]; mx = fmaxf(mx, fmaxf(fmaxf(x[0], x[1]), fmaxf(x[2], x[3]))); }
                mx = fmaxf(mx, __shfl_xor(mx, 16)); mx = fmaxf(mx, __shfl_xor(mx, 32));
                if (fq == 0) PM[(ai * 128 + wr * 64 + m * 16 + fr) * 4 + wc] = mx; }
        asm volatile("s_waitcnt lgkmcnt(0)" ::: "memory"); __builtin_amdgcn_s_barrier(); asm volatile("" ::: "memory");
#pragma unroll
        for (int ai = 0; ai < 2; ++ai)
#pragma unroll
            for (int m = 0; m < 4; ++m) { const int r = ai * 128 + wr * 64 + m * 16 + fr; const f32x4 pm = *(const LAS f32x4*)(PM + r * 4);
                const float M = fmaxf(fmaxf(pm[0], pm[1]), fmaxf(pm[2], pm[3])); float s = 0.f;
#pragma unroll
                for (int bj = 0; bj < 2; ++bj)
#pragma unroll
                    for (int n = 0; n < 2; ++n) { f32x4 x = acc[ai][bj][m][n]; x[0] = fexp2(x[0] - M); x[1] = fexp2(x[1] - M); x[2] = fexp2(x[2] - M); x[3] = fexp2(x[3] - M); acc[ai][bj][m][n] = x; s += (x[0] + x[1]) + (x[2] + x[3]); }
                s += __shfl_xor(s, 16); s += __shfl_xor(s, 32);
                if (fq == 0) PS[r * 4 + wc] = s; }
        asm volatile("s_waitcnt lgkmcnt(0)" ::: "memory"); __builtin_amdgcn_s_barrier(); asm volatile("" ::: "memory");
#pragma unroll
        for (int ai = 0; ai < 2; ++ai)
#pragma unroll
            for (int m = 0; m < 4; ++m) { const int r = ai * 128 + wr * 64 + m * 16 + fr; const f32x4 ps = *(const LAS f32x4*)(PS + r * 4); const float inv = 1.f / ((ps[0] + ps[1]) + (ps[2] + ps[3]));
#pragma unroll
                for (int bj = 0; bj < 2; ++bj)
#pragma unroll
                    for (int n = 0; n < 2; ++n) { const f32x4 x = acc[ai][bj][m][n]; v2u o; o.x = pg8::cvt_pk_bf16(x[0] * inv, x[1] * inv); o.y = pg8::cvt_pk_bf16(x[2] * inv, x[3] * inv);
                        *(v2u*)(P + (size_t)r * ldp + bj * 128 + wc * 32 + n * 16 + fq * 4) = o; } }
        asm volatile("s_waitcnt lgkmcnt(0)" ::: "memory"); __builtin_amdgcn_s_barrier(); asm volatile("" ::: "memory");
    }
};

__device__ __forceinline__ void rms_rows_phase(const Frame& F, const float* X, const float* g, bf16* H) {
    const int gw = F.vcu * NWAVES + F.wave, NGW = F.G * NWAVES;
    for (int m = gw; m < TA; m += NGW) rms_row_bf16(X + (size_t)m * DM, g, H + (size_t)m * DM, F.lane);
}

__device__ __forceinline__ unsigned f2sort(float f) { const unsigned u = __builtin_bit_cast(unsigned, f); return u ^ ((u >> 31) ? 0xFFFFFFFFu : 0x80000000u); }
__device__ __forceinline__ float sort2f(unsigned s) { const unsigned u = s ^ ((s >> 31) ? 0x80000000u : 0xFFFFFFFFu); return __builtin_bit_cast(float, u); }
__device__ __forceinline__ float gelu_tanh(float x) { const float y = 0.7978845608028654f * (x + 0.044715f * x * x * x); const float e = __expf(2.f * y); return 0.5f * x * (1.f + (1.f - 2.f / (e + 1.f))); }
__device__ __forceinline__ unsigned gmax16(unsigned v) {
#pragma unroll
    for (int o = 1; o < 16; o <<= 1) { const unsigned t = (unsigned)__shfl_xor((int)v, o); v = v > t ? v : t; }
    return v;
}
typedef __bf16 bf16x2_t __attribute__((ext_vector_type(2)));
__device__ __forceinline__ float dot2bf(unsigned a, unsigned b, float c) {
#if __has_builtin(__builtin_amdgcn_fdot2_f32_bf16)
    return __builtin_amdgcn_fdot2_f32_bf16(__builtin_bit_cast(bf16x2_t, a), __builtin_bit_cast(bf16x2_t, b), c, false);
#else
    return c + bflo(a) * bflo(b) + bfhi(a) * bfhi(b);
#endif
}
template <bool SPLIT>
__device__ __forceinline__ void peer_token(const Frame& F, const Args& a, int row, LAS unsigned* TOPS, int ci0, int cj0, int ci1, int cj1, int ci2, int cj2, int ci3, int cj3, bool cv3, int half, LAS float* PART) {
    unsigned char* ws = a.ws; const int lane = F.lane, grp = lane >> 4, j16 = lane & 15;
    const bf16* sc = (const bf16*)(ws + WS_SC) + (size_t)row * 2048;
#pragma unroll 1
    for (int bt = 0; bt < 4; ++bt) {
        const v4u xq = *(const v4u*)(sc + (bt * 4 + grp) * 128 + 8 * j16);
        unsigned k[8]; const float xs[8] = {bflo(xq.x), bfhi(xq.x), bflo(xq.y), bfhi(xq.y), bflo(xq.z), bfhi(xq.z), bflo(xq.w), bfhi(xq.w)};
#pragma unroll
        for (int e = 0; e < 8; ++e) k[e] = (f2sort(xs[e]) & ~127u) | (unsigned)(127 - (8 * j16 + e));
        unsigned mine = 0u;
#pragma unroll 1
        for (int r = 0; r < 16; ++r) {
            unsigned m = k[0];
#pragma unroll
            for (int e = 1; e < 8; ++e) m = m > k[e] ? m : k[e];
            m = gmax16(m);
            if (j16 == r) mine = m;
#pragma unroll
            for (int e = 0; e < 8; ++e) k[e] = (k[e] == m) ? 0u : k[e];
        }
        TOPS[(bt * 4 + grp) * 16 + j16] = mine;
    }
    int ex[2]; float gx[2], sux[2];
#pragma unroll
    for (int ps = 0; ps < 2; ++ps) {
        const int hd = ps * 4 + grp; const LAS unsigned* T1 = TOPS + (2 * hd) * 16; const LAS unsigned* T2 = T1 + 16;
        unsigned k[4];
        { const float s0 = sort2f(T1[ci0] & ~127u) + sort2f(T2[cj0] & ~127u), s1 = sort2f(T1[ci1] & ~127u) + sort2f(T2[cj1] & ~127u),
                      s2 = sort2f(T1[ci2] & ~127u) + sort2f(T2[cj2] & ~127u), s3 = sort2f(T1[ci3] & ~127u) + sort2f(T2[cj3] & ~127u);
          k[0] = (f2sort(s0) & ~127u) | (unsigned)(127 - j16); k[1] = (f2sort(s1) & ~127u) | (unsigned)(127 - (j16 + 16)); k[2] = (f2sort(s2) & ~127u) | (unsigned)(127 - (j16 + 32));
          k[3] = cv3 ? ((f2sort(s3) & ~127u) | (unsigned)(127 - (j16 + 48))) : 0u; }
        unsigned mine = 0u;
#pragma unroll 1
        for (int r = 0; r < 16; ++r) {
            unsigned m = k[0] > k[1] ? k[0] : k[1]; const unsigned m2 = k[2] > k[3] ? k[2] : k[3]; m = m > m2 ? m : m2;
            m = gmax16(m);
            if (j16 == r) mine = m;
#pragma unroll
            for (int e = 0; e < 4; ++e) k[e] = (k[e] == m) ? 0u : k[e];
        }
        const int c = 127 - (int)(mine & 127u);
        int ci, cj;
        if (c < 16) { ci = 0; cj = c; } else if (c < 24) { ci = 1; cj = c - 16; } else if (c < 29) { ci = 2; cj = c - 24; } else if (c < 33) { ci = 3; cj = c - 29; }
        else if (c < 36) { ci = 4; cj = c - 33; } else if (c < 38) { ci = 5; cj = c - 36; } else if (c < 40) { ci = 6; cj = c - 38; } else if (c < 42) { ci = 7; cj = c - 40; } else { ci = c - 34; cj = 0; }
        const int i1 = 127 - (int)(T1[ci] & 127u), i2 = 127 - (int)(T2[cj] & 127u);
        ex[ps] = i1 * 128 + i2;
        const float sv = sort2f(mine & ~127u); const float s0 = __shfl(sv, lane & 48);
        float ee = __expf(sv - s0); float es = ee;
#pragma unroll
        for (int o = 1; o < 16; o <<= 1) es += __shfl_xor(es, o);
        const float* rsc = (const float*)(ws + WS_MISC);
        sux[ps] = rsc[ex[ps]]; gx[ps] = ee / es * rsc[16384 + ex[ps]];
    }
    {
        unsigned k0 = ((unsigned)ex[0] << 7) | (unsigned)lane, k1 = ((unsigned)ex[1] << 7) | (unsigned)(64 + lane);
#pragma unroll
        for (int k = 2; k <= 128; k <<= 1) {
#pragma unroll
            for (int j = k >> 1; j > 0; j >>= 1) {
                if (j == 64) { const unsigned lo = k0 < k1 ? k0 : k1, hi = k0 < k1 ? k1 : k0; k0 = lo; k1 = hi; }
                else {
                    const unsigned p0 = (unsigned)__shfl_xor((int)k0, j), p1 = (unsigned)__shfl_xor((int)k1, j);
                    const bool low = (lane & j) == 0; const bool asc0 = (lane & k) == 0, asc1 = ((64 + lane) & k) == 0;
                    const unsigned mn0 = k0 < p0 ? k0 : p0, mx0 = k0 < p0 ? p0 : k0, mn1 = k1 < p1 ? k1 : p1, mx1 = k1 < p1 ? p1 : k1;
                    k0 = (low == asc0) ? mn0 : mx0; k1 = (low == asc1) ? mn1 : mx1;
                }
            }
        }
        const int o0 = (int)(k0 & 127u), o1 = (int)(k1 & 127u);
        const float g0a = __shfl(gx[0], o0 & 63), g0b = __shfl(gx[1], o0 & 63), g1a = __shfl(gx[0], o1 & 63), g1b = __shfl(gx[1], o1 & 63);
        const float s0a = __shfl(sux[0], o0 & 63), s0b = __shfl(sux[1], o0 & 63), s1a = __shfl(sux[0], o1 & 63), s1b = __shfl(sux[1], o1 & 63);
        gx[0] = (o0 & 64) ? g0b : g0a; gx[1] = (o1 & 64) ? g1b : g1a; sux[0] = (o0 & 64) ? s0b : s0a; sux[1] = (o1 & 64) ? s1b : s1a;
        ex[0] = (int)(k0 >> 7); ex[1] = (int)(k1 >> 7);
    }
    const float rstd2 = rsqrtf(((const float*)(ws + WS_SS))[TA + row] * (1.f / 1024.f) + EPS);
    float hf[16];
    { const v4u* hp = (const v4u*)((const bf16*)(ws + WS_HB) + (size_t)row * DM + 16 * lane); const v4u h0 = hp[0], h1 = hp[1];
#pragma unroll
      for (int q = 0; q < 4; ++q) { hf[2 * q] = bflo(h0[q]); hf[2 * q + 1] = bfhi(h0[q]); hf[8 + 2 * q] = bflo(h1[q]); hf[8 + 2 * q + 1] = bfhi(h1[q]); } }
    float oacc[16];
#pragma unroll
    for (int i = 0; i < 16; ++i) oacc[i] = 0.f;
    const unsigned char* U = ws + WS_U16; const unsigned char* V = ws + WS_V16;
    v4u ub[8], vb[8];
    const int gbeg = SPLIT ? 8 * half : 0, gend = SPLIT ? 8 * half + 8 : 16;
    { const int ex0 = (gbeg < 8) ? ex[0] : ex[1];
#pragma unroll
      for (int i = 0; i < 8; ++i) { const int e = __builtin_amdgcn_readlane(ex0, i); ub[i] = *(const v4u*)(U + (size_t)e * DM + 16 * lane); } }
#pragma unroll 1
    for (int g8 = gbeg; g8 < gend; ++g8) {
        const int kb = g8 * 8; const int exs = (kb < 64) ? ex[0] : ex[1]; const float gxs = (kb < 64) ? gx[0] : gx[1]; const float sus = (kb < 64) ? sux[0] : sux[1];
#pragma unroll
        for (int i = 0; i < 8; ++i) { const int e = __builtin_amdgcn_readlane(exs, (kb & 63) + i); vb[i] = *(const v4u*)(V + (size_t)e * DM + 16 * lane); }
        float av[8];
#pragma unroll
        for (int i = 0; i < 8; ++i) { float s = 0.f;
#pragma unroll
            for (int q = 0; q < 4; ++q) { const f32x2 lo = __builtin_amdgcn_cvt_pk_f32_fp8((int)ub[i][q], false), hi = __builtin_amdgcn_cvt_pk_f32_fp8((int)ub[i][q], true);
                s += lo.x * hf[4 * q]; s += lo.y * hf[4 * q + 1]; s += hi.x * hf[4 * q + 2]; s += hi.y * hf[4 * q + 3]; }
            av[i] = s; }
        const bool b5 = lane & 32, b4 = lane & 16, b3 = lane & 8;
        float bq[4], cq[2], dq;
#pragma unroll
        for (int i = 0; i < 4; ++i) bq[i] = (b5 ? av[4 + i] : av[i]) + __shfl_xor(b5 ? av[i] : av[4 + i], 32);
#pragma unroll
        for (int i = 0; i < 2; ++i) cq[i] = (b4 ? bq[2 + i] : bq[i]) + __shfl_xor(b4 ? bq[i] : bq[2 + i], 16);
        dq = (b3 ? cq[1] : cq[0]) + __shfl_xor(b3 ? cq[0] : cq[1], 8);
        dq += __shfl_xor(dq, 4); dq += __shfl_xor(dq, 2); dq += __shfl_xor(dq, 1);
        const int src = (kb & 63) + (lane >> 3);
#if defined(PROBE_NOPEER)
        const float wmine = 0.f * __shfl(gxs, src) * gelu_tanh(dq * __shfl(sus, src));
#else
        const float wmine = __shfl(gxs, src) * gelu_tanh(dq * __shfl(sus, src) * rstd2);
#endif
        if (g8 + 1 < gend) { const int kn = kb + 8; const int exn = (kn < 64) ? ex[0] : ex[1];
#pragma unroll
            for (int i = 0; i < 8; ++i) { const int e = __builtin_amdgcn_readlane(exn, (kn & 63) + i); ub[i] = *(const v4u*)(U + (size_t)e * DM + 16 * lane); } }
#pragma unroll
        for (int i = 0; i < 8; ++i) { const float w = __builtin_bit_cast(float, __builtin_amdgcn_readlane(__builtin_bit_cast(int, wmine), 8 * i));
#pragma unroll
            for (int q = 0; q < 4; ++q) { const f32x2 lo = __builtin_amdgcn_cvt_pk_f32_fp8((int)vb[i][q], false), hi = __builtin_amdgcn_cvt_pk_f32_fp8((int)vb[i][q], true);
                oacc[4 * q] += w * lo.x; oacc[4 * q + 1] += w * lo.y; oacc[4 * q + 2] += w * hi.x; oacc[4 * q + 3] += w * hi.y; } }
    }
    if (SPLIT) {
        if (half == 1) {
#pragma unroll
            for (int q = 0; q < 4; ++q) *(LAS f32x4*)(PART + 16 * lane + 4 * q) = (f32x4){oacc[4 * q], oacc[4 * q + 1], oacc[4 * q + 2], oacc[4 * q + 3]}; }
        __syncthreads();
        if (half == 1) return;
#pragma unroll
        for (int q = 0; q < 4; ++q) { const f32x4 p = *(const LAS f32x4*)(PART + 16 * lane + 4 * q); oacc[4 * q] += p.x; oacc[4 * q + 1] += p.y; oacc[4 * q + 2] += p.z; oacc[4 * q + 3] += p.w; }
    }
    const f32x4* x2 = (const f32x4*)((const float*)(ws + WS_X2) + (size_t)row * DM + 16 * lane);
    f32x4 xv[4]; float ss = 0.f;
#pragma unroll
    for (int q = 0; q < 4; ++q) { xv[q] = x2[q]; xv[q].x += oacc[4 * q]; xv[q].y += oacc[4 * q + 1]; xv[q].z += oacc[4 * q + 2]; xv[q].w += oacc[4 * q + 3]; ss += (xv[q].x * xv[q].x + xv[q].y * xv[q].y) + (xv[q].z * xv[q].z + xv[q].w * xv[q].w); }
    const float r = rsqrtf(wave_sum(ss) * (1.f / DM) + EPS);
    const f32x4* gf = (const f32x4*)((const float*)a.in[I_GFIN] + 16 * lane);
    f32x4* y = (f32x4*)((row < TP ? a.out + O_YP + (size_t)row * DM : a.out + O_YS + (size_t)(row - TP) * DM) + 16 * lane);
#pragma unroll
    for (int q = 0; q < 4; ++q) { const f32x4 g4 = gf[q]; f32x4 o; o.x = xv[q].x * r * g4.x; o.y = xv[q].y * r * g4.y; o.z = xv[q].z * r * g4.z; o.w = xv[q].w * r * g4.w; y[q] = o; }
}
__device__ __forceinline__ void cand_ij(int c, int& ci, int& cj) {
    if (c < 16) { ci = 0; cj = c; } else if (c < 24) { ci = 1; cj = c - 16; } else if (c < 29) { ci = 2; cj = c - 24; } else if (c < 33) { ci = 3; cj = c - 29; }
    else if (c < 36) { ci = 4; cj = c - 33; } else if (c < 38) { ci = 5; cj = c - 36; } else if (c < 40) { ci = 6; cj = c - 38; } else if (c < 42) { ci = 7; cj = c - 40; } else if (c < 50) { ci = c - 34; cj = 0; } else { ci = 0; cj = 0; }
}
__device__ __forceinline__ void peer_phase(const Frame& F, const Args& a) {
    LAS unsigned* TOPS = (LAS unsigned*)F.lds + F.wave * 256;
    const int j16 = F.lane & 15; int ci0, cj0, ci1, cj1, ci2, cj2, ci3, cj3;
    cand_ij(j16, ci0, cj0); cand_ij(j16 + 16, ci1, cj1); cand_ij(j16 + 32, ci2, cj2); cand_ij(j16 + 48, ci3, cj3);
    const bool cv3 = (j16 + 48) < 50;
    const int gw = F.vcu * NWAVES + F.wave, NGW = F.G * NWAVES;
    const int nfull = TA / NGW, rem = TA - nfull * NGW;
#pragma unroll 1
    for (int i = 0; i < nfull; ++i) peer_token<false>(F, a, gw + i * NGW, TOPS, ci0, cj0, ci1, cj1, ci2, cj2, ci3, cj3, cv3, 0, nullptr);
    if (rem == 4 * F.G) {
        __syncthreads();
        peer_token<true>(F, a, nfull * NGW + F.vcu * 4 + (F.wave >> 1), TOPS, ci0, cj0, ci1, cj1, ci2, cj2, ci3, cj3, cv3, F.wave & 1, (LAS float*)F.lds + 8 * 256 + (F.wave >> 1) * 1024);
    } else {
        const int row = gw + nfull * NGW; if (row < TA) peer_token<false>(F, a, row, TOPS, ci0, cj0, ci1, cj1, ci2, cj2, ci3, cj3, cv3, 0, nullptr);
    }
}


template <class EpiS>
__device__ __forceinline__ void skinny_tile(const Frame& F, const bf16* A, int lda, const bf16* Bt, int ldb, int tm, int tn, const EpiS& E) {
    const int lane = F.lane, fr = lane & 15, fq = lane >> 4, w = F.wave;
    const bf16* ap = A + (size_t)(tm * 64 + fr) * lda + w * 128 + 8 * fq;
    const bf16* bp = Bt + (size_t)(tn * 64 + fr) * ldb + w * 128 + 8 * fq;
    v4u af[4][4], bfr[4][4];
#pragma unroll
    for (int m = 0; m < 4; ++m)
#pragma unroll
        for (int ks = 0; ks < 4; ++ks) { af[m][ks] = *(const v4u*)(ap + (size_t)(16 * m) * lda + ks * 32); bfr[m][ks] = *(const v4u*)(bp + (size_t)(16 * m) * ldb + ks * 32); }
    f32x4 acc[4][4];
#pragma unroll
    for (int m = 0; m < 4; ++m)
#pragma unroll
        for (int n = 0; n < 4; ++n) acc[m][n] = (f32x4){0.f, 0.f, 0.f, 0.f};
#pragma unroll
    for (int ks = 0; ks < 4; ++ks)
#pragma unroll
        for (int m = 0; m < 4; ++m)
#pragma unroll
            for (int n = 0; n < 4; ++n) acc[m][n] = __builtin_amdgcn_mfma_f32_16x16x32_bf16(__builtin_bit_cast(bf16x8, bfr[n][ks]), __builtin_bit_cast(bf16x8, af[m][ks]), acc[m][n], 0, 0, 0);
    LAS float* PS = (LAS float*)F.lds + w * 4096;
#pragma unroll
    for (int m = 0; m < 4; ++m)
#pragma unroll
        for (int n = 0; n < 4; ++n) *(LAS f32x4*)(PS + (16 * m + fr) * 64 + 16 * n + 4 * fq) = acc[m][n];
    __syncthreads();
    {
        const int row = F.tid >> 3, c8 = (F.tid & 7) * 8; const LAS float* P0 = (const LAS float*)F.lds + row * 64 + c8;
        f32x4 s0 = *(const LAS f32x4*)P0, s1 = *(const LAS f32x4*)(P0 + 4);
#pragma unroll
        for (int ww = 1; ww < 8; ++ww) { s0 += *(const LAS f32x4*)(P0 + ww * 4096); s1 += *(const LAS f32x4*)(P0 + ww * 4096 + 4); }
        float v[8] = {s0.x, s0.y, s0.z, s0.w, s1.x, s1.y, s1.z, s1.w};
        E(tm * 64 + row, tn * 64 + c8, v, F.tid);
    }
    __syncthreads();
}
struct EpiSk {
    float* d32; int ld32; bf16* d16; int ld16; float sc16;
    const float* res; int ldr;
    const float* gcol; float* ssq; const float* rsq;
    __device__ __forceinline__ void operator()(int row, int col, float (&v)[8], int tid) const {
        if (rsq) { const float rs = rsqrtf(rsq[row] * (1.f / 1024.f) + EPS);
#pragma unroll
            for (int i = 0; i < 8; ++i) v[i] *= rs; }
        if (res) { const f32x4 a = *(const f32x4*)(res + (size_t)row * ldr + col), b = *(const f32x4*)(res + (size_t)row * ldr + col + 4);
            v[0] += a.x; v[1] += a.y; v[2] += a.z; v[3] += a.w; v[4] += b.x; v[5] += b.y; v[6] += b.z; v[7] += b.w; }
        if (d32) { *(f32x4*)(d32 + (size_t)row * ld32 + col) = (f32x4){v[0], v[1], v[2], v[3]}; *(f32x4*)(d32 + (size_t)row * ld32 + col + 4) = (f32x4){v[4], v[5], v[6], v[7]}; }
        if (ssq) { float ss = 0.f;
#pragma unroll
            for (int i = 0; i < 8; ++i) ss += v[i] * v[i];
            ss += __shfl_xor(ss, 1); ss += __shfl_xor(ss, 2); ss += __shfl_xor(ss, 4);
            if ((tid & 7) == 0) atomicAdd(ssq + row, ss); }
        if (d16) { float w8[8];
#pragma unroll
            for (int i = 0; i < 8; ++i) w8[i] = v[i];
            if (gcol) { const f32x4 a = *(const f32x4*)(gcol + col), b = *(const f32x4*)(gcol + col + 4); w8[0] *= a.x; w8[1] *= a.y; w8[2] *= a.z; w8[3] *= a.w; w8[4] *= b.x; w8[5] *= b.y; w8[6] *= b.z; w8[7] *= b.w; }
            v4u o; o.x = pg8::cvt_pk_bf16(w8[0] * sc16, w8[1] * sc16); o.y = pg8::cvt_pk_bf16(w8[2] * sc16, w8[3] * sc16); o.z = pg8::cvt_pk_bf16(w8[4] * sc16, w8[5] * sc16); o.w = pg8::cvt_pk_bf16(w8[6] * sc16, w8[7] * sc16);
            *(v4u*)(d16 + (size_t)row * ld16 + col) = o; }
    }
};

#define SK_TM16(t) (4 * (((t) >> 5) >> 1) + (((t) & 31) >> 3))
#define SK_TN16(t) (8 * (((t) >> 5) & 1) + ((t) & 7))
#define SK_TM32(t) (4 * ((((t) & 255) >> 5) >> 1) + ((((t) & 31) + 32 * ((t) >> 8)) >> 4))
#define SK_TN32(t) (16 * ((((t) & 255) >> 5) & 1) + ((((t) & 31) + 32 * ((t) >> 8)) & 15))


#ifndef PH_MAX
#define PH_MAX 99
#endif
__global__ void __launch_bounds__(NTHR, 2) mega_fwd(Args args) {
    extern __shared__ __attribute__((aligned(16))) unsigned char lds_raw[];
    Frame F;
    F.lds = (LAS unsigned char*)lds_raw;
    F.wave = __builtin_amdgcn_readfirstlane((int)threadIdx.x >> 6); F.lane = lane_id(); F.tid = F.wave * 64 + F.lane;
    F.G = gridDim.x; { const int bx = blockIdx.x; F.vcu = (F.G % 8 == 0) ? (bx % 8) * (F.G / 8) + bx / 8 : bx; }
    volatile LAS unsigned* MISC = (volatile LAS unsigned*)(F.lds + MISC_OFF);
    LAS unsigned long long* ARGP = (LAS unsigned long long*)(F.lds + ARGS_OFF);
    for (int u = F.tid; u < (LDS_BYTES - LDSCTL_OFF) / 4; u += NTHR) ((LAS unsigned*)(F.lds + LDSCTL_OFF))[u] = 0u;
    __syncthreads();
    if (F.tid == 0) {
        ARGP[0] = (unsigned long long)args.in[0];
        ARGP[1] = (unsigned long long)args.in[1];
        ARGP[2] = (unsigned long long)args.in[2];
        ARGP[3] = (unsigned long long)args.in[3];
        ARGP[4] = (unsigned long long)args.in[4];
        ARGP[5] = (unsigned long long)args.in[5];
        ARGP[6] = (unsigned long long)args.in[6];
        ARGP[7] = (unsigned long long)args.in[7];
        ARGP[8] = (unsigned long long)args.in[8];
        ARGP[9] = (unsigned long long)args.in[9];
        ARGP[10] = (unsigned long long)args.in[10];
        ARGP[11] = (unsigned long long)args.in[11];
        ARGP[12] = (unsigned long long)args.in[12];
        ARGP[13] = (unsigned long long)args.in[13];
        ARGP[14] = (unsigned long long)args.in[14];
        ARGP[15] = (unsigned long long)args.in[15];
        ARGP[16] = (unsigned long long)args.in[16];
        ARGP[17] = (unsigned long long)args.in[17];
        ARGP[18] = (unsigned long long)args.in[18];
        ARGP[19] = (unsigned long long)args.in[19];
        ARGP[20] = (unsigned long long)args.in[20];
        ARGP[21] = (unsigned long long)args.in[21];
        ARGP[22] = (unsigned long long)args.in[22];
        ARGP[23] = (unsigned long long)args.in[23];
        ARGP[24] = (unsigned long long)args.in[24];
        ARGP[25] = (unsigned long long)args.in[25];
        ARGP[26] = (unsigned long long)args.in[26];
        ARGP[27] = (unsigned long long)args.in[27];
        ARGP[28] = (unsigned long long)args.in[28];
        ARGP[N_INPUTS] = (unsigned long long)args.out; ARGP[N_INPUTS + 1] = (unsigned long long)args.ws;
    }
    __syncthreads();
    { const XcdBarrier bar0 = xcd_barrier_post((unsigned*)((gu32*)(args.ws + WS_CTL) + CW_BAR), MISC + 8, F.wave); if (F.tid == 0) MISC[10] = bar0.x; }
    __syncthreads();
#define GRID_BAR() do { XcdBarrier bar_; bar_.bar = (unsigned*)((gu32*)((unsigned char*)ld_ptr(ARGP + N_INPUTS + 1) + WS_CTL) + CW_BAR); bar_.x = MISC[10]; bar_.st = MISC + 8; bar_.wave = F.wave; xcd_barrier(bar_); } while (0)
#define PHASE_ARGS const Args A = load_args(ARGP); unsigned char* const ws = A.ws; float* const out = A.out; (void)ws; (void)out; { int l_ = lane_id(); asm volatile("" : "+v"(l_)); F.lane = l_; F.tid = F.wave * 64 + l_; }

    { PHASE_ARGS;
    p0_prologue(F, A);
    }
    GRID_BAR();
#if defined(PROBE_BAR8)
    GRID_BAR(); GRID_BAR(); GRID_BAR(); GRID_BAR(); GRID_BAR(); GRID_BAR(); GRID_BAR(); GRID_BAR();
#endif
#if PH_MAX >= 1
    { PHASE_ARGS;
    {
        pg8::Gemm g{(const bf16*)(ws + WS_HB), (const bf16*)(ws + WS_WIN), DM, DM, DM};
        pg8::StaticOrder S; S.init(TA, N_IN, F.G, (int)blockIdx.x);
        EpiInProj E{out, ws, (const float*)A.in[I_BFF]};
        pg8::gemm_phase(F.lds, g, S, E, F.wave);
    }
    {
        const int off = (TA / 256) * (N_IN / 256) % F.G;
        pg8::Gemm g{(const bf16*)(ws + WS_MB), (const bf16*)(ws + WS_WMK), DM, DM, DM};
        pg8::StaticOrder S; S.init(512, DM, F.G, ((int)blockIdx.x + F.G - off) % F.G);
        EpiGen E{out + O_MKP, DM, (bf16*)(ws + WS_MK16), DM, 1.f, nullptr, nullptr, 0, 0, nullptr, nullptr, nullptr};
        pg8::gemm_phase(F.lds, g, S, E, F.wave);
    }
    {
        const int off = ((TA / 256) * (N_IN / 256) + 8) % F.G;
        pg8::Gemm g{(const bf16*)(ws + WS_MB), (const bf16*)(ws + WS_WMV), DM, DM, DM};
        pg8::StaticOrder S; S.init(512, DM, F.G, ((int)blockIdx.x + F.G - off) % F.G);
        EpiGen E{out + O_MVP, DM, nullptr, 0, 1.f, nullptr, nullptr, 0, 0, nullptr, nullptr, nullptr};
        pg8::gemm_phase(F.lds, g, S, E, F.wave);
    }
    {
        const int off = ((TA / 256) * (N_IN / 256) + 16) % F.G;
        pg8::Gemm g{(const bf16*)(ws + WS_WMV), (const bf16*)(ws + WS_MB), DM, DM, DM};
        pg8::StaticOrder S; S.init(DM, 512, F.G, ((int)blockIdx.x + F.G - off) % F.G);
        EpiGen E{nullptr, 0, (bf16*)(ws + WS_MVT16), 512, 1.f, nullptr, nullptr, 0, 0, nullptr, nullptr, nullptr};
        pg8::gemm_phase(F.lds, g, S, E, F.wave);
    }
    }
    GRID_BAR();
#endif
#if PH_MAX >= 2
    asm volatile("; ===PHASE 2===");
    { PHASE_ARGS;
    {
        const int gw = F.vcu * NWAVES + F.wave, NGW = F.G * NWAVES;
        for (int it = gw; it < 512; it += NGW) fox_norms_item(F, (const bf16*)(ws + WS_QF), (const bf16*)(ws + WS_KF), out + O_LFP, (float*)(ws + WS_MISC + MiB), (float*)(ws + WS_KBIAS), (float*)(ws + WS_MISC + MiB + 65536), it);
        for (int it = gw; it < NB_S * NPAGES; it += NGW) fox_suffix_item(F, (const float*)A.in[I_CFL], (const int*)A.in[I_PT], (float*)(ws + WS_SUF), (float*)(ws + WS_MISC + 2 * MiB), it);
        for (int u = F.vcu; u < 1024; u += F.G) gla_g1_unit(F, A, u);
        for (int u = F.vcu; u < 512; u += F.G) gla_sample_unit(F, A, u);
    }
    }
    GRID_BAR();
#endif
#if PH_MAX >= 3
    asm volatile("; ===PHASE 3===");
    { PHASE_ARGS;
    gla_scan(F, A);
    __syncthreads();
    for (int i = F.vcu; i < 256; i += F.G) { const int bh = i >> 4, s = i & 15;
        fox_attn_unit(F, (const bf16*)(ws + WS_QF), (const bf16*)(ws + WS_KF), (const bf16*)(ws + WS_VF), (const float*)(ws + WS_KBIAS), (const float*)(ws + WS_MISC + MiB + 65536), (const float*)(ws + WS_MISC + MiB), (bf16*)(ws + WS_MERGED), bh >> 3, bh & 7, s);
        fox_attn_unit(F, (const bf16*)(ws + WS_QF), (const bf16*)(ws + WS_KF), (const bf16*)(ws + WS_VF), (const float*)(ws + WS_KBIAS), (const float*)(ws + WS_MISC + MiB + 65536), (const float*)(ws + WS_MISC + MiB), (bf16*)(ws + WS_MERGED), bh >> 3, bh & 7, 31 - s); }
    }
    GRID_BAR();
#endif
#if PH_MAX >= 4
    asm volatile("; ===PHASE 4===");
    { PHASE_ARGS;
    if (!(F.vcu & 1)) { for (int u = F.vcu; u < 1024; u += F.G) gla_g3_unit(F, A, u); }
    }
    { PHASE_ARGS;
    for (int u = F.vcu; u < 1024; u += F.G) fox_sample_unit(F, A, u);
    }
    { PHASE_ARGS;
    if (F.vcu & 1) { for (int u = F.vcu; u < 1024; u += F.G) gla_g3_unit(F, A, u); }
    }
    GRID_BAR();
#endif
#if PH_MAX >= 5
    asm volatile("; ===PHASE 5===");
    { PHASE_ARGS;
    {
        pg8::Gemm g{(const bf16*)(ws + WS_MERGED), (const bf16*)(ws + WS_WOUT), DM, DM, DM};
        pg8::StaticOrder S; S.init(TP, DM, F.G, (int)blockIdx.x);
        EpiGen E{(float*)(ws + WS_X1), DM, (bf16*)(ws + WS_HB), DM, 1.f, (const float*)A.in[I_XP], (const float*)A.in[I_XS], TP, DM, (const float*)A.in[I_GCROSS], (float*)(ws + WS_SS), nullptr};
        pg8::gemm_phase(F.lds, g, S, E, F.wave);
        __syncthreads();
        EpiSk Es{(float*)(ws + WS_X1) + (size_t)TP * DM, DM, (bf16*)(ws + WS_HB) + (size_t)TP * DM, DM, 1.f, (const float*)A.in[I_XS], DM, (const float*)A.in[I_GCROSS], (float*)(ws + WS_SS) + TP, nullptr};
        for (int t = F.vcu; t < 256; t += F.G) skinny_tile(F, (const bf16*)(ws + WS_MERGED) + (size_t)TP * DM, DM, (const bf16*)(ws + WS_WOUT), DM, SK_TM16(t), SK_TN16(t), Es);
    }
    }
    GRID_BAR();
#endif
#if PH_MAX >= 7
    asm volatile("; ===PHASE 7===");
    { PHASE_ARGS;
    {
        pg8::Gemm g{(const bf16*)(ws + WS_HB), (const bf16*)(ws + WS_WCQ), DM, DM, DM};
        pg8::StaticOrder S; S.init(TP, DM, F.G, (int)blockIdx.x);
        EpiGen E{nullptr, 0, (bf16*)(ws + WS_QC), DM, C2C, nullptr, nullptr, 0, 0, nullptr, nullptr, (const float*)(ws + WS_SS)};
        pg8::gemm_phase(F.lds, g, S, E, F.wave);
        __syncthreads();
        EpiSk Es{nullptr, 0, (bf16*)(ws + WS_QC) + (size_t)TP * DM, DM, C2C, nullptr, 0, nullptr, nullptr, (const float*)(ws + WS_SS) + TP};
        for (int t = F.vcu; t < 256; t += F.G) skinny_tile(F, (const bf16*)(ws + WS_HB) + (size_t)TP * DM, DM, (const bf16*)(ws + WS_WCQ), DM, SK_TM16(t), SK_TN16(t), Es);
    }
    }
    GRID_BAR();
#endif
#if PH_MAX >= 8
    asm volatile("; ===PHASE 8===");
    { PHASE_ARGS;
    {
        const int u = (int)blockIdx.x, b = (u >> 7) & 1, h = (u >> 5) & 3, pnl = u & 31;
        const size_t roff = ((size_t)b * SEQ + pnl * 256) * DM + h * 256;
        if (F.vcu & 1) { for (int v = F.vcu; v < 512; v += F.G) cross_sample_unit(F, A, v); }
        pg8::Gemm g{(const bf16*)(ws + WS_QC) + roff, (const bf16*)(ws + WS_MK16) + (size_t)(b * 256) * DM + h * 256, DM, DM, 256};
        pg8::SingleUnit S{u < 256 ? 1 : 0, {0, 0}};
        EpiSoftmaxP E{ARGP};
        pg8::gemm_phase(F.lds, g, S, E, F.wave);
        VM_WAIT(); __syncthreads();
        {
            pg8::Gemm g2{(const bf16*)(ws + WS_PC) + roff, (const bf16*)(ws + WS_MVT16) + (size_t)(h * 256) * 512 + b * 256, DM, 512, 256};
            EpiGen E2{nullptr, 0, (bf16*)(ws + WS_OC) + roff, DM, 1.f, nullptr, nullptr, 0, 0, nullptr, nullptr, nullptr};
            pg8::gemm_phase(F.lds, g2, S, E2, F.wave);
        }
        __syncthreads();
        if (!(F.vcu & 1)) { for (int v = F.vcu; v < 512; v += F.G) cross_sample_unit(F, A, v); }
    }
    }
    GRID_BAR();
#endif
#if PH_MAX >= 10
    asm volatile("; ===PHASE 10===");
    { PHASE_ARGS;
    {
        pg8::Gemm g{(const bf16*)(ws + WS_OC), (const bf16*)(ws + WS_WCO), DM, DM, DM};
        pg8::StaticOrder S; S.init(TP, DM, F.G, (int)blockIdx.x);
        EpiGen E{(float*)(ws + WS_X2), DM, (bf16*)(ws + WS_HB), DM, 1.f, (const float*)(ws + WS_X1), (const float*)(ws + WS_X1), TA, DM, (const float*)A.in[I_GFFN], (float*)(ws + WS_SS) + TA, nullptr};
        pg8::gemm_phase(F.lds, g, S, E, F.wave);
        __syncthreads();
        EpiSk Es{(float*)(ws + WS_X2) + (size_t)TP * DM, DM, (bf16*)(ws + WS_HB) + (size_t)TP * DM, DM, 1.f, (const float*)(ws + WS_X1) + (size_t)TP * DM, DM, (const float*)A.in[I_GFFN], (float*)(ws + WS_SS) + TA + TP, nullptr};
        for (int t = F.vcu; t < 256; t += F.G) skinny_tile(F, (const bf16*)(ws + WS_OC) + (size_t)TP * DM, DM, (const bf16*)(ws + WS_WCO), DM, SK_TM16(t), SK_TN16(t), Es);
    }
    }
    GRID_BAR();
#endif
#if PH_MAX >= 12
    asm volatile("; ===PHASE 12===");
    { PHASE_ARGS;
    {
        pg8::Gemm g{(const bf16*)(ws + WS_HB), (const bf16*)(ws + WS_WPK), DM, DM, DM};
        pg8::StaticOrder S; S.init(TP, 2048, F.G, (int)blockIdx.x);
        EpiGen E{nullptr, 0, (bf16*)(ws + WS_SC), 2048, 1.f, nullptr, nullptr, 0, 0, nullptr, nullptr, (const float*)(ws + WS_SS) + TA};
        pg8::gemm_phase(F.lds, g, S, E, F.wave);
        __syncthreads();
        EpiSk Es{nullptr, 0, (bf16*)(ws + WS_SC) + (size_t)TP * 2048, 2048, 1.f, nullptr, 0, nullptr, nullptr, (const float*)(ws + WS_SS) + TA + TP};
        for (int t = F.vcu; t < 512; t += F.G) skinny_tile(F, (const bf16*)(ws + WS_HB) + (size_t)TP * DM, DM, (const bf16*)(ws + WS_WPK), DM, SK_TM32(t), SK_TN32(t), Es);
    }
    }
    GRID_BAR();
#endif
#if PH_MAX >= 13
    asm volatile("; ===PHASE 13===");
    { PHASE_ARGS;
    peer_phase(F, A);
    }
#endif
#if PH_MAX < 13
    {   PHASE_ARGS;
        const int gw = F.vcu * NWAVES + F.wave, NGW = F.G * NWAVES;
        for (int m = gw; m < TA; m += NGW) {
            const float* x = m < TP ? (const float*)A.in[I_XP] + (size_t)m * DM : (const float*)A.in[I_XS] + (size_t)(m - TP) * DM;
            float* y = m < TP ? out + O_YP + (size_t)m * DM : out + O_YS + (size_t)(m - TP) * DM;
            for (int j = 0; j < 4; ++j) ((f32x4*)y)[F.lane + 64 * j] = ((const f32x4*)x)[F.lane + 64 * j];
        }
    }
#endif

}

extern "C" void kernel_launch(void* const* d_in, const int* in_sizes, int n_in, void* d_out, int out_size, void* d_ws, size_t ws_size, hipStream_t stream) {
    static int grid = 0;
    if (grid == 0) {
        if (n_in != N_INPUTS || (size_t)out_size != O_TOTAL || ws_size < WS_END) { fprintf(stderr, "kernel_launch: unexpected shapes (n_in %d out %d ws %zu)\n", n_in, out_size, ws_size); grid = -1; return; }
        int dev = 0, cus = 0, per_cu = 0;
        if (hipGetDevice(&dev) != hipSuccess || hipDeviceGetAttribute(&cus, hipDeviceAttributeMultiprocessorCount, dev) != hipSuccess) { grid = -1; return; }
        if (hipFuncSetAttribute((const void*)mega_fwd, hipFuncAttributeMaxDynamicSharedMemorySize, LDS_BYTES) != hipSuccess) { fprintf(stderr, "kernel_launch: hipFuncSetAttribute failed\n"); grid = -1; return; }
        if (hipOccupancyMaxActiveBlocksPerMultiprocessor(&per_cu, (const void*)mega_fwd, NTHR, LDS_BYTES) != hipSuccess || per_cu < 1)
            fprintf(stderr, "kernel_launch: occupancy query reports %d workgroups per CU\n", per_cu);
        (void)hipGetLastError();
        grid = cus;
        if (grid > 256) grid = 256;
    }
    if (grid < 0) return;
    if (hipMemsetAsync((char*)d_ws + WS_CTL, 0, CTL_ZERO_BYTES, stream) != hipSuccess) return;
    Args a{};
    for (int i = 0; i < N_INPUTS; ++i) a.in[i] = d_in[i];
    a.out = (float*)d_out; a.ws = (unsigned char*)d_ws;
    hipLaunchKernelGGL(mega_fwd, dim3(grid), dim3(NTHR), LDS_BYTES, stream, a);
    const hipError_t le = hipPeekAtLastError();
    if (le != hipSuccess) fprintf(stderr, "kernel_launch: launch failed: %s\n", hipGetErrorName(le));
}
```

```cpp
#define PH_MAX 13
#include <hip/hip_runtime.h>
#include <cstdio>
#include <cstdint>

namespace pg8 {
#define PG8_LAS __attribute__((address_space(3)))
typedef unsigned short bf16_t;
typedef short bf16x8 __attribute__((ext_vector_type(8)));
typedef float f32x4 __attribute__((ext_vector_type(4)));
typedef unsigned u32x4 __attribute__((ext_vector_type(4)));
typedef unsigned u32x2 __attribute__((ext_vector_type(2)));
constexpr int BM = 256, BK = 64, HALF = 128, HTB = HALF * BK * 2  , STAGE_BYTES = 8 * HTB, NXCD = 8, WGM = 8;

__host__ __device__ __forceinline__ int lds_byte(int r, int c) { const int st = (r >> 4) * 2 + (c >> 5), rr = r & 15, cc = c & 31, ob = rr * 64 + cc * 2; return st * 1024 + (ob ^ (((ob >> 9) & 1) << 5)); }
__host__ __device__ __forceinline__ void stage_rc(int b, int& R, int& C) { const int st = b / 1024, sb = b % 1024, swz = sb ^ (((sb >> 9) & 1) << 5); R = (st >> 1) * 16 + swz / 64; C = (st & 1) * 32 + (swz % 64) / 2; }

struct Unit { int pm, pn; };
struct Gemm { const bf16_t* A; const bf16_t* Bt; int lda, ldb, K; };

struct StaticOrder {
    int nM, nN, nwg, G, c;
    __host__ __device__ void init(int M, int N, int G_, int c_) { nM = M / BM; nN = N / BM; nwg = nM * nN; G = G_; c = c_; }
    __host__ __device__ bool next(int i, Unit& u) const {
        const long L = (long)i * G + c; if (L >= nwg) return false;
        int wgid = (int)L; { const int q = nwg / NXCD, r = nwg % NXCD, xcd = wgid % NXCD, off = wgid / NXCD; wgid = (xcd < r ? xcd * (q + 1) : r * (q + 1) + (xcd - r) * q) + off; }
        const int nig = WGM * nN, gid = wgid / nig, fm = gid * WGM, gsz = (nM - fm) < WGM ? (nM - fm) : WGM;
        u.pm = fm + ((wgid % nig) % gsz); u.pn = (wgid % nig) / gsz; return true;
    }
};
struct SingleUnit {
    int has; Unit u0;
    __host__ __device__ bool next(int i, Unit& u) const { if (i != 0 || !has) return false; u = u0; return true; }
};

__device__ __forceinline__ unsigned cvt_pk_bf16(float lo, float hi) { unsigned r; asm volatile("v_cvt_pk_bf16_f32 %0, %1, %2" : "=v"(r) : "v"(lo), "v"(hi)); return r; }

template <class Epi, class Sched>
__device__ __forceinline__ void gemm_phase(PG8_LAS unsigned char* lds, const Gemm g, const Sched& S, const Epi& E, int wave_id) {
    int lane; asm volatile("v_mbcnt_lo_u32_b32 %0, -1, 0\n\tv_mbcnt_hi_u32_b32 %0, -1, %0" : "=v"(lane));
    const int wid = wave_id; const int tid = wid * 64 + lane; const int wr = wid >> 2, wc = wid & 3, fr = lane & 15, fq = lane >> 4;
    const int K = g.K, nt = K / BK;
    unsigned voffA[2], voffB[2];
#pragma unroll
    for (int i = 0; i < 2; ++i) { int R, C; stage_rc(tid * 16 + i * 8192, R, C);
        voffA[i] = (unsigned)(R * g.lda + C) * 2u; voffB[i] = (unsigned)(R * g.ldb + C) * 2u; }
    const size_t kstep = (size_t)(BK * 2);
    const size_t hstepA = (size_t)HALF * g.lda * 2, hstepB = (size_t)HALF * g.ldb * 2;
    const size_t tstepA = 2 * hstepA, tstepB = 2 * hstepB;
    const unsigned ldsw = (unsigned)wid * 1024u;
    const int aoff = lds_byte(wr * 64 + fr, fq * 8), boff = lds_byte(wc * 32 + fr, fq * 8);
#define PG8_SA(b, h) (((b) * 2 + (h)) * HTB)
#define PG8_SB(b, h) ((4 + (b) * 2 + (h)) * HTB)
#define PG8_STAGE(bufoff, gbase, voff) do { _Pragma("unroll") for (int _i = 0; _i < 2; ++_i) \
        __builtin_amdgcn_global_load_lds((const unsigned*)((const char*)(gbase) + (voff)[_i]), (PG8_LAS unsigned*)(lds + (bufoff) + ldsw + _i * 8192), 16, 0, 0); } while (0)
#define PG8_LDA(dst, b, h) do { _Pragma("unroll") for (int m = 0; m < 4; ++m) _Pragma("unroll") for (int k = 0; k < 2; ++k) dst[m][k] = *(const PG8_LAS bf16x8*)(lds + PG8_SA(b, h) + aoff + m * 2048 + k * 1024); } while (0)
#define PG8_LDB(dst, b, h) do { _Pragma("unroll") for (int n = 0; n < 2; ++n) _Pragma("unroll") for (int k = 0; k < 2; ++k) dst[n][k] = *(const PG8_LAS bf16x8*)(lds + PG8_SB(b, h) + boff + n * 2048 + k * 1024); } while (0)
#define PG8_MMA(ai, bj, At, Bt) do { __builtin_amdgcn_s_setprio(1); _Pragma("unroll") for (int m = 0; m < 4; ++m) _Pragma("unroll") for (int n = 0; n < 2; ++n) _Pragma("unroll") for (int k = 0; k < 2; ++k) \
        acc[ai][bj][m][n] = __builtin_amdgcn_mfma_f32_16x16x32_bf16(Bt[n][k], At[m][k], acc[ai][bj][m][n], 0, 0, 0); __builtin_amdgcn_s_setprio(0); } while (0)
#define PG8_WAIT_V(n) asm volatile("s_waitcnt vmcnt(" #n ")" ::: "memory")
#define PG8_WAIT_L(n) asm volatile("s_waitcnt lgkmcnt(" #n ")" ::: "memory")
#define PG8_BAR __builtin_amdgcn_s_barrier()
#define PG8_SCHED __builtin_amdgcn_sched_barrier(0)
    Unit cur, nxt; int ui = 0;
    if (!S.next(0, cur)) return;
    f32x4 acc[2][2][4][2];
#pragma unroll
    for (int a = 0; a < 2; ++a)
#pragma unroll
        for (int b = 0; b < 2; ++b)
#pragma unroll
            for (int m = 0; m < 4; ++m)
#pragma unroll
                for (int n = 0; n < 2; ++n) acc[a][b][m][n] = (f32x4){0.f, 0.f, 0.f, 0.f};
    bf16x8 At[4][2], B0[2][2], B1[2][2];
    const char* cA = (const char*)g.A + (size_t)cur.pm * tstepA; const char* cB = (const char*)g.Bt + (size_t)cur.pn * tstepB;
    PG8_STAGE(PG8_SB(0, 0), cB, voffB); PG8_STAGE(PG8_SB(0, 1), cB + hstepB, voffB); PG8_STAGE(PG8_SA(0, 0), cA, voffA); PG8_STAGE(PG8_SA(0, 1), cA + hstepA, voffA);
    if (wr == 1) PG8_BAR;
    PG8_WAIT_V(2); PG8_BAR;
    PG8_STAGE(PG8_SB(1, 0), cB + kstep, voffB); PG8_STAGE(PG8_SA(1, 0), cA + kstep, voffA); PG8_STAGE(PG8_SB(1, 1), cB + hstepB + kstep, voffB);
    PG8_WAIT_V(6); PG8_BAR;
    for (;;) {
        const bool has_next = S.next(ui + 1, nxt);
        const char* nA = has_next ? (const char*)g.A + (size_t)nxt.pm * tstepA : cA; const char* nB = has_next ? (const char*)g.Bt + (size_t)nxt.pn * tstepB : cB;
        for (int t = 0; t < nt; t += 2) {
            const bool last = (t == nt - 2);
            const char* a1 = cA + (size_t)(t + 1) * kstep;
            const char* a2 = last ? nA : cA + (size_t)(t + 2) * kstep; const char* b2 = last ? nB : cB + (size_t)(t + 2) * kstep;
            const char* a3 = a2 + kstep; const char* b3 = b2 + kstep;
            PG8_LDB(B0, 0, 0); PG8_LDB(B1, 0, 1); PG8_SCHED; PG8_LDA(At, 0, 0); PG8_STAGE(PG8_SA(1, 1), a1 + hstepA, voffA);
            PG8_WAIT_V(8); PG8_WAIT_L(0); PG8_BAR; PG8_MMA(0, 0, At, B0); PG8_MMA(0, 1, At, B1); PG8_BAR; PG8_SCHED;
            PG8_LDA(At, 0, 1); PG8_STAGE(PG8_SB(0, 0), b2, voffB); PG8_STAGE(PG8_SB(0, 1), b2 + hstepB, voffB); PG8_STAGE(PG8_SA(0, 0), a2, voffA);
            PG8_WAIT_V(8); PG8_WAIT_L(0); PG8_BAR; PG8_MMA(1, 0, At, B0); PG8_MMA(1, 1, At, B1); PG8_BAR; PG8_SCHED;
            PG8_LDB(B0, 1, 0); PG8_LDB(B1, 1, 1); PG8_SCHED; PG8_LDA(At, 1, 0); PG8_STAGE(PG8_SA(0, 1), a2 + hstepA, voffA);
            PG8_WAIT_V(8); PG8_WAIT_L(0); PG8_BAR; PG8_MMA(0, 0, At, B0); PG8_MMA(0, 1, At, B1); PG8_BAR; PG8_SCHED;
            PG8_LDA(At, 1, 1); PG8_STAGE(PG8_SB(1, 0), b3, voffB); PG8_STAGE(PG8_SB(1, 1), b3 + hstepB, voffB); PG8_STAGE(PG8_SA(1, 0), a3, voffA);
            PG8_WAIT_V(8); PG8_WAIT_L(0); PG8_BAR; PG8_MMA(1, 0, At, B0); PG8_MMA(1, 1, At, B1); PG8_BAR; PG8_SCHED;
        }
        if (wr == 0) PG8_BAR;
        if constexpr (!Epi::AFTER_DRAIN) { E(acc, cur, wr, wc, fr, fq); }
        if (!has_next) break;
#pragma unroll
        for (int a = 0; a < 2; ++a)
#pragma unroll
            for (int b = 0; b < 2; ++b)
#pragma unroll
                for (int m = 0; m < 4; ++m)
#pragma unroll
                    for (int n = 0; n < 2; ++n) acc[a][b][m][n] = (f32x4){0.f, 0.f, 0.f, 0.f};
        cur = nxt; cA = nA; cB = nB; ++ui;
        if (wr == 1) PG8_BAR;
    }
    PG8_WAIT_V(0);
    PG8_BAR;
    if constexpr (Epi::AFTER_DRAIN) { E.fused(acc, cur, wr, wc, fr, fq, lds, wid, lane); }
#undef PG8_SA
#undef PG8_SB
#undef PG8_STAGE
#undef PG8_LDA
#undef PG8_LDB
#undef PG8_MMA
#undef PG8_WAIT_V
#undef PG8_WAIT_L
#undef PG8_BAR
#undef PG8_SCHED
}
}

#define GAS __attribute__((address_space(1)))
#define LAS __attribute__((address_space(3)))
typedef unsigned short bf16;
typedef unsigned v4u __attribute__((ext_vector_type(4)));
typedef unsigned v2u __attribute__((ext_vector_type(2)));
typedef float f32x4 __attribute__((ext_vector_type(4)));
typedef float f32x2 __attribute__((ext_vector_type(2)));
typedef float f32x16 __attribute__((ext_vector_type(16)));
typedef short bf16x8 __attribute__((ext_vector_type(8)));
typedef short s16x4 __attribute__((ext_vector_type(4)));
typedef GAS unsigned gu32;
#define RLX_AGENT __ATOMIC_RELAXED, __HIP_MEMORY_SCOPE_AGENT
#define LDS_WAIT() asm volatile("s_waitcnt lgkmcnt(0)" ::: "memory")
#define VM_WAIT() asm volatile("s_waitcnt vmcnt(0)" ::: "memory")
__device__ __forceinline__ unsigned f2bf(float f) { unsigned u = __builtin_bit_cast(unsigned, f); return (u + 0x7fffu + ((u >> 16) & 1u)) >> 16; }
__device__ __forceinline__ unsigned pk2(float lo, float hi) { return f2bf(lo) | (f2bf(hi) << 16); }
__device__ __forceinline__ float bf2f(unsigned short b) { return __builtin_bit_cast(float, (unsigned)b << 16); }
__device__ __forceinline__ float bflo(unsigned u) { return __builtin_bit_cast(float, u << 16); }
__device__ __forceinline__ float bfhi(unsigned u) { return __builtin_bit_cast(float, u & 0xffff0000u); }


__device__ __forceinline__ int lane_id() { int r; asm volatile("v_mbcnt_lo_u32_b32 %0, -1, 0\n\tv_mbcnt_hi_u32_b32 %0, -1, %0" : "=v"(r)); return r; }
#define TID_IS_ZERO(wave_) ((wave_) == 0 && lane_id() == 0)
#define XB_TMO      128
#define XB_XCNT(j)  (256  + 64 * (j))
#define XB_XSUB(j)  (1280 + 64 * (j))
#define XB_XGEN(j)  (2304 + 64 * (j))
#define XB_TOP      3328
#define XB_TOPGEN   3392
#define XCD_BAR_WORDS 3456
#define XB_SPIN_CAP (1u << 18)

__device__ __forceinline__ unsigned xb_ld(unsigned* p)              { return __hip_atomic_load(p, __ATOMIC_RELAXED, __HIP_MEMORY_SCOPE_AGENT); }
__device__ __forceinline__ unsigned xb_add(unsigned* p, unsigned v) { return __hip_atomic_fetch_add(p, v, __ATOMIC_RELAXED, __HIP_MEMORY_SCOPE_AGENT); }
__device__ __forceinline__ unsigned xb_xcc_id() { return (unsigned)__builtin_amdgcn_s_getreg((3 << 11) | 20) & 0xFu; }
#define XB_SPIN(cond, bar) do { unsigned _sp = 0; while (cond) { __builtin_amdgcn_s_sleep(1); \
    if ((++_sp & 255u) == 0u) { if (xb_ld(&(bar)[XB_TMO])) break; if (_sp > XB_SPIN_CAP) { atomicAdd(&(bar)[XB_TMO], 1u); break; } } } } while (0)

struct XcdBarrier {
    unsigned* bar; unsigned x; int wave;
    volatile LAS unsigned* st;
};

__device__ __forceinline__ XcdBarrier xcd_barrier_post(unsigned* bar, volatile LAS unsigned* st, int wave) {
    XcdBarrier b; b.bar = bar; b.x = xb_xcc_id(); b.st = st; b.wave = wave;
    if (TID_IS_ZERO(wave)) (void)xb_add(&bar[XB_XCNT(b.x)], 1u);
    return b;
}
__device__ __forceinline__ void xcd_barrier_complete(unsigned* bar, unsigned x, unsigned& nloc, unsigned& nx) {
    const unsigned G = gridDim.x * gridDim.y * gridDim.z;
    unsigned sum, cnt, mine, sp = 0u;
    for (;;) {
        sum = 0u; cnt = 0u; mine = 0u;
#pragma unroll
        for (unsigned j = 0; j < 16; ++j) { const unsigned c = xb_ld(&bar[XB_XCNT(j)]); sum += c; cnt += (c > 0u) ? 1u : 0u; mine = (j == x) ? c : mine; }
        if (sum == G) break;
        __builtin_amdgcn_s_sleep(1);
        if ((++sp & 255u) == 0u) { if (xb_ld(&bar[XB_TMO])) break; if (sp > XB_SPIN_CAP) { atomicAdd(&bar[XB_TMO], 1u); break; } }
    }
    nloc = mine > 0u ? mine : 1u; nx = cnt > 0u ? cnt : 1u;
}

__device__ __forceinline__ void xcd_barrier(const XcdBarrier& b) {
    asm volatile("s_waitcnt vmcnt(0)" ::: "memory");
    __syncthreads();
    if (TID_IS_ZERO(b.wave)) {
        unsigned* bar = b.bar;
        __builtin_amdgcn_s_waitcnt(0);
        unsigned nloc = b.st[0], nx = b.st[1];
        if (nloc == 0u) { xcd_barrier_complete(bar, b.x, nloc, nx); b.st[0] = nloc; b.st[1] = nx; }
        const unsigned old = xb_add(&bar[XB_XSUB(b.x)], 1u);
        const unsigned gen = old / nloc;
        if (old + 1u == (gen + 1u) * nloc) {
            __builtin_amdgcn_fence(__ATOMIC_RELEASE, "agent");
            asm volatile("s_waitcnt vmcnt(0)" ::: "memory");
            const unsigned og = xb_add(&bar[XB_TOP], 1u);
            const unsigned tg = og / nx;
            if (og + 1u == (tg + 1u) * nx) xb_add(&bar[XB_TOPGEN], 1u);
            else XB_SPIN(xb_ld(&bar[XB_TOPGEN]) == tg, bar);
            __builtin_amdgcn_fence(__ATOMIC_ACQUIRE, "agent");
            xb_add(&bar[XB_XGEN(b.x)], 1u);
            asm volatile("s_waitcnt vmcnt(0)" ::: "memory");
        } else {
            XB_SPIN(xb_ld(&bar[XB_XGEN(b.x)]) == gen, bar);
            __builtin_amdgcn_fence(__ATOMIC_ACQUIRE, "agent");
            asm volatile("s_waitcnt vmcnt(0)" ::: "memory");
        }
    }
    __syncthreads();
}


constexpr int NWAVES = 8, NTHR = 512;
constexpr int DM = 1024, TP = 16384, TS = 1024, TA = TP + TS, SEQ = 8192, NB_P = 2, NB_S = 128, LS = 8;
constexpr int N_IN = 3328;
constexpr int PASTL = 2048, PAGE = 128, NPAGES = 16;
constexpr float EPS = 1e-6f;
constexpr float LOG2E = 1.4426950408889634f;
constexpr float C2F = 0.125f * LOG2E;
constexpr float C2C = 0.0625f * LOG2E;

enum { I_XP = 0, I_XS, I_CFK, I_CFV, I_CFL, I_SGLA, I_CMK, I_CMV, I_PT, I_MEMP, I_GMIX, I_WIN, I_BFF, I_WG2, I_BG, I_GGO, I_WOUT, I_GCROSS, I_GMEM,
       I_WMK, I_WMV, I_WCQ, I_WCO, I_GFFN, I_PWQ, I_PSK, I_PU, I_PV, I_GFIN, N_INPUTS };
constexpr size_t O_YP = 0, O_YS = 16777216, O_FKP = 17825792, O_FVP = 26214400, O_LFP = 34603008, O_GSP = 34734080, O_MKP = 34799616, O_MVP = 35323904,
                 O_FKS = 35848192, O_FVS = 36372480, O_LFS = 36896768, O_GSS = 36904960, O_TOTAL = 41099264;

constexpr size_t MiB = 1u << 20;
constexpr size_t WS_CTL = 0, CTL_ZERO_BYTES = 1 * MiB;
constexpr size_t WS_WIN = 2 * MiB, WS_WOUT = 10 * MiB, WS_WMK = 12 * MiB, WS_WMV = 14 * MiB, WS_WCQ = 16 * MiB, WS_WCO = 18 * MiB, WS_WPK = 20 * MiB;
constexpr size_t WS_MB = 24 * MiB, WS_MK16 = 25 * MiB, WS_MVT16 = 26 * MiB, WS_KBIAS = 27 * MiB, WS_GDEC = 28 * MiB, WS_GG = 29 * MiB;
constexpr size_t WS_U16 = 32 * MiB, WS_V16 = 64 * MiB, WS_HB = 96 * MiB, WS_QF = 132 * MiB, WS_KF = 150 * MiB, WS_VF = 168 * MiB;
constexpr size_t WS_GQ = 186 * MiB, WS_GK = 204 * MiB, WS_GV = 222 * MiB, WS_GR = 256 * MiB, WS_SUF = 290 * MiB, WS_GKV = 298 * MiB;
constexpr size_t WS_MERGED = 330 * MiB, WS_X1 = 364 * MiB, WS_X2 = 432 * MiB, WS_QC = 500 * MiB, WS_PC = 534 * MiB, WS_OC = 566 * MiB, WS_SC = 600 * MiB;
constexpr size_t WS_MISC = 736 * MiB, WS_SS = 740 * MiB  , WS_BB = 744 * MiB, WS_END = 800 * MiB;
constexpr int CW_BAR = 4096;

constexpr int RING_BYTES = 131072;
constexpr int LDSCTL_OFF = RING_BYTES, MISC_OFF = LDSCTL_OFF + 320;
constexpr int ARGS_OFF = MISC_OFF + 128;
constexpr int LDS_BYTES = 147456;

struct Args { const void* in[N_INPUTS]; float* out; unsigned char* ws; };

__device__ __forceinline__ const void* ld_ptr(const LAS unsigned long long* p) { const unsigned long long v = *p; const unsigned lo = __builtin_amdgcn_readfirstlane((unsigned)v), hi = __builtin_amdgcn_readfirstlane((unsigned)(v >> 32)); return (const void*)(const GAS char*)(((unsigned long long)hi << 32) | lo); }
__device__ __forceinline__ Args load_args(const LAS unsigned long long* ARGP) { Args A;
    A.in[0] = ld_ptr(ARGP + 0);
    A.in[1] = ld_ptr(ARGP + 1);
    A.in[2] = ld_ptr(ARGP + 2);
    A.in[3] = ld_ptr(ARGP + 3);
    A.in[4] = ld_ptr(ARGP + 4);
    A.in[5] = ld_ptr(ARGP + 5);
    A.in[6] = ld_ptr(ARGP + 6);
    A.in[7] = ld_ptr(ARGP + 7);
    A.in[8] = ld_ptr(ARGP + 8);
    A.in[9] = ld_ptr(ARGP + 9);
    A.in[10] = ld_ptr(ARGP + 10);
    A.in[11] = ld_ptr(ARGP + 11);
    A.in[12] = ld_ptr(ARGP + 12);
    A.in[13] = ld_ptr(ARGP + 13);
    A.in[14] = ld_ptr(ARGP + 14);
    A.in[15] = ld_ptr(ARGP + 15);
    A.in[16] = ld_ptr(ARGP + 16);
    A.in[17] = ld_ptr(ARGP + 17);
    A.in[18] = ld_ptr(ARGP + 18);
    A.in[19] = ld_ptr(ARGP + 19);
    A.in[20] = ld_ptr(ARGP + 20);
    A.in[21] = ld_ptr(ARGP + 21);
    A.in[22] = ld_ptr(ARGP + 22);
    A.in[23] = ld_ptr(ARGP + 23);
    A.in[24] = ld_ptr(ARGP + 24);
    A.in[25] = ld_ptr(ARGP + 25);
    A.in[26] = ld_ptr(ARGP + 26);
    A.in[27] = ld_ptr(ARGP + 27);
    A.in[28] = ld_ptr(ARGP + 28);
    A.out = (float*)ld_ptr(ARGP + N_INPUTS); A.ws = (unsigned char*)ld_ptr(ARGP + N_INPUTS + 1); return A; }
struct Frame {
    LAS unsigned char* lds;
    int tid, lane, wave, vcu, G;
};

__device__ __forceinline__ float wave_sum(float v) {
#pragma unroll
    for (int o = 1; o < 64; o <<= 1) v += __shfl_xor(v, o);
    return v;
}
__device__ __forceinline__ float log_sigmoid(float x) { return fminf(x, 0.f) - log1pf(__expf(-fabsf(x))); }

__device__ __forceinline__ int win_src_col(int r) {
    if (r < 1536) return r;
    if (r < 1792) return 1544 + (r - 1536);
    if (r < 2048) return 1800 + (r - 1792);
    if (r < 2560) return 2056 + (r - 2048);
    if (r < 3072) return 2584 + (r - 2560);
    if (r < 3080) return 1536 + (r - 3072);
    if (r < 3096) return 2568 + (r - 3080);
    return -1;
}
template <bool WIN>
__device__ __forceinline__ void p0_transpose_item(const float* W, int ldw, int K, int nblk, bf16* WT, LAS float* scr, int item, int lane) {
    const int kb = item / nblk, nb = item % nblk, k0 = 64 * kb, n0 = 32 * nb;
    const int dr = n0 + (lane & 31); const int sc = WIN ? win_src_col(dr) : dr;
#pragma unroll 8
    for (int i = 0; i < 32; ++i) { const int kk = 2 * i + (lane >> 5); scr[kk * 33 + (lane & 31)] = (sc >= 0) ? W[(size_t)(k0 + kk) * ldw + sc] : 0.f; }
    LDS_WAIT(); asm volatile("" ::: "memory");
    const int c = lane & 7;
#pragma unroll
    for (int j = 0; j < 4; ++j) { const int n = (lane >> 3) + 8 * j; const LAS float* s = scr + (8 * c) * 33 + n;
        v4u o; o.x = pk2(s[0 * 33], s[1 * 33]); o.y = pk2(s[2 * 33], s[3 * 33]); o.z = pk2(s[4 * 33], s[5 * 33]); o.w = pk2(s[6 * 33], s[7 * 33]);
        *(GAS v4u*)(WT + (size_t)(n0 + n) * K + k0 + 8 * c) = o; }
    LDS_WAIT(); asm volatile("" ::: "memory");
}
__device__ __forceinline__ void rms_row_bf16(const float* xrow, const float* g, bf16* orow, int lane) {
    const f32x4* xr = (const f32x4*)xrow + lane; const f32x4* gr = (const f32x4*)g + lane;
    f32x4 v[4]; float s = 0.f;
#pragma unroll
    for (int j = 0; j < 4; ++j) { v[j] = xr[64 * j]; s += (v[j].x * v[j].x + v[j].y * v[j].y) + (v[j].z * v[j].z + v[j].w * v[j].w); }
    const float r = rsqrtf(wave_sum(s) * (1.f / DM) + EPS);
    v2u* o8 = (v2u*)orow + lane;
#pragma unroll
    for (int j = 0; j < 4; ++j) { const f32x4 gg = gr[64 * j]; v2u o; o.x = pk2(v[j].x * r * gg.x, v[j].y * r * gg.y); o.y = pk2(v[j].z * r * gg.z, v[j].w * r * gg.w); o8[64 * j] = o; }
}

using pg8::Unit;
struct EpiGen {
    static constexpr bool PERM = false, AFTER_DRAIN = false;
    float* d32; int ld32; bf16* d16; int ld16; float sc16;
    const float* r0; const float* r1; int rsplit; int ldr;
    const float* gcol;
    float* ssq;
    const float* rsq;
    __device__ __forceinline__ void operator()(const f32x4 (&acc)[2][2][4][2], const Unit& u, int wr, int wc, int fr, int fq) const {
        int row0 = u.pm * 256 + wr * 64 + fr, col0 = u.pn * 256 + wc * 32 + fq * 4;
        asm volatile("" : "+v"(row0), "+v"(col0));
#pragma unroll
        for (int ai = 0; ai < 2; ++ai)
#pragma unroll
            for (int m = 0; m < 4; ++m) { const int row = row0 + ai * 128 + m * 16;
                const float* rp = nullptr; if (r0) rp = (row < rsplit) ? r0 + (size_t)row * ldr : r1 + (size_t)(row - rsplit) * ldr;
                float rs = 1.f; if (rsq) rs = rsqrtf(rsq[row] * (1.f / 1024.f) + EPS);
                float ss = 0.f;
#pragma unroll
                for (int bj = 0; bj < 2; ++bj)
#pragma unroll
                    for (int n = 0; n < 2; ++n) { const int col = col0 + bj * 128 + n * 16; f32x4 v = acc[ai][bj][m][n];
                        if (rsq) { v[0] *= rs; v[1] *= rs; v[2] *= rs; v[3] *= rs; }
                        if (r0) v += *(const f32x4*)(rp + col);
                        if (d32) *(f32x4*)(d32 + (size_t)row * ld32 + col) = v;
                        if (ssq) ss += (v[0] * v[0] + v[1] * v[1]) + (v[2] * v[2] + v[3] * v[3]);
                        if (d16) { f32x4 w = v; if (gcol) w = w * *(const f32x4*)(gcol + col);
                            v2u o; o.x = pg8::cvt_pk_bf16(w[0] * sc16, w[1] * sc16); o.y = pg8::cvt_pk_bf16(w[2] * sc16, w[3] * sc16); *(v2u*)(d16 + (size_t)row * ld16 + col) = o; } }
                if (ssq) { ss += __shfl_xor(ss, 16); ss += __shfl_xor(ss, 32); if (fq == 0) atomicAdd(ssq + row, ss); } }
    }
};
struct EpiInProj {
    static constexpr bool PERM = false, AFTER_DRAIN = false;
    float* out; unsigned char* ws; const float* bff;
    __device__ __forceinline__ void operator()(const f32x4 (&acc)[2][2][4][2], const Unit& u, int wr, int wc, int fr, int fq) const {
        const int pn = u.pn; const bool smp = u.pm >= 64;
        int row0 = u.pm * 256 + wr * 64 + fr;
        int orow0 = (smp ? (u.pm - 64) * 256 : u.pm * 256) + wr * 64 + fr;
        asm volatile("" : "+v"(row0), "+v"(orow0));
        float* d32 = nullptr; int ld32 = 0; bool d32_grp = false; bf16* d16 = nullptr; int ld16 = 0; float s32 = 1.f, s16 = 1.f; int cb = 0;
        if (pn < 2) { d16 = (bf16*)(ws + WS_QF); ld16 = 512; s16 = C2F; cb = pn * 256; }
        else if (pn < 4) { d32 = out + (smp ? O_FKS : O_FKP); ld32 = 512; d32_grp = true; d16 = (bf16*)(ws + WS_KF); ld16 = 512; cb = (pn - 2) * 256; }
        else if (pn < 6) { d32 = out + (smp ? O_FVS : O_FVP); ld32 = 512; d32_grp = true; d16 = (bf16*)(ws + WS_VF); ld16 = 512; cb = (pn - 4) * 256; }
        else if (pn == 6) { d32 = (float*)(ws + WS_GQ); ld32 = 256; s32 = 0.125f; }
        else if (pn == 7) { d32 = (float*)(ws + WS_GK); ld32 = 256; }
        else if (pn < 10) { d32 = (float*)(ws + WS_GV); ld32 = 512; cb = (pn - 8) * 256; }
        else if (pn < 12) { d32 = (float*)(ws + WS_GR); ld32 = 512; cb = (pn - 10) * 256; }
        if (pn < 12) {
#pragma unroll
            for (int ai = 0; ai < 2; ++ai)
#pragma unroll
                for (int m = 0; m < 4; ++m) { const int row = row0 + ai * 128 + m * 16, orow = orow0 + ai * 128 + m * 16;
#pragma unroll
                    for (int bj = 0; bj < 2; ++bj)
#pragma unroll
                        for (int n = 0; n < 2; ++n) { const int col = cb + wc * 32 + fq * 4 + bj * 128 + n * 16; const f32x4 v = acc[ai][bj][m][n];
                            if (d32) *(f32x4*)(d32 + (size_t)(d32_grp ? orow : row) * ld32 + col) = v * s32;
                            if (d16) { v2u o; o.x = pg8::cvt_pk_bf16(v[0] * s16, v[1] * s16); o.y = pg8::cvt_pk_bf16(v[2] * s16, v[3] * s16); *(v2u*)(d16 + (size_t)row * ld16 + col) = o; } } }
        } else {
            if (wc == 0) {
                float* lf = out + (smp ? O_LFS : O_LFP); float* ggp = (float*)(ws + WS_GG);
#pragma unroll
                for (int ai = 0; ai < 2; ++ai)
#pragma unroll
                    for (int m = 0; m < 4; ++m) { const int row = row0 + ai * 128 + m * 16, orow = orow0 + ai * 128 + m * 16;
#pragma unroll
                        for (int n = 0; n < 2; ++n) { const int col = n * 16 + fq * 4; const f32x4 v = acc[ai][0][m][n];
                            if (col < 8) { f32x4 o; const f32x4 b = *(const f32x4*)(bff + col);
                                o[0] = log_sigmoid(v[0] + b[0]); o[1] = log_sigmoid(v[1] + b[1]); o[2] = log_sigmoid(v[2] + b[2]); o[3] = log_sigmoid(v[3] + b[3]);
                                *(f32x4*)(lf + (size_t)orow * 8 + col) = o; }
                            else if (col < 24) *(f32x4*)(ggp + (size_t)row * 16 + (col - 8)) = v; } }
            }
        }
    }
};


__device__ __forceinline__ void p0_prologue(const Frame& F, const Args& a) {
    unsigned char* ws = a.ws;
    LAS float* scr = (LAS float*)(F.lds + F.wave * 16384);
    const int gw = F.vcu * NWAVES + F.wave, NGW = F.G * NWAVES;
    constexpr int I_WINN = 16 * (N_IN / 32), I_SQ = 16 * 32;
    constexpr int NITEMS = I_WINN + 5 * I_SQ;
    for (int it = gw; it < NITEMS; it += NGW) {
        int r = it;
        if (r < I_WINN) { p0_transpose_item<true>((const float*)a.in[I_WIN], 3096, DM, N_IN / 32, (bf16*)(ws + WS_WIN), scr, r, F.lane); continue; } r -= I_WINN;
        const int which = r / I_SQ; r -= which * I_SQ;
        const float* src = (const float*)(which == 0 ? a.in[I_WOUT] : which == 1 ? a.in[I_WMK] : which == 2 ? a.in[I_WMV] : which == 3 ? a.in[I_WCQ] : a.in[I_WCO]);
        bf16* dst = (bf16*)(ws + (which == 0 ? WS_WOUT : which == 1 ? WS_WMK : which == 2 ? WS_WMV : which == 3 ? WS_WCQ : WS_WCO));
        p0_transpose_item<false>(src, DM, DM, 32, dst, scr, r, F.lane);
    }
    { float* ssz = (float*)(ws + WS_SS); for (int i = F.vcu * NTHR + F.tid; i < 2 * TA; i += F.G * NTHR) ssz[i] = 0.f; }
    for (int m0 = gw * 2; m0 < TA + 512; m0 += NGW * 2) {
        const float* xr[2]; const float* gr[2]; bf16* orow[2];
#pragma unroll
        for (int j = 0; j < 2; ++j) { const int m = m0 + j;
            if (m < TP) { xr[j] = (const float*)a.in[I_XP] + (size_t)m * DM; gr[j] = (const float*)a.in[I_GMIX]; orow[j] = (bf16*)(ws + WS_HB) + (size_t)m * DM; }
            else if (m < TA) { xr[j] = (const float*)a.in[I_XS] + (size_t)(m - TP) * DM; gr[j] = (const float*)a.in[I_GMIX]; orow[j] = (bf16*)(ws + WS_HB) + (size_t)m * DM; }
            else { xr[j] = (const float*)a.in[I_MEMP] + (size_t)(m - TA) * DM; gr[j] = (const float*)a.in[I_GMEM]; orow[j] = (bf16*)(ws + WS_MB) + (size_t)(m - TA) * DM; } }
        f32x4 v[2][4]; float s[2];
#pragma unroll
        for (int j = 0; j < 2; ++j) { s[j] = 0.f;
#pragma unroll
            for (int q = 0; q < 4; ++q) v[j][q] = ((const f32x4*)xr[j])[F.lane + 64 * q]; }
#pragma unroll
        for (int j = 0; j < 2; ++j) {
#pragma unroll
            for (int q = 0; q < 4; ++q) s[j] += (v[j][q].x * v[j][q].x + v[j][q].y * v[j][q].y) + (v[j][q].z * v[j][q].z + v[j][q].w * v[j][q].w);
            const float r = rsqrtf(wave_sum(s[j]) * (1.f / DM) + EPS);
#pragma unroll
            for (int q = 0; q < 4; ++q) { const f32x4 gg = ((const f32x4*)gr[j])[F.lane + 64 * q]; v2u o; o.x = pk2(v[j][q].x * r * gg.x, v[j][q].y * r * gg.y); o.y = pk2(v[j][q].z * r * gg.z, v[j][q].w * r * gg.w); ((v2u*)orow[j])[F.lane + 64 * q] = o; } }
    }
    {
        for (int r0 = gw * 4; r0 < 2 * 16384; r0 += NGW * 4) {
            f32x4 x[4][4];
#pragma unroll
            for (int j = 0; j < 4; ++j) { const int r = r0 + j; const bool isv = r >= 16384; const int e = isv ? r - 16384 : r;
                const f32x4* s = (const f32x4*)((const float*)(isv ? a.in[I_PV] : a.in[I_PU]) + (size_t)e * DM + 16 * F.lane);
#pragma unroll
                for (int q = 0; q < 4; ++q) x[j][q] = __builtin_nontemporal_load(s + q); }
#pragma unroll
            for (int j = 0; j < 4; ++j) { const int r = r0 + j; const bool isv = r >= 16384; const int e = isv ? r - 16384 : r; float am = 0.f;
#pragma unroll
                for (int q = 0; q < 4; ++q) am = fmaxf(am, fmaxf(fmaxf(fabsf(x[j][q].x), fabsf(x[j][q].y)), fmaxf(fabsf(x[j][q].z), fabsf(x[j][q].w))));
#pragma unroll
                for (int o = 1; o < 64; o <<= 1) am = fmaxf(am, __shfl_xor(am, o));
                const float inv = am > 0.f ? 448.f / am : 0.f;
                v4u o4;
#pragma unroll
                for (int q = 0; q < 4; ++q) { int pk = __builtin_amdgcn_cvt_pk_fp8_f32(x[j][q].x * inv, x[j][q].y * inv, 0, false); pk = __builtin_amdgcn_cvt_pk_fp8_f32(x[j][q].z * inv, x[j][q].w * inv, pk, true); o4[q] = (unsigned)pk; }
                *(v4u*)(ws + (isv ? WS_V16 : WS_U16) + (size_t)e * DM + 16 * F.lane) = o4;
                if (F.lane == 0) ((float*)(ws + WS_MISC))[r] = am * (1.f / 448.f); }
        }
    }
    __syncthreads();
    for (int it = blockIdx.x; it < 256; it += F.G) {
        const int c = it >> 4, kt = it & 15, half = c & 1;
        LAS float* SK = (LAS float*)F.lds; LAS float* WT = (LAS float*)(F.lds + 128 * 129 * 4);
        const float* sk = (const float*)a.in[I_PSK] + (size_t)half * 128 * 128; const float* wq = (const float*)a.in[I_PWQ] + (size_t)(kt * 64) * 2048 + c * 128;
#pragma unroll 4
        for (int i = 0; i < 32; ++i) { const int idx = F.tid + 512 * i; SK[(idx >> 7) * 129 + (idx & 127)] = sk[idx]; }
#pragma unroll 4
        for (int i = 0; i < 16; ++i) { const int idx = F.tid + 512 * i; WT[(idx >> 7) * 129 + (idx & 127)] = wq[(size_t)(idx >> 7) * 2048 + (idx & 127)]; }
        __syncthreads();
        const int tk = F.tid & 15, tkey = F.tid >> 4;
        float acc[4][4];
#pragma unroll
        for (int i = 0; i < 4; ++i)
#pragma unroll
            for (int j = 0; j < 4; ++j) acc[i][j] = 0.f;
        for (int j = 0; j < 128; ++j) {
            float av[4], bv[4];
#pragma unroll
            for (int i = 0; i < 4; ++i) { av[i] = SK[(4 * tkey + i) * 129 + j]; bv[i] = WT[(4 * tk + i) * 129 + j]; }
#pragma unroll
            for (int i = 0; i < 4; ++i)
#pragma unroll
                for (int i2 = 0; i2 < 4; ++i2) acc[i][i2] += av[i] * bv[i2];
        }
        bf16* wp = (bf16*)(ws + WS_WPK);
#pragma unroll
        for (int i = 0; i < 4; ++i) { v2u o; o.x = pk2(acc[i][0], acc[i][1]); o.y = pk2(acc[i][2], acc[i][3]); *(v2u*)(wp + (size_t)(c * 128 + 4 * tkey + i) * DM + kt * 64 + 4 * tk) = o; }
        __syncthreads();
    }
}


__device__ __forceinline__ void fox_prompt_cumsum(const Frame& F, const float* logf  , float* kbias, int b) {
    LAS float* WT = (LAS float*)F.lds;
    const int t0 = F.wave * 1024 + F.lane * 16;
    const f32x4* src = (const f32x4*)(logf + ((size_t)b * SEQ + t0) * 8);
    float s[8];
#pragma unroll
    for (int h = 0; h < 8; ++h) s[h] = 0.f;
#pragma unroll 4
    for (int i = 0; i < 16; ++i) { const f32x4 a = src[2 * i], c = src[2 * i + 1]; s[0] += a.x; s[1] += a.y; s[2] += a.z; s[3] += a.w; s[4] += c.x; s[5] += c.y; s[6] += c.z; s[7] += c.w; }
    float ex[8];
#pragma unroll
    for (int h = 0; h < 8; ++h) { float v = s[h];
#pragma unroll
        for (int o = 1; o < 64; o <<= 1) { const float t = __shfl_up(v, o); if (F.lane >= o) v += t; }
        ex[h] = v - s[h];
        if (F.lane == 63) WT[F.wave * 8 + h] = v; }
    __syncthreads();
#pragma unroll
    for (int h = 0; h < 8; ++h) { float c = 0.f; for (int w = 0; w < F.wave; ++w) c += WT[w * 8 + h]; ex[h] += c; }
    float* dst = kbias + (size_t)(b * 8) * SEQ + t0;
#pragma unroll 4
    for (int i = 0; i < 16; ++i) { const f32x4 a = src[2 * i], c = src[2 * i + 1];
        ex[0] += a.x; ex[1] += a.y; ex[2] += a.z; ex[3] += a.w; ex[4] += c.x; ex[5] += c.y; ex[6] += c.z; ex[7] += c.w;
#pragma unroll
        for (int h = 0; h < 8; ++h) dst[(size_t)h * SEQ + i] = -ex[h] * LOG2E; }
    __syncthreads();
}
__device__ __forceinline__ void fox_sample_suffix(const Frame& F, const float* cfl, const int* pt, float* suf, int bs) {
    float carry[8];
#pragma unroll
    for (int h = 0; h < 8; ++h) carry[h] = 0.f;
    const int mypg = pt[bs * NPAGES + (F.lane & 15)];
#pragma unroll 1
    for (int pb = NPAGES - 4; pb >= 0; pb -= 4) {
        f32x4 x[4][4];
#pragma unroll
        for (int j = 0; j < 4; ++j) { const int pg = __builtin_amdgcn_readlane(mypg, 0) * 0 + __shfl(mypg, pb + j); const f32x4* src = (const f32x4*)(cfl + ((size_t)pg * PAGE + 2 * F.lane) * 8);
            x[j][0] = src[0]; x[j][1] = src[1]; x[j][2] = src[2]; x[j][3] = src[3]; }
#pragma unroll
        for (int j = 3; j >= 0; --j) { const int p = pb + j;
            const float ra[8] = {x[j][0].x, x[j][0].y, x[j][0].z, x[j][0].w, x[j][1].x, x[j][1].y, x[j][1].z, x[j][1].w}, rb[8] = {x[j][2].x, x[j][2].y, x[j][2].z, x[j][2].w, x[j][3].x, x[j][3].y, x[j][3].z, x[j][3].w};
#pragma unroll
            for (int h = 0; h < 8; ++h) {
                const float ps = ra[h] + rb[h]; float v = ps;
#pragma unroll
                for (int o = 1; o < 64; o <<= 1) { const float t = __shfl_down(v, o); if (F.lane + o < 64) v += t; }
                const float exs = v - ps;
                float* d = suf + (size_t)(bs * 8 + h) * PASTL + p * PAGE + 2 * F.lane;
                *(f32x2*)d = (f32x2){(carry[h] + exs + rb[h]) * LOG2E, (carry[h] + exs) * LOG2E};
                carry[h] += __shfl(v, 0);
            }
        }
    }
}

__device__ __forceinline__ void gla_gate_tile(const Frame& F, const float* gg, const float* w2, const float* bg, int row0, int h, int nt, LAS float* LA, LAS float* GGS) {
    for (int e = F.tid; e < nt * 16; e += NTHR) GGS[e] = gg[(size_t)row0 * 16 + e];
    const int dk = F.tid & 63; float wc[16];
#pragma unroll
    for (int r = 0; r < 16; ++r) wc[r] = w2[r * 256 + h * 64 + dk];
    const float bb = bg[h * 64 + dk];
    __syncthreads();
    for (int t = F.tid >> 6; t < nt; t += 8) { float z = bb;
#pragma unroll
        for (int q = 0; q < 4; ++q) { const f32x4 g4 = *(const LAS f32x4*)(GGS + t * 16 + 4 * q); z += g4.x * wc[4 * q] + g4.y * wc[4 * q + 1] + g4.z * wc[4 * q + 2] + g4.w * wc[4 * q + 3]; }
        LA[t * 64 + dk] = log_sigmoid(z) * (1.f / 16.f); }
}
__device__ __forceinline__ void gla_cumsum64(const Frame& F, LAS float* LA, LAS float* SEG) {
    const int dk = F.lane, w = F.wave; float v[8]; float run = 0.f;
#pragma unroll
    for (int i = 0; i < 8; ++i) { run += LA[(8 * w + i) * 64 + dk]; v[i] = run; }
    SEG[w * 64 + dk] = run;
    __syncthreads();
    float pre = 0.f;
    for (int j = 0; j < w; ++j) pre += SEG[j * 64 + dk];
#pragma unroll
    for (int i = 0; i < 8; ++i) LA[(8 * w + i) * 64 + dk] = v[i] + pre;
    __syncthreads();
}
__device__ __forceinline__ void gla_g1_unit(const Frame& F, const Args& a, int u) {
    unsigned char* ws = a.ws;
    const int b = u >> 9, h = (u >> 7) & 3, n = u & 127; const int row0 = b * SEQ + n * 64;
    LAS float* LA = (LAS float*)F.lds; LAS float* KR = LA + 4096; LAS float* SEG = KR + 4096; LAS float* GGS = SEG + 512; LAS float* VS = GGS + 1024;
#pragma unroll
    for (int i = 0; i < 16; ++i) { const int e = F.tid + NTHR * i; VS[e] = ((const float*)(ws + WS_GV))[(size_t)(row0 + (e >> 7)) * 512 + h * 128 + (e & 127)]; }
    float gkv[8];
#pragma unroll
    for (int i = 0; i < 8; ++i) { const int e = F.tid + NTHR * i; gkv[i] = ((const float*)(ws + WS_GK))[(size_t)(row0 + (e >> 6)) * 256 + h * 64 + (e & 63)]; }
    gla_gate_tile(F, (const float*)(ws + WS_GG), (const float*)a.in[I_WG2], (const float*)a.in[I_BG], row0, h, 64, LA, GGS);
    __syncthreads();
    gla_cumsum64(F, LA, SEG);
    if (F.tid < 64) ((float*)(ws + WS_GDEC))[(size_t)((b * 4 + h) * 128 + n) * 64 + F.tid] = __expf(LA[63 * 64 + F.tid]);
    float* bbuf = (float*)(ws + WS_BB);
#pragma unroll
    for (int i = 0; i < 8; ++i) { const int e = F.tid + NTHR * i; const int t = e >> 6, dk = e & 63; const float bb = LA[e]; bbuf[(size_t)(row0 + t) * 256 + h * 64 + dk] = bb;
        KR[e] = gkv[i] * __expf(LA[63 * 64 + dk] - bb); }
    __syncthreads();
    {
        const int dvq = F.tid & 31, dkq = F.tid >> 5; float acc[4][4];
#pragma unroll
        for (int i = 0; i < 4; ++i)
#pragma unroll
            for (int j = 0; j < 4; ++j) acc[i][j] = 0.f;
#pragma unroll 8
        for (int t = 0; t < 64; ++t) { const f32x4 v4 = *(const LAS f32x4*)(VS + t * 128 + 4 * dvq), k4 = *(const LAS f32x4*)(KR + t * 64 + 4 * dkq);
#pragma unroll
            for (int i = 0; i < 4; ++i)
#pragma unroll
                for (int j = 0; j < 4; ++j) acc[i][j] += k4[i] * v4[j]; }
        float* kv = (float*)(ws + WS_GKV) + ((size_t)((b * 4 + h) * 128 + n) * 64 + 4 * dkq) * 128 + 4 * dvq;
#pragma unroll
        for (int i = 0; i < 4; ++i) *(f32x4*)(kv + (size_t)i * 128) = (f32x4){acc[i][0], acc[i][1], acc[i][2], acc[i][3]};
    }
    __syncthreads();
}
__device__ __forceinline__ void gla_scan(const Frame& F, const Args& a) {
    int tid = F.wave * 64 + lane_id(); asm volatile("" : "+v"(tid));
    if (tid >= 256) return;
    for (int e = F.vcu * 256 + tid; e < 65536; e += F.G * 256) {
    const int bh = e >> 13, dk = (e >> 7) & 63, dv = e & 127;
    float* kv = (float*)(a.ws + WS_GKV) + ((size_t)bh * 128 * 64 + dk) * 128 + dv; const float* dc = (const float*)(a.ws + WS_GDEC) + (size_t)bh * 128 * 64 + dk;
    float S = 0.f;
    for (int n0 = 0; n0 < 128; n0 += 8) { float kvv[8], dd[8];
#pragma unroll
        for (int j = 0; j < 8; ++j) { kvv[j] = kv[(size_t)(n0 + j) * 8192]; dd[j] = dc[(size_t)(n0 + j) * 64]; }
#pragma unroll
        for (int j = 0; j < 8; ++j) { kv[(size_t)(n0 + j) * 8192] = S; S = dd[j] * S + kvv[j]; } }
    a.out[O_GSP + (size_t)bh * 8192 + dk * 128 + dv] = S;
    }
}
__device__ __forceinline__ float silu(float x) { return x / (1.f + __expf(-x)); }
__device__ __forceinline__ void gla_sample_unit(const Frame& F, const Args& a, int u) {
    unsigned char* ws = a.ws;
    const int bs = u >> 2, h = u & 3; const int row0 = TP + bs * LS;
    LAS float* LA = (LAS float*)F.lds; LAS float* BL = LA + 512; LAS float* QD = BL + 64; LAS float* KI = QD + 512; LAS float* KR = KI + 512; LAS float* ATT = KR + 512; LAS float* OP = ATT + 64; LAS float* VS = OP + 4096;
    gla_gate_tile(F, (const float*)(ws + WS_GG), (const float*)a.in[I_WG2], (const float*)a.in[I_BG], row0, h, 8, LA, VS + 1024);
#pragma unroll
    for (int i = 0; i < 2; ++i) { const int e = F.tid + NTHR * i; VS[e] = ((const float*)(ws + WS_GV))[(size_t)(row0 + (e >> 7)) * 512 + h * 128 + (e & 127)]; }
    __syncthreads();
    if (F.tid < 64) { float run = 0.f;
#pragma unroll
        for (int t = 0; t < 8; ++t) { run += LA[t * 64 + F.tid]; LA[t * 64 + F.tid] = run; } BL[F.tid] = run; }
    __syncthreads();
    { const int e = F.tid, t = e >> 6, dk = e & 63; const float bb = LA[e];
      const float q = ((const float*)(ws + WS_GQ))[(size_t)(row0 + t) * 256 + h * 64 + dk], k = ((const float*)(ws + WS_GK))[(size_t)(row0 + t) * 256 + h * 64 + dk];
      QD[e] = q * __expf(bb); KI[e] = k * __expf(-bb); KR[e] = k * __expf(BL[dk] - bb); }
    __syncthreads();
    if (F.tid < 64) { const int t = F.tid >> 3, s = F.tid & 7; float acc = 0.f;
        if (s <= t) { for (int dk = 0; dk < 64; ++dk) acc += QD[t * 64 + dk] * KI[s * 64 + dk]; }
        ATT[F.tid] = acc; }
    const int dv = F.tid & 127, dkg = F.tid >> 7;
    {
        const float* st = (const float*)a.in[I_SGLA] + ((size_t)(bs * 4 + h) * 64 + dkg * 16) * 128 + dv;
        float S0[16];
#pragma unroll
        for (int i = 0; i < 16; ++i) S0[i] = st[(size_t)i * 128];
#pragma unroll
        for (int t = 0; t < 8; ++t) { float o = 0.f;
#pragma unroll
            for (int i = 0; i < 16; ++i) o += QD[t * 64 + dkg * 16 + i] * S0[i];
            OP[(dkg * 8 + t) * 128 + dv] = o; }
        float* so = a.out + O_GSS + ((size_t)(bs * 4 + h) * 64 + dkg * 16) * 128 + dv;
#pragma unroll
        for (int i = 0; i < 16; ++i) { float sn = __expf(BL[dkg * 16 + i]) * S0[i];
#pragma unroll
            for (int t = 0; t < 8; ++t) sn += KR[t * 64 + dkg * 16 + i] * VS[t * 128 + dv];
            so[(size_t)i * 128] = sn; }
    }
    __syncthreads();
    {
        const int t = F.wave; float o[2]; float ss = 0.f;
#pragma unroll
        for (int j = 0; j < 2; ++j) { const int d = 2 * F.lane + j; float v = OP[(0 * 8 + t) * 128 + d] + OP[(1 * 8 + t) * 128 + d] + OP[(2 * 8 + t) * 128 + d] + OP[(3 * 8 + t) * 128 + d];
            for (int s = 0; s <= t; ++s) v += ATT[t * 8 + s] * VS[s * 128 + d];
            o[j] = v; ss += v * v; }
        const float r = rsqrtf(wave_sum(ss) * (1.f / 128.f) + EPS);
        const float* ggo = (const float*)a.in[I_GGO] + h * 128 + 2 * F.lane; const float* gr = (const float*)(ws + WS_GR) + (size_t)(row0 + t) * 512 + h * 128 + 2 * F.lane;
        const float y0 = o[0] * r * ggo[0] * silu(gr[0]), y1 = o[1] * r * ggo[1] * silu(gr[1]);
        *(unsigned*)((bf16*)(ws + WS_MERGED) + (size_t)(row0 + t) * DM + 512 + h * 128 + 2 * F.lane) = pk2(y0, y1);
    }
    __syncthreads();
}


typedef short v4i16_t __attribute__((ext_vector_type(4)));
__device__ __forceinline__ s16x4 lds_tr16(LAS unsigned char* p) { return __builtin_bit_cast(s16x4, __builtin_amdgcn_ds_read_tr16_b64_v4i16((LAS v4i16_t*)p)); }
__device__ __forceinline__ int crow(int r, int hi) { return (r & 3) + 8 * (r >> 2) + 4 * hi; }
__device__ __forceinline__ float fexp2(float x) { return __builtin_amdgcn_exp2f(x); }
constexpr float FOX_SKIP = 160.f;


__device__ __forceinline__ void fox_norms_item(const Frame& F, const bf16* QF, const bf16* KF, const float* logf, float* FN, float* LC, float* BT, int item) {
    const int bh = item >> 5, qb = item & 31, b = bh >> 3, h = bh & 7;
    float qm = 0.f, km = 0.f;
    const float* lp = logf + ((size_t)b * SEQ + qb * 256 + 4 * F.lane) * 8 + h;
    const float l0 = lp[0], l1 = lp[8], l2 = lp[16], l3 = lp[24];
#pragma unroll
    for (int i = 0; i < 4; ++i) { const size_t row = (size_t)b * SEQ + qb * 256 + i * 64 + F.lane;
        const v4u* qp = (const v4u*)(QF + row * 512 + h * 64); const v4u* kp = (const v4u*)(KF + row * 512 + h * 64); float qs = 0.f, ks = 0.f;
#pragma unroll
        for (int c = 0; c < 8; ++c) { const v4u q = qp[c], k = kp[c];
#pragma unroll
            for (int j = 0; j < 4; ++j) { qs += bflo(q[j]) * bflo(q[j]) + bfhi(q[j]) * bfhi(q[j]); ks += bflo(k[j]) * bflo(k[j]) + bfhi(k[j]) * bfhi(k[j]); } }
        qm = fmaxf(qm, qs); km = fmaxf(km, ks); }
#pragma unroll
    for (int o = 1; o < 64; o <<= 1) { qm = fmaxf(qm, __shfl_xor(qm, o)); km = fmaxf(km, __shfl_xor(km, o)); }
    const float c0 = l0, c1 = c0 + l1, c2 = c1 + l2, c3 = c2 + l3; float v = c3;
#pragma unroll
    for (int o = 1; o < 64; o <<= 1) { const float t = __shfl_up(v, o); if (F.lane >= o) v += t; }
    const float ex = v - c3;
    *(f32x4*)(LC + (size_t)bh * SEQ + qb * 256 + 4 * F.lane) = (f32x4){ex + c0, ex + c1, ex + c2, ex + c3};
    if (F.lane == 63) BT[item] = v;
    if (F.lane == 0) { FN[item * 2] = qm; FN[item * 2 + 1] = km; }
}
__device__ __forceinline__ void fox_suffix_item(const Frame& F, const float* cfl, const int* pt, float* SW, float* PTOT, int item) {
    const int bs = item >> 4, p = item & 15; const int pg = __builtin_amdgcn_readfirstlane(pt[item]);
    const f32x4* src = (const f32x4*)(cfl + ((size_t)pg * PAGE + 2 * F.lane) * 8);
    const f32x4 a0 = src[0], a1 = src[1], b0 = src[2], b1 = src[3];
    const float ra[8] = {a0.x, a0.y, a0.z, a0.w, a1.x, a1.y, a1.z, a1.w}, rb[8] = {b0.x, b0.y, b0.z, b0.w, b1.x, b1.y, b1.z, b1.w};
#pragma unroll
    for (int h = 0; h < 8; ++h) {
        const float ps = ra[h] + rb[h]; float v = ps;
#pragma unroll
        for (int o = 1; o < 64; o <<= 1) { const float t = __shfl_down(v, o); if (F.lane + o < 64) v += t; }
        const float exs = v - ps;
        *(f32x2*)(SW + (size_t)(bs * 8 + h) * PASTL + p * PAGE + 2 * F.lane) = (f32x2){exs + rb[h], exs};
        if (F.lane == 0) PTOT[(bs * 8 + h) * NPAGES + p] = v;
    }
}
__device__ __forceinline__ void fox_attn_unit(const Frame& F, const bf16* QF, const bf16* KF, const bf16* VF, const float* LC, const float* BT, const float* FN, bf16* merged, int b, int h, int qb) {
    int tid = F.wave * 64 + lane_id(); asm volatile("" : "+v"(tid));
    const int lane = tid & 63, r32 = lane & 31, hi = lane >> 5, wid = F.wave;
    const size_t rowbase = (size_t)b * SEQ; const int q0 = qb * 256;
    LAS unsigned char* Ks = F.lds; LAS unsigned char* Vs = F.lds + 8192; LAS float* KBs = (LAS float*)(F.lds + 20480); LAS float* WSF = (LAS float*)(F.lds + 20736) + wid * 32;
    const bf16* Qw = QF + (rowbase + q0 + wid * 32 + r32) * 512 + h * 64;
    bf16x8 qr[4];
#pragma unroll
    for (int d0 = 0; d0 < 4; ++d0) qr[d0] = *(const bf16x8*)(Qw + d0 * 16 + hi * 8);
    const float* lcp = LC + (size_t)(b * 8 + h) * SEQ;
    float pbx; { const float btv = (lane < 32) ? BT[(b * 8 + h) * 32 + lane] : 0.f; float v = btv;
#pragma unroll
        for (int o = 1; o < 64; o <<= 1) { const float t = __shfl_up(v, o); if (lane >= o) v += t; }
        pbx = v - btv; }
    const float cref = lcp[q0] + __shfl(pbx, qb);
#define FOX_KB(t_, pos_) (-LOG2E * ((lcp[pos_] + __shfl(pbx, (t_) >> 2)) - cref))
    const int NT = (q0 + 256) / 64;
    int t0 = 0;
    {
        float kn = (lane < 32) ? FN[((b * 8 + h) * 32 + lane) * 2 + 1] : 0.f;
#pragma unroll
        for (int o = 1; o < 64; o <<= 1) kn = fmaxf(kn, __shfl_xor(kn, o));
        const float qk2 = 2.f * sqrtf(FN[((b * 8 + h) * 32 + qb) * 2]) * sqrtf(kn) * 1.01f;
        const int nbefore = q0 / 64;
        int found = -1;
        for (int base = 0; base < nbefore && found < 0; base += 64) {
            const int tl = nbefore - 1 - base - lane;
            const int tlc = tl < 0 ? 0 : tl; const float kbl = -LOG2E * ((lcp[tlc * 64 + 63] + __shfl(pbx, tlc >> 2)) - cref);
            const bool dead = (tl >= 0) && (qk2 + kbl < -FOX_SKIP);
            const unsigned long long bm = __ballot(dead);
            if (bm) found = nbefore - 1 - base - (int)__builtin_ctzll(bm);
        }
        t0 = found + 1;
        t0 = __builtin_amdgcn_readfirstlane(t0);
    }
    const int kkey = tid & 63, kch = tid >> 6, vkey = tid >> 3, vch = tid & 7;
    const bf16* ksrc = KF + (rowbase + kkey) * 512 + h * 64 + kch * 8;
    const bf16* vsrc = VF + (rowbase + vkey) * 512 + h * 64 + vch * 8;
    v4u kreg[2], vreg[2]; float kbreg[2];
#pragma unroll
    for (int hb = 0; hb < 2; ++hb) { const int tt = (t0 + hb < NT) ? t0 + hb : t0;
        kreg[hb] = *(const v4u*)(ksrc + (size_t)tt * 64 * 512); vreg[hb] = *(const v4u*)(vsrc + (size_t)tt * 64 * 512); kbreg[hb] = FOX_KB(tt, tt * 64 + (tid & 63)); }
    float m_run = -INFINITY, l_run = 0.f; f32x16 o0 = {}, o1 = {};
    const int qpos = q0 + wid * 32 + r32;
    const int vbase = (4 * hi + ((lane & 15) >> 2)) * 192 + (16 * ((lane >> 4) & 1) + 4 * (lane & 3)) * 2;
    LAS unsigned char* const Ks0 = Ks; LAS unsigned char* const Vs0 = Vs; LAS float* const KBs0 = KBs;
    __syncthreads();
    for (int t2 = t0; t2 < NT; t2 += 2) {
#pragma unroll
      for (int hb = 0; hb < 2; ++hb) {
        const int t = t2 + hb;
        if (t < NT) {
        LAS unsigned char* const Ks = Ks0 + hb * 28672; LAS unsigned char* const Vs = Vs0 + hb * 28672; LAS float* const KBs = (LAS float*)((LAS unsigned char*)KBs0 + hb * 28672);
        *(LAS v4u*)(Ks + kch * 1024 + kkey * 16) = kreg[hb]; *(LAS v4u*)(Vs + vkey * 192 + vch * 16) = vreg[hb]; if (tid < 64) KBs[tid] = kbreg[hb];
        __syncthreads();
        if (t + 2 < NT) { kreg[hb] = *(const v4u*)(ksrc + (size_t)(t + 2) * 64 * 512); vreg[hb] = *(const v4u*)(vsrc + (size_t)(t + 2) * 64 * 512); kbreg[hb] = FOX_KB(t + 2, (t + 2) * 64 + (tid & 63)); }
        const int k0 = t * 64;
        if (k0 <= q0 + wid * 32 + 31) {
        f32x16 p0, p1;
#pragma unroll
        for (int g = 0; g < 4; ++g) { const f32x4 ba = *(const LAS f32x4*)(KBs + 8 * g + 4 * hi), bb = *(const LAS f32x4*)(KBs + 32 + 8 * g + 4 * hi);
#pragma unroll
            for (int i = 0; i < 4; ++i) { p0[4 * g + i] = ba[i]; p1[4 * g + i] = bb[i]; } }
#pragma unroll
        for (int d0 = 0; d0 < 4; ++d0) {
            const bf16x8 a0 = *(const LAS bf16x8*)(Ks + (2 * d0 + hi) * 1024 + r32 * 16), a1 = *(const LAS bf16x8*)(Ks + (2 * d0 + hi) * 1024 + r32 * 16 + 512);
            p0 = __builtin_amdgcn_mfma_f32_32x32x16_bf16(a0, qr[d0], p0, 0, 0, 0); p1 = __builtin_amdgcn_mfma_f32_32x32x16_bf16(a1, qr[d0], p1, 0, 0, 0);
        }
        if (k0 + 63 > q0 + wid * 32) {
#pragma unroll
            for (int r = 0; r < 16; ++r) { const int key = k0 + crow(r, hi); if (key > qpos) p0[r] = -INFINITY; if (key + 32 > qpos) p1[r] = -INFINITY; }
        }
        float mx = fmaxf(p0[0], p1[0]);
#pragma unroll
        for (int r = 1; r < 16; ++r) mx = fmaxf(mx, fmaxf(p0[r], p1[r]));
        mx = fmaxf(mx, __shfl_xor(mx, 32));
        const float m_new = fmaxf(m_run, mx), alpha = fexp2(m_run - m_new); m_run = m_new;
        float ls = 0.f;
#pragma unroll
        for (int r = 0; r < 16; ++r) { p0[r] = fexp2(p0[r] - m_new); p1[r] = fexp2(p1[r] - m_new); ls += p0[r] + p1[r]; }
        l_run = l_run * alpha + ls;
        if (__ballot(alpha != 1.f) != 0ull) {
            if (hi == 0) WSF[r32] = alpha;
#pragma unroll
            for (int g = 0; g < 4; ++g) { const f32x4 al = *(const LAS f32x4*)(WSF + 8 * g + 4 * hi);
#pragma unroll
                for (int i = 0; i < 4; ++i) { o0[4 * g + i] *= al[i]; o1[4 * g + i] *= al[i]; } }
        }
        v4u pw[4];
#pragma unroll
        for (int j = 0; j < 4; ++j) { pw[0][j] = pg8::cvt_pk_bf16(p0[2 * j], p0[2 * j + 1]); pw[1][j] = pg8::cvt_pk_bf16(p0[8 + 2 * j], p0[8 + 2 * j + 1]);
                                      pw[2][j] = pg8::cvt_pk_bf16(p1[2 * j], p1[2 * j + 1]); pw[3][j] = pg8::cvt_pk_bf16(p1[8 + 2 * j], p1[8 + 2 * j + 1]); }
#pragma unroll
        for (int ks = 0; ks < 4; ++ks) {
            const bf16x8 pa = __builtin_bit_cast(bf16x8, pw[ks]);
#pragma unroll
            for (int d0 = 0; d0 < 2; ++d0) {
                const s16x4 lo = lds_tr16(Vs + vbase + ks * 16 * 192 + d0 * 64), hi4 = lds_tr16(Vs + vbase + ks * 16 * 192 + 8 * 192 + d0 * 64);
                const bf16x8 vb = (bf16x8){lo[0], lo[1], lo[2], lo[3], hi4[0], hi4[1], hi4[2], hi4[3]};
                if (d0 == 0) o0 = __builtin_amdgcn_mfma_f32_32x32x16_bf16(pa, vb, o0, 0, 0, 0); else o1 = __builtin_amdgcn_mfma_f32_32x32x16_bf16(pa, vb, o1, 0, 0, 0);
            }
        }
        }
        }
      }
    }
    l_run += __shfl_xor(l_run, 32);
    if (hi == 0) WSF[r32] = 1.f / l_run;
    bf16* Ow = merged + (rowbase + q0 + wid * 32) * DM + h * 64 + r32;
#pragma unroll
    for (int g = 0; g < 4; ++g) { const f32x4 rl = *(const LAS f32x4*)(WSF + 8 * g + 4 * hi);
#pragma unroll
        for (int i = 0; i < 4; ++i) { const int r = 4 * g + i; const int row = crow(r, hi);
            Ow[(size_t)row * DM] = (bf16)f2bf(o0[r] * rl[i]); Ow[(size_t)row * DM + 32] = (bf16)f2bf(o1[r] * rl[i]); } }
    __syncthreads();
#undef FOX_KB
}

template <int D> struct DecW {
    static constexpr int KS = D / 32;
    static constexpr int LPK = D / 4;
    static constexpr int KPI = 64 / LPK;
    float m[4], l[4]; float o[8][4];
};
template <int D>
__device__ __forceinline__ void dec_init(DecW<D>& w) {
#pragma unroll
    for (int i = 0; i < 4; ++i) { w.m[i] = -INFINITY; w.l[i] = 0.f; }
#pragma unroll
    for (int q = 0; q < 8; ++q)
#pragma unroll
        for (int j = 0; j < 4; ++j) w.o[q][j] = 0.f;
}
template <int D, int NTILE, int MODE>
__device__ __forceinline__ void dec_chunk(DecW<D>& w, const bf16x8 (&qa)[D / 32], const float* Kb, const float* Vb, int stride, const float* bias, float nb, LAS float* PL, int lane) {
    constexpr int KS = D / 32, LPK = D / 4, KPI = 64 / LPK;
    constexpr int NK = (MODE == 1) ? 8 : NTILE * 16, NV = NK / KPI;
    const int key = lane & 15, kq = lane >> 4;
    const unsigned koff = (unsigned)(key * stride + 8 * kq) * 4u;
    const int d4 = lane % LPK, ksub = lane / LPK;
    const unsigned voff = (unsigned)(ksub * stride + 4 * d4) * 4u;
    f32x4 kx[NTILE][2 * KS], vx[NV];
#pragma unroll
    for (int t = 0; t < NTILE; ++t) { const char* kp = (const char*)(Kb + (size_t)t * 16 * stride) + koff;
#pragma unroll
        for (int ks = 0; ks < KS; ++ks) { kx[t][2 * ks] = *(const f32x4*)(kp + 128 * ks); kx[t][2 * ks + 1] = *(const f32x4*)(kp + 128 * ks + 16); } }
    constexpr int NVA = (NV >= 8) ? NV / 2 : NV;
#pragma unroll
    for (int kk = 0; kk < NVA; ++kk) vx[kk] = *(const f32x4*)((const char*)(Vb + (size_t)kk * KPI * stride) + voff);
    f32x4 s[NTILE];
#pragma unroll
    for (int t = 0; t < NTILE; ++t) {
        f32x4 acc = {0.f, 0.f, 0.f, 0.f};
#pragma unroll
        for (int ks = 0; ks < KS; ++ks) { const f32x4 x0 = kx[t][2 * ks], x1 = kx[t][2 * ks + 1];
            v4u kb; kb.x = pg8::cvt_pk_bf16(x0.x, x0.y); kb.y = pg8::cvt_pk_bf16(x0.z, x0.w); kb.z = pg8::cvt_pk_bf16(x1.x, x1.y); kb.w = pg8::cvt_pk_bf16(x1.z, x1.w);
            acc = __builtin_amdgcn_mfma_f32_16x16x32_bf16(qa[ks], __builtin_bit_cast(bf16x8, kb), acc, 0, 0, 0); }
        if (MODE == 0) { if (bias) { const float bv = (bias[t * 16 + key] + nb) * LOG2E; acc += bv; } }
        else { acc += nb;
#pragma unroll
            for (int i = 0; i < 4; ++i) if (key > 4 * kq + i || key >= 8) acc[i] = -INFINITY; }
        s[t] = acc;
    }
#pragma unroll
    for (int kk = NVA; kk < NV; ++kk) vx[kk] = *(const f32x4*)((const char*)(Vb + (size_t)kk * KPI * stride) + voff);
    f32x4 mc = s[0];
#pragma unroll
    for (int t = 1; t < NTILE; ++t) { mc.x = fmaxf(mc.x, s[t].x); mc.y = fmaxf(mc.y, s[t].y); mc.z = fmaxf(mc.z, s[t].z); mc.w = fmaxf(mc.w, s[t].w); }
#pragma unroll
    for (int o = 1; o < 16; o <<= 1) { mc.x = fmaxf(mc.x, __shfl_xor(mc.x, o)); mc.y = fmaxf(mc.y, __shfl_xor(mc.y, o)); mc.z = fmaxf(mc.z, __shfl_xor(mc.z, o)); mc.w = fmaxf(mc.w, __shfl_xor(mc.w, o)); }
    float al[4];
#pragma unroll
    for (int i = 0; i < 4; ++i) { const float mn = fmaxf(w.m[i], mc[i]); al[i] = (mn == -INFINITY) ? 1.f : fexp2(w.m[i] - mn); w.m[i] = mn; w.l[i] *= al[i]; }
#pragma unroll
    for (int t = 0; t < NTILE; ++t) { f32x4 p;
#pragma unroll
        for (int i = 0; i < 4; ++i) { p[i] = (w.m[i] == -INFINITY) ? 0.f : fexp2(s[t][i] - w.m[i]); w.l[i] += p[i]; }
        if (kq < 2) *(LAS f32x4*)(PL + (t * 16 + key) * 8 + 4 * kq) = p; }
    if (key == 0 && kq < 2) *(LAS f32x4*)(PL + 1024 + 4 * kq) = (f32x4){al[0], al[1], al[2], al[3]};
    { const f32x4 a0 = *(const LAS f32x4*)(PL + 1024), a1 = *(const LAS f32x4*)(PL + 1028);
#pragma unroll
      for (int j = 0; j < 4; ++j) { w.o[0][j] *= a0.x; w.o[1][j] *= a0.y; w.o[2][j] *= a0.z; w.o[3][j] *= a0.w; w.o[4][j] *= a1.x; w.o[5][j] *= a1.y; w.o[6][j] *= a1.z; w.o[7][j] *= a1.w; } }
#pragma unroll
    for (int kk = 0; kk < NV; ++kk) { const int k = kk * KPI + ksub;
        const f32x4 v = vx[kk];
        const f32x4 pa = *(const LAS f32x4*)(PL + k * 8), pb = *(const LAS f32x4*)(PL + k * 8 + 4);
#pragma unroll
        for (int j = 0; j < 4; ++j) { w.o[0][j] += pa.x * v[j]; w.o[1][j] += pa.y * v[j]; w.o[2][j] += pa.z * v[j]; w.o[3][j] += pa.w * v[j];
                                      w.o[4][j] += pb.x * v[j]; w.o[5][j] += pb.y * v[j]; w.o[6][j] += pb.z * v[j]; w.o[7][j] += pb.w * v[j]; } }
}
__device__ __forceinline__ void dec_page_fox(DecW<64>& w, const bf16x8 (&qa)[2], const float* Kb, const float* Vb, const float* bias, float boff, LAS float* PL, int lane) {
    constexpr int stride = 512;
    const int key = lane & 15, kq = lane >> 4;
    const unsigned koff = (unsigned)(key * stride + 8 * kq) * 4u;
    const int d4 = lane & 15, ksub = lane >> 4;
    const unsigned voff = (unsigned)(ksub * stride + 4 * d4) * 4u;
    const __amdgpu_buffer_rsrc_t krs = __builtin_amdgcn_make_buffer_rsrc((void*)Kb, 0, 0x7fffffff, 0x00020000);
    const __amdgpu_buffer_rsrc_t vrs = __builtin_amdgcn_make_buffer_rsrc((void*)Vb, 0, 0x7fffffff, 0x00020000);
    const __amdgpu_buffer_rsrc_t brs = __builtin_amdgcn_make_buffer_rsrc((void*)bias, 0, 0x7fffffff, 0x00020000);
    f32x4 s[8];
#pragma unroll
    for (int hb = 0; hb < 2; ++hb) {
        f32x4 kx[4][4];
#pragma unroll
        for (int t = 0; t < 4; ++t) { const int so = (hb * 4 + t) * 16 * stride * 4;
            kx[t][0] = __builtin_bit_cast(f32x4, __builtin_amdgcn_raw_buffer_load_b128(krs, (int)koff, so, 0)); kx[t][1] = __builtin_bit_cast(f32x4, __builtin_amdgcn_raw_buffer_load_b128(krs, (int)koff + 16, so, 0));
            kx[t][2] = __builtin_bit_cast(f32x4, __builtin_amdgcn_raw_buffer_load_b128(krs, (int)koff + 128, so, 0)); kx[t][3] = __builtin_bit_cast(f32x4, __builtin_amdgcn_raw_buffer_load_b128(krs, (int)koff + 144, so, 0)); }
#pragma unroll
        for (int t = 0; t < 4; ++t) {
            f32x4 acc = {0.f, 0.f, 0.f, 0.f};
#pragma unroll
            for (int ks = 0; ks < 2; ++ks) { const f32x4 x0 = kx[t][2 * ks], x1 = kx[t][2 * ks + 1];
                v4u kb; kb.x = pg8::cvt_pk_bf16(x0.x, x0.y); kb.y = pg8::cvt_pk_bf16(x0.z, x0.w); kb.z = pg8::cvt_pk_bf16(x1.x, x1.y); kb.w = pg8::cvt_pk_bf16(x1.z, x1.w);
                acc = __builtin_amdgcn_mfma_f32_16x16x32_bf16(qa[ks], __builtin_bit_cast(bf16x8, kb), acc, 0, 0, 0); }
            acc += (__builtin_bit_cast(float, __builtin_amdgcn_raw_buffer_load_b32(brs, key * 4, (hb * 4 + t) * 64, 0)) + boff) * LOG2E;
            s[hb * 4 + t] = acc;
        }
        asm volatile("" ::: "memory");
    }
    f32x4 mc = s[0];
#pragma unroll
    for (int t = 1; t < 8; ++t) { mc.x = fmaxf(mc.x, s[t].x); mc.y = fmaxf(mc.y, s[t].y); mc.z = fmaxf(mc.z, s[t].z); mc.w = fmaxf(mc.w, s[t].w); }
#pragma unroll
    for (int o = 1; o < 16; o <<= 1) { mc.x = fmaxf(mc.x, __shfl_xor(mc.x, o)); mc.y = fmaxf(mc.y, __shfl_xor(mc.y, o)); mc.z = fmaxf(mc.z, __shfl_xor(mc.z, o)); mc.w = fmaxf(mc.w, __shfl_xor(mc.w, o)); }
    float al[4];
#pragma unroll
    for (int i = 0; i < 4; ++i) { const float mn = fmaxf(w.m[i], mc[i]); al[i] = fexp2(w.m[i] - mn); w.m[i] = mn; w.l[i] *= al[i]; }
    bool nz = false;
#pragma unroll
    for (int t = 0; t < 8; ++t) { f32x4 p;
#pragma unroll
        for (int i = 0; i < 4; ++i) { p[i] = fexp2(s[t][i] - w.m[i]); w.l[i] += p[i]; nz = nz || (p[i] != 0.f); }
        if (kq < 2) *(LAS f32x4*)(PL + (t * 16 + key) * 8 + 4 * kq) = p; }
    if (__ballot(nz && kq < 2) == 0ull) return;
    if (key == 0 && kq < 2) *(LAS f32x4*)(PL + 1024 + 4 * kq) = (f32x4){al[0], al[1], al[2], al[3]};
    { const f32x4 a0 = *(const LAS f32x4*)(PL + 1024), a1 = *(const LAS f32x4*)(PL + 1028);
#pragma unroll
      for (int j = 0; j < 4; ++j) { w.o[0][j] *= a0.x; w.o[1][j] *= a0.y; w.o[2][j] *= a0.z; w.o[3][j] *= a0.w; w.o[4][j] *= a1.x; w.o[5][j] *= a1.y; w.o[6][j] *= a1.z; w.o[7][j] *= a1.w; } }
#pragma unroll 1
    for (int vh = 0; vh < 2; ++vh) {
    f32x4 vx[16];
#pragma unroll
    for (int kk = 0; kk < 16; ++kk) vx[kk] = __builtin_bit_cast(f32x4, __builtin_amdgcn_raw_buffer_load_b128(vrs, (int)voff, (vh * 16 + kk) * 4 * stride * 4, 0));
#pragma unroll
    for (int kk = 0; kk < 16; ++kk) { const int k = (vh * 16 + kk) * 4 + ksub;
        const f32x4 v = vx[kk];
        const f32x4 pa = *(const LAS f32x4*)(PL + k * 8), pb = *(const LAS f32x4*)(PL + k * 8 + 4);
#pragma unroll
        for (int j = 0; j < 4; ++j) { w.o[0][j] += pa.x * v[j]; w.o[1][j] += pa.y * v[j]; w.o[2][j] += pa.z * v[j]; w.o[3][j] += pa.w * v[j];
                                      w.o[4][j] += pb.x * v[j]; w.o[5][j] += pb.y * v[j]; w.o[6][j] += pb.z * v[j]; w.o[7][j] += pb.w * v[j]; } }
    }
}
template <int D>
__device__ __forceinline__ void dec_park(DecW<D>& w, LAS float* CBw, int lane) {
    constexpr int LPK = D / 4;
    const int key = lane & 15, kq = lane >> 4, d4 = lane % LPK, ksub = lane / LPK;
#pragma unroll
    for (int i = 0; i < 4; ++i) { float l = w.l[i];
#pragma unroll
        for (int o = 1; o < 16; o <<= 1) l += __shfl_xor(l, o);
        w.l[i] = l; }
    if (key == 0 && kq < 2) { *(LAS f32x4*)(CBw + 4 * kq) = (f32x4){w.m[0], w.m[1], w.m[2], w.m[3]}; *(LAS f32x4*)(CBw + 8 + 4 * kq) = (f32x4){w.l[0], w.l[1], w.l[2], w.l[3]}; }
#pragma unroll
    for (int q = 0; q < 8; ++q) { f32x4 v = (f32x4){w.o[q][0], w.o[q][1], w.o[q][2], w.o[q][3]};
        if (LPK < 64) {
#pragma unroll
            for (int o = LPK; o < 64; o <<= 1) { v.x += __shfl_xor(v.x, o); v.y += __shfl_xor(v.y, o); v.z += __shfl_xor(v.z, o); v.w += __shfl_xor(v.w, o); } }
        if (ksub == 0) *(LAS f32x4*)(CBw + 16 + q * D + 4 * d4) = v; }
}
template <int D>
__device__ __forceinline__ void dec_combine(int tid, LAS float* CB, bf16* dst, int ldd) {
    constexpr int WSTR = 16 + 8 * D;
    for (int e = tid; e < 8 * D; e += NTHR) { const int q = e / D, d = e % D;
        float mt = -INFINITY;
#pragma unroll
        for (int w = 0; w < 8; ++w) mt = fmaxf(mt, CB[w * WSTR + q]);
        float num = 0.f, den = 0.f;
#pragma unroll
        for (int w = 0; w < 8; ++w) { const float mw = CB[w * WSTR + q]; const float f = (mw == -INFINITY) ? 0.f : fexp2(mw - mt); num += f * CB[w * WSTR + 16 + q * D + d]; den += f * CB[w * WSTR + 8 + q]; }
        dst[(size_t)q * ldd + d] = (bf16)f2bf(num / den); }
}
template <int D>
__device__ __forceinline__ void dec_load_q(bf16x8 (&qa)[D / 32], const bf16* Q, int ldq, int lane) {
    const int row = lane & 15, kq = lane >> 4;
#pragma unroll
    for (int ks = 0; ks < D / 32; ++ks) { v4u z = {0u, 0u, 0u, 0u}; if (row < 8) z = *(const v4u*)(Q + (size_t)row * ldq + 32 * ks + 8 * kq); qa[ks] = __builtin_bit_cast(bf16x8, z); }
}
constexpr int DEC_PL = 1040;
__device__ __forceinline__ void fox_sample_unit(const Frame& F, const Args& a, int u) {
    unsigned char* ws = a.ws; const int bs = u >> 3, h = u & 7;
    int ln = lane_id(); asm volatile("" : "+v"(ln));
    LAS float* PL = (LAS float*)F.lds + F.wave * DEC_PL; LAS float* CB = (LAS float*)F.lds + 8 * DEC_PL; constexpr int WSTR = 16 + 8 * 64;
    bf16x8 qa[2]; dec_load_q<64>(qa, (const bf16*)(ws + WS_QF) + (size_t)(TP + bs * LS) * 512 + h * 64, 512, ln);
    DecW<64> w; dec_init(w);
    {
        const int key = ln & 15; const float* lf = a.out + O_LFS + (size_t)(bs * LS) * 8 + h; float cn = 0.f;
#pragma unroll
        for (int j = 0; j < 8; ++j) { const float x = lf[j * 8]; cn += (j <= key) ? x : 0.f; }
        const float* Kb = a.out + O_FKS + (size_t)(bs * LS) * 512 + h * 64; const float* Vb = a.out + O_FVS + (size_t)(bs * LS) * 512 + h * 64;
        dec_chunk<64, 1, 1>(w, qa, Kb, Vb, 512, nullptr, -cn * LOG2E, PL, ln);
        if (F.wave != 0) {
#pragma unroll
            for (int i = 0; i < 4; ++i) w.l[i] = 0.f;
#pragma unroll
            for (int q = 0; q < 8; ++q)
#pragma unroll
                for (int j = 0; j < 4; ++j) w.o[q][j] = 0.f; }
    }
    const int* pt = (const int*)a.in[I_PT];
    float spx; { const float ptv = (ln < 16) ? ((const float*)(ws + WS_MISC + 2 * MiB))[(bs * 8 + h) * NPAGES + ln] : 0.f; float v = ptv;
#pragma unroll
        for (int o = 1; o < 16; o <<= 1) { const float t = __builtin_bit_cast(float, __builtin_amdgcn_ds_bpermute((ln + o) << 2, __builtin_bit_cast(int, v))); if (ln + o < 16) v += t; }
        spx = v - ptv; }
#if defined(OLD_FOXS)
#pragma unroll 1
    for (int pp = 0; pp < 4; ++pp) { const int p = F.wave * 2 + (pp >> 1), hf = pp & 1; const int pg = __builtin_amdgcn_readfirstlane(pt[bs * NPAGES + p]);
        const float* Kb = (const float*)a.in[I_CFK] + (((size_t)pg * PAGE + hf * 64) * 8 + h) * 64; const float* Vb = (const float*)a.in[I_CFV] + (((size_t)pg * PAGE + hf * 64) * 8 + h) * 64;
        dec_chunk<64, 4, 0>(w, qa, Kb, Vb, 512, (const float*)(ws + WS_SUF) + (size_t)(bs * 8 + h) * PASTL + p * PAGE + hf * 64, __builtin_bit_cast(float, __builtin_amdgcn_ds_bpermute(p << 2, __builtin_bit_cast(int, spx))), PL, ln); }
#else
#pragma unroll 1
    for (int pp = 1; pp >= 0; --pp) { const int p = pp ? (NPAGES - 1 - F.wave) : F.wave;
        const int pg = __builtin_amdgcn_readfirstlane(pt[bs * NPAGES + p]);
        const float* Kb = (const float*)a.in[I_CFK] + ((size_t)pg * PAGE * 8 + h) * 64; const float* Vb = (const float*)a.in[I_CFV] + ((size_t)pg * PAGE * 8 + h) * 64;
        dec_page_fox(w, qa, Kb, Vb, (const float*)(ws + WS_SUF) + (size_t)(bs * 8 + h) * PASTL + p * PAGE, __builtin_bit_cast(float, __builtin_amdgcn_ds_bpermute(p << 2, __builtin_bit_cast(int, spx))), PL, ln); }
#endif
    dec_park<64>(w, CB + F.wave * WSTR, ln);
    __syncthreads();
    dec_combine<64>(F.wave * 64 + ln, CB, (bf16*)(ws + WS_MERGED) + (size_t)(TP + bs * LS) * DM + h * 64, DM);
    __syncthreads();
}
__device__ __forceinline__ void cross_sample_unit(const Frame& F, const Args& a, int u) {
    unsigned char* ws = a.ws; const int bs = u >> 2, h = u & 3;
    LAS float* PL = (LAS float*)F.lds + F.wave * DEC_PL; LAS float* CB = (LAS float*)F.lds + 8 * DEC_PL; constexpr int WSTR = 16 + 8 * 256;
    bf16x8 qa[8]; dec_load_q<256>(qa, (const bf16*)(ws + WS_QC) + (size_t)(TP + bs * LS) * DM + h * 256, DM, F.lane);
    DecW<256> w; dec_init(w);
    const float* Kb = (const float*)a.in[I_CMK] + ((size_t)(bs * 256 + F.wave * 32) * 4 + h) * 256; const float* Vb = (const float*)a.in[I_CMV] + ((size_t)(bs * 256 + F.wave * 32) * 4 + h) * 256;
#pragma unroll 1
    for (int c = 0; c < 2; ++c) dec_chunk<256, 1, 0>(w, qa, Kb + (size_t)c * 16 * 1024, Vb + (size_t)c * 16 * 1024, 1024, nullptr, 0.f, PL, F.lane);
    dec_park<256>(w, CB + F.wave * WSTR, F.lane);
    __syncthreads();
    dec_combine<256>(F.tid, CB, (bf16*)(ws + WS_OC) + (size_t)(TP + bs * LS) * DM + h * 256, DM);
    __syncthreads();
}


__device__ __forceinline__ void gla_g3_unit(const Frame& F, const Args& a, int u) {
    unsigned char* ws = a.ws;
    const int b = u >> 9, h = (u >> 7) & 3, n = u & 127; const int row0 = b * SEQ + n * 64;
    LAS float* QDT = (LAS float*)F.lds; LAS float* KIT = QDT + 4352; LAS float* LA = KIT + 4352; LAS float* ATT = LA; LAS float* VS = LA + 4352; LAS float* SP = VS + 8192;
#pragma unroll
    for (int i = 0; i < 16; ++i) { const int e = F.tid + NTHR * i; VS[e] = ((const float*)(ws + WS_GV))[(size_t)(row0 + (e >> 7)) * 512 + h * 128 + (e & 127)];
        SP[e] = ((const float*)(ws + WS_GKV))[((size_t)((b * 4 + h) * 128 + n) * 64) * 128 + e]; }
#pragma unroll
    for (int i = 0; i < 8; ++i) { const int e = F.tid + NTHR * i, t = e >> 6, dk = e & 63; const size_t gi = (size_t)(row0 + t) * 256 + h * 64 + dk;
        const float bb = ((const float*)(ws + WS_BB))[gi];
        QDT[dk * 68 + t] = ((const float*)(ws + WS_GQ))[gi] * __expf(bb); KIT[dk * 68 + t] = ((const float*)(ws + WS_GK))[gi] * __expf(-bb); }
    __syncthreads();
    {
        const int tp = F.tid & 31, sq = F.tid >> 5; float acc[2][4];
#pragma unroll
        for (int i = 0; i < 2; ++i)
#pragma unroll
            for (int j = 0; j < 4; ++j) acc[i][j] = 0.f;
        if (4 * sq <= 2 * tp + 1) {
#pragma unroll 8
            for (int dk = 0; dk < 64; ++dk) { const f32x2 q2 = *(const LAS f32x2*)(QDT + dk * 68 + 2 * tp); const f32x4 k4 = *(const LAS f32x4*)(KIT + dk * 68 + 4 * sq);
#pragma unroll
                for (int j = 0; j < 4; ++j) { acc[0][j] += q2.x * k4[j]; acc[1][j] += q2.y * k4[j]; } }
        }
#pragma unroll
        for (int j = 0; j < 4; ++j) { const int s = 4 * sq + j; f32x2 o; o.x = (s <= 2 * tp) ? acc[0][j] : 0.f; o.y = (s <= 2 * tp + 1) ? acc[1][j] : 0.f; *(LAS f32x2*)(ATT + s * 68 + 2 * tp) = o; }
    }
    __syncthreads();
    {
        const int dvq = F.tid & 31, tq = F.tid >> 5; float acc[4][4];
#pragma unroll
        for (int i = 0; i < 4; ++i)
#pragma unroll
            for (int j = 0; j < 4; ++j) acc[i][j] = 0.f;
#pragma unroll 8
        for (int s = 0; s < 64; ++s) { const f32x4 v4 = *(const LAS f32x4*)(VS + s * 128 + 4 * dvq), a4 = *(const LAS f32x4*)(ATT + s * 68 + 4 * tq);
#pragma unroll
            for (int i = 0; i < 4; ++i)
#pragma unroll
                for (int j = 0; j < 4; ++j) acc[i][j] += a4[i] * v4[j]; }
#pragma unroll 8
        for (int dk = 0; dk < 64; ++dk) { const f32x4 v4 = *(const LAS f32x4*)(SP + dk * 128 + 4 * dvq), a4 = *(const LAS f32x4*)(QDT + dk * 68 + 4 * tq);
#pragma unroll
            for (int i = 0; i < 4; ++i)
#pragma unroll
                for (int j = 0; j < 4; ++j) acc[i][j] += a4[i] * v4[j]; }
        __syncthreads();
#pragma unroll
        for (int i = 0; i < 4; ++i) *(LAS f32x4*)(VS + (4 * tq + i) * 128 + 4 * dvq) = (f32x4){acc[i][0], acc[i][1], acc[i][2], acc[i][3]};
    }
    __syncthreads();
#pragma unroll
    for (int rr = 0; rr < 8; ++rr) { const int t = F.wave * 8 + rr; const float v0 = VS[t * 128 + F.lane], v1 = VS[t * 128 + 64 + F.lane];
        const float r = rsqrtf(wave_sum(v0 * v0 + v1 * v1) * (1.f / 128.f) + EPS);
        const float* ggo = (const float*)a.in[I_GGO] + h * 128; const float* gr = (const float*)(ws + WS_GR) + (size_t)(row0 + t) * 512 + h * 128;
        bf16* mo = (bf16*)(ws + WS_MERGED) + (size_t)(row0 + t) * DM + 512 + h * 128;
        mo[F.lane] = (bf16)f2bf(v0 * r * ggo[F.lane] * silu(gr[F.lane])); mo[64 + F.lane] = (bf16)f2bf(v1 * r * ggo[64 + F.lane] * silu(gr[64 + F.lane])); }
    __syncthreads();
}

struct EpiSoftmaxP {
    static constexpr bool PERM = false, AFTER_DRAIN = true;
    const LAS unsigned long long* argp;
    __device__ __forceinline__ void fused(f32x4 (&acc)[2][2][4][2], const Unit&, int wr, int wc, int fr, int fq, PG8_LAS unsigned char* lds, int wid, int lane) const {
        LAS float* PM = (LAS float*)lds; LAS float* PS = PM + 1024;
        const int ub = (int)blockIdx.x; const int ldp = DM;
        bf16* P = (bf16*)((unsigned char*)ld_ptr(argp + N_INPUTS + 1) + WS_PC) + ((size_t)((ub >> 7) & 1) * SEQ + (ub & 31) * 256) * DM + ((ub >> 5) & 3) * 256;
        { int t2 = lane_id(); asm volatile("" : "+v"(t2)); fr = t2 & 15; fq = (t2 >> 4) & 3; }
#pragma unroll
        for (int ai = 0; ai < 2; ++ai)
#pragma unroll
            for (int m = 0; m < 4; ++m) { float mx = -INFINITY;
#pragma unroll
                for (int bj = 0; bj < 2; ++bj)
#pragma unroll
                    for (int n = 0; n < 2; ++n) { const f32x4 x = acc[ai][bj][m][n]; mx = fmaxf(mx, fmaxf(fmaxf(x[0], x[1]), fmaxf(x[2], x[3]))); }
                mx = fmaxf(mx, __shfl_xor(mx, 16)); mx = fmaxf(mx, __shfl_xor(mx, 32));
                if (fq == 0) PM[(ai * 128 + wr * 64 + m * 16 + fr) * 4 + wc] = mx; }
        asm volatile("s_waitcnt lgkmcnt(0)" ::: "memory"); __builtin_amdgcn_s_barrier(); asm volatile("" ::: "memory");
#pragma unroll
        for (int ai = 0; ai < 2; ++ai)
#pragma unroll
            for (int m = 0; m < 4; ++m) { const int r = ai * 128 + wr * 64 + m * 16 + fr; const f32x4 pm = *(const LAS f32x4*)(PM + r * 4);
                const float M = fmaxf(fmaxf(pm[0], pm[1]), fmaxf(pm[2], pm[3])); float s = 0.f;
#pragma unroll
                for (int bj = 0; bj < 2; ++bj)
#pragma unroll
                    for (int n = 0; n < 2; ++n) { f32x4 x = acc[ai][bj][m][n]; x[0] = fexp2(x[0] - M); x[1] = fexp2(x[1] - M); x[2] = fexp2(x[2] - M); x[3] = fexp2(x[3] - M); acc[ai][bj][m][n] = x; s += (x[0] + x[1]) + (x[2] + x[3]); }
                s += __shfl_xor(s, 16); s += __shfl_xor(s, 32);
                if (fq == 0) PS[r * 4 + wc] = s; }
        asm volatile("s_waitcnt lgkmcnt(0)" ::: "memory"); __builtin_amdgcn_s_barrier(); asm volatile("" ::: "memory");
#pragma unroll
        for (int ai = 0; ai < 2; ++ai)
#pragma unroll
            for (int m = 0; m < 4; ++m) { const int r = ai * 128 + wr * 64 + m * 16 + fr; const f32x4 ps = *(const LAS f32x4*)(PS + r * 4); const float inv = 1.f / ((ps[0] + ps[1]) + (ps[2] + ps[3]));
#pragma unroll
                for (int bj = 0; bj < 2; ++bj)
#pragma unroll
                    for (int n = 0; n < 2; ++n) { const f32x4 x = acc[ai][bj][m][n]; v2u o; o.x = pg8::cvt_pk_bf16(x[0] * inv, x[1] * inv); o.y = pg8::cvt_pk_bf16(x[2] * inv, x[3] * inv);
                        *(v2u*)(P + (size_t)r * ldp + bj * 128 + wc * 32 + n * 16 + fq * 4) = o; } }
        asm volatile("s_waitcnt lgkmcnt(0)" ::: "memory"); __builtin_amdgcn_s_barrier(); asm volatile("" ::: "memory");
    }
};

__device__ __forceinline__ void rms_rows_phase(const Frame& F, const float* X, const float* g, bf16* H) {
    const int gw = F.vcu * NWAVES + F.wave, NGW = F.G * NWAVES;
    for (int m = gw; m < TA; m += NGW) rms_row_bf16(X + (size_t)m * DM, g, H + (size_t)m * DM, F.lane);
}

__device__ __forceinline__ unsigned f2sort(float f) { const unsigned u = __builtin_bit_cast(unsigned, f); return u ^ ((u >> 31) ? 0xFFFFFFFFu : 0x80000000u); }
__device__ __forceinline__ float sort2f(unsigned s) { const unsigned u = s ^ ((s >> 31) ? 0x80000000u : 0xFFFFFFFFu); return __builtin_bit_cast(float, u); }
__device__ __forceinline__ float gelu_tanh(float x) { const float y = 0.7978845608028654f * (x + 0.044715f * x * x * x); const float e = __expf(2.f * y); return 0.5f * x * (1.f + (1.f - 2.f / (e + 1.f))); }
__device__ __forceinline__ unsigned gmax16(unsigned v) {
#pragma unroll
    for (int o = 1; o < 16; o <<= 1) { const unsigned t = (unsigned)__shfl_xor((int)v, o); v = v > t ? v : t; }
    return v;
}
typedef __bf16 bf16x2_t __attribute__((ext_vector_type(2)));
__device__ __forceinline__ float dot2bf(unsigned a, unsigned b, float c) {
#if __has_builtin(__builtin_amdgcn_fdot2_f32_bf16)
    return __builtin_amdgcn_fdot2_f32_bf16(__builtin_bit_cast(bf16x2_t, a), __builtin_bit_cast(bf16x2_t, b), c, false);
#else
    return c + bflo(a) * bflo(b) + bfhi(a) * bfhi(b);
#endif
}
template <bool SPLIT>
__device__ __forceinline__ void peer_token(const Frame& F, const Args& a, int row, LAS unsigned* TOPS, const LAS unsigned* CT, int half, LAS float* PART) {
    unsigned char* ws = a.ws; const int lane = lane_id(), grp = lane >> 4, j16 = lane & 15;
    const bf16* sc = (const bf16*)(ws + WS_SC) + (size_t)row * 2048;
#pragma unroll 1
    for (int bt = 0; bt < 4; ++bt) {
        const v4u xq = *(const v4u*)(sc + (bt * 4 + grp) * 128 + 8 * j16);
        unsigned k[8]; const float xs[8] = {bflo(xq.x), bfhi(xq.x), bflo(xq.y), bfhi(xq.y), bflo(xq.z), bfhi(xq.z), bflo(xq.w), bfhi(xq.w)};
#pragma unroll
        for (int e = 0; e < 8; ++e) k[e] = (f2sort(xs[e]) & ~127u) | (unsigned)(127 - (8 * j16 + e));
        unsigned mine = 0u;
#pragma unroll 1
        for (int r = 0; r < 16; ++r) {
            unsigned m = k[0];
#pragma unroll
            for (int e = 1; e < 8; ++e) m = m > k[e] ? m : k[e];
            m = gmax16(m);
            if (j16 == r) mine = m;
#pragma unroll
            for (int e = 0; e < 8; ++e) k[e] = (k[e] == m) ? 0u : k[e];
        }
        TOPS[(bt * 4 + grp) * 16 + j16] = mine;
    }
    int ex[2]; float gx[2], sux[2];
#pragma unroll
    for (int ps = 0; ps < 2; ++ps) {
        const int hd = ps * 4 + grp; const LAS unsigned* T1 = TOPS + (2 * hd) * 16; const LAS unsigned* T2 = T1 + 16;
        const unsigned c0_ = CT[j16], c1_ = CT[j16 + 16], c2_ = CT[j16 + 32], c3_ = CT[j16 + 48];
        const int ci0 = c0_ & 255, cj0 = c0_ >> 8, ci1 = c1_ & 255, cj1 = c1_ >> 8, ci2 = c2_ & 255, cj2 = c2_ >> 8, ci3 = c3_ & 255, cj3 = c3_ >> 8; const bool cv3 = (j16 + 48) < 50;
        unsigned k[4];
        { const float s0 = sort2f(T1[ci0] & ~127u) + sort2f(T2[cj0] & ~127u), s1 = sort2f(T1[ci1] & ~127u) + sort2f(T2[cj1] & ~127u),
                      s2 = sort2f(T1[ci2] & ~127u) + sort2f(T2[cj2] & ~127u), s3 = sort2f(T1[ci3] & ~127u) + sort2f(T2[cj3] & ~127u);
          k[0] = (f2sort(s0) & ~127u) | (unsigned)(127 - j16); k[1] = (f2sort(s1) & ~127u) | (unsigned)(127 - (j16 + 16)); k[2] = (f2sort(s2) & ~127u) | (unsigned)(127 - (j16 + 32));
          k[3] = cv3 ? ((f2sort(s3) & ~127u) | (unsigned)(127 - (j16 + 48))) : 0u; }
        unsigned mine = 0u;
#pragma unroll 1
        for (int r = 0; r < 16; ++r) {
            unsigned m = k[0] > k[1] ? k[0] : k[1]; const unsigned m2 = k[2] > k[3] ? k[2] : k[3]; m = m > m2 ? m : m2;
            m = gmax16(m);
            if (j16 == r) mine = m;
#pragma unroll
            for (int e = 0; e < 4; ++e) k[e] = (k[e] == m) ? 0u : k[e];
        }
        const int c = 127 - (int)(mine & 127u);
        int ci, cj;
        if (c < 16) { ci = 0; cj = c; } else if (c < 24) { ci = 1; cj = c - 16; } else if (c < 29) { ci = 2; cj = c - 24; } else if (c < 33) { ci = 3; cj = c - 29; }
        else if (c < 36) { ci = 4; cj = c - 33; } else if (c < 38) { ci = 5; cj = c - 36; } else if (c < 40) { ci = 6; cj = c - 38; } else if (c < 42) { ci = 7; cj = c - 40; } else { ci = c - 34; cj = 0; }
        const int i1 = 127 - (int)(T1[ci] & 127u), i2 = 127 - (int)(T2[cj] & 127u);
        ex[ps] = i1 * 128 + i2;
        const float sv = sort2f(mine & ~127u); const float s0 = __shfl(sv, lane & 48);
        float ee = __expf(sv - s0); float es = ee;
#pragma unroll
        for (int o = 1; o < 16; o <<= 1) es += __shfl_xor(es, o);
        const float* rsc = (const float*)(ws + WS_MISC);
        sux[ps] = rsc[ex[ps]]; gx[ps] = ee / es * rsc[16384 + ex[ps]];
    }
    {
        unsigned k0 = ((unsigned)ex[0] << 7) | (unsigned)lane, k1 = ((unsigned)ex[1] << 7) | (unsigned)(64 + lane);
#pragma unroll
        for (int k = 2; k <= 128; k <<= 1) {
#pragma unroll
            for (int j = k >> 1; j > 0; j >>= 1) {
                if (j == 64) { const unsigned lo = k0 < k1 ? k0 : k1, hi = k0 < k1 ? k1 : k0; k0 = lo; k1 = hi; }
                else {
                    const unsigned p0 = (unsigned)__shfl_xor((int)k0, j), p1 = (unsigned)__shfl_xor((int)k1, j);
                    const bool low = (lane & j) == 0; const bool asc0 = (lane & k) == 0, asc1 = ((64 + lane) & k) == 0;
                    const unsigned mn0 = k0 < p0 ? k0 : p0, mx0 = k0 < p0 ? p0 : k0, mn1 = k1 < p1 ? k1 : p1, mx1 = k1 < p1 ? p1 : k1;
                    k0 = (low == asc0) ? mn0 : mx0; k1 = (low == asc1) ? mn1 : mx1;
                }
            }
        }
        const int o0 = (int)(k0 & 127u), o1 = (int)(k1 & 127u);
        const float g0a = __shfl(gx[0], o0 & 63), g0b = __shfl(gx[1], o0 & 63), g1a = __shfl(gx[0], o1 & 63), g1b = __shfl(gx[1], o1 & 63);
        const float s0a = __shfl(sux[0], o0 & 63), s0b = __shfl(sux[1], o0 & 63), s1a = __shfl(sux[0], o1 & 63), s1b = __shfl(sux[1], o1 & 63);
        gx[0] = (o0 & 64) ? g0b : g0a; gx[1] = (o1 & 64) ? g1b : g1a; sux[0] = (o0 & 64) ? s0b : s0a; sux[1] = (o1 & 64) ? s1b : s1a;
        ex[0] = (int)(k0 >> 7); ex[1] = (int)(k1 >> 7);
    }
    const float rstd2 = rsqrtf(((const float*)(ws + WS_SS))[TA + row] * (1.f / 1024.f) + EPS);
    float hf[16];
    { const v4u* hp = (const v4u*)((const bf16*)(ws + WS_HB) + (size_t)row * DM + 16 * lane); const v4u h0 = hp[0], h1 = hp[1];
#pragma unroll
      for (int q = 0; q < 4; ++q) { hf[2 * q] = bflo(h0[q]); hf[2 * q + 1] = bfhi(h0[q]); hf[8 + 2 * q] = bflo(h1[q]); hf[8 + 2 * q + 1] = bfhi(h1[q]); } }
    float oacc[16];
#pragma unroll
    for (int i = 0; i < 16; ++i) oacc[i] = 0.f;
    const unsigned char* U = ws + WS_U16; const unsigned char* V = ws + WS_V16;
    v4u ub[8], vbA[8], vbB[8];
    const int gbeg = SPLIT ? 8 * half : 0, gend = SPLIT ? 8 * half + 8 : 16;
#define PEER_LOAD(buf, TAB, g) do { const int kk_ = (g) * 8; const int exs_ = (kk_ < 64) ? ex[0] : ex[1]; \
        _Pragma("unroll") for (int i = 0; i < 8; ++i) { const int e_ = __builtin_amdgcn_readlane(exs_, (kk_ & 63) + i); buf[i] = *(const v4u*)(TAB + (size_t)e_ * DM + 16 * lane); } } while (0)
#define PEER_DOTS(buf, g, wout) do { const int kk_ = (g) * 8; const float gxs_ = (kk_ < 64) ? gx[0] : gx[1]; const float sus_ = (kk_ < 64) ? sux[0] : sux[1]; float av[8]; \
        _Pragma("unroll") for (int i = 0; i < 8; ++i) { float s = 0.f; \
            _Pragma("unroll") for (int q = 0; q < 4; ++q) { const f32x2 lo = __builtin_amdgcn_cvt_pk_f32_fp8((int)buf[i][q], false), hi = __builtin_amdgcn_cvt_pk_f32_fp8((int)buf[i][q], true); \
                s += lo.x * hf[4 * q]; s += lo.y * hf[4 * q + 1]; s += hi.x * hf[4 * q + 2]; s += hi.y * hf[4 * q + 3]; } \
            av[i] = s; } \
        const bool b5 = lane & 32, b4 = lane & 16, b3_ = lane & 8; float bq[4], cq[2], dq; \
        _Pragma("unroll") for (int i = 0; i < 4; ++i) bq[i] = (b5 ? av[4 + i] : av[i]) + __shfl_xor(b5 ? av[i] : av[4 + i], 32); \
        _Pragma("unroll") for (int i = 0; i < 2; ++i) cq[i] = (b4 ? bq[2 + i] : bq[i]) + __shfl_xor(b4 ? bq[i] : bq[2 + i], 16); \
        dq = (b3_ ? cq[1] : cq[0]) + __shfl_xor(b3_ ? cq[0] : cq[1], 8); \
        dq += __shfl_xor(dq, 4); dq += __shfl_xor(dq, 2); dq += __shfl_xor(dq, 1); \
        const int src = (kk_ & 63) + (lane >> 3); \
        wout = __shfl(gxs_, src) * gelu_tanh(dq * __shfl(sus_, src) * rstd2); } while (0)
#define PEER_ACC(buf, wv) do { _Pragma("unroll") for (int i = 0; i < 8; ++i) { const float w = __builtin_bit_cast(float, __builtin_amdgcn_readlane(__builtin_bit_cast(int, wv), 8 * i)); \
        _Pragma("unroll") for (int q = 0; q < 4; ++q) { const f32x2 lo = __builtin_amdgcn_cvt_pk_f32_fp8((int)buf[i][q], false), hi = __builtin_amdgcn_cvt_pk_f32_fp8((int)buf[i][q], true); \
            oacc[4 * q] += w * lo.x; oacc[4 * q + 1] += w * lo.y; oacc[4 * q + 2] += w * hi.x; oacc[4 * q + 3] += w * hi.y; } } } while (0)
    PEER_LOAD(ub, U, gbeg); PEER_LOAD(vbA, V, gbeg);
#pragma unroll 1
    for (int g0 = gbeg; g0 < gend; g0 += 2) {
        float w0, w1;
        PEER_DOTS(ub, g0, w0);
        PEER_LOAD(ub, U, g0 + 1); PEER_LOAD(vbB, V, g0 + 1);
        PEER_ACC(vbA, w0);
        PEER_DOTS(ub, g0 + 1, w1);
        { const int gn = (g0 + 2 < gend) ? g0 + 2 : g0 + 1;
          PEER_LOAD(ub, U, gn); PEER_LOAD(vbA, V, gn); }
        PEER_ACC(vbB, w1);
    }
#undef PEER_LOAD
#undef PEER_DOTS
#undef PEER_ACC
    if (SPLIT) {
        if (half == 1) {
#pragma unroll
            for (int q = 0; q < 4; ++q) *(LAS f32x4*)(PART + 16 * lane + 4 * q) = (f32x4){oacc[4 * q], oacc[4 * q + 1], oacc[4 * q + 2], oacc[4 * q + 3]}; }
        __syncthreads();
        if (half == 1) return;
#pragma unroll
        for (int q = 0; q < 4; ++q) { const f32x4 p = *(const LAS f32x4*)(PART + 16 * lane + 4 * q); oacc[4 * q] += p.x; oacc[4 * q + 1] += p.y; oacc[4 * q + 2] += p.z; oacc[4 * q + 3] += p.w; }
    }
    asm volatile("" : "+s"(row)); const int lane2 = lane_id();
    const f32x4* x2 = (const f32x4*)((const float*)(ws + WS_X2) + (size_t)row * DM + 16 * lane2);
    f32x4 xv[4]; float ss = 0.f;
#pragma unroll
    for (int q = 0; q < 4; ++q) { xv[q] = x2[q]; xv[q].x += oacc[4 * q]; xv[q].y += oacc[4 * q + 1]; xv[q].z += oacc[4 * q + 2]; xv[q].w += oacc[4 * q + 3]; ss += (xv[q].x * xv[q].x + xv[q].y * xv[q].y) + (xv[q].z * xv[q].z + xv[q].w * xv[q].w); }
    const float r = rsqrtf(wave_sum(ss) * (1.f / DM) + EPS);
    const f32x4* gf = (const f32x4*)((const float*)a.in[I_GFIN] + 16 * lane2);
    f32x4* y = (f32x4*)((row < TP ? a.out + O_YP + (size_t)row * DM : a.out + O_YS + (size_t)(row - TP) * DM) + 16 * lane2);
#pragma unroll
    for (int q = 0; q < 4; ++q) { const f32x4 g4 = gf[q]; f32x4 o; o.x = xv[q].x * r * g4.x; o.y = xv[q].y * r * g4.y; o.z = xv[q].z * r * g4.z; o.w = xv[q].w * r * g4.w; y[q] = o; }
}
__device__ __forceinline__ void cand_ij(int c, int& ci, int& cj) {
    if (c < 16) { ci = 0; cj = c; } else if (c < 24) { ci = 1; cj = c - 16; } else if (c < 29) { ci = 2; cj = c - 24; } else if (c < 33) { ci = 3; cj = c - 29; }
    else if (c < 36) { ci = 4; cj = c - 33; } else if (c < 38) { ci = 5; cj = c - 36; } else if (c < 40) { ci = 6; cj = c - 38; } else if (c < 42) { ci = 7; cj = c - 40; } else if (c < 50) { ci = c - 34; cj = 0; } else { ci = 0; cj = 0; }
}
__device__ __forceinline__ void peer_phase(const Frame& F, const Args& a) {
    LAS unsigned* TOPS = (LAS unsigned*)F.lds + F.wave * 256;
    LAS unsigned* CT = (LAS unsigned*)F.lds + 8 * 256 + 4 * 1024;
    if (F.tid < 64) { int ci, cj; cand_ij(F.tid, ci, cj); CT[F.tid] = (unsigned)ci | ((unsigned)cj << 8); }
    __syncthreads();
    const int gw = F.vcu * NWAVES + F.wave, NGW = F.G * NWAVES;
    const int nfull = TA / NGW, rem = TA - nfull * NGW;
#pragma unroll 1
    for (int i = 0; i < nfull; ++i) peer_token<false>(F, a, gw + i * NGW, TOPS, CT, 0, nullptr);
    if (rem == 4 * F.G) {
        __syncthreads();
        peer_token<true>(F, a, nfull * NGW + F.vcu * 4 + (F.wave >> 1), TOPS, CT, F.wave & 1, (LAS float*)F.lds + 8 * 256 + (F.wave >> 1) * 1024);
    } else {
        const int row = gw + nfull * NGW; if (row < TA) peer_token<false>(F, a, row, TOPS, CT, 0, nullptr);
    }
}


template <class EpiS>
__device__ __forceinline__ void skinny_tile(const Frame& F, const bf16* A, int lda, const bf16* Bt, int ldb, int tm, int tn, const EpiS& E) {
    const int lane = F.lane, fr = lane & 15, fq = lane >> 4, w = F.wave;
    const bf16* ap = A + (size_t)(tm * 64 + fr) * lda + w * 128 + 8 * fq;
    const bf16* bp = Bt + (size_t)(tn * 64 + fr) * ldb + w * 128 + 8 * fq;
    v4u af[4][4], bfr[4][4];
#pragma unroll
    for (int m = 0; m < 4; ++m)
#pragma unroll
        for (int ks = 0; ks < 4; ++ks) { af[m][ks] = *(const v4u*)(ap + (size_t)(16 * m) * lda + ks * 32); bfr[m][ks] = *(const v4u*)(bp + (size_t)(16 * m) * ldb + ks * 32); }
    f32x4 acc[4][4];
#pragma unroll
    for (int m = 0; m < 4; ++m)
#pragma unroll
        for (int n = 0; n < 4; ++n) acc[m][n] = (f32x4){0.f, 0.f, 0.f, 0.f};
#pragma unroll
    for (int ks = 0; ks < 4; ++ks)
#pragma unroll
        for (int m = 0; m < 4; ++m)
#pragma unroll
            for (int n = 0; n < 4; ++n) acc[m][n] = __builtin_amdgcn_mfma_f32_16x16x32_bf16(__builtin_bit_cast(bf16x8, bfr[n][ks]), __builtin_bit_cast(bf16x8, af[m][ks]), acc[m][n], 0, 0, 0);
    LAS float* PS = (LAS float*)F.lds + w * 4096;
#pragma unroll
    for (int m = 0; m < 4; ++m)
#pragma unroll
        for (int n = 0; n < 4; ++n) *(LAS f32x4*)(PS + (16 * m + fr) * 64 + 4 * ((4 * n + fq) ^ fr)) = acc[m][n];
    __syncthreads();
    {
        const int row = F.tid >> 3, c8 = (F.tid & 7) * 8; const LAS float* PR = (const LAS float*)F.lds + row * 64;
        const int ch0 = 4 * (((F.tid & 7) * 2) ^ (row & 15)), ch1 = 4 * (((F.tid & 7) * 2 + 1) ^ (row & 15));
        f32x4 s0 = *(const LAS f32x4*)(PR + ch0), s1 = *(const LAS f32x4*)(PR + ch1);
#pragma unroll
        for (int ww = 1; ww < 8; ++ww) { s0 += *(const LAS f32x4*)(PR + ww * 4096 + ch0); s1 += *(const LAS f32x4*)(PR + ww * 4096 + ch1); }
        float v[8] = {s0.x, s0.y, s0.z, s0.w, s1.x, s1.y, s1.z, s1.w};
        E(tm * 64 + row, tn * 64 + c8, v, F.tid);
    }
    __syncthreads();
}
struct EpiSk {
    float* d32; int ld32; bf16* d16; int ld16; float sc16;
    const float* res; int ldr;
    const float* gcol; float* ssq; const float* rsq;
    __device__ __forceinline__ void operator()(int row, int col, float (&v)[8], int tid) const {
        if (rsq) { const float rs = rsqrtf(rsq[row] * (1.f / 1024.f) + EPS);
#pragma unroll
            for (int i = 0; i < 8; ++i) v[i] *= rs; }
        if (res) { const f32x4 a = *(const f32x4*)(res + (size_t)row * ldr + col), b = *(const f32x4*)(res + (size_t)row * ldr + col + 4);
            v[0] += a.x; v[1] += a.y; v[2] += a.z; v[3] += a.w; v[4] += b.x; v[5] += b.y; v[6] += b.z; v[7] += b.w; }
        if (d32) { *(f32x4*)(d32 + (size_t)row * ld32 + col) = (f32x4){v[0], v[1], v[2], v[3]}; *(f32x4*)(d32 + (size_t)row * ld32 + col + 4) = (f32x4){v[4], v[5], v[6], v[7]}; }
        if (ssq) { float ss = 0.f;
#pragma unroll
            for (int i = 0; i < 8; ++i) ss += v[i] * v[i];
            ss += __shfl_xor(ss, 1); ss += __shfl_xor(ss, 2); ss += __shfl_xor(ss, 4);
            if ((tid & 7) == 0) atomicAdd(ssq + row, ss); }
        if (d16) { float w8[8];
#pragma unroll
            for (int i = 0; i < 8; ++i) w8[i] = v[i];
            if (gcol) { const f32x4 a = *(const f32x4*)(gcol + col), b = *(const f32x4*)(gcol + col + 4); w8[0] *= a.x; w8[1] *= a.y; w8[2] *= a.z; w8[3] *= a.w; w8[4] *= b.x; w8[5] *= b.y; w8[6] *= b.z; w8[7] *= b.w; }
            v4u o; o.x = pg8::cvt_pk_bf16(w8[0] * sc16, w8[1] * sc16); o.y = pg8::cvt_pk_bf16(w8[2] * sc16, w8[3] * sc16); o.z = pg8::cvt_pk_bf16(w8[4] * sc16, w8[5] * sc16); o.w = pg8::cvt_pk_bf16(w8[6] * sc16, w8[7] * sc16);
            *(v4u*)(d16 + (size_t)row * ld16 + col) = o; }
    }
};

#define SK_TM16(t) (4 * (((t) >> 5) >> 1) + (((t) & 31) >> 3))
#define SK_TN16(t) (8 * (((t) >> 5) & 1) + ((t) & 7))
#define SK_TM32(t) (4 * ((((t) & 255) >> 5) >> 1) + ((((t) & 31) + 32 * ((t) >> 8)) >> 4))
#define SK_TN32(t) (16 * ((((t) & 255) >> 5) & 1) + ((((t) & 31) + 32 * ((t) >> 8)) & 15))


#ifndef PH_MAX
#define PH_MAX 99
#endif
__global__ void __launch_bounds__(NTHR, 2) mega_fwd(Args args) {
    extern __shared__ __attribute__((aligned(16))) unsigned char lds_raw[];
    Frame F;
    F.lds = (LAS unsigned char*)lds_raw;
    F.wave = __builtin_amdgcn_readfirstlane((int)threadIdx.x >> 6); F.lane = lane_id(); F.tid = F.wave * 64 + F.lane;
    F.G = gridDim.x; { const int bx = blockIdx.x; F.vcu = (F.G % 8 == 0) ? (bx % 8) * (F.G / 8) + bx / 8 : bx; }
    volatile LAS unsigned* MISC = (volatile LAS unsigned*)(F.lds + MISC_OFF);
    LAS unsigned long long* ARGP = (LAS unsigned long long*)(F.lds + ARGS_OFF);
    for (int u = F.tid; u < (LDS_BYTES - LDSCTL_OFF) / 4; u += NTHR) ((LAS unsigned*)(F.lds + LDSCTL_OFF))[u] = 0u;
    __syncthreads();
    if (F.tid == 0) {
        ARGP[0] = (unsigned long long)args.in[0];
        ARGP[1] = (unsigned long long)args.in[1];
        ARGP[2] = (unsigned long long)args.in[2];
        ARGP[3] = (unsigned long long)args.in[3];
        ARGP[4] = (unsigned long long)args.in[4];
        ARGP[5] = (unsigned long long)args.in[5];
        ARGP[6] = (unsigned long long)args.in[6];
        ARGP[7] = (unsigned long long)args.in[7];
        ARGP[8] = (unsigned long long)args.in[8];
        ARGP[9] = (unsigned long long)args.in[9];
        ARGP[10] = (unsigned long long)args.in[10];
        ARGP[11] = (unsigned long long)args.in[11];
        ARGP[12] = (unsigned long long)args.in[12];
        ARGP[13] = (unsigned long long)args.in[13];
        ARGP[14] = (unsigned long long)args.in[14];
        ARGP[15] = (unsigned long long)args.in[15];
        ARGP[16] = (unsigned long long)args.in[16];
        ARGP[17] = (unsigned long long)args.in[17];
        ARGP[18] = (unsigned long long)args.in[18];
        ARGP[19] = (unsigned long long)args.in[19];
        ARGP[20] = (unsigned long long)args.in[20];
        ARGP[21] = (unsigned long long)args.in[21];
        ARGP[22] = (unsigned long long)args.in[22];
        ARGP[23] = (unsigned long long)args.in[23];
        ARGP[24] = (unsigned long long)args.in[24];
        ARGP[25] = (unsigned long long)args.in[25];
        ARGP[26] = (unsigned long long)args.in[26];
        ARGP[27] = (unsigned long long)args.in[27];
        ARGP[28] = (unsigned long long)args.in[28];
        ARGP[N_INPUTS] = (unsigned long long)args.out; ARGP[N_INPUTS + 1] = (unsigned long long)args.ws;
    }
    __syncthreads();
    { const XcdBarrier bar0 = xcd_barrier_post((unsigned*)((gu32*)(args.ws + WS_CTL) + CW_BAR), MISC + 8, F.wave); if (F.tid == 0) MISC[10] = bar0.x; }
    __syncthreads();
#define GRID_BAR() do { XcdBarrier bar_; bar_.bar = (unsigned*)((gu32*)((unsigned char*)ld_ptr(ARGP + N_INPUTS + 1) + WS_CTL) + CW_BAR); bar_.x = MISC[10]; bar_.st = MISC + 8; bar_.wave = F.wave; xcd_barrier(bar_); } while (0)
#define PHASE_ARGS const Args A = load_args(ARGP); unsigned char* const ws = A.ws; float* const out = A.out; (void)ws; (void)out; { int l_ = lane_id(); asm volatile("" : "+v"(l_)); F.lane = l_; F.tid = F.wave * 64 + l_; }

    { PHASE_ARGS;
    p0_prologue(F, A);
    }
    GRID_BAR();
#if defined(PROBE_BAR8)
    GRID_BAR(); GRID_BAR(); GRID_BAR(); GRID_BAR(); GRID_BAR(); GRID_BAR(); GRID_BAR(); GRID_BAR();
#endif
#if PH_MAX >= 1
    { PHASE_ARGS;
    {
        pg8::Gemm g{(const bf16*)(ws + WS_HB), (const bf16*)(ws + WS_WIN), DM, DM, DM};
        pg8::StaticOrder S; S.init(TA, N_IN, F.G, (int)blockIdx.x);
        EpiInProj E{out, ws, (const float*)A.in[I_BFF]};
        pg8::gemm_phase(F.lds, g, S, E, F.wave);
    }
    {
        const int off = (TA / 256) * (N_IN / 256) % F.G;
        pg8::Gemm g{(const bf16*)(ws + WS_MB), (const bf16*)(ws + WS_WMK), DM, DM, DM};
        pg8::StaticOrder S; S.init(512, DM, F.G, ((int)blockIdx.x + F.G - off) % F.G);
        EpiGen E{out + O_MKP, DM, (bf16*)(ws + WS_MK16), DM, 1.f, nullptr, nullptr, 0, 0, nullptr, nullptr, nullptr};
        pg8::gemm_phase(F.lds, g, S, E, F.wave);
    }
    {
        const int off = ((TA / 256) * (N_IN / 256) + 8) % F.G;
        pg8::Gemm g{(const bf16*)(ws + WS_MB), (const bf16*)(ws + WS_WMV), DM, DM, DM};
        pg8::StaticOrder S; S.init(512, DM, F.G, ((int)blockIdx.x + F.G - off) % F.G);
        EpiGen E{out + O_MVP, DM, nullptr, 0, 1.f, nullptr, nullptr, 0, 0, nullptr, nullptr, nullptr};
        pg8::gemm_phase(F.lds, g, S, E, F.wave);
    }
    {
        const int off = ((TA / 256) * (N_IN / 256) + 16) % F.G;
        pg8::Gemm g{(const bf16*)(ws + WS_WMV), (const bf16*)(ws + WS_MB), DM, DM, DM};
        pg8::StaticOrder S; S.init(DM, 512, F.G, ((int)blockIdx.x + F.G - off) % F.G);
        EpiGen E{nullptr, 0, (bf16*)(ws + WS_MVT16), 512, 1.f, nullptr, nullptr, 0, 0, nullptr, nullptr, nullptr};
        pg8::gemm_phase(F.lds, g, S, E, F.wave);
    }
    }
    GRID_BAR();
#endif
#if PH_MAX >= 2
    asm volatile("; ===PHASE 2===");
    { PHASE_ARGS;
    {
        const int gw = F.vcu * NWAVES + F.wave, NGW = F.G * NWAVES;
        for (int it = gw; it < 512; it += NGW) fox_norms_item(F, (const bf16*)(ws + WS_QF), (const bf16*)(ws + WS_KF), out + O_LFP, (float*)(ws + WS_MISC + MiB), (float*)(ws + WS_KBIAS), (float*)(ws + WS_MISC + MiB + 65536), it);
        for (int it = gw; it < NB_S * NPAGES; it += NGW) fox_suffix_item(F, (const float*)A.in[I_CFL], (const int*)A.in[I_PT], (float*)(ws + WS_SUF), (float*)(ws + WS_MISC + 2 * MiB), it);
        for (int u = F.vcu; u < 1024; u += F.G) gla_g1_unit(F, A, u);
        for (int u = F.vcu; u < 512; u += F.G) gla_sample_unit(F, A, u);
    }
    }
    GRID_BAR();
#endif
#if PH_MAX >= 3
    asm volatile("; ===PHASE 3===");
    { PHASE_ARGS;
    gla_scan(F, A);
    __syncthreads();
    for (int i = F.vcu; i < 256; i += F.G) { const int bh = i >> 4, s = i & 15;
        fox_attn_unit(F, (const bf16*)(ws + WS_QF), (const bf16*)(ws + WS_KF), (const bf16*)(ws + WS_VF), (const float*)(ws + WS_KBIAS), (const float*)(ws + WS_MISC + MiB + 65536), (const float*)(ws + WS_MISC + MiB), (bf16*)(ws + WS_MERGED), bh >> 3, bh & 7, s);
        fox_attn_unit(F, (const bf16*)(ws + WS_QF), (const bf16*)(ws + WS_KF), (const bf16*)(ws + WS_VF), (const float*)(ws + WS_KBIAS), (const float*)(ws + WS_MISC + MiB + 65536), (const float*)(ws + WS_MISC + MiB), (bf16*)(ws + WS_MERGED), bh >> 3, bh & 7, 31 - s); }
    }
    GRID_BAR();
#endif
#if PH_MAX >= 4
    asm volatile("; ===PHASE 4===");
    { PHASE_ARGS;
    if (!(F.vcu & 1)) { for (int u = F.vcu; u < 1024; u += F.G) gla_g3_unit(F, A, u); }
    }
    { PHASE_ARGS;
    for (int u = F.vcu; u < 1024; u += F.G) fox_sample_unit(F, A, u);
    }
    { PHASE_ARGS;
    if (F.vcu & 1) { for (int u = F.vcu; u < 1024; u += F.G) gla_g3_unit(F, A, u); }
    }
    GRID_BAR();
#endif
#if PH_MAX >= 5
    asm volatile("; ===PHASE 5===");
    { PHASE_ARGS;
    {
        pg8::Gemm g{(const bf16*)(ws + WS_MERGED), (const bf16*)(ws + WS_WOUT), DM, DM, DM};
        pg8::StaticOrder S; S.init(TP, DM, F.G, (int)blockIdx.x);
        EpiGen E{(float*)(ws + WS_X1), DM, (bf16*)(ws + WS_HB), DM, 1.f, (const float*)A.in[I_XP], (const float*)A.in[I_XS], TP, DM, (const float*)A.in[I_GCROSS], (float*)(ws + WS_SS), nullptr};
        pg8::gemm_phase(F.lds, g, S, E, F.wave);
        __syncthreads();
        EpiSk Es{(float*)(ws + WS_X1) + (size_t)TP * DM, DM, (bf16*)(ws + WS_HB) + (size_t)TP * DM, DM, 1.f, (const float*)A.in[I_XS], DM, (const float*)A.in[I_GCROSS], (float*)(ws + WS_SS) + TP, nullptr};
        for (int t = F.vcu; t < 256; t += F.G) skinny_tile(F, (const bf16*)(ws + WS_MERGED) + (size_t)TP * DM, DM, (const bf16*)(ws + WS_WOUT), DM, SK_TM16(t), SK_TN16(t), Es);
    }
    }
    GRID_BAR();
#endif
#if PH_MAX >= 7
    asm volatile("; ===PHASE 7===");
    { PHASE_ARGS;
    {
        pg8::Gemm g{(const bf16*)(ws + WS_HB), (const bf16*)(ws + WS_WCQ), DM, DM, DM};
        pg8::StaticOrder S; S.init(TP, DM, F.G, (int)blockIdx.x);
        EpiGen E{nullptr, 0, (bf16*)(ws + WS_QC), DM, C2C, nullptr, nullptr, 0, 0, nullptr, nullptr, (const float*)(ws + WS_SS)};
        pg8::gemm_phase(F.lds, g, S, E, F.wave);
        __syncthreads();
        EpiSk Es{nullptr, 0, (bf16*)(ws + WS_QC) + (size_t)TP * DM, DM, C2C, nullptr, 0, nullptr, nullptr, (const float*)(ws + WS_SS) + TP};
        for (int t = F.vcu; t < 256; t += F.G) skinny_tile(F, (const bf16*)(ws + WS_HB) + (size_t)TP * DM, DM, (const bf16*)(ws + WS_WCQ), DM, SK_TM16(t), SK_TN16(t), Es);
    }
    }
    GRID_BAR();
#endif
#if PH_MAX >= 8
    asm volatile("; ===PHASE 8===");
    { PHASE_ARGS;
    {
        const int u = (int)blockIdx.x, b = (u >> 7) & 1, h = (u >> 5) & 3, pnl = u & 31;
        const size_t roff = ((size_t)b * SEQ + pnl * 256) * DM + h * 256;
        if (F.vcu & 1) { for (int v = F.vcu; v < 512; v += F.G) cross_sample_unit(F, A, v); }
        pg8::Gemm g{(const bf16*)(ws + WS_QC) + roff, (const bf16*)(ws + WS_MK16) + (size_t)(b * 256) * DM + h * 256, DM, DM, 256};
        pg8::SingleUnit S{u < 256 ? 1 : 0, {0, 0}};
        EpiSoftmaxP E{ARGP};
        pg8::gemm_phase(F.lds, g, S, E, F.wave);
        VM_WAIT(); __syncthreads();
        {
            pg8::Gemm g2{(const bf16*)(ws + WS_PC) + roff, (const bf16*)(ws + WS_MVT16) + (size_t)(h * 256) * 512 + b * 256, DM, 512, 256};
            EpiGen E2{nullptr, 0, (bf16*)(ws + WS_OC) + roff, DM, 1.f, nullptr, nullptr, 0, 0, nullptr, nullptr, nullptr};
            pg8::gemm_phase(F.lds, g2, S, E2, F.wave);
        }
        __syncthreads();
        if (!(F.vcu & 1)) { for (int v = F.vcu; v < 512; v += F.G) cross_sample_unit(F, A, v); }
    }
    }
    GRID_BAR();
#endif
#if PH_MAX >= 10
    asm volatile("; ===PHASE 10===");
    { PHASE_ARGS;
    {
        pg8::Gemm g{(const bf16*)(ws + WS_OC), (const bf16*)(ws + WS_WCO), DM, DM, DM};
        pg8::StaticOrder S; S.init(TP, DM, F.G, (int)blockIdx.x);
        EpiGen E{(float*)(ws + WS_X2), DM, (bf16*)(ws + WS_HB), DM, 1.f, (const float*)(ws + WS_X1), (const float*)(ws + WS_X1), TA, DM, (const float*)A.in[I_GFFN], (float*)(ws + WS_SS) + TA, nullptr};
        pg8::gemm_phase(F.lds, g, S, E, F.wave);
        __syncthreads();
        EpiSk Es{(float*)(ws + WS_X2) + (size_t)TP * DM, DM, (bf16*)(ws + WS_HB) + (size_t)TP * DM, DM, 1.f, (const float*)(ws + WS_X1) + (size_t)TP * DM, DM, (const float*)A.in[I_GFFN], (float*)(ws + WS_SS) + TA + TP, nullptr};
        for (int t = F.vcu; t < 256; t += F.G) skinny_tile(F, (const bf16*)(ws + WS_OC) + (size_t)TP * DM, DM, (const bf16*)(ws + WS_WCO), DM, SK_TM16(t), SK_TN16(t), Es);
    }
    }
    GRID_BAR();
#endif
#if PH_MAX >= 12
    asm volatile("; ===PHASE 12===");
    { PHASE_ARGS;
    {
        pg8::Gemm g{(const bf16*)(ws + WS_HB), (const bf16*)(ws + WS_WPK), DM, DM, DM};
        pg8::StaticOrder S; S.init(TP, 2048, F.G, (int)blockIdx.x);
        EpiGen E{nullptr, 0, (bf16*)(ws + WS_SC), 2048, 1.f, nullptr, nullptr, 0, 0, nullptr, nullptr, (const float*)(ws + WS_SS) + TA};
        pg8::gemm_phase(F.lds, g, S, E, F.wave);
        __syncthreads();
        EpiSk Es{nullptr, 0, (bf16*)(ws + WS_SC) + (size_t)TP * 2048, 2048, 1.f, nullptr, 0, nullptr, nullptr, (const float*)(ws + WS_SS) + TA + TP};
        for (int t = F.vcu; t < 512; t += F.G) skinny_tile(F, (const bf16*)(ws + WS_HB) + (size_t)TP * DM, DM, (const bf16*)(ws + WS_WPK), DM, SK_TM32(t), SK_TN32(t), Es);
    }
    }
    GRID_BAR();
#endif
#if PH_MAX >= 13
    asm volatile("; ===PHASE 13===");
    { PHASE_ARGS;
    peer_phase(F, A);
    }
#endif
#if PH_MAX < 13
    {   PHASE_ARGS;
        const int gw = F.vcu * NWAVES + F.wave, NGW = F.G * NWAVES;
        for (int m = gw; m < TA; m += NGW) {
            const float* x = m < TP ? (const float*)A.in[I_XP] + (size_t)m * DM : (const float*)A.in[I_XS] + (size_t)(m - TP) * DM;
            float* y = m < TP ? out + O_YP + (size_t)m * DM : out + O_YS + (size_t)(m - TP) * DM;
            for (int j = 0; j < 4; ++j) ((f32x4*)y)[F.lane + 64 * j] = ((const f32x4*)x)[F.lane + 64 * j];
        }
    }
#endif

}

extern "C" void kernel_launch(void* const* d_in, const int* in_sizes, int n_in, void* d_out, int out_size, void* d_ws, size_t ws_size, hipStream_t stream) {
    static int grid = 0;
    if (grid == 0) {
        if (n_in != N_INPUTS || (size_t)out_size != O_TOTAL || ws_size < WS_END) { fprintf(stderr, "kernel_launch: unexpected shapes (n_in %d out %d ws %zu)\n", n_in, out_size, ws_size); grid = -1; return; }
        int dev = 0, cus = 0, per_cu = 0;
        if (hipGetDevice(&dev) != hipSuccess || hipDeviceGetAttribute(&cus, hipDeviceAttributeMultiprocessorCount, dev) != hipSuccess) { grid = -1; return; }
        if (hipFuncSetAttribute((const void*)mega_fwd, hipFuncAttributeMaxDynamicSharedMemorySize, LDS_BYTES) != hipSuccess) { fprintf(stderr, "kernel_launch: hipFuncSetAttribute failed\n"); grid = -1; return; }
        if (hipOccupancyMaxActiveBlocksPerMultiprocessor(&per_cu, (const void*)mega_fwd, NTHR, LDS_BYTES) != hipSuccess || per_cu < 1)
            fprintf(stderr, "kernel_launch: occupancy query reports %d workgroups per CU\n", per_cu);
        (void)hipGetLastError();
        grid = cus;
        if (grid > 256) grid = 256;
    }
    if (grid < 0) return;
    if (hipMemsetAsync((char*)d_ws + WS_CTL, 0, CTL_ZERO_BYTES, stream) != hipSuccess) return;
    Args a{};
    for (int i = 0; i < N_INPUTS; ++i) a.in[i] = d_in[i];
    a.out = (float*)d_out; a.ws = (unsigned char*)d_ws;
    hipLaunchKernelGGL(mega_fwd, dim3(grid), dim3(NTHR), LDS_BYTES, stream, a);
    const hipError_t le = hipPeekAtLastError();
    if (le != hipSuccess) fprintf(stderr, "kernel_launch: launch failed: %s\n", hipGetErrorName(le));
}
```

```cpp
#define PH_MAX 13
#include <hip/hip_runtime.h>
#include <cstdio>
#include <cstdint>

namespace pg8 {
#define PG8_LAS __attribute__((address_space(3)))
typedef unsigned short bf16_t;
typedef short bf16x8 __attribute__((ext_vector_type(8)));
typedef float f32x4 __attribute__((ext_vector_type(4)));
typedef unsigned u32x4 __attribute__((ext_vector_type(4)));
typedef unsigned u32x2 __attribute__((ext_vector_type(2)));
constexpr int BM = 256, BK = 64, HALF = 128, HTB = HALF * BK * 2  , STAGE_BYTES = 8 * HTB, NXCD = 8, WGM = 8;

__host__ __device__ __forceinline__ int lds_byte(int r, int c) { const int st = (r >> 4) * 2 + (c >> 5), rr = r & 15, cc = c & 31, ob = rr * 64 + cc * 2; return st * 1024 + (ob ^ (((ob >> 9) & 1) << 5)); }
__host__ __device__ __forceinline__ void stage_rc(int b, int& R, int& C) { const int st = b / 1024, sb = b % 1024, swz = sb ^ (((sb >> 9) & 1) << 5); R = (st >> 1) * 16 + swz / 64; C = (st & 1) * 32 + (swz % 64) / 2; }

struct Unit { int pm, pn; };
struct Gemm { const bf16_t* A; const bf16_t* Bt; int lda, ldb, K; };

struct StaticOrder {
    int nM, nN, nwg, G, c;
    __host__ __device__ void init(int M, int N, int G_, int c_) { nM = M / BM; nN = N / BM; nwg = nM * nN; G = G_; c = c_; }
    __host__ __device__ bool next(int i, Unit& u) const {
        const long L = (long)i * G + c; if (L >= nwg) return false;
        int wgid = (int)L; { const int q = nwg / NXCD, r = nwg % NXCD, xcd = wgid % NXCD, off = wgid / NXCD; wgid = (xcd < r ? xcd * (q + 1) : r * (q + 1) + (xcd - r) * q) + off; }
        const int nig = WGM * nN, gid = wgid / nig, fm = gid * WGM, gsz = (nM - fm) < WGM ? (nM - fm) : WGM;
        u.pm = fm + ((wgid % nig) % gsz); u.pn = (wgid % nig) / gsz; return true;
    }
};
struct SingleUnit {
    int has; Unit u0;
    __host__ __device__ bool next(int i, Unit& u) const { if (i != 0 || !has) return false; u = u0; return true; }
};

__device__ __forceinline__ unsigned cvt_pk_bf16(float lo, float hi) { unsigned r; asm volatile("v_cvt_pk_bf16_f32 %0, %1, %2" : "=v"(r) : "v"(lo), "v"(hi)); return r; }

template <class Epi, class Sched>
__device__ __forceinline__ void gemm_phase(PG8_LAS unsigned char* lds, const Gemm g, const Sched& S, const Epi& E, int wave_id) {
    int lane; asm volatile("v_mbcnt_lo_u32_b32 %0, -1, 0\n\tv_mbcnt_hi_u32_b32 %0, -1, %0" : "=v"(lane));
    const int wid = wave_id; const int tid = wid * 64 + lane; const int wr = wid >> 2, wc = wid & 3, fr = lane & 15, fq = lane >> 4;
    const int K = g.K, nt = K / BK;
    unsigned voffA[2], voffB[2];
#pragma unroll
    for (int i = 0; i < 2; ++i) { int R, C; stage_rc(tid * 16 + i * 8192, R, C);
        voffA[i] = (unsigned)(R * g.lda + C) * 2u; voffB[i] = (unsigned)(R * g.ldb + C) * 2u; }
    const size_t kstep = (size_t)(BK * 2);
    const size_t hstepA = (size_t)HALF * g.lda * 2, hstepB = (size_t)HALF * g.ldb * 2;
    const size_t tstepA = 2 * hstepA, tstepB = 2 * hstepB;
    const unsigned ldsw = (unsigned)wid * 1024u;
    const int aoff = lds_byte(wr * 64 + fr, fq * 8), boff = lds_byte(wc * 32 + fr, fq * 8);
#define PG8_SA(b, h) (((b) * 2 + (h)) * HTB)
#define PG8_SB(b, h) ((4 + (b) * 2 + (h)) * HTB)
#define PG8_STAGE(bufoff, gbase, voff) do { _Pragma("unroll") for (int _i = 0; _i < 2; ++_i) \
        __builtin_amdgcn_global_load_lds((const unsigned*)((const char*)(gbase) + (voff)[_i]), (PG8_LAS unsigned*)(lds + (bufoff) + ldsw + _i * 8192), 16, 0, 0); } while (0)
#define PG8_LDA(dst, b, h) do { _Pragma("unroll") for (int m = 0; m < 4; ++m) _Pragma("unroll") for (int k = 0; k < 2; ++k) dst[m][k] = *(const PG8_LAS bf16x8*)(lds + PG8_SA(b, h) + aoff + m * 2048 + k * 1024); } while (0)
#define PG8_LDB(dst, b, h) do { _Pragma("unroll") for (int n = 0; n < 2; ++n) _Pragma("unroll") for (int k = 0; k < 2; ++k) dst[n][k] = *(const PG8_LAS bf16x8*)(lds + PG8_SB(b, h) + boff + n * 2048 + k * 1024); } while (0)
#define PG8_MMA(ai, bj, At, Bt) do { __builtin_amdgcn_s_setprio(1); _Pragma("unroll") for (int m = 0; m < 4; ++m) _Pragma("unroll") for (int n = 0; n < 2; ++n) _Pragma("unroll") for (int k = 0; k < 2; ++k) \
        acc[ai][bj][m][n] = __builtin_amdgcn_mfma_f32_16x16x32_bf16(Bt[n][k], At[m][k], acc[ai][bj][m][n], 0, 0, 0); __builtin_amdgcn_s_setprio(0); } while (0)
#define PG8_WAIT_V(n) asm volatile("s_waitcnt vmcnt(" #n ")" ::: "memory")
#define PG8_WAIT_L(n) asm volatile("s_waitcnt lgkmcnt(" #n ")" ::: "memory")
#define PG8_BAR __builtin_amdgcn_s_barrier()
#define PG8_SCHED __builtin_amdgcn_sched_barrier(0)
    Unit cur, nxt; int ui = 0;
    if (!S.next(0, cur)) return;
    f32x4 acc[2][2][4][2];
#pragma unroll
    for (int a = 0; a < 2; ++a)
#pragma unroll
        for (int b = 0; b < 2; ++b)
#pragma unroll
            for (int m = 0; m < 4; ++m)
#pragma unroll
                for (int n = 0; n < 2; ++n) acc[a][b][m][n] = (f32x4){0.f, 0.f, 0.f, 0.f};
    bf16x8 At[4][2], B0[2][2], B1[2][2];
    const char* cA = (const char*)g.A + (size_t)cur.pm * tstepA; const char* cB = (const char*)g.Bt + (size_t)cur.pn * tstepB;
    PG8_STAGE(PG8_SB(0, 0), cB, voffB); PG8_STAGE(PG8_SB(0, 1), cB + hstepB, voffB); PG8_STAGE(PG8_SA(0, 0), cA, voffA); PG8_STAGE(PG8_SA(0, 1), cA + hstepA, voffA);
    if (wr == 1) PG8_BAR;
    PG8_WAIT_V(2); PG8_BAR;
    PG8_STAGE(PG8_SB(1, 0), cB + kstep, voffB); PG8_STAGE(PG8_SA(1, 0), cA + kstep, voffA); PG8_STAGE(PG8_SB(1, 1), cB + hstepB + kstep, voffB);
    PG8_WAIT_V(6); PG8_BAR;
    for (;;) {
        const bool has_next = S.next(ui + 1, nxt);
        const char* nA = has_next ? (const char*)g.A + (size_t)nxt.pm * tstepA : cA; const char* nB = has_next ? (const char*)g.Bt + (size_t)nxt.pn * tstepB : cB;
        for (int t = 0; t < nt; t += 2) {
            const bool last = (t == nt - 2);
            const char* a1 = cA + (size_t)(t + 1) * kstep;
            const char* a2 = last ? nA : cA + (size_t)(t + 2) * kstep; const char* b2 = last ? nB : cB + (size_t)(t + 2) * kstep;
            const char* a3 = a2 + kstep; const char* b3 = b2 + kstep;
            PG8_LDB(B0, 0, 0); PG8_LDB(B1, 0, 1); PG8_SCHED; PG8_LDA(At, 0, 0); PG8_STAGE(PG8_SA(1, 1), a1 + hstepA, voffA);
            PG8_WAIT_V(8); PG8_WAIT_L(0); PG8_BAR; PG8_MMA(0, 0, At, B0); PG8_MMA(0, 1, At, B1); PG8_BAR; PG8_SCHED;
            PG8_LDA(At, 0, 1); PG8_STAGE(PG8_SB(0, 0), b2, voffB); PG8_STAGE(PG8_SB(0, 1), b2 + hstepB, voffB); PG8_STAGE(PG8_SA(0, 0), a2, voffA);
            PG8_WAIT_V(8); PG8_WAIT_L(0); PG8_BAR; PG8_MMA(1, 0, At, B0); PG8_MMA(1, 1, At, B1); PG8_BAR; PG8_SCHED;
            PG8_LDB(B0, 1, 0); PG8_LDB(B1, 1, 1); PG8_SCHED; PG8_LDA(At, 1, 0); PG8_STAGE(PG8_SA(0, 1), a2 + hstepA, voffA);
            PG8_WAIT_V(8); PG8_WAIT_L(0); PG8_BAR; PG8_MMA(0, 0, At, B0); PG8_MMA(0, 1, At, B1); PG8_BAR; PG8_SCHED;
            PG8_LDA(At, 1, 1); PG8_STAGE(PG8_SB(1, 0), b3, voffB); PG8_STAGE(PG8_SB(1, 1), b3 + hstepB, voffB); PG8_STAGE(PG8_SA(1, 0), a3, voffA);
            PG8_WAIT_V(8); PG8_WAIT_L(0); PG8_BAR; PG8_MMA(1, 0, At, B0); PG8_MMA(1, 1, At, B1); PG8_BAR; PG8_SCHED;
        }
        if (wr == 0) PG8_BAR;
        if constexpr (!Epi::AFTER_DRAIN) { E(acc, cur, wr, wc, fr, fq); }
        if (!has_next) break;
#pragma unroll
        for (int a = 0; a < 2; ++a)
#pragma unroll
            for (int b = 0; b < 2; ++b)
#pragma unroll
                for (int m = 0; m < 4; ++m)
#pragma unroll
                    for (int n = 0; n < 2; ++n) acc[a][b][m][n] = (f32x4){0.f, 0.f, 0.f, 0.f};
        cur = nxt; cA = nA; cB = nB; ++ui;
        if (wr == 1) PG8_BAR;
    }
    PG8_WAIT_V(0);
    PG8_BAR;
    if constexpr (Epi::AFTER_DRAIN) { E.fused(acc, cur, wr, wc, fr, fq, lds, wid, lane); }
#undef PG8_SA
#undef PG8_SB
#undef PG8_STAGE
#undef PG8_LDA
#undef PG8_LDB
#undef PG8_MMA
#undef PG8_WAIT_V
#undef PG8_WAIT_L
#undef PG8_BAR
#undef PG8_SCHED
}
}

#define GAS __attribute__((address_space(1)))
#define LAS __attribute__((address_space(3)))
typedef unsigned short bf16;
typedef unsigned v4u __attribute__((ext_vector_type(4)));
typedef unsigned v2u __attribute__((ext_vector_type(2)));
typedef float f32x4 __attribute__((ext_vector_type(4)));
typedef float f32x2 __attribute__((ext_vector_type(2)));
typedef float f32x16 __attribute__((ext_vector_type(16)));
typedef short bf16x8 __attribute__((ext_vector_type(8)));
typedef short s16x4 __attribute__((ext_vector_type(4)));
typedef GAS unsigned gu32;
#define RLX_AGENT __ATOMIC_RELAXED, __HIP_MEMORY_SCOPE_AGENT
#define LDS_WAIT() asm volatile("s_waitcnt lgkmcnt(0)" ::: "memory")
#define VM_WAIT() asm volatile("s_waitcnt vmcnt(0)" ::: "memory")
__device__ __forceinline__ unsigned f2bf(float f) { unsigned u = __builtin_bit_cast(unsigned, f); return (u + 0x7fffu + ((u >> 16) & 1u)) >> 16; }
__device__ __forceinline__ unsigned pk2(float lo, float hi) { return f2bf(lo) | (f2bf(hi) << 16); }
__device__ __forceinline__ float bf2f(unsigned short b) { return __builtin_bit_cast(float, (unsigned)b << 16); }
__device__ __forceinline__ float bflo(unsigned u) { return __builtin_bit_cast(float, u << 16); }
__device__ __forceinline__ float bfhi(unsigned u) { return __builtin_bit_cast(float, u & 0xffff0000u); }


typedef short v4i16_t __attribute__((ext_vector_type(4)));
__device__ __forceinline__ s16x4 lds_tr16(LAS unsigned char* p) { return __builtin_bit_cast(s16x4, __builtin_amdgcn_ds_read_tr16_b64_v4i16((LAS v4i16_t*)p)); }
__device__ __forceinline__ int crow(int r, int hi) { return (r & 3) + 8 * (r >> 2) + 4 * hi; }
__device__ __forceinline__ void lds_barrier() { asm volatile("s_waitcnt lgkmcnt(0)\n\ts_barrier" ::: "memory"); }

struct BfPtr { const unsigned short* p; __device__ __forceinline__ float operator[](size_t i) const { return __builtin_bit_cast(float, (unsigned)p[i] << 16); }
               __device__ __forceinline__ BfPtr operator+(size_t o) const { return BfPtr{p + o}; } };
#define GLD(ptr) (BfPtr{(const unsigned short*)(ptr)})

__device__ __forceinline__ int lane_id() { int r; asm volatile("v_mbcnt_lo_u32_b32 %0, -1, 0\n\tv_mbcnt_hi_u32_b32 %0, -1, %0" : "=v"(r)); return r; }
#define TID_IS_ZERO(wave_) ((wave_) == 0 && lane_id() == 0)
#define XB_TMO      128
#define XB_XCNT(j)  (256  + 64 * (j))
#define XB_XSUB(j)  (1280 + 64 * (j))
#define XB_XGEN(j)  (2304 + 64 * (j))
#define XB_TOP      3328
#define XB_TOPGEN   3392
#define XCD_BAR_WORDS 3456
#define XB_SPIN_CAP (1u << 18)

__device__ __forceinline__ unsigned xb_ld(unsigned* p)              { return __hip_atomic_load(p, __ATOMIC_RELAXED, __HIP_MEMORY_SCOPE_AGENT); }
__device__ __forceinline__ unsigned xb_add(unsigned* p, unsigned v) { return __hip_atomic_fetch_add(p, v, __ATOMIC_RELAXED, __HIP_MEMORY_SCOPE_AGENT); }
__device__ __forceinline__ unsigned xb_xcc_id() { return (unsigned)__builtin_amdgcn_s_getreg((3 << 11) | 20) & 0xFu; }
#define XB_SPIN(cond, bar) do { unsigned _sp = 0; while (cond) { __builtin_amdgcn_s_sleep(1); \
    if ((++_sp & 255u) == 0u) { if (xb_ld(&(bar)[XB_TMO])) break; if (_sp > XB_SPIN_CAP) { atomicAdd(&(bar)[XB_TMO], 1u); break; } } } } while (0)

struct XcdBarrier {
    unsigned* bar; unsigned x; int wave;
    volatile LAS unsigned* st;
};

__device__ __forceinline__ XcdBarrier xcd_barrier_post(unsigned* bar, volatile LAS unsigned* st, int wave) {
    XcdBarrier b; b.bar = bar; b.x = xb_xcc_id(); b.st = st; b.wave = wave;
    if (TID_IS_ZERO(wave)) (void)xb_add(&bar[XB_XCNT(b.x)], 1u);
    return b;
}
__device__ __forceinline__ void xcd_barrier_complete(unsigned* bar, unsigned x, unsigned& nloc, unsigned& nx) {
    const unsigned G = gridDim.x * gridDim.y * gridDim.z;
    unsigned sum, cnt, mine, sp = 0u;
    for (;;) {
        sum = 0u; cnt = 0u; mine = 0u;
#pragma unroll
        for (unsigned j = 0; j < 16; ++j) { const unsigned c = xb_ld(&bar[XB_XCNT(j)]); sum += c; cnt += (c > 0u) ? 1u : 0u; mine = (j == x) ? c : mine; }
        if (sum == G) break;
        __builtin_amdgcn_s_sleep(1);
        if ((++sp & 255u) == 0u) { if (xb_ld(&bar[XB_TMO])) break; if (sp > XB_SPIN_CAP) { atomicAdd(&bar[XB_TMO], 1u); break; } }
    }
    nloc = mine > 0u ? mine : 1u; nx = cnt > 0u ? cnt : 1u;
}

__device__ __forceinline__ void xcd_barrier(const XcdBarrier& b) {
    asm volatile("s_waitcnt vmcnt(0)" ::: "memory");
    __syncthreads();
    if (TID_IS_ZERO(b.wave)) {
        unsigned* bar = b.bar;
        __builtin_amdgcn_s_waitcnt(0);
        unsigned nloc = b.st[0], nx = b.st[1];
        if (nloc == 0u) { xcd_barrier_complete(bar, b.x, nloc, nx); b.st[0] = nloc; b.st[1] = nx; }
        const unsigned old = xb_add(&bar[XB_XSUB(b.x)], 1u);
        const unsigned gen = old / nloc;
        if (old + 1u == (gen + 1u) * nloc) {
            __builtin_amdgcn_fence(__ATOMIC_RELEASE, "agent");
            asm volatile("s_waitcnt vmcnt(0)" ::: "memory");
            const unsigned og = xb_add(&bar[XB_TOP], 1u);
            const unsigned tg = og / nx;
            if (og + 1u == (tg + 1u) * nx) xb_add(&bar[XB_TOPGEN], 1u);
            else XB_SPIN(xb_ld(&bar[XB_TOPGEN]) == tg, bar);
            __builtin_amdgcn_fence(__ATOMIC_ACQUIRE, "agent");
            xb_add(&bar[XB_XGEN(b.x)], 1u);
            asm volatile("s_waitcnt vmcnt(0)" ::: "memory");
        } else {
            XB_SPIN(xb_ld(&bar[XB_XGEN(b.x)]) == gen, bar);
            __builtin_amdgcn_fence(__ATOMIC_ACQUIRE, "agent");
            asm volatile("s_waitcnt vmcnt(0)" ::: "memory");
        }
    }
    __syncthreads();
}


constexpr int NWAVES = 8, NTHR = 512;
constexpr int DM = 1024, TP = 16384, TS = 1024, TA = TP + TS, SEQ = 8192, NB_P = 2, NB_S = 128, LS = 8;
constexpr int N_IN = 3328;
constexpr int PASTL = 2048, PAGE = 128, NPAGES = 16;
constexpr float EPS = 1e-6f;
constexpr float LOG2E = 1.4426950408889634f;
constexpr float C2F = 0.125f * LOG2E;
constexpr float C2C = 0.0625f * LOG2E;

enum { I_XP = 0, I_XS, I_CFK, I_CFV, I_CFL, I_SGLA, I_CMK, I_CMV, I_PT, I_MEMP, I_GMIX, I_WIN, I_BFF, I_WG2, I_BG, I_GGO, I_WOUT, I_GCROSS, I_GMEM,
       I_WMK, I_WMV, I_WCQ, I_WCO, I_GFFN, I_PWQ, I_PSK, I_PU, I_PV, I_GFIN, N_INPUTS };
constexpr size_t O_YP = 0, O_YS = 16777216, O_FKP = 17825792, O_FVP = 26214400, O_LFP = 34603008, O_GSP = 34734080, O_MKP = 34799616, O_MVP = 35323904,
                 O_FKS = 35848192, O_FVS = 36372480, O_LFS = 36896768, O_GSS = 36904960, O_TOTAL = 41099264;

constexpr size_t MiB = 1u << 20;
constexpr size_t WS_CTL = 0, CTL_ZERO_BYTES = 1 * MiB;
constexpr size_t WS_WIN = 2 * MiB, WS_WOUT = 10 * MiB, WS_WMK = 12 * MiB, WS_WMV = 14 * MiB, WS_WCQ = 16 * MiB, WS_WCO = 18 * MiB, WS_WPK = 20 * MiB;
constexpr size_t WS_MB = 24 * MiB, WS_MK16 = 25 * MiB, WS_MVT16 = 26 * MiB, WS_KBIAS = 27 * MiB, WS_GDEC = 28 * MiB, WS_GG = 29 * MiB;
constexpr size_t WS_U16 = 32 * MiB, WS_V16 = 64 * MiB, WS_HB = 96 * MiB, WS_QF = 132 * MiB, WS_KF = 150 * MiB, WS_VF = 168 * MiB;
constexpr size_t WS_GQ = 186 * MiB, WS_GK = 204 * MiB, WS_GV = 222 * MiB, WS_GR = 256 * MiB, WS_SUF = 290 * MiB, WS_GKV = 298 * MiB;
constexpr size_t WS_MERGED = 330 * MiB, WS_X1 = 364 * MiB, WS_X2 = 432 * MiB, WS_QC = 500 * MiB, WS_PC = 534 * MiB, WS_OC = 566 * MiB, WS_SC = 600 * MiB;
constexpr size_t WS_MISC = 736 * MiB, WS_SS = 740 * MiB  , WS_BB = 744 * MiB, WS_END = 800 * MiB;
constexpr int CW_BAR = 4096;

constexpr int RING_BYTES = 131072;
constexpr int LDSCTL_OFF = RING_BYTES, MISC_OFF = LDSCTL_OFF + 320;
constexpr int ARGS_OFF = MISC_OFF + 128;
constexpr int LDS_BYTES = 147456;

struct Args { const void* in[N_INPUTS]; float* out; unsigned char* ws; };

__device__ __forceinline__ const void* ld_ptr(const LAS unsigned long long* p) { const unsigned long long v = *p; const unsigned lo = __builtin_amdgcn_readfirstlane((unsigned)v), hi = __builtin_amdgcn_readfirstlane((unsigned)(v >> 32)); return (const void*)(const GAS char*)(((unsigned long long)hi << 32) | lo); }
__device__ __forceinline__ Args load_args(const LAS unsigned long long* ARGP) { Args A;
    A.in[0] = ld_ptr(ARGP + 0);
    A.in[1] = ld_ptr(ARGP + 1);
    A.in[2] = ld_ptr(ARGP + 2);
    A.in[3] = ld_ptr(ARGP + 3);
    A.in[4] = ld_ptr(ARGP + 4);
    A.in[5] = ld_ptr(ARGP + 5);
    A.in[6] = ld_ptr(ARGP + 6);
    A.in[7] = ld_ptr(ARGP + 7);
    A.in[8] = ld_ptr(ARGP + 8);
    A.in[9] = ld_ptr(ARGP + 9);
    A.in[10] = ld_ptr(ARGP + 10);
    A.in[11] = ld_ptr(ARGP + 11);
    A.in[12] = ld_ptr(ARGP + 12);
    A.in[13] = ld_ptr(ARGP + 13);
    A.in[14] = ld_ptr(ARGP + 14);
    A.in[15] = ld_ptr(ARGP + 15);
    A.in[16] = ld_ptr(ARGP + 16);
    A.in[17] = ld_ptr(ARGP + 17);
    A.in[18] = ld_ptr(ARGP + 18);
    A.in[19] = ld_ptr(ARGP + 19);
    A.in[20] = ld_ptr(ARGP + 20);
    A.in[21] = ld_ptr(ARGP + 21);
    A.in[22] = ld_ptr(ARGP + 22);
    A.in[23] = ld_ptr(ARGP + 23);
    A.in[24] = ld_ptr(ARGP + 24);
    A.in[25] = ld_ptr(ARGP + 25);
    A.in[26] = ld_ptr(ARGP + 26);
    A.in[27] = ld_ptr(ARGP + 27);
    A.in[28] = ld_ptr(ARGP + 28);
    A.out = (float*)ld_ptr(ARGP + N_INPUTS); A.ws = (unsigned char*)ld_ptr(ARGP + N_INPUTS + 1); return A; }
struct Frame {
    LAS unsigned char* lds;
    int tid, lane, wave, vcu, G;
};

__device__ __forceinline__ float wave_sum(float v) {
#pragma unroll
    for (int o = 1; o < 64; o <<= 1) v += __shfl_xor(v, o);
    return v;
}
__device__ __forceinline__ float log_sigmoid(float x) { return fminf(x, 0.f) - log1pf(__expf(-fabsf(x))); }

__device__ __forceinline__ int win_src_col(int r) {
    if (r < 1536) return r;
    if (r < 1792) return 1544 + (r - 1536);
    if (r < 2048) return 1800 + (r - 1792);
    if (r < 2560) return 2056 + (r - 2048);
    if (r < 3072) return 2584 + (r - 2560);
    if (r < 3080) return 1536 + (r - 3072);
    if (r < 3096) return 2568 + (r - 3080);
    return -1;
}
template <bool WIN>
__device__ __forceinline__ void p0_transpose_item(const float* W, int ldw, int K, int nblk, bf16* WT, LAS float* scr, int item, int lane) {
    const int kb = item / nblk, nb = item % nblk, k0 = 64 * kb, n0 = 32 * nb;
    const int dr = n0 + (lane & 31); const int sc = WIN ? win_src_col(dr) : dr;
#pragma unroll 8
    for (int i = 0; i < 32; ++i) { const int kk = 2 * i + (lane >> 5); scr[kk * 33 + (lane & 31)] = (sc >= 0) ? W[(size_t)(k0 + kk) * ldw + sc] : 0.f; }
    LDS_WAIT(); asm volatile("" ::: "memory");
    const int c = lane & 7;
#pragma unroll
    for (int j = 0; j < 4; ++j) { const int n = (lane >> 3) + 8 * j; const LAS float* s = scr + (8 * c) * 33 + n;
        v4u o; o.x = pk2(s[0 * 33], s[1 * 33]); o.y = pk2(s[2 * 33], s[3 * 33]); o.z = pk2(s[4 * 33], s[5 * 33]); o.w = pk2(s[6 * 33], s[7 * 33]);
        *(GAS v4u*)(WT + (size_t)(n0 + n) * K + k0 + 8 * c) = o; }
    LDS_WAIT(); asm volatile("" ::: "memory");
}
__device__ __forceinline__ void rms_row_bf16(const float* xrow, const float* g, bf16* orow, int lane) {
    const f32x4* xr = (const f32x4*)xrow + lane; const f32x4* gr = (const f32x4*)g + lane;
    f32x4 v[4]; float s = 0.f;
#pragma unroll
    for (int j = 0; j < 4; ++j) { v[j] = xr[64 * j]; s += (v[j].x * v[j].x + v[j].y * v[j].y) + (v[j].z * v[j].z + v[j].w * v[j].w); }
    const float r = rsqrtf(wave_sum(s) * (1.f / DM) + EPS);
    v2u* o8 = (v2u*)orow + lane;
#pragma unroll
    for (int j = 0; j < 4; ++j) { const f32x4 gg = gr[64 * j]; v2u o; o.x = pk2(v[j].x * r * gg.x, v[j].y * r * gg.y); o.y = pk2(v[j].z * r * gg.z, v[j].w * r * gg.w); o8[64 * j] = o; }
}

using pg8::Unit;
struct EpiGen {
    static constexpr bool PERM = false, AFTER_DRAIN = false;
    float* d32; int ld32; bf16* d16; int ld16; float sc16;
    const float* r0; const float* r1; int rsplit; int ldr;
    const float* gcol;
    float* ssq;
    const float* rsq;
    __device__ __forceinline__ void operator()(const f32x4 (&acc)[2][2][4][2], const Unit& u, int wr, int wc, int fr, int fq) const {
        int row0 = u.pm * 256 + wr * 64 + fr, col0 = u.pn * 256 + wc * 32 + fq * 4;
        asm volatile("" : "+v"(row0), "+v"(col0));
#pragma unroll
        for (int ai = 0; ai < 2; ++ai)
#pragma unroll
            for (int m = 0; m < 4; ++m) { const int row = row0 + ai * 128 + m * 16;
                const float* rp = nullptr; if (r0) rp = (row < rsplit) ? r0 + (size_t)row * ldr : r1 + (size_t)(row - rsplit) * ldr;
                float rs = 1.f; if (rsq) rs = rsqrtf(rsq[row] * (1.f / 1024.f) + EPS);
                float ss = 0.f;
#pragma unroll
                for (int bj = 0; bj < 2; ++bj)
#pragma unroll
                    for (int n = 0; n < 2; ++n) { const int col = col0 + bj * 128 + n * 16; f32x4 v = acc[ai][bj][m][n];
                        if (rsq) { v[0] *= rs; v[1] *= rs; v[2] *= rs; v[3] *= rs; }
                        if (r0) v += *(const f32x4*)(rp + col);
                        if (d32) *(f32x4*)(d32 + (size_t)row * ld32 + col) = v;
                        if (ssq) ss += (v[0] * v[0] + v[1] * v[1]) + (v[2] * v[2] + v[3] * v[3]);
                        if (d16) { f32x4 w = v; if (gcol) w = w * *(const f32x4*)(gcol + col);
                            v2u o; o.x = pg8::cvt_pk_bf16(w[0] * sc16, w[1] * sc16); o.y = pg8::cvt_pk_bf16(w[2] * sc16, w[3] * sc16); *(v2u*)(d16 + (size_t)row * ld16 + col) = o; } }
                if (ssq) { ss += __shfl_xor(ss, 16); ss += __shfl_xor(ss, 32); if (fq == 0) atomicAdd(ssq + row, ss); } }
    }
};
struct EpiInProj {
    static constexpr bool PERM = false, AFTER_DRAIN = false;
    float* out; unsigned char* ws; const float* bff;
    __device__ __forceinline__ void operator()(const f32x4 (&acc)[2][2][4][2], const Unit& u, int wr, int wc, int fr, int fq) const {
        const int pn = u.pn; const bool smp = u.pm >= 64;
        int row0 = u.pm * 256 + wr * 64 + fr;
        int orow0 = (smp ? (u.pm - 64) * 256 : u.pm * 256) + wr * 64 + fr;
        asm volatile("" : "+v"(row0), "+v"(orow0));
        float* d32 = nullptr; int ld32 = 0; bool d32_grp = false; bf16* d16 = nullptr; int ld16 = 0; float s32 = 1.f, s16 = 1.f; int cb = 0;
        if (pn < 2) { d16 = (bf16*)(ws + WS_QF); ld16 = 512; s16 = C2F; cb = pn * 256; }
        else if (pn < 4) { d32 = out + (smp ? O_FKS : O_FKP); ld32 = 512; d32_grp = true; d16 = (bf16*)(ws + WS_KF); ld16 = 512; cb = (pn - 2) * 256; }
        else if (pn < 6) { d32 = out + (smp ? O_FVS : O_FVP); ld32 = 512; d32_grp = true; d16 = (bf16*)(ws + WS_VF); ld16 = 512; cb = (pn - 4) * 256; }
        else if (pn == 6) { d16 = (bf16*)(ws + WS_GQ); ld16 = 256; s16 = 0.125f; }
        else if (pn == 7) { d16 = (bf16*)(ws + WS_GK); ld16 = 256; }
        else if (pn < 10) { d16 = (bf16*)(ws + WS_GV); ld16 = 512; cb = (pn - 8) * 256; }
        else if (pn < 12) { d16 = (bf16*)(ws + WS_GR); ld16 = 512; cb = (pn - 10) * 256; }
        if (pn < 12) {
#pragma unroll
            for (int ai = 0; ai < 2; ++ai)
#pragma unroll
                for (int m = 0; m < 4; ++m) { const int row = row0 + ai * 128 + m * 16, orow = orow0 + ai * 128 + m * 16;
#pragma unroll
                    for (int bj = 0; bj < 2; ++bj)
#pragma unroll
                        for (int n = 0; n < 2; ++n) { const int col = cb + wc * 32 + fq * 4 + bj * 128 + n * 16; const f32x4 v = acc[ai][bj][m][n];
                            if (d32) *(f32x4*)(d32 + (size_t)(d32_grp ? orow : row) * ld32 + col) = v * s32;
                            if (d16) { v2u o; o.x = pg8::cvt_pk_bf16(v[0] * s16, v[1] * s16); o.y = pg8::cvt_pk_bf16(v[2] * s16, v[3] * s16); *(v2u*)(d16 + (size_t)row * ld16 + col) = o; } } }
        } else {
            if (wc == 0) {
                float* lf = out + (smp ? O_LFS : O_LFP); float* ggp = (float*)(ws + WS_GG);
#pragma unroll
                for (int ai = 0; ai < 2; ++ai)
#pragma unroll
                    for (int m = 0; m < 4; ++m) { const int row = row0 + ai * 128 + m * 16, orow = orow0 + ai * 128 + m * 16;
#pragma unroll
                        for (int n = 0; n < 2; ++n) { const int col = n * 16 + fq * 4; const f32x4 v = acc[ai][0][m][n];
                            if (col < 8) { f32x4 o; const f32x4 b = *(const f32x4*)(bff + col);
                                o[0] = log_sigmoid(v[0] + b[0]); o[1] = log_sigmoid(v[1] + b[1]); o[2] = log_sigmoid(v[2] + b[2]); o[3] = log_sigmoid(v[3] + b[3]);
                                *(f32x4*)(lf + (size_t)orow * 8 + col) = o; }
                            else if (col < 24) *(f32x4*)(ggp + (size_t)row * 16 + (col - 8)) = v; } }
            }
        }
    }
};


__device__ __forceinline__ void p0_prologue(const Frame& F, const Args& a) {
    unsigned char* ws = a.ws;
    LAS float* scr = (LAS float*)(F.lds + F.wave * 16384);
    const int gw = F.vcu * NWAVES + F.wave, NGW = F.G * NWAVES;
    constexpr int I_WINN = 16 * (N_IN / 32), I_SQ = 16 * 32;
    constexpr int NITEMS = I_WINN + 5 * I_SQ;
    for (int it = gw; it < NITEMS; it += NGW) {
        int r = it;
        if (r < I_WINN) { p0_transpose_item<true>((const float*)a.in[I_WIN], 3096, DM, N_IN / 32, (bf16*)(ws + WS_WIN), scr, r, F.lane); continue; } r -= I_WINN;
        const int which = r / I_SQ; r -= which * I_SQ;
        const float* src = (const float*)(which == 0 ? a.in[I_WOUT] : which == 1 ? a.in[I_WMK] : which == 2 ? a.in[I_WMV] : which == 3 ? a.in[I_WCQ] : a.in[I_WCO]);
        bf16* dst = (bf16*)(ws + (which == 0 ? WS_WOUT : which == 1 ? WS_WMK : which == 2 ? WS_WMV : which == 3 ? WS_WCQ : WS_WCO));
        p0_transpose_item<false>(src, DM, DM, 32, dst, scr, r, F.lane);
    }
    { float* ssz = (float*)(ws + WS_SS); for (int i = F.vcu * NTHR + F.tid; i < 2 * TA; i += F.G * NTHR) ssz[i] = 0.f; }
    for (int m0 = gw * 2; m0 < TA + 512; m0 += NGW * 2) {
        const float* xr[2]; const float* gr[2]; bf16* orow[2];
#pragma unroll
        for (int j = 0; j < 2; ++j) { const int m = m0 + j;
            if (m < TP) { xr[j] = (const float*)a.in[I_XP] + (size_t)m * DM; gr[j] = (const float*)a.in[I_GMIX]; orow[j] = (bf16*)(ws + WS_HB) + (size_t)m * DM; }
            else if (m < TA) { xr[j] = (const float*)a.in[I_XS] + (size_t)(m - TP) * DM; gr[j] = (const float*)a.in[I_GMIX]; orow[j] = (bf16*)(ws + WS_HB) + (size_t)m * DM; }
            else { xr[j] = (const float*)a.in[I_MEMP] + (size_t)(m - TA) * DM; gr[j] = (const float*)a.in[I_GMEM]; orow[j] = (bf16*)(ws + WS_MB) + (size_t)(m - TA) * DM; } }
        f32x4 v[2][4]; float s[2];
#pragma unroll
        for (int j = 0; j < 2; ++j) { s[j] = 0.f;
#pragma unroll
            for (int q = 0; q < 4; ++q) v[j][q] = ((const f32x4*)xr[j])[F.lane + 64 * q]; }
#pragma unroll
        for (int j = 0; j < 2; ++j) {
#pragma unroll
            for (int q = 0; q < 4; ++q) s[j] += (v[j][q].x * v[j][q].x + v[j][q].y * v[j][q].y) + (v[j][q].z * v[j][q].z + v[j][q].w * v[j][q].w);
            const float r = rsqrtf(wave_sum(s[j]) * (1.f / DM) + EPS);
#pragma unroll
            for (int q = 0; q < 4; ++q) { const f32x4 gg = ((const f32x4*)gr[j])[F.lane + 64 * q]; v2u o; o.x = pk2(v[j][q].x * r * gg.x, v[j][q].y * r * gg.y); o.y = pk2(v[j][q].z * r * gg.z, v[j][q].w * r * gg.w); ((v2u*)orow[j])[F.lane + 64 * q] = o; } }
    }
    {
        for (int r0 = gw * 4; r0 < 2 * 16384; r0 += NGW * 4) {
            f32x4 x[4][4];
#pragma unroll
            for (int j = 0; j < 4; ++j) { const int r = r0 + j; const bool isv = r >= 16384; const int e = isv ? r - 16384 : r;
                const f32x4* s = (const f32x4*)((const float*)(isv ? a.in[I_PV] : a.in[I_PU]) + (size_t)e * DM + 16 * F.lane);
#pragma unroll
                for (int q = 0; q < 4; ++q) x[j][q] = __builtin_nontemporal_load(s + q); }
#pragma unroll
            for (int j = 0; j < 4; ++j) { const int r = r0 + j; const bool isv = r >= 16384; const int e = isv ? r - 16384 : r; float am = 0.f;
#pragma unroll
                for (int q = 0; q < 4; ++q) am = fmaxf(am, fmaxf(fmaxf(fabsf(x[j][q].x), fabsf(x[j][q].y)), fmaxf(fabsf(x[j][q].z), fabsf(x[j][q].w))));
#pragma unroll
                for (int o = 1; o < 64; o <<= 1) am = fmaxf(am, __shfl_xor(am, o));
                const float inv = am > 0.f ? 448.f / am : 0.f;
                v4u o4;
#pragma unroll
                for (int q = 0; q < 4; ++q) { int pk = __builtin_amdgcn_cvt_pk_fp8_f32(x[j][q].x * inv, x[j][q].y * inv, 0, false); pk = __builtin_amdgcn_cvt_pk_fp8_f32(x[j][q].z * inv, x[j][q].w * inv, pk, true); o4[q] = (unsigned)pk; }
                *(v4u*)(ws + (isv ? WS_V16 : WS_U16) + (size_t)e * DM + 16 * F.lane) = o4;
                if (F.lane == 0) ((float*)(ws + WS_MISC))[r] = am * (1.f / 448.f); }
        }
    }
    __syncthreads();
    for (int it = blockIdx.x; it < 256; it += F.G) {
        const int c = it >> 4, kt = it & 15, half = c & 1;
        LAS float* SK = (LAS float*)F.lds; LAS float* WT = (LAS float*)(F.lds + 128 * 129 * 4);
        const float* sk = (const float*)a.in[I_PSK] + (size_t)half * 128 * 128; const float* wq = (const float*)a.in[I_PWQ] + (size_t)(kt * 64) * 2048 + c * 128;
#pragma unroll 4
        for (int i = 0; i < 32; ++i) { const int idx = F.tid + 512 * i; SK[(idx >> 7) * 129 + (idx & 127)] = sk[idx]; }
#pragma unroll 4
        for (int i = 0; i < 16; ++i) { const int idx = F.tid + 512 * i; WT[(idx >> 7) * 129 + (idx & 127)] = wq[(size_t)(idx >> 7) * 2048 + (idx & 127)]; }
        __syncthreads();
        const int tk = F.tid & 15, tkey = F.tid >> 4;
        float acc[4][4];
#pragma unroll
        for (int i = 0; i < 4; ++i)
#pragma unroll
            for (int j = 0; j < 4; ++j) acc[i][j] = 0.f;
        for (int j = 0; j < 128; ++j) {
            float av[4], bv[4];
#pragma unroll
            for (int i = 0; i < 4; ++i) { av[i] = SK[(4 * tkey + i) * 129 + j]; bv[i] = WT[(4 * tk + i) * 129 + j]; }
#pragma unroll
            for (int i = 0; i < 4; ++i)
#pragma unroll
                for (int i2 = 0; i2 < 4; ++i2) acc[i][i2] += av[i] * bv[i2];
        }
        bf16* wp = (bf16*)(ws + WS_WPK);
#pragma unroll
        for (int i = 0; i < 4; ++i) { v2u o; o.x = pk2(acc[i][0], acc[i][1]); o.y = pk2(acc[i][2], acc[i][3]); *(v2u*)(wp + (size_t)(c * 128 + 4 * tkey + i) * DM + kt * 64 + 4 * tk) = o; }
        __syncthreads();
    }
}


__device__ __forceinline__ void fox_prompt_cumsum(const Frame& F, const float* logf  , float* kbias, int b) {
    LAS float* WT = (LAS float*)F.lds;
    const int t0 = F.wave * 1024 + F.lane * 16;
    const f32x4* src = (const f32x4*)(logf + ((size_t)b * SEQ + t0) * 8);
    float s[8];
#pragma unroll
    for (int h = 0; h < 8; ++h) s[h] = 0.f;
#pragma unroll 4
    for (int i = 0; i < 16; ++i) { const f32x4 a = src[2 * i], c = src[2 * i + 1]; s[0] += a.x; s[1] += a.y; s[2] += a.z; s[3] += a.w; s[4] += c.x; s[5] += c.y; s[6] += c.z; s[7] += c.w; }
    float ex[8];
#pragma unroll
    for (int h = 0; h < 8; ++h) { float v = s[h];
#pragma unroll
        for (int o = 1; o < 64; o <<= 1) { const float t = __shfl_up(v, o); if (F.lane >= o) v += t; }
        ex[h] = v - s[h];
        if (F.lane == 63) WT[F.wave * 8 + h] = v; }
    __syncthreads();
#pragma unroll
    for (int h = 0; h < 8; ++h) { float c = 0.f; for (int w = 0; w < F.wave; ++w) c += WT[w * 8 + h]; ex[h] += c; }
    float* dst = kbias + (size_t)(b * 8) * SEQ + t0;
#pragma unroll 4
    for (int i = 0; i < 16; ++i) { const f32x4 a = src[2 * i], c = src[2 * i + 1];
        ex[0] += a.x; ex[1] += a.y; ex[2] += a.z; ex[3] += a.w; ex[4] += c.x; ex[5] += c.y; ex[6] += c.z; ex[7] += c.w;
#pragma unroll
        for (int h = 0; h < 8; ++h) dst[(size_t)h * SEQ + i] = -ex[h] * LOG2E; }
    __syncthreads();
}
__device__ __forceinline__ void fox_sample_suffix(const Frame& F, const float* cfl, const int* pt, float* suf, int bs) {
    float carry[8];
#pragma unroll
    for (int h = 0; h < 8; ++h) carry[h] = 0.f;
    const int mypg = pt[bs * NPAGES + (F.lane & 15)];
#pragma unroll 1
    for (int pb = NPAGES - 4; pb >= 0; pb -= 4) {
        f32x4 x[4][4];
#pragma unroll
        for (int j = 0; j < 4; ++j) { const int pg = __builtin_amdgcn_readlane(mypg, 0) * 0 + __shfl(mypg, pb + j); const f32x4* src = (const f32x4*)(cfl + ((size_t)pg * PAGE + 2 * F.lane) * 8);
            x[j][0] = src[0]; x[j][1] = src[1]; x[j][2] = src[2]; x[j][3] = src[3]; }
#pragma unroll
        for (int j = 3; j >= 0; --j) { const int p = pb + j;
            const float ra[8] = {x[j][0].x, x[j][0].y, x[j][0].z, x[j][0].w, x[j][1].x, x[j][1].y, x[j][1].z, x[j][1].w}, rb[8] = {x[j][2].x, x[j][2].y, x[j][2].z, x[j][2].w, x[j][3].x, x[j][3].y, x[j][3].z, x[j][3].w};
#pragma unroll
            for (int h = 0; h < 8; ++h) {
                const float ps = ra[h] + rb[h]; float v = ps;
#pragma unroll
                for (int o = 1; o < 64; o <<= 1) { const float t = __shfl_down(v, o); if (F.lane + o < 64) v += t; }
                const float exs = v - ps;
                float* d = suf + (size_t)(bs * 8 + h) * PASTL + p * PAGE + 2 * F.lane;
                *(f32x2*)d = (f32x2){(carry[h] + exs + rb[h]) * LOG2E, (carry[h] + exs) * LOG2E};
                carry[h] += __shfl(v, 0);
            }
        }
    }
}

__device__ __forceinline__ void gla_gate_tile(const Frame& F, const float* gg, const float* w2, const float* bg, int row0, int h, int nt, LAS float* LA, LAS float* GGS) {
    for (int e = F.tid; e < nt * 16; e += NTHR) GGS[e] = gg[(size_t)row0 * 16 + e];
    const int dk = F.tid & 63; float wc[16];
#pragma unroll
    for (int r = 0; r < 16; ++r) wc[r] = w2[r * 256 + h * 64 + dk];
    const float bb = bg[h * 64 + dk];
    __syncthreads();
    for (int t = F.tid >> 6; t < nt; t += 8) { float z = bb;
#pragma unroll
        for (int q = 0; q < 4; ++q) { const f32x4 g4 = *(const LAS f32x4*)(GGS + t * 16 + 4 * q); z += g4.x * wc[4 * q] + g4.y * wc[4 * q + 1] + g4.z * wc[4 * q + 2] + g4.w * wc[4 * q + 3]; }
        LA[t * 64 + dk] = log_sigmoid(z) * (1.f / 16.f); }
}
__device__ __forceinline__ void gla_cumsum64(const Frame& F, LAS float* LA, LAS float* SEG) {
    const int dk = F.lane, w = F.wave; float v[8]; float run = 0.f;
#pragma unroll
    for (int i = 0; i < 8; ++i) { run += LA[(8 * w + i) * 64 + dk]; v[i] = run; }
    SEG[w * 64 + dk] = run;
    __syncthreads();
    float pre = 0.f;
    for (int j = 0; j < w; ++j) pre += SEG[j * 64 + dk];
#pragma unroll
    for (int i = 0; i < 8; ++i) LA[(8 * w + i) * 64 + dk] = v[i] + pre;
    __syncthreads();
}
template <int SB>
__device__ __forceinline__ bf16x8 tr_frag(LAS unsigned char* base, int ks) {
    const s16x4 lo = lds_tr16(base + ks * 16 * SB), hi4 = lds_tr16(base + ks * 16 * SB + 8 * SB);
    return (bf16x8){lo[0], lo[1], lo[2], lo[3], hi4[0], hi4[1], hi4[2], hi4[3]};
}
__device__ __forceinline__ bf16x8 row_frag(const LAS unsigned char* rowp, int ks, int hi) {
    const v2u lo = *(const LAS v2u*)(rowp + (16 * ks + 4 * hi) * 2), hi2 = *(const LAS v2u*)(rowp + (16 * ks + 8 + 4 * hi) * 2);
    return __builtin_bit_cast(bf16x8, (v4u){lo.x, lo.y, hi2.x, hi2.y});
}
__device__ __forceinline__ void gla_g1_unit(const Frame& F, const Args& a, int u) {
    unsigned char* ws = a.ws;
    const int b = u >> 9, h = (u >> 7) & 3, n = u & 127; const int row0 = b * SEQ + n * 64;
    LAS float* LA = (LAS float*)F.lds; LAS float* SEG = LA + 4096; LAS float* GGS = SEG + 512; LAS unsigned char* KRB = F.lds + 22528; LAS unsigned char* VSB = F.lds + 34816;
    v4u vq[2];
#pragma unroll
    for (int i = 0; i < 2; ++i) { const int c = F.tid + NTHR * i; vq[i] = *(const v4u*)((const bf16*)(ws + WS_GV) + (size_t)(row0 + (c >> 4)) * 512 + h * 128 + (c & 15) * 8); }
    float gkv[8];
#pragma unroll
    for (int i = 0; i < 8; ++i) { const int e = F.tid + NTHR * i; gkv[i] = GLD(ws + WS_GK)[(size_t)(row0 + (e >> 6)) * 256 + h * 64 + (e & 63)]; }
    gla_gate_tile(F, (const float*)(ws + WS_GG), (const float*)a.in[I_WG2], (const float*)a.in[I_BG], row0, h, 64, LA, GGS);
#pragma unroll
    for (int i = 0; i < 2; ++i) { const int c = F.tid + NTHR * i; *(LAS v4u*)(VSB + (c >> 4) * 320 + (c & 15) * 16) = vq[i]; }
    __syncthreads();
    gla_cumsum64(F, LA, SEG);
    if (F.tid < 64) ((float*)(ws + WS_GDEC))[(size_t)((b * 4 + h) * 128 + n) * 64 + F.tid] = __expf(LA[63 * 64 + F.tid]);
    float* bbuf = (float*)(ws + WS_BB);
#pragma unroll
    for (int i = 0; i < 8; ++i) { const int e = F.tid + NTHR * i; const int t = e >> 6, dk = e & 63; const float bb = LA[e]; bbuf[(size_t)(row0 + t) * 256 + h * 64 + dk] = bb;
        *(LAS unsigned short*)(KRB + t * 192 + dk * 2) = (unsigned short)f2bf(gkv[i] * __expf(LA[63 * 64 + dk] - bb)); }
    __syncthreads();
    {
        const int lane = F.lane, r32 = lane & 31, hi = lane >> 5, mb = F.wave >> 2, nb = F.wave & 3;
        const int tb = (4 * hi + ((lane & 15) >> 2)), tc = (16 * ((lane >> 4) & 1) + 4 * (lane & 3)) * 2;
        LAS unsigned char* abase = KRB + tb * 192 + tc + 64 * mb; LAS unsigned char* bbase = VSB + tb * 320 + tc + 64 * nb;
        f32x16 acc = {};
#pragma unroll
        for (int ks = 0; ks < 4; ++ks) acc = __builtin_amdgcn_mfma_f32_32x32x16_bf16(tr_frag<192>(abase, ks), tr_frag<320>(bbase, ks), acc, 0, 0, 0);
        float* kv = (float*)(ws + WS_GKV) + ((size_t)((b * 4 + h) * 128 + n) * 64 + 32 * mb) * 128 + 32 * nb + r32;
#pragma unroll
        for (int r = 0; r < 16; ++r) kv[(size_t)crow(r, hi) * 128] = acc[r];
    }
    __syncthreads();
}
__device__ __forceinline__ void gla_scan(const Frame& F, const Args& a) {
    int tid = F.wave * 64 + lane_id(); asm volatile("" : "+v"(tid));
    if (tid >= 256) return;
    for (int e = F.vcu * 256 + tid; e < 65536; e += F.G * 256) {
    const int bh = e >> 13, dk = (e >> 7) & 63, dv = e & 127;
    float* kv = (float*)(a.ws + WS_GKV) + ((size_t)bh * 128 * 64 + dk) * 128 + dv; const float* dc = (const float*)(a.ws + WS_GDEC) + (size_t)bh * 128 * 64 + dk;
    float S = 0.f;
    for (int n0 = 0; n0 < 128; n0 += 8) { float kvv[8], dd[8];
#pragma unroll
        for (int j = 0; j < 8; ++j) { kvv[j] = kv[(size_t)(n0 + j) * 8192]; dd[j] = dc[(size_t)(n0 + j) * 64]; }
#pragma unroll
        for (int j = 0; j < 8; ++j) { kv[(size_t)(n0 + j) * 8192] = S; S = dd[j] * S + kvv[j]; } }
    a.out[O_GSP + (size_t)bh * 8192 + dk * 128 + dv] = S;
    }
}
__device__ __forceinline__ float silu(float x) { return x / (1.f + __expf(-x)); }
__device__ __forceinline__ void gla_sample_unit(const Frame& F, const Args& a, int u) {
    unsigned char* ws = a.ws;
    const int bs = u >> 2, h = u & 3; const int row0 = TP + bs * LS;
    LAS float* LA = (LAS float*)F.lds; LAS float* BL = LA + 512; LAS float* QD = BL + 64; LAS float* KI = QD + 512; LAS float* KR = KI + 512; LAS float* ATT = KR + 512; LAS float* OP = ATT + 64; LAS float* VS = OP + 4096;
    gla_gate_tile(F, (const float*)(ws + WS_GG), (const float*)a.in[I_WG2], (const float*)a.in[I_BG], row0, h, 8, LA, VS + 1024);
#pragma unroll
    for (int i = 0; i < 2; ++i) { const int e = F.tid + NTHR * i; VS[e] = GLD(ws + WS_GV)[(size_t)(row0 + (e >> 7)) * 512 + h * 128 + (e & 127)]; }
    __syncthreads();
    if (F.tid < 64) { float run = 0.f;
#pragma unroll
        for (int t = 0; t < 8; ++t) { run += LA[t * 64 + F.tid]; LA[t * 64 + F.tid] = run; } BL[F.tid] = run; }
    __syncthreads();
    { const int e = F.tid, t = e >> 6, dk = e & 63; const float bb = LA[e];
      const float q = GLD(ws + WS_GQ)[(size_t)(row0 + t) * 256 + h * 64 + dk], k = GLD(ws + WS_GK)[(size_t)(row0 + t) * 256 + h * 64 + dk];
      QD[e] = q * __expf(bb); KI[e] = k * __expf(-bb); KR[e] = k * __expf(BL[dk] - bb); }
    __syncthreads();
    if (F.tid < 64) { const int t = F.tid >> 3, s = F.tid & 7; float acc = 0.f;
        if (s <= t) { for (int dk = 0; dk < 64; ++dk) acc += QD[t * 64 + dk] * KI[s * 64 + dk]; }
        ATT[F.tid] = acc; }
    const int dv = F.tid & 127, dkg = F.tid >> 7;
    {
        const float* st = (const float*)a.in[I_SGLA] + ((size_t)(bs * 4 + h) * 64 + dkg * 16) * 128 + dv;
        float S0[16];
#pragma unroll
        for (int i = 0; i < 16; ++i) S0[i] = st[(size_t)i * 128];
#pragma unroll
        for (int t = 0; t < 8; ++t) { float o = 0.f;
#pragma unroll
            for (int i = 0; i < 16; ++i) o += QD[t * 64 + dkg * 16 + i] * S0[i];
            OP[(dkg * 8 + t) * 128 + dv] = o; }
        float* so = a.out + O_GSS + ((size_t)(bs * 4 + h) * 64 + dkg * 16) * 128 + dv;
#pragma unroll
        for (int i = 0; i < 16; ++i) { float sn = __expf(BL[dkg * 16 + i]) * S0[i];
#pragma unroll
            for (int t = 0; t < 8; ++t) sn += KR[t * 64 + dkg * 16 + i] * VS[t * 128 + dv];
            so[(size_t)i * 128] = sn; }
    }
    __syncthreads();
    {
        const int t = F.wave; float o[2]; float ss = 0.f;
#pragma unroll
        for (int j = 0; j < 2; ++j) { const int d = 2 * F.lane + j; float v = OP[(0 * 8 + t) * 128 + d] + OP[(1 * 8 + t) * 128 + d] + OP[(2 * 8 + t) * 128 + d] + OP[(3 * 8 + t) * 128 + d];
            for (int s = 0; s <= t; ++s) v += ATT[t * 8 + s] * VS[s * 128 + d];
            o[j] = v; ss += v * v; }
        const float r = rsqrtf(wave_sum(ss) * (1.f / 128.f) + EPS);
        const float* ggo = (const float*)a.in[I_GGO] + h * 128 + 2 * F.lane; const BfPtr gr = GLD(ws + WS_GR) + ((size_t)(row0 + t) * 512 + h * 128 + 2 * F.lane);
        const float y0 = o[0] * r * ggo[0] * silu(gr[0]), y1 = o[1] * r * ggo[1] * silu(gr[1]);
        *(unsigned*)((bf16*)(ws + WS_MERGED) + (size_t)(row0 + t) * DM + 512 + h * 128 + 2 * F.lane) = pk2(y0, y1);
    }
    __syncthreads();
}


__device__ __forceinline__ float fexp2(float x) { return __builtin_amdgcn_exp2f(x); }
constexpr float FOX_SKIP = 160.f;


__device__ __forceinline__ void fox_norms_item(const Frame& F, const bf16* QF, const bf16* KF, const float* logf, float* FN, float* LC, float* BT, int item) {
    const int bh = item >> 5, qb = item & 31, b = bh >> 3, h = bh & 7;
    float qm = 0.f, km = 0.f;
    const float* lp = logf + ((size_t)b * SEQ + qb * 256 + 4 * F.lane) * 8 + h;
    const float l0 = lp[0], l1 = lp[8], l2 = lp[16], l3 = lp[24];
#pragma unroll
    for (int i = 0; i < 4; ++i) { const size_t row = (size_t)b * SEQ + qb * 256 + i * 64 + F.lane;
        const v4u* qp = (const v4u*)(QF + row * 512 + h * 64); const v4u* kp = (const v4u*)(KF + row * 512 + h * 64); float qs = 0.f, ks = 0.f;
#pragma unroll
        for (int c = 0; c < 8; ++c) { const v4u q = qp[c], k = kp[c];
#pragma unroll
            for (int j = 0; j < 4; ++j) { qs += bflo(q[j]) * bflo(q[j]) + bfhi(q[j]) * bfhi(q[j]); ks += bflo(k[j]) * bflo(k[j]) + bfhi(k[j]) * bfhi(k[j]); } }
        qm = fmaxf(qm, qs); km = fmaxf(km, ks); }
#pragma unroll
    for (int o = 1; o < 64; o <<= 1) { qm = fmaxf(qm, __shfl_xor(qm, o)); km = fmaxf(km, __shfl_xor(km, o)); }
    const float c0 = l0, c1 = c0 + l1, c2 = c1 + l2, c3 = c2 + l3; float v = c3;
#pragma unroll
    for (int o = 1; o < 64; o <<= 1) { const float t = __shfl_up(v, o); if (F.lane >= o) v += t; }
    const float ex = v - c3;
    *(f32x4*)(LC + (size_t)bh * SEQ + qb * 256 + 4 * F.lane) = (f32x4){ex + c0, ex + c1, ex + c2, ex + c3};
    if (F.lane == 63) BT[item] = v;
    if (F.lane == 0) { FN[item * 2] = qm; FN[item * 2 + 1] = km; }
}
__device__ __forceinline__ void fox_suffix_item(const Frame& F, const float* cfl, const int* pt, float* SW, float* PTOT, int item) {
    const int bs = item >> 4, p = item & 15; const int pg = __builtin_amdgcn_readfirstlane(pt[item]);
    const f32x4* src = (const f32x4*)(cfl + ((size_t)pg * PAGE + 2 * F.lane) * 8);
    const f32x4 a0 = src[0], a1 = src[1], b0 = src[2], b1 = src[3];
    const float ra[8] = {a0.x, a0.y, a0.z, a0.w, a1.x, a1.y, a1.z, a1.w}, rb[8] = {b0.x, b0.y, b0.z, b0.w, b1.x, b1.y, b1.z, b1.w};
#pragma unroll
    for (int h = 0; h < 8; ++h) {
        const float ps = ra[h] + rb[h]; float v = ps;
#pragma unroll
        for (int o = 1; o < 64; o <<= 1) { const float t = __shfl_down(v, o); if (F.lane + o < 64) v += t; }
        const float exs = v - ps;
        *(f32x2*)(SW + (size_t)(bs * 8 + h) * PASTL + p * PAGE + 2 * F.lane) = (f32x2){exs + rb[h], exs};
        if (F.lane == 0) PTOT[(bs * 8 + h) * NPAGES + p] = v;
    }
}
__device__ __forceinline__ void fox_attn_unit(const Frame& F, const bf16* QF, const bf16* KF, const bf16* VF, const float* LC, const float* BT, const float* FN, bf16* merged, int b, int h, int qb) {
    int tid = F.wave * 64 + lane_id(); asm volatile("" : "+v"(tid));
    const int lane = tid & 63, r32 = lane & 31, hi = lane >> 5, wid = F.wave;
    const size_t rowbase = (size_t)b * SEQ; const int q0 = qb * 256;
    LAS unsigned char* Ks = F.lds; LAS unsigned char* Vs = F.lds + 8192; LAS float* KBs = (LAS float*)(F.lds + 20480); LAS float* WSF = (LAS float*)(F.lds + 20736) + wid * 32;
    const bf16* Qw = QF + (rowbase + q0 + wid * 32 + r32) * 512 + h * 64;
    bf16x8 qr[4];
#pragma unroll
    for (int d0 = 0; d0 < 4; ++d0) qr[d0] = *(const bf16x8*)(Qw + d0 * 16 + hi * 8);
    const float* lcp = LC + (size_t)(b * 8 + h) * SEQ;
    float pbx; { const float btv = (lane < 32) ? BT[(b * 8 + h) * 32 + lane] : 0.f; float v = btv;
#pragma unroll
        for (int o = 1; o < 64; o <<= 1) { const float t = __shfl_up(v, o); if (lane >= o) v += t; }
        pbx = v - btv; }
    const float cref = lcp[q0] + __shfl(pbx, qb);
#define FOX_KB(t_, pos_) (-LOG2E * ((lcp[pos_] + __shfl(pbx, (t_) >> 2)) - cref))
    const int NT = (q0 + 256) / 64;
    int t0 = 0;
    {
        float kn = (lane < 32) ? FN[((b * 8 + h) * 32 + lane) * 2 + 1] : 0.f;
#pragma unroll
        for (int o = 1; o < 64; o <<= 1) kn = fmaxf(kn, __shfl_xor(kn, o));
        const float qk2 = 2.f * sqrtf(FN[((b * 8 + h) * 32 + qb) * 2]) * sqrtf(kn) * 1.01f;
        const int nbefore = q0 / 64;
        int found = -1;
        for (int base = 0; base < nbefore && found < 0; base += 64) {
            const int tl = nbefore - 1 - base - lane;
            const int tlc = tl < 0 ? 0 : tl; const float kbl = -LOG2E * ((lcp[tlc * 64 + 63] + __shfl(pbx, tlc >> 2)) - cref);
            const bool dead = (tl >= 0) && (qk2 + kbl < -FOX_SKIP);
            const unsigned long long bm = __ballot(dead);
            if (bm) found = nbefore - 1 - base - (int)__builtin_ctzll(bm);
        }
        t0 = found + 1;
        t0 = __builtin_amdgcn_readfirstlane(t0);
    }
    const int kkey = tid & 63, kch = tid >> 6, vkey = tid >> 3, vch = tid & 7;
    const bf16* ksrc = KF + (rowbase + kkey) * 512 + h * 64 + kch * 8;
    const bf16* vsrc = VF + (rowbase + vkey) * 512 + h * 64 + vch * 8;
    v4u kreg[2], vreg[2]; float kbreg[2];
#pragma unroll
    for (int hb = 0; hb < 2; ++hb) { const int tt = (t0 + hb < NT) ? t0 + hb : t0;
        kreg[hb] = *(const v4u*)(ksrc + (size_t)tt * 64 * 512); vreg[hb] = *(const v4u*)(vsrc + (size_t)tt * 64 * 512); kbreg[hb] = FOX_KB(tt, tt * 64 + (tid & 63)); }
    float m_run = -INFINITY, l_run = 0.f; f32x16 o0 = {}, o1 = {};
    const int qpos = q0 + wid * 32 + r32;
    const int vbase = (4 * hi + ((lane & 15) >> 2)) * 192 + (16 * ((lane >> 4) & 1) + 4 * (lane & 3)) * 2;
    LAS unsigned char* const Ks0 = Ks; LAS unsigned char* const Vs0 = Vs; LAS float* const KBs0 = KBs;
    __syncthreads();
    for (int t2 = t0; t2 < NT; t2 += 2) {
#pragma unroll
      for (int hb = 0; hb < 2; ++hb) {
        const int t = t2 + hb;
        if (t < NT) {
        LAS unsigned char* const Ks = Ks0 + hb * 28672; LAS unsigned char* const Vs = Vs0 + hb * 28672; LAS float* const KBs = (LAS float*)((LAS unsigned char*)KBs0 + hb * 28672);
        *(LAS v4u*)(Ks + kch * 1024 + kkey * 16) = kreg[hb]; *(LAS v4u*)(Vs + vkey * 192 + vch * 16) = vreg[hb]; if (tid < 64) KBs[tid] = kbreg[hb];
        __syncthreads();
        if (t + 2 < NT) { kreg[hb] = *(const v4u*)(ksrc + (size_t)(t + 2) * 64 * 512); vreg[hb] = *(const v4u*)(vsrc + (size_t)(t + 2) * 64 * 512); kbreg[hb] = FOX_KB(t + 2, (t + 2) * 64 + (tid & 63)); }
        const int k0 = t * 64;
        if (k0 <= q0 + wid * 32 + 31) {
        f32x16 p0, p1;
#pragma unroll
        for (int g = 0; g < 4; ++g) { const f32x4 ba = *(const LAS f32x4*)(KBs + 8 * g + 4 * hi), bb = *(const LAS f32x4*)(KBs + 32 + 8 * g + 4 * hi);
#pragma unroll
            for (int i = 0; i < 4; ++i) { p0[4 * g + i] = ba[i]; p1[4 * g + i] = bb[i]; } }
#pragma unroll
        for (int d0 = 0; d0 < 4; ++d0) {
            const bf16x8 a0 = *(const LAS bf16x8*)(Ks + (2 * d0 + hi) * 1024 + r32 * 16), a1 = *(const LAS bf16x8*)(Ks + (2 * d0 + hi) * 1024 + r32 * 16 + 512);
            p0 = __builtin_amdgcn_mfma_f32_32x32x16_bf16(a0, qr[d0], p0, 0, 0, 0); p1 = __builtin_amdgcn_mfma_f32_32x32x16_bf16(a1, qr[d0], p1, 0, 0, 0);
        }
        if (k0 + 63 > q0 + wid * 32) {
#pragma unroll
            for (int r = 0; r < 16; ++r) { const int key = k0 + crow(r, hi); if (key > qpos) p0[r] = -INFINITY; if (key + 32 > qpos) p1[r] = -INFINITY; }
        }
        float mx = fmaxf(p0[0], p1[0]);
#pragma unroll
        for (int r = 1; r < 16; ++r) mx = fmaxf(mx, fmaxf(p0[r], p1[r]));
        mx = fmaxf(mx, __shfl_xor(mx, 32));
        const float m_new = fmaxf(m_run, mx), alpha = fexp2(m_run - m_new); m_run = m_new;
        float ls = 0.f;
#pragma unroll
        for (int r = 0; r < 16; ++r) { p0[r] = fexp2(p0[r] - m_new); p1[r] = fexp2(p1[r] - m_new); ls += p0[r] + p1[r]; }
        l_run = l_run * alpha + ls;
        if (__ballot(alpha != 1.f) != 0ull) {
            if (hi == 0) WSF[r32] = alpha;
#pragma unroll
            for (int g = 0; g < 4; ++g) { const f32x4 al = *(const LAS f32x4*)(WSF + 8 * g + 4 * hi);
#pragma unroll
                for (int i = 0; i < 4; ++i) { o0[4 * g + i] *= al[i]; o1[4 * g + i] *= al[i]; } }
        }
        v4u pw[4];
#pragma unroll
        for (int j = 0; j < 4; ++j) { pw[0][j] = pg8::cvt_pk_bf16(p0[2 * j], p0[2 * j + 1]); pw[1][j] = pg8::cvt_pk_bf16(p0[8 + 2 * j], p0[8 + 2 * j + 1]);
                                      pw[2][j] = pg8::cvt_pk_bf16(p1[2 * j], p1[2 * j + 1]); pw[3][j] = pg8::cvt_pk_bf16(p1[8 + 2 * j], p1[8 + 2 * j + 1]); }
#pragma unroll
        for (int ks = 0; ks < 4; ++ks) {
            const bf16x8 pa = __builtin_bit_cast(bf16x8, pw[ks]);
#pragma unroll
            for (int d0 = 0; d0 < 2; ++d0) {
                const s16x4 lo = lds_tr16(Vs + vbase + ks * 16 * 192 + d0 * 64), hi4 = lds_tr16(Vs + vbase + ks * 16 * 192 + 8 * 192 + d0 * 64);
                const bf16x8 vb = (bf16x8){lo[0], lo[1], lo[2], lo[3], hi4[0], hi4[1], hi4[2], hi4[3]};
                if (d0 == 0) o0 = __builtin_amdgcn_mfma_f32_32x32x16_bf16(pa, vb, o0, 0, 0, 0); else o1 = __builtin_amdgcn_mfma_f32_32x32x16_bf16(pa, vb, o1, 0, 0, 0);
            }
        }
        }
        }
      }
    }
    l_run += __shfl_xor(l_run, 32);
    if (hi == 0) WSF[r32] = 1.f / l_run;
    bf16* Ow = merged + (rowbase + q0 + wid * 32) * DM + h * 64 + r32;
#pragma unroll
    for (int g = 0; g < 4; ++g) { const f32x4 rl = *(const LAS f32x4*)(WSF + 8 * g + 4 * hi);
#pragma unroll
        for (int i = 0; i < 4; ++i) { const int r = 4 * g + i; const int row = crow(r, hi);
            Ow[(size_t)row * DM] = (bf16)f2bf(o0[r] * rl[i]); Ow[(size_t)row * DM + 32] = (bf16)f2bf(o1[r] * rl[i]); } }
    __syncthreads();
#undef FOX_KB
}

template <int D> struct DecW {
    static constexpr int KS = D / 32;
    static constexpr int LPK = D / 4;
    static constexpr int KPI = 64 / LPK;
    float m[4], l[4]; float o[8][4];
};
template <int D>
__device__ __forceinline__ void dec_init(DecW<D>& w) {
#pragma unroll
    for (int i = 0; i < 4; ++i) { w.m[i] = -INFINITY; w.l[i] = 0.f; }
#pragma unroll
    for (int q = 0; q < 8; ++q)
#pragma unroll
        for (int j = 0; j < 4; ++j) w.o[q][j] = 0.f;
}
template <int D, int NTILE, int MODE>
__device__ __forceinline__ void dec_chunk(DecW<D>& w, const bf16x8 (&qa)[D / 32], const float* Kb, const float* Vb, int stride, const float* bias, float nb, LAS float* PL, int lane) {
    constexpr int KS = D / 32, LPK = D / 4, KPI = 64 / LPK;
    constexpr int NK = (MODE == 1) ? 8 : NTILE * 16, NV = NK / KPI;
    const int key = lane & 15, kq = lane >> 4;
    const unsigned koff = (unsigned)(key * stride + 8 * kq) * 4u;
    const int d4 = lane % LPK, ksub = lane / LPK;
    const unsigned voff = (unsigned)(ksub * stride + 4 * d4) * 4u;
    f32x4 kx[NTILE][2 * KS], vx[NV];
#pragma unroll
    for (int t = 0; t < NTILE; ++t) { const char* kp = (const char*)(Kb + (size_t)t * 16 * stride) + koff;
#pragma unroll
        for (int ks = 0; ks < KS; ++ks) { kx[t][2 * ks] = *(const f32x4*)(kp + 128 * ks); kx[t][2 * ks + 1] = *(const f32x4*)(kp + 128 * ks + 16); } }
    constexpr int NVA = (NV >= 8) ? NV / 2 : NV;
#pragma unroll
    for (int kk = 0; kk < NVA; ++kk) vx[kk] = *(const f32x4*)((const char*)(Vb + (size_t)kk * KPI * stride) + voff);
    f32x4 s[NTILE];
#pragma unroll
    for (int t = 0; t < NTILE; ++t) {
        f32x4 acc = {0.f, 0.f, 0.f, 0.f};
#pragma unroll
        for (int ks = 0; ks < KS; ++ks) { const f32x4 x0 = kx[t][2 * ks], x1 = kx[t][2 * ks + 1];
            v4u kb; kb.x = pg8::cvt_pk_bf16(x0.x, x0.y); kb.y = pg8::cvt_pk_bf16(x0.z, x0.w); kb.z = pg8::cvt_pk_bf16(x1.x, x1.y); kb.w = pg8::cvt_pk_bf16(x1.z, x1.w);
            acc = __builtin_amdgcn_mfma_f32_16x16x32_bf16(qa[ks], __builtin_bit_cast(bf16x8, kb), acc, 0, 0, 0); }
        if (MODE == 0) { if (bias) { const float bv = (bias[t * 16 + key] + nb) * LOG2E; acc += bv; } }
        else { acc += nb;
#pragma unroll
            for (int i = 0; i < 4; ++i) if (key > 4 * kq + i || key >= 8) acc[i] = -INFINITY; }
        s[t] = acc;
    }
#pragma unroll
    for (int kk = NVA; kk < NV; ++kk) vx[kk] = *(const f32x4*)((const char*)(Vb + (size_t)kk * KPI * stride) + voff);
    f32x4 mc = s[0];
#pragma unroll
    for (int t = 1; t < NTILE; ++t) { mc.x = fmaxf(mc.x, s[t].x); mc.y = fmaxf(mc.y, s[t].y); mc.z = fmaxf(mc.z, s[t].z); mc.w = fmaxf(mc.w, s[t].w); }
#pragma unroll
    for (int o = 1; o < 16; o <<= 1) { mc.x = fmaxf(mc.x, __shfl_xor(mc.x, o)); mc.y = fmaxf(mc.y, __shfl_xor(mc.y, o)); mc.z = fmaxf(mc.z, __shfl_xor(mc.z, o)); mc.w = fmaxf(mc.w, __shfl_xor(mc.w, o)); }
    float al[4];
#pragma unroll
    for (int i = 0; i < 4; ++i) { const float mn = fmaxf(w.m[i], mc[i]); al[i] = (mn == -INFINITY) ? 1.f : fexp2(w.m[i] - mn); w.m[i] = mn; w.l[i] *= al[i]; }
#pragma unroll
    for (int t = 0; t < NTILE; ++t) { f32x4 p;
#pragma unroll
        for (int i = 0; i < 4; ++i) { p[i] = (w.m[i] == -INFINITY) ? 0.f : fexp2(s[t][i] - w.m[i]); w.l[i] += p[i]; }
        if (kq < 2) *(LAS f32x4*)(PL + (t * 16 + key) * 8 + 4 * kq) = p; }
    if (key == 0 && kq < 2) *(LAS f32x4*)(PL + 1024 + 4 * kq) = (f32x4){al[0], al[1], al[2], al[3]};
    { const f32x4 a0 = *(const LAS f32x4*)(PL + 1024), a1 = *(const LAS f32x4*)(PL + 1028);
#pragma unroll
      for (int j = 0; j < 4; ++j) { w.o[0][j] *= a0.x; w.o[1][j] *= a0.y; w.o[2][j] *= a0.z; w.o[3][j] *= a0.w; w.o[4][j] *= a1.x; w.o[5][j] *= a1.y; w.o[6][j] *= a1.z; w.o[7][j] *= a1.w; } }
#pragma unroll
    for (int kk = 0; kk < NV; ++kk) { const int k = kk * KPI + ksub;
        const f32x4 v = vx[kk];
        const f32x4 pa = *(const LAS f32x4*)(PL + k * 8), pb = *(const LAS f32x4*)(PL + k * 8 + 4);
#pragma unroll
        for (int j = 0; j < 4; ++j) { w.o[0][j] += pa.x * v[j]; w.o[1][j] += pa.y * v[j]; w.o[2][j] += pa.z * v[j]; w.o[3][j] += pa.w * v[j];
                                      w.o[4][j] += pb.x * v[j]; w.o[5][j] += pb.y * v[j]; w.o[6][j] += pb.z * v[j]; w.o[7][j] += pb.w * v[j]; } }
}
__device__ __forceinline__ void dec_page_fox(DecW<64>& w, const bf16x8 (&qa)[2], const float* Kb, const float* Vb, const float* bias, float boff, LAS float* PL, int lane) {
    constexpr int stride = 512;
    const int key = lane & 15, kq = lane >> 4;
    const unsigned koff = (unsigned)(key * stride + 8 * kq) * 4u;
    const int d4 = lane & 15, ksub = lane >> 4;
    const unsigned voff = (unsigned)(ksub * stride + 4 * d4) * 4u;
    const __amdgpu_buffer_rsrc_t krs = __builtin_amdgcn_make_buffer_rsrc((void*)Kb, 0, 0x7fffffff, 0x00020000);
    const __amdgpu_buffer_rsrc_t vrs = __builtin_amdgcn_make_buffer_rsrc((void*)Vb, 0, 0x7fffffff, 0x00020000);
    const __amdgpu_buffer_rsrc_t brs = __builtin_amdgcn_make_buffer_rsrc((void*)bias, 0, 0x7fffffff, 0x00020000);
    f32x4 s[8];
#pragma unroll
    for (int hb = 0; hb < 2; ++hb) {
        f32x4 kx[4][4];
#pragma unroll
        for (int t = 0; t < 4; ++t) { const int so = (hb * 4 + t) * 16 * stride * 4;
            kx[t][0] = __builtin_bit_cast(f32x4, __builtin_amdgcn_raw_buffer_load_b128(krs, (int)koff, so, 0)); kx[t][1] = __builtin_bit_cast(f32x4, __builtin_amdgcn_raw_buffer_load_b128(krs, (int)koff + 16, so, 0));
            kx[t][2] = __builtin_bit_cast(f32x4, __builtin_amdgcn_raw_buffer_load_b128(krs, (int)koff + 128, so, 0)); kx[t][3] = __builtin_bit_cast(f32x4, __builtin_amdgcn_raw_buffer_load_b128(krs, (int)koff + 144, so, 0)); }
#pragma unroll
        for (int t = 0; t < 4; ++t) {
            f32x4 acc = {0.f, 0.f, 0.f, 0.f};
#pragma unroll
            for (int ks = 0; ks < 2; ++ks) { const f32x4 x0 = kx[t][2 * ks], x1 = kx[t][2 * ks + 1];
                v4u kb; kb.x = pg8::cvt_pk_bf16(x0.x, x0.y); kb.y = pg8::cvt_pk_bf16(x0.z, x0.w); kb.z = pg8::cvt_pk_bf16(x1.x, x1.y); kb.w = pg8::cvt_pk_bf16(x1.z, x1.w);
                acc = __builtin_amdgcn_mfma_f32_16x16x32_bf16(qa[ks], __builtin_bit_cast(bf16x8, kb), acc, 0, 0, 0); }
            acc += (__builtin_bit_cast(float, __builtin_amdgcn_raw_buffer_load_b32(brs, key * 4, (hb * 4 + t) * 64, 0)) + boff) * LOG2E;
            s[hb * 4 + t] = acc;
        }
        asm volatile("" ::: "memory");
    }
    f32x4 mc = s[0];
#pragma unroll
    for (int t = 1; t < 8; ++t) { mc.x = fmaxf(mc.x, s[t].x); mc.y = fmaxf(mc.y, s[t].y); mc.z = fmaxf(mc.z, s[t].z); mc.w = fmaxf(mc.w, s[t].w); }
#pragma unroll
    for (int o = 1; o < 16; o <<= 1) { mc.x = fmaxf(mc.x, __shfl_xor(mc.x, o)); mc.y = fmaxf(mc.y, __shfl_xor(mc.y, o)); mc.z = fmaxf(mc.z, __shfl_xor(mc.z, o)); mc.w = fmaxf(mc.w, __shfl_xor(mc.w, o)); }
    float al[4];
#pragma unroll
    for (int i = 0; i < 4; ++i) { const float mn = fmaxf(w.m[i], mc[i]); al[i] = fexp2(w.m[i] - mn); w.m[i] = mn; w.l[i] *= al[i]; }
    bool nz = false;
#pragma unroll
    for (int t = 0; t < 8; ++t) { f32x4 p;
#pragma unroll
        for (int i = 0; i < 4; ++i) { p[i] = fexp2(s[t][i] - w.m[i]); w.l[i] += p[i]; nz = nz || (p[i] != 0.f); }
        if (kq < 2) *(LAS f32x4*)(PL + (t * 16 + key) * 8 + 4 * kq) = p; }
    if (__ballot(nz && kq < 2) == 0ull) return;
    if (key == 0 && kq < 2) *(LAS f32x4*)(PL + 1024 + 4 * kq) = (f32x4){al[0], al[1], al[2], al[3]};
    { const f32x4 a0 = *(const LAS f32x4*)(PL + 1024), a1 = *(const LAS f32x4*)(PL + 1028);
#pragma unroll
      for (int j = 0; j < 4; ++j) { w.o[0][j] *= a0.x; w.o[1][j] *= a0.y; w.o[2][j] *= a0.z; w.o[3][j] *= a0.w; w.o[4][j] *= a1.x; w.o[5][j] *= a1.y; w.o[6][j] *= a1.z; w.o[7][j] *= a1.w; } }
#pragma unroll 1
    for (int vh = 0; vh < 2; ++vh) {
    f32x4 vx[16];
#pragma unroll
    for (int kk = 0; kk < 16; ++kk) vx[kk] = __builtin_bit_cast(f32x4, __builtin_amdgcn_raw_buffer_load_b128(vrs, (int)voff, (vh * 16 + kk) * 4 * stride * 4, 0));
#pragma unroll
    for (int kk = 0; kk < 16; ++kk) { const int k = (vh * 16 + kk) * 4 + ksub;
        const f32x4 v = vx[kk];
        const f32x4 pa = *(const LAS f32x4*)(PL + k * 8), pb = *(const LAS f32x4*)(PL + k * 8 + 4);
#pragma unroll
        for (int j = 0; j < 4; ++j) { w.o[0][j] += pa.x * v[j]; w.o[1][j] += pa.y * v[j]; w.o[2][j] += pa.z * v[j]; w.o[3][j] += pa.w * v[j];
                                      w.o[4][j] += pb.x * v[j]; w.o[5][j] += pb.y * v[j]; w.o[6][j] += pb.z * v[j]; w.o[7][j] += pb.w * v[j]; } }
    }
}
template <int D>
__device__ __forceinline__ void dec_park(DecW<D>& w, LAS float* CBw, int lane) {
    constexpr int LPK = D / 4;
    const int key = lane & 15, kq = lane >> 4, d4 = lane % LPK, ksub = lane / LPK;
#pragma unroll
    for (int i = 0; i < 4; ++i) { float l = w.l[i];
#pragma unroll
        for (int o = 1; o < 16; o <<= 1) l += __shfl_xor(l, o);
        w.l[i] = l; }
    if (key == 0 && kq < 2) { *(LAS f32x4*)(CBw + 4 * kq) = (f32x4){w.m[0], w.m[1], w.m[2], w.m[3]}; *(LAS f32x4*)(CBw + 8 + 4 * kq) = (f32x4){w.l[0], w.l[1], w.l[2], w.l[3]}; }
#pragma unroll
    for (int q = 0; q < 8; ++q) { f32x4 v = (f32x4){w.o[q][0], w.o[q][1], w.o[q][2], w.o[q][3]};
        if (LPK < 64) {
#pragma unroll
            for (int o = LPK; o < 64; o <<= 1) { v.x += __shfl_xor(v.x, o); v.y += __shfl_xor(v.y, o); v.z += __shfl_xor(v.z, o); v.w += __shfl_xor(v.w, o); } }
        if (ksub == 0) *(LAS f32x4*)(CBw + 16 + q * D + 4 * d4) = v; }
}
template <int D>
__device__ __forceinline__ void dec_combine(int tid, LAS float* CB, bf16* dst, int ldd) {
    constexpr int WSTR = 16 + 8 * D;
    for (int e = tid; e < 8 * D; e += NTHR) { const int q = e / D, d = e % D;
        float mt = -INFINITY;
#pragma unroll
        for (int w = 0; w < 8; ++w) mt = fmaxf(mt, CB[w * WSTR + q]);
        float num = 0.f, den = 0.f;
#pragma unroll
        for (int w = 0; w < 8; ++w) { const float mw = CB[w * WSTR + q]; const float f = (mw == -INFINITY) ? 0.f : fexp2(mw - mt); num += f * CB[w * WSTR + 16 + q * D + d]; den += f * CB[w * WSTR + 8 + q]; }
        dst[(size_t)q * ldd + d] = (bf16)f2bf(num / den); }
}
template <int D>
__device__ __forceinline__ void dec_load_q(bf16x8 (&qa)[D / 32], const bf16* Q, int ldq, int lane) {
    const int row = lane & 15, kq = lane >> 4;
#pragma unroll
    for (int ks = 0; ks < D / 32; ++ks) { v4u z = {0u, 0u, 0u, 0u}; if (row < 8) z = *(const v4u*)(Q + (size_t)row * ldq + 32 * ks + 8 * kq); qa[ks] = __builtin_bit_cast(bf16x8, z); }
}
constexpr int DEC_PL = 1040;
__device__ __forceinline__ void fox_sample_unit(const Frame& F, const Args& a, int u) {
    unsigned char* ws = a.ws; const int bs = u >> 3, h = u & 7;
    int ln = lane_id(); asm volatile("" : "+v"(ln));
    LAS float* PL = (LAS float*)F.lds + F.wave * DEC_PL; LAS float* CB = (LAS float*)F.lds + 8 * DEC_PL; constexpr int WSTR = 16 + 8 * 64;
    bf16x8 qa[2]; dec_load_q<64>(qa, (const bf16*)(ws + WS_QF) + (size_t)(TP + bs * LS) * 512 + h * 64, 512, ln);
    DecW<64> w; dec_init(w);
    {
        const int key = ln & 15; const float* lf = a.out + O_LFS + (size_t)(bs * LS) * 8 + h; float cn = 0.f;
#pragma unroll
        for (int j = 0; j < 8; ++j) { const float x = lf[j * 8]; cn += (j <= key) ? x : 0.f; }
        const float* Kb = a.out + O_FKS + (size_t)(bs * LS) * 512 + h * 64; const float* Vb = a.out + O_FVS + (size_t)(bs * LS) * 512 + h * 64;
        dec_chunk<64, 1, 1>(w, qa, Kb, Vb, 512, nullptr, -cn * LOG2E, PL, ln);
        if (F.wave != 0) {
#pragma unroll
            for (int i = 0; i < 4; ++i) w.l[i] = 0.f;
#pragma unroll
            for (int q = 0; q < 8; ++q)
#pragma unroll
                for (int j = 0; j < 4; ++j) w.o[q][j] = 0.f; }
    }
    const int* pt = (const int*)a.in[I_PT];
    float spx; { const float ptv = (ln < 16) ? ((const float*)(ws + WS_MISC + 2 * MiB))[(bs * 8 + h) * NPAGES + ln] : 0.f; float v = ptv;
#pragma unroll
        for (int o = 1; o < 16; o <<= 1) { const float t = __builtin_bit_cast(float, __builtin_amdgcn_ds_bpermute((ln + o) << 2, __builtin_bit_cast(int, v))); if (ln + o < 16) v += t; }
        spx = v - ptv; }
#if defined(OLD_FOXS)
#pragma unroll 1
    for (int pp = 0; pp < 4; ++pp) { const int p = F.wave * 2 + (pp >> 1), hf = pp & 1; const int pg = __builtin_amdgcn_readfirstlane(pt[bs * NPAGES + p]);
        const float* Kb = (const float*)a.in[I_CFK] + (((size_t)pg * PAGE + hf * 64) * 8 + h) * 64; const float* Vb = (const float*)a.in[I_CFV] + (((size_t)pg * PAGE + hf * 64) * 8 + h) * 64;
        dec_chunk<64, 4, 0>(w, qa, Kb, Vb, 512, (const float*)(ws + WS_SUF) + (size_t)(bs * 8 + h) * PASTL + p * PAGE + hf * 64, __builtin_bit_cast(float, __builtin_amdgcn_ds_bpermute(p << 2, __builtin_bit_cast(int, spx))), PL, ln); }
#else
#pragma unroll 1
    for (int pp = 1; pp >= 0; --pp) { const int p = pp ? (NPAGES - 1 - F.wave) : F.wave;
        const int pg = __builtin_amdgcn_readfirstlane(pt[bs * NPAGES + p]);
        const float* Kb = (const float*)a.in[I_CFK] + ((size_t)pg * PAGE * 8 + h) * 64; const float* Vb = (const float*)a.in[I_CFV] + ((size_t)pg * PAGE * 8 + h) * 64;
        dec_page_fox(w, qa, Kb, Vb, (const float*)(ws + WS_SUF) + (size_t)(bs * 8 + h) * PASTL + p * PAGE, __builtin_bit_cast(float, __builtin_amdgcn_ds_bpermute(p << 2, __builtin_bit_cast(int, spx))), PL, ln); }
#endif
    dec_park<64>(w, CB + F.wave * WSTR, ln);
    __syncthreads();
    dec_combine<64>(F.wave * 64 + ln, CB, (bf16*)(ws + WS_MERGED) + (size_t)(TP + bs * LS) * DM + h * 64, DM);
    __syncthreads();
}
__device__ __forceinline__ void cross_sample_unit(const Frame& F, const Args& a, int u) {
    unsigned char* ws = a.ws; const int bs = u >> 2, h = u & 3;
    LAS float* PL = (LAS float*)F.lds + F.wave * DEC_PL; LAS float* CB = (LAS float*)F.lds + 8 * DEC_PL; constexpr int WSTR = 16 + 8 * 256;
    bf16x8 qa[8]; dec_load_q<256>(qa, (const bf16*)(ws + WS_QC) + (size_t)(TP + bs * LS) * DM + h * 256, DM, F.lane);
    DecW<256> w; dec_init(w);
    const float* Kb = (const float*)a.in[I_CMK] + ((size_t)(bs * 256 + F.wave * 32) * 4 + h) * 256; const float* Vb = (const float*)a.in[I_CMV] + ((size_t)(bs * 256 + F.wave * 32) * 4 + h) * 256;
#pragma unroll 1
    for (int c = 0; c < 2; ++c) dec_chunk<256, 1, 0>(w, qa, Kb + (size_t)c * 16 * 1024, Vb + (size_t)c * 16 * 1024, 1024, nullptr, 0.f, PL, F.lane);
    dec_park<256>(w, CB + F.wave * WSTR, F.lane);
    __syncthreads();
    dec_combine<256>(F.tid, CB, (bf16*)(ws + WS_OC) + (size_t)(TP + bs * LS) * DM + h * 256, DM);
    __syncthreads();
}


__device__ __forceinline__ void gla_g3_unit(const Frame& F, const Args& a, int u) {
    unsigned char* ws = a.ws;
    const int b = u >> 9, h = (u >> 7) & 3, n = u & 127; const int row0 = b * SEQ + n * 64;
    LAS unsigned char* KIB = F.lds; LAS unsigned char* ATTB = F.lds + 34816; LAS unsigned char* QDB = F.lds + 44032;
    LAS unsigned char* VSB = F.lds + 53248; LAS unsigned char* SPB = F.lds + 73728; LAS float* OS = (LAS float*)(F.lds + 94208);
#pragma unroll
    for (int i = 0; i < 2; ++i) { const int c = F.tid + NTHR * i; *(LAS v4u*)(VSB + (c >> 4) * 320 + (c & 15) * 16) = *(const v4u*)((const bf16*)(ws + WS_GV) + (size_t)(row0 + (c >> 4)) * 512 + h * 128 + (c & 15) * 8); }
#pragma unroll
    for (int i = 0; i < 4; ++i) { const int c4 = F.tid + NTHR * i; const f32x4 sp = *(const f32x4*)((const float*)(ws + WS_GKV) + ((size_t)((b * 4 + h) * 128 + n) * 64) * 128 + 4 * c4);
        v2u o; o.x = pg8::cvt_pk_bf16(sp.x, sp.y); o.y = pg8::cvt_pk_bf16(sp.z, sp.w); *(LAS v2u*)(SPB + (c4 >> 5) * 320 + (c4 & 31) * 8) = o; }
#pragma unroll
    for (int i = 0; i < 2; ++i) { const int c4 = F.tid + NTHR * i, t = c4 >> 4, d4 = (c4 & 15) * 4; const size_t gi = (size_t)(row0 + t) * 256 + h * 64 + d4;
        const f32x4 bb = *(const f32x4*)((const float*)(ws + WS_BB) + gi);
        const v2u qq = *(const v2u*)((const bf16*)(ws + WS_GQ) + gi), kk = *(const v2u*)((const bf16*)(ws + WS_GK) + gi);
        v2u qo, ko; qo.x = pg8::cvt_pk_bf16(bflo(qq.x) * __expf(bb.x), bfhi(qq.x) * __expf(bb.y)); qo.y = pg8::cvt_pk_bf16(bflo(qq.y) * __expf(bb.z), bfhi(qq.y) * __expf(bb.w));
        ko.x = pg8::cvt_pk_bf16(bflo(kk.x) * __expf(-bb.x), bfhi(kk.x) * __expf(-bb.y)); ko.y = pg8::cvt_pk_bf16(bflo(kk.y) * __expf(-bb.z), bfhi(kk.y) * __expf(-bb.w));
        *(LAS v2u*)(QDB + t * 144 + d4 * 2) = qo; *(LAS v2u*)(KIB + t * 144 + d4 * 2) = ko; }
    __syncthreads();
    {
        const int lane = F.lane, r32 = lane & 31, hi = lane >> 5;
        if (F.wave < 4) { const int tb = F.wave >> 1, sb = F.wave & 1; f32x16 acc = {};
            if (sb <= tb) {
                const LAS unsigned char* qrow = QDB + (32 * tb + r32) * 144; const LAS unsigned char* krow = KIB + (32 * sb + r32) * 144;
#pragma unroll
                for (int ks = 0; ks < 4; ++ks) acc = __builtin_amdgcn_mfma_f32_32x32x16_bf16(row_frag(qrow, ks, hi), row_frag(krow, ks, hi), acc, 0, 0, 0);
            }
#pragma unroll
            for (int r = 0; r < 16; ++r) { const int t = 32 * tb + crow(r, hi), s2 = 32 * sb + r32; *(LAS unsigned short*)(ATTB + t * 144 + s2 * 2) = (unsigned short)f2bf(s2 <= t ? acc[r] : 0.f); }
        }
    }
    __syncthreads();
    {
        const int lane = F.lane, r32 = lane & 31, hi = lane >> 5, tb = F.wave >> 2, nb = F.wave & 3;
        const int trb = (4 * hi + ((lane & 15) >> 2)) * 320 + (16 * ((lane >> 4) & 1) + 4 * (lane & 3)) * 2 + 64 * nb;
        const LAS unsigned char* arow = ATTB + (32 * tb + r32) * 144; const LAS unsigned char* qrow = QDB + (32 * tb + r32) * 144;
        f32x16 acc = {};
#pragma unroll
        for (int ks = 0; ks < 4; ++ks) acc = __builtin_amdgcn_mfma_f32_32x32x16_bf16(row_frag(arow, ks, hi), tr_frag<320>(VSB + trb, ks), acc, 0, 0, 0);
#pragma unroll
        for (int ks = 0; ks < 4; ++ks) acc = __builtin_amdgcn_mfma_f32_32x32x16_bf16(row_frag(qrow, ks, hi), tr_frag<320>(SPB + trb, ks), acc, 0, 0, 0);
#pragma unroll
        for (int r = 0; r < 16; ++r) OS[(32 * tb + crow(r, hi)) * 128 + 32 * nb + r32] = acc[r];
    }
    __syncthreads();
#pragma unroll
    for (int rr = 0; rr < 8; ++rr) { const int t = F.wave * 8 + rr; const float v0 = OS[t * 128 + F.lane], v1 = OS[t * 128 + 64 + F.lane];
        const float r = rsqrtf(wave_sum(v0 * v0 + v1 * v1) * (1.f / 128.f) + EPS);
        const float* ggo = (const float*)a.in[I_GGO] + h * 128; const BfPtr gr = GLD(ws + WS_GR) + ((size_t)(row0 + t) * 512 + h * 128);
        bf16* mo = (bf16*)(ws + WS_MERGED) + (size_t)(row0 + t) * DM + 512 + h * 128;
        mo[F.lane] = (bf16)f2bf(v0 * r * ggo[F.lane] * silu(gr[F.lane])); mo[64 + F.lane] = (bf16)f2bf(v1 * r * ggo[64 + F.lane] * silu(gr[64 + F.lane])); }
    __syncthreads();
}

struct EpiSoftmaxP {
    static constexpr bool PERM = false, AFTER_DRAIN = true;
    const LAS unsigned long long* argp;
    __device__ __forceinline__ void fused(f32x4 (&acc)[2][2][4][2], const Unit&, int wr, int wc, int fr, int fq, PG8_LAS unsigned char* lds, int wid, int lane) const {
        LAS float* PM = (LAS float*)lds; LAS float* PS = PM + 1024;
        const int ub = (int)blockIdx.x; const int ldp = DM;
        bf16* P = (bf16*)((unsigned char*)ld_ptr(argp + N_INPUTS + 1) + WS_PC) + ((size_t)((ub >> 7) & 1) * SEQ + (ub & 31) * 256) * DM + ((ub >> 5) & 3) * 256;
        { int t2 = lane_id(); asm volatile("" : "+v"(t2)); fr = t2 & 15; fq = (t2 >> 4) & 3; }
#pragma unroll
        for (int ai = 0; ai < 2; ++ai)
#pragma unroll
            for (int m = 0; m < 4; ++m) { float mx = -INFINITY;
#pragma unroll
                for (int bj = 0; bj < 2; ++bj)
#pragma unroll
                    for (int n = 0; n < 2; ++n) { const f32x4 x = acc[ai][bj][m][n]; mx = fmaxf(mx, fmaxf(fmaxf(x[0], x[1]), fmaxf(x[2], x[3]))); }
                mx = fmaxf(mx, __shfl_xor(mx, 16)); mx = fmaxf(mx, __shfl_xor(mx, 32));
                if (fq == 0) PM[(ai * 128 + wr * 64 + m * 16 + fr) * 4 + wc] = mx; }
        asm volatile("s_waitcnt lgkmcnt(0)" ::: "memory"); __builtin_amdgcn_s_barrier(); asm volatile("" ::: "memory");
#pragma unroll
        for (int ai = 0; ai < 2; ++ai)
#pragma unroll
            for (int m = 0; m < 4; ++m) { const int r = ai * 128 + wr * 64 + m * 16 + fr; const f32x4 pm = *(const LAS f32x4*)(PM + r * 4);
                const float M = fmaxf(fmaxf(pm[0], pm[1]), fmaxf(pm[2], pm[3])); float s = 0.f;
#pragma unroll
                for (int bj = 0; bj < 2; ++bj)
#pragma unroll
                    for (int n = 0; n < 2; ++n) { f32x4 x = acc[ai][bj][m][n]; x[0] = fexp2(x[0] - M); x[1] = fexp2(x[1] - M); x[2] = fexp2(x[2] - M); x[3] = fexp2(x[3] - M); acc[ai][bj][m][n] = x; s += (x[0] + x[1]) + (x[2] + x[3]); }
                s += __shfl_xor(s, 16); s += __shfl_xor(s, 32);
                if (fq == 0) PS[r * 4 + wc] = s; }
        asm volatile("s_waitcnt lgkmcnt(0)" ::: "memory"); __builtin_amdgcn_s_barrier(); asm volatile("" ::: "memory");
#pragma unroll
        for (int ai = 0; ai < 2; ++ai)
#pragma unroll
            for (int m = 0; m < 4; ++m) { const int r = ai * 128 + wr * 64 + m * 16 + fr; const f32x4 ps = *(const LAS f32x4*)(PS + r * 4); const float inv = 1.f / ((ps[0] + ps[1]) + (ps[2] + ps[3]));
#pragma unroll
                for (int bj = 0; bj < 2; ++bj)
#pragma unroll
                    for (int n = 0; n < 2; ++n) { const f32x4 x = acc[ai][bj][m][n]; v2u o; o.x = pg8::cvt_pk_bf16(x[0] * inv, x[1] * inv); o.y = pg8::cvt_pk_bf16(x[2] * inv, x[3] * inv);
                        *(v2u*)(P + (size_t)r * ldp + bj * 128 + wc * 32 + n * 16 + fq * 4) = o; } }
        asm volatile("s_waitcnt lgkmcnt(0)" ::: "memory"); __builtin_amdgcn_s_barrier(); asm volatile("" ::: "memory");
    }
};

__device__ __forceinline__ void rms_rows_phase(const Frame& F, const float* X, const float* g, bf16* H) {
    const int gw = F.vcu * NWAVES + F.wave, NGW = F.G * NWAVES;
    for (int m = gw; m < TA; m += NGW) rms_row_bf16(X + (size_t)m * DM, g, H + (size_t)m * DM, F.lane);
}

__device__ __forceinline__ unsigned f2sort(float f) { const unsigned u = __builtin_bit_cast(unsigned, f); return u ^ ((u >> 31) ? 0xFFFFFFFFu : 0x80000000u); }
__device__ __forceinline__ float sort2f(unsigned s) { const unsigned u = s ^ ((s >> 31) ? 0x80000000u : 0xFFFFFFFFu); return __builtin_bit_cast(float, u); }
__device__ __forceinline__ float gelu_tanh(float x) { const float y = 0.7978845608028654f * (x + 0.044715f * x * x * x); const float e = __expf(2.f * y); return 0.5f * x * (1.f + (1.f - 2.f / (e + 1.f))); }
__device__ __forceinline__ unsigned gmax16(unsigned v) {
#pragma unroll
    for (int o = 1; o < 16; o <<= 1) { const unsigned t = (unsigned)__shfl_xor((int)v, o); v = v > t ? v : t; }
    return v;
}
typedef __bf16 bf16x2_t __attribute__((ext_vector_type(2)));
__device__ __forceinline__ float dot2bf(unsigned a, unsigned b, float c) {
#if __has_builtin(__builtin_amdgcn_fdot2_f32_bf16)
    return __builtin_amdgcn_fdot2_f32_bf16(__builtin_bit_cast(bf16x2_t, a), __builtin_bit_cast(bf16x2_t, b), c, false);
#else
    return c + bflo(a) * bflo(b) + bfhi(a) * bfhi(b);
#endif
}
template <bool SPLIT>
__device__ __forceinline__ void peer_token(const Frame& F, const Args& a, int row, LAS unsigned* TOPS, const LAS unsigned* CT, int half, LAS float* PART) {
    unsigned char* ws = a.ws; const int lane = lane_id(), grp = lane >> 4, j16 = lane & 15;
    const bf16* sc = (const bf16*)(ws + WS_SC) + (size_t)row * 2048;
#pragma unroll 1
    for (int bt = 0; bt < 4; ++bt) {
        const v4u xq = *(const v4u*)(sc + (bt * 4 + grp) * 128 + 8 * j16);
        unsigned k[8]; const float xs[8] = {bflo(xq.x), bfhi(xq.x), bflo(xq.y), bfhi(xq.y), bflo(xq.z), bfhi(xq.z), bflo(xq.w), bfhi(xq.w)};
#pragma unroll
        for (int e = 0; e < 8; ++e) k[e] = (f2sort(xs[e]) & ~127u) | (unsigned)(127 - (8 * j16 + e));
        unsigned mine = 0u;
#pragma unroll 1
        for (int r = 0; r < 16; ++r) {
            unsigned m = k[0];
#pragma unroll
            for (int e = 1; e < 8; ++e) m = m > k[e] ? m : k[e];
            m = gmax16(m);
            if (j16 == r) mine = m;
#pragma unroll
            for (int e = 0; e < 8; ++e) k[e] = (k[e] == m) ? 0u : k[e];
        }
        TOPS[(bt * 4 + grp) * 16 + j16] = mine;
    }
    int ex[2]; float gx[2], sux[2];
#pragma unroll
    for (int ps = 0; ps < 2; ++ps) {
        const int hd = ps * 4 + grp; const LAS unsigned* T1 = TOPS + (2 * hd) * 16; const LAS unsigned* T2 = T1 + 16;
        const unsigned c0_ = CT[j16], c1_ = CT[j16 + 16], c2_ = CT[j16 + 32], c3_ = CT[j16 + 48];
        const int ci0 = c0_ & 255, cj0 = c0_ >> 8, ci1 = c1_ & 255, cj1 = c1_ >> 8, ci2 = c2_ & 255, cj2 = c2_ >> 8, ci3 = c3_ & 255, cj3 = c3_ >> 8; const bool cv3 = (j16 + 48) < 50;
        unsigned k[4];
        { const float s0 = sort2f(T1[ci0] & ~127u) + sort2f(T2[cj0] & ~127u), s1 = sort2f(T1[ci1] & ~127u) + sort2f(T2[cj1] & ~127u),
                      s2 = sort2f(T1[ci2] & ~127u) + sort2f(T2[cj2] & ~127u), s3 = sort2f(T1[ci3] & ~127u) + sort2f(T2[cj3] & ~127u);
          k[0] = (f2sort(s0) & ~127u) | (unsigned)(127 - j16); k[1] = (f2sort(s1) & ~127u) | (unsigned)(127 - (j16 + 16)); k[2] = (f2sort(s2) & ~127u) | (unsigned)(127 - (j16 + 32));
          k[3] = cv3 ? ((f2sort(s3) & ~127u) | (unsigned)(127 - (j16 + 48))) : 0u; }
        unsigned mine = 0u;
#pragma unroll 1
        for (int r = 0; r < 16; ++r) {
            unsigned m = k[0] > k[1] ? k[0] : k[1]; const unsigned m2 = k[2] > k[3] ? k[2] : k[3]; m = m > m2 ? m : m2;
            m = gmax16(m);
            if (j16 == r) mine = m;
#pragma unroll
            for (int e = 0; e < 4; ++e) k[e] = (k[e] == m) ? 0u : k[e];
        }
        const int c = 127 - (int)(mine & 127u);
        int ci, cj;
        if (c < 16) { ci = 0; cj = c; } else if (c < 24) { ci = 1; cj = c - 16; } else if (c < 29) { ci = 2; cj = c - 24; } else if (c < 33) { ci = 3; cj = c - 29; }
        else if (c < 36) { ci = 4; cj = c - 33; } else if (c < 38) { ci = 5; cj = c - 36; } else if (c < 40) { ci = 6; cj = c - 38; } else if (c < 42) { ci = 7; cj = c - 40; } else { ci = c - 34; cj = 0; }
        const int i1 = 127 - (int)(T1[ci] & 127u), i2 = 127 - (int)(T2[cj] & 127u);
        ex[ps] = i1 * 128 + i2;
        const float sv = sort2f(mine & ~127u); const float s0 = __shfl(sv, lane & 48);
        float ee = __expf(sv - s0); float es = ee;
#pragma unroll
        for (int o = 1; o < 16; o <<= 1) es += __shfl_xor(es, o);
        const float* rsc = (const float*)(ws + WS_MISC);
        sux[ps] = rsc[ex[ps]]; gx[ps] = ee / es * rsc[16384 + ex[ps]];
    }
    {
        unsigned k0 = ((unsigned)ex[0] << 7) | (unsigned)lane, k1 = ((unsigned)ex[1] << 7) | (unsigned)(64 + lane);
#pragma unroll
        for (int k = 2; k <= 128; k <<= 1) {
#pragma unroll
            for (int j = k >> 1; j > 0; j >>= 1) {
                if (j == 64) { const unsigned lo = k0 < k1 ? k0 : k1, hi = k0 < k1 ? k1 : k0; k0 = lo; k1 = hi; }
                else {
                    const unsigned p0 = (unsigned)__shfl_xor((int)k0, j), p1 = (unsigned)__shfl_xor((int)k1, j);
                    const bool low = (lane & j) == 0; const bool asc0 = (lane & k) == 0, asc1 = ((64 + lane) & k) == 0;
                    const unsigned mn0 = k0 < p0 ? k0 : p0, mx0 = k0 < p0 ? p0 : k0, mn1 = k1 < p1 ? k1 : p1, mx1 = k1 < p1 ? p1 : k1;
                    k0 = (low == asc0) ? mn0 : mx0; k1 = (low == asc1) ? mn1 : mx1;
                }
            }
        }
        const int o0 = (int)(k0 & 127u), o1 = (int)(k1 & 127u);
        const float g0a = __shfl(gx[0], o0 & 63), g0b = __shfl(gx[1], o0 & 63), g1a = __shfl(gx[0], o1 & 63), g1b = __shfl(gx[1], o1 & 63);
        const float s0a = __shfl(sux[0], o0 & 63), s0b = __shfl(sux[1], o0 & 63), s1a = __shfl(sux[0], o1 & 63), s1b = __shfl(sux[1], o1 & 63);
        gx[0] = (o0 & 64) ? g0b : g0a; gx[1] = (o1 & 64) ? g1b : g1a; sux[0] = (o0 & 64) ? s0b : s0a; sux[1] = (o1 & 64) ? s1b : s1a;
        ex[0] = (int)(k0 >> 7); ex[1] = (int)(k1 >> 7);
    }
    const float rstd2 = rsqrtf(((const float*)(ws + WS_SS))[TA + row] * (1.f / 1024.f) + EPS);
    float hf[16];
    { const v4u* hp = (const v4u*)((const bf16*)(ws + WS_HB) + (size_t)row * DM + 16 * lane); const v4u h0 = hp[0], h1 = hp[1];
#pragma unroll
      for (int q = 0; q < 4; ++q) { hf[2 * q] = bflo(h0[q]); hf[2 * q + 1] = bfhi(h0[q]); hf[8 + 2 * q] = bflo(h1[q]); hf[8 + 2 * q + 1] = bfhi(h1[q]); } }
    float oacc[16];
#pragma unroll
    for (int i = 0; i < 16; ++i) oacc[i] = 0.f;
    const unsigned char* U = ws + WS_U16; const unsigned char* V = ws + WS_V16;
    v4u ub[8], vbA[8], vbB[8];
    const int gbeg = SPLIT ? 8 * half : 0, gend = SPLIT ? 8 * half + 8 : 16;
#define PEER_LOAD(buf, TAB, g) do { const int kk_ = (g) * 8; const int exs_ = (kk_ < 64) ? ex[0] : ex[1]; \
        _Pragma("unroll") for (int i = 0; i < 8; ++i) { const int e_ = __builtin_amdgcn_readlane(exs_, (kk_ & 63) + i); buf[i] = *(const v4u*)(TAB + (size_t)e_ * DM + 16 * lane); } } while (0)
#define PEER_DOTS(buf, g, wout) do { const int kk_ = (g) * 8; const float gxs_ = (kk_ < 64) ? gx[0] : gx[1]; const float sus_ = (kk_ < 64) ? sux[0] : sux[1]; float av[8]; \
        _Pragma("unroll") for (int i = 0; i < 8; ++i) { float s = 0.f; \
            _Pragma("unroll") for (int q = 0; q < 4; ++q) { const f32x2 lo = __builtin_amdgcn_cvt_pk_f32_fp8((int)buf[i][q], false), hi = __builtin_amdgcn_cvt_pk_f32_fp8((int)buf[i][q], true); \
                s += lo.x * hf[4 * q]; s += lo.y * hf[4 * q + 1]; s += hi.x * hf[4 * q + 2]; s += hi.y * hf[4 * q + 3]; } \
            av[i] = s; } \
        const bool b5 = lane & 32, b4 = lane & 16, b3_ = lane & 8; float bq[4], cq[2], dq; \
        _Pragma("unroll") for (int i = 0; i < 4; ++i) bq[i] = (b5 ? av[4 + i] : av[i]) + __shfl_xor(b5 ? av[i] : av[4 + i], 32); \
        _Pragma("unroll") for (int i = 0; i < 2; ++i) cq[i] = (b4 ? bq[2 + i] : bq[i]) + __shfl_xor(b4 ? bq[i] : bq[2 + i], 16); \
        dq = (b3_ ? cq[1] : cq[0]) + __shfl_xor(b3_ ? cq[0] : cq[1], 8); \
        dq += __shfl_xor(dq, 4); dq += __shfl_xor(dq, 2); dq += __shfl_xor(dq, 1); \
        const int src = (kk_ & 63) + (lane >> 3); \
        wout = __shfl(gxs_, src) * gelu_tanh(dq * __shfl(sus_, src) * rstd2); } while (0)
#define PEER_ACC(buf, wv) do { _Pragma("unroll") for (int i = 0; i < 8; ++i) { const float w = __builtin_bit_cast(float, __builtin_amdgcn_readlane(__builtin_bit_cast(int, wv), 8 * i)); \
        _Pragma("unroll") for (int q = 0; q < 4; ++q) { const f32x2 lo = __builtin_amdgcn_cvt_pk_f32_fp8((int)buf[i][q], false), hi = __builtin_amdgcn_cvt_pk_f32_fp8((int)buf[i][q], true); \
            oacc[4 * q] += w * lo.x; oacc[4 * q + 1] += w * lo.y; oacc[4 * q + 2] += w * hi.x; oacc[4 * q + 3] += w * hi.y; } } } while (0)
    PEER_LOAD(ub, U, gbeg); PEER_LOAD(vbA, V, gbeg);
#pragma unroll 1
    for (int g0 = gbeg; g0 < gend; g0 += 2) {
        float w0, w1;
        PEER_DOTS(ub, g0, w0);
        PEER_LOAD(ub, U, g0 + 1); PEER_LOAD(vbB, V, g0 + 1);
        PEER_ACC(vbA, w0);
        PEER_DOTS(ub, g0 + 1, w1);
        { const int gn = (g0 + 2 < gend) ? g0 + 2 : g0 + 1;
          PEER_LOAD(ub, U, gn); PEER_LOAD(vbA, V, gn); }
        PEER_ACC(vbB, w1);
    }
#undef PEER_LOAD
#undef PEER_DOTS
#undef PEER_ACC
    if (SPLIT) {
        if (half == 1) {
#pragma unroll
            for (int q = 0; q < 4; ++q) *(LAS f32x4*)(PART + 16 * lane + 4 * q) = (f32x4){oacc[4 * q], oacc[4 * q + 1], oacc[4 * q + 2], oacc[4 * q + 3]}; }
        __syncthreads();
        if (half == 1) return;
#pragma unroll
        for (int q = 0; q < 4; ++q) { const f32x4 p = *(const LAS f32x4*)(PART + 16 * lane + 4 * q); oacc[4 * q] += p.x; oacc[4 * q + 1] += p.y; oacc[4 * q + 2] += p.z; oacc[4 * q + 3] += p.w; }
    }
    asm volatile("" : "+s"(row)); const int lane2 = lane_id();
    const f32x4* x2 = (const f32x4*)((const float*)(ws + WS_X2) + (size_t)row * DM + 16 * lane2);
    f32x4 xv[4]; float ss = 0.f;
#pragma unroll
    for (int q = 0; q < 4; ++q) { xv[q] = x2[q]; xv[q].x += oacc[4 * q]; xv[q].y += oacc[4 * q + 1]; xv[q].z += oacc[4 * q + 2]; xv[q].w += oacc[4 * q + 3]; ss += (xv[q].x * xv[q].x + xv[q].y * xv[q].y) + (xv[q].z * xv[q].z + xv[q].w * xv[q].w); }
    const float r = rsqrtf(wave_sum(ss) * (1.f / DM) + EPS);
    const f32x4* gf = (const f32x4*)((const float*)a.in[I_GFIN] + 16 * lane2);
    f32x4* y = (f32x4*)((row < TP ? a.out + O_YP + (size_t)row * DM : a.out + O_YS + (size_t)(row - TP) * DM) + 16 * lane2);
#pragma unroll
    for (int q = 0; q < 4; ++q) { const f32x4 g4 = gf[q]; f32x4 o; o.x = xv[q].x * r * g4.x; o.y = xv[q].y * r * g4.y; o.z = xv[q].z * r * g4.z; o.w = xv[q].w * r * g4.w; y[q] = o; }
}
__device__ __forceinline__ void cand_ij(int c, int& ci, int& cj) {
    if (c < 16) { ci = 0; cj = c; } else if (c < 24) { ci = 1; cj = c - 16; } else if (c < 29) { ci = 2; cj = c - 24; } else if (c < 33) { ci = 3; cj = c - 29; }
    else if (c < 36) { ci = 4; cj = c - 33; } else if (c < 38) { ci = 5; cj = c - 36; } else if (c < 40) { ci = 6; cj = c - 38; } else if (c < 42) { ci = 7; cj = c - 40; } else if (c < 50) { ci = c - 34; cj = 0; } else { ci = 0; cj = 0; }
}
__device__ __forceinline__ void peer_phase(const Frame& F, const Args& a) {
    LAS unsigned* TOPS = (LAS unsigned*)F.lds + F.wave * 256;
    LAS unsigned* CT = (LAS unsigned*)F.lds + 8 * 256 + 4 * 1024;
    if (F.tid < 64) { int ci, cj; cand_ij(F.tid, ci, cj); CT[F.tid] = (unsigned)ci | ((unsigned)cj << 8); }
    __syncthreads();
    const int gw = F.vcu * NWAVES + F.wave, NGW = F.G * NWAVES;
    const int nfull = TA / NGW, rem = TA - nfull * NGW;
#pragma unroll 1
    for (int i = 0; i < nfull; ++i) peer_token<false>(F, a, gw + i * NGW, TOPS, CT, 0, nullptr);
    if (rem == 4 * F.G) {
        __syncthreads();
        peer_token<true>(F, a, nfull * NGW + F.vcu * 4 + (F.wave >> 1), TOPS, CT, F.wave & 1, (LAS float*)F.lds + 8 * 256 + (F.wave >> 1) * 1024);
    } else {
        const int row = gw + nfull * NGW; if (row < TA) peer_token<false>(F, a, row, TOPS, CT, 0, nullptr);
    }
}


template <class EpiS>
__device__ __forceinline__ void skinny_tile(const Frame& F, const bf16* A, int lda, const bf16* Bt, int ldb, int tm, int tn, const EpiS& E) {
    const int lane = F.lane, fr = lane & 15, fq = lane >> 4, w = F.wave;
    const bf16* ap = A + (size_t)(tm * 64 + fr) * lda + w * 128 + 8 * fq;
    const bf16* bp = Bt + (size_t)(tn * 64 + fr) * ldb + w * 128 + 8 * fq;
    v4u af[4][4], bfr[4][4];
#pragma unroll
    for (int m = 0; m < 4; ++m)
#pragma unroll
        for (int ks = 0; ks < 4; ++ks) { af[m][ks] = *(const v4u*)(ap + (size_t)(16 * m) * lda + ks * 32); bfr[m][ks] = *(const v4u*)(bp + (size_t)(16 * m) * ldb + ks * 32); }
    f32x4 acc[4][4];
#pragma unroll
    for (int m = 0; m < 4; ++m)
#pragma unroll
        for (int n = 0; n < 4; ++n) acc[m][n] = (f32x4){0.f, 0.f, 0.f, 0.f};
#pragma unroll
    for (int ks = 0; ks < 4; ++ks)
#pragma unroll
        for (int m = 0; m < 4; ++m)
#pragma unroll
            for (int n = 0; n < 4; ++n) acc[m][n] = __builtin_amdgcn_mfma_f32_16x16x32_bf16(__builtin_bit_cast(bf16x8, bfr[n][ks]), __builtin_bit_cast(bf16x8, af[m][ks]), acc[m][n], 0, 0, 0);
    LAS float* PS = (LAS float*)F.lds + w * 4096;
#pragma unroll
    for (int m = 0; m < 4; ++m)
#pragma unroll
        for (int n = 0; n < 4; ++n) *(LAS f32x4*)(PS + (16 * m + fr) * 64 + 4 * ((4 * n + fq) ^ fr)) = acc[m][n];
    lds_barrier();
    {
        const int row = F.tid >> 3, c8 = (F.tid & 7) * 8; const LAS float* PR = (const LAS float*)F.lds + row * 64;
        const int ch0 = 4 * (((F.tid & 7) * 2) ^ (row & 15)), ch1 = 4 * (((F.tid & 7) * 2 + 1) ^ (row & 15));
        f32x4 s0 = *(const LAS f32x4*)(PR + ch0), s1 = *(const LAS f32x4*)(PR + ch1);
#pragma unroll
        for (int ww = 1; ww < 8; ++ww) { s0 += *(const LAS f32x4*)(PR + ww * 4096 + ch0); s1 += *(const LAS f32x4*)(PR + ww * 4096 + ch1); }
        float v[8] = {s0.x, s0.y, s0.z, s0.w, s1.x, s1.y, s1.z, s1.w};
        E(tm * 64 + row, tn * 64 + c8, v, F.tid);
    }
    lds_barrier();
}
struct EpiSk {
    float* d32; int ld32; bf16* d16; int ld16; float sc16;
    const float* res; int ldr;
    const float* gcol; float* ssq; const float* rsq;
    __device__ __forceinline__ void operator()(int row, int col, float (&v)[8], int tid) const {
        if (rsq) { const float rs = rsqrtf(rsq[row] * (1.f / 1024.f) + EPS);
#pragma unroll
            for (int i = 0; i < 8; ++i) v[i] *= rs; }
        if (res) { const f32x4 a = *(const f32x4*)(res + (size_t)row * ldr + col), b = *(const f32x4*)(res + (size_t)row * ldr + col + 4);
            v[0] += a.x; v[1] += a.y; v[2] += a.z; v[3] += a.w; v[4] += b.x; v[5] += b.y; v[6] += b.z; v[7] += b.w; }
        if (d32) { *(f32x4*)(d32 + (size_t)row * ld32 + col) = (f32x4){v[0], v[1], v[2], v[3]}; *(f32x4*)(d32 + (size_t)row * ld32 + col + 4) = (f32x4){v[4], v[5], v[6], v[7]}; }
        if (ssq) { float ss = 0.f;
#pragma unroll
            for (int i = 0; i < 8; ++i) ss += v[i] * v[i];
            ss += __shfl_xor(ss, 1); ss += __shfl_xor(ss, 2); ss += __shfl_xor(ss, 4);
            if ((tid & 7) == 0) atomicAdd(ssq + row, ss); }
        if (d16) { float w8[8];
#pragma unroll
            for (int i = 0; i < 8; ++i) w8[i] = v[i];
            if (gcol) { const f32x4 a = *(const f32x4*)(gcol + col), b = *(const f32x4*)(gcol + col + 4); w8[0] *= a.x; w8[1] *= a.y; w8[2] *= a.z; w8[3] *= a.w; w8[4] *= b.x; w8[5] *= b.y; w8[6] *= b.z; w8[7] *= b.w; }
            v4u o; o.x = pg8::cvt_pk_bf16(w8[0] * sc16, w8[1] * sc16); o.y = pg8::cvt_pk_bf16(w8[2] * sc16, w8[3] * sc16); o.z = pg8::cvt_pk_bf16(w8[4] * sc16, w8[5] * sc16); o.w = pg8::cvt_pk_bf16(w8[6] * sc16, w8[7] * sc16);
            *(v4u*)(d16 + (size_t)row * ld16 + col) = o; }
    }
};

#define SK_TM16(t) (4 * (((t) >> 5) >> 1) + (((t) & 31) >> 3))
#define SK_TN16(t) (8 * (((t) >> 5) & 1) + ((t) & 7))
#define SK_TM32(t) (4 * ((((t) & 255) >> 5) >> 1) + ((((t) & 31) + 32 * ((t) >> 8)) >> 4))
#define SK_TN32(t) (16 * ((((t) & 255) >> 5) & 1) + ((((t) & 31) + 32 * ((t) >> 8)) & 15))


#ifndef PH_MAX
#define PH_MAX 99
#endif
__global__ void __launch_bounds__(NTHR, 2) mega_fwd(Args args) {
    extern __shared__ __attribute__((aligned(16))) unsigned char lds_raw[];
    Frame F;
    F.lds = (LAS unsigned char*)lds_raw;
    F.wave = __builtin_amdgcn_readfirstlane((int)threadIdx.x >> 6); F.lane = lane_id(); F.tid = F.wave * 64 + F.lane;
    F.G = gridDim.x; { const int bx = blockIdx.x; F.vcu = (F.G % 8 == 0) ? (bx % 8) * (F.G / 8) + bx / 8 : bx; }
    volatile LAS unsigned* MISC = (volatile LAS unsigned*)(F.lds + MISC_OFF);
    LAS unsigned long long* ARGP = (LAS unsigned long long*)(F.lds + ARGS_OFF);
    for (int u = F.tid; u < (LDS_BYTES - LDSCTL_OFF) / 4; u += NTHR) ((LAS unsigned*)(F.lds + LDSCTL_OFF))[u] = 0u;
    __syncthreads();
    if (F.tid == 0) {
        ARGP[0] = (unsigned long long)args.in[0];
        ARGP[1] = (unsigned long long)args.in[1];
        ARGP[2] = (unsigned long long)args.in[2];
        ARGP[3] = (unsigned long long)args.in[3];
        ARGP[4] = (unsigned long long)args.in[4];
        ARGP[5] = (unsigned long long)args.in[5];
        ARGP[6] = (unsigned long long)args.in[6];
        ARGP[7] = (unsigned long long)args.in[7];
        ARGP[8] = (unsigned long long)args.in[8];
        ARGP[9] = (unsigned long long)args.in[9];
        ARGP[10] = (unsigned long long)args.in[10];
        ARGP[11] = (unsigned long long)args.in[11];
        ARGP[12] = (unsigned long long)args.in[12];
        ARGP[13] = (unsigned long long)args.in[13];
        ARGP[14] = (unsigned long long)args.in[14];
        ARGP[15] = (unsigned long long)args.in[15];
        ARGP[16] = (unsigned long long)args.in[16];
        ARGP[17] = (unsigned long long)args.in[17];
        ARGP[18] = (unsigned long long)args.in[18];
        ARGP[19] = (unsigned long long)args.in[19];
        ARGP[20] = (unsigned long long)args.in[20];
        ARGP[21] = (unsigned long long)args.in[21];
        ARGP[22] = (unsigned long long)args.in[22];
        ARGP[23] = (unsigned long long)args.in[23];
        ARGP[24] = (unsigned long long)args.in[24];
        ARGP[25] = (unsigned long long)args.in[25];
        ARGP[26] = (unsigned long long)args.in[26];
        ARGP[27] = (unsigned long long)args.in[27];
        ARGP[28] = (unsigned long long)args.in[28];
        ARGP[N_INPUTS] = (unsigned long long)args.out; ARGP[N_INPUTS + 1] = (unsigned long long)args.ws;
    }
    __syncthreads();
    { const XcdBarrier bar0 = xcd_barrier_post((unsigned*)((gu32*)(args.ws + WS_CTL) + CW_BAR), MISC + 8, F.wave); if (F.tid == 0) MISC[10] = bar0.x; }
    __syncthreads();
#define GRID_BAR() do { XcdBarrier bar_; bar_.bar = (unsigned*)((gu32*)((unsigned char*)ld_ptr(ARGP + N_INPUTS + 1) + WS_CTL) + CW_BAR); bar_.x = MISC[10]; bar_.st = MISC + 8; bar_.wave = F.wave; xcd_barrier(bar_); } while (0)
#define PHASE_ARGS const Args A = load_args(ARGP); unsigned char* const ws = A.ws; float* const out = A.out; (void)ws; (void)out; { int l_ = lane_id(); asm volatile("" : "+v"(l_)); F.lane = l_; F.tid = F.wave * 64 + l_; }

    { PHASE_ARGS;
    p0_prologue(F, A);
    }
    GRID_BAR();
#if defined(PROBE_BAR8)
    GRID_BAR(); GRID_BAR(); GRID_BAR(); GRID_BAR(); GRID_BAR(); GRID_BAR(); GRID_BAR(); GRID_BAR();
#endif
#if PH_MAX >= 1
    { PHASE_ARGS;
    {
        pg8::Gemm g{(const bf16*)(ws + WS_HB), (const bf16*)(ws + WS_WIN), DM, DM, DM};
        pg8::StaticOrder S; S.init(TA, N_IN, F.G, (int)blockIdx.x);
        EpiInProj E{out, ws, (const float*)A.in[I_BFF]};
        pg8::gemm_phase(F.lds, g, S, E, F.wave);
    }
    {
        const int off = (TA / 256) * (N_IN / 256) % F.G;
        pg8::Gemm g{(const bf16*)(ws + WS_MB), (const bf16*)(ws + WS_WMK), DM, DM, DM};
        pg8::StaticOrder S; S.init(512, DM, F.G, ((int)blockIdx.x + F.G - off) % F.G);
        EpiGen E{out + O_MKP, DM, (bf16*)(ws + WS_MK16), DM, 1.f, nullptr, nullptr, 0, 0, nullptr, nullptr, nullptr};
        pg8::gemm_phase(F.lds, g, S, E, F.wave);
    }
    {
        const int off = ((TA / 256) * (N_IN / 256) + 8) % F.G;
        pg8::Gemm g{(const bf16*)(ws + WS_MB), (const bf16*)(ws + WS_WMV), DM, DM, DM};
        pg8::StaticOrder S; S.init(512, DM, F.G, ((int)blockIdx.x + F.G - off) % F.G);
        EpiGen E{out + O_MVP, DM, nullptr, 0, 1.f, nullptr, nullptr, 0, 0, nullptr, nullptr, nullptr};
        pg8::gemm_phase(F.lds, g, S, E, F.wave);
    }
    {
        const int off = ((TA / 256) * (N_IN / 256) + 16) % F.G;
        pg8::Gemm g{(const bf16*)(ws + WS_WMV), (const bf16*)(ws + WS_MB), DM, DM, DM};
        pg8::StaticOrder S; S.init(DM, 512, F.G, ((int)blockIdx.x + F.G - off) % F.G);
        EpiGen E{nullptr, 0, (bf16*)(ws + WS_MVT16), 512, 1.f, nullptr, nullptr, 0, 0, nullptr, nullptr, nullptr};
        pg8::gemm_phase(F.lds, g, S, E, F.wave);
    }
    }
    GRID_BAR();
#endif
#if PH_MAX >= 2
    asm volatile("; ===PHASE 2===");
    { PHASE_ARGS;
    {
        const int gw = F.vcu * NWAVES + F.wave, NGW = F.G * NWAVES;
        for (int it = gw; it < 512; it += NGW) fox_norms_item(F, (const bf16*)(ws + WS_QF), (const bf16*)(ws + WS_KF), out + O_LFP, (float*)(ws + WS_MISC + MiB), (float*)(ws + WS_KBIAS), (float*)(ws + WS_MISC + MiB + 65536), it);
        for (int it = gw; it < NB_S * NPAGES; it += NGW) fox_suffix_item(F, (const float*)A.in[I_CFL], (const int*)A.in[I_PT], (float*)(ws + WS_SUF), (float*)(ws + WS_MISC + 2 * MiB), it);
        for (int u = F.vcu; u < 1024; u += F.G) gla_g1_unit(F, A, u);
        for (int u = F.vcu; u < 512; u += F.G) gla_sample_unit(F, A, u);
    }
    }
    GRID_BAR();
#endif
#if PH_MAX >= 3
    asm volatile("; ===PHASE 3===");
    { PHASE_ARGS;
    gla_scan(F, A);
    __syncthreads();
    for (int i = F.vcu; i < 256; i += F.G) { const int bh = i >> 4, s = i & 15;
        fox_attn_unit(F, (const bf16*)(ws + WS_QF), (const bf16*)(ws + WS_KF), (const bf16*)(ws + WS_VF), (const float*)(ws + WS_KBIAS), (const float*)(ws + WS_MISC + MiB + 65536), (const float*)(ws + WS_MISC + MiB), (bf16*)(ws + WS_MERGED), bh >> 3, bh & 7, s);
        fox_attn_unit(F, (const bf16*)(ws + WS_QF), (const bf16*)(ws + WS_KF), (const bf16*)(ws + WS_VF), (const float*)(ws + WS_KBIAS), (const float*)(ws + WS_MISC + MiB + 65536), (const float*)(ws + WS_MISC + MiB), (bf16*)(ws + WS_MERGED), bh >> 3, bh & 7, 31 - s); }
    }
    GRID_BAR();
#endif
#if PH_MAX >= 4
    asm volatile("; ===PHASE 4===");
    { PHASE_ARGS;
    if (!(F.vcu & 1)) { for (int u = F.vcu; u < 1024; u += F.G) gla_g3_unit(F, A, u); }
    }
    { PHASE_ARGS;
    for (int u = F.vcu; u < 1024; u += F.G) fox_sample_unit(F, A, u);
    }
    { PHASE_ARGS;
    if (F.vcu & 1) { for (int u = F.vcu; u < 1024; u += F.G) gla_g3_unit(F, A, u); }
    }
    GRID_BAR();
#endif
#if PH_MAX >= 5
    asm volatile("; ===PHASE 5===");
    { PHASE_ARGS;
    {
        pg8::Gemm g{(const bf16*)(ws + WS_MERGED), (const bf16*)(ws + WS_WOUT), DM, DM, DM};
        pg8::StaticOrder S; S.init(TP, DM, F.G, (int)blockIdx.x);
        EpiGen E{(float*)(ws + WS_X1), DM, (bf16*)(ws + WS_HB), DM, 1.f, (const float*)A.in[I_XP], (const float*)A.in[I_XS], TP, DM, (const float*)A.in[I_GCROSS], (float*)(ws + WS_SS), nullptr};
        pg8::gemm_phase(F.lds, g, S, E, F.wave);
        __syncthreads();
        EpiSk Es{(float*)(ws + WS_X1) + (size_t)TP * DM, DM, (bf16*)(ws + WS_HB) + (size_t)TP * DM, DM, 1.f, (const float*)A.in[I_XS], DM, (const float*)A.in[I_GCROSS], (float*)(ws + WS_SS) + TP, nullptr};
        for (int t = F.vcu; t < 256; t += F.G) skinny_tile(F, (const bf16*)(ws + WS_MERGED) + (size_t)TP * DM, DM, (const bf16*)(ws + WS_WOUT), DM, SK_TM16(t), SK_TN16(t), Es);
    }
    }
    GRID_BAR();
#endif
#if PH_MAX >= 7
    asm volatile("; ===PHASE 7===");
    { PHASE_ARGS;
    {
        pg8::Gemm g{(const bf16*)(ws + WS_HB), (const bf16*)(ws + WS_WCQ), DM, DM, DM};
        pg8::StaticOrder S; S.init(TP, DM, F.G, (int)blockIdx.x);
        EpiGen E{nullptr, 0, (bf16*)(ws + WS_QC), DM, C2C, nullptr, nullptr, 0, 0, nullptr, nullptr, (const float*)(ws + WS_SS)};
        pg8::gemm_phase(F.lds, g, S, E, F.wave);
        __syncthreads();
        EpiSk Es{nullptr, 0, (bf16*)(ws + WS_QC) + (size_t)TP * DM, DM, C2C, nullptr, 0, nullptr, nullptr, (const float*)(ws + WS_SS) + TP};
        for (int t = F.vcu; t < 256; t += F.G) skinny_tile(F, (const bf16*)(ws + WS_HB) + (size_t)TP * DM, DM, (const bf16*)(ws + WS_WCQ), DM, SK_TM16(t), SK_TN16(t), Es);
    }
    }
    GRID_BAR();
#endif
#if PH_MAX >= 8
    asm volatile("; ===PHASE 8===");
    { PHASE_ARGS;
    {
        const int u = (int)blockIdx.x, b = (u >> 7) & 1, h = (u >> 5) & 3, pnl = u & 31;
        const size_t roff = ((size_t)b * SEQ + pnl * 256) * DM + h * 256;
        if (F.vcu & 1) { for (int v = F.vcu; v < 512; v += F.G) cross_sample_unit(F, A, v); }
        pg8::Gemm g{(const bf16*)(ws + WS_QC) + roff, (const bf16*)(ws + WS_MK16) + (size_t)(b * 256) * DM + h * 256, DM, DM, 256};
        pg8::SingleUnit S{u < 256 ? 1 : 0, {0, 0}};
        EpiSoftmaxP E{ARGP};
        pg8::gemm_phase(F.lds, g, S, E, F.wave);
        VM_WAIT(); __syncthreads();
        {
            pg8::Gemm g2{(const bf16*)(ws + WS_PC) + roff, (const bf16*)(ws + WS_MVT16) + (size_t)(h * 256) * 512 + b * 256, DM, 512, 256};
            EpiGen E2{nullptr, 0, (bf16*)(ws + WS_OC) + roff, DM, 1.f, nullptr, nullptr, 0, 0, nullptr, nullptr, nullptr};
            pg8::gemm_phase(F.lds, g2, S, E2, F.wave);
        }
        __syncthreads();
        if (!(F.vcu & 1)) { for (int v = F.vcu; v < 512; v += F.G) cross_sample_unit(F, A, v); }
    }
    }
    GRID_BAR();
#endif
#if PH_MAX >= 10
    asm volatile("; ===PHASE 10===");
    { PHASE_ARGS;
    {
        pg8::Gemm g{(const bf16*)(ws + WS_OC), (const bf16*)(ws + WS_WCO), DM, DM, DM};
        pg8::StaticOrder S; S.init(TP, DM, F.G, (int)blockIdx.x);
        EpiGen E{(float*)(ws + WS_X2), DM, (bf16*)(ws + WS_HB), DM, 1.f, (const float*)(ws + WS_X1), (const float*)(ws + WS_X1), TA, DM, (const float*)A.in[I_GFFN], (float*)(ws + WS_SS) + TA, nullptr};
        pg8::gemm_phase(F.lds, g, S, E, F.wave);
        __syncthreads();
        EpiSk Es{(float*)(ws + WS_X2) + (size_t)TP * DM, DM, (bf16*)(ws + WS_HB) + (size_t)TP * DM, DM, 1.f, (const float*)(ws + WS_X1) + (size_t)TP * DM, DM, (const float*)A.in[I_GFFN], (float*)(ws + WS_SS) + TA + TP, nullptr};
        for (int t = F.vcu; t < 256; t += F.G) skinny_tile(F, (const bf16*)(ws + WS_OC) + (size_t)TP * DM, DM, (const bf16*)(ws + WS_WCO), DM, SK_TM16(t), SK_TN16(t), Es);
    }
    }
    GRID_BAR();
#endif
#if PH_MAX >= 12
    asm volatile("; ===PHASE 12===");
    { PHASE_ARGS;
    {
        pg8::Gemm g{(const bf16*)(ws + WS_HB), (const bf16*)(ws + WS_WPK), DM, DM, DM};
        pg8::StaticOrder S; S.init(TP, 2048, F.G, (int)blockIdx.x);
        EpiGen E{nullptr, 0, (bf16*)(ws + WS_SC), 2048, 1.f, nullptr, nullptr, 0, 0, nullptr, nullptr, (const float*)(ws + WS_SS) + TA};
        pg8::gemm_phase(F.lds, g, S, E, F.wave);
        __syncthreads();
        EpiSk Es{nullptr, 0, (bf16*)(ws + WS_SC) + (size_t)TP * 2048, 2048, 1.f, nullptr, 0, nullptr, nullptr, (const float*)(ws + WS_SS) + TA + TP};
        for (int t = F.vcu; t < 512; t += F.G) skinny_tile(F, (const bf16*)(ws + WS_HB) + (size_t)TP * DM, DM, (const bf16*)(ws + WS_WPK), DM, SK_TM32(t), SK_TN32(t), Es);
    }
    }
    GRID_BAR();
#endif
#if PH_MAX >= 13
    asm volatile("; ===PHASE 13===");
    { PHASE_ARGS;
    peer_phase(F, A);
    }
#endif
#if PH_MAX < 13
    {   PHASE_ARGS;
        const int gw = F.vcu * NWAVES + F.wave, NGW = F.G * NWAVES;
        for (int m = gw; m < TA; m += NGW) {
            const float* x = m < TP ? (const float*)A.in[I_XP] + (size_t)m * DM : (const float*)A.in[I_XS] + (size_t)(m - TP) * DM;
            float* y = m < TP ? out + O_YP + (size_t)m * DM : out + O_YS + (size_t)(m - TP) * DM;
            for (int j = 0; j < 4; ++j) ((f32x4*)y)[F.lane + 64 * j] = ((const f32x4*)x)[F.lane + 64 * j];
        }
    }
#endif

}

extern "C" void kernel_launch(void* const* d_in, const int* in_sizes, int n_in, void* d_out, int out_size, void* d_ws, size_t ws_size, hipStream_t stream) {
    static int grid = 0;
    if (grid == 0) {
        if (n_in != N_INPUTS || (size_t)out_size != O_TOTAL || ws_size < WS_END) { fprintf(stderr, "kernel_launch: unexpected shapes (n_in %d out %d ws %zu)\n", n_in, out_size, ws_size); grid = -1; return; }
        int dev = 0, cus = 0, per_cu = 0;
        if (hipGetDevice(&dev) != hipSuccess || hipDeviceGetAttribute(&cus, hipDeviceAttributeMultiprocessorCount, dev) != hipSuccess) { grid = -1; return; }
        if (hipFuncSetAttribute((const void*)mega_fwd, hipFuncAttributeMaxDynamicSharedMemorySize, LDS_BYTES) != hipSuccess) { fprintf(stderr, "kernel_launch: hipFuncSetAttribute failed\n"); grid = -1; return; }
        if (hipOccupancyMaxActiveBlocksPerMultiprocessor(&per_cu, (const void*)mega_fwd, NTHR, LDS_BYTES) != hipSuccess || per_cu < 1)
            fprintf(stderr, "kernel_launch: occupancy query reports %d workgroups per CU\n", per_cu);
        (void)hipGetLastError();
        grid = cus;
        if (grid > 256) grid = 256;
    }
    if (grid < 0) return;
    if (hipMemsetAsync((char*)d_ws + WS_CTL, 0, CTL_ZERO_BYTES, stream) != hipSuccess) return;
    Args a{};
    for (int i = 0; i < N_INPUTS; ++i) a.in[i] = d_in[i];
    a.out = (float*)d_out; a.ws = (unsigned char*)d_ws;
    hipLaunchKernelGGL(mega_fwd, dim3(grid), dim3(NTHR), LDS_BYTES, stream, a);
    const hipError_t le = hipPeekAtLastError();
    if (le != hipSuccess) fprintf(stderr, "kernel_launch: launch failed: %s\n", hipGetErrorName(le));
}
```

```cpp
#define PH_MAX 13
#include <hip/hip_runtime.h>
#include <cstdio>
#include <cstdint>

namespace pg8 {
#define PG8_LAS __attribute__((address_space(3)))
typedef unsigned short bf16_t;
typedef short bf16x8 __attribute__((ext_vector_type(8)));
typedef float f32x4 __attribute__((ext_vector_type(4)));
typedef unsigned u32x4 __attribute__((ext_vector_type(4)));
typedef unsigned u32x2 __attribute__((ext_vector_type(2)));
constexpr int BM = 256, BK = 64, HALF = 128, HTB = HALF * BK * 2  , STAGE_BYTES = 8 * HTB, NXCD = 8, WGM = 8;

__host__ __device__ __forceinline__ int lds_byte(int r, int c) { const int st = (r >> 4) * 2 + (c >> 5), rr = r & 15, cc = c & 31, ob = rr * 64 + cc * 2; return st * 1024 + (ob ^ (((ob >> 9) & 1) << 5)); }
__host__ __device__ __forceinline__ void stage_rc(int b, int& R, int& C) { const int st = b / 1024, sb = b % 1024, swz = sb ^ (((sb >> 9) & 1) << 5); R = (st >> 1) * 16 + swz / 64; C = (st & 1) * 32 + (swz % 64) / 2; }

struct Unit { int pm, pn; };
struct Gemm { const bf16_t* A; const bf16_t* Bt; int lda, ldb, K; };

struct StaticOrder {
    int nM, nN, nwg, G, c;
    __host__ __device__ void init(int M, int N, int G_, int c_) { nM = M / BM; nN = N / BM; nwg = nM * nN; G = G_; c = c_; }
    __host__ __device__ bool next(int i, Unit& u) const {
        const long L = (long)i * G + c; if (L >= nwg) return false;
        int wgid = (int)L; { const int q = nwg / NXCD, r = nwg % NXCD, xcd = wgid % NXCD, off = wgid / NXCD; wgid = (xcd < r ? xcd * (q + 1) : r * (q + 1) + (xcd - r) * q) + off; }
        const int nig = WGM * nN, gid = wgid / nig, fm = gid * WGM, gsz = (nM - fm) < WGM ? (nM - fm) : WGM;
        u.pm = fm + ((wgid % nig) % gsz); u.pn = (wgid % nig) / gsz; return true;
    }
};
struct SingleUnit {
    int has; Unit u0;
    __host__ __device__ bool next(int i, Unit& u) const { if (i != 0 || !has) return false; u = u0; return true; }
};

__device__ __forceinline__ unsigned cvt_pk_bf16(float lo, float hi) { unsigned r; asm volatile("v_cvt_pk_bf16_f32 %0, %1, %2" : "=v"(r) : "v"(lo), "v"(hi)); return r; }

template <class Epi, class Sched>
__device__ __forceinline__ void gemm_phase(PG8_LAS unsigned char* lds, const Gemm g, const Sched& S, const Epi& E, int wave_id) {
    int lane; asm volatile("v_mbcnt_lo_u32_b32 %0, -1, 0\n\tv_mbcnt_hi_u32_b32 %0, -1, %0" : "=v"(lane));
    const int wid = wave_id; const int tid = wid * 64 + lane; const int wr = wid >> 2, wc = wid & 3, fr = lane & 15, fq = lane >> 4;
    const int K = g.K, nt = K / BK;
    unsigned voffA[2], voffB[2];
#pragma unroll
    for (int i = 0; i < 2; ++i) { int R, C; stage_rc(tid * 16 + i * 8192, R, C);
        voffA[i] = (unsigned)(R * g.lda + C) * 2u; voffB[i] = (unsigned)(R * g.ldb + C) * 2u; }
    const size_t kstep = (size_t)(BK * 2);
    const size_t hstepA = (size_t)HALF * g.lda * 2, hstepB = (size_t)HALF * g.ldb * 2;
    const size_t tstepA = 2 * hstepA, tstepB = 2 * hstepB;
    const unsigned ldsw = (unsigned)wid * 1024u;
    const int aoff = lds_byte(wr * 64 + fr, fq * 8), boff = lds_byte(wc * 32 + fr, fq * 8);
#define PG8_SA(b, h) (((b) * 2 + (h)) * HTB)
#define PG8_SB(b, h) ((4 + (b) * 2 + (h)) * HTB)
#define PG8_STAGE(bufoff, gbase, voff) do { _Pragma("unroll") for (int _i = 0; _i < 2; ++_i) \
        __builtin_amdgcn_global_load_lds((const unsigned*)((const char*)(gbase) + (voff)[_i]), (PG8_LAS unsigned*)(lds + (bufoff) + ldsw + _i * 8192), 16, 0, 0); } while (0)
#define PG8_LDA(dst, b, h) do { _Pragma("unroll") for (int m = 0; m < 4; ++m) _Pragma("unroll") for (int k = 0; k < 2; ++k) dst[m][k] = *(const PG8_LAS bf16x8*)(lds + PG8_SA(b, h) + aoff + m * 2048 + k * 1024); } while (0)
#define PG8_LDB(dst, b, h) do { _Pragma("unroll") for (int n = 0; n < 2; ++n) _Pragma("unroll") for (int k = 0; k < 2; ++k) dst[n][k] = *(const PG8_LAS bf16x8*)(lds + PG8_SB(b, h) + boff + n * 2048 + k * 1024); } while (0)
#define PG8_MMA(ai, bj, At, Bt) do { __builtin_amdgcn_s_setprio(1); _Pragma("unroll") for (int m = 0; m < 4; ++m) _Pragma("unroll") for (int n = 0; n < 2; ++n) _Pragma("unroll") for (int k = 0; k < 2; ++k) \
        acc[ai][bj][m][n] = __builtin_amdgcn_mfma_f32_16x16x32_bf16(Bt[n][k], At[m][k], acc[ai][bj][m][n], 0, 0, 0); __builtin_amdgcn_s_setprio(0); } while (0)
#define PG8_WAIT_V(n) asm volatile("s_waitcnt vmcnt(" #n ")" ::: "memory")
#define PG8_WAIT_L(n) asm volatile("s_waitcnt lgkmcnt(" #n ")" ::: "memory")
#define PG8_BAR __builtin_amdgcn_s_barrier()
#define PG8_SCHED __builtin_amdgcn_sched_barrier(0)
    Unit cur, nxt; int ui = 0;
    if (!S.next(0, cur)) return;
    f32x4 acc[2][2][4][2];
#pragma unroll
    for (int a = 0; a < 2; ++a)
#pragma unroll
        for (int b = 0; b < 2; ++b)
#pragma unroll
            for (int m = 0; m < 4; ++m)
#pragma unroll
                for (int n = 0; n < 2; ++n) acc[a][b][m][n] = (f32x4){0.f, 0.f, 0.f, 0.f};
    bf16x8 At[4][2], B0[2][2], B1[2][2];
    const char* cA = (const char*)g.A + (size_t)cur.pm * tstepA; const char* cB = (const char*)g.Bt + (size_t)cur.pn * tstepB;
    PG8_STAGE(PG8_SB(0, 0), cB, voffB); PG8_STAGE(PG8_SB(0, 1), cB + hstepB, voffB); PG8_STAGE(PG8_SA(0, 0), cA, voffA); PG8_STAGE(PG8_SA(0, 1), cA + hstepA, voffA);
    if (wr == 1) PG8_BAR;
    PG8_WAIT_V(2); PG8_BAR;
    PG8_STAGE(PG8_SB(1, 0), cB + kstep, voffB); PG8_STAGE(PG8_SA(1, 0), cA + kstep, voffA); PG8_STAGE(PG8_SB(1, 1), cB + hstepB + kstep, voffB);
    PG8_WAIT_V(6); PG8_BAR;
    for (;;) {
        const bool has_next = S.next(ui + 1, nxt);
        const char* nA = has_next ? (const char*)g.A + (size_t)nxt.pm * tstepA : cA; const char* nB = has_next ? (const char*)g.Bt + (size_t)nxt.pn * tstepB : cB;
        for (int t = 0; t < nt; t += 2) {
            const bool last = (t == nt - 2);
            const char* a1 = cA + (size_t)(t + 1) * kstep;
            const char* a2 = last ? nA : cA + (size_t)(t + 2) * kstep; const char* b2 = last ? nB : cB + (size_t)(t + 2) * kstep;
            const char* a3 = a2 + kstep; const char* b3 = b2 + kstep;
            PG8_LDB(B0, 0, 0); PG8_LDB(B1, 0, 1); PG8_SCHED; PG8_LDA(At, 0, 0); PG8_STAGE(PG8_SA(1, 1), a1 + hstepA, voffA);
            PG8_WAIT_V(8); PG8_WAIT_L(0); PG8_BAR; PG8_MMA(0, 0, At, B0); PG8_MMA(0, 1, At, B1); PG8_BAR; PG8_SCHED;
            PG8_LDA(At, 0, 1); PG8_STAGE(PG8_SB(0, 0), b2, voffB); PG8_STAGE(PG8_SB(0, 1), b2 + hstepB, voffB); PG8_STAGE(PG8_SA(0, 0), a2, voffA);
            PG8_WAIT_V(8); PG8_WAIT_L(0); PG8_BAR; PG8_MMA(1, 0, At, B0); PG8_MMA(1, 1, At, B1); PG8_BAR; PG8_SCHED;
            PG8_LDB(B0, 1, 0); PG8_LDB(B1, 1, 1); PG8_SCHED; PG8_LDA(At, 1, 0); PG8_STAGE(PG8_SA(0, 1), a2 + hstepA, voffA);
            PG8_WAIT_V(8); PG8_WAIT_L(0); PG8_BAR; PG8_MMA(0, 0, At, B0); PG8_MMA(0, 1, At, B1); PG8_BAR; PG8_SCHED;
            PG8_LDA(At, 1, 1); PG8_STAGE(PG8_SB(1, 0), b3, voffB); PG8_STAGE(PG8_SB(1, 1), b3 + hstepB, voffB); PG8_STAGE(PG8_SA(1, 0), a3, voffA);
            PG8_WAIT_V(8); PG8_WAIT_L(0); PG8_BAR; PG8_MMA(1, 0, At, B0); PG8_MMA(1, 1, At, B1); PG8_BAR; PG8_SCHED;
        }
        if (wr == 0) PG8_BAR;
        if constexpr (!Epi::AFTER_DRAIN) { E(acc, cur, wr, wc, fr, fq); }
        if (!has_next) break;
#pragma unroll
        for (int a = 0; a < 2; ++a)
#pragma unroll
            for (int b = 0; b < 2; ++b)
#pragma unroll
                for (int m = 0; m < 4; ++m)
#pragma unroll
                    for (int n = 0; n < 2; ++n) acc[a][b][m][n] = (f32x4){0.f, 0.f, 0.f, 0.f};
        cur = nxt; cA = nA; cB = nB; ++ui;
        if (wr == 1) PG8_BAR;
    }
    PG8_WAIT_V(0);
    PG8_BAR;
    if constexpr (Epi::AFTER_DRAIN) { E.fused(acc, cur, wr, wc, fr, fq, lds, wid, lane); }
#undef PG8_SA
#undef PG8_SB
#undef PG8_STAGE
#undef PG8_LDA
#undef PG8_LDB
#undef PG8_MMA
#undef PG8_WAIT_V
#undef PG8_WAIT_L
#undef PG8_BAR
#undef PG8_SCHED
}
}

#define GAS __attribute__((address_space(1)))
#define LAS __attribute__((address_space(3)))
typedef unsigned short bf16;
typedef unsigned v4u __attribute__((ext_vector_type(4)));
typedef unsigned v2u __attribute__((ext_vector_type(2)));
typedef float f32x4 __attribute__((ext_vector_type(4)));
typedef float f32x2 __attribute__((ext_vector_type(2)));
typedef float f32x16 __attribute__((ext_vector_type(16)));
typedef short bf16x8 __attribute__((ext_vector_type(8)));
typedef short s16x4 __attribute__((ext_vector_type(4)));
typedef GAS unsigned gu32;
#define RLX_AGENT __ATOMIC_RELAXED, __HIP_MEMORY_SCOPE_AGENT
#define LDS_WAIT() asm volatile("s_waitcnt lgkmcnt(0)" ::: "memory")
#define VM_WAIT() asm volatile("s_waitcnt vmcnt(0)" ::: "memory")
__device__ __forceinline__ unsigned f2bf(float f) { unsigned u = __builtin_bit_cast(unsigned, f); return (u + 0x7fffu + ((u >> 16) & 1u)) >> 16; }
__device__ __forceinline__ unsigned pk2(float lo, float hi) { return f2bf(lo) | (f2bf(hi) << 16); }
__device__ __forceinline__ float bf2f(unsigned short b) { return __builtin_bit_cast(float, (unsigned)b << 16); }
__device__ __forceinline__ float bflo(unsigned u) { return __builtin_bit_cast(float, u << 16); }
__device__ __forceinline__ float bfhi(unsigned u) { return __builtin_bit_cast(float, u & 0xffff0000u); }


typedef short v4i16_t __attribute__((ext_vector_type(4)));
__device__ __forceinline__ s16x4 lds_tr16(LAS unsigned char* p) { return __builtin_bit_cast(s16x4, __builtin_amdgcn_ds_read_tr16_b64_v4i16((LAS v4i16_t*)p)); }
__device__ __forceinline__ int crow(int r, int hi) { return (r & 3) + 8 * (r >> 2) + 4 * hi; }
__device__ __forceinline__ void lds_barrier() { asm volatile("s_waitcnt lgkmcnt(0)\n\ts_barrier" ::: "memory"); }

struct BfPtr { const unsigned short* p; __device__ __forceinline__ float operator[](size_t i) const { return __builtin_bit_cast(float, (unsigned)p[i] << 16); }
               __device__ __forceinline__ BfPtr operator+(size_t o) const { return BfPtr{p + o}; } };
#define GLD(ptr) (BfPtr{(const unsigned short*)(ptr)})

__device__ __forceinline__ int lane_id() { int r; asm volatile("v_mbcnt_lo_u32_b32 %0, -1, 0\n\tv_mbcnt_hi_u32_b32 %0, -1, %0" : "=v"(r)); return r; }
#define TID_IS_ZERO(wave_) ((wave_) == 0 && lane_id() == 0)
#define XB_TMO      128
#define XB_XCNT(j)  (256  + 64 * (j))
#define XB_XSUB(j)  (1280 + 64 * (j))
#define XB_XGEN(j)  (2304 + 64 * (j))
#define XB_TOP      3328
#define XB_TOPGEN   3392
#define XCD_BAR_WORDS 3456
#define XB_SPIN_CAP (1u << 18)

__device__ __forceinline__ unsigned xb_ld(unsigned* p)              { return __hip_atomic_load(p, __ATOMIC_RELAXED, __HIP_MEMORY_SCOPE_AGENT); }
__device__ __forceinline__ unsigned xb_add(unsigned* p, unsigned v) { return __hip_atomic_fetch_add(p, v, __ATOMIC_RELAXED, __HIP_MEMORY_SCOPE_AGENT); }
__device__ __forceinline__ unsigned xb_xcc_id() { return (unsigned)__builtin_amdgcn_s_getreg((3 << 11) | 20) & 0xFu; }
#define XB_SPIN(cond, bar) do { unsigned _sp = 0; while (cond) { __builtin_amdgcn_s_sleep(1); \
    if ((++_sp & 255u) == 0u) { if (xb_ld(&(bar)[XB_TMO])) break; if (_sp > XB_SPIN_CAP) { atomicAdd(&(bar)[XB_TMO], 1u); break; } } } } while (0)

struct XcdBarrier {
    unsigned* bar; unsigned x; int wave;
    volatile LAS unsigned* st;
};

__device__ __forceinline__ XcdBarrier xcd_barrier_post(unsigned* bar, volatile LAS unsigned* st, int wave) {
    XcdBarrier b; b.bar = bar; b.x = xb_xcc_id(); b.st = st; b.wave = wave;
    if (TID_IS_ZERO(wave)) (void)xb_add(&bar[XB_XCNT(b.x)], 1u);
    return b;
}
__device__ __forceinline__ void xcd_barrier_complete(unsigned* bar, unsigned x, unsigned& nloc, unsigned& nx) {
    const unsigned G = gridDim.x * gridDim.y * gridDim.z;
    unsigned sum, cnt, mine, sp = 0u;
    for (;;) {
        sum = 0u; cnt = 0u; mine = 0u;
#pragma unroll
        for (unsigned j = 0; j < 16; ++j) { const unsigned c = xb_ld(&bar[XB_XCNT(j)]); sum += c; cnt += (c > 0u) ? 1u : 0u; mine = (j == x) ? c : mine; }
        if (sum == G) break;
        __builtin_amdgcn_s_sleep(1);
        if ((++sp & 255u) == 0u) { if (xb_ld(&bar[XB_TMO])) break; if (sp > XB_SPIN_CAP) { atomicAdd(&bar[XB_TMO], 1u); break; } }
    }
    nloc = mine > 0u ? mine : 1u; nx = cnt > 0u ? cnt : 1u;
}

__device__ __forceinline__ void xcd_barrier(const XcdBarrier& b) {
    asm volatile("s_waitcnt vmcnt(0)" ::: "memory");
    __syncthreads();
    if (TID_IS_ZERO(b.wave)) {
        unsigned* bar = b.bar;
        __builtin_amdgcn_s_waitcnt(0);
        unsigned nloc = b.st[0], nx = b.st[1];
        if (nloc == 0u) { xcd_barrier_complete(bar, b.x, nloc, nx); b.st[0] = nloc; b.st[1] = nx; }
        const unsigned old = xb_add(&bar[XB_XSUB(b.x)], 1u);
        const unsigned gen = old / nloc;
        if (old + 1u == (gen + 1u) * nloc) {
            __builtin_amdgcn_fence(__ATOMIC_RELEASE, "agent");
            asm volatile("s_waitcnt vmcnt(0)" ::: "memory");
            const unsigned og = xb_add(&bar[XB_TOP], 1u);
            const unsigned tg = og / nx;
            if (og + 1u == (tg + 1u) * nx) xb_add(&bar[XB_TOPGEN], 1u);
            else XB_SPIN(xb_ld(&bar[XB_TOPGEN]) == tg, bar);
            __builtin_amdgcn_fence(__ATOMIC_ACQUIRE, "agent");
            xb_add(&bar[XB_XGEN(b.x)], 1u);
            asm volatile("s_waitcnt vmcnt(0)" ::: "memory");
        } else {
            XB_SPIN(xb_ld(&bar[XB_XGEN(b.x)]) == gen, bar);
            __builtin_amdgcn_fence(__ATOMIC_ACQUIRE, "agent");
            asm volatile("s_waitcnt vmcnt(0)" ::: "memory");
        }
    }
    __syncthreads();
}


constexpr int NWAVES = 8, NTHR = 512;
constexpr int DM = 1024, TP = 16384, TS = 1024, TA = TP + TS, SEQ = 8192, NB_P = 2, NB_S = 128, LS = 8;
constexpr int N_IN = 3328;
constexpr int PASTL = 2048, PAGE = 128, NPAGES = 16;
constexpr float EPS = 1e-6f;
constexpr float LOG2E = 1.4426950408889634f;
constexpr float C2F = 0.125f * LOG2E;
constexpr float C2C = 0.0625f * LOG2E;

enum { I_XP = 0, I_XS, I_CFK, I_CFV, I_CFL, I_SGLA, I_CMK, I_CMV, I_PT, I_MEMP, I_GMIX, I_WIN, I_BFF, I_WG2, I_BG, I_GGO, I_WOUT, I_GCROSS, I_GMEM,
       I_WMK, I_WMV, I_WCQ, I_WCO, I_GFFN, I_PWQ, I_PSK, I_PU, I_PV, I_GFIN, N_INPUTS };
constexpr size_t O_YP = 0, O_YS = 16777216, O_FKP = 17825792, O_FVP = 26214400, O_LFP = 34603008, O_GSP = 34734080, O_MKP = 34799616, O_MVP = 35323904,
                 O_FKS = 35848192, O_FVS = 36372480, O_LFS = 36896768, O_GSS = 36904960, O_TOTAL = 41099264;

constexpr size_t MiB = 1u << 20;
constexpr size_t WS_CTL = 0, CTL_ZERO_BYTES = 1 * MiB;
constexpr size_t WS_WIN = 2 * MiB, WS_WOUT = 10 * MiB, WS_WMK = 12 * MiB, WS_WMV = 14 * MiB, WS_WCQ = 16 * MiB, WS_WCO = 18 * MiB, WS_WPK = 20 * MiB;
constexpr size_t WS_MB = 24 * MiB, WS_MK16 = 25 * MiB, WS_MVT16 = 26 * MiB, WS_KBIAS = 27 * MiB, WS_GDEC = 28 * MiB, WS_GG = 29 * MiB;
constexpr size_t WS_U16 = 32 * MiB, WS_V16 = 64 * MiB, WS_HB = 96 * MiB, WS_QF = 132 * MiB, WS_KF = 150 * MiB, WS_VF = 168 * MiB;
constexpr size_t WS_GQ = 186 * MiB, WS_GK = 204 * MiB, WS_GV = 222 * MiB, WS_GR = 256 * MiB, WS_SUF = 290 * MiB, WS_GKV = 298 * MiB;
constexpr size_t WS_MERGED = 330 * MiB, WS_X1 = 364 * MiB, WS_X2 = 432 * MiB, WS_QC = 500 * MiB, WS_PC = 534 * MiB, WS_OC = 566 * MiB, WS_SC = 600 * MiB;
constexpr size_t WS_MISC = 736 * MiB, WS_SS = 740 * MiB  , WS_BB = 744 * MiB, WS_END = 800 * MiB;
constexpr int CW_BAR = 4096;

constexpr int RING_BYTES = 131072;
constexpr int LDSCTL_OFF = RING_BYTES, MISC_OFF = LDSCTL_OFF + 320;
constexpr int ARGS_OFF = MISC_OFF + 128;
constexpr int LDS_BYTES = 147456;

struct Args { const void* in[N_INPUTS]; float* out; unsigned char* ws; };

__device__ __forceinline__ const void* ld_ptr(const LAS unsigned long long* p) { const unsigned long long v = *p; const unsigned lo = __builtin_amdgcn_readfirstlane((unsigned)v), hi = __builtin_amdgcn_readfirstlane((unsigned)(v >> 32)); return (const void*)(const GAS char*)(((unsigned long long)hi << 32) | lo); }
__device__ __forceinline__ Args load_args(const LAS unsigned long long* ARGP) { Args A;
    A.in[0] = ld_ptr(ARGP + 0);
    A.in[1] = ld_ptr(ARGP + 1);
    A.in[2] = ld_ptr(ARGP + 2);
    A.in[3] = ld_ptr(ARGP + 3);
    A.in[4] = ld_ptr(ARGP + 4);
    A.in[5] = ld_ptr(ARGP + 5);
    A.in[6] = ld_ptr(ARGP + 6);
    A.in[7] = ld_ptr(ARGP + 7);
    A.in[8] = ld_ptr(ARGP + 8);
    A.in[9] = ld_ptr(ARGP + 9);
    A.in[10] = ld_ptr(ARGP + 10);
    A.in[11] = ld_ptr(ARGP + 11);
    A.in[12] = ld_ptr(ARGP + 12);
    A.in[13] = ld_ptr(ARGP + 13);
    A.in[14] = ld_ptr(ARGP + 14);
    A.in[15] = ld_ptr(ARGP + 15);
    A.in[16] = ld_ptr(ARGP + 16);
    A.in[17] = ld_ptr(ARGP + 17);
    A.in[18] = ld_ptr(ARGP + 18);
    A.in[19] = ld_ptr(ARGP + 19);
    A.in[20] = ld_ptr(ARGP + 20);
    A.in[21] = ld_ptr(ARGP + 21);
    A.in[22] = ld_ptr(ARGP + 22);
    A.in[23] = ld_ptr(ARGP + 23);
    A.in[24] = ld_ptr(ARGP + 24);
    A.in[25] = ld_ptr(ARGP + 25);
    A.in[26] = ld_ptr(ARGP + 26);
    A.in[27] = ld_ptr(ARGP + 27);
    A.in[28] = ld_ptr(ARGP + 28);
    A.out = (float*)ld_ptr(ARGP + N_INPUTS); A.ws = (unsigned char*)ld_ptr(ARGP + N_INPUTS + 1); return A; }
struct Frame {
    LAS unsigned char* lds;
    int tid, lane, wave, vcu, G;
};

__device__ __forceinline__ float wave_sum(float v) {
#pragma unroll
    for (int o = 1; o < 64; o <<= 1) v += __shfl_xor(v, o);
    return v;
}
__device__ __forceinline__ float log_sigmoid(float x) { return fminf(x, 0.f) - log1pf(__expf(-fabsf(x))); }

__device__ __forceinline__ int win_src_col(int r) {
    if (r < 1536) return r;
    if (r < 1792) return 1544 + (r - 1536);
    if (r < 2048) return 1800 + (r - 1792);
    if (r < 2560) return 2056 + (r - 2048);
    if (r < 3072) return 2584 + (r - 2560);
    if (r < 3080) return 1536 + (r - 3072);
    if (r < 3096) return 2568 + (r - 3080);
    return -1;
}
template <bool WIN>
__device__ __forceinline__ void p0_transpose_item(const float* W, int ldw, int K, int nblk, bf16* WT, LAS float* scr, int item, int lane) {
    const int kb = item / nblk, nb = item % nblk, k0 = 64 * kb, n0 = 32 * nb;
    const int dr = n0 + (lane & 31); const int sc = WIN ? win_src_col(dr) : dr;
#pragma unroll 8
    for (int i = 0; i < 32; ++i) { const int kk = 2 * i + (lane >> 5); scr[kk * 33 + (lane & 31)] = (sc >= 0) ? W[(size_t)(k0 + kk) * ldw + sc] : 0.f; }
    LDS_WAIT(); asm volatile("" ::: "memory");
    const int c = lane & 7;
#pragma unroll
    for (int j = 0; j < 4; ++j) { const int n = (lane >> 3) + 8 * j; const LAS float* s = scr + (8 * c) * 33 + n;
        v4u o; o.x = pk2(s[0 * 33], s[1 * 33]); o.y = pk2(s[2 * 33], s[3 * 33]); o.z = pk2(s[4 * 33], s[5 * 33]); o.w = pk2(s[6 * 33], s[7 * 33]);
        *(GAS v4u*)(WT + (size_t)(n0 + n) * K + k0 + 8 * c) = o; }
    LDS_WAIT(); asm volatile("" ::: "memory");
}
__device__ __forceinline__ void rms_row_bf16(const float* xrow, const float* g, bf16* orow, int lane) {
    const f32x4* xr = (const f32x4*)xrow + lane; const f32x4* gr = (const f32x4*)g + lane;
    f32x4 v[4]; float s = 0.f;
#pragma unroll
    for (int j = 0; j < 4; ++j) { v[j] = xr[64 * j]; s += (v[j].x * v[j].x + v[j].y * v[j].y) + (v[j].z * v[j].z + v[j].w * v[j].w); }
    const float r = rsqrtf(wave_sum(s) * (1.f / DM) + EPS);
    v2u* o8 = (v2u*)orow + lane;
#pragma unroll
    for (int j = 0; j < 4; ++j) { const f32x4 gg = gr[64 * j]; v2u o; o.x = pk2(v[j].x * r * gg.x, v[j].y * r * gg.y); o.y = pk2(v[j].z * r * gg.z, v[j].w * r * gg.w); o8[64 * j] = o; }
}

using pg8::Unit;
struct EpiGen {
    static constexpr bool PERM = false, AFTER_DRAIN = false;
    float* d32; int ld32; bf16* d16; int ld16; float sc16;
    const float* r0; const float* r1; int rsplit; int ldr;
    const float* gcol;
    float* ssq;
    const float* rsq;
    __device__ __forceinline__ void operator()(const f32x4 (&acc)[2][2][4][2], const Unit& u, int wr, int wc, int fr, int fq) const {
        int row0 = u.pm * 256 + wr * 64 + fr, col0 = u.pn * 256 + wc * 32 + fq * 4;
        asm volatile("" : "+v"(row0), "+v"(col0));
#pragma unroll
        for (int ai = 0; ai < 2; ++ai)
#pragma unroll
            for (int m = 0; m < 4; ++m) { const int row = row0 + ai * 128 + m * 16;
                const float* rp = nullptr; if (r0) rp = (row < rsplit) ? r0 + (size_t)row * ldr : r1 + (size_t)(row - rsplit) * ldr;
                float rs = 1.f; if (rsq) rs = rsqrtf(rsq[row] * (1.f / 1024.f) + EPS);
                float ss = 0.f;
#pragma unroll
                for (int bj = 0; bj < 2; ++bj)
#pragma unroll
                    for (int n = 0; n < 2; ++n) { const int col = col0 + bj * 128 + n * 16; f32x4 v = acc[ai][bj][m][n];
                        if (rsq) { v[0] *= rs; v[1] *= rs; v[2] *= rs; v[3] *= rs; }
                        if (r0) v += *(const f32x4*)(rp + col);
                        if (d32) *(f32x4*)(d32 + (size_t)row * ld32 + col) = v;
                        if (ssq) ss += (v[0] * v[0] + v[1] * v[1]) + (v[2] * v[2] + v[3] * v[3]);
                        if (d16) { f32x4 w = v; if (gcol) w = w * *(const f32x4*)(gcol + col);
                            v2u o; o.x = pg8::cvt_pk_bf16(w[0] * sc16, w[1] * sc16); o.y = pg8::cvt_pk_bf16(w[2] * sc16, w[3] * sc16); *(v2u*)(d16 + (size_t)row * ld16 + col) = o; } }
                if (ssq) { ss += __shfl_xor(ss, 16); ss += __shfl_xor(ss, 32); if (fq == 0) atomicAdd(ssq + row, ss); } }
    }
};
struct EpiInProj {
    static constexpr bool PERM = false, AFTER_DRAIN = false;
    float* out; unsigned char* ws; const float* bff;
    __device__ __forceinline__ void operator()(const f32x4 (&acc)[2][2][4][2], const Unit& u, int wr, int wc, int fr, int fq) const {
        const int pn = u.pn; const bool smp = u.pm >= 64;
        int row0 = u.pm * 256 + wr * 64 + fr;
        int orow0 = (smp ? (u.pm - 64) * 256 : u.pm * 256) + wr * 64 + fr;
        asm volatile("" : "+v"(row0), "+v"(orow0));
        float* d32 = nullptr; int ld32 = 0; bool d32_grp = false; bf16* d16 = nullptr; int ld16 = 0; float s32 = 1.f, s16 = 1.f; int cb = 0;
        if (pn < 2) { d16 = (bf16*)(ws + WS_QF); ld16 = 512; s16 = C2F; cb = pn * 256; }
        else if (pn < 4) { d32 = out + (smp ? O_FKS : O_FKP); ld32 = 512; d32_grp = true; d16 = (bf16*)(ws + WS_KF); ld16 = 512; cb = (pn - 2) * 256; }
        else if (pn < 6) { d32 = out + (smp ? O_FVS : O_FVP); ld32 = 512; d32_grp = true; d16 = (bf16*)(ws + WS_VF); ld16 = 512; cb = (pn - 4) * 256; }
        else if (pn == 6) { d16 = (bf16*)(ws + WS_GQ); ld16 = 256; s16 = 0.125f; }
        else if (pn == 7) { d16 = (bf16*)(ws + WS_GK); ld16 = 256; }
        else if (pn < 10) { d16 = (bf16*)(ws + WS_GV); ld16 = 512; cb = (pn - 8) * 256; }
        else if (pn < 12) { d16 = (bf16*)(ws + WS_GR); ld16 = 512; cb = (pn - 10) * 256; }
        if (pn < 12) {
#pragma unroll
            for (int ai = 0; ai < 2; ++ai)
#pragma unroll
                for (int m = 0; m < 4; ++m) { const int row = row0 + ai * 128 + m * 16, orow = orow0 + ai * 128 + m * 16;
#pragma unroll
                    for (int bj = 0; bj < 2; ++bj)
#pragma unroll
                        for (int n = 0; n < 2; ++n) { const int col = cb + wc * 32 + fq * 4 + bj * 128 + n * 16; const f32x4 v = acc[ai][bj][m][n];
                            if (d32) *(f32x4*)(d32 + (size_t)(d32_grp ? orow : row) * ld32 + col) = v * s32;
                            if (d16) { v2u o; o.x = pg8::cvt_pk_bf16(v[0] * s16, v[1] * s16); o.y = pg8::cvt_pk_bf16(v[2] * s16, v[3] * s16); *(v2u*)(d16 + (size_t)row * ld16 + col) = o; } } }
        } else {
            if (wc == 0) {
                float* lf = out + (smp ? O_LFS : O_LFP); float* ggp = (float*)(ws + WS_GG);
#pragma unroll
                for (int ai = 0; ai < 2; ++ai)
#pragma unroll
                    for (int m = 0; m < 4; ++m) { const int row = row0 + ai * 128 + m * 16, orow = orow0 + ai * 128 + m * 16;
#pragma unroll
                        for (int n = 0; n < 2; ++n) { const int col = n * 16 + fq * 4; const f32x4 v = acc[ai][0][m][n];
                            if (col < 8) { f32x4 o; const f32x4 b = *(const f32x4*)(bff + col);
                                o[0] = log_sigmoid(v[0] + b[0]); o[1] = log_sigmoid(v[1] + b[1]); o[2] = log_sigmoid(v[2] + b[2]); o[3] = log_sigmoid(v[3] + b[3]);
                                *(f32x4*)(lf + (size_t)orow * 8 + col) = o; }
                            else if (col < 24) *(f32x4*)(ggp + (size_t)row * 16 + (col - 8)) = v; } }
            }
        }
    }
};


__device__ __forceinline__ void p0_prologue(const Frame& F, const Args& a) {
    unsigned char* ws = a.ws;
    LAS float* scr = (LAS float*)(F.lds + F.wave * 16384);
    const int gw = F.vcu * NWAVES + F.wave, NGW = F.G * NWAVES;
    constexpr int I_WINN = 16 * (N_IN / 32), I_SQ = 16 * 32;
    constexpr int NITEMS = I_WINN + 5 * I_SQ;
    for (int it = (gw + NGW / 2) % NGW; it < NITEMS; it += NGW) {
        int r = it;
        if (r < I_WINN) { p0_transpose_item<true>((const float*)a.in[I_WIN], 3096, DM, N_IN / 32, (bf16*)(ws + WS_WIN), scr, r, F.lane); continue; } r -= I_WINN;
        const int which = r / I_SQ; r -= which * I_SQ;
        const float* src = (const float*)(which == 0 ? a.in[I_WOUT] : which == 1 ? a.in[I_WMK] : which == 2 ? a.in[I_WMV] : which == 3 ? a.in[I_WCQ] : a.in[I_WCO]);
        bf16* dst = (bf16*)(ws + (which == 0 ? WS_WOUT : which == 1 ? WS_WMK : which == 2 ? WS_WMV : which == 3 ? WS_WCQ : WS_WCO));
        p0_transpose_item<false>(src, DM, DM, 32, dst, scr, r, F.lane);
    }
    { float* ssz = (float*)(ws + WS_SS); for (int i = F.vcu * NTHR + F.tid; i < 2 * TA; i += F.G * NTHR) ssz[i] = 0.f; }
    for (int m0 = gw * 2; m0 < TA + 512; m0 += NGW * 2) {
        const float* xr[2]; const float* gr[2]; bf16* orow[2];
#pragma unroll
        for (int j = 0; j < 2; ++j) { const int m = m0 + j;
            if (m < TP) { xr[j] = (const float*)a.in[I_XP] + (size_t)m * DM; gr[j] = (const float*)a.in[I_GMIX]; orow[j] = (bf16*)(ws + WS_HB) + (size_t)m * DM; }
            else if (m < TA) { xr[j] = (const float*)a.in[I_XS] + (size_t)(m - TP) * DM; gr[j] = (const float*)a.in[I_GMIX]; orow[j] = (bf16*)(ws + WS_HB) + (size_t)m * DM; }
            else { xr[j] = (const float*)a.in[I_MEMP] + (size_t)(m - TA) * DM; gr[j] = (const float*)a.in[I_GMEM]; orow[j] = (bf16*)(ws + WS_MB) + (size_t)(m - TA) * DM; } }
        f32x4 v[2][4]; float s[2];
#pragma unroll
        for (int j = 0; j < 2; ++j) { s[j] = 0.f;
#pragma unroll
            for (int q = 0; q < 4; ++q) v[j][q] = ((const f32x4*)xr[j])[F.lane + 64 * q]; }
#pragma unroll
        for (int j = 0; j < 2; ++j) {
#pragma unroll
            for (int q = 0; q < 4; ++q) s[j] += (v[j][q].x * v[j][q].x + v[j][q].y * v[j][q].y) + (v[j][q].z * v[j][q].z + v[j][q].w * v[j][q].w);
            const float r = rsqrtf(wave_sum(s[j]) * (1.f / DM) + EPS);
#pragma unroll
            for (int q = 0; q < 4; ++q) { const f32x4 gg = ((const f32x4*)gr[j])[F.lane + 64 * q]; v2u o; o.x = pk2(v[j][q].x * r * gg.x, v[j][q].y * r * gg.y); o.y = pk2(v[j][q].z * r * gg.z, v[j][q].w * r * gg.w); ((v2u*)orow[j])[F.lane + 64 * q] = o; } }
    }
    {
        for (int r0 = gw * 4; r0 < 2 * 16384; r0 += NGW * 4) {
            f32x4 x[4][4];
#pragma unroll
            for (int j = 0; j < 4; ++j) { const int r = r0 + j; const bool isv = r >= 16384; const int e = isv ? r - 16384 : r;
                const f32x4* s = (const f32x4*)((const float*)(isv ? a.in[I_PV] : a.in[I_PU]) + (size_t)e * DM + 16 * F.lane);
#pragma unroll
                for (int q = 0; q < 4; ++q) x[j][q] = __builtin_nontemporal_load(s + q); }
#pragma unroll
            for (int j = 0; j < 4; ++j) { const int r = r0 + j; const bool isv = r >= 16384; const int e = isv ? r - 16384 : r; float am = 0.f;
#pragma unroll
                for (int q = 0; q < 4; ++q) am = fmaxf(am, fmaxf(fmaxf(fabsf(x[j][q].x), fabsf(x[j][q].y)), fmaxf(fabsf(x[j][q].z), fabsf(x[j][q].w))));
#pragma unroll
                for (int o = 1; o < 64; o <<= 1) am = fmaxf(am, __shfl_xor(am, o));
                const float inv = am > 0.f ? 448.f / am : 0.f;
                v4u o4;
#pragma unroll
                for (int q = 0; q < 4; ++q) { int pk = __builtin_amdgcn_cvt_pk_fp8_f32(x[j][q].x * inv, x[j][q].y * inv, 0, false); pk = __builtin_amdgcn_cvt_pk_fp8_f32(x[j][q].z * inv, x[j][q].w * inv, pk, true); o4[q] = (unsigned)pk; }
                *(v4u*)(ws + (isv ? WS_V16 : WS_U16) + (size_t)e * DM + 16 * F.lane) = o4;
                if (F.lane == 0) ((float*)(ws + WS_MISC))[r] = am * (1.f / 448.f); }
        }
    }
    __syncthreads();
    for (int it = blockIdx.x; it < 256; it += F.G) {
        const int c = it >> 4, kt = it & 15, half = c & 1;
        LAS float* SK = (LAS float*)F.lds; LAS float* WT = (LAS float*)(F.lds + 128 * 129 * 4);
        const float* sk = (const float*)a.in[I_PSK] + (size_t)half * 128 * 128; const float* wq = (const float*)a.in[I_PWQ] + (size_t)(kt * 64) * 2048 + c * 128;
#pragma unroll 4
        for (int i = 0; i < 32; ++i) { const int idx = F.tid + 512 * i; SK[(idx >> 7) * 129 + (idx & 127)] = sk[idx]; }
#pragma unroll 4
        for (int i = 0; i < 16; ++i) { const int idx = F.tid + 512 * i; WT[(idx >> 7) * 129 + (idx & 127)] = wq[(size_t)(idx >> 7) * 2048 + (idx & 127)]; }
        __syncthreads();
        const int tk = F.tid & 15, tkey = F.tid >> 4;
        float acc[4][4];
#pragma unroll
        for (int i = 0; i < 4; ++i)
#pragma unroll
            for (int j = 0; j < 4; ++j) acc[i][j] = 0.f;
        for (int j = 0; j < 128; ++j) {
            float av[4], bv[4];
#pragma unroll
            for (int i = 0; i < 4; ++i) { av[i] = SK[(4 * tkey + i) * 129 + j]; bv[i] = WT[(4 * tk + i) * 129 + j]; }
#pragma unroll
            for (int i = 0; i < 4; ++i)
#pragma unroll
                for (int i2 = 0; i2 < 4; ++i2) acc[i][i2] += av[i] * bv[i2];
        }
        bf16* wp = (bf16*)(ws + WS_WPK);
#pragma unroll
        for (int i = 0; i < 4; ++i) { v2u o; o.x = pk2(acc[i][0], acc[i][1]); o.y = pk2(acc[i][2], acc[i][3]); *(v2u*)(wp + (size_t)(c * 128 + 4 * tkey + i) * DM + kt * 64 + 4 * tk) = o; }
        __syncthreads();
    }
}


__device__ __forceinline__ void fox_prompt_cumsum(const Frame& F, const float* logf  , float* kbias, int b) {
    LAS float* WT = (LAS float*)F.lds;
    const int t0 = F.wave * 1024 + F.lane * 16;
    const f32x4* src = (const f32x4*)(logf + ((size_t)b * SEQ + t0) * 8);
    float s[8];
#pragma unroll
    for (int h = 0; h < 8; ++h) s[h] = 0.f;
#pragma unroll 4
    for (int i = 0; i < 16; ++i) { const f32x4 a = src[2 * i], c = src[2 * i + 1]; s[0] += a.x; s[1] += a.y; s[2] += a.z; s[3] += a.w; s[4] += c.x; s[5] += c.y; s[6] += c.z; s[7] += c.w; }
    float ex[8];
#pragma unroll
    for (int h = 0; h < 8; ++h) { float v = s[h];
#pragma unroll
        for (int o = 1; o < 64; o <<= 1) { const float t = __shfl_up(v, o); if (F.lane >= o) v += t; }
        ex[h] = v - s[h];
        if (F.lane == 63) WT[F.wave * 8 + h] = v; }
    __syncthreads();
#pragma unroll
    for (int h = 0; h < 8; ++h) { float c = 0.f; for (int w = 0; w < F.wave; ++w) c += WT[w * 8 + h]; ex[h] += c; }
    float* dst = kbias + (size_t)(b * 8) * SEQ + t0;
#pragma unroll 4
    for (int i = 0; i < 16; ++i) { const f32x4 a = src[2 * i], c = src[2 * i + 1];
        ex[0] += a.x; ex[1] += a.y; ex[2] += a.z; ex[3] += a.w; ex[4] += c.x; ex[5] += c.y; ex[6] += c.z; ex[7] += c.w;
#pragma unroll
        for (int h = 0; h < 8; ++h) dst[(size_t)h * SEQ + i] = -ex[h] * LOG2E; }
    __syncthreads();
}
__device__ __forceinline__ void fox_sample_suffix(const Frame& F, const float* cfl, const int* pt, float* suf, int bs) {
    float carry[8];
#pragma unroll
    for (int h = 0; h < 8; ++h) carry[h] = 0.f;
    const int mypg = pt[bs * NPAGES + (F.lane & 15)];
#pragma unroll 1
    for (int pb = NPAGES - 4; pb >= 0; pb -= 4) {
        f32x4 x[4][4];
#pragma unroll
        for (int j = 0; j < 4; ++j) { const int pg = __builtin_amdgcn_readlane(mypg, 0) * 0 + __shfl(mypg, pb + j); const f32x4* src = (const f32x4*)(cfl + ((size_t)pg * PAGE + 2 * F.lane) * 8);
            x[j][0] = src[0]; x[j][1] = src[1]; x[j][2] = src[2]; x[j][3] = src[3]; }
#pragma unroll
        for (int j = 3; j >= 0; --j) { const int p = pb + j;
            const float ra[8] = {x[j][0].x, x[j][0].y, x[j][0].z, x[j][0].w, x[j][1].x, x[j][1].y, x[j][1].z, x[j][1].w}, rb[8] = {x[j][2].x, x[j][2].y, x[j][2].z, x[j][2].w, x[j][3].x, x[j][3].y, x[j][3].z, x[j][3].w};
#pragma unroll
            for (int h = 0; h < 8; ++h) {
                const float ps = ra[h] + rb[h]; float v = ps;
#pragma unroll
                for (int o = 1; o < 64; o <<= 1) { const float t = __shfl_down(v, o); if (F.lane + o < 64) v += t; }
                const float exs = v - ps;
                float* d = suf + (size_t)(bs * 8 + h) * PASTL + p * PAGE + 2 * F.lane;
                *(f32x2*)d = (f32x2){(carry[h] + exs + rb[h]) * LOG2E, (carry[h] + exs) * LOG2E};
                carry[h] += __shfl(v, 0);
            }
        }
    }
}

__device__ __forceinline__ void gla_gate_tile(const Frame& F, const float* gg, const float* w2, const float* bg, int row0, int h, int nt, LAS float* LA, LAS float* GGS) {
    for (int e = F.tid; e < nt * 16; e += NTHR) GGS[e] = gg[(size_t)row0 * 16 + e];
    const int dk = F.tid & 63; float wc[16];
#pragma unroll
    for (int r = 0; r < 16; ++r) wc[r] = w2[r * 256 + h * 64 + dk];
    const float bb = bg[h * 64 + dk];
    __syncthreads();
    for (int t = F.tid >> 6; t < nt; t += 8) { float z = bb;
#pragma unroll
        for (int q = 0; q < 4; ++q) { const f32x4 g4 = *(const LAS f32x4*)(GGS + t * 16 + 4 * q); z += g4.x * wc[4 * q] + g4.y * wc[4 * q + 1] + g4.z * wc[4 * q + 2] + g4.w * wc[4 * q + 3]; }
        LA[t * 64 + dk] = log_sigmoid(z) * (1.f / 16.f); }
}
__device__ __forceinline__ void gla_cumsum64(const Frame& F, LAS float* LA, LAS float* SEG) {
    const int dk = F.lane, w = F.wave; float v[8]; float run = 0.f;
#pragma unroll
    for (int i = 0; i < 8; ++i) { run += LA[(8 * w + i) * 64 + dk]; v[i] = run; }
    SEG[w * 64 + dk] = run;
    __syncthreads();
    float pre = 0.f;
    for (int j = 0; j < w; ++j) pre += SEG[j * 64 + dk];
#pragma unroll
    for (int i = 0; i < 8; ++i) LA[(8 * w + i) * 64 + dk] = v[i] + pre;
    __syncthreads();
}
template <int SB>
__device__ __forceinline__ bf16x8 tr_frag(LAS unsigned char* base, int ks) {
    const s16x4 lo = lds_tr16(base + ks * 16 * SB), hi4 = lds_tr16(base + ks * 16 * SB + 8 * SB);
    return (bf16x8){lo[0], lo[1], lo[2], lo[3], hi4[0], hi4[1], hi4[2], hi4[3]};
}
__device__ __forceinline__ bf16x8 row_frag(const LAS unsigned char* rowp, int ks, int hi) {
    const v2u lo = *(const LAS v2u*)(rowp + (16 * ks + 4 * hi) * 2), hi2 = *(const LAS v2u*)(rowp + (16 * ks + 8 + 4 * hi) * 2);
    return __builtin_bit_cast(bf16x8, (v4u){lo.x, lo.y, hi2.x, hi2.y});
}
__device__ __forceinline__ void gla_g1_unit(const Frame& F, const Args& a, int u) {
    unsigned char* ws = a.ws;
    const int b = u >> 9, h = (u >> 7) & 3, n = u & 127; const int row0 = b * SEQ + n * 64;
    LAS float* LA = (LAS float*)F.lds; LAS float* SEG = LA + 4096; LAS float* GGS = SEG + 512; LAS unsigned char* KRB = F.lds + 22528; LAS unsigned char* VSB = F.lds + 34816;
    v4u vq[2];
#pragma unroll
    for (int i = 0; i < 2; ++i) { const int c = F.tid + NTHR * i; vq[i] = *(const v4u*)((const bf16*)(ws + WS_GV) + (size_t)(row0 + (c >> 4)) * 512 + h * 128 + (c & 15) * 8); }
    float gkv[8];
#pragma unroll
    for (int i = 0; i < 8; ++i) { const int e = F.tid + NTHR * i; gkv[i] = GLD(ws + WS_GK)[(size_t)(row0 + (e >> 6)) * 256 + h * 64 + (e & 63)]; }
    gla_gate_tile(F, (const float*)(ws + WS_GG), (const float*)a.in[I_WG2], (const float*)a.in[I_BG], row0, h, 64, LA, GGS);
#pragma unroll
    for (int i = 0; i < 2; ++i) { const int c = F.tid + NTHR * i; *(LAS v4u*)(VSB + (c >> 4) * 320 + (c & 15) * 16) = vq[i]; }
    __syncthreads();
    gla_cumsum64(F, LA, SEG);
    if (F.tid < 64) ((float*)(ws + WS_GDEC))[(size_t)((b * 4 + h) * 128 + n) * 64 + F.tid] = __expf(LA[63 * 64 + F.tid]);
    float* bbuf = (float*)(ws + WS_BB);
#pragma unroll
    for (int i = 0; i < 8; ++i) { const int e = F.tid + NTHR * i; const int t = e >> 6, dk = e & 63; const float bb = LA[e]; bbuf[(size_t)(row0 + t) * 256 + h * 64 + dk] = bb;
        *(LAS unsigned short*)(KRB + t * 192 + dk * 2) = (unsigned short)f2bf(gkv[i] * __expf(LA[63 * 64 + dk] - bb)); }
    __syncthreads();
    {
        const int lane = F.lane, r32 = lane & 31, hi = lane >> 5, mb = F.wave >> 2, nb = F.wave & 3;
        const int tb = (4 * hi + ((lane & 15) >> 2)), tc = (16 * ((lane >> 4) & 1) + 4 * (lane & 3)) * 2;
        LAS unsigned char* abase = KRB + tb * 192 + tc + 64 * mb; LAS unsigned char* bbase = VSB + tb * 320 + tc + 64 * nb;
        f32x16 acc = {};
#pragma unroll
        for (int ks = 0; ks < 4; ++ks) acc = __builtin_amdgcn_mfma_f32_32x32x16_bf16(tr_frag<192>(abase, ks), tr_frag<320>(bbase, ks), acc, 0, 0, 0);
        float* kv = (float*)(ws + WS_GKV) + ((size_t)((b * 4 + h) * 128 + n) * 64 + 32 * mb) * 128 + 32 * nb + r32;
#pragma unroll
        for (int r = 0; r < 16; ++r) kv[(size_t)crow(r, hi) * 128] = acc[r];
    }
    __syncthreads();
}
__device__ __forceinline__ void gla_scan(const Frame& F, const Args& a) {
    int tid = F.wave * 64 + lane_id(); asm volatile("" : "+v"(tid));
    if (tid >= 256) return;
    for (int e = F.vcu * 256 + tid; e < 65536; e += F.G * 256) {
    const int bh = e >> 13, dk = (e >> 7) & 63, dv = e & 127;
    float* kv = (float*)(a.ws + WS_GKV) + ((size_t)bh * 128 * 64 + dk) * 128 + dv; const float* dc = (const float*)(a.ws + WS_GDEC) + (size_t)bh * 128 * 64 + dk;
    float S = 0.f;
#pragma unroll 1
    for (int n0 = 0; n0 < 128; n0 += 32) { float kvv[32], dd[32];
#pragma unroll
        for (int j = 0; j < 32; ++j) { kvv[j] = kv[(size_t)(n0 + j) * 8192]; dd[j] = dc[(size_t)(n0 + j) * 64]; }
#pragma unroll
        for (int j = 0; j < 32; ++j) { kv[(size_t)(n0 + j) * 8192] = S; S = dd[j] * S + kvv[j]; } }
    a.out[O_GSP + (size_t)bh * 8192 + dk * 128 + dv] = S;
    }
}
__device__ __forceinline__ float silu(float x) { return x / (1.f + __expf(-x)); }
__device__ __forceinline__ void gla_sample_unit(const Frame& F, const Args& a, int u) {
    unsigned char* ws = a.ws;
    const int bs = u >> 2, h = u & 3; const int row0 = TP + bs * LS;
    LAS float* LA = (LAS float*)F.lds; LAS float* BL = LA + 512; LAS float* QD = BL + 64; LAS float* KI = QD + 512; LAS float* KR = KI + 512; LAS float* ATT = KR + 512; LAS float* OP = ATT + 64; LAS float* VS = OP + 4096;
    gla_gate_tile(F, (const float*)(ws + WS_GG), (const float*)a.in[I_WG2], (const float*)a.in[I_BG], row0, h, 8, LA, VS + 1024);
#pragma unroll
    for (int i = 0; i < 2; ++i) { const int e = F.tid + NTHR * i; VS[e] = GLD(ws + WS_GV)[(size_t)(row0 + (e >> 7)) * 512 + h * 128 + (e & 127)]; }
    __syncthreads();
    if (F.tid < 64) { float run = 0.f;
#pragma unroll
        for (int t = 0; t < 8; ++t) { run += LA[t * 64 + F.tid]; LA[t * 64 + F.tid] = run; } BL[F.tid] = run; }
    __syncthreads();
    { const int e = F.tid, t = e >> 6, dk = e & 63; const float bb = LA[e];
      const float q = GLD(ws + WS_GQ)[(size_t)(row0 + t) * 256 + h * 64 + dk], k = GLD(ws + WS_GK)[(size_t)(row0 + t) * 256 + h * 64 + dk];
      QD[e] = q * __expf(bb); KI[e] = k * __expf(-bb); KR[e] = k * __expf(BL[dk] - bb); }
    __syncthreads();
    if (F.tid < 64) { const int t = F.tid >> 3, s = F.tid & 7; float acc = 0.f;
        if (s <= t) { for (int dk = 0; dk < 64; ++dk) acc += QD[t * 64 + dk] * KI[s * 64 + dk]; }
        ATT[F.tid] = acc; }
    const int dv = F.tid & 127, dkg = F.tid >> 7;
    {
        const float* st = (const float*)a.in[I_SGLA] + ((size_t)(bs * 4 + h) * 64 + dkg * 16) * 128 + dv;
        float S0[16];
#pragma unroll
        for (int i = 0; i < 16; ++i) S0[i] = st[(size_t)i * 128];
#pragma unroll
        for (int t = 0; t < 8; ++t) { float o = 0.f;
#pragma unroll
            for (int i = 0; i < 16; ++i) o += QD[t * 64 + dkg * 16 + i] * S0[i];
            OP[(dkg * 8 + t) * 128 + dv] = o; }
        float* so = a.out + O_GSS + ((size_t)(bs * 4 + h) * 64 + dkg * 16) * 128 + dv;
#pragma unroll
        for (int i = 0; i < 16; ++i) { float sn = __expf(BL[dkg * 16 + i]) * S0[i];
#pragma unroll
            for (int t = 0; t < 8; ++t) sn += KR[t * 64 + dkg * 16 + i] * VS[t * 128 + dv];
            so[(size_t)i * 128] = sn; }
    }
    __syncthreads();
    {
        const int t = F.wave; float o[2]; float ss = 0.f;
#pragma unroll
        for (int j = 0; j < 2; ++j) { const int d = 2 * F.lane + j; float v = OP[(0 * 8 + t) * 128 + d] + OP[(1 * 8 + t) * 128 + d] + OP[(2 * 8 + t) * 128 + d] + OP[(3 * 8 + t) * 128 + d];
            for (int s = 0; s <= t; ++s) v += ATT[t * 8 + s] * VS[s * 128 + d];
            o[j] = v; ss += v * v; }
        const float r = rsqrtf(wave_sum(ss) * (1.f / 128.f) + EPS);
        const float* ggo = (const float*)a.in[I_GGO] + h * 128 + 2 * F.lane; const BfPtr gr = GLD(ws + WS_GR) + ((size_t)(row0 + t) * 512 + h * 128 + 2 * F.lane);
        const float y0 = o[0] * r * ggo[0] * silu(gr[0]), y1 = o[1] * r * ggo[1] * silu(gr[1]);
        *(unsigned*)((bf16*)(ws + WS_MERGED) + (size_t)(row0 + t) * DM + 512 + h * 128 + 2 * F.lane) = pk2(y0, y1);
    }
    __syncthreads();
}


__device__ __forceinline__ float fexp2(float x) { return __builtin_amdgcn_exp2f(x); }
constexpr float FOX_SKIP = 160.f;


__device__ __forceinline__ void fox_norms_item(const Frame& F, const bf16* QF, const bf16* KF, const float* logf, float* FN, float* LC, float* BT, int item) {
    const int bh = item >> 5, qb = item & 31, b = bh >> 3, h = bh & 7;
    float qm = 0.f, km = 0.f;
    const float* lp = logf + ((size_t)b * SEQ + qb * 256 + 4 * F.lane) * 8 + h;
    const float l0 = lp[0], l1 = lp[8], l2 = lp[16], l3 = lp[24];
#pragma unroll 8
    for (int i = 0; i < 32; ++i) { const size_t row = (size_t)b * SEQ + qb * 256 + i * 8 + (F.lane >> 3);
        const v4u q = *(const v4u*)(QF + row * 512 + h * 64 + (F.lane & 7) * 8), k = *(const v4u*)(KF + row * 512 + h * 64 + (F.lane & 7) * 8); float qs = 0.f, ks = 0.f;
#pragma unroll
        for (int j = 0; j < 4; ++j) { qs += bflo(q[j]) * bflo(q[j]) + bfhi(q[j]) * bfhi(q[j]); ks += bflo(k[j]) * bflo(k[j]) + bfhi(k[j]) * bfhi(k[j]); }
        qs += __shfl_xor(qs, 1); qs += __shfl_xor(qs, 2); qs += __shfl_xor(qs, 4); ks += __shfl_xor(ks, 1); ks += __shfl_xor(ks, 2); ks += __shfl_xor(ks, 4);
        qm = fmaxf(qm, qs); km = fmaxf(km, ks); }
#pragma unroll
    for (int o = 1; o < 64; o <<= 1) { qm = fmaxf(qm, __shfl_xor(qm, o)); km = fmaxf(km, __shfl_xor(km, o)); }
    const float c0 = l0, c1 = c0 + l1, c2 = c1 + l2, c3 = c2 + l3; float v = c3;
#pragma unroll
    for (int o = 1; o < 64; o <<= 1) { const float t = __shfl_up(v, o); if (F.lane >= o) v += t; }
    const float ex = v - c3;
    *(f32x4*)(LC + (size_t)bh * SEQ + qb * 256 + 4 * F.lane) = (f32x4){ex + c0, ex + c1, ex + c2, ex + c3};
    if (F.lane == 63) BT[item] = v;
    if (F.lane == 0) { FN[item * 2] = qm; FN[item * 2 + 1] = km; }
}
__device__ __forceinline__ void fox_suffix_item(const Frame& F, const float* cfl, const int* pt, float* SW, float* PTOT, int item) {
    const int bs = item >> 4, p = item & 15; const int pg = __builtin_amdgcn_readfirstlane(pt[item]);
    const f32x4* src = (const f32x4*)(cfl + ((size_t)pg * PAGE + 2 * F.lane) * 8);
    const f32x4 a0 = src[0], a1 = src[1], b0 = src[2], b1 = src[3];
    const float ra[8] = {a0.x, a0.y, a0.z, a0.w, a1.x, a1.y, a1.z, a1.w}, rb[8] = {b0.x, b0.y, b0.z, b0.w, b1.x, b1.y, b1.z, b1.w};
#pragma unroll
    for (int h = 0; h < 8; ++h) {
        const float ps = ra[h] + rb[h]; float v = ps;
#pragma unroll
        for (int o = 1; o < 64; o <<= 1) { const float t = __shfl_down(v, o); if (F.lane + o < 64) v += t; }
        const float exs = v - ps;
        *(f32x2*)(SW + (size_t)(bs * 8 + h) * PASTL + p * PAGE + 2 * F.lane) = (f32x2){exs + rb[h], exs};
        if (F.lane == 0) PTOT[(bs * 8 + h) * NPAGES + p] = v;
    }
}
__device__ __forceinline__ void fox_attn_unit(const Frame& F, const bf16* QF, const bf16* KF, const bf16* VF, const float* LC, const float* BT, const float* FN, bf16* merged, int b, int h, int qb) {
    int tid = F.wave * 64 + lane_id(); asm volatile("" : "+v"(tid));
    const int lane = tid & 63, r32 = lane & 31, hi = lane >> 5, wid = F.wave;
    const size_t rowbase = (size_t)b * SEQ; const int q0 = qb * 256;
    LAS unsigned char* Ks = F.lds; LAS unsigned char* Vs = F.lds + 8192; LAS float* KBs = (LAS float*)(F.lds + 20480); LAS float* WSF = (LAS float*)(F.lds + 20736) + wid * 32;
    const bf16* Qw = QF + (rowbase + q0 + wid * 32 + r32) * 512 + h * 64;
    bf16x8 qr[4];
#pragma unroll
    for (int d0 = 0; d0 < 4; ++d0) qr[d0] = *(const bf16x8*)(Qw + d0 * 16 + hi * 8);
    const float* lcp = LC + (size_t)(b * 8 + h) * SEQ;
    float pbx; { const float btv = (lane < 32) ? BT[(b * 8 + h) * 32 + lane] : 0.f; float v = btv;
#pragma unroll
        for (int o = 1; o < 64; o <<= 1) { const float t = __shfl_up(v, o); if (lane >= o) v += t; }
        pbx = v - btv; }
    const float cref = lcp[q0] + __shfl(pbx, qb);
#define FOX_KB(t_, pos_) (-LOG2E * ((lcp[pos_] + __shfl(pbx, (t_) >> 2)) - cref))
    const int NT = (q0 + 256) / 64;
    int t0 = 0;
    {
        float kn = (lane < 32) ? FN[((b * 8 + h) * 32 + lane) * 2 + 1] : 0.f;
#pragma unroll
        for (int o = 1; o < 64; o <<= 1) kn = fmaxf(kn, __shfl_xor(kn, o));
        const float qk2 = 2.f * sqrtf(FN[((b * 8 + h) * 32 + qb) * 2]) * sqrtf(kn) * 1.01f;
        const int nbefore = q0 / 64;
        int found = -1;
        for (int base = 0; base < nbefore && found < 0; base += 64) {
            const int tl = nbefore - 1 - base - lane;
            const int tlc = tl < 0 ? 0 : tl; const float kbl = -LOG2E * ((lcp[tlc * 64 + 63] + __shfl(pbx, tlc >> 2)) - cref);
            const bool dead = (tl >= 0) && (qk2 + kbl < -FOX_SKIP);
            const unsigned long long bm = __ballot(dead);
            if (bm) found = nbefore - 1 - base - (int)__builtin_ctzll(bm);
        }
        t0 = found + 1;
        t0 = __builtin_amdgcn_readfirstlane(t0);
    }
    const int kkey = tid & 63, kch = tid >> 6, vkey = tid >> 3, vch = tid & 7;
    const bf16* ksrc = KF + (rowbase + kkey) * 512 + h * 64 + kch * 8;
    const bf16* vsrc = VF + (rowbase + vkey) * 512 + h * 64 + vch * 8;
    v4u kreg[2], vreg[2]; float kbreg[2];
#pragma unroll
    for (int hb = 0; hb < 2; ++hb) { const int tt = (t0 + hb < NT) ? t0 + hb : t0;
        kreg[hb] = *(const v4u*)(ksrc + (size_t)tt * 64 * 512); vreg[hb] = *(const v4u*)(vsrc + (size_t)tt * 64 * 512); kbreg[hb] = FOX_KB(tt, tt * 64 + (tid & 63)); }
    float m_run = -INFINITY, l_run = 0.f; f32x16 o0 = {}, o1 = {};
    const int qpos = q0 + wid * 32 + r32;
    const int vbase = (4 * hi + ((lane & 15) >> 2)) * 192 + (16 * ((lane >> 4) & 1) + 4 * (lane & 3)) * 2;
    LAS unsigned char* const Ks0 = Ks; LAS unsigned char* const Vs0 = Vs; LAS float* const KBs0 = KBs;
    __syncthreads();
    for (int t2 = t0; t2 < NT; t2 += 2) {
#pragma unroll
      for (int hb = 0; hb < 2; ++hb) {
        const int t = t2 + hb;
        if (t < NT) {
        LAS unsigned char* const Ks = Ks0 + hb * 28672; LAS unsigned char* const Vs = Vs0 + hb * 28672; LAS float* const KBs = (LAS float*)((LAS unsigned char*)KBs0 + hb * 28672);
        *(LAS v4u*)(Ks + kch * 1024 + kkey * 16) = kreg[hb]; *(LAS v4u*)(Vs + vkey * 192 + vch * 16) = vreg[hb]; if (tid < 64) KBs[tid] = kbreg[hb];
        __syncthreads();
        if (t + 2 < NT) { kreg[hb] = *(const v4u*)(ksrc + (size_t)(t + 2) * 64 * 512); vreg[hb] = *(const v4u*)(vsrc + (size_t)(t + 2) * 64 * 512); kbreg[hb] = FOX_KB(t + 2, (t + 2) * 64 + (tid & 63)); }
        const int k0 = t * 64;
        if (k0 <= q0 + wid * 32 + 31) {
        f32x16 p0, p1;
#pragma unroll
        for (int g = 0; g < 4; ++g) { const f32x4 ba = *(const LAS f32x4*)(KBs + 8 * g + 4 * hi), bb = *(const LAS f32x4*)(KBs + 32 + 8 * g + 4 * hi);
#pragma unroll
            for (int i = 0; i < 4; ++i) { p0[4 * g + i] = ba[i]; p1[4 * g + i] = bb[i]; } }
#pragma unroll
        for (int d0 = 0; d0 < 4; ++d0) {
            const bf16x8 a0 = *(const LAS bf16x8*)(Ks + (2 * d0 + hi) * 1024 + r32 * 16), a1 = *(const LAS bf16x8*)(Ks + (2 * d0 + hi) * 1024 + r32 * 16 + 512);
            p0 = __builtin_amdgcn_mfma_f32_32x32x16_bf16(a0, qr[d0], p0, 0, 0, 0); p1 = __builtin_amdgcn_mfma_f32_32x32x16_bf16(a1, qr[d0], p1, 0, 0, 0);
        }
        if (k0 + 63 > q0 + wid * 32) {
#pragma unroll
            for (int r = 0; r < 16; ++r) { const int key = k0 + crow(r, hi); if (key > qpos) p0[r] = -INFINITY; if (key + 32 > qpos) p1[r] = -INFINITY; }
        }
        float mx = fmaxf(p0[0], p1[0]);
#pragma unroll
        for (int r = 1; r < 16; ++r) mx = fmaxf(mx, fmaxf(p0[r], p1[r]));
        mx = fmaxf(mx, __shfl_xor(mx, 32));
        const float m_new = fmaxf(m_run, mx), alpha = fexp2(m_run - m_new); m_run = m_new;
        float ls = 0.f;
#pragma unroll
        for (int r = 0; r < 16; ++r) { p0[r] = fexp2(p0[r] - m_new); p1[r] = fexp2(p1[r] - m_new); ls += p0[r] + p1[r]; }
        l_run = l_run * alpha + ls;
        if (__ballot(alpha != 1.f) != 0ull) {
            if (hi == 0) WSF[r32] = alpha;
#pragma unroll
            for (int g = 0; g < 4; ++g) { const f32x4 al = *(const LAS f32x4*)(WSF + 8 * g + 4 * hi);
#pragma unroll
                for (int i = 0; i < 4; ++i) { o0[4 * g + i] *= al[i]; o1[4 * g + i] *= al[i]; } }
        }
        v4u pw[4];
#pragma unroll
        for (int j = 0; j < 4; ++j) { pw[0][j] = pg8::cvt_pk_bf16(p0[2 * j], p0[2 * j + 1]); pw[1][j] = pg8::cvt_pk_bf16(p0[8 + 2 * j], p0[8 + 2 * j + 1]);
                                      pw[2][j] = pg8::cvt_pk_bf16(p1[2 * j], p1[2 * j + 1]); pw[3][j] = pg8::cvt_pk_bf16(p1[8 + 2 * j], p1[8 + 2 * j + 1]); }
#pragma unroll
        for (int ks = 0; ks < 4; ++ks) {
            const bf16x8 pa = __builtin_bit_cast(bf16x8, pw[ks]);
#pragma unroll
            for (int d0 = 0; d0 < 2; ++d0) {
                const s16x4 lo = lds_tr16(Vs + vbase + ks * 16 * 192 + d0 * 64), hi4 = lds_tr16(Vs + vbase + ks * 16 * 192 + 8 * 192 + d0 * 64);
                const bf16x8 vb = (bf16x8){lo[0], lo[1], lo[2], lo[3], hi4[0], hi4[1], hi4[2], hi4[3]};
                if (d0 == 0) o0 = __builtin_amdgcn_mfma_f32_32x32x16_bf16(pa, vb, o0, 0, 0, 0); else o1 = __builtin_amdgcn_mfma_f32_32x32x16_bf16(pa, vb, o1, 0, 0, 0);
            }
        }
        }
        }
      }
    }
    l_run += __shfl_xor(l_run, 32);
    if (hi == 0) WSF[r32] = 1.f / l_run;
    bf16* Ow = merged + (rowbase + q0 + wid * 32) * DM + h * 64 + r32;
#pragma unroll
    for (int g = 0; g < 4; ++g) { const f32x4 rl = *(const LAS f32x4*)(WSF + 8 * g + 4 * hi);
#pragma unroll
        for (int i = 0; i < 4; ++i) { const int r = 4 * g + i; const int row = crow(r, hi);
            Ow[(size_t)row * DM] = (bf16)f2bf(o0[r] * rl[i]); Ow[(size_t)row * DM + 32] = (bf16)f2bf(o1[r] * rl[i]); } }
    __syncthreads();
#undef FOX_KB
}

template <int D> struct DecW {
    static constexpr int KS = D / 32;
    static constexpr int LPK = D / 4;
    static constexpr int KPI = 64 / LPK;
    float m[4], l[4]; float o[8][4];
};
template <int D>
__device__ __forceinline__ void dec_init(DecW<D>& w) {
#pragma unroll
    for (int i = 0; i < 4; ++i) { w.m[i] = -INFINITY; w.l[i] = 0.f; }
#pragma unroll
    for (int q = 0; q < 8; ++q)
#pragma unroll
        for (int j = 0; j < 4; ++j) w.o[q][j] = 0.f;
}
template <int D, int NTILE, int MODE>
__device__ __forceinline__ void dec_chunk(DecW<D>& w, const bf16x8 (&qa)[D / 32], const float* Kb, const float* Vb, int stride, const float* bias, float nb, LAS float* PL, int lane) {
    constexpr int KS = D / 32, LPK = D / 4, KPI = 64 / LPK;
    constexpr int NK = (MODE == 1) ? 8 : NTILE * 16, NV = NK / KPI;
    const int key = lane & 15, kq = lane >> 4;
    const unsigned koff = (unsigned)(key * stride + 8 * kq) * 4u;
    const int d4 = lane % LPK, ksub = lane / LPK;
    const unsigned voff = (unsigned)(ksub * stride + 4 * d4) * 4u;
    f32x4 kx[NTILE][2 * KS], vx[NV];
#pragma unroll
    for (int t = 0; t < NTILE; ++t) { const char* kp = (const char*)(Kb + (size_t)t * 16 * stride) + koff;
#pragma unroll
        for (int ks = 0; ks < KS; ++ks) { kx[t][2 * ks] = *(const f32x4*)(kp + 128 * ks); kx[t][2 * ks + 1] = *(const f32x4*)(kp + 128 * ks + 16); } }
    constexpr int NVA = (NV >= 8) ? NV / 2 : NV;
#pragma unroll
    for (int kk = 0; kk < NVA; ++kk) vx[kk] = *(const f32x4*)((const char*)(Vb + (size_t)kk * KPI * stride) + voff);
    f32x4 s[NTILE];
#pragma unroll
    for (int t = 0; t < NTILE; ++t) {
        f32x4 acc = {0.f, 0.f, 0.f, 0.f};
#pragma unroll
        for (int ks = 0; ks < KS; ++ks) { const f32x4 x0 = kx[t][2 * ks], x1 = kx[t][2 * ks + 1];
            v4u kb; kb.x = pg8::cvt_pk_bf16(x0.x, x0.y); kb.y = pg8::cvt_pk_bf16(x0.z, x0.w); kb.z = pg8::cvt_pk_bf16(x1.x, x1.y); kb.w = pg8::cvt_pk_bf16(x1.z, x1.w);
            acc = __builtin_amdgcn_mfma_f32_16x16x32_bf16(qa[ks], __builtin_bit_cast(bf16x8, kb), acc, 0, 0, 0); }
        if (MODE == 0) { if (bias) { const float bv = (bias[t * 16 + key] + nb) * LOG2E; acc += bv; } }
        else { acc += nb;
#pragma unroll
            for (int i = 0; i < 4; ++i) if (key > 4 * kq + i || key >= 8) acc[i] = -INFINITY; }
        s[t] = acc;
    }
#pragma unroll
    for (int kk = NVA; kk < NV; ++kk) vx[kk] = *(const f32x4*)((const char*)(Vb + (size_t)kk * KPI * stride) + voff);
    f32x4 mc = s[0];
#pragma unroll
    for (int t = 1; t < NTILE; ++t) { mc.x = fmaxf(mc.x, s[t].x); mc.y = fmaxf(mc.y, s[t].y); mc.z = fmaxf(mc.z, s[t].z); mc.w = fmaxf(mc.w, s[t].w); }
#pragma unroll
    for (int o = 1; o < 16; o <<= 1) { mc.x = fmaxf(mc.x, __shfl_xor(mc.x, o)); mc.y = fmaxf(mc.y, __shfl_xor(mc.y, o)); mc.z = fmaxf(mc.z, __shfl_xor(mc.z, o)); mc.w = fmaxf(mc.w, __shfl_xor(mc.w, o)); }
    float al[4];
#pragma unroll
    for (int i = 0; i < 4; ++i) { const float mn = fmaxf(w.m[i], mc[i]); al[i] = (mn == -INFINITY) ? 1.f : fexp2(w.m[i] - mn); w.m[i] = mn; w.l[i] *= al[i]; }
#pragma unroll
    for (int t = 0; t < NTILE; ++t) { f32x4 p;
#pragma unroll
        for (int i = 0; i < 4; ++i) { p[i] = (w.m[i] == -INFINITY) ? 0.f : fexp2(s[t][i] - w.m[i]); w.l[i] += p[i]; }
        if (kq < 2) *(LAS f32x4*)(PL + (t * 16 + key) * 8 + 4 * kq) = p; }
    if (key == 0 && kq < 2) *(LAS f32x4*)(PL + 1024 + 4 * kq) = (f32x4){al[0], al[1], al[2], al[3]};
    { const f32x4 a0 = *(const LAS f32x4*)(PL + 1024), a1 = *(const LAS f32x4*)(PL + 1028);
#pragma unroll
      for (int j = 0; j < 4; ++j) { w.o[0][j] *= a0.x; w.o[1][j] *= a0.y; w.o[2][j] *= a0.z; w.o[3][j] *= a0.w; w.o[4][j] *= a1.x; w.o[5][j] *= a1.y; w.o[6][j] *= a1.z; w.o[7][j] *= a1.w; } }
#pragma unroll
    for (int kk = 0; kk < NV; ++kk) { const int k = kk * KPI + ksub;
        const f32x4 v = vx[kk];
        const f32x4 pa = *(const LAS f32x4*)(PL + k * 8), pb = *(const LAS f32x4*)(PL + k * 8 + 4);
#pragma unroll
        for (int j = 0; j < 4; ++j) { w.o[0][j] += pa.x * v[j]; w.o[1][j] += pa.y * v[j]; w.o[2][j] += pa.z * v[j]; w.o[3][j] += pa.w * v[j];
                                      w.o[4][j] += pb.x * v[j]; w.o[5][j] += pb.y * v[j]; w.o[6][j] += pb.z * v[j]; w.o[7][j] += pb.w * v[j]; } }
}
__device__ __forceinline__ void dec_page_fox(DecW<64>& w, const bf16x8 (&qa)[2], const float* Kb, const float* Vb, const float* bias, float boff, LAS float* PL, int lane) {
    constexpr int stride = 512;
    const int key = lane & 15, kq = lane >> 4;
    const unsigned koff = (unsigned)(key * stride + 8 * kq) * 4u;
    const int d4 = lane & 15, ksub = lane >> 4;
    const unsigned voff = (unsigned)(ksub * stride + 4 * d4) * 4u;
    const __amdgpu_buffer_rsrc_t krs = __builtin_amdgcn_make_buffer_rsrc((void*)Kb, 0, 0x7fffffff, 0x00020000);
    const __amdgpu_buffer_rsrc_t vrs = __builtin_amdgcn_make_buffer_rsrc((void*)Vb, 0, 0x7fffffff, 0x00020000);
    const __amdgpu_buffer_rsrc_t brs = __builtin_amdgcn_make_buffer_rsrc((void*)bias, 0, 0x7fffffff, 0x00020000);
    f32x4 s[8];
#pragma unroll
    for (int hb = 0; hb < 2; ++hb) {
        f32x4 kx[4][4];
#pragma unroll
        for (int t = 0; t < 4; ++t) { const int so = (hb * 4 + t) * 16 * stride * 4;
            kx[t][0] = __builtin_bit_cast(f32x4, __builtin_amdgcn_raw_buffer_load_b128(krs, (int)koff, so, 0)); kx[t][1] = __builtin_bit_cast(f32x4, __builtin_amdgcn_raw_buffer_load_b128(krs, (int)koff + 16, so, 0));
            kx[t][2] = __builtin_bit_cast(f32x4, __builtin_amdgcn_raw_buffer_load_b128(krs, (int)koff + 128, so, 0)); kx[t][3] = __builtin_bit_cast(f32x4, __builtin_amdgcn_raw_buffer_load_b128(krs, (int)koff + 144, so, 0)); }
#pragma unroll
        for (int t = 0; t < 4; ++t) {
            f32x4 acc = {0.f, 0.f, 0.f, 0.f};
#pragma unroll
            for (int ks = 0; ks < 2; ++ks) { const f32x4 x0 = kx[t][2 * ks], x1 = kx[t][2 * ks + 1];
                v4u kb; kb.x = pg8::cvt_pk_bf16(x0.x, x0.y); kb.y = pg8::cvt_pk_bf16(x0.z, x0.w); kb.z = pg8::cvt_pk_bf16(x1.x, x1.y); kb.w = pg8::cvt_pk_bf16(x1.z, x1.w);
                acc = __builtin_amdgcn_mfma_f32_16x16x32_bf16(qa[ks], __builtin_bit_cast(bf16x8, kb), acc, 0, 0, 0); }
            acc += (__builtin_bit_cast(float, __builtin_amdgcn_raw_buffer_load_b32(brs, key * 4, (hb * 4 + t) * 64, 0)) + boff) * LOG2E;
            s[hb * 4 + t] = acc;
        }
        asm volatile("" ::: "memory");
    }
    f32x4 mc = s[0];
#pragma unroll
    for (int t = 1; t < 8; ++t) { mc.x = fmaxf(mc.x, s[t].x); mc.y = fmaxf(mc.y, s[t].y); mc.z = fmaxf(mc.z, s[t].z); mc.w = fmaxf(mc.w, s[t].w); }
#pragma unroll
    for (int o = 1; o < 16; o <<= 1) { mc.x = fmaxf(mc.x, __shfl_xor(mc.x, o)); mc.y = fmaxf(mc.y, __shfl_xor(mc.y, o)); mc.z = fmaxf(mc.z, __shfl_xor(mc.z, o)); mc.w = fmaxf(mc.w, __shfl_xor(mc.w, o)); }
    float al[4];
#pragma unroll
    for (int i = 0; i < 4; ++i) { const float mn = fmaxf(w.m[i], mc[i]); al[i] = fexp2(w.m[i] - mn); w.m[i] = mn; w.l[i] *= al[i]; }
    bool nz = false;
#pragma unroll
    for (int t = 0; t < 8; ++t) { f32x4 p;
#pragma unroll
        for (int i = 0; i < 4; ++i) { p[i] = fexp2(s[t][i] - w.m[i]); w.l[i] += p[i]; nz = nz || (p[i] != 0.f); }
        if (kq < 2) *(LAS f32x4*)(PL + (t * 16 + key) * 8 + 4 * kq) = p; }
    if (__ballot(nz && kq < 2) == 0ull) return;
    if (key == 0 && kq < 2) *(LAS f32x4*)(PL + 1024 + 4 * kq) = (f32x4){al[0], al[1], al[2], al[3]};
    { const f32x4 a0 = *(const LAS f32x4*)(PL + 1024), a1 = *(const LAS f32x4*)(PL + 1028);
#pragma unroll
      for (int j = 0; j < 4; ++j) { w.o[0][j] *= a0.x; w.o[1][j] *= a0.y; w.o[2][j] *= a0.z; w.o[3][j] *= a0.w; w.o[4][j] *= a1.x; w.o[5][j] *= a1.y; w.o[6][j] *= a1.z; w.o[7][j] *= a1.w; } }
#pragma unroll 1
    for (int vh = 0; vh < 2; ++vh) {
    f32x4 vx[16];
#pragma unroll
    for (int kk = 0; kk < 16; ++kk) vx[kk] = __builtin_bit_cast(f32x4, __builtin_amdgcn_raw_buffer_load_b128(vrs, (int)voff, (vh * 16 + kk) * 4 * stride * 4, 0));
#pragma unroll
    for (int kk = 0; kk < 16; ++kk) { const int k = (vh * 16 + kk) * 4 + ksub;
        const f32x4 v = vx[kk];
        const f32x4 pa = *(const LAS f32x4*)(PL + k * 8), pb = *(const LAS f32x4*)(PL + k * 8 + 4);
#pragma unroll
        for (int j = 0; j < 4; ++j) { w.o[0][j] += pa.x * v[j]; w.o[1][j] += pa.y * v[j]; w.o[2][j] += pa.z * v[j]; w.o[3][j] += pa.w * v[j];
                                      w.o[4][j] += pb.x * v[j]; w.o[5][j] += pb.y * v[j]; w.o[6][j] += pb.z * v[j]; w.o[7][j] += pb.w * v[j]; } }
    }
}
template <int D>
__device__ __forceinline__ void dec_park(DecW<D>& w, LAS float* CBw, int lane) {
    constexpr int LPK = D / 4;
    const int key = lane & 15, kq = lane >> 4, d4 = lane % LPK, ksub = lane / LPK;
#pragma unroll
    for (int i = 0; i < 4; ++i) { float l = w.l[i];
#pragma unroll
        for (int o = 1; o < 16; o <<= 1) l += __shfl_xor(l, o);
        w.l[i] = l; }
    if (key == 0 && kq < 2) { *(LAS f32x4*)(CBw + 4 * kq) = (f32x4){w.m[0], w.m[1], w.m[2], w.m[3]}; *(LAS f32x4*)(CBw + 8 + 4 * kq) = (f32x4){w.l[0], w.l[1], w.l[2], w.l[3]}; }
#pragma unroll
    for (int q = 0; q < 8; ++q) { f32x4 v = (f32x4){w.o[q][0], w.o[q][1], w.o[q][2], w.o[q][3]};
        if (LPK < 64) {
#pragma unroll
            for (int o = LPK; o < 64; o <<= 1) { v.x += __shfl_xor(v.x, o); v.y += __shfl_xor(v.y, o); v.z += __shfl_xor(v.z, o); v.w += __shfl_xor(v.w, o); } }
        if (ksub == 0) *(LAS f32x4*)(CBw + 16 + q * D + 4 * d4) = v; }
}
template <int D>
__device__ __forceinline__ void dec_combine(int tid, LAS float* CB, bf16* dst, int ldd) {
    constexpr int WSTR = 16 + 8 * D;
    for (int e = tid; e < 8 * D; e += NTHR) { const int q = e / D, d = e % D;
        float mt = -INFINITY;
#pragma unroll
        for (int w = 0; w < 8; ++w) mt = fmaxf(mt, CB[w * WSTR + q]);
        float num = 0.f, den = 0.f;
#pragma unroll
        for (int w = 0; w < 8; ++w) { const float mw = CB[w * WSTR + q]; const float f = (mw == -INFINITY) ? 0.f : fexp2(mw - mt); num += f * CB[w * WSTR + 16 + q * D + d]; den += f * CB[w * WSTR + 8 + q]; }
        dst[(size_t)q * ldd + d] = (bf16)f2bf(num / den); }
}
template <int D>
__device__ __forceinline__ void dec_load_q(bf16x8 (&qa)[D / 32], const bf16* Q, int ldq, int lane) {
    const int row = lane & 15, kq = lane >> 4;
#pragma unroll
    for (int ks = 0; ks < D / 32; ++ks) { v4u z = {0u, 0u, 0u, 0u}; if (row < 8) z = *(const v4u*)(Q + (size_t)row * ldq + 32 * ks + 8 * kq); qa[ks] = __builtin_bit_cast(bf16x8, z); }
}
constexpr int DEC_PL = 1040;
__device__ __forceinline__ void fox_sample_unit(const Frame& F, const Args& a, int u) {
    unsigned char* ws = a.ws; const int bs = u >> 3, h = u & 7;
    int ln = lane_id(); asm volatile("" : "+v"(ln));
    LAS float* PL = (LAS float*)F.lds + F.wave * DEC_PL; LAS float* CB = (LAS float*)F.lds + 8 * DEC_PL; constexpr int WSTR = 16 + 8 * 64;
    bf16x8 qa[2]; dec_load_q<64>(qa, (const bf16*)(ws + WS_QF) + (size_t)(TP + bs * LS) * 512 + h * 64, 512, ln);
    DecW<64> w; dec_init(w);
    {
        const int key = ln & 15; const float* lf = a.out + O_LFS + (size_t)(bs * LS) * 8 + h; float cn = 0.f;
#pragma unroll
        for (int j = 0; j < 8; ++j) { const float x = lf[j * 8]; cn += (j <= key) ? x : 0.f; }
        const float* Kb = a.out + O_FKS + (size_t)(bs * LS) * 512 + h * 64; const float* Vb = a.out + O_FVS + (size_t)(bs * LS) * 512 + h * 64;
        dec_chunk<64, 1, 1>(w, qa, Kb, Vb, 512, nullptr, -cn * LOG2E, PL, ln);
        if (F.wave != 0) {
#pragma unroll
            for (int i = 0; i < 4; ++i) w.l[i] = 0.f;
#pragma unroll
            for (int q = 0; q < 8; ++q)
#pragma unroll
                for (int j = 0; j < 4; ++j) w.o[q][j] = 0.f; }
    }
    const int* pt = (const int*)a.in[I_PT];
    float spx; { const float ptv = (ln < 16) ? ((const float*)(ws + WS_MISC + 2 * MiB))[(bs * 8 + h) * NPAGES + ln] : 0.f; float v = ptv;
#pragma unroll
        for (int o = 1; o < 16; o <<= 1) { const float t = __builtin_bit_cast(float, __builtin_amdgcn_ds_bpermute((ln + o) << 2, __builtin_bit_cast(int, v))); if (ln + o < 16) v += t; }
        spx = v - ptv; }
#if defined(OLD_FOXS)
#pragma unroll 1
    for (int pp = 0; pp < 4; ++pp) { const int p = F.wave * 2 + (pp >> 1), hf = pp & 1; const int pg = __builtin_amdgcn_readfirstlane(pt[bs * NPAGES + p]);
        const float* Kb = (const float*)a.in[I_CFK] + (((size_t)pg * PAGE + hf * 64) * 8 + h) * 64; const float* Vb = (const float*)a.in[I_CFV] + (((size_t)pg * PAGE + hf * 64) * 8 + h) * 64;
        dec_chunk<64, 4, 0>(w, qa, Kb, Vb, 512, (const float*)(ws + WS_SUF) + (size_t)(bs * 8 + h) * PASTL + p * PAGE + hf * 64, __builtin_bit_cast(float, __builtin_amdgcn_ds_bpermute(p << 2, __builtin_bit_cast(int, spx))), PL, ln); }
#else
#pragma unroll 1
    for (int pp = 1; pp >= 0; --pp) { const int p = pp ? (NPAGES - 1 - F.wave) : F.wave;
        const int pg = __builtin_amdgcn_readfirstlane(pt[bs * NPAGES + p]);
        const float* Kb = (const float*)a.in[I_CFK] + ((size_t)pg * PAGE * 8 + h) * 64; const float* Vb = (const float*)a.in[I_CFV] + ((size_t)pg * PAGE * 8 + h) * 64;
        dec_page_fox(w, qa, Kb, Vb, (const float*)(ws + WS_SUF) + (size_t)(bs * 8 + h) * PASTL + p * PAGE, __builtin_bit_cast(float, __builtin_amdgcn_ds_bpermute(p << 2, __builtin_bit_cast(int, spx))), PL, ln); }
#endif
    dec_park<64>(w, CB + F.wave * WSTR, ln);
    __syncthreads();
    dec_combine<64>(F.wave * 64 + ln, CB, (bf16*)(ws + WS_MERGED) + (size_t)(TP + bs * LS) * DM + h * 64, DM);
    __syncthreads();
}
__device__ __forceinline__ void cross_sample_unit(const Frame& F, const Args& a, int u) {
    unsigned char* ws = a.ws; const int bs = u >> 2, h = u & 3;
    LAS float* PL = (LAS float*)F.lds + F.wave * DEC_PL; LAS float* CB = (LAS float*)F.lds + 8 * DEC_PL; constexpr int WSTR = 16 + 8 * 256;
    bf16x8 qa[8]; dec_load_q<256>(qa, (const bf16*)(ws + WS_QC) + (size_t)(TP + bs * LS) * DM + h * 256, DM, F.lane);
    DecW<256> w; dec_init(w);
    const float* Kb = (const float*)a.in[I_CMK] + ((size_t)(bs * 256 + F.wave * 32) * 4 + h) * 256; const float* Vb = (const float*)a.in[I_CMV] + ((size_t)(bs * 256 + F.wave * 32) * 4 + h) * 256;
#pragma unroll 1
    for (int c = 0; c < 2; ++c) dec_chunk<256, 1, 0>(w, qa, Kb + (size_t)c * 16 * 1024, Vb + (size_t)c * 16 * 1024, 1024, nullptr, 0.f, PL, F.lane);
    dec_park<256>(w, CB + F.wave * WSTR, F.lane);
    __syncthreads();
    dec_combine<256>(F.tid, CB, (bf16*)(ws + WS_OC) + (size_t)(TP + bs * LS) * DM + h * 256, DM);
    __syncthreads();
}


__device__ __forceinline__ void gla_g3_unit(const Frame& F, const Args& a, int u) {
    unsigned char* ws = a.ws;
    const int b = u >> 9, h = (u >> 7) & 3, n = u & 127; const int row0 = b * SEQ + n * 64;
    LAS unsigned char* KIB = F.lds; LAS unsigned char* ATTB = F.lds + 34816; LAS unsigned char* QDB = F.lds + 44032;
    LAS unsigned char* VSB = F.lds + 53248; LAS unsigned char* SPB = F.lds + 73728; LAS float* OS = (LAS float*)(F.lds + 94208);
#pragma unroll
    for (int i = 0; i < 2; ++i) { const int c = F.tid + NTHR * i; *(LAS v4u*)(VSB + (c >> 4) * 320 + (c & 15) * 16) = *(const v4u*)((const bf16*)(ws + WS_GV) + (size_t)(row0 + (c >> 4)) * 512 + h * 128 + (c & 15) * 8); }
#pragma unroll
    for (int i = 0; i < 4; ++i) { const int c4 = F.tid + NTHR * i; const f32x4 sp = *(const f32x4*)((const float*)(ws + WS_GKV) + ((size_t)((b * 4 + h) * 128 + n) * 64) * 128 + 4 * c4);
        v2u o; o.x = pg8::cvt_pk_bf16(sp.x, sp.y); o.y = pg8::cvt_pk_bf16(sp.z, sp.w); *(LAS v2u*)(SPB + (c4 >> 5) * 320 + (c4 & 31) * 8) = o; }
#pragma unroll
    for (int i = 0; i < 2; ++i) { const int c4 = F.tid + NTHR * i, t = c4 >> 4, d4 = (c4 & 15) * 4; const size_t gi = (size_t)(row0 + t) * 256 + h * 64 + d4;
        const f32x4 bb = *(const f32x4*)((const float*)(ws + WS_BB) + gi);
        const v2u qq = *(const v2u*)((const bf16*)(ws + WS_GQ) + gi), kk = *(const v2u*)((const bf16*)(ws + WS_GK) + gi);
        v2u qo, ko; qo.x = pg8::cvt_pk_bf16(bflo(qq.x) * __expf(bb.x), bfhi(qq.x) * __expf(bb.y)); qo.y = pg8::cvt_pk_bf16(bflo(qq.y) * __expf(bb.z), bfhi(qq.y) * __expf(bb.w));
        ko.x = pg8::cvt_pk_bf16(bflo(kk.x) * __expf(-bb.x), bfhi(kk.x) * __expf(-bb.y)); ko.y = pg8::cvt_pk_bf16(bflo(kk.y) * __expf(-bb.z), bfhi(kk.y) * __expf(-bb.w));
        *(LAS v2u*)(QDB + t * 144 + d4 * 2) = qo; *(LAS v2u*)(KIB + t * 144 + d4 * 2) = ko; }
    __syncthreads();
    {
        const int lane = F.lane, r32 = lane & 31, hi = lane >> 5;
        if (F.wave < 4) { const int tb = F.wave >> 1, sb = F.wave & 1; f32x16 acc = {};
            if (sb <= tb) {
                const LAS unsigned char* qrow = QDB + (32 * tb + r32) * 144; const LAS unsigned char* krow = KIB + (32 * sb + r32) * 144;
#pragma unroll
                for (int ks = 0; ks < 4; ++ks) acc = __builtin_amdgcn_mfma_f32_32x32x16_bf16(row_frag(qrow, ks, hi), row_frag(krow, ks, hi), acc, 0, 0, 0);
            }
#pragma unroll
            for (int r = 0; r < 16; ++r) { const int t = 32 * tb + crow(r, hi), s2 = 32 * sb + r32; *(LAS unsigned short*)(ATTB + t * 144 + s2 * 2) = (unsigned short)f2bf(s2 <= t ? acc[r] : 0.f); }
        }
    }
    __syncthreads();
    {
        const int lane = F.lane, r32 = lane & 31, hi = lane >> 5, tb = F.wave >> 2, nb = F.wave & 3;
        const int trb = (4 * hi + ((lane & 15) >> 2)) * 320 + (16 * ((lane >> 4) & 1) + 4 * (lane & 3)) * 2 + 64 * nb;
        const LAS unsigned char* arow = ATTB + (32 * tb + r32) * 144; const LAS unsigned char* qrow = QDB + (32 * tb + r32) * 144;
        f32x16 acc = {};
#pragma unroll
        for (int ks = 0; ks < 4; ++ks) acc = __builtin_amdgcn_mfma_f32_32x32x16_bf16(row_frag(arow, ks, hi), tr_frag<320>(VSB + trb, ks), acc, 0, 0, 0);
#pragma unroll
        for (int ks = 0; ks < 4; ++ks) acc = __builtin_amdgcn_mfma_f32_32x32x16_bf16(row_frag(qrow, ks, hi), tr_frag<320>(SPB + trb, ks), acc, 0, 0, 0);
#pragma unroll
        for (int r = 0; r < 16; ++r) OS[(32 * tb + crow(r, hi)) * 128 + 32 * nb + r32] = acc[r];
    }
    __syncthreads();
#pragma unroll
    for (int rr = 0; rr < 8; ++rr) { const int t = F.wave * 8 + rr; const float v0 = OS[t * 128 + F.lane], v1 = OS[t * 128 + 64 + F.lane];
        const float r = rsqrtf(wave_sum(v0 * v0 + v1 * v1) * (1.f / 128.f) + EPS);
        const float* ggo = (const float*)a.in[I_GGO] + h * 128; const BfPtr gr = GLD(ws + WS_GR) + ((size_t)(row0 + t) * 512 + h * 128);
        bf16* mo = (bf16*)(ws + WS_MERGED) + (size_t)(row0 + t) * DM + 512 + h * 128;
        mo[F.lane] = (bf16)f2bf(v0 * r * ggo[F.lane] * silu(gr[F.lane])); mo[64 + F.lane] = (bf16)f2bf(v1 * r * ggo[64 + F.lane] * silu(gr[64 + F.lane])); }
    __syncthreads();
}

struct EpiSoftmaxP {
    static constexpr bool PERM = false, AFTER_DRAIN = true;
    const LAS unsigned long long* argp;
    __device__ __forceinline__ void fused(f32x4 (&acc)[2][2][4][2], const Unit&, int wr, int wc, int fr, int fq, PG8_LAS unsigned char* lds, int wid, int lane) const {
        LAS float* PM = (LAS float*)lds; LAS float* PS = PM + 1024;
        const int ub = (int)blockIdx.x; const int ldp = DM;
        bf16* P = (bf16*)((unsigned char*)ld_ptr(argp + N_INPUTS + 1) + WS_PC) + ((size_t)((ub >> 7) & 1) * SEQ + (ub & 31) * 256) * DM + ((ub >> 5) & 3) * 256;
        { int t2 = lane_id(); asm volatile("" : "+v"(t2)); fr = t2 & 15; fq = (t2 >> 4) & 3; }
#pragma unroll
        for (int ai = 0; ai < 2; ++ai)
#pragma unroll
            for (int m = 0; m < 4; ++m) { float mx = -INFINITY;
#pragma unroll
                for (int bj = 0; bj < 2; ++bj)
#pragma unroll
                    for (int n = 0; n < 2; ++n) { const f32x4 x = acc[ai][bj][m][n]; mx = fmaxf(mx, fmaxf(fmaxf(x[0], x[1]), fmaxf(x[2], x[3]))); }
                mx = fmaxf(mx, __shfl_xor(mx, 16)); mx = fmaxf(mx, __shfl_xor(mx, 32));
                if (fq == 0) PM[(ai * 128 + wr * 64 + m * 16 + fr) * 4 + wc] = mx; }
        asm volatile("s_waitcnt lgkmcnt(0)" ::: "memory"); __builtin_amdgcn_s_barrier(); asm volatile("" ::: "memory");
#pragma unroll
        for (int ai = 0; ai < 2; ++ai)
#pragma unroll
            for (int m = 0; m < 4; ++m) { const int r = ai * 128 + wr * 64 + m * 16 + fr; const f32x4 pm = *(const LAS f32x4*)(PM + r * 4);
                const float M = fmaxf(fmaxf(pm[0], pm[1]), fmaxf(pm[2], pm[3])); float s = 0.f;
#pragma unroll
                for (int bj = 0; bj < 2; ++bj)
#pragma unroll
                    for (int n = 0; n < 2; ++n) { f32x4 x = acc[ai][bj][m][n]; x[0] = fexp2(x[0] - M); x[1] = fexp2(x[1] - M); x[2] = fexp2(x[2] - M); x[3] = fexp2(x[3] - M); acc[ai][bj][m][n] = x; s += (x[0] + x[1]) + (x[2] + x[3]); }
                s += __shfl_xor(s, 16); s += __shfl_xor(s, 32);
                if (fq == 0) PS[r * 4 + wc] = s; }
        asm volatile("s_waitcnt lgkmcnt(0)" ::: "memory"); __builtin_amdgcn_s_barrier(); asm volatile("" ::: "memory");
#pragma unroll
        for (int ai = 0; ai < 2; ++ai)
#pragma unroll
            for (int m = 0; m < 4; ++m) { const int r = ai * 128 + wr * 64 + m * 16 + fr; const f32x4 ps = *(const LAS f32x4*)(PS + r * 4); const float inv = 1.f / ((ps[0] + ps[1]) + (ps[2] + ps[3]));
#pragma unroll
                for (int bj = 0; bj < 2; ++bj)
#pragma unroll
                    for (int n = 0; n < 2; ++n) { const f32x4 x = acc[ai][bj][m][n]; v2u o; o.x = pg8::cvt_pk_bf16(x[0] * inv, x[1] * inv); o.y = pg8::cvt_pk_bf16(x[2] * inv, x[3] * inv);
                        *(v2u*)(P + (size_t)r * ldp + bj * 128 + wc * 32 + n * 16 + fq * 4) = o; } }
        asm volatile("s_waitcnt lgkmcnt(0)" ::: "memory"); __builtin_amdgcn_s_barrier(); asm volatile("" ::: "memory");
    }
};

__device__ __forceinline__ void rms_rows_phase(const Frame& F, const float* X, const float* g, bf16* H) {
    const int gw = F.vcu * NWAVES + F.wave, NGW = F.G * NWAVES;
    for (int m = gw; m < TA; m += NGW) rms_row_bf16(X + (size_t)m * DM, g, H + (size_t)m * DM, F.lane);
}

__device__ __forceinline__ unsigned f2sort(float f) { const unsigned u = __builtin_bit_cast(unsigned, f); return u ^ ((u >> 31) ? 0xFFFFFFFFu : 0x80000000u); }
__device__ __forceinline__ float sort2f(unsigned s) { const unsigned u = s ^ ((s >> 31) ? 0x80000000u : 0xFFFFFFFFu); return __builtin_bit_cast(float, u); }
__device__ __forceinline__ float gelu_tanh(float x) { const float y = 0.7978845608028654f * (x + 0.044715f * x * x * x); const float e = __expf(2.f * y); return 0.5f * x * (1.f + (1.f - 2.f / (e + 1.f))); }
__device__ __forceinline__ unsigned gmax16(unsigned v) {
#pragma unroll
    for (int o = 1; o < 16; o <<= 1) { const unsigned t = (unsigned)__shfl_xor((int)v, o); v = v > t ? v : t; }
    return v;
}
typedef __bf16 bf16x2_t __attribute__((ext_vector_type(2)));
__device__ __forceinline__ float dot2bf(unsigned a, unsigned b, float c) {
#if __has_builtin(__builtin_amdgcn_fdot2_f32_bf16)
    return __builtin_amdgcn_fdot2_f32_bf16(__builtin_bit_cast(bf16x2_t, a), __builtin_bit_cast(bf16x2_t, b), c, false);
#else
    return c + bflo(a) * bflo(b) + bfhi(a) * bfhi(b);
#endif
}
template <bool SPLIT>
__device__ __forceinline__ void peer_token(const Frame& F, const Args& a, int row, LAS unsigned* TOPS, const LAS unsigned* CT, int half, LAS float* PART) {
    unsigned char* ws = a.ws; const int lane = lane_id(), grp = lane >> 4, j16 = lane & 15;
    const bf16* sc = (const bf16*)(ws + WS_SC) + (size_t)row * 2048;
#pragma unroll 1
    for (int bt = 0; bt < 4; ++bt) {
        const v4u xq = *(const v4u*)(sc + (bt * 4 + grp) * 128 + 8 * j16);
        unsigned k[8]; const float xs[8] = {bflo(xq.x), bfhi(xq.x), bflo(xq.y), bfhi(xq.y), bflo(xq.z), bfhi(xq.z), bflo(xq.w), bfhi(xq.w)};
#pragma unroll
        for (int e = 0; e < 8; ++e) k[e] = (f2sort(xs[e]) & ~127u) | (unsigned)(127 - (8 * j16 + e));
        unsigned mine = 0u;
#pragma unroll 1
        for (int r = 0; r < 16; ++r) {
            unsigned m = k[0];
#pragma unroll
            for (int e = 1; e < 8; ++e) m = m > k[e] ? m : k[e];
            m = gmax16(m);
            if (j16 == r) mine = m;
#pragma unroll
            for (int e = 0; e < 8; ++e) k[e] = (k[e] == m) ? 0u : k[e];
        }
        TOPS[(bt * 4 + grp) * 16 + j16] = mine;
    }
    int ex[2]; float gx[2], sux[2];
#pragma unroll
    for (int ps = 0; ps < 2; ++ps) {
        const int hd = ps * 4 + grp; const LAS unsigned* T1 = TOPS + (2 * hd) * 16; const LAS unsigned* T2 = T1 + 16;
        const unsigned c0_ = CT[j16], c1_ = CT[j16 + 16], c2_ = CT[j16 + 32], c3_ = CT[j16 + 48];
        const int ci0 = c0_ & 255, cj0 = c0_ >> 8, ci1 = c1_ & 255, cj1 = c1_ >> 8, ci2 = c2_ & 255, cj2 = c2_ >> 8, ci3 = c3_ & 255, cj3 = c3_ >> 8; const bool cv3 = (j16 + 48) < 50;
        unsigned k[4];
        { const float s0 = sort2f(T1[ci0] & ~127u) + sort2f(T2[cj0] & ~127u), s1 = sort2f(T1[ci1] & ~127u) + sort2f(T2[cj1] & ~127u),
                      s2 = sort2f(T1[ci2] & ~127u) + sort2f(T2[cj2] & ~127u), s3 = sort2f(T1[ci3] & ~127u) + sort2f(T2[cj3] & ~127u);
          k[0] = (f2sort(s0) & ~127u) | (unsigned)(127 - j16); k[1] = (f2sort(s1) & ~127u) | (unsigned)(127 - (j16 + 16)); k[2] = (f2sort(s2) & ~127u) | (unsigned)(127 - (j16 + 32));
          k[3] = cv3 ? ((f2sort(s3) & ~127u) | (unsigned)(127 - (j16 + 48))) : 0u; }
        unsigned mine = 0u;
#pragma unroll 1
        for (int r = 0; r < 16; ++r) {
            unsigned m = k[0] > k[1] ? k[0] : k[1]; const unsigned m2 = k[2] > k[3] ? k[2] : k[3]; m = m > m2 ? m : m2;
            m = gmax16(m);
            if (j16 == r) mine = m;
#pragma unroll
            for (int e = 0; e < 4; ++e) k[e] = (k[e] == m) ? 0u : k[e];
        }
        const int c = 127 - (int)(mine & 127u);
        int ci, cj;
        if (c < 16) { ci = 0; cj = c; } else if (c < 24) { ci = 1; cj = c - 16; } else if (c < 29) { ci = 2; cj = c - 24; } else if (c < 33) { ci = 3; cj = c - 29; }
        else if (c < 36) { ci = 4; cj = c - 33; } else if (c < 38) { ci = 5; cj = c - 36; } else if (c < 40) { ci = 6; cj = c - 38; } else if (c < 42) { ci = 7; cj = c - 40; } else { ci = c - 34; cj = 0; }
        const int i1 = 127 - (int)(T1[ci] & 127u), i2 = 127 - (int)(T2[cj] & 127u);
        ex[ps] = i1 * 128 + i2;
        const float sv = sort2f(mine & ~127u); const float s0 = __shfl(sv, lane & 48);
        float ee = __expf(sv - s0); float es = ee;
#pragma unroll
        for (int o = 1; o < 16; o <<= 1) es += __shfl_xor(es, o);
        const float* rsc = (const float*)(ws + WS_MISC);
        sux[ps] = rsc[ex[ps]]; gx[ps] = ee / es * rsc[16384 + ex[ps]];
    }
    {
        unsigned k0 = ((unsigned)ex[0] << 7) | (unsigned)lane, k1 = ((unsigned)ex[1] << 7) | (unsigned)(64 + lane);
#pragma unroll
        for (int k = 2; k <= 128; k <<= 1) {
#pragma unroll
            for (int j = k >> 1; j > 0; j >>= 1) {
                if (j == 64) { const unsigned lo = k0 < k1 ? k0 : k1, hi = k0 < k1 ? k1 : k0; k0 = lo; k1 = hi; }
                else {
                    const unsigned p0 = (unsigned)__shfl_xor((int)k0, j), p1 = (unsigned)__shfl_xor((int)k1, j);
                    const bool low = (lane & j) == 0; const bool asc0 = (lane & k) == 0, asc1 = ((64 + lane) & k) == 0;
                    const unsigned mn0 = k0 < p0 ? k0 : p0, mx0 = k0 < p0 ? p0 : k0, mn1 = k1 < p1 ? k1 : p1, mx1 = k1 < p1 ? p1 : k1;
                    k0 = (low == asc0) ? mn0 : mx0; k1 = (low == asc1) ? mn1 : mx1;
                }
            }
        }
        const int o0 = (int)(k0 & 127u), o1 = (int)(k1 & 127u);
        const float g0a = __shfl(gx[0], o0 & 63), g0b = __shfl(gx[1], o0 & 63), g1a = __shfl(gx[0], o1 & 63), g1b = __shfl(gx[1], o1 & 63);
        const float s0a = __shfl(sux[0], o0 & 63), s0b = __shfl(sux[1], o0 & 63), s1a = __shfl(sux[0], o1 & 63), s1b = __shfl(sux[1], o1 & 63);
        gx[0] = (o0 & 64) ? g0b : g0a; gx[1] = (o1 & 64) ? g1b : g1a; sux[0] = (o0 & 64) ? s0b : s0a; sux[1] = (o1 & 64) ? s1b : s1a;
        ex[0] = (int)(k0 >> 7); ex[1] = (int)(k1 >> 7);
    }
    const float rstd2 = rsqrtf(((const float*)(ws + WS_SS))[TA + row] * (1.f / 1024.f) + EPS);
    float hf[16];
    { const v4u* hp = (const v4u*)((const bf16*)(ws + WS_HB) + (size_t)row * DM + 16 * lane); const v4u h0 = hp[0], h1 = hp[1];
#pragma unroll
      for (int q = 0; q < 4; ++q) { hf[2 * q] = bflo(h0[q]); hf[2 * q + 1] = bfhi(h0[q]); hf[8 + 2 * q] = bflo(h1[q]); hf[8 + 2 * q + 1] = bfhi(h1[q]); } }
    float oacc[16];
#pragma unroll
    for (int i = 0; i < 16; ++i) oacc[i] = 0.f;
    const unsigned char* U = ws + WS_U16; const unsigned char* V = ws + WS_V16;
    v4u ub[8], vbA[8], vbB[8];
    const int gbeg = SPLIT ? 8 * half : 0, gend = SPLIT ? 8 * half + 8 : 16;
#define PEER_LOAD(buf, TAB, g) do { const int kk_ = (g) * 8; const int exs_ = (kk_ < 64) ? ex[0] : ex[1]; \
        _Pragma("unroll") for (int i = 0; i < 8; ++i) { const int e_ = __builtin_amdgcn_readlane(exs_, (kk_ & 63) + i); buf[i] = *(const v4u*)(TAB + (size_t)e_ * DM + 16 * lane); } } while (0)
#define PEER_DOTS(buf, g, wout) do { const int kk_ = (g) * 8; const float gxs_ = (kk_ < 64) ? gx[0] : gx[1]; const float sus_ = (kk_ < 64) ? sux[0] : sux[1]; float av[8]; \
        _Pragma("unroll") for (int i = 0; i < 8; ++i) { float s = 0.f; \
            _Pragma("unroll") for (int q = 0; q < 4; ++q) { const f32x2 lo = __builtin_amdgcn_cvt_pk_f32_fp8((int)buf[i][q], false), hi = __builtin_amdgcn_cvt_pk_f32_fp8((int)buf[i][q], true); \
                s += lo.x * hf[4 * q]; s += lo.y * hf[4 * q + 1]; s += hi.x * hf[4 * q + 2]; s += hi.y * hf[4 * q + 3]; } \
            av[i] = s; } \
        const bool b5 = lane & 32, b4 = lane & 16, b3_ = lane & 8; float bq[4], cq[2], dq; \
        _Pragma("unroll") for (int i = 0; i < 4; ++i) bq[i] = (b5 ? av[4 + i] : av[i]) + __shfl_xor(b5 ? av[i] : av[4 + i], 32); \
        _Pragma("unroll") for (int i = 0; i < 2; ++i) cq[i] = (b4 ? bq[2 + i] : bq[i]) + __shfl_xor(b4 ? bq[i] : bq[2 + i], 16); \
        dq = (b3_ ? cq[1] : cq[0]) + __shfl_xor(b3_ ? cq[0] : cq[1], 8); \
        dq += __shfl_xor(dq, 4); dq += __shfl_xor(dq, 2); dq += __shfl_xor(dq, 1); \
        const int src = (kk_ & 63) + (lane >> 3); \
        wout = __shfl(gxs_, src) * gelu_tanh(dq * __shfl(sus_, src) * rstd2); } while (0)
#define PEER_ACC(buf, wv) do { _Pragma("unroll") for (int i = 0; i < 8; ++i) { const float w = __builtin_bit_cast(float, __builtin_amdgcn_readlane(__builtin_bit_cast(int, wv), 8 * i)); \
        _Pragma("unroll") for (int q = 0; q < 4; ++q) { const f32x2 lo = __builtin_amdgcn_cvt_pk_f32_fp8((int)buf[i][q], false), hi = __builtin_amdgcn_cvt_pk_f32_fp8((int)buf[i][q], true); \
            oacc[4 * q] += w * lo.x; oacc[4 * q + 1] += w * lo.y; oacc[4 * q + 2] += w * hi.x; oacc[4 * q + 3] += w * hi.y; } } } while (0)
    PEER_LOAD(ub, U, gbeg); PEER_LOAD(vbA, V, gbeg);
#pragma unroll 1
    for (int g0 = gbeg; g0 < gend; g0 += 2) {
        float w0, w1;
        PEER_DOTS(ub, g0, w0);
        PEER_LOAD(ub, U, g0 + 1); PEER_LOAD(vbB, V, g0 + 1);
        PEER_ACC(vbA, w0);
        PEER_DOTS(ub, g0 + 1, w1);
        { const int gn = (g0 + 2 < gend) ? g0 + 2 : g0 + 1;
          PEER_LOAD(ub, U, gn); PEER_LOAD(vbA, V, gn); }
        PEER_ACC(vbB, w1);
    }
#undef PEER_LOAD
#undef PEER_DOTS
#undef PEER_ACC
    if (SPLIT) {
        if (half == 1) {
#pragma unroll
            for (int q = 0; q < 4; ++q) *(LAS f32x4*)(PART + 16 * lane + 4 * q) = (f32x4){oacc[4 * q], oacc[4 * q + 1], oacc[4 * q + 2], oacc[4 * q + 3]}; }
        __syncthreads();
        if (half == 1) return;
#pragma unroll
        for (int q = 0; q < 4; ++q) { const f32x4 p = *(const LAS f32x4*)(PART + 16 * lane + 4 * q); oacc[4 * q] += p.x; oacc[4 * q + 1] += p.y; oacc[4 * q + 2] += p.z; oacc[4 * q + 3] += p.w; }
    }
    asm volatile("" : "+s"(row)); const int lane2 = lane_id();
    const f32x4* x2 = (const f32x4*)((const float*)(ws + WS_X2) + (size_t)row * DM + 16 * lane2);
    f32x4 xv[4]; float ss = 0.f;
#pragma unroll
    for (int q = 0; q < 4; ++q) { xv[q] = x2[q]; xv[q].x += oacc[4 * q]; xv[q].y += oacc[4 * q + 1]; xv[q].z += oacc[4 * q + 2]; xv[q].w += oacc[4 * q + 3]; ss += (xv[q].x * xv[q].x + xv[q].y * xv[q].y) + (xv[q].z * xv[q].z + xv[q].w * xv[q].w); }
    const float r = rsqrtf(wave_sum(ss) * (1.f / DM) + EPS);
    const f32x4* gf = (const f32x4*)((const float*)a.in[I_GFIN] + 16 * lane2);
    f32x4* y = (f32x4*)((row < TP ? a.out + O_YP + (size_t)row * DM : a.out + O_YS + (size_t)(row - TP) * DM) + 16 * lane2);
#pragma unroll
    for (int q = 0; q < 4; ++q) { const f32x4 g4 = gf[q]; f32x4 o; o.x = xv[q].x * r * g4.x; o.y = xv[q].y * r * g4.y; o.z = xv[q].z * r * g4.z; o.w = xv[q].w * r * g4.w; y[q] = o; }
}
__device__ __forceinline__ void cand_ij(int c, int& ci, int& cj) {
    if (c < 16) { ci = 0; cj = c; } else if (c < 24) { ci = 1; cj = c - 16; } else if (c < 29) { ci = 2; cj = c - 24; } else if (c < 33) { ci = 3; cj = c - 29; }
    else if (c < 36) { ci = 4; cj = c - 33; } else if (c < 38) { ci = 5; cj = c - 36; } else if (c < 40) { ci = 6; cj = c - 38; } else if (c < 42) { ci = 7; cj = c - 40; } else if (c < 50) { ci = c - 34; cj = 0; } else { ci = 0; cj = 0; }
}
__device__ __forceinline__ void peer_phase(const Frame& F, const Args& a) {
    LAS unsigned* TOPS = (LAS unsigned*)F.lds + F.wave * 256;
    LAS unsigned* CT = (LAS unsigned*)F.lds + 8 * 256 + 4 * 1024;
    if (F.tid < 64) { int ci, cj; cand_ij(F.tid, ci, cj); CT[F.tid] = (unsigned)ci | ((unsigned)cj << 8); }
    __syncthreads();
    const int gw = F.vcu * NWAVES + F.wave, NGW = F.G * NWAVES;
    const int nfull = TA / NGW, rem = TA - nfull * NGW;
#pragma unroll 1
    for (int i = 0; i < nfull; ++i) peer_token<false>(F, a, gw + i * NGW, TOPS, CT, 0, nullptr);
    if (rem == 4 * F.G) {
        __syncthreads();
        peer_token<true>(F, a, nfull * NGW + F.vcu * 4 + (F.wave >> 1), TOPS, CT, F.wave & 1, (LAS float*)F.lds + 8 * 256 + (F.wave >> 1) * 1024);
    } else {
        const int row = gw + nfull * NGW; if (row < TA) peer_token<false>(F, a, row, TOPS, CT, 0, nullptr);
    }
}


template <class EpiS>
__device__ __forceinline__ void skinny_tile(const Frame& F, const bf16* A, int lda, const bf16* Bt, int ldb, int tm, int tn, const EpiS& E) {
    const int lane = F.lane, fr = lane & 15, fq = lane >> 4, w = F.wave;
    const bf16* ap = A + (size_t)(tm * 64 + fr) * lda + w * 128 + 8 * fq;
    const bf16* bp = Bt + (size_t)(tn * 64 + fr) * ldb + w * 128 + 8 * fq;
    v4u af[4][4], bfr[4][4];
#pragma unroll
    for (int m = 0; m < 4; ++m)
#pragma unroll
        for (int ks = 0; ks < 4; ++ks) { af[m][ks] = *(const v4u*)(ap + (size_t)(16 * m) * lda + ks * 32); bfr[m][ks] = *(const v4u*)(bp + (size_t)(16 * m) * ldb + ks * 32); }
    f32x4 acc[4][4];
#pragma unroll
    for (int m = 0; m < 4; ++m)
#pragma unroll
        for (int n = 0; n < 4; ++n) acc[m][n] = (f32x4){0.f, 0.f, 0.f, 0.f};
#pragma unroll
    for (int ks = 0; ks < 4; ++ks)
#pragma unroll
        for (int m = 0; m < 4; ++m)
#pragma unroll
            for (int n = 0; n < 4; ++n) acc[m][n] = __builtin_amdgcn_mfma_f32_16x16x32_bf16(__builtin_bit_cast(bf16x8, bfr[n][ks]), __builtin_bit_cast(bf16x8, af[m][ks]), acc[m][n], 0, 0, 0);
    LAS float* PS = (LAS float*)F.lds + w * 4096;
#pragma unroll
    for (int m = 0; m < 4; ++m)
#pragma unroll
        for (int n = 0; n < 4; ++n) *(LAS f32x4*)(PS + (16 * m + fr) * 64 + 4 * ((4 * n + fq) ^ fr)) = acc[m][n];
    lds_barrier();
    {
        const int row = F.tid >> 3, c8 = (F.tid & 7) * 8; const LAS float* PR = (const LAS float*)F.lds + row * 64;
        const int ch0 = 4 * (((F.tid & 7) * 2) ^ (row & 15)), ch1 = 4 * (((F.tid & 7) * 2 + 1) ^ (row & 15));
        f32x4 s0 = *(const LAS f32x4*)(PR + ch0), s1 = *(const LAS f32x4*)(PR + ch1);
#pragma unroll
        for (int ww = 1; ww < 8; ++ww) { s0 += *(const LAS f32x4*)(PR + ww * 4096 + ch0); s1 += *(const LAS f32x4*)(PR + ww * 4096 + ch1); }
        float v[8] = {s0.x, s0.y, s0.z, s0.w, s1.x, s1.y, s1.z, s1.w};
        E(tm * 64 + row, tn * 64 + c8, v, F.tid);
    }
    lds_barrier();
}
struct EpiSk {
    float* d32; int ld32; bf16* d16; int ld16; float sc16;
    const float* res; int ldr;
    const float* gcol; float* ssq; const float* rsq;
    __device__ __forceinline__ void operator()(int row, int col, float (&v)[8], int tid) const {
        if (rsq) { const float rs = rsqrtf(rsq[row] * (1.f / 1024.f) + EPS);
#pragma unroll
            for (int i = 0; i < 8; ++i) v[i] *= rs; }
        if (res) { const f32x4 a = *(const f32x4*)(res + (size_t)row * ldr + col), b = *(const f32x4*)(res + (size_t)row * ldr + col + 4);
            v[0] += a.x; v[1] += a.y; v[2] += a.z; v[3] += a.w; v[4] += b.x; v[5] += b.y; v[6] += b.z; v[7] += b.w; }
        if (d32) { *(f32x4*)(d32 + (size_t)row * ld32 + col) = (f32x4){v[0], v[1], v[2], v[3]}; *(f32x4*)(d32 + (size_t)row * ld32 + col + 4) = (f32x4){v[4], v[5], v[6], v[7]}; }
        if (ssq) { float ss = 0.f;
#pragma unroll
            for (int i = 0; i < 8; ++i) ss += v[i] * v[i];
            ss += __shfl_xor(ss, 1); ss += __shfl_xor(ss, 2); ss += __shfl_xor(ss, 4);
            if ((tid & 7) == 0) atomicAdd(ssq + row, ss); }
        if (d16) { float w8[8];
#pragma unroll
            for (int i = 0; i < 8; ++i) w8[i] = v[i];
            if (gcol) { const f32x4 a = *(const f32x4*)(gcol + col), b = *(const f32x4*)(gcol + col + 4); w8[0] *= a.x; w8[1] *= a.y; w8[2] *= a.z; w8[3] *= a.w; w8[4] *= b.x; w8[5] *= b.y; w8[6] *= b.z; w8[7] *= b.w; }
            v4u o; o.x = pg8::cvt_pk_bf16(w8[0] * sc16, w8[1] * sc16); o.y = pg8::cvt_pk_bf16(w8[2] * sc16, w8[3] * sc16); o.z = pg8::cvt_pk_bf16(w8[4] * sc16, w8[5] * sc16); o.w = pg8::cvt_pk_bf16(w8[6] * sc16, w8[7] * sc16);
            *(v4u*)(d16 + (size_t)row * ld16 + col) = o; }
    }
};

#define SK_TM16(t) (4 * (((t) >> 5) >> 1) + (((t) & 31) >> 3))
#define SK_TN16(t) (8 * (((t) >> 5) & 1) + ((t) & 7))
#define SK_TM32(t) (4 * ((((t) & 255) >> 5) >> 1) + ((((t) & 31) + 32 * ((t) >> 8)) >> 4))
#define SK_TN32(t) (16 * ((((t) & 255) >> 5) & 1) + ((((t) & 31) + 32 * ((t) >> 8)) & 15))


#ifndef PH_MAX
#define PH_MAX 99
#endif
__global__ void __launch_bounds__(NTHR, 2) mega_fwd(Args args) {
    extern __shared__ __attribute__((aligned(16))) unsigned char lds_raw[];
    Frame F;
    F.lds = (LAS unsigned char*)lds_raw;
    F.wave = __builtin_amdgcn_readfirstlane((int)threadIdx.x >> 6); F.lane = lane_id(); F.tid = F.wave * 64 + F.lane;
    F.G = gridDim.x; { const int bx = blockIdx.x; F.vcu = (F.G % 8 == 0) ? (bx % 8) * (F.G / 8) + bx / 8 : bx; }
    volatile LAS unsigned* MISC = (volatile LAS unsigned*)(F.lds + MISC_OFF);
    LAS unsigned long long* ARGP = (LAS unsigned long long*)(F.lds + ARGS_OFF);
    for (int u = F.tid; u < (LDS_BYTES - LDSCTL_OFF) / 4; u += NTHR) ((LAS unsigned*)(F.lds + LDSCTL_OFF))[u] = 0u;
    __syncthreads();
    if (F.tid == 0) {
        ARGP[0] = (unsigned long long)args.in[0];
        ARGP[1] = (unsigned long long)args.in[1];
        ARGP[2] = (unsigned long long)args.in[2];
        ARGP[3] = (unsigned long long)args.in[3];
        ARGP[4] = (unsigned long long)args.in[4];
        ARGP[5] = (unsigned long long)args.in[5];
        ARGP[6] = (unsigned long long)args.in[6];
        ARGP[7] = (unsigned long long)args.in[7];
        ARGP[8] = (unsigned long long)args.in[8];
        ARGP[9] = (unsigned long long)args.in[9];
        ARGP[10] = (unsigned long long)args.in[10];
        ARGP[11] = (unsigned long long)args.in[11];
        ARGP[12] = (unsigned long long)args.in[12];
        ARGP[13] = (unsigned long long)args.in[13];
        ARGP[14] = (unsigned long long)args.in[14];
        ARGP[15] = (unsigned long long)args.in[15];
        ARGP[16] = (unsigned long long)args.in[16];
        ARGP[17] = (unsigned long long)args.in[17];
        ARGP[18] = (unsigned long long)args.in[18];
        ARGP[19] = (unsigned long long)args.in[19];
        ARGP[20] = (unsigned long long)args.in[20];
        ARGP[21] = (unsigned long long)args.in[21];
        ARGP[22] = (unsigned long long)args.in[22];
        ARGP[23] = (unsigned long long)args.in[23];
        ARGP[24] = (unsigned long long)args.in[24];
        ARGP[25] = (unsigned long long)args.in[25];
        ARGP[26] = (unsigned long long)args.in[26];
        ARGP[27] = (unsigned long long)args.in[27];
        ARGP[28] = (unsigned long long)args.in[28];
        ARGP[N_INPUTS] = (unsigned long long)args.out; ARGP[N_INPUTS + 1] = (unsigned long long)args.ws;
    }
    __syncthreads();
    { const XcdBarrier bar0 = xcd_barrier_post((unsigned*)((gu32*)(args.ws + WS_CTL) + CW_BAR), MISC + 8, F.wave); if (F.tid == 0) MISC[10] = bar0.x; }
    __syncthreads();
#define GRID_BAR() do { XcdBarrier bar_; bar_.bar = (unsigned*)((gu32*)((unsigned char*)ld_ptr(ARGP + N_INPUTS + 1) + WS_CTL) + CW_BAR); bar_.x = MISC[10]; bar_.st = MISC + 8; bar_.wave = F.wave; xcd_barrier(bar_); } while (0)
#define PHASE_ARGS const Args A = load_args(ARGP); unsigned char* const ws = A.ws; float* const out = A.out; (void)ws; (void)out; { int l_ = lane_id(); asm volatile("" : "+v"(l_)); F.lane = l_; F.tid = F.wave * 64 + l_; }

    { PHASE_ARGS;
    p0_prologue(F, A);
    }
    GRID_BAR();
#if defined(PROBE_BAR8)
    GRID_BAR(); GRID_BAR(); GRID_BAR(); GRID_BAR(); GRID_BAR(); GRID_BAR(); GRID_BAR(); GRID_BAR();
#endif
#if PH_MAX >= 1
    { PHASE_ARGS;
    {
        pg8::Gemm g{(const bf16*)(ws + WS_HB), (const bf16*)(ws + WS_WIN), DM, DM, DM};
        pg8::StaticOrder S; S.init(TA, N_IN, F.G, (int)blockIdx.x);
        EpiInProj E{out, ws, (const float*)A.in[I_BFF]};
        pg8::gemm_phase(F.lds, g, S, E, F.wave);
    }
    {
        const int off = (TA / 256) * (N_IN / 256) % F.G;
        pg8::Gemm g{(const bf16*)(ws + WS_MB), (const bf16*)(ws + WS_WMK), DM, DM, DM};
        pg8::StaticOrder S; S.init(512, DM, F.G, ((int)blockIdx.x + F.G - off) % F.G);
        EpiGen E{out + O_MKP, DM, (bf16*)(ws + WS_MK16), DM, 1.f, nullptr, nullptr, 0, 0, nullptr, nullptr, nullptr};
        pg8::gemm_phase(F.lds, g, S, E, F.wave);
    }
    {
        const int off = ((TA / 256) * (N_IN / 256) + 8) % F.G;
        pg8::Gemm g{(const bf16*)(ws + WS_MB), (const bf16*)(ws + WS_WMV), DM, DM, DM};
        pg8::StaticOrder S; S.init(512, DM, F.G, ((int)blockIdx.x + F.G - off) % F.G);
        EpiGen E{out + O_MVP, DM, nullptr, 0, 1.f, nullptr, nullptr, 0, 0, nullptr, nullptr, nullptr};
        pg8::gemm_phase(F.lds, g, S, E, F.wave);
    }
    {
        const int off = ((TA / 256) * (N_IN / 256) + 16) % F.G;
        pg8::Gemm g{(const bf16*)(ws + WS_WMV), (const bf16*)(ws + WS_MB), DM, DM, DM};
        pg8::StaticOrder S; S.init(DM, 512, F.G, ((int)blockIdx.x + F.G - off) % F.G);
        EpiGen E{nullptr, 0, (bf16*)(ws + WS_MVT16), 512, 1.f, nullptr, nullptr, 0, 0, nullptr, nullptr, nullptr};
        pg8::gemm_phase(F.lds, g, S, E, F.wave);
    }
    }
    GRID_BAR();
#endif
#if PH_MAX >= 2
    asm volatile("; ===PHASE 2===");
    { PHASE_ARGS;
    {
        const int gw = F.vcu * NWAVES + F.wave, NGW = F.G * NWAVES;
        if ((gw & 3) == 0) for (int it = gw >> 2; it < 512; it += NGW >> 2) fox_norms_item(F, (const bf16*)(ws + WS_QF), (const bf16*)(ws + WS_KF), out + O_LFP, (float*)(ws + WS_MISC + MiB), (float*)(ws + WS_KBIAS), (float*)(ws + WS_MISC + MiB + 65536), it);
        for (int it = gw; it < NB_S * NPAGES; it += NGW) fox_suffix_item(F, (const float*)A.in[I_CFL], (const int*)A.in[I_PT], (float*)(ws + WS_SUF), (float*)(ws + WS_MISC + 2 * MiB), it);
        for (int u = F.vcu; u < 1024; u += F.G) gla_g1_unit(F, A, u);
        for (int u = F.vcu; u < 512; u += F.G) gla_sample_unit(F, A, u);
    }
    }
    GRID_BAR();
#endif
#if PH_MAX >= 3
    asm volatile("; ===PHASE 3===");
    { PHASE_ARGS;
    gla_scan(F, A);
    __syncthreads();
    for (int i = F.vcu; i < 256; i += F.G) { const int bh = i >> 4, s = i & 15;
        fox_attn_unit(F, (const bf16*)(ws + WS_QF), (const bf16*)(ws + WS_KF), (const bf16*)(ws + WS_VF), (const float*)(ws + WS_KBIAS), (const float*)(ws + WS_MISC + MiB + 65536), (const float*)(ws + WS_MISC + MiB), (bf16*)(ws + WS_MERGED), bh >> 3, bh & 7, s);
        fox_attn_unit(F, (const bf16*)(ws + WS_QF), (const bf16*)(ws + WS_KF), (const bf16*)(ws + WS_VF), (const float*)(ws + WS_KBIAS), (const float*)(ws + WS_MISC + MiB + 65536), (const float*)(ws + WS_MISC + MiB), (bf16*)(ws + WS_MERGED), bh >> 3, bh & 7, 31 - s); }
    }
    GRID_BAR();
#endif
#if PH_MAX >= 4
    asm volatile("; ===PHASE 4===");
    { PHASE_ARGS;
    if (!(F.vcu & 1)) { for (int u = F.vcu; u < 1024; u += F.G) gla_g3_unit(F, A, u); }
    }
    { PHASE_ARGS;
    for (int u = F.vcu; u < 1024; u += F.G) fox_sample_unit(F, A, u);
    }
    { PHASE_ARGS;
    if (F.vcu & 1) { for (int u = F.vcu; u < 1024; u += F.G) gla_g3_unit(F, A, u); }
    }
    GRID_BAR();
#endif
#if PH_MAX >= 5
    asm volatile("; ===PHASE 5===");
    { PHASE_ARGS;
    {
        pg8::Gemm g{(const bf16*)(ws + WS_MERGED), (const bf16*)(ws + WS_WOUT), DM, DM, DM};
        pg8::StaticOrder S; S.init(TP, DM, F.G, (int)blockIdx.x);
        EpiGen E{(float*)(ws + WS_X1), DM, (bf16*)(ws + WS_HB), DM, 1.f, (const float*)A.in[I_XP], (const float*)A.in[I_XS], TP, DM, (const float*)A.in[I_GCROSS], (float*)(ws + WS_SS), nullptr};
        pg8::gemm_phase(F.lds, g, S, E, F.wave);
        __syncthreads();
        EpiSk Es{(float*)(ws + WS_X1) + (size_t)TP * DM, DM, (bf16*)(ws + WS_HB) + (size_t)TP * DM, DM, 1.f, (const float*)A.in[I_XS], DM, (const float*)A.in[I_GCROSS], (float*)(ws + WS_SS) + TP, nullptr};
        for (int t = F.vcu; t < 256; t += F.G) skinny_tile(F, (const bf16*)(ws + WS_MERGED) + (size_t)TP * DM, DM, (const bf16*)(ws + WS_WOUT), DM, SK_TM16(t), SK_TN16(t), Es);
    }
    }
    GRID_BAR();
#endif
#if PH_MAX >= 7
    asm volatile("; ===PHASE 7===");
    { PHASE_ARGS;
    {
        pg8::Gemm g{(const bf16*)(ws + WS_HB), (const bf16*)(ws + WS_WCQ), DM, DM, DM};
        pg8::StaticOrder S; S.init(TP, DM, F.G, (int)blockIdx.x);
        EpiGen E{nullptr, 0, (bf16*)(ws + WS_QC), DM, C2C, nullptr, nullptr, 0, 0, nullptr, nullptr, (const float*)(ws + WS_SS)};
        pg8::gemm_phase(F.lds, g, S, E, F.wave);
        __syncthreads();
        EpiSk Es{nullptr, 0, (bf16*)(ws + WS_QC) + (size_t)TP * DM, DM, C2C, nullptr, 0, nullptr, nullptr, (const float*)(ws + WS_SS) + TP};
        for (int t = F.vcu; t < 256; t += F.G) skinny_tile(F, (const bf16*)(ws + WS_HB) + (size_t)TP * DM, DM, (const bf16*)(ws + WS_WCQ), DM, SK_TM16(t), SK_TN16(t), Es);
    }
    }
    GRID_BAR();
#endif
#if PH_MAX >= 8
    asm volatile("; ===PHASE 8===");
    { PHASE_ARGS;
    {
        const int u = (int)blockIdx.x, b = (u >> 7) & 1, h = (u >> 5) & 3, pnl = u & 31;
        const size_t roff = ((size_t)b * SEQ + pnl * 256) * DM + h * 256;
        if (F.vcu & 1) { for (int v = F.vcu; v < 512; v += F.G) cross_sample_unit(F, A, v); }
        pg8::Gemm g{(const bf16*)(ws + WS_QC) + roff, (const bf16*)(ws + WS_MK16) + (size_t)(b * 256) * DM + h * 256, DM, DM, 256};
        pg8::SingleUnit S{u < 256 ? 1 : 0, {0, 0}};
        EpiSoftmaxP E{ARGP};
        pg8::gemm_phase(F.lds, g, S, E, F.wave);
        VM_WAIT(); __syncthreads();
        {
            pg8::Gemm g2{(const bf16*)(ws + WS_PC) + roff, (const bf16*)(ws + WS_MVT16) + (size_t)(h * 256) * 512 + b * 256, DM, 512, 256};
            EpiGen E2{nullptr, 0, (bf16*)(ws + WS_OC) + roff, DM, 1.f, nullptr, nullptr, 0, 0, nullptr, nullptr, nullptr};
            pg8::gemm_phase(F.lds, g2, S, E2, F.wave);
        }
        __syncthreads();
        if (!(F.vcu & 1)) { for (int v = F.vcu; v < 512; v += F.G) cross_sample_unit(F, A, v); }
    }
    }
    GRID_BAR();
#endif
#if PH_MAX >= 10
    asm volatile("; ===PHASE 10===");
    { PHASE_ARGS;
    {
        pg8::Gemm g{(const bf16*)(ws + WS_OC), (const bf16*)(ws + WS_WCO), DM, DM, DM};
        pg8::StaticOrder S; S.init(TP, DM, F.G, (int)blockIdx.x);
        EpiGen E{(float*)(ws + WS_X2), DM, (bf16*)(ws + WS_HB), DM, 1.f, (const float*)(ws + WS_X1), (const float*)(ws + WS_X1), TA, DM, (const float*)A.in[I_GFFN], (float*)(ws + WS_SS) + TA, nullptr};
        pg8::gemm_phase(F.lds, g, S, E, F.wave);
        __syncthreads();
        EpiSk Es{(float*)(ws + WS_X2) + (size_t)TP * DM, DM, (bf16*)(ws + WS_HB) + (size_t)TP * DM, DM, 1.f, (const float*)(ws + WS_X1) + (size_t)TP * DM, DM, (const float*)A.in[I_GFFN], (float*)(ws + WS_SS) + TA + TP, nullptr};
        for (int t = F.vcu; t < 256; t += F.G) skinny_tile(F, (const bf16*)(ws + WS_OC) + (size_t)TP * DM, DM, (const bf16*)(ws + WS_WCO), DM, SK_TM16(t), SK_TN16(t), Es);
    }
    }
    GRID_BAR();
#endif
#if PH_MAX >= 12
    asm volatile("; ===PHASE 12===");
    { PHASE_ARGS;
    {
        pg8::Gemm g{(const bf16*)(ws + WS_HB), (const bf16*)(ws + WS_WPK), DM, DM, DM};
        pg8::StaticOrder S; S.init(TP, 2048, F.G, (int)blockIdx.x);
        EpiGen E{nullptr, 0, (bf16*)(ws + WS_SC), 2048, 1.f, nullptr, nullptr, 0, 0, nullptr, nullptr, (const float*)(ws + WS_SS) + TA};
        pg8::gemm_phase(F.lds, g, S, E, F.wave);
        __syncthreads();
        EpiSk Es{nullptr, 0, (bf16*)(ws + WS_SC) + (size_t)TP * 2048, 2048, 1.f, nullptr, 0, nullptr, nullptr, (const float*)(ws + WS_SS) + TA + TP};
        for (int t = F.vcu; t < 512; t += F.G) skinny_tile(F, (const bf16*)(ws + WS_HB) + (size_t)TP * DM, DM, (const bf16*)(ws + WS_WPK), DM, SK_TM32(t), SK_TN32(t), Es);
    }
    }
    GRID_BAR();
#endif
#if PH_MAX >= 13
    asm volatile("; ===PHASE 13===");
    { PHASE_ARGS;
    peer_phase(F, A);
    }
#endif
#if PH_MAX < 13
    {   PHASE_ARGS;
        const int gw = F.vcu * NWAVES + F.wave, NGW = F.G * NWAVES;
        for (int m = gw; m < TA; m += NGW) {
            const float* x = m < TP ? (const float*)A.in[I_XP] + (size_t)m * DM : (const float*)A.in[I_XS] + (size_t)(m - TP) * DM;
            float* y = m < TP ? out + O_YP + (size_t)m * DM : out + O_YS + (size_t)(m - TP) * DM;
            for (int j = 0; j < 4; ++j) ((f32x4*)y)[F.lane + 64 * j] = ((const f32x4*)x)[F.lane + 64 * j];
        }
    }
#endif

}

extern "C" void kernel_launch(void* const* d_in, const int* in_sizes, int n_in, void* d_out, int out_size, void* d_ws, size_t ws_size, hipStream_t stream) {
    static int grid = 0;
    if (grid == 0) {
        if (n_in != N_INPUTS || (size_t)out_size != O_TOTAL || ws_size < WS_END) { fprintf(stderr, "kernel_launch: unexpected shapes (n_in %d out %d ws %zu)\n", n_in, out_size, ws_size); grid = -1; return; }
        int dev = 0, cus = 0, per_cu = 0;
        if (hipGetDevice(&dev) != hipSuccess || hipDeviceGetAttribute(&cus, hipDeviceAttributeMultiprocessorCount, dev) != hipSuccess) { grid = -1; return; }
        if (hipFuncSetAttribute((const void*)mega_fwd, hipFuncAttributeMaxDynamicSharedMemorySize, LDS_BYTES) != hipSuccess) { fprintf(stderr, "kernel_launch: hipFuncSetAttribute failed\n"); grid = -1; return; }
        if (hipOccupancyMaxActiveBlocksPerMultiprocessor(&per_cu, (const void*)mega_fwd, NTHR, LDS_BYTES) != hipSuccess || per_cu < 1)
            fprintf(stderr, "kernel_launch: occupancy query reports %d workgroups per CU\n", per_cu);
        (void)hipGetLastError();
        grid = cus;
        if (grid > 256) grid = 256;
    }
    if (grid < 0) return;
    if (hipMemsetAsync((char*)d_ws + WS_CTL, 0, CTL_ZERO_BYTES, stream) != hipSuccess) return;
    Args a{};
    for (int i = 0; i < N_INPUTS; ++i) a.in[i] = d_in[i];
    a.out = (float*)d_out; a.ws = (unsigned char*)d_ws;
    hipLaunchKernelGGL(mega_fwd, dim3(grid), dim3(NTHR), LDS_BYTES, stream, a);
    const hipError_t le = hipPeekAtLastError();
    if (le != hipSuccess) fprintf(stderr, "kernel_launch: launch failed: %s\n", hipGetErrorName(le));
}
```

```cpp
#define PH_MAX 13
#include <hip/hip_runtime.h>
#include <cstdio>
#include <cstdint>

namespace pg8 {
#define PG8_LAS __attribute__((address_space(3)))
typedef unsigned short bf16_t;
typedef short bf16x8 __attribute__((ext_vector_type(8)));
typedef float f32x4 __attribute__((ext_vector_type(4)));
typedef unsigned u32x4 __attribute__((ext_vector_type(4)));
typedef unsigned u32x2 __attribute__((ext_vector_type(2)));
constexpr int BM = 256, BK = 64, HALF = 128, HTB = HALF * BK * 2  , STAGE_BYTES = 8 * HTB, NXCD = 8, WGM = 8;

__host__ __device__ __forceinline__ int lds_byte(int r, int c) { const int st = (r >> 4) * 2 + (c >> 5), rr = r & 15, cc = c & 31, ob = rr * 64 + cc * 2; return st * 1024 + (ob ^ (((ob >> 9) & 1) << 5)); }
__host__ __device__ __forceinline__ void stage_rc(int b, int& R, int& C) { const int st = b / 1024, sb = b % 1024, swz = sb ^ (((sb >> 9) & 1) << 5); R = (st >> 1) * 16 + swz / 64; C = (st & 1) * 32 + (swz % 64) / 2; }

struct Unit { int pm, pn; };
struct Gemm { const bf16_t* A; const bf16_t* Bt; int lda, ldb, K; };

struct StaticOrder {
    int nM, nN, nwg, G, c;
    __host__ __device__ void init(int M, int N, int G_, int c_) { nM = M / BM; nN = N / BM; nwg = nM * nN; G = G_; c = c_; }
    __host__ __device__ bool next(int i, Unit& u) const {
        const long L = (long)i * G + c; if (L >= nwg) return false;
        int wgid = (int)L; { const int q = nwg / NXCD, r = nwg % NXCD, xcd = wgid % NXCD, off = wgid / NXCD; wgid = (xcd < r ? xcd * (q + 1) : r * (q + 1) + (xcd - r) * q) + off; }
        const int nig = WGM * nN, gid = wgid / nig, fm = gid * WGM, gsz = (nM - fm) < WGM ? (nM - fm) : WGM;
        u.pm = fm + ((wgid % nig) % gsz); u.pn = (wgid % nig) / gsz; return true;
    }
};
struct SingleUnit {
    int has; Unit u0;
    __host__ __device__ bool next(int i, Unit& u) const { if (i != 0 || !has) return false; u = u0; return true; }
};

__device__ __forceinline__ unsigned cvt_pk_bf16(float lo, float hi) { unsigned r; asm volatile("v_cvt_pk_bf16_f32 %0, %1, %2" : "=v"(r) : "v"(lo), "v"(hi)); return r; }

template <class Epi, class Sched>
__device__ __forceinline__ void gemm_phase(PG8_LAS unsigned char* lds, const Gemm g, const Sched& S, const Epi& E, int wave_id) {
    int lane; asm volatile("v_mbcnt_lo_u32_b32 %0, -1, 0\n\tv_mbcnt_hi_u32_b32 %0, -1, %0" : "=v"(lane));
    const int wid = wave_id; const int tid = wid * 64 + lane; const int wr = wid >> 2, wc = wid & 3, fr = lane & 15, fq = lane >> 4;
    const int K = g.K, nt = K / BK;
    unsigned voffA[2], voffB[2];
#pragma unroll
    for (int i = 0; i < 2; ++i) { int R, C; stage_rc(tid * 16 + i * 8192, R, C);
        voffA[i] = (unsigned)(R * g.lda + C) * 2u; voffB[i] = (unsigned)(R * g.ldb + C) * 2u; }
    const size_t kstep = (size_t)(BK * 2);
    const size_t hstepA = (size_t)HALF * g.lda * 2, hstepB = (size_t)HALF * g.ldb * 2;
    const size_t tstepA = 2 * hstepA, tstepB = 2 * hstepB;
    const unsigned ldsw = (unsigned)wid * 1024u;
    const int aoff = lds_byte(wr * 64 + fr, fq * 8), boff = lds_byte(wc * 32 + fr, fq * 8);
#define PG8_SA(b, h) (((b) * 2 + (h)) * HTB)
#define PG8_SB(b, h) ((4 + (b) * 2 + (h)) * HTB)
#define PG8_STAGE(bufoff, gbase, voff) do { _Pragma("unroll") for (int _i = 0; _i < 2; ++_i) \
        __builtin_amdgcn_global_load_lds((const unsigned*)((const char*)(gbase) + (voff)[_i]), (PG8_LAS unsigned*)(lds + (bufoff) + ldsw + _i * 8192), 16, 0, 0); } while (0)
#define PG8_LDA(dst, b, h) do { _Pragma("unroll") for (int m = 0; m < 4; ++m) _Pragma("unroll") for (int k = 0; k < 2; ++k) dst[m][k] = *(const PG8_LAS bf16x8*)(lds + PG8_SA(b, h) + aoff + m * 2048 + k * 1024); } while (0)
#define PG8_LDB(dst, b, h) do { _Pragma("unroll") for (int n = 0; n < 2; ++n) _Pragma("unroll") for (int k = 0; k < 2; ++k) dst[n][k] = *(const PG8_LAS bf16x8*)(lds + PG8_SB(b, h) + boff + n * 2048 + k * 1024); } while (0)
#define PG8_MMA(ai, bj, At, Bt) do { __builtin_amdgcn_s_setprio(1); _Pragma("unroll") for (int m = 0; m < 4; ++m) _Pragma("unroll") for (int n = 0; n < 2; ++n) _Pragma("unroll") for (int k = 0; k < 2; ++k) \
        acc[ai][bj][m][n] = __builtin_amdgcn_mfma_f32_16x16x32_bf16(Bt[n][k], At[m][k], acc[ai][bj][m][n], 0, 0, 0); __builtin_amdgcn_s_setprio(0); } while (0)
#define PG8_WAIT_V(n) asm volatile("s_waitcnt vmcnt(" #n ")" ::: "memory")
#define PG8_WAIT_L(n) asm volatile("s_waitcnt lgkmcnt(" #n ")" ::: "memory")
#define PG8_BAR __builtin_amdgcn_s_barrier()
#define PG8_SCHED __builtin_amdgcn_sched_barrier(0)
    Unit cur, nxt; int ui = 0;
    if (!S.next(0, cur)) return;
    f32x4 acc[2][2][4][2];
#pragma unroll
    for (int a = 0; a < 2; ++a)
#pragma unroll
        for (int b = 0; b < 2; ++b)
#pragma unroll
            for (int m = 0; m < 4; ++m)
#pragma unroll
                for (int n = 0; n < 2; ++n) acc[a][b][m][n] = (f32x4){0.f, 0.f, 0.f, 0.f};
    bf16x8 At[4][2], B0[2][2], B1[2][2];
    const char* cA = (const char*)g.A + (size_t)cur.pm * tstepA; const char* cB = (const char*)g.Bt + (size_t)cur.pn * tstepB;
    PG8_STAGE(PG8_SB(0, 0), cB, voffB); PG8_STAGE(PG8_SB(0, 1), cB + hstepB, voffB); PG8_STAGE(PG8_SA(0, 0), cA, voffA); PG8_STAGE(PG8_SA(0, 1), cA + hstepA, voffA);
    if (wr == 1) PG8_BAR;
    PG8_WAIT_V(2); PG8_BAR;
    PG8_STAGE(PG8_SB(1, 0), cB + kstep, voffB); PG8_STAGE(PG8_SA(1, 0), cA + kstep, voffA); PG8_STAGE(PG8_SB(1, 1), cB + hstepB + kstep, voffB);
    PG8_WAIT_V(6); PG8_BAR;
    for (;;) {
        const bool has_next = S.next(ui + 1, nxt);
        const char* nA = has_next ? (const char*)g.A + (size_t)nxt.pm * tstepA : cA; const char* nB = has_next ? (const char*)g.Bt + (size_t)nxt.pn * tstepB : cB;
        for (int t = 0; t < nt; t += 2) {
            const bool last = (t == nt - 2);
            const char* a1 = cA + (size_t)(t + 1) * kstep;
            const char* a2 = last ? nA : cA + (size_t)(t + 2) * kstep; const char* b2 = last ? nB : cB + (size_t)(t + 2) * kstep;
            const char* a3 = a2 + kstep; const char* b3 = b2 + kstep;
            PG8_LDB(B0, 0, 0); PG8_LDB(B1, 0, 1); PG8_SCHED; PG8_LDA(At, 0, 0); PG8_STAGE(PG8_SA(1, 1), a1 + hstepA, voffA);
            PG8_WAIT_V(8); PG8_WAIT_L(0); PG8_BAR; PG8_MMA(0, 0, At, B0); PG8_MMA(0, 1, At, B1); PG8_BAR; PG8_SCHED;
            PG8_LDA(At, 0, 1); PG8_STAGE(PG8_SB(0, 0), b2, voffB); PG8_STAGE(PG8_SB(0, 1), b2 + hstepB, voffB); PG8_STAGE(PG8_SA(0, 0), a2, voffA);
            PG8_WAIT_V(8); PG8_WAIT_L(0); PG8_BAR; PG8_MMA(1, 0, At, B0); PG8_MMA(1, 1, At, B1); PG8_BAR; PG8_SCHED;
            PG8_LDB(B0, 1, 0); PG8_LDB(B1, 1, 1); PG8_SCHED; PG8_LDA(At, 1, 0); PG8_STAGE(PG8_SA(0, 1), a2 + hstepA, voffA);
            PG8_WAIT_V(8); PG8_WAIT_L(0); PG8_BAR; PG8_MMA(0, 0, At, B0); PG8_MMA(0, 1, At, B1); PG8_BAR; PG8_SCHED;
            PG8_LDA(At, 1, 1); PG8_STAGE(PG8_SB(1, 0), b3, voffB); PG8_STAGE(PG8_SB(1, 1), b3 + hstepB, voffB); PG8_STAGE(PG8_SA(1, 0), a3, voffA);
            PG8_WAIT_V(8); PG8_WAIT_L(0); PG8_BAR; PG8_MMA(1, 0, At, B0); PG8_MMA(1, 1, At, B1); PG8_BAR; PG8_SCHED;
        }
        if (wr == 0) PG8_BAR;
        if constexpr (!Epi::AFTER_DRAIN) { E(acc, cur, wr, wc, fr, fq); }
        if (!has_next) break;
#pragma unroll
        for (int a = 0; a < 2; ++a)
#pragma unroll
            for (int b = 0; b < 2; ++b)
#pragma unroll
                for (int m = 0; m < 4; ++m)
#pragma unroll
                    for (int n = 0; n < 2; ++n) acc[a][b][m][n] = (f32x4){0.f, 0.f, 0.f, 0.f};
        cur = nxt; cA = nA; cB = nB; ++ui;
        if (wr == 1) PG8_BAR;
    }
    PG8_WAIT_V(0);
    PG8_BAR;
    if constexpr (Epi::AFTER_DRAIN) { E.fused(acc, cur, wr, wc, fr, fq, lds, wid, lane); }
#undef PG8_SA
#undef PG8_SB
#undef PG8_STAGE
#undef PG8_LDA
#undef PG8_LDB
#undef PG8_MMA
#undef PG8_WAIT_V
#undef PG8_WAIT_L
#undef PG8_BAR
#undef PG8_SCHED
}
}

#define GAS __attribute__((address_space(1)))
#define LAS __attribute__((address_space(3)))
typedef unsigned short bf16;
typedef unsigned v4u __attribute__((ext_vector_type(4)));
typedef unsigned v2u __attribute__((ext_vector_type(2)));
typedef float f32x4 __attribute__((ext_vector_type(4)));
typedef float f32x2 __attribute__((ext_vector_type(2)));
typedef float f32x16 __attribute__((ext_vector_type(16)));
typedef short bf16x8 __attribute__((ext_vector_type(8)));
typedef short s16x4 __attribute__((ext_vector_type(4)));
typedef GAS unsigned gu32;
#define RLX_AGENT __ATOMIC_RELAXED, __HIP_MEMORY_SCOPE_AGENT
#define LDS_WAIT() asm volatile("s_waitcnt lgkmcnt(0)" ::: "memory")
#define VM_WAIT() asm volatile("s_waitcnt vmcnt(0)" ::: "memory")
__device__ __forceinline__ unsigned f2bf(float f) { unsigned u = __builtin_bit_cast(unsigned, f); return (u + 0x7fffu + ((u >> 16) & 1u)) >> 16; }
__device__ __forceinline__ unsigned pk2(float lo, float hi) { return f2bf(lo) | (f2bf(hi) << 16); }
__device__ __forceinline__ float bf2f(unsigned short b) { return __builtin_bit_cast(float, (unsigned)b << 16); }
__device__ __forceinline__ float bflo(unsigned u) { return __builtin_bit_cast(float, u << 16); }
__device__ __forceinline__ float bfhi(unsigned u) { return __builtin_bit_cast(float, u & 0xffff0000u); }


typedef short v4i16_t __attribute__((ext_vector_type(4)));
__device__ __forceinline__ s16x4 lds_tr16(LAS unsigned char* p) { return __builtin_bit_cast(s16x4, __builtin_amdgcn_ds_read_tr16_b64_v4i16((LAS v4i16_t*)p)); }
__device__ __forceinline__ int crow(int r, int hi) { return (r & 3) + 8 * (r >> 2) + 4 * hi; }

#define DPP_I(v, ctrl) __builtin_amdgcn_update_dpp(0, (v), (ctrl), 0xF, 0xF, false)
#define DPP_F(v, ctrl) __builtin_bit_cast(float, __builtin_amdgcn_update_dpp(0, __builtin_bit_cast(int, (v)), (ctrl), 0xF, 0xF, false))
constexpr int DPP_X1 = 0xB1, DPP_X2 = 0x4E, DPP_HMIR = 0x141, DPP_MIR = 0x140;
__device__ __forceinline__ unsigned max16_u32(unsigned v) {
    unsigned t = (unsigned)DPP_I((int)v, DPP_X1); v = v > t ? v : t; t = (unsigned)DPP_I((int)v, DPP_X2); v = v > t ? v : t;
    t = (unsigned)DPP_I((int)v, DPP_HMIR); v = v > t ? v : t; t = (unsigned)DPP_I((int)v, DPP_MIR); v = v > t ? v : t; return v; }
__device__ __forceinline__ float sum8_f32(float v) { v += DPP_F(v, DPP_X1); v += DPP_F(v, DPP_X2); v += DPP_F(v, DPP_HMIR); return v; }
__device__ __forceinline__ float sum16_f32(float v) { v = sum8_f32(v); v += DPP_F(v, DPP_MIR); return v; }
__device__ __forceinline__ float max16_f32(float v) { v = fmaxf(v, DPP_F(v, DPP_X1)); v = fmaxf(v, DPP_F(v, DPP_X2)); v = fmaxf(v, DPP_F(v, DPP_HMIR)); v = fmaxf(v, DPP_F(v, DPP_MIR)); return v; }
__device__ __forceinline__ float xor16_f32(float v) { return __builtin_bit_cast(float, __builtin_amdgcn_ds_swizzle(__builtin_bit_cast(int, v), 0x1F | (16 << 10))); }
__device__ __forceinline__ float sum64_f32(float v) {
    v = sum16_f32(v); v += xor16_f32(v);
    return __builtin_bit_cast(float, __builtin_amdgcn_readlane(__builtin_bit_cast(int, v), 0)) + __builtin_bit_cast(float, __builtin_amdgcn_readlane(__builtin_bit_cast(int, v), 32)); }
template <int J> __device__ __forceinline__ unsigned xchg_xor_u32(unsigned v) {
    if constexpr (J == 1) return (unsigned)DPP_I((int)v, DPP_X1);
    else if constexpr (J == 2) return (unsigned)DPP_I((int)v, DPP_X2);
    else return (unsigned)__builtin_amdgcn_ds_swizzle((int)v, 0x1F | (J << 10)); }

__device__ __forceinline__ void lds_barrier() { asm volatile("s_waitcnt lgkmcnt(0)\n\ts_barrier" ::: "memory"); }

struct BfPtr { const unsigned short* p; __device__ __forceinline__ float operator[](size_t i) const { return __builtin_bit_cast(float, (unsigned)p[i] << 16); }
               __device__ __forceinline__ BfPtr operator+(size_t o) const { return BfPtr{p + o}; } };
#define GLD(ptr) (BfPtr{(const unsigned short*)(ptr)})

__device__ __forceinline__ int lane_id() { int r; asm volatile("v_mbcnt_lo_u32_b32 %0, -1, 0\n\tv_mbcnt_hi_u32_b32 %0, -1, %0" : "=v"(r)); return r; }
#define TID_IS_ZERO(wave_) ((wave_) == 0 && lane_id() == 0)
#define XB_TMO      128
#define XB_XCNT(j)  (256  + 64 * (j))
#define XB_XSUB(j)  (1280 + 64 * (j))
#define XB_XGEN(j)  (2304 + 64 * (j))
#define XB_TOP      3328
#define XB_TOPGEN   3392
#define XCD_BAR_WORDS 3456
#define XB_SPIN_CAP (1u << 18)

__device__ __forceinline__ unsigned xb_ld(unsigned* p)              { return __hip_atomic_load(p, __ATOMIC_RELAXED, __HIP_MEMORY_SCOPE_AGENT); }
__device__ __forceinline__ unsigned xb_add(unsigned* p, unsigned v) { return __hip_atomic_fetch_add(p, v, __ATOMIC_RELAXED, __HIP_MEMORY_SCOPE_AGENT); }
__device__ __forceinline__ unsigned xb_xcc_id() { return (unsigned)__builtin_amdgcn_s_getreg((3 << 11) | 20) & 0xFu; }
#define XB_SPIN(cond, bar) do { unsigned _sp = 0; while (cond) { __builtin_amdgcn_s_sleep(1); \
    if ((++_sp & 255u) == 0u) { if (xb_ld(&(bar)[XB_TMO])) break; if (_sp > XB_SPIN_CAP) { atomicAdd(&(bar)[XB_TMO], 1u); break; } } } } while (0)

struct XcdBarrier {
    unsigned* bar; unsigned x; int wave;
    volatile LAS unsigned* st;
};

__device__ __forceinline__ XcdBarrier xcd_barrier_post(unsigned* bar, volatile LAS unsigned* st, int wave) {
    XcdBarrier b; b.bar = bar; b.x = xb_xcc_id(); b.st = st; b.wave = wave;
    if (TID_IS_ZERO(wave)) (void)xb_add(&bar[XB_XCNT(b.x)], 1u);
    return b;
}
__device__ __forceinline__ void xcd_barrier_complete(unsigned* bar, unsigned x, unsigned& nloc, unsigned& nx) {
    const unsigned G = gridDim.x * gridDim.y * gridDim.z;
    unsigned sum, cnt, mine, sp = 0u;
    for (;;) {
        sum = 0u; cnt = 0u; mine = 0u;
#pragma unroll
        for (unsigned j = 0; j < 16; ++j) { const unsigned c = xb_ld(&bar[XB_XCNT(j)]); sum += c; cnt += (c > 0u) ? 1u : 0u; mine = (j == x) ? c : mine; }
        if (sum == G) break;
        __builtin_amdgcn_s_sleep(1);
        if ((++sp & 255u) == 0u) { if (xb_ld(&bar[XB_TMO])) break; if (sp > XB_SPIN_CAP) { atomicAdd(&bar[XB_TMO], 1u); break; } }
    }
    nloc = mine > 0u ? mine : 1u; nx = cnt > 0u ? cnt : 1u;
}

__device__ __forceinline__ void xcd_barrier(const XcdBarrier& b) {
    asm volatile("s_waitcnt vmcnt(0)" ::: "memory");
    __syncthreads();
    if (TID_IS_ZERO(b.wave)) {
        unsigned* bar = b.bar;
        __builtin_amdgcn_s_waitcnt(0);
        unsigned nloc = b.st[0], nx = b.st[1];
        if (nloc == 0u) { xcd_barrier_complete(bar, b.x, nloc, nx); b.st[0] = nloc; b.st[1] = nx; }
        const unsigned old = xb_add(&bar[XB_XSUB(b.x)], 1u);
        const unsigned gen = old / nloc;
        if (old + 1u == (gen + 1u) * nloc) {
            __builtin_amdgcn_fence(__ATOMIC_RELEASE, "agent");
            asm volatile("s_waitcnt vmcnt(0)" ::: "memory");
            const unsigned og = xb_add(&bar[XB_TOP], 1u);
            const unsigned tg = og / nx;
            if (og + 1u == (tg + 1u) * nx) xb_add(&bar[XB_TOPGEN], 1u);
            else XB_SPIN(xb_ld(&bar[XB_TOPGEN]) == tg, bar);
            __builtin_amdgcn_fence(__ATOMIC_ACQUIRE, "agent");
            xb_add(&bar[XB_XGEN(b.x)], 1u);
            asm volatile("s_waitcnt vmcnt(0)" ::: "memory");
        } else {
            XB_SPIN(xb_ld(&bar[XB_XGEN(b.x)]) == gen, bar);
            __builtin_amdgcn_fence(__ATOMIC_ACQUIRE, "agent");
            asm volatile("s_waitcnt vmcnt(0)" ::: "memory");
        }
    }
    __syncthreads();
}


constexpr int NWAVES = 8, NTHR = 512;
constexpr int DM = 1024, TP = 16384, TS = 1024, TA = TP + TS, SEQ = 8192, NB_P = 2, NB_S = 128, LS = 8;
constexpr int N_IN = 3328;
constexpr int PASTL = 2048, PAGE = 128, NPAGES = 16;
constexpr float EPS = 1e-6f;
constexpr float LOG2E = 1.4426950408889634f;
constexpr float C2F = 0.125f * LOG2E;
constexpr float C2C = 0.0625f * LOG2E;

enum { I_XP = 0, I_XS, I_CFK, I_CFV, I_CFL, I_SGLA, I_CMK, I_CMV, I_PT, I_MEMP, I_GMIX, I_WIN, I_BFF, I_WG2, I_BG, I_GGO, I_WOUT, I_GCROSS, I_GMEM,
       I_WMK, I_WMV, I_WCQ, I_WCO, I_GFFN, I_PWQ, I_PSK, I_PU, I_PV, I_GFIN, N_INPUTS };
constexpr size_t O_YP = 0, O_YS = 16777216, O_FKP = 17825792, O_FVP = 26214400, O_LFP = 34603008, O_GSP = 34734080, O_MKP = 34799616, O_MVP = 35323904,
                 O_FKS = 35848192, O_FVS = 36372480, O_LFS = 36896768, O_GSS = 36904960, O_TOTAL = 41099264;

constexpr size_t MiB = 1u << 20;
constexpr size_t WS_CTL = 0, CTL_ZERO_BYTES = 1 * MiB;
constexpr size_t WS_WIN = 2 * MiB, WS_WOUT = 10 * MiB, WS_WMK = 12 * MiB, WS_WMV = 14 * MiB, WS_WCQ = 16 * MiB, WS_WCO = 18 * MiB, WS_WPK = 20 * MiB;
constexpr size_t WS_MB = 24 * MiB, WS_MK16 = 25 * MiB, WS_MVT16 = 26 * MiB, WS_KBIAS = 27 * MiB, WS_GDEC = 28 * MiB, WS_GG = 29 * MiB;
constexpr size_t WS_U16 = 32 * MiB, WS_V16 = 64 * MiB, WS_HB = 96 * MiB, WS_QF = 132 * MiB, WS_KF = 150 * MiB, WS_VF = 168 * MiB;
constexpr size_t WS_GQ = 186 * MiB, WS_GK = 204 * MiB, WS_GV = 222 * MiB, WS_GR = 256 * MiB, WS_SUF = 290 * MiB, WS_GKV = 298 * MiB;
constexpr size_t WS_MERGED = 330 * MiB, WS_X1 = 364 * MiB, WS_X2 = 432 * MiB, WS_QC = 500 * MiB, WS_PC = 534 * MiB, WS_OC = 566 * MiB, WS_SC = 600 * MiB;
constexpr size_t WS_MISC = 736 * MiB, WS_SS = 740 * MiB  , WS_BB = 744 * MiB, WS_END = 800 * MiB;
constexpr int CW_BAR = 4096;

constexpr int RING_BYTES = 131072;
constexpr int LDSCTL_OFF = RING_BYTES, MISC_OFF = LDSCTL_OFF + 320;
constexpr int ARGS_OFF = MISC_OFF + 128;
constexpr int LDS_BYTES = 147456;

struct Args { const void* in[N_INPUTS]; float* out; unsigned char* ws; };

__device__ __forceinline__ const void* ld_ptr(const LAS unsigned long long* p) { const unsigned long long v = *p; const unsigned lo = __builtin_amdgcn_readfirstlane((unsigned)v), hi = __builtin_amdgcn_readfirstlane((unsigned)(v >> 32)); return (const void*)(const GAS char*)(((unsigned long long)hi << 32) | lo); }
__device__ __forceinline__ Args load_args(const LAS unsigned long long* ARGP) { Args A;
    A.in[0] = ld_ptr(ARGP + 0);
    A.in[1] = ld_ptr(ARGP + 1);
    A.in[2] = ld_ptr(ARGP + 2);
    A.in[3] = ld_ptr(ARGP + 3);
    A.in[4] = ld_ptr(ARGP + 4);
    A.in[5] = ld_ptr(ARGP + 5);
    A.in[6] = ld_ptr(ARGP + 6);
    A.in[7] = ld_ptr(ARGP + 7);
    A.in[8] = ld_ptr(ARGP + 8);
    A.in[9] = ld_ptr(ARGP + 9);
    A.in[10] = ld_ptr(ARGP + 10);
    A.in[11] = ld_ptr(ARGP + 11);
    A.in[12] = ld_ptr(ARGP + 12);
    A.in[13] = ld_ptr(ARGP + 13);
    A.in[14] = ld_ptr(ARGP + 14);
    A.in[15] = ld_ptr(ARGP + 15);
    A.in[16] = ld_ptr(ARGP + 16);
    A.in[17] = ld_ptr(ARGP + 17);
    A.in[18] = ld_ptr(ARGP + 18);
    A.in[19] = ld_ptr(ARGP + 19);
    A.in[20] = ld_ptr(ARGP + 20);
    A.in[21] = ld_ptr(ARGP + 21);
    A.in[22] = ld_ptr(ARGP + 22);
    A.in[23] = ld_ptr(ARGP + 23);
    A.in[24] = ld_ptr(ARGP + 24);
    A.in[25] = ld_ptr(ARGP + 25);
    A.in[26] = ld_ptr(ARGP + 26);
    A.in[27] = ld_ptr(ARGP + 27);
    A.in[28] = ld_ptr(ARGP + 28);
    A.out = (float*)ld_ptr(ARGP + N_INPUTS); A.ws = (unsigned char*)ld_ptr(ARGP + N_INPUTS + 1); return A; }
struct Frame {
    LAS unsigned char* lds;
    int tid, lane, wave, vcu, G;
};

__device__ __forceinline__ float wave_sum(float v) { return sum64_f32(v); }
__device__ __forceinline__ float log_sigmoid(float x) { return fminf(x, 0.f) - log1pf(__expf(-fabsf(x))); }

__device__ __forceinline__ int win_src_col(int r) {
    if (r < 1536) return r;
    if (r < 1792) return 1544 + (r - 1536);
    if (r < 2048) return 1800 + (r - 1792);
    if (r < 2560) return 2056 + (r - 2048);
    if (r < 3072) return 2584 + (r - 2560);
    if (r < 3080) return 1536 + (r - 3072);
    if (r < 3096) return 2568 + (r - 3080);
    return -1;
}
template <bool WIN>
__device__ __forceinline__ void p0_transpose_item(const float* W, int ldw, int K, int nblk, bf16* WT, LAS float* scr, int item, int lane) {
    const int kb = item / nblk, nb = item % nblk, k0 = 64 * kb, n0 = 32 * nb;
    const int dr = n0 + (lane & 31); const int sc = WIN ? win_src_col(dr) : dr;
#pragma unroll 8
    for (int i = 0; i < 32; ++i) { const int kk = 2 * i + (lane >> 5); scr[kk * 33 + (lane & 31)] = (sc >= 0) ? W[(size_t)(k0 + kk) * ldw + sc] : 0.f; }
    LDS_WAIT(); asm volatile("" ::: "memory");
    const int c = lane & 7;
#pragma unroll
    for (int j = 0; j < 4; ++j) { const int n = (lane >> 3) + 8 * j; const LAS float* s = scr + (8 * c) * 33 + n;
        v4u o; o.x = pk2(s[0 * 33], s[1 * 33]); o.y = pk2(s[2 * 33], s[3 * 33]); o.z = pk2(s[4 * 33], s[5 * 33]); o.w = pk2(s[6 * 33], s[7 * 33]);
        *(GAS v4u*)(WT + (size_t)(n0 + n) * K + k0 + 8 * c) = o; }
    LDS_WAIT(); asm volatile("" ::: "memory");
}
__device__ __forceinline__ void rms_row_bf16(const float* xrow, const float* g, bf16* orow, int lane) {
    const f32x4* xr = (const f32x4*)xrow + lane; const f32x4* gr = (const f32x4*)g + lane;
    f32x4 v[4]; float s = 0.f;
#pragma unroll
    for (int j = 0; j < 4; ++j) { v[j] = xr[64 * j]; s += (v[j].x * v[j].x + v[j].y * v[j].y) + (v[j].z * v[j].z + v[j].w * v[j].w); }
    const float r = rsqrtf(wave_sum(s) * (1.f / DM) + EPS);
    v2u* o8 = (v2u*)orow + lane;
#pragma unroll
    for (int j = 0; j < 4; ++j) { const f32x4 gg = gr[64 * j]; v2u o; o.x = pk2(v[j].x * r * gg.x, v[j].y * r * gg.y); o.y = pk2(v[j].z * r * gg.z, v[j].w * r * gg.w); o8[64 * j] = o; }
}

using pg8::Unit;
struct EpiGen {
    static constexpr bool PERM = false, AFTER_DRAIN = false;
    float* d32; int ld32; bf16* d16; int ld16; float sc16;
    const float* r0; const float* r1; int rsplit; int ldr;
    const float* gcol;
    float* ssq;
    const float* rsq;
    __device__ __forceinline__ void operator()(const f32x4 (&acc)[2][2][4][2], const Unit& u, int wr, int wc, int fr, int fq) const {
        int row0 = u.pm * 256 + wr * 64 + fr, col0 = u.pn * 256 + wc * 32 + fq * 4;
        asm volatile("" : "+v"(row0), "+v"(col0));
#pragma unroll
        for (int ai = 0; ai < 2; ++ai)
#pragma unroll
            for (int m = 0; m < 4; ++m) { const int row = row0 + ai * 128 + m * 16;
                const float* rp = nullptr; if (r0) rp = (row < rsplit) ? r0 + (size_t)row * ldr : r1 + (size_t)(row - rsplit) * ldr;
                float rs = 1.f; if (rsq) rs = rsqrtf(rsq[row] * (1.f / 1024.f) + EPS);
                float ss = 0.f;
#pragma unroll
                for (int bj = 0; bj < 2; ++bj)
#pragma unroll
                    for (int n = 0; n < 2; ++n) { const int col = col0 + bj * 128 + n * 16; f32x4 v = acc[ai][bj][m][n];
                        if (rsq) { v[0] *= rs; v[1] *= rs; v[2] *= rs; v[3] *= rs; }
                        if (r0) v += *(const f32x4*)(rp + col);
                        if (d32) *(f32x4*)(d32 + (size_t)row * ld32 + col) = v;
                        if (ssq) ss += (v[0] * v[0] + v[1] * v[1]) + (v[2] * v[2] + v[3] * v[3]);
                        if (d16) { f32x4 w = v; if (gcol) w = w * *(const f32x4*)(gcol + col);
                            v2u o; o.x = pg8::cvt_pk_bf16(w[0] * sc16, w[1] * sc16); o.y = pg8::cvt_pk_bf16(w[2] * sc16, w[3] * sc16); *(v2u*)(d16 + (size_t)row * ld16 + col) = o; } }
                if (ssq) { ss += xor16_f32(ss); ss += __shfl_xor(ss, 32); if (fq == 0) atomicAdd(ssq + row, ss); } }
    }
};
struct EpiInProj {
    static constexpr bool PERM = false, AFTER_DRAIN = false;
    float* out; unsigned char* ws; const float* bff;
    __device__ __forceinline__ void operator()(const f32x4 (&acc)[2][2][4][2], const Unit& u, int wr, int wc, int fr, int fq) const {
        const int pn = u.pn; const bool smp = u.pm >= 64;
        int row0 = u.pm * 256 + wr * 64 + fr;
        int orow0 = (smp ? (u.pm - 64) * 256 : u.pm * 256) + wr * 64 + fr;
        asm volatile("" : "+v"(row0), "+v"(orow0));
        float* d32 = nullptr; int ld32 = 0; bool d32_grp = false; bf16* d16 = nullptr; int ld16 = 0; float s32 = 1.f, s16 = 1.f; int cb = 0;
        if (pn < 2) { d16 = (bf16*)(ws + WS_QF); ld16 = 512; s16 = C2F; cb = pn * 256; }
        else if (pn < 4) { d32 = out + (smp ? O_FKS : O_FKP); ld32 = 512; d32_grp = true; d16 = (bf16*)(ws + WS_KF); ld16 = 512; cb = (pn - 2) * 256; }
        else if (pn < 6) { d32 = out + (smp ? O_FVS : O_FVP); ld32 = 512; d32_grp = true; d16 = (bf16*)(ws + WS_VF); ld16 = 512; cb = (pn - 4) * 256; }
        else if (pn == 6) { d16 = (bf16*)(ws + WS_GQ); ld16 = 256; s16 = 0.125f; }
        else if (pn == 7) { d16 = (bf16*)(ws + WS_GK); ld16 = 256; }
        else if (pn < 10) { d16 = (bf16*)(ws + WS_GV); ld16 = 512; cb = (pn - 8) * 256; }
        else if (pn < 12) { d16 = (bf16*)(ws + WS_GR); ld16 = 512; cb = (pn - 10) * 256; }
        if (pn < 12) {
#pragma unroll
            for (int ai = 0; ai < 2; ++ai)
#pragma unroll
                for (int m = 0; m < 4; ++m) { const int row = row0 + ai * 128 + m * 16, orow = orow0 + ai * 128 + m * 16;
#pragma unroll
                    for (int bj = 0; bj < 2; ++bj)
#pragma unroll
                        for (int n = 0; n < 2; ++n) { const int col = cb + wc * 32 + fq * 4 + bj * 128 + n * 16; const f32x4 v = acc[ai][bj][m][n];
                            if (d32) *(f32x4*)(d32 + (size_t)(d32_grp ? orow : row) * ld32 + col) = v * s32;
                            if (d16) { v2u o; o.x = pg8::cvt_pk_bf16(v[0] * s16, v[1] * s16); o.y = pg8::cvt_pk_bf16(v[2] * s16, v[3] * s16); *(v2u*)(d16 + (size_t)row * ld16 + col) = o; } } }
        } else {
            if (wc == 0) {
                float* lf = out + (smp ? O_LFS : O_LFP); float* ggp = (float*)(ws + WS_GG);
#pragma unroll
                for (int ai = 0; ai < 2; ++ai)
#pragma unroll
                    for (int m = 0; m < 4; ++m) { const int row = row0 + ai * 128 + m * 16, orow = orow0 + ai * 128 + m * 16;
#pragma unroll
                        for (int n = 0; n < 2; ++n) { const int col = n * 16 + fq * 4; const f32x4 v = acc[ai][0][m][n];
                            if (col < 8) { f32x4 o; const f32x4 b = *(const f32x4*)(bff + col);
                                o[0] = log_sigmoid(v[0] + b[0]); o[1] = log_sigmoid(v[1] + b[1]); o[2] = log_sigmoid(v[2] + b[2]); o[3] = log_sigmoid(v[3] + b[3]);
                                *(f32x4*)(lf + (size_t)orow * 8 + col) = o; }
                            else if (col < 24) *(f32x4*)(ggp + (size_t)row * 16 + (col - 8)) = v; } }
            }
        }
    }
};


__device__ __forceinline__ void p0_prologue(const Frame& F, const Args& a) {
    unsigned char* ws = a.ws;
    LAS float* scr = (LAS float*)(F.lds + F.wave * 16384);
    const int gw = F.vcu * NWAVES + F.wave, NGW = F.G * NWAVES;
    constexpr int I_WINN = 16 * (N_IN / 32), I_SQ = 16 * 32;
    constexpr int NITEMS = I_WINN + 5 * I_SQ;
    for (int it = (gw + NGW / 2) % NGW; it < NITEMS; it += NGW) {
        int r = it;
        if (r < I_WINN) { p0_transpose_item<true>((const float*)a.in[I_WIN], 3096, DM, N_IN / 32, (bf16*)(ws + WS_WIN), scr, r, F.lane); continue; } r -= I_WINN;
        const int which = r / I_SQ; r -= which * I_SQ;
        const float* src = (const float*)(which == 0 ? a.in[I_WOUT] : which == 1 ? a.in[I_WMK] : which == 2 ? a.in[I_WMV] : which == 3 ? a.in[I_WCQ] : a.in[I_WCO]);
        bf16* dst = (bf16*)(ws + (which == 0 ? WS_WOUT : which == 1 ? WS_WMK : which == 2 ? WS_WMV : which == 3 ? WS_WCQ : WS_WCO));
        p0_transpose_item<false>(src, DM, DM, 32, dst, scr, r, F.lane);
    }
    { float* ssz = (float*)(ws + WS_SS); for (int i = F.vcu * NTHR + F.tid; i < 2 * TA; i += F.G * NTHR) ssz[i] = 0.f; }
    for (int m0 = gw * 2; m0 < TA + 512; m0 += NGW * 2) {
        const float* xr[2]; const float* gr[2]; bf16* orow[2];
#pragma unroll
        for (int j = 0; j < 2; ++j) { const int m = m0 + j;
            if (m < TP) { xr[j] = (const float*)a.in[I_XP] + (size_t)m * DM; gr[j] = (const float*)a.in[I_GMIX]; orow[j] = (bf16*)(ws + WS_HB) + (size_t)m * DM; }
            else if (m < TA) { xr[j] = (const float*)a.in[I_XS] + (size_t)(m - TP) * DM; gr[j] = (const float*)a.in[I_GMIX]; orow[j] = (bf16*)(ws + WS_HB) + (size_t)m * DM; }
            else { xr[j] = (const float*)a.in[I_MEMP] + (size_t)(m - TA) * DM; gr[j] = (const float*)a.in[I_GMEM]; orow[j] = (bf16*)(ws + WS_MB) + (size_t)(m - TA) * DM; } }
        f32x4 v[2][4]; float s[2];
#pragma unroll
        for (int j = 0; j < 2; ++j) { s[j] = 0.f;
#pragma unroll
            for (int q = 0; q < 4; ++q) v[j][q] = ((const f32x4*)xr[j])[F.lane + 64 * q]; }
#pragma unroll
        for (int j = 0; j < 2; ++j) {
#pragma unroll
            for (int q = 0; q < 4; ++q) s[j] += (v[j][q].x * v[j][q].x + v[j][q].y * v[j][q].y) + (v[j][q].z * v[j][q].z + v[j][q].w * v[j][q].w);
            const float r = rsqrtf(wave_sum(s[j]) * (1.f / DM) + EPS);
#pragma unroll
            for (int q = 0; q < 4; ++q) { const f32x4 gg = ((const f32x4*)gr[j])[F.lane + 64 * q]; v2u o; o.x = pk2(v[j][q].x * r * gg.x, v[j][q].y * r * gg.y); o.y = pk2(v[j][q].z * r * gg.z, v[j][q].w * r * gg.w); ((v2u*)orow[j])[F.lane + 64 * q] = o; } }
    }
    {
        for (int r0 = gw * 4; r0 < 2 * 16384; r0 += NGW * 4) {
            f32x4 x[4][4];
#pragma unroll
            for (int j = 0; j < 4; ++j) { const int r = r0 + j; const bool isv = r >= 16384; const int e = isv ? r - 16384 : r;
                const f32x4* s = (const f32x4*)((const float*)(isv ? a.in[I_PV] : a.in[I_PU]) + (size_t)e * DM + 16 * F.lane);
#pragma unroll
                for (int q = 0; q < 4; ++q) x[j][q] = __builtin_nontemporal_load(s + q); }
#pragma unroll
            for (int j = 0; j < 4; ++j) { const int r = r0 + j; const bool isv = r >= 16384; const int e = isv ? r - 16384 : r; float am = 0.f;
#pragma unroll
                for (int q = 0; q < 4; ++q) am = fmaxf(am, fmaxf(fmaxf(fabsf(x[j][q].x), fabsf(x[j][q].y)), fmaxf(fabsf(x[j][q].z), fabsf(x[j][q].w))));
#pragma unroll
                for (int o = 1; o < 64; o <<= 1) am = fmaxf(am, __shfl_xor(am, o));
                const float inv = am > 0.f ? 448.f / am : 0.f;
                v4u o4;
#pragma unroll
                for (int q = 0; q < 4; ++q) { int pk = __builtin_amdgcn_cvt_pk_fp8_f32(x[j][q].x * inv, x[j][q].y * inv, 0, false); pk = __builtin_amdgcn_cvt_pk_fp8_f32(x[j][q].z * inv, x[j][q].w * inv, pk, true); o4[q] = (unsigned)pk; }
                *(v4u*)(ws + (isv ? WS_V16 : WS_U16) + (size_t)e * DM + 16 * F.lane) = o4;
                if (F.lane == 0) ((float*)(ws + WS_MISC))[r] = am * (1.f / 448.f); }
        }
    }
    __syncthreads();
    for (int it = blockIdx.x; it < 256; it += F.G) {
        const int c = it >> 4, kt = it & 15, half = c & 1;
        LAS float* SK = (LAS float*)F.lds; LAS float* WT = (LAS float*)(F.lds + 128 * 129 * 4);
        const float* sk = (const float*)a.in[I_PSK] + (size_t)half * 128 * 128; const float* wq = (const float*)a.in[I_PWQ] + (size_t)(kt * 64) * 2048 + c * 128;
#pragma unroll 4
        for (int i = 0; i < 32; ++i) { const int idx = F.tid + 512 * i; SK[(idx >> 7) * 129 + (idx & 127)] = sk[idx]; }
#pragma unroll 4
        for (int i = 0; i < 16; ++i) { const int idx = F.tid + 512 * i; WT[(idx >> 7) * 129 + (idx & 127)] = wq[(size_t)(idx >> 7) * 2048 + (idx & 127)]; }
        __syncthreads();
        const int tk = F.tid & 15, tkey = F.tid >> 4;
        float acc[4][4];
#pragma unroll
        for (int i = 0; i < 4; ++i)
#pragma unroll
            for (int j = 0; j < 4; ++j) acc[i][j] = 0.f;
        for (int j = 0; j < 128; ++j) {
            float av[4], bv[4];
#pragma unroll
            for (int i = 0; i < 4; ++i) { av[i] = SK[(4 * tkey + i) * 129 + j]; bv[i] = WT[(4 * tk + i) * 129 + j]; }
#pragma unroll
            for (int i = 0; i < 4; ++i)
#pragma unroll
                for (int i2 = 0; i2 < 4; ++i2) acc[i][i2] += av[i] * bv[i2];
        }
        bf16* wp = (bf16*)(ws + WS_WPK);
#pragma unroll
        for (int i = 0; i < 4; ++i) { v2u o; o.x = pk2(acc[i][0], acc[i][1]); o.y = pk2(acc[i][2], acc[i][3]); *(v2u*)(wp + (size_t)(c * 128 + 4 * tkey + i) * DM + kt * 64 + 4 * tk) = o; }
        __syncthreads();
    }
}


__device__ __forceinline__ void fox_prompt_cumsum(const Frame& F, const float* logf  , float* kbias, int b) {
    LAS float* WT = (LAS float*)F.lds;
    const int t0 = F.wave * 1024 + F.lane * 16;
    const f32x4* src = (const f32x4*)(logf + ((size_t)b * SEQ + t0) * 8);
    float s[8];
#pragma unroll
    for (int h = 0; h < 8; ++h) s[h] = 0.f;
#pragma unroll 4
    for (int i = 0; i < 16; ++i) { const f32x4 a = src[2 * i], c = src[2 * i + 1]; s[0] += a.x; s[1] += a.y; s[2] += a.z; s[3] += a.w; s[4] += c.x; s[5] += c.y; s[6] += c.z; s[7] += c.w; }
    float ex[8];
#pragma unroll
    for (int h = 0; h < 8; ++h) { float v = s[h];
#pragma unroll
        for (int o = 1; o < 64; o <<= 1) { const float t = __shfl_up(v, o); if (F.lane >= o) v += t; }
        ex[h] = v - s[h];
        if (F.lane == 63) WT[F.wave * 8 + h] = v; }
    __syncthreads();
#pragma unroll
    for (int h = 0; h < 8; ++h) { float c = 0.f; for (int w = 0; w < F.wave; ++w) c += WT[w * 8 + h]; ex[h] += c; }
    float* dst = kbias + (size_t)(b * 8) * SEQ + t0;
#pragma unroll 4
    for (int i = 0; i < 16; ++i) { const f32x4 a = src[2 * i], c = src[2 * i + 1];
        ex[0] += a.x; ex[1] += a.y; ex[2] += a.z; ex[3] += a.w; ex[4] += c.x; ex[5] += c.y; ex[6] += c.z; ex[7] += c.w;
#pragma unroll
        for (int h = 0; h < 8; ++h) dst[(size_t)h * SEQ + i] = -ex[h] * LOG2E; }
    __syncthreads();
}
__device__ __forceinline__ void fox_sample_suffix(const Frame& F, const float* cfl, const int* pt, float* suf, int bs) {
    float carry[8];
#pragma unroll
    for (int h = 0; h < 8; ++h) carry[h] = 0.f;
    const int mypg = pt[bs * NPAGES + (F.lane & 15)];
#pragma unroll 1
    for (int pb = NPAGES - 4; pb >= 0; pb -= 4) {
        f32x4 x[4][4];
#pragma unroll
        for (int j = 0; j < 4; ++j) { const int pg = __builtin_amdgcn_readlane(mypg, 0) * 0 + __shfl(mypg, pb + j); const f32x4* src = (const f32x4*)(cfl + ((size_t)pg * PAGE + 2 * F.lane) * 8);
            x[j][0] = src[0]; x[j][1] = src[1]; x[j][2] = src[2]; x[j][3] = src[3]; }
#pragma unroll
        for (int j = 3; j >= 0; --j) { const int p = pb + j;
            const float ra[8] = {x[j][0].x, x[j][0].y, x[j][0].z, x[j][0].w, x[j][1].x, x[j][1].y, x[j][1].z, x[j][1].w}, rb[8] = {x[j][2].x, x[j][2].y, x[j][2].z, x[j][2].w, x[j][3].x, x[j][3].y, x[j][3].z, x[j][3].w};
#pragma unroll
            for (int h = 0; h < 8; ++h) {
                const float ps = ra[h] + rb[h]; float v = ps;
#pragma unroll
                for (int o = 1; o < 64; o <<= 1) { const float t = __shfl_down(v, o); if (F.lane + o < 64) v += t; }
                const float exs = v - ps;
                float* d = suf + (size_t)(bs * 8 + h) * PASTL + p * PAGE + 2 * F.lane;
                *(f32x2*)d = (f32x2){(carry[h] + exs + rb[h]) * LOG2E, (carry[h] + exs) * LOG2E};
                carry[h] += __shfl(v, 0);
            }
        }
    }
}

__device__ __forceinline__ void gla_gate_tile(const Frame& F, const float* gg, const float* w2, const float* bg, int row0, int h, int nt, LAS float* LA, LAS float* GGS) {
    for (int e = F.tid; e < nt * 16; e += NTHR) GGS[e] = gg[(size_t)row0 * 16 + e];
    const int dk = F.tid & 63; float wc[16];
#pragma unroll
    for (int r = 0; r < 16; ++r) wc[r] = w2[r * 256 + h * 64 + dk];
    const float bb = bg[h * 64 + dk];
    __syncthreads();
    for (int t = F.tid >> 6; t < nt; t += 8) { float z = bb;
#pragma unroll
        for (int q = 0; q < 4; ++q) { const f32x4 g4 = *(const LAS f32x4*)(GGS + t * 16 + 4 * q); z += g4.x * wc[4 * q] + g4.y * wc[4 * q + 1] + g4.z * wc[4 * q + 2] + g4.w * wc[4 * q + 3]; }
        LA[t * 64 + dk] = log_sigmoid(z) * (1.f / 16.f); }
}
__device__ __forceinline__ void gla_cumsum64(const Frame& F, LAS float* LA, LAS float* SEG) {
    const int dk = F.lane, w = F.wave; float v[8]; float run = 0.f;
#pragma unroll
    for (int i = 0; i < 8; ++i) { run += LA[(8 * w + i) * 64 + dk]; v[i] = run; }
    SEG[w * 64 + dk] = run;
    __syncthreads();
    float pre = 0.f;
    for (int j = 0; j < w; ++j) pre += SEG[j * 64 + dk];
#pragma unroll
    for (int i = 0; i < 8; ++i) LA[(8 * w + i) * 64 + dk] = v[i] + pre;
    __syncthreads();
}
template <int SB>
__device__ __forceinline__ bf16x8 tr_frag(LAS unsigned char* base, int ks) {
    const s16x4 lo = lds_tr16(base + ks * 16 * SB), hi4 = lds_tr16(base + ks * 16 * SB + 8 * SB);
    return (bf16x8){lo[0], lo[1], lo[2], lo[3], hi4[0], hi4[1], hi4[2], hi4[3]};
}
__device__ __forceinline__ bf16x8 row_frag(const LAS unsigned char* rowp, int ks, int hi) {
    const v2u lo = *(const LAS v2u*)(rowp + (16 * ks + 4 * hi) * 2), hi2 = *(const LAS v2u*)(rowp + (16 * ks + 8 + 4 * hi) * 2);
    return __builtin_bit_cast(bf16x8, (v4u){lo.x, lo.y, hi2.x, hi2.y});
}
__device__ __forceinline__ void gla_g1_unit(const Frame& F, const Args& a, int u) {
    unsigned char* ws = a.ws;
    const int b = u >> 9, h = (u >> 7) & 3, n = u & 127; const int row0 = b * SEQ + n * 64;
    LAS float* LA = (LAS float*)F.lds; LAS float* SEG = LA + 4096; LAS float* GGS = SEG + 512; LAS unsigned char* KRB = F.lds + 22528; LAS unsigned char* VSB = F.lds + 34816;
    v4u vq[2];
#pragma unroll
    for (int i = 0; i < 2; ++i) { const int c = F.tid + NTHR * i; vq[i] = *(const v4u*)((const bf16*)(ws + WS_GV) + (size_t)(row0 + (c >> 4)) * 512 + h * 128 + (c & 15) * 8); }
    float gkv[8];
#pragma unroll
    for (int i = 0; i < 8; ++i) { const int e = F.tid + NTHR * i; gkv[i] = GLD(ws + WS_GK)[(size_t)(row0 + (e >> 6)) * 256 + h * 64 + (e & 63)]; }
    gla_gate_tile(F, (const float*)(ws + WS_GG), (const float*)a.in[I_WG2], (const float*)a.in[I_BG], row0, h, 64, LA, GGS);
#pragma unroll
    for (int i = 0; i < 2; ++i) { const int c = F.tid + NTHR * i; *(LAS v4u*)(VSB + (c >> 4) * 320 + (c & 15) * 16) = vq[i]; }
    __syncthreads();
    gla_cumsum64(F, LA, SEG);
    if (F.tid < 64) ((float*)(ws + WS_GDEC))[(size_t)((b * 4 + h) * 128 + n) * 64 + F.tid] = __expf(LA[63 * 64 + F.tid]);
    float* bbuf = (float*)(ws + WS_BB);
#pragma unroll
    for (int i = 0; i < 8; ++i) { const int e = F.tid + NTHR * i; const int t = e >> 6, dk = e & 63; const float bb = LA[e]; bbuf[(size_t)(row0 + t) * 256 + h * 64 + dk] = bb;
        *(LAS unsigned short*)(KRB + t * 192 + dk * 2) = (unsigned short)f2bf(gkv[i] * __expf(LA[63 * 64 + dk] - bb)); }
    __syncthreads();
    {
        const int lane = F.lane, r32 = lane & 31, hi = lane >> 5, mb = F.wave >> 2, nb = F.wave & 3;
        const int tb = (4 * hi + ((lane & 15) >> 2)), tc = (16 * ((lane >> 4) & 1) + 4 * (lane & 3)) * 2;
        LAS unsigned char* abase = KRB + tb * 192 + tc + 64 * mb; LAS unsigned char* bbase = VSB + tb * 320 + tc + 64 * nb;
        f32x16 acc = {};
#pragma unroll
        for (int ks = 0; ks < 4; ++ks) acc = __builtin_amdgcn_mfma_f32_32x32x16_bf16(tr_frag<192>(abase, ks), tr_frag<320>(bbase, ks), acc, 0, 0, 0);
        float* kv = (float*)(ws + WS_GKV) + ((size_t)((b * 4 + h) * 128 + n) * 64 + 32 * mb) * 128 + 32 * nb + r32;
#pragma unroll
        for (int r = 0; r < 16; ++r) kv[(size_t)crow(r, hi) * 128] = acc[r];
    }
    __syncthreads();
}
__device__ __forceinline__ void gla_scan(const Frame& F, const Args& a) {
    int tid = F.wave * 64 + lane_id(); asm volatile("" : "+v"(tid));
    if (tid >= 256) return;
    for (int e = F.vcu * 256 + tid; e < 65536; e += F.G * 256) {
    const int bh = e >> 13, dk = (e >> 7) & 63, dv = e & 127;
    float* kv = (float*)(a.ws + WS_GKV) + ((size_t)bh * 128 * 64 + dk) * 128 + dv; const float* dc = (const float*)(a.ws + WS_GDEC) + (size_t)bh * 128 * 64 + dk;
    float S = 0.f;
#pragma unroll 1
    for (int n0 = 0; n0 < 128; n0 += 32) { float kvv[32], dd[32];
#pragma unroll
        for (int j = 0; j < 32; ++j) { kvv[j] = kv[(size_t)(n0 + j) * 8192]; dd[j] = dc[(size_t)(n0 + j) * 64]; }
#pragma unroll
        for (int j = 0; j < 32; ++j) { kv[(size_t)(n0 + j) * 8192] = S; S = dd[j] * S + kvv[j]; } }
    a.out[O_GSP + (size_t)bh * 8192 + dk * 128 + dv] = S;
    }
}
__device__ __forceinline__ float silu(float x) { return x / (1.f + __expf(-x)); }
__device__ __forceinline__ void gla_sample_unit(const Frame& F, const Args& a, int u) {
    unsigned char* ws = a.ws;
    const int bs = u >> 2, h = u & 3; const int row0 = TP + bs * LS;
    LAS float* LA = (LAS float*)F.lds; LAS float* BL = LA + 512; LAS float* QD = BL + 64; LAS float* KI = QD + 512; LAS float* KR = KI + 512; LAS float* ATT = KR + 512; LAS float* OP = ATT + 64; LAS float* VS = OP + 4096;
    gla_gate_tile(F, (const float*)(ws + WS_GG), (const float*)a.in[I_WG2], (const float*)a.in[I_BG], row0, h, 8, LA, VS + 1024);
#pragma unroll
    for (int i = 0; i < 2; ++i) { const int e = F.tid + NTHR * i; VS[e] = GLD(ws + WS_GV)[(size_t)(row0 + (e >> 7)) * 512 + h * 128 + (e & 127)]; }
    __syncthreads();
    if (F.tid < 64) { float run = 0.f;
#pragma unroll
        for (int t = 0; t < 8; ++t) { run += LA[t * 64 + F.tid]; LA[t * 64 + F.tid] = run; } BL[F.tid] = run; }
    __syncthreads();
    { const int e = F.tid, t = e >> 6, dk = e & 63; const float bb = LA[e];
      const float q = GLD(ws + WS_GQ)[(size_t)(row0 + t) * 256 + h * 64 + dk], k = GLD(ws + WS_GK)[(size_t)(row0 + t) * 256 + h * 64 + dk];
      QD[e] = q * __expf(bb); KI[e] = k * __expf(-bb); KR[e] = k * __expf(BL[dk] - bb); }
    __syncthreads();
    if (F.tid < 64) { const int t = F.tid >> 3, s = F.tid & 7; float acc = 0.f;
        if (s <= t) { for (int dk = 0; dk < 64; ++dk) acc += QD[t * 64 + dk] * KI[s * 64 + dk]; }
        ATT[F.tid] = acc; }
    const int dv = F.tid & 127, dkg = F.tid >> 7;
    {
        const float* st = (const float*)a.in[I_SGLA] + ((size_t)(bs * 4 + h) * 64 + dkg * 16) * 128 + dv;
        float S0[16];
#pragma unroll
        for (int i = 0; i < 16; ++i) S0[i] = st[(size_t)i * 128];
#pragma unroll
        for (int t = 0; t < 8; ++t) { float o = 0.f;
#pragma unroll
            for (int i = 0; i < 16; ++i) o += QD[t * 64 + dkg * 16 + i] * S0[i];
            OP[(dkg * 8 + t) * 128 + dv] = o; }
        float* so = a.out + O_GSS + ((size_t)(bs * 4 + h) * 64 + dkg * 16) * 128 + dv;
#pragma unroll
        for (int i = 0; i < 16; ++i) { float sn = __expf(BL[dkg * 16 + i]) * S0[i];
#pragma unroll
            for (int t = 0; t < 8; ++t) sn += KR[t * 64 + dkg * 16 + i] * VS[t * 128 + dv];
            so[(size_t)i * 128] = sn; }
    }
    __syncthreads();
    {
        const int t = F.wave; float o[2]; float ss = 0.f;
#pragma unroll
        for (int j = 0; j < 2; ++j) { const int d = 2 * F.lane + j; float v = OP[(0 * 8 + t) * 128 + d] + OP[(1 * 8 + t) * 128 + d] + OP[(2 * 8 + t) * 128 + d] + OP[(3 * 8 + t) * 128 + d];
            for (int s = 0; s <= t; ++s) v += ATT[t * 8 + s] * VS[s * 128 + d];
            o[j] = v; ss += v * v; }
        const float r = rsqrtf(wave_sum(ss) * (1.f / 128.f) + EPS);
        const float* ggo = (const float*)a.in[I_GGO] + h * 128 + 2 * F.lane; const BfPtr gr = GLD(ws + WS_GR) + ((size_t)(row0 + t) * 512 + h * 128 + 2 * F.lane);
        const float y0 = o[0] * r * ggo[0] * silu(gr[0]), y1 = o[1] * r * ggo[1] * silu(gr[1]);
        *(unsigned*)((bf16*)(ws + WS_MERGED) + (size_t)(row0 + t) * DM + 512 + h * 128 + 2 * F.lane) = pk2(y0, y1);
    }
    __syncthreads();
}


__device__ __forceinline__ float fexp2(float x) { return __builtin_amdgcn_exp2f(x); }
constexpr float FOX_SKIP = 160.f;


__device__ __forceinline__ void fox_norms_item(const Frame& F, const bf16* QF, const bf16* KF, const float* logf, float* FN, float* LC, float* BT, int item) {
    const int bh = item >> 5, qb = item & 31, b = bh >> 3, h = bh & 7;
    float qm = 0.f, km = 0.f;
    const float* lp = logf + ((size_t)b * SEQ + qb * 256 + 4 * F.lane) * 8 + h;
    const float l0 = lp[0], l1 = lp[8], l2 = lp[16], l3 = lp[24];
#pragma unroll 8
    for (int i = 0; i < 32; ++i) { const size_t row = (size_t)b * SEQ + qb * 256 + i * 8 + (F.lane >> 3);
        const v4u q = *(const v4u*)(QF + row * 512 + h * 64 + (F.lane & 7) * 8), k = *(const v4u*)(KF + row * 512 + h * 64 + (F.lane & 7) * 8); float qs = 0.f, ks = 0.f;
#pragma unroll
        for (int j = 0; j < 4; ++j) { qs += bflo(q[j]) * bflo(q[j]) + bfhi(q[j]) * bfhi(q[j]); ks += bflo(k[j]) * bflo(k[j]) + bfhi(k[j]) * bfhi(k[j]); }
        qs = sum8_f32(qs); ks = sum8_f32(ks);
        qm = fmaxf(qm, qs); km = fmaxf(km, ks); }
#pragma unroll
    for (int o = 1; o < 64; o <<= 1) { qm = fmaxf(qm, __shfl_xor(qm, o)); km = fmaxf(km, __shfl_xor(km, o)); }
    const float c0 = l0, c1 = c0 + l1, c2 = c1 + l2, c3 = c2 + l3; float v = c3;
#pragma unroll
    for (int o = 1; o < 64; o <<= 1) { const float t = __shfl_up(v, o); if (F.lane >= o) v += t; }
    const float ex = v - c3;
    *(f32x4*)(LC + (size_t)bh * SEQ + qb * 256 + 4 * F.lane) = (f32x4){ex + c0, ex + c1, ex + c2, ex + c3};
    if (F.lane == 63) BT[item] = v;
    if (F.lane == 0) { FN[item * 2] = qm; FN[item * 2 + 1] = km; }
}
__device__ __forceinline__ void fox_suffix_item(const Frame& F, const float* cfl, const int* pt, float* SW, float* PTOT, int item) {
    const int bs = item >> 4, p = item & 15; const int pg = __builtin_amdgcn_readfirstlane(pt[item]);
    const f32x4* src = (const f32x4*)(cfl + ((size_t)pg * PAGE + 2 * F.lane) * 8);
    const f32x4 a0 = src[0], a1 = src[1], b0 = src[2], b1 = src[3];
    const float ra[8] = {a0.x, a0.y, a0.z, a0.w, a1.x, a1.y, a1.z, a1.w}, rb[8] = {b0.x, b0.y, b0.z, b0.w, b1.x, b1.y, b1.z, b1.w};
#pragma unroll
    for (int h = 0; h < 8; ++h) {
        const float ps = ra[h] + rb[h]; float v = ps;
#pragma unroll
        for (int o = 1; o < 64; o <<= 1) { const float t = __shfl_down(v, o); if (F.lane + o < 64) v += t; }
        const float exs = v - ps;
        *(f32x2*)(SW + (size_t)(bs * 8 + h) * PASTL + p * PAGE + 2 * F.lane) = (f32x2){exs + rb[h], exs};
        if (F.lane == 0) PTOT[(bs * 8 + h) * NPAGES + p] = v;
    }
}
__device__ __forceinline__ void fox_attn_unit(const Frame& F, const bf16* QF, const bf16* KF, const bf16* VF, const float* LC, const float* BT, const float* FN, bf16* merged, int b, int h, int qb) {
    int tid = F.wave * 64 + lane_id(); asm volatile("" : "+v"(tid));
    const int lane = tid & 63, r32 = lane & 31, hi = lane >> 5, wid = F.wave;
    const size_t rowbase = (size_t)b * SEQ; const int q0 = qb * 256;
    LAS unsigned char* Ks = F.lds; LAS unsigned char* Vs = F.lds + 8192; LAS float* KBs = (LAS float*)(F.lds + 20480); LAS float* WSF = (LAS float*)(F.lds + 20736) + wid * 32;
    const bf16* Qw = QF + (rowbase + q0 + wid * 32 + r32) * 512 + h * 64;
    bf16x8 qr[4];
#pragma unroll
    for (int d0 = 0; d0 < 4; ++d0) qr[d0] = *(const bf16x8*)(Qw + d0 * 16 + hi * 8);
    const float* lcp = LC + (size_t)(b * 8 + h) * SEQ;
    float pbx; { const float btv = (lane < 32) ? BT[(b * 8 + h) * 32 + lane] : 0.f; float v = btv;
#pragma unroll
        for (int o = 1; o < 64; o <<= 1) { const float t = __shfl_up(v, o); if (lane >= o) v += t; }
        pbx = v - btv; }
    const float cref = lcp[q0] + __shfl(pbx, qb);
#define FOX_KB(t_, pos_) (-LOG2E * ((lcp[pos_] + __shfl(pbx, (t_) >> 2)) - cref))
    const int NT = (q0 + 256) / 64;
    int t0 = 0;
    {
        float kn = (lane < 32) ? FN[((b * 8 + h) * 32 + lane) * 2 + 1] : 0.f;
#pragma unroll
        for (int o = 1; o < 64; o <<= 1) kn = fmaxf(kn, __shfl_xor(kn, o));
        const float qk2 = 2.f * sqrtf(FN[((b * 8 + h) * 32 + qb) * 2]) * sqrtf(kn) * 1.01f;
        const int nbefore = q0 / 64;
        int found = -1;
        for (int base = 0; base < nbefore && found < 0; base += 64) {
            const int tl = nbefore - 1 - base - lane;
            const int tlc = tl < 0 ? 0 : tl; const float kbl = -LOG2E * ((lcp[tlc * 64 + 63] + __shfl(pbx, tlc >> 2)) - cref);
            const bool dead = (tl >= 0) && (qk2 + kbl < -FOX_SKIP);
            const unsigned long long bm = __ballot(dead);
            if (bm) found = nbefore - 1 - base - (int)__builtin_ctzll(bm);
        }
        t0 = found + 1;
        t0 = __builtin_amdgcn_readfirstlane(t0);
    }
    const int kkey = tid & 63, kch = tid >> 6, vkey = tid >> 3, vch = tid & 7;
    const bf16* ksrc = KF + (rowbase + kkey) * 512 + h * 64 + kch * 8;
    const bf16* vsrc = VF + (rowbase + vkey) * 512 + h * 64 + vch * 8;
    v4u kreg[2], vreg[2]; float kbreg[2];
#pragma unroll
    for (int hb = 0; hb < 2; ++hb) { const int tt = (t0 + hb < NT) ? t0 + hb : t0;
        kreg[hb] = *(const v4u*)(ksrc + (size_t)tt * 64 * 512); vreg[hb] = *(const v4u*)(vsrc + (size_t)tt * 64 * 512); kbreg[hb] = FOX_KB(tt, tt * 64 + (tid & 63)); }
    float m_run = -INFINITY, l_run = 0.f; f32x16 o0 = {}, o1 = {};
    const int qpos = q0 + wid * 32 + r32;
    const int vbase = (4 * hi + ((lane & 15) >> 2)) * 192 + (16 * ((lane >> 4) & 1) + 4 * (lane & 3)) * 2;
    LAS unsigned char* const Ks0 = Ks; LAS unsigned char* const Vs0 = Vs; LAS float* const KBs0 = KBs;
    __syncthreads();
    for (int t2 = t0; t2 < NT; t2 += 2) {
#pragma unroll
      for (int hb = 0; hb < 2; ++hb) {
        const int t = t2 + hb;
        if (t < NT) {
        LAS unsigned char* const Ks = Ks0 + hb * 28672; LAS unsigned char* const Vs = Vs0 + hb * 28672; LAS float* const KBs = (LAS float*)((LAS unsigned char*)KBs0 + hb * 28672);
        *(LAS v4u*)(Ks + kch * 1024 + kkey * 16) = kreg[hb]; *(LAS v4u*)(Vs + vkey * 192 + vch * 16) = vreg[hb]; if (tid < 64) KBs[tid] = kbreg[hb];
        __syncthreads();
        if (t + 2 < NT) { kreg[hb] = *(const v4u*)(ksrc + (size_t)(t + 2) * 64 * 512); vreg[hb] = *(const v4u*)(vsrc + (size_t)(t + 2) * 64 * 512); kbreg[hb] = FOX_KB(t + 2, (t + 2) * 64 + (tid & 63)); }
        const int k0 = t * 64;
        if (k0 <= q0 + wid * 32 + 31) {
        f32x16 p0, p1;
#pragma unroll
        for (int g = 0; g < 4; ++g) { const f32x4 ba = *(const LAS f32x4*)(KBs + 8 * g + 4 * hi), bb = *(const LAS f32x4*)(KBs + 32 + 8 * g + 4 * hi);
#pragma unroll
            for (int i = 0; i < 4; ++i) { p0[4 * g + i] = ba[i]; p1[4 * g + i] = bb[i]; } }
#pragma unroll
        for (int d0 = 0; d0 < 4; ++d0) {
            const bf16x8 a0 = *(const LAS bf16x8*)(Ks + (2 * d0 + hi) * 1024 + r32 * 16), a1 = *(const LAS bf16x8*)(Ks + (2 * d0 + hi) * 1024 + r32 * 16 + 512);
            p0 = __builtin_amdgcn_mfma_f32_32x32x16_bf16(a0, qr[d0], p0, 0, 0, 0); p1 = __builtin_amdgcn_mfma_f32_32x32x16_bf16(a1, qr[d0], p1, 0, 0, 0);
        }
        if (k0 + 63 > q0 + wid * 32) {
#pragma unroll
            for (int r = 0; r < 16; ++r) { const int key = k0 + crow(r, hi); if (key > qpos) p0[r] = -INFINITY; if (key + 32 > qpos) p1[r] = -INFINITY; }
        }
        float mx = fmaxf(p0[0], p1[0]);
#pragma unroll
        for (int r = 1; r < 16; ++r) mx = fmaxf(mx, fmaxf(p0[r], p1[r]));
        mx = fmaxf(mx, __shfl_xor(mx, 32));
        const float m_new = fmaxf(m_run, mx), alpha = fexp2(m_run - m_new); m_run = m_new;
        float ls = 0.f;
#pragma unroll
        for (int r = 0; r < 16; ++r) { p0[r] = fexp2(p0[r] - m_new); p1[r] = fexp2(p1[r] - m_new); ls += p0[r] + p1[r]; }
        l_run = l_run * alpha + ls;
        if (__ballot(alpha != 1.f) != 0ull) {
            if (hi == 0) WSF[r32] = alpha;
#pragma unroll
            for (int g = 0; g < 4; ++g) { const f32x4 al = *(const LAS f32x4*)(WSF + 8 * g + 4 * hi);
#pragma unroll
                for (int i = 0; i < 4; ++i) { o0[4 * g + i] *= al[i]; o1[4 * g + i] *= al[i]; } }
        }
        v4u pw[4];
#pragma unroll
        for (int j = 0; j < 4; ++j) { pw[0][j] = pg8::cvt_pk_bf16(p0[2 * j], p0[2 * j + 1]); pw[1][j] = pg8::cvt_pk_bf16(p0[8 + 2 * j], p0[8 + 2 * j + 1]);
                                      pw[2][j] = pg8::cvt_pk_bf16(p1[2 * j], p1[2 * j + 1]); pw[3][j] = pg8::cvt_pk_bf16(p1[8 + 2 * j], p1[8 + 2 * j + 1]); }
#pragma unroll
        for (int ks = 0; ks < 4; ++ks) {
            const bf16x8 pa = __builtin_bit_cast(bf16x8, pw[ks]);
#pragma unroll
            for (int d0 = 0; d0 < 2; ++d0) {
                const s16x4 lo = lds_tr16(Vs + vbase + ks * 16 * 192 + d0 * 64), hi4 = lds_tr16(Vs + vbase + ks * 16 * 192 + 8 * 192 + d0 * 64);
                const bf16x8 vb = (bf16x8){lo[0], lo[1], lo[2], lo[3], hi4[0], hi4[1], hi4[2], hi4[3]};
                if (d0 == 0) o0 = __builtin_amdgcn_mfma_f32_32x32x16_bf16(pa, vb, o0, 0, 0, 0); else o1 = __builtin_amdgcn_mfma_f32_32x32x16_bf16(pa, vb, o1, 0, 0, 0);
            }
        }
        }
        }
      }
    }
    l_run += __shfl_xor(l_run, 32);
    if (hi == 0) WSF[r32] = 1.f / l_run;
    bf16* Ow = merged + (rowbase + q0 + wid * 32) * DM + h * 64 + r32;
#pragma unroll
    for (int g = 0; g < 4; ++g) { const f32x4 rl = *(const LAS f32x4*)(WSF + 8 * g + 4 * hi);
#pragma unroll
        for (int i = 0; i < 4; ++i) { const int r = 4 * g + i; const int row = crow(r, hi);
            Ow[(size_t)row * DM] = (bf16)f2bf(o0[r] * rl[i]); Ow[(size_t)row * DM + 32] = (bf16)f2bf(o1[r] * rl[i]); } }
    __syncthreads();
#undef FOX_KB
}

template <int D> struct DecW {
    static constexpr int KS = D / 32;
    static constexpr int LPK = D / 4;
    static constexpr int KPI = 64 / LPK;
    float m[4], l[4]; float o[8][4];
};
template <int D>
__device__ __forceinline__ void dec_init(DecW<D>& w) {
#pragma unroll
    for (int i = 0; i < 4; ++i) { w.m[i] = -INFINITY; w.l[i] = 0.f; }
#pragma unroll
    for (int q = 0; q < 8; ++q)
#pragma unroll
        for (int j = 0; j < 4; ++j) w.o[q][j] = 0.f;
}
template <int D, int NTILE, int MODE>
__device__ __forceinline__ void dec_chunk(DecW<D>& w, const bf16x8 (&qa)[D / 32], const float* Kb, const float* Vb, int stride, const float* bias, float nb, LAS float* PL, int lane) {
    constexpr int KS = D / 32, LPK = D / 4, KPI = 64 / LPK;
    constexpr int NK = (MODE == 1) ? 8 : NTILE * 16, NV = NK / KPI;
    const int key = lane & 15, kq = lane >> 4;
    const unsigned koff = (unsigned)(key * stride + 8 * kq) * 4u;
    const int d4 = lane % LPK, ksub = lane / LPK;
    const unsigned voff = (unsigned)(ksub * stride + 4 * d4) * 4u;
    f32x4 kx[NTILE][2 * KS], vx[NV];
#pragma unroll
    for (int t = 0; t < NTILE; ++t) { const char* kp = (const char*)(Kb + (size_t)t * 16 * stride) + koff;
#pragma unroll
        for (int ks = 0; ks < KS; ++ks) { kx[t][2 * ks] = *(const f32x4*)(kp + 128 * ks); kx[t][2 * ks + 1] = *(const f32x4*)(kp + 128 * ks + 16); } }
    constexpr int NVA = (NV >= 8) ? NV / 2 : NV;
#pragma unroll
    for (int kk = 0; kk < NVA; ++kk) vx[kk] = *(const f32x4*)((const char*)(Vb + (size_t)kk * KPI * stride) + voff);
    f32x4 s[NTILE];
#pragma unroll
    for (int t = 0; t < NTILE; ++t) {
        f32x4 acc = {0.f, 0.f, 0.f, 0.f};
#pragma unroll
        for (int ks = 0; ks < KS; ++ks) { const f32x4 x0 = kx[t][2 * ks], x1 = kx[t][2 * ks + 1];
            v4u kb; kb.x = pg8::cvt_pk_bf16(x0.x, x0.y); kb.y = pg8::cvt_pk_bf16(x0.z, x0.w); kb.z = pg8::cvt_pk_bf16(x1.x, x1.y); kb.w = pg8::cvt_pk_bf16(x1.z, x1.w);
            acc = __builtin_amdgcn_mfma_f32_16x16x32_bf16(qa[ks], __builtin_bit_cast(bf16x8, kb), acc, 0, 0, 0); }
        if (MODE == 0) { if (bias) { const float bv = (bias[t * 16 + key] + nb) * LOG2E; acc += bv; } }
        else { acc += nb;
#pragma unroll
            for (int i = 0; i < 4; ++i) if (key > 4 * kq + i || key >= 8) acc[i] = -INFINITY; }
        s[t] = acc;
    }
#pragma unroll
    for (int kk = NVA; kk < NV; ++kk) vx[kk] = *(const f32x4*)((const char*)(Vb + (size_t)kk * KPI * stride) + voff);
    f32x4 mc = s[0];
#pragma unroll
    for (int t = 1; t < NTILE; ++t) { mc.x = fmaxf(mc.x, s[t].x); mc.y = fmaxf(mc.y, s[t].y); mc.z = fmaxf(mc.z, s[t].z); mc.w = fmaxf(mc.w, s[t].w); }
    mc.x = max16_f32(mc.x); mc.y = max16_f32(mc.y); mc.z = max16_f32(mc.z); mc.w = max16_f32(mc.w);
    float al[4];
#pragma unroll
    for (int i = 0; i < 4; ++i) { const float mn = fmaxf(w.m[i], mc[i]); al[i] = (mn == -INFINITY) ? 1.f : fexp2(w.m[i] - mn); w.m[i] = mn; w.l[i] *= al[i]; }
#pragma unroll
    for (int t = 0; t < NTILE; ++t) { f32x4 p;
#pragma unroll
        for (int i = 0; i < 4; ++i) { p[i] = (w.m[i] == -INFINITY) ? 0.f : fexp2(s[t][i] - w.m[i]); w.l[i] += p[i]; }
        if (kq < 2) *(LAS f32x4*)(PL + (t * 16 + key) * 8 + 4 * kq) = p; }
    if (key == 0 && kq < 2) *(LAS f32x4*)(PL + 1024 + 4 * kq) = (f32x4){al[0], al[1], al[2], al[3]};
    { const f32x4 a0 = *(const LAS f32x4*)(PL + 1024), a1 = *(const LAS f32x4*)(PL + 1028);
#pragma unroll
      for (int j = 0; j < 4; ++j) { w.o[0][j] *= a0.x; w.o[1][j] *= a0.y; w.o[2][j] *= a0.z; w.o[3][j] *= a0.w; w.o[4][j] *= a1.x; w.o[5][j] *= a1.y; w.o[6][j] *= a1.z; w.o[7][j] *= a1.w; } }
#pragma unroll
    for (int kk = 0; kk < NV; ++kk) { const int k = kk * KPI + ksub;
        const f32x4 v = vx[kk];
        const f32x4 pa = *(const LAS f32x4*)(PL + k * 8), pb = *(const LAS f32x4*)(PL + k * 8 + 4);
#pragma unroll
        for (int j = 0; j < 4; ++j) { w.o[0][j] += pa.x * v[j]; w.o[1][j] += pa.y * v[j]; w.o[2][j] += pa.z * v[j]; w.o[3][j] += pa.w * v[j];
                                      w.o[4][j] += pb.x * v[j]; w.o[5][j] += pb.y * v[j]; w.o[6][j] += pb.z * v[j]; w.o[7][j] += pb.w * v[j]; } }
}
__device__ __forceinline__ void dec_page_fox(DecW<64>& w, const bf16x8 (&qa)[2], const float* Kb, const float* Vb, const float* bias, float boff, LAS float* PL, int lane) {
    constexpr int stride = 512;
    const int key = lane & 15, kq = lane >> 4;
    const unsigned koff = (unsigned)(key * stride + 8 * kq) * 4u;
    const int d4 = lane & 15, ksub = lane >> 4;
    const unsigned voff = (unsigned)(ksub * stride + 4 * d4) * 4u;
    const __amdgpu_buffer_rsrc_t krs = __builtin_amdgcn_make_buffer_rsrc((void*)Kb, 0, 0x7fffffff, 0x00020000);
    const __amdgpu_buffer_rsrc_t vrs = __builtin_amdgcn_make_buffer_rsrc((void*)Vb, 0, 0x7fffffff, 0x00020000);
    const __amdgpu_buffer_rsrc_t brs = __builtin_amdgcn_make_buffer_rsrc((void*)bias, 0, 0x7fffffff, 0x00020000);
    f32x4 s[8];
#pragma unroll
    for (int hb = 0; hb < 2; ++hb) {
        f32x4 kx[4][4];
#pragma unroll
        for (int t = 0; t < 4; ++t) { const int so = (hb * 4 + t) * 16 * stride * 4;
            kx[t][0] = __builtin_bit_cast(f32x4, __builtin_amdgcn_raw_buffer_load_b128(krs, (int)koff, so, 0)); kx[t][1] = __builtin_bit_cast(f32x4, __builtin_amdgcn_raw_buffer_load_b128(krs, (int)koff + 16, so, 0));
            kx[t][2] = __builtin_bit_cast(f32x4, __builtin_amdgcn_raw_buffer_load_b128(krs, (int)koff + 128, so, 0)); kx[t][3] = __builtin_bit_cast(f32x4, __builtin_amdgcn_raw_buffer_load_b128(krs, (int)koff + 144, so, 0)); }
#pragma unroll
        for (int t = 0; t < 4; ++t) {
            f32x4 acc = {0.f, 0.f, 0.f, 0.f};
#pragma unroll
            for (int ks = 0; ks < 2; ++ks) { const f32x4 x0 = kx[t][2 * ks], x1 = kx[t][2 * ks + 1];
                v4u kb; kb.x = pg8::cvt_pk_bf16(x0.x, x0.y); kb.y = pg8::cvt_pk_bf16(x0.z, x0.w); kb.z = pg8::cvt_pk_bf16(x1.x, x1.y); kb.w = pg8::cvt_pk_bf16(x1.z, x1.w);
                acc = __builtin_amdgcn_mfma_f32_16x16x32_bf16(qa[ks], __builtin_bit_cast(bf16x8, kb), acc, 0, 0, 0); }
            acc += (__builtin_bit_cast(float, __builtin_amdgcn_raw_buffer_load_b32(brs, key * 4, (hb * 4 + t) * 64, 0)) + boff) * LOG2E;
            s[hb * 4 + t] = acc;
        }
        asm volatile("" ::: "memory");
    }
    f32x4 mc = s[0];
#pragma unroll
    for (int t = 1; t < 8; ++t) { mc.x = fmaxf(mc.x, s[t].x); mc.y = fmaxf(mc.y, s[t].y); mc.z = fmaxf(mc.z, s[t].z); mc.w = fmaxf(mc.w, s[t].w); }
    mc.x = max16_f32(mc.x); mc.y = max16_f32(mc.y); mc.z = max16_f32(mc.z); mc.w = max16_f32(mc.w);
    float al[4];
#pragma unroll
    for (int i = 0; i < 4; ++i) { const float mn = fmaxf(w.m[i], mc[i]); al[i] = fexp2(w.m[i] - mn); w.m[i] = mn; w.l[i] *= al[i]; }
    bool nz = false;
#pragma unroll
    for (int t = 0; t < 8; ++t) { f32x4 p;
#pragma unroll
        for (int i = 0; i < 4; ++i) { p[i] = fexp2(s[t][i] - w.m[i]); w.l[i] += p[i]; nz = nz || (p[i] != 0.f); }
        if (kq < 2) *(LAS f32x4*)(PL + (t * 16 + key) * 8 + 4 * kq) = p; }
    if (__ballot(nz && kq < 2) == 0ull) return;
    if (key == 0 && kq < 2) *(LAS f32x4*)(PL + 1024 + 4 * kq) = (f32x4){al[0], al[1], al[2], al[3]};
    { const f32x4 a0 = *(const LAS f32x4*)(PL + 1024), a1 = *(const LAS f32x4*)(PL + 1028);
#pragma unroll
      for (int j = 0; j < 4; ++j) { w.o[0][j] *= a0.x; w.o[1][j] *= a0.y; w.o[2][j] *= a0.z; w.o[3][j] *= a0.w; w.o[4][j] *= a1.x; w.o[5][j] *= a1.y; w.o[6][j] *= a1.z; w.o[7][j] *= a1.w; } }
#pragma unroll 1
    for (int vh = 0; vh < 2; ++vh) {
    f32x4 vx[16];
#pragma unroll
    for (int kk = 0; kk < 16; ++kk) vx[kk] = __builtin_bit_cast(f32x4, __builtin_amdgcn_raw_buffer_load_b128(vrs, (int)voff, (vh * 16 + kk) * 4 * stride * 4, 0));
#pragma unroll
    for (int kk = 0; kk < 16; ++kk) { const int k = (vh * 16 + kk) * 4 + ksub;
        const f32x4 v = vx[kk];
        const f32x4 pa = *(const LAS f32x4*)(PL + k * 8), pb = *(const LAS f32x4*)(PL + k * 8 + 4);
#pragma unroll
        for (int j = 0; j < 4; ++j) { w.o[0][j] += pa.x * v[j]; w.o[1][j] += pa.y * v[j]; w.o[2][j] += pa.z * v[j]; w.o[3][j] += pa.w * v[j];
                                      w.o[4][j] += pb.x * v[j]; w.o[5][j] += pb.y * v[j]; w.o[6][j] += pb.z * v[j]; w.o[7][j] += pb.w * v[j]; } }
    }
}
template <int D>
__device__ __forceinline__ void dec_park(DecW<D>& w, LAS float* CBw, int lane) {
    constexpr int LPK = D / 4;
    const int key = lane & 15, kq = lane >> 4, d4 = lane % LPK, ksub = lane / LPK;
#pragma unroll
    for (int i = 0; i < 4; ++i) { float l = w.l[i];
        l = sum16_f32(l);
        w.l[i] = l; }
    if (key == 0 && kq < 2) { *(LAS f32x4*)(CBw + 4 * kq) = (f32x4){w.m[0], w.m[1], w.m[2], w.m[3]}; *(LAS f32x4*)(CBw + 8 + 4 * kq) = (f32x4){w.l[0], w.l[1], w.l[2], w.l[3]}; }
#pragma unroll
    for (int q = 0; q < 8; ++q) { f32x4 v = (f32x4){w.o[q][0], w.o[q][1], w.o[q][2], w.o[q][3]};
        if (LPK < 64) {
#pragma unroll
            for (int o = LPK; o < 64; o <<= 1) { if (o == 16) { v.x += xor16_f32(v.x); v.y += xor16_f32(v.y); v.z += xor16_f32(v.z); v.w += xor16_f32(v.w); }
                else { v.x += __shfl_xor(v.x, o); v.y += __shfl_xor(v.y, o); v.z += __shfl_xor(v.z, o); v.w += __shfl_xor(v.w, o); } } }
        if (ksub == 0) *(LAS f32x4*)(CBw + 16 + q * D + 4 * d4) = v; }
}
template <int D>
__device__ __forceinline__ void dec_combine(int tid, LAS float* CB, bf16* dst, int ldd) {
    constexpr int WSTR = 16 + 8 * D;
    for (int e = tid; e < 8 * D; e += NTHR) { const int q = e / D, d = e % D;
        float mt = -INFINITY;
#pragma unroll
        for (int w = 0; w < 8; ++w) mt = fmaxf(mt, CB[w * WSTR + q]);
        float num = 0.f, den = 0.f;
#pragma unroll
        for (int w = 0; w < 8; ++w) { const float mw = CB[w * WSTR + q]; const float f = (mw == -INFINITY) ? 0.f : fexp2(mw - mt); num += f * CB[w * WSTR + 16 + q * D + d]; den += f * CB[w * WSTR + 8 + q]; }
        dst[(size_t)q * ldd + d] = (bf16)f2bf(num / den); }
}
template <int D>
__device__ __forceinline__ void dec_load_q(bf16x8 (&qa)[D / 32], const bf16* Q, int ldq, int lane) {
    const int row = lane & 15, kq = lane >> 4;
#pragma unroll
    for (int ks = 0; ks < D / 32; ++ks) { v4u z = {0u, 0u, 0u, 0u}; if (row < 8) z = *(const v4u*)(Q + (size_t)row * ldq + 32 * ks + 8 * kq); qa[ks] = __builtin_bit_cast(bf16x8, z); }
}
constexpr int DEC_PL = 1040;
__device__ __forceinline__ void fox_sample_unit(const Frame& F, const Args& a, int u) {
    unsigned char* ws = a.ws; const int bs = u >> 3, h = u & 7;
    int ln = lane_id(); asm volatile("" : "+v"(ln));
    LAS float* PL = (LAS float*)F.lds + F.wave * DEC_PL; LAS float* CB = (LAS float*)F.lds + 8 * DEC_PL; constexpr int WSTR = 16 + 8 * 64;
    bf16x8 qa[2]; dec_load_q<64>(qa, (const bf16*)(ws + WS_QF) + (size_t)(TP + bs * LS) * 512 + h * 64, 512, ln);
    DecW<64> w; dec_init(w);
    {
        const int key = ln & 15; const float* lf = a.out + O_LFS + (size_t)(bs * LS) * 8 + h; float cn = 0.f;
#pragma unroll
        for (int j = 0; j < 8; ++j) { const float x = lf[j * 8]; cn += (j <= key) ? x : 0.f; }
        const float* Kb = a.out + O_FKS + (size_t)(bs * LS) * 512 + h * 64; const float* Vb = a.out + O_FVS + (size_t)(bs * LS) * 512 + h * 64;
        dec_chunk<64, 1, 1>(w, qa, Kb, Vb, 512, nullptr, -cn * LOG2E, PL, ln);
        if (F.wave != 0) {
#pragma unroll
            for (int i = 0; i < 4; ++i) w.l[i] = 0.f;
#pragma unroll
            for (int q = 0; q < 8; ++q)
#pragma unroll
                for (int j = 0; j < 4; ++j) w.o[q][j] = 0.f; }
    }
    const int* pt = (const int*)a.in[I_PT];
    float spx; { const float ptv = (ln < 16) ? ((const float*)(ws + WS_MISC + 2 * MiB))[(bs * 8 + h) * NPAGES + ln] : 0.f; float v = ptv;
#pragma unroll
        for (int o = 1; o < 16; o <<= 1) { const float t = __builtin_bit_cast(float, __builtin_amdgcn_ds_bpermute((ln + o) << 2, __builtin_bit_cast(int, v))); if (ln + o < 16) v += t; }
        spx = v - ptv; }
#if defined(OLD_FOXS)
#pragma unroll 1
    for (int pp = 0; pp < 4; ++pp) { const int p = F.wave * 2 + (pp >> 1), hf = pp & 1; const int pg = __builtin_amdgcn_readfirstlane(pt[bs * NPAGES + p]);
        const float* Kb = (const float*)a.in[I_CFK] + (((size_t)pg * PAGE + hf * 64) * 8 + h) * 64; const float* Vb = (const float*)a.in[I_CFV] + (((size_t)pg * PAGE + hf * 64) * 8 + h) * 64;
        dec_chunk<64, 4, 0>(w, qa, Kb, Vb, 512, (const float*)(ws + WS_SUF) + (size_t)(bs * 8 + h) * PASTL + p * PAGE + hf * 64, __builtin_bit_cast(float, __builtin_amdgcn_ds_bpermute(p << 2, __builtin_bit_cast(int, spx))), PL, ln); }
#else
#pragma unroll 1
    for (int pp = 1; pp >= 0; --pp) { const int p = pp ? (NPAGES - 1 - F.wave) : F.wave;
        const int pg = __builtin_amdgcn_readfirstlane(pt[bs * NPAGES + p]);
        const float* Kb = (const float*)a.in[I_CFK] + ((size_t)pg * PAGE * 8 + h) * 64; const float* Vb = (const float*)a.in[I_CFV] + ((size_t)pg * PAGE * 8 + h) * 64;
        dec_page_fox(w, qa, Kb, Vb, (const float*)(ws + WS_SUF) + (size_t)(bs * 8 + h) * PASTL + p * PAGE, __builtin_bit_cast(float, __builtin_amdgcn_ds_bpermute(p << 2, __builtin_bit_cast(int, spx))), PL, ln); }
#endif
    dec_park<64>(w, CB + F.wave * WSTR, ln);
    __syncthreads();
    dec_combine<64>(F.wave * 64 + ln, CB, (bf16*)(ws + WS_MERGED) + (size_t)(TP + bs * LS) * DM + h * 64, DM);
    __syncthreads();
}
__device__ __forceinline__ void cross_sample_unit(const Frame& F, const Args& a, int u) {
    unsigned char* ws = a.ws; const int bs = u >> 2, h = u & 3;
    LAS float* PL = (LAS float*)F.lds + F.wave * DEC_PL; LAS float* CB = (LAS float*)F.lds + 8 * DEC_PL; constexpr int WSTR = 16 + 8 * 256;
    bf16x8 qa[8]; dec_load_q<256>(qa, (const bf16*)(ws + WS_QC) + (size_t)(TP + bs * LS) * DM + h * 256, DM, F.lane);
    DecW<256> w; dec_init(w);
    const float* Kb = (const float*)a.in[I_CMK] + ((size_t)(bs * 256 + F.wave * 32) * 4 + h) * 256; const float* Vb = (const float*)a.in[I_CMV] + ((size_t)(bs * 256 + F.wave * 32) * 4 + h) * 256;
#pragma unroll 1
    for (int c = 0; c < 2; ++c) dec_chunk<256, 1, 0>(w, qa, Kb + (size_t)c * 16 * 1024, Vb + (size_t)c * 16 * 1024, 1024, nullptr, 0.f, PL, F.lane);
    dec_park<256>(w, CB + F.wave * WSTR, F.lane);
    __syncthreads();
    dec_combine<256>(F.tid, CB, (bf16*)(ws + WS_OC) + (size_t)(TP + bs * LS) * DM + h * 256, DM);
    __syncthreads();
}


__device__ __forceinline__ void gla_g3_unit(const Frame& F, const Args& a, int u) {
    unsigned char* ws = a.ws;
    const int b = u >> 9, h = (u >> 7) & 3, n = u & 127; const int row0 = b * SEQ + n * 64;
    LAS unsigned char* KIB = F.lds; LAS unsigned char* ATTB = F.lds + 34816; LAS unsigned char* QDB = F.lds + 44032;
    LAS unsigned char* VSB = F.lds + 53248; LAS unsigned char* SPB = F.lds + 73728; LAS float* OS = (LAS float*)(F.lds + 94208);
#pragma unroll
    for (int i = 0; i < 2; ++i) { const int c = F.tid + NTHR * i; *(LAS v4u*)(VSB + (c >> 4) * 320 + (c & 15) * 16) = *(const v4u*)((const bf16*)(ws + WS_GV) + (size_t)(row0 + (c >> 4)) * 512 + h * 128 + (c & 15) * 8); }
#pragma unroll
    for (int i = 0; i < 4; ++i) { const int c4 = F.tid + NTHR * i; const f32x4 sp = *(const f32x4*)((const float*)(ws + WS_GKV) + ((size_t)((b * 4 + h) * 128 + n) * 64) * 128 + 4 * c4);
        v2u o; o.x = pg8::cvt_pk_bf16(sp.x, sp.y); o.y = pg8::cvt_pk_bf16(sp.z, sp.w); *(LAS v2u*)(SPB + (c4 >> 5) * 320 + (c4 & 31) * 8) = o; }
#pragma unroll
    for (int i = 0; i < 2; ++i) { const int c4 = F.tid + NTHR * i, t = c4 >> 4, d4 = (c4 & 15) * 4; const size_t gi = (size_t)(row0 + t) * 256 + h * 64 + d4;
        const f32x4 bb = *(const f32x4*)((const float*)(ws + WS_BB) + gi);
        const v2u qq = *(const v2u*)((const bf16*)(ws + WS_GQ) + gi), kk = *(const v2u*)((const bf16*)(ws + WS_GK) + gi);
        v2u qo, ko; qo.x = pg8::cvt_pk_bf16(bflo(qq.x) * __expf(bb.x), bfhi(qq.x) * __expf(bb.y)); qo.y = pg8::cvt_pk_bf16(bflo(qq.y) * __expf(bb.z), bfhi(qq.y) * __expf(bb.w));
        ko.x = pg8::cvt_pk_bf16(bflo(kk.x) * __expf(-bb.x), bfhi(kk.x) * __expf(-bb.y)); ko.y = pg8::cvt_pk_bf16(bflo(kk.y) * __expf(-bb.z), bfhi(kk.y) * __expf(-bb.w));
        *(LAS v2u*)(QDB + t * 144 + d4 * 2) = qo; *(LAS v2u*)(KIB + t * 144 + d4 * 2) = ko; }
    __syncthreads();
    {
        const int lane = F.lane, r32 = lane & 31, hi = lane >> 5;
        if (F.wave < 4) { const int tb = F.wave >> 1, sb = F.wave & 1; f32x16 acc = {};
            if (sb <= tb) {
                const LAS unsigned char* qrow = QDB + (32 * tb + r32) * 144; const LAS unsigned char* krow = KIB + (32 * sb + r32) * 144;
#pragma unroll
                for (int ks = 0; ks < 4; ++ks) acc = __builtin_amdgcn_mfma_f32_32x32x16_bf16(row_frag(qrow, ks, hi), row_frag(krow, ks, hi), acc, 0, 0, 0);
            }
#pragma unroll
            for (int r = 0; r < 16; ++r) { const int t = 32 * tb + crow(r, hi), s2 = 32 * sb + r32; *(LAS unsigned short*)(ATTB + t * 144 + s2 * 2) = (unsigned short)f2bf(s2 <= t ? acc[r] : 0.f); }
        }
    }
    __syncthreads();
    {
        const int lane = F.lane, r32 = lane & 31, hi = lane >> 5, tb = F.wave >> 2, nb = F.wave & 3;
        const int trb = (4 * hi + ((lane & 15) >> 2)) * 320 + (16 * ((lane >> 4) & 1) + 4 * (lane & 3)) * 2 + 64 * nb;
        const LAS unsigned char* arow = ATTB + (32 * tb + r32) * 144; const LAS unsigned char* qrow = QDB + (32 * tb + r32) * 144;
        f32x16 acc = {};
#pragma unroll
        for (int ks = 0; ks < 4; ++ks) acc = __builtin_amdgcn_mfma_f32_32x32x16_bf16(row_frag(arow, ks, hi), tr_frag<320>(VSB + trb, ks), acc, 0, 0, 0);
#pragma unroll
        for (int ks = 0; ks < 4; ++ks) acc = __builtin_amdgcn_mfma_f32_32x32x16_bf16(row_frag(qrow, ks, hi), tr_frag<320>(SPB + trb, ks), acc, 0, 0, 0);
#pragma unroll
        for (int r = 0; r < 16; ++r) OS[(32 * tb + crow(r, hi)) * 128 + 32 * nb + r32] = acc[r];
    }
    __syncthreads();
#pragma unroll
    for (int rr = 0; rr < 8; ++rr) { const int t = F.wave * 8 + rr; const float v0 = OS[t * 128 + F.lane], v1 = OS[t * 128 + 64 + F.lane];
        const float r = rsqrtf(wave_sum(v0 * v0 + v1 * v1) * (1.f / 128.f) + EPS);
        const float* ggo = (const float*)a.in[I_GGO] + h * 128; const BfPtr gr = GLD(ws + WS_GR) + ((size_t)(row0 + t) * 512 + h * 128);
        bf16* mo = (bf16*)(ws + WS_MERGED) + (size_t)(row0 + t) * DM + 512 + h * 128;
        mo[F.lane] = (bf16)f2bf(v0 * r * ggo[F.lane] * silu(gr[F.lane])); mo[64 + F.lane] = (bf16)f2bf(v1 * r * ggo[64 + F.lane] * silu(gr[64 + F.lane])); }
    __syncthreads();
}

struct EpiSoftmaxP {
    static constexpr bool PERM = false, AFTER_DRAIN = true;
    const LAS unsigned long long* argp;
    __device__ __forceinline__ void fused(f32x4 (&acc)[2][2][4][2], const Unit&, int wr, int wc, int fr, int fq, PG8_LAS unsigned char* lds, int wid, int lane) const {
        LAS float* PM = (LAS float*)lds; LAS float* PS = PM + 1024;
        const int ub = (int)blockIdx.x; const int ldp = DM;
        bf16* P = (bf16*)((unsigned char*)ld_ptr(argp + N_INPUTS + 1) + WS_PC) + ((size_t)((ub >> 7) & 1) * SEQ + (ub & 31) * 256) * DM + ((ub >> 5) & 3) * 256;
        { int t2 = lane_id(); asm volatile("" : "+v"(t2)); fr = t2 & 15; fq = (t2 >> 4) & 3; }
#pragma unroll
        for (int ai = 0; ai < 2; ++ai)
#pragma unroll
            for (int m = 0; m < 4; ++m) { float mx = -INFINITY;
#pragma unroll
                for (int bj = 0; bj < 2; ++bj)
#pragma unroll
                    for (int n = 0; n < 2; ++n) { const f32x4 x = acc[ai][bj][m][n]; mx = fmaxf(mx, fmaxf(fmaxf(x[0], x[1]), fmaxf(x[2], x[3]))); }
                mx = fmaxf(mx, xor16_f32(mx)); mx = fmaxf(mx, __shfl_xor(mx, 32));
                if (fq == 0) PM[(ai * 128 + wr * 64 + m * 16 + fr) * 4 + wc] = mx; }
        asm volatile("s_waitcnt lgkmcnt(0)" ::: "memory"); __builtin_amdgcn_s_barrier(); asm volatile("" ::: "memory");
#pragma unroll
        for (int ai = 0; ai < 2; ++ai)
#pragma unroll
            for (int m = 0; m < 4; ++m) { const int r = ai * 128 + wr * 64 + m * 16 + fr; const f32x4 pm = *(const LAS f32x4*)(PM + r * 4);
                const float M = fmaxf(fmaxf(pm[0], pm[1]), fmaxf(pm[2], pm[3])); float s = 0.f;
#pragma unroll
                for (int bj = 0; bj < 2; ++bj)
#pragma unroll
                    for (int n = 0; n < 2; ++n) { f32x4 x = acc[ai][bj][m][n]; x[0] = fexp2(x[0] - M); x[1] = fexp2(x[1] - M); x[2] = fexp2(x[2] - M); x[3] = fexp2(x[3] - M); acc[ai][bj][m][n] = x; s += (x[0] + x[1]) + (x[2] + x[3]); }
                s += xor16_f32(s); s += __shfl_xor(s, 32);
                if (fq == 0) PS[r * 4 + wc] = s; }
        asm volatile("s_waitcnt lgkmcnt(0)" ::: "memory"); __builtin_amdgcn_s_barrier(); asm volatile("" ::: "memory");
#pragma unroll
        for (int ai = 0; ai < 2; ++ai)
#pragma unroll
            for (int m = 0; m < 4; ++m) { const int r = ai * 128 + wr * 64 + m * 16 + fr; const f32x4 ps = *(const LAS f32x4*)(PS + r * 4); const float inv = 1.f / ((ps[0] + ps[1]) + (ps[2] + ps[3]));
#pragma unroll
                for (int bj = 0; bj < 2; ++bj)
#pragma unroll
                    for (int n = 0; n < 2; ++n) { const f32x4 x = acc[ai][bj][m][n]; v2u o; o.x = pg8::cvt_pk_bf16(x[0] * inv, x[1] * inv); o.y = pg8::cvt_pk_bf16(x[2] * inv, x[3] * inv);
                        *(v2u*)(P + (size_t)r * ldp + bj * 128 + wc * 32 + n * 16 + fq * 4) = o; } }
        asm volatile("s_waitcnt lgkmcnt(0)" ::: "memory"); __builtin_amdgcn_s_barrier(); asm volatile("" ::: "memory");
    }
};

__device__ __forceinline__ void rms_rows_phase(const Frame& F, const float* X, const float* g, bf16* H) {
    const int gw = F.vcu * NWAVES + F.wave, NGW = F.G * NWAVES;
    for (int m = gw; m < TA; m += NGW) rms_row_bf16(X + (size_t)m * DM, g, H + (size_t)m * DM, F.lane);
}

__device__ __forceinline__ unsigned f2sort(float f) { const unsigned u = __builtin_bit_cast(unsigned, f); return u ^ ((u >> 31) ? 0xFFFFFFFFu : 0x80000000u); }
__device__ __forceinline__ float sort2f(unsigned s) { const unsigned u = s ^ ((s >> 31) ? 0x80000000u : 0xFFFFFFFFu); return __builtin_bit_cast(float, u); }
__device__ __forceinline__ float gelu_tanh(float x) { const float y = 0.7978845608028654f * (x + 0.044715f * x * x * x); const float e = __expf(2.f * y); return 0.5f * x * (1.f + (1.f - 2.f / (e + 1.f))); }
__device__ __forceinline__ unsigned gmax16(unsigned v) { return max16_u32(v); }
typedef __bf16 bf16x2_t __attribute__((ext_vector_type(2)));
__device__ __forceinline__ float dot2bf(unsigned a, unsigned b, float c) {
#if __has_builtin(__builtin_amdgcn_fdot2_f32_bf16)
    return __builtin_amdgcn_fdot2_f32_bf16(__builtin_bit_cast(bf16x2_t, a), __builtin_bit_cast(bf16x2_t, b), c, false);
#else
    return c + bflo(a) * bflo(b) + bfhi(a) * bfhi(b);
#endif
}
template <bool SPLIT>
__device__ __forceinline__ void peer_token(const Frame& F, const Args& a, int row, LAS unsigned* TOPS, const LAS unsigned* CT, int half, LAS float* PART) {
    unsigned char* ws = a.ws; const int lane = lane_id(), grp = lane >> 4, j16 = lane & 15;
    const bf16* sc = (const bf16*)(ws + WS_SC) + (size_t)row * 2048;
#pragma unroll 1
    for (int bt = 0; bt < 4; ++bt) {
        const v4u xq = *(const v4u*)(sc + (bt * 4 + grp) * 128 + 8 * j16);
        unsigned k[8]; const float xs[8] = {bflo(xq.x), bfhi(xq.x), bflo(xq.y), bfhi(xq.y), bflo(xq.z), bfhi(xq.z), bflo(xq.w), bfhi(xq.w)};
#pragma unroll
        for (int e = 0; e < 8; ++e) k[e] = (f2sort(xs[e]) & ~127u) | (unsigned)(127 - (8 * j16 + e));
        unsigned mine = 0u;
#pragma unroll 1
        for (int r = 0; r < 16; ++r) {
            unsigned m = k[0];
#pragma unroll
            for (int e = 1; e < 8; ++e) m = m > k[e] ? m : k[e];
            m = gmax16(m);
            if (j16 == r) mine = m;
#pragma unroll
            for (int e = 0; e < 8; ++e) k[e] = (k[e] == m) ? 0u : k[e];
        }
        TOPS[(bt * 4 + grp) * 16 + j16] = mine;
    }
    int ex[2]; float gx[2], sux[2];
#pragma unroll
    for (int ps = 0; ps < 2; ++ps) {
        const int hd = ps * 4 + grp; const LAS unsigned* T1 = TOPS + (2 * hd) * 16; const LAS unsigned* T2 = T1 + 16;
        const unsigned c0_ = CT[j16], c1_ = CT[j16 + 16], c2_ = CT[j16 + 32], c3_ = CT[j16 + 48];
        const int ci0 = c0_ & 255, cj0 = c0_ >> 8, ci1 = c1_ & 255, cj1 = c1_ >> 8, ci2 = c2_ & 255, cj2 = c2_ >> 8, ci3 = c3_ & 255, cj3 = c3_ >> 8; const bool cv3 = (j16 + 48) < 50;
        unsigned k[4];
        { const float s0 = sort2f(T1[ci0] & ~127u) + sort2f(T2[cj0] & ~127u), s1 = sort2f(T1[ci1] & ~127u) + sort2f(T2[cj1] & ~127u),
                      s2 = sort2f(T1[ci2] & ~127u) + sort2f(T2[cj2] & ~127u), s3 = sort2f(T1[ci3] & ~127u) + sort2f(T2[cj3] & ~127u);
          k[0] = (f2sort(s0) & ~127u) | (unsigned)(127 - j16); k[1] = (f2sort(s1) & ~127u) | (unsigned)(127 - (j16 + 16)); k[2] = (f2sort(s2) & ~127u) | (unsigned)(127 - (j16 + 32));
          k[3] = cv3 ? ((f2sort(s3) & ~127u) | (unsigned)(127 - (j16 + 48))) : 0u; }
        unsigned mine = 0u;
#pragma unroll 1
        for (int r = 0; r < 16; ++r) {
            unsigned m = k[0] > k[1] ? k[0] : k[1]; const unsigned m2 = k[2] > k[3] ? k[2] : k[3]; m = m > m2 ? m : m2;
            m = gmax16(m);
            if (j16 == r) mine = m;
#pragma unroll
            for (int e = 0; e < 4; ++e) k[e] = (k[e] == m) ? 0u : k[e];
        }
        const int c = 127 - (int)(mine & 127u);
        int ci, cj;
        if (c < 16) { ci = 0; cj = c; } else if (c < 24) { ci = 1; cj = c - 16; } else if (c < 29) { ci = 2; cj = c - 24; } else if (c < 33) { ci = 3; cj = c - 29; }
        else if (c < 36) { ci = 4; cj = c - 33; } else if (c < 38) { ci = 5; cj = c - 36; } else if (c < 40) { ci = 6; cj = c - 38; } else if (c < 42) { ci = 7; cj = c - 40; } else { ci = c - 34; cj = 0; }
        const int i1 = 127 - (int)(T1[ci] & 127u), i2 = 127 - (int)(T2[cj] & 127u);
        ex[ps] = i1 * 128 + i2;
        const float sv = sort2f(mine & ~127u); const float s0 = __shfl(sv, lane & 48);
        float ee = __expf(sv - s0); const float es = sum16_f32(ee);
        const float* rsc = (const float*)(ws + WS_MISC);
        sux[ps] = rsc[ex[ps]]; gx[ps] = ee / es * rsc[16384 + ex[ps]];
    }
    {
        unsigned k0 = ((unsigned)ex[0] << 7) | (unsigned)lane, k1 = ((unsigned)ex[1] << 7) | (unsigned)(64 + lane);
#pragma unroll
        for (int k = 2; k <= 128; k <<= 1) {
#pragma unroll
            for (int j = k >> 1; j > 0; j >>= 1) {
                if (j == 64) { const unsigned lo = k0 < k1 ? k0 : k1, hi = k0 < k1 ? k1 : k0; k0 = lo; k1 = hi; }
                else {
                    unsigned p0, p1;
                    if (j == 32) { p0 = (unsigned)__shfl_xor((int)k0, 32); p1 = (unsigned)__shfl_xor((int)k1, 32); }
                    else if (j == 16) { p0 = xchg_xor_u32<16>(k0); p1 = xchg_xor_u32<16>(k1); } else if (j == 8) { p0 = xchg_xor_u32<8>(k0); p1 = xchg_xor_u32<8>(k1); }
                    else if (j == 4) { p0 = xchg_xor_u32<4>(k0); p1 = xchg_xor_u32<4>(k1); } else if (j == 2) { p0 = xchg_xor_u32<2>(k0); p1 = xchg_xor_u32<2>(k1); }
                    else { p0 = xchg_xor_u32<1>(k0); p1 = xchg_xor_u32<1>(k1); }
                    const bool low = (lane & j) == 0; const bool asc0 = (lane & k) == 0, asc1 = ((64 + lane) & k) == 0;
                    const unsigned mn0 = k0 < p0 ? k0 : p0, mx0 = k0 < p0 ? p0 : k0, mn1 = k1 < p1 ? k1 : p1, mx1 = k1 < p1 ? p1 : k1;
                    k0 = (low == asc0) ? mn0 : mx0; k1 = (low == asc1) ? mn1 : mx1;
                }
            }
        }
        const int o0 = (int)(k0 & 127u), o1 = (int)(k1 & 127u);
        const float g0a = __shfl(gx[0], o0 & 63), g0b = __shfl(gx[1], o0 & 63), g1a = __shfl(gx[0], o1 & 63), g1b = __shfl(gx[1], o1 & 63);
        const float s0a = __shfl(sux[0], o0 & 63), s0b = __shfl(sux[1], o0 & 63), s1a = __shfl(sux[0], o1 & 63), s1b = __shfl(sux[1], o1 & 63);
        gx[0] = (o0 & 64) ? g0b : g0a; gx[1] = (o1 & 64) ? g1b : g1a; sux[0] = (o0 & 64) ? s0b : s0a; sux[1] = (o1 & 64) ? s1b : s1a;
        ex[0] = (int)(k0 >> 7); ex[1] = (int)(k1 >> 7);
    }
    const float rstd2 = rsqrtf(((const float*)(ws + WS_SS))[TA + row] * (1.f / 1024.f) + EPS);
    float hf[16];
    { const v4u* hp = (const v4u*)((const bf16*)(ws + WS_HB) + (size_t)row * DM + 16 * lane); const v4u h0 = hp[0], h1 = hp[1];
#pragma unroll
      for (int q = 0; q < 4; ++q) { hf[2 * q] = bflo(h0[q]); hf[2 * q + 1] = bfhi(h0[q]); hf[8 + 2 * q] = bflo(h1[q]); hf[8 + 2 * q + 1] = bfhi(h1[q]); } }
    float oacc[16];
#pragma unroll
    for (int i = 0; i < 16; ++i) oacc[i] = 0.f;
    const unsigned char* U = ws + WS_U16; const unsigned char* V = ws + WS_V16;
    v4u ub[8], vbA[8], vbB[8];
    const int gbeg = SPLIT ? 8 * half : 0, gend = SPLIT ? 8 * half + 8 : 16;
    const int addr32 = (lane ^ 32) << 2;
#define PEER_LOAD(buf, TAB, g) do { const int kk_ = (g) * 8; const int exs_ = (kk_ < 64) ? ex[0] : ex[1]; \
        _Pragma("unroll") for (int i = 0; i < 8; ++i) { const int e_ = __builtin_amdgcn_readlane(exs_, (kk_ & 63) + i); buf[i] = *(const v4u*)(TAB + (size_t)e_ * DM + 16 * lane); } } while (0)
#define PEER_DOTS(buf, g, wout) do { const int kk_ = (g) * 8; const float gxs_ = (kk_ < 64) ? gx[0] : gx[1]; const float sus_ = (kk_ < 64) ? sux[0] : sux[1]; float av[8]; \
        _Pragma("unroll") for (int i = 0; i < 8; ++i) { float s = 0.f; \
            _Pragma("unroll") for (int q = 0; q < 4; ++q) { const f32x2 lo = __builtin_amdgcn_cvt_pk_f32_fp8((int)buf[i][q], false), hi = __builtin_amdgcn_cvt_pk_f32_fp8((int)buf[i][q], true); \
                s += lo.x * hf[4 * q]; s += lo.y * hf[4 * q + 1]; s += hi.x * hf[4 * q + 2]; s += hi.y * hf[4 * q + 3]; } \
            av[i] = s; } \
        const bool b5 = lane & 32, b4 = lane & 16, b3_ = lane & 8; float bq[4], cq[2], dq; \
        _Pragma("unroll") for (int i = 0; i < 4; ++i) bq[i] = (b5 ? av[4 + i] : av[i]) + __builtin_bit_cast(float, __builtin_amdgcn_ds_bpermute(addr32, __builtin_bit_cast(int, b5 ? av[i] : av[4 + i])));     \
        _Pragma("unroll") for (int i = 0; i < 2; ++i) cq[i] = (b4 ? bq[2 + i] : bq[i]) + xor16_f32(b4 ? bq[i] : bq[2 + i]); \
        dq = (b3_ ? cq[1] : cq[0]) + DPP_F(b3_ ? cq[0] : cq[1], DPP_MIR);        \
        dq = sum8_f32(dq); \
        const int src = (kk_ & 63) + (lane >> 3); \
        wout = __shfl(gxs_, src) * gelu_tanh(dq * __shfl(sus_, src) * rstd2); } while (0)
#define PEER_ACC(buf, wv) do { _Pragma("unroll") for (int i = 0; i < 8; ++i) { const float w = __builtin_bit_cast(float, __builtin_amdgcn_readlane(__builtin_bit_cast(int, wv), 8 * i)); \
        _Pragma("unroll") for (int q = 0; q < 4; ++q) { const f32x2 lo = __builtin_amdgcn_cvt_pk_f32_fp8((int)buf[i][q], false), hi = __builtin_amdgcn_cvt_pk_f32_fp8((int)buf[i][q], true); \
            oacc[4 * q] += w * lo.x; oacc[4 * q + 1] += w * lo.y; oacc[4 * q + 2] += w * hi.x; oacc[4 * q + 3] += w * hi.y; } } } while (0)
    PEER_LOAD(ub, U, gbeg); PEER_LOAD(vbA, V, gbeg);
#pragma unroll 1
    for (int g0 = gbeg; g0 < gend; g0 += 2) {
        float w0, w1;
        PEER_DOTS(ub, g0, w0);
        PEER_LOAD(ub, U, g0 + 1); PEER_LOAD(vbB, V, g0 + 1);
        PEER_ACC(vbA, w0);
        PEER_DOTS(ub, g0 + 1, w1);
        { const int gn = (g0 + 2 < gend) ? g0 + 2 : g0 + 1;
          PEER_LOAD(ub, U, gn); PEER_LOAD(vbA, V, gn); }
        PEER_ACC(vbB, w1);
    }
#undef PEER_LOAD
#undef PEER_DOTS
#undef PEER_ACC
    if (SPLIT) {
        if (half == 1) {
#pragma unroll
            for (int q = 0; q < 4; ++q) *(LAS f32x4*)(PART + 16 * lane + 4 * q) = (f32x4){oacc[4 * q], oacc[4 * q + 1], oacc[4 * q + 2], oacc[4 * q + 3]}; }
        __syncthreads();
        if (half == 1) return;
#pragma unroll
        for (int q = 0; q < 4; ++q) { const f32x4 p = *(const LAS f32x4*)(PART + 16 * lane + 4 * q); oacc[4 * q] += p.x; oacc[4 * q + 1] += p.y; oacc[4 * q + 2] += p.z; oacc[4 * q + 3] += p.w; }
    }
    asm volatile("" : "+s"(row)); const int lane2 = lane_id();
    const f32x4* x2 = (const f32x4*)((const float*)(ws + WS_X2) + (size_t)row * DM + 16 * lane2);
    f32x4 xv[4]; float ss = 0.f;
#pragma unroll
    for (int q = 0; q < 4; ++q) { xv[q] = x2[q]; xv[q].x += oacc[4 * q]; xv[q].y += oacc[4 * q + 1]; xv[q].z += oacc[4 * q + 2]; xv[q].w += oacc[4 * q + 3]; ss += (xv[q].x * xv[q].x + xv[q].y * xv[q].y) + (xv[q].z * xv[q].z + xv[q].w * xv[q].w); }
    const float r = rsqrtf(wave_sum(ss) * (1.f / DM) + EPS);
    const f32x4* gf = (const f32x4*)((const float*)a.in[I_GFIN] + 16 * lane2);
    f32x4* y = (f32x4*)((row < TP ? a.out + O_YP + (size_t)row * DM : a.out + O_YS + (size_t)(row - TP) * DM) + 16 * lane2);
#pragma unroll
    for (int q = 0; q < 4; ++q) { const f32x4 g4 = gf[q]; f32x4 o; o.x = xv[q].x * r * g4.x; o.y = xv[q].y * r * g4.y; o.z = xv[q].z * r * g4.z; o.w = xv[q].w * r * g4.w; y[q] = o; }
}
__device__ __forceinline__ void cand_ij(int c, int& ci, int& cj) {
    if (c < 16) { ci = 0; cj = c; } else if (c < 24) { ci = 1; cj = c - 16; } else if (c < 29) { ci = 2; cj = c - 24; } else if (c < 33) { ci = 3; cj = c - 29; }
    else if (c < 36) { ci = 4; cj = c - 33; } else if (c < 38) { ci = 5; cj = c - 36; } else if (c < 40) { ci = 6; cj = c - 38; } else if (c < 42) { ci = 7; cj = c - 40; } else if (c < 50) { ci = c - 34; cj = 0; } else { ci = 0; cj = 0; }
}
__device__ __forceinline__ void peer_phase(const Frame& F, const Args& a) {
    LAS unsigned* TOPS = (LAS unsigned*)F.lds + F.wave * 256;
    LAS unsigned* CT = (LAS unsigned*)F.lds + 8 * 256 + 4 * 1024;
    if (F.tid < 64) { int ci, cj; cand_ij(F.tid, ci, cj); CT[F.tid] = (unsigned)ci | ((unsigned)cj << 8); }
    __syncthreads();
    const int gw = F.vcu * NWAVES + F.wave, NGW = F.G * NWAVES;
    const int nfull = TA / NGW, rem = TA - nfull * NGW;
#pragma unroll 1
    for (int i = 0; i < nfull; ++i) peer_token<false>(F, a, gw + i * NGW, TOPS, CT, 0, nullptr);
    if (rem == 4 * F.G) {
        __syncthreads();
        peer_token<true>(F, a, nfull * NGW + F.vcu * 4 + (F.wave >> 1), TOPS, CT, F.wave & 1, (LAS float*)F.lds + 8 * 256 + (F.wave >> 1) * 1024);
    } else {
        const int row = gw + nfull * NGW; if (row < TA) peer_token<false>(F, a, row, TOPS, CT, 0, nullptr);
    }
}


template <class EpiS>
__device__ __forceinline__ void skinny_tile(const Frame& F, const bf16* A, int lda, const bf16* Bt, int ldb, int tm, int tn, const EpiS& E) {
    const int lane = F.lane, fr = lane & 15, fq = lane >> 4, w = F.wave;
    const bf16* ap = A + (size_t)(tm * 64 + fr) * lda + w * 128 + 8 * fq;
    const bf16* bp = Bt + (size_t)(tn * 64 + fr) * ldb + w * 128 + 8 * fq;
    v4u af[4][4], bfr[4][4];
#pragma unroll
    for (int m = 0; m < 4; ++m)
#pragma unroll
        for (int ks = 0; ks < 4; ++ks) { af[m][ks] = *(const v4u*)(ap + (size_t)(16 * m) * lda + ks * 32); bfr[m][ks] = *(const v4u*)(bp + (size_t)(16 * m) * ldb + ks * 32); }
    f32x4 acc[4][4];
#pragma unroll
    for (int m = 0; m < 4; ++m)
#pragma unroll
        for (int n = 0; n < 4; ++n) acc[m][n] = (f32x4){0.f, 0.f, 0.f, 0.f};
#pragma unroll
    for (int ks = 0; ks < 4; ++ks)
#pragma unroll
        for (int m = 0; m < 4; ++m)
#pragma unroll
            for (int n = 0; n < 4; ++n) acc[m][n] = __builtin_amdgcn_mfma_f32_16x16x32_bf16(__builtin_bit_cast(bf16x8, bfr[n][ks]), __builtin_bit_cast(bf16x8, af[m][ks]), acc[m][n], 0, 0, 0);
    LAS float* PS = (LAS float*)F.lds + w * 4096;
#pragma unroll
    for (int m = 0; m < 4; ++m)
#pragma unroll
        for (int n = 0; n < 4; ++n) *(LAS f32x4*)(PS + (16 * m + fr) * 64 + 4 * ((4 * n + fq) ^ fr)) = acc[m][n];
    lds_barrier();
    {
        const int row = F.tid >> 3, c8 = (F.tid & 7) * 8; const LAS float* PR = (const LAS float*)F.lds + row * 64;
        const int ch0 = 4 * (((F.tid & 7) * 2) ^ (row & 15)), ch1 = 4 * (((F.tid & 7) * 2 + 1) ^ (row & 15));
        f32x4 s0 = *(const LAS f32x4*)(PR + ch0), s1 = *(const LAS f32x4*)(PR + ch1);
#pragma unroll
        for (int ww = 1; ww < 8; ++ww) { s0 += *(const LAS f32x4*)(PR + ww * 4096 + ch0); s1 += *(const LAS f32x4*)(PR + ww * 4096 + ch1); }
        float v[8] = {s0.x, s0.y, s0.z, s0.w, s1.x, s1.y, s1.z, s1.w};
        E(tm * 64 + row, tn * 64 + c8, v, F.tid);
    }
    lds_barrier();
}
struct EpiSk {
    float* d32; int ld32; bf16* d16; int ld16; float sc16;
    const float* res; int ldr;
    const float* gcol; float* ssq; const float* rsq;
    __device__ __forceinline__ void operator()(int row, int col, float (&v)[8], int tid) const {
        if (rsq) { const float rs = rsqrtf(rsq[row] * (1.f / 1024.f) + EPS);
#pragma unroll
            for (int i = 0; i < 8; ++i) v[i] *= rs; }
        if (res) { const f32x4 a = *(const f32x4*)(res + (size_t)row * ldr + col), b = *(const f32x4*)(res + (size_t)row * ldr + col + 4);
            v[0] += a.x; v[1] += a.y; v[2] += a.z; v[3] += a.w; v[4] += b.x; v[5] += b.y; v[6] += b.z; v[7] += b.w; }
        if (d32) { *(f32x4*)(d32 + (size_t)row * ld32 + col) = (f32x4){v[0], v[1], v[2], v[3]}; *(f32x4*)(d32 + (size_t)row * ld32 + col + 4) = (f32x4){v[4], v[5], v[6], v[7]}; }
        if (ssq) { float ss = 0.f;
#pragma unroll
            for (int i = 0; i < 8; ++i) ss += v[i] * v[i];
            ss = sum8_f32(ss);
            if ((tid & 7) == 0) atomicAdd(ssq + row, ss); }
        if (d16) { float w8[8];
#pragma unroll
            for (int i = 0; i < 8; ++i) w8[i] = v[i];
            if (gcol) { const f32x4 a = *(const f32x4*)(gcol + col), b = *(const f32x4*)(gcol + col + 4); w8[0] *= a.x; w8[1] *= a.y; w8[2] *= a.z; w8[3] *= a.w; w8[4] *= b.x; w8[5] *= b.y; w8[6] *= b.z; w8[7] *= b.w; }
            v4u o; o.x = pg8::cvt_pk_bf16(w8[0] * sc16, w8[1] * sc16); o.y = pg8::cvt_pk_bf16(w8[2] * sc16, w8[3] * sc16); o.z = pg8::cvt_pk_bf16(w8[4] * sc16, w8[5] * sc16); o.w = pg8::cvt_pk_bf16(w8[6] * sc16, w8[7] * sc16);
            *(v4u*)(d16 + (size_t)row * ld16 + col) = o; }
    }
};

#define SK_TM16(t) (4 * (((t) >> 5) >> 1) + (((t) & 31) >> 3))
#define SK_TN16(t) (8 * (((t) >> 5) & 1) + ((t) & 7))
#define SK_TM32(t) (4 * ((((t) & 255) >> 5) >> 1) + ((((t) & 31) + 32 * ((t) >> 8)) >> 4))
#define SK_TN32(t) (16 * ((((t) & 255) >> 5) & 1) + ((((t) & 31) + 32 * ((t) >> 8)) & 15))


#ifndef PH_MAX
#define PH_MAX 99
#endif
__global__ void __launch_bounds__(NTHR, 2) mega_fwd(Args args) {
    extern __shared__ __attribute__((aligned(16))) unsigned char lds_raw[];
    Frame F;
    F.lds = (LAS unsigned char*)lds_raw;
    F.wave = __builtin_amdgcn_readfirstlane((int)threadIdx.x >> 6); F.lane = lane_id(); F.tid = F.wave * 64 + F.lane;
    F.G = gridDim.x; { const int bx = blockIdx.x; F.vcu = (F.G % 8 == 0) ? (bx % 8) * (F.G / 8) + bx / 8 : bx; }
    volatile LAS unsigned* MISC = (volatile LAS unsigned*)(F.lds + MISC_OFF);
    LAS unsigned long long* ARGP = (LAS unsigned long long*)(F.lds + ARGS_OFF);
    for (int u = F.tid; u < (LDS_BYTES - LDSCTL_OFF) / 4; u += NTHR) ((LAS unsigned*)(F.lds + LDSCTL_OFF))[u] = 0u;
    __syncthreads();
    if (F.tid == 0) {
        ARGP[0] = (unsigned long long)args.in[0];
        ARGP[1] = (unsigned long long)args.in[1];
        ARGP[2] = (unsigned long long)args.in[2];
        ARGP[3] = (unsigned long long)args.in[3];
        ARGP[4] = (unsigned long long)args.in[4];
        ARGP[5] = (unsigned long long)args.in[5];
        ARGP[6] = (unsigned long long)args.in[6];
        ARGP[7] = (unsigned long long)args.in[7];
        ARGP[8] = (unsigned long long)args.in[8];
        ARGP[9] = (unsigned long long)args.in[9];
        ARGP[10] = (unsigned long long)args.in[10];
        ARGP[11] = (unsigned long long)args.in[11];
        ARGP[12] = (unsigned long long)args.in[12];
        ARGP[13] = (unsigned long long)args.in[13];
        ARGP[14] = (unsigned long long)args.in[14];
        ARGP[15] = (unsigned long long)args.in[15];
        ARGP[16] = (unsigned long long)args.in[16];
        ARGP[17] = (unsigned long long)args.in[17];
        ARGP[18] = (unsigned long long)args.in[18];
        ARGP[19] = (unsigned long long)args.in[19];
        ARGP[20] = (unsigned long long)args.in[20];
        ARGP[21] = (unsigned long long)args.in[21];
        ARGP[22] = (unsigned long long)args.in[22];
        ARGP[23] = (unsigned long long)args.in[23];
        ARGP[24] = (unsigned long long)args.in[24];
        ARGP[25] = (unsigned long long)args.in[25];
        ARGP[26] = (unsigned long long)args.in[26];
        ARGP[27] = (unsigned long long)args.in[27];
        ARGP[28] = (unsigned long long)args.in[28];
        ARGP[N_INPUTS] = (unsigned long long)args.out; ARGP[N_INPUTS + 1] = (unsigned long long)args.ws;
    }
    __syncthreads();
    { const XcdBarrier bar0 = xcd_barrier_post((unsigned*)((gu32*)(args.ws + WS_CTL) + CW_BAR), MISC + 8, F.wave); if (F.tid == 0) MISC[10] = bar0.x; }
    __syncthreads();
#define GRID_BAR() do { XcdBarrier bar_; bar_.bar = (unsigned*)((gu32*)((unsigned char*)ld_ptr(ARGP + N_INPUTS + 1) + WS_CTL) + CW_BAR); bar_.x = MISC[10]; bar_.st = MISC + 8; bar_.wave = F.wave; xcd_barrier(bar_); } while (0)
#define PHASE_ARGS const Args A = load_args(ARGP); unsigned char* const ws = A.ws; float* const out = A.out; (void)ws; (void)out; { int l_ = lane_id(); asm volatile("" : "+v"(l_)); F.lane = l_; F.tid = F.wave * 64 + l_; }

    { PHASE_ARGS;
    p0_prologue(F, A);
    }
    GRID_BAR();
#if defined(PROBE_BAR8)
    GRID_BAR(); GRID_BAR(); GRID_BAR(); GRID_BAR(); GRID_BAR(); GRID_BAR(); GRID_BAR(); GRID_BAR();
#endif
#if PH_MAX >= 1
    { PHASE_ARGS;
    {
        pg8::Gemm g{(const bf16*)(ws + WS_HB), (const bf16*)(ws + WS_WIN), DM, DM, DM};
        pg8::StaticOrder S; S.init(TA, N_IN, F.G, (int)blockIdx.x);
        EpiInProj E{out, ws, (const float*)A.in[I_BFF]};
        pg8::gemm_phase(F.lds, g, S, E, F.wave);
    }
    {
        const int off = (TA / 256) * (N_IN / 256) % F.G;
        pg8::Gemm g{(const bf16*)(ws + WS_MB), (const bf16*)(ws + WS_WMK), DM, DM, DM};
        pg8::StaticOrder S; S.init(512, DM, F.G, ((int)blockIdx.x + F.G - off) % F.G);
        EpiGen E{out + O_MKP, DM, (bf16*)(ws + WS_MK16), DM, 1.f, nullptr, nullptr, 0, 0, nullptr, nullptr, nullptr};
        pg8::gemm_phase(F.lds, g, S, E, F.wave);
    }
    {
        const int off = ((TA / 256) * (N_IN / 256) + 8) % F.G;
        pg8::Gemm g{(const bf16*)(ws + WS_MB), (const bf16*)(ws + WS_WMV), DM, DM, DM};
        pg8::StaticOrder S; S.init(512, DM, F.G, ((int)blockIdx.x + F.G - off) % F.G);
        EpiGen E{out + O_MVP, DM, nullptr, 0, 1.f, nullptr, nullptr, 0, 0, nullptr, nullptr, nullptr};
        pg8::gemm_phase(F.lds, g, S, E, F.wave);
    }
    {
        const int off = ((TA / 256) * (N_IN / 256) + 16) % F.G;
        pg8::Gemm g{(const bf16*)(ws + WS_WMV), (const bf16*)(ws + WS_MB), DM, DM, DM};
        pg8::StaticOrder S; S.init(DM, 512, F.G, ((int)blockIdx.x + F.G - off) % F.G);
        EpiGen E{nullptr, 0, (bf16*)(ws + WS_MVT16), 512, 1.f, nullptr, nullptr, 0, 0, nullptr, nullptr, nullptr};
        pg8::gemm_phase(F.lds, g, S, E, F.wave);
    }
    }
    GRID_BAR();
#endif
#if PH_MAX >= 2
    asm volatile("; ===PHASE 2===");
    { PHASE_ARGS;
    {
        const int gw = F.vcu * NWAVES + F.wave, NGW = F.G * NWAVES;
        if ((gw & 3) == 0) for (int it = gw >> 2; it < 512; it += NGW >> 2) fox_norms_item(F, (const bf16*)(ws + WS_QF), (const bf16*)(ws + WS_KF), out + O_LFP, (float*)(ws + WS_MISC + MiB), (float*)(ws + WS_KBIAS), (float*)(ws + WS_MISC + MiB + 65536), it);
        for (int it = gw; it < NB_S * NPAGES; it += NGW) fox_suffix_item(F, (const float*)A.in[I_CFL], (const int*)A.in[I_PT], (float*)(ws + WS_SUF), (float*)(ws + WS_MISC + 2 * MiB), it);
        for (int u = F.vcu; u < 1024; u += F.G) gla_g1_unit(F, A, u);
        for (int u = F.vcu; u < 512; u += F.G) gla_sample_unit(F, A, u);
    }
    }
    GRID_BAR();
#endif
#if PH_MAX >= 3
    asm volatile("; ===PHASE 3===");
    { PHASE_ARGS;
    gla_scan(F, A);
    __syncthreads();
    for (int i = F.vcu; i < 256; i += F.G) { const int bh = i >> 4, s = i & 15;
        fox_attn_unit(F, (const bf16*)(ws + WS_QF), (const bf16*)(ws + WS_KF), (const bf16*)(ws + WS_VF), (const float*)(ws + WS_KBIAS), (const float*)(ws + WS_MISC + MiB + 65536), (const float*)(ws + WS_MISC + MiB), (bf16*)(ws + WS_MERGED), bh >> 3, bh & 7, s);
        fox_attn_unit(F, (const bf16*)(ws + WS_QF), (const bf16*)(ws + WS_KF), (const bf16*)(ws + WS_VF), (const float*)(ws + WS_KBIAS), (const float*)(ws + WS_MISC + MiB + 65536), (const float*)(ws + WS_MISC + MiB), (bf16*)(ws + WS_MERGED), bh >> 3, bh & 7, 31 - s); }
    }
    GRID_BAR();
#endif
#if PH_MAX >= 4
    asm volatile("; ===PHASE 4===");
    { PHASE_ARGS;
    if (!(F.vcu & 1)) { for (int u = F.vcu; u < 1024; u += F.G) gla_g3_unit(F, A, u); }
    }
    { PHASE_ARGS;
    for (int u = F.vcu; u < 1024; u += F.G) fox_sample_unit(F, A, u);
    }
    { PHASE_ARGS;
    if (F.vcu & 1) { for (int u = F.vcu; u < 1024; u += F.G) gla_g3_unit(F, A, u); }
    }
    GRID_BAR();
#endif
#if PH_MAX >= 5
    asm volatile("; ===PHASE 5===");
    { PHASE_ARGS;
    {
        pg8::Gemm g{(const bf16*)(ws + WS_MERGED), (const bf16*)(ws + WS_WOUT), DM, DM, DM};
        pg8::StaticOrder S; S.init(TP, DM, F.G, (int)blockIdx.x);
        EpiGen E{(float*)(ws + WS_X1), DM, (bf16*)(ws + WS_HB), DM, 1.f, (const float*)A.in[I_XP], (const float*)A.in[I_XS], TP, DM, (const float*)A.in[I_GCROSS], (float*)(ws + WS_SS), nullptr};
        pg8::gemm_phase(F.lds, g, S, E, F.wave);
        __syncthreads();
        EpiSk Es{(float*)(ws + WS_X1) + (size_t)TP * DM, DM, (bf16*)(ws + WS_HB) + (size_t)TP * DM, DM, 1.f, (const float*)A.in[I_XS], DM, (const float*)A.in[I_GCROSS], (float*)(ws + WS_SS) + TP, nullptr};
        for (int t = F.vcu; t < 256; t += F.G) skinny_tile(F, (const bf16*)(ws + WS_MERGED) + (size_t)TP * DM, DM, (const bf16*)(ws + WS_WOUT), DM, SK_TM16(t), SK_TN16(t), Es);
    }
    }
    GRID_BAR();
#endif
#if PH_MAX >= 7
    asm volatile("; ===PHASE 7===");
    { PHASE_ARGS;
    {
        pg8::Gemm g{(const bf16*)(ws + WS_HB), (const bf16*)(ws + WS_WCQ), DM, DM, DM};
        pg8::StaticOrder S; S.init(TP, DM, F.G, (int)blockIdx.x);
        EpiGen E{nullptr, 0, (bf16*)(ws + WS_QC), DM, C2C, nullptr, nullptr, 0, 0, nullptr, nullptr, (const float*)(ws + WS_SS)};
        pg8::gemm_phase(F.lds, g, S, E, F.wave);
        __syncthreads();
        EpiSk Es{nullptr, 0, (bf16*)(ws + WS_QC) + (size_t)TP * DM, DM, C2C, nullptr, 0, nullptr, nullptr, (const float*)(ws + WS_SS) + TP};
        for (int t = F.vcu; t < 256; t += F.G) skinny_tile(F, (const bf16*)(ws + WS_HB) + (size_t)TP * DM, DM, (const bf16*)(ws + WS_WCQ), DM, SK_TM16(t), SK_TN16(t), Es);
    }
    }
    GRID_BAR();
#endif
#if PH_MAX >= 8
    asm volatile("; ===PHASE 8===");
    { PHASE_ARGS;
    {
        const int u = (int)blockIdx.x, b = (u >> 7) & 1, h = (u >> 5) & 3, pnl = u & 31;
        const size_t roff = ((size_t)b * SEQ + pnl * 256) * DM + h * 256;
        if (F.vcu & 1) { for (int v = F.vcu; v < 512; v += F.G) cross_sample_unit(F, A, v); }
        pg8::Gemm g{(const bf16*)(ws + WS_QC) + roff, (const bf16*)(ws + WS_MK16) + (size_t)(b * 256) * DM + h * 256, DM, DM, 256};
        pg8::SingleUnit S{u < 256 ? 1 : 0, {0, 0}};
        EpiSoftmaxP E{ARGP};
        pg8::gemm_phase(F.lds, g, S, E, F.wave);
        VM_WAIT(); __syncthreads();
        {
            pg8::Gemm g2{(const bf16*)(ws + WS_PC) + roff, (const bf16*)(ws + WS_MVT16) + (size_t)(h * 256) * 512 + b * 256, DM, 512, 256};
            EpiGen E2{nullptr, 0, (bf16*)(ws + WS_OC) + roff, DM, 1.f, nullptr, nullptr, 0, 0, nullptr, nullptr, nullptr};
            pg8::gemm_phase(F.lds, g2, S, E2, F.wave);
        }
        __syncthreads();
        if (!(F.vcu & 1)) { for (int v = F.vcu; v < 512; v += F.G) cross_sample_unit(F, A, v); }
    }
    }
    GRID_BAR();
#endif
#if PH_MAX >= 10
    asm volatile("; ===PHASE 10===");
    { PHASE_ARGS;
    {
        pg8::Gemm g{(const bf16*)(ws + WS_OC), (const bf16*)(ws + WS_WCO), DM, DM, DM};
        pg8::StaticOrder S; S.init(TP, DM, F.G, (int)blockIdx.x);
        EpiGen E{(float*)(ws + WS_X2), DM, (bf16*)(ws + WS_HB), DM, 1.f, (const float*)(ws + WS_X1), (const float*)(ws + WS_X1), TA, DM, (const float*)A.in[I_GFFN], (float*)(ws + WS_SS) + TA, nullptr};
        pg8::gemm_phase(F.lds, g, S, E, F.wave);
        __syncthreads();
        EpiSk Es{(float*)(ws + WS_X2) + (size_t)TP * DM, DM, (bf16*)(ws + WS_HB) + (size_t)TP * DM, DM, 1.f, (const float*)(ws + WS_X1) + (size_t)TP * DM, DM, (const float*)A.in[I_GFFN], (float*)(ws + WS_SS) + TA + TP, nullptr};
        for (int t = F.vcu; t < 256; t += F.G) skinny_tile(F, (const bf16*)(ws + WS_OC) + (size_t)TP * DM, DM, (const bf16*)(ws + WS_WCO), DM, SK_TM16(t), SK_TN16(t), Es);
    }
    }
    GRID_BAR();
#endif
#if PH_MAX >= 12
    asm volatile("; ===PHASE 12===");
    { PHASE_ARGS;
    {
        pg8::Gemm g{(const bf16*)(ws + WS_HB), (const bf16*)(ws + WS_WPK), DM, DM, DM};
        pg8::StaticOrder S; S.init(TP, 2048, F.G, (int)blockIdx.x);
        EpiGen E{nullptr, 0, (bf16*)(ws + WS_SC), 2048, 1.f, nullptr, nullptr, 0, 0, nullptr, nullptr, (const float*)(ws + WS_SS) + TA};
        pg8::gemm_phase(F.lds, g, S, E, F.wave);
        __syncthreads();
        EpiSk Es{nullptr, 0, (bf16*)(ws + WS_SC) + (size_t)TP * 2048, 2048, 1.f, nullptr, 0, nullptr, nullptr, (const float*)(ws + WS_SS) + TA + TP};
        for (int t = F.vcu; t < 512; t += F.G) skinny_tile(F, (const bf16*)(ws + WS_HB) + (size_t)TP * DM, DM, (const bf16*)(ws + WS_WPK), DM, SK_TM32(t), SK_TN32(t), Es);
    }
    }
    GRID_BAR();
#endif
#if PH_MAX >= 13
    asm volatile("; ===PHASE 13===");
    { PHASE_ARGS;
    peer_phase(F, A);
    }
#endif
#if PH_MAX < 13
    {   PHASE_ARGS;
        const int gw = F.vcu * NWAVES + F.wave, NGW = F.G * NWAVES;
        for (int m = gw; m < TA; m += NGW) {
            const float* x = m < TP ? (const float*)A.in[I_XP] + (size_t)m * DM : (const float*)A.in[I_XS] + (size_t)(m - TP) * DM;
            float* y = m < TP ? out + O_YP + (size_t)m * DM : out + O_YS + (size_t)(m - TP) * DM;
            for (int j = 0; j < 4; ++j) ((f32x4*)y)[F.lane + 64 * j] = ((const f32x4*)x)[F.lane + 64 * j];
        }
    }
#endif

}

extern "C" void kernel_launch(void* const* d_in, const int* in_sizes, int n_in, void* d_out, int out_size, void* d_ws, size_t ws_size, hipStream_t stream) {
    static int grid = 0;
    if (grid == 0) {
        if (n_in != N_INPUTS || (size_t)out_size != O_TOTAL || ws_size < WS_END) { fprintf(stderr, "kernel_launch: unexpected shapes (n_in %d out %d ws %zu)\n", n_in, out_size, ws_size); grid = -1; return; }
        int dev = 0, cus = 0, per_cu = 0;
        if (hipGetDevice(&dev) != hipSuccess || hipDeviceGetAttribute(&cus, hipDeviceAttributeMultiprocessorCount, dev) != hipSuccess) { grid = -1; return; }
        if (hipFuncSetAttribute((const void*)mega_fwd, hipFuncAttributeMaxDynamicSharedMemorySize, LDS_BYTES) != hipSuccess) { fprintf(stderr, "kernel_launch: hipFuncSetAttribute failed\n"); grid = -1; return; }
        if (hipOccupancyMaxActiveBlocksPerMultiprocessor(&per_cu, (const void*)mega_fwd, NTHR, LDS_BYTES) != hipSuccess || per_cu < 1)
            fprintf(stderr, "kernel_launch: occupancy query reports %d workgroups per CU\n", per_cu);
        (void)hipGetLastError();
        grid = cus;
        if (grid > 256) grid = 256;
    }
    if (grid < 0) return;
    if (hipMemsetAsync((char*)d_ws + WS_CTL, 0, CTL_ZERO_BYTES, stream) != hipSuccess) return;
    Args a{};
    for (int i = 0; i < N_INPUTS; ++i) a.in[i] = d_in[i];
    a.out = (float*)d_out; a.ws = (unsigned char*)d_ws;
    hipLaunchKernelGGL(mega_fwd, dim3(grid), dim3(NTHR), LDS_BYTES, stream, a);
    const hipError_t le = hipPeekAtLastError();
    if (le != hipSuccess) fprintf(stderr, "kernel_launch: launch failed: %s\n", hipGetErrorName(le));
}
```

```cpp
#define PH_MAX 13
#include <hip/hip_runtime.h>
#include <cstdio>
#include <cstdint>

namespace pg8 {
#define PG8_LAS __attribute__((address_space(3)))
typedef unsigned short bf16_t;
typedef short bf16x8 __attribute__((ext_vector_type(8)));
typedef float f32x4 __attribute__((ext_vector_type(4)));
typedef unsigned u32x4 __attribute__((ext_vector_type(4)));
typedef unsigned u32x2 __attribute__((ext_vector_type(2)));
constexpr int BM = 256, BK = 64, HALF = 128, HTB = HALF * BK * 2  , STAGE_BYTES = 8 * HTB, NXCD = 8, WGM = 8;

__host__ __device__ __forceinline__ int lds_byte(int r, int c) { const int st = (r >> 4) * 2 + (c >> 5), rr = r & 15, cc = c & 31, ob = rr * 64 + cc * 2; return st * 1024 + (ob ^ (((ob >> 9) & 1) << 5)); }
__host__ __device__ __forceinline__ void stage_rc(int b, int& R, int& C) { const int st = b / 1024, sb = b % 1024, swz = sb ^ (((sb >> 9) & 1) << 5); R = (st >> 1) * 16 + swz / 64; C = (st & 1) * 32 + (swz % 64) / 2; }

struct Unit { int pm, pn; };
struct Gemm { const bf16_t* A; const bf16_t* Bt; int lda, ldb, K; };

struct StaticOrder {
    int nM, nN, nwg, G, c;
    __host__ __device__ void init(int M, int N, int G_, int c_) { nM = M / BM; nN = N / BM; nwg = nM * nN; G = G_; c = c_; }
    __host__ __device__ bool next(int i, Unit& u) const {
        const long L = (long)i * G + c; if (L >= nwg) return false;
        int wgid = (int)L; { const int q = nwg / NXCD, r = nwg % NXCD, xcd = wgid % NXCD, off = wgid / NXCD; wgid = (xcd < r ? xcd * (q + 1) : r * (q + 1) + (xcd - r) * q) + off; }
        const int nig = WGM * nN, gid = wgid / nig, fm = gid * WGM, gsz = (nM - fm) < WGM ? (nM - fm) : WGM;
        u.pm = fm + ((wgid % nig) % gsz); u.pn = (wgid % nig) / gsz; return true;
    }
};
struct SingleUnit {
    int has; Unit u0;
    __host__ __device__ bool next(int i, Unit& u) const { if (i != 0 || !has) return false; u = u0; return true; }
};

__device__ __forceinline__ unsigned cvt_pk_bf16(float lo, float hi) { unsigned r; asm volatile("v_cvt_pk_bf16_f32 %0, %1, %2" : "=v"(r) : "v"(lo), "v"(hi)); return r; }

template <class Epi, class Sched>
__device__ __forceinline__ void gemm_phase(PG8_LAS unsigned char* lds, const Gemm g, const Sched& S, const Epi& E, int wave_id) {
    int lane; asm volatile("v_mbcnt_lo_u32_b32 %0, -1, 0\n\tv_mbcnt_hi_u32_b32 %0, -1, %0" : "=v"(lane));
    const int wid = wave_id; const int tid = wid * 64 + lane; const int wr = wid >> 2, wc = wid & 3, fr = lane & 15, fq = lane >> 4;
    const int K = g.K, nt = K / BK;
    unsigned voffA[2], voffB[2];
#pragma unroll
    for (int i = 0; i < 2; ++i) { int R, C; stage_rc(tid * 16 + i * 8192, R, C);
        voffA[i] = (unsigned)(R * g.lda + C) * 2u; voffB[i] = (unsigned)(R * g.ldb + C) * 2u; }
    const size_t kstep = (size_t)(BK * 2);
    const size_t hstepA = (size_t)HALF * g.lda * 2, hstepB = (size_t)HALF * g.ldb * 2;
    const size_t tstepA = 2 * hstepA, tstepB = 2 * hstepB;
    const unsigned ldsw = (unsigned)wid * 1024u;
    const int aoff = lds_byte(wr * 64 + fr, fq * 8), boff = lds_byte(wc * 32 + fr, fq * 8);
#define PG8_SA(b, h) (((b) * 2 + (h)) * HTB)
#define PG8_SB(b, h) ((4 + (b) * 2 + (h)) * HTB)
#define PG8_STAGE(bufoff, gbase, voff) do { _Pragma("unroll") for (int _i = 0; _i < 2; ++_i) \
        __builtin_amdgcn_global_load_lds((const unsigned*)((const char*)(gbase) + (voff)[_i]), (PG8_LAS unsigned*)(lds + (bufoff) + ldsw + _i * 8192), 16, 0, 0); } while (0)
#define PG8_LDA(dst, b, h) do { _Pragma("unroll") for (int m = 0; m < 4; ++m) _Pragma("unroll") for (int k = 0; k < 2; ++k) dst[m][k] = *(const PG8_LAS bf16x8*)(lds + PG8_SA(b, h) + aoff + m * 2048 + k * 1024); } while (0)
#define PG8_LDB(dst, b, h) do { _Pragma("unroll") for (int n = 0; n < 2; ++n) _Pragma("unroll") for (int k = 0; k < 2; ++k) dst[n][k] = *(const PG8_LAS bf16x8*)(lds + PG8_SB(b, h) + boff + n * 2048 + k * 1024); } while (0)
#define PG8_MMA(ai, bj, At, Bt) do { __builtin_amdgcn_s_setprio(1); _Pragma("unroll") for (int m = 0; m < 4; ++m) _Pragma("unroll") for (int n = 0; n < 2; ++n) _Pragma("unroll") for (int k = 0; k < 2; ++k) \
        acc[ai][bj][m][n] = __builtin_amdgcn_mfma_f32_16x16x32_bf16(Bt[n][k], At[m][k], acc[ai][bj][m][n], 0, 0, 0); __builtin_amdgcn_s_setprio(0); } while (0)
#define PG8_WAIT_V(n) asm volatile("s_waitcnt vmcnt(" #n ")" ::: "memory")
#define PG8_WAIT_L(n) asm volatile("s_waitcnt lgkmcnt(" #n ")" ::: "memory")
#define PG8_BAR __builtin_amdgcn_s_barrier()
#define PG8_SCHED __builtin_amdgcn_sched_barrier(0)
    Unit cur, nxt; int ui = 0;
    if (!S.next(0, cur)) return;
    f32x4 acc[2][2][4][2];
#pragma unroll
    for (int a = 0; a < 2; ++a)
#pragma unroll
        for (int b = 0; b < 2; ++b)
#pragma unroll
            for (int m = 0; m < 4; ++m)
#pragma unroll
                for (int n = 0; n < 2; ++n) acc[a][b][m][n] = (f32x4){0.f, 0.f, 0.f, 0.f};
    bf16x8 At[4][2], B0[2][2], B1[2][2];
    const char* cA = (const char*)g.A + (size_t)cur.pm * tstepA; const char* cB = (const char*)g.Bt + (size_t)cur.pn * tstepB;
    PG8_STAGE(PG8_SB(0, 0), cB, voffB); PG8_STAGE(PG8_SB(0, 1), cB + hstepB, voffB); PG8_STAGE(PG8_SA(0, 0), cA, voffA); PG8_STAGE(PG8_SA(0, 1), cA + hstepA, voffA);
    if (wr == 1) PG8_BAR;
    PG8_WAIT_V(2); PG8_BAR;
    PG8_STAGE(PG8_SB(1, 0), cB + kstep, voffB); PG8_STAGE(PG8_SA(1, 0), cA + kstep, voffA); PG8_STAGE(PG8_SB(1, 1), cB + hstepB + kstep, voffB);
    PG8_WAIT_V(6); PG8_BAR;
    for (;;) {
        const bool has_next = S.next(ui + 1, nxt);
        const char* nA = has_next ? (const char*)g.A + (size_t)nxt.pm * tstepA : cA; const char* nB = has_next ? (const char*)g.Bt + (size_t)nxt.pn * tstepB : cB;
        for (int t = 0; t < nt; t += 2) {
            const bool last = (t == nt - 2);
            const char* a1 = cA + (size_t)(t + 1) * kstep;
            const char* a2 = last ? nA : cA + (size_t)(t + 2) * kstep; const char* b2 = last ? nB : cB + (size_t)(t + 2) * kstep;
            const char* a3 = a2 + kstep; const char* b3 = b2 + kstep;
            PG8_LDB(B0, 0, 0); PG8_LDB(B1, 0, 1); PG8_SCHED; PG8_LDA(At, 0, 0); PG8_STAGE(PG8_SA(1, 1), a1 + hstepA, voffA);
            PG8_WAIT_V(8); PG8_WAIT_L(0); PG8_BAR; PG8_MMA(0, 0, At, B0); PG8_MMA(0, 1, At, B1); PG8_BAR; PG8_SCHED;
            PG8_LDA(At, 0, 1); PG8_STAGE(PG8_SB(0, 0), b2, voffB); PG8_STAGE(PG8_SB(0, 1), b2 + hstepB, voffB); PG8_STAGE(PG8_SA(0, 0), a2, voffA);
            PG8_WAIT_V(8); PG8_WAIT_L(0); PG8_BAR; PG8_MMA(1, 0, At, B0); PG8_MMA(1, 1, At, B1); PG8_BAR; PG8_SCHED;
            PG8_LDB(B0, 1, 0); PG8_LDB(B1, 1, 1); PG8_SCHED; PG8_LDA(At, 1, 0); PG8_STAGE(PG8_SA(0, 1), a2 + hstepA, voffA);
            PG8_WAIT_V(8); PG8_WAIT_L(0); PG8_BAR; PG8_MMA(0, 0, At, B0); PG8_MMA(0, 1, At, B1); PG8_BAR; PG8_SCHED;
            PG8_LDA(At, 1, 1); PG8_STAGE(PG8_SB(1, 0), b3, voffB); PG8_STAGE(PG8_SB(1, 1), b3 + hstepB, voffB); PG8_STAGE(PG8_SA(1, 0), a3, voffA);
            PG8_WAIT_V(8); PG8_WAIT_L(0); PG8_BAR; PG8_MMA(1, 0, At, B0); PG8_MMA(1, 1, At, B1); PG8_BAR; PG8_SCHED;
        }
        if (wr == 0) PG8_BAR;
        if constexpr (!Epi::AFTER_DRAIN) { E(acc, cur, wr, wc, fr, fq); }
        if (!has_next) break;
#pragma unroll
        for (int a = 0; a < 2; ++a)
#pragma unroll
            for (int b = 0; b < 2; ++b)
#pragma unroll
                for (int m = 0; m < 4; ++m)
#pragma unroll
                    for (int n = 0; n < 2; ++n) acc[a][b][m][n] = (f32x4){0.f, 0.f, 0.f, 0.f};
        cur = nxt; cA = nA; cB = nB; ++ui;
        if (wr == 1) PG8_BAR;
    }
    PG8_WAIT_V(0);
    PG8_BAR;
    if constexpr (Epi::AFTER_DRAIN) { E.fused(acc, cur, wr, wc, fr, fq, lds, wid, lane); }
#undef PG8_SA
#undef PG8_SB
#undef PG8_STAGE
#undef PG8_LDA
#undef PG8_LDB
#undef PG8_MMA
#undef PG8_WAIT_V
#undef PG8_WAIT_L
#undef PG8_BAR
#undef PG8_SCHED
}
}

#define GAS __attribute__((address_space(1)))
#define LAS __attribute__((address_space(3)))
typedef unsigned short bf16;
typedef unsigned v4u __attribute__((ext_vector_type(4)));
typedef unsigned v2u __attribute__((ext_vector_type(2)));
typedef float f32x4 __attribute__((ext_vector_type(4)));
typedef float f32x2 __attribute__((ext_vector_type(2)));
typedef float f32x16 __attribute__((ext_vector_type(16)));
typedef short bf16x8 __attribute__((ext_vector_type(8)));
typedef short s16x4 __attribute__((ext_vector_type(4)));
typedef GAS unsigned gu32;
#define RLX_AGENT __ATOMIC_RELAXED, __HIP_MEMORY_SCOPE_AGENT
#define LDS_WAIT() asm volatile("s_waitcnt lgkmcnt(0)" ::: "memory")
#define VM_WAIT() asm volatile("s_waitcnt vmcnt(0)" ::: "memory")
__device__ __forceinline__ unsigned f2bf(float f) { unsigned u = __builtin_bit_cast(unsigned, f); return (u + 0x7fffu + ((u >> 16) & 1u)) >> 16; }
__device__ __forceinline__ unsigned pk2(float lo, float hi) { return f2bf(lo) | (f2bf(hi) << 16); }
__device__ __forceinline__ float bf2f(unsigned short b) { return __builtin_bit_cast(float, (unsigned)b << 16); }
__device__ __forceinline__ float bflo(unsigned u) { return __builtin_bit_cast(float, u << 16); }
__device__ __forceinline__ float bfhi(unsigned u) { return __builtin_bit_cast(float, u & 0xffff0000u); }


typedef short v4i16_t __attribute__((ext_vector_type(4)));
__device__ __forceinline__ s16x4 lds_tr16(LAS unsigned char* p) { return __builtin_bit_cast(s16x4, __builtin_amdgcn_ds_read_tr16_b64_v4i16((LAS v4i16_t*)p)); }
__device__ __forceinline__ int crow(int r, int hi) { return (r & 3) + 8 * (r >> 2) + 4 * hi; }

#define DPP_I(v, ctrl) __builtin_amdgcn_update_dpp(0, (v), (ctrl), 0xF, 0xF, false)
#define DPP_F(v, ctrl) __builtin_bit_cast(float, __builtin_amdgcn_update_dpp(0, __builtin_bit_cast(int, (v)), (ctrl), 0xF, 0xF, false))
constexpr int DPP_X1 = 0xB1, DPP_X2 = 0x4E, DPP_HMIR = 0x141, DPP_MIR = 0x140;
__device__ __forceinline__ unsigned max16_u32(unsigned v) {
    unsigned t = (unsigned)DPP_I((int)v, DPP_X1); v = v > t ? v : t; t = (unsigned)DPP_I((int)v, DPP_X2); v = v > t ? v : t;
    t = (unsigned)DPP_I((int)v, DPP_HMIR); v = v > t ? v : t; t = (unsigned)DPP_I((int)v, DPP_MIR); v = v > t ? v : t; return v; }
__device__ __forceinline__ float sum8_f32(float v) { v += DPP_F(v, DPP_X1); v += DPP_F(v, DPP_X2); v += DPP_F(v, DPP_HMIR); return v; }
__device__ __forceinline__ float sum16_f32(float v) { v = sum8_f32(v); v += DPP_F(v, DPP_MIR); return v; }
__device__ __forceinline__ float max16_f32(float v) { v = fmaxf(v, DPP_F(v, DPP_X1)); v = fmaxf(v, DPP_F(v, DPP_X2)); v = fmaxf(v, DPP_F(v, DPP_HMIR)); v = fmaxf(v, DPP_F(v, DPP_MIR)); return v; }
__device__ __forceinline__ float xor16_f32(float v) { return __builtin_bit_cast(float, __builtin_amdgcn_ds_swizzle(__builtin_bit_cast(int, v), 0x1F | (16 << 10))); }
__device__ __forceinline__ float sum64_f32(float v) {
    v = sum16_f32(v); v += xor16_f32(v);
    return __builtin_bit_cast(float, __builtin_amdgcn_readlane(__builtin_bit_cast(int, v), 0)) + __builtin_bit_cast(float, __builtin_amdgcn_readlane(__builtin_bit_cast(int, v), 32)); }
template <int J> __device__ __forceinline__ unsigned xchg_xor_u32(unsigned v) {
    if constexpr (J == 1) return (unsigned)DPP_I((int)v, DPP_X1);
    else if constexpr (J == 2) return (unsigned)DPP_I((int)v, DPP_X2);
    else return (unsigned)__builtin_amdgcn_ds_swizzle((int)v, 0x1F | (J << 10)); }

__device__ __forceinline__ void lds_barrier() { asm volatile("s_waitcnt lgkmcnt(0)\n\ts_barrier" ::: "memory"); }

struct BfPtr { const unsigned short* p; __device__ __forceinline__ float operator[](size_t i) const { return __builtin_bit_cast(float, (unsigned)p[i] << 16); }
               __device__ __forceinline__ BfPtr operator+(size_t o) const { return BfPtr{p + o}; } };
#define GLD(ptr) (BfPtr{(const unsigned short*)(ptr)})

__device__ __forceinline__ int lane_id() { int r; asm volatile("v_mbcnt_lo_u32_b32 %0, -1, 0\n\tv_mbcnt_hi_u32_b32 %0, -1, %0" : "=v"(r)); return r; }
#define TID_IS_ZERO(wave_) ((wave_) == 0 && lane_id() == 0)
#define XB_TMO      128
#define XB_XCNT(j)  (256  + 64 * (j))
#define XB_XSUB(j)  (1280 + 64 * (j))
#define XB_XGEN(j)  (2304 + 64 * (j))
#define XB_TOP      3328
#define XB_TOPGEN   3392
#define XCD_BAR_WORDS 3456
#define XB_SPIN_CAP (1u << 18)

__device__ __forceinline__ unsigned xb_ld(unsigned* p)              { return __hip_atomic_load(p, __ATOMIC_RELAXED, __HIP_MEMORY_SCOPE_AGENT); }
__device__ __forceinline__ unsigned xb_add(unsigned* p, unsigned v) { return __hip_atomic_fetch_add(p, v, __ATOMIC_RELAXED, __HIP_MEMORY_SCOPE_AGENT); }
__device__ __forceinline__ unsigned xb_xcc_id() { return (unsigned)__builtin_amdgcn_s_getreg((3 << 11) | 20) & 0xFu; }
#define XB_SPIN(cond, bar) do { unsigned _sp = 0; while (cond) { __builtin_amdgcn_s_sleep(1); \
    if ((++_sp & 255u) == 0u) { if (xb_ld(&(bar)[XB_TMO])) break; if (_sp > XB_SPIN_CAP) { atomicAdd(&(bar)[XB_TMO], 1u); break; } } } } while (0)

struct XcdBarrier {
    unsigned* bar; unsigned x; int wave;
    volatile LAS unsigned* st;
};

__device__ __forceinline__ XcdBarrier xcd_barrier_post(unsigned* bar, volatile LAS unsigned* st, int wave) {
    XcdBarrier b; b.bar = bar; b.x = xb_xcc_id(); b.st = st; b.wave = wave;
    if (TID_IS_ZERO(wave)) (void)xb_add(&bar[XB_XCNT(b.x)], 1u);
    return b;
}
__device__ __forceinline__ void xcd_barrier_complete(unsigned* bar, unsigned x, unsigned& nloc, unsigned& nx) {
    const unsigned G = gridDim.x * gridDim.y * gridDim.z;
    unsigned sum, cnt, mine, sp = 0u;
    for (;;) {
        sum = 0u; cnt = 0u; mine = 0u;
#pragma unroll
        for (unsigned j = 0; j < 16; ++j) { const unsigned c = xb_ld(&bar[XB_XCNT(j)]); sum += c; cnt += (c > 0u) ? 1u : 0u; mine = (j == x) ? c : mine; }
        if (sum == G) break;
        __builtin_amdgcn_s_sleep(1);
        if ((++sp & 255u) == 0u) { if (xb_ld(&bar[XB_TMO])) break; if (sp > XB_SPIN_CAP) { atomicAdd(&bar[XB_TMO], 1u); break; } }
    }
    nloc = mine > 0u ? mine : 1u; nx = cnt > 0u ? cnt : 1u;
}

__device__ __forceinline__ void xcd_barrier(const XcdBarrier& b) {
    asm volatile("s_waitcnt vmcnt(0)" ::: "memory");
    __syncthreads();
    if (TID_IS_ZERO(b.wave)) {
        unsigned* bar = b.bar;
        __builtin_amdgcn_s_waitcnt(0);
        unsigned nloc = b.st[0], nx = b.st[1];
        if (nloc == 0u) { xcd_barrier_complete(bar, b.x, nloc, nx); b.st[0] = nloc; b.st[1] = nx; }
        const unsigned old = xb_add(&bar[XB_XSUB(b.x)], 1u);
        const unsigned gen = old / nloc;
        if (old + 1u == (gen + 1u) * nloc) {
            __builtin_amdgcn_fence(__ATOMIC_RELEASE, "agent");
            asm volatile("s_waitcnt vmcnt(0)" ::: "memory");
            const unsigned og = xb_add(&bar[XB_TOP], 1u);
            const unsigned tg = og / nx;
            if (og + 1u == (tg + 1u) * nx) xb_add(&bar[XB_TOPGEN], 1u);
            else XB_SPIN(xb_ld(&bar[XB_TOPGEN]) == tg, bar);
            __builtin_amdgcn_fence(__ATOMIC_ACQUIRE, "agent");
            xb_add(&bar[XB_XGEN(b.x)], 1u);
            asm volatile("s_waitcnt vmcnt(0)" ::: "memory");
        } else {
            XB_SPIN(xb_ld(&bar[XB_XGEN(b.x)]) == gen, bar);
            __builtin_amdgcn_fence(__ATOMIC_ACQUIRE, "agent");
            asm volatile("s_waitcnt vmcnt(0)" ::: "memory");
        }
    }
    __syncthreads();
}


constexpr int NWAVES = 8, NTHR = 512;
constexpr int DM = 1024, TP = 16384, TS = 1024, TA = TP + TS, SEQ = 8192, NB_P = 2, NB_S = 128, LS = 8;
constexpr int N_IN = 3328;
constexpr int PASTL = 2048, PAGE = 128, NPAGES = 16;
constexpr float EPS = 1e-6f;
constexpr float LOG2E = 1.4426950408889634f;
constexpr float C2F = 0.125f * LOG2E;
constexpr float C2C = 0.0625f * LOG2E;

enum { I_XP = 0, I_XS, I_CFK, I_CFV, I_CFL, I_SGLA, I_CMK, I_CMV, I_PT, I_MEMP, I_GMIX, I_WIN, I_BFF, I_WG2, I_BG, I_GGO, I_WOUT, I_GCROSS, I_GMEM,
       I_WMK, I_WMV, I_WCQ, I_WCO, I_GFFN, I_PWQ, I_PSK, I_PU, I_PV, I_GFIN, N_INPUTS };
constexpr size_t O_YP = 0, O_YS = 16777216, O_FKP = 17825792, O_FVP = 26214400, O_LFP = 34603008, O_GSP = 34734080, O_MKP = 34799616, O_MVP = 35323904,
                 O_FKS = 35848192, O_FVS = 36372480, O_LFS = 36896768, O_GSS = 36904960, O_TOTAL = 41099264;

constexpr size_t MiB = 1u << 20;
constexpr size_t WS_CTL = 0, CTL_ZERO_BYTES = 1 * MiB;
constexpr size_t WS_WIN = 2 * MiB, WS_WOUT = 10 * MiB, WS_WMK = 12 * MiB, WS_WMV = 14 * MiB, WS_WCQ = 16 * MiB, WS_WCO = 18 * MiB, WS_WPK = 20 * MiB;
constexpr size_t WS_MB = 24 * MiB, WS_MK16 = 25 * MiB, WS_MVT16 = 26 * MiB, WS_KBIAS = 27 * MiB, WS_GDEC = 28 * MiB, WS_GG = 29 * MiB;
constexpr size_t WS_U16 = 32 * MiB, WS_V16 = 64 * MiB, WS_HB = 96 * MiB, WS_QF = 132 * MiB, WS_KF = 150 * MiB, WS_VF = 168 * MiB;
constexpr size_t WS_GQ = 186 * MiB, WS_GK = 204 * MiB, WS_GV = 222 * MiB, WS_GR = 256 * MiB, WS_SUF = 290 * MiB, WS_GKV = 298 * MiB;
constexpr size_t WS_MERGED = 330 * MiB, WS_X1 = 364 * MiB, WS_X2 = 432 * MiB, WS_QC = 500 * MiB, WS_PC = 534 * MiB, WS_OC = 566 * MiB, WS_SC = 600 * MiB;
constexpr size_t WS_MISC = 736 * MiB, WS_SS = 740 * MiB  , WS_BB = 744 * MiB, WS_END = 800 * MiB;
constexpr int CW_BAR = 4096;

constexpr int RING_BYTES = 131072;
constexpr int LDSCTL_OFF = RING_BYTES, MISC_OFF = LDSCTL_OFF + 320;
constexpr int ARGS_OFF = MISC_OFF + 128;
constexpr int LDS_BYTES = 147456;

struct Args { const void* in[N_INPUTS]; float* out; unsigned char* ws; };

__device__ __forceinline__ const void* ld_ptr(const LAS unsigned long long* p) { const unsigned long long v = *p; const unsigned lo = __builtin_amdgcn_readfirstlane((unsigned)v), hi = __builtin_amdgcn_readfirstlane((unsigned)(v >> 32)); return (const void*)(const GAS char*)(((unsigned long long)hi << 32) | lo); }
__device__ __forceinline__ Args load_args(const LAS unsigned long long* ARGP) { Args A;
    A.in[0] = ld_ptr(ARGP + 0);
    A.in[1] = ld_ptr(ARGP + 1);
    A.in[2] = ld_ptr(ARGP + 2);
    A.in[3] = ld_ptr(ARGP + 3);
    A.in[4] = ld_ptr(ARGP + 4);
    A.in[5] = ld_ptr(ARGP + 5);
    A.in[6] = ld_ptr(ARGP + 6);
    A.in[7] = ld_ptr(ARGP + 7);
    A.in[8] = ld_ptr(ARGP + 8);
    A.in[9] = ld_ptr(ARGP + 9);
    A.in[10] = ld_ptr(ARGP + 10);
    A.in[11] = ld_ptr(ARGP + 11);
    A.in[12] = ld_ptr(ARGP + 12);
    A.in[13] = ld_ptr(ARGP + 13);
    A.in[14] = ld_ptr(ARGP + 14);
    A.in[15] = ld_ptr(ARGP + 15);
    A.in[16] = ld_ptr(ARGP + 16);
    A.in[17] = ld_ptr(ARGP + 17);
    A.in[18] = ld_ptr(ARGP + 18);
    A.in[19] = ld_ptr(ARGP + 19);
    A.in[20] = ld_ptr(ARGP + 20);
    A.in[21] = ld_ptr(ARGP + 21);
    A.in[22] = ld_ptr(ARGP + 22);
    A.in[23] = ld_ptr(ARGP + 23);
    A.in[24] = ld_ptr(ARGP + 24);
    A.in[25] = ld_ptr(ARGP + 25);
    A.in[26] = ld_ptr(ARGP + 26);
    A.in[27] = ld_ptr(ARGP + 27);
    A.in[28] = ld_ptr(ARGP + 28);
    A.out = (float*)ld_ptr(ARGP + N_INPUTS); A.ws = (unsigned char*)ld_ptr(ARGP + N_INPUTS + 1); return A; }
struct Frame {
    LAS unsigned char* lds;
    int tid, lane, wave, vcu, G;
};

__device__ __forceinline__ float wave_sum(float v) { return sum64_f32(v); }
__device__ __forceinline__ float log_sigmoid(float x) { return fminf(x, 0.f) - log1pf(__expf(-fabsf(x))); }

__device__ __forceinline__ int win_src_col(int r) {
    if (r < 1536) return r;
    if (r < 1792) return 1544 + (r - 1536);
    if (r < 2048) return 1800 + (r - 1792);
    if (r < 2560) return 2056 + (r - 2048);
    if (r < 3072) return 2584 + (r - 2560);
    if (r < 3080) return 1536 + (r - 3072);
    if (r < 3096) return 2568 + (r - 3080);
    return -1;
}
template <bool WIN>
__device__ __forceinline__ void p0_transpose_item(const float* W, int ldw, int K, int nblk, bf16* WT, LAS float* scr, int item, int lane) {
    const int kb = item / nblk, nb = item % nblk, k0 = 64 * kb, n0 = 32 * nb;
    const int dr = n0 + (lane & 31); const int sc = WIN ? win_src_col(dr) : dr;
#pragma unroll 8
    for (int i = 0; i < 32; ++i) { const int kk = 2 * i + (lane >> 5); scr[kk * 33 + (lane & 31)] = (sc >= 0) ? W[(size_t)(k0 + kk) * ldw + sc] : 0.f; }
    LDS_WAIT(); asm volatile("" ::: "memory");
    const int c = lane & 7;
#pragma unroll
    for (int j = 0; j < 4; ++j) { const int n = (lane >> 3) + 8 * j; const LAS float* s = scr + (8 * c) * 33 + n;
        v4u o; o.x = pk2(s[0 * 33], s[1 * 33]); o.y = pk2(s[2 * 33], s[3 * 33]); o.z = pk2(s[4 * 33], s[5 * 33]); o.w = pk2(s[6 * 33], s[7 * 33]);
        *(GAS v4u*)(WT + (size_t)(n0 + n) * K + k0 + 8 * c) = o; }
    LDS_WAIT(); asm volatile("" ::: "memory");
}
__device__ __forceinline__ void rms_row_bf16(const float* xrow, const float* g, bf16* orow, int lane) {
    const f32x4* xr = (const f32x4*)xrow + lane; const f32x4* gr = (const f32x4*)g + lane;
    f32x4 v[4]; float s = 0.f;
#pragma unroll
    for (int j = 0; j < 4; ++j) { v[j] = xr[64 * j]; s += (v[j].x * v[j].x + v[j].y * v[j].y) + (v[j].z * v[j].z + v[j].w * v[j].w); }
    const float r = rsqrtf(wave_sum(s) * (1.f / DM) + EPS);
    v2u* o8 = (v2u*)orow + lane;
#pragma unroll
    for (int j = 0; j < 4; ++j) { const f32x4 gg = gr[64 * j]; v2u o; o.x = pk2(v[j].x * r * gg.x, v[j].y * r * gg.y); o.y = pk2(v[j].z * r * gg.z, v[j].w * r * gg.w); o8[64 * j] = o; }
}

using pg8::Unit;
struct EpiGen {
    static constexpr bool PERM = false, AFTER_DRAIN = false;
    float* d32; int ld32; bf16* d16; int ld16; float sc16;
    const float* r0; const float* r1; int rsplit; int ldr;
    const float* gcol;
    float* ssq;
    const float* rsq;
    __device__ __forceinline__ void operator()(const f32x4 (&acc)[2][2][4][2], const Unit& u, int wr, int wc, int fr, int fq) const {
        int row0 = u.pm * 256 + wr * 64 + fr, col0 = u.pn * 256 + wc * 32 + fq * 4;
        asm volatile("" : "+v"(row0), "+v"(col0));
#pragma unroll
        for (int ai = 0; ai < 2; ++ai)
#pragma unroll
            for (int m = 0; m < 4; ++m) { const int row = row0 + ai * 128 + m * 16;
                const float* rp = nullptr; if (r0) rp = (row < rsplit) ? r0 + (size_t)row * ldr : r1 + (size_t)(row - rsplit) * ldr;
                float rs = 1.f; if (rsq) rs = rsqrtf(rsq[row] * (1.f / 1024.f) + EPS);
                float ss = 0.f;
#pragma unroll
                for (int bj = 0; bj < 2; ++bj)
#pragma unroll
                    for (int n = 0; n < 2; ++n) { const int col = col0 + bj * 128 + n * 16; f32x4 v = acc[ai][bj][m][n];
                        if (rsq) { v[0] *= rs; v[1] *= rs; v[2] *= rs; v[3] *= rs; }
                        if (r0) v += *(const f32x4*)(rp + col);
                        if (d32) *(f32x4*)(d32 + (size_t)row * ld32 + col) = v;
                        if (ssq) ss += (v[0] * v[0] + v[1] * v[1]) + (v[2] * v[2] + v[3] * v[3]);
                        if (d16) { f32x4 w = v; if (gcol) w = w * *(const f32x4*)(gcol + col);
                            v2u o; o.x = pg8::cvt_pk_bf16(w[0] * sc16, w[1] * sc16); o.y = pg8::cvt_pk_bf16(w[2] * sc16, w[3] * sc16); *(v2u*)(d16 + (size_t)row * ld16 + col) = o; } }
                if (ssq) { ss += xor16_f32(ss); ss += __shfl_xor(ss, 32); if (fq == 0) atomicAdd(ssq + row, ss); } }
    }
};
struct EpiInProj {
    static constexpr bool PERM = false, AFTER_DRAIN = false;
    float* out; unsigned char* ws; const float* bff;
    __device__ __forceinline__ void operator()(const f32x4 (&acc)[2][2][4][2], const Unit& u, int wr, int wc, int fr, int fq) const {
        const int pn = u.pn; const bool smp = u.pm >= 64;
        int row0 = u.pm * 256 + wr * 64 + fr;
        int orow0 = (smp ? (u.pm - 64) * 256 : u.pm * 256) + wr * 64 + fr;
        asm volatile("" : "+v"(row0), "+v"(orow0));
        float* d32 = nullptr; int ld32 = 0; bool d32_grp = false; bf16* d16 = nullptr; int ld16 = 0; float s32 = 1.f, s16 = 1.f; int cb = 0;
        if (pn < 2) { d16 = (bf16*)(ws + WS_QF); ld16 = 512; s16 = C2F; cb = pn * 256; }
        else if (pn < 4) { d32 = out + (smp ? O_FKS : O_FKP); ld32 = 512; d32_grp = true; d16 = (bf16*)(ws + WS_KF); ld16 = 512; cb = (pn - 2) * 256; }
        else if (pn < 6) { d32 = out + (smp ? O_FVS : O_FVP); ld32 = 512; d32_grp = true; d16 = (bf16*)(ws + WS_VF); ld16 = 512; cb = (pn - 4) * 256; }
        else if (pn == 6) { d16 = (bf16*)(ws + WS_GQ); ld16 = 256; s16 = 0.125f; }
        else if (pn == 7) { d16 = (bf16*)(ws + WS_GK); ld16 = 256; }
        else if (pn < 10) { d16 = (bf16*)(ws + WS_GV); ld16 = 512; cb = (pn - 8) * 256; }
        else if (pn < 12) { d16 = (bf16*)(ws + WS_GR); ld16 = 512; cb = (pn - 10) * 256; }
        if (pn < 12) {
#pragma unroll
            for (int ai = 0; ai < 2; ++ai)
#pragma unroll
                for (int m = 0; m < 4; ++m) { const int row = row0 + ai * 128 + m * 16, orow = orow0 + ai * 128 + m * 16;
#pragma unroll
                    for (int bj = 0; bj < 2; ++bj)
#pragma unroll
                        for (int n = 0; n < 2; ++n) { const int col = cb + wc * 32 + fq * 4 + bj * 128 + n * 16; const f32x4 v = acc[ai][bj][m][n];
                            if (d32) *(f32x4*)(d32 + (size_t)(d32_grp ? orow : row) * ld32 + col) = v * s32;
                            if (d16) { v2u o; o.x = pg8::cvt_pk_bf16(v[0] * s16, v[1] * s16); o.y = pg8::cvt_pk_bf16(v[2] * s16, v[3] * s16); *(v2u*)(d16 + (size_t)row * ld16 + col) = o; } } }
        } else {
            if (wc == 0) {
                float* lf = out + (smp ? O_LFS : O_LFP); float* ggp = (float*)(ws + WS_GG);
#pragma unroll
                for (int ai = 0; ai < 2; ++ai)
#pragma unroll
                    for (int m = 0; m < 4; ++m) { const int row = row0 + ai * 128 + m * 16, orow = orow0 + ai * 128 + m * 16;
#pragma unroll
                        for (int n = 0; n < 2; ++n) { const int col = n * 16 + fq * 4; const f32x4 v = acc[ai][0][m][n];
                            if (col < 8) { f32x4 o; const f32x4 b = *(const f32x4*)(bff + col);
                                o[0] = log_sigmoid(v[0] + b[0]); o[1] = log_sigmoid(v[1] + b[1]); o[2] = log_sigmoid(v[2] + b[2]); o[3] = log_sigmoid(v[3] + b[3]);
                                *(f32x4*)(lf + (size_t)orow * 8 + col) = o; }
                            else if (col < 24) *(f32x4*)(ggp + (size_t)row * 16 + (col - 8)) = v; } }
            }
        }
    }
};


__device__ __forceinline__ void p0_prologue(const Frame& F, const Args& a) {
    unsigned char* ws = a.ws;
    LAS float* scr = (LAS float*)(F.lds + F.wave * 16384);
    const int gw = F.vcu * NWAVES + F.wave, NGW = F.G * NWAVES;
    constexpr int I_WINN = 16 * (N_IN / 32), I_SQ = 16 * 32;
    constexpr int NITEMS = I_WINN + 5 * I_SQ;
    for (int it = (gw + NGW / 2) % NGW; it < NITEMS; it += NGW) {
        int r = it;
        if (r < I_WINN) { p0_transpose_item<true>((const float*)a.in[I_WIN], 3096, DM, N_IN / 32, (bf16*)(ws + WS_WIN), scr, r, F.lane); continue; } r -= I_WINN;
        const int which = r / I_SQ; r -= which * I_SQ;
        const float* src = (const float*)(which == 0 ? a.in[I_WOUT] : which == 1 ? a.in[I_WMK] : which == 2 ? a.in[I_WMV] : which == 3 ? a.in[I_WCQ] : a.in[I_WCO]);
        bf16* dst = (bf16*)(ws + (which == 0 ? WS_WOUT : which == 1 ? WS_WMK : which == 2 ? WS_WMV : which == 3 ? WS_WCQ : WS_WCO));
        p0_transpose_item<false>(src, DM, DM, 32, dst, scr, r, F.lane);
    }
    { float* ssz = (float*)(ws + WS_SS); for (int i = F.vcu * NTHR + F.tid; i < 2 * TA; i += F.G * NTHR) ssz[i] = 0.f; }
    for (int m0 = gw * 2; m0 < TA + 512; m0 += NGW * 2) {
        const float* xr[2]; const float* gr[2]; bf16* orow[2];
#pragma unroll
        for (int j = 0; j < 2; ++j) { const int m = m0 + j;
            if (m < TP) { xr[j] = (const float*)a.in[I_XP] + (size_t)m * DM; gr[j] = (const float*)a.in[I_GMIX]; orow[j] = (bf16*)(ws + WS_HB) + (size_t)m * DM; }
            else if (m < TA) { xr[j] = (const float*)a.in[I_XS] + (size_t)(m - TP) * DM; gr[j] = (const float*)a.in[I_GMIX]; orow[j] = (bf16*)(ws + WS_HB) + (size_t)m * DM; }
            else { xr[j] = (const float*)a.in[I_MEMP] + (size_t)(m - TA) * DM; gr[j] = (const float*)a.in[I_GMEM]; orow[j] = (bf16*)(ws + WS_MB) + (size_t)(m - TA) * DM; } }
        f32x4 v[2][4]; float s[2];
#pragma unroll
        for (int j = 0; j < 2; ++j) { s[j] = 0.f;
#pragma unroll
            for (int q = 0; q < 4; ++q) v[j][q] = ((const f32x4*)xr[j])[F.lane + 64 * q]; }
#pragma unroll
        for (int j = 0; j < 2; ++j) {
#pragma unroll
            for (int q = 0; q < 4; ++q) s[j] += (v[j][q].x * v[j][q].x + v[j][q].y * v[j][q].y) + (v[j][q].z * v[j][q].z + v[j][q].w * v[j][q].w);
            const float r = rsqrtf(wave_sum(s[j]) * (1.f / DM) + EPS);
#pragma unroll
            for (int q = 0; q < 4; ++q) { const f32x4 gg = ((const f32x4*)gr[j])[F.lane + 64 * q]; v2u o; o.x = pk2(v[j][q].x * r * gg.x, v[j][q].y * r * gg.y); o.y = pk2(v[j][q].z * r * gg.z, v[j][q].w * r * gg.w); ((v2u*)orow[j])[F.lane + 64 * q] = o; } }
    }
    {
        for (int r0 = gw * 4; r0 < 2 * 16384; r0 += NGW * 4) {
            f32x4 x[4][4];
#pragma unroll
            for (int j = 0; j < 4; ++j) { const int r = r0 + j; const bool isv = r >= 16384; const int e = isv ? r - 16384 : r;
                const f32x4* s = (const f32x4*)((const float*)(isv ? a.in[I_PV] : a.in[I_PU]) + (size_t)e * DM) + F.lane;
#pragma unroll
                for (int q = 0; q < 4; ++q) x[j][q] = __builtin_nontemporal_load(s + 64 * q); }
#pragma unroll
            for (int j = 0; j < 4; ++j) { const int r = r0 + j; const bool isv = r >= 16384; const int e = isv ? r - 16384 : r; float am = 0.f;
#pragma unroll
                for (int q = 0; q < 4; ++q) am = fmaxf(am, fmaxf(fmaxf(fabsf(x[j][q].x), fabsf(x[j][q].y)), fmaxf(fabsf(x[j][q].z), fabsf(x[j][q].w))));
#pragma unroll
                for (int o = 1; o < 64; o <<= 1) am = fmaxf(am, __shfl_xor(am, o));
                const float inv = am > 0.f ? 448.f / am : 0.f;
                v4u o4;
#pragma unroll
                for (int q = 0; q < 4; ++q) { int pk = __builtin_amdgcn_cvt_pk_fp8_f32(x[j][q].x * inv, x[j][q].y * inv, 0, false); pk = __builtin_amdgcn_cvt_pk_fp8_f32(x[j][q].z * inv, x[j][q].w * inv, pk, true); o4[q] = (unsigned)pk; }
                *(v4u*)(ws + (isv ? WS_V16 : WS_U16) + (size_t)e * DM + 16 * F.lane) = o4;
                if (F.lane == 0) ((float*)(ws + WS_MISC))[r] = am * (1.f / 448.f); }
        }
    }
    __syncthreads();
    for (int it = blockIdx.x; it < 256; it += F.G) {
        const int c = it >> 4, kt = it & 15, half = c & 1;
        LAS float* SK = (LAS float*)F.lds; LAS float* WT = (LAS float*)(F.lds + 128 * 129 * 4);
        const float* sk = (const float*)a.in[I_PSK] + (size_t)half * 128 * 128; const float* wq = (const float*)a.in[I_PWQ] + (size_t)(kt * 64) * 2048 + c * 128;
#pragma unroll 4
        for (int i = 0; i < 32; ++i) { const int idx = F.tid + 512 * i; SK[(idx >> 7) * 129 + (idx & 127)] = sk[idx]; }
#pragma unroll 4
        for (int i = 0; i < 16; ++i) { const int idx = F.tid + 512 * i; WT[(idx >> 7) * 129 + (idx & 127)] = wq[(size_t)(idx >> 7) * 2048 + (idx & 127)]; }
        __syncthreads();
        const int tk = F.tid & 15, tkey = F.tid >> 4;
        float acc[4][4];
#pragma unroll
        for (int i = 0; i < 4; ++i)
#pragma unroll
            for (int j = 0; j < 4; ++j) acc[i][j] = 0.f;
        for (int j = 0; j < 128; ++j) {
            float av[4], bv[4];
#pragma unroll
            for (int i = 0; i < 4; ++i) { av[i] = SK[(4 * tkey + i) * 129 + j]; bv[i] = WT[(4 * tk + i) * 129 + j]; }
#pragma unroll
            for (int i = 0; i < 4; ++i)
#pragma unroll
                for (int i2 = 0; i2 < 4; ++i2) acc[i][i2] += av[i] * bv[i2];
        }
        bf16* wp = (bf16*)(ws + WS_WPK);
#pragma unroll
        for (int i = 0; i < 4; ++i) { v2u o; o.x = pk2(acc[i][0], acc[i][1]); o.y = pk2(acc[i][2], acc[i][3]); *(v2u*)(wp + (size_t)(c * 128 + 4 * tkey + i) * DM + kt * 64 + 4 * tk) = o; }
        __syncthreads();
    }
}


__device__ __forceinline__ void fox_prompt_cumsum(const Frame& F, const float* logf  , float* kbias, int b) {
    LAS float* WT = (LAS float*)F.lds;
    const int t0 = F.wave * 1024 + F.lane * 16;
    const f32x4* src = (const f32x4*)(logf + ((size_t)b * SEQ + t0) * 8);
    float s[8];
#pragma unroll
    for (int h = 0; h < 8; ++h) s[h] = 0.f;
#pragma unroll 4
    for (int i = 0; i < 16; ++i) { const f32x4 a = src[2 * i], c = src[2 * i + 1]; s[0] += a.x; s[1] += a.y; s[2] += a.z; s[3] += a.w; s[4] += c.x; s[5] += c.y; s[6] += c.z; s[7] += c.w; }
    float ex[8];
#pragma unroll
    for (int h = 0; h < 8; ++h) { float v = s[h];
#pragma unroll
        for (int o = 1; o < 64; o <<= 1) { const float t = __shfl_up(v, o); if (F.lane >= o) v += t; }
        ex[h] = v - s[h];
        if (F.lane == 63) WT[F.wave * 8 + h] = v; }
    __syncthreads();
#pragma unroll
    for (int h = 0; h < 8; ++h) { float c = 0.f; for (int w = 0; w < F.wave; ++w) c += WT[w * 8 + h]; ex[h] += c; }
    float* dst = kbias + (size_t)(b * 8) * SEQ + t0;
#pragma unroll 4
    for (int i = 0; i < 16; ++i) { const f32x4 a = src[2 * i], c = src[2 * i + 1];
        ex[0] += a.x; ex[1] += a.y; ex[2] += a.z; ex[3] += a.w; ex[4] += c.x; ex[5] += c.y; ex[6] += c.z; ex[7] += c.w;
#pragma unroll
        for (int h = 0; h < 8; ++h) dst[(size_t)h * SEQ + i] = -ex[h] * LOG2E; }
    __syncthreads();
}
__device__ __forceinline__ void fox_sample_suffix(const Frame& F, const float* cfl, const int* pt, float* suf, int bs) {
    float carry[8];
#pragma unroll
    for (int h = 0; h < 8; ++h) carry[h] = 0.f;
    const int mypg = pt[bs * NPAGES + (F.lane & 15)];
#pragma unroll 1
    for (int pb = NPAGES - 4; pb >= 0; pb -= 4) {
        f32x4 x[4][4];
#pragma unroll
        for (int j = 0; j < 4; ++j) { const int pg = __builtin_amdgcn_readlane(mypg, 0) * 0 + __shfl(mypg, pb + j); const f32x4* src = (const f32x4*)(cfl + ((size_t)pg * PAGE + 2 * F.lane) * 8);
            x[j][0] = src[0]; x[j][1] = src[1]; x[j][2] = src[2]; x[j][3] = src[3]; }
#pragma unroll
        for (int j = 3; j >= 0; --j) { const int p = pb + j;
            const float ra[8] = {x[j][0].x, x[j][0].y, x[j][0].z, x[j][0].w, x[j][1].x, x[j][1].y, x[j][1].z, x[j][1].w}, rb[8] = {x[j][2].x, x[j][2].y, x[j][2].z, x[j][2].w, x[j][3].x, x[j][3].y, x[j][3].z, x[j][3].w};
#pragma unroll
            for (int h = 0; h < 8; ++h) {
                const float ps = ra[h] + rb[h]; float v = ps;
#pragma unroll
                for (int o = 1; o < 64; o <<= 1) { const float t = __shfl_down(v, o); if (F.lane + o < 64) v += t; }
                const float exs = v - ps;
                float* d = suf + (size_t)(bs * 8 + h) * PASTL + p * PAGE + 2 * F.lane;
                *(f32x2*)d = (f32x2){(carry[h] + exs + rb[h]) * LOG2E, (carry[h] + exs) * LOG2E};
                carry[h] += __shfl(v, 0);
            }
        }
    }
}

__device__ __forceinline__ void gla_gate_tile(const Frame& F, const float* gg, const float* w2, const float* bg, int row0, int h, int nt, LAS float* LA, LAS float* GGS) {
    for (int e = F.tid; e < nt * 16; e += NTHR) GGS[e] = gg[(size_t)row0 * 16 + e];
    const int dk = F.tid & 63; float wc[16];
#pragma unroll
    for (int r = 0; r < 16; ++r) wc[r] = w2[r * 256 + h * 64 + dk];
    const float bb = bg[h * 64 + dk];
    __syncthreads();
    for (int t = F.tid >> 6; t < nt; t += 8) { float z = bb;
#pragma unroll
        for (int q = 0; q < 4; ++q) { const f32x4 g4 = *(const LAS f32x4*)(GGS + t * 16 + 4 * q); z += g4.x * wc[4 * q] + g4.y * wc[4 * q + 1] + g4.z * wc[4 * q + 2] + g4.w * wc[4 * q + 3]; }
        LA[t * 64 + dk] = log_sigmoid(z) * (1.f / 16.f); }
}
__device__ __forceinline__ void gla_cumsum64(const Frame& F, LAS float* LA, LAS float* SEG) {
    const int dk = F.lane, w = F.wave; float v[8]; float run = 0.f;
#pragma unroll
    for (int i = 0; i < 8; ++i) { run += LA[(8 * w + i) * 64 + dk]; v[i] = run; }
    SEG[w * 64 + dk] = run;
    __syncthreads();
    float pre = 0.f;
    for (int j = 0; j < w; ++j) pre += SEG[j * 64 + dk];
#pragma unroll
    for (int i = 0; i < 8; ++i) LA[(8 * w + i) * 64 + dk] = v[i] + pre;
    __syncthreads();
}
template <int SB>
__device__ __forceinline__ bf16x8 tr_frag(LAS unsigned char* base, int ks) {
    const s16x4 lo = lds_tr16(base + ks * 16 * SB), hi4 = lds_tr16(base + ks * 16 * SB + 8 * SB);
    return (bf16x8){lo[0], lo[1], lo[2], lo[3], hi4[0], hi4[1], hi4[2], hi4[3]};
}
__device__ __forceinline__ bf16x8 row_frag(const LAS unsigned char* rowp, int ks, int hi) {
    const v2u lo = *(const LAS v2u*)(rowp + (16 * ks + 4 * hi) * 2), hi2 = *(const LAS v2u*)(rowp + (16 * ks + 8 + 4 * hi) * 2);
    return __builtin_bit_cast(bf16x8, (v4u){lo.x, lo.y, hi2.x, hi2.y});
}
__device__ __forceinline__ void gla_g1_unit(const Frame& F, const Args& a, int u) {
    unsigned char* ws = a.ws;
    const int b = u >> 9, h = (u >> 7) & 3, n = u & 127; const int row0 = b * SEQ + n * 64;
    LAS float* LA = (LAS float*)F.lds; LAS float* SEG = LA + 4096; LAS float* GGS = SEG + 512; LAS unsigned char* KRB = F.lds + 22528; LAS unsigned char* VSB = F.lds + 34816;
    v4u vq[2];
#pragma unroll
    for (int i = 0; i < 2; ++i) { const int c = F.tid + NTHR * i; vq[i] = *(const v4u*)((const bf16*)(ws + WS_GV) + (size_t)(row0 + (c >> 4)) * 512 + h * 128 + (c & 15) * 8); }
    float gkv[8];
#pragma unroll
    for (int i = 0; i < 8; ++i) { const int e = F.tid + NTHR * i; gkv[i] = GLD(ws + WS_GK)[(size_t)(row0 + (e >> 6)) * 256 + h * 64 + (e & 63)]; }
    gla_gate_tile(F, (const float*)(ws + WS_GG), (const float*)a.in[I_WG2], (const float*)a.in[I_BG], row0, h, 64, LA, GGS);
#pragma unroll
    for (int i = 0; i < 2; ++i) { const int c = F.tid + NTHR * i; *(LAS v4u*)(VSB + (c >> 4) * 320 + (c & 15) * 16) = vq[i]; }
    __syncthreads();
    gla_cumsum64(F, LA, SEG);
    if (F.tid < 64) ((float*)(ws + WS_GDEC))[(size_t)((b * 4 + h) * 128 + n) * 64 + F.tid] = __expf(LA[63 * 64 + F.tid]);
    float* bbuf = (float*)(ws + WS_BB);
#pragma unroll
    for (int i = 0; i < 8; ++i) { const int e = F.tid + NTHR * i; const int t = e >> 6, dk = e & 63; const float bb = LA[e]; bbuf[(size_t)(row0 + t) * 256 + h * 64 + dk] = bb;
        *(LAS unsigned short*)(KRB + t * 192 + dk * 2) = (unsigned short)f2bf(gkv[i] * __expf(LA[63 * 64 + dk] - bb)); }
    __syncthreads();
    {
        const int lane = F.lane, r32 = lane & 31, hi = lane >> 5, mb = F.wave >> 2, nb = F.wave & 3;
        const int tb = (4 * hi + ((lane & 15) >> 2)), tc = (16 * ((lane >> 4) & 1) + 4 * (lane & 3)) * 2;
        LAS unsigned char* abase = KRB + tb * 192 + tc + 64 * mb; LAS unsigned char* bbase = VSB + tb * 320 + tc + 64 * nb;
        f32x16 acc = {};
#pragma unroll
        for (int ks = 0; ks < 4; ++ks) acc = __builtin_amdgcn_mfma_f32_32x32x16_bf16(tr_frag<192>(abase, ks), tr_frag<320>(bbase, ks), acc, 0, 0, 0);
        float* kv = (float*)(ws + WS_GKV) + ((size_t)((b * 4 + h) * 128 + n) * 64 + 32 * mb) * 128 + 32 * nb + r32;
#pragma unroll
        for (int r = 0; r < 16; ++r) kv[(size_t)crow(r, hi) * 128] = acc[r];
    }
    __syncthreads();
}
__device__ __forceinline__ void gla_scan(const Frame& F, const Args& a) {
    int tid = F.wave * 64 + lane_id(); asm volatile("" : "+v"(tid));
    if (tid >= 256) return;
    for (int e = F.vcu * 256 + tid; e < 65536; e += F.G * 256) {
    const int bh = e >> 13, dk = (e >> 7) & 63, dv = e & 127;
    float* kv = (float*)(a.ws + WS_GKV) + ((size_t)bh * 128 * 64 + dk) * 128 + dv; const float* dc = (const float*)(a.ws + WS_GDEC) + (size_t)bh * 128 * 64 + dk;
    float S = 0.f;
#pragma unroll 1
    for (int n0 = 0; n0 < 128; n0 += 32) { float kvv[32], dd[32];
#pragma unroll
        for (int j = 0; j < 32; ++j) { kvv[j] = kv[(size_t)(n0 + j) * 8192]; dd[j] = dc[(size_t)(n0 + j) * 64]; }
#pragma unroll
        for (int j = 0; j < 32; ++j) { kv[(size_t)(n0 + j) * 8192] = S; S = dd[j] * S + kvv[j]; } }
    a.out[O_GSP + (size_t)bh * 8192 + dk * 128 + dv] = S;
    }
}
__device__ __forceinline__ float silu(float x) { return x / (1.f + __expf(-x)); }
__device__ __forceinline__ void gla_sample_unit(const Frame& F, const Args& a, int u) {
    unsigned char* ws = a.ws;
    const int bs = u >> 2, h = u & 3; const int row0 = TP + bs * LS;
    LAS float* LA = (LAS float*)F.lds; LAS float* BL = LA + 512; LAS float* QD = BL + 64; LAS float* KI = QD + 512; LAS float* KR = KI + 512; LAS float* ATT = KR + 512; LAS float* OP = ATT + 64; LAS float* VS = OP + 4096;
    gla_gate_tile(F, (const float*)(ws + WS_GG), (const float*)a.in[I_WG2], (const float*)a.in[I_BG], row0, h, 8, LA, VS + 1024);
#pragma unroll
    for (int i = 0; i < 2; ++i) { const int e = F.tid + NTHR * i; VS[e] = GLD(ws + WS_GV)[(size_t)(row0 + (e >> 7)) * 512 + h * 128 + (e & 127)]; }
    __syncthreads();
    if (F.tid < 64) { float run = 0.f;
#pragma unroll
        for (int t = 0; t < 8; ++t) { run += LA[t * 64 + F.tid]; LA[t * 64 + F.tid] = run; } BL[F.tid] = run; }
    __syncthreads();
    { const int e = F.tid, t = e >> 6, dk = e & 63; const float bb = LA[e];
      const float q = GLD(ws + WS_GQ)[(size_t)(row0 + t) * 256 + h * 64 + dk], k = GLD(ws + WS_GK)[(size_t)(row0 + t) * 256 + h * 64 + dk];
      QD[e] = q * __expf(bb); KI[e] = k * __expf(-bb); KR[e] = k * __expf(BL[dk] - bb); }
    __syncthreads();
    if (F.tid < 64) { const int t = F.tid >> 3, s = F.tid & 7; float acc = 0.f;
        if (s <= t) { for (int dk = 0; dk < 64; ++dk) acc += QD[t * 64 + dk] * KI[s * 64 + dk]; }
        ATT[F.tid] = acc; }
    const int dv = F.tid & 127, dkg = F.tid >> 7;
    {
        const float* st = (const float*)a.in[I_SGLA] + ((size_t)(bs * 4 + h) * 64 + dkg * 16) * 128 + dv;
        float S0[16];
#pragma unroll
        for (int i = 0; i < 16; ++i) S0[i] = st[(size_t)i * 128];
#pragma unroll
        for (int t = 0; t < 8; ++t) { float o = 0.f;
#pragma unroll
            for (int i = 0; i < 16; ++i) o += QD[t * 64 + dkg * 16 + i] * S0[i];
            OP[(dkg * 8 + t) * 128 + dv] = o; }
        float* so = a.out + O_GSS + ((size_t)(bs * 4 + h) * 64 + dkg * 16) * 128 + dv;
#pragma unroll
        for (int i = 0; i < 16; ++i) { float sn = __expf(BL[dkg * 16 + i]) * S0[i];
#pragma unroll
            for (int t = 0; t < 8; ++t) sn += KR[t * 64 + dkg * 16 + i] * VS[t * 128 + dv];
            so[(size_t)i * 128] = sn; }
    }
    __syncthreads();
    {
        const int t = F.wave; float o[2]; float ss = 0.f;
#pragma unroll
        for (int j = 0; j < 2; ++j) { const int d = 2 * F.lane + j; float v = OP[(0 * 8 + t) * 128 + d] + OP[(1 * 8 + t) * 128 + d] + OP[(2 * 8 + t) * 128 + d] + OP[(3 * 8 + t) * 128 + d];
            for (int s = 0; s <= t; ++s) v += ATT[t * 8 + s] * VS[s * 128 + d];
            o[j] = v; ss += v * v; }
        const float r = rsqrtf(wave_sum(ss) * (1.f / 128.f) + EPS);
        const float* ggo = (const float*)a.in[I_GGO] + h * 128 + 2 * F.lane; const BfPtr gr = GLD(ws + WS_GR) + ((size_t)(row0 + t) * 512 + h * 128 + 2 * F.lane);
        const float y0 = o[0] * r * ggo[0] * silu(gr[0]), y1 = o[1] * r * ggo[1] * silu(gr[1]);
        *(unsigned*)((bf16*)(ws + WS_MERGED) + (size_t)(row0 + t) * DM + 512 + h * 128 + 2 * F.lane) = pk2(y0, y1);
    }
    __syncthreads();
}


__device__ __forceinline__ float fexp2(float x) { return __builtin_amdgcn_exp2f(x); }
constexpr float FOX_SKIP = 160.f;


__device__ __forceinline__ void fox_norms_item(const Frame& F, const bf16* QF, const bf16* KF, const float* logf, float* FN, float* LC, float* BT, int item) {
    const int bh = item >> 5, qb = item & 31, b = bh >> 3, h = bh & 7;
    float qm = 0.f, km = 0.f;
    const float* lp = logf + ((size_t)b * SEQ + qb * 256 + 4 * F.lane) * 8 + h;
    const float l0 = lp[0], l1 = lp[8], l2 = lp[16], l3 = lp[24];
#pragma unroll 8
    for (int i = 0; i < 32; ++i) { const size_t row = (size_t)b * SEQ + qb * 256 + i * 8 + (F.lane >> 3);
        const v4u q = *(const v4u*)(QF + row * 512 + h * 64 + (F.lane & 7) * 8), k = *(const v4u*)(KF + row * 512 + h * 64 + (F.lane & 7) * 8); float qs = 0.f, ks = 0.f;
#pragma unroll
        for (int j = 0; j < 4; ++j) { qs += bflo(q[j]) * bflo(q[j]) + bfhi(q[j]) * bfhi(q[j]); ks += bflo(k[j]) * bflo(k[j]) + bfhi(k[j]) * bfhi(k[j]); }
        qs = sum8_f32(qs); ks = sum8_f32(ks);
        qm = fmaxf(qm, qs); km = fmaxf(km, ks); }
#pragma unroll
    for (int o = 1; o < 64; o <<= 1) { qm = fmaxf(qm, __shfl_xor(qm, o)); km = fmaxf(km, __shfl_xor(km, o)); }
    const float c0 = l0, c1 = c0 + l1, c2 = c1 + l2, c3 = c2 + l3; float v = c3;
#pragma unroll
    for (int o = 1; o < 64; o <<= 1) { const float t = __shfl_up(v, o); if (F.lane >= o) v += t; }
    const float ex = v - c3;
    *(f32x4*)(LC + (size_t)bh * SEQ + qb * 256 + 4 * F.lane) = (f32x4){ex + c0, ex + c1, ex + c2, ex + c3};
    if (F.lane == 63) BT[item] = v;
    if (F.lane == 0) { FN[item * 2] = qm; FN[item * 2 + 1] = km; }
}
__device__ __forceinline__ void fox_suffix_item(const Frame& F, const float* cfl, const int* pt, float* SW, float* PTOT, int item) {
    const int bs = item >> 4, p = item & 15; const int pg = __builtin_amdgcn_readfirstlane(pt[item]);
    const f32x4* src = (const f32x4*)(cfl + ((size_t)pg * PAGE + 2 * F.lane) * 8);
    const f32x4 a0 = src[0], a1 = src[1], b0 = src[2], b1 = src[3];
    const float ra[8] = {a0.x, a0.y, a0.z, a0.w, a1.x, a1.y, a1.z, a1.w}, rb[8] = {b0.x, b0.y, b0.z, b0.w, b1.x, b1.y, b1.z, b1.w};
#pragma unroll
    for (int h = 0; h < 8; ++h) {
        const float ps = ra[h] + rb[h]; float v = ps;
#pragma unroll
        for (int o = 1; o < 64; o <<= 1) { const float t = __shfl_down(v, o); if (F.lane + o < 64) v += t; }
        const float exs = v - ps;
        *(f32x2*)(SW + (size_t)(bs * 8 + h) * PASTL + p * PAGE + 2 * F.lane) = (f32x2){exs + rb[h], exs};
        if (F.lane == 0) PTOT[(bs * 8 + h) * NPAGES + p] = v;
    }
}
__device__ __forceinline__ void fox_attn_unit(const Frame& F, const bf16* QF, const bf16* KF, const bf16* VF, const float* LC, const float* BT, const float* FN, bf16* merged, int b, int h, int qb) {
    int tid = F.wave * 64 + lane_id(); asm volatile("" : "+v"(tid));
    const int lane = tid & 63, r32 = lane & 31, hi = lane >> 5, wid = F.wave;
    const size_t rowbase = (size_t)b * SEQ; const int q0 = qb * 256;
    LAS unsigned char* Ks = F.lds; LAS unsigned char* Vs = F.lds + 8192; LAS float* KBs = (LAS float*)(F.lds + 20480); LAS float* WSF = (LAS float*)(F.lds + 20736) + wid * 32;
    const bf16* Qw = QF + (rowbase + q0 + wid * 32 + r32) * 512 + h * 64;
    bf16x8 qr[4];
#pragma unroll
    for (int d0 = 0; d0 < 4; ++d0) qr[d0] = *(const bf16x8*)(Qw + d0 * 16 + hi * 8);
    const float* lcp = LC + (size_t)(b * 8 + h) * SEQ;
    float pbx; { const float btv = (lane < 32) ? BT[(b * 8 + h) * 32 + lane] : 0.f; float v = btv;
#pragma unroll
        for (int o = 1; o < 64; o <<= 1) { const float t = __shfl_up(v, o); if (lane >= o) v += t; }
        pbx = v - btv; }
    const float cref = lcp[q0] + __shfl(pbx, qb);
#define FOX_KB(t_, pos_) (-LOG2E * ((lcp[pos_] + __shfl(pbx, (t_) >> 2)) - cref))
    const int NT = (q0 + 256) / 64;
    int t0 = 0;
    {
        float kn = (lane < 32) ? FN[((b * 8 + h) * 32 + lane) * 2 + 1] : 0.f;
#pragma unroll
        for (int o = 1; o < 64; o <<= 1) kn = fmaxf(kn, __shfl_xor(kn, o));
        const float qk2 = 2.f * sqrtf(FN[((b * 8 + h) * 32 + qb) * 2]) * sqrtf(kn) * 1.01f;
        const int nbefore = q0 / 64;
        int found = -1;
        for (int base = 0; base < nbefore && found < 0; base += 64) {
            const int tl = nbefore - 1 - base - lane;
            const int tlc = tl < 0 ? 0 : tl; const float kbl = -LOG2E * ((lcp[tlc * 64 + 63] + __shfl(pbx, tlc >> 2)) - cref);
            const bool dead = (tl >= 0) && (qk2 + kbl < -FOX_SKIP);
            const unsigned long long bm = __ballot(dead);
            if (bm) found = nbefore - 1 - base - (int)__builtin_ctzll(bm);
        }
        t0 = found + 1;
        t0 = __builtin_amdgcn_readfirstlane(t0);
    }
    const int kkey = tid & 63, kch = tid >> 6, vkey = tid >> 3, vch = tid & 7;
    const bf16* ksrc = KF + (rowbase + kkey) * 512 + h * 64 + kch * 8;
    const bf16* vsrc = VF + (rowbase + vkey) * 512 + h * 64 + vch * 8;
    v4u kreg[2], vreg[2]; float kbreg[2];
#pragma unroll
    for (int hb = 0; hb < 2; ++hb) { const int tt = (t0 + hb < NT) ? t0 + hb : t0;
        kreg[hb] = *(const v4u*)(ksrc + (size_t)tt * 64 * 512); vreg[hb] = *(const v4u*)(vsrc + (size_t)tt * 64 * 512); kbreg[hb] = FOX_KB(tt, tt * 64 + (tid & 63)); }
    float m_run = -INFINITY, l_run = 0.f; f32x16 o0 = {}, o1 = {};
    const int qpos = q0 + wid * 32 + r32;
    const int vbase = (4 * hi + ((lane & 15) >> 2)) * 192 + (16 * ((lane >> 4) & 1) + 4 * (lane & 3)) * 2;
    LAS unsigned char* const Ks0 = Ks; LAS unsigned char* const Vs0 = Vs; LAS float* const KBs0 = KBs;
    __syncthreads();
    for (int t2 = t0; t2 < NT; t2 += 2) {
#pragma unroll
      for (int hb = 0; hb < 2; ++hb) {
        const int t = t2 + hb;
        if (t < NT) {
        LAS unsigned char* const Ks = Ks0 + hb * 28672; LAS unsigned char* const Vs = Vs0 + hb * 28672; LAS float* const KBs = (LAS float*)((LAS unsigned char*)KBs0 + hb * 28672);
        *(LAS v4u*)(Ks + kch * 1024 + kkey * 16) = kreg[hb]; *(LAS v4u*)(Vs + vkey * 192 + vch * 16) = vreg[hb]; if (tid < 64) KBs[tid] = kbreg[hb];
        __syncthreads();
        if (t + 2 < NT) { kreg[hb] = *(const v4u*)(ksrc + (size_t)(t + 2) * 64 * 512); vreg[hb] = *(const v4u*)(vsrc + (size_t)(t + 2) * 64 * 512); kbreg[hb] = FOX_KB(t + 2, (t + 2) * 64 + (tid & 63)); }
        const int k0 = t * 64;
        if (k0 <= q0 + wid * 32 + 31) {
        f32x16 p0, p1;
#pragma unroll
        for (int g = 0; g < 4; ++g) { const f32x4 ba = *(const LAS f32x4*)(KBs + 8 * g + 4 * hi), bb = *(const LAS f32x4*)(KBs + 32 + 8 * g + 4 * hi);
#pragma unroll
            for (int i = 0; i < 4; ++i) { p0[4 * g + i] = ba[i]; p1[4 * g + i] = bb[i]; } }
#pragma unroll
        for (int d0 = 0; d0 < 4; ++d0) {
            const bf16x8 a0 = *(const LAS bf16x8*)(Ks + (2 * d0 + hi) * 1024 + r32 * 16), a1 = *(const LAS bf16x8*)(Ks + (2 * d0 + hi) * 1024 + r32 * 16 + 512);
            p0 = __builtin_amdgcn_mfma_f32_32x32x16_bf16(a0, qr[d0], p0, 0, 0, 0); p1 = __builtin_amdgcn_mfma_f32_32x32x16_bf16(a1, qr[d0], p1, 0, 0, 0);
        }
        if (k0 + 63 > q0 + wid * 32) {
#pragma unroll
            for (int r = 0; r < 16; ++r) { const int key = k0 + crow(r, hi); if (key > qpos) p0[r] = -INFINITY; if (key + 32 > qpos) p1[r] = -INFINITY; }
        }
        float mx = fmaxf(p0[0], p1[0]);
#pragma unroll
        for (int r = 1; r < 16; ++r) mx = fmaxf(mx, fmaxf(p0[r], p1[r]));
        mx = fmaxf(mx, __shfl_xor(mx, 32));
        const float m_new = fmaxf(m_run, mx), alpha = fexp2(m_run - m_new); m_run = m_new;
        float ls = 0.f;
#pragma unroll
        for (int r = 0; r < 16; ++r) { p0[r] = fexp2(p0[r] - m_new); p1[r] = fexp2(p1[r] - m_new); ls += p0[r] + p1[r]; }
        l_run = l_run * alpha + ls;
        if (__ballot(alpha != 1.f) != 0ull) {
            if (hi == 0) WSF[r32] = alpha;
#pragma unroll
            for (int g = 0; g < 4; ++g) { const f32x4 al = *(const LAS f32x4*)(WSF + 8 * g + 4 * hi);
#pragma unroll
                for (int i = 0; i < 4; ++i) { o0[4 * g + i] *= al[i]; o1[4 * g + i] *= al[i]; } }
        }
        v4u pw[4];
#pragma unroll
        for (int j = 0; j < 4; ++j) { pw[0][j] = pg8::cvt_pk_bf16(p0[2 * j], p0[2 * j + 1]); pw[1][j] = pg8::cvt_pk_bf16(p0[8 + 2 * j], p0[8 + 2 * j + 1]);
                                      pw[2][j] = pg8::cvt_pk_bf16(p1[2 * j], p1[2 * j + 1]); pw[3][j] = pg8::cvt_pk_bf16(p1[8 + 2 * j], p1[8 + 2 * j + 1]); }
#pragma unroll
        for (int ks = 0; ks < 4; ++ks) {
            const bf16x8 pa = __builtin_bit_cast(bf16x8, pw[ks]);
#pragma unroll
            for (int d0 = 0; d0 < 2; ++d0) {
                const s16x4 lo = lds_tr16(Vs + vbase + ks * 16 * 192 + d0 * 64), hi4 = lds_tr16(Vs + vbase + ks * 16 * 192 + 8 * 192 + d0 * 64);
                const bf16x8 vb = (bf16x8){lo[0], lo[1], lo[2], lo[3], hi4[0], hi4[1], hi4[2], hi4[3]};
                if (d0 == 0) o0 = __builtin_amdgcn_mfma_f32_32x32x16_bf16(pa, vb, o0, 0, 0, 0); else o1 = __builtin_amdgcn_mfma_f32_32x32x16_bf16(pa, vb, o1, 0, 0, 0);
            }
        }
        }
        }
      }
    }
    l_run += __shfl_xor(l_run, 32);
    if (hi == 0) WSF[r32] = 1.f / l_run;
    bf16* Ow = merged + (rowbase + q0 + wid * 32) * DM + h * 64 + r32;
#pragma unroll
    for (int g = 0; g < 4; ++g) { const f32x4 rl = *(const LAS f32x4*)(WSF + 8 * g + 4 * hi);
#pragma unroll
        for (int i = 0; i < 4; ++i) { const int r = 4 * g + i; const int row = crow(r, hi);
            Ow[(size_t)row * DM] = (bf16)f2bf(o0[r] * rl[i]); Ow[(size_t)row * DM + 32] = (bf16)f2bf(o1[r] * rl[i]); } }
    __syncthreads();
#undef FOX_KB
}

template <int D> struct DecW {
    static constexpr int KS = D / 32;
    static constexpr int LPK = D / 4;
    static constexpr int KPI = 64 / LPK;
    float m[4], l[4]; float o[8][4];
};
template <int D>
__device__ __forceinline__ void dec_init(DecW<D>& w) {
#pragma unroll
    for (int i = 0; i < 4; ++i) { w.m[i] = -INFINITY; w.l[i] = 0.f; }
#pragma unroll
    for (int q = 0; q < 8; ++q)
#pragma unroll
        for (int j = 0; j < 4; ++j) w.o[q][j] = 0.f;
}
template <int D, int NTILE, int MODE>
__device__ __forceinline__ void dec_chunk(DecW<D>& w, const bf16x8 (&qa)[D / 32], const float* Kb, const float* Vb, int stride, const float* bias, float nb, LAS float* PL, int lane) {
    constexpr int KS = D / 32, LPK = D / 4, KPI = 64 / LPK;
    constexpr int NK = (MODE == 1) ? 8 : NTILE * 16, NV = NK / KPI;
    const int key = lane & 15, kq = lane >> 4;
    const unsigned koff = (unsigned)(key * stride + 8 * kq) * 4u;
    const int d4 = lane % LPK, ksub = lane / LPK;
    const unsigned voff = (unsigned)(ksub * stride + 4 * d4) * 4u;
    f32x4 kx[NTILE][2 * KS], vx[NV];
#pragma unroll
    for (int t = 0; t < NTILE; ++t) { const char* kp = (const char*)(Kb + (size_t)t * 16 * stride) + koff;
#pragma unroll
        for (int ks = 0; ks < KS; ++ks) { kx[t][2 * ks] = *(const f32x4*)(kp + 128 * ks); kx[t][2 * ks + 1] = *(const f32x4*)(kp + 128 * ks + 16); } }
    constexpr int NVA = (NV >= 8) ? NV / 2 : NV;
#pragma unroll
    for (int kk = 0; kk < NVA; ++kk) vx[kk] = *(const f32x4*)((const char*)(Vb + (size_t)kk * KPI * stride) + voff);
    f32x4 s[NTILE];
#pragma unroll
    for (int t = 0; t < NTILE; ++t) {
        f32x4 acc = {0.f, 0.f, 0.f, 0.f};
#pragma unroll
        for (int ks = 0; ks < KS; ++ks) { const f32x4 x0 = kx[t][2 * ks], x1 = kx[t][2 * ks + 1];
            v4u kb; kb.x = pg8::cvt_pk_bf16(x0.x, x0.y); kb.y = pg8::cvt_pk_bf16(x0.z, x0.w); kb.z = pg8::cvt_pk_bf16(x1.x, x1.y); kb.w = pg8::cvt_pk_bf16(x1.z, x1.w);
            acc = __builtin_amdgcn_mfma_f32_16x16x32_bf16(qa[ks], __builtin_bit_cast(bf16x8, kb), acc, 0, 0, 0); }
        if (MODE == 0) { if (bias) { const float bv = (bias[t * 16 + key] + nb) * LOG2E; acc += bv; } }
        else { acc += nb;
#pragma unroll
            for (int i = 0; i < 4; ++i) if (key > 4 * kq + i || key >= 8) acc[i] = -INFINITY; }
        s[t] = acc;
    }
#pragma unroll
    for (int kk = NVA; kk < NV; ++kk) vx[kk] = *(const f32x4*)((const char*)(Vb + (size_t)kk * KPI * stride) + voff);
    f32x4 mc = s[0];
#pragma unroll
    for (int t = 1; t < NTILE; ++t) { mc.x = fmaxf(mc.x, s[t].x); mc.y = fmaxf(mc.y, s[t].y); mc.z = fmaxf(mc.z, s[t].z); mc.w = fmaxf(mc.w, s[t].w); }
    mc.x = max16_f32(mc.x); mc.y = max16_f32(mc.y); mc.z = max16_f32(mc.z); mc.w = max16_f32(mc.w);
    float al[4];
#pragma unroll
    for (int i = 0; i < 4; ++i) { const float mn = fmaxf(w.m[i], mc[i]); al[i] = (mn == -INFINITY) ? 1.f : fexp2(w.m[i] - mn); w.m[i] = mn; w.l[i] *= al[i]; }
#pragma unroll
    for (int t = 0; t < NTILE; ++t) { f32x4 p;
#pragma unroll
        for (int i = 0; i < 4; ++i) { p[i] = (w.m[i] == -INFINITY) ? 0.f : fexp2(s[t][i] - w.m[i]); w.l[i] += p[i]; }
        if (kq < 2) *(LAS f32x4*)(PL + (t * 16 + key) * 8 + 4 * kq) = p; }
    if (key == 0 && kq < 2) *(LAS f32x4*)(PL + 1024 + 4 * kq) = (f32x4){al[0], al[1], al[2], al[3]};
    { const f32x4 a0 = *(const LAS f32x4*)(PL + 1024), a1 = *(const LAS f32x4*)(PL + 1028);
#pragma unroll
      for (int j = 0; j < 4; ++j) { w.o[0][j] *= a0.x; w.o[1][j] *= a0.y; w.o[2][j] *= a0.z; w.o[3][j] *= a0.w; w.o[4][j] *= a1.x; w.o[5][j] *= a1.y; w.o[6][j] *= a1.z; w.o[7][j] *= a1.w; } }
#pragma unroll
    for (int kk = 0; kk < NV; ++kk) { const int k = kk * KPI + ksub;
        const f32x4 v = vx[kk];
        const f32x4 pa = *(const LAS f32x4*)(PL + k * 8), pb = *(const LAS f32x4*)(PL + k * 8 + 4);
#pragma unroll
        for (int j = 0; j < 4; ++j) { w.o[0][j] += pa.x * v[j]; w.o[1][j] += pa.y * v[j]; w.o[2][j] += pa.z * v[j]; w.o[3][j] += pa.w * v[j];
                                      w.o[4][j] += pb.x * v[j]; w.o[5][j] += pb.y * v[j]; w.o[6][j] += pb.z * v[j]; w.o[7][j] += pb.w * v[j]; } }
}
__device__ __forceinline__ void dec_page_fox(DecW<64>& w, const bf16x8 (&qa)[2], const float* Kb, const float* Vb, const float* bias, float boff, LAS float* PL, int lane) {
    constexpr int stride = 512;
    const int key = lane & 15, kq = lane >> 4;
    const unsigned koff = (unsigned)(key * stride + 8 * kq) * 4u;
    const int d4 = lane & 15, ksub = lane >> 4;
    const unsigned voff = (unsigned)(ksub * stride + 4 * d4) * 4u;
    const __amdgpu_buffer_rsrc_t krs = __builtin_amdgcn_make_buffer_rsrc((void*)Kb, 0, 0x7fffffff, 0x00020000);
    const __amdgpu_buffer_rsrc_t vrs = __builtin_amdgcn_make_buffer_rsrc((void*)Vb, 0, 0x7fffffff, 0x00020000);
    const __amdgpu_buffer_rsrc_t brs = __builtin_amdgcn_make_buffer_rsrc((void*)bias, 0, 0x7fffffff, 0x00020000);
    f32x4 s[8];
#pragma unroll
    for (int hb = 0; hb < 2; ++hb) {
        f32x4 kx[4][4];
#pragma unroll
        for (int t = 0; t < 4; ++t) { const int so = (hb * 4 + t) * 16 * stride * 4;
            kx[t][0] = __builtin_bit_cast(f32x4, __builtin_amdgcn_raw_buffer_load_b128(krs, (int)koff, so, 0)); kx[t][1] = __builtin_bit_cast(f32x4, __builtin_amdgcn_raw_buffer_load_b128(krs, (int)koff + 16, so, 0));
            kx[t][2] = __builtin_bit_cast(f32x4, __builtin_amdgcn_raw_buffer_load_b128(krs, (int)koff + 128, so, 0)); kx[t][3] = __builtin_bit_cast(f32x4, __builtin_amdgcn_raw_buffer_load_b128(krs, (int)koff + 144, so, 0)); }
#pragma unroll
        for (int t = 0; t < 4; ++t) {
            f32x4 acc = {0.f, 0.f, 0.f, 0.f};
#pragma unroll
            for (int ks = 0; ks < 2; ++ks) { const f32x4 x0 = kx[t][2 * ks], x1 = kx[t][2 * ks + 1];
                v4u kb; kb.x = pg8::cvt_pk_bf16(x0.x, x0.y); kb.y = pg8::cvt_pk_bf16(x0.z, x0.w); kb.z = pg8::cvt_pk_bf16(x1.x, x1.y); kb.w = pg8::cvt_pk_bf16(x1.z, x1.w);
                acc = __builtin_amdgcn_mfma_f32_16x16x32_bf16(qa[ks], __builtin_bit_cast(bf16x8, kb), acc, 0, 0, 0); }
            acc += (__builtin_bit_cast(float, __builtin_amdgcn_raw_buffer_load_b32(brs, key * 4, (hb * 4 + t) * 64, 0)) + boff) * LOG2E;
            s[hb * 4 + t] = acc;
        }
        asm volatile("" ::: "memory");
    }
    f32x4 mc = s[0];
#pragma unroll
    for (int t = 1; t < 8; ++t) { mc.x = fmaxf(mc.x, s[t].x); mc.y = fmaxf(mc.y, s[t].y); mc.z = fmaxf(mc.z, s[t].z); mc.w = fmaxf(mc.w, s[t].w); }
    mc.x = max16_f32(mc.x); mc.y = max16_f32(mc.y); mc.z = max16_f32(mc.z); mc.w = max16_f32(mc.w);
    float al[4];
#pragma unroll
    for (int i = 0; i < 4; ++i) { const float mn = fmaxf(w.m[i], mc[i]); al[i] = fexp2(w.m[i] - mn); w.m[i] = mn; w.l[i] *= al[i]; }
    bool nz = false;
#pragma unroll
    for (int t = 0; t < 8; ++t) { f32x4 p;
#pragma unroll
        for (int i = 0; i < 4; ++i) { p[i] = fexp2(s[t][i] - w.m[i]); w.l[i] += p[i]; nz = nz || (p[i] != 0.f); }
        if (kq < 2) *(LAS f32x4*)(PL + (t * 16 + key) * 8 + 4 * kq) = p; }
    if (__ballot(nz && kq < 2) == 0ull) return;
    if (key == 0 && kq < 2) *(LAS f32x4*)(PL + 1024 + 4 * kq) = (f32x4){al[0], al[1], al[2], al[3]};
    { const f32x4 a0 = *(const LAS f32x4*)(PL + 1024), a1 = *(const LAS f32x4*)(PL + 1028);
#pragma unroll
      for (int j = 0; j < 4; ++j) { w.o[0][j] *= a0.x; w.o[1][j] *= a0.y; w.o[2][j] *= a0.z; w.o[3][j] *= a0.w; w.o[4][j] *= a1.x; w.o[5][j] *= a1.y; w.o[6][j] *= a1.z; w.o[7][j] *= a1.w; } }
#pragma unroll 1
    for (int vh = 0; vh < 2; ++vh) {
    f32x4 vx[16];
#pragma unroll
    for (int kk = 0; kk < 16; ++kk) vx[kk] = __builtin_bit_cast(f32x4, __builtin_amdgcn_raw_buffer_load_b128(vrs, (int)voff, (vh * 16 + kk) * 4 * stride * 4, 0));
#pragma unroll
    for (int kk = 0; kk < 16; ++kk) { const int k = (vh * 16 + kk) * 4 + ksub;
        const f32x4 v = vx[kk];
        const f32x4 pa = *(const LAS f32x4*)(PL + k * 8), pb = *(const LAS f32x4*)(PL + k * 8 + 4);
#pragma unroll
        for (int j = 0; j < 4; ++j) { w.o[0][j] += pa.x * v[j]; w.o[1][j] += pa.y * v[j]; w.o[2][j] += pa.z * v[j]; w.o[3][j] += pa.w * v[j];
                                      w.o[4][j] += pb.x * v[j]; w.o[5][j] += pb.y * v[j]; w.o[6][j] += pb.z * v[j]; w.o[7][j] += pb.w * v[j]; } }
    }
}
template <int D>
__device__ __forceinline__ void dec_park(DecW<D>& w, LAS float* CBw, int lane) {
    constexpr int LPK = D / 4;
    const int key = lane & 15, kq = lane >> 4, d4 = lane % LPK, ksub = lane / LPK;
#pragma unroll
    for (int i = 0; i < 4; ++i) { float l = w.l[i];
        l = sum16_f32(l);
        w.l[i] = l; }
    if (key == 0 && kq < 2) { *(LAS f32x4*)(CBw + 4 * kq) = (f32x4){w.m[0], w.m[1], w.m[2], w.m[3]}; *(LAS f32x4*)(CBw + 8 + 4 * kq) = (f32x4){w.l[0], w.l[1], w.l[2], w.l[3]}; }
#pragma unroll
    for (int q = 0; q < 8; ++q) { f32x4 v = (f32x4){w.o[q][0], w.o[q][1], w.o[q][2], w.o[q][3]};
        if (LPK < 64) {
#pragma unroll
            for (int o = LPK; o < 64; o <<= 1) { if (o == 16) { v.x += xor16_f32(v.x); v.y += xor16_f32(v.y); v.z += xor16_f32(v.z); v.w += xor16_f32(v.w); }
                else { v.x += __shfl_xor(v.x, o); v.y += __shfl_xor(v.y, o); v.z += __shfl_xor(v.z, o); v.w += __shfl_xor(v.w, o); } } }
        if (ksub == 0) *(LAS f32x4*)(CBw + 16 + q * D + 4 * d4) = v; }
}
template <int D>
__device__ __forceinline__ void dec_combine(int tid, LAS float* CB, bf16* dst, int ldd) {
    constexpr int WSTR = 16 + 8 * D;
    for (int e = tid; e < 8 * D; e += NTHR) { const int q = e / D, d = e % D;
        float mt = -INFINITY;
#pragma unroll
        for (int w = 0; w < 8; ++w) mt = fmaxf(mt, CB[w * WSTR + q]);
        float num = 0.f, den = 0.f;
#pragma unroll
        for (int w = 0; w < 8; ++w) { const float mw = CB[w * WSTR + q]; const float f = (mw == -INFINITY) ? 0.f : fexp2(mw - mt); num += f * CB[w * WSTR + 16 + q * D + d]; den += f * CB[w * WSTR + 8 + q]; }
        dst[(size_t)q * ldd + d] = (bf16)f2bf(num / den); }
}
template <int D>
__device__ __forceinline__ void dec_load_q(bf16x8 (&qa)[D / 32], const bf16* Q, int ldq, int lane) {
    const int row = lane & 15, kq = lane >> 4;
#pragma unroll
    for (int ks = 0; ks < D / 32; ++ks) { v4u z = {0u, 0u, 0u, 0u}; if (row < 8) z = *(const v4u*)(Q + (size_t)row * ldq + 32 * ks + 8 * kq); qa[ks] = __builtin_bit_cast(bf16x8, z); }
}
constexpr int DEC_PL = 1040;
__device__ __forceinline__ void fox_sample_unit(const Frame& F, const Args& a, int u) {
    unsigned char* ws = a.ws; const int bs = u >> 3, h = u & 7;
    int ln = lane_id(); asm volatile("" : "+v"(ln));
    LAS float* PL = (LAS float*)F.lds + F.wave * DEC_PL; LAS float* CB = (LAS float*)F.lds + 8 * DEC_PL; constexpr int WSTR = 16 + 8 * 64;
    bf16x8 qa[2]; dec_load_q<64>(qa, (const bf16*)(ws + WS_QF) + (size_t)(TP + bs * LS) * 512 + h * 64, 512, ln);
    DecW<64> w; dec_init(w);
    {
        const int key = ln & 15; const float* lf = a.out + O_LFS + (size_t)(bs * LS) * 8 + h; float cn = 0.f;
#pragma unroll
        for (int j = 0; j < 8; ++j) { const float x = lf[j * 8]; cn += (j <= key) ? x : 0.f; }
        const float* Kb = a.out + O_FKS + (size_t)(bs * LS) * 512 + h * 64; const float* Vb = a.out + O_FVS + (size_t)(bs * LS) * 512 + h * 64;
        dec_chunk<64, 1, 1>(w, qa, Kb, Vb, 512, nullptr, -cn * LOG2E, PL, ln);
        if (F.wave != 0) {
#pragma unroll
            for (int i = 0; i < 4; ++i) w.l[i] = 0.f;
#pragma unroll
            for (int q = 0; q < 8; ++q)
#pragma unroll
                for (int j = 0; j < 4; ++j) w.o[q][j] = 0.f; }
    }
    const int* pt = (const int*)a.in[I_PT];
    float spx; { const float ptv = (ln < 16) ? ((const float*)(ws + WS_MISC + 2 * MiB))[(bs * 8 + h) * NPAGES + ln] : 0.f; float v = ptv;
#pragma unroll
        for (int o = 1; o < 16; o <<= 1) { const float t = __builtin_bit_cast(float, __builtin_amdgcn_ds_bpermute((ln + o) << 2, __builtin_bit_cast(int, v))); if (ln + o < 16) v += t; }
        spx = v - ptv; }
#if defined(OLD_FOXS)
#pragma unroll 1
    for (int pp = 0; pp < 4; ++pp) { const int p = F.wave * 2 + (pp >> 1), hf = pp & 1; const int pg = __builtin_amdgcn_readfirstlane(pt[bs * NPAGES + p]);
        const float* Kb = (const float*)a.in[I_CFK] + (((size_t)pg * PAGE + hf * 64) * 8 + h) * 64; const float* Vb = (const float*)a.in[I_CFV] + (((size_t)pg * PAGE + hf * 64) * 8 + h) * 64;
        dec_chunk<64, 4, 0>(w, qa, Kb, Vb, 512, (const float*)(ws + WS_SUF) + (size_t)(bs * 8 + h) * PASTL + p * PAGE + hf * 64, __builtin_bit_cast(float, __builtin_amdgcn_ds_bpermute(p << 2, __builtin_bit_cast(int, spx))), PL, ln); }
#else
#pragma unroll 1
    for (int pp = 1; pp >= 0; --pp) { const int p = pp ? (NPAGES - 1 - F.wave) : F.wave;
        const int pg = __builtin_amdgcn_readfirstlane(pt[bs * NPAGES + p]);
        const float* Kb = (const float*)a.in[I_CFK] + ((size_t)pg * PAGE * 8 + h) * 64; const float* Vb = (const float*)a.in[I_CFV] + ((size_t)pg * PAGE * 8 + h) * 64;
        dec_page_fox(w, qa, Kb, Vb, (const float*)(ws + WS_SUF) + (size_t)(bs * 8 + h) * PASTL + p * PAGE, __builtin_bit_cast(float, __builtin_amdgcn_ds_bpermute(p << 2, __builtin_bit_cast(int, spx))), PL, ln); }
#endif
    dec_park<64>(w, CB + F.wave * WSTR, ln);
    __syncthreads();
    dec_combine<64>(F.wave * 64 + ln, CB, (bf16*)(ws + WS_MERGED) + (size_t)(TP + bs * LS) * DM + h * 64, DM);
    __syncthreads();
}
__device__ __forceinline__ void cross_sample_unit(const Frame& F, const Args& a, int u) {
    unsigned char* ws = a.ws; const int bs = u >> 2, h = u & 3;
    LAS float* PL = (LAS float*)F.lds + F.wave * DEC_PL; LAS float* CB = (LAS float*)F.lds + 8 * DEC_PL; constexpr int WSTR = 16 + 8 * 256;
    bf16x8 qa[8]; dec_load_q<256>(qa, (const bf16*)(ws + WS_QC) + (size_t)(TP + bs * LS) * DM + h * 256, DM, F.lane);
    DecW<256> w; dec_init(w);
    const float* Kb = (const float*)a.in[I_CMK] + ((size_t)(bs * 256 + F.wave * 32) * 4 + h) * 256; const float* Vb = (const float*)a.in[I_CMV] + ((size_t)(bs * 256 + F.wave * 32) * 4 + h) * 256;
#pragma unroll 1
    for (int c = 0; c < 2; ++c) dec_chunk<256, 1, 0>(w, qa, Kb + (size_t)c * 16 * 1024, Vb + (size_t)c * 16 * 1024, 1024, nullptr, 0.f, PL, F.lane);
    dec_park<256>(w, CB + F.wave * WSTR, F.lane);
    __syncthreads();
    dec_combine<256>(F.tid, CB, (bf16*)(ws + WS_OC) + (size_t)(TP + bs * LS) * DM + h * 256, DM);
    __syncthreads();
}


__device__ __forceinline__ void gla_g3_unit(const Frame& F, const Args& a, int u) {
    unsigned char* ws = a.ws;
    const int b = u >> 9, h = (u >> 7) & 3, n = u & 127; const int row0 = b * SEQ + n * 64;
    LAS unsigned char* KIB = F.lds; LAS unsigned char* ATTB = F.lds + 34816; LAS unsigned char* QDB = F.lds + 44032;
    LAS unsigned char* VSB = F.lds + 53248; LAS unsigned char* SPB = F.lds + 73728; LAS float* OS = (LAS float*)(F.lds + 94208);
#pragma unroll
    for (int i = 0; i < 2; ++i) { const int c = F.tid + NTHR * i; *(LAS v4u*)(VSB + (c >> 4) * 320 + (c & 15) * 16) = *(const v4u*)((const bf16*)(ws + WS_GV) + (size_t)(row0 + (c >> 4)) * 512 + h * 128 + (c & 15) * 8); }
#pragma unroll
    for (int i = 0; i < 4; ++i) { const int c4 = F.tid + NTHR * i; const f32x4 sp = *(const f32x4*)((const float*)(ws + WS_GKV) + ((size_t)((b * 4 + h) * 128 + n) * 64) * 128 + 4 * c4);
        v2u o; o.x = pg8::cvt_pk_bf16(sp.x, sp.y); o.y = pg8::cvt_pk_bf16(sp.z, sp.w); *(LAS v2u*)(SPB + (c4 >> 5) * 320 + (c4 & 31) * 8) = o; }
#pragma unroll
    for (int i = 0; i < 2; ++i) { const int c4 = F.tid + NTHR * i, t = c4 >> 4, d4 = (c4 & 15) * 4; const size_t gi = (size_t)(row0 + t) * 256 + h * 64 + d4;
        const f32x4 bb = *(const f32x4*)((const float*)(ws + WS_BB) + gi);
        const v2u qq = *(const v2u*)((const bf16*)(ws + WS_GQ) + gi), kk = *(const v2u*)((const bf16*)(ws + WS_GK) + gi);
        v2u qo, ko; qo.x = pg8::cvt_pk_bf16(bflo(qq.x) * __expf(bb.x), bfhi(qq.x) * __expf(bb.y)); qo.y = pg8::cvt_pk_bf16(bflo(qq.y) * __expf(bb.z), bfhi(qq.y) * __expf(bb.w));
        ko.x = pg8::cvt_pk_bf16(bflo(kk.x) * __expf(-bb.x), bfhi(kk.x) * __expf(-bb.y)); ko.y = pg8::cvt_pk_bf16(bflo(kk.y) * __expf(-bb.z), bfhi(kk.y) * __expf(-bb.w));
        *(LAS v2u*)(QDB + t * 144 + d4 * 2) = qo; *(LAS v2u*)(KIB + t * 144 + d4 * 2) = ko; }
    __syncthreads();
    {
        const int lane = F.lane, r32 = lane & 31, hi = lane >> 5;
        if (F.wave < 4) { const int tb = F.wave >> 1, sb = F.wave & 1; f32x16 acc = {};
            if (sb <= tb) {
                const LAS unsigned char* qrow = QDB + (32 * tb + r32) * 144; const LAS unsigned char* krow = KIB + (32 * sb + r32) * 144;
#pragma unroll
                for (int ks = 0; ks < 4; ++ks) acc = __builtin_amdgcn_mfma_f32_32x32x16_bf16(row_frag(qrow, ks, hi), row_frag(krow, ks, hi), acc, 0, 0, 0);
            }
#pragma unroll
            for (int r = 0; r < 16; ++r) { const int t = 32 * tb + crow(r, hi), s2 = 32 * sb + r32; *(LAS unsigned short*)(ATTB + t * 144 + s2 * 2) = (unsigned short)f2bf(s2 <= t ? acc[r] : 0.f); }
        }
    }
    __syncthreads();
    {
        const int lane = F.lane, r32 = lane & 31, hi = lane >> 5, tb = F.wave >> 2, nb = F.wave & 3;
        const int trb = (4 * hi + ((lane & 15) >> 2)) * 320 + (16 * ((lane >> 4) & 1) + 4 * (lane & 3)) * 2 + 64 * nb;
        const LAS unsigned char* arow = ATTB + (32 * tb + r32) * 144; const LAS unsigned char* qrow = QDB + (32 * tb + r32) * 144;
        f32x16 acc = {};
#pragma unroll
        for (int ks = 0; ks < 4; ++ks) acc = __builtin_amdgcn_mfma_f32_32x32x16_bf16(row_frag(arow, ks, hi), tr_frag<320>(VSB + trb, ks), acc, 0, 0, 0);
#pragma unroll
        for (int ks = 0; ks < 4; ++ks) acc = __builtin_amdgcn_mfma_f32_32x32x16_bf16(row_frag(qrow, ks, hi), tr_frag<320>(SPB + trb, ks), acc, 0, 0, 0);
#pragma unroll
        for (int r = 0; r < 16; ++r) OS[(32 * tb + crow(r, hi)) * 128 + 32 * nb + r32] = acc[r];
    }
    __syncthreads();
#pragma unroll
    for (int rr = 0; rr < 8; ++rr) { const int t = F.wave * 8 + rr; const float v0 = OS[t * 128 + F.lane], v1 = OS[t * 128 + 64 + F.lane];
        const float r = rsqrtf(wave_sum(v0 * v0 + v1 * v1) * (1.f / 128.f) + EPS);
        const float* ggo = (const float*)a.in[I_GGO] + h * 128; const BfPtr gr = GLD(ws + WS_GR) + ((size_t)(row0 + t) * 512 + h * 128);
        bf16* mo = (bf16*)(ws + WS_MERGED) + (size_t)(row0 + t) * DM + 512 + h * 128;
        mo[F.lane] = (bf16)f2bf(v0 * r * ggo[F.lane] * silu(gr[F.lane])); mo[64 + F.lane] = (bf16)f2bf(v1 * r * ggo[64 + F.lane] * silu(gr[64 + F.lane])); }
    __syncthreads();
}

struct EpiSoftmaxP {
    static constexpr bool PERM = false, AFTER_DRAIN = true;
    const LAS unsigned long long* argp;
    __device__ __forceinline__ void fused(f32x4 (&acc)[2][2][4][2], const Unit&, int wr, int wc, int fr, int fq, PG8_LAS unsigned char* lds, int wid, int lane) const {
        LAS float* PM = (LAS float*)lds; LAS float* PS = PM + 1024;
        const int ub = (int)blockIdx.x; const int ldp = DM;
        bf16* P = (bf16*)((unsigned char*)ld_ptr(argp + N_INPUTS + 1) + WS_PC) + ((size_t)((ub >> 7) & 1) * SEQ + (ub & 31) * 256) * DM + ((ub >> 5) & 3) * 256;
        { int t2 = lane_id(); asm volatile("" : "+v"(t2)); fr = t2 & 15; fq = (t2 >> 4) & 3; }
#pragma unroll
        for (int ai = 0; ai < 2; ++ai)
#pragma unroll
            for (int m = 0; m < 4; ++m) { float mx = -INFINITY;
#pragma unroll
                for (int bj = 0; bj < 2; ++bj)
#pragma unroll
                    for (int n = 0; n < 2; ++n) { const f32x4 x = acc[ai][bj][m][n]; mx = fmaxf(mx, fmaxf(fmaxf(x[0], x[1]), fmaxf(x[2], x[3]))); }
                mx = fmaxf(mx, xor16_f32(mx)); mx = fmaxf(mx, __shfl_xor(mx, 32));
                if (fq == 0) PM[(ai * 128 + wr * 64 + m * 16 + fr) * 4 + wc] = mx; }
        asm volatile("s_waitcnt lgkmcnt(0)" ::: "memory"); __builtin_amdgcn_s_barrier(); asm volatile("" ::: "memory");
#pragma unroll
        for (int ai = 0; ai < 2; ++ai)
#pragma unroll
            for (int m = 0; m < 4; ++m) { const int r = ai * 128 + wr * 64 + m * 16 + fr; const f32x4 pm = *(const LAS f32x4*)(PM + r * 4);
                const float M = fmaxf(fmaxf(pm[0], pm[1]), fmaxf(pm[2], pm[3])); float s = 0.f;
#pragma unroll
                for (int bj = 0; bj < 2; ++bj)
#pragma unroll
                    for (int n = 0; n < 2; ++n) { f32x4 x = acc[ai][bj][m][n]; x[0] = fexp2(x[0] - M); x[1] = fexp2(x[1] - M); x[2] = fexp2(x[2] - M); x[3] = fexp2(x[3] - M); acc[ai][bj][m][n] = x; s += (x[0] + x[1]) + (x[2] + x[3]); }
                s += xor16_f32(s); s += __shfl_xor(s, 32);
                if (fq == 0) PS[r * 4 + wc] = s; }
        asm volatile("s_waitcnt lgkmcnt(0)" ::: "memory"); __builtin_amdgcn_s_barrier(); asm volatile("" ::: "memory");
#pragma unroll
        for (int ai = 0; ai < 2; ++ai)
#pragma unroll
            for (int m = 0; m < 4; ++m) { const int r = ai * 128 + wr * 64 + m * 16 + fr; const f32x4 ps = *(const LAS f32x4*)(PS + r * 4); const float inv = 1.f / ((ps[0] + ps[1]) + (ps[2] + ps[3]));
#pragma unroll
                for (int bj = 0; bj < 2; ++bj)
#pragma unroll
                    for (int n = 0; n < 2; ++n) { const f32x4 x = acc[ai][bj][m][n]; v2u o; o.x = pg8::cvt_pk_bf16(x[0] * inv, x[1] * inv); o.y = pg8::cvt_pk_bf16(x[2] * inv, x[3] * inv);
                        *(v2u*)(P + (size_t)r * ldp + bj * 128 + wc * 32 + n * 16 + fq * 4) = o; } }
        asm volatile("s_waitcnt lgkmcnt(0)" ::: "memory"); __builtin_amdgcn_s_barrier(); asm volatile("" ::: "memory");
    }
};

__device__ __forceinline__ void rms_rows_phase(const Frame& F, const float* X, const float* g, bf16* H) {
    const int gw = F.vcu * NWAVES + F.wave, NGW = F.G * NWAVES;
    for (int m = gw; m < TA; m += NGW) rms_row_bf16(X + (size_t)m * DM, g, H + (size_t)m * DM, F.lane);
}

__device__ __forceinline__ unsigned f2sort(float f) { const unsigned u = __builtin_bit_cast(unsigned, f); return u ^ ((u >> 31) ? 0xFFFFFFFFu : 0x80000000u); }
__device__ __forceinline__ float sort2f(unsigned s) { const unsigned u = s ^ ((s >> 31) ? 0x80000000u : 0xFFFFFFFFu); return __builtin_bit_cast(float, u); }
__device__ __forceinline__ float gelu_tanh(float x) { const float y = 0.7978845608028654f * (x + 0.044715f * x * x * x); const float e = __expf(2.f * y); return 0.5f * x * (1.f + (1.f - 2.f / (e + 1.f))); }
__device__ __forceinline__ unsigned gmax16(unsigned v) { return max16_u32(v); }
typedef __bf16 bf16x2_t __attribute__((ext_vector_type(2)));
__device__ __forceinline__ float dot2bf(unsigned a, unsigned b, float c) {
#if __has_builtin(__builtin_amdgcn_fdot2_f32_bf16)
    return __builtin_amdgcn_fdot2_f32_bf16(__builtin_bit_cast(bf16x2_t, a), __builtin_bit_cast(bf16x2_t, b), c, false);
#else
    return c + bflo(a) * bflo(b) + bfhi(a) * bfhi(b);
#endif
}
template <bool SPLIT>
__device__ __forceinline__ void peer_token(const Frame& F, const Args& a, int row, LAS unsigned* TOPS, const LAS unsigned* CT, int half, LAS float* PART) {
    unsigned char* ws = a.ws; const int lane = lane_id(), grp = lane >> 4, j16 = lane & 15;
    const bf16* sc = (const bf16*)(ws + WS_SC) + (size_t)row * 2048;
#pragma unroll 1
    for (int bt = 0; bt < 4; ++bt) {
        const v4u xq = *(const v4u*)(sc + (bt * 4 + grp) * 128 + 8 * j16);
        unsigned k[8]; const float xs[8] = {bflo(xq.x), bfhi(xq.x), bflo(xq.y), bfhi(xq.y), bflo(xq.z), bfhi(xq.z), bflo(xq.w), bfhi(xq.w)};
#pragma unroll
        for (int e = 0; e < 8; ++e) k[e] = (f2sort(xs[e]) & ~127u) | (unsigned)(127 - (8 * j16 + e));
        unsigned mine = 0u;
#pragma unroll 1
        for (int r = 0; r < 16; ++r) {
            unsigned m = k[0];
#pragma unroll
            for (int e = 1; e < 8; ++e) m = m > k[e] ? m : k[e];
            m = gmax16(m);
            if (j16 == r) mine = m;
#pragma unroll
            for (int e = 0; e < 8; ++e) k[e] = (k[e] == m) ? 0u : k[e];
        }
        TOPS[(bt * 4 + grp) * 16 + j16] = mine;
    }
    int ex[2]; float gx[2], sux[2];
#pragma unroll
    for (int ps = 0; ps < 2; ++ps) {
        const int hd = ps * 4 + grp; const LAS unsigned* T1 = TOPS + (2 * hd) * 16; const LAS unsigned* T2 = T1 + 16;
        const unsigned c0_ = CT[j16], c1_ = CT[j16 + 16], c2_ = CT[j16 + 32], c3_ = CT[j16 + 48];
        const int ci0 = c0_ & 255, cj0 = c0_ >> 8, ci1 = c1_ & 255, cj1 = c1_ >> 8, ci2 = c2_ & 255, cj2 = c2_ >> 8, ci3 = c3_ & 255, cj3 = c3_ >> 8; const bool cv3 = (j16 + 48) < 50;
        unsigned k[4];
        { const float s0 = sort2f(T1[ci0] & ~127u) + sort2f(T2[cj0] & ~127u), s1 = sort2f(T1[ci1] & ~127u) + sort2f(T2[cj1] & ~127u),
                      s2 = sort2f(T1[ci2] & ~127u) + sort2f(T2[cj2] & ~127u), s3 = sort2f(T1[ci3] & ~127u) + sort2f(T2[cj3] & ~127u);
          k[0] = (f2sort(s0) & ~127u) | (unsigned)(127 - j16); k[1] = (f2sort(s1) & ~127u) | (unsigned)(127 - (j16 + 16)); k[2] = (f2sort(s2) & ~127u) | (unsigned)(127 - (j16 + 32));
          k[3] = cv3 ? ((f2sort(s3) & ~127u) | (unsigned)(127 - (j16 + 48))) : 0u; }
        unsigned mine = 0u;
#pragma unroll 1
        for (int r = 0; r < 16; ++r) {
            unsigned m = k[0] > k[1] ? k[0] : k[1]; const unsigned m2 = k[2] > k[3] ? k[2] : k[3]; m = m > m2 ? m : m2;
            m = gmax16(m);
            if (j16 == r) mine = m;
#pragma unroll
            for (int e = 0; e < 4; ++e) k[e] = (k[e] == m) ? 0u : k[e];
        }
        const int c = 127 - (int)(mine & 127u);
        int ci, cj;
        if (c < 16) { ci = 0; cj = c; } else if (c < 24) { ci = 1; cj = c - 16; } else if (c < 29) { ci = 2; cj = c - 24; } else if (c < 33) { ci = 3; cj = c - 29; }
        else if (c < 36) { ci = 4; cj = c - 33; } else if (c < 38) { ci = 5; cj = c - 36; } else if (c < 40) { ci = 6; cj = c - 38; } else if (c < 42) { ci = 7; cj = c - 40; } else { ci = c - 34; cj = 0; }
        const int i1 = 127 - (int)(T1[ci] & 127u), i2 = 127 - (int)(T2[cj] & 127u);
        ex[ps] = i1 * 128 + i2;
        const float sv = sort2f(mine & ~127u); const float s0 = __shfl(sv, lane & 48);
        float ee = __expf(sv - s0); const float es = sum16_f32(ee);
        const float* rsc = (const float*)(ws + WS_MISC);
        sux[ps] = rsc[ex[ps]]; gx[ps] = ee / es * rsc[16384 + ex[ps]];
    }
    {
        unsigned k0 = ((unsigned)ex[0] << 7) | (unsigned)lane, k1 = ((unsigned)ex[1] << 7) | (unsigned)(64 + lane);
#pragma unroll
        for (int k = 2; k <= 128; k <<= 1) {
#pragma unroll
            for (int j = k >> 1; j > 0; j >>= 1) {
                if (j == 64) { const unsigned lo = k0 < k1 ? k0 : k1, hi = k0 < k1 ? k1 : k0; k0 = lo; k1 = hi; }
                else {
                    unsigned p0, p1;
                    if (j == 32) { p0 = (unsigned)__shfl_xor((int)k0, 32); p1 = (unsigned)__shfl_xor((int)k1, 32); }
                    else if (j == 16) { p0 = xchg_xor_u32<16>(k0); p1 = xchg_xor_u32<16>(k1); } else if (j == 8) { p0 = xchg_xor_u32<8>(k0); p1 = xchg_xor_u32<8>(k1); }
                    else if (j == 4) { p0 = xchg_xor_u32<4>(k0); p1 = xchg_xor_u32<4>(k1); } else if (j == 2) { p0 = xchg_xor_u32<2>(k0); p1 = xchg_xor_u32<2>(k1); }
                    else { p0 = xchg_xor_u32<1>(k0); p1 = xchg_xor_u32<1>(k1); }
                    const bool low = (lane & j) == 0; const bool asc0 = (lane & k) == 0, asc1 = ((64 + lane) & k) == 0;
                    const unsigned mn0 = k0 < p0 ? k0 : p0, mx0 = k0 < p0 ? p0 : k0, mn1 = k1 < p1 ? k1 : p1, mx1 = k1 < p1 ? p1 : k1;
                    k0 = (low == asc0) ? mn0 : mx0; k1 = (low == asc1) ? mn1 : mx1;
                }
            }
        }
        const int o0 = (int)(k0 & 127u), o1 = (int)(k1 & 127u);
        const float g0a = __shfl(gx[0], o0 & 63), g0b = __shfl(gx[1], o0 & 63), g1a = __shfl(gx[0], o1 & 63), g1b = __shfl(gx[1], o1 & 63);
        const float s0a = __shfl(sux[0], o0 & 63), s0b = __shfl(sux[1], o0 & 63), s1a = __shfl(sux[0], o1 & 63), s1b = __shfl(sux[1], o1 & 63);
        gx[0] = (o0 & 64) ? g0b : g0a; gx[1] = (o1 & 64) ? g1b : g1a; sux[0] = (o0 & 64) ? s0b : s0a; sux[1] = (o1 & 64) ? s1b : s1a;
        ex[0] = (int)(k0 >> 7); ex[1] = (int)(k1 >> 7);
    }
    const float rstd2 = rsqrtf(((const float*)(ws + WS_SS))[TA + row] * (1.f / 1024.f) + EPS);
    float hf[16];
    { const bf16* hb = (const bf16*)(ws + WS_HB) + (size_t)row * DM + 4 * lane;
#pragma unroll
      for (int q = 0; q < 4; ++q) { const v2u hq = *(const v2u*)(hb + 256 * q); hf[4 * q] = bflo(hq.x); hf[4 * q + 1] = bfhi(hq.x); hf[4 * q + 2] = bflo(hq.y); hf[4 * q + 3] = bfhi(hq.y); } }
    float oacc[16];
#pragma unroll
    for (int i = 0; i < 16; ++i) oacc[i] = 0.f;
    const unsigned char* U = ws + WS_U16; const unsigned char* V = ws + WS_V16;
    v4u ub[8], vbA[8], vbB[8];
    const int gbeg = SPLIT ? 8 * half : 0, gend = SPLIT ? 8 * half + 8 : 16;
    const int addr32 = (lane ^ 32) << 2;
#define PEER_LOAD(buf, TAB, g) do { const int kk_ = (g) * 8; const int exs_ = (kk_ < 64) ? ex[0] : ex[1]; \
        _Pragma("unroll") for (int i = 0; i < 8; ++i) { const int e_ = __builtin_amdgcn_readlane(exs_, (kk_ & 63) + i); buf[i] = *(const v4u*)(TAB + (size_t)e_ * DM + 16 * lane); } } while (0)
#define PEER_DOTS(buf, g, wout) do { const int kk_ = (g) * 8; const float gxs_ = (kk_ < 64) ? gx[0] : gx[1]; const float sus_ = (kk_ < 64) ? sux[0] : sux[1]; float av[8]; \
        _Pragma("unroll") for (int i = 0; i < 8; ++i) { float s = 0.f; \
            _Pragma("unroll") for (int q = 0; q < 4; ++q) { const f32x2 lo = __builtin_amdgcn_cvt_pk_f32_fp8((int)buf[i][q], false), hi = __builtin_amdgcn_cvt_pk_f32_fp8((int)buf[i][q], true); \
                s += lo.x * hf[4 * q]; s += lo.y * hf[4 * q + 1]; s += hi.x * hf[4 * q + 2]; s += hi.y * hf[4 * q + 3]; } \
            av[i] = s; } \
        const bool b5 = lane & 32, b4 = lane & 16, b3_ = lane & 8; float bq[4], cq[2], dq; \
        _Pragma("unroll") for (int i = 0; i < 4; ++i) bq[i] = (b5 ? av[4 + i] : av[i]) + __builtin_bit_cast(float, __builtin_amdgcn_ds_bpermute(addr32, __builtin_bit_cast(int, b5 ? av[i] : av[4 + i])));     \
        _Pragma("unroll") for (int i = 0; i < 2; ++i) cq[i] = (b4 ? bq[2 + i] : bq[i]) + xor16_f32(b4 ? bq[i] : bq[2 + i]); \
        dq = (b3_ ? cq[1] : cq[0]) + DPP_F(b3_ ? cq[0] : cq[1], DPP_MIR);        \
        dq = sum8_f32(dq); \
        const int src = (kk_ & 63) + (lane >> 3); \
        wout = __shfl(gxs_, src) * gelu_tanh(dq * __shfl(sus_, src) * rstd2); } while (0)
#define PEER_ACC(buf, wv) do { _Pragma("unroll") for (int i = 0; i < 8; ++i) { const float w = __builtin_bit_cast(float, __builtin_amdgcn_readlane(__builtin_bit_cast(int, wv), 8 * i)); \
        _Pragma("unroll") for (int q = 0; q < 4; ++q) { const f32x2 lo = __builtin_amdgcn_cvt_pk_f32_fp8((int)buf[i][q], false), hi = __builtin_amdgcn_cvt_pk_f32_fp8((int)buf[i][q], true); \
            oacc[4 * q] += w * lo.x; oacc[4 * q + 1] += w * lo.y; oacc[4 * q + 2] += w * hi.x; oacc[4 * q + 3] += w * hi.y; } } } while (0)
    PEER_LOAD(ub, U, gbeg); PEER_LOAD(vbA, V, gbeg);
#pragma unroll 1
    for (int g0 = gbeg; g0 < gend; g0 += 2) {
        float w0, w1;
        PEER_DOTS(ub, g0, w0);
        PEER_LOAD(ub, U, g0 + 1); PEER_LOAD(vbB, V, g0 + 1);
        PEER_ACC(vbA, w0);
        PEER_DOTS(ub, g0 + 1, w1);
        { const int gn = (g0 + 2 < gend) ? g0 + 2 : g0 + 1;
          PEER_LOAD(ub, U, gn); PEER_LOAD(vbA, V, gn); }
        PEER_ACC(vbB, w1);
    }
#undef PEER_LOAD
#undef PEER_DOTS
#undef PEER_ACC
    if (SPLIT) {
        if (half == 1) {
#pragma unroll
            for (int q = 0; q < 4; ++q) *(LAS f32x4*)(PART + 16 * lane + 4 * q) = (f32x4){oacc[4 * q], oacc[4 * q + 1], oacc[4 * q + 2], oacc[4 * q + 3]}; }
        __syncthreads();
        if (half == 1) return;
#pragma unroll
        for (int q = 0; q < 4; ++q) { const f32x4 p = *(const LAS f32x4*)(PART + 16 * lane + 4 * q); oacc[4 * q] += p.x; oacc[4 * q + 1] += p.y; oacc[4 * q + 2] += p.z; oacc[4 * q + 3] += p.w; }
    }
    asm volatile("" : "+s"(row)); const int lane2 = lane_id();
    const f32x4* x2 = (const f32x4*)((const float*)(ws + WS_X2) + (size_t)row * DM) + lane2;
    f32x4 xv[4]; float ss = 0.f;
#pragma unroll
    for (int q = 0; q < 4; ++q) { xv[q] = x2[64 * q]; xv[q].x += oacc[4 * q]; xv[q].y += oacc[4 * q + 1]; xv[q].z += oacc[4 * q + 2]; xv[q].w += oacc[4 * q + 3]; ss += (xv[q].x * xv[q].x + xv[q].y * xv[q].y) + (xv[q].z * xv[q].z + xv[q].w * xv[q].w); }
    const float r = rsqrtf(wave_sum(ss) * (1.f / DM) + EPS);
    const f32x4* gf = (const f32x4*)((const float*)a.in[I_GFIN]) + lane2;
    f32x4* y = (f32x4*)(row < TP ? a.out + O_YP + (size_t)row * DM : a.out + O_YS + (size_t)(row - TP) * DM) + lane2;
#pragma unroll
    for (int q = 0; q < 4; ++q) { const f32x4 g4 = gf[64 * q]; f32x4 o; o.x = xv[q].x * r * g4.x; o.y = xv[q].y * r * g4.y; o.z = xv[q].z * r * g4.z; o.w = xv[q].w * r * g4.w; y[64 * q] = o; }
}
__device__ __forceinline__ void cand_ij(int c, int& ci, int& cj) {
    if (c < 16) { ci = 0; cj = c; } else if (c < 24) { ci = 1; cj = c - 16; } else if (c < 29) { ci = 2; cj = c - 24; } else if (c < 33) { ci = 3; cj = c - 29; }
    else if (c < 36) { ci = 4; cj = c - 33; } else if (c < 38) { ci = 5; cj = c - 36; } else if (c < 40) { ci = 6; cj = c - 38; } else if (c < 42) { ci = 7; cj = c - 40; } else if (c < 50) { ci = c - 34; cj = 0; } else { ci = 0; cj = 0; }
}
__device__ __forceinline__ void peer_phase(const Frame& F, const Args& a) {
    LAS unsigned* TOPS = (LAS unsigned*)F.lds + F.wave * 256;
    LAS unsigned* CT = (LAS unsigned*)F.lds + 8 * 256 + 4 * 1024;
    if (F.tid < 64) { int ci, cj; cand_ij(F.tid, ci, cj); CT[F.tid] = (unsigned)ci | ((unsigned)cj << 8); }
    __syncthreads();
    const int gw = F.vcu * NWAVES + F.wave, NGW = F.G * NWAVES;
    const int nfull = TA / NGW, rem = TA - nfull * NGW;
#pragma unroll 1
    for (int i = 0; i < nfull; ++i) peer_token<false>(F, a, gw + i * NGW, TOPS, CT, 0, nullptr);
    if (rem == 4 * F.G) {
        __syncthreads();
        peer_token<true>(F, a, nfull * NGW + F.vcu * 4 + (F.wave >> 1), TOPS, CT, F.wave & 1, (LAS float*)F.lds + 8 * 256 + (F.wave >> 1) * 1024);
    } else {
        const int row = gw + nfull * NGW; if (row < TA) peer_token<false>(F, a, row, TOPS, CT, 0, nullptr);
    }
}


template <class EpiS>
__device__ __forceinline__ void skinny_tile(const Frame& F, const bf16* A, int lda, const bf16* Bt, int ldb, int tm, int tn, const EpiS& E) {
    const int lane = F.lane, fr = lane & 15, fq = lane >> 4, w = F.wave;
    const bf16* ap = A + (size_t)(tm * 64 + fr) * lda + w * 128 + 8 * fq;
    const bf16* bp = Bt + (size_t)(tn * 64 + fr) * ldb + w * 128 + 8 * fq;
    v4u af[4][4], bfr[4][4];
#pragma unroll
    for (int m = 0; m < 4; ++m)
#pragma unroll
        for (int ks = 0; ks < 4; ++ks) { af[m][ks] = *(const v4u*)(ap + (size_t)(16 * m) * lda + ks * 32); bfr[m][ks] = *(const v4u*)(bp + (size_t)(16 * m) * ldb + ks * 32); }
    f32x4 acc[4][4];
#pragma unroll
    for (int m = 0; m < 4; ++m)
#pragma unroll
        for (int n = 0; n < 4; ++n) acc[m][n] = (f32x4){0.f, 0.f, 0.f, 0.f};
#pragma unroll
    for (int ks = 0; ks < 4; ++ks)
#pragma unroll
        for (int m = 0; m < 4; ++m)
#pragma unroll
            for (int n = 0; n < 4; ++n) acc[m][n] = __builtin_amdgcn_mfma_f32_16x16x32_bf16(__builtin_bit_cast(bf16x8, bfr[n][ks]), __builtin_bit_cast(bf16x8, af[m][ks]), acc[m][n], 0, 0, 0);
    LAS float* PS = (LAS float*)F.lds + w * 4096;
#pragma unroll
    for (int m = 0; m < 4; ++m)
#pragma unroll
        for (int n = 0; n < 4; ++n) *(LAS f32x4*)(PS + (16 * m + fr) * 64 + 4 * ((4 * n + fq) ^ fr)) = acc[m][n];
    lds_barrier();
    {
        const int row = F.tid >> 3, c8 = (F.tid & 7) * 8; const LAS float* PR = (const LAS float*)F.lds + row * 64;
        const int ch0 = 4 * (((F.tid & 7) * 2) ^ (row & 15)), ch1 = 4 * (((F.tid & 7) * 2 + 1) ^ (row & 15));
        f32x4 s0 = *(const LAS f32x4*)(PR + ch0), s1 = *(const LAS f32x4*)(PR + ch1);
#pragma unroll
        for (int ww = 1; ww < 8; ++ww) { s0 += *(const LAS f32x4*)(PR + ww * 4096 + ch0); s1 += *(const LAS f32x4*)(PR + ww * 4096 + ch1); }
        float v[8] = {s0.x, s0.y, s0.z, s0.w, s1.x, s1.y, s1.z, s1.w};
        E(tm * 64 + row, tn * 64 + c8, v, F.tid);
    }
    lds_barrier();
}
struct EpiSk {
    float* d32; int ld32; bf16* d16; int ld16; float sc16;
    const float* res; int ldr;
    const float* gcol; float* ssq; const float* rsq;
    __device__ __forceinline__ void operator()(int row, int col, float (&v)[8], int tid) const {
        if (rsq) { const float rs = rsqrtf(rsq[row] * (1.f / 1024.f) + EPS);
#pragma unroll
            for (int i = 0; i < 8; ++i) v[i] *= rs; }
        if (res) { const f32x4 a = *(const f32x4*)(res + (size_t)row * ldr + col), b = *(const f32x4*)(res + (size_t)row * ldr + col + 4);
            v[0] += a.x; v[1] += a.y; v[2] += a.z; v[3] += a.w; v[4] += b.x; v[5] += b.y; v[6] += b.z; v[7] += b.w; }
        if (d32) { *(f32x4*)(d32 + (size_t)row * ld32 + col) = (f32x4){v[0], v[1], v[2], v[3]}; *(f32x4*)(d32 + (size_t)row * ld32 + col + 4) = (f32x4){v[4], v[5], v[6], v[7]}; }
        if (ssq) { float ss = 0.f;
#pragma unroll
            for (int i = 0; i < 8; ++i) ss += v[i] * v[i];
            ss = sum8_f32(ss);
            if ((tid & 7) == 0) atomicAdd(ssq + row, ss); }
        if (d16) { float w8[8];
#pragma unroll
            for (int i = 0; i < 8; ++i) w8[i] = v[i];
            if (gcol) { const f32x4 a = *(const f32x4*)(gcol + col), b = *(const f32x4*)(gcol + col + 4); w8[0] *= a.x; w8[1] *= a.y; w8[2] *= a.z; w8[3] *= a.w; w8[4] *= b.x; w8[5] *= b.y; w8[6] *= b.z; w8[7] *= b.w; }
            v4u o; o.x = pg8::cvt_pk_bf16(w8[0] * sc16, w8[1] * sc16); o.y = pg8::cvt_pk_bf16(w8[2] * sc16, w8[3] * sc16); o.z = pg8::cvt_pk_bf16(w8[4] * sc16, w8[5] * sc16); o.w = pg8::cvt_pk_bf16(w8[6] * sc16, w8[7] * sc16);
            *(v4u*)(d16 + (size_t)row * ld16 + col) = o; }
    }
};

#define SK_TM16(t) (4 * (((t) >> 5) >> 1) + (((t) & 31) >> 3))
#define SK_TN16(t) (8 * (((t) >> 5) & 1) + ((t) & 7))
#define SK_TM32(t) (4 * ((((t) & 255) >> 5) >> 1) + ((((t) & 31) + 32 * ((t) >> 8)) >> 4))
#define SK_TN32(t) (16 * ((((t) & 255) >> 5) & 1) + ((((t) & 31) + 32 * ((t) >> 8)) & 15))


#ifndef PH_MAX
#define PH_MAX 99
#endif
__global__ void __launch_bounds__(NTHR, 2) mega_fwd(Args args) {
    extern __shared__ __attribute__((aligned(16))) unsigned char lds_raw[];
    Frame F;
    F.lds = (LAS unsigned char*)lds_raw;
    F.wave = __builtin_amdgcn_readfirstlane((int)threadIdx.x >> 6); F.lane = lane_id(); F.tid = F.wave * 64 + F.lane;
    F.G = gridDim.x; { const int bx = blockIdx.x; F.vcu = (F.G % 8 == 0) ? (bx % 8) * (F.G / 8) + bx / 8 : bx; }
    volatile LAS unsigned* MISC = (volatile LAS unsigned*)(F.lds + MISC_OFF);
    LAS unsigned long long* ARGP = (LAS unsigned long long*)(F.lds + ARGS_OFF);
    for (int u = F.tid; u < (LDS_BYTES - LDSCTL_OFF) / 4; u += NTHR) ((LAS unsigned*)(F.lds + LDSCTL_OFF))[u] = 0u;
    __syncthreads();
    if (F.tid == 0) {
        ARGP[0] = (unsigned long long)args.in[0];
        ARGP[1] = (unsigned long long)args.in[1];
        ARGP[2] = (unsigned long long)args.in[2];
        ARGP[3] = (unsigned long long)args.in[3];
        ARGP[4] = (unsigned long long)args.in[4];
        ARGP[5] = (unsigned long long)args.in[5];
        ARGP[6] = (unsigned long long)args.in[6];
        ARGP[7] = (unsigned long long)args.in[7];
        ARGP[8] = (unsigned long long)args.in[8];
        ARGP[9] = (unsigned long long)args.in[9];
        ARGP[10] = (unsigned long long)args.in[10];
        ARGP[11] = (unsigned long long)args.in[11];
        ARGP[12] = (unsigned long long)args.in[12];
        ARGP[13] = (unsigned long long)args.in[13];
        ARGP[14] = (unsigned long long)args.in[14];
        ARGP[15] = (unsigned long long)args.in[15];
        ARGP[16] = (unsigned long long)args.in[16];
        ARGP[17] = (unsigned long long)args.in[17];
        ARGP[18] = (unsigned long long)args.in[18];
        ARGP[19] = (unsigned long long)args.in[19];
        ARGP[20] = (unsigned long long)args.in[20];
        ARGP[21] = (unsigned long long)args.in[21];
        ARGP[22] = (unsigned long long)args.in[22];
        ARGP[23] = (unsigned long long)args.in[23];
        ARGP[24] = (unsigned long long)args.in[24];
        ARGP[25] = (unsigned long long)args.in[25];
        ARGP[26] = (unsigned long long)args.in[26];
        ARGP[27] = (unsigned long long)args.in[27];
        ARGP[28] = (unsigned long long)args.in[28];
        ARGP[N_INPUTS] = (unsigned long long)args.out; ARGP[N_INPUTS + 1] = (unsigned long long)args.ws;
    }
    __syncthreads();
    { const XcdBarrier bar0 = xcd_barrier_post((unsigned*)((gu32*)(args.ws + WS_CTL) + CW_BAR), MISC + 8, F.wave); if (F.tid == 0) MISC[10] = bar0.x; }
    __syncthreads();
#define GRID_BAR() do { XcdBarrier bar_; bar_.bar = (unsigned*)((gu32*)((unsigned char*)ld_ptr(ARGP + N_INPUTS + 1) + WS_CTL) + CW_BAR); bar_.x = MISC[10]; bar_.st = MISC + 8; bar_.wave = F.wave; xcd_barrier(bar_); } while (0)
#define PHASE_ARGS const Args A = load_args(ARGP); unsigned char* const ws = A.ws; float* const out = A.out; (void)ws; (void)out; { int l_ = lane_id(); asm volatile("" : "+v"(l_)); F.lane = l_; F.tid = F.wave * 64 + l_; }

    { PHASE_ARGS;
    p0_prologue(F, A);
    }
    GRID_BAR();
#if defined(PROBE_BAR8)
    GRID_BAR(); GRID_BAR(); GRID_BAR(); GRID_BAR(); GRID_BAR(); GRID_BAR(); GRID_BAR(); GRID_BAR();
#endif
#if PH_MAX >= 1
    { PHASE_ARGS;
    {
        pg8::Gemm g{(const bf16*)(ws + WS_HB), (const bf16*)(ws + WS_WIN), DM, DM, DM};
        pg8::StaticOrder S; S.init(TA, N_IN, F.G, (int)blockIdx.x);
        EpiInProj E{out, ws, (const float*)A.in[I_BFF]};
        pg8::gemm_phase(F.lds, g, S, E, F.wave);
    }
    {
        const int off = (TA / 256) * (N_IN / 256) % F.G;
        pg8::Gemm g{(const bf16*)(ws + WS_MB), (const bf16*)(ws + WS_WMK), DM, DM, DM};
        pg8::StaticOrder S; S.init(512, DM, F.G, ((int)blockIdx.x + F.G - off) % F.G);
        EpiGen E{out + O_MKP, DM, (bf16*)(ws + WS_MK16), DM, 1.f, nullptr, nullptr, 0, 0, nullptr, nullptr, nullptr};
        pg8::gemm_phase(F.lds, g, S, E, F.wave);
    }
    {
        const int off = ((TA / 256) * (N_IN / 256) + 8) % F.G;
        pg8::Gemm g{(const bf16*)(ws + WS_MB), (const bf16*)(ws + WS_WMV), DM, DM, DM};
        pg8::StaticOrder S; S.init(512, DM, F.G, ((int)blockIdx.x + F.G - off) % F.G);
        EpiGen E{out + O_MVP, DM, nullptr, 0, 1.f, nullptr, nullptr, 0, 0, nullptr, nullptr, nullptr};
        pg8::gemm_phase(F.lds, g, S, E, F.wave);
    }
    {
        const int off = ((TA / 256) * (N_IN / 256) + 16) % F.G;
        pg8::Gemm g{(const bf16*)(ws + WS_WMV), (const bf16*)(ws + WS_MB), DM, DM, DM};
        pg8::StaticOrder S; S.init(DM, 512, F.G, ((int)blockIdx.x + F.G - off) % F.G);
        EpiGen E{nullptr, 0, (bf16*)(ws + WS_MVT16), 512, 1.f, nullptr, nullptr, 0, 0, nullptr, nullptr, nullptr};
        pg8::gemm_phase(F.lds, g, S, E, F.wave);
    }
    }
    GRID_BAR();
#endif
#if PH_MAX >= 2
    asm volatile("; ===PHASE 2===");
    { PHASE_ARGS;
    {
        const int gw = F.vcu * NWAVES + F.wave, NGW = F.G * NWAVES;
        if ((gw & 3) == 0) for (int it = gw >> 2; it < 512; it += NGW >> 2) fox_norms_item(F, (const bf16*)(ws + WS_QF), (const bf16*)(ws + WS_KF), out + O_LFP, (float*)(ws + WS_MISC + MiB), (float*)(ws + WS_KBIAS), (float*)(ws + WS_MISC + MiB + 65536), it);
        for (int it = gw; it < NB_S * NPAGES; it += NGW) fox_suffix_item(F, (const float*)A.in[I_CFL], (const int*)A.in[I_PT], (float*)(ws + WS_SUF), (float*)(ws + WS_MISC + 2 * MiB), it);
        for (int u = F.vcu; u < 1024; u += F.G) gla_g1_unit(F, A, u);
        for (int u = F.vcu; u < 512; u += F.G) gla_sample_unit(F, A, u);
    }
    }
    GRID_BAR();
#endif
#if PH_MAX >= 3
    asm volatile("; ===PHASE 3===");
    { PHASE_ARGS;
    gla_scan(F, A);
    __syncthreads();
    for (int i = F.vcu; i < 256; i += F.G) { const int bh = i >> 4, s = i & 15;
        fox_attn_unit(F, (const bf16*)(ws + WS_QF), (const bf16*)(ws + WS_KF), (const bf16*)(ws + WS_VF), (const float*)(ws + WS_KBIAS), (const float*)(ws + WS_MISC + MiB + 65536), (const float*)(ws + WS_MISC + MiB), (bf16*)(ws + WS_MERGED), bh >> 3, bh & 7, s);
        fox_attn_unit(F, (const bf16*)(ws + WS_QF), (const bf16*)(ws + WS_KF), (const bf16*)(ws + WS_VF), (const float*)(ws + WS_KBIAS), (const float*)(ws + WS_MISC + MiB + 65536), (const float*)(ws + WS_MISC + MiB), (bf16*)(ws + WS_MERGED), bh >> 3, bh & 7, 31 - s); }
    }
    GRID_BAR();
#endif
#if PH_MAX >= 4
    asm volatile("; ===PHASE 4===");
    { PHASE_ARGS;
    if (!(F.vcu & 1)) { for (int u = F.vcu; u < 1024; u += F.G) gla_g3_unit(F, A, u); }
    }
    { PHASE_ARGS;
    for (int u = F.vcu; u < 1024; u += F.G) fox_sample_unit(F, A, u);
    }
    { PHASE_ARGS;
    if (F.vcu & 1) { for (int u = F.vcu; u < 1024; u += F.G) gla_g3_unit(F, A, u); }
    }
    GRID_BAR();
#endif
#if PH_MAX >= 5
    asm volatile("; ===PHASE 5===");
    { PHASE_ARGS;
    {
        pg8::Gemm g{(const bf16*)(ws + WS_MERGED), (const bf16*)(ws + WS_WOUT), DM, DM, DM};
        pg8::StaticOrder S; S.init(TP, DM, F.G, (int)blockIdx.x);
        EpiGen E{(float*)(ws + WS_X1), DM, (bf16*)(ws + WS_HB), DM, 1.f, (const float*)A.in[I_XP], (const float*)A.in[I_XS], TP, DM, (const float*)A.in[I_GCROSS], (float*)(ws + WS_SS), nullptr};
        pg8::gemm_phase(F.lds, g, S, E, F.wave);
        __syncthreads();
        EpiSk Es{(float*)(ws + WS_X1) + (size_t)TP * DM, DM, (bf16*)(ws + WS_HB) + (size_t)TP * DM, DM, 1.f, (const float*)A.in[I_XS], DM, (const float*)A.in[I_GCROSS], (float*)(ws + WS_SS) + TP, nullptr};
        for (int t = F.vcu; t < 256; t += F.G) skinny_tile(F, (const bf16*)(ws + WS_MERGED) + (size_t)TP * DM, DM, (const bf16*)(ws + WS_WOUT), DM, SK_TM16(t), SK_TN16(t), Es);
    }
    }
    GRID_BAR();
#endif
#if PH_MAX >= 7
    asm volatile("; ===PHASE 7===");
    { PHASE_ARGS;
    {
        pg8::Gemm g{(const bf16*)(ws + WS_HB), (const bf16*)(ws + WS_WCQ), DM, DM, DM};
        pg8::StaticOrder S; S.init(TP, DM, F.G, (int)blockIdx.x);
        EpiGen E{nullptr, 0, (bf16*)(ws + WS_QC), DM, C2C, nullptr, nullptr, 0, 0, nullptr, nullptr, (const float*)(ws + WS_SS)};
        pg8::gemm_phase(F.lds, g, S, E, F.wave);
        __syncthreads();
        EpiSk Es{nullptr, 0, (bf16*)(ws + WS_QC) + (size_t)TP * DM, DM, C2C, nullptr, 0, nullptr, nullptr, (const float*)(ws + WS_SS) + TP};
        for (int t = F.vcu; t < 256; t += F.G) skinny_tile(F, (const bf16*)(ws + WS_HB) + (size_t)TP * DM, DM, (const bf16*)(ws + WS_WCQ), DM, SK_TM16(t), SK_TN16(t), Es);
    }
    }
    GRID_BAR();
#endif
#if PH_MAX >= 8
    asm volatile("; ===PHASE 8===");
    { PHASE_ARGS;
    {
        const int u = (int)blockIdx.x, b = (u >> 7) & 1, h = (u >> 5) & 3, pnl = u & 31;
        const size_t roff = ((size_t)b * SEQ + pnl * 256) * DM + h * 256;
        if (F.vcu & 1) { for (int v = F.vcu; v < 512; v += F.G) cross_sample_unit(F, A, v); }
        pg8::Gemm g{(const bf16*)(ws + WS_QC) + roff, (const bf16*)(ws + WS_MK16) + (size_t)(b * 256) * DM + h * 256, DM, DM, 256};
        pg8::SingleUnit S{u < 256 ? 1 : 0, {0, 0}};
        EpiSoftmaxP E{ARGP};
        pg8::gemm_phase(F.lds, g, S, E, F.wave);
        VM_WAIT(); __syncthreads();
        {
            pg8::Gemm g2{(const bf16*)(ws + WS_PC) + roff, (const bf16*)(ws + WS_MVT16) + (size_t)(h * 256) * 512 + b * 256, DM, 512, 256};
            EpiGen E2{nullptr, 0, (bf16*)(ws + WS_OC) + roff, DM, 1.f, nullptr, nullptr, 0, 0, nullptr, nullptr, nullptr};
            pg8::gemm_phase(F.lds, g2, S, E2, F.wave);
        }
        __syncthreads();
        if (!(F.vcu & 1)) { for (int v = F.vcu; v < 512; v += F.G) cross_sample_unit(F, A, v); }
    }
    }
    GRID_BAR();
#endif
#if PH_MAX >= 10
    asm volatile("; ===PHASE 10===");
    { PHASE_ARGS;
    {
        pg8::Gemm g{(const bf16*)(ws + WS_OC), (const bf16*)(ws + WS_WCO), DM, DM, DM};
        pg8::StaticOrder S; S.init(TP, DM, F.G, (int)blockIdx.x);
        EpiGen E{(float*)(ws + WS_X2), DM, (bf16*)(ws + WS_HB), DM, 1.f, (const float*)(ws + WS_X1), (const float*)(ws + WS_X1), TA, DM, (const float*)A.in[I_GFFN], (float*)(ws + WS_SS) + TA, nullptr};
        pg8::gemm_phase(F.lds, g, S, E, F.wave);
        __syncthreads();
        EpiSk Es{(float*)(ws + WS_X2) + (size_t)TP * DM, DM, (bf16*)(ws + WS_HB) + (size_t)TP * DM, DM, 1.f, (const float*)(ws + WS_X1) + (size_t)TP * DM, DM, (const float*)A.in[I_GFFN], (float*)(ws + WS_SS) + TA + TP, nullptr};
        for (int t = F.vcu; t < 256; t += F.G) skinny_tile(F, (const bf16*)(ws + WS_OC) + (size_t)TP * DM, DM, (const bf16*)(ws + WS_WCO), DM, SK_TM16(t), SK_TN16(t), Es);
    }
    }
    GRID_BAR();
#endif
#if PH_MAX >= 12
    asm volatile("; ===PHASE 12===");
    { PHASE_ARGS;
    {
        pg8::Gemm g{(const bf16*)(ws + WS_HB), (const bf16*)(ws + WS_WPK), DM, DM, DM};
        pg8::StaticOrder S; S.init(TP, 2048, F.G, (int)blockIdx.x);
        EpiGen E{nullptr, 0, (bf16*)(ws + WS_SC), 2048, 1.f, nullptr, nullptr, 0, 0, nullptr, nullptr, (const float*)(ws + WS_SS) + TA};
        pg8::gemm_phase(F.lds, g, S, E, F.wave);
        __syncthreads();
        EpiSk Es{nullptr, 0, (bf16*)(ws + WS_SC) + (size_t)TP * 2048, 2048, 1.f, nullptr, 0, nullptr, nullptr, (const float*)(ws + WS_SS) + TA + TP};
        for (int t = F.vcu; t < 512; t += F.G) skinny_tile(F, (const bf16*)(ws + WS_HB) + (size_t)TP * DM, DM, (const bf16*)(ws + WS_WPK), DM, SK_TM32(t), SK_TN32(t), Es);
    }
    }
    GRID_BAR();
#endif
#if PH_MAX >= 13
    asm volatile("; ===PHASE 13===");
    { PHASE_ARGS;
    peer_phase(F, A);
    }
#endif
#if PH_MAX < 13
    {   PHASE_ARGS;
        const int gw = F.vcu * NWAVES + F.wave, NGW = F.G * NWAVES;
        for (int m = gw; m < TA; m += NGW) {
            const float* x = m < TP ? (const float*)A.in[I_XP] + (size_t)m * DM : (const float*)A.in[I_XS] + (size_t)(m - TP) * DM;
            float* y = m < TP ? out + O_YP + (size_t)m * DM : out + O_YS + (size_t)(m - TP) * DM;
            for (int j = 0; j < 4; ++j) ((f32x4*)y)[F.lane + 64 * j] = ((const f32x4*)x)[F.lane + 64 * j];
        }
    }
#endif

}

extern "C" void kernel_launch(void* const* d_in, const int* in_sizes, int n_in, void* d_out, int out_size, void* d_ws, size_t ws_size, hipStream_t stream) {
    static int grid = 0;
    if (grid == 0) {
        if (n_in != N_INPUTS || (size_t)out_size != O_TOTAL || ws_size < WS_END) { fprintf(stderr, "kernel_launch: unexpected shapes (n_in %d out %d ws %zu)\n", n_in, out_size, ws_size); grid = -1; return; }
        int dev = 0, cus = 0, per_cu = 0;
        if (hipGetDevice(&dev) != hipSuccess || hipDeviceGetAttribute(&cus, hipDeviceAttributeMultiprocessorCount, dev) != hipSuccess) { grid = -1; return; }
        if (hipFuncSetAttribute((const void*)mega_fwd, hipFuncAttributeMaxDynamicSharedMemorySize, LDS_BYTES) != hipSuccess) { fprintf(stderr, "kernel_launch: hipFuncSetAttribute failed\n"); grid = -1; return; }
        if (hipOccupancyMaxActiveBlocksPerMultiprocessor(&per_cu, (const void*)mega_fwd, NTHR, LDS_BYTES) != hipSuccess || per_cu < 1)
            fprintf(stderr, "kernel_launch: occupancy query reports %d workgroups per CU\n", per_cu);
        (void)hipGetLastError();
        grid = cus;
        if (grid > 256) grid = 256;
    }
    if (grid < 0) return;
    if (hipMemsetAsync((char*)d_ws + WS_CTL, 0, CTL_ZERO_BYTES, stream) != hipSuccess) return;
    Args a{};
    for (int i = 0; i < N_INPUTS; ++i) a.in[i] = d_in[i];
    a.out = (float*)d_out; a.ws = (unsigned char*)d_ws;
    hipLaunchKernelGGL(mega_fwd, dim3(grid), dim3(NTHR), LDS_BYTES, stream, a);
    const hipError_t le = hipPeekAtLastError();
    if (le != hipSuccess) fprintf(stderr, "kernel_launch: launch failed: %s\n", hipGetErrorName(le));
}
```

```cpp
#define PH_MAX 13
#include <hip/hip_runtime.h>
#include <cstdio>
#include <cstdint>

namespace pg8 {
#define PG8_LAS __attribute__((address_space(3)))
typedef unsigned short bf16_t;
typedef short bf16x8 __attribute__((ext_vector_type(8)));
typedef float f32x4 __attribute__((ext_vector_type(4)));
typedef unsigned u32x4 __attribute__((ext_vector_type(4)));
typedef unsigned u32x2 __attribute__((ext_vector_type(2)));
constexpr int BM = 256, BK = 64, HALF = 128, HTB = HALF * BK * 2  , STAGE_BYTES = 8 * HTB, NXCD = 8, WGM = 8;

__host__ __device__ __forceinline__ int lds_byte(int r, int c) { const int st = (r >> 4) * 2 + (c >> 5), rr = r & 15, cc = c & 31, ob = rr * 64 + cc * 2; return st * 1024 + (ob ^ (((ob >> 9) & 1) << 5)); }
__host__ __device__ __forceinline__ void stage_rc(int b, int& R, int& C) { const int st = b / 1024, sb = b % 1024, swz = sb ^ (((sb >> 9) & 1) << 5); R = (st >> 1) * 16 + swz / 64; C = (st & 1) * 32 + (swz % 64) / 2; }

struct Unit { int pm, pn; };
struct Gemm { const bf16_t* A; const bf16_t* Bt; int lda, ldb, K; };

struct StaticOrder {
    int nM, nN, nwg, G, c;
    __host__ __device__ void init(int M, int N, int G_, int c_) { nM = M / BM; nN = N / BM; nwg = nM * nN; G = G_; c = c_; }
    __host__ __device__ bool next(int i, Unit& u) const {
        const long L = (long)i * G + c; if (L >= nwg) return false;
        int wgid = (int)L; { const int q = nwg / NXCD, r = nwg % NXCD, xcd = wgid % NXCD, off = wgid / NXCD; wgid = (xcd < r ? xcd * (q + 1) : r * (q + 1) + (xcd - r) * q) + off; }
        const int nig = WGM * nN, gid = wgid / nig, fm = gid * WGM, gsz = (nM - fm) < WGM ? (nM - fm) : WGM;
        u.pm = fm + ((wgid % nig) % gsz); u.pn = (wgid % nig) / gsz; return true;
    }
};
struct SingleUnit {
    int has; Unit u0;
    __host__ __device__ bool next(int i, Unit& u) const { if (i != 0 || !has) return false; u = u0; return true; }
};

__device__ __forceinline__ unsigned cvt_pk_bf16(float lo, float hi) { unsigned r; asm volatile("v_cvt_pk_bf16_f32 %0, %1, %2" : "=v"(r) : "v"(lo), "v"(hi)); return r; }

template <class Epi, class Sched>
__device__ __forceinline__ void gemm_phase(PG8_LAS unsigned char* lds, const Gemm g, const Sched& S, const Epi& E, int wave_id) {
    int lane; asm volatile("v_mbcnt_lo_u32_b32 %0, -1, 0\n\tv_mbcnt_hi_u32_b32 %0, -1, %0" : "=v"(lane));
    const int wid = wave_id; const int tid = wid * 64 + lane; const int wr = wid >> 2, wc = wid & 3, fr = lane & 15, fq = lane >> 4;
    const int K = g.K, nt = K / BK;
    unsigned voffA[2], voffB[2];
#pragma unroll
    for (int i = 0; i < 2; ++i) { int R, C; stage_rc(tid * 16 + i * 8192, R, C);
        voffA[i] = (unsigned)(R * g.lda + C) * 2u; voffB[i] = (unsigned)(R * g.ldb + C) * 2u; }
    const size_t kstep = (size_t)(BK * 2);
    const size_t hstepA = (size_t)HALF * g.lda * 2, hstepB = (size_t)HALF * g.ldb * 2;
    const size_t tstepA = 2 * hstepA, tstepB = 2 * hstepB;
    const unsigned ldsw = (unsigned)wid * 1024u;
    const int aoff = lds_byte(wr * 64 + fr, fq * 8), boff = lds_byte(wc * 32 + fr, fq * 8);
#define PG8_SA(b, h) (((b) * 2 + (h)) * HTB)
#define PG8_SB(b, h) ((4 + (b) * 2 + (h)) * HTB)
#define PG8_STAGE(bufoff, gbase, voff) do { _Pragma("unroll") for (int _i = 0; _i < 2; ++_i) \
        __builtin_amdgcn_global_load_lds((const unsigned*)((const char*)(gbase) + (voff)[_i]), (PG8_LAS unsigned*)(lds + (bufoff) + ldsw + _i * 8192), 16, 0, 0); } while (0)
#define PG8_LDA(dst, b, h) do { _Pragma("unroll") for (int m = 0; m < 4; ++m) _Pragma("unroll") for (int k = 0; k < 2; ++k) dst[m][k] = *(const PG8_LAS bf16x8*)(lds + PG8_SA(b, h) + aoff + m * 2048 + k * 1024); } while (0)
#define PG8_LDB(dst, b, h) do { _Pragma("unroll") for (int n = 0; n < 2; ++n) _Pragma("unroll") for (int k = 0; k < 2; ++k) dst[n][k] = *(const PG8_LAS bf16x8*)(lds + PG8_SB(b, h) + boff + n * 2048 + k * 1024); } while (0)
#define PG8_MMA(ai, bj, At, Bt) do { __builtin_amdgcn_s_setprio(1); _Pragma("unroll") for (int m = 0; m < 4; ++m) _Pragma("unroll") for (int n = 0; n < 2; ++n) _Pragma("unroll") for (int k = 0; k < 2; ++k) \
        acc[ai][bj][m][n] = __builtin_amdgcn_mfma_f32_16x16x32_bf16(Bt[n][k], At[m][k], acc[ai][bj][m][n], 0, 0, 0); __builtin_amdgcn_s_setprio(0); } while (0)
#define PG8_WAIT_V(n) asm volatile("s_waitcnt vmcnt(" #n ")" ::: "memory")
#define PG8_WAIT_L(n) asm volatile("s_waitcnt lgkmcnt(" #n ")" ::: "memory")
#define PG8_BAR __builtin_amdgcn_s_barrier()
#define PG8_SCHED __builtin_amdgcn_sched_barrier(0)
    Unit cur, nxt; int ui = 0;
    if (!S.next(0, cur)) return;
    f32x4 acc[2][2][4][2];
#pragma unroll
    for (int a = 0; a < 2; ++a)
#pragma unroll
        for (int b = 0; b < 2; ++b)
#pragma unroll
            for (int m = 0; m < 4; ++m)
#pragma unroll
                for (int n = 0; n < 2; ++n) acc[a][b][m][n] = (f32x4){0.f, 0.f, 0.f, 0.f};
    bf16x8 At[4][2], B0[2][2], B1[2][2];
    const char* cA = (const char*)g.A + (size_t)cur.pm * tstepA; const char* cB = (const char*)g.Bt + (size_t)cur.pn * tstepB;
    PG8_STAGE(PG8_SB(0, 0), cB, voffB); PG8_STAGE(PG8_SB(0, 1), cB + hstepB, voffB); PG8_STAGE(PG8_SA(0, 0), cA, voffA); PG8_STAGE(PG8_SA(0, 1), cA + hstepA, voffA);
    if (wr == 1) PG8_BAR;
    PG8_WAIT_V(2); PG8_BAR;
    PG8_STAGE(PG8_SB(1, 0), cB + kstep, voffB); PG8_STAGE(PG8_SA(1, 0), cA + kstep, voffA); PG8_STAGE(PG8_SB(1, 1), cB + hstepB + kstep, voffB);
    PG8_WAIT_V(6); PG8_BAR;
    for (;;) {
        const bool has_next = S.next(ui + 1, nxt);
        const char* nA = has_next ? (const char*)g.A + (size_t)nxt.pm * tstepA : cA; const char* nB = has_next ? (const char*)g.Bt + (size_t)nxt.pn * tstepB : cB;
        for (int t = 0; t < nt; t += 2) {
            const bool last = (t == nt - 2);
            const char* a1 = cA + (size_t)(t + 1) * kstep;
            const char* a2 = last ? nA : cA + (size_t)(t + 2) * kstep; const char* b2 = last ? nB : cB + (size_t)(t + 2) * kstep;
            const char* a3 = a2 + kstep; const char* b3 = b2 + kstep;
            PG8_LDB(B0, 0, 0); PG8_LDB(B1, 0, 1); PG8_SCHED; PG8_LDA(At, 0, 0); PG8_STAGE(PG8_SA(1, 1), a1 + hstepA, voffA);
            PG8_WAIT_V(8); PG8_WAIT_L(0); PG8_BAR; PG8_MMA(0, 0, At, B0); PG8_MMA(0, 1, At, B1); PG8_BAR; PG8_SCHED;
            PG8_LDA(At, 0, 1); PG8_STAGE(PG8_SB(0, 0), b2, voffB); PG8_STAGE(PG8_SB(0, 1), b2 + hstepB, voffB); PG8_STAGE(PG8_SA(0, 0), a2, voffA);
            PG8_WAIT_V(8); PG8_WAIT_L(0); PG8_BAR; PG8_MMA(1, 0, At, B0); PG8_MMA(1, 1, At, B1); PG8_BAR; PG8_SCHED;
            PG8_LDB(B0, 1, 0); PG8_LDB(B1, 1, 1); PG8_SCHED; PG8_LDA(At, 1, 0); PG8_STAGE(PG8_SA(0, 1), a2 + hstepA, voffA);
            PG8_WAIT_V(8); PG8_WAIT_L(0); PG8_BAR; PG8_MMA(0, 0, At, B0); PG8_MMA(0, 1, At, B1); PG8_BAR; PG8_SCHED;
            PG8_LDA(At, 1, 1); PG8_STAGE(PG8_SB(1, 0), b3, voffB); PG8_STAGE(PG8_SB(1, 1), b3 + hstepB, voffB); PG8_STAGE(PG8_SA(1, 0), a3, voffA);
            PG8_WAIT_V(8); PG8_WAIT_L(0); PG8_BAR; PG8_MMA(1, 0, At, B0); PG8_MMA(1, 1, At, B1); PG8_BAR; PG8_SCHED;
        }
        if (wr == 0) PG8_BAR;
        if constexpr (!Epi::AFTER_DRAIN) { E(acc, cur, wr, wc, fr, fq); }
        if (!has_next) break;
#pragma unroll
        for (int a = 0; a < 2; ++a)
#pragma unroll
            for (int b = 0; b < 2; ++b)
#pragma unroll
                for (int m = 0; m < 4; ++m)
#pragma unroll
                    for (int n = 0; n < 2; ++n) acc[a][b][m][n] = (f32x4){0.f, 0.f, 0.f, 0.f};
        cur = nxt; cA = nA; cB = nB; ++ui;
        if (wr == 1) PG8_BAR;
    }
    PG8_WAIT_V(0);
    PG8_BAR;
    if constexpr (Epi::AFTER_DRAIN) { E.fused(acc, cur, wr, wc, fr, fq, lds, wid, lane); }
#undef PG8_SA
#undef PG8_SB
#undef PG8_STAGE
#undef PG8_LDA
#undef PG8_LDB
#undef PG8_MMA
#undef PG8_WAIT_V
#undef PG8_WAIT_L
#undef PG8_BAR
#undef PG8_SCHED
}
}

#define GAS __attribute__((address_space(1)))
#define LAS __attribute__((address_space(3)))
typedef unsigned short bf16;
typedef unsigned v4u __attribute__((ext_vector_type(4)));
typedef unsigned v2u __attribute__((ext_vector_type(2)));
typedef float f32x4 __attribute__((ext_vector_type(4)));
typedef float f32x2 __attribute__((ext_vector_type(2)));
typedef float f32x16 __attribute__((ext_vector_type(16)));
typedef short bf16x8 __attribute__((ext_vector_type(8)));
typedef short s16x4 __attribute__((ext_vector_type(4)));
typedef GAS unsigned gu32;
#define RLX_AGENT __ATOMIC_RELAXED, __HIP_MEMORY_SCOPE_AGENT
#define LDS_WAIT() asm volatile("s_waitcnt lgkmcnt(0)" ::: "memory")
#define VM_WAIT() asm volatile("s_waitcnt vmcnt(0)" ::: "memory")
__device__ __forceinline__ unsigned f2bf(float f) { unsigned u = __builtin_bit_cast(unsigned, f); return (u + 0x7fffu + ((u >> 16) & 1u)) >> 16; }
__device__ __forceinline__ unsigned pk2(float lo, float hi) { return f2bf(lo) | (f2bf(hi) << 16); }
__device__ __forceinline__ float bf2f(unsigned short b) { return __builtin_bit_cast(float, (unsigned)b << 16); }
__device__ __forceinline__ float bflo(unsigned u) { return __builtin_bit_cast(float, u << 16); }
__device__ __forceinline__ float bfhi(unsigned u) { return __builtin_bit_cast(float, u & 0xffff0000u); }


typedef short v4i16_t __attribute__((ext_vector_type(4)));
__device__ __forceinline__ s16x4 lds_tr16(LAS unsigned char* p) { return __builtin_bit_cast(s16x4, __builtin_amdgcn_ds_read_tr16_b64_v4i16((LAS v4i16_t*)p)); }
__device__ __forceinline__ int crow(int r, int hi) { return (r & 3) + 8 * (r >> 2) + 4 * hi; }

#define DPP_I(v, ctrl) __builtin_amdgcn_update_dpp(0, (v), (ctrl), 0xF, 0xF, false)
#define DPP_F(v, ctrl) __builtin_bit_cast(float, __builtin_amdgcn_update_dpp(0, __builtin_bit_cast(int, (v)), (ctrl), 0xF, 0xF, false))
constexpr int DPP_X1 = 0xB1, DPP_X2 = 0x4E, DPP_HMIR = 0x141, DPP_MIR = 0x140;
__device__ __forceinline__ unsigned max16_u32(unsigned v) {
    unsigned t = (unsigned)DPP_I((int)v, DPP_X1); v = v > t ? v : t; t = (unsigned)DPP_I((int)v, DPP_X2); v = v > t ? v : t;
    t = (unsigned)DPP_I((int)v, DPP_HMIR); v = v > t ? v : t; t = (unsigned)DPP_I((int)v, DPP_MIR); v = v > t ? v : t; return v; }
__device__ __forceinline__ float sum8_f32(float v) { v += DPP_F(v, DPP_X1); v += DPP_F(v, DPP_X2); v += DPP_F(v, DPP_HMIR); return v; }
__device__ __forceinline__ float sum16_f32(float v) { v = sum8_f32(v); v += DPP_F(v, DPP_MIR); return v; }
__device__ __forceinline__ float max16_f32(float v) { v = fmaxf(v, DPP_F(v, DPP_X1)); v = fmaxf(v, DPP_F(v, DPP_X2)); v = fmaxf(v, DPP_F(v, DPP_HMIR)); v = fmaxf(v, DPP_F(v, DPP_MIR)); return v; }
__device__ __forceinline__ float xor16_f32(float v) { return __builtin_bit_cast(float, __builtin_amdgcn_ds_swizzle(__builtin_bit_cast(int, v), 0x1F | (16 << 10))); }
__device__ __forceinline__ float sum64_f32(float v) {
    v = sum16_f32(v); v += xor16_f32(v);
    return __builtin_bit_cast(float, __builtin_amdgcn_readlane(__builtin_bit_cast(int, v), 0)) + __builtin_bit_cast(float, __builtin_amdgcn_readlane(__builtin_bit_cast(int, v), 32)); }
template <int J> __device__ __forceinline__ unsigned xchg_xor_u32(unsigned v) {
    if constexpr (J == 1) return (unsigned)DPP_I((int)v, DPP_X1);
    else if constexpr (J == 2) return (unsigned)DPP_I((int)v, DPP_X2);
    else return (unsigned)__builtin_amdgcn_ds_swizzle((int)v, 0x1F | (J << 10)); }

__device__ __forceinline__ void lds_barrier() { asm volatile("s_waitcnt lgkmcnt(0)\n\ts_barrier" ::: "memory"); }

struct BfPtr { const unsigned short* p; __device__ __forceinline__ float operator[](size_t i) const { return __builtin_bit_cast(float, (unsigned)p[i] << 16); }
               __device__ __forceinline__ BfPtr operator+(size_t o) const { return BfPtr{p + o}; } };
#define GLD(ptr) (BfPtr{(const unsigned short*)(ptr)})

__device__ __forceinline__ int lane_id() { int r; asm volatile("v_mbcnt_lo_u32_b32 %0, -1, 0\n\tv_mbcnt_hi_u32_b32 %0, -1, %0" : "=v"(r)); return r; }
#define TID_IS_ZERO(wave_) ((wave_) == 0 && lane_id() == 0)
#define XB_TMO      128
#define XB_XCNT(j)  (256  + 64 * (j))
#define XB_XSUB(j)  (1280 + 64 * (j))
#define XB_XGEN(j)  (2304 + 64 * (j))
#define XB_TOP      3328
#define XB_TOPGEN   3392
#define XCD_BAR_WORDS 3456
#define XB_SPIN_CAP (1u << 18)

__device__ __forceinline__ unsigned xb_ld(unsigned* p)              { return __hip_atomic_load(p, __ATOMIC_RELAXED, __HIP_MEMORY_SCOPE_AGENT); }
__device__ __forceinline__ unsigned xb_add(unsigned* p, unsigned v) { return __hip_atomic_fetch_add(p, v, __ATOMIC_RELAXED, __HIP_MEMORY_SCOPE_AGENT); }
__device__ __forceinline__ unsigned xb_xcc_id() { return (unsigned)__builtin_amdgcn_s_getreg((3 << 11) | 20) & 0xFu; }
#define XB_SPIN(cond, bar) do { unsigned _sp = 0; while (cond) { __builtin_amdgcn_s_sleep(1); \
    if ((++_sp & 255u) == 0u) { if (xb_ld(&(bar)[XB_TMO])) break; if (_sp > XB_SPIN_CAP) { atomicAdd(&(bar)[XB_TMO], 1u); break; } } } } while (0)

struct XcdBarrier {
    unsigned* bar; unsigned x; int wave;
    volatile LAS unsigned* st;
};

__device__ __forceinline__ XcdBarrier xcd_barrier_post(unsigned* bar, volatile LAS unsigned* st, int wave) {
    XcdBarrier b; b.bar = bar; b.x = xb_xcc_id(); b.st = st; b.wave = wave;
    if (TID_IS_ZERO(wave)) (void)xb_add(&bar[XB_XCNT(b.x)], 1u);
    return b;
}
__device__ __forceinline__ void xcd_barrier_complete(unsigned* bar, unsigned x, unsigned& nloc, unsigned& nx) {
    const unsigned G = gridDim.x * gridDim.y * gridDim.z;
    unsigned sum, cnt, mine, sp = 0u;
    for (;;) {
        sum = 0u; cnt = 0u; mine = 0u;
#pragma unroll
        for (unsigned j = 0; j < 16; ++j) { const unsigned c = xb_ld(&bar[XB_XCNT(j)]); sum += c; cnt += (c > 0u) ? 1u : 0u; mine = (j == x) ? c : mine; }
        if (sum == G) break;
        __builtin_amdgcn_s_sleep(1);
        if ((++sp & 255u) == 0u) { if (xb_ld(&bar[XB_TMO])) break; if (sp > XB_SPIN_CAP) { atomicAdd(&bar[XB_TMO], 1u); break; } }
    }
    nloc = mine > 0u ? mine : 1u; nx = cnt > 0u ? cnt : 1u;
}

__device__ __forceinline__ void xcd_barrier(const XcdBarrier& b) {
    asm volatile("s_waitcnt vmcnt(0)" ::: "memory");
    __syncthreads();
    if (TID_IS_ZERO(b.wave)) {
        unsigned* bar = b.bar;
        __builtin_amdgcn_s_waitcnt(0);
        unsigned nloc = b.st[0], nx = b.st[1];
        if (nloc == 0u) { xcd_barrier_complete(bar, b.x, nloc, nx); b.st[0] = nloc; b.st[1] = nx; }
        const unsigned old = xb_add(&bar[XB_XSUB(b.x)], 1u);
        const unsigned gen = old / nloc;
        if (old + 1u == (gen + 1u) * nloc) {
            __builtin_amdgcn_fence(__ATOMIC_RELEASE, "agent");
            asm volatile("s_waitcnt vmcnt(0)" ::: "memory");
            const unsigned og = xb_add(&bar[XB_TOP], 1u);
            const unsigned tg = og / nx;
            if (og + 1u == (tg + 1u) * nx) xb_add(&bar[XB_TOPGEN], 1u);
            else XB_SPIN(xb_ld(&bar[XB_TOPGEN]) == tg, bar);
            __builtin_amdgcn_fence(__ATOMIC_ACQUIRE, "agent");
            xb_add(&bar[XB_XGEN(b.x)], 1u);
            asm volatile("s_waitcnt vmcnt(0)" ::: "memory");
        } else {
            XB_SPIN(xb_ld(&bar[XB_XGEN(b.x)]) == gen, bar);
            __builtin_amdgcn_fence(__ATOMIC_ACQUIRE, "agent");
            asm volatile("s_waitcnt vmcnt(0)" ::: "memory");
        }
    }
    __syncthreads();
}


constexpr int NWAVES = 8, NTHR = 512;
constexpr int DM = 1024, TP = 16384, TS = 1024, TA = TP + TS, SEQ = 8192, NB_P = 2, NB_S = 128, LS = 8;
constexpr int N_IN = 3328;
constexpr int PASTL = 2048, PAGE = 128, NPAGES = 16;
constexpr float EPS = 1e-6f;
constexpr float LOG2E = 1.4426950408889634f;
constexpr float C2F = 0.125f * LOG2E;
constexpr float C2C = 0.0625f * LOG2E;

enum { I_XP = 0, I_XS, I_CFK, I_CFV, I_CFL, I_SGLA, I_CMK, I_CMV, I_PT, I_MEMP, I_GMIX, I_WIN, I_BFF, I_WG2, I_BG, I_GGO, I_WOUT, I_GCROSS, I_GMEM,
       I_WMK, I_WMV, I_WCQ, I_WCO, I_GFFN, I_PWQ, I_PSK, I_PU, I_PV, I_GFIN, N_INPUTS };
constexpr size_t O_YP = 0, O_YS = 16777216, O_FKP = 17825792, O_FVP = 26214400, O_LFP = 34603008, O_GSP = 34734080, O_MKP = 34799616, O_MVP = 35323904,
                 O_FKS = 35848192, O_FVS = 36372480, O_LFS = 36896768, O_GSS = 36904960, O_TOTAL = 41099264;

constexpr size_t MiB = 1u << 20;
constexpr size_t WS_CTL = 0, CTL_ZERO_BYTES = 1 * MiB;
constexpr size_t WS_WIN = 2 * MiB, WS_WOUT = 10 * MiB, WS_WMK = 12 * MiB, WS_WMV = 14 * MiB, WS_WCQ = 16 * MiB, WS_WCO = 18 * MiB, WS_WPK = 20 * MiB;
constexpr size_t WS_MB = 24 * MiB, WS_MK16 = 25 * MiB, WS_MVT16 = 26 * MiB, WS_KBIAS = 27 * MiB, WS_GDEC = 28 * MiB, WS_GG = 29 * MiB;
constexpr size_t WS_U16 = 32 * MiB, WS_V16 = 64 * MiB, WS_HB = 96 * MiB, WS_QF = 132 * MiB, WS_KF = 150 * MiB, WS_VF = 168 * MiB;
constexpr size_t WS_GQ = 186 * MiB, WS_GK = 204 * MiB, WS_GV = 222 * MiB, WS_GR = 256 * MiB, WS_SUF = 290 * MiB, WS_GKV = 298 * MiB;
constexpr size_t WS_MERGED = 330 * MiB, WS_X1 = 364 * MiB, WS_X2 = 432 * MiB, WS_QC = 500 * MiB, WS_PC = 534 * MiB, WS_OC = 566 * MiB, WS_SC = 600 * MiB;
constexpr size_t WS_MISC = 736 * MiB, WS_SS = 740 * MiB  , WS_BB = 744 * MiB, WS_END = 800 * MiB;
constexpr int CW_BAR = 4096;

constexpr int RING_BYTES = 131072;
constexpr int LDSCTL_OFF = RING_BYTES, MISC_OFF = LDSCTL_OFF + 320;
constexpr int ARGS_OFF = MISC_OFF + 128;
constexpr int LDS_BYTES = 147456;

struct Args { const void* in[N_INPUTS]; float* out; unsigned char* ws; };

__device__ __forceinline__ const void* ld_ptr(const LAS unsigned long long* p) { const unsigned long long v = *p; const unsigned lo = __builtin_amdgcn_readfirstlane((unsigned)v), hi = __builtin_amdgcn_readfirstlane((unsigned)(v >> 32)); return (const void*)(const GAS char*)(((unsigned long long)hi << 32) | lo); }
__device__ __forceinline__ Args load_args(const LAS unsigned long long* ARGP) { Args A;
    A.in[0] = ld_ptr(ARGP + 0);
    A.in[1] = ld_ptr(ARGP + 1);
    A.in[2] = ld_ptr(ARGP + 2);
    A.in[3] = ld_ptr(ARGP + 3);
    A.in[4] = ld_ptr(ARGP + 4);
    A.in[5] = ld_ptr(ARGP + 5);
    A.in[6] = ld_ptr(ARGP + 6);
    A.in[7] = ld_ptr(ARGP + 7);
    A.in[8] = ld_ptr(ARGP + 8);
    A.in[9] = ld_ptr(ARGP + 9);
    A.in[10] = ld_ptr(ARGP + 10);
    A.in[11] = ld_ptr(ARGP + 11);
    A.in[12] = ld_ptr(ARGP + 12);
    A.in[13] = ld_ptr(ARGP + 13);
    A.in[14] = ld_ptr(ARGP + 14);
    A.in[15] = ld_ptr(ARGP + 15);
    A.in[16] = ld_ptr(ARGP + 16);
    A.in[17] = ld_ptr(ARGP + 17);
    A.in[18] = ld_ptr(ARGP + 18);
    A.in[19] = ld_ptr(ARGP + 19);
    A.in[20] = ld_ptr(ARGP + 20);
    A.in[21] = ld_ptr(ARGP + 21);
    A.in[22] = ld_ptr(ARGP + 22);
    A.in[23] = ld_ptr(ARGP + 23);
    A.in[24] = ld_ptr(ARGP + 24);
    A.in[25] = ld_ptr(ARGP + 25);
    A.in[26] = ld_ptr(ARGP + 26);
    A.in[27] = ld_ptr(ARGP + 27);
    A.in[28] = ld_ptr(ARGP + 28);
    A.out = (float*)ld_ptr(ARGP + N_INPUTS); A.ws = (unsigned char*)ld_ptr(ARGP + N_INPUTS + 1); return A; }
struct Frame {
    LAS unsigned char* lds;
    int tid, lane, wave, vcu, G;
};

__device__ __forceinline__ float wave_sum(float v) { return sum64_f32(v); }
__device__ __forceinline__ float log_sigmoid(float x) { return fminf(x, 0.f) - log1pf(__expf(-fabsf(x))); }

__device__ __forceinline__ int win_src_col(int r) {
    if (r < 1536) return r;
    if (r < 1792) return 1544 + (r - 1536);
    if (r < 2048) return 1800 + (r - 1792);
    if (r < 2560) return 2056 + (r - 2048);
    if (r < 3072) return 2584 + (r - 2560);
    if (r < 3080) return 1536 + (r - 3072);
    if (r < 3096) return 2568 + (r - 3080);
    return -1;
}
template <bool WIN>
__device__ __forceinline__ void p0_transpose_item(const float* W, int ldw, int K, int nblk, bf16* WT, LAS float* scr, int item, int lane) {
    const int kb = item / nblk, nb = item % nblk, k0 = 64 * kb, n0 = 32 * nb;
    const int dr = n0 + (lane & 31); const int sc = WIN ? win_src_col(dr) : dr;
#pragma unroll 8
    for (int i = 0; i < 32; ++i) { const int kk = 2 * i + (lane >> 5); scr[kk * 33 + (lane & 31)] = (sc >= 0) ? W[(size_t)(k0 + kk) * ldw + sc] : 0.f; }
    LDS_WAIT(); asm volatile("" ::: "memory");
    const int c = lane & 7;
#pragma unroll
    for (int j = 0; j < 4; ++j) { const int n = (lane >> 3) + 8 * j; const LAS float* s = scr + (8 * c) * 33 + n;
        v4u o; o.x = pk2(s[0 * 33], s[1 * 33]); o.y = pk2(s[2 * 33], s[3 * 33]); o.z = pk2(s[4 * 33], s[5 * 33]); o.w = pk2(s[6 * 33], s[7 * 33]);
        *(GAS v4u*)(WT + (size_t)(n0 + n) * K + k0 + 8 * c) = o; }
    LDS_WAIT(); asm volatile("" ::: "memory");
}
__device__ __forceinline__ void rms_row_bf16(const float* xrow, const float* g, bf16* orow, int lane) {
    const f32x4* xr = (const f32x4*)xrow + lane; const f32x4* gr = (const f32x4*)g + lane;
    f32x4 v[4]; float s = 0.f;
#pragma unroll
    for (int j = 0; j < 4; ++j) { v[j] = xr[64 * j]; s += (v[j].x * v[j].x + v[j].y * v[j].y) + (v[j].z * v[j].z + v[j].w * v[j].w); }
    const float r = rsqrtf(wave_sum(s) * (1.f / DM) + EPS);
    v2u* o8 = (v2u*)orow + lane;
#pragma unroll
    for (int j = 0; j < 4; ++j) { const f32x4 gg = gr[64 * j]; v2u o; o.x = pk2(v[j].x * r * gg.x, v[j].y * r * gg.y); o.y = pk2(v[j].z * r * gg.z, v[j].w * r * gg.w); o8[64 * j] = o; }
}

using pg8::Unit;
struct EpiGen {
    static constexpr bool PERM = false, AFTER_DRAIN = false;
    float* d32; int ld32; bf16* d16; int ld16; float sc16;
    const float* r0; const float* r1; int rsplit; int ldr;
    const float* gcol;
    float* ssq;
    const float* rsq;
    __device__ __forceinline__ void operator()(const f32x4 (&acc)[2][2][4][2], const Unit& u, int wr, int wc, int fr, int fq) const {
        int row0 = u.pm * 256 + wr * 64 + fr, col0 = u.pn * 256 + wc * 32 + fq * 4;
        asm volatile("" : "+v"(row0), "+v"(col0));
#pragma unroll
        for (int ai = 0; ai < 2; ++ai)
#pragma unroll
            for (int m = 0; m < 4; ++m) { const int row = row0 + ai * 128 + m * 16;
                const float* rp = nullptr; if (r0) rp = (row < rsplit) ? r0 + (size_t)row * ldr : r1 + (size_t)(row - rsplit) * ldr;
                float rs = 1.f; if (rsq) rs = rsqrtf(rsq[row] * (1.f / 1024.f) + EPS);
                float ss = 0.f;
#pragma unroll
                for (int bj = 0; bj < 2; ++bj)
#pragma unroll
                    for (int n = 0; n < 2; ++n) { const int col = col0 + bj * 128 + n * 16; f32x4 v = acc[ai][bj][m][n];
                        if (rsq) { v[0] *= rs; v[1] *= rs; v[2] *= rs; v[3] *= rs; }
                        if (r0) v += *(const f32x4*)(rp + col);
                        if (d32) *(f32x4*)(d32 + (size_t)row * ld32 + col) = v;
                        if (ssq) ss += (v[0] * v[0] + v[1] * v[1]) + (v[2] * v[2] + v[3] * v[3]);
                        if (d16) { f32x4 w = v; if (gcol) w = w * *(const f32x4*)(gcol + col);
                            v2u o; o.x = pg8::cvt_pk_bf16(w[0] * sc16, w[1] * sc16); o.y = pg8::cvt_pk_bf16(w[2] * sc16, w[3] * sc16); *(v2u*)(d16 + (size_t)row * ld16 + col) = o; } }
                if (ssq) { ss += xor16_f32(ss); ss += __shfl_xor(ss, 32); if (fq == 0) atomicAdd(ssq + row, ss); } }
    }
};
struct EpiInProj {
    static constexpr bool PERM = false, AFTER_DRAIN = false;
    float* out; unsigned char* ws; const float* bff;
    __device__ __forceinline__ void operator()(const f32x4 (&acc)[2][2][4][2], const Unit& u, int wr, int wc, int fr, int fq) const {
        const int pn = u.pn; const bool smp = u.pm >= 64;
        int row0 = u.pm * 256 + wr * 64 + fr;
        int orow0 = (smp ? (u.pm - 64) * 256 : u.pm * 256) + wr * 64 + fr;
        asm volatile("" : "+v"(row0), "+v"(orow0));
        float* d32 = nullptr; int ld32 = 0; bool d32_grp = false; bf16* d16 = nullptr; int ld16 = 0; float s32 = 1.f, s16 = 1.f; int cb = 0;
        if (pn < 2) { d16 = (bf16*)(ws + WS_QF); ld16 = 512; s16 = C2F; cb = pn * 256; }
        else if (pn < 4) { d32 = out + (smp ? O_FKS : O_FKP); ld32 = 512; d32_grp = true; d16 = (bf16*)(ws + WS_KF); ld16 = 512; cb = (pn - 2) * 256; }
        else if (pn < 6) { d32 = out + (smp ? O_FVS : O_FVP); ld32 = 512; d32_grp = true; d16 = (bf16*)(ws + WS_VF); ld16 = 512; cb = (pn - 4) * 256; }
        else if (pn == 6) { d16 = (bf16*)(ws + WS_GQ); ld16 = 256; s16 = 0.125f; }
        else if (pn == 7) { d16 = (bf16*)(ws + WS_GK); ld16 = 256; }
        else if (pn < 10) { d16 = (bf16*)(ws + WS_GV); ld16 = 512; cb = (pn - 8) * 256; }
        else if (pn < 12) { d16 = (bf16*)(ws + WS_GR); ld16 = 512; cb = (pn - 10) * 256; }
        if (pn < 12) {
#pragma unroll
            for (int ai = 0; ai < 2; ++ai)
#pragma unroll
                for (int m = 0; m < 4; ++m) { const int row = row0 + ai * 128 + m * 16, orow = orow0 + ai * 128 + m * 16;
#pragma unroll
                    for (int bj = 0; bj < 2; ++bj)
#pragma unroll
                        for (int n = 0; n < 2; ++n) { const int col = cb + wc * 32 + fq * 4 + bj * 128 + n * 16; const f32x4 v = acc[ai][bj][m][n];
                            if (d32) *(f32x4*)(d32 + (size_t)(d32_grp ? orow : row) * ld32 + col) = v * s32;
                            if (d16) { v2u o; o.x = pg8::cvt_pk_bf16(v[0] * s16, v[1] * s16); o.y = pg8::cvt_pk_bf16(v[2] * s16, v[3] * s16); *(v2u*)(d16 + (size_t)row * ld16 + col) = o; } } }
        } else {
            if (wc == 0) {
                float* lf = out + (smp ? O_LFS : O_LFP); float* ggp = (float*)(ws + WS_GG);
#pragma unroll
                for (int ai = 0; ai < 2; ++ai)
#pragma unroll
                    for (int m = 0; m < 4; ++m) { const int row = row0 + ai * 128 + m * 16, orow = orow0 + ai * 128 + m * 16;
#pragma unroll
                        for (int n = 0; n < 2; ++n) { const int col = n * 16 + fq * 4; const f32x4 v = acc[ai][0][m][n];
                            if (col < 8) { f32x4 o; const f32x4 b = *(const f32x4*)(bff + col);
                                o[0] = log_sigmoid(v[0] + b[0]); o[1] = log_sigmoid(v[1] + b[1]); o[2] = log_sigmoid(v[2] + b[2]); o[3] = log_sigmoid(v[3] + b[3]);
                                *(f32x4*)(lf + (size_t)orow * 8 + col) = o; }
                            else if (col < 24) *(f32x4*)(ggp + (size_t)row * 16 + (col - 8)) = v; } }
            }
        }
    }
};


__device__ __forceinline__ void p0_prologue(const Frame& F, const Args& a) {
    unsigned char* ws = a.ws;
    LAS float* scr = (LAS float*)(F.lds + F.wave * 16384);
    const int gw = F.vcu * NWAVES + F.wave, NGW = F.G * NWAVES;
    constexpr int I_WINN = 16 * (N_IN / 32), I_SQ = 16 * 32;
    constexpr int NITEMS = I_WINN + 5 * I_SQ;
    for (int it = (gw + NGW / 2) % NGW; it < NITEMS; it += NGW) {
        int r = it;
        if (r < I_WINN) { p0_transpose_item<true>((const float*)a.in[I_WIN], 3096, DM, N_IN / 32, (bf16*)(ws + WS_WIN), scr, r, F.lane); continue; } r -= I_WINN;
        const int which = r / I_SQ; r -= which * I_SQ;
        const float* src = (const float*)(which == 0 ? a.in[I_WOUT] : which == 1 ? a.in[I_WMK] : which == 2 ? a.in[I_WMV] : which == 3 ? a.in[I_WCQ] : a.in[I_WCO]);
        bf16* dst = (bf16*)(ws + (which == 0 ? WS_WOUT : which == 1 ? WS_WMK : which == 2 ? WS_WMV : which == 3 ? WS_WCQ : WS_WCO));
        p0_transpose_item<false>(src, DM, DM, 32, dst, scr, r, F.lane);
    }
    { float* ssz = (float*)(ws + WS_SS); for (int i = F.vcu * NTHR + F.tid; i < 2 * TA; i += F.G * NTHR) ssz[i] = 0.f; }
    for (int m0 = gw * 2; m0 < TA + 512; m0 += NGW * 2) {
        const float* xr[2]; const float* gr[2]; bf16* orow[2];
#pragma unroll
        for (int j = 0; j < 2; ++j) { const int m = m0 + j;
            if (m < TP) { xr[j] = (const float*)a.in[I_XP] + (size_t)m * DM; gr[j] = (const float*)a.in[I_GMIX]; orow[j] = (bf16*)(ws + WS_HB) + (size_t)m * DM; }
            else if (m < TA) { xr[j] = (const float*)a.in[I_XS] + (size_t)(m - TP) * DM; gr[j] = (const float*)a.in[I_GMIX]; orow[j] = (bf16*)(ws + WS_HB) + (size_t)m * DM; }
            else { xr[j] = (const float*)a.in[I_MEMP] + (size_t)(m - TA) * DM; gr[j] = (const float*)a.in[I_GMEM]; orow[j] = (bf16*)(ws + WS_MB) + (size_t)(m - TA) * DM; } }
        f32x4 v[2][4]; float s[2];
#pragma unroll
        for (int j = 0; j < 2; ++j) { s[j] = 0.f;
#pragma unroll
            for (int q = 0; q < 4; ++q) v[j][q] = ((const f32x4*)xr[j])[F.lane + 64 * q]; }
#pragma unroll
        for (int j = 0; j < 2; ++j) {
#pragma unroll
            for (int q = 0; q < 4; ++q) s[j] += (v[j][q].x * v[j][q].x + v[j][q].y * v[j][q].y) + (v[j][q].z * v[j][q].z + v[j][q].w * v[j][q].w);
            const float r = rsqrtf(wave_sum(s[j]) * (1.f / DM) + EPS);
#pragma unroll
            for (int q = 0; q < 4; ++q) { const f32x4 gg = ((const f32x4*)gr[j])[F.lane + 64 * q]; v2u o; o.x = pk2(v[j][q].x * r * gg.x, v[j][q].y * r * gg.y); o.y = pk2(v[j][q].z * r * gg.z, v[j][q].w * r * gg.w); ((v2u*)orow[j])[F.lane + 64 * q] = o; } }
    }
    {
        for (int r0 = gw * 4; r0 < 2 * 16384; r0 += NGW * 4) {
            f32x4 x[4][4];
#pragma unroll
            for (int j = 0; j < 4; ++j) { const int r = r0 + j; const bool isv = r >= 16384; const int e = isv ? r - 16384 : r;
                const f32x4* s = (const f32x4*)((const float*)(isv ? a.in[I_PV] : a.in[I_PU]) + (size_t)e * DM) + F.lane;
#pragma unroll
                for (int q = 0; q < 4; ++q) x[j][q] = __builtin_nontemporal_load(s + 64 * q); }
#pragma unroll
            for (int j = 0; j < 4; ++j) { const int r = r0 + j; const bool isv = r >= 16384; const int e = isv ? r - 16384 : r; float am = 0.f;
#pragma unroll
                for (int q = 0; q < 4; ++q) am = fmaxf(am, fmaxf(fmaxf(fabsf(x[j][q].x), fabsf(x[j][q].y)), fmaxf(fabsf(x[j][q].z), fabsf(x[j][q].w))));
#pragma unroll
                for (int o = 1; o < 64; o <<= 1) am = fmaxf(am, __shfl_xor(am, o));
                const float inv = am > 0.f ? 448.f / am : 0.f;
                v4u o4;
#pragma unroll
                for (int q = 0; q < 4; ++q) { int pk = __builtin_amdgcn_cvt_pk_fp8_f32(x[j][q].x * inv, x[j][q].y * inv, 0, false); pk = __builtin_amdgcn_cvt_pk_fp8_f32(x[j][q].z * inv, x[j][q].w * inv, pk, true); o4[q] = (unsigned)pk; }
                *(v4u*)(ws + (isv ? WS_V16 : WS_U16) + (size_t)e * DM + 16 * F.lane) = o4;
                if (F.lane == 0) ((float*)(ws + WS_MISC))[r] = am * (1.f / 448.f); }
        }
    }
    __syncthreads();
    for (int it = blockIdx.x; it < 256; it += F.G) {
        const int c = it >> 4, kt = it & 15, half = c & 1;
        LAS float* SK = (LAS float*)F.lds; LAS float* WT = (LAS float*)(F.lds + 128 * 129 * 4);
        const float* sk = (const float*)a.in[I_PSK] + (size_t)half * 128 * 128; const float* wq = (const float*)a.in[I_PWQ] + (size_t)(kt * 64) * 2048 + c * 128;
#pragma unroll 4
        for (int i = 0; i < 32; ++i) { const int idx = F.tid + 512 * i; SK[(idx >> 7) * 129 + (idx & 127)] = sk[idx]; }
#pragma unroll 4
        for (int i = 0; i < 16; ++i) { const int idx = F.tid + 512 * i; WT[(idx >> 7) * 129 + (idx & 127)] = wq[(size_t)(idx >> 7) * 2048 + (idx & 127)]; }
        __syncthreads();
        const int tk = F.tid & 15, tkey = F.tid >> 4;
        float acc[4][4];
#pragma unroll
        for (int i = 0; i < 4; ++i)
#pragma unroll
            for (int j = 0; j < 4; ++j) acc[i][j] = 0.f;
        for (int j = 0; j < 128; ++j) {
            float av[4], bv[4];
#pragma unroll
            for (int i = 0; i < 4; ++i) { av[i] = SK[(4 * tkey + i) * 129 + j]; bv[i] = WT[(4 * tk + i) * 129 + j]; }
#pragma unroll
            for (int i = 0; i < 4; ++i)
#pragma unroll
                for (int i2 = 0; i2 < 4; ++i2) acc[i][i2] += av[i] * bv[i2];
        }
        bf16* wp = (bf16*)(ws + WS_WPK);
#pragma unroll
        for (int i = 0; i < 4; ++i) { v2u o; o.x = pk2(acc[i][0], acc[i][1]); o.y = pk2(acc[i][2], acc[i][3]); *(v2u*)(wp + (size_t)(c * 128 + 4 * tkey + i) * DM + kt * 64 + 4 * tk) = o; }
        __syncthreads();
    }
}


__device__ __forceinline__ void fox_prompt_cumsum(const Frame& F, const float* logf  , float* kbias, int b) {
    LAS float* WT = (LAS float*)F.lds;
    const int t0 = F.wave * 1024 + F.lane * 16;
    const f32x4* src = (const f32x4*)(logf + ((size_t)b * SEQ + t0) * 8);
    float s[8];
#pragma unroll
    for (int h = 0; h < 8; ++h) s[h] = 0.f;
#pragma unroll 4
    for (int i = 0; i < 16; ++i) { const f32x4 a = src[2 * i], c = src[2 * i + 1]; s[0] += a.x; s[1] += a.y; s[2] += a.z; s[3] += a.w; s[4] += c.x; s[5] += c.y; s[6] += c.z; s[7] += c.w; }
    float ex[8];
#pragma unroll
    for (int h = 0; h < 8; ++h) { float v = s[h];
#pragma unroll
        for (int o = 1; o < 64; o <<= 1) { const float t = __shfl_up(v, o); if (F.lane >= o) v += t; }
        ex[h] = v - s[h];
        if (F.lane == 63) WT[F.wave * 8 + h] = v; }
    __syncthreads();
#pragma unroll
    for (int h = 0; h < 8; ++h) { float c = 0.f; for (int w = 0; w < F.wave; ++w) c += WT[w * 8 + h]; ex[h] += c; }
    float* dst = kbias + (size_t)(b * 8) * SEQ + t0;
#pragma unroll 4
    for (int i = 0; i < 16; ++i) { const f32x4 a = src[2 * i], c = src[2 * i + 1];
        ex[0] += a.x; ex[1] += a.y; ex[2] += a.z; ex[3] += a.w; ex[4] += c.x; ex[5] += c.y; ex[6] += c.z; ex[7] += c.w;
#pragma unroll
        for (int h = 0; h < 8; ++h) dst[(size_t)h * SEQ + i] = -ex[h] * LOG2E; }
    __syncthreads();
}
__device__ __forceinline__ void fox_sample_suffix(const Frame& F, const float* cfl, const int* pt, float* suf, int bs) {
    float carry[8];
#pragma unroll
    for (int h = 0; h < 8; ++h) carry[h] = 0.f;
    const int mypg = pt[bs * NPAGES + (F.lane & 15)];
#pragma unroll 1
    for (int pb = NPAGES - 4; pb >= 0; pb -= 4) {
        f32x4 x[4][4];
#pragma unroll
        for (int j = 0; j < 4; ++j) { const int pg = __builtin_amdgcn_readlane(mypg, 0) * 0 + __shfl(mypg, pb + j); const f32x4* src = (const f32x4*)(cfl + ((size_t)pg * PAGE + 2 * F.lane) * 8);
            x[j][0] = src[0]; x[j][1] = src[1]; x[j][2] = src[2]; x[j][3] = src[3]; }
#pragma unroll
        for (int j = 3; j >= 0; --j) { const int p = pb + j;
            const float ra[8] = {x[j][0].x, x[j][0].y, x[j][0].z, x[j][0].w, x[j][1].x, x[j][1].y, x[j][1].z, x[j][1].w}, rb[8] = {x[j][2].x, x[j][2].y, x[j][2].z, x[j][2].w, x[j][3].x, x[j][3].y, x[j][3].z, x[j][3].w};
#pragma unroll
            for (int h = 0; h < 8; ++h) {
                const float ps = ra[h] + rb[h]; float v = ps;
#pragma unroll
                for (int o = 1; o < 64; o <<= 1) { const float t = __shfl_down(v, o); if (F.lane + o < 64) v += t; }
                const float exs = v - ps;
                float* d = suf + (size_t)(bs * 8 + h) * PASTL + p * PAGE + 2 * F.lane;
                *(f32x2*)d = (f32x2){(carry[h] + exs + rb[h]) * LOG2E, (carry[h] + exs) * LOG2E};
                carry[h] += __shfl(v, 0);
            }
        }
    }
}

__device__ __forceinline__ void gla_gate_tile(const Frame& F, const float* gg, const float* w2, const float* bg, int row0, int h, int nt, LAS float* LA, LAS float* GGS) {
    for (int e = F.tid; e < nt * 16; e += NTHR) GGS[e] = gg[(size_t)row0 * 16 + e];
    const int dk = F.tid & 63; float wc[16];
#pragma unroll
    for (int r = 0; r < 16; ++r) wc[r] = w2[r * 256 + h * 64 + dk];
    const float bb = bg[h * 64 + dk];
    __syncthreads();
    for (int t = F.tid >> 6; t < nt; t += 8) { float z = bb;
#pragma unroll
        for (int q = 0; q < 4; ++q) { const f32x4 g4 = *(const LAS f32x4*)(GGS + t * 16 + 4 * q); z += g4.x * wc[4 * q] + g4.y * wc[4 * q + 1] + g4.z * wc[4 * q + 2] + g4.w * wc[4 * q + 3]; }
        LA[t * 64 + dk] = log_sigmoid(z) * (1.f / 16.f); }
}
__device__ __forceinline__ void gla_cumsum64(const Frame& F, LAS float* LA, LAS float* SEG) {
    const int dk = F.lane, w = F.wave; float v[8]; float run = 0.f;
#pragma unroll
    for (int i = 0; i < 8; ++i) { run += LA[(8 * w + i) * 64 + dk]; v[i] = run; }
    SEG[w * 64 + dk] = run;
    __syncthreads();
    float pre = 0.f;
    for (int j = 0; j < w; ++j) pre += SEG[j * 64 + dk];
#pragma unroll
    for (int i = 0; i < 8; ++i) LA[(8 * w + i) * 64 + dk] = v[i] + pre;
    __syncthreads();
}
template <int SB>
__device__ __forceinline__ bf16x8 tr_frag(LAS unsigned char* base, int ks) {
    const s16x4 lo = lds_tr16(base + ks * 16 * SB), hi4 = lds_tr16(base + ks * 16 * SB + 8 * SB);
    return (bf16x8){lo[0], lo[1], lo[2], lo[3], hi4[0], hi4[1], hi4[2], hi4[3]};
}
__device__ __forceinline__ bf16x8 row_frag(const LAS unsigned char* rowp, int ks, int hi) {
    const v2u lo = *(const LAS v2u*)(rowp + (16 * ks + 4 * hi) * 2), hi2 = *(const LAS v2u*)(rowp + (16 * ks + 8 + 4 * hi) * 2);
    return __builtin_bit_cast(bf16x8, (v4u){lo.x, lo.y, hi2.x, hi2.y});
}
__device__ __forceinline__ void gla_g1_unit(const Frame& F, const Args& a, int u) {
    unsigned char* ws = a.ws;
    const int b = u >> 9, h = (u >> 7) & 3, n = u & 127; const int row0 = b * SEQ + n * 64;
    LAS float* LA = (LAS float*)F.lds; LAS float* SEG = LA + 4096; LAS float* GGS = SEG + 512; LAS unsigned char* KRB = F.lds + 22528; LAS unsigned char* VSB = F.lds + 34816;
    v4u vq[2];
#pragma unroll
    for (int i = 0; i < 2; ++i) { const int c = F.tid + NTHR * i; vq[i] = *(const v4u*)((const bf16*)(ws + WS_GV) + (size_t)(row0 + (c >> 4)) * 512 + h * 128 + (c & 15) * 8); }
    float gkv[8];
#pragma unroll
    for (int i = 0; i < 8; ++i) { const int e = F.tid + NTHR * i; gkv[i] = GLD(ws + WS_GK)[(size_t)(row0 + (e >> 6)) * 256 + h * 64 + (e & 63)]; }
    gla_gate_tile(F, (const float*)(ws + WS_GG), (const float*)a.in[I_WG2], (const float*)a.in[I_BG], row0, h, 64, LA, GGS);
#pragma unroll
    for (int i = 0; i < 2; ++i) { const int c = F.tid + NTHR * i; *(LAS v4u*)(VSB + (c >> 4) * 320 + (c & 15) * 16) = vq[i]; }
    __syncthreads();
    gla_cumsum64(F, LA, SEG);
    if (F.tid < 64) ((float*)(ws + WS_GDEC))[(size_t)((b * 4 + h) * 128 + n) * 64 + F.tid] = __expf(LA[63 * 64 + F.tid]);
    float* bbuf = (float*)(ws + WS_BB);
#pragma unroll
    for (int i = 0; i < 8; ++i) { const int e = F.tid + NTHR * i; const int t = e >> 6, dk = e & 63; const float bb = LA[e]; bbuf[(size_t)(row0 + t) * 256 + h * 64 + dk] = bb;
        *(LAS unsigned short*)(KRB + t * 192 + dk * 2) = (unsigned short)f2bf(gkv[i] * __expf(LA[63 * 64 + dk] - bb)); }
    __syncthreads();
    {
        const int lane = F.lane, r32 = lane & 31, hi = lane >> 5, mb = F.wave >> 2, nb = F.wave & 3;
        const int tb = (4 * hi + ((lane & 15) >> 2)), tc = (16 * ((lane >> 4) & 1) + 4 * (lane & 3)) * 2;
        LAS unsigned char* abase = KRB + tb * 192 + tc + 64 * mb; LAS unsigned char* bbase = VSB + tb * 320 + tc + 64 * nb;
        f32x16 acc = {};
#pragma unroll
        for (int ks = 0; ks < 4; ++ks) acc = __builtin_amdgcn_mfma_f32_32x32x16_bf16(tr_frag<192>(abase, ks), tr_frag<320>(bbase, ks), acc, 0, 0, 0);
        float* kv = (float*)(ws + WS_GKV) + ((size_t)((b * 4 + h) * 128 + n) * 64 + 32 * mb) * 128 + 32 * nb + r32;
#pragma unroll
        for (int r = 0; r < 16; ++r) kv[(size_t)crow(r, hi) * 128] = acc[r];
    }
    __syncthreads();
}
__device__ __forceinline__ void gla_scan(const Frame& F, const Args& a) {
    int tid = F.wave * 64 + lane_id(); asm volatile("" : "+v"(tid));
    if (tid >= 256) return;
    for (int e = F.vcu * 256 + tid; e < 65536; e += F.G * 256) {
    const int bh = e >> 13, dk = (e >> 7) & 63, dv = e & 127;
    float* kv = (float*)(a.ws + WS_GKV) + ((size_t)bh * 128 * 64 + dk) * 128 + dv; const float* dc = (const float*)(a.ws + WS_GDEC) + (size_t)bh * 128 * 64 + dk;
    float S = 0.f;
#pragma unroll 1
    for (int n0 = 0; n0 < 128; n0 += 32) { float kvv[32], dd[32];
#pragma unroll
        for (int j = 0; j < 32; ++j) { kvv[j] = kv[(size_t)(n0 + j) * 8192]; dd[j] = dc[(size_t)(n0 + j) * 64]; }
#pragma unroll
        for (int j = 0; j < 32; ++j) { kv[(size_t)(n0 + j) * 8192] = S; S = dd[j] * S + kvv[j]; } }
    a.out[O_GSP + (size_t)bh * 8192 + dk * 128 + dv] = S;
    }
}
__device__ __forceinline__ float silu(float x) { return x / (1.f + __expf(-x)); }
__device__ __forceinline__ void gla_sample_unit(const Frame& F, const Args& a, int u) {
    unsigned char* ws = a.ws;
    const int bs = u >> 2, h = u & 3; const int row0 = TP + bs * LS;
    LAS float* LA = (LAS float*)F.lds; LAS float* BL = LA + 512; LAS float* QD = BL + 64; LAS float* KI = QD + 512; LAS float* KR = KI + 512; LAS float* ATT = KR + 512; LAS float* OP = ATT + 64; LAS float* VS = OP + 4096;
    gla_gate_tile(F, (const float*)(ws + WS_GG), (const float*)a.in[I_WG2], (const float*)a.in[I_BG], row0, h, 8, LA, VS + 1024);
#pragma unroll
    for (int i = 0; i < 2; ++i) { const int e = F.tid + NTHR * i; VS[e] = GLD(ws + WS_GV)[(size_t)(row0 + (e >> 7)) * 512 + h * 128 + (e & 127)]; }
    __syncthreads();
    if (F.tid < 64) { float run = 0.f;
#pragma unroll
        for (int t = 0; t < 8; ++t) { run += LA[t * 64 + F.tid]; LA[t * 64 + F.tid] = run; } BL[F.tid] = run; }
    __syncthreads();
    { const int e = F.tid, t = e >> 6, dk = e & 63; const float bb = LA[e];
      const float q = GLD(ws + WS_GQ)[(size_t)(row0 + t) * 256 + h * 64 + dk], k = GLD(ws + WS_GK)[(size_t)(row0 + t) * 256 + h * 64 + dk];
      QD[e] = q * __expf(bb); KI[e] = k * __expf(-bb); KR[e] = k * __expf(BL[dk] - bb); }
    __syncthreads();
    if (F.tid < 64) { const int t = F.tid >> 3, s = F.tid & 7; float acc = 0.f;
        if (s <= t) { for (int dk = 0; dk < 64; ++dk) acc += QD[t * 64 + dk] * KI[s * 64 + dk]; }
        ATT[F.tid] = acc; }
    const int dv = F.tid & 127, dkg = F.tid >> 7;
    {
        const float* st = (const float*)a.in[I_SGLA] + ((size_t)(bs * 4 + h) * 64 + dkg * 16) * 128 + dv;
        float S0[16];
#pragma unroll
        for (int i = 0; i < 16; ++i) S0[i] = st[(size_t)i * 128];
#pragma unroll
        for (int t = 0; t < 8; ++t) { float o = 0.f;
#pragma unroll
            for (int i = 0; i < 16; ++i) o += QD[t * 64 + dkg * 16 + i] * S0[i];
            OP[(dkg * 8 + t) * 128 + dv] = o; }
        float* so = a.out + O_GSS + ((size_t)(bs * 4 + h) * 64 + dkg * 16) * 128 + dv;
#pragma unroll
        for (int i = 0; i < 16; ++i) { float sn = __expf(BL[dkg * 16 + i]) * S0[i];
#pragma unroll
            for (int t = 0; t < 8; ++t) sn += KR[t * 64 + dkg * 16 + i] * VS[t * 128 + dv];
            so[(size_t)i * 128] = sn; }
    }
    __syncthreads();
    {
        const int t = F.wave; float o[2]; float ss = 0.f;
#pragma unroll
        for (int j = 0; j < 2; ++j) { const int d = 2 * F.lane + j; float v = OP[(0 * 8 + t) * 128 + d] + OP[(1 * 8 + t) * 128 + d] + OP[(2 * 8 + t) * 128 + d] + OP[(3 * 8 + t) * 128 + d];
            for (int s = 0; s <= t; ++s) v += ATT[t * 8 + s] * VS[s * 128 + d];
            o[j] = v; ss += v * v; }
        const float r = rsqrtf(wave_sum(ss) * (1.f / 128.f) + EPS);
        const float* ggo = (const float*)a.in[I_GGO] + h * 128 + 2 * F.lane; const BfPtr gr = GLD(ws + WS_GR) + ((size_t)(row0 + t) * 512 + h * 128 + 2 * F.lane);
        const float y0 = o[0] * r * ggo[0] * silu(gr[0]), y1 = o[1] * r * ggo[1] * silu(gr[1]);
        *(unsigned*)((bf16*)(ws + WS_MERGED) + (size_t)(row0 + t) * DM + 512 + h * 128 + 2 * F.lane) = pk2(y0, y1);
    }
    __syncthreads();
}


__device__ __forceinline__ float fexp2(float x) { return __builtin_amdgcn_exp2f(x); }
constexpr float FOX_SKIP = 160.f;


__device__ __forceinline__ void fox_norms_item(const Frame& F, const bf16* QF, const bf16* KF, const float* logf, float* FN, float* LC, float* BT, int item) {
    const int bh = item >> 5, qb = item & 31, b = bh >> 3, h = bh & 7;
    float qm = 0.f, km = 0.f;
    const float* lp = logf + ((size_t)b * SEQ + qb * 256 + 4 * F.lane) * 8 + h;
    const float l0 = lp[0], l1 = lp[8], l2 = lp[16], l3 = lp[24];
#pragma unroll 8
    for (int i = 0; i < 32; ++i) { const size_t row = (size_t)b * SEQ + qb * 256 + i * 8 + (F.lane >> 3);
        const v4u q = *(const v4u*)(QF + row * 512 + h * 64 + (F.lane & 7) * 8), k = *(const v4u*)(KF + row * 512 + h * 64 + (F.lane & 7) * 8); float qs = 0.f, ks = 0.f;
#pragma unroll
        for (int j = 0; j < 4; ++j) { qs += bflo(q[j]) * bflo(q[j]) + bfhi(q[j]) * bfhi(q[j]); ks += bflo(k[j]) * bflo(k[j]) + bfhi(k[j]) * bfhi(k[j]); }
        qs = sum8_f32(qs); ks = sum8_f32(ks);
        qm = fmaxf(qm, qs); km = fmaxf(km, ks); }
#pragma unroll
    for (int o = 1; o < 64; o <<= 1) { qm = fmaxf(qm, __shfl_xor(qm, o)); km = fmaxf(km, __shfl_xor(km, o)); }
    const float c0 = l0, c1 = c0 + l1, c2 = c1 + l2, c3 = c2 + l3; float v = c3;
#pragma unroll
    for (int o = 1; o < 64; o <<= 1) { const float t = __shfl_up(v, o); if (F.lane >= o) v += t; }
    const float ex = v - c3;
    *(f32x4*)(LC + (size_t)bh * SEQ + qb * 256 + 4 * F.lane) = (f32x4){ex + c0, ex + c1, ex + c2, ex + c3};
    if (F.lane == 63) BT[item] = v;
    if (F.lane == 0) { FN[item * 2] = qm; FN[item * 2 + 1] = km; }
}
__device__ __forceinline__ void fox_suffix_item(const Frame& F, const float* cfl, const int* pt, float* SW, float* PTOT, int item) {
    const int bs = item >> 4, p = item & 15; const int pg = __builtin_amdgcn_readfirstlane(pt[item]);
    const f32x4* src = (const f32x4*)(cfl + ((size_t)pg * PAGE + 2 * F.lane) * 8);
    const f32x4 a0 = src[0], a1 = src[1], b0 = src[2], b1 = src[3];
    const float ra[8] = {a0.x, a0.y, a0.z, a0.w, a1.x, a1.y, a1.z, a1.w}, rb[8] = {b0.x, b0.y, b0.z, b0.w, b1.x, b1.y, b1.z, b1.w};
#pragma unroll
    for (int h = 0; h < 8; ++h) {
        const float ps = ra[h] + rb[h]; float v = ps;
#pragma unroll
        for (int o = 1; o < 64; o <<= 1) { const float t = __shfl_down(v, o); if (F.lane + o < 64) v += t; }
        const float exs = v - ps;
        *(f32x2*)(SW + (size_t)(bs * 8 + h) * PASTL + p * PAGE + 2 * F.lane) = (f32x2){exs + rb[h], exs};
        if (F.lane == 0) PTOT[(bs * 8 + h) * NPAGES + p] = v;
    }
}
__device__ __forceinline__ void fox_attn_unit(const Frame& F, const bf16* QF, const bf16* KF, const bf16* VF, const float* LC, const float* BT, const float* FN, bf16* merged, int b, int h, int qb) {
    int tid = F.wave * 64 + lane_id(); asm volatile("" : "+v"(tid));
    const int lane = tid & 63, r32 = lane & 31, hi = lane >> 5, wid = F.wave;
    const size_t rowbase = (size_t)b * SEQ; const int q0 = qb * 256;
    LAS unsigned char* Ks = F.lds; LAS unsigned char* Vs = F.lds + 8192; LAS float* KBs = (LAS float*)(F.lds + 20480); LAS float* WSF = (LAS float*)(F.lds + 20736) + wid * 32;
    const bf16* Qw = QF + (rowbase + q0 + wid * 32 + r32) * 512 + h * 64;
    bf16x8 qr[4];
#pragma unroll
    for (int d0 = 0; d0 < 4; ++d0) qr[d0] = *(const bf16x8*)(Qw + d0 * 16 + hi * 8);
    const float* lcp = LC + (size_t)(b * 8 + h) * SEQ;
    float pbx; { const float btv = (lane < 32) ? BT[(b * 8 + h) * 32 + lane] : 0.f; float v = btv;
#pragma unroll
        for (int o = 1; o < 64; o <<= 1) { const float t = __shfl_up(v, o); if (lane >= o) v += t; }
        pbx = v - btv; }
    const float cref = lcp[q0] + __shfl(pbx, qb);
#define FOX_KB(t_, pos_) (-LOG2E * ((lcp[pos_] + __shfl(pbx, (t_) >> 2)) - cref))
    const int NT = (q0 + 256) / 64;
    int t0 = 0;
    {
        float kn = (lane < 32) ? FN[((b * 8 + h) * 32 + lane) * 2 + 1] : 0.f;
#pragma unroll
        for (int o = 1; o < 64; o <<= 1) kn = fmaxf(kn, __shfl_xor(kn, o));
        const float qk2 = 2.f * sqrtf(FN[((b * 8 + h) * 32 + qb) * 2]) * sqrtf(kn) * 1.01f;
        const int nbefore = q0 / 64;
        int found = -1;
        for (int base = 0; base < nbefore && found < 0; base += 64) {
            const int tl = nbefore - 1 - base - lane;
            const int tlc = tl < 0 ? 0 : tl; const float kbl = -LOG2E * ((lcp[tlc * 64 + 63] + __shfl(pbx, tlc >> 2)) - cref);
            const bool dead = (tl >= 0) && (qk2 + kbl < -FOX_SKIP);
            const unsigned long long bm = __ballot(dead);
            if (bm) found = nbefore - 1 - base - (int)__builtin_ctzll(bm);
        }
        t0 = found + 1;
        t0 = __builtin_amdgcn_readfirstlane(t0);
    }
    const int kkey = tid >> 3, kch = tid & 7, vkey = tid >> 3, vch = tid & 7;
    const bf16* ksrc = KF + (rowbase + kkey) * 512 + h * 64 + kch * 8;
    const bf16* vsrc = VF + (rowbase + vkey) * 512 + h * 64 + vch * 8;
    v4u kreg[2], vreg[2]; float kbreg[2];
#pragma unroll
    for (int hb = 0; hb < 2; ++hb) { const int tt = (t0 + hb < NT) ? t0 + hb : t0;
        kreg[hb] = *(const v4u*)(ksrc + (size_t)tt * 64 * 512); vreg[hb] = *(const v4u*)(vsrc + (size_t)tt * 64 * 512); kbreg[hb] = FOX_KB(tt, tt * 64 + (tid & 63)); }
    float m_run = -INFINITY, l_run = 0.f; f32x16 o0 = {}, o1 = {};
    const int qpos = q0 + wid * 32 + r32;
    const int vbase = (4 * hi + ((lane & 15) >> 2)) * 192 + (16 * ((lane >> 4) & 1) + 4 * (lane & 3)) * 2;
    LAS unsigned char* const Ks0 = Ks; LAS unsigned char* const Vs0 = Vs; LAS float* const KBs0 = KBs;
    __syncthreads();
    for (int t2 = t0; t2 < NT; t2 += 2) {
#pragma unroll
      for (int hb = 0; hb < 2; ++hb) {
        const int t = t2 + hb;
        if (t < NT) {
        LAS unsigned char* const Ks = Ks0 + hb * 28672; LAS unsigned char* const Vs = Vs0 + hb * 28672; LAS float* const KBs = (LAS float*)((LAS unsigned char*)KBs0 + hb * 28672);
        *(LAS v4u*)(Ks + kkey * 128 + ((kch ^ (kkey & 7)) << 4)) = kreg[hb];            *(LAS v4u*)(Vs + vkey * 192 + vch * 16) = vreg[hb]; if (tid < 64) KBs[tid] = kbreg[hb];
        __syncthreads();
        if (t + 2 < NT) { kreg[hb] = *(const v4u*)(ksrc + (size_t)(t + 2) * 64 * 512); vreg[hb] = *(const v4u*)(vsrc + (size_t)(t + 2) * 64 * 512); kbreg[hb] = FOX_KB(t + 2, (t + 2) * 64 + (tid & 63)); }
        const int k0 = t * 64;
        if (k0 <= q0 + wid * 32 + 31) {
        f32x16 p0, p1;
#pragma unroll
        for (int g = 0; g < 4; ++g) { const f32x4 ba = *(const LAS f32x4*)(KBs + 8 * g + 4 * hi), bb = *(const LAS f32x4*)(KBs + 32 + 8 * g + 4 * hi);
#pragma unroll
            for (int i = 0; i < 4; ++i) { p0[4 * g + i] = ba[i]; p1[4 * g + i] = bb[i]; } }
#pragma unroll
        for (int d0 = 0; d0 < 4; ++d0) {
            const bf16x8 a0 = *(const LAS bf16x8*)(Ks + r32 * 128 + (((2 * d0 + hi) ^ (r32 & 7)) << 4)), a1 = *(const LAS bf16x8*)(Ks + (r32 + 32) * 128 + (((2 * d0 + hi) ^ (r32 & 7)) << 4));
            p0 = __builtin_amdgcn_mfma_f32_32x32x16_bf16(a0, qr[d0], p0, 0, 0, 0); p1 = __builtin_amdgcn_mfma_f32_32x32x16_bf16(a1, qr[d0], p1, 0, 0, 0);
        }
        if (k0 + 63 > q0 + wid * 32) {
#pragma unroll
            for (int r = 0; r < 16; ++r) { const int key = k0 + crow(r, hi); if (key > qpos) p0[r] = -INFINITY; if (key + 32 > qpos) p1[r] = -INFINITY; }
        }
        float mx = fmaxf(p0[0], p1[0]);
#pragma unroll
        for (int r = 1; r < 16; ++r) mx = fmaxf(mx, fmaxf(p0[r], p1[r]));
        mx = fmaxf(mx, __shfl_xor(mx, 32));
        const float m_new = fmaxf(m_run, mx), alpha = fexp2(m_run - m_new); m_run = m_new;
        float ls = 0.f;
#pragma unroll
        for (int r = 0; r < 16; ++r) { p0[r] = fexp2(p0[r] - m_new); p1[r] = fexp2(p1[r] - m_new); ls += p0[r] + p1[r]; }
        l_run = l_run * alpha + ls;
        if (__ballot(alpha != 1.f) != 0ull) {
            if (hi == 0) WSF[r32] = alpha;
#pragma unroll
            for (int g = 0; g < 4; ++g) { const f32x4 al = *(const LAS f32x4*)(WSF + 8 * g + 4 * hi);
#pragma unroll
                for (int i = 0; i < 4; ++i) { o0[4 * g + i] *= al[i]; o1[4 * g + i] *= al[i]; } }
        }
        v4u pw[4];
#pragma unroll
        for (int j = 0; j < 4; ++j) { pw[0][j] = pg8::cvt_pk_bf16(p0[2 * j], p0[2 * j + 1]); pw[1][j] = pg8::cvt_pk_bf16(p0[8 + 2 * j], p0[8 + 2 * j + 1]);
                                      pw[2][j] = pg8::cvt_pk_bf16(p1[2 * j], p1[2 * j + 1]); pw[3][j] = pg8::cvt_pk_bf16(p1[8 + 2 * j], p1[8 + 2 * j + 1]); }
#pragma unroll
        for (int ks = 0; ks < 4; ++ks) {
            const bf16x8 pa = __builtin_bit_cast(bf16x8, pw[ks]);
#pragma unroll
            for (int d0 = 0; d0 < 2; ++d0) {
                const s16x4 lo = lds_tr16(Vs + vbase + ks * 16 * 192 + d0 * 64), hi4 = lds_tr16(Vs + vbase + ks * 16 * 192 + 8 * 192 + d0 * 64);
                const bf16x8 vb = (bf16x8){lo[0], lo[1], lo[2], lo[3], hi4[0], hi4[1], hi4[2], hi4[3]};
                if (d0 == 0) o0 = __builtin_amdgcn_mfma_f32_32x32x16_bf16(pa, vb, o0, 0, 0, 0); else o1 = __builtin_amdgcn_mfma_f32_32x32x16_bf16(pa, vb, o1, 0, 0, 0);
            }
        }
        }
        }
      }
    }
    l_run += __shfl_xor(l_run, 32);
    if (hi == 0) WSF[r32] = 1.f / l_run;
    bf16* Ow = merged + (rowbase + q0 + wid * 32) * DM + h * 64 + r32;
#pragma unroll
    for (int g = 0; g < 4; ++g) { const f32x4 rl = *(const LAS f32x4*)(WSF + 8 * g + 4 * hi);
#pragma unroll
        for (int i = 0; i < 4; ++i) { const int r = 4 * g + i; const int row = crow(r, hi);
            Ow[(size_t)row * DM] = (bf16)f2bf(o0[r] * rl[i]); Ow[(size_t)row * DM + 32] = (bf16)f2bf(o1[r] * rl[i]); } }
    __syncthreads();
#undef FOX_KB
}

template <int D> struct DecW {
    static constexpr int KS = D / 32;
    static constexpr int LPK = D / 4;
    static constexpr int KPI = 64 / LPK;
    float m[4], l[4]; float o[8][4];
};
template <int D>
__device__ __forceinline__ void dec_init(DecW<D>& w) {
#pragma unroll
    for (int i = 0; i < 4; ++i) { w.m[i] = -INFINITY; w.l[i] = 0.f; }
#pragma unroll
    for (int q = 0; q < 8; ++q)
#pragma unroll
        for (int j = 0; j < 4; ++j) w.o[q][j] = 0.f;
}
template <int D, int NTILE, int MODE>
__device__ __forceinline__ void dec_chunk(DecW<D>& w, const bf16x8 (&qa)[D / 32], const float* Kb, const float* Vb, int stride, const float* bias, float nb, LAS float* PL, int lane) {
    constexpr int KS = D / 32, LPK = D / 4, KPI = 64 / LPK;
    constexpr int NK = (MODE == 1) ? 8 : NTILE * 16, NV = NK / KPI;
    const int key = lane & 15, kq = lane >> 4;
    const unsigned koff = (unsigned)(key * stride + 8 * kq) * 4u;
    const int d4 = lane % LPK, ksub = lane / LPK;
    const unsigned voff = (unsigned)(ksub * stride + 4 * d4) * 4u;
    f32x4 kx[NTILE][2 * KS], vx[NV];
#pragma unroll
    for (int t = 0; t < NTILE; ++t) { const char* kp = (const char*)(Kb + (size_t)t * 16 * stride) + koff;
#pragma unroll
        for (int ks = 0; ks < KS; ++ks) { kx[t][2 * ks] = *(const f32x4*)(kp + 128 * ks); kx[t][2 * ks + 1] = *(const f32x4*)(kp + 128 * ks + 16); } }
    constexpr int NVA = (NV >= 8) ? NV / 2 : NV;
#pragma unroll
    for (int kk = 0; kk < NVA; ++kk) vx[kk] = *(const f32x4*)((const char*)(Vb + (size_t)kk * KPI * stride) + voff);
    f32x4 s[NTILE];
#pragma unroll
    for (int t = 0; t < NTILE; ++t) {
        f32x4 acc = {0.f, 0.f, 0.f, 0.f};
#pragma unroll
        for (int ks = 0; ks < KS; ++ks) { const f32x4 x0 = kx[t][2 * ks], x1 = kx[t][2 * ks + 1];
            v4u kb; kb.x = pg8::cvt_pk_bf16(x0.x, x0.y); kb.y = pg8::cvt_pk_bf16(x0.z, x0.w); kb.z = pg8::cvt_pk_bf16(x1.x, x1.y); kb.w = pg8::cvt_pk_bf16(x1.z, x1.w);
            acc = __builtin_amdgcn_mfma_f32_16x16x32_bf16(qa[ks], __builtin_bit_cast(bf16x8, kb), acc, 0, 0, 0); }
        if (MODE == 0) { if (bias) { const float bv = (bias[t * 16 + key] + nb) * LOG2E; acc += bv; } }
        else { acc += nb;
#pragma unroll
            for (int i = 0; i < 4; ++i) if (key > 4 * kq + i || key >= 8) acc[i] = -INFINITY; }
        s[t] = acc;
    }
#pragma unroll
    for (int kk = NVA; kk < NV; ++kk) vx[kk] = *(const f32x4*)((const char*)(Vb + (size_t)kk * KPI * stride) + voff);
    f32x4 mc = s[0];
#pragma unroll
    for (int t = 1; t < NTILE; ++t) { mc.x = fmaxf(mc.x, s[t].x); mc.y = fmaxf(mc.y, s[t].y); mc.z = fmaxf(mc.z, s[t].z); mc.w = fmaxf(mc.w, s[t].w); }
    mc.x = max16_f32(mc.x); mc.y = max16_f32(mc.y); mc.z = max16_f32(mc.z); mc.w = max16_f32(mc.w);
    float al[4];
#pragma unroll
    for (int i = 0; i < 4; ++i) { const float mn = fmaxf(w.m[i], mc[i]); al[i] = (mn == -INFINITY) ? 1.f : fexp2(w.m[i] - mn); w.m[i] = mn; w.l[i] *= al[i]; }
#pragma unroll
    for (int t = 0; t < NTILE; ++t) { f32x4 p;
#pragma unroll
        for (int i = 0; i < 4; ++i) { p[i] = (w.m[i] == -INFINITY) ? 0.f : fexp2(s[t][i] - w.m[i]); w.l[i] += p[i]; }
        if (kq < 2) *(LAS f32x4*)(PL + (t * 16 + key) * 8 + 4 * kq) = p; }
    if (key == 0 && kq < 2) *(LAS f32x4*)(PL + 1024 + 4 * kq) = (f32x4){al[0], al[1], al[2], al[3]};
    { const f32x4 a0 = *(const LAS f32x4*)(PL + 1024), a1 = *(const LAS f32x4*)(PL + 1028);
#pragma unroll
      for (int j = 0; j < 4; ++j) { w.o[0][j] *= a0.x; w.o[1][j] *= a0.y; w.o[2][j] *= a0.z; w.o[3][j] *= a0.w; w.o[4][j] *= a1.x; w.o[5][j] *= a1.y; w.o[6][j] *= a1.z; w.o[7][j] *= a1.w; } }
#pragma unroll
    for (int kk = 0; kk < NV; ++kk) { const int k = kk * KPI + ksub;
        const f32x4 v = vx[kk];
        const f32x4 pa = *(const LAS f32x4*)(PL + k * 8), pb = *(const LAS f32x4*)(PL + k * 8 + 4);
#pragma unroll
        for (int j = 0; j < 4; ++j) { w.o[0][j] += pa.x * v[j]; w.o[1][j] += pa.y * v[j]; w.o[2][j] += pa.z * v[j]; w.o[3][j] += pa.w * v[j];
                                      w.o[4][j] += pb.x * v[j]; w.o[5][j] += pb.y * v[j]; w.o[6][j] += pb.z * v[j]; w.o[7][j] += pb.w * v[j]; } }
}
__device__ __forceinline__ void dec_page_fox(DecW<64>& w, const bf16x8 (&qa)[2], const float* Kb, const float* Vb, const float* bias, float boff, LAS float* PL, int lane) {
    constexpr int stride = 512;
    const int key = lane & 15, kq = lane >> 4;
    const unsigned koff = (unsigned)(key * stride + 8 * kq) * 4u;
    const int d4 = lane & 15, ksub = lane >> 4;
    const unsigned voff = (unsigned)(ksub * stride + 4 * d4) * 4u;
    const __amdgpu_buffer_rsrc_t krs = __builtin_amdgcn_make_buffer_rsrc((void*)Kb, 0, 0x7fffffff, 0x00020000);
    const __amdgpu_buffer_rsrc_t vrs = __builtin_amdgcn_make_buffer_rsrc((void*)Vb, 0, 0x7fffffff, 0x00020000);
    const __amdgpu_buffer_rsrc_t brs = __builtin_amdgcn_make_buffer_rsrc((void*)bias, 0, 0x7fffffff, 0x00020000);
    f32x4 s[8];
#pragma unroll
    for (int hb = 0; hb < 2; ++hb) {
        f32x4 kx[4][4];
#pragma unroll
        for (int t = 0; t < 4; ++t) { const int so = (hb * 4 + t) * 16 * stride * 4;
            kx[t][0] = __builtin_bit_cast(f32x4, __builtin_amdgcn_raw_buffer_load_b128(krs, (int)koff, so, 0)); kx[t][1] = __builtin_bit_cast(f32x4, __builtin_amdgcn_raw_buffer_load_b128(krs, (int)koff + 16, so, 0));
            kx[t][2] = __builtin_bit_cast(f32x4, __builtin_amdgcn_raw_buffer_load_b128(krs, (int)koff + 128, so, 0)); kx[t][3] = __builtin_bit_cast(f32x4, __builtin_amdgcn_raw_buffer_load_b128(krs, (int)koff + 144, so, 0)); }
#pragma unroll
        for (int t = 0; t < 4; ++t) {
            f32x4 acc = {0.f, 0.f, 0.f, 0.f};
#pragma unroll
            for (int ks = 0; ks < 2; ++ks) { const f32x4 x0 = kx[t][2 * ks], x1 = kx[t][2 * ks + 1];
                v4u kb; kb.x = pg8::cvt_pk_bf16(x0.x, x0.y); kb.y = pg8::cvt_pk_bf16(x0.z, x0.w); kb.z = pg8::cvt_pk_bf16(x1.x, x1.y); kb.w = pg8::cvt_pk_bf16(x1.z, x1.w);
                acc = __builtin_amdgcn_mfma_f32_16x16x32_bf16(qa[ks], __builtin_bit_cast(bf16x8, kb), acc, 0, 0, 0); }
            acc += (__builtin_bit_cast(float, __builtin_amdgcn_raw_buffer_load_b32(brs, key * 4, (hb * 4 + t) * 64, 0)) + boff) * LOG2E;
            s[hb * 4 + t] = acc;
        }
        asm volatile("" ::: "memory");
    }
    f32x4 mc = s[0];
#pragma unroll
    for (int t = 1; t < 8; ++t) { mc.x = fmaxf(mc.x, s[t].x); mc.y = fmaxf(mc.y, s[t].y); mc.z = fmaxf(mc.z, s[t].z); mc.w = fmaxf(mc.w, s[t].w); }
    mc.x = max16_f32(mc.x); mc.y = max16_f32(mc.y); mc.z = max16_f32(mc.z); mc.w = max16_f32(mc.w);
    float al[4];
#pragma unroll
    for (int i = 0; i < 4; ++i) { const float mn = fmaxf(w.m[i], mc[i]); al[i] = fexp2(w.m[i] - mn); w.m[i] = mn; w.l[i] *= al[i]; }
    bool nz = false;
#pragma unroll
    for (int t = 0; t < 8; ++t) { f32x4 p;
#pragma unroll
        for (int i = 0; i < 4; ++i) { p[i] = fexp2(s[t][i] - w.m[i]); w.l[i] += p[i]; nz = nz || (p[i] != 0.f); }
        if (kq < 2) *(LAS f32x4*)(PL + (t * 16 + key) * 8 + 4 * kq) = p; }
    if (__ballot(nz && kq < 2) == 0ull) return;
    if (key == 0 && kq < 2) *(LAS f32x4*)(PL + 1024 + 4 * kq) = (f32x4){al[0], al[1], al[2], al[3]};
    { const f32x4 a0 = *(const LAS f32x4*)(PL + 1024), a1 = *(const LAS f32x4*)(PL + 1028);
#pragma unroll
      for (int j = 0; j < 4; ++j) { w.o[0][j] *= a0.x; w.o[1][j] *= a0.y; w.o[2][j] *= a0.z; w.o[3][j] *= a0.w; w.o[4][j] *= a1.x; w.o[5][j] *= a1.y; w.o[6][j] *= a1.z; w.o[7][j] *= a1.w; } }
#pragma unroll 1
    for (int vh = 0; vh < 2; ++vh) {
    f32x4 vx[16];
#pragma unroll
    for (int kk = 0; kk < 16; ++kk) vx[kk] = __builtin_bit_cast(f32x4, __builtin_amdgcn_raw_buffer_load_b128(vrs, (int)voff, (vh * 16 + kk) * 4 * stride * 4, 0));
#pragma unroll
    for (int kk = 0; kk < 16; ++kk) { const int k = (vh * 16 + kk) * 4 + ksub;
        const f32x4 v = vx[kk];
        const f32x4 pa = *(const LAS f32x4*)(PL + k * 8), pb = *(const LAS f32x4*)(PL + k * 8 + 4);
#pragma unroll
        for (int j = 0; j < 4; ++j) { w.o[0][j] += pa.x * v[j]; w.o[1][j] += pa.y * v[j]; w.o[2][j] += pa.z * v[j]; w.o[3][j] += pa.w * v[j];
                                      w.o[4][j] += pb.x * v[j]; w.o[5][j] += pb.y * v[j]; w.o[6][j] += pb.z * v[j]; w.o[7][j] += pb.w * v[j]; } }
    }
}
template <int D>
__device__ __forceinline__ void dec_park(DecW<D>& w, LAS float* CBw, int lane) {
    constexpr int LPK = D / 4;
    const int key = lane & 15, kq = lane >> 4, d4 = lane % LPK, ksub = lane / LPK;
#pragma unroll
    for (int i = 0; i < 4; ++i) { float l = w.l[i];
        l = sum16_f32(l);
        w.l[i] = l; }
    if (key == 0 && kq < 2) { *(LAS f32x4*)(CBw + 4 * kq) = (f32x4){w.m[0], w.m[1], w.m[2], w.m[3]}; *(LAS f32x4*)(CBw + 8 + 4 * kq) = (f32x4){w.l[0], w.l[1], w.l[2], w.l[3]}; }
#pragma unroll
    for (int q = 0; q < 8; ++q) { f32x4 v = (f32x4){w.o[q][0], w.o[q][1], w.o[q][2], w.o[q][3]};
        if (LPK < 64) {
#pragma unroll
            for (int o = LPK; o < 64; o <<= 1) { if (o == 16) { v.x += xor16_f32(v.x); v.y += xor16_f32(v.y); v.z += xor16_f32(v.z); v.w += xor16_f32(v.w); }
                else { v.x += __shfl_xor(v.x, o); v.y += __shfl_xor(v.y, o); v.z += __shfl_xor(v.z, o); v.w += __shfl_xor(v.w, o); } } }
        if (ksub == 0) *(LAS f32x4*)(CBw + 16 + q * D + 4 * d4) = v; }
}
template <int D>
__device__ __forceinline__ void dec_combine(int tid, LAS float* CB, bf16* dst, int ldd) {
    constexpr int WSTR = 16 + 8 * D;
    for (int e = tid; e < 8 * D; e += NTHR) { const int q = e / D, d = e % D;
        float mt = -INFINITY;
#pragma unroll
        for (int w = 0; w < 8; ++w) mt = fmaxf(mt, CB[w * WSTR + q]);
        float num = 0.f, den = 0.f;
#pragma unroll
        for (int w = 0; w < 8; ++w) { const float mw = CB[w * WSTR + q]; const float f = (mw == -INFINITY) ? 0.f : fexp2(mw - mt); num += f * CB[w * WSTR + 16 + q * D + d]; den += f * CB[w * WSTR + 8 + q]; }
        dst[(size_t)q * ldd + d] = (bf16)f2bf(num / den); }
}
template <int D>
__device__ __forceinline__ void dec_load_q(bf16x8 (&qa)[D / 32], const bf16* Q, int ldq, int lane) {
    const int row = lane & 15, kq = lane >> 4;
#pragma unroll
    for (int ks = 0; ks < D / 32; ++ks) { v4u z = {0u, 0u, 0u, 0u}; if (row < 8) z = *(const v4u*)(Q + (size_t)row * ldq + 32 * ks + 8 * kq); qa[ks] = __builtin_bit_cast(bf16x8, z); }
}
constexpr int DEC_PL = 1040;
__device__ __forceinline__ void fox_sample_unit(const Frame& F, const Args& a, int u) {
    unsigned char* ws = a.ws; const int bs = u >> 3, h = u & 7;
    int ln = lane_id(); asm volatile("" : "+v"(ln));
    LAS float* PL = (LAS float*)F.lds + F.wave * DEC_PL; LAS float* CB = (LAS float*)F.lds + 8 * DEC_PL; constexpr int WSTR = 16 + 8 * 64;
    bf16x8 qa[2]; dec_load_q<64>(qa, (const bf16*)(ws + WS_QF) + (size_t)(TP + bs * LS) * 512 + h * 64, 512, ln);
    DecW<64> w; dec_init(w);
    {
        const int key = ln & 15; const float* lf = a.out + O_LFS + (size_t)(bs * LS) * 8 + h; float cn = 0.f;
#pragma unroll
        for (int j = 0; j < 8; ++j) { const float x = lf[j * 8]; cn += (j <= key) ? x : 0.f; }
        const float* Kb = a.out + O_FKS + (size_t)(bs * LS) * 512 + h * 64; const float* Vb = a.out + O_FVS + (size_t)(bs * LS) * 512 + h * 64;
        dec_chunk<64, 1, 1>(w, qa, Kb, Vb, 512, nullptr, -cn * LOG2E, PL, ln);
        if (F.wave != 0) {
#pragma unroll
            for (int i = 0; i < 4; ++i) w.l[i] = 0.f;
#pragma unroll
            for (int q = 0; q < 8; ++q)
#pragma unroll
                for (int j = 0; j < 4; ++j) w.o[q][j] = 0.f; }
    }
    const int* pt = (const int*)a.in[I_PT];
    float spx; { const float ptv = (ln < 16) ? ((const float*)(ws + WS_MISC + 2 * MiB))[(bs * 8 + h) * NPAGES + ln] : 0.f; float v = ptv;
#pragma unroll
        for (int o = 1; o < 16; o <<= 1) { const float t = __builtin_bit_cast(float, __builtin_amdgcn_ds_bpermute((ln + o) << 2, __builtin_bit_cast(int, v))); if (ln + o < 16) v += t; }
        spx = v - ptv; }
#if defined(OLD_FOXS)
#pragma unroll 1
    for (int pp = 0; pp < 4; ++pp) { const int p = F.wave * 2 + (pp >> 1), hf = pp & 1; const int pg = __builtin_amdgcn_readfirstlane(pt[bs * NPAGES + p]);
        const float* Kb = (const float*)a.in[I_CFK] + (((size_t)pg * PAGE + hf * 64) * 8 + h) * 64; const float* Vb = (const float*)a.in[I_CFV] + (((size_t)pg * PAGE + hf * 64) * 8 + h) * 64;
        dec_chunk<64, 4, 0>(w, qa, Kb, Vb, 512, (const float*)(ws + WS_SUF) + (size_t)(bs * 8 + h) * PASTL + p * PAGE + hf * 64, __builtin_bit_cast(float, __builtin_amdgcn_ds_bpermute(p << 2, __builtin_bit_cast(int, spx))), PL, ln); }
#else
#pragma unroll 1
    for (int pp = 1; pp >= 0; --pp) { const int p = pp ? (NPAGES - 1 - F.wave) : F.wave;
        const int pg = __builtin_amdgcn_readfirstlane(pt[bs * NPAGES + p]);
        const float* Kb = (const float*)a.in[I_CFK] + ((size_t)pg * PAGE * 8 + h) * 64; const float* Vb = (const float*)a.in[I_CFV] + ((size_t)pg * PAGE * 8 + h) * 64;
        dec_page_fox(w, qa, Kb, Vb, (const float*)(ws + WS_SUF) + (size_t)(bs * 8 + h) * PASTL + p * PAGE, __builtin_bit_cast(float, __builtin_amdgcn_ds_bpermute(p << 2, __builtin_bit_cast(int, spx))), PL, ln); }
#endif
    dec_park<64>(w, CB + F.wave * WSTR, ln);
    __syncthreads();
    dec_combine<64>(F.wave * 64 + ln, CB, (bf16*)(ws + WS_MERGED) + (size_t)(TP + bs * LS) * DM + h * 64, DM);
    __syncthreads();
}
__device__ __forceinline__ void cross_sample_unit(const Frame& F, const Args& a, int u) {
    unsigned char* ws = a.ws; const int bs = u >> 2, h = u & 3;
    LAS float* PL = (LAS float*)F.lds + F.wave * DEC_PL; LAS float* CB = (LAS float*)F.lds + 8 * DEC_PL; constexpr int WSTR = 16 + 8 * 256;
    bf16x8 qa[8]; dec_load_q<256>(qa, (const bf16*)(ws + WS_QC) + (size_t)(TP + bs * LS) * DM + h * 256, DM, F.lane);
    DecW<256> w; dec_init(w);
    const float* Kb = (const float*)a.in[I_CMK] + ((size_t)(bs * 256 + F.wave * 32) * 4 + h) * 256; const float* Vb = (const float*)a.in[I_CMV] + ((size_t)(bs * 256 + F.wave * 32) * 4 + h) * 256;
#pragma unroll 1
    for (int c = 0; c < 2; ++c) dec_chunk<256, 1, 0>(w, qa, Kb + (size_t)c * 16 * 1024, Vb + (size_t)c * 16 * 1024, 1024, nullptr, 0.f, PL, F.lane);
    dec_park<256>(w, CB + F.wave * WSTR, F.lane);
    __syncthreads();
    dec_combine<256>(F.tid, CB, (bf16*)(ws + WS_OC) + (size_t)(TP + bs * LS) * DM + h * 256, DM);
    __syncthreads();
}


__device__ __forceinline__ void gla_g3_unit(const Frame& F, const Args& a, int u) {
    unsigned char* ws = a.ws;
    const int b = u >> 9, h = (u >> 7) & 3, n = u & 127; const int row0 = b * SEQ + n * 64;
    LAS unsigned char* KIB = F.lds; LAS unsigned char* ATTB = F.lds + 34816; LAS unsigned char* QDB = F.lds + 44032;
    LAS unsigned char* VSB = F.lds + 53248; LAS unsigned char* SPB = F.lds + 73728; LAS float* OS = (LAS float*)(F.lds + 94208);
#pragma unroll
    for (int i = 0; i < 2; ++i) { const int c = F.tid + NTHR * i; *(LAS v4u*)(VSB + (c >> 4) * 320 + (c & 15) * 16) = *(const v4u*)((const bf16*)(ws + WS_GV) + (size_t)(row0 + (c >> 4)) * 512 + h * 128 + (c & 15) * 8); }
#pragma unroll
    for (int i = 0; i < 4; ++i) { const int c4 = F.tid + NTHR * i; const f32x4 sp = *(const f32x4*)((const float*)(ws + WS_GKV) + ((size_t)((b * 4 + h) * 128 + n) * 64) * 128 + 4 * c4);
        v2u o; o.x = pg8::cvt_pk_bf16(sp.x, sp.y); o.y = pg8::cvt_pk_bf16(sp.z, sp.w); *(LAS v2u*)(SPB + (c4 >> 5) * 320 + (c4 & 31) * 8) = o; }
#pragma unroll
    for (int i = 0; i < 2; ++i) { const int c4 = F.tid + NTHR * i, t = c4 >> 4, d4 = (c4 & 15) * 4; const size_t gi = (size_t)(row0 + t) * 256 + h * 64 + d4;
        const f32x4 bb = *(const f32x4*)((const float*)(ws + WS_BB) + gi);
        const v2u qq = *(const v2u*)((const bf16*)(ws + WS_GQ) + gi), kk = *(const v2u*)((const bf16*)(ws + WS_GK) + gi);
        v2u qo, ko; qo.x = pg8::cvt_pk_bf16(bflo(qq.x) * __expf(bb.x), bfhi(qq.x) * __expf(bb.y)); qo.y = pg8::cvt_pk_bf16(bflo(qq.y) * __expf(bb.z), bfhi(qq.y) * __expf(bb.w));
        ko.x = pg8::cvt_pk_bf16(bflo(kk.x) * __expf(-bb.x), bfhi(kk.x) * __expf(-bb.y)); ko.y = pg8::cvt_pk_bf16(bflo(kk.y) * __expf(-bb.z), bfhi(kk.y) * __expf(-bb.w));
        *(LAS v2u*)(QDB + t * 144 + d4 * 2) = qo; *(LAS v2u*)(KIB + t * 144 + d4 * 2) = ko; }
    __syncthreads();
    {
        const int lane = F.lane, r32 = lane & 31, hi = lane >> 5;
        if (F.wave < 4) { const int tb = F.wave >> 1, sb = F.wave & 1; f32x16 acc = {};
            if (sb <= tb) {
                const LAS unsigned char* qrow = QDB + (32 * tb + r32) * 144; const LAS unsigned char* krow = KIB + (32 * sb + r32) * 144;
#pragma unroll
                for (int ks = 0; ks < 4; ++ks) acc = __builtin_amdgcn_mfma_f32_32x32x16_bf16(row_frag(qrow, ks, hi), row_frag(krow, ks, hi), acc, 0, 0, 0);
            }
#pragma unroll
            for (int r = 0; r < 16; ++r) { const int t = 32 * tb + crow(r, hi), s2 = 32 * sb + r32; *(LAS unsigned short*)(ATTB + t * 144 + s2 * 2) = (unsigned short)f2bf(s2 <= t ? acc[r] : 0.f); }
        }
    }
    __syncthreads();
    {
        const int lane = F.lane, r32 = lane & 31, hi = lane >> 5, tb = F.wave >> 2, nb = F.wave & 3;
        const int trb = (4 * hi + ((lane & 15) >> 2)) * 320 + (16 * ((lane >> 4) & 1) + 4 * (lane & 3)) * 2 + 64 * nb;
        const LAS unsigned char* arow = ATTB + (32 * tb + r32) * 144; const LAS unsigned char* qrow = QDB + (32 * tb + r32) * 144;
        f32x16 acc = {};
#pragma unroll
        for (int ks = 0; ks < 4; ++ks) acc = __builtin_amdgcn_mfma_f32_32x32x16_bf16(row_frag(arow, ks, hi), tr_frag<320>(VSB + trb, ks), acc, 0, 0, 0);
#pragma unroll
        for (int ks = 0; ks < 4; ++ks) acc = __builtin_amdgcn_mfma_f32_32x32x16_bf16(row_frag(qrow, ks, hi), tr_frag<320>(SPB + trb, ks), acc, 0, 0, 0);
#pragma unroll
        for (int r = 0; r < 16; ++r) OS[(32 * tb + crow(r, hi)) * 128 + 32 * nb + r32] = acc[r];
    }
    __syncthreads();
#pragma unroll
    for (int rr = 0; rr < 8; ++rr) { const int t = F.wave * 8 + rr; const float v0 = OS[t * 128 + F.lane], v1 = OS[t * 128 + 64 + F.lane];
        const float r = rsqrtf(wave_sum(v0 * v0 + v1 * v1) * (1.f / 128.f) + EPS);
        const float* ggo = (const float*)a.in[I_GGO] + h * 128; const BfPtr gr = GLD(ws + WS_GR) + ((size_t)(row0 + t) * 512 + h * 128);
        bf16* mo = (bf16*)(ws + WS_MERGED) + (size_t)(row0 + t) * DM + 512 + h * 128;
        mo[F.lane] = (bf16)f2bf(v0 * r * ggo[F.lane] * silu(gr[F.lane])); mo[64 + F.lane] = (bf16)f2bf(v1 * r * ggo[64 + F.lane] * silu(gr[64 + F.lane])); }
    __syncthreads();
}

struct EpiSoftmaxP {
    static constexpr bool PERM = false, AFTER_DRAIN = true;
    const LAS unsigned long long* argp;
    __device__ __forceinline__ void fused(f32x4 (&acc)[2][2][4][2], const Unit&, int wr, int wc, int fr, int fq, PG8_LAS unsigned char* lds, int wid, int lane) const {
        LAS float* PM = (LAS float*)lds; LAS float* PS = PM + 1024;
        const int ub = (int)blockIdx.x; const int ldp = DM;
        bf16* P = (bf16*)((unsigned char*)ld_ptr(argp + N_INPUTS + 1) + WS_PC) + ((size_t)((ub >> 7) & 1) * SEQ + (ub & 31) * 256) * DM + ((ub >> 5) & 3) * 256;
        { int t2 = lane_id(); asm volatile("" : "+v"(t2)); fr = t2 & 15; fq = (t2 >> 4) & 3; }
#pragma unroll
        for (int ai = 0; ai < 2; ++ai)
#pragma unroll
            for (int m = 0; m < 4; ++m) { float mx = -INFINITY;
#pragma unroll
                for (int bj = 0; bj < 2; ++bj)
#pragma unroll
                    for (int n = 0; n < 2; ++n) { const f32x4 x = acc[ai][bj][m][n]; mx = fmaxf(mx, fmaxf(fmaxf(x[0], x[1]), fmaxf(x[2], x[3]))); }
                mx = fmaxf(mx, xor16_f32(mx)); mx = fmaxf(mx, __shfl_xor(mx, 32));
                if (fq == 0) PM[(ai * 128 + wr * 64 + m * 16 + fr) * 4 + wc] = mx; }
        asm volatile("s_waitcnt lgkmcnt(0)" ::: "memory"); __builtin_amdgcn_s_barrier(); asm volatile("" ::: "memory");
#pragma unroll
        for (int ai = 0; ai < 2; ++ai)
#pragma unroll
            for (int m = 0; m < 4; ++m) { const int r = ai * 128 + wr * 64 + m * 16 + fr; const f32x4 pm = *(const LAS f32x4*)(PM + r * 4);
                const float M = fmaxf(fmaxf(pm[0], pm[1]), fmaxf(pm[2], pm[3])); float s = 0.f;
#pragma unroll
                for (int bj = 0; bj < 2; ++bj)
#pragma unroll
                    for (int n = 0; n < 2; ++n) { f32x4 x = acc[ai][bj][m][n]; x[0] = fexp2(x[0] - M); x[1] = fexp2(x[1] - M); x[2] = fexp2(x[2] - M); x[3] = fexp2(x[3] - M); acc[ai][bj][m][n] = x; s += (x[0] + x[1]) + (x[2] + x[3]); }
                s += xor16_f32(s); s += __shfl_xor(s, 32);
                if (fq == 0) PS[r * 4 + wc] = s; }
        asm volatile("s_waitcnt lgkmcnt(0)" ::: "memory"); __builtin_amdgcn_s_barrier(); asm volatile("" ::: "memory");
#pragma unroll
        for (int ai = 0; ai < 2; ++ai)
#pragma unroll
            for (int m = 0; m < 4; ++m) { const int r = ai * 128 + wr * 64 + m * 16 + fr; const f32x4 ps = *(const LAS f32x4*)(PS + r * 4); const float inv = 1.f / ((ps[0] + ps[1]) + (ps[2] + ps[3]));
#pragma unroll
                for (int bj = 0; bj < 2; ++bj)
#pragma unroll
                    for (int n = 0; n < 2; ++n) { const f32x4 x = acc[ai][bj][m][n]; v2u o; o.x = pg8::cvt_pk_bf16(x[0] * inv, x[1] * inv); o.y = pg8::cvt_pk_bf16(x[2] * inv, x[3] * inv);
                        *(v2u*)(P + (size_t)r * ldp + bj * 128 + wc * 32 + n * 16 + fq * 4) = o; } }
        asm volatile("s_waitcnt lgkmcnt(0)" ::: "memory"); __builtin_amdgcn_s_barrier(); asm volatile("" ::: "memory");
    }
};

__device__ __forceinline__ void rms_rows_phase(const Frame& F, const float* X, const float* g, bf16* H) {
    const int gw = F.vcu * NWAVES + F.wave, NGW = F.G * NWAVES;
    for (int m = gw; m < TA; m += NGW) rms_row_bf16(X + (size_t)m * DM, g, H + (size_t)m * DM, F.lane);
}

__device__ __forceinline__ unsigned f2sort(float f) { const unsigned u = __builtin_bit_cast(unsigned, f); return u ^ ((u >> 31) ? 0xFFFFFFFFu : 0x80000000u); }
__device__ __forceinline__ float sort2f(unsigned s) { const unsigned u = s ^ ((s >> 31) ? 0x80000000u : 0xFFFFFFFFu); return __builtin_bit_cast(float, u); }
__device__ __forceinline__ float gelu_tanh(float x) { const float y = 0.7978845608028654f * (x + 0.044715f * x * x * x); const float e = __expf(2.f * y); return 0.5f * x * (1.f + (1.f - 2.f / (e + 1.f))); }
__device__ __forceinline__ unsigned gmax16(unsigned v) { return max16_u32(v); }
typedef __bf16 bf16x2_t __attribute__((ext_vector_type(2)));
__device__ __forceinline__ float dot2bf(unsigned a, unsigned b, float c) {
#if __has_builtin(__builtin_amdgcn_fdot2_f32_bf16)
    return __builtin_amdgcn_fdot2_f32_bf16(__builtin_bit_cast(bf16x2_t, a), __builtin_bit_cast(bf16x2_t, b), c, false);
#else
    return c + bflo(a) * bflo(b) + bfhi(a) * bfhi(b);
#endif
}
template <bool SPLIT>
__device__ __forceinline__ void peer_token(const Frame& F, const Args& a, int row, LAS unsigned* TOPS, const LAS unsigned* CT, int half, LAS float* PART) {
    unsigned char* ws = a.ws; const int lane = lane_id(), grp = lane >> 4, j16 = lane & 15;
    const bf16* sc = (const bf16*)(ws + WS_SC) + (size_t)row * 2048;
#pragma unroll 1
    for (int bt = 0; bt < 4; ++bt) {
        const v4u xq = *(const v4u*)(sc + (bt * 4 + grp) * 128 + 8 * j16);
        unsigned k[8]; const float xs[8] = {bflo(xq.x), bfhi(xq.x), bflo(xq.y), bfhi(xq.y), bflo(xq.z), bfhi(xq.z), bflo(xq.w), bfhi(xq.w)};
#pragma unroll
        for (int e = 0; e < 8; ++e) k[e] = (f2sort(xs[e]) & ~127u) | (unsigned)(127 - (8 * j16 + e));
        unsigned mine = 0u;
#pragma unroll 1
        for (int r = 0; r < 16; ++r) {
            unsigned m = k[0];
#pragma unroll
            for (int e = 1; e < 8; ++e) m = m > k[e] ? m : k[e];
            m = gmax16(m);
            if (j16 == r) mine = m;
#pragma unroll
            for (int e = 0; e < 8; ++e) k[e] = (k[e] == m) ? 0u : k[e];
        }
        TOPS[(bt * 4 + grp) * 16 + j16] = mine;
    }
    int ex[2]; float gx[2], sux[2];
#pragma unroll
    for (int ps = 0; ps < 2; ++ps) {
        const int hd = ps * 4 + grp; const LAS unsigned* T1 = TOPS + (2 * hd) * 16; const LAS unsigned* T2 = T1 + 16;
        const unsigned c0_ = CT[j16], c1_ = CT[j16 + 16], c2_ = CT[j16 + 32], c3_ = CT[j16 + 48];
        const int ci0 = c0_ & 255, cj0 = c0_ >> 8, ci1 = c1_ & 255, cj1 = c1_ >> 8, ci2 = c2_ & 255, cj2 = c2_ >> 8, ci3 = c3_ & 255, cj3 = c3_ >> 8; const bool cv3 = (j16 + 48) < 50;
        unsigned k[4];
        { const float s0 = sort2f(T1[ci0] & ~127u) + sort2f(T2[cj0] & ~127u), s1 = sort2f(T1[ci1] & ~127u) + sort2f(T2[cj1] & ~127u),
                      s2 = sort2f(T1[ci2] & ~127u) + sort2f(T2[cj2] & ~127u), s3 = sort2f(T1[ci3] & ~127u) + sort2f(T2[cj3] & ~127u);
          k[0] = (f2sort(s0) & ~127u) | (unsigned)(127 - j16); k[1] = (f2sort(s1) & ~127u) | (unsigned)(127 - (j16 + 16)); k[2] = (f2sort(s2) & ~127u) | (unsigned)(127 - (j16 + 32));
          k[3] = cv3 ? ((f2sort(s3) & ~127u) | (unsigned)(127 - (j16 + 48))) : 0u; }
        unsigned mine = 0u;
#pragma unroll 1
        for (int r = 0; r < 16; ++r) {
            unsigned m = k[0] > k[1] ? k[0] : k[1]; const unsigned m2 = k[2] > k[3] ? k[2] : k[3]; m = m > m2 ? m : m2;
            m = gmax16(m);
            if (j16 == r) mine = m;
#pragma unroll
            for (int e = 0; e < 4; ++e) k[e] = (k[e] == m) ? 0u : k[e];
        }
        const int c = 127 - (int)(mine & 127u);
        int ci, cj;
        if (c < 16) { ci = 0; cj = c; } else if (c < 24) { ci = 1; cj = c - 16; } else if (c < 29) { ci = 2; cj = c - 24; } else if (c < 33) { ci = 3; cj = c - 29; }
        else if (c < 36) { ci = 4; cj = c - 33; } else if (c < 38) { ci = 5; cj = c - 36; } else if (c < 40) { ci = 6; cj = c - 38; } else if (c < 42) { ci = 7; cj = c - 40; } else { ci = c - 34; cj = 0; }
        const int i1 = 127 - (int)(T1[ci] & 127u), i2 = 127 - (int)(T2[cj] & 127u);
        ex[ps] = i1 * 128 + i2;
        const float sv = sort2f(mine & ~127u); const float s0 = __shfl(sv, lane & 48);
        float ee = __expf(sv - s0); const float es = sum16_f32(ee);
        const float* rsc = (const float*)(ws + WS_MISC);
        sux[ps] = rsc[ex[ps]]; gx[ps] = ee / es * rsc[16384 + ex[ps]];
    }
    {
        unsigned k0 = ((unsigned)ex[0] << 7) | (unsigned)lane, k1 = ((unsigned)ex[1] << 7) | (unsigned)(64 + lane);
#pragma unroll
        for (int k = 2; k <= 128; k <<= 1) {
#pragma unroll
            for (int j = k >> 1; j > 0; j >>= 1) {
                if (j == 64) { const unsigned lo = k0 < k1 ? k0 : k1, hi = k0 < k1 ? k1 : k0; k0 = lo; k1 = hi; }
                else {
                    unsigned p0, p1;
                    if (j == 32) { p0 = (unsigned)__shfl_xor((int)k0, 32); p1 = (unsigned)__shfl_xor((int)k1, 32); }
                    else if (j == 16) { p0 = xchg_xor_u32<16>(k0); p1 = xchg_xor_u32<16>(k1); } else if (j == 8) { p0 = xchg_xor_u32<8>(k0); p1 = xchg_xor_u32<8>(k1); }
                    else if (j == 4) { p0 = xchg_xor_u32<4>(k0); p1 = xchg_xor_u32<4>(k1); } else if (j == 2) { p0 = xchg_xor_u32<2>(k0); p1 = xchg_xor_u32<2>(k1); }
                    else { p0 = xchg_xor_u32<1>(k0); p1 = xchg_xor_u32<1>(k1); }
                    const bool low = (lane & j) == 0; const bool asc0 = (lane & k) == 0, asc1 = ((64 + lane) & k) == 0;
                    const unsigned mn0 = k0 < p0 ? k0 : p0, mx0 = k0 < p0 ? p0 : k0, mn1 = k1 < p1 ? k1 : p1, mx1 = k1 < p1 ? p1 : k1;
                    k0 = (low == asc0) ? mn0 : mx0; k1 = (low == asc1) ? mn1 : mx1;
                }
            }
        }
        const int o0 = (int)(k0 & 127u), o1 = (int)(k1 & 127u);
        const float g0a = __shfl(gx[0], o0 & 63), g0b = __shfl(gx[1], o0 & 63), g1a = __shfl(gx[0], o1 & 63), g1b = __shfl(gx[1], o1 & 63);
        const float s0a = __shfl(sux[0], o0 & 63), s0b = __shfl(sux[1], o0 & 63), s1a = __shfl(sux[0], o1 & 63), s1b = __shfl(sux[1], o1 & 63);
        gx[0] = (o0 & 64) ? g0b : g0a; gx[1] = (o1 & 64) ? g1b : g1a; sux[0] = (o0 & 64) ? s0b : s0a; sux[1] = (o1 & 64) ? s1b : s1a;
        ex[0] = (int)(k0 >> 7); ex[1] = (int)(k1 >> 7);
    }
    const float rstd2 = rsqrtf(((const float*)(ws + WS_SS))[TA + row] * (1.f / 1024.f) + EPS);
    float hf[16];
    { const bf16* hb = (const bf16*)(ws + WS_HB) + (size_t)row * DM + 4 * lane;
#pragma unroll
      for (int q = 0; q < 4; ++q) { const v2u hq = *(const v2u*)(hb + 256 * q); hf[4 * q] = bflo(hq.x); hf[4 * q + 1] = bfhi(hq.x); hf[4 * q + 2] = bflo(hq.y); hf[4 * q + 3] = bfhi(hq.y); } }
    float oacc[16];
#pragma unroll
    for (int i = 0; i < 16; ++i) oacc[i] = 0.f;
    const unsigned char* U = ws + WS_U16; const unsigned char* V = ws + WS_V16;
    v4u ub[8], vbA[8], vbB[8];
    const int gbeg = SPLIT ? 8 * half : 0, gend = SPLIT ? 8 * half + 8 : 16;
    const int addr32 = (lane ^ 32) << 2;
#define PEER_LOAD(buf, TAB, g) do { const int kk_ = (g) * 8; const int exs_ = (kk_ < 64) ? ex[0] : ex[1]; \
        _Pragma("unroll") for (int i = 0; i < 8; ++i) { const int e_ = __builtin_amdgcn_readlane(exs_, (kk_ & 63) + i); buf[i] = *(const v4u*)(TAB + (size_t)e_ * DM + 16 * lane); } } while (0)
#define PEER_DOTS(buf, g, wout) do { const int kk_ = (g) * 8; const float gxs_ = (kk_ < 64) ? gx[0] : gx[1]; const float sus_ = (kk_ < 64) ? sux[0] : sux[1]; float av[8]; \
        _Pragma("unroll") for (int i = 0; i < 8; ++i) { float s = 0.f; \
            _Pragma("unroll") for (int q = 0; q < 4; ++q) { const f32x2 lo = __builtin_amdgcn_cvt_pk_f32_fp8((int)buf[i][q], false), hi = __builtin_amdgcn_cvt_pk_f32_fp8((int)buf[i][q], true); \
                s += lo.x * hf[4 * q]; s += lo.y * hf[4 * q + 1]; s += hi.x * hf[4 * q + 2]; s += hi.y * hf[4 * q + 3]; } \
            av[i] = s; } \
        const bool b5 = lane & 32, b4 = lane & 16, b3_ = lane & 8; float bq[4], cq[2], dq; \
        _Pragma("unroll") for (int i = 0; i < 4; ++i) bq[i] = (b5 ? av[4 + i] : av[i]) + __builtin_bit_cast(float, __builtin_amdgcn_ds_bpermute(addr32, __builtin_bit_cast(int, b5 ? av[i] : av[4 + i])));     \
        _Pragma("unroll") for (int i = 0; i < 2; ++i) cq[i] = (b4 ? bq[2 + i] : bq[i]) + xor16_f32(b4 ? bq[i] : bq[2 + i]); \
        dq = (b3_ ? cq[1] : cq[0]) + DPP_F(b3_ ? cq[0] : cq[1], DPP_MIR);        \
        dq = sum8_f32(dq); \
        const int src = (kk_ & 63) + (lane >> 3); \
        wout = __shfl(gxs_, src) * gelu_tanh(dq * __shfl(sus_, src) * rstd2); } while (0)
#define PEER_ACC(buf, wv) do { _Pragma("unroll") for (int i = 0; i < 8; ++i) { const float w = __builtin_bit_cast(float, __builtin_amdgcn_readlane(__builtin_bit_cast(int, wv), 8 * i)); \
        _Pragma("unroll") for (int q = 0; q < 4; ++q) { const f32x2 lo = __builtin_amdgcn_cvt_pk_f32_fp8((int)buf[i][q], false), hi = __builtin_amdgcn_cvt_pk_f32_fp8((int)buf[i][q], true); \
            oacc[4 * q] += w * lo.x; oacc[4 * q + 1] += w * lo.y; oacc[4 * q + 2] += w * hi.x; oacc[4 * q + 3] += w * hi.y; } } } while (0)
    PEER_LOAD(ub, U, gbeg); PEER_LOAD(vbA, V, gbeg);
#pragma unroll 1
    for (int g0 = gbeg; g0 < gend; g0 += 2) {
        float w0, w1;
        PEER_DOTS(ub, g0, w0);
        PEER_LOAD(ub, U, g0 + 1); PEER_LOAD(vbB, V, g0 + 1);
        PEER_ACC(vbA, w0);
        PEER_DOTS(ub, g0 + 1, w1);
        { const int gn = (g0 + 2 < gend) ? g0 + 2 : g0 + 1;
          PEER_LOAD(ub, U, gn); PEER_LOAD(vbA, V, gn); }
        PEER_ACC(vbB, w1);
    }
#undef PEER_LOAD
#undef PEER_DOTS
#undef PEER_ACC
    if (SPLIT) {
        if (half == 1) {
#pragma unroll
            for (int q = 0; q < 4; ++q) *(LAS f32x4*)(PART + 16 * lane + 4 * q) = (f32x4){oacc[4 * q], oacc[4 * q + 1], oacc[4 * q + 2], oacc[4 * q + 3]}; }
        __syncthreads();
        if (half == 1) return;
#pragma unroll
        for (int q = 0; q < 4; ++q) { const f32x4 p = *(const LAS f32x4*)(PART + 16 * lane + 4 * q); oacc[4 * q] += p.x; oacc[4 * q + 1] += p.y; oacc[4 * q + 2] += p.z; oacc[4 * q + 3] += p.w; }
    }
    asm volatile("" : "+s"(row)); const int lane2 = lane_id();
    const f32x4* x2 = (const f32x4*)((const float*)(ws + WS_X2) + (size_t)row * DM) + lane2;
    f32x4 xv[4]; float ss = 0.f;
#pragma unroll
    for (int q = 0; q < 4; ++q) { xv[q] = x2[64 * q]; xv[q].x += oacc[4 * q]; xv[q].y += oacc[4 * q + 1]; xv[q].z += oacc[4 * q + 2]; xv[q].w += oacc[4 * q + 3]; ss += (xv[q].x * xv[q].x + xv[q].y * xv[q].y) + (xv[q].z * xv[q].z + xv[q].w * xv[q].w); }
    const float r = rsqrtf(wave_sum(ss) * (1.f / DM) + EPS);
    const f32x4* gf = (const f32x4*)((const float*)a.in[I_GFIN]) + lane2;
    f32x4* y = (f32x4*)(row < TP ? a.out + O_YP + (size_t)row * DM : a.out + O_YS + (size_t)(row - TP) * DM) + lane2;
#pragma unroll
    for (int q = 0; q < 4; ++q) { const f32x4 g4 = gf[64 * q]; f32x4 o; o.x = xv[q].x * r * g4.x; o.y = xv[q].y * r * g4.y; o.z = xv[q].z * r * g4.z; o.w = xv[q].w * r * g4.w; y[64 * q] = o; }
}
__device__ __forceinline__ void cand_ij(int c, int& ci, int& cj) {
    if (c < 16) { ci = 0; cj = c; } else if (c < 24) { ci = 1; cj = c - 16; } else if (c < 29) { ci = 2; cj = c - 24; } else if (c < 33) { ci = 3; cj = c - 29; }
    else if (c < 36) { ci = 4; cj = c - 33; } else if (c < 38) { ci = 5; cj = c - 36; } else if (c < 40) { ci = 6; cj = c - 38; } else if (c < 42) { ci = 7; cj = c - 40; } else if (c < 50) { ci = c - 34; cj = 0; } else { ci = 0; cj = 0; }
}
__device__ __forceinline__ void peer_phase(const Frame& F, const Args& a) {
    LAS unsigned* TOPS = (LAS unsigned*)F.lds + F.wave * 256;
    LAS unsigned* CT = (LAS unsigned*)F.lds + 8 * 256 + 4 * 1024;
    if (F.tid < 64) { int ci, cj; cand_ij(F.tid, ci, cj); CT[F.tid] = (unsigned)ci | ((unsigned)cj << 8); }
    __syncthreads();
    const int gw = F.vcu * NWAVES + F.wave, NGW = F.G * NWAVES;
    const int nfull = TA / NGW, rem = TA - nfull * NGW;
#pragma unroll 1
    for (int i = 0; i < nfull; ++i) peer_token<false>(F, a, gw + i * NGW, TOPS, CT, 0, nullptr);
    if (rem == 4 * F.G) {
        __syncthreads();
        peer_token<true>(F, a, nfull * NGW + F.vcu * 4 + (F.wave >> 1), TOPS, CT, F.wave & 1, (LAS float*)F.lds + 8 * 256 + (F.wave >> 1) * 1024);
    } else {
        const int row = gw + nfull * NGW; if (row < TA) peer_token<false>(F, a, row, TOPS, CT, 0, nullptr);
    }
}


template <class EpiS>
__device__ __forceinline__ void skinny_tile(const Frame& F, const bf16* A, int lda, const bf16* Bt, int ldb, int tm, int tn, const EpiS& E) {
    const int lane = F.lane, fr = lane & 15, fq = lane >> 4, w = F.wave, lr = lane >> 3, lc = lane & 7;
    LAS unsigned char* SA = F.lds + w * 16384; LAS unsigned char* SB = SA + 8192;
    const bf16* ag = A + (size_t)(tm * 64 + lr) * lda + w * 128 + 8 * lc;
    const bf16* bg = Bt + (size_t)(tn * 64 + lr) * ldb + w * 128 + 8 * lc;
    f32x4 acc[4][4];
#pragma unroll
    for (int m = 0; m < 4; ++m)
#pragma unroll
        for (int n = 0; n < 4; ++n) acc[m][n] = (f32x4){0.f, 0.f, 0.f, 0.f};
    v4u ar[2][8], br[2][8];
#pragma unroll
    for (int kh = 0; kh < 2; ++kh)
#pragma unroll
        for (int i = 0; i < 8; ++i) { ar[kh][i] = *(const v4u*)(ag + (size_t)(8 * i) * lda + 64 * kh); br[kh][i] = *(const v4u*)(bg + (size_t)(8 * i) * ldb + 64 * kh); }
#pragma unroll
    for (int kh = 0; kh < 2; ++kh) {
#pragma unroll
        for (int i = 0; i < 8; ++i) { const int row = 8 * i + lr; *(LAS v4u*)(SA + row * 128 + ((lc ^ (row & 7)) << 4)) = ar[kh][i]; *(LAS v4u*)(SB + row * 128 + ((lc ^ (row & 7)) << 4)) = br[kh][i]; }
        bf16x8 af[4][2], bfr[4][2];
#pragma unroll
        for (int m = 0; m < 4; ++m)
#pragma unroll
            for (int ks = 0; ks < 2; ++ks) { const int row = 16 * m + fr; const int off = row * 128 + (((4 * ks + fq) ^ (row & 7)) << 4);
                af[m][ks] = *(const LAS bf16x8*)(SA + off); bfr[m][ks] = *(const LAS bf16x8*)(SB + off); }
#pragma unroll
        for (int ks = 0; ks < 2; ++ks)
#pragma unroll
            for (int m = 0; m < 4; ++m)
#pragma unroll
                for (int n = 0; n < 4; ++n) acc[m][n] = __builtin_amdgcn_mfma_f32_16x16x32_bf16(bfr[n][ks], af[m][ks], acc[m][n], 0, 0, 0);
        asm volatile("s_waitcnt lgkmcnt(0)" ::: "memory");
    }
    LAS float* PS = (LAS float*)F.lds + w * 4096;
#pragma unroll
    for (int m = 0; m < 4; ++m)
#pragma unroll
        for (int n = 0; n < 4; ++n) *(LAS f32x4*)(PS + (16 * m + fr) * 64 + 4 * ((4 * n + fq) ^ fr)) = acc[m][n];
    lds_barrier();
    {
        const int row = F.tid >> 3, c8 = (F.tid & 7) * 8; const LAS float* PR = (const LAS float*)F.lds + row * 64;
        const int ch0 = 4 * (((F.tid & 7) * 2) ^ (row & 15)), ch1 = 4 * (((F.tid & 7) * 2 + 1) ^ (row & 15));
        f32x4 s0 = *(const LAS f32x4*)(PR + ch0), s1 = *(const LAS f32x4*)(PR + ch1);
#pragma unroll
        for (int ww = 1; ww < 8; ++ww) { s0 += *(const LAS f32x4*)(PR + ww * 4096 + ch0); s1 += *(const LAS f32x4*)(PR + ww * 4096 + ch1); }
        float v[8] = {s0.x, s0.y, s0.z, s0.w, s1.x, s1.y, s1.z, s1.w};
        E(tm * 64 + row, tn * 64 + c8, v, F.tid);
    }
    lds_barrier();
}
struct EpiSk {
    float* d32; int ld32; bf16* d16; int ld16; float sc16;
    const float* res; int ldr;
    const float* gcol; float* ssq; const float* rsq;
    __device__ __forceinline__ void operator()(int row, int col, float (&v)[8], int tid) const {
        if (rsq) { const float rs = rsqrtf(rsq[row] * (1.f / 1024.f) + EPS);
#pragma unroll
            for (int i = 0; i < 8; ++i) v[i] *= rs; }
        if (res) { const f32x4 a = *(const f32x4*)(res + (size_t)row * ldr + col), b = *(const f32x4*)(res + (size_t)row * ldr + col + 4);
            v[0] += a.x; v[1] += a.y; v[2] += a.z; v[3] += a.w; v[4] += b.x; v[5] += b.y; v[6] += b.z; v[7] += b.w; }
        if (d32) { *(f32x4*)(d32 + (size_t)row * ld32 + col) = (f32x4){v[0], v[1], v[2], v[3]}; *(f32x4*)(d32 + (size_t)row * ld32 + col + 4) = (f32x4){v[4], v[5], v[6], v[7]}; }
        if (ssq) { float ss = 0.f;
#pragma unroll
            for (int i = 0; i < 8; ++i) ss += v[i] * v[i];
            ss = sum8_f32(ss);
            if ((tid & 7) == 0) atomicAdd(ssq + row, ss); }
        if (d16) { float w8[8];
#pragma unroll
            for (int i = 0; i < 8; ++i) w8[i] = v[i];
            if (gcol) { const f32x4 a = *(const f32x4*)(gcol + col), b = *(const f32x4*)(gcol + col + 4); w8[0] *= a.x; w8[1] *= a.y; w8[2] *= a.z; w8[3] *= a.w; w8[4] *= b.x; w8[5] *= b.y; w8[6] *= b.z; w8[7] *= b.w; }
            v4u o; o.x = pg8::cvt_pk_bf16(w8[0] * sc16, w8[1] * sc16); o.y = pg8::cvt_pk_bf16(w8[2] * sc16, w8[3] * sc16); o.z = pg8::cvt_pk_bf16(w8[4] * sc16, w8[5] * sc16); o.w = pg8::cvt_pk_bf16(w8[6] * sc16, w8[7] * sc16);
            *(v4u*)(d16 + (size_t)row * ld16 + col) = o; }
    }
};

#define SK_TM16(t) (4 * (((t) >> 5) >> 1) + (((t) & 31) >> 3))
#define SK_TN16(t) (8 * (((t) >> 5) & 1) + ((t) & 7))
#define SK_TM32(t) (4 * ((((t) & 255) >> 5) >> 1) + ((((t) & 31) + 32 * ((t) >> 8)) >> 4))
#define SK_TN32(t) (16 * ((((t) & 255) >> 5) & 1) + ((((t) & 31) + 32 * ((t) >> 8)) & 15))


#ifndef PH_MAX
#define PH_MAX 99
#endif
__global__ void __launch_bounds__(NTHR, 2) mega_fwd(Args args) {
    extern __shared__ __attribute__((aligned(16))) unsigned char lds_raw[];
    Frame F;
    F.lds = (LAS unsigned char*)lds_raw;
    F.wave = __builtin_amdgcn_readfirstlane((int)threadIdx.x >> 6); F.lane = lane_id(); F.tid = F.wave * 64 + F.lane;
    F.G = gridDim.x; { const int bx = blockIdx.x; F.vcu = (F.G % 8 == 0) ? (bx % 8) * (F.G / 8) + bx / 8 : bx; }
    volatile LAS unsigned* MISC = (volatile LAS unsigned*)(F.lds + MISC_OFF);
    LAS unsigned long long* ARGP = (LAS unsigned long long*)(F.lds + ARGS_OFF);
    for (int u = F.tid; u < (LDS_BYTES - LDSCTL_OFF) / 4; u += NTHR) ((LAS unsigned*)(F.lds + LDSCTL_OFF))[u] = 0u;
    __syncthreads();
    if (F.tid == 0) {
        ARGP[0] = (unsigned long long)args.in[0];
        ARGP[1] = (unsigned long long)args.in[1];
        ARGP[2] = (unsigned long long)args.in[2];
        ARGP[3] = (unsigned long long)args.in[3];
        ARGP[4] = (unsigned long long)args.in[4];
        ARGP[5] = (unsigned long long)args.in[5];
        ARGP[6] = (unsigned long long)args.in[6];
        ARGP[7] = (unsigned long long)args.in[7];
        ARGP[8] = (unsigned long long)args.in[8];
        ARGP[9] = (unsigned long long)args.in[9];
        ARGP[10] = (unsigned long long)args.in[10];
        ARGP[11] = (unsigned long long)args.in[11];
        ARGP[12] = (unsigned long long)args.in[12];
        ARGP[13] = (unsigned long long)args.in[13];
        ARGP[14] = (unsigned long long)args.in[14];
        ARGP[15] = (unsigned long long)args.in[15];
        ARGP[16] = (unsigned long long)args.in[16];
        ARGP[17] = (unsigned long long)args.in[17];
        ARGP[18] = (unsigned long long)args.in[18];
        ARGP[19] = (unsigned long long)args.in[19];
        ARGP[20] = (unsigned long long)args.in[20];
        ARGP[21] = (unsigned long long)args.in[21];
        ARGP[22] = (unsigned long long)args.in[22];
        ARGP[23] = (unsigned long long)args.in[23];
        ARGP[24] = (unsigned long long)args.in[24];
        ARGP[25] = (unsigned long long)args.in[25];
        ARGP[26] = (unsigned long long)args.in[26];
        ARGP[27] = (unsigned long long)args.in[27];
        ARGP[28] = (unsigned long long)args.in[28];
        ARGP[N_INPUTS] = (unsigned long long)args.out; ARGP[N_INPUTS + 1] = (unsigned long long)args.ws;
    }
    __syncthreads();
    { const XcdBarrier bar0 = xcd_barrier_post((unsigned*)((gu32*)(args.ws + WS_CTL) + CW_BAR), MISC + 8, F.wave); if (F.tid == 0) MISC[10] = bar0.x; }
    __syncthreads();
#define GRID_BAR() do { XcdBarrier bar_; bar_.bar = (unsigned*)((gu32*)((unsigned char*)ld_ptr(ARGP + N_INPUTS + 1) + WS_CTL) + CW_BAR); bar_.x = MISC[10]; bar_.st = MISC + 8; bar_.wave = F.wave; xcd_barrier(bar_); } while (0)
#define PHASE_ARGS const Args A = load_args(ARGP); unsigned char* const ws = A.ws; float* const out = A.out; (void)ws; (void)out; { int l_ = lane_id(); asm volatile("" : "+v"(l_)); F.lane = l_; F.tid = F.wave * 64 + l_; }

    { PHASE_ARGS;
    p0_prologue(F, A);
    }
    GRID_BAR();
#if defined(PROBE_BAR8)
    GRID_BAR(); GRID_BAR(); GRID_BAR(); GRID_BAR(); GRID_BAR(); GRID_BAR(); GRID_BAR(); GRID_BAR();
#endif
#if PH_MAX >= 1
    { PHASE_ARGS;
    {
        pg8::Gemm g{(const bf16*)(ws + WS_HB), (const bf16*)(ws + WS_WIN), DM, DM, DM};
        pg8::StaticOrder S; S.init(TA, N_IN, F.G, (int)blockIdx.x);
        EpiInProj E{out, ws, (const float*)A.in[I_BFF]};
        pg8::gemm_phase(F.lds, g, S, E, F.wave);
    }
    {
        const int off = (TA / 256) * (N_IN / 256) % F.G;
        pg8::Gemm g{(const bf16*)(ws + WS_MB), (const bf16*)(ws + WS_WMK), DM, DM, DM};
        pg8::StaticOrder S; S.init(512, DM, F.G, ((int)blockIdx.x + F.G - off) % F.G);
        EpiGen E{out + O_MKP, DM, (bf16*)(ws + WS_MK16), DM, 1.f, nullptr, nullptr, 0, 0, nullptr, nullptr, nullptr};
        pg8::gemm_phase(F.lds, g, S, E, F.wave);
    }
    {
        const int off = ((TA / 256) * (N_IN / 256) + 8) % F.G;
        pg8::Gemm g{(const bf16*)(ws + WS_MB), (const bf16*)(ws + WS_WMV), DM, DM, DM};
        pg8::StaticOrder S; S.init(512, DM, F.G, ((int)blockIdx.x + F.G - off) % F.G);
        EpiGen E{out + O_MVP, DM, nullptr, 0, 1.f, nullptr, nullptr, 0, 0, nullptr, nullptr, nullptr};
        pg8::gemm_phase(F.lds, g, S, E, F.wave);
    }
    {
        const int off = ((TA / 256) * (N_IN / 256) + 16) % F.G;
        pg8::Gemm g{(const bf16*)(ws + WS_WMV), (const bf16*)(ws + WS_MB), DM, DM, DM};
        pg8::StaticOrder S; S.init(DM, 512, F.G, ((int)blockIdx.x + F.G - off) % F.G);
        EpiGen E{nullptr, 0, (bf16*)(ws + WS_MVT16), 512, 1.f, nullptr, nullptr, 0, 0, nullptr, nullptr, nullptr};
        pg8::gemm_phase(F.lds, g, S, E, F.wave);
    }
    }
    GRID_BAR();
#endif
#if PH_MAX >= 2
    asm volatile("; ===PHASE 2===");
    { PHASE_ARGS;
    {
        const int gw = F.vcu * NWAVES + F.wave, NGW = F.G * NWAVES;
        if ((gw & 3) == 0) for (int it = gw >> 2; it < 512; it += NGW >> 2) fox_norms_item(F, (const bf16*)(ws + WS_QF), (const bf16*)(ws + WS_KF), out + O_LFP, (float*)(ws + WS_MISC + MiB), (float*)(ws + WS_KBIAS), (float*)(ws + WS_MISC + MiB + 65536), it);
        for (int it = gw; it < NB_S * NPAGES; it += NGW) fox_suffix_item(F, (const float*)A.in[I_CFL], (const int*)A.in[I_PT], (float*)(ws + WS_SUF), (float*)(ws + WS_MISC + 2 * MiB), it);
        for (int u = F.vcu; u < 1024; u += F.G) gla_g1_unit(F, A, u);
        for (int u = F.vcu; u < 512; u += F.G) gla_sample_unit(F, A, u);
    }
    }
    GRID_BAR();
#endif
#if PH_MAX >= 3
    asm volatile("; ===PHASE 3===");
    { PHASE_ARGS;
    gla_scan(F, A);
    __syncthreads();
    for (int i = F.vcu; i < 256; i += F.G) { const int bh = i >> 4, s = i & 15;
        fox_attn_unit(F, (const bf16*)(ws + WS_QF), (const bf16*)(ws + WS_KF), (const bf16*)(ws + WS_VF), (const float*)(ws + WS_KBIAS), (const float*)(ws + WS_MISC + MiB + 65536), (const float*)(ws + WS_MISC + MiB), (bf16*)(ws + WS_MERGED), bh >> 3, bh & 7, s);
        fox_attn_unit(F, (const bf16*)(ws + WS_QF), (const bf16*)(ws + WS_KF), (const bf16*)(ws + WS_VF), (const float*)(ws + WS_KBIAS), (const float*)(ws + WS_MISC + MiB + 65536), (const float*)(ws + WS_MISC + MiB), (bf16*)(ws + WS_MERGED), bh >> 3, bh & 7, 31 - s); }
    }
    GRID_BAR();
#endif
#if PH_MAX >= 4
    asm volatile("; ===PHASE 4===");
    { PHASE_ARGS;
    if (!(F.vcu & 1)) { for (int u = F.vcu; u < 1024; u += F.G) gla_g3_unit(F, A, u); }
    }
    { PHASE_ARGS;
    for (int u = F.vcu; u < 1024; u += F.G) fox_sample_unit(F, A, u);
    }
    { PHASE_ARGS;
    if (F.vcu & 1) { for (int u = F.vcu; u < 1024; u += F.G) gla_g3_unit(F, A, u); }
    }
    GRID_BAR();
#endif
#if PH_MAX >= 5
    asm volatile("; ===PHASE 5===");
    { PHASE_ARGS;
    {
        pg8::Gemm g{(const bf16*)(ws + WS_MERGED), (const bf16*)(ws + WS_WOUT), DM, DM, DM};
        pg8::StaticOrder S; S.init(TP, DM, F.G, (int)blockIdx.x);
        EpiGen E{(float*)(ws + WS_X1), DM, (bf16*)(ws + WS_HB), DM, 1.f, (const float*)A.in[I_XP], (const float*)A.in[I_XS], TP, DM, (const float*)A.in[I_GCROSS], (float*)(ws + WS_SS), nullptr};
        pg8::gemm_phase(F.lds, g, S, E, F.wave);
        __syncthreads();
        EpiSk Es{(float*)(ws + WS_X1) + (size_t)TP * DM, DM, (bf16*)(ws + WS_HB) + (size_t)TP * DM, DM, 1.f, (const float*)A.in[I_XS], DM, (const float*)A.in[I_GCROSS], (float*)(ws + WS_SS) + TP, nullptr};
        for (int t = F.vcu; t < 256; t += F.G) skinny_tile(F, (const bf16*)(ws + WS_MERGED) + (size_t)TP * DM, DM, (const bf16*)(ws + WS_WOUT), DM, SK_TM16(t), SK_TN16(t), Es);
    }
    }
    GRID_BAR();
#endif
#if PH_MAX >= 7
    asm volatile("; ===PHASE 7===");
    { PHASE_ARGS;
    {
        pg8::Gemm g{(const bf16*)(ws + WS_HB), (const bf16*)(ws + WS_WCQ), DM, DM, DM};
        pg8::StaticOrder S; S.init(TP, DM, F.G, (int)blockIdx.x);
        EpiGen E{nullptr, 0, (bf16*)(ws + WS_QC), DM, C2C, nullptr, nullptr, 0, 0, nullptr, nullptr, (const float*)(ws + WS_SS)};
        pg8::gemm_phase(F.lds, g, S, E, F.wave);
        __syncthreads();
        EpiSk Es{nullptr, 0, (bf16*)(ws + WS_QC) + (size_t)TP * DM, DM, C2C, nullptr, 0, nullptr, nullptr, (const float*)(ws + WS_SS) + TP};
        for (int t = F.vcu; t < 256; t += F.G) skinny_tile(F, (const bf16*)(ws + WS_HB) + (size_t)TP * DM, DM, (const bf16*)(ws + WS_WCQ), DM, SK_TM16(t), SK_TN16(t), Es);
    }
    }
    GRID_BAR();
#endif
#if PH_MAX >= 8
    asm volatile("; ===PHASE 8===");
    { PHASE_ARGS;
    {
        const int u = (int)blockIdx.x, b = (u >> 7) & 1, h = (u >> 5) & 3, pnl = u & 31;
        const size_t roff = ((size_t)b * SEQ + pnl * 256) * DM + h * 256;
        if (F.vcu & 1) { for (int v = F.vcu; v < 512; v += F.G) cross_sample_unit(F, A, v); }
        pg8::Gemm g{(const bf16*)(ws + WS_QC) + roff, (const bf16*)(ws + WS_MK16) + (size_t)(b * 256) * DM + h * 256, DM, DM, 256};
        pg8::SingleUnit S{u < 256 ? 1 : 0, {0, 0}};
        EpiSoftmaxP E{ARGP};
        pg8::gemm_phase(F.lds, g, S, E, F.wave);
        VM_WAIT(); __syncthreads();
        {
            pg8::Gemm g2{(const bf16*)(ws + WS_PC) + roff, (const bf16*)(ws + WS_MVT16) + (size_t)(h * 256) * 512 + b * 256, DM, 512, 256};
            EpiGen E2{nullptr, 0, (bf16*)(ws + WS_OC) + roff, DM, 1.f, nullptr, nullptr, 0, 0, nullptr, nullptr, nullptr};
            pg8::gemm_phase(F.lds, g2, S, E2, F.wave);
        }
        __syncthreads();
        if (!(F.vcu & 1)) { for (int v = F.vcu; v < 512; v += F.G) cross_sample_unit(F, A, v); }
    }
    }
    GRID_BAR();
#endif
#if PH_MAX >= 10
    asm volatile("; ===PHASE 10===");
    { PHASE_ARGS;
    {
        pg8::Gemm g{(const bf16*)(ws + WS_OC), (const bf16*)(ws + WS_WCO), DM, DM, DM};
        pg8::StaticOrder S; S.init(TP, DM, F.G, (int)blockIdx.x);
        EpiGen E{(float*)(ws + WS_X2), DM, (bf16*)(ws + WS_HB), DM, 1.f, (const float*)(ws + WS_X1), (const float*)(ws + WS_X1), TA, DM, (const float*)A.in[I_GFFN], (float*)(ws + WS_SS) + TA, nullptr};
        pg8::gemm_phase(F.lds, g, S, E, F.wave);
        __syncthreads();
        EpiSk Es{(float*)(ws + WS_X2) + (size_t)TP * DM, DM, (bf16*)(ws + WS_HB) + (size_t)TP * DM, DM, 1.f, (const float*)(ws + WS_X1) + (size_t)TP * DM, DM, (const float*)A.in[I_GFFN], (float*)(ws + WS_SS) + TA + TP, nullptr};
        for (int t = F.vcu; t < 256; t += F.G) skinny_tile(F, (const bf16*)(ws + WS_OC) + (size_t)TP * DM, DM, (const bf16*)(ws + WS_WCO), DM, SK_TM16(t), SK_TN16(t), Es);
    }
    }
    GRID_BAR();
#endif
#if PH_MAX >= 12
    asm volatile("; ===PHASE 12===");
    { PHASE_ARGS;
    {
        pg8::Gemm g{(const bf16*)(ws + WS_HB), (const bf16*)(ws + WS_WPK), DM, DM, DM};
        pg8::StaticOrder S; S.init(TP, 2048, F.G, (int)blockIdx.x);
        EpiGen E{nullptr, 0, (bf16*)(ws + WS_SC), 2048, 1.f, nullptr, nullptr, 0, 0, nullptr, nullptr, (const float*)(ws + WS_SS) + TA};
        pg8::gemm_phase(F.lds, g, S, E, F.wave);
        __syncthreads();
        EpiSk Es{nullptr, 0, (bf16*)(ws + WS_SC) + (size_t)TP * 2048, 2048, 1.f, nullptr, 0, nullptr, nullptr, (const float*)(ws + WS_SS) + TA + TP};
        for (int t = F.vcu; t < 512; t += F.G) skinny_tile(F, (const bf16*)(ws + WS_HB) + (size_t)TP * DM, DM, (const bf16*)(ws + WS_WPK), DM, SK_TM32(t), SK_TN32(t), Es);
    }
    }
    GRID_BAR();
#endif
#if PH_MAX >= 13
    asm volatile("; ===PHASE 13===");
    { PHASE_ARGS;
    peer_phase(F, A);
    }
#endif
#if PH_MAX < 13
    {   PHASE_ARGS;
        const int gw = F.vcu * NWAVES + F.wave, NGW = F.G * NWAVES;
        for (int m = gw; m < TA; m += NGW) {
            const float* x = m < TP ? (const float*)A.in[I_XP] + (size_t)m * DM : (const float*)A.in[I_XS] + (size_t)(m - TP) * DM;
            float* y = m < TP ? out + O_YP + (size_t)m * DM : out + O_YS + (size_t)(m - TP) * DM;
            for (int j = 0; j < 4; ++j) ((f32x4*)y)[F.lane + 64 * j] = ((const f32x4*)x)[F.lane + 64 * j];
        }
    }
#endif

}

extern "C" void kernel_launch(void* const* d_in, const int* in_sizes, int n_in, void* d_out, int out_size, void* d_ws, size_t ws_size, hipStream_t stream) {
    static int grid = 0;
    if (grid == 0) {
        if (n_in != N_INPUTS || (size_t)out_size != O_TOTAL || ws_size < WS_END) { fprintf(stderr, "kernel_launch: unexpected shapes (n_in %d out %d ws %zu)\n", n_in, out_size, ws_size); grid = -1; return; }
        int dev = 0, cus = 0, per_cu = 0;
        if (hipGetDevice(&dev) != hipSuccess || hipDeviceGetAttribute(&cus, hipDeviceAttributeMultiprocessorCount, dev) != hipSuccess) { grid = -1; return; }
        if (hipFuncSetAttribute((const void*)mega_fwd, hipFuncAttributeMaxDynamicSharedMemorySize, LDS_BYTES) != hipSuccess) { fprintf(stderr, "kernel_launch: hipFuncSetAttribute failed\n"); grid = -1; return; }
        if (hipOccupancyMaxActiveBlocksPerMultiprocessor(&per_cu, (const void*)mega_fwd, NTHR, LDS_BYTES) != hipSuccess || per_cu < 1)
            fprintf(stderr, "kernel_launch: occupancy query reports %d workgroups per CU\n", per_cu);
        (void)hipGetLastError();
        grid = cus;
        if (grid > 256) grid = 256;
    }
    if (grid < 0) return;
    if (hipMemsetAsync((char*)d_ws + WS_CTL, 0, CTL_ZERO_BYTES, stream) != hipSuccess) return;
    Args a{};
    for (int i = 0; i < N_INPUTS; ++i) a.in[i] = d_in[i];
    a.out = (float*)d_out; a.ws = (unsigned char*)d_ws;
    hipLaunchKernelGGL(mega_fwd, dim3(grid), dim3(NTHR), LDS_BYTES, stream, a);
    const hipError_t le = hipPeekAtLastError();
    if (le != hipSuccess) fprintf(stderr, "kernel_launch: launch failed: %s\n", hipGetErrorName(le));
}
```

```cpp
#define PH_MAX 13
#include <hip/hip_runtime.h>
#include <cstdio>
#include <cstdint>

namespace pg8 {
#define PG8_LAS __attribute__((address_space(3)))
typedef unsigned short bf16_t;
typedef short bf16x8 __attribute__((ext_vector_type(8)));
typedef float f32x4 __attribute__((ext_vector_type(4)));
typedef unsigned u32x4 __attribute__((ext_vector_type(4)));
typedef unsigned u32x2 __attribute__((ext_vector_type(2)));
constexpr int BM = 256, BK = 64, HALF = 128, HTB = HALF * BK * 2  , STAGE_BYTES = 8 * HTB, NXCD = 8, WGM = 8;

__host__ __device__ __forceinline__ int lds_byte(int r, int c) { const int st = (r >> 4) * 2 + (c >> 5), rr = r & 15, cc = c & 31, ob = rr * 64 + cc * 2; return st * 1024 + (ob ^ (((ob >> 9) & 1) << 5)); }
__host__ __device__ __forceinline__ void stage_rc(int b, int& R, int& C) { const int st = b / 1024, sb = b % 1024, swz = sb ^ (((sb >> 9) & 1) << 5); R = (st >> 1) * 16 + swz / 64; C = (st & 1) * 32 + (swz % 64) / 2; }

struct Unit { int pm, pn; };
struct Gemm { const bf16_t* A; const bf16_t* Bt; int lda, ldb, K; };

struct StaticOrder {
    int nM, nN, nwg, G, c;
    __host__ __device__ void init(int M, int N, int G_, int c_) { nM = M / BM; nN = N / BM; nwg = nM * nN; G = G_; c = c_; }
    __host__ __device__ bool next(int i, Unit& u) const {
        const long L = (long)i * G + c; if (L >= nwg) return false;
        int wgid = (int)L; { const int q = nwg / NXCD, r = nwg % NXCD, xcd = wgid % NXCD, off = wgid / NXCD; wgid = (xcd < r ? xcd * (q + 1) : r * (q + 1) + (xcd - r) * q) + off; }
        const int nig = WGM * nN, gid = wgid / nig, fm = gid * WGM, gsz = (nM - fm) < WGM ? (nM - fm) : WGM;
        u.pm = fm + ((wgid % nig) % gsz); u.pn = (wgid % nig) / gsz; return true;
    }
};
struct SingleUnit {
    int has; Unit u0;
    __host__ __device__ bool next(int i, Unit& u) const { if (i != 0 || !has) return false; u = u0; return true; }
};

__device__ __forceinline__ unsigned cvt_pk_bf16(float lo, float hi) { unsigned r; asm volatile("v_cvt_pk_bf16_f32 %0, %1, %2" : "=v"(r) : "v"(lo), "v"(hi)); return r; }

template <class Epi, class Sched>
__device__ __forceinline__ void gemm_phase(PG8_LAS unsigned char* lds, const Gemm g, const Sched& S, const Epi& E, int wave_id) {
    int lane; asm volatile("v_mbcnt_lo_u32_b32 %0, -1, 0\n\tv_mbcnt_hi_u32_b32 %0, -1, %0" : "=v"(lane));
    const int wid = wave_id; const int tid = wid * 64 + lane; const int wr = wid >> 2, wc = wid & 3, fr = lane & 15, fq = lane >> 4;
    const int K = g.K, nt = K / BK;
    unsigned voffA[2], voffB[2];
#pragma unroll
    for (int i = 0; i < 2; ++i) { int R, C; stage_rc(tid * 16 + i * 8192, R, C);
        voffA[i] = (unsigned)(R * g.lda + C) * 2u; voffB[i] = (unsigned)(R * g.ldb + C) * 2u; }
    const size_t kstep = (size_t)(BK * 2);
    const size_t hstepA = (size_t)HALF * g.lda * 2, hstepB = (size_t)HALF * g.ldb * 2;
    const size_t tstepA = 2 * hstepA, tstepB = 2 * hstepB;
    const unsigned ldsw = (unsigned)wid * 1024u;
    const int aoff = lds_byte(wr * 64 + fr, fq * 8), boff = lds_byte(wc * 32 + fr, fq * 8);
#define PG8_SA(b, h) (((b) * 2 + (h)) * HTB)
#define PG8_SB(b, h) ((4 + (b) * 2 + (h)) * HTB)
#define PG8_STAGE(bufoff, gbase, voff) do { _Pragma("unroll") for (int _i = 0; _i < 2; ++_i) \
        __builtin_amdgcn_global_load_lds((const unsigned*)((const char*)(gbase) + (voff)[_i]), (PG8_LAS unsigned*)(lds + (bufoff) + ldsw + _i * 8192), 16, 0, 0); } while (0)
#define PG8_LDA(dst, b, h) do { _Pragma("unroll") for (int m = 0; m < 4; ++m) _Pragma("unroll") for (int k = 0; k < 2; ++k) dst[m][k] = *(const PG8_LAS bf16x8*)(lds + PG8_SA(b, h) + aoff + m * 2048 + k * 1024); } while (0)
#define PG8_LDB(dst, b, h) do { _Pragma("unroll") for (int n = 0; n < 2; ++n) _Pragma("unroll") for (int k = 0; k < 2; ++k) dst[n][k] = *(const PG8_LAS bf16x8*)(lds + PG8_SB(b, h) + boff + n * 2048 + k * 1024); } while (0)
#define PG8_MMA(ai, bj, At, Bt) do { __builtin_amdgcn_s_setprio(1); _Pragma("unroll") for (int m = 0; m < 4; ++m) _Pragma("unroll") for (int n = 0; n < 2; ++n) _Pragma("unroll") for (int k = 0; k < 2; ++k) \
        acc[ai][bj][m][n] = __builtin_amdgcn_mfma_f32_16x16x32_bf16(Bt[n][k], At[m][k], acc[ai][bj][m][n], 0, 0, 0); __builtin_amdgcn_s_setprio(0); } while (0)
#define PG8_WAIT_V(n) asm volatile("s_waitcnt vmcnt(" #n ")" ::: "memory")
#define PG8_WAIT_L(n) asm volatile("s_waitcnt lgkmcnt(" #n ")" ::: "memory")
#define PG8_BAR __builtin_amdgcn_s_barrier()
#define PG8_SCHED __builtin_amdgcn_sched_barrier(0)
    Unit cur, nxt; int ui = 0;
    if (!S.next(0, cur)) return;
    f32x4 acc[2][2][4][2];
#pragma unroll
    for (int a = 0; a < 2; ++a)
#pragma unroll
        for (int b = 0; b < 2; ++b)
#pragma unroll
            for (int m = 0; m < 4; ++m)
#pragma unroll
                for (int n = 0; n < 2; ++n) acc[a][b][m][n] = (f32x4){0.f, 0.f, 0.f, 0.f};
    bf16x8 At[4][2], B0[2][2], B1[2][2];
    const char* cA = (const char*)g.A + (size_t)cur.pm * tstepA; const char* cB = (const char*)g.Bt + (size_t)cur.pn * tstepB;
    PG8_STAGE(PG8_SB(0, 0), cB, voffB); PG8_STAGE(PG8_SB(0, 1), cB + hstepB, voffB); PG8_STAGE(PG8_SA(0, 0), cA, voffA); PG8_STAGE(PG8_SA(0, 1), cA + hstepA, voffA);
    if (wr == 1) PG8_BAR;
    PG8_WAIT_V(2); PG8_BAR;
    PG8_STAGE(PG8_SB(1, 0), cB + kstep, voffB); PG8_STAGE(PG8_SA(1, 0), cA + kstep, voffA); PG8_STAGE(PG8_SB(1, 1), cB + hstepB + kstep, voffB);
    PG8_WAIT_V(6); PG8_BAR;
    for (;;) {
        const bool has_next = S.next(ui + 1, nxt);
        const char* nA = has_next ? (const char*)g.A + (size_t)nxt.pm * tstepA : cA; const char* nB = has_next ? (const char*)g.Bt + (size_t)nxt.pn * tstepB : cB;
        for (int t = 0; t < nt; t += 2) {
            const bool last = (t == nt - 2);
            const char* a1 = cA + (size_t)(t + 1) * kstep;
            const char* a2 = last ? nA : cA + (size_t)(t + 2) * kstep; const char* b2 = last ? nB : cB + (size_t)(t + 2) * kstep;
            const char* a3 = a2 + kstep; const char* b3 = b2 + kstep;
            PG8_LDB(B0, 0, 0); PG8_LDB(B1, 0, 1); PG8_SCHED; PG8_LDA(At, 0, 0); PG8_STAGE(PG8_SA(1, 1), a1 + hstepA, voffA);
            PG8_WAIT_V(8); PG8_WAIT_L(0); PG8_BAR; PG8_MMA(0, 0, At, B0); PG8_MMA(0, 1, At, B1); PG8_BAR; PG8_SCHED;
            PG8_LDA(At, 0, 1); PG8_STAGE(PG8_SB(0, 0), b2, voffB); PG8_STAGE(PG8_SB(0, 1), b2 + hstepB, voffB); PG8_STAGE(PG8_SA(0, 0), a2, voffA);
            PG8_WAIT_V(8); PG8_WAIT_L(0); PG8_BAR; PG8_MMA(1, 0, At, B0); PG8_MMA(1, 1, At, B1); PG8_BAR; PG8_SCHED;
            PG8_LDB(B0, 1, 0); PG8_LDB(B1, 1, 1); PG8_SCHED; PG8_LDA(At, 1, 0); PG8_STAGE(PG8_SA(0, 1), a2 + hstepA, voffA);
            PG8_WAIT_V(8); PG8_WAIT_L(0); PG8_BAR; PG8_MMA(0, 0, At, B0); PG8_MMA(0, 1, At, B1); PG8_BAR; PG8_SCHED;
            PG8_LDA(At, 1, 1); PG8_STAGE(PG8_SB(1, 0), b3, voffB); PG8_STAGE(PG8_SB(1, 1), b3 + hstepB, voffB); PG8_STAGE(PG8_SA(1, 0), a3, voffA);
            PG8_WAIT_V(8); PG8_WAIT_L(0); PG8_BAR; PG8_MMA(1, 0, At, B0); PG8_MMA(1, 1, At, B1); PG8_BAR; PG8_SCHED;
        }
        if (wr == 0) PG8_BAR;
        if constexpr (!Epi::AFTER_DRAIN) { E(acc, cur, wr, wc, fr, fq); }
        if (!has_next) break;
#pragma unroll
        for (int a = 0; a < 2; ++a)
#pragma unroll
            for (int b = 0; b < 2; ++b)
#pragma unroll
                for (int m = 0; m < 4; ++m)
#pragma unroll
                    for (int n = 0; n < 2; ++n) acc[a][b][m][n] = (f32x4){0.f, 0.f, 0.f, 0.f};
        cur = nxt; cA = nA; cB = nB; ++ui;
        if (wr == 1) PG8_BAR;
    }
    PG8_WAIT_V(0);
    PG8_BAR;
    if constexpr (Epi::AFTER_DRAIN) { E.fused(acc, cur, wr, wc, fr, fq, lds, wid, lane); }
#undef PG8_SA
#undef PG8_SB
#undef PG8_STAGE
#undef PG8_LDA
#undef PG8_LDB
#undef PG8_MMA
#undef PG8_WAIT_V
#undef PG8_WAIT_L
#undef PG8_BAR
#undef PG8_SCHED
}
}

#define GAS __attribute__((address_space(1)))
#define LAS __attribute__((address_space(3)))
typedef unsigned short bf16;
typedef unsigned v4u __attribute__((ext_vector_type(4)));
typedef unsigned v2u __attribute__((ext_vector_type(2)));
typedef float f32x4 __attribute__((ext_vector_type(4)));
typedef float f32x2 __attribute__((ext_vector_type(2)));
typedef float f32x16 __attribute__((ext_vector_type(16)));
typedef short bf16x8 __attribute__((ext_vector_type(8)));
typedef short s16x4 __attribute__((ext_vector_type(4)));
typedef GAS unsigned gu32;
#define RLX_AGENT __ATOMIC_RELAXED, __HIP_MEMORY_SCOPE_AGENT
#define LDS_WAIT() asm volatile("s_waitcnt lgkmcnt(0)" ::: "memory")
#define VM_WAIT() asm volatile("s_waitcnt vmcnt(0)" ::: "memory")
__device__ __forceinline__ unsigned f2bf(float f) { unsigned u = __builtin_bit_cast(unsigned, f); return (u + 0x7fffu + ((u >> 16) & 1u)) >> 16; }
__device__ __forceinline__ unsigned pk2(float lo, float hi) { return f2bf(lo) | (f2bf(hi) << 16); }
__device__ __forceinline__ float bf2f(unsigned short b) { return __builtin_bit_cast(float, (unsigned)b << 16); }
__device__ __forceinline__ float bflo(unsigned u) { return __builtin_bit_cast(float, u << 16); }
__device__ __forceinline__ float bfhi(unsigned u) { return __builtin_bit_cast(float, u & 0xffff0000u); }


typedef short v4i16_t __attribute__((ext_vector_type(4)));
__device__ __forceinline__ s16x4 lds_tr16(LAS unsigned char* p) { return __builtin_bit_cast(s16x4, __builtin_amdgcn_ds_read_tr16_b64_v4i16((LAS v4i16_t*)p)); }
__device__ __forceinline__ int crow(int r, int hi) { return (r & 3) + 8 * (r >> 2) + 4 * hi; }

#define DPP_I(v, ctrl) __builtin_amdgcn_update_dpp(0, (v), (ctrl), 0xF, 0xF, false)
#define DPP_F(v, ctrl) __builtin_bit_cast(float, __builtin_amdgcn_update_dpp(0, __builtin_bit_cast(int, (v)), (ctrl), 0xF, 0xF, false))
constexpr int DPP_X1 = 0xB1, DPP_X2 = 0x4E, DPP_HMIR = 0x141, DPP_MIR = 0x140;
__device__ __forceinline__ unsigned max16_u32(unsigned v) {
    unsigned t = (unsigned)DPP_I((int)v, DPP_X1); v = v > t ? v : t; t = (unsigned)DPP_I((int)v, DPP_X2); v = v > t ? v : t;
    t = (unsigned)DPP_I((int)v, DPP_HMIR); v = v > t ? v : t; t = (unsigned)DPP_I((int)v, DPP_MIR); v = v > t ? v : t; return v; }
__device__ __forceinline__ float sum8_f32(float v) { v += DPP_F(v, DPP_X1); v += DPP_F(v, DPP_X2); v += DPP_F(v, DPP_HMIR); return v; }
__device__ __forceinline__ float sum16_f32(float v) { v = sum8_f32(v); v += DPP_F(v, DPP_MIR); return v; }
__device__ __forceinline__ float max16_f32(float v) { v = fmaxf(v, DPP_F(v, DPP_X1)); v = fmaxf(v, DPP_F(v, DPP_X2)); v = fmaxf(v, DPP_F(v, DPP_HMIR)); v = fmaxf(v, DPP_F(v, DPP_MIR)); return v; }
__device__ __forceinline__ float xor16_f32(float v) { return __builtin_bit_cast(float, __builtin_amdgcn_ds_swizzle(__builtin_bit_cast(int, v), 0x1F | (16 << 10))); }
__device__ __forceinline__ float sum64_f32(float v) {
    v = sum16_f32(v); v += xor16_f32(v);
    return __builtin_bit_cast(float, __builtin_amdgcn_readlane(__builtin_bit_cast(int, v), 0)) + __builtin_bit_cast(float, __builtin_amdgcn_readlane(__builtin_bit_cast(int, v), 32)); }
template <int J> __device__ __forceinline__ unsigned xchg_xor_u32(unsigned v) {
    if constexpr (J == 1) return (unsigned)DPP_I((int)v, DPP_X1);
    else if constexpr (J == 2) return (unsigned)DPP_I((int)v, DPP_X2);
    else return (unsigned)__builtin_amdgcn_ds_swizzle((int)v, 0x1F | (J << 10)); }

__device__ __forceinline__ void lds_barrier() { asm volatile("s_waitcnt lgkmcnt(0)\n\ts_barrier" ::: "memory"); }

struct BfPtr { const unsigned short* p; __device__ __forceinline__ float operator[](size_t i) const { return __builtin_bit_cast(float, (unsigned)p[i] << 16); }
               __device__ __forceinline__ BfPtr operator+(size_t o) const { return BfPtr{p + o}; } };
#define GLD(ptr) (BfPtr{(const unsigned short*)(ptr)})

__device__ __forceinline__ int lane_id() { int r; asm volatile("v_mbcnt_lo_u32_b32 %0, -1, 0\n\tv_mbcnt_hi_u32_b32 %0, -1, %0" : "=v"(r)); return r; }
#define TID_IS_ZERO(wave_) ((wave_) == 0 && lane_id() == 0)
#define XB_TMO      128
#define XB_XCNT(j)  (256  + 64 * (j))
#define XB_XSUB(j)  (1280 + 64 * (j))
#define XB_XGEN(j)  (2304 + 64 * (j))
#define XB_TOP      3328
#define XB_TOPGEN   3392
#define XCD_BAR_WORDS 3456
#define XB_SPIN_CAP (1u << 18)

__device__ __forceinline__ unsigned xb_ld(unsigned* p)              { return __hip_atomic_load(p, __ATOMIC_RELAXED, __HIP_MEMORY_SCOPE_AGENT); }
__device__ __forceinline__ unsigned xb_add(unsigned* p, unsigned v) { return __hip_atomic_fetch_add(p, v, __ATOMIC_RELAXED, __HIP_MEMORY_SCOPE_AGENT); }
__device__ __forceinline__ unsigned xb_xcc_id() { return (unsigned)__builtin_amdgcn_s_getreg((3 << 11) | 20) & 0xFu; }
#define XB_SPIN(cond, bar) do { unsigned _sp = 0; while (cond) { __builtin_amdgcn_s_sleep(1); \
    if ((++_sp & 255u) == 0u) { if (xb_ld(&(bar)[XB_TMO])) break; if (_sp > XB_SPIN_CAP) { atomicAdd(&(bar)[XB_TMO], 1u); break; } } } } while (0)

struct XcdBarrier {
    unsigned* bar; unsigned x; int wave;
    volatile LAS unsigned* st;
};

__device__ __forceinline__ XcdBarrier xcd_barrier_post(unsigned* bar, volatile LAS unsigned* st, int wave) {
    XcdBarrier b; b.bar = bar; b.x = xb_xcc_id(); b.st = st; b.wave = wave;
    if (TID_IS_ZERO(wave)) (void)xb_add(&bar[XB_XCNT(b.x)], 1u);
    return b;
}
__device__ __forceinline__ void xcd_barrier_complete(unsigned* bar, unsigned x, unsigned& nloc, unsigned& nx) {
    const unsigned G = gridDim.x * gridDim.y * gridDim.z;
    unsigned sum, cnt, mine, sp = 0u;
    for (;;) {
        sum = 0u; cnt = 0u; mine = 0u;
#pragma unroll
        for (unsigned j = 0; j < 16; ++j) { const unsigned c = xb_ld(&bar[XB_XCNT(j)]); sum += c; cnt += (c > 0u) ? 1u : 0u; mine = (j == x) ? c : mine; }
        if (sum == G) break;
        __builtin_amdgcn_s_sleep(1);
        if ((++sp & 255u) == 0u) { if (xb_ld(&bar[XB_TMO])) break; if (sp > XB_SPIN_CAP) { atomicAdd(&bar[XB_TMO], 1u); break; } }
    }
    nloc = mine > 0u ? mine : 1u; nx = cnt > 0u ? cnt : 1u;
}

__device__ __forceinline__ void xcd_barrier(const XcdBarrier& b) {
    asm volatile("s_waitcnt vmcnt(0)" ::: "memory");
    __syncthreads();
    if (TID_IS_ZERO(b.wave)) {
        unsigned* bar = b.bar;
        __builtin_amdgcn_s_waitcnt(0);
        unsigned nloc = b.st[0], nx = b.st[1];
        if (nloc == 0u) { xcd_barrier_complete(bar, b.x, nloc, nx); b.st[0] = nloc; b.st[1] = nx; }
        const unsigned old = xb_add(&bar[XB_XSUB(b.x)], 1u);
        const unsigned gen = old / nloc;
        if (old + 1u == (gen + 1u) * nloc) {
            __builtin_amdgcn_fence(__ATOMIC_RELEASE, "agent");
            asm volatile("s_waitcnt vmcnt(0)" ::: "memory");
            const unsigned og = xb_add(&bar[XB_TOP], 1u);
            const unsigned tg = og / nx;
            if (og + 1u == (tg + 1u) * nx) xb_add(&bar[XB_TOPGEN], 1u);
            else XB_SPIN(xb_ld(&bar[XB_TOPGEN]) == tg, bar);
            __builtin_amdgcn_fence(__ATOMIC_ACQUIRE, "agent");
            xb_add(&bar[XB_XGEN(b.x)], 1u);
            asm volatile("s_waitcnt vmcnt(0)" ::: "memory");
        } else {
            XB_SPIN(xb_ld(&bar[XB_XGEN(b.x)]) == gen, bar);
            __builtin_amdgcn_fence(__ATOMIC_ACQUIRE, "agent");
            asm volatile("s_waitcnt vmcnt(0)" ::: "memory");
        }
    }
    __syncthreads();
}


constexpr int NWAVES = 8, NTHR = 512;
constexpr int DM = 1024, TP = 16384, TS = 1024, TA = TP + TS, SEQ = 8192, NB_P = 2, NB_S = 128, LS = 8;
constexpr int N_IN = 3328;
constexpr int PASTL = 2048, PAGE = 128, NPAGES = 16;
constexpr float EPS = 1e-6f;
constexpr float LOG2E = 1.4426950408889634f;
constexpr float C2F = 0.125f * LOG2E;
constexpr float C2C = 0.0625f * LOG2E;

enum { I_XP = 0, I_XS, I_CFK, I_CFV, I_CFL, I_SGLA, I_CMK, I_CMV, I_PT, I_MEMP, I_GMIX, I_WIN, I_BFF, I_WG2, I_BG, I_GGO, I_WOUT, I_GCROSS, I_GMEM,
       I_WMK, I_WMV, I_WCQ, I_WCO, I_GFFN, I_PWQ, I_PSK, I_PU, I_PV, I_GFIN, N_INPUTS };
constexpr size_t O_YP = 0, O_YS = 16777216, O_FKP = 17825792, O_FVP = 26214400, O_LFP = 34603008, O_GSP = 34734080, O_MKP = 34799616, O_MVP = 35323904,
                 O_FKS = 35848192, O_FVS = 36372480, O_LFS = 36896768, O_GSS = 36904960, O_TOTAL = 41099264;

constexpr size_t MiB = 1u << 20;
constexpr size_t WS_CTL = 0, CTL_ZERO_BYTES = 1 * MiB;
constexpr size_t WS_WIN = 2 * MiB, WS_WOUT = 10 * MiB, WS_WMK = 12 * MiB, WS_WMV = 14 * MiB, WS_WCQ = 16 * MiB, WS_WCO = 18 * MiB, WS_WPK = 20 * MiB;
constexpr size_t WS_MB = 24 * MiB, WS_MK16 = 25 * MiB, WS_MVT16 = 26 * MiB, WS_KBIAS = 27 * MiB, WS_GDEC = 28 * MiB, WS_GG = 29 * MiB;
constexpr size_t WS_U16 = 32 * MiB, WS_V16 = 64 * MiB, WS_HB = 96 * MiB, WS_QF = 132 * MiB, WS_KF = 150 * MiB, WS_VF = 168 * MiB;
constexpr size_t WS_GQ = 186 * MiB, WS_GK = 204 * MiB, WS_GV = 222 * MiB, WS_GR = 256 * MiB, WS_SUF = 290 * MiB, WS_GKV = 298 * MiB;
constexpr size_t WS_MERGED = 330 * MiB, WS_X1 = 364 * MiB, WS_X2 = 432 * MiB, WS_QC = 500 * MiB, WS_PC = 534 * MiB, WS_OC = 566 * MiB, WS_SC = 600 * MiB;
constexpr size_t WS_MISC = 736 * MiB, WS_SS = 740 * MiB  , WS_BB = 744 * MiB, WS_END = 800 * MiB;
constexpr int CW_BAR = 4096;

constexpr int RING_BYTES = 131072;
constexpr int LDSCTL_OFF = RING_BYTES, MISC_OFF = LDSCTL_OFF + 320;
constexpr int ARGS_OFF = MISC_OFF + 128;
constexpr int LDS_BYTES = 147456;

struct Args { const void* in[N_INPUTS]; float* out; unsigned char* ws; };

__device__ __forceinline__ const void* ld_ptr(const LAS unsigned long long* p) { const unsigned long long v = *p; const unsigned lo = __builtin_amdgcn_readfirstlane((unsigned)v), hi = __builtin_amdgcn_readfirstlane((unsigned)(v >> 32)); return (const void*)(const GAS char*)(((unsigned long long)hi << 32) | lo); }
__device__ __forceinline__ Args load_args(const LAS unsigned long long* ARGP) { Args A;
    A.in[0] = ld_ptr(ARGP + 0);
    A.in[1] = ld_ptr(ARGP + 1);
    A.in[2] = ld_ptr(ARGP + 2);
    A.in[3] = ld_ptr(ARGP + 3);
    A.in[4] = ld_ptr(ARGP + 4);
    A.in[5] = ld_ptr(ARGP + 5);
    A.in[6] = ld_ptr(ARGP + 6);
    A.in[7] = ld_ptr(ARGP + 7);
    A.in[8] = ld_ptr(ARGP + 8);
    A.in[9] = ld_ptr(ARGP + 9);
    A.in[10] = ld_ptr(ARGP + 10);
    A.in[11] = ld_ptr(ARGP + 11);
    A.in[12] = ld_ptr(ARGP + 12);
    A.in[13] = ld_ptr(ARGP + 13);
    A.in[14] = ld_ptr(ARGP + 14);
    A.in[15] = ld_ptr(ARGP + 15);
    A.in[16] = ld_ptr(ARGP + 16);
    A.in[17] = ld_ptr(ARGP + 17);
    A.in[18] = ld_ptr(ARGP + 18);
    A.in[19] = ld_ptr(ARGP + 19);
    A.in[20] = ld_ptr(ARGP + 20);
    A.in[21] = ld_ptr(ARGP + 21);
    A.in[22] = ld_ptr(ARGP + 22);
    A.in[23] = ld_ptr(ARGP + 23);
    A.in[24] = ld_ptr(ARGP + 24);
    A.in[25] = ld_ptr(ARGP + 25);
    A.in[26] = ld_ptr(ARGP + 26);
    A.in[27] = ld_ptr(ARGP + 27);
    A.in[28] = ld_ptr(ARGP + 28);
    A.out = (float*)ld_ptr(ARGP + N_INPUTS); A.ws = (unsigned char*)ld_ptr(ARGP + N_INPUTS + 1); return A; }
struct Frame {
    LAS unsigned char* lds;
    int tid, lane, wave, vcu, G;
};

__device__ __forceinline__ float wave_sum(float v) { return sum64_f32(v); }
__device__ __forceinline__ float log_sigmoid(float x) { return fminf(x, 0.f) - log1pf(__expf(-fabsf(x))); }

__device__ __forceinline__ int win_src_col(int r) {
    if (r < 1536) return r;
    if (r < 1792) return 1544 + (r - 1536);
    if (r < 2048) return 1800 + (r - 1792);
    if (r < 2560) return 2056 + (r - 2048);
    if (r < 3072) return 2584 + (r - 2560);
    if (r < 3080) return 1536 + (r - 3072);
    if (r < 3096) return 2568 + (r - 3080);
    return -1;
}
template <bool WIN>
__device__ __forceinline__ void p0_transpose_item(const float* W, int ldw, int K, int nblk, bf16* WT, LAS float* scr, int item, int lane) {
    const int kb = item / nblk, nb = item % nblk, k0 = 64 * kb, n0 = 32 * nb;
    const int dr = n0 + (lane & 31); const int sc = WIN ? win_src_col(dr) : dr;
#pragma unroll 8
    for (int i = 0; i < 32; ++i) { const int kk = 2 * i + (lane >> 5); scr[kk * 33 + (lane & 31)] = (sc >= 0) ? W[(size_t)(k0 + kk) * ldw + sc] : 0.f; }
    LDS_WAIT(); asm volatile("" ::: "memory");
    const int c = lane & 7;
#pragma unroll
    for (int j = 0; j < 4; ++j) { const int n = (lane >> 3) + 8 * j; const LAS float* s = scr + (8 * c) * 33 + n;
        v4u o; o.x = pk2(s[0 * 33], s[1 * 33]); o.y = pk2(s[2 * 33], s[3 * 33]); o.z = pk2(s[4 * 33], s[5 * 33]); o.w = pk2(s[6 * 33], s[7 * 33]);
        *(GAS v4u*)(WT + (size_t)(n0 + n) * K + k0 + 8 * c) = o; }
    LDS_WAIT(); asm volatile("" ::: "memory");
}
__device__ __forceinline__ void rms_row_bf16(const float* xrow, const float* g, bf16* orow, int lane) {
    const f32x4* xr = (const f32x4*)xrow + lane; const f32x4* gr = (const f32x4*)g + lane;
    f32x4 v[4]; float s = 0.f;
#pragma unroll
    for (int j = 0; j < 4; ++j) { v[j] = xr[64 * j]; s += (v[j].x * v[j].x + v[j].y * v[j].y) + (v[j].z * v[j].z + v[j].w * v[j].w); }
    const float r = rsqrtf(wave_sum(s) * (1.f / DM) + EPS);
    v2u* o8 = (v2u*)orow + lane;
#pragma unroll
    for (int j = 0; j < 4; ++j) { const f32x4 gg = gr[64 * j]; v2u o; o.x = pk2(v[j].x * r * gg.x, v[j].y * r * gg.y); o.y = pk2(v[j].z * r * gg.z, v[j].w * r * gg.w); o8[64 * j] = o; }
}

using pg8::Unit;
struct EpiGen {
    static constexpr bool PERM = false, AFTER_DRAIN = false;
    float* d32; int ld32; bf16* d16; int ld16; float sc16;
    const float* r0; const float* r1; int rsplit; int ldr;
    const float* gcol;
    float* ssq;
    const float* rsq;
    __device__ __forceinline__ void operator()(const f32x4 (&acc)[2][2][4][2], const Unit& u, int wr, int wc, int fr, int fq) const {
        int row0 = u.pm * 256 + wr * 64 + fr, col0 = u.pn * 256 + wc * 32 + fq * 4;
        asm volatile("" : "+v"(row0), "+v"(col0));
#pragma unroll
        for (int ai = 0; ai < 2; ++ai)
#pragma unroll
            for (int m = 0; m < 4; ++m) { const int row = row0 + ai * 128 + m * 16;
                const float* rp = nullptr; if (r0) rp = (row < rsplit) ? r0 + (size_t)row * ldr : r1 + (size_t)(row - rsplit) * ldr;
                float rs = 1.f; if (rsq) rs = rsqrtf(rsq[row] * (1.f / 1024.f) + EPS);
                float ss = 0.f;
#pragma unroll
                for (int bj = 0; bj < 2; ++bj)
#pragma unroll
                    for (int n = 0; n < 2; ++n) { const int col = col0 + bj * 128 + n * 16; f32x4 v = acc[ai][bj][m][n];
                        if (rsq) { v[0] *= rs; v[1] *= rs; v[2] *= rs; v[3] *= rs; }
                        if (r0) v += *(const f32x4*)(rp + col);
                        if (d32) *(f32x4*)(d32 + (size_t)row * ld32 + col) = v;
                        if (ssq) ss += (v[0] * v[0] + v[1] * v[1]) + (v[2] * v[2] + v[3] * v[3]);
                        if (d16) { f32x4 w = v; if (gcol) w = w * *(const f32x4*)(gcol + col);
                            v2u o; o.x = pg8::cvt_pk_bf16(w[0] * sc16, w[1] * sc16); o.y = pg8::cvt_pk_bf16(w[2] * sc16, w[3] * sc16); *(v2u*)(d16 + (size_t)row * ld16 + col) = o; } }
                if (ssq) { ss += xor16_f32(ss); ss += __shfl_xor(ss, 32); if (fq == 0) atomicAdd(ssq + row, ss); } }
    }
};
struct EpiInProj {
    static constexpr bool PERM = false, AFTER_DRAIN = false;
    float* out; unsigned char* ws; const float* bff;
    __device__ __forceinline__ void operator()(const f32x4 (&acc)[2][2][4][2], const Unit& u, int wr, int wc, int fr, int fq) const {
        const int pn = u.pn; const bool smp = u.pm >= 64;
        int row0 = u.pm * 256 + wr * 64 + fr;
        int orow0 = (smp ? (u.pm - 64) * 256 : u.pm * 256) + wr * 64 + fr;
        asm volatile("" : "+v"(row0), "+v"(orow0));
        float* d32 = nullptr; int ld32 = 0; bool d32_grp = false; bf16* d16 = nullptr; int ld16 = 0; float s32 = 1.f, s16 = 1.f; int cb = 0;
        if (pn < 2) { d16 = (bf16*)(ws + WS_QF); ld16 = 512; s16 = C2F; cb = pn * 256; }
        else if (pn < 4) { d32 = out + (smp ? O_FKS : O_FKP); ld32 = 512; d32_grp = true; d16 = (bf16*)(ws + WS_KF); ld16 = 512; cb = (pn - 2) * 256; }
        else if (pn < 6) { d32 = out + (smp ? O_FVS : O_FVP); ld32 = 512; d32_grp = true; d16 = (bf16*)(ws + WS_VF); ld16 = 512; cb = (pn - 4) * 256; }
        else if (pn == 6) { d16 = (bf16*)(ws + WS_GQ); ld16 = 256; s16 = 0.125f; }
        else if (pn == 7) { d16 = (bf16*)(ws + WS_GK); ld16 = 256; }
        else if (pn < 10) { d16 = (bf16*)(ws + WS_GV); ld16 = 512; cb = (pn - 8) * 256; }
        else if (pn < 12) { d16 = (bf16*)(ws + WS_GR); ld16 = 512; cb = (pn - 10) * 256; }
        if (pn < 12) {
#pragma unroll
            for (int ai = 0; ai < 2; ++ai)
#pragma unroll
                for (int m = 0; m < 4; ++m) { const int row = row0 + ai * 128 + m * 16, orow = orow0 + ai * 128 + m * 16;
#pragma unroll
                    for (int bj = 0; bj < 2; ++bj)
#pragma unroll
                        for (int n = 0; n < 2; ++n) { const int col = cb + wc * 32 + fq * 4 + bj * 128 + n * 16; const f32x4 v = acc[ai][bj][m][n];
                            if (d32) *(f32x4*)(d32 + (size_t)(d32_grp ? orow : row) * ld32 + col) = v * s32;
                            if (d16) { v2u o; o.x = pg8::cvt_pk_bf16(v[0] * s16, v[1] * s16); o.y = pg8::cvt_pk_bf16(v[2] * s16, v[3] * s16); *(v2u*)(d16 + (size_t)row * ld16 + col) = o; } } }
        } else {
            if (wc == 0) {
                float* lf = out + (smp ? O_LFS : O_LFP); float* ggp = (float*)(ws + WS_GG);
#pragma unroll
                for (int ai = 0; ai < 2; ++ai)
#pragma unroll
                    for (int m = 0; m < 4; ++m) { const int row = row0 + ai * 128 + m * 16, orow = orow0 + ai * 128 + m * 16;
#pragma unroll
                        for (int n = 0; n < 2; ++n) { const int col = n * 16 + fq * 4; const f32x4 v = acc[ai][0][m][n];
                            if (col < 8) { f32x4 o; const f32x4 b = *(const f32x4*)(bff + col);
                                o[0] = log_sigmoid(v[0] + b[0]); o[1] = log_sigmoid(v[1] + b[1]); o[2] = log_sigmoid(v[2] + b[2]); o[3] = log_sigmoid(v[3] + b[3]);
                                *(f32x4*)(lf + (size_t)orow * 8 + col) = o; }
                            else if (col < 24) *(f32x4*)(ggp + (size_t)row * 16 + (col - 8)) = v; } }
            }
        }
    }
};


__device__ __forceinline__ void p0_prologue(const Frame& F, const Args& a) {
    unsigned char* ws = a.ws;
    LAS float* scr = (LAS float*)(F.lds + F.wave * 16384);
    const int gw = F.vcu * NWAVES + F.wave, NGW = F.G * NWAVES;
    constexpr int I_WINN = 16 * (N_IN / 32), I_SQ = 16 * 32;
    constexpr int NITEMS = I_WINN + 5 * I_SQ;
    for (int it = (gw + NGW / 2) % NGW; it < NITEMS; it += NGW) {
        int r = it;
        if (r < I_WINN) { p0_transpose_item<true>((const float*)a.in[I_WIN], 3096, DM, N_IN / 32, (bf16*)(ws + WS_WIN), scr, r, F.lane); continue; } r -= I_WINN;
        const int which = r / I_SQ; r -= which * I_SQ;
        const float* src = (const float*)(which == 0 ? a.in[I_WOUT] : which == 1 ? a.in[I_WMK] : which == 2 ? a.in[I_WMV] : which == 3 ? a.in[I_WCQ] : a.in[I_WCO]);
        bf16* dst = (bf16*)(ws + (which == 0 ? WS_WOUT : which == 1 ? WS_WMK : which == 2 ? WS_WMV : which == 3 ? WS_WCQ : WS_WCO));
        p0_transpose_item<false>(src, DM, DM, 32, dst, scr, r, F.lane);
    }
    { float* ssz = (float*)(ws + WS_SS); for (int i = F.vcu * NTHR + F.tid; i < 2 * TA; i += F.G * NTHR) ssz[i] = 0.f; }
    for (int m0 = gw * 2; m0 < TA + 512; m0 += NGW * 2) {
        const float* xr[2]; const float* gr[2]; bf16* orow[2];
#pragma unroll
        for (int j = 0; j < 2; ++j) { const int m = m0 + j;
            if (m < TP) { xr[j] = (const float*)a.in[I_XP] + (size_t)m * DM; gr[j] = (const float*)a.in[I_GMIX]; orow[j] = (bf16*)(ws + WS_HB) + (size_t)m * DM; }
            else if (m < TA) { xr[j] = (const float*)a.in[I_XS] + (size_t)(m - TP) * DM; gr[j] = (const float*)a.in[I_GMIX]; orow[j] = (bf16*)(ws + WS_HB) + (size_t)m * DM; }
            else { xr[j] = (const float*)a.in[I_MEMP] + (size_t)(m - TA) * DM; gr[j] = (const float*)a.in[I_GMEM]; orow[j] = (bf16*)(ws + WS_MB) + (size_t)(m - TA) * DM; } }
        f32x4 v[2][4]; float s[2];
#pragma unroll
        for (int j = 0; j < 2; ++j) { s[j] = 0.f;
#pragma unroll
            for (int q = 0; q < 4; ++q) v[j][q] = ((const f32x4*)xr[j])[F.lane + 64 * q]; }
#pragma unroll
        for (int j = 0; j < 2; ++j) {
#pragma unroll
            for (int q = 0; q < 4; ++q) s[j] += (v[j][q].x * v[j][q].x + v[j][q].y * v[j][q].y) + (v[j][q].z * v[j][q].z + v[j][q].w * v[j][q].w);
            const float r = rsqrtf(wave_sum(s[j]) * (1.f / DM) + EPS);
#pragma unroll
            for (int q = 0; q < 4; ++q) { const f32x4 gg = ((const f32x4*)gr[j])[F.lane + 64 * q]; v2u o; o.x = pk2(v[j][q].x * r * gg.x, v[j][q].y * r * gg.y); o.y = pk2(v[j][q].z * r * gg.z, v[j][q].w * r * gg.w); ((v2u*)orow[j])[F.lane + 64 * q] = o; } }
    }
    {
        for (int r0 = gw * 4; r0 < 2 * 16384; r0 += NGW * 4) {
            f32x4 x[4][4];
#pragma unroll
            for (int j = 0; j < 4; ++j) { const int r = r0 + j; const bool isv = r >= 16384; const int e = isv ? r - 16384 : r;
                const f32x4* s = (const f32x4*)((const float*)(isv ? a.in[I_PV] : a.in[I_PU]) + (size_t)e * DM) + F.lane;
#pragma unroll
                for (int q = 0; q < 4; ++q) x[j][q] = __builtin_nontemporal_load(s + 64 * q); }
#pragma unroll
            for (int j = 0; j < 4; ++j) { const int r = r0 + j; const bool isv = r >= 16384; const int e = isv ? r - 16384 : r; float am = 0.f;
#pragma unroll
                for (int q = 0; q < 4; ++q) am = fmaxf(am, fmaxf(fmaxf(fabsf(x[j][q].x), fabsf(x[j][q].y)), fmaxf(fabsf(x[j][q].z), fabsf(x[j][q].w))));
#pragma unroll
                for (int o = 1; o < 64; o <<= 1) am = fmaxf(am, __shfl_xor(am, o));
                const float inv = am > 0.f ? 448.f / am : 0.f;
                v4u o4;
#pragma unroll
                for (int q = 0; q < 4; ++q) { int pk = __builtin_amdgcn_cvt_pk_fp8_f32(x[j][q].x * inv, x[j][q].y * inv, 0, false); pk = __builtin_amdgcn_cvt_pk_fp8_f32(x[j][q].z * inv, x[j][q].w * inv, pk, true); o4[q] = (unsigned)pk; }
                *(v4u*)(ws + (isv ? WS_V16 : WS_U16) + (size_t)e * DM + 16 * F.lane) = o4;
                if (F.lane == 0) ((float*)(ws + WS_MISC))[r] = am * (1.f / 448.f); }
        }
    }
    __syncthreads();
    for (int it = blockIdx.x; it < 256; it += F.G) {
        const int c = it >> 4, kt = it & 15, half = c & 1;
        LAS float* SK = (LAS float*)F.lds; LAS float* WT = (LAS float*)(F.lds + 128 * 129 * 4);
        const float* sk = (const float*)a.in[I_PSK] + (size_t)half * 128 * 128; const float* wq = (const float*)a.in[I_PWQ] + (size_t)(kt * 64) * 2048 + c * 128;
#pragma unroll 4
        for (int i = 0; i < 32; ++i) { const int idx = F.tid + 512 * i; SK[(idx >> 7) * 129 + (idx & 127)] = sk[idx]; }
#pragma unroll 4
        for (int i = 0; i < 16; ++i) { const int idx = F.tid + 512 * i; WT[(idx >> 7) * 129 + (idx & 127)] = wq[(size_t)(idx >> 7) * 2048 + (idx & 127)]; }
        __syncthreads();
        const int tk = F.tid & 15, tkey = F.tid >> 4;
        float acc[4][4];
#pragma unroll
        for (int i = 0; i < 4; ++i)
#pragma unroll
            for (int j = 0; j < 4; ++j) acc[i][j] = 0.f;
        for (int j = 0; j < 128; ++j) {
            float av[4], bv[4];
#pragma unroll
            for (int i = 0; i < 4; ++i) { av[i] = SK[(4 * tkey + i) * 129 + j]; bv[i] = WT[(4 * tk + i) * 129 + j]; }
#pragma unroll
            for (int i = 0; i < 4; ++i)
#pragma unroll
                for (int i2 = 0; i2 < 4; ++i2) acc[i][i2] += av[i] * bv[i2];
        }
        bf16* wp = (bf16*)(ws + WS_WPK);
#pragma unroll
        for (int i = 0; i < 4; ++i) { v2u o; o.x = pk2(acc[i][0], acc[i][1]); o.y = pk2(acc[i][2], acc[i][3]); *(v2u*)(wp + (size_t)(c * 128 + 4 * tkey + i) * DM + kt * 64 + 4 * tk) = o; }
        __syncthreads();
    }
}


__device__ __forceinline__ void fox_prompt_cumsum(const Frame& F, const float* logf  , float* kbias, int b) {
    LAS float* WT = (LAS float*)F.lds;
    const int t0 = F.wave * 1024 + F.lane * 16;
    const f32x4* src = (const f32x4*)(logf + ((size_t)b * SEQ + t0) * 8);
    float s[8];
#pragma unroll
    for (int h = 0; h < 8; ++h) s[h] = 0.f;
#pragma unroll 4
    for (int i = 0; i < 16; ++i) { const f32x4 a = src[2 * i], c = src[2 * i + 1]; s[0] += a.x; s[1] += a.y; s[2] += a.z; s[3] += a.w; s[4] += c.x; s[5] += c.y; s[6] += c.z; s[7] += c.w; }
    float ex[8];
#pragma unroll
    for (int h = 0; h < 8; ++h) { float v = s[h];
#pragma unroll
        for (int o = 1; o < 64; o <<= 1) { const float t = __shfl_up(v, o); if (F.lane >= o) v += t; }
        ex[h] = v - s[h];
        if (F.lane == 63) WT[F.wave * 8 + h] = v; }
    __syncthreads();
#pragma unroll
    for (int h = 0; h < 8; ++h) { float c = 0.f; for (int w = 0; w < F.wave; ++w) c += WT[w * 8 + h]; ex[h] += c; }
    float* dst = kbias + (size_t)(b * 8) * SEQ + t0;
#pragma unroll 4
    for (int i = 0; i < 16; ++i) { const f32x4 a = src[2 * i], c = src[2 * i + 1];
        ex[0] += a.x; ex[1] += a.y; ex[2] += a.z; ex[3] += a.w; ex[4] += c.x; ex[5] += c.y; ex[6] += c.z; ex[7] += c.w;
#pragma unroll
        for (int h = 0; h < 8; ++h) dst[(size_t)h * SEQ + i] = -ex[h] * LOG2E; }
    __syncthreads();
}
__device__ __forceinline__ void fox_sample_suffix(const Frame& F, const float* cfl, const int* pt, float* suf, int bs) {
    float carry[8];
#pragma unroll
    for (int h = 0; h < 8; ++h) carry[h] = 0.f;
    const int mypg = pt[bs * NPAGES + (F.lane & 15)];
#pragma unroll 1
    for (int pb = NPAGES - 4; pb >= 0; pb -= 4) {
        f32x4 x[4][4];
#pragma unroll
        for (int j = 0; j < 4; ++j) { const int pg = __builtin_amdgcn_readlane(mypg, 0) * 0 + __shfl(mypg, pb + j); const f32x4* src = (const f32x4*)(cfl + ((size_t)pg * PAGE + 2 * F.lane) * 8);
            x[j][0] = src[0]; x[j][1] = src[1]; x[j][2] = src[2]; x[j][3] = src[3]; }
#pragma unroll
        for (int j = 3; j >= 0; --j) { const int p = pb + j;
            const float ra[8] = {x[j][0].x, x[j][0].y, x[j][0].z, x[j][0].w, x[j][1].x, x[j][1].y, x[j][1].z, x[j][1].w}, rb[8] = {x[j][2].x, x[j][2].y, x[j][2].z, x[j][2].w, x[j][3].x, x[j][3].y, x[j][3].z, x[j][3].w};
#pragma unroll
            for (int h = 0; h < 8; ++h) {
                const float ps = ra[h] + rb[h]; float v = ps;
#pragma unroll
                for (int o = 1; o < 64; o <<= 1) { const float t = __shfl_down(v, o); if (F.lane + o < 64) v += t; }
                const float exs = v - ps;
                float* d = suf + (size_t)(bs * 8 + h) * PASTL + p * PAGE + 2 * F.lane;
                *(f32x2*)d = (f32x2){(carry[h] + exs + rb[h]) * LOG2E, (carry[h] + exs) * LOG2E};
                carry[h] += __shfl(v, 0);
            }
        }
    }
}

__device__ __forceinline__ void gla_gate_tile(const Frame& F, const float* gg, const float* w2, const float* bg, int row0, int h, int nt, LAS float* LA, LAS float* GGS) {
    for (int e = F.tid; e < nt * 16; e += NTHR) GGS[e] = gg[(size_t)row0 * 16 + e];
    const int dk = F.tid & 63; float wc[16];
#pragma unroll
    for (int r = 0; r < 16; ++r) wc[r] = w2[r * 256 + h * 64 + dk];
    const float bb = bg[h * 64 + dk];
    __syncthreads();
    for (int t = F.tid >> 6; t < nt; t += 8) { float z = bb;
#pragma unroll
        for (int q = 0; q < 4; ++q) { const f32x4 g4 = *(const LAS f32x4*)(GGS + t * 16 + 4 * q); z += g4.x * wc[4 * q] + g4.y * wc[4 * q + 1] + g4.z * wc[4 * q + 2] + g4.w * wc[4 * q + 3]; }
        LA[t * 64 + dk] = log_sigmoid(z) * (1.f / 16.f); }
}
__device__ __forceinline__ void gla_cumsum64(const Frame& F, LAS float* LA, LAS float* SEG) {
    const int dk = F.lane, w = F.wave; float v[8]; float run = 0.f;
#pragma unroll
    for (int i = 0; i < 8; ++i) { run += LA[(8 * w + i) * 64 + dk]; v[i] = run; }
    SEG[w * 64 + dk] = run;
    __syncthreads();
    float pre = 0.f;
    for (int j = 0; j < w; ++j) pre += SEG[j * 64 + dk];
#pragma unroll
    for (int i = 0; i < 8; ++i) LA[(8 * w + i) * 64 + dk] = v[i] + pre;
    __syncthreads();
}
template <int SB>
__device__ __forceinline__ bf16x8 tr_frag(LAS unsigned char* base, int ks) {
    const s16x4 lo = lds_tr16(base + ks * 16 * SB), hi4 = lds_tr16(base + ks * 16 * SB + 8 * SB);
    return (bf16x8){lo[0], lo[1], lo[2], lo[3], hi4[0], hi4[1], hi4[2], hi4[3]};
}
__device__ __forceinline__ bf16x8 row_frag(const LAS unsigned char* rowp, int ks, int hi) {
    const v2u lo = *(const LAS v2u*)(rowp + (16 * ks + 4 * hi) * 2), hi2 = *(const LAS v2u*)(rowp + (16 * ks + 8 + 4 * hi) * 2);
    return __builtin_bit_cast(bf16x8, (v4u){lo.x, lo.y, hi2.x, hi2.y});
}
__device__ __forceinline__ void gla_g1_unit(const Frame& F, const Args& a, int u) {
    unsigned char* ws = a.ws;
    const int b = u >> 9, h = (u >> 7) & 3, n = u & 127; const int row0 = b * SEQ + n * 64;
    LAS float* LA = (LAS float*)F.lds; LAS float* SEG = LA + 4096; LAS float* GGS = SEG + 512; LAS unsigned char* KRB = F.lds + 22528; LAS unsigned char* VSB = F.lds + 34816;
    v4u vq[2];
#pragma unroll
    for (int i = 0; i < 2; ++i) { const int c = F.tid + NTHR * i; vq[i] = *(const v4u*)((const bf16*)(ws + WS_GV) + (size_t)(row0 + (c >> 4)) * 512 + h * 128 + (c & 15) * 8); }
    float gkv[8];
#pragma unroll
    for (int i = 0; i < 8; ++i) { const int e = F.tid + NTHR * i; gkv[i] = GLD(ws + WS_GK)[(size_t)(row0 + (e >> 6)) * 256 + h * 64 + (e & 63)]; }
    gla_gate_tile(F, (const float*)(ws + WS_GG), (const float*)a.in[I_WG2], (const float*)a.in[I_BG], row0, h, 64, LA, GGS);
#pragma unroll
    for (int i = 0; i < 2; ++i) { const int c = F.tid + NTHR * i; *(LAS v4u*)(VSB + (c >> 4) * 320 + (c & 15) * 16) = vq[i]; }
    __syncthreads();
    gla_cumsum64(F, LA, SEG);
    if (F.tid < 64) ((float*)(ws + WS_GDEC))[(size_t)((b * 4 + h) * 128 + n) * 64 + F.tid] = __expf(LA[63 * 64 + F.tid]);
    float* bbuf = (float*)(ws + WS_BB);
#pragma unroll
    for (int i = 0; i < 8; ++i) { const int e = F.tid + NTHR * i; const int t = e >> 6, dk = e & 63; const float bb = LA[e]; bbuf[(size_t)(row0 + t) * 256 + h * 64 + dk] = bb;
        *(LAS unsigned short*)(KRB + t * 192 + dk * 2) = (unsigned short)f2bf(gkv[i] * __expf(LA[63 * 64 + dk] - bb)); }
    __syncthreads();
    {
        const int lane = F.lane, r32 = lane & 31, hi = lane >> 5, mb = F.wave >> 2, nb = F.wave & 3;
        const int tb = (4 * hi + ((lane & 15) >> 2)), tc = (16 * ((lane >> 4) & 1) + 4 * (lane & 3)) * 2;
        LAS unsigned char* abase = KRB + tb * 192 + tc + 64 * mb; LAS unsigned char* bbase = VSB + tb * 320 + tc + 64 * nb;
        f32x16 acc = {};
#pragma unroll
        for (int ks = 0; ks < 4; ++ks) acc = __builtin_amdgcn_mfma_f32_32x32x16_bf16(tr_frag<192>(abase, ks), tr_frag<320>(bbase, ks), acc, 0, 0, 0);
        float* kv = (float*)(ws + WS_GKV) + ((size_t)((b * 4 + h) * 128 + n) * 64 + 32 * mb) * 128 + 32 * nb + r32;
#pragma unroll
        for (int r = 0; r < 16; ++r) kv[(size_t)crow(r, hi) * 128] = acc[r];
    }
    __syncthreads();
}
__device__ __forceinline__ void gla_scan(const Frame& F, const Args& a) {
    int tid = F.wave * 64 + lane_id(); asm volatile("" : "+v"(tid));
    if (tid >= 256) return;
    for (int e = F.vcu * 256 + tid; e < 65536; e += F.G * 256) {
    const int bh = e >> 13, dk = (e >> 7) & 63, dv = e & 127;
    float* kv = (float*)(a.ws + WS_GKV) + ((size_t)bh * 128 * 64 + dk) * 128 + dv; const float* dc = (const float*)(a.ws + WS_GDEC) + (size_t)bh * 128 * 64 + dk;
    float S = 0.f;
#pragma unroll 1
    for (int n0 = 0; n0 < 128; n0 += 32) { float kvv[32], dd[32];
#pragma unroll
        for (int j = 0; j < 32; ++j) { kvv[j] = kv[(size_t)(n0 + j) * 8192]; dd[j] = dc[(size_t)(n0 + j) * 64]; }
#pragma unroll
        for (int j = 0; j < 32; ++j) { kv[(size_t)(n0 + j) * 8192] = S; S = dd[j] * S + kvv[j]; } }
    a.out[O_GSP + (size_t)bh * 8192 + dk * 128 + dv] = S;
    }
}
__device__ __forceinline__ float silu(float x) { return x / (1.f + __expf(-x)); }
__device__ __forceinline__ void gla_sample_unit(const Frame& F, const Args& a, int u) {
    unsigned char* ws = a.ws;
    const int bs = u >> 2, h = u & 3; const int row0 = TP + bs * LS;
    LAS float* LA = (LAS float*)F.lds; LAS float* BL = LA + 512; LAS float* QD = BL + 64; LAS float* KI = QD + 512; LAS float* KR = KI + 512; LAS float* ATT = KR + 512; LAS float* OP = ATT + 64; LAS float* VS = OP + 4096;
    gla_gate_tile(F, (const float*)(ws + WS_GG), (const float*)a.in[I_WG2], (const float*)a.in[I_BG], row0, h, 8, LA, VS + 1024);
#pragma unroll
    for (int i = 0; i < 2; ++i) { const int e = F.tid + NTHR * i; VS[e] = GLD(ws + WS_GV)[(size_t)(row0 + (e >> 7)) * 512 + h * 128 + (e & 127)]; }
    __syncthreads();
    if (F.tid < 64) { float run = 0.f;
#pragma unroll
        for (int t = 0; t < 8; ++t) { run += LA[t * 64 + F.tid]; LA[t * 64 + F.tid] = run; } BL[F.tid] = run; }
    __syncthreads();
    { const int e = F.tid, t = e >> 6, dk = e & 63; const float bb = LA[e];
      const float q = GLD(ws + WS_GQ)[(size_t)(row0 + t) * 256 + h * 64 + dk], k = GLD(ws + WS_GK)[(size_t)(row0 + t) * 256 + h * 64 + dk];
      QD[e] = q * __expf(bb); KI[e] = k * __expf(-bb); KR[e] = k * __expf(BL[dk] - bb); }
    __syncthreads();
    if (F.tid < 64) { const int t = F.tid >> 3, s = F.tid & 7; float acc = 0.f;
        if (s <= t) { for (int dk = 0; dk < 64; ++dk) acc += QD[t * 64 + dk] * KI[s * 64 + dk]; }
        ATT[F.tid] = acc; }
    const int dv = F.tid & 127, dkg = F.tid >> 7;
    {
        const float* st = (const float*)a.in[I_SGLA] + ((size_t)(bs * 4 + h) * 64 + dkg * 16) * 128 + dv;
        float S0[16];
#pragma unroll
        for (int i = 0; i < 16; ++i) S0[i] = st[(size_t)i * 128];
#pragma unroll
        for (int t = 0; t < 8; ++t) { float o = 0.f;
#pragma unroll
            for (int i = 0; i < 16; ++i) o += QD[t * 64 + dkg * 16 + i] * S0[i];
            OP[(dkg * 8 + t) * 128 + dv] = o; }
        float* so = a.out + O_GSS + ((size_t)(bs * 4 + h) * 64 + dkg * 16) * 128 + dv;
#pragma unroll
        for (int i = 0; i < 16; ++i) { float sn = __expf(BL[dkg * 16 + i]) * S0[i];
#pragma unroll
            for (int t = 0; t < 8; ++t) sn += KR[t * 64 + dkg * 16 + i] * VS[t * 128 + dv];
            so[(size_t)i * 128] = sn; }
    }
    __syncthreads();
    {
        const int t = F.wave; float o[2]; float ss = 0.f;
#pragma unroll
        for (int j = 0; j < 2; ++j) { const int d = 2 * F.lane + j; float v = OP[(0 * 8 + t) * 128 + d] + OP[(1 * 8 + t) * 128 + d] + OP[(2 * 8 + t) * 128 + d] + OP[(3 * 8 + t) * 128 + d];
            for (int s = 0; s <= t; ++s) v += ATT[t * 8 + s] * VS[s * 128 + d];
            o[j] = v; ss += v * v; }
        const float r = rsqrtf(wave_sum(ss) * (1.f / 128.f) + EPS);
        const float* ggo = (const float*)a.in[I_GGO] + h * 128 + 2 * F.lane; const BfPtr gr = GLD(ws + WS_GR) + ((size_t)(row0 + t) * 512 + h * 128 + 2 * F.lane);
        const float y0 = o[0] * r * ggo[0] * silu(gr[0]), y1 = o[1] * r * ggo[1] * silu(gr[1]);
        *(unsigned*)((bf16*)(ws + WS_MERGED) + (size_t)(row0 + t) * DM + 512 + h * 128 + 2 * F.lane) = pk2(y0, y1);
    }
    __syncthreads();
}


__device__ __forceinline__ float fexp2(float x) { return __builtin_amdgcn_exp2f(x); }
constexpr float FOX_SKIP = 160.f;


__device__ __forceinline__ void fox_norms_item(const Frame& F, const bf16* QF, const bf16* KF, const float* logf, float* FN, float* LC, float* BT, int item) {
    const int bh = item >> 5, qb = item & 31, b = bh >> 3, h = bh & 7;
    float qm = 0.f, km = 0.f;
    const float* lp = logf + ((size_t)b * SEQ + qb * 256 + 4 * F.lane) * 8 + h;
    const float l0 = lp[0], l1 = lp[8], l2 = lp[16], l3 = lp[24];
#pragma unroll 8
    for (int i = 0; i < 32; ++i) { const size_t row = (size_t)b * SEQ + qb * 256 + i * 8 + (F.lane >> 3);
        const v4u q = *(const v4u*)(QF + row * 512 + h * 64 + (F.lane & 7) * 8), k = *(const v4u*)(KF + row * 512 + h * 64 + (F.lane & 7) * 8); float qs = 0.f, ks = 0.f;
#pragma unroll
        for (int j = 0; j < 4; ++j) { qs += bflo(q[j]) * bflo(q[j]) + bfhi(q[j]) * bfhi(q[j]); ks += bflo(k[j]) * bflo(k[j]) + bfhi(k[j]) * bfhi(k[j]); }
        qs = sum8_f32(qs); ks = sum8_f32(ks);
        qm = fmaxf(qm, qs); km = fmaxf(km, ks); }
#pragma unroll
    for (int o = 1; o < 64; o <<= 1) { qm = fmaxf(qm, __shfl_xor(qm, o)); km = fmaxf(km, __shfl_xor(km, o)); }
    const float c0 = l0, c1 = c0 + l1, c2 = c1 + l2, c3 = c2 + l3; float v = c3;
#pragma unroll
    for (int o = 1; o < 64; o <<= 1) { const float t = __shfl_up(v, o); if (F.lane >= o) v += t; }
    const float ex = v - c3;
    *(f32x4*)(LC + (size_t)bh * SEQ + qb * 256 + 4 * F.lane) = (f32x4){ex + c0, ex + c1, ex + c2, ex + c3};
    if (F.lane == 63) BT[item] = v;
    if (F.lane == 0) { FN[item * 2] = qm; FN[item * 2 + 1] = km; }
}
__device__ __forceinline__ void fox_suffix_item(const Frame& F, const float* cfl, const int* pt, float* SW, float* PTOT, int item) {
    const int bs = item >> 4, p = item & 15; const int pg = __builtin_amdgcn_readfirstlane(pt[item]);
    const f32x4* src = (const f32x4*)(cfl + ((size_t)pg * PAGE + 2 * F.lane) * 8);
    const f32x4 a0 = src[0], a1 = src[1], b0 = src[2], b1 = src[3];
    const float ra[8] = {a0.x, a0.y, a0.z, a0.w, a1.x, a1.y, a1.z, a1.w}, rb[8] = {b0.x, b0.y, b0.z, b0.w, b1.x, b1.y, b1.z, b1.w};
#pragma unroll
    for (int h = 0; h < 8; ++h) {
        const float ps = ra[h] + rb[h]; float v = ps;
#pragma unroll
        for (int o = 1; o < 64; o <<= 1) { const float t = __shfl_down(v, o); if (F.lane + o < 64) v += t; }
        const float exs = v - ps;
        *(f32x2*)(SW + (size_t)(bs * 8 + h) * PASTL + p * PAGE + 2 * F.lane) = (f32x2){exs + rb[h], exs};
        if (F.lane == 0) PTOT[(bs * 8 + h) * NPAGES + p] = v;
    }
}
__device__ __forceinline__ void fox_attn_unit(const Frame& F, const bf16* QF, const bf16* KF, const bf16* VF, const float* LC, const float* BT, const float* FN, bf16* merged, int b, int h, int qb) {
    int tid = F.wave * 64 + lane_id(); asm volatile("" : "+v"(tid));
    const int lane = tid & 63, r32 = lane & 31, hi = lane >> 5, wid = F.wave;
    const size_t rowbase = (size_t)b * SEQ; const int q0 = qb * 256;
    LAS unsigned char* Ks = F.lds; LAS unsigned char* Vs = F.lds + 8192; LAS float* KBs = (LAS float*)(F.lds + 20480); LAS float* WSF = (LAS float*)(F.lds + 20736) + wid * 32;
    const bf16* Qw = QF + (rowbase + q0 + wid * 32 + r32) * 512 + h * 64;
    bf16x8 qr[4];
#pragma unroll
    for (int d0 = 0; d0 < 4; ++d0) qr[d0] = *(const bf16x8*)(Qw + d0 * 16 + hi * 8);
    const float* lcp = LC + (size_t)(b * 8 + h) * SEQ;
    float pbx; { const float btv = (lane < 32) ? BT[(b * 8 + h) * 32 + lane] : 0.f; float v = btv;
#pragma unroll
        for (int o = 1; o < 64; o <<= 1) { const float t = __shfl_up(v, o); if (lane >= o) v += t; }
        pbx = v - btv; }
    const float cref = lcp[q0] + __shfl(pbx, qb);
#define FOX_KB(t_, pos_) (-LOG2E * ((lcp[pos_] + __shfl(pbx, (t_) >> 2)) - cref))
    const int NT = (q0 + 256) / 64;
    int t0 = 0;
    {
        float kn = (lane < 32) ? FN[((b * 8 + h) * 32 + lane) * 2 + 1] : 0.f;
#pragma unroll
        for (int o = 1; o < 64; o <<= 1) kn = fmaxf(kn, __shfl_xor(kn, o));
        const float qk2 = 2.f * sqrtf(FN[((b * 8 + h) * 32 + qb) * 2]) * sqrtf(kn) * 1.01f;
        const int nbefore = q0 / 64;
        int found = -1;
        for (int base = 0; base < nbefore && found < 0; base += 64) {
            const int tl = nbefore - 1 - base - lane;
            const int tlc = tl < 0 ? 0 : tl; const float kbl = -LOG2E * ((lcp[tlc * 64 + 63] + __shfl(pbx, tlc >> 2)) - cref);
            const bool dead = (tl >= 0) && (qk2 + kbl < -FOX_SKIP);
            const unsigned long long bm = __ballot(dead);
            if (bm) found = nbefore - 1 - base - (int)__builtin_ctzll(bm);
        }
        t0 = found + 1;
        t0 = __builtin_amdgcn_readfirstlane(t0);
    }
    const int kkey = tid >> 3, kch = tid & 7, vkey = tid >> 3, vch = tid & 7;
    const bf16* ksrc = KF + (rowbase + kkey) * 512 + h * 64 + kch * 8;
    const bf16* vsrc = VF + (rowbase + vkey) * 512 + h * 64 + vch * 8;
    v4u kreg[2], vreg[2]; float kbreg[2];
#pragma unroll
    for (int hb = 0; hb < 2; ++hb) { const int tt = (t0 + hb < NT) ? t0 + hb : t0;
        kreg[hb] = *(const v4u*)(ksrc + (size_t)tt * 64 * 512); vreg[hb] = *(const v4u*)(vsrc + (size_t)tt * 64 * 512); kbreg[hb] = FOX_KB(tt, tt * 64 + (tid & 63)); }
    float m_run = -INFINITY, l_run = 0.f; f32x16 o0 = {}, o1 = {};
    const int qpos = q0 + wid * 32 + r32;
    const int vbase = (4 * hi + ((lane & 15) >> 2)) * 192 + (16 * ((lane >> 4) & 1) + 4 * (lane & 3)) * 2;
    LAS unsigned char* const Ks0 = Ks; LAS unsigned char* const Vs0 = Vs; LAS float* const KBs0 = KBs;
    __syncthreads();
    for (int t2 = t0; t2 < NT; t2 += 2) {
#pragma unroll
      for (int hb = 0; hb < 2; ++hb) {
        const int t = t2 + hb;
        if (t < NT) {
        LAS unsigned char* const Ks = Ks0 + hb * 28672; LAS unsigned char* const Vs = Vs0 + hb * 28672; LAS float* const KBs = (LAS float*)((LAS unsigned char*)KBs0 + hb * 28672);
        *(LAS v4u*)(Ks + kkey * 128 + ((kch ^ (kkey & 7)) << 4)) = kreg[hb];            *(LAS v4u*)(Vs + vkey * 192 + vch * 16) = vreg[hb]; if (tid < 64) KBs[tid] = kbreg[hb];
        __syncthreads();
        if (t + 2 < NT) { kreg[hb] = *(const v4u*)(ksrc + (size_t)(t + 2) * 64 * 512); vreg[hb] = *(const v4u*)(vsrc + (size_t)(t + 2) * 64 * 512); kbreg[hb] = FOX_KB(t + 2, (t + 2) * 64 + (tid & 63)); }
        const int k0 = t * 64;
        if (k0 <= q0 + wid * 32 + 31) {
        f32x16 p0, p1;
#pragma unroll
        for (int g = 0; g < 4; ++g) { const f32x4 ba = *(const LAS f32x4*)(KBs + 8 * g + 4 * hi), bb = *(const LAS f32x4*)(KBs + 32 + 8 * g + 4 * hi);
#pragma unroll
            for (int i = 0; i < 4; ++i) { p0[4 * g + i] = ba[i]; p1[4 * g + i] = bb[i]; } }
#pragma unroll
        for (int d0 = 0; d0 < 4; ++d0) {
            const bf16x8 a0 = *(const LAS bf16x8*)(Ks + r32 * 128 + (((2 * d0 + hi) ^ (r32 & 7)) << 4)), a1 = *(const LAS bf16x8*)(Ks + (r32 + 32) * 128 + (((2 * d0 + hi) ^ (r32 & 7)) << 4));
            p0 = __builtin_amdgcn_mfma_f32_32x32x16_bf16(a0, qr[d0], p0, 0, 0, 0); p1 = __builtin_amdgcn_mfma_f32_32x32x16_bf16(a1, qr[d0], p1, 0, 0, 0);
        }
        if (k0 + 63 > q0 + wid * 32) {
#pragma unroll
            for (int r = 0; r < 16; ++r) { const int key = k0 + crow(r, hi); if (key > qpos) p0[r] = -INFINITY; if (key + 32 > qpos) p1[r] = -INFINITY; }
        }
        float mx = fmaxf(p0[0], p1[0]);
#pragma unroll
        for (int r = 1; r < 16; ++r) mx = fmaxf(mx, fmaxf(p0[r], p1[r]));
        mx = fmaxf(mx, __shfl_xor(mx, 32));
        const float m_new = fmaxf(m_run, mx), alpha = fexp2(m_run - m_new); m_run = m_new;
        float ls = 0.f;
#pragma unroll
        for (int r = 0; r < 16; ++r) { p0[r] = fexp2(p0[r] - m_new); p1[r] = fexp2(p1[r] - m_new); ls += p0[r] + p1[r]; }
        l_run = l_run * alpha + ls;
        if (__ballot(alpha != 1.f) != 0ull) {
            if (hi == 0) WSF[r32] = alpha;
#pragma unroll
            for (int g = 0; g < 4; ++g) { const f32x4 al = *(const LAS f32x4*)(WSF + 8 * g + 4 * hi);
#pragma unroll
                for (int i = 0; i < 4; ++i) { o0[4 * g + i] *= al[i]; o1[4 * g + i] *= al[i]; } }
        }
        v4u pw[4];
#pragma unroll
        for (int j = 0; j < 4; ++j) { pw[0][j] = pg8::cvt_pk_bf16(p0[2 * j], p0[2 * j + 1]); pw[1][j] = pg8::cvt_pk_bf16(p0[8 + 2 * j], p0[8 + 2 * j + 1]);
                                      pw[2][j] = pg8::cvt_pk_bf16(p1[2 * j], p1[2 * j + 1]); pw[3][j] = pg8::cvt_pk_bf16(p1[8 + 2 * j], p1[8 + 2 * j + 1]); }
#pragma unroll
        for (int ks = 0; ks < 4; ++ks) {
            const bf16x8 pa = __builtin_bit_cast(bf16x8, pw[ks]);
#pragma unroll
            for (int d0 = 0; d0 < 2; ++d0) {
                const s16x4 lo = lds_tr16(Vs + vbase + ks * 16 * 192 + d0 * 64), hi4 = lds_tr16(Vs + vbase + ks * 16 * 192 + 8 * 192 + d0 * 64);
                const bf16x8 vb = (bf16x8){lo[0], lo[1], lo[2], lo[3], hi4[0], hi4[1], hi4[2], hi4[3]};
                if (d0 == 0) o0 = __builtin_amdgcn_mfma_f32_32x32x16_bf16(pa, vb, o0, 0, 0, 0); else o1 = __builtin_amdgcn_mfma_f32_32x32x16_bf16(pa, vb, o1, 0, 0, 0);
            }
        }
        }
        }
      }
    }
    l_run += __shfl_xor(l_run, 32);
    if (hi == 0) WSF[r32] = 1.f / l_run;
    bf16* Ow = merged + (rowbase + q0 + wid * 32) * DM + h * 64 + r32;
#pragma unroll
    for (int g = 0; g < 4; ++g) { const f32x4 rl = *(const LAS f32x4*)(WSF + 8 * g + 4 * hi);
#pragma unroll
        for (int i = 0; i < 4; ++i) { const int r = 4 * g + i; const int row = crow(r, hi);
            Ow[(size_t)row * DM] = (bf16)f2bf(o0[r] * rl[i]); Ow[(size_t)row * DM + 32] = (bf16)f2bf(o1[r] * rl[i]); } }
    __syncthreads();
#undef FOX_KB
}

template <int D> struct DecW {
    static constexpr int KS = D / 32;
    static constexpr int LPK = D / 4;
    static constexpr int KPI = 64 / LPK;
    float m[4], l[4]; float o[8][4];
};
template <int D>
__device__ __forceinline__ void dec_init(DecW<D>& w) {
#pragma unroll
    for (int i = 0; i < 4; ++i) { w.m[i] = -INFINITY; w.l[i] = 0.f; }
#pragma unroll
    for (int q = 0; q < 8; ++q)
#pragma unroll
        for (int j = 0; j < 4; ++j) w.o[q][j] = 0.f;
}
template <int D, int NTILE, int MODE>
__device__ __forceinline__ void dec_chunk(DecW<D>& w, const bf16x8 (&qa)[D / 32], const float* Kb, const float* Vb, int stride, const float* bias, float nb, LAS float* PL, int lane) {
    constexpr int KS = D / 32, LPK = D / 4, KPI = 64 / LPK;
    constexpr int NK = (MODE == 1) ? 8 : NTILE * 16, NV = NK / KPI;
    const int key = lane & 15, kq = lane >> 4;
    const unsigned koff = (unsigned)(key * stride + 8 * kq) * 4u;
    const int d4 = lane % LPK, ksub = lane / LPK;
    const unsigned voff = (unsigned)(ksub * stride + 4 * d4) * 4u;
    f32x4 kx[NTILE][2 * KS], vx[NV];
#pragma unroll
    for (int t = 0; t < NTILE; ++t) { const char* kp = (const char*)(Kb + (size_t)t * 16 * stride) + koff;
#pragma unroll
        for (int ks = 0; ks < KS; ++ks) { kx[t][2 * ks] = *(const f32x4*)(kp + 128 * ks); kx[t][2 * ks + 1] = *(const f32x4*)(kp + 128 * ks + 16); } }
    constexpr int NVA = (NV >= 8) ? NV / 2 : NV;
#pragma unroll
    for (int kk = 0; kk < NVA; ++kk) vx[kk] = *(const f32x4*)((const char*)(Vb + (size_t)kk * KPI * stride) + voff);
    f32x4 s[NTILE];
#pragma unroll
    for (int t = 0; t < NTILE; ++t) {
        f32x4 acc = {0.f, 0.f, 0.f, 0.f};
#pragma unroll
        for (int ks = 0; ks < KS; ++ks) { const f32x4 x0 = kx[t][2 * ks], x1 = kx[t][2 * ks + 1];
            v4u kb; kb.x = pg8::cvt_pk_bf16(x0.x, x0.y); kb.y = pg8::cvt_pk_bf16(x0.z, x0.w); kb.z = pg8::cvt_pk_bf16(x1.x, x1.y); kb.w = pg8::cvt_pk_bf16(x1.z, x1.w);
            acc = __builtin_amdgcn_mfma_f32_16x16x32_bf16(qa[ks], __builtin_bit_cast(bf16x8, kb), acc, 0, 0, 0); }
        if (MODE == 0) { if (bias) { const float bv = (bias[t * 16 + key] + nb) * LOG2E; acc += bv; } }
        else { acc += nb;
#pragma unroll
            for (int i = 0; i < 4; ++i) if (key > 4 * kq + i || key >= 8) acc[i] = -INFINITY; }
        s[t] = acc;
    }
#pragma unroll
    for (int kk = NVA; kk < NV; ++kk) vx[kk] = *(const f32x4*)((const char*)(Vb + (size_t)kk * KPI * stride) + voff);
    f32x4 mc = s[0];
#pragma unroll
    for (int t = 1; t < NTILE; ++t) { mc.x = fmaxf(mc.x, s[t].x); mc.y = fmaxf(mc.y, s[t].y); mc.z = fmaxf(mc.z, s[t].z); mc.w = fmaxf(mc.w, s[t].w); }
    mc.x = max16_f32(mc.x); mc.y = max16_f32(mc.y); mc.z = max16_f32(mc.z); mc.w = max16_f32(mc.w);
    float al[4];
#pragma unroll
    for (int i = 0; i < 4; ++i) { const float mn = fmaxf(w.m[i], mc[i]); al[i] = (mn == -INFINITY) ? 1.f : fexp2(w.m[i] - mn); w.m[i] = mn; w.l[i] *= al[i]; }
#pragma unroll
    for (int t = 0; t < NTILE; ++t) { f32x4 p;
#pragma unroll
        for (int i = 0; i < 4; ++i) { p[i] = (w.m[i] == -INFINITY) ? 0.f : fexp2(s[t][i] - w.m[i]); w.l[i] += p[i]; }
        if (kq < 2) *(LAS f32x4*)(PL + (t * 16 + key) * 8 + 4 * kq) = p; }
    if (key == 0 && kq < 2) *(LAS f32x4*)(PL + 1024 + 4 * kq) = (f32x4){al[0], al[1], al[2], al[3]};
    { const f32x4 a0 = *(const LAS f32x4*)(PL + 1024), a1 = *(const LAS f32x4*)(PL + 1028);
#pragma unroll
      for (int j = 0; j < 4; ++j) { w.o[0][j] *= a0.x; w.o[1][j] *= a0.y; w.o[2][j] *= a0.z; w.o[3][j] *= a0.w; w.o[4][j] *= a1.x; w.o[5][j] *= a1.y; w.o[6][j] *= a1.z; w.o[7][j] *= a1.w; } }
#pragma unroll
    for (int kk = 0; kk < NV; ++kk) { const int k = kk * KPI + ksub;
        const f32x4 v = vx[kk];
        const f32x4 pa = *(const LAS f32x4*)(PL + k * 8), pb = *(const LAS f32x4*)(PL + k * 8 + 4);
#pragma unroll
        for (int j = 0; j < 4; ++j) { w.o[0][j] += pa.x * v[j]; w.o[1][j] += pa.y * v[j]; w.o[2][j] += pa.z * v[j]; w.o[3][j] += pa.w * v[j];
                                      w.o[4][j] += pb.x * v[j]; w.o[5][j] += pb.y * v[j]; w.o[6][j] += pb.z * v[j]; w.o[7][j] += pb.w * v[j]; } }
}
__device__ __forceinline__ void dec_page_fox(DecW<64>& w, const bf16x8 (&qa)[2], const float* Kb, const float* Vb, const float* bias, float boff, LAS float* PL, int lane) {
    constexpr int stride = 512;
    const int key = lane & 15, kq = lane >> 4;
    const unsigned koff = (unsigned)(key * stride + 8 * kq) * 4u;
    const int d4 = lane & 15, ksub = lane >> 4;
    const unsigned voff = (unsigned)(ksub * stride + 4 * d4) * 4u;
    const __amdgpu_buffer_rsrc_t krs = __builtin_amdgcn_make_buffer_rsrc((void*)Kb, 0, 0x7fffffff, 0x00020000);
    const __amdgpu_buffer_rsrc_t vrs = __builtin_amdgcn_make_buffer_rsrc((void*)Vb, 0, 0x7fffffff, 0x00020000);
    const __amdgpu_buffer_rsrc_t brs = __builtin_amdgcn_make_buffer_rsrc((void*)bias, 0, 0x7fffffff, 0x00020000);
    f32x4 s[8];
#pragma unroll
    for (int hb = 0; hb < 2; ++hb) {
        f32x4 kx[4][4];
#pragma unroll
        for (int t = 0; t < 4; ++t) { const int so = (hb * 4 + t) * 16 * stride * 4;
            kx[t][0] = __builtin_bit_cast(f32x4, __builtin_amdgcn_raw_buffer_load_b128(krs, (int)koff, so, 0)); kx[t][1] = __builtin_bit_cast(f32x4, __builtin_amdgcn_raw_buffer_load_b128(krs, (int)koff + 16, so, 0));
            kx[t][2] = __builtin_bit_cast(f32x4, __builtin_amdgcn_raw_buffer_load_b128(krs, (int)koff + 128, so, 0)); kx[t][3] = __builtin_bit_cast(f32x4, __builtin_amdgcn_raw_buffer_load_b128(krs, (int)koff + 144, so, 0)); }
#pragma unroll
        for (int t = 0; t < 4; ++t) {
            f32x4 acc = {0.f, 0.f, 0.f, 0.f};
#pragma unroll
            for (int ks = 0; ks < 2; ++ks) { const f32x4 x0 = kx[t][2 * ks], x1 = kx[t][2 * ks + 1];
                v4u kb; kb.x = pg8::cvt_pk_bf16(x0.x, x0.y); kb.y = pg8::cvt_pk_bf16(x0.z, x0.w); kb.z = pg8::cvt_pk_bf16(x1.x, x1.y); kb.w = pg8::cvt_pk_bf16(x1.z, x1.w);
                acc = __builtin_amdgcn_mfma_f32_16x16x32_bf16(qa[ks], __builtin_bit_cast(bf16x8, kb), acc, 0, 0, 0); }
            acc += (__builtin_bit_cast(float, __builtin_amdgcn_raw_buffer_load_b32(brs, key * 4, (hb * 4 + t) * 64, 0)) + boff) * LOG2E;
            s[hb * 4 + t] = acc;
        }
        asm volatile("" ::: "memory");
    }
    f32x4 mc = s[0];
#pragma unroll
    for (int t = 1; t < 8; ++t) { mc.x = fmaxf(mc.x, s[t].x); mc.y = fmaxf(mc.y, s[t].y); mc.z = fmaxf(mc.z, s[t].z); mc.w = fmaxf(mc.w, s[t].w); }
    mc.x = max16_f32(mc.x); mc.y = max16_f32(mc.y); mc.z = max16_f32(mc.z); mc.w = max16_f32(mc.w);
    float al[4];
#pragma unroll
    for (int i = 0; i < 4; ++i) { const float mn = fmaxf(w.m[i], mc[i]); al[i] = fexp2(w.m[i] - mn); w.m[i] = mn; w.l[i] *= al[i]; }
    bool nz = false;
#pragma unroll
    for (int t = 0; t < 8; ++t) { f32x4 p;
#pragma unroll
        for (int i = 0; i < 4; ++i) { p[i] = fexp2(s[t][i] - w.m[i]); w.l[i] += p[i]; nz = nz || (p[i] != 0.f); }
        if (kq < 2) *(LAS f32x4*)(PL + (t * 16 + key) * 8 + 4 * kq) = p; }
    if (__ballot(nz && kq < 2) == 0ull) return;
    if (key == 0 && kq < 2) *(LAS f32x4*)(PL + 1024 + 4 * kq) = (f32x4){al[0], al[1], al[2], al[3]};
    { const f32x4 a0 = *(const LAS f32x4*)(PL + 1024), a1 = *(const LAS f32x4*)(PL + 1028);
#pragma unroll
      for (int j = 0; j < 4; ++j) { w.o[0][j] *= a0.x; w.o[1][j] *= a0.y; w.o[2][j] *= a0.z; w.o[3][j] *= a0.w; w.o[4][j] *= a1.x; w.o[5][j] *= a1.y; w.o[6][j] *= a1.z; w.o[7][j] *= a1.w; } }
#pragma unroll 1
    for (int vh = 0; vh < 2; ++vh) {
    f32x4 vx[16];
#pragma unroll
    for (int kk = 0; kk < 16; ++kk) vx[kk] = __builtin_bit_cast(f32x4, __builtin_amdgcn_raw_buffer_load_b128(vrs, (int)voff, (vh * 16 + kk) * 4 * stride * 4, 0));
#pragma unroll
    for (int kk = 0; kk < 16; ++kk) { const int k = (vh * 16 + kk) * 4 + ksub;
        const f32x4 v = vx[kk];
        const f32x4 pa = *(const LAS f32x4*)(PL + k * 8), pb = *(const LAS f32x4*)(PL + k * 8 + 4);
#pragma unroll
        for (int j = 0; j < 4; ++j) { w.o[0][j] += pa.x * v[j]; w.o[1][j] += pa.y * v[j]; w.o[2][j] += pa.z * v[j]; w.o[3][j] += pa.w * v[j];
                                      w.o[4][j] += pb.x * v[j]; w.o[5][j] += pb.y * v[j]; w.o[6][j] += pb.z * v[j]; w.o[7][j] += pb.w * v[j]; } }
    }
}
template <int D>
__device__ __forceinline__ void dec_park(DecW<D>& w, LAS float* CBw, int lane) {
    constexpr int LPK = D / 4;
    const int key = lane & 15, kq = lane >> 4, d4 = lane % LPK, ksub = lane / LPK;
#pragma unroll
    for (int i = 0; i < 4; ++i) { float l = w.l[i];
        l = sum16_f32(l);
        w.l[i] = l; }
    if (key == 0 && kq < 2) { *(LAS f32x4*)(CBw + 4 * kq) = (f32x4){w.m[0], w.m[1], w.m[2], w.m[3]}; *(LAS f32x4*)(CBw + 8 + 4 * kq) = (f32x4){w.l[0], w.l[1], w.l[2], w.l[3]}; }
#pragma unroll
    for (int q = 0; q < 8; ++q) { f32x4 v = (f32x4){w.o[q][0], w.o[q][1], w.o[q][2], w.o[q][3]};
        if (LPK < 64) {
#pragma unroll
            for (int o = LPK; o < 64; o <<= 1) { if (o == 16) { v.x += xor16_f32(v.x); v.y += xor16_f32(v.y); v.z += xor16_f32(v.z); v.w += xor16_f32(v.w); }
                else { v.x += __shfl_xor(v.x, o); v.y += __shfl_xor(v.y, o); v.z += __shfl_xor(v.z, o); v.w += __shfl_xor(v.w, o); } } }
        if (ksub == 0) *(LAS f32x4*)(CBw + 16 + q * D + 4 * d4) = v; }
}
template <int D>
__device__ __forceinline__ void dec_combine(int tid, LAS float* CB, bf16* dst, int ldd) {
    constexpr int WSTR = 16 + 8 * D;
    for (int e = tid; e < 8 * D; e += NTHR) { const int q = e / D, d = e % D;
        float mt = -INFINITY;
#pragma unroll
        for (int w = 0; w < 8; ++w) mt = fmaxf(mt, CB[w * WSTR + q]);
        float num = 0.f, den = 0.f;
#pragma unroll
        for (int w = 0; w < 8; ++w) { const float mw = CB[w * WSTR + q]; const float f = (mw == -INFINITY) ? 0.f : fexp2(mw - mt); num += f * CB[w * WSTR + 16 + q * D + d]; den += f * CB[w * WSTR + 8 + q]; }
        dst[(size_t)q * ldd + d] = (bf16)f2bf(num / den); }
}
template <int D>
__device__ __forceinline__ void dec_load_q(bf16x8 (&qa)[D / 32], const bf16* Q, int ldq, int lane) {
    const int row = lane & 15, kq = lane >> 4;
#pragma unroll
    for (int ks = 0; ks < D / 32; ++ks) { v4u z = {0u, 0u, 0u, 0u}; if (row < 8) z = *(const v4u*)(Q + (size_t)row * ldq + 32 * ks + 8 * kq); qa[ks] = __builtin_bit_cast(bf16x8, z); }
}
constexpr int DEC_PL = 1040;
__device__ __forceinline__ void fox_sample_unit(const Frame& F, const Args& a, int u) {
    unsigned char* ws = a.ws; const int bs = u >> 3, h = u & 7;
    int ln = lane_id(); asm volatile("" : "+v"(ln));
    LAS float* PL = (LAS float*)F.lds + F.wave * DEC_PL; LAS float* CB = (LAS float*)F.lds + 8 * DEC_PL; constexpr int WSTR = 16 + 8 * 64;
    bf16x8 qa[2]; dec_load_q<64>(qa, (const bf16*)(ws + WS_QF) + (size_t)(TP + bs * LS) * 512 + h * 64, 512, ln);
    DecW<64> w; dec_init(w);
    {
        const int key = ln & 15; const float* lf = a.out + O_LFS + (size_t)(bs * LS) * 8 + h; float cn = 0.f;
#pragma unroll
        for (int j = 0; j < 8; ++j) { const float x = lf[j * 8]; cn += (j <= key) ? x : 0.f; }
        const float* Kb = a.out + O_FKS + (size_t)(bs * LS) * 512 + h * 64; const float* Vb = a.out + O_FVS + (size_t)(bs * LS) * 512 + h * 64;
        dec_chunk<64, 1, 1>(w, qa, Kb, Vb, 512, nullptr, -cn * LOG2E, PL, ln);
        if (F.wave != 0) {
#pragma unroll
            for (int i = 0; i < 4; ++i) w.l[i] = 0.f;
#pragma unroll
            for (int q = 0; q < 8; ++q)
#pragma unroll
                for (int j = 0; j < 4; ++j) w.o[q][j] = 0.f; }
    }
    const int* pt = (const int*)a.in[I_PT];
    float spx; { const float ptv = (ln < 16) ? ((const float*)(ws + WS_MISC + 2 * MiB))[(bs * 8 + h) * NPAGES + ln] : 0.f; float v = ptv;
#pragma unroll
        for (int o = 1; o < 16; o <<= 1) { const float t = __builtin_bit_cast(float, __builtin_amdgcn_ds_bpermute((ln + o) << 2, __builtin_bit_cast(int, v))); if (ln + o < 16) v += t; }
        spx = v - ptv; }
#if defined(OLD_FOXS)
#pragma unroll 1
    for (int pp = 0; pp < 4; ++pp) { const int p = F.wave * 2 + (pp >> 1), hf = pp & 1; const int pg = __builtin_amdgcn_readfirstlane(pt[bs * NPAGES + p]);
        const float* Kb = (const float*)a.in[I_CFK] + (((size_t)pg * PAGE + hf * 64) * 8 + h) * 64; const float* Vb = (const float*)a.in[I_CFV] + (((size_t)pg * PAGE + hf * 64) * 8 + h) * 64;
        dec_chunk<64, 4, 0>(w, qa, Kb, Vb, 512, (const float*)(ws + WS_SUF) + (size_t)(bs * 8 + h) * PASTL + p * PAGE + hf * 64, __builtin_bit_cast(float, __builtin_amdgcn_ds_bpermute(p << 2, __builtin_bit_cast(int, spx))), PL, ln); }
#else
#pragma unroll 1
    for (int pp = 1; pp >= 0; --pp) { const int p = pp ? (NPAGES - 1 - F.wave) : F.wave;
        const int pg = __builtin_amdgcn_readfirstlane(pt[bs * NPAGES + p]);
        const float* Kb = (const float*)a.in[I_CFK] + ((size_t)pg * PAGE * 8 + h) * 64; const float* Vb = (const float*)a.in[I_CFV] + ((size_t)pg * PAGE * 8 + h) * 64;
        dec_page_fox(w, qa, Kb, Vb, (const float*)(ws + WS_SUF) + (size_t)(bs * 8 + h) * PASTL + p * PAGE, __builtin_bit_cast(float, __builtin_amdgcn_ds_bpermute(p << 2, __builtin_bit_cast(int, spx))), PL, ln); }
#endif
    dec_park<64>(w, CB + F.wave * WSTR, ln);
    __syncthreads();
    dec_combine<64>(F.wave * 64 + ln, CB, (bf16*)(ws + WS_MERGED) + (size_t)(TP + bs * LS) * DM + h * 64, DM);
    __syncthreads();
}
__device__ __forceinline__ void cross_sample_unit(const Frame& F, const Args& a, int u) {
    unsigned char* ws = a.ws; const int bs = u >> 2, h = u & 3;
    LAS float* PL = (LAS float*)F.lds + F.wave * DEC_PL; LAS float* CB = (LAS float*)F.lds + 8 * DEC_PL; constexpr int WSTR = 16 + 8 * 256;
    bf16x8 qa[8]; dec_load_q<256>(qa, (const bf16*)(ws + WS_QC) + (size_t)(TP + bs * LS) * DM + h * 256, DM, F.lane);
    DecW<256> w; dec_init(w);
    const float* Kb = (const float*)a.in[I_CMK] + ((size_t)(bs * 256 + F.wave * 32) * 4 + h) * 256; const float* Vb = (const float*)a.in[I_CMV] + ((size_t)(bs * 256 + F.wave * 32) * 4 + h) * 256;
#pragma unroll 1
    for (int c = 0; c < 2; ++c) dec_chunk<256, 1, 0>(w, qa, Kb + (size_t)c * 16 * 1024, Vb + (size_t)c * 16 * 1024, 1024, nullptr, 0.f, PL, F.lane);
    dec_park<256>(w, CB + F.wave * WSTR, F.lane);
    __syncthreads();
    dec_combine<256>(F.tid, CB, (bf16*)(ws + WS_OC) + (size_t)(TP + bs * LS) * DM + h * 256, DM);
    __syncthreads();
}


__device__ __forceinline__ void gla_g3_unit(const Frame& F, const Args& a, int u) {
    unsigned char* ws = a.ws;
    const int b = u >> 9, h = (u >> 7) & 3, n = u & 127; const int row0 = b * SEQ + n * 64;
    LAS unsigned char* KIB = F.lds; LAS unsigned char* ATTB = F.lds + 34816; LAS unsigned char* QDB = F.lds + 44032;
    LAS unsigned char* VSB = F.lds + 53248; LAS unsigned char* SPB = F.lds + 73728; LAS float* OS = (LAS float*)(F.lds + 94208);
#pragma unroll
    for (int i = 0; i < 2; ++i) { const int c = F.tid + NTHR * i; *(LAS v4u*)(VSB + (c >> 4) * 320 + (c & 15) * 16) = *(const v4u*)((const bf16*)(ws + WS_GV) + (size_t)(row0 + (c >> 4)) * 512 + h * 128 + (c & 15) * 8); }
#pragma unroll
    for (int i = 0; i < 4; ++i) { const int c4 = F.tid + NTHR * i; const f32x4 sp = *(const f32x4*)((const float*)(ws + WS_GKV) + ((size_t)((b * 4 + h) * 128 + n) * 64) * 128 + 4 * c4);
        v2u o; o.x = pg8::cvt_pk_bf16(sp.x, sp.y); o.y = pg8::cvt_pk_bf16(sp.z, sp.w); *(LAS v2u*)(SPB + (c4 >> 5) * 320 + (c4 & 31) * 8) = o; }
#pragma unroll
    for (int i = 0; i < 2; ++i) { const int c4 = F.tid + NTHR * i, t = c4 >> 4, d4 = (c4 & 15) * 4; const size_t gi = (size_t)(row0 + t) * 256 + h * 64 + d4;
        const f32x4 bb = *(const f32x4*)((const float*)(ws + WS_BB) + gi);
        const v2u qq = *(const v2u*)((const bf16*)(ws + WS_GQ) + gi), kk = *(const v2u*)((const bf16*)(ws + WS_GK) + gi);
        v2u qo, ko; qo.x = pg8::cvt_pk_bf16(bflo(qq.x) * __expf(bb.x), bfhi(qq.x) * __expf(bb.y)); qo.y = pg8::cvt_pk_bf16(bflo(qq.y) * __expf(bb.z), bfhi(qq.y) * __expf(bb.w));
        ko.x = pg8::cvt_pk_bf16(bflo(kk.x) * __expf(-bb.x), bfhi(kk.x) * __expf(-bb.y)); ko.y = pg8::cvt_pk_bf16(bflo(kk.y) * __expf(-bb.z), bfhi(kk.y) * __expf(-bb.w));
        *(LAS v2u*)(QDB + t * 144 + d4 * 2) = qo; *(LAS v2u*)(KIB + t * 144 + d4 * 2) = ko; }
    __syncthreads();
    {
        const int lane = F.lane, r32 = lane & 31, hi = lane >> 5;
        if (F.wave < 4) { const int tb = F.wave >> 1, sb = F.wave & 1; f32x16 acc = {};
            if (sb <= tb) {
                const LAS unsigned char* qrow = QDB + (32 * tb + r32) * 144; const LAS unsigned char* krow = KIB + (32 * sb + r32) * 144;
#pragma unroll
                for (int ks = 0; ks < 4; ++ks) acc = __builtin_amdgcn_mfma_f32_32x32x16_bf16(row_frag(qrow, ks, hi), row_frag(krow, ks, hi), acc, 0, 0, 0);
            }
#pragma unroll
            for (int r = 0; r < 16; ++r) { const int t = 32 * tb + crow(r, hi), s2 = 32 * sb + r32; *(LAS unsigned short*)(ATTB + t * 144 + s2 * 2) = (unsigned short)f2bf(s2 <= t ? acc[r] : 0.f); }
        }
    }
    __syncthreads();
    {
        const int lane = F.lane, r32 = lane & 31, hi = lane >> 5, tb = F.wave >> 2, nb = F.wave & 3;
        const int trb = (4 * hi + ((lane & 15) >> 2)) * 320 + (16 * ((lane >> 4) & 1) + 4 * (lane & 3)) * 2 + 64 * nb;
        const LAS unsigned char* arow = ATTB + (32 * tb + r32) * 144; const LAS unsigned char* qrow = QDB + (32 * tb + r32) * 144;
        f32x16 acc = {};
#pragma unroll
        for (int ks = 0; ks < 4; ++ks) acc = __builtin_amdgcn_mfma_f32_32x32x16_bf16(row_frag(arow, ks, hi), tr_frag<320>(VSB + trb, ks), acc, 0, 0, 0);
#pragma unroll
        for (int ks = 0; ks < 4; ++ks) acc = __builtin_amdgcn_mfma_f32_32x32x16_bf16(row_frag(qrow, ks, hi), tr_frag<320>(SPB + trb, ks), acc, 0, 0, 0);
#pragma unroll
        for (int r = 0; r < 16; ++r) OS[(32 * tb + crow(r, hi)) * 128 + 32 * nb + r32] = acc[r];
    }
    __syncthreads();
#pragma unroll
    for (int rr = 0; rr < 8; ++rr) { const int t = F.wave * 8 + rr; const float v0 = OS[t * 128 + F.lane], v1 = OS[t * 128 + 64 + F.lane];
        const float r = rsqrtf(wave_sum(v0 * v0 + v1 * v1) * (1.f / 128.f) + EPS);
        const float* ggo = (const float*)a.in[I_GGO] + h * 128; const BfPtr gr = GLD(ws + WS_GR) + ((size_t)(row0 + t) * 512 + h * 128);
        bf16* mo = (bf16*)(ws + WS_MERGED) + (size_t)(row0 + t) * DM + 512 + h * 128;
        mo[F.lane] = (bf16)f2bf(v0 * r * ggo[F.lane] * silu(gr[F.lane])); mo[64 + F.lane] = (bf16)f2bf(v1 * r * ggo[64 + F.lane] * silu(gr[64 + F.lane])); }
    __syncthreads();
}

struct EpiSoftmaxP {
    static constexpr bool PERM = false, AFTER_DRAIN = true;
    const LAS unsigned long long* argp;
    __device__ __forceinline__ void fused(f32x4 (&acc)[2][2][4][2], const Unit&, int wr, int wc, int fr, int fq, PG8_LAS unsigned char* lds, int wid, int lane) const {
        LAS float* PM = (LAS float*)lds; LAS float* PS = PM + 1024;
        const int ub = (int)blockIdx.x; const int ldp = DM;
        bf16* P = (bf16*)((unsigned char*)ld_ptr(argp + N_INPUTS + 1) + WS_PC) + ((size_t)((ub >> 7) & 1) * SEQ + (ub & 31) * 256) * DM + ((ub >> 5) & 3) * 256;
        { int t2 = lane_id(); asm volatile("" : "+v"(t2)); fr = t2 & 15; fq = (t2 >> 4) & 3; }
#pragma unroll
        for (int ai = 0; ai < 2; ++ai)
#pragma unroll
            for (int m = 0; m < 4; ++m) { float mx = -INFINITY;
#pragma unroll
                for (int bj = 0; bj < 2; ++bj)
#pragma unroll
                    for (int n = 0; n < 2; ++n) { const f32x4 x = acc[ai][bj][m][n]; mx = fmaxf(mx, fmaxf(fmaxf(x[0], x[1]), fmaxf(x[2], x[3]))); }
                mx = fmaxf(mx, xor16_f32(mx)); mx = fmaxf(mx, __shfl_xor(mx, 32));
                if (fq == 0) PM[(ai * 128 + wr * 64 + m * 16 + fr) * 4 + wc] = mx; }
        asm volatile("s_waitcnt lgkmcnt(0)" ::: "memory"); __builtin_amdgcn_s_barrier(); asm volatile("" ::: "memory");
#pragma unroll
        for (int ai = 0; ai < 2; ++ai)
#pragma unroll
            for (int m = 0; m < 4; ++m) { const int r = ai * 128 + wr * 64 + m * 16 + fr; const f32x4 pm = *(const LAS f32x4*)(PM + r * 4);
                const float M = fmaxf(fmaxf(pm[0], pm[1]), fmaxf(pm[2], pm[3])); float s = 0.f;
#pragma unroll
                for (int bj = 0; bj < 2; ++bj)
#pragma unroll
                    for (int n = 0; n < 2; ++n) { f32x4 x = acc[ai][bj][m][n]; x[0] = fexp2(x[0] - M); x[1] = fexp2(x[1] - M); x[2] = fexp2(x[2] - M); x[3] = fexp2(x[3] - M); acc[ai][bj][m][n] = x; s += (x[0] + x[1]) + (x[2] + x[3]); }
                s += xor16_f32(s); s += __shfl_xor(s, 32);
                if (fq == 0) PS[r * 4 + wc] = s; }
        asm volatile("s_waitcnt lgkmcnt(0)" ::: "memory"); __builtin_amdgcn_s_barrier(); asm volatile("" ::: "memory");
#pragma unroll
        for (int ai = 0; ai < 2; ++ai)
#pragma unroll
            for (int m = 0; m < 4; ++m) { const int r = ai * 128 + wr * 64 + m * 16 + fr; const f32x4 ps = *(const LAS f32x4*)(PS + r * 4); const float inv = 1.f / ((ps[0] + ps[1]) + (ps[2] + ps[3]));
#pragma unroll
                for (int bj = 0; bj < 2; ++bj)
#pragma unroll
                    for (int n = 0; n < 2; ++n) { const f32x4 x = acc[ai][bj][m][n]; v2u o; o.x = pg8::cvt_pk_bf16(x[0] * inv, x[1] * inv); o.y = pg8::cvt_pk_bf16(x[2] * inv, x[3] * inv);
                        *(v2u*)(P + (size_t)r * ldp + bj * 128 + wc * 32 + n * 16 + fq * 4) = o; } }
        asm volatile("s_waitcnt lgkmcnt(0)" ::: "memory"); __builtin_amdgcn_s_barrier(); asm volatile("" ::: "memory");
    }
};

__device__ __forceinline__ void rms_rows_phase(const Frame& F, const float* X, const float* g, bf16* H) {
    const int gw = F.vcu * NWAVES + F.wave, NGW = F.G * NWAVES;
    for (int m = gw; m < TA; m += NGW) rms_row_bf16(X + (size_t)m * DM, g, H + (size_t)m * DM, F.lane);
}

__device__ __forceinline__ unsigned f2sort(float f) { const unsigned u = __builtin_bit_cast(unsigned, f); return u ^ ((u >> 31) ? 0xFFFFFFFFu : 0x80000000u); }
__device__ __forceinline__ float sort2f(unsigned s) { const unsigned u = s ^ ((s >> 31) ? 0x80000000u : 0xFFFFFFFFu); return __builtin_bit_cast(float, u); }
__device__ __forceinline__ float gelu_tanh(float x) { const float y = 0.7978845608028654f * (x + 0.044715f * x * x * x); const float e = __expf(2.f * y); return 0.5f * x * (1.f + (1.f - 2.f / (e + 1.f))); }
__device__ __forceinline__ unsigned gmax16(unsigned v) { return max16_u32(v); }
typedef __bf16 bf16x2_t __attribute__((ext_vector_type(2)));
__device__ __forceinline__ float dot2bf(unsigned a, unsigned b, float c) {
#if __has_builtin(__builtin_amdgcn_fdot2_f32_bf16)
    return __builtin_amdgcn_fdot2_f32_bf16(__builtin_bit_cast(bf16x2_t, a), __builtin_bit_cast(bf16x2_t, b), c, false);
#else
    return c + bflo(a) * bflo(b) + bfhi(a) * bfhi(b);
#endif
}
template <bool SPLIT>
__device__ __forceinline__ void peer_token(const Frame& F, const Args& a, int row, LAS unsigned* TOPS, const LAS unsigned* CT, int half, LAS float* PART) {
    unsigned char* ws = a.ws; const int lane = lane_id(), grp = lane >> 4, j16 = lane & 15;
    const bf16* sc = (const bf16*)(ws + WS_SC) + (size_t)row * 2048;
#pragma unroll 1
    for (int bt = 0; bt < 4; ++bt) {
        const v4u xq = *(const v4u*)(sc + (bt * 4 + grp) * 128 + 8 * j16);
        unsigned k[8]; const float xs[8] = {bflo(xq.x), bfhi(xq.x), bflo(xq.y), bfhi(xq.y), bflo(xq.z), bfhi(xq.z), bflo(xq.w), bfhi(xq.w)};
#pragma unroll
        for (int e = 0; e < 8; ++e) k[e] = (f2sort(xs[e]) & ~127u) | (unsigned)(127 - (8 * j16 + e));
#define PEER_CE(i, j) { const unsigned hi_ = k[i] > k[j] ? k[i] : k[j], lo_ = k[i] > k[j] ? k[j] : k[i]; k[i] = hi_; k[j] = lo_; }
        PEER_CE(0, 1) PEER_CE(2, 3) PEER_CE(4, 5) PEER_CE(6, 7)
        PEER_CE(0, 2) PEER_CE(1, 3) PEER_CE(4, 6) PEER_CE(5, 7)
        PEER_CE(1, 2) PEER_CE(5, 6)
        PEER_CE(0, 4) PEER_CE(1, 5) PEER_CE(2, 6) PEER_CE(3, 7)
        PEER_CE(2, 4) PEER_CE(3, 5)
        PEER_CE(1, 2) PEER_CE(3, 4) PEER_CE(5, 6)
#undef PEER_CE
        unsigned mine = 0u;
#pragma unroll 1
        for (int r = 0; r < 16; ++r) {
            const unsigned m = gmax16(k[0]);
            if (j16 == r) mine = m;
            const bool won = (k[0] == m);
#pragma unroll
            for (int e = 0; e < 7; ++e) k[e] = won ? k[e + 1] : k[e];
            k[7] = won ? 0u : k[7];
        }
        TOPS[(bt * 4 + grp) * 16 + j16] = mine;
    }
    int ex[2]; float gx[2], sux[2];
#pragma unroll
    for (int ps = 0; ps < 2; ++ps) {
        const int hd = ps * 4 + grp; const LAS unsigned* T1 = TOPS + (2 * hd) * 16; const LAS unsigned* T2 = T1 + 16;
        const unsigned c0_ = CT[j16], c1_ = CT[j16 + 16], c2_ = CT[j16 + 32], c3_ = CT[j16 + 48];
        const int ci0 = c0_ & 255, cj0 = c0_ >> 8, ci1 = c1_ & 255, cj1 = c1_ >> 8, ci2 = c2_ & 255, cj2 = c2_ >> 8, ci3 = c3_ & 255, cj3 = c3_ >> 8; const bool cv3 = (j16 + 48) < 50;
        unsigned k[4];
        { const float s0 = sort2f(T1[ci0] & ~127u) + sort2f(T2[cj0] & ~127u), s1 = sort2f(T1[ci1] & ~127u) + sort2f(T2[cj1] & ~127u),
                      s2 = sort2f(T1[ci2] & ~127u) + sort2f(T2[cj2] & ~127u), s3 = sort2f(T1[ci3] & ~127u) + sort2f(T2[cj3] & ~127u);
          k[0] = (f2sort(s0) & ~127u) | (unsigned)(127 - j16); k[1] = (f2sort(s1) & ~127u) | (unsigned)(127 - (j16 + 16)); k[2] = (f2sort(s2) & ~127u) | (unsigned)(127 - (j16 + 32));
          k[3] = cv3 ? ((f2sort(s3) & ~127u) | (unsigned)(127 - (j16 + 48))) : 0u; }
#define PEER_CE(i, j) { const unsigned hi_ = k[i] > k[j] ? k[i] : k[j], lo_ = k[i] > k[j] ? k[j] : k[i]; k[i] = hi_; k[j] = lo_; }
        PEER_CE(0, 1) PEER_CE(2, 3) PEER_CE(0, 2) PEER_CE(1, 3) PEER_CE(1, 2)
#undef PEER_CE
        unsigned mine = 0u;
#pragma unroll 1
        for (int r = 0; r < 16; ++r) {
            const unsigned m = gmax16(k[0]);
            if (j16 == r) mine = m;
            const bool won = (k[0] == m);
            k[0] = won ? k[1] : k[0]; k[1] = won ? k[2] : k[1]; k[2] = won ? k[3] : k[2]; k[3] = won ? 0u : k[3];
        }
        const int c = 127 - (int)(mine & 127u);
        int ci, cj;
        if (c < 16) { ci = 0; cj = c; } else if (c < 24) { ci = 1; cj = c - 16; } else if (c < 29) { ci = 2; cj = c - 24; } else if (c < 33) { ci = 3; cj = c - 29; }
        else if (c < 36) { ci = 4; cj = c - 33; } else if (c < 38) { ci = 5; cj = c - 36; } else if (c < 40) { ci = 6; cj = c - 38; } else if (c < 42) { ci = 7; cj = c - 40; } else { ci = c - 34; cj = 0; }
        const int i1 = 127 - (int)(T1[ci] & 127u), i2 = 127 - (int)(T2[cj] & 127u);
        ex[ps] = i1 * 128 + i2;
        const float sv = sort2f(mine & ~127u); const float s0 = __shfl(sv, lane & 48);
        float ee = __expf(sv - s0); const float es = sum16_f32(ee);
        const float* rsc = (const float*)(ws + WS_MISC);
        sux[ps] = rsc[ex[ps]]; gx[ps] = ee / es * rsc[16384 + ex[ps]];
    }
    {
        unsigned k0 = ((unsigned)ex[0] << 7) | (unsigned)lane, k1 = ((unsigned)ex[1] << 7) | (unsigned)(64 + lane);
#pragma unroll
        for (int k = 2; k <= 128; k <<= 1) {
#pragma unroll
            for (int j = k >> 1; j > 0; j >>= 1) {
                if (j == 64) { const unsigned lo = k0 < k1 ? k0 : k1, hi = k0 < k1 ? k1 : k0; k0 = lo; k1 = hi; }
                else {
                    unsigned p0, p1;
                    if (j == 32) { p0 = (unsigned)__shfl_xor((int)k0, 32); p1 = (unsigned)__shfl_xor((int)k1, 32); }
                    else if (j == 16) { p0 = xchg_xor_u32<16>(k0); p1 = xchg_xor_u32<16>(k1); } else if (j == 8) { p0 = xchg_xor_u32<8>(k0); p1 = xchg_xor_u32<8>(k1); }
                    else if (j == 4) { p0 = xchg_xor_u32<4>(k0); p1 = xchg_xor_u32<4>(k1); } else if (j == 2) { p0 = xchg_xor_u32<2>(k0); p1 = xchg_xor_u32<2>(k1); }
                    else { p0 = xchg_xor_u32<1>(k0); p1 = xchg_xor_u32<1>(k1); }
                    const bool low = (lane & j) == 0; const bool asc0 = (lane & k) == 0, asc1 = ((64 + lane) & k) == 0;
                    const unsigned mn0 = k0 < p0 ? k0 : p0, mx0 = k0 < p0 ? p0 : k0, mn1 = k1 < p1 ? k1 : p1, mx1 = k1 < p1 ? p1 : k1;
                    k0 = (low == asc0) ? mn0 : mx0; k1 = (low == asc1) ? mn1 : mx1;
                }
            }
        }
        const int o0 = (int)(k0 & 127u), o1 = (int)(k1 & 127u);
        const float g0a = __shfl(gx[0], o0 & 63), g0b = __shfl(gx[1], o0 & 63), g1a = __shfl(gx[0], o1 & 63), g1b = __shfl(gx[1], o1 & 63);
        const float s0a = __shfl(sux[0], o0 & 63), s0b = __shfl(sux[1], o0 & 63), s1a = __shfl(sux[0], o1 & 63), s1b = __shfl(sux[1], o1 & 63);
        gx[0] = (o0 & 64) ? g0b : g0a; gx[1] = (o1 & 64) ? g1b : g1a; sux[0] = (o0 & 64) ? s0b : s0a; sux[1] = (o1 & 64) ? s1b : s1a;
        ex[0] = (int)(k0 >> 7); ex[1] = (int)(k1 >> 7);
    }
    const float rstd2 = rsqrtf(((const float*)(ws + WS_SS))[TA + row] * (1.f / 1024.f) + EPS);
    float hf[16];
    { const bf16* hb = (const bf16*)(ws + WS_HB) + (size_t)row * DM + 4 * lane;
#pragma unroll
      for (int q = 0; q < 4; ++q) { const v2u hq = *(const v2u*)(hb + 256 * q); hf[4 * q] = bflo(hq.x); hf[4 * q + 1] = bfhi(hq.x); hf[4 * q + 2] = bflo(hq.y); hf[4 * q + 3] = bfhi(hq.y); } }
    float oacc[16];
#pragma unroll
    for (int i = 0; i < 16; ++i) oacc[i] = 0.f;
    const unsigned char* U = ws + WS_U16; const unsigned char* V = ws + WS_V16;
    v4u ub[8], vbA[8], vbB[8];
    const int gbeg = SPLIT ? 8 * half : 0, gend = SPLIT ? 8 * half + 8 : 16;
    const int addr32 = (lane ^ 32) << 2;
#define PEER_LOAD(buf, TAB, g) do { const int kk_ = (g) * 8; const int exs_ = (kk_ < 64) ? ex[0] : ex[1]; \
        _Pragma("unroll") for (int i = 0; i < 8; ++i) { const int e_ = __builtin_amdgcn_readlane(exs_, (kk_ & 63) + i); buf[i] = *(const v4u*)(TAB + (size_t)e_ * DM + 16 * lane); } } while (0)
#define PEER_DOTS(buf, g, wout) do { const int kk_ = (g) * 8; const float gxs_ = (kk_ < 64) ? gx[0] : gx[1]; const float sus_ = (kk_ < 64) ? sux[0] : sux[1]; float av[8]; \
        _Pragma("unroll") for (int i = 0; i < 8; ++i) { float s = 0.f; \
            _Pragma("unroll") for (int q = 0; q < 4; ++q) { const f32x2 lo = __builtin_amdgcn_cvt_pk_f32_fp8((int)buf[i][q], false), hi = __builtin_amdgcn_cvt_pk_f32_fp8((int)buf[i][q], true); \
                s += lo.x * hf[4 * q]; s += lo.y * hf[4 * q + 1]; s += hi.x * hf[4 * q + 2]; s += hi.y * hf[4 * q + 3]; } \
            av[i] = s; } \
        const bool b5 = lane & 32, b4 = lane & 16, b3_ = lane & 8; float bq[4], cq[2], dq; \
        _Pragma("unroll") for (int i = 0; i < 4; ++i) bq[i] = (b5 ? av[4 + i] : av[i]) + __builtin_bit_cast(float, __builtin_amdgcn_ds_bpermute(addr32, __builtin_bit_cast(int, b5 ? av[i] : av[4 + i])));     \
        _Pragma("unroll") for (int i = 0; i < 2; ++i) cq[i] = (b4 ? bq[2 + i] : bq[i]) + xor16_f32(b4 ? bq[i] : bq[2 + i]); \
        dq = (b3_ ? cq[1] : cq[0]) + DPP_F(b3_ ? cq[0] : cq[1], DPP_MIR);        \
        dq = sum8_f32(dq); \
        const int src = (kk_ & 63) + (lane >> 3); \
        wout = __shfl(gxs_, src) * gelu_tanh(dq * __shfl(sus_, src) * rstd2); } while (0)
#define PEER_ACC(buf, wv) do { _Pragma("unroll") for (int i = 0; i < 8; ++i) { const float w = __builtin_bit_cast(float, __builtin_amdgcn_readlane(__builtin_bit_cast(int, wv), 8 * i)); \
        _Pragma("unroll") for (int q = 0; q < 4; ++q) { const f32x2 lo = __builtin_amdgcn_cvt_pk_f32_fp8((int)buf[i][q], false), hi = __builtin_amdgcn_cvt_pk_f32_fp8((int)buf[i][q], true); \
            oacc[4 * q] += w * lo.x; oacc[4 * q + 1] += w * lo.y; oacc[4 * q + 2] += w * hi.x; oacc[4 * q + 3] += w * hi.y; } } } while (0)
    PEER_LOAD(ub, U, gbeg); PEER_LOAD(vbA, V, gbeg);
#pragma unroll 1
    for (int g0 = gbeg; g0 < gend; g0 += 2) {
        float w0, w1;
        PEER_DOTS(ub, g0, w0);
        PEER_LOAD(ub, U, g0 + 1); PEER_LOAD(vbB, V, g0 + 1);
        PEER_ACC(vbA, w0);
        PEER_DOTS(ub, g0 + 1, w1);
        { const int gn = (g0 + 2 < gend) ? g0 + 2 : g0 + 1;
          PEER_LOAD(ub, U, gn); PEER_LOAD(vbA, V, gn); }
        PEER_ACC(vbB, w1);
    }
#undef PEER_LOAD
#undef PEER_DOTS
#undef PEER_ACC
    if (SPLIT) {
        if (half == 1) {
#pragma unroll
            for (int q = 0; q < 4; ++q) *(LAS f32x4*)(PART + 16 * lane + 4 * q) = (f32x4){oacc[4 * q], oacc[4 * q + 1], oacc[4 * q + 2], oacc[4 * q + 3]}; }
        __syncthreads();
        if (half == 1) return;
#pragma unroll
        for (int q = 0; q < 4; ++q) { const f32x4 p = *(const LAS f32x4*)(PART + 16 * lane + 4 * q); oacc[4 * q] += p.x; oacc[4 * q + 1] += p.y; oacc[4 * q + 2] += p.z; oacc[4 * q + 3] += p.w; }
    }
    asm volatile("" : "+s"(row)); const int lane2 = lane_id();
    const f32x4* x2 = (const f32x4*)((const float*)(ws + WS_X2) + (size_t)row * DM) + lane2;
    f32x4 xv[4]; float ss = 0.f;
#pragma unroll
    for (int q = 0; q < 4; ++q) { xv[q] = x2[64 * q]; xv[q].x += oacc[4 * q]; xv[q].y += oacc[4 * q + 1]; xv[q].z += oacc[4 * q + 2]; xv[q].w += oacc[4 * q + 3]; ss += (xv[q].x * xv[q].x + xv[q].y * xv[q].y) + (xv[q].z * xv[q].z + xv[q].w * xv[q].w); }
    const float r = rsqrtf(wave_sum(ss) * (1.f / DM) + EPS);
    const f32x4* gf = (const f32x4*)((const float*)a.in[I_GFIN]) + lane2;
    f32x4* y = (f32x4*)(row < TP ? a.out + O_YP + (size_t)row * DM : a.out + O_YS + (size_t)(row - TP) * DM) + lane2;
#pragma unroll
    for (int q = 0; q < 4; ++q) { const f32x4 g4 = gf[64 * q]; f32x4 o; o.x = xv[q].x * r * g4.x; o.y = xv[q].y * r * g4.y; o.z = xv[q].z * r * g4.z; o.w = xv[q].w * r * g4.w; y[64 * q] = o; }
}
__device__ __forceinline__ void cand_ij(int c, int& ci, int& cj) {
    if (c < 16) { ci = 0; cj = c; } else if (c < 24) { ci = 1; cj = c - 16; } else if (c < 29) { ci = 2; cj = c - 24; } else if (c < 33) { ci = 3; cj = c - 29; }
    else if (c < 36) { ci = 4; cj = c - 33; } else if (c < 38) { ci = 5; cj = c - 36; } else if (c < 40) { ci = 6; cj = c - 38; } else if (c < 42) { ci = 7; cj = c - 40; } else if (c < 50) { ci = c - 34; cj = 0; } else { ci = 0; cj = 0; }
}
__device__ __forceinline__ void peer_phase(const Frame& F, const Args& a) {
    LAS unsigned* TOPS = (LAS unsigned*)F.lds + F.wave * 256;
    LAS unsigned* CT = (LAS unsigned*)F.lds + 8 * 256 + 4 * 1024;
    if (F.tid < 64) { int ci, cj; cand_ij(F.tid, ci, cj); CT[F.tid] = (unsigned)ci | ((unsigned)cj << 8); }
    __syncthreads();
    const int gw = F.vcu * NWAVES + F.wave, NGW = F.G * NWAVES;
    const int nfull = TA / NGW, rem = TA - nfull * NGW;
#pragma unroll 1
    for (int i = 0; i < nfull; ++i) peer_token<false>(F, a, gw + i * NGW, TOPS, CT, 0, nullptr);
    if (rem == 4 * F.G) {
        __syncthreads();
        peer_token<true>(F, a, nfull * NGW + F.vcu * 4 + (F.wave >> 1), TOPS, CT, F.wave & 1, (LAS float*)F.lds + 8 * 256 + (F.wave >> 1) * 1024);
    } else {
        const int row = gw + nfull * NGW; if (row < TA) peer_token<false>(F, a, row, TOPS, CT, 0, nullptr);
    }
}


template <class EpiS>
__device__ __forceinline__ void skinny_tile(const Frame& F, const bf16* A, int lda, const bf16* Bt, int ldb, int tm, int tn, const EpiS& E) {
    const int lane = F.lane, fr = lane & 15, fq = lane >> 4, w = F.wave, lr = lane >> 3, lc = lane & 7;
    LAS unsigned char* SA = F.lds + w * 16384; LAS unsigned char* SB = SA + 8192;
    const bf16* ag = A + (size_t)(tm * 64 + lr) * lda + w * 128 + 8 * lc;
    const bf16* bg = Bt + (size_t)(tn * 64 + lr) * ldb + w * 128 + 8 * lc;
    f32x4 acc[4][4];
#pragma unroll
    for (int m = 0; m < 4; ++m)
#pragma unroll
        for (int n = 0; n < 4; ++n) acc[m][n] = (f32x4){0.f, 0.f, 0.f, 0.f};
    v4u ar[2][8], br[2][8];
#pragma unroll
    for (int kh = 0; kh < 2; ++kh)
#pragma unroll
        for (int i = 0; i < 8; ++i) { ar[kh][i] = *(const v4u*)(ag + (size_t)(8 * i) * lda + 64 * kh); br[kh][i] = *(const v4u*)(bg + (size_t)(8 * i) * ldb + 64 * kh); }
#pragma unroll
    for (int kh = 0; kh < 2; ++kh) {
#pragma unroll
        for (int i = 0; i < 8; ++i) { const int row = 8 * i + lr; *(LAS v4u*)(SA + row * 128 + ((lc ^ (row & 7)) << 4)) = ar[kh][i]; *(LAS v4u*)(SB + row * 128 + ((lc ^ (row & 7)) << 4)) = br[kh][i]; }
        bf16x8 af[4][2], bfr[4][2];
#pragma unroll
        for (int m = 0; m < 4; ++m)
#pragma unroll
            for (int ks = 0; ks < 2; ++ks) { const int row = 16 * m + fr; const int off = row * 128 + (((4 * ks + fq) ^ (row & 7)) << 4);
                af[m][ks] = *(const LAS bf16x8*)(SA + off); bfr[m][ks] = *(const LAS bf16x8*)(SB + off); }
#pragma unroll
        for (int ks = 0; ks < 2; ++ks)
#pragma unroll
            for (int m = 0; m < 4; ++m)
#pragma unroll
                for (int n = 0; n < 4; ++n) acc[m][n] = __builtin_amdgcn_mfma_f32_16x16x32_bf16(bfr[n][ks], af[m][ks], acc[m][n], 0, 0, 0);
        asm volatile("s_waitcnt lgkmcnt(0)" ::: "memory");
    }
    LAS float* PS = (LAS float*)F.lds + w * 4096;
#pragma unroll
    for (int m = 0; m < 4; ++m)
#pragma unroll
        for (int n = 0; n < 4; ++n) *(LAS f32x4*)(PS + (16 * m + fr) * 64 + 4 * ((4 * n + fq) ^ fr)) = acc[m][n];
    lds_barrier();
    {
        const int row = F.tid >> 3, c8 = (F.tid & 7) * 8; const LAS float* PR = (const LAS float*)F.lds + row * 64;
        const int ch0 = 4 * (((F.tid & 7) * 2) ^ (row & 15)), ch1 = 4 * (((F.tid & 7) * 2 + 1) ^ (row & 15));
        f32x4 s0 = *(const LAS f32x4*)(PR + ch0), s1 = *(const LAS f32x4*)(PR + ch1);
#pragma unroll
        for (int ww = 1; ww < 8; ++ww) { s0 += *(const LAS f32x4*)(PR + ww * 4096 + ch0); s1 += *(const LAS f32x4*)(PR + ww * 4096 + ch1); }
        float v[8] = {s0.x, s0.y, s0.z, s0.w, s1.x, s1.y, s1.z, s1.w};
        E(tm * 64 + row, tn * 64 + c8, v, F.tid);
    }
    lds_barrier();
}
struct EpiSk {
    float* d32; int ld32; bf16* d16; int ld16; float sc16;
    const float* res; int ldr;
    const float* gcol; float* ssq; const float* rsq;
    __device__ __forceinline__ void operator()(int row, int col, float (&v)[8], int tid) const {
        if (rsq) { const float rs = rsqrtf(rsq[row] * (1.f / 1024.f) + EPS);
#pragma unroll
            for (int i = 0; i < 8; ++i) v[i] *= rs; }
        if (res) { const f32x4 a = *(const f32x4*)(res + (size_t)row * ldr + col), b = *(const f32x4*)(res + (size_t)row * ldr + col + 4);
            v[0] += a.x; v[1] += a.y; v[2] += a.z; v[3] += a.w; v[4] += b.x; v[5] += b.y; v[6] += b.z; v[7] += b.w; }
        if (d32) { *(f32x4*)(d32 + (size_t)row * ld32 + col) = (f32x4){v[0], v[1], v[2], v[3]}; *(f32x4*)(d32 + (size_t)row * ld32 + col + 4) = (f32x4){v[4], v[5], v[6], v[7]}; }
        if (ssq) { float ss = 0.f;
#pragma unroll
            for (int i = 0; i < 8; ++i) ss += v[i] * v[i];
            ss = sum8_f32(ss);
            if ((tid & 7) == 0) atomicAdd(ssq + row, ss); }
        if (d16) { float w8[8];
#pragma unroll
            for (int i = 0; i < 8; ++i) w8[i] = v[i];
            if (gcol) { const f32x4 a = *(const f32x4*)(gcol + col), b = *(const f32x4*)(gcol + col + 4); w8[0] *= a.x; w8[1] *= a.y; w8[2] *= a.z; w8[3] *= a.w; w8[4] *= b.x; w8[5] *= b.y; w8[6] *= b.z; w8[7] *= b.w; }
            v4u o; o.x = pg8::cvt_pk_bf16(w8[0] * sc16, w8[1] * sc16); o.y = pg8::cvt_pk_bf16(w8[2] * sc16, w8[3] * sc16); o.z = pg8::cvt_pk_bf16(w8[4] * sc16, w8[5] * sc16); o.w = pg8::cvt_pk_bf16(w8[6] * sc16, w8[7] * sc16);
            *(v4u*)(d16 + (size_t)row * ld16 + col) = o; }
    }
};

#define SK_TM16(t) (4 * (((t) >> 5) >> 1) + (((t) & 31) >> 3))
#define SK_TN16(t) (8 * (((t) >> 5) & 1) + ((t) & 7))
#define SK_TM32(t) (4 * ((((t) & 255) >> 5) >> 1) + ((((t) & 31) + 32 * ((t) >> 8)) >> 4))
#define SK_TN32(t) (16 * ((((t) & 255) >> 5) & 1) + ((((t) & 31) + 32 * ((t) >> 8)) & 15))


#ifndef PH_MAX
#define PH_MAX 99
#endif
__global__ void __launch_bounds__(NTHR, 2) mega_fwd(Args args) {
    extern __shared__ __attribute__((aligned(16))) unsigned char lds_raw[];
    Frame F;
    F.lds = (LAS unsigned char*)lds_raw;
    F.wave = __builtin_amdgcn_readfirstlane((int)threadIdx.x >> 6); F.lane = lane_id(); F.tid = F.wave * 64 + F.lane;
    F.G = gridDim.x; { const int bx = blockIdx.x; F.vcu = (F.G % 8 == 0) ? (bx % 8) * (F.G / 8) + bx / 8 : bx; }
    volatile LAS unsigned* MISC = (volatile LAS unsigned*)(F.lds + MISC_OFF);
    LAS unsigned long long* ARGP = (LAS unsigned long long*)(F.lds + ARGS_OFF);
    for (int u = F.tid; u < (LDS_BYTES - LDSCTL_OFF) / 4; u += NTHR) ((LAS unsigned*)(F.lds + LDSCTL_OFF))[u] = 0u;
    __syncthreads();
    if (F.tid == 0) {
        ARGP[0] = (unsigned long long)args.in[0];
        ARGP[1] = (unsigned long long)args.in[1];
        ARGP[2] = (unsigned long long)args.in[2];
        ARGP[3] = (unsigned long long)args.in[3];
        ARGP[4] = (unsigned long long)args.in[4];
        ARGP[5] = (unsigned long long)args.in[5];
        ARGP[6] = (unsigned long long)args.in[6];
        ARGP[7] = (unsigned long long)args.in[7];
        ARGP[8] = (unsigned long long)args.in[8];
        ARGP[9] = (unsigned long long)args.in[9];
        ARGP[10] = (unsigned long long)args.in[10];
        ARGP[11] = (unsigned long long)args.in[11];
        ARGP[12] = (unsigned long long)args.in[12];
        ARGP[13] = (unsigned long long)args.in[13];
        ARGP[14] = (unsigned long long)args.in[14];
        ARGP[15] = (unsigned long long)args.in[15];
        ARGP[16] = (unsigned long long)args.in[16];
        ARGP[17] = (unsigned long long)args.in[17];
        ARGP[18] = (unsigned long long)args.in[18];
        ARGP[19] = (unsigned long long)args.in[19];
        ARGP[20] = (unsigned long long)args.in[20];
        ARGP[21] = (unsigned long long)args.in[21];
        ARGP[22] = (unsigned long long)args.in[22];
        ARGP[23] = (unsigned long long)args.in[23];
        ARGP[24] = (unsigned long long)args.in[24];
        ARGP[25] = (unsigned long long)args.in[25];
        ARGP[26] = (unsigned long long)args.in[26];
        ARGP[27] = (unsigned long long)args.in[27];
        ARGP[28] = (unsigned long long)args.in[28];
        ARGP[N_INPUTS] = (unsigned long long)args.out; ARGP[N_INPUTS + 1] = (unsigned long long)args.ws;
    }
    __syncthreads();
    { const XcdBarrier bar0 = xcd_barrier_post((unsigned*)((gu32*)(args.ws + WS_CTL) + CW_BAR), MISC + 8, F.wave); if (F.tid == 0) MISC[10] = bar0.x; }
    __syncthreads();
#define GRID_BAR() do { XcdBarrier bar_; bar_.bar = (unsigned*)((gu32*)((unsigned char*)ld_ptr(ARGP + N_INPUTS + 1) + WS_CTL) + CW_BAR); bar_.x = MISC[10]; bar_.st = MISC + 8; bar_.wave = F.wave; xcd_barrier(bar_); } while (0)
#define PHASE_ARGS const Args A = load_args(ARGP); unsigned char* const ws = A.ws; float* const out = A.out; (void)ws; (void)out; { int l_ = lane_id(); asm volatile("" : "+v"(l_)); F.lane = l_; F.tid = F.wave * 64 + l_; }

    { PHASE_ARGS;
    p0_prologue(F, A);
    }
    GRID_BAR();
#if defined(PROBE_BAR8)
    GRID_BAR(); GRID_BAR(); GRID_BAR(); GRID_BAR(); GRID_BAR(); GRID_BAR(); GRID_BAR(); GRID_BAR();
#endif
#if PH_MAX >= 1
    { PHASE_ARGS;
    {
        pg8::Gemm g{(const bf16*)(ws + WS_HB), (const bf16*)(ws + WS_WIN), DM, DM, DM};
        pg8::StaticOrder S; S.init(TA, N_IN, F.G, (int)blockIdx.x);
        EpiInProj E{out, ws, (const float*)A.in[I_BFF]};
        pg8::gemm_phase(F.lds, g, S, E, F.wave);
    }
    {
        const int off = (TA / 256) * (N_IN / 256) % F.G;
        pg8::Gemm g{(const bf16*)(ws + WS_MB), (const bf16*)(ws + WS_WMK), DM, DM, DM};
        pg8::StaticOrder S; S.init(512, DM, F.G, ((int)blockIdx.x + F.G - off) % F.G);
        EpiGen E{out + O_MKP, DM, (bf16*)(ws + WS_MK16), DM, 1.f, nullptr, nullptr, 0, 0, nullptr, nullptr, nullptr};
        pg8::gemm_phase(F.lds, g, S, E, F.wave);
    }
    {
        const int off = ((TA / 256) * (N_IN / 256) + 8) % F.G;
        pg8::Gemm g{(const bf16*)(ws + WS_MB), (const bf16*)(ws + WS_WMV), DM, DM, DM};
        pg8::StaticOrder S; S.init(512, DM, F.G, ((int)blockIdx.x + F.G - off) % F.G);
        EpiGen E{out + O_MVP, DM, nullptr, 0, 1.f, nullptr, nullptr, 0, 0, nullptr, nullptr, nullptr};
        pg8::gemm_phase(F.lds, g, S, E, F.wave);
    }
    {
        const int off = ((TA / 256) * (N_IN / 256) + 16) % F.G;
        pg8::Gemm g{(const bf16*)(ws + WS_WMV), (const bf16*)(ws + WS_MB), DM, DM, DM};
        pg8::StaticOrder S; S.init(DM, 512, F.G, ((int)blockIdx.x + F.G - off) % F.G);
        EpiGen E{nullptr, 0, (bf16*)(ws + WS_MVT16), 512, 1.f, nullptr, nullptr, 0, 0, nullptr, nullptr, nullptr};
        pg8::gemm_phase(F.lds, g, S, E, F.wave);
    }
    }
    GRID_BAR();
#endif
#if PH_MAX >= 2
    asm volatile("; ===PHASE 2===");
    { PHASE_ARGS;
    {
        const int gw = F.vcu * NWAVES + F.wave, NGW = F.G * NWAVES;
        if ((gw & 3) == 0) for (int it = gw >> 2; it < 512; it += NGW >> 2) fox_norms_item(F, (const bf16*)(ws + WS_QF), (const bf16*)(ws + WS_KF), out + O_LFP, (float*)(ws + WS_MISC + MiB), (float*)(ws + WS_KBIAS), (float*)(ws + WS_MISC + MiB + 65536), it);
        for (int it = gw; it < NB_S * NPAGES; it += NGW) fox_suffix_item(F, (const float*)A.in[I_CFL], (const int*)A.in[I_PT], (float*)(ws + WS_SUF), (float*)(ws + WS_MISC + 2 * MiB), it);
        for (int u = F.vcu; u < 1024; u += F.G) gla_g1_unit(F, A, u);
        for (int u = F.vcu; u < 512; u += F.G) gla_sample_unit(F, A, u);
    }
    }
    GRID_BAR();
#endif
#if PH_MAX >= 3
    asm volatile("; ===PHASE 3===");
    { PHASE_ARGS;
    gla_scan(F, A);
    __syncthreads();
    for (int i = F.vcu; i < 256; i += F.G) { const int bh = i >> 4, s = i & 15;
        fox_attn_unit(F, (const bf16*)(ws + WS_QF), (const bf16*)(ws + WS_KF), (const bf16*)(ws + WS_VF), (const float*)(ws + WS_KBIAS), (const float*)(ws + WS_MISC + MiB + 65536), (const float*)(ws + WS_MISC + MiB), (bf16*)(ws + WS_MERGED), bh >> 3, bh & 7, s);
        fox_attn_unit(F, (const bf16*)(ws + WS_QF), (const bf16*)(ws + WS_KF), (const bf16*)(ws + WS_VF), (const float*)(ws + WS_KBIAS), (const float*)(ws + WS_MISC + MiB + 65536), (const float*)(ws + WS_MISC + MiB), (bf16*)(ws + WS_MERGED), bh >> 3, bh & 7, 31 - s); }
    }
    GRID_BAR();
#endif
#if PH_MAX >= 4
    asm volatile("; ===PHASE 4===");
    { PHASE_ARGS;
    if (!(F.vcu & 1)) { for (int u = F.vcu; u < 1024; u += F.G) gla_g3_unit(F, A, u); }
    }
    { PHASE_ARGS;
    for (int u = F.vcu; u < 1024; u += F.G) fox_sample_unit(F, A, u);
    }
    { PHASE_ARGS;
    if (F.vcu & 1) { for (int u = F.vcu; u < 1024; u += F.G) gla_g3_unit(F, A, u); }
    }
    GRID_BAR();
#endif
#if PH_MAX >= 5
    asm volatile("; ===PHASE 5===");
    { PHASE_ARGS;
    {
        pg8::Gemm g{(const bf16*)(ws + WS_MERGED), (const bf16*)(ws + WS_WOUT), DM, DM, DM};
        pg8::StaticOrder S; S.init(TP, DM, F.G, (int)blockIdx.x);
        EpiGen E{(float*)(ws + WS_X1), DM, (bf16*)(ws + WS_HB), DM, 1.f, (const float*)A.in[I_XP], (const float*)A.in[I_XS], TP, DM, (const float*)A.in[I_GCROSS], (float*)(ws + WS_SS), nullptr};
        pg8::gemm_phase(F.lds, g, S, E, F.wave);
        __syncthreads();
        EpiSk Es{(float*)(ws + WS_X1) + (size_t)TP * DM, DM, (bf16*)(ws + WS_HB) + (size_t)TP * DM, DM, 1.f, (const float*)A.in[I_XS], DM, (const float*)A.in[I_GCROSS], (float*)(ws + WS_SS) + TP, nullptr};
        for (int t = F.vcu; t < 256; t += F.G) skinny_tile(F, (const bf16*)(ws + WS_MERGED) + (size_t)TP * DM, DM, (const bf16*)(ws + WS_WOUT), DM, SK_TM16(t), SK_TN16(t), Es);
    }
    }
    GRID_BAR();
#endif
#if PH_MAX >= 7
    asm volatile("; ===PHASE 7===");
    { PHASE_ARGS;
    {
        pg8::Gemm g{(const bf16*)(ws + WS_HB), (const bf16*)(ws + WS_WCQ), DM, DM, DM};
        pg8::StaticOrder S; S.init(TP, DM, F.G, (int)blockIdx.x);
        EpiGen E{nullptr, 0, (bf16*)(ws + WS_QC), DM, C2C, nullptr, nullptr, 0, 0, nullptr, nullptr, (const float*)(ws + WS_SS)};
        pg8::gemm_phase(F.lds, g, S, E, F.wave);
        __syncthreads();
        EpiSk Es{nullptr, 0, (bf16*)(ws + WS_QC) + (size_t)TP * DM, DM, C2C, nullptr, 0, nullptr, nullptr, (const float*)(ws + WS_SS) + TP};
        for (int t = F.vcu; t < 256; t += F.G) skinny_tile(F, (const bf16*)(ws + WS_HB) + (size_t)TP * DM, DM, (const bf16*)(ws + WS_WCQ), DM, SK_TM16(t), SK_TN16(t), Es);
    }
    }
    GRID_BAR();
#endif
#if PH_MAX >= 8
    asm volatile("; ===PHASE 8===");
    { PHASE_ARGS;
    {
        const int u = (int)blockIdx.x, b = (u >> 7) & 1, h = (u >> 5) & 3, pnl = u & 31;
        const size_t roff = ((size_t)b * SEQ + pnl * 256) * DM + h * 256;
        if (F.vcu & 1) { for (int v = F.vcu; v < 512; v += F.G) cross_sample_unit(F, A, v); }
        pg8::Gemm g{(const bf16*)(ws + WS_QC) + roff, (const bf16*)(ws + WS_MK16) + (size_t)(b * 256) * DM + h * 256, DM, DM, 256};
        pg8::SingleUnit S{u < 256 ? 1 : 0, {0, 0}};
        EpiSoftmaxP E{ARGP};
        pg8::gemm_phase(F.lds, g, S, E, F.wave);
        VM_WAIT(); __syncthreads();
        {
            pg8::Gemm g2{(const bf16*)(ws + WS_PC) + roff, (const bf16*)(ws + WS_MVT16) + (size_t)(h * 256) * 512 + b * 256, DM, 512, 256};
            EpiGen E2{nullptr, 0, (bf16*)(ws + WS_OC) + roff, DM, 1.f, nullptr, nullptr, 0, 0, nullptr, nullptr, nullptr};
            pg8::gemm_phase(F.lds, g2, S, E2, F.wave);
        }
        __syncthreads();
        if (!(F.vcu & 1)) { for (int v = F.vcu; v < 512; v += F.G) cross_sample_unit(F, A, v); }
    }
    }
    GRID_BAR();
#endif
#if PH_MAX >= 10
    asm volatile("; ===PHASE 10===");
    { PHASE_ARGS;
    {
        pg8::Gemm g{(const bf16*)(ws + WS_OC), (const bf16*)(ws + WS_WCO), DM, DM, DM};
        pg8::StaticOrder S; S.init(TP, DM, F.G, (int)blockIdx.x);
        EpiGen E{(float*)(ws + WS_X2), DM, (bf16*)(ws + WS_HB), DM, 1.f, (const float*)(ws + WS_X1), (const float*)(ws + WS_X1), TA, DM, (const float*)A.in[I_GFFN], (float*)(ws + WS_SS) + TA, nullptr};
        pg8::gemm_phase(F.lds, g, S, E, F.wave);
        __syncthreads();
        EpiSk Es{(float*)(ws + WS_X2) + (size_t)TP * DM, DM, (bf16*)(ws + WS_HB) + (size_t)TP * DM, DM, 1.f, (const float*)(ws + WS_X1) + (size_t)TP * DM, DM, (const float*)A.in[I_GFFN], (float*)(ws + WS_SS) + TA + TP, nullptr};
        for (int t = F.vcu; t < 256; t += F.G) skinny_tile(F, (const bf16*)(ws + WS_OC) + (size_t)TP * DM, DM, (const bf16*)(ws + WS_WCO), DM, SK_TM16(t), SK_TN16(t), Es);
    }
    }
    GRID_BAR();
#endif
#if PH_MAX >= 12
    asm volatile("; ===PHASE 12===");
    { PHASE_ARGS;
    {
        pg8::Gemm g{(const bf16*)(ws + WS_HB), (const bf16*)(ws + WS_WPK), DM, DM, DM};
        pg8::StaticOrder S; S.init(TP, 2048, F.G, (int)blockIdx.x);
        EpiGen E{nullptr, 0, (bf16*)(ws + WS_SC), 2048, 1.f, nullptr, nullptr, 0, 0, nullptr, nullptr, (const float*)(ws + WS_SS) + TA};
        pg8::gemm_phase(F.lds, g, S, E, F.wave);
        __syncthreads();
        EpiSk Es{nullptr, 0, (bf16*)(ws + WS_SC) + (size_t)TP * 2048, 2048, 1.f, nullptr, 0, nullptr, nullptr, (const float*)(ws + WS_SS) + TA + TP};
        for (int t = F.vcu; t < 512; t += F.G) skinny_tile(F, (const bf16*)(ws + WS_HB) + (size_t)TP * DM, DM, (const bf16*)(ws + WS_WPK), DM, SK_TM32(t), SK_TN32(t), Es);
    }
    }
    GRID_BAR();
#endif
#if PH_MAX >= 13
    asm volatile("; ===PHASE 13===");
    { PHASE_ARGS;
    peer_phase(F, A);
    }
#endif
#if PH_MAX < 13
    {   PHASE_ARGS;
        const int gw = F.vcu * NWAVES + F.wave, NGW = F.G * NWAVES;
        for (int m = gw; m < TA; m += NGW) {
            const float* x = m < TP ? (const float*)A.in[I_XP] + (size_t)m * DM : (const float*)A.in[I_XS] + (size_t)(m - TP) * DM;
            float* y = m < TP ? out + O_YP + (size_t)m * DM : out + O_YS + (size_t)(m - TP) * DM;
            for (int j = 0; j < 4; ++j) ((f32x4*)y)[F.lane + 64 * j] = ((const f32x4*)x)[F.lane + 64 * j];
        }
    }
#endif

}

extern "C" void kernel_launch(void* const* d_in, const int* in_sizes, int n_in, void* d_out, int out_size, void* d_ws, size_t ws_size, hipStream_t stream) {
    static int grid = 0;
    if (grid == 0) {
        if (n_in != N_INPUTS || (size_t)out_size != O_TOTAL || ws_size < WS_END) { fprintf(stderr, "kernel_launch: unexpected shapes (n_in %d out %d ws %zu)\n", n_in, out_size, ws_size); grid = -1; return; }
        int dev = 0, cus = 0, per_cu = 0;
        if (hipGetDevice(&dev) != hipSuccess || hipDeviceGetAttribute(&cus, hipDeviceAttributeMultiprocessorCount, dev) != hipSuccess) { grid = -1; return; }
        if (hipFuncSetAttribute((const void*)mega_fwd, hipFuncAttributeMaxDynamicSharedMemorySize, LDS_BYTES) != hipSuccess) { fprintf(stderr, "kernel_launch: hipFuncSetAttribute failed\n"); grid = -1; return; }
        if (hipOccupancyMaxActiveBlocksPerMultiprocessor(&per_cu, (const void*)mega_fwd, NTHR, LDS_BYTES) != hipSuccess || per_cu < 1)
            fprintf(stderr, "kernel_launch: occupancy query reports %d workgroups per CU\n", per_cu);
        (void)hipGetLastError();
        grid = cus;
        if (grid > 256) grid = 256;
    }
    if (grid < 0) return;
    if (hipMemsetAsync((char*)d_ws + WS_CTL, 0, CTL_ZERO_BYTES, stream) != hipSuccess) return;
    Args a{};
    for (int i = 0; i < N_INPUTS; ++i) a.in[i] = d_in[i];
    a.out = (float*)d_out; a.ws = (unsigned char*)d_ws;
    hipLaunchKernelGGL(mega_fwd, dim3(grid), dim3(NTHR), LDS_BYTES, stream, a);
    const hipError_t le = hipPeekAtLastError();
    if (le != hipSuccess) fprintf(stderr, "kernel_launch: launch failed: %s\n", hipGetErrorName(le));
}
```

```cpp
#define PH_MAX 13
#include <hip/hip_runtime.h>
#include <cstdio>
#include <cstdint>

namespace pg8 {
#define PG8_LAS __attribute__((address_space(3)))
typedef unsigned short bf16_t;
typedef short bf16x8 __attribute__((ext_vector_type(8)));
typedef float f32x4 __attribute__((ext_vector_type(4)));
typedef unsigned u32x4 __attribute__((ext_vector_type(4)));
typedef unsigned u32x2 __attribute__((ext_vector_type(2)));
constexpr int BM = 256, BK = 64, HALF = 128, HTB = HALF * BK * 2  , STAGE_BYTES = 8 * HTB, NXCD = 8, WGM = 8;

__host__ __device__ __forceinline__ int lds_byte(int r, int c) { const int st = (r >> 4) * 2 + (c >> 5), rr = r & 15, cc = c & 31, ob = rr * 64 + cc * 2; return st * 1024 + (ob ^ (((ob >> 9) & 1) << 5)); }
__host__ __device__ __forceinline__ void stage_rc(int b, int& R, int& C) { const int st = b / 1024, sb = b % 1024, swz = sb ^ (((sb >> 9) & 1) << 5); R = (st >> 1) * 16 + swz / 64; C = (st & 1) * 32 + (swz % 64) / 2; }

struct Unit { int pm, pn; };
struct Gemm { const bf16_t* A; const bf16_t* Bt; int lda, ldb, K; };

struct StaticOrder {
    int nM, nN, nwg, G, c;
    __host__ __device__ void init(int M, int N, int G_, int c_) { nM = M / BM; nN = N / BM; nwg = nM * nN; G = G_; c = c_; }
    __host__ __device__ bool next(int i, Unit& u) const {
        const long L = (long)i * G + c; if (L >= nwg) return false;
        int wgid = (int)L; { const int q = nwg / NXCD, r = nwg % NXCD, xcd = wgid % NXCD, off = wgid / NXCD; wgid = (xcd < r ? xcd * (q + 1) : r * (q + 1) + (xcd - r) * q) + off; }
        const int nig = WGM * nN, gid = wgid / nig, fm = gid * WGM, gsz = (nM - fm) < WGM ? (nM - fm) : WGM;
        u.pm = fm + ((wgid % nig) % gsz); u.pn = (wgid % nig) / gsz; return true;
    }
};
struct SingleUnit {
    int has; Unit u0;
    __host__ __device__ bool next(int i, Unit& u) const { if (i != 0 || !has) return false; u = u0; return true; }
};

__device__ __forceinline__ unsigned cvt_pk_bf16(float lo, float hi) { unsigned r; asm volatile("v_cvt_pk_bf16_f32 %0, %1, %2" : "=v"(r) : "v"(lo), "v"(hi)); return r; }

template <class Epi, class Sched>
__device__ __forceinline__ void gemm_phase(PG8_LAS unsigned char* lds, const Gemm g, const Sched& S, const Epi& E, int wave_id) {
    int lane; asm volatile("v_mbcnt_lo_u32_b32 %0, -1, 0\n\tv_mbcnt_hi_u32_b32 %0, -1, %0" : "=v"(lane));
    const int wid = wave_id; const int tid = wid * 64 + lane; const int wr = wid >> 2, wc = wid & 3, fr = lane & 15, fq = lane >> 4;
    const int K = g.K, nt = K / BK;
    unsigned voffA[2], voffB[2];
#pragma unroll
    for (int i = 0; i < 2; ++i) { int R, C; stage_rc(tid * 16 + i * 8192, R, C);
        voffA[i] = (unsigned)(R * g.lda + C) * 2u; voffB[i] = (unsigned)(R * g.ldb + C) * 2u; }
    const size_t kstep = (size_t)(BK * 2);
    const size_t hstepA = (size_t)HALF * g.lda * 2, hstepB = (size_t)HALF * g.ldb * 2;
    const size_t tstepA = 2 * hstepA, tstepB = 2 * hstepB;
    const unsigned ldsw = (unsigned)wid * 1024u;
    const int aoff = lds_byte(wr * 64 + fr, fq * 8), boff = lds_byte(wc * 32 + fr, fq * 8);
#define PG8_SA(b, h) (((b) * 2 + (h)) * HTB)
#define PG8_SB(b, h) ((4 + (b) * 2 + (h)) * HTB)
#define PG8_STAGE(bufoff, gbase, voff) do { _Pragma("unroll") for (int _i = 0; _i < 2; ++_i) \
        __builtin_amdgcn_global_load_lds((const unsigned*)((const char*)(gbase) + (voff)[_i]), (PG8_LAS unsigned*)(lds + (bufoff) + ldsw + _i * 8192), 16, 0, 0); } while (0)
#define PG8_LDA(dst, b, h) do { _Pragma("unroll") for (int m = 0; m < 4; ++m) _Pragma("unroll") for (int k = 0; k < 2; ++k) dst[m][k] = *(const PG8_LAS bf16x8*)(lds + PG8_SA(b, h) + aoff + m * 2048 + k * 1024); } while (0)
#define PG8_LDB(dst, b, h) do { _Pragma("unroll") for (int n = 0; n < 2; ++n) _Pragma("unroll") for (int k = 0; k < 2; ++k) dst[n][k] = *(const PG8_LAS bf16x8*)(lds + PG8_SB(b, h) + boff + n * 2048 + k * 1024); } while (0)
#define PG8_MMA(ai, bj, At, Bt) do { __builtin_amdgcn_s_setprio(1); _Pragma("unroll") for (int m = 0; m < 4; ++m) _Pragma("unroll") for (int n = 0; n < 2; ++n) _Pragma("unroll") for (int k = 0; k < 2; ++k) \
        acc[ai][bj][m][n] = __builtin_amdgcn_mfma_f32_16x16x32_bf16(Bt[n][k], At[m][k], acc[ai][bj][m][n], 0, 0, 0); __builtin_amdgcn_s_setprio(0); } while (0)
#define PG8_WAIT_V(n) asm volatile("s_waitcnt vmcnt(" #n ")" ::: "memory")
#define PG8_WAIT_L(n) asm volatile("s_waitcnt lgkmcnt(" #n ")" ::: "memory")
#define PG8_BAR __builtin_amdgcn_s_barrier()
#define PG8_SCHED __builtin_amdgcn_sched_barrier(0)
    Unit cur, nxt; int ui = 0;
    if (!S.next(0, cur)) return;
    f32x4 acc[2][2][4][2];
#pragma unroll
    for (int a = 0; a < 2; ++a)
#pragma unroll
        for (int b = 0; b < 2; ++b)
#pragma unroll
            for (int m = 0; m < 4; ++m)
#pragma unroll
                for (int n = 0; n < 2; ++n) acc[a][b][m][n] = (f32x4){0.f, 0.f, 0.f, 0.f};
    bf16x8 At[4][2], B0[2][2], B1[2][2];
    const char* cA = (const char*)g.A + (size_t)cur.pm * tstepA; const char* cB = (const char*)g.Bt + (size_t)cur.pn * tstepB;
    PG8_STAGE(PG8_SB(0, 0), cB, voffB); PG8_STAGE(PG8_SB(0, 1), cB + hstepB, voffB); PG8_STAGE(PG8_SA(0, 0), cA, voffA); PG8_STAGE(PG8_SA(0, 1), cA + hstepA, voffA);
    if (wr == 1) PG8_BAR;
    PG8_WAIT_V(2); PG8_BAR;
    PG8_STAGE(PG8_SB(1, 0), cB + kstep, voffB); PG8_STAGE(PG8_SA(1, 0), cA + kstep, voffA); PG8_STAGE(PG8_SB(1, 1), cB + hstepB + kstep, voffB);
    PG8_WAIT_V(6); PG8_BAR;
    for (;;) {
        const bool has_next = S.next(ui + 1, nxt);
        const char* nA = has_next ? (const char*)g.A + (size_t)nxt.pm * tstepA : cA; const char* nB = has_next ? (const char*)g.Bt + (size_t)nxt.pn * tstepB : cB;
        for (int t = 0; t < nt; t += 2) {
            const bool last = (t == nt - 2);
            const char* a1 = cA + (size_t)(t + 1) * kstep;
            const char* a2 = last ? nA : cA + (size_t)(t + 2) * kstep; const char* b2 = last ? nB : cB + (size_t)(t + 2) * kstep;
            const char* a3 = a2 + kstep; const char* b3 = b2 + kstep;
            PG8_LDB(B0, 0, 0); PG8_LDB(B1, 0, 1); PG8_SCHED; PG8_LDA(At, 0, 0); PG8_STAGE(PG8_SA(1, 1), a1 + hstepA, voffA);
            PG8_WAIT_V(8); PG8_WAIT_L(0); PG8_BAR; PG8_MMA(0, 0, At, B0); PG8_MMA(0, 1, At, B1); PG8_BAR; PG8_SCHED;
            PG8_LDA(At, 0, 1); PG8_STAGE(PG8_SB(0, 0), b2, voffB); PG8_STAGE(PG8_SB(0, 1), b2 + hstepB, voffB); PG8_STAGE(PG8_SA(0, 0), a2, voffA);
            PG8_WAIT_V(8); PG8_WAIT_L(0); PG8_BAR; PG8_MMA(1, 0, At, B0); PG8_MMA(1, 1, At, B1); PG8_BAR; PG8_SCHED;
            PG8_LDB(B0, 1, 0); PG8_LDB(B1, 1, 1); PG8_SCHED; PG8_LDA(At, 1, 0); PG8_STAGE(PG8_SA(0, 1), a2 + hstepA, voffA);
            PG8_WAIT_V(8); PG8_WAIT_L(0); PG8_BAR; PG8_MMA(0, 0, At, B0); PG8_MMA(0, 1, At, B1); PG8_BAR; PG8_SCHED;
            PG8_LDA(At, 1, 1); PG8_STAGE(PG8_SB(1, 0), b3, voffB); PG8_STAGE(PG8_SB(1, 1), b3 + hstepB, voffB); PG8_STAGE(PG8_SA(1, 0), a3, voffA);
            PG8_WAIT_V(8); PG8_WAIT_L(0); PG8_BAR; PG8_MMA(1, 0, At, B0); PG8_MMA(1, 1, At, B1); PG8_BAR; PG8_SCHED;
        }
        if (wr == 0) PG8_BAR;
        if constexpr (!Epi::AFTER_DRAIN) { E(acc, cur, wr, wc, fr, fq); }
        if (!has_next) break;
#pragma unroll
        for (int a = 0; a < 2; ++a)
#pragma unroll
            for (int b = 0; b < 2; ++b)
#pragma unroll
                for (int m = 0; m < 4; ++m)
#pragma unroll
                    for (int n = 0; n < 2; ++n) acc[a][b][m][n] = (f32x4){0.f, 0.f, 0.f, 0.f};
        cur = nxt; cA = nA; cB = nB; ++ui;
        if (wr == 1) PG8_BAR;
    }
    PG8_WAIT_V(0);
    PG8_BAR;
    if constexpr (Epi::AFTER_DRAIN) { E.fused(acc, cur, wr, wc, fr, fq, lds, wid, lane); }
#undef PG8_SA
#undef PG8_SB
#undef PG8_STAGE
#undef PG8_LDA
#undef PG8_LDB
#undef PG8_MMA
#undef PG8_WAIT_V
#undef PG8_WAIT_L
#undef PG8_BAR
#undef PG8_SCHED
}
}

#define GAS __attribute__((address_space(1)))
#define LAS __attribute__((address_space(3)))
typedef unsigned short bf16;
typedef unsigned v4u __attribute__((ext_vector_type(4)));
typedef unsigned v2u __attribute__((ext_vector_type(2)));
typedef float f32x4 __attribute__((ext_vector_type(4)));
typedef float f32x2 __attribute__((ext_vector_type(2)));
typedef float f32x16 __attribute__((ext_vector_type(16)));
typedef short bf16x8 __attribute__((ext_vector_type(8)));
typedef short s16x4 __attribute__((ext_vector_type(4)));
typedef GAS unsigned gu32;
#define RLX_AGENT __ATOMIC_RELAXED, __HIP_MEMORY_SCOPE_AGENT
#define LDS_WAIT() asm volatile("s_waitcnt lgkmcnt(0)" ::: "memory")
#define VM_WAIT() asm volatile("s_waitcnt vmcnt(0)" ::: "memory")
__device__ __forceinline__ unsigned f2bf(float f) { unsigned u = __builtin_bit_cast(unsigned, f); return (u + 0x7fffu + ((u >> 16) & 1u)) >> 16; }
__device__ __forceinline__ unsigned pk2(float lo, float hi) { return f2bf(lo) | (f2bf(hi) << 16); }
__device__ __forceinline__ float bf2f(unsigned short b) { return __builtin_bit_cast(float, (unsigned)b << 16); }
__device__ __forceinline__ float bflo(unsigned u) { return __builtin_bit_cast(float, u << 16); }
__device__ __forceinline__ float bfhi(unsigned u) { return __builtin_bit_cast(float, u & 0xffff0000u); }


typedef short v4i16_t __attribute__((ext_vector_type(4)));
__device__ __forceinline__ s16x4 lds_tr16(LAS unsigned char* p) { return __builtin_bit_cast(s16x4, __builtin_amdgcn_ds_read_tr16_b64_v4i16((LAS v4i16_t*)p)); }
__device__ __forceinline__ int crow(int r, int hi) { return (r & 3) + 8 * (r >> 2) + 4 * hi; }

#define DPP_I(v, ctrl) __builtin_amdgcn_update_dpp(0, (v), (ctrl), 0xF, 0xF, false)
#define DPP_F(v, ctrl) __builtin_bit_cast(float, __builtin_amdgcn_update_dpp(0, __builtin_bit_cast(int, (v)), (ctrl), 0xF, 0xF, false))
constexpr int DPP_X1 = 0xB1, DPP_X2 = 0x4E, DPP_HMIR = 0x141, DPP_MIR = 0x140;
__device__ __forceinline__ unsigned max16_u32(unsigned v) {
    unsigned t = (unsigned)DPP_I((int)v, DPP_X1); v = v > t ? v : t; t = (unsigned)DPP_I((int)v, DPP_X2); v = v > t ? v : t;
    t = (unsigned)DPP_I((int)v, DPP_HMIR); v = v > t ? v : t; t = (unsigned)DPP_I((int)v, DPP_MIR); v = v > t ? v : t; return v; }
__device__ __forceinline__ float sum8_f32(float v) { v += DPP_F(v, DPP_X1); v += DPP_F(v, DPP_X2); v += DPP_F(v, DPP_HMIR); return v; }
__device__ __forceinline__ float sum16_f32(float v) { v = sum8_f32(v); v += DPP_F(v, DPP_MIR); return v; }
__device__ __forceinline__ float max16_f32(float v) { v = fmaxf(v, DPP_F(v, DPP_X1)); v = fmaxf(v, DPP_F(v, DPP_X2)); v = fmaxf(v, DPP_F(v, DPP_HMIR)); v = fmaxf(v, DPP_F(v, DPP_MIR)); return v; }
__device__ __forceinline__ float xor16_f32(float v) { return __builtin_bit_cast(float, __builtin_amdgcn_ds_swizzle(__builtin_bit_cast(int, v), 0x1F | (16 << 10))); }
__device__ __forceinline__ float sum64_f32(float v) {
    v = sum16_f32(v); v += xor16_f32(v);
    return __builtin_bit_cast(float, __builtin_amdgcn_readlane(__builtin_bit_cast(int, v), 0)) + __builtin_bit_cast(float, __builtin_amdgcn_readlane(__builtin_bit_cast(int, v), 32)); }
template <int J> __device__ __forceinline__ unsigned xchg_xor_u32(unsigned v) {
    if constexpr (J == 1) return (unsigned)DPP_I((int)v, DPP_X1);
    else if constexpr (J == 2) return (unsigned)DPP_I((int)v, DPP_X2);
    else return (unsigned)__builtin_amdgcn_ds_swizzle((int)v, 0x1F | (J << 10)); }

template <int SB>
__device__ __forceinline__ bf16x8 tr_frag(LAS unsigned char* base, int ks) {
    const s16x4 lo = lds_tr16(base + ks * 16 * SB), hi4 = lds_tr16(base + ks * 16 * SB + 8 * SB);
    return (bf16x8){lo[0], lo[1], lo[2], lo[3], hi4[0], hi4[1], hi4[2], hi4[3]};
}
__device__ __forceinline__ bf16x8 row_frag(const LAS unsigned char* rowp, int ks, int hi) {
    const v2u lo = *(const LAS v2u*)(rowp + (16 * ks + 4 * hi) * 2), hi2 = *(const LAS v2u*)(rowp + (16 * ks + 8 + 4 * hi) * 2);
    return __builtin_bit_cast(bf16x8, (v4u){lo.x, lo.y, hi2.x, hi2.y});
}
__device__ __forceinline__ void lds_barrier() { asm volatile("s_waitcnt lgkmcnt(0)\n\ts_barrier" ::: "memory"); }

struct BfPtr { const unsigned short* p; __device__ __forceinline__ float operator[](size_t i) const { return __builtin_bit_cast(float, (unsigned)p[i] << 16); }
               __device__ __forceinline__ BfPtr operator+(size_t o) const { return BfPtr{p + o}; } };
#define GLD(ptr) (BfPtr{(const unsigned short*)(ptr)})

__device__ __forceinline__ int lane_id() { int r; asm volatile("v_mbcnt_lo_u32_b32 %0, -1, 0\n\tv_mbcnt_hi_u32_b32 %0, -1, %0" : "=v"(r)); return r; }
#define TID_IS_ZERO(wave_) ((wave_) == 0 && lane_id() == 0)
#define XB_TMO      128
#define XB_XCNT(j)  (256  + 64 * (j))
#define XB_XSUB(j)  (1280 + 64 * (j))
#define XB_XGEN(j)  (2304 + 64 * (j))
#define XB_TOP      3328
#define XB_TOPGEN   3392
#define XCD_BAR_WORDS 3456
#define XB_SPIN_CAP (1u << 18)

__device__ __forceinline__ unsigned xb_ld(unsigned* p)              { return __hip_atomic_load(p, __ATOMIC_RELAXED, __HIP_MEMORY_SCOPE_AGENT); }
__device__ __forceinline__ unsigned xb_add(unsigned* p, unsigned v) { return __hip_atomic_fetch_add(p, v, __ATOMIC_RELAXED, __HIP_MEMORY_SCOPE_AGENT); }
__device__ __forceinline__ unsigned xb_xcc_id() { return (unsigned)__builtin_amdgcn_s_getreg((3 << 11) | 20) & 0xFu; }
#define XB_SPIN(cond, bar) do { unsigned _sp = 0; while (cond) { __builtin_amdgcn_s_sleep(1); \
    if ((++_sp & 255u) == 0u) { if (xb_ld(&(bar)[XB_TMO])) break; if (_sp > XB_SPIN_CAP) { atomicAdd(&(bar)[XB_TMO], 1u); break; } } } } while (0)

struct XcdBarrier {
    unsigned* bar; unsigned x; int wave;
    volatile LAS unsigned* st;
};

__device__ __forceinline__ XcdBarrier xcd_barrier_post(unsigned* bar, volatile LAS unsigned* st, int wave) {
    XcdBarrier b; b.bar = bar; b.x = xb_xcc_id(); b.st = st; b.wave = wave;
    if (TID_IS_ZERO(wave)) (void)xb_add(&bar[XB_XCNT(b.x)], 1u);
    return b;
}
__device__ __forceinline__ void xcd_barrier_complete(unsigned* bar, unsigned x, unsigned& nloc, unsigned& nx) {
    const unsigned G = gridDim.x * gridDim.y * gridDim.z;
    unsigned sum, cnt, mine, sp = 0u;
    for (;;) {
        sum = 0u; cnt = 0u; mine = 0u;
#pragma unroll
        for (unsigned j = 0; j < 16; ++j) { const unsigned c = xb_ld(&bar[XB_XCNT(j)]); sum += c; cnt += (c > 0u) ? 1u : 0u; mine = (j == x) ? c : mine; }
        if (sum == G) break;
        __builtin_amdgcn_s_sleep(1);
        if ((++sp & 255u) == 0u) { if (xb_ld(&bar[XB_TMO])) break; if (sp > XB_SPIN_CAP) { atomicAdd(&bar[XB_TMO], 1u); break; } }
    }
    nloc = mine > 0u ? mine : 1u; nx = cnt > 0u ? cnt : 1u;
}

__device__ __forceinline__ void xcd_barrier(const XcdBarrier& b) {
    asm volatile("s_waitcnt vmcnt(0)" ::: "memory");
    __syncthreads();
    if (TID_IS_ZERO(b.wave)) {
        unsigned* bar = b.bar;
        __builtin_amdgcn_s_waitcnt(0);
        unsigned nloc = b.st[0], nx = b.st[1];
        if (nloc == 0u) { xcd_barrier_complete(bar, b.x, nloc, nx); b.st[0] = nloc; b.st[1] = nx; }
        const unsigned old = xb_add(&bar[XB_XSUB(b.x)], 1u);
        const unsigned gen = old / nloc;
        if (old + 1u == (gen + 1u) * nloc) {
            __builtin_amdgcn_fence(__ATOMIC_RELEASE, "agent");
            asm volatile("s_waitcnt vmcnt(0)" ::: "memory");
            const unsigned og = xb_add(&bar[XB_TOP], 1u);
            const unsigned tg = og / nx;
            if (og + 1u == (tg + 1u) * nx) xb_add(&bar[XB_TOPGEN], 1u);
            else XB_SPIN(xb_ld(&bar[XB_TOPGEN]) == tg, bar);
            __builtin_amdgcn_fence(__ATOMIC_ACQUIRE, "agent");
            xb_add(&bar[XB_XGEN(b.x)], 1u);
            asm volatile("s_waitcnt vmcnt(0)" ::: "memory");
        } else {
            XB_SPIN(xb_ld(&bar[XB_XGEN(b.x)]) == gen, bar);
            __builtin_amdgcn_fence(__ATOMIC_ACQUIRE, "agent");
            asm volatile("s_waitcnt vmcnt(0)" ::: "memory");
        }
    }
    __syncthreads();
}


constexpr int NWAVES = 8, NTHR = 512;
constexpr int DM = 1024, TP = 16384, TS = 1024, TA = TP + TS, SEQ = 8192, NB_P = 2, NB_S = 128, LS = 8;
constexpr int N_IN = 3328;
constexpr int PASTL = 2048, PAGE = 128, NPAGES = 16;
constexpr float EPS = 1e-6f;
constexpr float LOG2E = 1.4426950408889634f;
constexpr float C2F = 0.125f * LOG2E;
constexpr float C2C = 0.0625f * LOG2E;

enum { I_XP = 0, I_XS, I_CFK, I_CFV, I_CFL, I_SGLA, I_CMK, I_CMV, I_PT, I_MEMP, I_GMIX, I_WIN, I_BFF, I_WG2, I_BG, I_GGO, I_WOUT, I_GCROSS, I_GMEM,
       I_WMK, I_WMV, I_WCQ, I_WCO, I_GFFN, I_PWQ, I_PSK, I_PU, I_PV, I_GFIN, N_INPUTS };
constexpr size_t O_YP = 0, O_YS = 16777216, O_FKP = 17825792, O_FVP = 26214400, O_LFP = 34603008, O_GSP = 34734080, O_MKP = 34799616, O_MVP = 35323904,
                 O_FKS = 35848192, O_FVS = 36372480, O_LFS = 36896768, O_GSS = 36904960, O_TOTAL = 41099264;

constexpr size_t MiB = 1u << 20;
constexpr size_t WS_CTL = 0, CTL_ZERO_BYTES = 1 * MiB;
constexpr size_t WS_WIN = 2 * MiB, WS_WOUT = 10 * MiB, WS_WMK = 12 * MiB, WS_WMV = 14 * MiB, WS_WCQ = 16 * MiB, WS_WCO = 18 * MiB, WS_WPK = 20 * MiB;
constexpr size_t WS_MB = 24 * MiB, WS_MK16 = 25 * MiB, WS_MVT16 = 26 * MiB, WS_KBIAS = 27 * MiB, WS_GDEC = 28 * MiB, WS_GG = 29 * MiB;
constexpr size_t WS_U16 = 32 * MiB, WS_V16 = 64 * MiB, WS_HB = 96 * MiB, WS_QF = 132 * MiB, WS_KF = 150 * MiB, WS_VF = 168 * MiB;
constexpr size_t WS_GQ = 186 * MiB, WS_GK = 204 * MiB, WS_GV = 222 * MiB, WS_GR = 256 * MiB, WS_SUF = 290 * MiB, WS_GKV = 298 * MiB;
constexpr size_t WS_MERGED = 330 * MiB, WS_X1 = 364 * MiB, WS_X2 = 432 * MiB, WS_QC = 500 * MiB, WS_PC = 534 * MiB, WS_OC = 566 * MiB, WS_SC = 600 * MiB;
constexpr size_t WS_MISC = 736 * MiB, WS_SS = 740 * MiB  , WS_BB = 744 * MiB, WS_END = 800 * MiB;
constexpr int CW_BAR = 4096;

constexpr int RING_BYTES = 131072;
constexpr int LDSCTL_OFF = RING_BYTES, MISC_OFF = LDSCTL_OFF + 320;
constexpr int ARGS_OFF = MISC_OFF + 128;
constexpr int LDS_BYTES = 147456;

struct Args { const void* in[N_INPUTS]; float* out; unsigned char* ws; };

__device__ __forceinline__ const void* ld_ptr(const LAS unsigned long long* p) { const unsigned long long v = *p; const unsigned lo = __builtin_amdgcn_readfirstlane((unsigned)v), hi = __builtin_amdgcn_readfirstlane((unsigned)(v >> 32)); return (const void*)(const GAS char*)(((unsigned long long)hi << 32) | lo); }
__device__ __forceinline__ Args load_args(const LAS unsigned long long* ARGP) { Args A;
    A.in[0] = ld_ptr(ARGP + 0);
    A.in[1] = ld_ptr(ARGP + 1);
    A.in[2] = ld_ptr(ARGP + 2);
    A.in[3] = ld_ptr(ARGP + 3);
    A.in[4] = ld_ptr(ARGP + 4);
    A.in[5] = ld_ptr(ARGP + 5);
    A.in[6] = ld_ptr(ARGP + 6);
    A.in[7] = ld_ptr(ARGP + 7);
    A.in[8] = ld_ptr(ARGP + 8);
    A.in[9] = ld_ptr(ARGP + 9);
    A.in[10] = ld_ptr(ARGP + 10);
    A.in[11] = ld_ptr(ARGP + 11);
    A.in[12] = ld_ptr(ARGP + 12);
    A.in[13] = ld_ptr(ARGP + 13);
    A.in[14] = ld_ptr(ARGP + 14);
    A.in[15] = ld_ptr(ARGP + 15);
    A.in[16] = ld_ptr(ARGP + 16);
    A.in[17] = ld_ptr(ARGP + 17);
    A.in[18] = ld_ptr(ARGP + 18);
    A.in[19] = ld_ptr(ARGP + 19);
    A.in[20] = ld_ptr(ARGP + 20);
    A.in[21] = ld_ptr(ARGP + 21);
    A.in[22] = ld_ptr(ARGP + 22);
    A.in[23] = ld_ptr(ARGP + 23);
    A.in[24] = ld_ptr(ARGP + 24);
    A.in[25] = ld_ptr(ARGP + 25);
    A.in[26] = ld_ptr(ARGP + 26);
    A.in[27] = ld_ptr(ARGP + 27);
    A.in[28] = ld_ptr(ARGP + 28);
    A.out = (float*)ld_ptr(ARGP + N_INPUTS); A.ws = (unsigned char*)ld_ptr(ARGP + N_INPUTS + 1); return A; }
struct Frame {
    LAS unsigned char* lds;
    int tid, lane, wave, vcu, G;
};

__device__ __forceinline__ float wave_sum(float v) { return sum64_f32(v); }
__device__ __forceinline__ float log_sigmoid(float x) { return fminf(x, 0.f) - log1pf(__expf(-fabsf(x))); }

__device__ __forceinline__ int win_src_col(int r) {
    if (r < 1536) return r;
    if (r < 1792) return 1544 + (r - 1536);
    if (r < 2048) return 1800 + (r - 1792);
    if (r < 2560) return 2056 + (r - 2048);
    if (r < 3072) return 2584 + (r - 2560);
    if (r < 3080) return 1536 + (r - 3072);
    if (r < 3096) return 2568 + (r - 3080);
    return -1;
}
template <bool WIN>
__device__ __forceinline__ void p0_transpose_item(const float* W, int ldw, int K, int nblk, bf16* WT, LAS float* scr, int item, int lane) {
    const int kb = item / nblk, nb = item % nblk, k0 = 64 * kb, n0 = 32 * nb;
    const int dr = n0 + (lane & 31); const int sc = WIN ? win_src_col(dr) : dr;
#pragma unroll 8
    for (int i = 0; i < 32; ++i) { const int kk = 2 * i + (lane >> 5); scr[kk * 33 + (lane & 31)] = (sc >= 0) ? W[(size_t)(k0 + kk) * ldw + sc] : 0.f; }
    LDS_WAIT(); asm volatile("" ::: "memory");
    const int c = lane & 7;
#pragma unroll
    for (int j = 0; j < 4; ++j) { const int n = (lane >> 3) + 8 * j; const LAS float* s = scr + (8 * c) * 33 + n;
        v4u o; o.x = pk2(s[0 * 33], s[1 * 33]); o.y = pk2(s[2 * 33], s[3 * 33]); o.z = pk2(s[4 * 33], s[5 * 33]); o.w = pk2(s[6 * 33], s[7 * 33]);
        *(GAS v4u*)(WT + (size_t)(n0 + n) * K + k0 + 8 * c) = o; }
    LDS_WAIT(); asm volatile("" ::: "memory");
}
__device__ __forceinline__ void rms_row_bf16(const float* xrow, const float* g, bf16* orow, int lane) {
    const f32x4* xr = (const f32x4*)xrow + lane; const f32x4* gr = (const f32x4*)g + lane;
    f32x4 v[4]; float s = 0.f;
#pragma unroll
    for (int j = 0; j < 4; ++j) { v[j] = xr[64 * j]; s += (v[j].x * v[j].x + v[j].y * v[j].y) + (v[j].z * v[j].z + v[j].w * v[j].w); }
    const float r = rsqrtf(wave_sum(s) * (1.f / DM) + EPS);
    v2u* o8 = (v2u*)orow + lane;
#pragma unroll
    for (int j = 0; j < 4; ++j) { const f32x4 gg = gr[64 * j]; v2u o; o.x = pk2(v[j].x * r * gg.x, v[j].y * r * gg.y); o.y = pk2(v[j].z * r * gg.z, v[j].w * r * gg.w); o8[64 * j] = o; }
}

using pg8::Unit;
struct EpiGen {
    static constexpr bool PERM = false, AFTER_DRAIN = false;
    float* d32; int ld32; bf16* d16; int ld16; float sc16;
    const float* r0; const float* r1; int rsplit; int ldr;
    const float* gcol;
    float* ssq;
    const float* rsq;
    __device__ __forceinline__ void operator()(const f32x4 (&acc)[2][2][4][2], const Unit& u, int wr, int wc, int fr, int fq) const {
        int row0 = u.pm * 256 + wr * 64 + fr, col0 = u.pn * 256 + wc * 32 + fq * 4;
        asm volatile("" : "+v"(row0), "+v"(col0));
#pragma unroll
        for (int ai = 0; ai < 2; ++ai)
#pragma unroll
            for (int m = 0; m < 4; ++m) { const int row = row0 + ai * 128 + m * 16;
                const float* rp = nullptr; if (r0) rp = (row < rsplit) ? r0 + (size_t)row * ldr : r1 + (size_t)(row - rsplit) * ldr;
                float rs = 1.f; if (rsq) rs = rsqrtf(rsq[row] * (1.f / 1024.f) + EPS);
                float ss = 0.f;
#pragma unroll
                for (int bj = 0; bj < 2; ++bj)
#pragma unroll
                    for (int n = 0; n < 2; ++n) { const int col = col0 + bj * 128 + n * 16; f32x4 v = acc[ai][bj][m][n];
                        if (rsq) { v[0] *= rs; v[1] *= rs; v[2] *= rs; v[3] *= rs; }
                        if (r0) v += *(const f32x4*)(rp + col);
                        if (d32) *(f32x4*)(d32 + (size_t)row * ld32 + col) = v;
                        if (ssq) ss += (v[0] * v[0] + v[1] * v[1]) + (v[2] * v[2] + v[3] * v[3]);
                        if (d16) { f32x4 w = v; if (gcol) w = w * *(const f32x4*)(gcol + col);
                            v2u o; o.x = pg8::cvt_pk_bf16(w[0] * sc16, w[1] * sc16); o.y = pg8::cvt_pk_bf16(w[2] * sc16, w[3] * sc16); *(v2u*)(d16 + (size_t)row * ld16 + col) = o; } }
                if (ssq) { ss += xor16_f32(ss); ss += __shfl_xor(ss, 32); if (fq == 0) atomicAdd(ssq + row, ss); } }
    }
};
struct EpiInProj {
    static constexpr bool PERM = false, AFTER_DRAIN = false;
    float* out; unsigned char* ws; const float* bff;
    __device__ __forceinline__ void operator()(const f32x4 (&acc)[2][2][4][2], const Unit& u, int wr, int wc, int fr, int fq) const {
        const int pn = u.pn; const bool smp = u.pm >= 64;
        int row0 = u.pm * 256 + wr * 64 + fr;
        int orow0 = (smp ? (u.pm - 64) * 256 : u.pm * 256) + wr * 64 + fr;
        asm volatile("" : "+v"(row0), "+v"(orow0));
        float* d32 = nullptr; int ld32 = 0; bool d32_grp = false; bf16* d16 = nullptr; int ld16 = 0; float s32 = 1.f, s16 = 1.f; int cb = 0;
        if (pn < 2) { d16 = (bf16*)(ws + WS_QF); ld16 = 512; s16 = C2F; cb = pn * 256; }
        else if (pn < 4) { d32 = out + (smp ? O_FKS : O_FKP); ld32 = 512; d32_grp = true; d16 = (bf16*)(ws + WS_KF); ld16 = 512; cb = (pn - 2) * 256; }
        else if (pn < 6) { d32 = out + (smp ? O_FVS : O_FVP); ld32 = 512; d32_grp = true; d16 = (bf16*)(ws + WS_VF); ld16 = 512; cb = (pn - 4) * 256; }
        else if (pn == 6) { d16 = (bf16*)(ws + WS_GQ); ld16 = 256; s16 = 0.125f; }
        else if (pn == 7) { d16 = (bf16*)(ws + WS_GK); ld16 = 256; }
        else if (pn < 10) { d16 = (bf16*)(ws + WS_GV); ld16 = 512; cb = (pn - 8) * 256; }
        else if (pn < 12) { d16 = (bf16*)(ws + WS_GR); ld16 = 512; cb = (pn - 10) * 256; }
        if (pn < 12) {
#pragma unroll
            for (int ai = 0; ai < 2; ++ai)
#pragma unroll
                for (int m = 0; m < 4; ++m) { const int row = row0 + ai * 128 + m * 16, orow = orow0 + ai * 128 + m * 16;
#pragma unroll
                    for (int bj = 0; bj < 2; ++bj)
#pragma unroll
                        for (int n = 0; n < 2; ++n) { const int col = cb + wc * 32 + fq * 4 + bj * 128 + n * 16; const f32x4 v = acc[ai][bj][m][n];
                            if (d32) *(f32x4*)(d32 + (size_t)(d32_grp ? orow : row) * ld32 + col) = v * s32;
                            if (d16) { v2u o; o.x = pg8::cvt_pk_bf16(v[0] * s16, v[1] * s16); o.y = pg8::cvt_pk_bf16(v[2] * s16, v[3] * s16); *(v2u*)(d16 + (size_t)row * ld16 + col) = o; } } }
        } else {
            if (wc == 0) {
                float* lf = out + (smp ? O_LFS : O_LFP); float* ggp = (float*)(ws + WS_GG);
#pragma unroll
                for (int ai = 0; ai < 2; ++ai)
#pragma unroll
                    for (int m = 0; m < 4; ++m) { const int row = row0 + ai * 128 + m * 16, orow = orow0 + ai * 128 + m * 16;
#pragma unroll
                        for (int n = 0; n < 2; ++n) { const int col = n * 16 + fq * 4; const f32x4 v = acc[ai][0][m][n];
                            if (col < 8) { f32x4 o; const f32x4 b = *(const f32x4*)(bff + col);
                                o[0] = log_sigmoid(v[0] + b[0]); o[1] = log_sigmoid(v[1] + b[1]); o[2] = log_sigmoid(v[2] + b[2]); o[3] = log_sigmoid(v[3] + b[3]);
                                *(f32x4*)(lf + (size_t)orow * 8 + col) = o; }
                            else if (col < 24) *(f32x4*)(ggp + (size_t)row * 16 + (col - 8)) = v; } }
            }
        }
    }
};


__device__ __forceinline__ void p0_prologue(const Frame& F, const Args& a) {
    unsigned char* ws = a.ws;
    LAS float* scr = (LAS float*)(F.lds + F.wave * 16384);
    const int gw = F.vcu * NWAVES + F.wave, NGW = F.G * NWAVES;
    constexpr int I_WINN = 16 * (N_IN / 32), I_SQ = 16 * 32;
    constexpr int NITEMS = I_WINN + 5 * I_SQ;
    for (int it = (gw + NGW / 2) % NGW; it < NITEMS; it += NGW) {
        int r = it;
        if (r < I_WINN) { p0_transpose_item<true>((const float*)a.in[I_WIN], 3096, DM, N_IN / 32, (bf16*)(ws + WS_WIN), scr, r, F.lane); continue; } r -= I_WINN;
        const int which = r / I_SQ; r -= which * I_SQ;
        const float* src = (const float*)(which == 0 ? a.in[I_WOUT] : which == 1 ? a.in[I_WMK] : which == 2 ? a.in[I_WMV] : which == 3 ? a.in[I_WCQ] : a.in[I_WCO]);
        bf16* dst = (bf16*)(ws + (which == 0 ? WS_WOUT : which == 1 ? WS_WMK : which == 2 ? WS_WMV : which == 3 ? WS_WCQ : WS_WCO));
        p0_transpose_item<false>(src, DM, DM, 32, dst, scr, r, F.lane);
    }
    { float* ssz = (float*)(ws + WS_SS); for (int i = F.vcu * NTHR + F.tid; i < 2 * TA; i += F.G * NTHR) ssz[i] = 0.f; }
    for (int m0 = gw * 2; m0 < TA + 512; m0 += NGW * 2) {
        const float* xr[2]; const float* gr[2]; bf16* orow[2];
#pragma unroll
        for (int j = 0; j < 2; ++j) { const int m = m0 + j;
            if (m < TP) { xr[j] = (const float*)a.in[I_XP] + (size_t)m * DM; gr[j] = (const float*)a.in[I_GMIX]; orow[j] = (bf16*)(ws + WS_HB) + (size_t)m * DM; }
            else if (m < TA) { xr[j] = (const float*)a.in[I_XS] + (size_t)(m - TP) * DM; gr[j] = (const float*)a.in[I_GMIX]; orow[j] = (bf16*)(ws + WS_HB) + (size_t)m * DM; }
            else { xr[j] = (const float*)a.in[I_MEMP] + (size_t)(m - TA) * DM; gr[j] = (const float*)a.in[I_GMEM]; orow[j] = (bf16*)(ws + WS_MB) + (size_t)(m - TA) * DM; } }
        f32x4 v[2][4]; float s[2];
#pragma unroll
        for (int j = 0; j < 2; ++j) { s[j] = 0.f;
#pragma unroll
            for (int q = 0; q < 4; ++q) v[j][q] = ((const f32x4*)xr[j])[F.lane + 64 * q]; }
#pragma unroll
        for (int j = 0; j < 2; ++j) {
#pragma unroll
            for (int q = 0; q < 4; ++q) s[j] += (v[j][q].x * v[j][q].x + v[j][q].y * v[j][q].y) + (v[j][q].z * v[j][q].z + v[j][q].w * v[j][q].w);
            const float r = rsqrtf(wave_sum(s[j]) * (1.f / DM) + EPS);
#pragma unroll
            for (int q = 0; q < 4; ++q) { const f32x4 gg = ((const f32x4*)gr[j])[F.lane + 64 * q]; v2u o; o.x = pk2(v[j][q].x * r * gg.x, v[j][q].y * r * gg.y); o.y = pk2(v[j][q].z * r * gg.z, v[j][q].w * r * gg.w); ((v2u*)orow[j])[F.lane + 64 * q] = o; } }
    }
    {
        for (int r0 = gw * 4; r0 < 2 * 16384; r0 += NGW * 4) {
            f32x4 x[4][4];
#pragma unroll
            for (int j = 0; j < 4; ++j) { const int r = r0 + j; const bool isv = r >= 16384; const int e = isv ? r - 16384 : r;
                const f32x4* s = (const f32x4*)((const float*)(isv ? a.in[I_PV] : a.in[I_PU]) + (size_t)e * DM) + F.lane;
#pragma unroll
                for (int q = 0; q < 4; ++q) x[j][q] = __builtin_nontemporal_load(s + 64 * q); }
#pragma unroll
            for (int j = 0; j < 4; ++j) { const int r = r0 + j; const bool isv = r >= 16384; const int e = isv ? r - 16384 : r; float am = 0.f;
#pragma unroll
                for (int q = 0; q < 4; ++q) am = fmaxf(am, fmaxf(fmaxf(fabsf(x[j][q].x), fabsf(x[j][q].y)), fmaxf(fabsf(x[j][q].z), fabsf(x[j][q].w))));
#pragma unroll
                for (int o = 1; o < 64; o <<= 1) am = fmaxf(am, __shfl_xor(am, o));
                const float inv = am > 0.f ? 448.f / am : 0.f;
                v4u o4;
#pragma unroll
                for (int q = 0; q < 4; ++q) { int pk = __builtin_amdgcn_cvt_pk_fp8_f32(x[j][q].x * inv, x[j][q].y * inv, 0, false); pk = __builtin_amdgcn_cvt_pk_fp8_f32(x[j][q].z * inv, x[j][q].w * inv, pk, true); o4[q] = (unsigned)pk; }
                *(v4u*)(ws + (isv ? WS_V16 : WS_U16) + (size_t)e * DM + 16 * F.lane) = o4;
                if (F.lane == 0) ((float*)(ws + WS_MISC))[r] = am * (1.f / 448.f); }
        }
    }
    __syncthreads();
    for (int it = blockIdx.x; it < 256; it += F.G) {
        const int c = it >> 4, kt = it & 15, half = c & 1;
        LAS unsigned char* SKB = F.lds; LAS unsigned char* WB = F.lds + 128 * 272;
        const float* sk = (const float*)a.in[I_PSK] + (size_t)half * 128 * 128; const float* wq = (const float*)a.in[I_PWQ] + (size_t)(kt * 64) * 2048 + c * 128;
#pragma unroll
        for (int i = 0; i < 8; ++i) { const int c4 = F.tid + NTHR * i; const f32x4 x = *(const f32x4*)(sk + 4 * c4);
            v2u o; o.x = pk2(x.x, x.y); o.y = pk2(x.z, x.w); *(LAS v2u*)(SKB + (c4 >> 5) * 272 + (c4 & 31) * 8) = o; }
#pragma unroll
        for (int i = 0; i < 4; ++i) { const int c4 = F.tid + NTHR * i; const f32x4 x = *(const f32x4*)(wq + (size_t)(c4 >> 5) * 2048 + (c4 & 31) * 4);
            v2u o; o.x = pk2(x.x, x.y); o.y = pk2(x.z, x.w); *(LAS v2u*)(WB + (c4 >> 5) * 272 + (c4 & 31) * 8) = o; }
        __syncthreads();
        {
            const int r32 = F.lane & 31, hi = F.lane >> 5, mb = F.wave >> 1, nb = F.wave & 1;
            const LAS unsigned char* arow = SKB + (32 * mb + r32) * 272; const LAS unsigned char* brow = WB + (32 * nb + r32) * 272;
            f32x16 acc = {};
#pragma unroll
            for (int ks = 0; ks < 8; ++ks) acc = __builtin_amdgcn_mfma_f32_32x32x16_bf16(row_frag(arow, ks, hi), row_frag(brow, ks, hi), acc, 0, 0, 0);
            bf16* wp = (bf16*)(ws + WS_WPK) + (size_t)(c * 128 + 32 * mb) * DM + kt * 64 + 32 * nb + r32;
#pragma unroll
            for (int r = 0; r < 16; ++r) wp[(size_t)crow(r, hi) * DM] = (bf16)f2bf(acc[r]);
        }
        __syncthreads();
    }
}


__device__ __forceinline__ void fox_prompt_cumsum(const Frame& F, const float* logf  , float* kbias, int b) {
    LAS float* WT = (LAS float*)F.lds;
    const int t0 = F.wave * 1024 + F.lane * 16;
    const f32x4* src = (const f32x4*)(logf + ((size_t)b * SEQ + t0) * 8);
    float s[8];
#pragma unroll
    for (int h = 0; h < 8; ++h) s[h] = 0.f;
#pragma unroll 4
    for (int i = 0; i < 16; ++i) { const f32x4 a = src[2 * i], c = src[2 * i + 1]; s[0] += a.x; s[1] += a.y; s[2] += a.z; s[3] += a.w; s[4] += c.x; s[5] += c.y; s[6] += c.z; s[7] += c.w; }
    float ex[8];
#pragma unroll
    for (int h = 0; h < 8; ++h) { float v = s[h];
#pragma unroll
        for (int o = 1; o < 64; o <<= 1) { const float t = __shfl_up(v, o); if (F.lane >= o) v += t; }
        ex[h] = v - s[h];
        if (F.lane == 63) WT[F.wave * 8 + h] = v; }
    __syncthreads();
#pragma unroll
    for (int h = 0; h < 8; ++h) { float c = 0.f; for (int w = 0; w < F.wave; ++w) c += WT[w * 8 + h]; ex[h] += c; }
    float* dst = kbias + (size_t)(b * 8) * SEQ + t0;
#pragma unroll 4
    for (int i = 0; i < 16; ++i) { const f32x4 a = src[2 * i], c = src[2 * i + 1];
        ex[0] += a.x; ex[1] += a.y; ex[2] += a.z; ex[3] += a.w; ex[4] += c.x; ex[5] += c.y; ex[6] += c.z; ex[7] += c.w;
#pragma unroll
        for (int h = 0; h < 8; ++h) dst[(size_t)h * SEQ + i] = -ex[h] * LOG2E; }
    __syncthreads();
}
__device__ __forceinline__ void fox_sample_suffix(const Frame& F, const float* cfl, const int* pt, float* suf, int bs) {
    float carry[8];
#pragma unroll
    for (int h = 0; h < 8; ++h) carry[h] = 0.f;
    const int mypg = pt[bs * NPAGES + (F.lane & 15)];
#pragma unroll 1
    for (int pb = NPAGES - 4; pb >= 0; pb -= 4) {
        f32x4 x[4][4];
#pragma unroll
        for (int j = 0; j < 4; ++j) { const int pg = __builtin_amdgcn_readlane(mypg, 0) * 0 + __shfl(mypg, pb + j); const f32x4* src = (const f32x4*)(cfl + ((size_t)pg * PAGE + 2 * F.lane) * 8);
            x[j][0] = src[0]; x[j][1] = src[1]; x[j][2] = src[2]; x[j][3] = src[3]; }
#pragma unroll
        for (int j = 3; j >= 0; --j) { const int p = pb + j;
            const float ra[8] = {x[j][0].x, x[j][0].y, x[j][0].z, x[j][0].w, x[j][1].x, x[j][1].y, x[j][1].z, x[j][1].w}, rb[8] = {x[j][2].x, x[j][2].y, x[j][2].z, x[j][2].w, x[j][3].x, x[j][3].y, x[j][3].z, x[j][3].w};
#pragma unroll
            for (int h = 0; h < 8; ++h) {
                const float ps = ra[h] + rb[h]; float v = ps;
#pragma unroll
                for (int o = 1; o < 64; o <<= 1) { const float t = __shfl_down(v, o); if (F.lane + o < 64) v += t; }
                const float exs = v - ps;
                float* d = suf + (size_t)(bs * 8 + h) * PASTL + p * PAGE + 2 * F.lane;
                *(f32x2*)d = (f32x2){(carry[h] + exs + rb[h]) * LOG2E, (carry[h] + exs) * LOG2E};
                carry[h] += __shfl(v, 0);
            }
        }
    }
}

__device__ __forceinline__ void gla_gate_tile(const Frame& F, const float* gg, const float* w2, const float* bg, int row0, int h, int nt, LAS float* LA, LAS float* GGS) {
    for (int e = F.tid; e < nt * 16; e += NTHR) GGS[e] = gg[(size_t)row0 * 16 + e];
    const int dk = F.tid & 63; float wc[16];
#pragma unroll
    for (int r = 0; r < 16; ++r) wc[r] = w2[r * 256 + h * 64 + dk];
    const float bb = bg[h * 64 + dk];
    __syncthreads();
    for (int t = F.tid >> 6; t < nt; t += 8) { float z = bb;
#pragma unroll
        for (int q = 0; q < 4; ++q) { const f32x4 g4 = *(const LAS f32x4*)(GGS + t * 16 + 4 * q); z += g4.x * wc[4 * q] + g4.y * wc[4 * q + 1] + g4.z * wc[4 * q + 2] + g4.w * wc[4 * q + 3]; }
        LA[t * 64 + dk] = log_sigmoid(z) * (1.f / 16.f); }
}
__device__ __forceinline__ void gla_cumsum64(const Frame& F, LAS float* LA, LAS float* SEG) {
    const int dk = F.lane, w = F.wave; float v[8]; float run = 0.f;
#pragma unroll
    for (int i = 0; i < 8; ++i) { run += LA[(8 * w + i) * 64 + dk]; v[i] = run; }
    SEG[w * 64 + dk] = run;
    __syncthreads();
    float pre = 0.f;
    for (int j = 0; j < w; ++j) pre += SEG[j * 64 + dk];
#pragma unroll
    for (int i = 0; i < 8; ++i) LA[(8 * w + i) * 64 + dk] = v[i] + pre;
    __syncthreads();
}
__device__ __forceinline__ void gla_g1_unit(const Frame& F, const Args& a, int u) {
    unsigned char* ws = a.ws;
    const int b = u >> 9, h = (u >> 7) & 3, n = u & 127; const int row0 = b * SEQ + n * 64;
    LAS float* LA = (LAS float*)F.lds; LAS float* SEG = LA + 4096; LAS float* GGS = SEG + 512; LAS unsigned char* KRB = F.lds + 22528; LAS unsigned char* VSB = F.lds + 34816;
    v4u vq[2];
#pragma unroll
    for (int i = 0; i < 2; ++i) { const int c = F.tid + NTHR * i; vq[i] = *(const v4u*)((const bf16*)(ws + WS_GV) + (size_t)(row0 + (c >> 4)) * 512 + h * 128 + (c & 15) * 8); }
    float gkv[8];
#pragma unroll
    for (int i = 0; i < 8; ++i) { const int e = F.tid + NTHR * i; gkv[i] = GLD(ws + WS_GK)[(size_t)(row0 + (e >> 6)) * 256 + h * 64 + (e & 63)]; }
    gla_gate_tile(F, (const float*)(ws + WS_GG), (const float*)a.in[I_WG2], (const float*)a.in[I_BG], row0, h, 64, LA, GGS);
#pragma unroll
    for (int i = 0; i < 2; ++i) { const int c = F.tid + NTHR * i; *(LAS v4u*)(VSB + (c >> 4) * 320 + (c & 15) * 16) = vq[i]; }
    __syncthreads();
    gla_cumsum64(F, LA, SEG);
    if (F.tid < 64) ((float*)(ws + WS_GDEC))[(size_t)((b * 4 + h) * 128 + n) * 64 + F.tid] = __expf(LA[63 * 64 + F.tid]);
    float* bbuf = (float*)(ws + WS_BB);
#pragma unroll
    for (int i = 0; i < 8; ++i) { const int e = F.tid + NTHR * i; const int t = e >> 6, dk = e & 63; const float bb = LA[e]; bbuf[(size_t)(row0 + t) * 256 + h * 64 + dk] = bb;
        *(LAS unsigned short*)(KRB + t * 192 + dk * 2) = (unsigned short)f2bf(gkv[i] * __expf(LA[63 * 64 + dk] - bb)); }
    __syncthreads();
    {
        const int lane = F.lane, r32 = lane & 31, hi = lane >> 5, mb = F.wave >> 2, nb = F.wave & 3;
        const int tb = (4 * hi + ((lane & 15) >> 2)), tc = (16 * ((lane >> 4) & 1) + 4 * (lane & 3)) * 2;
        LAS unsigned char* abase = KRB + tb * 192 + tc + 64 * mb; LAS unsigned char* bbase = VSB + tb * 320 + tc + 64 * nb;
        f32x16 acc = {};
#pragma unroll
        for (int ks = 0; ks < 4; ++ks) acc = __builtin_amdgcn_mfma_f32_32x32x16_bf16(tr_frag<192>(abase, ks), tr_frag<320>(bbase, ks), acc, 0, 0, 0);
        float* kv = (float*)(ws + WS_GKV) + ((size_t)((b * 4 + h) * 128 + n) * 64 + 32 * mb) * 128 + 32 * nb + r32;
#pragma unroll
        for (int r = 0; r < 16; ++r) kv[(size_t)crow(r, hi) * 128] = acc[r];
    }
    __syncthreads();
}
__device__ __forceinline__ void gla_scan(const Frame& F, const Args& a) {
    int tid = F.wave * 64 + lane_id(); asm volatile("" : "+v"(tid));
    if (tid >= 256) return;
    for (int e = F.vcu * 256 + tid; e < 65536; e += F.G * 256) {
    const int bh = e >> 13, dk = (e >> 7) & 63, dv = e & 127;
    float* kv = (float*)(a.ws + WS_GKV) + ((size_t)bh * 128 * 64 + dk) * 128 + dv; const float* dc = (const float*)(a.ws + WS_GDEC) + (size_t)bh * 128 * 64 + dk;
    float S = 0.f;
#pragma unroll 1
    for (int n0 = 0; n0 < 128; n0 += 32) { float kvv[32], dd[32];
#pragma unroll
        for (int j = 0; j < 32; ++j) { kvv[j] = kv[(size_t)(n0 + j) * 8192]; dd[j] = dc[(size_t)(n0 + j) * 64]; }
#pragma unroll
        for (int j = 0; j < 32; ++j) { kv[(size_t)(n0 + j) * 8192] = S; S = dd[j] * S + kvv[j]; } }
    a.out[O_GSP + (size_t)bh * 8192 + dk * 128 + dv] = S;
    }
}
__device__ __forceinline__ float silu(float x) { return x / (1.f + __expf(-x)); }
__device__ __forceinline__ void gla_sample_unit(const Frame& F, const Args& a, int u) {
    unsigned char* ws = a.ws;
    const int bs = u >> 2, h = u & 3; const int row0 = TP + bs * LS;
    LAS float* LA = (LAS float*)F.lds; LAS float* BL = LA + 512; LAS float* QD = BL + 64; LAS float* KI = QD + 512; LAS float* KR = KI + 512; LAS float* ATT = KR + 512; LAS float* OP = ATT + 64; LAS float* VS = OP + 4096;
    gla_gate_tile(F, (const float*)(ws + WS_GG), (const float*)a.in[I_WG2], (const float*)a.in[I_BG], row0, h, 8, LA, VS + 1024);
#pragma unroll
    for (int i = 0; i < 2; ++i) { const int e = F.tid + NTHR * i; VS[e] = GLD(ws + WS_GV)[(size_t)(row0 + (e >> 7)) * 512 + h * 128 + (e & 127)]; }
    __syncthreads();
    if (F.tid < 64) { float run = 0.f;
#pragma unroll
        for (int t = 0; t < 8; ++t) { run += LA[t * 64 + F.tid]; LA[t * 64 + F.tid] = run; } BL[F.tid] = run; }
    __syncthreads();
    { const int e = F.tid, t = e >> 6, dk = e & 63; const float bb = LA[e];
      const float q = GLD(ws + WS_GQ)[(size_t)(row0 + t) * 256 + h * 64 + dk], k = GLD(ws + WS_GK)[(size_t)(row0 + t) * 256 + h * 64 + dk];
      QD[e] = q * __expf(bb); KI[e] = k * __expf(-bb); KR[e] = k * __expf(BL[dk] - bb); }
    __syncthreads();
    if (F.tid < 64) { const int t = F.tid >> 3, s = F.tid & 7; float acc = 0.f;
        if (s <= t) { for (int dk = 0; dk < 64; ++dk) acc += QD[t * 64 + dk] * KI[s * 64 + dk]; }
        ATT[F.tid] = acc; }
    const int dv = F.tid & 127, dkg = F.tid >> 7;
    {
        const float* st = (const float*)a.in[I_SGLA] + ((size_t)(bs * 4 + h) * 64 + dkg * 16) * 128 + dv;
        float S0[16];
#pragma unroll
        for (int i = 0; i < 16; ++i) S0[i] = st[(size_t)i * 128];
#pragma unroll
        for (int t = 0; t < 8; ++t) { float o = 0.f;
#pragma unroll
            for (int i = 0; i < 16; ++i) o += QD[t * 64 + dkg * 16 + i] * S0[i];
            OP[(dkg * 8 + t) * 128 + dv] = o; }
        float* so = a.out + O_GSS + ((size_t)(bs * 4 + h) * 64 + dkg * 16) * 128 + dv;
#pragma unroll
        for (int i = 0; i < 16; ++i) { float sn = __expf(BL[dkg * 16 + i]) * S0[i];
#pragma unroll
            for (int t = 0; t < 8; ++t) sn += KR[t * 64 + dkg * 16 + i] * VS[t * 128 + dv];
            so[(size_t)i * 128] = sn; }
    }
    __syncthreads();
    {
        const int t = F.wave; float o[2]; float ss = 0.f;
#pragma unroll
        for (int j = 0; j < 2; ++j) { const int d = 2 * F.lane + j; float v = OP[(0 * 8 + t) * 128 + d] + OP[(1 * 8 + t) * 128 + d] + OP[(2 * 8 + t) * 128 + d] + OP[(3 * 8 + t) * 128 + d];
            for (int s = 0; s <= t; ++s) v += ATT[t * 8 + s] * VS[s * 128 + d];
            o[j] = v; ss += v * v; }
        const float r = rsqrtf(wave_sum(ss) * (1.f / 128.f) + EPS);
        const float* ggo = (const float*)a.in[I_GGO] + h * 128 + 2 * F.lane; const BfPtr gr = GLD(ws + WS_GR) + ((size_t)(row0 + t) * 512 + h * 128 + 2 * F.lane);
        const float y0 = o[0] * r * ggo[0] * silu(gr[0]), y1 = o[1] * r * ggo[1] * silu(gr[1]);
        *(unsigned*)((bf16*)(ws + WS_MERGED) + (size_t)(row0 + t) * DM + 512 + h * 128 + 2 * F.lane) = pk2(y0, y1);
    }
    __syncthreads();
}


__device__ __forceinline__ float fexp2(float x) { return __builtin_amdgcn_exp2f(x); }
constexpr float FOX_SKIP = 160.f;


__device__ __forceinline__ void fox_norms_item(const Frame& F, const bf16* QF, const bf16* KF, const float* logf, float* FN, float* LC, float* BT, int item) {
    const int bh = item >> 5, qb = item & 31, b = bh >> 3, h = bh & 7;
    float qm = 0.f, km = 0.f;
    const float* lp = logf + ((size_t)b * SEQ + qb * 256 + 4 * F.lane) * 8 + h;
    const float l0 = lp[0], l1 = lp[8], l2 = lp[16], l3 = lp[24];
#pragma unroll 8
    for (int i = 0; i < 32; ++i) { const size_t row = (size_t)b * SEQ + qb * 256 + i * 8 + (F.lane >> 3);
        const v4u q = *(const v4u*)(QF + row * 512 + h * 64 + (F.lane & 7) * 8), k = *(const v4u*)(KF + row * 512 + h * 64 + (F.lane & 7) * 8); float qs = 0.f, ks = 0.f;
#pragma unroll
        for (int j = 0; j < 4; ++j) { qs += bflo(q[j]) * bflo(q[j]) + bfhi(q[j]) * bfhi(q[j]); ks += bflo(k[j]) * bflo(k[j]) + bfhi(k[j]) * bfhi(k[j]); }
        qs = sum8_f32(qs); ks = sum8_f32(ks);
        qm = fmaxf(qm, qs); km = fmaxf(km, ks); }
#pragma unroll
    for (int o = 1; o < 64; o <<= 1) { qm = fmaxf(qm, __shfl_xor(qm, o)); km = fmaxf(km, __shfl_xor(km, o)); }
    const float c0 = l0, c1 = c0 + l1, c2 = c1 + l2, c3 = c2 + l3; float v = c3;
#pragma unroll
    for (int o = 1; o < 64; o <<= 1) { const float t = __shfl_up(v, o); if (F.lane >= o) v += t; }
    const float ex = v - c3;
    *(f32x4*)(LC + (size_t)bh * SEQ + qb * 256 + 4 * F.lane) = (f32x4){ex + c0, ex + c1, ex + c2, ex + c3};
    if (F.lane == 63) BT[item] = v;
    if (F.lane == 0) { FN[item * 2] = qm; FN[item * 2 + 1] = km; }
}
__device__ __forceinline__ void fox_suffix_item(const Frame& F, const float* cfl, const int* pt, float* SW, float* PTOT, int item) {
    const int bs = item >> 4, p = item & 15; const int pg = __builtin_amdgcn_readfirstlane(pt[item]);
    const f32x4* src = (const f32x4*)(cfl + ((size_t)pg * PAGE + 2 * F.lane) * 8);
    const f32x4 a0 = src[0], a1 = src[1], b0 = src[2], b1 = src[3];
    const float ra[8] = {a0.x, a0.y, a0.z, a0.w, a1.x, a1.y, a1.z, a1.w}, rb[8] = {b0.x, b0.y, b0.z, b0.w, b1.x, b1.y, b1.z, b1.w};
#pragma unroll
    for (int h = 0; h < 8; ++h) {
        const float ps = ra[h] + rb[h]; float v = ps;
#pragma unroll
        for (int o = 1; o < 64; o <<= 1) { const float t = __shfl_down(v, o); if (F.lane + o < 64) v += t; }
        const float exs = v - ps;
        *(f32x2*)(SW + (size_t)(bs * 8 + h) * PASTL + p * PAGE + 2 * F.lane) = (f32x2){exs + rb[h], exs};
        if (F.lane == 0) PTOT[(bs * 8 + h) * NPAGES + p] = v;
    }
}
__device__ __forceinline__ void fox_attn_unit(const Frame& F, const bf16* QF, const bf16* KF, const bf16* VF, const float* LC, const float* BT, const float* FN, bf16* merged, int b, int h, int qb) {
    int tid = F.wave * 64 + lane_id(); asm volatile("" : "+v"(tid));
    const int lane = tid & 63, r32 = lane & 31, hi = lane >> 5, wid = F.wave;
    const size_t rowbase = (size_t)b * SEQ; const int q0 = qb * 256;
    LAS unsigned char* Ks = F.lds; LAS unsigned char* Vs = F.lds + 8192; LAS float* KBs = (LAS float*)(F.lds + 20480); LAS float* WSF = (LAS float*)(F.lds + 20736) + wid * 32;
    const bf16* Qw = QF + (rowbase + q0 + wid * 32 + r32) * 512 + h * 64;
    bf16x8 qr[4];
#pragma unroll
    for (int d0 = 0; d0 < 4; ++d0) qr[d0] = *(const bf16x8*)(Qw + d0 * 16 + hi * 8);
    const float* lcp = LC + (size_t)(b * 8 + h) * SEQ;
    float pbx; { const float btv = (lane < 32) ? BT[(b * 8 + h) * 32 + lane] : 0.f; float v = btv;
#pragma unroll
        for (int o = 1; o < 64; o <<= 1) { const float t = __shfl_up(v, o); if (lane >= o) v += t; }
        pbx = v - btv; }
    const float cref = lcp[q0] + __shfl(pbx, qb);
#define FOX_KB(t_, pos_) (-LOG2E * ((lcp[pos_] + __shfl(pbx, (t_) >> 2)) - cref))
    const int NT = (q0 + 256) / 64;
    int t0 = 0;
    {
        float kn = (lane < 32) ? FN[((b * 8 + h) * 32 + lane) * 2 + 1] : 0.f;
#pragma unroll
        for (int o = 1; o < 64; o <<= 1) kn = fmaxf(kn, __shfl_xor(kn, o));
        const float qk2 = 2.f * sqrtf(FN[((b * 8 + h) * 32 + qb) * 2]) * sqrtf(kn) * 1.01f;
        const int nbefore = q0 / 64;
        int found = -1;
        for (int base = 0; base < nbefore && found < 0; base += 64) {
            const int tl = nbefore - 1 - base - lane;
            const int tlc = tl < 0 ? 0 : tl; const float kbl = -LOG2E * ((lcp[tlc * 64 + 63] + __shfl(pbx, tlc >> 2)) - cref);
            const bool dead = (tl >= 0) && (qk2 + kbl < -FOX_SKIP);
            const unsigned long long bm = __ballot(dead);
            if (bm) found = nbefore - 1 - base - (int)__builtin_ctzll(bm);
        }
        t0 = found + 1;
        t0 = __builtin_amdgcn_readfirstlane(t0);
    }
    const int kkey = tid >> 3, kch = tid & 7, vkey = tid >> 3, vch = tid & 7;
    const bf16* ksrc = KF + (rowbase + kkey) * 512 + h * 64 + kch * 8;
    const bf16* vsrc = VF + (rowbase + vkey) * 512 + h * 64 + vch * 8;
    v4u kreg[2], vreg[2]; float kbreg[2];
#pragma unroll
    for (int hb = 0; hb < 2; ++hb) { const int tt = (t0 + hb < NT) ? t0 + hb : t0;
        kreg[hb] = *(const v4u*)(ksrc + (size_t)tt * 64 * 512); vreg[hb] = *(const v4u*)(vsrc + (size_t)tt * 64 * 512); kbreg[hb] = FOX_KB(tt, tt * 64 + (tid & 63)); }
    float m_run = -INFINITY, l_run = 0.f; f32x16 o0 = {}, o1 = {};
    const int qpos = q0 + wid * 32 + r32;
    const int vbase = (4 * hi + ((lane & 15) >> 2)) * 192 + (16 * ((lane >> 4) & 1) + 4 * (lane & 3)) * 2;
    LAS unsigned char* const Ks0 = Ks; LAS unsigned char* const Vs0 = Vs; LAS float* const KBs0 = KBs;
    __syncthreads();
    for (int t2 = t0; t2 < NT; t2 += 2) {
#pragma unroll
      for (int hb = 0; hb < 2; ++hb) {
        const int t = t2 + hb;
        if (t < NT) {
        LAS unsigned char* const Ks = Ks0 + hb * 28672; LAS unsigned char* const Vs = Vs0 + hb * 28672; LAS float* const KBs = (LAS float*)((LAS unsigned char*)KBs0 + hb * 28672);
        *(LAS v4u*)(Ks + kkey * 128 + ((kch ^ (kkey & 7)) << 4)) = kreg[hb];            *(LAS v4u*)(Vs + vkey * 192 + vch * 16) = vreg[hb]; if (tid < 64) KBs[tid] = kbreg[hb];
        __syncthreads();
        if (t + 2 < NT) { kreg[hb] = *(const v4u*)(ksrc + (size_t)(t + 2) * 64 * 512); vreg[hb] = *(const v4u*)(vsrc + (size_t)(t + 2) * 64 * 512); kbreg[hb] = FOX_KB(t + 2, (t + 2) * 64 + (tid & 63)); }
        const int k0 = t * 64;
        if (k0 <= q0 + wid * 32 + 31) {
        f32x16 p0, p1;
#pragma unroll
        for (int g = 0; g < 4; ++g) { const f32x4 ba = *(const LAS f32x4*)(KBs + 8 * g + 4 * hi), bb = *(const LAS f32x4*)(KBs + 32 + 8 * g + 4 * hi);
#pragma unroll
            for (int i = 0; i < 4; ++i) { p0[4 * g + i] = ba[i]; p1[4 * g + i] = bb[i]; } }
#pragma unroll
        for (int d0 = 0; d0 < 4; ++d0) {
            const bf16x8 a0 = *(const LAS bf16x8*)(Ks + r32 * 128 + (((2 * d0 + hi) ^ (r32 & 7)) << 4)), a1 = *(const LAS bf16x8*)(Ks + (r32 + 32) * 128 + (((2 * d0 + hi) ^ (r32 & 7)) << 4));
            p0 = __builtin_amdgcn_mfma_f32_32x32x16_bf16(a0, qr[d0], p0, 0, 0, 0); p1 = __builtin_amdgcn_mfma_f32_32x32x16_bf16(a1, qr[d0], p1, 0, 0, 0);
        }
        if (k0 + 63 > q0 + wid * 32) {
#pragma unroll
            for (int r = 0; r < 16; ++r) { const int key = k0 + crow(r, hi); if (key > qpos) p0[r] = -INFINITY; if (key + 32 > qpos) p1[r] = -INFINITY; }
        }
        float mx = fmaxf(p0[0], p1[0]);
#pragma unroll
        for (int r = 1; r < 16; ++r) mx = fmaxf(mx, fmaxf(p0[r], p1[r]));
        mx = fmaxf(mx, __shfl_xor(mx, 32));
        const float m_new = fmaxf(m_run, mx), alpha = fexp2(m_run - m_new); m_run = m_new;
        float ls = 0.f;
#pragma unroll
        for (int r = 0; r < 16; ++r) { p0[r] = fexp2(p0[r] - m_new); p1[r] = fexp2(p1[r] - m_new); ls += p0[r] + p1[r]; }
        l_run = l_run * alpha + ls;
        if (__ballot(alpha != 1.f) != 0ull) {
            if (hi == 0) WSF[r32] = alpha;
#pragma unroll
            for (int g = 0; g < 4; ++g) { const f32x4 al = *(const LAS f32x4*)(WSF + 8 * g + 4 * hi);
#pragma unroll
                for (int i = 0; i < 4; ++i) { o0[4 * g + i] *= al[i]; o1[4 * g + i] *= al[i]; } }
        }
        v4u pw[4];
#pragma unroll
        for (int j = 0; j < 4; ++j) { pw[0][j] = pg8::cvt_pk_bf16(p0[2 * j], p0[2 * j + 1]); pw[1][j] = pg8::cvt_pk_bf16(p0[8 + 2 * j], p0[8 + 2 * j + 1]);
                                      pw[2][j] = pg8::cvt_pk_bf16(p1[2 * j], p1[2 * j + 1]); pw[3][j] = pg8::cvt_pk_bf16(p1[8 + 2 * j], p1[8 + 2 * j + 1]); }
#pragma unroll
        for (int ks = 0; ks < 4; ++ks) {
            const bf16x8 pa = __builtin_bit_cast(bf16x8, pw[ks]);
#pragma unroll
            for (int d0 = 0; d0 < 2; ++d0) {
                const s16x4 lo = lds_tr16(Vs + vbase + ks * 16 * 192 + d0 * 64), hi4 = lds_tr16(Vs + vbase + ks * 16 * 192 + 8 * 192 + d0 * 64);
                const bf16x8 vb = (bf16x8){lo[0], lo[1], lo[2], lo[3], hi4[0], hi4[1], hi4[2], hi4[3]};
                if (d0 == 0) o0 = __builtin_amdgcn_mfma_f32_32x32x16_bf16(pa, vb, o0, 0, 0, 0); else o1 = __builtin_amdgcn_mfma_f32_32x32x16_bf16(pa, vb, o1, 0, 0, 0);
            }
        }
        }
        }
      }
    }
    l_run += __shfl_xor(l_run, 32);
    if (hi == 0) WSF[r32] = 1.f / l_run;
    bf16* Ow = merged + (rowbase + q0 + wid * 32) * DM + h * 64 + r32;
#pragma unroll
    for (int g = 0; g < 4; ++g) { const f32x4 rl = *(const LAS f32x4*)(WSF + 8 * g + 4 * hi);
#pragma unroll
        for (int i = 0; i < 4; ++i) { const int r = 4 * g + i; const int row = crow(r, hi);
            Ow[(size_t)row * DM] = (bf16)f2bf(o0[r] * rl[i]); Ow[(size_t)row * DM + 32] = (bf16)f2bf(o1[r] * rl[i]); } }
    __syncthreads();
#undef FOX_KB
}

template <int D> struct DecW {
    static constexpr int KS = D / 32;
    static constexpr int LPK = D / 4;
    static constexpr int KPI = 64 / LPK;
    float m[4], l[4]; float o[8][4];
};
template <int D>
__device__ __forceinline__ void dec_init(DecW<D>& w) {
#pragma unroll
    for (int i = 0; i < 4; ++i) { w.m[i] = -INFINITY; w.l[i] = 0.f; }
#pragma unroll
    for (int q = 0; q < 8; ++q)
#pragma unroll
        for (int j = 0; j < 4; ++j) w.o[q][j] = 0.f;
}
template <int D, int NTILE, int MODE>
__device__ __forceinline__ void dec_chunk(DecW<D>& w, const bf16x8 (&qa)[D / 32], const float* Kb, const float* Vb, int stride, const float* bias, float nb, LAS float* PL, int lane) {
    constexpr int KS = D / 32, LPK = D / 4, KPI = 64 / LPK;
    constexpr int NK = (MODE == 1) ? 8 : NTILE * 16, NV = NK / KPI;
    const int key = lane & 15, kq = lane >> 4;
    const unsigned koff = (unsigned)(key * stride + 8 * kq) * 4u;
    const int d4 = lane % LPK, ksub = lane / LPK;
    const unsigned voff = (unsigned)(ksub * stride + 4 * d4) * 4u;
    f32x4 kx[NTILE][2 * KS], vx[NV];
#pragma unroll
    for (int t = 0; t < NTILE; ++t) { const char* kp = (const char*)(Kb + (size_t)t * 16 * stride) + koff;
#pragma unroll
        for (int ks = 0; ks < KS; ++ks) { kx[t][2 * ks] = *(const f32x4*)(kp + 128 * ks); kx[t][2 * ks + 1] = *(const f32x4*)(kp + 128 * ks + 16); } }
    constexpr int NVA = (NV >= 8) ? NV / 2 : NV;
#pragma unroll
    for (int kk = 0; kk < NVA; ++kk) vx[kk] = *(const f32x4*)((const char*)(Vb + (size_t)kk * KPI * stride) + voff);
    f32x4 s[NTILE];
#pragma unroll
    for (int t = 0; t < NTILE; ++t) {
        f32x4 acc = {0.f, 0.f, 0.f, 0.f};
#pragma unroll
        for (int ks = 0; ks < KS; ++ks) { const f32x4 x0 = kx[t][2 * ks], x1 = kx[t][2 * ks + 1];
            v4u kb; kb.x = pg8::cvt_pk_bf16(x0.x, x0.y); kb.y = pg8::cvt_pk_bf16(x0.z, x0.w); kb.z = pg8::cvt_pk_bf16(x1.x, x1.y); kb.w = pg8::cvt_pk_bf16(x1.z, x1.w);
            acc = __builtin_amdgcn_mfma_f32_16x16x32_bf16(qa[ks], __builtin_bit_cast(bf16x8, kb), acc, 0, 0, 0); }
        if (MODE == 0) { if (bias) { const float bv = (bias[t * 16 + key] + nb) * LOG2E; acc += bv; } }
        else { acc += nb;
#pragma unroll
            for (int i = 0; i < 4; ++i) if (key > 4 * kq + i || key >= 8) acc[i] = -INFINITY; }
        s[t] = acc;
    }
#pragma unroll
    for (int kk = NVA; kk < NV; ++kk) vx[kk] = *(const f32x4*)((const char*)(Vb + (size_t)kk * KPI * stride) + voff);
    f32x4 mc = s[0];
#pragma unroll
    for (int t = 1; t < NTILE; ++t) { mc.x = fmaxf(mc.x, s[t].x); mc.y = fmaxf(mc.y, s[t].y); mc.z = fmaxf(mc.z, s[t].z); mc.w = fmaxf(mc.w, s[t].w); }
    mc.x = max16_f32(mc.x); mc.y = max16_f32(mc.y); mc.z = max16_f32(mc.z); mc.w = max16_f32(mc.w);
    float al[4];
#pragma unroll
    for (int i = 0; i < 4; ++i) { const float mn = fmaxf(w.m[i], mc[i]); al[i] = (mn == -INFINITY) ? 1.f : fexp2(w.m[i] - mn); w.m[i] = mn; w.l[i] *= al[i]; }
#pragma unroll
    for (int t = 0; t < NTILE; ++t) { f32x4 p;
#pragma unroll
        for (int i = 0; i < 4; ++i) { p[i] = (w.m[i] == -INFINITY) ? 0.f : fexp2(s[t][i] - w.m[i]); w.l[i] += p[i]; }
        if (kq < 2) *(LAS f32x4*)(PL + (t * 16 + key) * 8 + 4 * kq) = p; }
    if (key == 0 && kq < 2) *(LAS f32x4*)(PL + 1024 + 4 * kq) = (f32x4){al[0], al[1], al[2], al[3]};
    { const f32x4 a0 = *(const LAS f32x4*)(PL + 1024), a1 = *(const LAS f32x4*)(PL + 1028);
#pragma unroll
      for (int j = 0; j < 4; ++j) { w.o[0][j] *= a0.x; w.o[1][j] *= a0.y; w.o[2][j] *= a0.z; w.o[3][j] *= a0.w; w.o[4][j] *= a1.x; w.o[5][j] *= a1.y; w.o[6][j] *= a1.z; w.o[7][j] *= a1.w; } }
#pragma unroll
    for (int kk = 0; kk < NV; ++kk) { const int k = kk * KPI + ksub;
        const f32x4 v = vx[kk];
        const f32x4 pa = *(const LAS f32x4*)(PL + k * 8), pb = *(const LAS f32x4*)(PL + k * 8 + 4);
#pragma unroll
        for (int j = 0; j < 4; ++j) { w.o[0][j] += pa.x * v[j]; w.o[1][j] += pa.y * v[j]; w.o[2][j] += pa.z * v[j]; w.o[3][j] += pa.w * v[j];
                                      w.o[4][j] += pb.x * v[j]; w.o[5][j] += pb.y * v[j]; w.o[6][j] += pb.z * v[j]; w.o[7][j] += pb.w * v[j]; } }
}
__device__ __forceinline__ void dec_page_fox(DecW<64>& w, const bf16x8 (&qa)[2], const float* Kb, const float* Vb, const float* bias, float boff, LAS float* PL, int lane) {
    constexpr int stride = 512;
    const int key = lane & 15, kq = lane >> 4;
    const unsigned koff = (unsigned)(key * stride + 8 * kq) * 4u;
    const int d4 = lane & 15, ksub = lane >> 4;
    const unsigned voff = (unsigned)(ksub * stride + 4 * d4) * 4u;
    const __amdgpu_buffer_rsrc_t krs = __builtin_amdgcn_make_buffer_rsrc((void*)Kb, 0, 0x7fffffff, 0x00020000);
    const __amdgpu_buffer_rsrc_t vrs = __builtin_amdgcn_make_buffer_rsrc((void*)Vb, 0, 0x7fffffff, 0x00020000);
    const __amdgpu_buffer_rsrc_t brs = __builtin_amdgcn_make_buffer_rsrc((void*)bias, 0, 0x7fffffff, 0x00020000);
    f32x4 s[8];
#pragma unroll
    for (int hb = 0; hb < 2; ++hb) {
        f32x4 kx[4][4];
#pragma unroll
        for (int t = 0; t < 4; ++t) { const int so = (hb * 4 + t) * 16 * stride * 4;
            kx[t][0] = __builtin_bit_cast(f32x4, __builtin_amdgcn_raw_buffer_load_b128(krs, (int)koff, so, 0)); kx[t][1] = __builtin_bit_cast(f32x4, __builtin_amdgcn_raw_buffer_load_b128(krs, (int)koff + 16, so, 0));
            kx[t][2] = __builtin_bit_cast(f32x4, __builtin_amdgcn_raw_buffer_load_b128(krs, (int)koff + 128, so, 0)); kx[t][3] = __builtin_bit_cast(f32x4, __builtin_amdgcn_raw_buffer_load_b128(krs, (int)koff + 144, so, 0)); }
#pragma unroll
        for (int t = 0; t < 4; ++t) {
            f32x4 acc = {0.f, 0.f, 0.f, 0.f};
#pragma unroll
            for (int ks = 0; ks < 2; ++ks) { const f32x4 x0 = kx[t][2 * ks], x1 = kx[t][2 * ks + 1];
                v4u kb; kb.x = pg8::cvt_pk_bf16(x0.x, x0.y); kb.y = pg8::cvt_pk_bf16(x0.z, x0.w); kb.z = pg8::cvt_pk_bf16(x1.x, x1.y); kb.w = pg8::cvt_pk_bf16(x1.z, x1.w);
                acc = __builtin_amdgcn_mfma_f32_16x16x32_bf16(qa[ks], __builtin_bit_cast(bf16x8, kb), acc, 0, 0, 0); }
            acc += (__builtin_bit_cast(float, __builtin_amdgcn_raw_buffer_load_b32(brs, key * 4, (hb * 4 + t) * 64, 0)) + boff) * LOG2E;
            s[hb * 4 + t] = acc;
        }
        asm volatile("" ::: "memory");
    }
    f32x4 mc = s[0];
#pragma unroll
    for (int t = 1; t < 8; ++t) { mc.x = fmaxf(mc.x, s[t].x); mc.y = fmaxf(mc.y, s[t].y); mc.z = fmaxf(mc.z, s[t].z); mc.w = fmaxf(mc.w, s[t].w); }
    mc.x = max16_f32(mc.x); mc.y = max16_f32(mc.y); mc.z = max16_f32(mc.z); mc.w = max16_f32(mc.w);
    float al[4];
#pragma unroll
    for (int i = 0; i < 4; ++i) { const float mn = fmaxf(w.m[i], mc[i]); al[i] = fexp2(w.m[i] - mn); w.m[i] = mn; w.l[i] *= al[i]; }
    bool nz = false;
#pragma unroll
    for (int t = 0; t < 8; ++t) { f32x4 p;
#pragma unroll
        for (int i = 0; i < 4; ++i) { p[i] = fexp2(s[t][i] - w.m[i]); w.l[i] += p[i]; nz = nz || (p[i] != 0.f); }
        if (kq < 2) *(LAS f32x4*)(PL + (t * 16 + key) * 8 + 4 * kq) = p; }
    if (__ballot(nz && kq < 2) == 0ull) return;
    if (key == 0 && kq < 2) *(LAS f32x4*)(PL + 1024 + 4 * kq) = (f32x4){al[0], al[1], al[2], al[3]};
    { const f32x4 a0 = *(const LAS f32x4*)(PL + 1024), a1 = *(const LAS f32x4*)(PL + 1028);
#pragma unroll
      for (int j = 0; j < 4; ++j) { w.o[0][j] *= a0.x; w.o[1][j] *= a0.y; w.o[2][j] *= a0.z; w.o[3][j] *= a0.w; w.o[4][j] *= a1.x; w.o[5][j] *= a1.y; w.o[6][j] *= a1.z; w.o[7][j] *= a1.w; } }
#pragma unroll 1
    for (int vh = 0; vh < 2; ++vh) {
    f32x4 vx[16];
#pragma unroll
    for (int kk = 0; kk < 16; ++kk) vx[kk] = __builtin_bit_cast(f32x4, __builtin_amdgcn_raw_buffer_load_b128(vrs, (int)voff, (vh * 16 + kk) * 4 * stride * 4, 0));
#pragma unroll
    for (int kk = 0; kk < 16; ++kk) { const int k = (vh * 16 + kk) * 4 + ksub;
        const f32x4 v = vx[kk];
        const f32x4 pa = *(const LAS f32x4*)(PL + k * 8), pb = *(const LAS f32x4*)(PL + k * 8 + 4);
#pragma unroll
        for (int j = 0; j < 4; ++j) { w.o[0][j] += pa.x * v[j]; w.o[1][j] += pa.y * v[j]; w.o[2][j] += pa.z * v[j]; w.o[3][j] += pa.w * v[j];
                                      w.o[4][j] += pb.x * v[j]; w.o[5][j] += pb.y * v[j]; w.o[6][j] += pb.z * v[j]; w.o[7][j] += pb.w * v[j]; } }
    }
}
template <int D>
__device__ __forceinline__ void dec_park(DecW<D>& w, LAS float* CBw, int lane) {
    constexpr int LPK = D / 4;
    const int key = lane & 15, kq = lane >> 4, d4 = lane % LPK, ksub = lane / LPK;
#pragma unroll
    for (int i = 0; i < 4; ++i) { float l = w.l[i];
        l = sum16_f32(l);
        w.l[i] = l; }
    if (key == 0 && kq < 2) { *(LAS f32x4*)(CBw + 4 * kq) = (f32x4){w.m[0], w.m[1], w.m[2], w.m[3]}; *(LAS f32x4*)(CBw + 8 + 4 * kq) = (f32x4){w.l[0], w.l[1], w.l[2], w.l[3]}; }
#pragma unroll
    for (int q = 0; q < 8; ++q) { f32x4 v = (f32x4){w.o[q][0], w.o[q][1], w.o[q][2], w.o[q][3]};
        if (LPK < 64) {
#pragma unroll
            for (int o = LPK; o < 64; o <<= 1) { if (o == 16) { v.x += xor16_f32(v.x); v.y += xor16_f32(v.y); v.z += xor16_f32(v.z); v.w += xor16_f32(v.w); }
                else { v.x += __shfl_xor(v.x, o); v.y += __shfl_xor(v.y, o); v.z += __shfl_xor(v.z, o); v.w += __shfl_xor(v.w, o); } } }
        if (ksub == 0) *(LAS f32x4*)(CBw + 16 + q * D + 4 * d4) = v; }
}
template <int D>
__device__ __forceinline__ void dec_combine(int tid, LAS float* CB, bf16* dst, int ldd) {
    constexpr int WSTR = 16 + 8 * D;
    for (int e = tid; e < 8 * D; e += NTHR) { const int q = e / D, d = e % D;
        float mt = -INFINITY;
#pragma unroll
        for (int w = 0; w < 8; ++w) mt = fmaxf(mt, CB[w * WSTR + q]);
        float num = 0.f, den = 0.f;
#pragma unroll
        for (int w = 0; w < 8; ++w) { const float mw = CB[w * WSTR + q]; const float f = (mw == -INFINITY) ? 0.f : fexp2(mw - mt); num += f * CB[w * WSTR + 16 + q * D + d]; den += f * CB[w * WSTR + 8 + q]; }
        dst[(size_t)q * ldd + d] = (bf16)f2bf(num / den); }
}
template <int D>
__device__ __forceinline__ void dec_load_q(bf16x8 (&qa)[D / 32], const bf16* Q, int ldq, int lane) {
    const int row = lane & 15, kq = lane >> 4;
#pragma unroll
    for (int ks = 0; ks < D / 32; ++ks) { v4u z = {0u, 0u, 0u, 0u}; if (row < 8) z = *(const v4u*)(Q + (size_t)row * ldq + 32 * ks + 8 * kq); qa[ks] = __builtin_bit_cast(bf16x8, z); }
}
constexpr int DEC_PL = 1040;
__device__ __forceinline__ void fox_sample_unit(const Frame& F, const Args& a, int u) {
    unsigned char* ws = a.ws; const int bs = u >> 3, h = u & 7;
    int ln = lane_id(); asm volatile("" : "+v"(ln));
    LAS float* PL = (LAS float*)F.lds + F.wave * DEC_PL; LAS float* CB = (LAS float*)F.lds + 8 * DEC_PL; constexpr int WSTR = 16 + 8 * 64;
    bf16x8 qa[2]; dec_load_q<64>(qa, (const bf16*)(ws + WS_QF) + (size_t)(TP + bs * LS) * 512 + h * 64, 512, ln);
    DecW<64> w; dec_init(w);
    {
        const int key = ln & 15; const float* lf = a.out + O_LFS + (size_t)(bs * LS) * 8 + h; float cn = 0.f;
#pragma unroll
        for (int j = 0; j < 8; ++j) { const float x = lf[j * 8]; cn += (j <= key) ? x : 0.f; }
        const float* Kb = a.out + O_FKS + (size_t)(bs * LS) * 512 + h * 64; const float* Vb = a.out + O_FVS + (size_t)(bs * LS) * 512 + h * 64;
        dec_chunk<64, 1, 1>(w, qa, Kb, Vb, 512, nullptr, -cn * LOG2E, PL, ln);
        if (F.wave != 0) {
#pragma unroll
            for (int i = 0; i < 4; ++i) w.l[i] = 0.f;
#pragma unroll
            for (int q = 0; q < 8; ++q)
#pragma unroll
                for (int j = 0; j < 4; ++j) w.o[q][j] = 0.f; }
    }
    const int* pt = (const int*)a.in[I_PT];
    float spx; { const float ptv = (ln < 16) ? ((const float*)(ws + WS_MISC + 2 * MiB))[(bs * 8 + h) * NPAGES + ln] : 0.f; float v = ptv;
#pragma unroll
        for (int o = 1; o < 16; o <<= 1) { const float t = __builtin_bit_cast(float, __builtin_amdgcn_ds_bpermute((ln + o) << 2, __builtin_bit_cast(int, v))); if (ln + o < 16) v += t; }
        spx = v - ptv; }
#if defined(OLD_FOXS)
#pragma unroll 1
    for (int pp = 0; pp < 4; ++pp) { const int p = F.wave * 2 + (pp >> 1), hf = pp & 1; const int pg = __builtin_amdgcn_readfirstlane(pt[bs * NPAGES + p]);
        const float* Kb = (const float*)a.in[I_CFK] + (((size_t)pg * PAGE + hf * 64) * 8 + h) * 64; const float* Vb = (const float*)a.in[I_CFV] + (((size_t)pg * PAGE + hf * 64) * 8 + h) * 64;
        dec_chunk<64, 4, 0>(w, qa, Kb, Vb, 512, (const float*)(ws + WS_SUF) + (size_t)(bs * 8 + h) * PASTL + p * PAGE + hf * 64, __builtin_bit_cast(float, __builtin_amdgcn_ds_bpermute(p << 2, __builtin_bit_cast(int, spx))), PL, ln); }
#else
#pragma unroll 1
    for (int pp = 1; pp >= 0; --pp) { const int p = pp ? (NPAGES - 1 - F.wave) : F.wave;
        const int pg = __builtin_amdgcn_readfirstlane(pt[bs * NPAGES + p]);
        const float* Kb = (const float*)a.in[I_CFK] + ((size_t)pg * PAGE * 8 + h) * 64; const float* Vb = (const float*)a.in[I_CFV] + ((size_t)pg * PAGE * 8 + h) * 64;
        dec_page_fox(w, qa, Kb, Vb, (const float*)(ws + WS_SUF) + (size_t)(bs * 8 + h) * PASTL + p * PAGE, __builtin_bit_cast(float, __builtin_amdgcn_ds_bpermute(p << 2, __builtin_bit_cast(int, spx))), PL, ln); }
#endif
    dec_park<64>(w, CB + F.wave * WSTR, ln);
    __syncthreads();
    dec_combine<64>(F.wave * 64 + ln, CB, (bf16*)(ws + WS_MERGED) + (size_t)(TP + bs * LS) * DM + h * 64, DM);
    __syncthreads();
}
__device__ __forceinline__ void cross_sample_unit(const Frame& F, const Args& a, int u) {
    unsigned char* ws = a.ws; const int bs = u >> 2, h = u & 3;
    LAS float* PL = (LAS float*)F.lds + F.wave * DEC_PL; LAS float* CB = (LAS float*)F.lds + 8 * DEC_PL; constexpr int WSTR = 16 + 8 * 256;
    bf16x8 qa[8]; dec_load_q<256>(qa, (const bf16*)(ws + WS_QC) + (size_t)(TP + bs * LS) * DM + h * 256, DM, F.lane);
    DecW<256> w; dec_init(w);
    const float* Kb = (const float*)a.in[I_CMK] + ((size_t)(bs * 256 + F.wave * 32) * 4 + h) * 256; const float* Vb = (const float*)a.in[I_CMV] + ((size_t)(bs * 256 + F.wave * 32) * 4 + h) * 256;
#pragma unroll 1
    for (int c = 0; c < 2; ++c) dec_chunk<256, 1, 0>(w, qa, Kb + (size_t)c * 16 * 1024, Vb + (size_t)c * 16 * 1024, 1024, nullptr, 0.f, PL, F.lane);
    dec_park<256>(w, CB + F.wave * WSTR, F.lane);
    __syncthreads();
    dec_combine<256>(F.tid, CB, (bf16*)(ws + WS_OC) + (size_t)(TP + bs * LS) * DM + h * 256, DM);
    __syncthreads();
}


__device__ __forceinline__ void gla_g3_unit(const Frame& F, const Args& a, int u) {
    unsigned char* ws = a.ws;
    const int b = u >> 9, h = (u >> 7) & 3, n = u & 127; const int row0 = b * SEQ + n * 64;
    LAS unsigned char* KIB = F.lds; LAS unsigned char* ATTB = F.lds + 34816; LAS unsigned char* QDB = F.lds + 44032;
    LAS unsigned char* VSB = F.lds + 53248; LAS unsigned char* SPB = F.lds + 73728; LAS float* OS = (LAS float*)(F.lds + 94208);
#pragma unroll
    for (int i = 0; i < 2; ++i) { const int c = F.tid + NTHR * i; *(LAS v4u*)(VSB + (c >> 4) * 320 + (c & 15) * 16) = *(const v4u*)((const bf16*)(ws + WS_GV) + (size_t)(row0 + (c >> 4)) * 512 + h * 128 + (c & 15) * 8); }
#pragma unroll
    for (int i = 0; i < 4; ++i) { const int c4 = F.tid + NTHR * i; const f32x4 sp = *(const f32x4*)((const float*)(ws + WS_GKV) + ((size_t)((b * 4 + h) * 128 + n) * 64) * 128 + 4 * c4);
        v2u o; o.x = pg8::cvt_pk_bf16(sp.x, sp.y); o.y = pg8::cvt_pk_bf16(sp.z, sp.w); *(LAS v2u*)(SPB + (c4 >> 5) * 320 + (c4 & 31) * 8) = o; }
#pragma unroll
    for (int i = 0; i < 2; ++i) { const int c4 = F.tid + NTHR * i, t = c4 >> 4, d4 = (c4 & 15) * 4; const size_t gi = (size_t)(row0 + t) * 256 + h * 64 + d4;
        const f32x4 bb = *(const f32x4*)((const float*)(ws + WS_BB) + gi);
        const v2u qq = *(const v2u*)((const bf16*)(ws + WS_GQ) + gi), kk = *(const v2u*)((const bf16*)(ws + WS_GK) + gi);
        v2u qo, ko; qo.x = pg8::cvt_pk_bf16(bflo(qq.x) * __expf(bb.x), bfhi(qq.x) * __expf(bb.y)); qo.y = pg8::cvt_pk_bf16(bflo(qq.y) * __expf(bb.z), bfhi(qq.y) * __expf(bb.w));
        ko.x = pg8::cvt_pk_bf16(bflo(kk.x) * __expf(-bb.x), bfhi(kk.x) * __expf(-bb.y)); ko.y = pg8::cvt_pk_bf16(bflo(kk.y) * __expf(-bb.z), bfhi(kk.y) * __expf(-bb.w));
        *(LAS v2u*)(QDB + t * 144 + d4 * 2) = qo; *(LAS v2u*)(KIB + t * 144 + d4 * 2) = ko; }
    __syncthreads();
    {
        const int lane = F.lane, r32 = lane & 31, hi = lane >> 5;
        if (F.wave < 4) { const int tb = F.wave >> 1, sb = F.wave & 1; f32x16 acc = {};
            if (sb <= tb) {
                const LAS unsigned char* qrow = QDB + (32 * tb + r32) * 144; const LAS unsigned char* krow = KIB + (32 * sb + r32) * 144;
#pragma unroll
                for (int ks = 0; ks < 4; ++ks) acc = __builtin_amdgcn_mfma_f32_32x32x16_bf16(row_frag(qrow, ks, hi), row_frag(krow, ks, hi), acc, 0, 0, 0);
            }
#pragma unroll
            for (int r = 0; r < 16; ++r) { const int t = 32 * tb + crow(r, hi), s2 = 32 * sb + r32; *(LAS unsigned short*)(ATTB + t * 144 + s2 * 2) = (unsigned short)f2bf(s2 <= t ? acc[r] : 0.f); }
        }
    }
    __syncthreads();
    {
        const int lane = F.lane, r32 = lane & 31, hi = lane >> 5, tb = F.wave >> 2, nb = F.wave & 3;
        const int trb = (4 * hi + ((lane & 15) >> 2)) * 320 + (16 * ((lane >> 4) & 1) + 4 * (lane & 3)) * 2 + 64 * nb;
        const LAS unsigned char* arow = ATTB + (32 * tb + r32) * 144; const LAS unsigned char* qrow = QDB + (32 * tb + r32) * 144;
        f32x16 acc = {};
#pragma unroll
        for (int ks = 0; ks < 4; ++ks) acc = __builtin_amdgcn_mfma_f32_32x32x16_bf16(row_frag(arow, ks, hi), tr_frag<320>(VSB + trb, ks), acc, 0, 0, 0);
#pragma unroll
        for (int ks = 0; ks < 4; ++ks) acc = __builtin_amdgcn_mfma_f32_32x32x16_bf16(row_frag(qrow, ks, hi), tr_frag<320>(SPB + trb, ks), acc, 0, 0, 0);
#pragma unroll
        for (int r = 0; r < 16; ++r) OS[(32 * tb + crow(r, hi)) * 128 + 32 * nb + r32] = acc[r];
    }
    __syncthreads();
#pragma unroll
    for (int rr = 0; rr < 8; ++rr) { const int t = F.wave * 8 + rr; const float v0 = OS[t * 128 + F.lane], v1 = OS[t * 128 + 64 + F.lane];
        const float r = rsqrtf(wave_sum(v0 * v0 + v1 * v1) * (1.f / 128.f) + EPS);
        const float* ggo = (const float*)a.in[I_GGO] + h * 128; const BfPtr gr = GLD(ws + WS_GR) + ((size_t)(row0 + t) * 512 + h * 128);
        bf16* mo = (bf16*)(ws + WS_MERGED) + (size_t)(row0 + t) * DM + 512 + h * 128;
        mo[F.lane] = (bf16)f2bf(v0 * r * ggo[F.lane] * silu(gr[F.lane])); mo[64 + F.lane] = (bf16)f2bf(v1 * r * ggo[64 + F.lane] * silu(gr[64 + F.lane])); }
    __syncthreads();
}

struct EpiSoftmaxP {
    static constexpr bool PERM = false, AFTER_DRAIN = true;
    const LAS unsigned long long* argp;
    __device__ __forceinline__ void fused(f32x4 (&acc)[2][2][4][2], const Unit&, int wr, int wc, int fr, int fq, PG8_LAS unsigned char* lds, int wid, int lane) const {
        LAS float* PM = (LAS float*)lds; LAS float* PS = PM + 1024;
        const int ub = (int)blockIdx.x; const int ldp = DM;
        bf16* P = (bf16*)((unsigned char*)ld_ptr(argp + N_INPUTS + 1) + WS_PC) + ((size_t)((ub >> 7) & 1) * SEQ + (ub & 31) * 256) * DM + ((ub >> 5) & 3) * 256;
        { int t2 = lane_id(); asm volatile("" : "+v"(t2)); fr = t2 & 15; fq = (t2 >> 4) & 3; }
#pragma unroll
        for (int ai = 0; ai < 2; ++ai)
#pragma unroll
            for (int m = 0; m < 4; ++m) { float mx = -INFINITY;
#pragma unroll
                for (int bj = 0; bj < 2; ++bj)
#pragma unroll
                    for (int n = 0; n < 2; ++n) { const f32x4 x = acc[ai][bj][m][n]; mx = fmaxf(mx, fmaxf(fmaxf(x[0], x[1]), fmaxf(x[2], x[3]))); }
                mx = fmaxf(mx, xor16_f32(mx)); mx = fmaxf(mx, __shfl_xor(mx, 32));
                if (fq == 0) PM[(ai * 128 + wr * 64 + m * 16 + fr) * 4 + wc] = mx; }
        asm volatile("s_waitcnt lgkmcnt(0)" ::: "memory"); __builtin_amdgcn_s_barrier(); asm volatile("" ::: "memory");
#pragma unroll
        for (int ai = 0; ai < 2; ++ai)
#pragma unroll
            for (int m = 0; m < 4; ++m) { const int r = ai * 128 + wr * 64 + m * 16 + fr; const f32x4 pm = *(const LAS f32x4*)(PM + r * 4);
                const float M = fmaxf(fmaxf(pm[0], pm[1]), fmaxf(pm[2], pm[3])); float s = 0.f;
#pragma unroll
                for (int bj = 0; bj < 2; ++bj)
#pragma unroll
                    for (int n = 0; n < 2; ++n) { f32x4 x = acc[ai][bj][m][n]; x[0] = fexp2(x[0] - M); x[1] = fexp2(x[1] - M); x[2] = fexp2(x[2] - M); x[3] = fexp2(x[3] - M); acc[ai][bj][m][n] = x; s += (x[0] + x[1]) + (x[2] + x[3]); }
                s += xor16_f32(s); s += __shfl_xor(s, 32);
                if (fq == 0) PS[r * 4 + wc] = s; }
        asm volatile("s_waitcnt lgkmcnt(0)" ::: "memory"); __builtin_amdgcn_s_barrier(); asm volatile("" ::: "memory");
#pragma unroll
        for (int ai = 0; ai < 2; ++ai)
#pragma unroll
            for (int m = 0; m < 4; ++m) { const int r = ai * 128 + wr * 64 + m * 16 + fr; const f32x4 ps = *(const LAS f32x4*)(PS + r * 4); const float inv = 1.f / ((ps[0] + ps[1]) + (ps[2] + ps[3]));
#pragma unroll
                for (int bj = 0; bj < 2; ++bj)
#pragma unroll
                    for (int n = 0; n < 2; ++n) { const f32x4 x = acc[ai][bj][m][n]; v2u o; o.x = pg8::cvt_pk_bf16(x[0] * inv, x[1] * inv); o.y = pg8::cvt_pk_bf16(x[2] * inv, x[3] * inv);
                        *(v2u*)(P + (size_t)r * ldp + bj * 128 + wc * 32 + n * 16 + fq * 4) = o; } }
        asm volatile("s_waitcnt lgkmcnt(0)" ::: "memory"); __builtin_amdgcn_s_barrier(); asm volatile("" ::: "memory");
    }
};

__device__ __forceinline__ void rms_rows_phase(const Frame& F, const float* X, const float* g, bf16* H) {
    const int gw = F.vcu * NWAVES + F.wave, NGW = F.G * NWAVES;
    for (int m = gw; m < TA; m += NGW) rms_row_bf16(X + (size_t)m * DM, g, H + (size_t)m * DM, F.lane);
}

__device__ __forceinline__ unsigned f2sort(float f) { const unsigned u = __builtin_bit_cast(unsigned, f); return u ^ ((u >> 31) ? 0xFFFFFFFFu : 0x80000000u); }
__device__ __forceinline__ float sort2f(unsigned s) { const unsigned u = s ^ ((s >> 31) ? 0x80000000u : 0xFFFFFFFFu); return __builtin_bit_cast(float, u); }
__device__ __forceinline__ float gelu_tanh(float x) { const float y = 0.7978845608028654f * (x + 0.044715f * x * x * x); const float e = __expf(2.f * y); return 0.5f * x * (1.f + (1.f - 2.f / (e + 1.f))); }
__device__ __forceinline__ unsigned gmax16(unsigned v) { return max16_u32(v); }
typedef __bf16 bf16x2_t __attribute__((ext_vector_type(2)));
__device__ __forceinline__ float dot2bf(unsigned a, unsigned b, float c) {
#if __has_builtin(__builtin_amdgcn_fdot2_f32_bf16)
    return __builtin_amdgcn_fdot2_f32_bf16(__builtin_bit_cast(bf16x2_t, a), __builtin_bit_cast(bf16x2_t, b), c, false);
#else
    return c + bflo(a) * bflo(b) + bfhi(a) * bfhi(b);
#endif
}
template <bool SPLIT>
__device__ __forceinline__ void peer_token(const Frame& F, const Args& a, int row, LAS unsigned* TOPS, const LAS unsigned* CT, int half, LAS float* PART) {
    unsigned char* ws = a.ws; const int lane = lane_id(), grp = lane >> 4, j16 = lane & 15;
    const bf16* sc = (const bf16*)(ws + WS_SC) + (size_t)row * 2048;
#pragma unroll 1
    for (int bt = 0; bt < 4; ++bt) {
        const v4u xq = *(const v4u*)(sc + (bt * 4 + grp) * 128 + 8 * j16);
        unsigned k[8]; const float xs[8] = {bflo(xq.x), bfhi(xq.x), bflo(xq.y), bfhi(xq.y), bflo(xq.z), bfhi(xq.z), bflo(xq.w), bfhi(xq.w)};
#pragma unroll
        for (int e = 0; e < 8; ++e) k[e] = (f2sort(xs[e]) & ~127u) | (unsigned)(127 - (8 * j16 + e));
#define PEER_CE(i, j) { const unsigned hi_ = k[i] > k[j] ? k[i] : k[j], lo_ = k[i] > k[j] ? k[j] : k[i]; k[i] = hi_; k[j] = lo_; }
        PEER_CE(0, 1) PEER_CE(2, 3) PEER_CE(4, 5) PEER_CE(6, 7)
        PEER_CE(0, 2) PEER_CE(1, 3) PEER_CE(4, 6) PEER_CE(5, 7)
        PEER_CE(1, 2) PEER_CE(5, 6)
        PEER_CE(0, 4) PEER_CE(1, 5) PEER_CE(2, 6) PEER_CE(3, 7)
        PEER_CE(2, 4) PEER_CE(3, 5)
        PEER_CE(1, 2) PEER_CE(3, 4) PEER_CE(5, 6)
#undef PEER_CE
        unsigned mine = 0u;
#pragma unroll 1
        for (int r = 0; r < 16; ++r) {
            const unsigned m = gmax16(k[0]);
            if (j16 == r) mine = m;
            const bool won = (k[0] == m);
#pragma unroll
            for (int e = 0; e < 7; ++e) k[e] = won ? k[e + 1] : k[e];
            k[7] = won ? 0u : k[7];
        }
        TOPS[(bt * 4 + grp) * 16 + j16] = mine;
    }
    int ex[2]; float gx[2], sux[2];
#pragma unroll
    for (int ps = 0; ps < 2; ++ps) {
        const int hd = ps * 4 + grp; const LAS unsigned* T1 = TOPS + (2 * hd) * 16; const LAS unsigned* T2 = T1 + 16;
        const unsigned c0_ = CT[j16], c1_ = CT[j16 + 16], c2_ = CT[j16 + 32], c3_ = CT[j16 + 48];
        const int ci0 = c0_ & 255, cj0 = c0_ >> 8, ci1 = c1_ & 255, cj1 = c1_ >> 8, ci2 = c2_ & 255, cj2 = c2_ >> 8, ci3 = c3_ & 255, cj3 = c3_ >> 8; const bool cv3 = (j16 + 48) < 50;
        unsigned k[4];
        { const float s0 = sort2f(T1[ci0] & ~127u) + sort2f(T2[cj0] & ~127u), s1 = sort2f(T1[ci1] & ~127u) + sort2f(T2[cj1] & ~127u),
                      s2 = sort2f(T1[ci2] & ~127u) + sort2f(T2[cj2] & ~127u), s3 = sort2f(T1[ci3] & ~127u) + sort2f(T2[cj3] & ~127u);
          k[0] = (f2sort(s0) & ~127u) | (unsigned)(127 - j16); k[1] = (f2sort(s1) & ~127u) | (unsigned)(127 - (j16 + 16)); k[2] = (f2sort(s2) & ~127u) | (unsigned)(127 - (j16 + 32));
          k[3] = cv3 ? ((f2sort(s3) & ~127u) | (unsigned)(127 - (j16 + 48))) : 0u; }
#define PEER_CE(i, j) { const unsigned hi_ = k[i] > k[j] ? k[i] : k[j], lo_ = k[i] > k[j] ? k[j] : k[i]; k[i] = hi_; k[j] = lo_; }
        PEER_CE(0, 1) PEER_CE(2, 3) PEER_CE(0, 2) PEER_CE(1, 3) PEER_CE(1, 2)
#undef PEER_CE
        unsigned mine = 0u;
#pragma unroll 1
        for (int r = 0; r < 16; ++r) {
            const unsigned m = gmax16(k[0]);
            if (j16 == r) mine = m;
            const bool won = (k[0] == m);
            k[0] = won ? k[1] : k[0]; k[1] = won ? k[2] : k[1]; k[2] = won ? k[3] : k[2]; k[3] = won ? 0u : k[3];
        }
        const int c = 127 - (int)(mine & 127u);
        int ci, cj;
        if (c < 16) { ci = 0; cj = c; } else if (c < 24) { ci = 1; cj = c - 16; } else if (c < 29) { ci = 2; cj = c - 24; } else if (c < 33) { ci = 3; cj = c - 29; }
        else if (c < 36) { ci = 4; cj = c - 33; } else if (c < 38) { ci = 5; cj = c - 36; } else if (c < 40) { ci = 6; cj = c - 38; } else if (c < 42) { ci = 7; cj = c - 40; } else { ci = c - 34; cj = 0; }
        const int i1 = 127 - (int)(T1[ci] & 127u), i2 = 127 - (int)(T2[cj] & 127u);
        ex[ps] = i1 * 128 + i2;
        const float sv = sort2f(mine & ~127u); const float s0 = __shfl(sv, lane & 48);
        float ee = __expf(sv - s0); const float es = sum16_f32(ee);
        const float* rsc = (const float*)(ws + WS_MISC);
        sux[ps] = rsc[ex[ps]]; gx[ps] = ee / es * rsc[16384 + ex[ps]];
    }
    {
        unsigned k0 = ((unsigned)ex[0] << 7) | (unsigned)lane, k1 = ((unsigned)ex[1] << 7) | (unsigned)(64 + lane);
#pragma unroll
        for (int k = 2; k <= 128; k <<= 1) {
#pragma unroll
            for (int j = k >> 1; j > 0; j >>= 1) {
                if (j == 64) { const unsigned lo = k0 < k1 ? k0 : k1, hi = k0 < k1 ? k1 : k0; k0 = lo; k1 = hi; }
                else {
                    unsigned p0, p1;
                    if (j == 32) { p0 = (unsigned)__shfl_xor((int)k0, 32); p1 = (unsigned)__shfl_xor((int)k1, 32); }
                    else if (j == 16) { p0 = xchg_xor_u32<16>(k0); p1 = xchg_xor_u32<16>(k1); } else if (j == 8) { p0 = xchg_xor_u32<8>(k0); p1 = xchg_xor_u32<8>(k1); }
                    else if (j == 4) { p0 = xchg_xor_u32<4>(k0); p1 = xchg_xor_u32<4>(k1); } else if (j == 2) { p0 = xchg_xor_u32<2>(k0); p1 = xchg_xor_u32<2>(k1); }
                    else { p0 = xchg_xor_u32<1>(k0); p1 = xchg_xor_u32<1>(k1); }
                    const bool low = (lane & j) == 0; const bool asc0 = (lane & k) == 0, asc1 = ((64 + lane) & k) == 0;
                    const unsigned mn0 = k0 < p0 ? k0 : p0, mx0 = k0 < p0 ? p0 : k0, mn1 = k1 < p1 ? k1 : p1, mx1 = k1 < p1 ? p1 : k1;
                    k0 = (low == asc0) ? mn0 : mx0; k1 = (low == asc1) ? mn1 : mx1;
                }
            }
        }
        const int o0 = (int)(k0 & 127u), o1 = (int)(k1 & 127u);
        const float g0a = __shfl(gx[0], o0 & 63), g0b = __shfl(gx[1], o0 & 63), g1a = __shfl(gx[0], o1 & 63), g1b = __shfl(gx[1], o1 & 63);
        const float s0a = __shfl(sux[0], o0 & 63), s0b = __shfl(sux[1], o0 & 63), s1a = __shfl(sux[0], o1 & 63), s1b = __shfl(sux[1], o1 & 63);
        gx[0] = (o0 & 64) ? g0b : g0a; gx[1] = (o1 & 64) ? g1b : g1a; sux[0] = (o0 & 64) ? s0b : s0a; sux[1] = (o1 & 64) ? s1b : s1a;
        ex[0] = (int)(k0 >> 7); ex[1] = (int)(k1 >> 7);
    }
    const float rstd2 = rsqrtf(((const float*)(ws + WS_SS))[TA + row] * (1.f / 1024.f) + EPS);
    float hf[16];
    { const bf16* hb = (const bf16*)(ws + WS_HB) + (size_t)row * DM + 4 * lane;
#pragma unroll
      for (int q = 0; q < 4; ++q) { const v2u hq = *(const v2u*)(hb + 256 * q); hf[4 * q] = bflo(hq.x); hf[4 * q + 1] = bfhi(hq.x); hf[4 * q + 2] = bflo(hq.y); hf[4 * q + 3] = bfhi(hq.y); } }
    float oacc[16];
#pragma unroll
    for (int i = 0; i < 16; ++i) oacc[i] = 0.f;
    const unsigned char* U = ws + WS_U16; const unsigned char* V = ws + WS_V16;
    v4u ub[8], vbA[8], vbB[8];
    const int gbeg = SPLIT ? 8 * half : 0, gend = SPLIT ? 8 * half + 8 : 16;
    const int addr32 = (lane ^ 32) << 2;
#define PEER_LOAD(buf, TAB, g) do { const int kk_ = (g) * 8; const int exs_ = (kk_ < 64) ? ex[0] : ex[1]; \
        _Pragma("unroll") for (int i = 0; i < 8; ++i) { const int e_ = __builtin_amdgcn_readlane(exs_, (kk_ & 63) + i); buf[i] = *(const v4u*)(TAB + (size_t)e_ * DM + 16 * lane); } } while (0)
#define PEER_DOTS(buf, g, wout) do { const int kk_ = (g) * 8; const float gxs_ = (kk_ < 64) ? gx[0] : gx[1]; const float sus_ = (kk_ < 64) ? sux[0] : sux[1]; float av[8]; \
        _Pragma("unroll") for (int i = 0; i < 8; ++i) { float s = 0.f; \
            _Pragma("unroll") for (int q = 0; q < 4; ++q) { const f32x2 lo = __builtin_amdgcn_cvt_pk_f32_fp8((int)buf[i][q], false), hi = __builtin_amdgcn_cvt_pk_f32_fp8((int)buf[i][q], true); \
                s += lo.x * hf[4 * q]; s += lo.y * hf[4 * q + 1]; s += hi.x * hf[4 * q + 2]; s += hi.y * hf[4 * q + 3]; } \
            av[i] = s; } \
        const bool b5 = lane & 32, b4 = lane & 16, b3_ = lane & 8; float bq[4], cq[2], dq; \
        _Pragma("unroll") for (int i = 0; i < 4; ++i) bq[i] = (b5 ? av[4 + i] : av[i]) + __builtin_bit_cast(float, __builtin_amdgcn_ds_bpermute(addr32, __builtin_bit_cast(int, b5 ? av[i] : av[4 + i])));     \
        _Pragma("unroll") for (int i = 0; i < 2; ++i) cq[i] = (b4 ? bq[2 + i] : bq[i]) + xor16_f32(b4 ? bq[i] : bq[2 + i]); \
        dq = (b3_ ? cq[1] : cq[0]) + DPP_F(b3_ ? cq[0] : cq[1], DPP_MIR);        \
        dq = sum8_f32(dq); \
        const int src = (kk_ & 63) + (lane >> 3); \
        wout = __shfl(gxs_, src) * gelu_tanh(dq * __shfl(sus_, src) * rstd2); } while (0)
#define PEER_ACC(buf, wv) do { _Pragma("unroll") for (int i = 0; i < 8; ++i) { const float w = __builtin_bit_cast(float, __builtin_amdgcn_readlane(__builtin_bit_cast(int, wv), 8 * i)); \
        _Pragma("unroll") for (int q = 0; q < 4; ++q) { const f32x2 lo = __builtin_amdgcn_cvt_pk_f32_fp8((int)buf[i][q], false), hi = __builtin_amdgcn_cvt_pk_f32_fp8((int)buf[i][q], true); \
            oacc[4 * q] += w * lo.x; oacc[4 * q + 1] += w * lo.y; oacc[4 * q + 2] += w * hi.x; oacc[4 * q + 3] += w * hi.y; } } } while (0)
    PEER_LOAD(ub, U, gbeg); PEER_LOAD(vbA, V, gbeg);
#pragma unroll 1
    for (int g0 = gbeg; g0 < gend; g0 += 2) {
        float w0, w1;
        PEER_DOTS(ub, g0, w0);
        PEER_LOAD(ub, U, g0 + 1); PEER_LOAD(vbB, V, g0 + 1);
        PEER_ACC(vbA, w0);
        PEER_DOTS(ub, g0 + 1, w1);
        { const int gn = (g0 + 2 < gend) ? g0 + 2 : g0 + 1;
          PEER_LOAD(ub, U, gn); PEER_LOAD(vbA, V, gn); }
        PEER_ACC(vbB, w1);
    }
#undef PEER_LOAD
#undef PEER_DOTS
#undef PEER_ACC
    if (SPLIT) {
        if (half == 1) {
#pragma unroll
            for (int q = 0; q < 4; ++q) *(LAS f32x4*)(PART + 16 * lane + 4 * q) = (f32x4){oacc[4 * q], oacc[4 * q + 1], oacc[4 * q + 2], oacc[4 * q + 3]}; }
        __syncthreads();
        if (half == 1) return;
#pragma unroll
        for (int q = 0; q < 4; ++q) { const f32x4 p = *(const LAS f32x4*)(PART + 16 * lane + 4 * q); oacc[4 * q] += p.x; oacc[4 * q + 1] += p.y; oacc[4 * q + 2] += p.z; oacc[4 * q + 3] += p.w; }
    }
    asm volatile("" : "+s"(row)); const int lane2 = lane_id();
    const f32x4* x2 = (const f32x4*)((const float*)(ws + WS_X2) + (size_t)row * DM) + lane2;
    f32x4 xv[4]; float ss = 0.f;
#pragma unroll
    for (int q = 0; q < 4; ++q) { xv[q] = x2[64 * q]; xv[q].x += oacc[4 * q]; xv[q].y += oacc[4 * q + 1]; xv[q].z += oacc[4 * q + 2]; xv[q].w += oacc[4 * q + 3]; ss += (xv[q].x * xv[q].x + xv[q].y * xv[q].y) + (xv[q].z * xv[q].z + xv[q].w * xv[q].w); }
    const float r = rsqrtf(wave_sum(ss) * (1.f / DM) + EPS);
    const f32x4* gf = (const f32x4*)((const float*)a.in[I_GFIN]) + lane2;
    f32x4* y = (f32x4*)(row < TP ? a.out + O_YP + (size_t)row * DM : a.out + O_YS + (size_t)(row - TP) * DM) + lane2;
#pragma unroll
    for (int q = 0; q < 4; ++q) { const f32x4 g4 = gf[64 * q]; f32x4 o; o.x = xv[q].x * r * g4.x; o.y = xv[q].y * r * g4.y; o.z = xv[q].z * r * g4.z; o.w = xv[q].w * r * g4.w; y[64 * q] = o; }
}
__device__ __forceinline__ void cand_ij(int c, int& ci, int& cj) {
    if (c < 16) { ci = 0; cj = c; } else if (c < 24) { ci = 1; cj = c - 16; } else if (c < 29) { ci = 2; cj = c - 24; } else if (c < 33) { ci = 3; cj = c - 29; }
    else if (c < 36) { ci = 4; cj = c - 33; } else if (c < 38) { ci = 5; cj = c - 36; } else if (c < 40) { ci = 6; cj = c - 38; } else if (c < 42) { ci = 7; cj = c - 40; } else if (c < 50) { ci = c - 34; cj = 0; } else { ci = 0; cj = 0; }
}
__device__ __forceinline__ void peer_phase(const Frame& F, const Args& a) {
    LAS unsigned* TOPS = (LAS unsigned*)F.lds + F.wave * 256;
    LAS unsigned* CT = (LAS unsigned*)F.lds + 8 * 256 + 4 * 1024;
    if (F.tid < 64) { int ci, cj; cand_ij(F.tid, ci, cj); CT[F.tid] = (unsigned)ci | ((unsigned)cj << 8); }
    __syncthreads();
    const int gw = F.vcu * NWAVES + F.wave, NGW = F.G * NWAVES;
    const int nfull = TA / NGW, rem = TA - nfull * NGW;
#pragma unroll 1
    for (int i = 0; i < nfull; ++i) peer_token<false>(F, a, gw + i * NGW, TOPS, CT, 0, nullptr);
    if (rem == 4 * F.G) {
        __syncthreads();
        peer_token<true>(F, a, nfull * NGW + F.vcu * 4 + (F.wave >> 1), TOPS, CT, F.wave & 1, (LAS float*)F.lds + 8 * 256 + (F.wave >> 1) * 1024);
    } else {
        const int row = gw + nfull * NGW; if (row < TA) peer_token<false>(F, a, row, TOPS, CT, 0, nullptr);
    }
}


template <class EpiS>
__device__ __forceinline__ void skinny_tile(const Frame& F, const bf16* A, int lda, const bf16* Bt, int ldb, int tm, int tn, const EpiS& E) {
    const int lane = F.lane, fr = lane & 15, fq = lane >> 4, w = F.wave, lr = lane >> 3, lc = lane & 7;
    LAS unsigned char* SA = F.lds + w * 16384; LAS unsigned char* SB = SA + 8192;
    const bf16* ag = A + (size_t)(tm * 64 + lr) * lda + w * 128 + 8 * lc;
    const bf16* bg = Bt + (size_t)(tn * 64 + lr) * ldb + w * 128 + 8 * lc;
    f32x4 acc[4][4];
#pragma unroll
    for (int m = 0; m < 4; ++m)
#pragma unroll
        for (int n = 0; n < 4; ++n) acc[m][n] = (f32x4){0.f, 0.f, 0.f, 0.f};
    v4u ar[2][8], br[2][8];
#pragma unroll
    for (int kh = 0; kh < 2; ++kh)
#pragma unroll
        for (int i = 0; i < 8; ++i) { ar[kh][i] = *(const v4u*)(ag + (size_t)(8 * i) * lda + 64 * kh); br[kh][i] = *(const v4u*)(bg + (size_t)(8 * i) * ldb + 64 * kh); }
#pragma unroll
    for (int kh = 0; kh < 2; ++kh) {
#pragma unroll
        for (int i = 0; i < 8; ++i) { const int row = 8 * i + lr; *(LAS v4u*)(SA + row * 128 + ((lc ^ (row & 7)) << 4)) = ar[kh][i]; *(LAS v4u*)(SB + row * 128 + ((lc ^ (row & 7)) << 4)) = br[kh][i]; }
        bf16x8 af[4][2], bfr[4][2];
#pragma unroll
        for (int m = 0; m < 4; ++m)
#pragma unroll
            for (int ks = 0; ks < 2; ++ks) { const int row = 16 * m + fr; const int off = row * 128 + (((4 * ks + fq) ^ (row & 7)) << 4);
                af[m][ks] = *(const LAS bf16x8*)(SA + off); bfr[m][ks] = *(const LAS bf16x8*)(SB + off); }
#pragma unroll
        for (int ks = 0; ks < 2; ++ks)
#pragma unroll
            for (int m = 0; m < 4; ++m)
#pragma unroll
                for (int n = 0; n < 4; ++n) acc[m][n] = __builtin_amdgcn_mfma_f32_16x16x32_bf16(bfr[n][ks], af[m][ks], acc[m][n], 0, 0, 0);
        asm volatile("s_waitcnt lgkmcnt(0)" ::: "memory");
    }
    LAS float* PS = (LAS float*)F.lds + w * 4096;
#pragma unroll
    for (int m = 0; m < 4; ++m)
#pragma unroll
        for (int n = 0; n < 4; ++n) *(LAS f32x4*)(PS + (16 * m + fr) * 64 + 4 * ((4 * n + fq) ^ fr)) = acc[m][n];
    lds_barrier();
    {
        const int row = F.tid >> 3, c8 = (F.tid & 7) * 8; const LAS float* PR = (const LAS float*)F.lds + row * 64;
        const int ch0 = 4 * (((F.tid & 7) * 2) ^ (row & 15)), ch1 = 4 * (((F.tid & 7) * 2 + 1) ^ (row & 15));
        f32x4 s0 = *(const LAS f32x4*)(PR + ch0), s1 = *(const LAS f32x4*)(PR + ch1);
#pragma unroll
        for (int ww = 1; ww < 8; ++ww) { s0 += *(const LAS f32x4*)(PR + ww * 4096 + ch0); s1 += *(const LAS f32x4*)(PR + ww * 4096 + ch1); }
        float v[8] = {s0.x, s0.y, s0.z, s0.w, s1.x, s1.y, s1.z, s1.w};
        E(tm * 64 + row, tn * 64 + c8, v, F.tid);
    }
    lds_barrier();
}
struct EpiSk {
    float* d32; int ld32; bf16* d16; int ld16; float sc16;
    const float* res; int ldr;
    const float* gcol; float* ssq; const float* rsq;
    __device__ __forceinline__ void operator()(int row, int col, float (&v)[8], int tid) const {
        if (rsq) { const float rs = rsqrtf(rsq[row] * (1.f / 1024.f) + EPS);
#pragma unroll
            for (int i = 0; i < 8; ++i) v[i] *= rs; }
        if (res) { const f32x4 a = *(const f32x4*)(res + (size_t)row * ldr + col), b = *(const f32x4*)(res + (size_t)row * ldr + col + 4);
            v[0] += a.x; v[1] += a.y; v[2] += a.z; v[3] += a.w; v[4] += b.x; v[5] += b.y; v[6] += b.z; v[7] += b.w; }
        if (d32) { *(f32x4*)(d32 + (size_t)row * ld32 + col) = (f32x4){v[0], v[1], v[2], v[3]}; *(f32x4*)(d32 + (size_t)row * ld32 + col + 4) = (f32x4){v[4], v[5], v[6], v[7]}; }
        if (ssq) { float ss = 0.f;
#pragma unroll
            for (int i = 0; i < 8; ++i) ss += v[i] * v[i];
            ss = sum8_f32(ss);
            if ((tid & 7) == 0) atomicAdd(ssq + row, ss); }
        if (d16) { float w8[8];
#pragma unroll
            for (int i = 0; i < 8; ++i) w8[i] = v[i];
            if (gcol) { const f32x4 a = *(const f32x4*)(gcol + col), b = *(const f32x4*)(gcol + col + 4); w8[0] *= a.x; w8[1] *= a.y; w8[2] *= a.z; w8[3] *= a.w; w8[4] *= b.x; w8[5] *= b.y; w8[6] *= b.z; w8[7] *= b.w; }
            v4u o; o.x = pg8::cvt_pk_bf16(w8[0] * sc16, w8[1] * sc16); o.y = pg8::cvt_pk_bf16(w8[2] * sc16, w8[3] * sc16); o.z = pg8::cvt_pk_bf16(w8[4] * sc16, w8[5] * sc16); o.w = pg8::cvt_pk_bf16(w8[6] * sc16, w8[7] * sc16);
            *(v4u*)(d16 + (size_t)row * ld16 + col) = o; }
    }
};

#define SK_TM16(t) (4 * (((t) >> 5) >> 1) + (((t) & 31) >> 3))
#define SK_TN16(t) (8 * (((t) >> 5) & 1) + ((t) & 7))
#define SK_TM32(t) (4 * ((((t) & 255) >> 5) >> 1) + ((((t) & 31) + 32 * ((t) >> 8)) >> 4))
#define SK_TN32(t) (16 * ((((t) & 255) >> 5) & 1) + ((((t) & 31) + 32 * ((t) >> 8)) & 15))


#ifndef PH_MAX
#define PH_MAX 99
#endif
__global__ void __launch_bounds__(NTHR, 2) mega_fwd(Args args) {
    extern __shared__ __attribute__((aligned(16))) unsigned char lds_raw[];
    Frame F;
    F.lds = (LAS unsigned char*)lds_raw;
    F.wave = __builtin_amdgcn_readfirstlane((int)threadIdx.x >> 6); F.lane = lane_id(); F.tid = F.wave * 64 + F.lane;
    F.G = gridDim.x; { const int bx = blockIdx.x; F.vcu = (F.G % 8 == 0) ? (bx % 8) * (F.G / 8) + bx / 8 : bx; }
    volatile LAS unsigned* MISC = (volatile LAS unsigned*)(F.lds + MISC_OFF);
    LAS unsigned long long* ARGP = (LAS unsigned long long*)(F.lds + ARGS_OFF);
    for (int u = F.tid; u < (LDS_BYTES - LDSCTL_OFF) / 4; u += NTHR) ((LAS unsigned*)(F.lds + LDSCTL_OFF))[u] = 0u;
    __syncthreads();
    if (F.tid == 0) {
        ARGP[0] = (unsigned long long)args.in[0];
        ARGP[1] = (unsigned long long)args.in[1];
        ARGP[2] = (unsigned long long)args.in[2];
        ARGP[3] = (unsigned long long)args.in[3];
        ARGP[4] = (unsigned long long)args.in[4];
        ARGP[5] = (unsigned long long)args.in[5];
        ARGP[6] = (unsigned long long)args.in[6];
        ARGP[7] = (unsigned long long)args.in[7];
        ARGP[8] = (unsigned long long)args.in[8];
        ARGP[9] = (unsigned long long)args.in[9];
        ARGP[10] = (unsigned long long)args.in[10];
        ARGP[11] = (unsigned long long)args.in[11];
        ARGP[12] = (unsigned long long)args.in[12];
        ARGP[13] = (unsigned long long)args.in[13];
        ARGP[14] = (unsigned long long)args.in[14];
        ARGP[15] = (unsigned long long)args.in[15];
        ARGP[16] = (unsigned long long)args.in[16];
        ARGP[17] = (unsigned long long)args.in[17];
        ARGP[18] = (unsigned long long)args.in[18];
        ARGP[19] = (unsigned long long)args.in[19];
        ARGP[20] = (unsigned long long)args.in[20];
        ARGP[21] = (unsigned long long)args.in[21];
        ARGP[22] = (unsigned long long)args.in[22];
        ARGP[23] = (unsigned long long)args.in[23];
        ARGP[24] = (unsigned long long)args.in[24];
        ARGP[25] = (unsigned long long)args.in[25];
        ARGP[26] = (unsigned long long)args.in[26];
        ARGP[27] = (unsigned long long)args.in[27];
        ARGP[28] = (unsigned long long)args.in[28];
        ARGP[N_INPUTS] = (unsigned long long)args.out; ARGP[N_INPUTS + 1] = (unsigned long long)args.ws;
    }
    __syncthreads();
    { const XcdBarrier bar0 = xcd_barrier_post((unsigned*)((gu32*)(args.ws + WS_CTL) + CW_BAR), MISC + 8, F.wave); if (F.tid == 0) MISC[10] = bar0.x; }
    __syncthreads();
#define GRID_BAR() do { XcdBarrier bar_; bar_.bar = (unsigned*)((gu32*)((unsigned char*)ld_ptr(ARGP + N_INPUTS + 1) + WS_CTL) + CW_BAR); bar_.x = MISC[10]; bar_.st = MISC + 8; bar_.wave = F.wave; xcd_barrier(bar_); } while (0)
#define PHASE_ARGS const Args A = load_args(ARGP); unsigned char* const ws = A.ws; float* const out = A.out; (void)ws; (void)out; { int l_ = lane_id(); asm volatile("" : "+v"(l_)); F.lane = l_; F.tid = F.wave * 64 + l_; }

    { PHASE_ARGS;
    p0_prologue(F, A);
    }
    GRID_BAR();
#if defined(PROBE_BAR8)
    GRID_BAR(); GRID_BAR(); GRID_BAR(); GRID_BAR(); GRID_BAR(); GRID_BAR(); GRID_BAR(); GRID_BAR();
#endif
#if PH_MAX >= 1
    { PHASE_ARGS;
    {
        pg8::Gemm g{(const bf16*)(ws + WS_HB), (const bf16*)(ws + WS_WIN), DM, DM, DM};
        pg8::StaticOrder S; S.init(TA, N_IN, F.G, (int)blockIdx.x);
        EpiInProj E{out, ws, (const float*)A.in[I_BFF]};
        pg8::gemm_phase(F.lds, g, S, E, F.wave);
    }
    {
        const int off = (TA / 256) * (N_IN / 256) % F.G;
        pg8::Gemm g{(const bf16*)(ws + WS_MB), (const bf16*)(ws + WS_WMK), DM, DM, DM};
        pg8::StaticOrder S; S.init(512, DM, F.G, ((int)blockIdx.x + F.G - off) % F.G);
        EpiGen E{out + O_MKP, DM, (bf16*)(ws + WS_MK16), DM, 1.f, nullptr, nullptr, 0, 0, nullptr, nullptr, nullptr};
        pg8::gemm_phase(F.lds, g, S, E, F.wave);
    }
    {
        const int off = ((TA / 256) * (N_IN / 256) + 8) % F.G;
        pg8::Gemm g{(const bf16*)(ws + WS_MB), (const bf16*)(ws + WS_WMV), DM, DM, DM};
        pg8::StaticOrder S; S.init(512, DM, F.G, ((int)blockIdx.x + F.G - off) % F.G);
        EpiGen E{out + O_MVP, DM, nullptr, 0, 1.f, nullptr, nullptr, 0, 0, nullptr, nullptr, nullptr};
        pg8::gemm_phase(F.lds, g, S, E, F.wave);
    }
    {
        const int off = ((TA / 256) * (N_IN / 256) + 16) % F.G;
        pg8::Gemm g{(const bf16*)(ws + WS_WMV), (const bf16*)(ws + WS_MB), DM, DM, DM};
        pg8::StaticOrder S; S.init(DM, 512, F.G, ((int)blockIdx.x + F.G - off) % F.G);
        EpiGen E{nullptr, 0, (bf16*)(ws + WS_MVT16), 512, 1.f, nullptr, nullptr, 0, 0, nullptr, nullptr, nullptr};
        pg8::gemm_phase(F.lds, g, S, E, F.wave);
    }
    }
    GRID_BAR();
#endif
#if PH_MAX >= 2
    asm volatile("; ===PHASE 2===");
    { PHASE_ARGS;
    {
        const int gw = F.vcu * NWAVES + F.wave, NGW = F.G * NWAVES;
        if ((gw & 3) == 0) for (int it = gw >> 2; it < 512; it += NGW >> 2) fox_norms_item(F, (const bf16*)(ws + WS_QF), (const bf16*)(ws + WS_KF), out + O_LFP, (float*)(ws + WS_MISC + MiB), (float*)(ws + WS_KBIAS), (float*)(ws + WS_MISC + MiB + 65536), it);
        for (int it = gw; it < NB_S * NPAGES; it += NGW) fox_suffix_item(F, (const float*)A.in[I_CFL], (const int*)A.in[I_PT], (float*)(ws + WS_SUF), (float*)(ws + WS_MISC + 2 * MiB), it);
        for (int u = F.vcu; u < 1024; u += F.G) gla_g1_unit(F, A, u);
        for (int u = F.vcu; u < 512; u += F.G) gla_sample_unit(F, A, u);
    }
    }
    GRID_BAR();
#endif
#if PH_MAX >= 3
    asm volatile("; ===PHASE 3===");
    { PHASE_ARGS;
    gla_scan(F, A);
    __syncthreads();
    for (int i = F.vcu; i < 256; i += F.G) { const int bh = i >> 4, s = i & 15;
        fox_attn_unit(F, (const bf16*)(ws + WS_QF), (const bf16*)(ws + WS_KF), (const bf16*)(ws + WS_VF), (const float*)(ws + WS_KBIAS), (const float*)(ws + WS_MISC + MiB + 65536), (const float*)(ws + WS_MISC + MiB), (bf16*)(ws + WS_MERGED), bh >> 3, bh & 7, s);
        fox_attn_unit(F, (const bf16*)(ws + WS_QF), (const bf16*)(ws + WS_KF), (const bf16*)(ws + WS_VF), (const float*)(ws + WS_KBIAS), (const float*)(ws + WS_MISC + MiB + 65536), (const float*)(ws + WS_MISC + MiB), (bf16*)(ws + WS_MERGED), bh >> 3, bh & 7, 31 - s); }
    }
    GRID_BAR();
#endif
#if PH_MAX >= 4
    asm volatile("; ===PHASE 4===");
    { PHASE_ARGS;
    if (!(F.vcu & 1)) { for (int u = F.vcu; u < 1024; u += F.G) gla_g3_unit(F, A, u); }
    }
    { PHASE_ARGS;
    for (int u = F.vcu; u < 1024; u += F.G) fox_sample_unit(F, A, u);
    }
    { PHASE_ARGS;
    if (F.vcu & 1) { for (int u = F.vcu; u < 1024; u += F.G) gla_g3_unit(F, A, u); }
    }
    GRID_BAR();
#endif
#if PH_MAX >= 5
    asm volatile("; ===PHASE 5===");
    { PHASE_ARGS;
    {
        pg8::Gemm g{(const bf16*)(ws + WS_MERGED), (const bf16*)(ws + WS_WOUT), DM, DM, DM};
        pg8::StaticOrder S; S.init(TP, DM, F.G, (int)blockIdx.x);
        EpiGen E{(float*)(ws + WS_X1), DM, (bf16*)(ws + WS_HB), DM, 1.f, (const float*)A.in[I_XP], (const float*)A.in[I_XS], TP, DM, (const float*)A.in[I_GCROSS], (float*)(ws + WS_SS), nullptr};
        pg8::gemm_phase(F.lds, g, S, E, F.wave);
        __syncthreads();
        EpiSk Es{(float*)(ws + WS_X1) + (size_t)TP * DM, DM, (bf16*)(ws + WS_HB) + (size_t)TP * DM, DM, 1.f, (const float*)A.in[I_XS], DM, (const float*)A.in[I_GCROSS], (float*)(ws + WS_SS) + TP, nullptr};
        for (int t = F.vcu; t < 256; t += F.G) skinny_tile(F, (const bf16*)(ws + WS_MERGED) + (size_t)TP * DM, DM, (const bf16*)(ws + WS_WOUT), DM, SK_TM16(t), SK_TN16(t), Es);
    }
    }
    GRID_BAR();
#endif
#if PH_MAX >= 7
    asm volatile("; ===PHASE 7===");
    { PHASE_ARGS;
    {
        pg8::Gemm g{(const bf16*)(ws + WS_HB), (const bf16*)(ws + WS_WCQ), DM, DM, DM};
        pg8::StaticOrder S; S.init(TP, DM, F.G, (int)blockIdx.x);
        EpiGen E{nullptr, 0, (bf16*)(ws + WS_QC), DM, C2C, nullptr, nullptr, 0, 0, nullptr, nullptr, (const float*)(ws + WS_SS)};
        pg8::gemm_phase(F.lds, g, S, E, F.wave);
        __syncthreads();
        EpiSk Es{nullptr, 0, (bf16*)(ws + WS_QC) + (size_t)TP * DM, DM, C2C, nullptr, 0, nullptr, nullptr, (const float*)(ws + WS_SS) + TP};
        for (int t = F.vcu; t < 256; t += F.G) skinny_tile(F, (const bf16*)(ws + WS_HB) + (size_t)TP * DM, DM, (const bf16*)(ws + WS_WCQ), DM, SK_TM16(t), SK_TN16(t), Es);
    }
    }
    GRID_BAR();
#endif
#if PH_MAX >= 8
    asm volatile("; ===PHASE 8===");
    { PHASE_ARGS;
    {
        const int u = (int)blockIdx.x, b = (u >> 7) & 1, h = (u >> 5) & 3, pnl = u & 31;
        const size_t roff = ((size_t)b * SEQ + pnl * 256) * DM + h * 256;
        if (F.vcu & 1) { for (int v = F.vcu; v < 512; v += F.G) cross_sample_unit(F, A, v); }
        pg8::Gemm g{(const bf16*)(ws + WS_QC) + roff, (const bf16*)(ws + WS_MK16) + (size_t)(b * 256) * DM + h * 256, DM, DM, 256};
        pg8::SingleUnit S{u < 256 ? 1 : 0, {0, 0}};
        EpiSoftmaxP E{ARGP};
        pg8::gemm_phase(F.lds, g, S, E, F.wave);
        VM_WAIT(); __syncthreads();
        {
            pg8::Gemm g2{(const bf16*)(ws + WS_PC) + roff, (const bf16*)(ws + WS_MVT16) + (size_t)(h * 256) * 512 + b * 256, DM, 512, 256};
            EpiGen E2{nullptr, 0, (bf16*)(ws + WS_OC) + roff, DM, 1.f, nullptr, nullptr, 0, 0, nullptr, nullptr, nullptr};
            pg8::gemm_phase(F.lds, g2, S, E2, F.wave);
        }
        __syncthreads();
        if (!(F.vcu & 1)) { for (int v = F.vcu; v < 512; v += F.G) cross_sample_unit(F, A, v); }
    }
    }
    GRID_BAR();
#endif
#if PH_MAX >= 10
    asm volatile("; ===PHASE 10===");
    { PHASE_ARGS;
    {
        pg8::Gemm g{(const bf16*)(ws + WS_OC), (const bf16*)(ws + WS_WCO), DM, DM, DM};
        pg8::StaticOrder S; S.init(TP, DM, F.G, (int)blockIdx.x);
        EpiGen E{(float*)(ws + WS_X2), DM, (bf16*)(ws + WS_HB), DM, 1.f, (const float*)(ws + WS_X1), (const float*)(ws + WS_X1), TA, DM, (const float*)A.in[I_GFFN], (float*)(ws + WS_SS) + TA, nullptr};
        pg8::gemm_phase(F.lds, g, S, E, F.wave);
        __syncthreads();
        EpiSk Es{(float*)(ws + WS_X2) + (size_t)TP * DM, DM, (bf16*)(ws + WS_HB) + (size_t)TP * DM, DM, 1.f, (const float*)(ws + WS_X1) + (size_t)TP * DM, DM, (const float*)A.in[I_GFFN], (float*)(ws + WS_SS) + TA + TP, nullptr};
        for (int t = F.vcu; t < 256; t += F.G) skinny_tile(F, (const bf16*)(ws + WS_OC) + (size_t)TP * DM, DM, (const bf16*)(ws + WS_WCO), DM, SK_TM16(t), SK_TN16(t), Es);
    }
    }
    GRID_BAR();
#endif
#if PH_MAX >= 12
    asm volatile("; ===PHASE 12===");
    { PHASE_ARGS;
    {
        pg8::Gemm g{(const bf16*)(ws + WS_HB), (const bf16*)(ws + WS_WPK), DM, DM, DM};
        pg8::StaticOrder S; S.init(TP, 2048, F.G, (int)blockIdx.x);
        EpiGen E{nullptr, 0, (bf16*)(ws + WS_SC), 2048, 1.f, nullptr, nullptr, 0, 0, nullptr, nullptr, (const float*)(ws + WS_SS) + TA};
        pg8::gemm_phase(F.lds, g, S, E, F.wave);
        __syncthreads();
        EpiSk Es{nullptr, 0, (bf16*)(ws + WS_SC) + (size_t)TP * 2048, 2048, 1.f, nullptr, 0, nullptr, nullptr, (const float*)(ws + WS_SS) + TA + TP};
        for (int t = F.vcu; t < 512; t += F.G) skinny_tile(F, (const bf16*)(ws + WS_HB) + (size_t)TP * DM, DM, (const bf16*)(ws + WS_WPK), DM, SK_TM32(t), SK_TN32(t), Es);
    }
    }
    GRID_BAR();
#endif
#if PH_MAX >= 13
    asm volatile("; ===PHASE 13===");
    { PHASE_ARGS;
    peer_phase(F, A);
    }
#endif
#if PH_MAX < 13
    {   PHASE_ARGS;
        const int gw = F.vcu * NWAVES + F.wave, NGW = F.G * NWAVES;
        for (int m = gw; m < TA; m += NGW) {
            const float* x = m < TP ? (const float*)A.in[I_XP] + (size_t)m * DM : (const float*)A.in[I_XS] + (size_t)(m - TP) * DM;
            float* y = m < TP ? out + O_YP + (size_t)m * DM : out + O_YS + (size_t)(m - TP) * DM;
            for (int j = 0; j < 4; ++j) ((f32x4*)y)[F.lane + 64 * j] = ((const f32x4*)x)[F.lane + 64 * j];
        }
    }
#endif

}

extern "C" void kernel_launch(void* const* d_in, const int* in_sizes, int n_in, void* d_out, int out_size, void* d_ws, size_t ws_size, hipStream_t stream) {
    static int grid = 0;
    if (grid == 0) {
        if (n_in != N_INPUTS || (size_t)out_size != O_TOTAL || ws_size < WS_END) { fprintf(stderr, "kernel_launch: unexpected shapes (n_in %d out %d ws %zu)\n", n_in, out_size, ws_size); grid = -1; return; }
        int dev = 0, cus = 0, per_cu = 0;
        if (hipGetDevice(&dev) != hipSuccess || hipDeviceGetAttribute(&cus, hipDeviceAttributeMultiprocessorCount, dev) != hipSuccess) { grid = -1; return; }
        if (hipFuncSetAttribute((const void*)mega_fwd, hipFuncAttributeMaxDynamicSharedMemorySize, LDS_BYTES) != hipSuccess) { fprintf(stderr, "kernel_launch: hipFuncSetAttribute failed\n"); grid = -1; return; }
        if (hipOccupancyMaxActiveBlocksPerMultiprocessor(&per_cu, (const void*)mega_fwd, NTHR, LDS_BYTES) != hipSuccess || per_cu < 1)
            fprintf(stderr, "kernel_launch: occupancy query reports %d workgroups per CU\n", per_cu);
        (void)hipGetLastError();
        grid = cus;
        if (grid > 256) grid = 256;
    }
    if (grid < 0) return;
    if (hipMemsetAsync((char*)d_ws + WS_CTL, 0, CTL_ZERO_BYTES, stream) != hipSuccess) return;
    Args a{};
    for (int i = 0; i < N_INPUTS; ++i) a.in[i] = d_in[i];
    a.out = (float*)d_out; a.ws = (unsigned char*)d_ws;
    hipLaunchKernelGGL(mega_fwd, dim3(grid), dim3(NTHR), LDS_BYTES, stream, a);
    const hipError_t le = hipPeekAtLastError();
    if (le != hipSuccess) fprintf(stderr, "kernel_launch: launch failed: %s\n", hipGetErrorName(le));
}
```

```cpp
#define PH_MAX 13
#include <hip/hip_runtime.h>
#include <cstdio>
#include <cstdint>

namespace pg8 {
#define PG8_LAS __attribute__((address_space(3)))
typedef unsigned short bf16_t;
typedef short bf16x8 __attribute__((ext_vector_type(8)));
typedef float f32x4 __attribute__((ext_vector_type(4)));
typedef unsigned u32x4 __attribute__((ext_vector_type(4)));
typedef unsigned u32x2 __attribute__((ext_vector_type(2)));
constexpr int BM = 256, BK = 64, HALF = 128, HTB = HALF * BK * 2  , STAGE_BYTES = 8 * HTB, NXCD = 8, WGM = 8;

__host__ __device__ __forceinline__ int lds_byte(int r, int c) { const int st = (r >> 4) * 2 + (c >> 5), rr = r & 15, cc = c & 31, ob = rr * 64 + cc * 2; return st * 1024 + (ob ^ (((ob >> 9) & 1) << 5)); }
__host__ __device__ __forceinline__ void stage_rc(int b, int& R, int& C) { const int st = b / 1024, sb = b % 1024, swz = sb ^ (((sb >> 9) & 1) << 5); R = (st >> 1) * 16 + swz / 64; C = (st & 1) * 32 + (swz % 64) / 2; }

__host__ __device__ __forceinline__ int perm32(int rho) { const int n = rho >> 4, i = rho & 15; return 8 * (i >> 2) + 4 * n + (i & 3); }

struct Unit { int pm, pn; };
struct Gemm { const bf16_t* A; const bf16_t* Bt; int lda, ldb, K; };

struct StaticOrder {
    int nM, nN, nwg, G, c;
    __host__ __device__ void init(int M, int N, int G_, int c_) { nM = M / BM; nN = N / BM; nwg = nM * nN; G = G_; c = c_; }
    __host__ __device__ bool next(int i, Unit& u) const {
        const long L = (long)i * G + c; if (L >= nwg) return false;
        int wgid = (int)L; { const int q = nwg / NXCD, r = nwg % NXCD, xcd = wgid % NXCD, off = wgid / NXCD; wgid = (xcd < r ? xcd * (q + 1) : r * (q + 1) + (xcd - r) * q) + off; }
        const int nig = WGM * nN, gid = wgid / nig, fm = gid * WGM, gsz = (nM - fm) < WGM ? (nM - fm) : WGM;
        u.pm = fm + ((wgid % nig) % gsz); u.pn = (wgid % nig) / gsz; return true;
    }
};
struct SingleUnit {
    int has; Unit u0;
    __host__ __device__ bool next(int i, Unit& u) const { if (i != 0 || !has) return false; u = u0; return true; }
};

__device__ __forceinline__ unsigned cvt_pk_bf16(float lo, float hi) { unsigned r; asm volatile("v_cvt_pk_bf16_f32 %0, %1, %2" : "=v"(r) : "v"(lo), "v"(hi)); return r; }

template <class Epi, class Sched>
__device__ __forceinline__ void gemm_phase(PG8_LAS unsigned char* lds, const Gemm g, const Sched& S, const Epi& E, int wave_id) {
    int lane; asm volatile("v_mbcnt_lo_u32_b32 %0, -1, 0\n\tv_mbcnt_hi_u32_b32 %0, -1, %0" : "=v"(lane));
    const int wid = wave_id; const int tid = wid * 64 + lane; const int wr = wid >> 2, wc = wid & 3, fr = lane & 15, fq = lane >> 4;
    const int K = g.K, nt = K / BK;
    unsigned voffA[2], voffB[2];
#pragma unroll
    for (int i = 0; i < 2; ++i) { int R, C; stage_rc(tid * 16 + i * 8192, R, C);
        const int Rb = Epi::PERM ? ((R & ~31) + perm32(R & 31)) : R;
        voffA[i] = (unsigned)(R * g.lda + C) * 2u; voffB[i] = (unsigned)(Rb * g.ldb + C) * 2u; }
    const size_t kstep = (size_t)(BK * 2);
    const size_t hstepA = (size_t)HALF * g.lda * 2, hstepB = (size_t)HALF * g.ldb * 2;
    const size_t tstepA = 2 * hstepA, tstepB = 2 * hstepB;
    const unsigned ldsw = (unsigned)wid * 1024u;
    const int aoff = lds_byte(wr * 64 + fr, fq * 8), boff = lds_byte(wc * 32 + fr, fq * 8);
#define PG8_SA(b, h) (((b) * 2 + (h)) * HTB)
#define PG8_SB(b, h) ((4 + (b) * 2 + (h)) * HTB)
#define PG8_STAGE(bufoff, gbase, voff) do { _Pragma("unroll") for (int _i = 0; _i < 2; ++_i) \
        __builtin_amdgcn_global_load_lds((const unsigned*)((const char*)(gbase) + (voff)[_i]), (PG8_LAS unsigned*)(lds + (bufoff) + ldsw + _i * 8192), 16, 0, 0); } while (0)
#define PG8_LDA(dst, b, h) do { _Pragma("unroll") for (int m = 0; m < 4; ++m) _Pragma("unroll") for (int k = 0; k < 2; ++k) dst[m][k] = *(const PG8_LAS bf16x8*)(lds + PG8_SA(b, h) + aoff + m * 2048 + k * 1024); } while (0)
#define PG8_LDB(dst, b, h) do { _Pragma("unroll") for (int n = 0; n < 2; ++n) _Pragma("unroll") for (int k = 0; k < 2; ++k) dst[n][k] = *(const PG8_LAS bf16x8*)(lds + PG8_SB(b, h) + boff + n * 2048 + k * 1024); } while (0)
#define PG8_MMA(ai, bj, At, Bt) do { __builtin_amdgcn_s_setprio(1); _Pragma("unroll") for (int m = 0; m < 4; ++m) _Pragma("unroll") for (int n = 0; n < 2; ++n) _Pragma("unroll") for (int k = 0; k < 2; ++k) \
        acc[ai][bj][m][n] = __builtin_amdgcn_mfma_f32_16x16x32_bf16(Bt[n][k], At[m][k], acc[ai][bj][m][n], 0, 0, 0); __builtin_amdgcn_s_setprio(0); } while (0)
#define PG8_WAIT_V(n) asm volatile("s_waitcnt vmcnt(" #n ")" ::: "memory")
#define PG8_WAIT_L(n) asm volatile("s_waitcnt lgkmcnt(" #n ")" ::: "memory")
#define PG8_BAR __builtin_amdgcn_s_barrier()
#define PG8_SCHED __builtin_amdgcn_sched_barrier(0)
    Unit cur, nxt; int ui = 0;
    if (!S.next(0, cur)) return;
    f32x4 acc[2][2][4][2];
#pragma unroll
    for (int a = 0; a < 2; ++a)
#pragma unroll
        for (int b = 0; b < 2; ++b)
#pragma unroll
            for (int m = 0; m < 4; ++m)
#pragma unroll
                for (int n = 0; n < 2; ++n) acc[a][b][m][n] = (f32x4){0.f, 0.f, 0.f, 0.f};
    bf16x8 At[4][2], B0[2][2], B1[2][2];
    const char* cA = (const char*)g.A + (size_t)cur.pm * tstepA; const char* cB = (const char*)g.Bt + (size_t)cur.pn * tstepB;
    PG8_STAGE(PG8_SB(0, 0), cB, voffB); PG8_STAGE(PG8_SB(0, 1), cB + hstepB, voffB); PG8_STAGE(PG8_SA(0, 0), cA, voffA); PG8_STAGE(PG8_SA(0, 1), cA + hstepA, voffA);
    if (wr == 1) PG8_BAR;
    PG8_WAIT_V(2); PG8_BAR;
    PG8_STAGE(PG8_SB(1, 0), cB + kstep, voffB); PG8_STAGE(PG8_SA(1, 0), cA + kstep, voffA); PG8_STAGE(PG8_SB(1, 1), cB + hstepB + kstep, voffB);
    PG8_WAIT_V(6); PG8_BAR;
    for (;;) {
        const bool has_next = S.next(ui + 1, nxt);
        const char* nA = has_next ? (const char*)g.A + (size_t)nxt.pm * tstepA : cA; const char* nB = has_next ? (const char*)g.Bt + (size_t)nxt.pn * tstepB : cB;
        for (int t = 0; t < nt; t += 2) {
            const bool last = (t == nt - 2);
            const char* a1 = cA + (size_t)(t + 1) * kstep;
            const char* a2 = last ? nA : cA + (size_t)(t + 2) * kstep; const char* b2 = last ? nB : cB + (size_t)(t + 2) * kstep;
            const char* a3 = a2 + kstep; const char* b3 = b2 + kstep;
            PG8_LDB(B0, 0, 0); PG8_LDB(B1, 0, 1); PG8_SCHED; PG8_LDA(At, 0, 0); PG8_STAGE(PG8_SA(1, 1), a1 + hstepA, voffA);
            PG8_WAIT_V(8); PG8_WAIT_L(0); PG8_BAR; PG8_MMA(0, 0, At, B0); PG8_MMA(0, 1, At, B1); PG8_BAR; PG8_SCHED;
            PG8_LDA(At, 0, 1); PG8_STAGE(PG8_SB(0, 0), b2, voffB); PG8_STAGE(PG8_SB(0, 1), b2 + hstepB, voffB); PG8_STAGE(PG8_SA(0, 0), a2, voffA);
            PG8_WAIT_V(8); PG8_WAIT_L(0); PG8_BAR; PG8_MMA(1, 0, At, B0); PG8_MMA(1, 1, At, B1); PG8_BAR; PG8_SCHED;
            PG8_LDB(B0, 1, 0); PG8_LDB(B1, 1, 1); PG8_SCHED; PG8_LDA(At, 1, 0); PG8_STAGE(PG8_SA(0, 1), a2 + hstepA, voffA);
            PG8_WAIT_V(8); PG8_WAIT_L(0); PG8_BAR; PG8_MMA(0, 0, At, B0); PG8_MMA(0, 1, At, B1); PG8_BAR; PG8_SCHED;
            PG8_LDA(At, 1, 1); PG8_STAGE(PG8_SB(1, 0), b3, voffB); PG8_STAGE(PG8_SB(1, 1), b3 + hstepB, voffB); PG8_STAGE(PG8_SA(1, 0), a3, voffA);
            PG8_WAIT_V(8); PG8_WAIT_L(0); PG8_BAR; PG8_MMA(1, 0, At, B0); PG8_MMA(1, 1, At, B1); PG8_BAR; PG8_SCHED;
        }
        if (wr == 0) PG8_BAR;
        if constexpr (!Epi::AFTER_DRAIN) { E(acc, cur, wr, wc, fr, fq); }
        if (!has_next) break;
#pragma unroll
        for (int a = 0; a < 2; ++a)
#pragma unroll
            for (int b = 0; b < 2; ++b)
#pragma unroll
                for (int m = 0; m < 4; ++m)
#pragma unroll
                    for (int n = 0; n < 2; ++n) acc[a][b][m][n] = (f32x4){0.f, 0.f, 0.f, 0.f};
        cur = nxt; cA = nA; cB = nB; ++ui;
        if (wr == 1) PG8_BAR;
    }
    PG8_WAIT_V(0);
    PG8_BAR;
    if constexpr (Epi::AFTER_DRAIN) { E.fused(acc, cur, wr, wc, fr, fq, lds, wid, lane); }
#undef PG8_SA
#undef PG8_SB
#undef PG8_STAGE
#undef PG8_LDA
#undef PG8_LDB
#undef PG8_MMA
#undef PG8_WAIT_V
#undef PG8_WAIT_L
#undef PG8_BAR
#undef PG8_SCHED
}
}

#define GAS __attribute__((address_space(1)))
#define LAS __attribute__((address_space(3)))
typedef unsigned short bf16;
typedef unsigned v4u __attribute__((ext_vector_type(4)));
typedef unsigned v2u __attribute__((ext_vector_type(2)));
typedef float f32x4 __attribute__((ext_vector_type(4)));
typedef float f32x2 __attribute__((ext_vector_type(2)));
typedef float f32x16 __attribute__((ext_vector_type(16)));
typedef short bf16x8 __attribute__((ext_vector_type(8)));
typedef short s16x4 __attribute__((ext_vector_type(4)));
typedef GAS unsigned gu32;
#define RLX_AGENT __ATOMIC_RELAXED, __HIP_MEMORY_SCOPE_AGENT
#define LDS_WAIT() asm volatile("s_waitcnt lgkmcnt(0)" ::: "memory")
#define VM_WAIT() asm volatile("s_waitcnt vmcnt(0)" ::: "memory")
__device__ __forceinline__ unsigned f2bf(float f) { unsigned u = __builtin_bit_cast(unsigned, f); return (u + 0x7fffu + ((u >> 16) & 1u)) >> 16; }
__device__ __forceinline__ unsigned pk2(float lo, float hi) { return f2bf(lo) | (f2bf(hi) << 16); }
__device__ __forceinline__ float bf2f(unsigned short b) { return __builtin_bit_cast(float, (unsigned)b << 16); }
__device__ __forceinline__ float bflo(unsigned u) { return __builtin_bit_cast(float, u << 16); }
__device__ __forceinline__ float bfhi(unsigned u) { return __builtin_bit_cast(float, u & 0xffff0000u); }


typedef short v4i16_t __attribute__((ext_vector_type(4)));
__device__ __forceinline__ s16x4 lds_tr16(LAS unsigned char* p) { return __builtin_bit_cast(s16x4, __builtin_amdgcn_ds_read_tr16_b64_v4i16((LAS v4i16_t*)p)); }
__device__ __forceinline__ int crow(int r, int hi) { return (r & 3) + 8 * (r >> 2) + 4 * hi; }

#define DPP_I(v, ctrl) __builtin_amdgcn_update_dpp(0, (v), (ctrl), 0xF, 0xF, false)
#define DPP_F(v, ctrl) __builtin_bit_cast(float, __builtin_amdgcn_update_dpp(0, __builtin_bit_cast(int, (v)), (ctrl), 0xF, 0xF, false))
constexpr int DPP_X1 = 0xB1, DPP_X2 = 0x4E, DPP_HMIR = 0x141, DPP_MIR = 0x140;
__device__ __forceinline__ unsigned max16_u32(unsigned v) {
    unsigned t = (unsigned)DPP_I((int)v, DPP_X1); v = v > t ? v : t; t = (unsigned)DPP_I((int)v, DPP_X2); v = v > t ? v : t;
    t = (unsigned)DPP_I((int)v, DPP_HMIR); v = v > t ? v : t; t = (unsigned)DPP_I((int)v, DPP_MIR); v = v > t ? v : t; return v; }
__device__ __forceinline__ float sum8_f32(float v) { v += DPP_F(v, DPP_X1); v += DPP_F(v, DPP_X2); v += DPP_F(v, DPP_HMIR); return v; }
__device__ __forceinline__ float sum16_f32(float v) { v = sum8_f32(v); v += DPP_F(v, DPP_MIR); return v; }
__device__ __forceinline__ float max16_f32(float v) { v = fmaxf(v, DPP_F(v, DPP_X1)); v = fmaxf(v, DPP_F(v, DPP_X2)); v = fmaxf(v, DPP_F(v, DPP_HMIR)); v = fmaxf(v, DPP_F(v, DPP_MIR)); return v; }
__device__ __forceinline__ float xor16_f32(float v) { return __builtin_bit_cast(float, __builtin_amdgcn_ds_swizzle(__builtin_bit_cast(int, v), 0x1F | (16 << 10))); }
__device__ __forceinline__ float sum64_f32(float v) {
    v = sum16_f32(v); v += xor16_f32(v);
    return __builtin_bit_cast(float, __builtin_amdgcn_readlane(__builtin_bit_cast(int, v), 0)) + __builtin_bit_cast(float, __builtin_amdgcn_readlane(__builtin_bit_cast(int, v), 32)); }
template <int J> __device__ __forceinline__ unsigned xchg_xor_u32(unsigned v) {
    if constexpr (J == 1) return (unsigned)DPP_I((int)v, DPP_X1);
    else if constexpr (J == 2) return (unsigned)DPP_I((int)v, DPP_X2);
    else return (unsigned)__builtin_amdgcn_ds_swizzle((int)v, 0x1F | (J << 10)); }

template <int SB>
__device__ __forceinline__ bf16x8 tr_frag(LAS unsigned char* base, int ks) {
    const s16x4 lo = lds_tr16(base + ks * 16 * SB), hi4 = lds_tr16(base + ks * 16 * SB + 8 * SB);
    return (bf16x8){lo[0], lo[1], lo[2], lo[3], hi4[0], hi4[1], hi4[2], hi4[3]};
}
__device__ __forceinline__ bf16x8 row_frag(const LAS unsigned char* rowp, int ks, int hi) {
    const v2u lo = *(const LAS v2u*)(rowp + (16 * ks + 4 * hi) * 2), hi2 = *(const LAS v2u*)(rowp + (16 * ks + 8 + 4 * hi) * 2);
    return __builtin_bit_cast(bf16x8, (v4u){lo.x, lo.y, hi2.x, hi2.y});
}
__device__ __forceinline__ void lds_barrier() { asm volatile("s_waitcnt lgkmcnt(0)\n\ts_barrier" ::: "memory"); }

struct BfPtr { const unsigned short* p; __device__ __forceinline__ float operator[](size_t i) const { return __builtin_bit_cast(float, (unsigned)p[i] << 16); }
               __device__ __forceinline__ BfPtr operator+(size_t o) const { return BfPtr{p + o}; } };
#define GLD(ptr) (BfPtr{(const unsigned short*)(ptr)})

__device__ __forceinline__ int lane_id() { int r; asm volatile("v_mbcnt_lo_u32_b32 %0, -1, 0\n\tv_mbcnt_hi_u32_b32 %0, -1, %0" : "=v"(r)); return r; }
#define TID_IS_ZERO(wave_) ((wave_) == 0 && lane_id() == 0)
#define XB_TMO      128
#define XB_XCNT(j)  (256  + 64 * (j))
#define XB_XSUB(j)  (1280 + 64 * (j))
#define XB_XGEN(j)  (2304 + 64 * (j))
#define XB_TOP      3328
#define XB_TOPGEN   3392
#define XCD_BAR_WORDS 3456
#define XB_SPIN_CAP (1u << 18)

__device__ __forceinline__ unsigned xb_ld(unsigned* p)              { return __hip_atomic_load(p, __ATOMIC_RELAXED, __HIP_MEMORY_SCOPE_AGENT); }
__device__ __forceinline__ unsigned xb_add(unsigned* p, unsigned v) { return __hip_atomic_fetch_add(p, v, __ATOMIC_RELAXED, __HIP_MEMORY_SCOPE_AGENT); }
__device__ __forceinline__ unsigned xb_xcc_id() { return (unsigned)__builtin_amdgcn_s_getreg((3 << 11) | 20) & 0xFu; }
#define XB_SPIN(cond, bar) do { unsigned _sp = 0; while (cond) { __builtin_amdgcn_s_sleep(1); \
    if ((++_sp & 255u) == 0u) { if (xb_ld(&(bar)[XB_TMO])) break; if (_sp > XB_SPIN_CAP) { atomicAdd(&(bar)[XB_TMO], 1u); break; } } } } while (0)

struct XcdBarrier {
    unsigned* bar; unsigned x; int wave;
    volatile LAS unsigned* st;
};

__device__ __forceinline__ XcdBarrier xcd_barrier_post(unsigned* bar, volatile LAS unsigned* st, int wave) {
    XcdBarrier b; b.bar = bar; b.x = xb_xcc_id(); b.st = st; b.wave = wave;
    if (TID_IS_ZERO(wave)) (void)xb_add(&bar[XB_XCNT(b.x)], 1u);
    return b;
}
__device__ __forceinline__ void xcd_barrier_complete(unsigned* bar, unsigned x, unsigned& nloc, unsigned& nx) {
    const unsigned G = gridDim.x * gridDim.y * gridDim.z;
    unsigned sum, cnt, mine, sp = 0u;
    for (;;) {
        sum = 0u; cnt = 0u; mine = 0u;
#pragma unroll
        for (unsigned j = 0; j < 16; ++j) { const unsigned c = xb_ld(&bar[XB_XCNT(j)]); sum += c; cnt += (c > 0u) ? 1u : 0u; mine = (j == x) ? c : mine; }
        if (sum == G) break;
        __builtin_amdgcn_s_sleep(1);
        if ((++sp & 255u) == 0u) { if (xb_ld(&bar[XB_TMO])) break; if (sp > XB_SPIN_CAP) { atomicAdd(&bar[XB_TMO], 1u); break; } }
    }
    nloc = mine > 0u ? mine : 1u; nx = cnt > 0u ? cnt : 1u;
}

__device__ __forceinline__ void xcd_barrier(const XcdBarrier& b) {
    asm volatile("s_waitcnt vmcnt(0)" ::: "memory");
    __syncthreads();
    if (TID_IS_ZERO(b.wave)) {
        unsigned* bar = b.bar;
        __builtin_amdgcn_s_waitcnt(0);
        unsigned nloc = b.st[0], nx = b.st[1];
        if (nloc == 0u) { xcd_barrier_complete(bar, b.x, nloc, nx); b.st[0] = nloc; b.st[1] = nx; }
        const unsigned old = xb_add(&bar[XB_XSUB(b.x)], 1u);
        const unsigned gen = old / nloc;
        if (old + 1u == (gen + 1u) * nloc) {
            __builtin_amdgcn_fence(__ATOMIC_RELEASE, "agent");
            asm volatile("s_waitcnt vmcnt(0)" ::: "memory");
            const unsigned og = xb_add(&bar[XB_TOP], 1u);
            const unsigned tg = og / nx;
            if (og + 1u == (tg + 1u) * nx) xb_add(&bar[XB_TOPGEN], 1u);
            else XB_SPIN(xb_ld(&bar[XB_TOPGEN]) == tg, bar);
            __builtin_amdgcn_fence(__ATOMIC_ACQUIRE, "agent");
            xb_add(&bar[XB_XGEN(b.x)], 1u);
            asm volatile("s_waitcnt vmcnt(0)" ::: "memory");
        } else {
            XB_SPIN(xb_ld(&bar[XB_XGEN(b.x)]) == gen, bar);
            __builtin_amdgcn_fence(__ATOMIC_ACQUIRE, "agent");
            asm volatile("s_waitcnt vmcnt(0)" ::: "memory");
        }
    }
    __syncthreads();
}


constexpr int NWAVES = 8, NTHR = 512;
constexpr int DM = 1024, TP = 16384, TS = 1024, TA = TP + TS, SEQ = 8192, NB_P = 2, NB_S = 128, LS = 8;
constexpr int N_IN = 3328;
constexpr int PASTL = 2048, PAGE = 128, NPAGES = 16;
constexpr float EPS = 1e-6f;
constexpr float LOG2E = 1.4426950408889634f;
constexpr float C2F = 0.125f * LOG2E;
constexpr float C2C = 0.0625f * LOG2E;

enum { I_XP = 0, I_XS, I_CFK, I_CFV, I_CFL, I_SGLA, I_CMK, I_CMV, I_PT, I_MEMP, I_GMIX, I_WIN, I_BFF, I_WG2, I_BG, I_GGO, I_WOUT, I_GCROSS, I_GMEM,
       I_WMK, I_WMV, I_WCQ, I_WCO, I_GFFN, I_PWQ, I_PSK, I_PU, I_PV, I_GFIN, N_INPUTS };
constexpr size_t O_YP = 0, O_YS = 16777216, O_FKP = 17825792, O_FVP = 26214400, O_LFP = 34603008, O_GSP = 34734080, O_MKP = 34799616, O_MVP = 35323904,
                 O_FKS = 35848192, O_FVS = 36372480, O_LFS = 36896768, O_GSS = 36904960, O_TOTAL = 41099264;

constexpr size_t MiB = 1u << 20;
constexpr size_t WS_CTL = 0, CTL_ZERO_BYTES = 1 * MiB;
constexpr size_t WS_WIN = 2 * MiB, WS_WOUT = 10 * MiB, WS_WMK = 12 * MiB, WS_WMV = 14 * MiB, WS_WCQ = 16 * MiB, WS_WCO = 18 * MiB, WS_WPK = 20 * MiB;
constexpr size_t WS_MB = 24 * MiB, WS_MK16 = 25 * MiB, WS_MVT16 = 26 * MiB, WS_KBIAS = 27 * MiB, WS_GDEC = 28 * MiB, WS_GG = 29 * MiB;
constexpr size_t WS_U16 = 32 * MiB, WS_V16 = 64 * MiB, WS_HB = 96 * MiB, WS_QF = 132 * MiB, WS_KF = 150 * MiB, WS_VF = 168 * MiB;
constexpr size_t WS_GQ = 186 * MiB, WS_GK = 204 * MiB, WS_GV = 222 * MiB, WS_GR = 256 * MiB, WS_SUF = 290 * MiB, WS_GKV = 298 * MiB;
constexpr size_t WS_MERGED = 330 * MiB, WS_X1 = 364 * MiB, WS_X2 = 432 * MiB, WS_QC = 500 * MiB, WS_PC = 534 * MiB, WS_OC = 566 * MiB, WS_SC = 600 * MiB;
constexpr size_t WS_MISC = 736 * MiB, WS_SS = 740 * MiB  , WS_BB = 744 * MiB, WS_END = 800 * MiB;
constexpr int CW_BAR = 4096;

constexpr int RING_BYTES = 131072;
constexpr int LDSCTL_OFF = RING_BYTES, MISC_OFF = LDSCTL_OFF + 320;
constexpr int ARGS_OFF = MISC_OFF + 128;
constexpr int LDS_BYTES = 147456;

struct Args { const void* in[N_INPUTS]; float* out; unsigned char* ws; };

__device__ __forceinline__ const void* ld_ptr(const LAS unsigned long long* p) { const unsigned long long v = *p; const unsigned lo = __builtin_amdgcn_readfirstlane((unsigned)v), hi = __builtin_amdgcn_readfirstlane((unsigned)(v >> 32)); return (const void*)(const GAS char*)(((unsigned long long)hi << 32) | lo); }
__device__ __forceinline__ Args load_args(const LAS unsigned long long* ARGP) { Args A;
    A.in[0] = ld_ptr(ARGP + 0);
    A.in[1] = ld_ptr(ARGP + 1);
    A.in[2] = ld_ptr(ARGP + 2);
    A.in[3] = ld_ptr(ARGP + 3);
    A.in[4] = ld_ptr(ARGP + 4);
    A.in[5] = ld_ptr(ARGP + 5);
    A.in[6] = ld_ptr(ARGP + 6);
    A.in[7] = ld_ptr(ARGP + 7);
    A.in[8] = ld_ptr(ARGP + 8);
    A.in[9] = ld_ptr(ARGP + 9);
    A.in[10] = ld_ptr(ARGP + 10);
    A.in[11] = ld_ptr(ARGP + 11);
    A.in[12] = ld_ptr(ARGP + 12);
    A.in[13] = ld_ptr(ARGP + 13);
    A.in[14] = ld_ptr(ARGP + 14);
    A.in[15] = ld_ptr(ARGP + 15);
    A.in[16] = ld_ptr(ARGP + 16);
    A.in[17] = ld_ptr(ARGP + 17);
    A.in[18] = ld_ptr(ARGP + 18);
    A.in[19] = ld_ptr(ARGP + 19);
    A.in[20] = ld_ptr(ARGP + 20);
    A.in[21] = ld_ptr(ARGP + 21);
    A.in[22] = ld_ptr(ARGP + 22);
    A.in[23] = ld_ptr(ARGP + 23);
    A.in[24] = ld_ptr(ARGP + 24);
    A.in[25] = ld_ptr(ARGP + 25);
    A.in[26] = ld_ptr(ARGP + 26);
    A.in[27] = ld_ptr(ARGP + 27);
    A.in[28] = ld_ptr(ARGP + 28);
    A.out = (float*)ld_ptr(ARGP + N_INPUTS); A.ws = (unsigned char*)ld_ptr(ARGP + N_INPUTS + 1); return A; }
struct Frame {
    LAS unsigned char* lds;
    int tid, lane, wave, vcu, G;
};

__device__ __forceinline__ float wave_sum(float v) { return sum64_f32(v); }
__device__ __forceinline__ float log_sigmoid(float x) { return fminf(x, 0.f) - log1pf(__expf(-fabsf(x))); }

__device__ __forceinline__ int win_src_col(int r) {
    if (r < 1536) return r;
    if (r < 1792) return 1544 + (r - 1536);
    if (r < 2048) return 1800 + (r - 1792);
    if (r < 2560) return 2056 + (r - 2048);
    if (r < 3072) return 2584 + (r - 2560);
    if (r < 3080) return 1536 + (r - 3072);
    if (r < 3096) return 2568 + (r - 3080);
    return -1;
}
template <bool WIN>
__device__ __forceinline__ void p0_transpose_item(const float* W, int ldw, int K, int nblk, bf16* WT, LAS float* scr, int item, int lane) {
    const int kb = item / nblk, nb = item % nblk, k0 = 64 * kb, n0 = 32 * nb;
    const int dr = n0 + (lane & 31); const int sc = WIN ? win_src_col(dr) : dr;
#pragma unroll 8
    for (int i = 0; i < 32; ++i) { const int kk = 2 * i + (lane >> 5); scr[kk * 33 + (lane & 31)] = (sc >= 0) ? W[(size_t)(k0 + kk) * ldw + sc] : 0.f; }
    LDS_WAIT(); asm volatile("" ::: "memory");
    const int c = lane & 7;
#pragma unroll
    for (int j = 0; j < 4; ++j) { const int n = (lane >> 3) + 8 * j; const LAS float* s = scr + (8 * c) * 33 + n;
        v4u o; o.x = pk2(s[0 * 33], s[1 * 33]); o.y = pk2(s[2 * 33], s[3 * 33]); o.z = pk2(s[4 * 33], s[5 * 33]); o.w = pk2(s[6 * 33], s[7 * 33]);
        *(GAS v4u*)(WT + (size_t)(n0 + n) * K + k0 + 8 * c) = o; }
    LDS_WAIT(); asm volatile("" ::: "memory");
}
__device__ __forceinline__ void rms_row_bf16(const float* xrow, const float* g, bf16* orow, int lane) {
    const f32x4* xr = (const f32x4*)xrow + lane; const f32x4* gr = (const f32x4*)g + lane;
    f32x4 v[4]; float s = 0.f;
#pragma unroll
    for (int j = 0; j < 4; ++j) { v[j] = xr[64 * j]; s += (v[j].x * v[j].x + v[j].y * v[j].y) + (v[j].z * v[j].z + v[j].w * v[j].w); }
    const float r = rsqrtf(wave_sum(s) * (1.f / DM) + EPS);
    v2u* o8 = (v2u*)orow + lane;
#pragma unroll
    for (int j = 0; j < 4; ++j) { const f32x4 gg = gr[64 * j]; v2u o; o.x = pk2(v[j].x * r * gg.x, v[j].y * r * gg.y); o.y = pk2(v[j].z * r * gg.z, v[j].w * r * gg.w); o8[64 * j] = o; }
}

using pg8::Unit;
struct EpiGen {
    static constexpr bool PERM = true, AFTER_DRAIN = false;
    float* d32; int ld32; bf16* d16; int ld16; float sc16;
    const float* r0; const float* r1; int rsplit; int ldr;
    const float* gcol;
    float* ssq;
    const float* rsq;
    __device__ __forceinline__ void operator()(const f32x4 (&acc)[2][2][4][2], const Unit& u, int wr, int wc, int fr, int fq) const {
        int row0 = u.pm * 256 + wr * 64 + fr, col0 = u.pn * 256 + wc * 32 + fq * 8;
        asm volatile("" : "+v"(row0), "+v"(col0));
#pragma unroll
        for (int ai = 0; ai < 2; ++ai)
#pragma unroll
            for (int m = 0; m < 4; ++m) { const int row = row0 + ai * 128 + m * 16;
                const float* rp = nullptr; if (r0) rp = (row < rsplit) ? r0 + (size_t)row * ldr : r1 + (size_t)(row - rsplit) * ldr;
                float rs = 1.f; if (rsq) rs = rsqrtf(rsq[row] * (1.f / 1024.f) + EPS);
                float ss = 0.f;
#pragma unroll
                for (int bj = 0; bj < 2; ++bj) { const int col = col0 + bj * 128; f32x4 v0 = acc[ai][bj][m][0], v1 = acc[ai][bj][m][1];
                    if (rsq) { v0[0] *= rs; v0[1] *= rs; v0[2] *= rs; v0[3] *= rs; v1[0] *= rs; v1[1] *= rs; v1[2] *= rs; v1[3] *= rs; }
                    if (r0) { v0 += *(const f32x4*)(rp + col); v1 += *(const f32x4*)(rp + col + 4); }
                    if (d32) { *(f32x4*)(d32 + (size_t)row * ld32 + col) = v0; *(f32x4*)(d32 + (size_t)row * ld32 + col + 4) = v1; }
                    if (ssq) ss += ((v0[0] * v0[0] + v0[1] * v0[1]) + (v0[2] * v0[2] + v0[3] * v0[3])) + ((v1[0] * v1[0] + v1[1] * v1[1]) + (v1[2] * v1[2] + v1[3] * v1[3]));
                    if (d16) { f32x4 w0 = v0, w1 = v1; if (gcol) { w0 = w0 * *(const f32x4*)(gcol + col); w1 = w1 * *(const f32x4*)(gcol + col + 4); }
                        v4u o; o.x = pg8::cvt_pk_bf16(w0[0] * sc16, w0[1] * sc16); o.y = pg8::cvt_pk_bf16(w0[2] * sc16, w0[3] * sc16); o.z = pg8::cvt_pk_bf16(w1[0] * sc16, w1[1] * sc16); o.w = pg8::cvt_pk_bf16(w1[2] * sc16, w1[3] * sc16);
                        *(v4u*)(d16 + (size_t)row * ld16 + col) = o; } }
                if (ssq) { ss += xor16_f32(ss); ss += __shfl_xor(ss, 32); if (fq == 0) atomicAdd(ssq + row, ss); } }
    }
};
struct EpiInProj {
    static constexpr bool PERM = true, AFTER_DRAIN = false;
    float* out; unsigned char* ws; const float* bff;
    __device__ __forceinline__ void operator()(const f32x4 (&acc)[2][2][4][2], const Unit& u, int wr, int wc, int fr, int fq) const {
        const int pn = u.pn; const bool smp = u.pm >= 64;
        int row0 = u.pm * 256 + wr * 64 + fr;
        int orow0 = (smp ? (u.pm - 64) * 256 : u.pm * 256) + wr * 64 + fr;
        asm volatile("" : "+v"(row0), "+v"(orow0));
        float* d32 = nullptr; int ld32 = 0; bool d32_grp = false; bf16* d16 = nullptr; int ld16 = 0; float s32 = 1.f, s16 = 1.f; int cb = 0;
        if (pn < 2) { d16 = (bf16*)(ws + WS_QF); ld16 = 512; s16 = C2F; cb = pn * 256; }
        else if (pn < 4) { d32 = out + (smp ? O_FKS : O_FKP); ld32 = 512; d32_grp = true; d16 = (bf16*)(ws + WS_KF); ld16 = 512; cb = (pn - 2) * 256; }
        else if (pn < 6) { d32 = out + (smp ? O_FVS : O_FVP); ld32 = 512; d32_grp = true; d16 = (bf16*)(ws + WS_VF); ld16 = 512; cb = (pn - 4) * 256; }
        else if (pn == 6) { d16 = (bf16*)(ws + WS_GQ); ld16 = 256; s16 = 0.125f; }
        else if (pn == 7) { d16 = (bf16*)(ws + WS_GK); ld16 = 256; }
        else if (pn < 10) { d16 = (bf16*)(ws + WS_GV); ld16 = 512; cb = (pn - 8) * 256; }
        else if (pn < 12) { d16 = (bf16*)(ws + WS_GR); ld16 = 512; cb = (pn - 10) * 256; }
        if (pn < 12) {
#pragma unroll
            for (int ai = 0; ai < 2; ++ai)
#pragma unroll
                for (int m = 0; m < 4; ++m) { const int row = row0 + ai * 128 + m * 16, orow = orow0 + ai * 128 + m * 16;
#pragma unroll
                    for (int bj = 0; bj < 2; ++bj) { const int col = cb + wc * 32 + fq * 8 + bj * 128; const f32x4 v0 = acc[ai][bj][m][0], v1 = acc[ai][bj][m][1];
                        if (d32) { float* dp = d32 + (size_t)(d32_grp ? orow : row) * ld32 + col; *(f32x4*)dp = v0 * s32; *(f32x4*)(dp + 4) = v1 * s32; }
                        if (d16) { v4u o; o.x = pg8::cvt_pk_bf16(v0[0] * s16, v0[1] * s16); o.y = pg8::cvt_pk_bf16(v0[2] * s16, v0[3] * s16); o.z = pg8::cvt_pk_bf16(v1[0] * s16, v1[1] * s16); o.w = pg8::cvt_pk_bf16(v1[2] * s16, v1[3] * s16);
                            *(v4u*)(d16 + (size_t)row * ld16 + col) = o; } } }
        } else {
            if (wc == 0) {
                float* lf = out + (smp ? O_LFS : O_LFP); float* ggp = (float*)(ws + WS_GG);
#pragma unroll
                for (int ai = 0; ai < 2; ++ai)
#pragma unroll
                    for (int m = 0; m < 4; ++m) { const int row = row0 + ai * 128 + m * 16, orow = orow0 + ai * 128 + m * 16;
#pragma unroll
                        for (int n = 0; n < 2; ++n) { const int col = fq * 8 + 4 * n; const f32x4 v = acc[ai][0][m][n];
                            if (col < 8) { f32x4 o; const f32x4 b = *(const f32x4*)(bff + col);
                                o[0] = log_sigmoid(v[0] + b[0]); o[1] = log_sigmoid(v[1] + b[1]); o[2] = log_sigmoid(v[2] + b[2]); o[3] = log_sigmoid(v[3] + b[3]);
                                *(f32x4*)(lf + (size_t)orow * 8 + col) = o; }
                            else if (col < 24) *(f32x4*)(ggp + (size_t)row * 16 + (col - 8)) = v; } }
            }
        }
    }
};


__device__ __forceinline__ void p0_prologue(const Frame& F, const Args& a) {
    unsigned char* ws = a.ws;
    LAS float* scr = (LAS float*)(F.lds + F.wave * 16384);
    const int gw = F.vcu * NWAVES + F.wave, NGW = F.G * NWAVES;
    constexpr int I_WINN = 16 * (N_IN / 32), I_SQ = 16 * 32;
    constexpr int NITEMS = I_WINN + 5 * I_SQ;
    for (int it = (gw + NGW / 2) % NGW; it < NITEMS; it += NGW) {
        int r = it;
        if (r < I_WINN) { p0_transpose_item<true>((const float*)a.in[I_WIN], 3096, DM, N_IN / 32, (bf16*)(ws + WS_WIN), scr, r, F.lane); continue; } r -= I_WINN;
        const int which = r / I_SQ; r -= which * I_SQ;
        const float* src = (const float*)(which == 0 ? a.in[I_WOUT] : which == 1 ? a.in[I_WMK] : which == 2 ? a.in[I_WMV] : which == 3 ? a.in[I_WCQ] : a.in[I_WCO]);
        bf16* dst = (bf16*)(ws + (which == 0 ? WS_WOUT : which == 1 ? WS_WMK : which == 2 ? WS_WMV : which == 3 ? WS_WCQ : WS_WCO));
        p0_transpose_item<false>(src, DM, DM, 32, dst, scr, r, F.lane);
    }
    { float* ssz = (float*)(ws + WS_SS); for (int i = F.vcu * NTHR + F.tid; i < 2 * TA; i += F.G * NTHR) ssz[i] = 0.f; }
    for (int m0 = gw * 2; m0 < TA + 512; m0 += NGW * 2) {
        const float* xr[2]; const float* gr[2]; bf16* orow[2];
#pragma unroll
        for (int j = 0; j < 2; ++j) { const int m = m0 + j;
            if (m < TP) { xr[j] = (const float*)a.in[I_XP] + (size_t)m * DM; gr[j] = (const float*)a.in[I_GMIX]; orow[j] = (bf16*)(ws + WS_HB) + (size_t)m * DM; }
            else if (m < TA) { xr[j] = (const float*)a.in[I_XS] + (size_t)(m - TP) * DM; gr[j] = (const float*)a.in[I_GMIX]; orow[j] = (bf16*)(ws + WS_HB) + (size_t)m * DM; }
            else { xr[j] = (const float*)a.in[I_MEMP] + (size_t)(m - TA) * DM; gr[j] = (const float*)a.in[I_GMEM]; orow[j] = (bf16*)(ws + WS_MB) + (size_t)(m - TA) * DM; } }
        f32x4 v[2][4]; float s[2];
#pragma unroll
        for (int j = 0; j < 2; ++j) { s[j] = 0.f;
#pragma unroll
            for (int q = 0; q < 4; ++q) v[j][q] = ((const f32x4*)xr[j])[F.lane + 64 * q]; }
#pragma unroll
        for (int j = 0; j < 2; ++j) {
#pragma unroll
            for (int q = 0; q < 4; ++q) s[j] += (v[j][q].x * v[j][q].x + v[j][q].y * v[j][q].y) + (v[j][q].z * v[j][q].z + v[j][q].w * v[j][q].w);
            const float r = rsqrtf(wave_sum(s[j]) * (1.f / DM) + EPS);
#pragma unroll
            for (int q = 0; q < 4; ++q) { const f32x4 gg = ((const f32x4*)gr[j])[F.lane + 64 * q]; v2u o; o.x = pk2(v[j][q].x * r * gg.x, v[j][q].y * r * gg.y); o.y = pk2(v[j][q].z * r * gg.z, v[j][q].w * r * gg.w); ((v2u*)orow[j])[F.lane + 64 * q] = o; } }
    }
    {
        for (int r0 = gw * 4; r0 < 2 * 16384; r0 += NGW * 4) {
            f32x4 x[4][4];
#pragma unroll
            for (int j = 0; j < 4; ++j) { const int r = r0 + j; const bool isv = r >= 16384; const int e = isv ? r - 16384 : r;
                const f32x4* s = (const f32x4*)((const float*)(isv ? a.in[I_PV] : a.in[I_PU]) + (size_t)e * DM) + F.lane;
#pragma unroll
                for (int q = 0; q < 4; ++q) x[j][q] = __builtin_nontemporal_load(s + 64 * q); }
#pragma unroll
            for (int j = 0; j < 4; ++j) { const int r = r0 + j; const bool isv = r >= 16384; const int e = isv ? r - 16384 : r; float am = 0.f;
#pragma unroll
                for (int q = 0; q < 4; ++q) am = fmaxf(am, fmaxf(fmaxf(fabsf(x[j][q].x), fabsf(x[j][q].y)), fmaxf(fabsf(x[j][q].z), fabsf(x[j][q].w))));
#pragma unroll
                for (int o = 1; o < 64; o <<= 1) am = fmaxf(am, __shfl_xor(am, o));
                const float inv = am > 0.f ? 448.f / am : 0.f;
                v4u o4;
#pragma unroll
                for (int q = 0; q < 4; ++q) { int pk = __builtin_amdgcn_cvt_pk_fp8_f32(x[j][q].x * inv, x[j][q].y * inv, 0, false); pk = __builtin_amdgcn_cvt_pk_fp8_f32(x[j][q].z * inv, x[j][q].w * inv, pk, true); o4[q] = (unsigned)pk; }
                *(v4u*)(ws + (isv ? WS_V16 : WS_U16) + (size_t)e * DM + 16 * F.lane) = o4;
                if (F.lane == 0) ((float*)(ws + WS_MISC))[r] = am * (1.f / 448.f); }
        }
    }
    __syncthreads();
    for (int it = blockIdx.x; it < 256; it += F.G) {
        const int c = it >> 4, kt = it & 15, half = c & 1;
        LAS unsigned char* SKB = F.lds; LAS unsigned char* WB = F.lds + 128 * 272;
        const float* sk = (const float*)a.in[I_PSK] + (size_t)half * 128 * 128; const float* wq = (const float*)a.in[I_PWQ] + (size_t)(kt * 64) * 2048 + c * 128;
#pragma unroll
        for (int i = 0; i < 8; ++i) { const int c4 = F.tid + NTHR * i; const f32x4 x = *(const f32x4*)(sk + 4 * c4);
            v2u o; o.x = pk2(x.x, x.y); o.y = pk2(x.z, x.w); *(LAS v2u*)(SKB + (c4 >> 5) * 272 + (c4 & 31) * 8) = o; }
#pragma unroll
        for (int i = 0; i < 4; ++i) { const int c4 = F.tid + NTHR * i; const f32x4 x = *(const f32x4*)(wq + (size_t)(c4 >> 5) * 2048 + (c4 & 31) * 4);
            v2u o; o.x = pk2(x.x, x.y); o.y = pk2(x.z, x.w); *(LAS v2u*)(WB + (c4 >> 5) * 272 + (c4 & 31) * 8) = o; }
        __syncthreads();
        {
            const int r32 = F.lane & 31, hi = F.lane >> 5, mb = F.wave >> 1, nb = F.wave & 1;
            const LAS unsigned char* arow = SKB + (32 * mb + r32) * 272; const LAS unsigned char* brow = WB + (32 * nb + r32) * 272;
            f32x16 acc = {};
#pragma unroll
            for (int ks = 0; ks < 8; ++ks) acc = __builtin_amdgcn_mfma_f32_32x32x16_bf16(row_frag(arow, ks, hi), row_frag(brow, ks, hi), acc, 0, 0, 0);
            bf16* wp = (bf16*)(ws + WS_WPK) + (size_t)(c * 128 + 32 * mb) * DM + kt * 64 + 32 * nb + r32;
#pragma unroll
            for (int r = 0; r < 16; ++r) wp[(size_t)crow(r, hi) * DM] = (bf16)f2bf(acc[r]);
        }
        __syncthreads();
    }
}


__device__ __forceinline__ void fox_prompt_cumsum(const Frame& F, const float* logf  , float* kbias, int b) {
    LAS float* WT = (LAS float*)F.lds;
    const int t0 = F.wave * 1024 + F.lane * 16;
    const f32x4* src = (const f32x4*)(logf + ((size_t)b * SEQ + t0) * 8);
    float s[8];
#pragma unroll
    for (int h = 0; h < 8; ++h) s[h] = 0.f;
#pragma unroll 4
    for (int i = 0; i < 16; ++i) { const f32x4 a = src[2 * i], c = src[2 * i + 1]; s[0] += a.x; s[1] += a.y; s[2] += a.z; s[3] += a.w; s[4] += c.x; s[5] += c.y; s[6] += c.z; s[7] += c.w; }
    float ex[8];
#pragma unroll
    for (int h = 0; h < 8; ++h) { float v = s[h];
#pragma unroll
        for (int o = 1; o < 64; o <<= 1) { const float t = __shfl_up(v, o); if (F.lane >= o) v += t; }
        ex[h] = v - s[h];
        if (F.lane == 63) WT[F.wave * 8 + h] = v; }
    __syncthreads();
#pragma unroll
    for (int h = 0; h < 8; ++h) { float c = 0.f; for (int w = 0; w < F.wave; ++w) c += WT[w * 8 + h]; ex[h] += c; }
    float* dst = kbias + (size_t)(b * 8) * SEQ + t0;
#pragma unroll 4
    for (int i = 0; i < 16; ++i) { const f32x4 a = src[2 * i], c = src[2 * i + 1];
        ex[0] += a.x; ex[1] += a.y; ex[2] += a.z; ex[3] += a.w; ex[4] += c.x; ex[5] += c.y; ex[6] += c.z; ex[7] += c.w;
#pragma unroll
        for (int h = 0; h < 8; ++h) dst[(size_t)h * SEQ + i] = -ex[h] * LOG2E; }
    __syncthreads();
}
__device__ __forceinline__ void fox_sample_suffix(const Frame& F, const float* cfl, const int* pt, float* suf, int bs) {
    float carry[8];
#pragma unroll
    for (int h = 0; h < 8; ++h) carry[h] = 0.f;
    const int mypg = pt[bs * NPAGES + (F.lane & 15)];
#pragma unroll 1
    for (int pb = NPAGES - 4; pb >= 0; pb -= 4) {
        f32x4 x[4][4];
#pragma unroll
        for (int j = 0; j < 4; ++j) { const int pg = __builtin_amdgcn_readlane(mypg, 0) * 0 + __shfl(mypg, pb + j); const f32x4* src = (const f32x4*)(cfl + ((size_t)pg * PAGE + 2 * F.lane) * 8);
            x[j][0] = src[0]; x[j][1] = src[1]; x[j][2] = src[2]; x[j][3] = src[3]; }
#pragma unroll
        for (int j = 3; j >= 0; --j) { const int p = pb + j;
            const float ra[8] = {x[j][0].x, x[j][0].y, x[j][0].z, x[j][0].w, x[j][1].x, x[j][1].y, x[j][1].z, x[j][1].w}, rb[8] = {x[j][2].x, x[j][2].y, x[j][2].z, x[j][2].w, x[j][3].x, x[j][3].y, x[j][3].z, x[j][3].w};
#pragma unroll
            for (int h = 0; h < 8; ++h) {
                const float ps = ra[h] + rb[h]; float v = ps;
#pragma unroll
                for (int o = 1; o < 64; o <<= 1) { const float t = __shfl_down(v, o); if (F.lane + o < 64) v += t; }
                const float exs = v - ps;
                float* d = suf + (size_t)(bs * 8 + h) * PASTL + p * PAGE + 2 * F.lane;
                *(f32x2*)d = (f32x2){(carry[h] + exs + rb[h]) * LOG2E, (carry[h] + exs) * LOG2E};
                carry[h] += __shfl(v, 0);
            }
        }
    }
}

__device__ __forceinline__ void gla_gate_tile(const Frame& F, const float* gg, const float* w2, const float* bg, int row0, int h, int nt, LAS float* LA, LAS float* GGS) {
    for (int e = F.tid; e < nt * 16; e += NTHR) GGS[e] = gg[(size_t)row0 * 16 + e];
    const int dk = F.tid & 63; float wc[16];
#pragma unroll
    for (int r = 0; r < 16; ++r) wc[r] = w2[r * 256 + h * 64 + dk];
    const float bb = bg[h * 64 + dk];
    __syncthreads();
    for (int t = F.tid >> 6; t < nt; t += 8) { float z = bb;
#pragma unroll
        for (int q = 0; q < 4; ++q) { const f32x4 g4 = *(const LAS f32x4*)(GGS + t * 16 + 4 * q); z += g4.x * wc[4 * q] + g4.y * wc[4 * q + 1] + g4.z * wc[4 * q + 2] + g4.w * wc[4 * q + 3]; }
        LA[t * 64 + dk] = log_sigmoid(z) * (1.f / 16.f); }
}
__device__ __forceinline__ void gla_cumsum64(const Frame& F, LAS float* LA, LAS float* SEG) {
    const int dk = F.lane, w = F.wave; float v[8]; float run = 0.f;
#pragma unroll
    for (int i = 0; i < 8; ++i) { run += LA[(8 * w + i) * 64 + dk]; v[i] = run; }
    SEG[w * 64 + dk] = run;
    __syncthreads();
    float pre = 0.f;
    for (int j = 0; j < w; ++j) pre += SEG[j * 64 + dk];
#pragma unroll
    for (int i = 0; i < 8; ++i) LA[(8 * w + i) * 64 + dk] = v[i] + pre;
    __syncthreads();
}
__device__ __forceinline__ void gla_g1_unit(const Frame& F, const Args& a, int u) {
    unsigned char* ws = a.ws;
    const int b = u >> 9, h = (u >> 7) & 3, n = u & 127; const int row0 = b * SEQ + n * 64;
    LAS float* LA = (LAS float*)F.lds; LAS float* SEG = LA + 4096; LAS float* GGS = SEG + 512; LAS unsigned char* KRB = F.lds + 22528; LAS unsigned char* VSB = F.lds + 34816;
    v4u vq[2];
#pragma unroll
    for (int i = 0; i < 2; ++i) { const int c = F.tid + NTHR * i; vq[i] = *(const v4u*)((const bf16*)(ws + WS_GV) + (size_t)(row0 + (c >> 4)) * 512 + h * 128 + (c & 15) * 8); }
    float gkv[8];
#pragma unroll
    for (int i = 0; i < 8; ++i) { const int e = F.tid + NTHR * i; gkv[i] = GLD(ws + WS_GK)[(size_t)(row0 + (e >> 6)) * 256 + h * 64 + (e & 63)]; }
    gla_gate_tile(F, (const float*)(ws + WS_GG), (const float*)a.in[I_WG2], (const float*)a.in[I_BG], row0, h, 64, LA, GGS);
#pragma unroll
    for (int i = 0; i < 2; ++i) { const int c = F.tid + NTHR * i; *(LAS v4u*)(VSB + (c >> 4) * 320 + (c & 15) * 16) = vq[i]; }
    __syncthreads();
    gla_cumsum64(F, LA, SEG);
    if (F.tid < 64) ((float*)(ws + WS_GDEC))[(size_t)((b * 4 + h) * 128 + n) * 64 + F.tid] = __expf(LA[63 * 64 + F.tid]);
    float* bbuf = (float*)(ws + WS_BB);
#pragma unroll
    for (int i = 0; i < 8; ++i) { const int e = F.tid + NTHR * i; const int t = e >> 6, dk = e & 63; const float bb = LA[e]; bbuf[(size_t)(row0 + t) * 256 + h * 64 + dk] = bb;
        *(LAS unsigned short*)(KRB + t * 192 + dk * 2) = (unsigned short)f2bf(gkv[i] * __expf(LA[63 * 64 + dk] - bb)); }
    __syncthreads();
    {
        const int lane = F.lane, r32 = lane & 31, hi = lane >> 5, mb = F.wave >> 2, nb = F.wave & 3;
        const int tb = (4 * hi + ((lane & 15) >> 2)), tc = (16 * ((lane >> 4) & 1) + 4 * (lane & 3)) * 2;
        LAS unsigned char* abase = KRB + tb * 192 + tc + 64 * mb; LAS unsigned char* bbase = VSB + tb * 320 + tc + 64 * nb;
        f32x16 acc = {};
#pragma unroll
        for (int ks = 0; ks < 4; ++ks) acc = __builtin_amdgcn_mfma_f32_32x32x16_bf16(tr_frag<192>(abase, ks), tr_frag<320>(bbase, ks), acc, 0, 0, 0);
        float* kv = (float*)(ws + WS_GKV) + ((size_t)((b * 4 + h) * 128 + n) * 64 + 32 * mb) * 128 + 32 * nb + r32;
#pragma unroll
        for (int r = 0; r < 16; ++r) kv[(size_t)crow(r, hi) * 128] = acc[r];
    }
    __syncthreads();
}
__device__ __forceinline__ void gla_scan(const Frame& F, const Args& a) {
    int tid = F.wave * 64 + lane_id(); asm volatile("" : "+v"(tid));
    if (tid >= 256) return;
    for (int e = F.vcu * 256 + tid; e < 65536; e += F.G * 256) {
    const int bh = e >> 13, dk = (e >> 7) & 63, dv = e & 127;
    float* kv = (float*)(a.ws + WS_GKV) + ((size_t)bh * 128 * 64 + dk) * 128 + dv; const float* dc = (const float*)(a.ws + WS_GDEC) + (size_t)bh * 128 * 64 + dk;
    float S = 0.f;
#pragma unroll 1
    for (int n0 = 0; n0 < 128; n0 += 32) { float kvv[32], dd[32];
#pragma unroll
        for (int j = 0; j < 32; ++j) { kvv[j] = kv[(size_t)(n0 + j) * 8192]; dd[j] = dc[(size_t)(n0 + j) * 64]; }
#pragma unroll
        for (int j = 0; j < 32; ++j) { kv[(size_t)(n0 + j) * 8192] = S; S = dd[j] * S + kvv[j]; } }
    a.out[O_GSP + (size_t)bh * 8192 + dk * 128 + dv] = S;
    }
}
__device__ __forceinline__ float silu(float x) { return x / (1.f + __expf(-x)); }
__device__ __forceinline__ void gla_sample_unit(const Frame& F, const Args& a, int u) {
    unsigned char* ws = a.ws;
    const int bs = u >> 2, h = u & 3; const int row0 = TP + bs * LS;
    LAS float* LA = (LAS float*)F.lds; LAS float* BL = LA + 512; LAS float* QD = BL + 64; LAS float* KI = QD + 512; LAS float* KR = KI + 512; LAS float* ATT = KR + 512; LAS float* OP = ATT + 64; LAS float* VS = OP + 4096;
    gla_gate_tile(F, (const float*)(ws + WS_GG), (const float*)a.in[I_WG2], (const float*)a.in[I_BG], row0, h, 8, LA, VS + 1024);
#pragma unroll
    for (int i = 0; i < 2; ++i) { const int e = F.tid + NTHR * i; VS[e] = GLD(ws + WS_GV)[(size_t)(row0 + (e >> 7)) * 512 + h * 128 + (e & 127)]; }
    __syncthreads();
    if (F.tid < 64) { float run = 0.f;
#pragma unroll
        for (int t = 0; t < 8; ++t) { run += LA[t * 64 + F.tid]; LA[t * 64 + F.tid] = run; } BL[F.tid] = run; }
    __syncthreads();
    { const int e = F.tid, t = e >> 6, dk = e & 63; const float bb = LA[e];
      const float q = GLD(ws + WS_GQ)[(size_t)(row0 + t) * 256 + h * 64 + dk], k = GLD(ws + WS_GK)[(size_t)(row0 + t) * 256 + h * 64 + dk];
      QD[e] = q * __expf(bb); KI[e] = k * __expf(-bb); KR[e] = k * __expf(BL[dk] - bb); }
    __syncthreads();
    if (F.tid < 64) { const int t = F.tid >> 3, s = F.tid & 7; float acc = 0.f;
        if (s <= t) { for (int dk = 0; dk < 64; ++dk) acc += QD[t * 64 + dk] * KI[s * 64 + dk]; }
        ATT[F.tid] = acc; }
    const int dv = F.tid & 127, dkg = F.tid >> 7;
    {
        const float* st = (const float*)a.in[I_SGLA] + ((size_t)(bs * 4 + h) * 64 + dkg * 16) * 128 + dv;
        float S0[16];
#pragma unroll
        for (int i = 0; i < 16; ++i) S0[i] = st[(size_t)i * 128];
#pragma unroll
        for (int t = 0; t < 8; ++t) { float o = 0.f;
#pragma unroll
            for (int i = 0; i < 16; ++i) o += QD[t * 64 + dkg * 16 + i] * S0[i];
            OP[(dkg * 8 + t) * 128 + dv] = o; }
        float* so = a.out + O_GSS + ((size_t)(bs * 4 + h) * 64 + dkg * 16) * 128 + dv;
#pragma unroll
        for (int i = 0; i < 16; ++i) { float sn = __expf(BL[dkg * 16 + i]) * S0[i];
#pragma unroll
            for (int t = 0; t < 8; ++t) sn += KR[t * 64 + dkg * 16 + i] * VS[t * 128 + dv];
            so[(size_t)i * 128] = sn; }
    }
    __syncthreads();
    {
        const int t = F.wave; float o[2]; float ss = 0.f;
#pragma unroll
        for (int j = 0; j < 2; ++j) { const int d = 2 * F.lane + j; float v = OP[(0 * 8 + t) * 128 + d] + OP[(1 * 8 + t) * 128 + d] + OP[(2 * 8 + t) * 128 + d] + OP[(3 * 8 + t) * 128 + d];
            for (int s = 0; s <= t; ++s) v += ATT[t * 8 + s] * VS[s * 128 + d];
            o[j] = v; ss += v * v; }
        const float r = rsqrtf(wave_sum(ss) * (1.f / 128.f) + EPS);
        const float* ggo = (const float*)a.in[I_GGO] + h * 128 + 2 * F.lane; const BfPtr gr = GLD(ws + WS_GR) + ((size_t)(row0 + t) * 512 + h * 128 + 2 * F.lane);
        const float y0 = o[0] * r * ggo[0] * silu(gr[0]), y1 = o[1] * r * ggo[1] * silu(gr[1]);
        *(unsigned*)((bf16*)(ws + WS_MERGED) + (size_t)(row0 + t) * DM + 512 + h * 128 + 2 * F.lane) = pk2(y0, y1);
    }
    __syncthreads();
}


__device__ __forceinline__ float fexp2(float x) { return __builtin_amdgcn_exp2f(x); }
constexpr float FOX_SKIP = 160.f;


__device__ __forceinline__ void fox_norms_item(const Frame& F, const bf16* QF, const bf16* KF, const float* logf, float* FN, float* LC, float* BT, int item) {
    const int bh = item >> 5, qb = item & 31, b = bh >> 3, h = bh & 7;
    float qm = 0.f, km = 0.f;
    const float* lp = logf + ((size_t)b * SEQ + qb * 256 + 4 * F.lane) * 8 + h;
    const float l0 = lp[0], l1 = lp[8], l2 = lp[16], l3 = lp[24];
#pragma unroll 8
    for (int i = 0; i < 32; ++i) { const size_t row = (size_t)b * SEQ + qb * 256 + i * 8 + (F.lane >> 3);
        const v4u q = *(const v4u*)(QF + row * 512 + h * 64 + (F.lane & 7) * 8), k = *(const v4u*)(KF + row * 512 + h * 64 + (F.lane & 7) * 8); float qs = 0.f, ks = 0.f;
#pragma unroll
        for (int j = 0; j < 4; ++j) { qs += bflo(q[j]) * bflo(q[j]) + bfhi(q[j]) * bfhi(q[j]); ks += bflo(k[j]) * bflo(k[j]) + bfhi(k[j]) * bfhi(k[j]); }
        qs = sum8_f32(qs); ks = sum8_f32(ks);
        qm = fmaxf(qm, qs); km = fmaxf(km, ks); }
#pragma unroll
    for (int o = 1; o < 64; o <<= 1) { qm = fmaxf(qm, __shfl_xor(qm, o)); km = fmaxf(km, __shfl_xor(km, o)); }
    const float c0 = l0, c1 = c0 + l1, c2 = c1 + l2, c3 = c2 + l3; float v = c3;
#pragma unroll
    for (int o = 1; o < 64; o <<= 1) { const float t = __shfl_up(v, o); if (F.lane >= o) v += t; }
    const float ex = v - c3;
    *(f32x4*)(LC + (size_t)bh * SEQ + qb * 256 + 4 * F.lane) = (f32x4){ex + c0, ex + c1, ex + c2, ex + c3};
    if (F.lane == 63) BT[item] = v;
    if (F.lane == 0) { FN[item * 2] = qm; FN[item * 2 + 1] = km; }
}
__device__ __forceinline__ void fox_suffix_item(const Frame& F, const float* cfl, const int* pt, float* SW, float* PTOT, int item) {
    const int bs = item >> 4, p = item & 15; const int pg = __builtin_amdgcn_readfirstlane(pt[item]);
    const f32x4* src = (const f32x4*)(cfl + ((size_t)pg * PAGE + 2 * F.lane) * 8);
    const f32x4 a0 = src[0], a1 = src[1], b0 = src[2], b1 = src[3];
    const float ra[8] = {a0.x, a0.y, a0.z, a0.w, a1.x, a1.y, a1.z, a1.w}, rb[8] = {b0.x, b0.y, b0.z, b0.w, b1.x, b1.y, b1.z, b1.w};
#pragma unroll
    for (int h = 0; h < 8; ++h) {
        const float ps = ra[h] + rb[h]; float v = ps;
#pragma unroll
        for (int o = 1; o < 64; o <<= 1) { const float t = __shfl_down(v, o); if (F.lane + o < 64) v += t; }
        const float exs = v - ps;
        *(f32x2*)(SW + (size_t)(bs * 8 + h) * PASTL + p * PAGE + 2 * F.lane) = (f32x2){exs + rb[h], exs};
        if (F.lane == 0) PTOT[(bs * 8 + h) * NPAGES + p] = v;
    }
}
__device__ __forceinline__ void fox_attn_unit(const Frame& F, const bf16* QF, const bf16* KF, const bf16* VF, const float* LC, const float* BT, const float* FN, bf16* merged, int b, int h, int qb) {
    int tid = F.wave * 64 + lane_id(); asm volatile("" : "+v"(tid));
    const int lane = tid & 63, r32 = lane & 31, hi = lane >> 5, wid = F.wave;
    const size_t rowbase = (size_t)b * SEQ; const int q0 = qb * 256;
    LAS unsigned char* Ks = F.lds; LAS unsigned char* Vs = F.lds + 8192; LAS float* KBs = (LAS float*)(F.lds + 20480); LAS float* WSF = (LAS float*)(F.lds + 20736) + wid * 32;
    const bf16* Qw = QF + (rowbase + q0 + wid * 32 + r32) * 512 + h * 64;
    bf16x8 qr[4];
#pragma unroll
    for (int d0 = 0; d0 < 4; ++d0) qr[d0] = *(const bf16x8*)(Qw + d0 * 16 + hi * 8);
    const float* lcp = LC + (size_t)(b * 8 + h) * SEQ;
    float pbx; { const float btv = (lane < 32) ? BT[(b * 8 + h) * 32 + lane] : 0.f; float v = btv;
#pragma unroll
        for (int o = 1; o < 64; o <<= 1) { const float t = __shfl_up(v, o); if (lane >= o) v += t; }
        pbx = v - btv; }
    const float cref = lcp[q0] + __shfl(pbx, qb);
#define FOX_KB(t_, pos_) (-LOG2E * ((lcp[pos_] + __shfl(pbx, (t_) >> 2)) - cref))
    const int NT = (q0 + 256) / 64;
    int t0 = 0;
    {
        float kn = (lane < 32) ? FN[((b * 8 + h) * 32 + lane) * 2 + 1] : 0.f;
#pragma unroll
        for (int o = 1; o < 64; o <<= 1) kn = fmaxf(kn, __shfl_xor(kn, o));
        const float qk2 = 2.f * sqrtf(FN[((b * 8 + h) * 32 + qb) * 2]) * sqrtf(kn) * 1.01f;
        const int nbefore = q0 / 64;
        int found = -1;
        for (int base = 0; base < nbefore && found < 0; base += 64) {
            const int tl = nbefore - 1 - base - lane;
            const int tlc = tl < 0 ? 0 : tl; const float kbl = -LOG2E * ((lcp[tlc * 64 + 63] + __shfl(pbx, tlc >> 2)) - cref);
            const bool dead = (tl >= 0) && (qk2 + kbl < -FOX_SKIP);
            const unsigned long long bm = __ballot(dead);
            if (bm) found = nbefore - 1 - base - (int)__builtin_ctzll(bm);
        }
        t0 = found + 1;
        t0 = __builtin_amdgcn_readfirstlane(t0);
    }
    const int kkey = tid >> 3, kch = tid & 7, vkey = tid >> 3, vch = tid & 7;
    const bf16* ksrc = KF + (rowbase + kkey) * 512 + h * 64 + kch * 8;
    const bf16* vsrc = VF + (rowbase + vkey) * 512 + h * 64 + vch * 8;
    v4u kreg[2], vreg[2]; float kbreg[2];
#pragma unroll
    for (int hb = 0; hb < 2; ++hb) { const int tt = (t0 + hb < NT) ? t0 + hb : t0;
        kreg[hb] = *(const v4u*)(ksrc + (size_t)tt * 64 * 512); vreg[hb] = *(const v4u*)(vsrc + (size_t)tt * 64 * 512); kbreg[hb] = FOX_KB(tt, tt * 64 + (tid & 63)); }
    float m_run = -INFINITY, l_run = 0.f; f32x16 o0 = {}, o1 = {};
    const int qpos = q0 + wid * 32 + r32;
    const int vbase = (4 * hi + ((lane & 15) >> 2)) * 192 + (16 * ((lane >> 4) & 1) + 4 * (lane & 3)) * 2;
    LAS unsigned char* const Ks0 = Ks; LAS unsigned char* const Vs0 = Vs; LAS float* const KBs0 = KBs;
    __syncthreads();
    for (int t2 = t0; t2 < NT; t2 += 2) {
#pragma unroll
      for (int hb = 0; hb < 2; ++hb) {
        const int t = t2 + hb;
        if (t < NT) {
        LAS unsigned char* const Ks = Ks0 + hb * 28672; LAS unsigned char* const Vs = Vs0 + hb * 28672; LAS float* const KBs = (LAS float*)((LAS unsigned char*)KBs0 + hb * 28672);
        *(LAS v4u*)(Ks + kkey * 128 + ((kch ^ (kkey & 7)) << 4)) = kreg[hb];            *(LAS v4u*)(Vs + vkey * 192 + vch * 16) = vreg[hb]; if (tid < 64) KBs[tid] = kbreg[hb];
        __syncthreads();
        if (t + 2 < NT) { kreg[hb] = *(const v4u*)(ksrc + (size_t)(t + 2) * 64 * 512); vreg[hb] = *(const v4u*)(vsrc + (size_t)(t + 2) * 64 * 512); kbreg[hb] = FOX_KB(t + 2, (t + 2) * 64 + (tid & 63)); }
        const int k0 = t * 64;
        if (k0 <= q0 + wid * 32 + 31) {
        f32x16 p0, p1;
#pragma unroll
        for (int g = 0; g < 4; ++g) { const f32x4 ba = *(const LAS f32x4*)(KBs + 8 * g + 4 * hi), bb = *(const LAS f32x4*)(KBs + 32 + 8 * g + 4 * hi);
#pragma unroll
            for (int i = 0; i < 4; ++i) { p0[4 * g + i] = ba[i]; p1[4 * g + i] = bb[i]; } }
#pragma unroll
        for (int d0 = 0; d0 < 4; ++d0) {
            const bf16x8 a0 = *(const LAS bf16x8*)(Ks + r32 * 128 + (((2 * d0 + hi) ^ (r32 & 7)) << 4)), a1 = *(const LAS bf16x8*)(Ks + (r32 + 32) * 128 + (((2 * d0 + hi) ^ (r32 & 7)) << 4));
            p0 = __builtin_amdgcn_mfma_f32_32x32x16_bf16(a0, qr[d0], p0, 0, 0, 0); p1 = __builtin_amdgcn_mfma_f32_32x32x16_bf16(a1, qr[d0], p1, 0, 0, 0);
        }
        if (k0 + 63 > q0 + wid * 32) {
#pragma unroll
            for (int r = 0; r < 16; ++r) { const int key = k0 + crow(r, hi); if (key > qpos) p0[r] = -INFINITY; if (key + 32 > qpos) p1[r] = -INFINITY; }
        }
        float mx = fmaxf(p0[0], p1[0]);
#pragma unroll
        for (int r = 1; r < 16; ++r) mx = fmaxf(mx, fmaxf(p0[r], p1[r]));
        mx = fmaxf(mx, __shfl_xor(mx, 32));
        const float m_new = fmaxf(m_run, mx), alpha = fexp2(m_run - m_new); m_run = m_new;
        float ls = 0.f;
#pragma unroll
        for (int r = 0; r < 16; ++r) { p0[r] = fexp2(p0[r] - m_new); p1[r] = fexp2(p1[r] - m_new); ls += p0[r] + p1[r]; }
        l_run = l_run * alpha + ls;
        if (__ballot(alpha != 1.f) != 0ull) {
            if (hi == 0) WSF[r32] = alpha;
#pragma unroll
            for (int g = 0; g < 4; ++g) { const f32x4 al = *(const LAS f32x4*)(WSF + 8 * g + 4 * hi);
#pragma unroll
                for (int i = 0; i < 4; ++i) { o0[4 * g + i] *= al[i]; o1[4 * g + i] *= al[i]; } }
        }
        v4u pw[4];
#pragma unroll
        for (int j = 0; j < 4; ++j) { pw[0][j] = pg8::cvt_pk_bf16(p0[2 * j], p0[2 * j + 1]); pw[1][j] = pg8::cvt_pk_bf16(p0[8 + 2 * j], p0[8 + 2 * j + 1]);
                                      pw[2][j] = pg8::cvt_pk_bf16(p1[2 * j], p1[2 * j + 1]); pw[3][j] = pg8::cvt_pk_bf16(p1[8 + 2 * j], p1[8 + 2 * j + 1]); }
#pragma unroll
        for (int ks = 0; ks < 4; ++ks) {
            const bf16x8 pa = __builtin_bit_cast(bf16x8, pw[ks]);
#pragma unroll
            for (int d0 = 0; d0 < 2; ++d0) {
                const s16x4 lo = lds_tr16(Vs + vbase + ks * 16 * 192 + d0 * 64), hi4 = lds_tr16(Vs + vbase + ks * 16 * 192 + 8 * 192 + d0 * 64);
                const bf16x8 vb = (bf16x8){lo[0], lo[1], lo[2], lo[3], hi4[0], hi4[1], hi4[2], hi4[3]};
                if (d0 == 0) o0 = __builtin_amdgcn_mfma_f32_32x32x16_bf16(pa, vb, o0, 0, 0, 0); else o1 = __builtin_amdgcn_mfma_f32_32x32x16_bf16(pa, vb, o1, 0, 0, 0);
            }
        }
        }
        }
      }
    }
    l_run += __shfl_xor(l_run, 32);
    if (hi == 0) WSF[r32] = 1.f / l_run;
    bf16* Ow = merged + (rowbase + q0 + wid * 32) * DM + h * 64 + r32;
#pragma unroll
    for (int g = 0; g < 4; ++g) { const f32x4 rl = *(const LAS f32x4*)(WSF + 8 * g + 4 * hi);
#pragma unroll
        for (int i = 0; i < 4; ++i) { const int r = 4 * g + i; const int row = crow(r, hi);
            Ow[(size_t)row * DM] = (bf16)f2bf(o0[r] * rl[i]); Ow[(size_t)row * DM + 32] = (bf16)f2bf(o1[r] * rl[i]); } }
    __syncthreads();
#undef FOX_KB
}

template <int D> struct DecW {
    static constexpr int KS = D / 32;
    static constexpr int LPK = D / 4;
    static constexpr int KPI = 64 / LPK;
    float m[4], l[4]; float o[8][4];
};
template <int D>
__device__ __forceinline__ void dec_init(DecW<D>& w) {
#pragma unroll
    for (int i = 0; i < 4; ++i) { w.m[i] = -INFINITY; w.l[i] = 0.f; }
#pragma unroll
    for (int q = 0; q < 8; ++q)
#pragma unroll
        for (int j = 0; j < 4; ++j) w.o[q][j] = 0.f;
}
template <int D, int NTILE, int MODE>
__device__ __forceinline__ void dec_chunk(DecW<D>& w, const bf16x8 (&qa)[D / 32], const float* Kb, const float* Vb, int stride, const float* bias, float nb, LAS float* PL, int lane) {
    constexpr int KS = D / 32, LPK = D / 4, KPI = 64 / LPK;
    constexpr int NK = (MODE == 1) ? 8 : NTILE * 16, NV = NK / KPI;
    const int key = lane & 15, kq = lane >> 4;
    const unsigned koff = (unsigned)(key * stride + 8 * kq) * 4u;
    const int d4 = lane % LPK, ksub = lane / LPK;
    const unsigned voff = (unsigned)(ksub * stride + 4 * d4) * 4u;
    f32x4 kx[NTILE][2 * KS], vx[NV];
#pragma unroll
    for (int t = 0; t < NTILE; ++t) { const char* kp = (const char*)(Kb + (size_t)t * 16 * stride) + koff;
#pragma unroll
        for (int ks = 0; ks < KS; ++ks) { kx[t][2 * ks] = *(const f32x4*)(kp + 128 * ks); kx[t][2 * ks + 1] = *(const f32x4*)(kp + 128 * ks + 16); } }
    constexpr int NVA = (NV >= 8) ? NV / 2 : NV;
#pragma unroll
    for (int kk = 0; kk < NVA; ++kk) vx[kk] = *(const f32x4*)((const char*)(Vb + (size_t)kk * KPI * stride) + voff);
    f32x4 s[NTILE];
#pragma unroll
    for (int t = 0; t < NTILE; ++t) {
        f32x4 acc = {0.f, 0.f, 0.f, 0.f};
#pragma unroll
        for (int ks = 0; ks < KS; ++ks) { const f32x4 x0 = kx[t][2 * ks], x1 = kx[t][2 * ks + 1];
            v4u kb; kb.x = pg8::cvt_pk_bf16(x0.x, x0.y); kb.y = pg8::cvt_pk_bf16(x0.z, x0.w); kb.z = pg8::cvt_pk_bf16(x1.x, x1.y); kb.w = pg8::cvt_pk_bf16(x1.z, x1.w);
            acc = __builtin_amdgcn_mfma_f32_16x16x32_bf16(qa[ks], __builtin_bit_cast(bf16x8, kb), acc, 0, 0, 0); }
        if (MODE == 0) { if (bias) { const float bv = (bias[t * 16 + key] + nb) * LOG2E; acc += bv; } }
        else { acc += nb;
#pragma unroll
            for (int i = 0; i < 4; ++i) if (key > 4 * kq + i || key >= 8) acc[i] = -INFINITY; }
        s[t] = acc;
    }
#pragma unroll
    for (int kk = NVA; kk < NV; ++kk) vx[kk] = *(const f32x4*)((const char*)(Vb + (size_t)kk * KPI * stride) + voff);
    f32x4 mc = s[0];
#pragma unroll
    for (int t = 1; t < NTILE; ++t) { mc.x = fmaxf(mc.x, s[t].x); mc.y = fmaxf(mc.y, s[t].y); mc.z = fmaxf(mc.z, s[t].z); mc.w = fmaxf(mc.w, s[t].w); }
    mc.x = max16_f32(mc.x); mc.y = max16_f32(mc.y); mc.z = max16_f32(mc.z); mc.w = max16_f32(mc.w);
    float al[4];
#pragma unroll
    for (int i = 0; i < 4; ++i) { const float mn = fmaxf(w.m[i], mc[i]); al[i] = (mn == -INFINITY) ? 1.f : fexp2(w.m[i] - mn); w.m[i] = mn; w.l[i] *= al[i]; }
#pragma unroll
    for (int t = 0; t < NTILE; ++t) { f32x4 p;
#pragma unroll
        for (int i = 0; i < 4; ++i) { p[i] = (w.m[i] == -INFINITY) ? 0.f : fexp2(s[t][i] - w.m[i]); w.l[i] += p[i]; }
        if (kq < 2) *(LAS f32x4*)(PL + (t * 16 + key) * 8 + 4 * kq) = p; }
    if (key == 0 && kq < 2) *(LAS f32x4*)(PL + 1024 + 4 * kq) = (f32x4){al[0], al[1], al[2], al[3]};
    { const f32x4 a0 = *(const LAS f32x4*)(PL + 1024), a1 = *(const LAS f32x4*)(PL + 1028);
#pragma unroll
      for (int j = 0; j < 4; ++j) { w.o[0][j] *= a0.x; w.o[1][j] *= a0.y; w.o[2][j] *= a0.z; w.o[3][j] *= a0.w; w.o[4][j] *= a1.x; w.o[5][j] *= a1.y; w.o[6][j] *= a1.z; w.o[7][j] *= a1.w; } }
#pragma unroll
    for (int kk = 0; kk < NV; ++kk) { const int k = kk * KPI + ksub;
        const f32x4 v = vx[kk];
        const f32x4 pa = *(const LAS f32x4*)(PL + k * 8), pb = *(const LAS f32x4*)(PL + k * 8 + 4);
#pragma unroll
        for (int j = 0; j < 4; ++j) { w.o[0][j] += pa.x * v[j]; w.o[1][j] += pa.y * v[j]; w.o[2][j] += pa.z * v[j]; w.o[3][j] += pa.w * v[j];
                                      w.o[4][j] += pb.x * v[j]; w.o[5][j] += pb.y * v[j]; w.o[6][j] += pb.z * v[j]; w.o[7][j] += pb.w * v[j]; } }
}
__device__ __forceinline__ void dec_page_fox(DecW<64>& w, const bf16x8 (&qa)[2], const float* Kb, const float* Vb, const float* bias, float boff, LAS float* PL, int lane) {
    constexpr int stride = 512;
    const int key = lane & 15, kq = lane >> 4;
    const unsigned koff = (unsigned)(key * stride + 8 * kq) * 4u;
    const int d4 = lane & 15, ksub = lane >> 4;
    const unsigned voff = (unsigned)(ksub * stride + 4 * d4) * 4u;
    const __amdgpu_buffer_rsrc_t krs = __builtin_amdgcn_make_buffer_rsrc((void*)Kb, 0, 0x7fffffff, 0x00020000);
    const __amdgpu_buffer_rsrc_t vrs = __builtin_amdgcn_make_buffer_rsrc((void*)Vb, 0, 0x7fffffff, 0x00020000);
    const __amdgpu_buffer_rsrc_t brs = __builtin_amdgcn_make_buffer_rsrc((void*)bias, 0, 0x7fffffff, 0x00020000);
    f32x4 s[8];
#pragma unroll
    for (int hb = 0; hb < 2; ++hb) {
        f32x4 kx[4][4];
#pragma unroll
        for (int t = 0; t < 4; ++t) { const int so = (hb * 4 + t) * 16 * stride * 4;
            kx[t][0] = __builtin_bit_cast(f32x4, __builtin_amdgcn_raw_buffer_load_b128(krs, (int)koff, so, 0)); kx[t][1] = __builtin_bit_cast(f32x4, __builtin_amdgcn_raw_buffer_load_b128(krs, (int)koff + 16, so, 0));
            kx[t][2] = __builtin_bit_cast(f32x4, __builtin_amdgcn_raw_buffer_load_b128(krs, (int)koff + 128, so, 0)); kx[t][3] = __builtin_bit_cast(f32x4, __builtin_amdgcn_raw_buffer_load_b128(krs, (int)koff + 144, so, 0)); }
#pragma unroll
        for (int t = 0; t < 4; ++t) {
            f32x4 acc = {0.f, 0.f, 0.f, 0.f};
#pragma unroll
            for (int ks = 0; ks < 2; ++ks) { const f32x4 x0 = kx[t][2 * ks], x1 = kx[t][2 * ks + 1];
                v4u kb; kb.x = pg8::cvt_pk_bf16(x0.x, x0.y); kb.y = pg8::cvt_pk_bf16(x0.z, x0.w); kb.z = pg8::cvt_pk_bf16(x1.x, x1.y); kb.w = pg8::cvt_pk_bf16(x1.z, x1.w);
                acc = __builtin_amdgcn_mfma_f32_16x16x32_bf16(qa[ks], __builtin_bit_cast(bf16x8, kb), acc, 0, 0, 0); }
            acc += (__builtin_bit_cast(float, __builtin_amdgcn_raw_buffer_load_b32(brs, key * 4, (hb * 4 + t) * 64, 0)) + boff) * LOG2E;
            s[hb * 4 + t] = acc;
        }
        asm volatile("" ::: "memory");
    }
    f32x4 mc = s[0];
#pragma unroll
    for (int t = 1; t < 8; ++t) { mc.x = fmaxf(mc.x, s[t].x); mc.y = fmaxf(mc.y, s[t].y); mc.z = fmaxf(mc.z, s[t].z); mc.w = fmaxf(mc.w, s[t].w); }
    mc.x = max16_f32(mc.x); mc.y = max16_f32(mc.y); mc.z = max16_f32(mc.z); mc.w = max16_f32(mc.w);
    float al[4];
#pragma unroll
    for (int i = 0; i < 4; ++i) { const float mn = fmaxf(w.m[i], mc[i]); al[i] = fexp2(w.m[i] - mn); w.m[i] = mn; w.l[i] *= al[i]; }
    bool nz = false;
#pragma unroll
    for (int t = 0; t < 8; ++t) { f32x4 p;
#pragma unroll
        for (int i = 0; i < 4; ++i) { p[i] = fexp2(s[t][i] - w.m[i]); w.l[i] += p[i]; nz = nz || (p[i] != 0.f); }
        if (kq < 2) *(LAS f32x4*)(PL + (t * 16 + key) * 8 + 4 * kq) = p; }
    if (__ballot(nz && kq < 2) == 0ull) return;
    if (key == 0 && kq < 2) *(LAS f32x4*)(PL + 1024 + 4 * kq) = (f32x4){al[0], al[1], al[2], al[3]};
    { const f32x4 a0 = *(const LAS f32x4*)(PL + 1024), a1 = *(const LAS f32x4*)(PL + 1028);
#pragma unroll
      for (int j = 0; j < 4; ++j) { w.o[0][j] *= a0.x; w.o[1][j] *= a0.y; w.o[2][j] *= a0.z; w.o[3][j] *= a0.w; w.o[4][j] *= a1.x; w.o[5][j] *= a1.y; w.o[6][j] *= a1.z; w.o[7][j] *= a1.w; } }
#pragma unroll 1
    for (int vh = 0; vh < 2; ++vh) {
    f32x4 vx[16];
#pragma unroll
    for (int kk = 0; kk < 16; ++kk) vx[kk] = __builtin_bit_cast(f32x4, __builtin_amdgcn_raw_buffer_load_b128(vrs, (int)voff, (vh * 16 + kk) * 4 * stride * 4, 0));
#pragma unroll
    for (int kk = 0; kk < 16; ++kk) { const int k = (vh * 16 + kk) * 4 + ksub;
        const f32x4 v = vx[kk];
        const f32x4 pa = *(const LAS f32x4*)(PL + k * 8), pb = *(const LAS f32x4*)(PL + k * 8 + 4);
#pragma unroll
        for (int j = 0; j < 4; ++j) { w.o[0][j] += pa.x * v[j]; w.o[1][j] += pa.y * v[j]; w.o[2][j] += pa.z * v[j]; w.o[3][j] += pa.w * v[j];
                                      w.o[4][j] += pb.x * v[j]; w.o[5][j] += pb.y * v[j]; w.o[6][j] += pb.z * v[j]; w.o[7][j] += pb.w * v[j]; } }
    }
}
template <int D>
__device__ __forceinline__ void dec_park(DecW<D>& w, LAS float* CBw, int lane) {
    constexpr int LPK = D / 4;
    const int key = lane & 15, kq = lane >> 4, d4 = lane % LPK, ksub = lane / LPK;
#pragma unroll
    for (int i = 0; i < 4; ++i) { float l = w.l[i];
        l = sum16_f32(l);
        w.l[i] = l; }
    if (key == 0 && kq < 2) { *(LAS f32x4*)(CBw + 4 * kq) = (f32x4){w.m[0], w.m[1], w.m[2], w.m[3]}; *(LAS f32x4*)(CBw + 8 + 4 * kq) = (f32x4){w.l[0], w.l[1], w.l[2], w.l[3]}; }
#pragma unroll
    for (int q = 0; q < 8; ++q) { f32x4 v = (f32x4){w.o[q][0], w.o[q][1], w.o[q][2], w.o[q][3]};
        if (LPK < 64) {
#pragma unroll
            for (int o = LPK; o < 64; o <<= 1) { if (o == 16) { v.x += xor16_f32(v.x); v.y += xor16_f32(v.y); v.z += xor16_f32(v.z); v.w += xor16_f32(v.w); }
                else { v.x += __shfl_xor(v.x, o); v.y += __shfl_xor(v.y, o); v.z += __shfl_xor(v.z, o); v.w += __shfl_xor(v.w, o); } } }
        if (ksub == 0) *(LAS f32x4*)(CBw + 16 + q * D + 4 * d4) = v; }
}
template <int D>
__device__ __forceinline__ void dec_combine(int tid, LAS float* CB, bf16* dst, int ldd) {
    constexpr int WSTR = 16 + 8 * D;
    for (int e = tid; e < 8 * D; e += NTHR) { const int q = e / D, d = e % D;
        float mt = -INFINITY;
#pragma unroll
        for (int w = 0; w < 8; ++w) mt = fmaxf(mt, CB[w * WSTR + q]);
        float num = 0.f, den = 0.f;
#pragma unroll
        for (int w = 0; w < 8; ++w) { const float mw = CB[w * WSTR + q]; const float f = (mw == -INFINITY) ? 0.f : fexp2(mw - mt); num += f * CB[w * WSTR + 16 + q * D + d]; den += f * CB[w * WSTR + 8 + q]; }
        dst[(size_t)q * ldd + d] = (bf16)f2bf(num / den); }
}
template <int D>
__device__ __forceinline__ void dec_load_q(bf16x8 (&qa)[D / 32], const bf16* Q, int ldq, int lane) {
    const int row = lane & 15, kq = lane >> 4;
#pragma unroll
    for (int ks = 0; ks < D / 32; ++ks) { v4u z = {0u, 0u, 0u, 0u}; if (row < 8) z = *(const v4u*)(Q + (size_t)row * ldq + 32 * ks + 8 * kq); qa[ks] = __builtin_bit_cast(bf16x8, z); }
}
constexpr int DEC_PL = 1040;
__device__ __forceinline__ void fox_sample_unit(const Frame& F, const Args& a, int u) {
    unsigned char* ws = a.ws; const int bs = u >> 3, h = u & 7;
    int ln = lane_id(); asm volatile("" : "+v"(ln));
    LAS float* PL = (LAS float*)F.lds + F.wave * DEC_PL; LAS float* CB = (LAS float*)F.lds + 8 * DEC_PL; constexpr int WSTR = 16 + 8 * 64;
    bf16x8 qa[2]; dec_load_q<64>(qa, (const bf16*)(ws + WS_QF) + (size_t)(TP + bs * LS) * 512 + h * 64, 512, ln);
    DecW<64> w; dec_init(w);
    {
        const int key = ln & 15; const float* lf = a.out + O_LFS + (size_t)(bs * LS) * 8 + h; float cn = 0.f;
#pragma unroll
        for (int j = 0; j < 8; ++j) { const float x = lf[j * 8]; cn += (j <= key) ? x : 0.f; }
        const float* Kb = a.out + O_FKS + (size_t)(bs * LS) * 512 + h * 64; const float* Vb = a.out + O_FVS + (size_t)(bs * LS) * 512 + h * 64;
        dec_chunk<64, 1, 1>(w, qa, Kb, Vb, 512, nullptr, -cn * LOG2E, PL, ln);
        if (F.wave != 0) {
#pragma unroll
            for (int i = 0; i < 4; ++i) w.l[i] = 0.f;
#pragma unroll
            for (int q = 0; q < 8; ++q)
#pragma unroll
                for (int j = 0; j < 4; ++j) w.o[q][j] = 0.f; }
    }
    const int* pt = (const int*)a.in[I_PT];
    float spx; { const float ptv = (ln < 16) ? ((const float*)(ws + WS_MISC + 2 * MiB))[(bs * 8 + h) * NPAGES + ln] : 0.f; float v = ptv;
#pragma unroll
        for (int o = 1; o < 16; o <<= 1) { const float t = __builtin_bit_cast(float, __builtin_amdgcn_ds_bpermute((ln + o) << 2, __builtin_bit_cast(int, v))); if (ln + o < 16) v += t; }
        spx = v - ptv; }
#if defined(OLD_FOXS)
#pragma unroll 1
    for (int pp = 0; pp < 4; ++pp) { const int p = F.wave * 2 + (pp >> 1), hf = pp & 1; const int pg = __builtin_amdgcn_readfirstlane(pt[bs * NPAGES + p]);
        const float* Kb = (const float*)a.in[I_CFK] + (((size_t)pg * PAGE + hf * 64) * 8 + h) * 64; const float* Vb = (const float*)a.in[I_CFV] + (((size_t)pg * PAGE + hf * 64) * 8 + h) * 64;
        dec_chunk<64, 4, 0>(w, qa, Kb, Vb, 512, (const float*)(ws + WS_SUF) + (size_t)(bs * 8 + h) * PASTL + p * PAGE + hf * 64, __builtin_bit_cast(float, __builtin_amdgcn_ds_bpermute(p << 2, __builtin_bit_cast(int, spx))), PL, ln); }
#else
#pragma unroll 1
    for (int pp = 1; pp >= 0; --pp) { const int p = pp ? (NPAGES - 1 - F.wave) : F.wave;
        const int pg = __builtin_amdgcn_readfirstlane(pt[bs * NPAGES + p]);
        const float* Kb = (const float*)a.in[I_CFK] + ((size_t)pg * PAGE * 8 + h) * 64; const float* Vb = (const float*)a.in[I_CFV] + ((size_t)pg * PAGE * 8 + h) * 64;
        dec_page_fox(w, qa, Kb, Vb, (const float*)(ws + WS_SUF) + (size_t)(bs * 8 + h) * PASTL + p * PAGE, __builtin_bit_cast(float, __builtin_amdgcn_ds_bpermute(p << 2, __builtin_bit_cast(int, spx))), PL, ln); }
#endif
    dec_park<64>(w, CB + F.wave * WSTR, ln);
    __syncthreads();
    dec_combine<64>(F.wave * 64 + ln, CB, (bf16*)(ws + WS_MERGED) + (size_t)(TP + bs * LS) * DM + h * 64, DM);
    __syncthreads();
}
__device__ __forceinline__ void cross_sample_unit(const Frame& F, const Args& a, int u) {
    unsigned char* ws = a.ws; const int bs = u >> 2, h = u & 3;
    LAS float* PL = (LAS float*)F.lds + F.wave * DEC_PL; LAS float* CB = (LAS float*)F.lds + 8 * DEC_PL; constexpr int WSTR = 16 + 8 * 256;
    bf16x8 qa[8]; dec_load_q<256>(qa, (const bf16*)(ws + WS_QC) + (size_t)(TP + bs * LS) * DM + h * 256, DM, F.lane);
    DecW<256> w; dec_init(w);
    const float* Kb = (const float*)a.in[I_CMK] + ((size_t)(bs * 256 + F.wave * 32) * 4 + h) * 256; const float* Vb = (const float*)a.in[I_CMV] + ((size_t)(bs * 256 + F.wave * 32) * 4 + h) * 256;
#pragma unroll 1
    for (int c = 0; c < 2; ++c) dec_chunk<256, 1, 0>(w, qa, Kb + (size_t)c * 16 * 1024, Vb + (size_t)c * 16 * 1024, 1024, nullptr, 0.f, PL, F.lane);
    dec_park<256>(w, CB + F.wave * WSTR, F.lane);
    __syncthreads();
    dec_combine<256>(F.tid, CB, (bf16*)(ws + WS_OC) + (size_t)(TP + bs * LS) * DM + h * 256, DM);
    __syncthreads();
}


__device__ __forceinline__ void gla_g3_unit(const Frame& F, const Args& a, int u) {
    unsigned char* ws = a.ws;
    const int b = u >> 9, h = (u >> 7) & 3, n = u & 127; const int row0 = b * SEQ + n * 64;
    LAS unsigned char* KIB = F.lds; LAS unsigned char* ATTB = F.lds + 34816; LAS unsigned char* QDB = F.lds + 44032;
    LAS unsigned char* VSB = F.lds + 53248; LAS unsigned char* SPB = F.lds + 73728; LAS float* OS = (LAS float*)(F.lds + 94208);
#pragma unroll
    for (int i = 0; i < 2; ++i) { const int c = F.tid + NTHR * i; *(LAS v4u*)(VSB + (c >> 4) * 320 + (c & 15) * 16) = *(const v4u*)((const bf16*)(ws + WS_GV) + (size_t)(row0 + (c >> 4)) * 512 + h * 128 + (c & 15) * 8); }
#pragma unroll
    for (int i = 0; i < 4; ++i) { const int c4 = F.tid + NTHR * i; const f32x4 sp = *(const f32x4*)((const float*)(ws + WS_GKV) + ((size_t)((b * 4 + h) * 128 + n) * 64) * 128 + 4 * c4);
        v2u o; o.x = pg8::cvt_pk_bf16(sp.x, sp.y); o.y = pg8::cvt_pk_bf16(sp.z, sp.w); *(LAS v2u*)(SPB + (c4 >> 5) * 320 + (c4 & 31) * 8) = o; }
#pragma unroll
    for (int i = 0; i < 2; ++i) { const int c4 = F.tid + NTHR * i, t = c4 >> 4, d4 = (c4 & 15) * 4; const size_t gi = (size_t)(row0 + t) * 256 + h * 64 + d4;
        const f32x4 bb = *(const f32x4*)((const float*)(ws + WS_BB) + gi);
        const v2u qq = *(const v2u*)((const bf16*)(ws + WS_GQ) + gi), kk = *(const v2u*)((const bf16*)(ws + WS_GK) + gi);
        v2u qo, ko; qo.x = pg8::cvt_pk_bf16(bflo(qq.x) * __expf(bb.x), bfhi(qq.x) * __expf(bb.y)); qo.y = pg8::cvt_pk_bf16(bflo(qq.y) * __expf(bb.z), bfhi(qq.y) * __expf(bb.w));
        ko.x = pg8::cvt_pk_bf16(bflo(kk.x) * __expf(-bb.x), bfhi(kk.x) * __expf(-bb.y)); ko.y = pg8::cvt_pk_bf16(bflo(kk.y) * __expf(-bb.z), bfhi(kk.y) * __expf(-bb.w));
        *(LAS v2u*)(QDB + t * 144 + d4 * 2) = qo; *(LAS v2u*)(KIB + t * 144 + d4 * 2) = ko; }
    __syncthreads();
    {
        const int lane = F.lane, r32 = lane & 31, hi = lane >> 5;
        if (F.wave < 4) { const int tb = F.wave >> 1, sb = F.wave & 1; f32x16 acc = {};
            if (sb <= tb) {
                const LAS unsigned char* qrow = QDB + (32 * tb + r32) * 144; const LAS unsigned char* krow = KIB + (32 * sb + r32) * 144;
#pragma unroll
                for (int ks = 0; ks < 4; ++ks) acc = __builtin_amdgcn_mfma_f32_32x32x16_bf16(row_frag(qrow, ks, hi), row_frag(krow, ks, hi), acc, 0, 0, 0);
            }
#pragma unroll
            for (int r = 0; r < 16; ++r) { const int t = 32 * tb + crow(r, hi), s2 = 32 * sb + r32; *(LAS unsigned short*)(ATTB + t * 144 + s2 * 2) = (unsigned short)f2bf(s2 <= t ? acc[r] : 0.f); }
        }
    }
    __syncthreads();
    {
        const int lane = F.lane, r32 = lane & 31, hi = lane >> 5, tb = F.wave >> 2, nb = F.wave & 3;
        const int trb = (4 * hi + ((lane & 15) >> 2)) * 320 + (16 * ((lane >> 4) & 1) + 4 * (lane & 3)) * 2 + 64 * nb;
        const LAS unsigned char* arow = ATTB + (32 * tb + r32) * 144; const LAS unsigned char* qrow = QDB + (32 * tb + r32) * 144;
        f32x16 acc = {};
#pragma unroll
        for (int ks = 0; ks < 4; ++ks) acc = __builtin_amdgcn_mfma_f32_32x32x16_bf16(row_frag(arow, ks, hi), tr_frag<320>(VSB + trb, ks), acc, 0, 0, 0);
#pragma unroll
        for (int ks = 0; ks < 4; ++ks) acc = __builtin_amdgcn_mfma_f32_32x32x16_bf16(row_frag(qrow, ks, hi), tr_frag<320>(SPB + trb, ks), acc, 0, 0, 0);
#pragma unroll
        for (int r = 0; r < 16; ++r) OS[(32 * tb + crow(r, hi)) * 128 + 32 * nb + r32] = acc[r];
    }
    __syncthreads();
#pragma unroll
    for (int rr = 0; rr < 8; ++rr) { const int t = F.wave * 8 + rr; const float v0 = OS[t * 128 + F.lane], v1 = OS[t * 128 + 64 + F.lane];
        const float r = rsqrtf(wave_sum(v0 * v0 + v1 * v1) * (1.f / 128.f) + EPS);
        const float* ggo = (const float*)a.in[I_GGO] + h * 128; const BfPtr gr = GLD(ws + WS_GR) + ((size_t)(row0 + t) * 512 + h * 128);
        bf16* mo = (bf16*)(ws + WS_MERGED) + (size_t)(row0 + t) * DM + 512 + h * 128;
        mo[F.lane] = (bf16)f2bf(v0 * r * ggo[F.lane] * silu(gr[F.lane])); mo[64 + F.lane] = (bf16)f2bf(v1 * r * ggo[64 + F.lane] * silu(gr[64 + F.lane])); }
    __syncthreads();
}

struct EpiSoftmaxP {
    static constexpr bool PERM = true, AFTER_DRAIN = true;
    const LAS unsigned long long* argp;
    __device__ __forceinline__ void fused(f32x4 (&acc)[2][2][4][2], const Unit&, int wr, int wc, int fr, int fq, PG8_LAS unsigned char* lds, int wid, int lane) const {
        LAS float* PM = (LAS float*)lds; LAS float* PS = PM + 1024;
        const int ub = (int)blockIdx.x; const int ldp = DM;
        bf16* P = (bf16*)((unsigned char*)ld_ptr(argp + N_INPUTS + 1) + WS_PC) + ((size_t)((ub >> 7) & 1) * SEQ + (ub & 31) * 256) * DM + ((ub >> 5) & 3) * 256;
        { int t2 = lane_id(); asm volatile("" : "+v"(t2)); fr = t2 & 15; fq = (t2 >> 4) & 3; }
#pragma unroll
        for (int ai = 0; ai < 2; ++ai)
#pragma unroll
            for (int m = 0; m < 4; ++m) { float mx = -INFINITY;
#pragma unroll
                for (int bj = 0; bj < 2; ++bj)
#pragma unroll
                    for (int n = 0; n < 2; ++n) { const f32x4 x = acc[ai][bj][m][n]; mx = fmaxf(mx, fmaxf(fmaxf(x[0], x[1]), fmaxf(x[2], x[3]))); }
                mx = fmaxf(mx, xor16_f32(mx)); mx = fmaxf(mx, __shfl_xor(mx, 32));
                if (fq == 0) PM[(ai * 128 + wr * 64 + m * 16 + fr) * 4 + wc] = mx; }
        asm volatile("s_waitcnt lgkmcnt(0)" ::: "memory"); __builtin_amdgcn_s_barrier(); asm volatile("" ::: "memory");
#pragma unroll
        for (int ai = 0; ai < 2; ++ai)
#pragma unroll
            for (int m = 0; m < 4; ++m) { const int r = ai * 128 + wr * 64 + m * 16 + fr; const f32x4 pm = *(const LAS f32x4*)(PM + r * 4);
                const float M = fmaxf(fmaxf(pm[0], pm[1]), fmaxf(pm[2], pm[3])); float s = 0.f;
#pragma unroll
                for (int bj = 0; bj < 2; ++bj)
#pragma unroll
                    for (int n = 0; n < 2; ++n) { f32x4 x = acc[ai][bj][m][n]; x[0] = fexp2(x[0] - M); x[1] = fexp2(x[1] - M); x[2] = fexp2(x[2] - M); x[3] = fexp2(x[3] - M); acc[ai][bj][m][n] = x; s += (x[0] + x[1]) + (x[2] + x[3]); }
                s += xor16_f32(s); s += __shfl_xor(s, 32);
                if (fq == 0) PS[r * 4 + wc] = s; }
        asm volatile("s_waitcnt lgkmcnt(0)" ::: "memory"); __builtin_amdgcn_s_barrier(); asm volatile("" ::: "memory");
#pragma unroll
        for (int ai = 0; ai < 2; ++ai)
#pragma unroll
            for (int m = 0; m < 4; ++m) { const int r = ai * 128 + wr * 64 + m * 16 + fr; const f32x4 ps = *(const LAS f32x4*)(PS + r * 4); const float inv = 1.f / ((ps[0] + ps[1]) + (ps[2] + ps[3]));
#pragma unroll
                for (int bj = 0; bj < 2; ++bj) { const f32x4 x0 = acc[ai][bj][m][0], x1 = acc[ai][bj][m][1];
                    v4u o; o.x = pg8::cvt_pk_bf16(x0[0] * inv, x0[1] * inv); o.y = pg8::cvt_pk_bf16(x0[2] * inv, x0[3] * inv); o.z = pg8::cvt_pk_bf16(x1[0] * inv, x1[1] * inv); o.w = pg8::cvt_pk_bf16(x1[2] * inv, x1[3] * inv);
                    *(v4u*)(P + (size_t)r * ldp + bj * 128 + wc * 32 + fq * 8) = o; } }
        asm volatile("s_waitcnt lgkmcnt(0)" ::: "memory"); __builtin_amdgcn_s_barrier(); asm volatile("" ::: "memory");
    }
};

__device__ __forceinline__ void rms_rows_phase(const Frame& F, const float* X, const float* g, bf16* H) {
    const int gw = F.vcu * NWAVES + F.wave, NGW = F.G * NWAVES;
    for (int m = gw; m < TA; m += NGW) rms_row_bf16(X + (size_t)m * DM, g, H + (size_t)m * DM, F.lane);
}

__device__ __forceinline__ unsigned f2sort(float f) { const unsigned u = __builtin_bit_cast(unsigned, f); return u ^ ((u >> 31) ? 0xFFFFFFFFu : 0x80000000u); }
__device__ __forceinline__ float sort2f(unsigned s) { const unsigned u = s ^ ((s >> 31) ? 0x80000000u : 0xFFFFFFFFu); return __builtin_bit_cast(float, u); }
__device__ __forceinline__ float gelu_tanh(float x) { const float y = 0.7978845608028654f * (x + 0.044715f * x * x * x); const float e = __expf(2.f * y); return 0.5f * x * (1.f + (1.f - 2.f / (e + 1.f))); }
__device__ __forceinline__ unsigned gmax16(unsigned v) { return max16_u32(v); }
typedef __bf16 bf16x2_t __attribute__((ext_vector_type(2)));
__device__ __forceinline__ float dot2bf(unsigned a, unsigned b, float c) {
#if __has_builtin(__builtin_amdgcn_fdot2_f32_bf16)
    return __builtin_amdgcn_fdot2_f32_bf16(__builtin_bit_cast(bf16x2_t, a), __builtin_bit_cast(bf16x2_t, b), c, false);
#else
    return c + bflo(a) * bflo(b) + bfhi(a) * bfhi(b);
#endif
}
template <bool SPLIT>
__device__ __forceinline__ void peer_token(const Frame& F, const Args& a, int row, LAS unsigned* TOPS, const LAS unsigned* CT, int half, LAS float* PART) {
    unsigned char* ws = a.ws; const int lane = lane_id(), grp = lane >> 4, j16 = lane & 15;
    const bf16* sc = (const bf16*)(ws + WS_SC) + (size_t)row * 2048;
#pragma unroll 1
    for (int bt = 0; bt < 4; ++bt) {
        const v4u xq = *(const v4u*)(sc + (bt * 4 + grp) * 128 + 8 * j16);
        unsigned k[8]; const float xs[8] = {bflo(xq.x), bfhi(xq.x), bflo(xq.y), bfhi(xq.y), bflo(xq.z), bfhi(xq.z), bflo(xq.w), bfhi(xq.w)};
#pragma unroll
        for (int e = 0; e < 8; ++e) k[e] = (f2sort(xs[e]) & ~127u) | (unsigned)(127 - (8 * j16 + e));
#define PEER_CE(i, j) { const unsigned hi_ = k[i] > k[j] ? k[i] : k[j], lo_ = k[i] > k[j] ? k[j] : k[i]; k[i] = hi_; k[j] = lo_; }
        PEER_CE(0, 1) PEER_CE(2, 3) PEER_CE(4, 5) PEER_CE(6, 7)
        PEER_CE(0, 2) PEER_CE(1, 3) PEER_CE(4, 6) PEER_CE(5, 7)
        PEER_CE(1, 2) PEER_CE(5, 6)
        PEER_CE(0, 4) PEER_CE(1, 5) PEER_CE(2, 6) PEER_CE(3, 7)
        PEER_CE(2, 4) PEER_CE(3, 5)
        PEER_CE(1, 2) PEER_CE(3, 4) PEER_CE(5, 6)
#undef PEER_CE
        unsigned mine = 0u;
#pragma unroll 1
        for (int r = 0; r < 16; ++r) {
            const unsigned m = gmax16(k[0]);
            if (j16 == r) mine = m;
            const bool won = (k[0] == m);
#pragma unroll
            for (int e = 0; e < 7; ++e) k[e] = won ? k[e + 1] : k[e];
            k[7] = won ? 0u : k[7];
        }
        TOPS[(bt * 4 + grp) * 16 + j16] = mine;
    }
    int ex[2]; float gx[2], sux[2];
#pragma unroll
    for (int ps = 0; ps < 2; ++ps) {
        const int hd = ps * 4 + grp; const LAS unsigned* T1 = TOPS + (2 * hd) * 16; const LAS unsigned* T2 = T1 + 16;
        const unsigned c0_ = CT[j16], c1_ = CT[j16 + 16], c2_ = CT[j16 + 32], c3_ = CT[j16 + 48];
        const int ci0 = c0_ & 255, cj0 = c0_ >> 8, ci1 = c1_ & 255, cj1 = c1_ >> 8, ci2 = c2_ & 255, cj2 = c2_ >> 8, ci3 = c3_ & 255, cj3 = c3_ >> 8; const bool cv3 = (j16 + 48) < 50;
        unsigned k[4];
        { const float s0 = sort2f(T1[ci0] & ~127u) + sort2f(T2[cj0] & ~127u), s1 = sort2f(T1[ci1] & ~127u) + sort2f(T2[cj1] & ~127u),
                      s2 = sort2f(T1[ci2] & ~127u) + sort2f(T2[cj2] & ~127u), s3 = sort2f(T1[ci3] & ~127u) + sort2f(T2[cj3] & ~127u);
          k[0] = (f2sort(s0) & ~127u) | (unsigned)(127 - j16); k[1] = (f2sort(s1) & ~127u) | (unsigned)(127 - (j16 + 16)); k[2] = (f2sort(s2) & ~127u) | (unsigned)(127 - (j16 + 32));
          k[3] = cv3 ? ((f2sort(s3) & ~127u) | (unsigned)(127 - (j16 + 48))) : 0u; }
#define PEER_CE(i, j) { const unsigned hi_ = k[i] > k[j] ? k[i] : k[j], lo_ = k[i] > k[j] ? k[j] : k[i]; k[i] = hi_; k[j] = lo_; }
        PEER_CE(0, 1) PEER_CE(2, 3) PEER_CE(0, 2) PEER_CE(1, 3) PEER_CE(1, 2)
#undef PEER_CE
        unsigned mine = 0u;
#pragma unroll 1
        for (int r = 0; r < 16; ++r) {
            const unsigned m = gmax16(k[0]);
            if (j16 == r) mine = m;
            const bool won = (k[0] == m);
            k[0] = won ? k[1] : k[0]; k[1] = won ? k[2] : k[1]; k[2] = won ? k[3] : k[2]; k[3] = won ? 0u : k[3];
        }
        const int c = 127 - (int)(mine & 127u);
        int ci, cj;
        if (c < 16) { ci = 0; cj = c; } else if (c < 24) { ci = 1; cj = c - 16; } else if (c < 29) { ci = 2; cj = c - 24; } else if (c < 33) { ci = 3; cj = c - 29; }
        else if (c < 36) { ci = 4; cj = c - 33; } else if (c < 38) { ci = 5; cj = c - 36; } else if (c < 40) { ci = 6; cj = c - 38; } else if (c < 42) { ci = 7; cj = c - 40; } else { ci = c - 34; cj = 0; }
        const int i1 = 127 - (int)(T1[ci] & 127u), i2 = 127 - (int)(T2[cj] & 127u);
        ex[ps] = i1 * 128 + i2;
        const float sv = sort2f(mine & ~127u); const float s0 = __shfl(sv, lane & 48);
        float ee = __expf(sv - s0); const float es = sum16_f32(ee);
        const float* rsc = (const float*)(ws + WS_MISC);
        sux[ps] = rsc[ex[ps]]; gx[ps] = ee / es * rsc[16384 + ex[ps]];
    }
    {
        unsigned k0 = ((unsigned)ex[0] << 7) | (unsigned)lane, k1 = ((unsigned)ex[1] << 7) | (unsigned)(64 + lane);
#pragma unroll
        for (int k = 2; k <= 128; k <<= 1) {
#pragma unroll
            for (int j = k >> 1; j > 0; j >>= 1) {
                if (j == 64) { const unsigned lo = k0 < k1 ? k0 : k1, hi = k0 < k1 ? k1 : k0; k0 = lo; k1 = hi; }
                else {
                    unsigned p0, p1;
                    if (j == 32) { p0 = (unsigned)__shfl_xor((int)k0, 32); p1 = (unsigned)__shfl_xor((int)k1, 32); }
                    else if (j == 16) { p0 = xchg_xor_u32<16>(k0); p1 = xchg_xor_u32<16>(k1); } else if (j == 8) { p0 = xchg_xor_u32<8>(k0); p1 = xchg_xor_u32<8>(k1); }
                    else if (j == 4) { p0 = xchg_xor_u32<4>(k0); p1 = xchg_xor_u32<4>(k1); } else if (j == 2) { p0 = xchg_xor_u32<2>(k0); p1 = xchg_xor_u32<2>(k1); }
                    else { p0 = xchg_xor_u32<1>(k0); p1 = xchg_xor_u32<1>(k1); }
                    const bool low = (lane & j) == 0; const bool asc0 = (lane & k) == 0, asc1 = ((64 + lane) & k) == 0;
                    const unsigned mn0 = k0 < p0 ? k0 : p0, mx0 = k0 < p0 ? p0 : k0, mn1 = k1 < p1 ? k1 : p1, mx1 = k1 < p1 ? p1 : k1;
                    k0 = (low == asc0) ? mn0 : mx0; k1 = (low == asc1) ? mn1 : mx1;
                }
            }
        }
        const int o0 = (int)(k0 & 127u), o1 = (int)(k1 & 127u);
        const float g0a = __shfl(gx[0], o0 & 63), g0b = __shfl(gx[1], o0 & 63), g1a = __shfl(gx[0], o1 & 63), g1b = __shfl(gx[1], o1 & 63);
        const float s0a = __shfl(sux[0], o0 & 63), s0b = __shfl(sux[1], o0 & 63), s1a = __shfl(sux[0], o1 & 63), s1b = __shfl(sux[1], o1 & 63);
        gx[0] = (o0 & 64) ? g0b : g0a; gx[1] = (o1 & 64) ? g1b : g1a; sux[0] = (o0 & 64) ? s0b : s0a; sux[1] = (o1 & 64) ? s1b : s1a;
        ex[0] = (int)(k0 >> 7); ex[1] = (int)(k1 >> 7);
    }
    const float rstd2 = rsqrtf(((const float*)(ws + WS_SS))[TA + row] * (1.f / 1024.f) + EPS);
    float hf[16];
    { const bf16* hb = (const bf16*)(ws + WS_HB) + (size_t)row * DM + 4 * lane;
#pragma unroll
      for (int q = 0; q < 4; ++q) { const v2u hq = *(const v2u*)(hb + 256 * q); hf[4 * q] = bflo(hq.x); hf[4 * q + 1] = bfhi(hq.x); hf[4 * q + 2] = bflo(hq.y); hf[4 * q + 3] = bfhi(hq.y); } }
    float oacc[16];
#pragma unroll
    for (int i = 0; i < 16; ++i) oacc[i] = 0.f;
    const unsigned char* U = ws + WS_U16; const unsigned char* V = ws + WS_V16;
    v4u ub[8], vbA[8], vbB[8];
    const int gbeg = SPLIT ? 8 * half : 0, gend = SPLIT ? 8 * half + 8 : 16;
    const int addr32 = (lane ^ 32) << 2;
#define PEER_LOAD(buf, TAB, g) do { const int kk_ = (g) * 8; const int exs_ = (kk_ < 64) ? ex[0] : ex[1]; \
        _Pragma("unroll") for (int i = 0; i < 8; ++i) { const int e_ = __builtin_amdgcn_readlane(exs_, (kk_ & 63) + i); buf[i] = *(const v4u*)(TAB + (size_t)e_ * DM + 16 * lane); } } while (0)
#define PEER_DOTS(buf, g, wout) do { const int kk_ = (g) * 8; const float gxs_ = (kk_ < 64) ? gx[0] : gx[1]; const float sus_ = (kk_ < 64) ? sux[0] : sux[1]; float av[8]; \
        _Pragma("unroll") for (int i = 0; i < 8; ++i) { float s = 0.f; \
            _Pragma("unroll") for (int q = 0; q < 4; ++q) { const f32x2 lo = __builtin_amdgcn_cvt_pk_f32_fp8((int)buf[i][q], false), hi = __builtin_amdgcn_cvt_pk_f32_fp8((int)buf[i][q], true); \
                s += lo.x * hf[4 * q]; s += lo.y * hf[4 * q + 1]; s += hi.x * hf[4 * q + 2]; s += hi.y * hf[4 * q + 3]; } \
            av[i] = s; } \
        const bool b5 = lane & 32, b4 = lane & 16, b3_ = lane & 8; float bq[4], cq[2], dq; \
        _Pragma("unroll") for (int i = 0; i < 4; ++i) bq[i] = (b5 ? av[4 + i] : av[i]) + __builtin_bit_cast(float, __builtin_amdgcn_ds_bpermute(addr32, __builtin_bit_cast(int, b5 ? av[i] : av[4 + i])));     \
        _Pragma("unroll") for (int i = 0; i < 2; ++i) cq[i] = (b4 ? bq[2 + i] : bq[i]) + xor16_f32(b4 ? bq[i] : bq[2 + i]); \
        dq = (b3_ ? cq[1] : cq[0]) + DPP_F(b3_ ? cq[0] : cq[1], DPP_MIR);        \
        dq = sum8_f32(dq); \
        const int src = (kk_ & 63) + (lane >> 3); \
        wout = __shfl(gxs_, src) * gelu_tanh(dq * __shfl(sus_, src) * rstd2); } while (0)
#define PEER_ACC(buf, wv) do { _Pragma("unroll") for (int i = 0; i < 8; ++i) { const float w = __builtin_bit_cast(float, __builtin_amdgcn_readlane(__builtin_bit_cast(int, wv), 8 * i)); \
        _Pragma("unroll") for (int q = 0; q < 4; ++q) { const f32x2 lo = __builtin_amdgcn_cvt_pk_f32_fp8((int)buf[i][q], false), hi = __builtin_amdgcn_cvt_pk_f32_fp8((int)buf[i][q], true); \
            oacc[4 * q] += w * lo.x; oacc[4 * q + 1] += w * lo.y; oacc[4 * q + 2] += w * hi.x; oacc[4 * q + 3] += w * hi.y; } } } while (0)
    PEER_LOAD(ub, U, gbeg); PEER_LOAD(vbA, V, gbeg);
#pragma unroll 1
    for (int g0 = gbeg; g0 < gend; g0 += 2) {
        float w0, w1;
        PEER_DOTS(ub, g0, w0);
        PEER_LOAD(ub, U, g0 + 1); PEER_LOAD(vbB, V, g0 + 1);
        PEER_ACC(vbA, w0);
        PEER_DOTS(ub, g0 + 1, w1);
        { const int gn = (g0 + 2 < gend) ? g0 + 2 : g0 + 1;
          PEER_LOAD(ub, U, gn); PEER_LOAD(vbA, V, gn); }
        PEER_ACC(vbB, w1);
    }
#undef PEER_LOAD
#undef PEER_DOTS
#undef PEER_ACC
    if (SPLIT) {
        if (half == 1) {
#pragma unroll
            for (int q = 0; q < 4; ++q) *(LAS f32x4*)(PART + 16 * lane + 4 * q) = (f32x4){oacc[4 * q], oacc[4 * q + 1], oacc[4 * q + 2], oacc[4 * q + 3]}; }
        __syncthreads();
        if (half == 1) return;
#pragma unroll
        for (int q = 0; q < 4; ++q) { const f32x4 p = *(const LAS f32x4*)(PART + 16 * lane + 4 * q); oacc[4 * q] += p.x; oacc[4 * q + 1] += p.y; oacc[4 * q + 2] += p.z; oacc[4 * q + 3] += p.w; }
    }
    asm volatile("" : "+s"(row)); const int lane2 = lane_id();
    const f32x4* x2 = (const f32x4*)((const float*)(ws + WS_X2) + (size_t)row * DM) + lane2;
    f32x4 xv[4]; float ss = 0.f;
#pragma unroll
    for (int q = 0; q < 4; ++q) { xv[q] = x2[64 * q]; xv[q].x += oacc[4 * q]; xv[q].y += oacc[4 * q + 1]; xv[q].z += oacc[4 * q + 2]; xv[q].w += oacc[4 * q + 3]; ss += (xv[q].x * xv[q].x + xv[q].y * xv[q].y) + (xv[q].z * xv[q].z + xv[q].w * xv[q].w); }
    const float r = rsqrtf(wave_sum(ss) * (1.f / DM) + EPS);
    const f32x4* gf = (const f32x4*)((const float*)a.in[I_GFIN]) + lane2;
    f32x4* y = (f32x4*)(row < TP ? a.out + O_YP + (size_t)row * DM : a.out + O_YS + (size_t)(row - TP) * DM) + lane2;
#pragma unroll
    for (int q = 0; q < 4; ++q) { const f32x4 g4 = gf[64 * q]; f32x4 o; o.x = xv[q].x * r * g4.x; o.y = xv[q].y * r * g4.y; o.z = xv[q].z * r * g4.z; o.w = xv[q].w * r * g4.w; y[64 * q] = o; }
}
__device__ __forceinline__ void cand_ij(int c, int& ci, int& cj) {
    if (c < 16) { ci = 0; cj = c; } else if (c < 24) { ci = 1; cj = c - 16; } else if (c < 29) { ci = 2; cj = c - 24; } else if (c < 33) { ci = 3; cj = c - 29; }
    else if (c < 36) { ci = 4; cj = c - 33; } else if (c < 38) { ci = 5; cj = c - 36; } else if (c < 40) { ci = 6; cj = c - 38; } else if (c < 42) { ci = 7; cj = c - 40; } else if (c < 50) { ci = c - 34; cj = 0; } else { ci = 0; cj = 0; }
}
__device__ __forceinline__ void peer_phase(const Frame& F, const Args& a) {
    LAS unsigned* TOPS = (LAS unsigned*)F.lds + F.wave * 256;
    LAS unsigned* CT = (LAS unsigned*)F.lds + 8 * 256 + 4 * 1024;
    if (F.tid < 64) { int ci, cj; cand_ij(F.tid, ci, cj); CT[F.tid] = (unsigned)ci | ((unsigned)cj << 8); }
    __syncthreads();
    const int gw = F.vcu * NWAVES + F.wave, NGW = F.G * NWAVES;
    const int nfull = TA / NGW, rem = TA - nfull * NGW;
#pragma unroll 1
    for (int i = 0; i < nfull; ++i) peer_token<false>(F, a, gw + i * NGW, TOPS, CT, 0, nullptr);
    if (rem == 4 * F.G) {
        __syncthreads();
        peer_token<true>(F, a, nfull * NGW + F.vcu * 4 + (F.wave >> 1), TOPS, CT, F.wave & 1, (LAS float*)F.lds + 8 * 256 + (F.wave >> 1) * 1024);
    } else {
        const int row = gw + nfull * NGW; if (row < TA) peer_token<false>(F, a, row, TOPS, CT, 0, nullptr);
    }
}


template <class EpiS>
__device__ __forceinline__ void skinny_tile(const Frame& F, const bf16* A, int lda, const bf16* Bt, int ldb, int tm, int tn, const EpiS& E) {
    const int lane = F.lane, fr = lane & 15, fq = lane >> 4, w = F.wave, lr = lane >> 3, lc = lane & 7;
    LAS unsigned char* SA = F.lds + w * 16384; LAS unsigned char* SB = SA + 8192;
    const bf16* ag = A + (size_t)(tm * 64 + lr) * lda + w * 128 + 8 * lc;
    const bf16* bg = Bt + (size_t)(tn * 64 + lr) * ldb + w * 128 + 8 * lc;
    f32x4 acc[4][4];
#pragma unroll
    for (int m = 0; m < 4; ++m)
#pragma unroll
        for (int n = 0; n < 4; ++n) acc[m][n] = (f32x4){0.f, 0.f, 0.f, 0.f};
    v4u ar[2][8], br[2][8];
#pragma unroll
    for (int kh = 0; kh < 2; ++kh)
#pragma unroll
        for (int i = 0; i < 8; ++i) { ar[kh][i] = *(const v4u*)(ag + (size_t)(8 * i) * lda + 64 * kh); br[kh][i] = *(const v4u*)(bg + (size_t)(8 * i) * ldb + 64 * kh); }
#pragma unroll
    for (int kh = 0; kh < 2; ++kh) {
#pragma unroll
        for (int i = 0; i < 8; ++i) { const int row = 8 * i + lr; *(LAS v4u*)(SA + row * 128 + ((lc ^ (row & 7)) << 4)) = ar[kh][i]; *(LAS v4u*)(SB + row * 128 + ((lc ^ (row & 7)) << 4)) = br[kh][i]; }
        bf16x8 af[4][2], bfr[4][2];
#pragma unroll
        for (int m = 0; m < 4; ++m)
#pragma unroll
            for (int ks = 0; ks < 2; ++ks) { const int row = 16 * m + fr; const int off = row * 128 + (((4 * ks + fq) ^ (row & 7)) << 4);
                af[m][ks] = *(const LAS bf16x8*)(SA + off); bfr[m][ks] = *(const LAS bf16x8*)(SB + off); }
#pragma unroll
        for (int ks = 0; ks < 2; ++ks)
#pragma unroll
            for (int m = 0; m < 4; ++m)
#pragma unroll
                for (int n = 0; n < 4; ++n) acc[m][n] = __builtin_amdgcn_mfma_f32_16x16x32_bf16(bfr[n][ks], af[m][ks], acc[m][n], 0, 0, 0);
        asm volatile("s_waitcnt lgkmcnt(0)" ::: "memory");
    }
    LAS float* PS = (LAS float*)F.lds + w * 4096;
#pragma unroll
    for (int m = 0; m < 4; ++m)
#pragma unroll
        for (int n = 0; n < 4; ++n) *(LAS f32x4*)(PS + (16 * m + fr) * 64 + 4 * ((4 * n + fq) ^ fr)) = acc[m][n];
    lds_barrier();
    {
        const int row = F.tid >> 3, c8 = (F.tid & 7) * 8; const LAS float* PR = (const LAS float*)F.lds + row * 64;
        const int ch0 = 4 * (((F.tid & 7) * 2) ^ (row & 15)), ch1 = 4 * (((F.tid & 7) * 2 + 1) ^ (row & 15));
        f32x4 s0 = *(const LAS f32x4*)(PR + ch0), s1 = *(const LAS f32x4*)(PR + ch1);
#pragma unroll
        for (int ww = 1; ww < 8; ++ww) { s0 += *(const LAS f32x4*)(PR + ww * 4096 + ch0); s1 += *(const LAS f32x4*)(PR + ww * 4096 + ch1); }
        float v[8] = {s0.x, s0.y, s0.z, s0.w, s1.x, s1.y, s1.z, s1.w};
        E(tm * 64 + row, tn * 64 + c8, v, F.tid);
    }
    lds_barrier();
}
struct EpiSk {
    float* d32; int ld32; bf16* d16; int ld16; float sc16;
    const float* res; int ldr;
    const float* gcol; float* ssq; const float* rsq;
    __device__ __forceinline__ void operator()(int row, int col, float (&v)[8], int tid) const {
        if (rsq) { const float rs = rsqrtf(rsq[row] * (1.f / 1024.f) + EPS);
#pragma unroll
            for (int i = 0; i < 8; ++i) v[i] *= rs; }
        if (res) { const f32x4 a = *(const f32x4*)(res + (size_t)row * ldr + col), b = *(const f32x4*)(res + (size_t)row * ldr + col + 4);
            v[0] += a.x; v[1] += a.y; v[2] += a.z; v[3] += a.w; v[4] += b.x; v[5] += b.y; v[6] += b.z; v[7] += b.w; }
        if (d32) { *(f32x4*)(d32 + (size_t)row * ld32 + col) = (f32x4){v[0], v[1], v[2], v[3]}; *(f32x4*)(d32 + (size_t)row * ld32 + col + 4) = (f32x4){v[4], v[5], v[6], v[7]}; }
        if (ssq) { float ss = 0.f;
#pragma unroll
            for (int i = 0; i < 8; ++i) ss += v[i] * v[i];
            ss = sum8_f32(ss);
            if ((tid & 7) == 0) atomicAdd(ssq + row, ss); }
        if (d16) { float w8[8];
#pragma unroll
            for (int i = 0; i < 8; ++i) w8[i] = v[i];
            if (gcol) { const f32x4 a = *(const f32x4*)(gcol + col), b = *(const f32x4*)(gcol + col + 4); w8[0] *= a.x; w8[1] *= a.y; w8[2] *= a.z; w8[3] *= a.w; w8[4] *= b.x; w8[5] *= b.y; w8[6] *= b.z; w8[7] *= b.w; }
            v4u o; o.x = pg8::cvt_pk_bf16(w8[0] * sc16, w8[1] * sc16); o.y = pg8::cvt_pk_bf16(w8[2] * sc16, w8[3] * sc16); o.z = pg8::cvt_pk_bf16(w8[4] * sc16, w8[5] * sc16); o.w = pg8::cvt_pk_bf16(w8[6] * sc16, w8[7] * sc16);
            *(v4u*)(d16 + (size_t)row * ld16 + col) = o; }
    }
};

#define SK_TM16(t) (4 * (((t) >> 5) >> 1) + (((t) & 31) >> 3))
#define SK_TN16(t) (8 * (((t) >> 5) & 1) + ((t) & 7))
#define SK_TM32(t) (4 * ((((t) & 255) >> 5) >> 1) + ((((t) & 31) + 32 * ((t) >> 8)) >> 4))
#define SK_TN32(t) (16 * ((((t) & 255) >> 5) & 1) + ((((t) & 31) + 32 * ((t) >> 8)) & 15))


#ifndef PH_MAX
#define PH_MAX 99
#endif
__global__ void __launch_bounds__(NTHR, 2) mega_fwd(Args args) {
    extern __shared__ __attribute__((aligned(16))) unsigned char lds_raw[];
    Frame F;
    F.lds = (LAS unsigned char*)lds_raw;
    F.wave = __builtin_amdgcn_readfirstlane((int)threadIdx.x >> 6); F.lane = lane_id(); F.tid = F.wave * 64 + F.lane;
    F.G = gridDim.x; { const int bx = blockIdx.x; F.vcu = (F.G % 8 == 0) ? (bx % 8) * (F.G / 8) + bx / 8 : bx; }
    volatile LAS unsigned* MISC = (volatile LAS unsigned*)(F.lds + MISC_OFF);
    LAS unsigned long long* ARGP = (LAS unsigned long long*)(F.lds + ARGS_OFF);
    for (int u = F.tid; u < (LDS_BYTES - LDSCTL_OFF) / 4; u += NTHR) ((LAS unsigned*)(F.lds + LDSCTL_OFF))[u] = 0u;
    __syncthreads();
    if (F.tid == 0) {
        ARGP[0] = (unsigned long long)args.in[0];
        ARGP[1] = (unsigned long long)args.in[1];
        ARGP[2] = (unsigned long long)args.in[2];
        ARGP[3] = (unsigned long long)args.in[3];
        ARGP[4] = (unsigned long long)args.in[4];
        ARGP[5] = (unsigned long long)args.in[5];
        ARGP[6] = (unsigned long long)args.in[6];
        ARGP[7] = (unsigned long long)args.in[7];
        ARGP[8] = (unsigned long long)args.in[8];
        ARGP[9] = (unsigned long long)args.in[9];
        ARGP[10] = (unsigned long long)args.in[10];
        ARGP[11] = (unsigned long long)args.in[11];
        ARGP[12] = (unsigned long long)args.in[12];
        ARGP[13] = (unsigned long long)args.in[13];
        ARGP[14] = (unsigned long long)args.in[14];
        ARGP[15] = (unsigned long long)args.in[15];
        ARGP[16] = (unsigned long long)args.in[16];
        ARGP[17] = (unsigned long long)args.in[17];
        ARGP[18] = (unsigned long long)args.in[18];
        ARGP[19] = (unsigned long long)args.in[19];
        ARGP[20] = (unsigned long long)args.in[20];
        ARGP[21] = (unsigned long long)args.in[21];
        ARGP[22] = (unsigned long long)args.in[22];
        ARGP[23] = (unsigned long long)args.in[23];
        ARGP[24] = (unsigned long long)args.in[24];
        ARGP[25] = (unsigned long long)args.in[25];
        ARGP[26] = (unsigned long long)args.in[26];
        ARGP[27] = (unsigned long long)args.in[27];
        ARGP[28] = (unsigned long long)args.in[28];
        ARGP[N_INPUTS] = (unsigned long long)args.out; ARGP[N_INPUTS + 1] = (unsigned long long)args.ws;
    }
    __syncthreads();
    { const XcdBarrier bar0 = xcd_barrier_post((unsigned*)((gu32*)(args.ws + WS_CTL) + CW_BAR), MISC + 8, F.wave); if (F.tid == 0) MISC[10] = bar0.x; }
    __syncthreads();
#define GRID_BAR() do { XcdBarrier bar_; bar_.bar = (unsigned*)((gu32*)((unsigned char*)ld_ptr(ARGP + N_INPUTS + 1) + WS_CTL) + CW_BAR); bar_.x = MISC[10]; bar_.st = MISC + 8; bar_.wave = F.wave; xcd_barrier(bar_); } while (0)
#define PHASE_ARGS const Args A = load_args(ARGP); unsigned char* const ws = A.ws; float* const out = A.out; (void)ws; (void)out; { int l_ = lane_id(); asm volatile("" : "+v"(l_)); F.lane = l_; F.tid = F.wave * 64 + l_; }

    { PHASE_ARGS;
    p0_prologue(F, A);
    }
    GRID_BAR();
#if defined(PROBE_BAR8)
    GRID_BAR(); GRID_BAR(); GRID_BAR(); GRID_BAR(); GRID_BAR(); GRID_BAR(); GRID_BAR(); GRID_BAR();
#endif
#if PH_MAX >= 1
    { PHASE_ARGS;
    {
        pg8::Gemm g{(const bf16*)(ws + WS_HB), (const bf16*)(ws + WS_WIN), DM, DM, DM};
        pg8::StaticOrder S; S.init(TA, N_IN, F.G, (int)blockIdx.x);
        EpiInProj E{out, ws, (const float*)A.in[I_BFF]};
        pg8::gemm_phase(F.lds, g, S, E, F.wave);
    }
    {
        const int off = (TA / 256) * (N_IN / 256) % F.G;
        pg8::Gemm g{(const bf16*)(ws + WS_MB), (const bf16*)(ws + WS_WMK), DM, DM, DM};
        pg8::StaticOrder S; S.init(512, DM, F.G, ((int)blockIdx.x + F.G - off) % F.G);
        EpiGen E{out + O_MKP, DM, (bf16*)(ws + WS_MK16), DM, 1.f, nullptr, nullptr, 0, 0, nullptr, nullptr, nullptr};
        pg8::gemm_phase(F.lds, g, S, E, F.wave);
    }
    {
        const int off = ((TA / 256) * (N_IN / 256) + 8) % F.G;
        pg8::Gemm g{(const bf16*)(ws + WS_MB), (const bf16*)(ws + WS_WMV), DM, DM, DM};
        pg8::StaticOrder S; S.init(512, DM, F.G, ((int)blockIdx.x + F.G - off) % F.G);
        EpiGen E{out + O_MVP, DM, nullptr, 0, 1.f, nullptr, nullptr, 0, 0, nullptr, nullptr, nullptr};
        pg8::gemm_phase(F.lds, g, S, E, F.wave);
    }
    {
        const int off = ((TA / 256) * (N_IN / 256) + 16) % F.G;
        pg8::Gemm g{(const bf16*)(ws + WS_WMV), (const bf16*)(ws + WS_MB), DM, DM, DM};
        pg8::StaticOrder S; S.init(DM, 512, F.G, ((int)blockIdx.x + F.G - off) % F.G);
        EpiGen E{nullptr, 0, (bf16*)(ws + WS_MVT16), 512, 1.f, nullptr, nullptr, 0, 0, nullptr, nullptr, nullptr};
        pg8::gemm_phase(F.lds, g, S, E, F.wave);
    }
    }
    GRID_BAR();
#endif
#if PH_MAX >= 2
    asm volatile("; ===PHASE 2===");
    { PHASE_ARGS;
    {
        const int gw = F.vcu * NWAVES + F.wave, NGW = F.G * NWAVES;
        if ((gw & 3) == 0) for (int it = gw >> 2; it < 512; it += NGW >> 2) fox_norms_item(F, (const bf16*)(ws + WS_QF), (const bf16*)(ws + WS_KF), out + O_LFP, (float*)(ws + WS_MISC + MiB), (float*)(ws + WS_KBIAS), (float*)(ws + WS_MISC + MiB + 65536), it);
        for (int it = gw; it < NB_S * NPAGES; it += NGW) fox_suffix_item(F, (const float*)A.in[I_CFL], (const int*)A.in[I_PT], (float*)(ws + WS_SUF), (float*)(ws + WS_MISC + 2 * MiB), it);
        for (int u = F.vcu; u < 1024; u += F.G) gla_g1_unit(F, A, u);
        for (int u = F.vcu; u < 512; u += F.G) gla_sample_unit(F, A, u);
    }
    }
    GRID_BAR();
#endif
#if PH_MAX >= 3
    asm volatile("; ===PHASE 3===");
    { PHASE_ARGS;
    gla_scan(F, A);
    __syncthreads();
    for (int i = F.vcu; i < 256; i += F.G) { const int bh = i >> 4, s = i & 15;
        fox_attn_unit(F, (const bf16*)(ws + WS_QF), (const bf16*)(ws + WS_KF), (const bf16*)(ws + WS_VF), (const float*)(ws + WS_KBIAS), (const float*)(ws + WS_MISC + MiB + 65536), (const float*)(ws + WS_MISC + MiB), (bf16*)(ws + WS_MERGED), bh >> 3, bh & 7, s);
        fox_attn_unit(F, (const bf16*)(ws + WS_QF), (const bf16*)(ws + WS_KF), (const bf16*)(ws + WS_VF), (const float*)(ws + WS_KBIAS), (const float*)(ws + WS_MISC + MiB + 65536), (const float*)(ws + WS_MISC + MiB), (bf16*)(ws + WS_MERGED), bh >> 3, bh & 7, 31 - s); }
    }
    GRID_BAR();
#endif
#if PH_MAX >= 4
    asm volatile("; ===PHASE 4===");
    { PHASE_ARGS;
    if (!(F.vcu & 1)) { for (int u = F.vcu; u < 1024; u += F.G) gla_g3_unit(F, A, u); }
    }
    { PHASE_ARGS;
    for (int u = F.vcu; u < 1024; u += F.G) fox_sample_unit(F, A, u);
    }
    { PHASE_ARGS;
    if (F.vcu & 1) { for (int u = F.vcu; u < 1024; u += F.G) gla_g3_unit(F, A, u); }
    }
    GRID_BAR();
#endif
#if PH_MAX >= 5
    asm volatile("; ===PHASE 5===");
    { PHASE_ARGS;
    {
        pg8::Gemm g{(const bf16*)(ws + WS_MERGED), (const bf16*)(ws + WS_WOUT), DM, DM, DM};
        pg8::StaticOrder S; S.init(TP, DM, F.G, (int)blockIdx.x);
        EpiGen E{(float*)(ws + WS_X1), DM, (bf16*)(ws + WS_HB), DM, 1.f, (const float*)A.in[I_XP], (const float*)A.in[I_XS], TP, DM, (const float*)A.in[I_GCROSS], (float*)(ws + WS_SS), nullptr};
        pg8::gemm_phase(F.lds, g, S, E, F.wave);
        __syncthreads();
        EpiSk Es{(float*)(ws + WS_X1) + (size_t)TP * DM, DM, (bf16*)(ws + WS_HB) + (size_t)TP * DM, DM, 1.f, (const float*)A.in[I_XS], DM, (const float*)A.in[I_GCROSS], (float*)(ws + WS_SS) + TP, nullptr};
        for (int t = F.vcu; t < 256; t += F.G) skinny_tile(F, (const bf16*)(ws + WS_MERGED) + (size_t)TP * DM, DM, (const bf16*)(ws + WS_WOUT), DM, SK_TM16(t), SK_TN16(t), Es);
    }
    }
    GRID_BAR();
#endif
#if PH_MAX >= 7
    asm volatile("; ===PHASE 7===");
    { PHASE_ARGS;
    {
        pg8::Gemm g{(const bf16*)(ws + WS_HB), (const bf16*)(ws + WS_WCQ), DM, DM, DM};
        pg8::StaticOrder S; S.init(TP, DM, F.G, (int)blockIdx.x);
        EpiGen E{nullptr, 0, (bf16*)(ws + WS_QC), DM, C2C, nullptr, nullptr, 0, 0, nullptr, nullptr, (const float*)(ws + WS_SS)};
        pg8::gemm_phase(F.lds, g, S, E, F.wave);
        __syncthreads();
        EpiSk Es{nullptr, 0, (bf16*)(ws + WS_QC) + (size_t)TP * DM, DM, C2C, nullptr, 0, nullptr, nullptr, (const float*)(ws + WS_SS) + TP};
        for (int t = F.vcu; t < 256; t += F.G) skinny_tile(F, (const bf16*)(ws + WS_HB) + (size_t)TP * DM, DM, (const bf16*)(ws + WS_WCQ), DM, SK_TM16(t), SK_TN16(t), Es);
    }
    }
    GRID_BAR();
#endif
#if PH_MAX >= 8
    asm volatile("; ===PHASE 8===");
    { PHASE_ARGS;
    {
        const int u = (int)blockIdx.x, b = (u >> 7) & 1, h = (u >> 5) & 3, pnl = u & 31;
        const size_t roff = ((size_t)b * SEQ + pnl * 256) * DM + h * 256;
        if (F.vcu & 1) { for (int v = F.vcu; v < 512; v += F.G) cross_sample_unit(F, A, v); }
        pg8::Gemm g{(const bf16*)(ws + WS_QC) + roff, (const bf16*)(ws + WS_MK16) + (size_t)(b * 256) * DM + h * 256, DM, DM, 256};
        pg8::SingleUnit S{u < 256 ? 1 : 0, {0, 0}};
        EpiSoftmaxP E{ARGP};
        pg8::gemm_phase(F.lds, g, S, E, F.wave);
        VM_WAIT(); __syncthreads();
        {
            pg8::Gemm g2{(const bf16*)(ws + WS_PC) + roff, (const bf16*)(ws + WS_MVT16) + (size_t)(h * 256) * 512 + b * 256, DM, 512, 256};
            EpiGen E2{nullptr, 0, (bf16*)(ws + WS_OC) + roff, DM, 1.f, nullptr, nullptr, 0, 0, nullptr, nullptr, nullptr};
            pg8::gemm_phase(F.lds, g2, S, E2, F.wave);
        }
        __syncthreads();
        if (!(F.vcu & 1)) { for (int v = F.vcu; v < 512; v += F.G) cross_sample_unit(F, A, v); }
    }
    }
    GRID_BAR();
#endif
#if PH_MAX >= 10
    asm volatile("; ===PHASE 10===");
    { PHASE_ARGS;
    {
        pg8::Gemm g{(const bf16*)(ws + WS_OC), (const bf16*)(ws + WS_WCO), DM, DM, DM};
        pg8::StaticOrder S; S.init(TP, DM, F.G, (int)blockIdx.x);
        EpiGen E{(float*)(ws + WS_X2), DM, (bf16*)(ws + WS_HB), DM, 1.f, (const float*)(ws + WS_X1), (const float*)(ws + WS_X1), TA, DM, (const float*)A.in[I_GFFN], (float*)(ws + WS_SS) + TA, nullptr};
        pg8::gemm_phase(F.lds, g, S, E, F.wave);
        __syncthreads();
        EpiSk Es{(float*)(ws + WS_X2) + (size_t)TP * DM, DM, (bf16*)(ws + WS_HB) + (size_t)TP * DM, DM, 1.f, (const float*)(ws + WS_X1) + (size_t)TP * DM, DM, (const float*)A.in[I_GFFN], (float*)(ws + WS_SS) + TA + TP, nullptr};
        for (int t = F.vcu; t < 256; t += F.G) skinny_tile(F, (const bf16*)(ws + WS_OC) + (size_t)TP * DM, DM, (const bf16*)(ws + WS_WCO), DM, SK_TM16(t), SK_TN16(t), Es);
    }
    }
    GRID_BAR();
#endif
#if PH_MAX >= 12
    asm volatile("; ===PHASE 12===");
    { PHASE_ARGS;
    {
        pg8::Gemm g{(const bf16*)(ws + WS_HB), (const bf16*)(ws + WS_WPK), DM, DM, DM};
        pg8::StaticOrder S; S.init(TP, 2048, F.G, (int)blockIdx.x);
        EpiGen E{nullptr, 0, (bf16*)(ws + WS_SC), 2048, 1.f, nullptr, nullptr, 0, 0, nullptr, nullptr, (const float*)(ws + WS_SS) + TA};
        pg8::gemm_phase(F.lds, g, S, E, F.wave);
        __syncthreads();
        EpiSk Es{nullptr, 0, (bf16*)(ws + WS_SC) + (size_t)TP * 2048, 2048, 1.f, nullptr, 0, nullptr, nullptr, (const float*)(ws + WS_SS) + TA + TP};
        for (int t = F.vcu; t < 512; t += F.G) skinny_tile(F, (const bf16*)(ws + WS_HB) + (size_t)TP * DM, DM, (const bf16*)(ws + WS_WPK), DM, SK_TM32(t), SK_TN32(t), Es);
    }
    }
    GRID_BAR();
#endif
#if PH_MAX >= 13
    asm volatile("; ===PHASE 13===");
    { PHASE_ARGS;
    peer_phase(F, A);
    }
#endif
#if PH_MAX < 13
    {   PHASE_ARGS;
        const int gw = F.vcu * NWAVES + F.wave, NGW = F.G * NWAVES;
        for (int m = gw; m < TA; m += NGW) {
            const float* x = m < TP ? (const float*)A.in[I_XP] + (size_t)m * DM : (const float*)A.in[I_XS] + (size_t)(m - TP) * DM;
            float* y = m < TP ? out + O_YP + (size_t)m * DM : out + O_YS + (size_t)(m - TP) * DM;
            for (int j = 0; j < 4; ++j) ((f32x4*)y)[F.lane + 64 * j] = ((const f32x4*)x)[F.lane + 64 * j];
        }
    }
#endif

}

extern "C" void kernel_launch(void* const* d_in, const int* in_sizes, int n_in, void* d_out, int out_size, void* d_ws, size_t ws_size, hipStream_t stream) {
    static int grid = 0;
    if (grid == 0) {
        if (n_in != N_INPUTS || (size_t)out_size != O_TOTAL || ws_size < WS_END) { fprintf(stderr, "kernel_launch: unexpected shapes (n_in %d out %d ws %zu)\n", n_in, out_size, ws_size); grid = -1; return; }
        int dev = 0, cus = 0, per_cu = 0;
        if (hipGetDevice(&dev) != hipSuccess || hipDeviceGetAttribute(&cus, hipDeviceAttributeMultiprocessorCount, dev) != hipSuccess) { grid = -1; return; }
        if (hipFuncSetAttribute((const void*)mega_fwd, hipFuncAttributeMaxDynamicSharedMemorySize, LDS_BYTES) != hipSuccess) { fprintf(stderr, "kernel_launch: hipFuncSetAttribute failed\n"); grid = -1; return; }
        if (hipOccupancyMaxActiveBlocksPerMultiprocessor(&per_cu, (const void*)mega_fwd, NTHR, LDS_BYTES) != hipSuccess || per_cu < 1)
            fprintf(stderr, "kernel_launch: occupancy query reports %d workgroups per CU\n", per_cu);
        (void)hipGetLastError();
        grid = cus;
        if (grid > 256) grid = 256;
    }
    if (grid < 0) return;
    if (hipMemsetAsync((char*)d_ws + WS_CTL, 0, CTL_ZERO_BYTES, stream) != hipSuccess) return;
    Args a{};
    for (int i = 0; i < N_INPUTS; ++i) a.in[i] = d_in[i];
    a.out = (float*)d_out; a.ws = (unsigned char*)d_ws;
    hipLaunchKernelGGL(mega_fwd, dim3(grid), dim3(NTHR), LDS_BYTES, stream, a);
    const hipError_t le = hipPeekAtLastError();
    if (le != hipSuccess) fprintf(stderr, "kernel_launch: launch failed: %s\n", hipGetErrorName(le));
}
```

```cpp
#define PH_MAX 13
#include <hip/hip_runtime.h>
#include <cstdio>
#include <cstdint>

namespace pg8 {
#define PG8_LAS __attribute__((address_space(3)))
typedef unsigned short bf16_t;
typedef short bf16x8 __attribute__((ext_vector_type(8)));
typedef float f32x4 __attribute__((ext_vector_type(4)));
typedef unsigned u32x4 __attribute__((ext_vector_type(4)));
typedef unsigned u32x2 __attribute__((ext_vector_type(2)));
constexpr int BM = 256, BK = 64, HALF = 128, HTB = HALF * BK * 2  , STAGE_BYTES = 8 * HTB, NXCD = 8, WGM = 8;

__host__ __device__ __forceinline__ int lds_byte(int r, int c) { const int st = (r >> 4) * 2 + (c >> 5), rr = r & 15, cc = c & 31, ob = rr * 64 + cc * 2; return st * 1024 + (ob ^ (((ob >> 9) & 1) << 5)); }
__host__ __device__ __forceinline__ void stage_rc(int b, int& R, int& C) { const int st = b / 1024, sb = b % 1024, swz = sb ^ (((sb >> 9) & 1) << 5); R = (st >> 1) * 16 + swz / 64; C = (st & 1) * 32 + (swz % 64) / 2; }

__host__ __device__ __forceinline__ int perm32(int rho) { const int n = rho >> 4, i = rho & 15; return 8 * (i >> 2) + 4 * n + (i & 3); }

struct Unit { int pm, pn; };
struct Gemm { const bf16_t* A; const bf16_t* Bt; int lda, ldb, K; };

struct StaticOrder {
    int nM, nN, nwg, G, c;
    __host__ __device__ void init(int M, int N, int G_, int c_) { nM = M / BM; nN = N / BM; nwg = nM * nN; G = G_; c = c_; }
    __host__ __device__ bool next(int i, Unit& u) const {
        const long L = (long)i * G + c; if (L >= nwg) return false;
        int wgid = (int)L; { const int q = nwg / NXCD, r = nwg % NXCD, xcd = wgid % NXCD, off = wgid / NXCD; wgid = (xcd < r ? xcd * (q + 1) : r * (q + 1) + (xcd - r) * q) + off; }
        const int nig = WGM * nN, gid = wgid / nig, fm = gid * WGM, gsz = (nM - fm) < WGM ? (nM - fm) : WGM;
        u.pm = fm + ((wgid % nig) % gsz); u.pn = (wgid % nig) / gsz; return true;
    }
};
struct SingleUnit {
    int has; Unit u0;
    __host__ __device__ bool next(int i, Unit& u) const { if (i != 0 || !has) return false; u = u0; return true; }
};

__device__ __forceinline__ unsigned cvt_pk_bf16(float lo, float hi) { unsigned r; asm volatile("v_cvt_pk_bf16_f32 %0, %1, %2" : "=v"(r) : "v"(lo), "v"(hi)); return r; }

template <class Epi, class Sched>
__device__ __forceinline__ void gemm_phase(PG8_LAS unsigned char* lds, const Gemm g, const Sched& S, const Epi& E, int wave_id) {
    int lane; asm volatile("v_mbcnt_lo_u32_b32 %0, -1, 0\n\tv_mbcnt_hi_u32_b32 %0, -1, %0" : "=v"(lane));
    const int wid = wave_id; const int tid = wid * 64 + lane; const int wr = wid >> 2, wc = wid & 3, fr = lane & 15, fq = lane >> 4;
    const int K = g.K, nt = K / BK;
    unsigned voffA[2], voffB[2];
#pragma unroll
    for (int i = 0; i < 2; ++i) { int R, C; stage_rc(tid * 16 + i * 8192, R, C);
        const int Rb = Epi::PERM ? ((R & ~31) + perm32(R & 31)) : R;
        voffA[i] = (unsigned)(R * g.lda + C) * 2u; voffB[i] = (unsigned)(Rb * g.ldb + C) * 2u; }
    const size_t kstep = (size_t)(BK * 2);
    const size_t hstepA = (size_t)HALF * g.lda * 2, hstepB = (size_t)HALF * g.ldb * 2;
    const size_t tstepA = 2 * hstepA, tstepB = 2 * hstepB;
    const unsigned ldsw = (unsigned)wid * 1024u;
    const int aoff = lds_byte(wr * 64 + fr, fq * 8), boff = lds_byte(wc * 32 + fr, fq * 8);
#define PG8_SA(b, h) (((b) * 2 + (h)) * HTB)
#define PG8_SB(b, h) ((4 + (b) * 2 + (h)) * HTB)
#define PG8_STAGE(bufoff, gbase, voff) do { _Pragma("unroll") for (int _i = 0; _i < 2; ++_i) \
        __builtin_amdgcn_global_load_lds((const unsigned*)((const char*)(gbase) + (voff)[_i]), (PG8_LAS unsigned*)(lds + (bufoff) + ldsw + _i * 8192), 16, 0, 0); } while (0)
#define PG8_LDA(dst, b, h) do { _Pragma("unroll") for (int m = 0; m < 4; ++m) _Pragma("unroll") for (int k = 0; k < 2; ++k) dst[m][k] = *(const PG8_LAS bf16x8*)(lds + PG8_SA(b, h) + aoff + m * 2048 + k * 1024); } while (0)
#define PG8_LDB(dst, b, h) do { _Pragma("unroll") for (int n = 0; n < 2; ++n) _Pragma("unroll") for (int k = 0; k < 2; ++k) dst[n][k] = *(const PG8_LAS bf16x8*)(lds + PG8_SB(b, h) + boff + n * 2048 + k * 1024); } while (0)
#define PG8_MMA(ai, bj, At, Bt) do { __builtin_amdgcn_s_setprio(1); _Pragma("unroll") for (int m = 0; m < 4; ++m) _Pragma("unroll") for (int n = 0; n < 2; ++n) _Pragma("unroll") for (int k = 0; k < 2; ++k) \
        acc[ai][bj][m][n] = __builtin_amdgcn_mfma_f32_16x16x32_bf16(Bt[n][k], At[m][k], acc[ai][bj][m][n], 0, 0, 0); __builtin_amdgcn_s_setprio(0); } while (0)
#define PG8_WAIT_V(n) asm volatile("s_waitcnt vmcnt(" #n ")" ::: "memory")
#define PG8_WAIT_L(n) asm volatile("s_waitcnt lgkmcnt(" #n ")" ::: "memory")
#define PG8_BAR __builtin_amdgcn_s_barrier()
#define PG8_SCHED __builtin_amdgcn_sched_barrier(0)
    Unit cur, nxt; int ui = 0;
    if (!S.next(0, cur)) return;
    f32x4 acc[2][2][4][2];
#pragma unroll
    for (int a = 0; a < 2; ++a)
#pragma unroll
        for (int b = 0; b < 2; ++b)
#pragma unroll
            for (int m = 0; m < 4; ++m)
#pragma unroll
                for (int n = 0; n < 2; ++n) acc[a][b][m][n] = (f32x4){0.f, 0.f, 0.f, 0.f};
    bf16x8 At[4][2], B0[2][2], B1[2][2];
    const char* cA = (const char*)g.A + (size_t)cur.pm * tstepA; const char* cB = (const char*)g.Bt + (size_t)cur.pn * tstepB;
    PG8_STAGE(PG8_SB(0, 0), cB, voffB); PG8_STAGE(PG8_SB(0, 1), cB + hstepB, voffB); PG8_STAGE(PG8_SA(0, 0), cA, voffA); PG8_STAGE(PG8_SA(0, 1), cA + hstepA, voffA);
    if (wr == 1) PG8_BAR;
    PG8_WAIT_V(2); PG8_BAR;
    PG8_STAGE(PG8_SB(1, 0), cB + kstep, voffB); PG8_STAGE(PG8_SA(1, 0), cA + kstep, voffA); PG8_STAGE(PG8_SB(1, 1), cB + hstepB + kstep, voffB);
    PG8_WAIT_V(6); PG8_BAR;
    for (;;) {
        const bool has_next = S.next(ui + 1, nxt);
        const char* nA = has_next ? (const char*)g.A + (size_t)nxt.pm * tstepA : cA; const char* nB = has_next ? (const char*)g.Bt + (size_t)nxt.pn * tstepB : cB;
        for (int t = 0; t < nt; t += 2) {
            const bool last = (t == nt - 2);
            const char* a1 = cA + (size_t)(t + 1) * kstep;
            const char* a2 = last ? nA : cA + (size_t)(t + 2) * kstep; const char* b2 = last ? nB : cB + (size_t)(t + 2) * kstep;
            const char* a3 = a2 + kstep; const char* b3 = b2 + kstep;
            PG8_LDB(B0, 0, 0); PG8_LDB(B1, 0, 1); PG8_SCHED; PG8_LDA(At, 0, 0); PG8_STAGE(PG8_SA(1, 1), a1 + hstepA, voffA);
            PG8_WAIT_V(8); PG8_WAIT_L(0); PG8_BAR; PG8_MMA(0, 0, At, B0); PG8_MMA(0, 1, At, B1); PG8_BAR; PG8_SCHED;
            PG8_LDA(At, 0, 1); PG8_STAGE(PG8_SB(0, 0), b2, voffB); PG8_STAGE(PG8_SB(0, 1), b2 + hstepB, voffB); PG8_STAGE(PG8_SA(0, 0), a2, voffA);
            PG8_WAIT_V(8); PG8_WAIT_L(0); PG8_BAR; PG8_MMA(1, 0, At, B0); PG8_MMA(1, 1, At, B1); PG8_BAR; PG8_SCHED;
            PG8_LDB(B0, 1, 0); PG8_LDB(B1, 1, 1); PG8_SCHED; PG8_LDA(At, 1, 0); PG8_STAGE(PG8_SA(0, 1), a2 + hstepA, voffA);
            PG8_WAIT_V(8); PG8_WAIT_L(0); PG8_BAR; PG8_MMA(0, 0, At, B0); PG8_MMA(0, 1, At, B1); PG8_BAR; PG8_SCHED;
            PG8_LDA(At, 1, 1); PG8_STAGE(PG8_SB(1, 0), b3, voffB); PG8_STAGE(PG8_SB(1, 1), b3 + hstepB, voffB); PG8_STAGE(PG8_SA(1, 0), a3, voffA);
            PG8_WAIT_V(8); PG8_WAIT_L(0); PG8_BAR; PG8_MMA(1, 0, At, B0); PG8_MMA(1, 1, At, B1); PG8_BAR; PG8_SCHED;
        }
        if (wr == 0) PG8_BAR;
        if constexpr (!Epi::AFTER_DRAIN) { E(acc, cur, wr, wc, fr, fq); }
        if (!has_next) break;
#pragma unroll
        for (int a = 0; a < 2; ++a)
#pragma unroll
            for (int b = 0; b < 2; ++b)
#pragma unroll
                for (int m = 0; m < 4; ++m)
#pragma unroll
                    for (int n = 0; n < 2; ++n) acc[a][b][m][n] = (f32x4){0.f, 0.f, 0.f, 0.f};
        cur = nxt; cA = nA; cB = nB; ++ui;
        if (wr == 1) PG8_BAR;
    }
    PG8_WAIT_V(0);
    PG8_BAR;
    if constexpr (Epi::AFTER_DRAIN) { E.fused(acc, cur, wr, wc, fr, fq, lds, wid, lane); }
#undef PG8_SA
#undef PG8_SB
#undef PG8_STAGE
#undef PG8_LDA
#undef PG8_LDB
#undef PG8_MMA
#undef PG8_WAIT_V
#undef PG8_WAIT_L
#undef PG8_BAR
#undef PG8_SCHED
}
}

#define GAS __attribute__((address_space(1)))
#define LAS __attribute__((address_space(3)))
typedef unsigned short bf16;
typedef unsigned v4u __attribute__((ext_vector_type(4)));
typedef unsigned v2u __attribute__((ext_vector_type(2)));
typedef float f32x4 __attribute__((ext_vector_type(4)));
typedef float f32x2 __attribute__((ext_vector_type(2)));
typedef float f32x16 __attribute__((ext_vector_type(16)));
typedef short bf16x8 __attribute__((ext_vector_type(8)));
typedef short s16x4 __attribute__((ext_vector_type(4)));
typedef GAS unsigned gu32;
#define RLX_AGENT __ATOMIC_RELAXED, __HIP_MEMORY_SCOPE_AGENT
#define LDS_WAIT() asm volatile("s_waitcnt lgkmcnt(0)" ::: "memory")
#define VM_WAIT() asm volatile("s_waitcnt vmcnt(0)" ::: "memory")
__device__ __forceinline__ unsigned f2bf(float f) { unsigned u = __builtin_bit_cast(unsigned, f); return (u + 0x7fffu + ((u >> 16) & 1u)) >> 16; }
__device__ __forceinline__ unsigned pk2(float lo, float hi) { return f2bf(lo) | (f2bf(hi) << 16); }
__device__ __forceinline__ float bf2f(unsigned short b) { return __builtin_bit_cast(float, (unsigned)b << 16); }
__device__ __forceinline__ float bflo(unsigned u) { return __builtin_bit_cast(float, u << 16); }
__device__ __forceinline__ float bfhi(unsigned u) { return __builtin_bit_cast(float, u & 0xffff0000u); }


typedef short v4i16_t __attribute__((ext_vector_type(4)));
__device__ __forceinline__ s16x4 lds_tr16(LAS unsigned char* p) { return __builtin_bit_cast(s16x4, __builtin_amdgcn_ds_read_tr16_b64_v4i16((LAS v4i16_t*)p)); }
__device__ __forceinline__ int crow(int r, int hi) { return (r & 3) + 8 * (r >> 2) + 4 * hi; }

#define DPP_I(v, ctrl) __builtin_amdgcn_update_dpp(0, (v), (ctrl), 0xF, 0xF, false)
#define DPP_F(v, ctrl) __builtin_bit_cast(float, __builtin_amdgcn_update_dpp(0, __builtin_bit_cast(int, (v)), (ctrl), 0xF, 0xF, false))
constexpr int DPP_X1 = 0xB1, DPP_X2 = 0x4E, DPP_HMIR = 0x141, DPP_MIR = 0x140;
__device__ __forceinline__ unsigned max16_u32(unsigned v) {
    unsigned t = (unsigned)DPP_I((int)v, DPP_X1); v = v > t ? v : t; t = (unsigned)DPP_I((int)v, DPP_X2); v = v > t ? v : t;
    t = (unsigned)DPP_I((int)v, DPP_HMIR); v = v > t ? v : t; t = (unsigned)DPP_I((int)v, DPP_MIR); v = v > t ? v : t; return v; }
__device__ __forceinline__ float sum8_f32(float v) { v += DPP_F(v, DPP_X1); v += DPP_F(v, DPP_X2); v += DPP_F(v, DPP_HMIR); return v; }
__device__ __forceinline__ float sum16_f32(float v) { v = sum8_f32(v); v += DPP_F(v, DPP_MIR); return v; }
__device__ __forceinline__ float max16_f32(float v) { v = fmaxf(v, DPP_F(v, DPP_X1)); v = fmaxf(v, DPP_F(v, DPP_X2)); v = fmaxf(v, DPP_F(v, DPP_HMIR)); v = fmaxf(v, DPP_F(v, DPP_MIR)); return v; }
__device__ __forceinline__ float xor16_f32(float v) { return __builtin_bit_cast(float, __builtin_amdgcn_ds_swizzle(__builtin_bit_cast(int, v), 0x1F | (16 << 10))); }
__device__ __forceinline__ float sum64_f32(float v) {
    v = sum16_f32(v); v += xor16_f32(v);
    return __builtin_bit_cast(float, __builtin_amdgcn_readlane(__builtin_bit_cast(int, v), 0)) + __builtin_bit_cast(float, __builtin_amdgcn_readlane(__builtin_bit_cast(int, v), 32)); }
template <int J> __device__ __forceinline__ unsigned xchg_xor_u32(unsigned v) {
    if constexpr (J == 1) return (unsigned)DPP_I((int)v, DPP_X1);
    else if constexpr (J == 2) return (unsigned)DPP_I((int)v, DPP_X2);
    else return (unsigned)__builtin_amdgcn_ds_swizzle((int)v, 0x1F | (J << 10)); }

template <int SB>
__device__ __forceinline__ bf16x8 tr_frag(LAS unsigned char* base, int ks) {
    const s16x4 lo = lds_tr16(base + ks * 16 * SB), hi4 = lds_tr16(base + ks * 16 * SB + 8 * SB);
    return (bf16x8){lo[0], lo[1], lo[2], lo[3], hi4[0], hi4[1], hi4[2], hi4[3]};
}
__device__ __forceinline__ bf16x8 row_frag(const LAS unsigned char* rowp, int ks, int hi) {
    const v2u lo = *(const LAS v2u*)(rowp + (16 * ks + 4 * hi) * 2), hi2 = *(const LAS v2u*)(rowp + (16 * ks + 8 + 4 * hi) * 2);
    return __builtin_bit_cast(bf16x8, (v4u){lo.x, lo.y, hi2.x, hi2.y});
}
__device__ __forceinline__ void lds_barrier() { asm volatile("s_waitcnt lgkmcnt(0)\n\ts_barrier" ::: "memory"); }

struct BfPtr { const unsigned short* p; __device__ __forceinline__ float operator[](size_t i) const { return __builtin_bit_cast(float, (unsigned)p[i] << 16); }
               __device__ __forceinline__ BfPtr operator+(size_t o) const { return BfPtr{p + o}; } };
#define GLD(ptr) (BfPtr{(const unsigned short*)(ptr)})

__device__ __forceinline__ int lane_id() { int r; asm volatile("v_mbcnt_lo_u32_b32 %0, -1, 0\n\tv_mbcnt_hi_u32_b32 %0, -1, %0" : "=v"(r)); return r; }
#define TID_IS_ZERO(wave_) ((wave_) == 0 && lane_id() == 0)
#define XB_TMO      128
#define XB_XCNT(j)  (256  + 64 * (j))
#define XB_XSUB(j)  (1280 + 64 * (j))
#define XB_XGEN(j)  (2304 + 64 * (j))
#define XB_TOP      3328
#define XB_TOPGEN   3392
#define XCD_BAR_WORDS 3456
#define XB_SPIN_CAP (1u << 18)

__device__ __forceinline__ unsigned xb_ld(unsigned* p)              { return __hip_atomic_load(p, __ATOMIC_RELAXED, __HIP_MEMORY_SCOPE_AGENT); }
__device__ __forceinline__ unsigned xb_add(unsigned* p, unsigned v) { return __hip_atomic_fetch_add(p, v, __ATOMIC_RELAXED, __HIP_MEMORY_SCOPE_AGENT); }
__device__ __forceinline__ unsigned xb_xcc_id() { return (unsigned)__builtin_amdgcn_s_getreg((3 << 11) | 20) & 0xFu; }
#define XB_SPIN(cond, bar) do { unsigned _sp = 0; while (cond) { __builtin_amdgcn_s_sleep(1); \
    if ((++_sp & 255u) == 0u) { if (xb_ld(&(bar)[XB_TMO])) break; if (_sp > XB_SPIN_CAP) { atomicAdd(&(bar)[XB_TMO], 1u); break; } } } } while (0)

struct XcdBarrier {
    unsigned* bar; unsigned x; int wave;
    volatile LAS unsigned* st;
};

__device__ __forceinline__ XcdBarrier xcd_barrier_post(unsigned* bar, volatile LAS unsigned* st, int wave) {
    XcdBarrier b; b.bar = bar; b.x = xb_xcc_id(); b.st = st; b.wave = wave;
    if (TID_IS_ZERO(wave)) (void)xb_add(&bar[XB_XCNT(b.x)], 1u);
    return b;
}
__device__ __forceinline__ void xcd_barrier_complete(unsigned* bar, unsigned x, unsigned& nloc, unsigned& nx) {
    const unsigned G = gridDim.x * gridDim.y * gridDim.z;
    unsigned sum, cnt, mine, sp = 0u;
    for (;;) {
        sum = 0u; cnt = 0u; mine = 0u;
#pragma unroll
        for (unsigned j = 0; j < 16; ++j) { const unsigned c = xb_ld(&bar[XB_XCNT(j)]); sum += c; cnt += (c > 0u) ? 1u : 0u; mine = (j == x) ? c : mine; }
        if (sum == G) break;
        __builtin_amdgcn_s_sleep(1);
        if ((++sp & 255u) == 0u) { if (xb_ld(&bar[XB_TMO])) break; if (sp > XB_SPIN_CAP) { atomicAdd(&bar[XB_TMO], 1u); break; } }
    }
    nloc = mine > 0u ? mine : 1u; nx = cnt > 0u ? cnt : 1u;
}

__device__ __forceinline__ void xcd_barrier(const XcdBarrier& b) {
    asm volatile("s_waitcnt vmcnt(0)" ::: "memory");
    __syncthreads();
    if (TID_IS_ZERO(b.wave)) {
        unsigned* bar = b.bar;
        __builtin_amdgcn_s_waitcnt(0);
        unsigned nloc = b.st[0], nx = b.st[1];
        if (nloc == 0u) { xcd_barrier_complete(bar, b.x, nloc, nx); b.st[0] = nloc; b.st[1] = nx; }
        const unsigned old = xb_add(&bar[XB_XSUB(b.x)], 1u);
        const unsigned gen = old / nloc;
        if (old + 1u == (gen + 1u) * nloc) {
            __builtin_amdgcn_fence(__ATOMIC_RELEASE, "agent");
            asm volatile("s_waitcnt vmcnt(0)" ::: "memory");
            const unsigned og = xb_add(&bar[XB_TOP], 1u);
            const unsigned tg = og / nx;
            if (og + 1u == (tg + 1u) * nx) xb_add(&bar[XB_TOPGEN], 1u);
            else XB_SPIN(xb_ld(&bar[XB_TOPGEN]) == tg, bar);
            __builtin_amdgcn_fence(__ATOMIC_ACQUIRE, "agent");
            xb_add(&bar[XB_XGEN(b.x)], 1u);
            asm volatile("s_waitcnt vmcnt(0)" ::: "memory");
        } else {
            XB_SPIN(xb_ld(&bar[XB_XGEN(b.x)]) == gen, bar);
            __builtin_amdgcn_fence(__ATOMIC_ACQUIRE, "agent");
            asm volatile("s_waitcnt vmcnt(0)" ::: "memory");
        }
    }
    __syncthreads();
}


constexpr int NWAVES = 8, NTHR = 512;
constexpr int DM = 1024, TP = 16384, TS = 1024, TA = TP + TS, SEQ = 8192, NB_P = 2, NB_S = 128, LS = 8;
constexpr int N_IN = 3328;
constexpr int PASTL = 2048, PAGE = 128, NPAGES = 16;
constexpr float EPS = 1e-6f;
constexpr float LOG2E = 1.4426950408889634f;
constexpr float C2F = 0.125f * LOG2E;
constexpr float C2C = 0.0625f * LOG2E;

enum { I_XP = 0, I_XS, I_CFK, I_CFV, I_CFL, I_SGLA, I_CMK, I_CMV, I_PT, I_MEMP, I_GMIX, I_WIN, I_BFF, I_WG2, I_BG, I_GGO, I_WOUT, I_GCROSS, I_GMEM,
       I_WMK, I_WMV, I_WCQ, I_WCO, I_GFFN, I_PWQ, I_PSK, I_PU, I_PV, I_GFIN, N_INPUTS };
constexpr size_t O_YP = 0, O_YS = 16777216, O_FKP = 17825792, O_FVP = 26214400, O_LFP = 34603008, O_GSP = 34734080, O_MKP = 34799616, O_MVP = 35323904,
                 O_FKS = 35848192, O_FVS = 36372480, O_LFS = 36896768, O_GSS = 36904960, O_TOTAL = 41099264;

constexpr size_t MiB = 1u << 20;
constexpr size_t WS_CTL = 0, CTL_ZERO_BYTES = 1 * MiB;
constexpr size_t WS_WIN = 2 * MiB, WS_WOUT = 10 * MiB, WS_WMK = 12 * MiB, WS_WMV = 14 * MiB, WS_WCQ = 16 * MiB, WS_WCO = 18 * MiB, WS_WPK = 20 * MiB;
constexpr size_t WS_MB = 24 * MiB, WS_MK16 = 25 * MiB, WS_MVT16 = 26 * MiB, WS_KBIAS = 27 * MiB, WS_GDEC = 28 * MiB, WS_GG = 29 * MiB;
constexpr size_t WS_U16 = 32 * MiB, WS_V16 = 64 * MiB, WS_HB = 96 * MiB, WS_QF = 132 * MiB, WS_KF = 150 * MiB, WS_VF = 168 * MiB;
constexpr size_t WS_GQ = 186 * MiB, WS_GK = 204 * MiB, WS_GV = 222 * MiB, WS_GR = 256 * MiB, WS_SUF = 290 * MiB, WS_GKV = 298 * MiB;
constexpr size_t WS_MERGED = 330 * MiB, WS_X1 = 364 * MiB, WS_X2 = 432 * MiB, WS_QC = 500 * MiB, WS_PC = 534 * MiB, WS_OC = 566 * MiB, WS_SC = 600 * MiB;
constexpr size_t WS_MISC = 736 * MiB, WS_SS = 740 * MiB  , WS_BB = 744 * MiB, WS_END = 800 * MiB;
constexpr int CW_BAR = 4096;

constexpr int RING_BYTES = 131072;
constexpr int LDSCTL_OFF = RING_BYTES, MISC_OFF = LDSCTL_OFF + 320;
constexpr int ARGS_OFF = MISC_OFF + 128;
constexpr int LDS_BYTES = 147456;

struct Args { const void* in[N_INPUTS]; float* out; unsigned char* ws; };

__device__ __forceinline__ const void* ld_ptr(const LAS unsigned long long* p) { const unsigned long long v = *p; const unsigned lo = __builtin_amdgcn_readfirstlane((unsigned)v), hi = __builtin_amdgcn_readfirstlane((unsigned)(v >> 32)); return (const void*)(const GAS char*)(((unsigned long long)hi << 32) | lo); }
__device__ __forceinline__ Args load_args(const LAS unsigned long long* ARGP) { Args A;
    A.in[0] = ld_ptr(ARGP + 0);
    A.in[1] = ld_ptr(ARGP + 1);
    A.in[2] = ld_ptr(ARGP + 2);
    A.in[3] = ld_ptr(ARGP + 3);
    A.in[4] = ld_ptr(ARGP + 4);
    A.in[5] = ld_ptr(ARGP + 5);
    A.in[6] = ld_ptr(ARGP + 6);
    A.in[7] = ld_ptr(ARGP + 7);
    A.in[8] = ld_ptr(ARGP + 8);
    A.in[9] = ld_ptr(ARGP + 9);
    A.in[10] = ld_ptr(ARGP + 10);
    A.in[11] = ld_ptr(ARGP + 11);
    A.in[12] = ld_ptr(ARGP + 12);
    A.in[13] = ld_ptr(ARGP + 13);
    A.in[14] = ld_ptr(ARGP + 14);
    A.in[15] = ld_ptr(ARGP + 15);
    A.in[16] = ld_ptr(ARGP + 16);
    A.in[17] = ld_ptr(ARGP + 17);
    A.in[18] = ld_ptr(ARGP + 18);
    A.in[19] = ld_ptr(ARGP + 19);
    A.in[20] = ld_ptr(ARGP + 20);
    A.in[21] = ld_ptr(ARGP + 21);
    A.in[22] = ld_ptr(ARGP + 22);
    A.in[23] = ld_ptr(ARGP + 23);
    A.in[24] = ld_ptr(ARGP + 24);
    A.in[25] = ld_ptr(ARGP + 25);
    A.in[26] = ld_ptr(ARGP + 26);
    A.in[27] = ld_ptr(ARGP + 27);
    A.in[28] = ld_ptr(ARGP + 28);
    A.out = (float*)ld_ptr(ARGP + N_INPUTS); A.ws = (unsigned char*)ld_ptr(ARGP + N_INPUTS + 1); return A; }
struct Frame {
    LAS unsigned char* lds;
    int tid, lane, wave, vcu, G;
};

__device__ __forceinline__ float wave_sum(float v) { return sum64_f32(v); }
__device__ __forceinline__ float log_sigmoid(float x) { return fminf(x, 0.f) - __logf(1.f + __expf(-fabsf(x))); }

__device__ __forceinline__ int win_src_col(int r) {
    if (r < 1536) return r;
    if (r < 1792) return 1544 + (r - 1536);
    if (r < 2048) return 1800 + (r - 1792);
    if (r < 2560) return 2056 + (r - 2048);
    if (r < 3072) return 2584 + (r - 2560);
    if (r < 3080) return 1536 + (r - 3072);
    if (r < 3096) return 2568 + (r - 3080);
    return -1;
}
template <bool WIN>
__device__ __forceinline__ void p0_transpose_item(const float* W, int ldw, int K, int nblk, bf16* WT, LAS float* scr, int item, int lane) {
    const int kb = item / nblk, nb = item % nblk, k0 = 64 * kb, n0 = 32 * nb;
    const int dr = n0 + (lane & 31); const int sc = WIN ? win_src_col(dr) : dr;
#pragma unroll 8
    for (int i = 0; i < 32; ++i) { const int kk = 2 * i + (lane >> 5); scr[kk * 33 + (lane & 31)] = (sc >= 0) ? W[(size_t)(k0 + kk) * ldw + sc] : 0.f; }
    LDS_WAIT(); asm volatile("" ::: "memory");
    const int c = lane & 7;
#pragma unroll
    for (int j = 0; j < 4; ++j) { const int n = (lane >> 3) + 8 * j; const LAS float* s = scr + (8 * c) * 33 + n;
        v4u o; o.x = pk2(s[0 * 33], s[1 * 33]); o.y = pk2(s[2 * 33], s[3 * 33]); o.z = pk2(s[4 * 33], s[5 * 33]); o.w = pk2(s[6 * 33], s[7 * 33]);
        *(GAS v4u*)(WT + (size_t)(n0 + n) * K + k0 + 8 * c) = o; }
    LDS_WAIT(); asm volatile("" ::: "memory");
}
__device__ __forceinline__ void rms_row_bf16(const float* xrow, const float* g, bf16* orow, int lane) {
    const f32x4* xr = (const f32x4*)xrow + lane; const f32x4* gr = (const f32x4*)g + lane;
    f32x4 v[4]; float s = 0.f;
#pragma unroll
    for (int j = 0; j < 4; ++j) { v[j] = xr[64 * j]; s += (v[j].x * v[j].x + v[j].y * v[j].y) + (v[j].z * v[j].z + v[j].w * v[j].w); }
    const float r = rsqrtf(wave_sum(s) * (1.f / DM) + EPS);
    v2u* o8 = (v2u*)orow + lane;
#pragma unroll
    for (int j = 0; j < 4; ++j) { const f32x4 gg = gr[64 * j]; v2u o; o.x = pk2(v[j].x * r * gg.x, v[j].y * r * gg.y); o.y = pk2(v[j].z * r * gg.z, v[j].w * r * gg.w); o8[64 * j] = o; }
}

using pg8::Unit;
struct EpiGen {
    static constexpr bool PERM = true, AFTER_DRAIN = false;
    float* d32; int ld32; bf16* d16; int ld16; float sc16;
    const float* r0; const float* r1; int rsplit; int ldr;
    const float* gcol;
    float* ssq;
    const float* rsq;
    __device__ __forceinline__ void operator()(const f32x4 (&acc)[2][2][4][2], const Unit& u, int wr, int wc, int fr, int fq) const {
        int row0 = u.pm * 256 + wr * 64 + fr, col0 = u.pn * 256 + wc * 32 + fq * 8;
        asm volatile("" : "+v"(row0), "+v"(col0));
#pragma unroll
        for (int ai = 0; ai < 2; ++ai)
#pragma unroll
            for (int m = 0; m < 4; ++m) { const int row = row0 + ai * 128 + m * 16;
                const float* rp = nullptr; if (r0) rp = (row < rsplit) ? r0 + (size_t)row * ldr : r1 + (size_t)(row - rsplit) * ldr;
                float rs = 1.f; if (rsq) rs = rsqrtf(rsq[row] * (1.f / 1024.f) + EPS);
                float ss = 0.f;
#pragma unroll
                for (int bj = 0; bj < 2; ++bj) { const int col = col0 + bj * 128; f32x4 v0 = acc[ai][bj][m][0], v1 = acc[ai][bj][m][1];
                    if (rsq) { v0[0] *= rs; v0[1] *= rs; v0[2] *= rs; v0[3] *= rs; v1[0] *= rs; v1[1] *= rs; v1[2] *= rs; v1[3] *= rs; }
                    if (r0) { v0 += *(const f32x4*)(rp + col); v1 += *(const f32x4*)(rp + col + 4); }
                    if (d32) { *(f32x4*)(d32 + (size_t)row * ld32 + col) = v0; *(f32x4*)(d32 + (size_t)row * ld32 + col + 4) = v1; }
                    if (ssq) ss += ((v0[0] * v0[0] + v0[1] * v0[1]) + (v0[2] * v0[2] + v0[3] * v0[3])) + ((v1[0] * v1[0] + v1[1] * v1[1]) + (v1[2] * v1[2] + v1[3] * v1[3]));
                    if (d16) { f32x4 w0 = v0, w1 = v1; if (gcol) { w0 = w0 * *(const f32x4*)(gcol + col); w1 = w1 * *(const f32x4*)(gcol + col + 4); }
                        v4u o; o.x = pg8::cvt_pk_bf16(w0[0] * sc16, w0[1] * sc16); o.y = pg8::cvt_pk_bf16(w0[2] * sc16, w0[3] * sc16); o.z = pg8::cvt_pk_bf16(w1[0] * sc16, w1[1] * sc16); o.w = pg8::cvt_pk_bf16(w1[2] * sc16, w1[3] * sc16);
                        *(v4u*)(d16 + (size_t)row * ld16 + col) = o; } }
                if (ssq) { ss += xor16_f32(ss); ss += __shfl_xor(ss, 32); if (fq == 0) atomicAdd(ssq + row, ss); } }
    }
};
struct EpiInProj {
    static constexpr bool PERM = true, AFTER_DRAIN = false;
    float* out; unsigned char* ws; const float* bff;
    __device__ __forceinline__ void operator()(const f32x4 (&acc)[2][2][4][2], const Unit& u, int wr, int wc, int fr, int fq) const {
        const int pn = u.pn; const bool smp = u.pm >= 64;
        int row0 = u.pm * 256 + wr * 64 + fr;
        int orow0 = (smp ? (u.pm - 64) * 256 : u.pm * 256) + wr * 64 + fr;
        asm volatile("" : "+v"(row0), "+v"(orow0));
        float* d32 = nullptr; int ld32 = 0; bool d32_grp = false; bf16* d16 = nullptr; int ld16 = 0; float s32 = 1.f, s16 = 1.f; int cb = 0;
        if (pn < 2) { d16 = (bf16*)(ws + WS_QF); ld16 = 512; s16 = C2F; cb = pn * 256; }
        else if (pn < 4) { d32 = out + (smp ? O_FKS : O_FKP); ld32 = 512; d32_grp = true; d16 = (bf16*)(ws + WS_KF); ld16 = 512; cb = (pn - 2) * 256; }
        else if (pn < 6) { d32 = out + (smp ? O_FVS : O_FVP); ld32 = 512; d32_grp = true; d16 = (bf16*)(ws + WS_VF); ld16 = 512; cb = (pn - 4) * 256; }
        else if (pn == 6) { d16 = (bf16*)(ws + WS_GQ); ld16 = 256; s16 = 0.125f; }
        else if (pn == 7) { d16 = (bf16*)(ws + WS_GK); ld16 = 256; }
        else if (pn < 10) { d16 = (bf16*)(ws + WS_GV); ld16 = 512; cb = (pn - 8) * 256; }
        else if (pn < 12) { d16 = (bf16*)(ws + WS_GR); ld16 = 512; cb = (pn - 10) * 256; }
        if (pn < 12) {
#pragma unroll
            for (int ai = 0; ai < 2; ++ai)
#pragma unroll
                for (int m = 0; m < 4; ++m) { const int row = row0 + ai * 128 + m * 16, orow = orow0 + ai * 128 + m * 16;
#pragma unroll
                    for (int bj = 0; bj < 2; ++bj) { const int col = cb + wc * 32 + fq * 8 + bj * 128; const f32x4 v0 = acc[ai][bj][m][0], v1 = acc[ai][bj][m][1];
                        if (d32) { float* dp = d32 + (size_t)(d32_grp ? orow : row) * ld32 + col; *(f32x4*)dp = v0 * s32; *(f32x4*)(dp + 4) = v1 * s32; }
                        if (d16) { v4u o; o.x = pg8::cvt_pk_bf16(v0[0] * s16, v0[1] * s16); o.y = pg8::cvt_pk_bf16(v0[2] * s16, v0[3] * s16); o.z = pg8::cvt_pk_bf16(v1[0] * s16, v1[1] * s16); o.w = pg8::cvt_pk_bf16(v1[2] * s16, v1[3] * s16);
                            *(v4u*)(d16 + (size_t)row * ld16 + col) = o; } } }
        } else {
            if (wc == 0) {
                float* lf = out + (smp ? O_LFS : O_LFP); float* ggp = (float*)(ws + WS_GG);
#pragma unroll
                for (int ai = 0; ai < 2; ++ai)
#pragma unroll
                    for (int m = 0; m < 4; ++m) { const int row = row0 + ai * 128 + m * 16, orow = orow0 + ai * 128 + m * 16;
#pragma unroll
                        for (int n = 0; n < 2; ++n) { const int col = fq * 8 + 4 * n; const f32x4 v = acc[ai][0][m][n];
                            if (col < 8) { f32x4 o; const f32x4 b = *(const f32x4*)(bff + col);
                                o[0] = log_sigmoid(v[0] + b[0]); o[1] = log_sigmoid(v[1] + b[1]); o[2] = log_sigmoid(v[2] + b[2]); o[3] = log_sigmoid(v[3] + b[3]);
                                *(f32x4*)(lf + (size_t)orow * 8 + col) = o; }
                            else if (col < 24) *(f32x4*)(ggp + (size_t)row * 16 + (col - 8)) = v; } }
            }
        }
    }
};


__device__ __forceinline__ void p0_prologue(const Frame& F, const Args& a) {
    unsigned char* ws = a.ws;
    LAS float* scr = (LAS float*)(F.lds + F.wave * 16384);
    const int gw = F.vcu * NWAVES + F.wave, NGW = F.G * NWAVES;
    constexpr int I_WINN = 16 * (N_IN / 32), I_SQ = 16 * 32;
    constexpr int NITEMS = I_WINN + 5 * I_SQ;
    for (int it = (gw + NGW / 2) % NGW; it < NITEMS; it += NGW) {
        int r = it;
        if (r < I_WINN) { p0_transpose_item<true>((const float*)a.in[I_WIN], 3096, DM, N_IN / 32, (bf16*)(ws + WS_WIN), scr, r, F.lane); continue; } r -= I_WINN;
        const int which = r / I_SQ; r -= which * I_SQ;
        const float* src = (const float*)(which == 0 ? a.in[I_WOUT] : which == 1 ? a.in[I_WMK] : which == 2 ? a.in[I_WMV] : which == 3 ? a.in[I_WCQ] : a.in[I_WCO]);
        bf16* dst = (bf16*)(ws + (which == 0 ? WS_WOUT : which == 1 ? WS_WMK : which == 2 ? WS_WMV : which == 3 ? WS_WCQ : WS_WCO));
        p0_transpose_item<false>(src, DM, DM, 32, dst, scr, r, F.lane);
    }
    { float* ssz = (float*)(ws + WS_SS); for (int i = F.vcu * NTHR + F.tid; i < 2 * TA; i += F.G * NTHR) ssz[i] = 0.f; }
    for (int m0 = gw * 2; m0 < TA + 512; m0 += NGW * 2) {
        const float* xr[2]; const float* gr[2]; bf16* orow[2];
#pragma unroll
        for (int j = 0; j < 2; ++j) { const int m = m0 + j;
            if (m < TP) { xr[j] = (const float*)a.in[I_XP] + (size_t)m * DM; gr[j] = (const float*)a.in[I_GMIX]; orow[j] = (bf16*)(ws + WS_HB) + (size_t)m * DM; }
            else if (m < TA) { xr[j] = (const float*)a.in[I_XS] + (size_t)(m - TP) * DM; gr[j] = (const float*)a.in[I_GMIX]; orow[j] = (bf16*)(ws + WS_HB) + (size_t)m * DM; }
            else { xr[j] = (const float*)a.in[I_MEMP] + (size_t)(m - TA) * DM; gr[j] = (const float*)a.in[I_GMEM]; orow[j] = (bf16*)(ws + WS_MB) + (size_t)(m - TA) * DM; } }
        f32x4 v[2][4]; float s[2];
#pragma unroll
        for (int j = 0; j < 2; ++j) { s[j] = 0.f;
#pragma unroll
            for (int q = 0; q < 4; ++q) v[j][q] = ((const f32x4*)xr[j])[F.lane + 64 * q]; }
#pragma unroll
        for (int j = 0; j < 2; ++j) {
#pragma unroll
            for (int q = 0; q < 4; ++q) s[j] += (v[j][q].x * v[j][q].x + v[j][q].y * v[j][q].y) + (v[j][q].z * v[j][q].z + v[j][q].w * v[j][q].w);
            const float r = rsqrtf(wave_sum(s[j]) * (1.f / DM) + EPS);
#pragma unroll
            for (int q = 0; q < 4; ++q) { const f32x4 gg = ((const f32x4*)gr[j])[F.lane + 64 * q]; v2u o; o.x = pk2(v[j][q].x * r * gg.x, v[j][q].y * r * gg.y); o.y = pk2(v[j][q].z * r * gg.z, v[j][q].w * r * gg.w); ((v2u*)orow[j])[F.lane + 64 * q] = o; } }
    }
    {
        for (int r0 = gw * 4; r0 < 2 * 16384; r0 += NGW * 4) {
            f32x4 x[4][4];
#pragma unroll
            for (int j = 0; j < 4; ++j) { const int r = r0 + j; const bool isv = r >= 16384; const int e = isv ? r - 16384 : r;
                const f32x4* s = (const f32x4*)((const float*)(isv ? a.in[I_PV] : a.in[I_PU]) + (size_t)e * DM) + F.lane;
#pragma unroll
                for (int q = 0; q < 4; ++q) x[j][q] = __builtin_nontemporal_load(s + 64 * q); }
#pragma unroll
            for (int j = 0; j < 4; ++j) { const int r = r0 + j; const bool isv = r >= 16384; const int e = isv ? r - 16384 : r; float am = 0.f;
#pragma unroll
                for (int q = 0; q < 4; ++q) am = fmaxf(am, fmaxf(fmaxf(fabsf(x[j][q].x), fabsf(x[j][q].y)), fmaxf(fabsf(x[j][q].z), fabsf(x[j][q].w))));
#pragma unroll
                for (int o = 1; o < 64; o <<= 1) am = fmaxf(am, __shfl_xor(am, o));
                const float inv = am > 0.f ? 448.f / am : 0.f;
                v4u o4;
#pragma unroll
                for (int q = 0; q < 4; ++q) { int pk = __builtin_amdgcn_cvt_pk_fp8_f32(x[j][q].x * inv, x[j][q].y * inv, 0, false); pk = __builtin_amdgcn_cvt_pk_fp8_f32(x[j][q].z * inv, x[j][q].w * inv, pk, true); o4[q] = (unsigned)pk; }
                *(v4u*)(ws + (isv ? WS_V16 : WS_U16) + (size_t)e * DM + 16 * F.lane) = o4;
                if (F.lane == 0) ((float*)(ws + WS_MISC))[r] = am * (1.f / 448.f); }
        }
    }
    __syncthreads();
    for (int it = blockIdx.x; it < 256; it += F.G) {
        const int c = it >> 4, kt = it & 15, half = c & 1;
        LAS unsigned char* SKB = F.lds; LAS unsigned char* WB = F.lds + 128 * 272;
        const float* sk = (const float*)a.in[I_PSK] + (size_t)half * 128 * 128; const float* wq = (const float*)a.in[I_PWQ] + (size_t)(kt * 64) * 2048 + c * 128;
#pragma unroll
        for (int i = 0; i < 8; ++i) { const int c4 = F.tid + NTHR * i; const f32x4 x = *(const f32x4*)(sk + 4 * c4);
            v2u o; o.x = pk2(x.x, x.y); o.y = pk2(x.z, x.w); *(LAS v2u*)(SKB + (c4 >> 5) * 272 + (c4 & 31) * 8) = o; }
#pragma unroll
        for (int i = 0; i < 4; ++i) { const int c4 = F.tid + NTHR * i; const f32x4 x = *(const f32x4*)(wq + (size_t)(c4 >> 5) * 2048 + (c4 & 31) * 4);
            v2u o; o.x = pk2(x.x, x.y); o.y = pk2(x.z, x.w); *(LAS v2u*)(WB + (c4 >> 5) * 272 + (c4 & 31) * 8) = o; }
        __syncthreads();
        {
            const int r32 = F.lane & 31, hi = F.lane >> 5, mb = F.wave >> 1, nb = F.wave & 1;
            const LAS unsigned char* arow = SKB + (32 * mb + r32) * 272; const LAS unsigned char* brow = WB + (32 * nb + r32) * 272;
            f32x16 acc = {};
#pragma unroll
            for (int ks = 0; ks < 8; ++ks) acc = __builtin_amdgcn_mfma_f32_32x32x16_bf16(row_frag(arow, ks, hi), row_frag(brow, ks, hi), acc, 0, 0, 0);
            bf16* wp = (bf16*)(ws + WS_WPK) + (size_t)(c * 128 + 32 * mb) * DM + kt * 64 + 32 * nb + r32;
#pragma unroll
            for (int r = 0; r < 16; ++r) wp[(size_t)crow(r, hi) * DM] = (bf16)f2bf(acc[r]);
        }
        __syncthreads();
    }
}


__device__ __forceinline__ void fox_prompt_cumsum(const Frame& F, const float* logf  , float* kbias, int b) {
    LAS float* WT = (LAS float*)F.lds;
    const int t0 = F.wave * 1024 + F.lane * 16;
    const f32x4* src = (const f32x4*)(logf + ((size_t)b * SEQ + t0) * 8);
    float s[8];
#pragma unroll
    for (int h = 0; h < 8; ++h) s[h] = 0.f;
#pragma unroll 4
    for (int i = 0; i < 16; ++i) { const f32x4 a = src[2 * i], c = src[2 * i + 1]; s[0] += a.x; s[1] += a.y; s[2] += a.z; s[3] += a.w; s[4] += c.x; s[5] += c.y; s[6] += c.z; s[7] += c.w; }
    float ex[8];
#pragma unroll
    for (int h = 0; h < 8; ++h) { float v = s[h];
#pragma unroll
        for (int o = 1; o < 64; o <<= 1) { const float t = __shfl_up(v, o); if (F.lane >= o) v += t; }
        ex[h] = v - s[h];
        if (F.lane == 63) WT[F.wave * 8 + h] = v; }
    __syncthreads();
#pragma unroll
    for (int h = 0; h < 8; ++h) { float c = 0.f; for (int w = 0; w < F.wave; ++w) c += WT[w * 8 + h]; ex[h] += c; }
    float* dst = kbias + (size_t)(b * 8) * SEQ + t0;
#pragma unroll 4
    for (int i = 0; i < 16; ++i) { const f32x4 a = src[2 * i], c = src[2 * i + 1];
        ex[0] += a.x; ex[1] += a.y; ex[2] += a.z; ex[3] += a.w; ex[4] += c.x; ex[5] += c.y; ex[6] += c.z; ex[7] += c.w;
#pragma unroll
        for (int h = 0; h < 8; ++h) dst[(size_t)h * SEQ + i] = -ex[h] * LOG2E; }
    __syncthreads();
}
__device__ __forceinline__ void fox_sample_suffix(const Frame& F, const float* cfl, const int* pt, float* suf, int bs) {
    float carry[8];
#pragma unroll
    for (int h = 0; h < 8; ++h) carry[h] = 0.f;
    const int mypg = pt[bs * NPAGES + (F.lane & 15)];
#pragma unroll 1
    for (int pb = NPAGES - 4; pb >= 0; pb -= 4) {
        f32x4 x[4][4];
#pragma unroll
        for (int j = 0; j < 4; ++j) { const int pg = __builtin_amdgcn_readlane(mypg, 0) * 0 + __shfl(mypg, pb + j); const f32x4* src = (const f32x4*)(cfl + ((size_t)pg * PAGE + 2 * F.lane) * 8);
            x[j][0] = src[0]; x[j][1] = src[1]; x[j][2] = src[2]; x[j][3] = src[3]; }
#pragma unroll
        for (int j = 3; j >= 0; --j) { const int p = pb + j;
            const float ra[8] = {x[j][0].x, x[j][0].y, x[j][0].z, x[j][0].w, x[j][1].x, x[j][1].y, x[j][1].z, x[j][1].w}, rb[8] = {x[j][2].x, x[j][2].y, x[j][2].z, x[j][2].w, x[j][3].x, x[j][3].y, x[j][3].z, x[j][3].w};
#pragma unroll
            for (int h = 0; h < 8; ++h) {
                const float ps = ra[h] + rb[h]; float v = ps;
#pragma unroll
                for (int o = 1; o < 64; o <<= 1) { const float t = __shfl_down(v, o); if (F.lane + o < 64) v += t; }
                const float exs = v - ps;
                float* d = suf + (size_t)(bs * 8 + h) * PASTL + p * PAGE + 2 * F.lane;
                *(f32x2*)d = (f32x2){(carry[h] + exs + rb[h]) * LOG2E, (carry[h] + exs) * LOG2E};
                carry[h] += __shfl(v, 0);
            }
        }
    }
}

__device__ __forceinline__ void gla_gate_tile(const Frame& F, const float* gg, const float* w2, const float* bg, int row0, int h, int nt, LAS float* LA, LAS float* GGS) {
    for (int e = F.tid; e < nt * 16; e += NTHR) GGS[e] = gg[(size_t)row0 * 16 + e];
    const int dk = F.tid & 63; float wc[16];
#pragma unroll
    for (int r = 0; r < 16; ++r) wc[r] = w2[r * 256 + h * 64 + dk];
    const float bb = bg[h * 64 + dk];
    __syncthreads();
    for (int t = F.tid >> 6; t < nt; t += 8) { float z = bb;
#pragma unroll
        for (int q = 0; q < 4; ++q) { const f32x4 g4 = *(const LAS f32x4*)(GGS + t * 16 + 4 * q); z += g4.x * wc[4 * q] + g4.y * wc[4 * q + 1] + g4.z * wc[4 * q + 2] + g4.w * wc[4 * q + 3]; }
        LA[t * 64 + dk] = log_sigmoid(z) * (1.f / 16.f); }
}
__device__ __forceinline__ void gla_cumsum64(const Frame& F, LAS float* LA, LAS float* SEG) {
    const int dk = F.lane, w = F.wave; float v[8]; float run = 0.f;
#pragma unroll
    for (int i = 0; i < 8; ++i) { run += LA[(8 * w + i) * 64 + dk]; v[i] = run; }
    SEG[w * 64 + dk] = run;
    __syncthreads();
    float pre = 0.f;
    for (int j = 0; j < w; ++j) pre += SEG[j * 64 + dk];
#pragma unroll
    for (int i = 0; i < 8; ++i) LA[(8 * w + i) * 64 + dk] = v[i] + pre;
    __syncthreads();
}
__device__ __forceinline__ void gla_g1_unit(const Frame& F, const Args& a, int u) {
    unsigned char* ws = a.ws;
    const int b = u >> 9, h = (u >> 7) & 3, n = u & 127; const int row0 = b * SEQ + n * 64;
    LAS float* LA = (LAS float*)F.lds; LAS float* SEG = LA + 4096; LAS float* GGS = SEG + 512; LAS unsigned char* KRB = F.lds + 22528; LAS unsigned char* VSB = F.lds + 34816;
    v4u vq[2];
#pragma unroll
    for (int i = 0; i < 2; ++i) { const int c = F.tid + NTHR * i; vq[i] = *(const v4u*)((const bf16*)(ws + WS_GV) + (size_t)(row0 + (c >> 4)) * 512 + h * 128 + (c & 15) * 8); }
    float gkv[8];
#pragma unroll
    for (int i = 0; i < 8; ++i) { const int e = F.tid + NTHR * i; gkv[i] = GLD(ws + WS_GK)[(size_t)(row0 + (e >> 6)) * 256 + h * 64 + (e & 63)]; }
    gla_gate_tile(F, (const float*)(ws + WS_GG), (const float*)a.in[I_WG2], (const float*)a.in[I_BG], row0, h, 64, LA, GGS);
#pragma unroll
    for (int i = 0; i < 2; ++i) { const int c = F.tid + NTHR * i; *(LAS v4u*)(VSB + (c >> 4) * 320 + (c & 15) * 16) = vq[i]; }
    __syncthreads();
    gla_cumsum64(F, LA, SEG);
    if (F.tid < 64) ((float*)(ws + WS_GDEC))[(size_t)((b * 4 + h) * 128 + n) * 64 + F.tid] = __expf(LA[63 * 64 + F.tid]);
    float* bbuf = (float*)(ws + WS_BB);
#pragma unroll
    for (int i = 0; i < 8; ++i) { const int e = F.tid + NTHR * i; const int t = e >> 6, dk = e & 63; const float bb = LA[e]; bbuf[(size_t)(row0 + t) * 256 + h * 64 + dk] = bb;
        *(LAS unsigned short*)(KRB + t * 192 + dk * 2) = (unsigned short)f2bf(gkv[i] * __expf(LA[63 * 64 + dk] - bb)); }
    __syncthreads();
    {
        const int lane = F.lane, r32 = lane & 31, hi = lane >> 5, mb = F.wave >> 2, nb = F.wave & 3;
        const int tb = (4 * hi + ((lane & 15) >> 2)), tc = (16 * ((lane >> 4) & 1) + 4 * (lane & 3)) * 2;
        LAS unsigned char* abase = KRB + tb * 192 + tc + 64 * mb; LAS unsigned char* bbase = VSB + tb * 320 + tc + 64 * nb;
        f32x16 acc = {};
#pragma unroll
        for (int ks = 0; ks < 4; ++ks) acc = __builtin_amdgcn_mfma_f32_32x32x16_bf16(tr_frag<192>(abase, ks), tr_frag<320>(bbase, ks), acc, 0, 0, 0);
        float* kv = (float*)(ws + WS_GKV) + ((size_t)((b * 4 + h) * 128 + n) * 64 + 32 * mb) * 128 + 32 * nb + r32;
#pragma unroll
        for (int r = 0; r < 16; ++r) kv[(size_t)crow(r, hi) * 128] = acc[r];
    }
    __syncthreads();
}
__device__ __forceinline__ void gla_scan(const Frame& F, const Args& a) {
    int tid = F.wave * 64 + lane_id(); asm volatile("" : "+v"(tid));
    if (tid >= 256) return;
    for (int e = F.vcu * 256 + tid; e < 65536; e += F.G * 256) {
    const int bh = e >> 13, dk = (e >> 7) & 63, dv = e & 127;
    float* kv = (float*)(a.ws + WS_GKV) + ((size_t)bh * 128 * 64 + dk) * 128 + dv; const float* dc = (const float*)(a.ws + WS_GDEC) + (size_t)bh * 128 * 64 + dk;
    float S = 0.f;
#pragma unroll 1
    for (int n0 = 0; n0 < 128; n0 += 32) { float kvv[32], dd[32];
#pragma unroll
        for (int j = 0; j < 32; ++j) { kvv[j] = kv[(size_t)(n0 + j) * 8192]; dd[j] = dc[(size_t)(n0 + j) * 64]; }
#pragma unroll
        for (int j = 0; j < 32; ++j) { kv[(size_t)(n0 + j) * 8192] = S; S = dd[j] * S + kvv[j]; } }
    a.out[O_GSP + (size_t)bh * 8192 + dk * 128 + dv] = S;
    }
}
__device__ __forceinline__ float silu(float x) { return x / (1.f + __expf(-x)); }
__device__ __forceinline__ void gla_sample_unit(const Frame& F, const Args& a, int u) {
    unsigned char* ws = a.ws;
    const int bs = u >> 2, h = u & 3; const int row0 = TP + bs * LS;
    LAS float* LA = (LAS float*)F.lds; LAS float* BL = LA + 512; LAS float* QD = BL + 64; LAS float* KI = QD + 512; LAS float* KR = KI + 512; LAS float* ATT = KR + 512; LAS float* OP = ATT + 64; LAS float* VS = OP + 4096;
    gla_gate_tile(F, (const float*)(ws + WS_GG), (const float*)a.in[I_WG2], (const float*)a.in[I_BG], row0, h, 8, LA, VS + 1024);
#pragma unroll
    for (int i = 0; i < 2; ++i) { const int e = F.tid + NTHR * i; VS[e] = GLD(ws + WS_GV)[(size_t)(row0 + (e >> 7)) * 512 + h * 128 + (e & 127)]; }
    __syncthreads();
    if (F.tid < 64) { float run = 0.f;
#pragma unroll
        for (int t = 0; t < 8; ++t) { run += LA[t * 64 + F.tid]; LA[t * 64 + F.tid] = run; } BL[F.tid] = run; }
    __syncthreads();
    { const int e = F.tid, t = e >> 6, dk = e & 63; const float bb = LA[e];
      const float q = GLD(ws + WS_GQ)[(size_t)(row0 + t) * 256 + h * 64 + dk], k = GLD(ws + WS_GK)[(size_t)(row0 + t) * 256 + h * 64 + dk];
      QD[e] = q * __expf(bb); KI[e] = k * __expf(-bb); KR[e] = k * __expf(BL[dk] - bb); }
    __syncthreads();
    if (F.tid < 64) { const int t = F.tid >> 3, s = F.tid & 7; float acc = 0.f;
        if (s <= t) { for (int dk = 0; dk < 64; ++dk) acc += QD[t * 64 + dk] * KI[s * 64 + dk]; }
        ATT[F.tid] = acc; }
    const int dv = F.tid & 127, dkg = F.tid >> 7;
    {
        const float* st = (const float*)a.in[I_SGLA] + ((size_t)(bs * 4 + h) * 64 + dkg * 16) * 128 + dv;
        float S0[16];
#pragma unroll
        for (int i = 0; i < 16; ++i) S0[i] = st[(size_t)i * 128];
#pragma unroll
        for (int t = 0; t < 8; ++t) { float o = 0.f;
#pragma unroll
            for (int i = 0; i < 16; ++i) o += QD[t * 64 + dkg * 16 + i] * S0[i];
            OP[(dkg * 8 + t) * 128 + dv] = o; }
        float* so = a.out + O_GSS + ((size_t)(bs * 4 + h) * 64 + dkg * 16) * 128 + dv;
#pragma unroll
        for (int i = 0; i < 16; ++i) { float sn = __expf(BL[dkg * 16 + i]) * S0[i];
#pragma unroll
            for (int t = 0; t < 8; ++t) sn += KR[t * 64 + dkg * 16 + i] * VS[t * 128 + dv];
            so[(size_t)i * 128] = sn; }
    }
    __syncthreads();
    {
        const int t = F.wave; float o[2]; float ss = 0.f;
#pragma unroll
        for (int j = 0; j < 2; ++j) { const int d = 2 * F.lane + j; float v = OP[(0 * 8 + t) * 128 + d] + OP[(1 * 8 + t) * 128 + d] + OP[(2 * 8 + t) * 128 + d] + OP[(3 * 8 + t) * 128 + d];
            for (int s = 0; s <= t; ++s) v += ATT[t * 8 + s] * VS[s * 128 + d];
            o[j] = v; ss += v * v; }
        const float r = rsqrtf(wave_sum(ss) * (1.f / 128.f) + EPS);
        const float* ggo = (const float*)a.in[I_GGO] + h * 128 + 2 * F.lane; const BfPtr gr = GLD(ws + WS_GR) + ((size_t)(row0 + t) * 512 + h * 128 + 2 * F.lane);
        const float y0 = o[0] * r * ggo[0] * silu(gr[0]), y1 = o[1] * r * ggo[1] * silu(gr[1]);
        *(unsigned*)((bf16*)(ws + WS_MERGED) + (size_t)(row0 + t) * DM + 512 + h * 128 + 2 * F.lane) = pk2(y0, y1);
    }
    __syncthreads();
}


__device__ __forceinline__ float fexp2(float x) { return __builtin_amdgcn_exp2f(x); }
constexpr float FOX_SKIP = 160.f;


__device__ __forceinline__ void fox_norms_item(const Frame& F, const bf16* QF, const bf16* KF, const float* logf, float* FN, float* LC, float* BT, int item) {
    const int bh = item >> 5, qb = item & 31, b = bh >> 3, h = bh & 7;
    float qm = 0.f, km = 0.f;
    const float* lp = logf + ((size_t)b * SEQ + qb * 256 + 4 * F.lane) * 8 + h;
    const float l0 = lp[0], l1 = lp[8], l2 = lp[16], l3 = lp[24];
#pragma unroll 8
    for (int i = 0; i < 32; ++i) { const size_t row = (size_t)b * SEQ + qb * 256 + i * 8 + (F.lane >> 3);
        const v4u q = *(const v4u*)(QF + row * 512 + h * 64 + (F.lane & 7) * 8), k = *(const v4u*)(KF + row * 512 + h * 64 + (F.lane & 7) * 8); float qs = 0.f, ks = 0.f;
#pragma unroll
        for (int j = 0; j < 4; ++j) { qs += bflo(q[j]) * bflo(q[j]) + bfhi(q[j]) * bfhi(q[j]); ks += bflo(k[j]) * bflo(k[j]) + bfhi(k[j]) * bfhi(k[j]); }
        qs = sum8_f32(qs); ks = sum8_f32(ks);
        qm = fmaxf(qm, qs); km = fmaxf(km, ks); }
#pragma unroll
    for (int o = 1; o < 64; o <<= 1) { qm = fmaxf(qm, __shfl_xor(qm, o)); km = fmaxf(km, __shfl_xor(km, o)); }
    const float c0 = l0, c1 = c0 + l1, c2 = c1 + l2, c3 = c2 + l3; float v = c3;
#pragma unroll
    for (int o = 1; o < 64; o <<= 1) { const float t = __shfl_up(v, o); if (F.lane >= o) v += t; }
    const float ex = v - c3;
    *(f32x4*)(LC + (size_t)bh * SEQ + qb * 256 + 4 * F.lane) = (f32x4){ex + c0, ex + c1, ex + c2, ex + c3};
    if (F.lane == 63) BT[item] = v;
    if (F.lane == 0) { FN[item * 2] = qm; FN[item * 2 + 1] = km; }
}
__device__ __forceinline__ void fox_suffix_item(const Frame& F, const float* cfl, const int* pt, float* SW, float* PTOT, int item) {
    const int bs = item >> 4, p = item & 15; const int pg = __builtin_amdgcn_readfirstlane(pt[item]);
    const f32x4* src = (const f32x4*)(cfl + ((size_t)pg * PAGE + 2 * F.lane) * 8);
    const f32x4 a0 = src[0], a1 = src[1], b0 = src[2], b1 = src[3];
    const float ra[8] = {a0.x, a0.y, a0.z, a0.w, a1.x, a1.y, a1.z, a1.w}, rb[8] = {b0.x, b0.y, b0.z, b0.w, b1.x, b1.y, b1.z, b1.w};
#pragma unroll
    for (int h = 0; h < 8; ++h) {
        const float ps = ra[h] + rb[h]; float v = ps;
#pragma unroll
        for (int o = 1; o < 64; o <<= 1) { const float t = __shfl_down(v, o); if (F.lane + o < 64) v += t; }
        const float exs = v - ps;
        *(f32x2*)(SW + (size_t)(bs * 8 + h) * PASTL + p * PAGE + 2 * F.lane) = (f32x2){exs + rb[h], exs};
        if (F.lane == 0) PTOT[(bs * 8 + h) * NPAGES + p] = v;
    }
}
__device__ __forceinline__ void fox_attn_unit(const Frame& F, const bf16* QF, const bf16* KF, const bf16* VF, const float* LC, const float* BT, const float* FN, bf16* merged, int b, int h, int qb) {
    int tid = F.wave * 64 + lane_id(); asm volatile("" : "+v"(tid));
    const int lane = tid & 63, r32 = lane & 31, hi = lane >> 5, wid = F.wave;
    const size_t rowbase = (size_t)b * SEQ; const int q0 = qb * 256;
    LAS unsigned char* Ks = F.lds; LAS unsigned char* Vs = F.lds + 8192; LAS float* KBs = (LAS float*)(F.lds + 20480); LAS float* WSF = (LAS float*)(F.lds + 20736) + wid * 32;
    const bf16* Qw = QF + (rowbase + q0 + wid * 32 + r32) * 512 + h * 64;
    bf16x8 qr[4];
#pragma unroll
    for (int d0 = 0; d0 < 4; ++d0) qr[d0] = *(const bf16x8*)(Qw + d0 * 16 + hi * 8);
    const float* lcp = LC + (size_t)(b * 8 + h) * SEQ;
    float pbx; { const float btv = (lane < 32) ? BT[(b * 8 + h) * 32 + lane] : 0.f; float v = btv;
#pragma unroll
        for (int o = 1; o < 64; o <<= 1) { const float t = __shfl_up(v, o); if (lane >= o) v += t; }
        pbx = v - btv; }
    const float cref = lcp[q0] + __shfl(pbx, qb);
#define FOX_KB(t_, pos_) (-LOG2E * ((lcp[pos_] + __shfl(pbx, (t_) >> 2)) - cref))
    const int NT = (q0 + 256) / 64;
    int t0 = 0;
    {
        float kn = (lane < 32) ? FN[((b * 8 + h) * 32 + lane) * 2 + 1] : 0.f;
#pragma unroll
        for (int o = 1; o < 64; o <<= 1) kn = fmaxf(kn, __shfl_xor(kn, o));
        const float qk2 = 2.f * sqrtf(FN[((b * 8 + h) * 32 + qb) * 2]) * sqrtf(kn) * 1.01f;
        const int nbefore = q0 / 64;
        int found = -1;
        for (int base = 0; base < nbefore && found < 0; base += 64) {
            const int tl = nbefore - 1 - base - lane;
            const int tlc = tl < 0 ? 0 : tl; const float kbl = -LOG2E * ((lcp[tlc * 64 + 63] + __shfl(pbx, tlc >> 2)) - cref);
            const bool dead = (tl >= 0) && (qk2 + kbl < -FOX_SKIP);
            const unsigned long long bm = __ballot(dead);
            if (bm) found = nbefore - 1 - base - (int)__builtin_ctzll(bm);
        }
        t0 = found + 1;
        t0 = __builtin_amdgcn_readfirstlane(t0);
    }
    const int kkey = tid >> 3, kch = tid & 7, vkey = tid >> 3, vch = tid & 7;
    const bf16* ksrc = KF + (rowbase + kkey) * 512 + h * 64 + kch * 8;
    const bf16* vsrc = VF + (rowbase + vkey) * 512 + h * 64 + vch * 8;
    v4u kreg[2], vreg[2]; float kbreg[2];
#pragma unroll
    for (int hb = 0; hb < 2; ++hb) { const int tt = (t0 + hb < NT) ? t0 + hb : t0;
        kreg[hb] = *(const v4u*)(ksrc + (size_t)tt * 64 * 512); vreg[hb] = *(const v4u*)(vsrc + (size_t)tt * 64 * 512); kbreg[hb] = FOX_KB(tt, tt * 64 + (tid & 63)); }
    float m_run = -INFINITY, l_run = 0.f; f32x16 o0 = {}, o1 = {};
    const int qpos = q0 + wid * 32 + r32;
    const int vbase = (4 * hi + ((lane & 15) >> 2)) * 192 + (16 * ((lane >> 4) & 1) + 4 * (lane & 3)) * 2;
    LAS unsigned char* const Ks0 = Ks; LAS unsigned char* const Vs0 = Vs; LAS float* const KBs0 = KBs;
    __syncthreads();
    for (int t2 = t0; t2 < NT; t2 += 2) {
#pragma unroll
      for (int hb = 0; hb < 2; ++hb) {
        const int t = t2 + hb;
        if (t < NT) {
        LAS unsigned char* const Ks = Ks0 + hb * 28672; LAS unsigned char* const Vs = Vs0 + hb * 28672; LAS float* const KBs = (LAS float*)((LAS unsigned char*)KBs0 + hb * 28672);
        *(LAS v4u*)(Ks + kkey * 128 + ((kch ^ (kkey & 7)) << 4)) = kreg[hb];            *(LAS v4u*)(Vs + vkey * 192 + vch * 16) = vreg[hb]; if (tid < 64) KBs[tid] = kbreg[hb];
        __syncthreads();
        if (t + 2 < NT) { kreg[hb] = *(const v4u*)(ksrc + (size_t)(t + 2) * 64 * 512); vreg[hb] = *(const v4u*)(vsrc + (size_t)(t + 2) * 64 * 512); kbreg[hb] = FOX_KB(t + 2, (t + 2) * 64 + (tid & 63)); }
        const int k0 = t * 64;
        if (k0 <= q0 + wid * 32 + 31) {
        f32x16 p0, p1;
#pragma unroll
        for (int g = 0; g < 4; ++g) { const f32x4 ba = *(const LAS f32x4*)(KBs + 8 * g + 4 * hi), bb = *(const LAS f32x4*)(KBs + 32 + 8 * g + 4 * hi);
#pragma unroll
            for (int i = 0; i < 4; ++i) { p0[4 * g + i] = ba[i]; p1[4 * g + i] = bb[i]; } }
#pragma unroll
        for (int d0 = 0; d0 < 4; ++d0) {
            const bf16x8 a0 = *(const LAS bf16x8*)(Ks + r32 * 128 + (((2 * d0 + hi) ^ (r32 & 7)) << 4)), a1 = *(const LAS bf16x8*)(Ks + (r32 + 32) * 128 + (((2 * d0 + hi) ^ (r32 & 7)) << 4));
            p0 = __builtin_amdgcn_mfma_f32_32x32x16_bf16(a0, qr[d0], p0, 0, 0, 0); p1 = __builtin_amdgcn_mfma_f32_32x32x16_bf16(a1, qr[d0], p1, 0, 0, 0);
        }
        if (k0 + 63 > q0 + wid * 32) {
#pragma unroll
            for (int r = 0; r < 16; ++r) { const int key = k0 + crow(r, hi); if (key > qpos) p0[r] = -INFINITY; if (key + 32 > qpos) p1[r] = -INFINITY; }
        }
        float mx = fmaxf(p0[0], p1[0]);
#pragma unroll
        for (int r = 1; r < 16; ++r) mx = fmaxf(mx, fmaxf(p0[r], p1[r]));
        mx = fmaxf(mx, __shfl_xor(mx, 32));
        const float m_new = fmaxf(m_run, mx), alpha = fexp2(m_run - m_new); m_run = m_new;
        float ls = 0.f;
#pragma unroll
        for (int r = 0; r < 16; ++r) { p0[r] = fexp2(p0[r] - m_new); p1[r] = fexp2(p1[r] - m_new); ls += p0[r] + p1[r]; }
        l_run = l_run * alpha + ls;
        if (__ballot(alpha != 1.f) != 0ull) {
            if (hi == 0) WSF[r32] = alpha;
#pragma unroll
            for (int g = 0; g < 4; ++g) { const f32x4 al = *(const LAS f32x4*)(WSF + 8 * g + 4 * hi);
#pragma unroll
                for (int i = 0; i < 4; ++i) { o0[4 * g + i] *= al[i]; o1[4 * g + i] *= al[i]; } }
        }
        v4u pw[4];
#pragma unroll
        for (int j = 0; j < 4; ++j) { pw[0][j] = pg8::cvt_pk_bf16(p0[2 * j], p0[2 * j + 1]); pw[1][j] = pg8::cvt_pk_bf16(p0[8 + 2 * j], p0[8 + 2 * j + 1]);
                                      pw[2][j] = pg8::cvt_pk_bf16(p1[2 * j], p1[2 * j + 1]); pw[3][j] = pg8::cvt_pk_bf16(p1[8 + 2 * j], p1[8 + 2 * j + 1]); }
#pragma unroll
        for (int ks = 0; ks < 4; ++ks) {
            const bf16x8 pa = __builtin_bit_cast(bf16x8, pw[ks]);
#pragma unroll
            for (int d0 = 0; d0 < 2; ++d0) {
                const s16x4 lo = lds_tr16(Vs + vbase + ks * 16 * 192 + d0 * 64), hi4 = lds_tr16(Vs + vbase + ks * 16 * 192 + 8 * 192 + d0 * 64);
                const bf16x8 vb = (bf16x8){lo[0], lo[1], lo[2], lo[3], hi4[0], hi4[1], hi4[2], hi4[3]};
                if (d0 == 0) o0 = __builtin_amdgcn_mfma_f32_32x32x16_bf16(pa, vb, o0, 0, 0, 0); else o1 = __builtin_amdgcn_mfma_f32_32x32x16_bf16(pa, vb, o1, 0, 0, 0);
            }
        }
        }
        }
      }
    }
    l_run += __shfl_xor(l_run, 32);
    if (hi == 0) WSF[r32] = 1.f / l_run;
    bf16* Ow = merged + (rowbase + q0 + wid * 32) * DM + h * 64 + r32;
#pragma unroll
    for (int g = 0; g < 4; ++g) { const f32x4 rl = *(const LAS f32x4*)(WSF + 8 * g + 4 * hi);
#pragma unroll
        for (int i = 0; i < 4; ++i) { const int r = 4 * g + i; const int row = crow(r, hi);
            Ow[(size_t)row * DM] = (bf16)f2bf(o0[r] * rl[i]); Ow[(size_t)row * DM + 32] = (bf16)f2bf(o1[r] * rl[i]); } }
    __syncthreads();
#undef FOX_KB
}

template <int D> struct DecW {
    static constexpr int KS = D / 32;
    static constexpr int LPK = D / 4;
    static constexpr int KPI = 64 / LPK;
    float m[4], l[4]; float o[8][4];
};
template <int D>
__device__ __forceinline__ void dec_init(DecW<D>& w) {
#pragma unroll
    for (int i = 0; i < 4; ++i) { w.m[i] = -INFINITY; w.l[i] = 0.f; }
#pragma unroll
    for (int q = 0; q < 8; ++q)
#pragma unroll
        for (int j = 0; j < 4; ++j) w.o[q][j] = 0.f;
}
template <int D, int NTILE, int MODE>
__device__ __forceinline__ void dec_chunk(DecW<D>& w, const bf16x8 (&qa)[D / 32], const float* Kb, const float* Vb, int stride, const float* bias, float nb, LAS float* PL, int lane) {
    constexpr int KS = D / 32, LPK = D / 4, KPI = 64 / LPK;
    constexpr int NK = (MODE == 1) ? 8 : NTILE * 16, NV = NK / KPI;
    const int key = lane & 15, kq = lane >> 4;
    const unsigned koff = (unsigned)(key * stride + 8 * kq) * 4u;
    const int d4 = lane % LPK, ksub = lane / LPK;
    const unsigned voff = (unsigned)(ksub * stride + 4 * d4) * 4u;
    f32x4 kx[NTILE][2 * KS], vx[NV];
#pragma unroll
    for (int t = 0; t < NTILE; ++t) { const char* kp = (const char*)(Kb + (size_t)t * 16 * stride) + koff;
#pragma unroll
        for (int ks = 0; ks < KS; ++ks) { kx[t][2 * ks] = *(const f32x4*)(kp + 128 * ks); kx[t][2 * ks + 1] = *(const f32x4*)(kp + 128 * ks + 16); } }
    constexpr int NVA = (NV >= 8) ? NV / 2 : NV;
#pragma unroll
    for (int kk = 0; kk < NVA; ++kk) vx[kk] = *(const f32x4*)((const char*)(Vb + (size_t)kk * KPI * stride) + voff);
    f32x4 s[NTILE];
#pragma unroll
    for (int t = 0; t < NTILE; ++t) {
        f32x4 acc = {0.f, 0.f, 0.f, 0.f};
#pragma unroll
        for (int ks = 0; ks < KS; ++ks) { const f32x4 x0 = kx[t][2 * ks], x1 = kx[t][2 * ks + 1];
            v4u kb; kb.x = pg8::cvt_pk_bf16(x0.x, x0.y); kb.y = pg8::cvt_pk_bf16(x0.z, x0.w); kb.z = pg8::cvt_pk_bf16(x1.x, x1.y); kb.w = pg8::cvt_pk_bf16(x1.z, x1.w);
            acc = __builtin_amdgcn_mfma_f32_16x16x32_bf16(qa[ks], __builtin_bit_cast(bf16x8, kb), acc, 0, 0, 0); }
        if (MODE == 0) { if (bias) { const float bv = (bias[t * 16 + key] + nb) * LOG2E; acc += bv; } }
        else { acc += nb;
#pragma unroll
            for (int i = 0; i < 4; ++i) if (key > 4 * kq + i || key >= 8) acc[i] = -INFINITY; }
        s[t] = acc;
    }
#pragma unroll
    for (int kk = NVA; kk < NV; ++kk) vx[kk] = *(const f32x4*)((const char*)(Vb + (size_t)kk * KPI * stride) + voff);
    f32x4 mc = s[0];
#pragma unroll
    for (int t = 1; t < NTILE; ++t) { mc.x = fmaxf(mc.x, s[t].x); mc.y = fmaxf(mc.y, s[t].y); mc.z = fmaxf(mc.z, s[t].z); mc.w = fmaxf(mc.w, s[t].w); }
    mc.x = max16_f32(mc.x); mc.y = max16_f32(mc.y); mc.z = max16_f32(mc.z); mc.w = max16_f32(mc.w);
    float al[4];
#pragma unroll
    for (int i = 0; i < 4; ++i) { const float mn = fmaxf(w.m[i], mc[i]); al[i] = (mn == -INFINITY) ? 1.f : fexp2(w.m[i] - mn); w.m[i] = mn; w.l[i] *= al[i]; }
#pragma unroll
    for (int t = 0; t < NTILE; ++t) { f32x4 p;
#pragma unroll
        for (int i = 0; i < 4; ++i) { p[i] = (w.m[i] == -INFINITY) ? 0.f : fexp2(s[t][i] - w.m[i]); w.l[i] += p[i]; }
        if (kq < 2) *(LAS f32x4*)(PL + (t * 16 + key) * 8 + 4 * kq) = p; }
    if (key == 0 && kq < 2) *(LAS f32x4*)(PL + 1024 + 4 * kq) = (f32x4){al[0], al[1], al[2], al[3]};
    { const f32x4 a0 = *(const LAS f32x4*)(PL + 1024), a1 = *(const LAS f32x4*)(PL + 1028);
#pragma unroll
      for (int j = 0; j < 4; ++j) { w.o[0][j] *= a0.x; w.o[1][j] *= a0.y; w.o[2][j] *= a0.z; w.o[3][j] *= a0.w; w.o[4][j] *= a1.x; w.o[5][j] *= a1.y; w.o[6][j] *= a1.z; w.o[7][j] *= a1.w; } }
#pragma unroll
    for (int kk = 0; kk < NV; ++kk) { const int k = kk * KPI + ksub;
        const f32x4 v = vx[kk];
        const f32x4 pa = *(const LAS f32x4*)(PL + k * 8), pb = *(const LAS f32x4*)(PL + k * 8 + 4);
#pragma unroll
        for (int j = 0; j < 4; ++j) { w.o[0][j] += pa.x * v[j]; w.o[1][j] += pa.y * v[j]; w.o[2][j] += pa.z * v[j]; w.o[3][j] += pa.w * v[j];
                                      w.o[4][j] += pb.x * v[j]; w.o[5][j] += pb.y * v[j]; w.o[6][j] += pb.z * v[j]; w.o[7][j] += pb.w * v[j]; } }
}
__device__ __forceinline__ void dec_page_fox(DecW<64>& w, const bf16x8 (&qa)[2], const float* Kb, const float* Vb, const float* bias, float boff, LAS float* PL, int lane) {
    constexpr int stride = 512;
    const int key = lane & 15, kq = lane >> 4;
    const unsigned koff = (unsigned)(key * stride + 8 * kq) * 4u;
    const int d4 = lane & 15, ksub = lane >> 4;
    const unsigned voff = (unsigned)(ksub * stride + 4 * d4) * 4u;
    const __amdgpu_buffer_rsrc_t krs = __builtin_amdgcn_make_buffer_rsrc((void*)Kb, 0, 0x7fffffff, 0x00020000);
    const __amdgpu_buffer_rsrc_t vrs = __builtin_amdgcn_make_buffer_rsrc((void*)Vb, 0, 0x7fffffff, 0x00020000);
    const __amdgpu_buffer_rsrc_t brs = __builtin_amdgcn_make_buffer_rsrc((void*)bias, 0, 0x7fffffff, 0x00020000);
    f32x4 s[8];
#pragma unroll
    for (int hb = 0; hb < 2; ++hb) {
        f32x4 kx[4][4];
#pragma unroll
        for (int t = 0; t < 4; ++t) { const int so = (hb * 4 + t) * 16 * stride * 4;
            kx[t][0] = __builtin_bit_cast(f32x4, __builtin_amdgcn_raw_buffer_load_b128(krs, (int)koff, so, 0)); kx[t][1] = __builtin_bit_cast(f32x4, __builtin_amdgcn_raw_buffer_load_b128(krs, (int)koff + 16, so, 0));
            kx[t][2] = __builtin_bit_cast(f32x4, __builtin_amdgcn_raw_buffer_load_b128(krs, (int)koff + 128, so, 0)); kx[t][3] = __builtin_bit_cast(f32x4, __builtin_amdgcn_raw_buffer_load_b128(krs, (int)koff + 144, so, 0)); }
#pragma unroll
        for (int t = 0; t < 4; ++t) {
            f32x4 acc = {0.f, 0.f, 0.f, 0.f};
#pragma unroll
            for (int ks = 0; ks < 2; ++ks) { const f32x4 x0 = kx[t][2 * ks], x1 = kx[t][2 * ks + 1];
                v4u kb; kb.x = pg8::cvt_pk_bf16(x0.x, x0.y); kb.y = pg8::cvt_pk_bf16(x0.z, x0.w); kb.z = pg8::cvt_pk_bf16(x1.x, x1.y); kb.w = pg8::cvt_pk_bf16(x1.z, x1.w);
                acc = __builtin_amdgcn_mfma_f32_16x16x32_bf16(qa[ks], __builtin_bit_cast(bf16x8, kb), acc, 0, 0, 0); }
            acc += (__builtin_bit_cast(float, __builtin_amdgcn_raw_buffer_load_b32(brs, key * 4, (hb * 4 + t) * 64, 0)) + boff) * LOG2E;
            s[hb * 4 + t] = acc;
        }
        asm volatile("" ::: "memory");
    }
    f32x4 mc = s[0];
#pragma unroll
    for (int t = 1; t < 8; ++t) { mc.x = fmaxf(mc.x, s[t].x); mc.y = fmaxf(mc.y, s[t].y); mc.z = fmaxf(mc.z, s[t].z); mc.w = fmaxf(mc.w, s[t].w); }
    mc.x = max16_f32(mc.x); mc.y = max16_f32(mc.y); mc.z = max16_f32(mc.z); mc.w = max16_f32(mc.w);
    float al[4];
#pragma unroll
    for (int i = 0; i < 4; ++i) { const float mn = fmaxf(w.m[i], mc[i]); al[i] = fexp2(w.m[i] - mn); w.m[i] = mn; w.l[i] *= al[i]; }
    bool nz = false;
#pragma unroll
    for (int t = 0; t < 8; ++t) { f32x4 p;
#pragma unroll
        for (int i = 0; i < 4; ++i) { p[i] = fexp2(s[t][i] - w.m[i]); w.l[i] += p[i]; nz = nz || (p[i] != 0.f); }
        if (kq < 2) *(LAS f32x4*)(PL + (t * 16 + key) * 8 + 4 * kq) = p; }
    if (__ballot(nz && kq < 2) == 0ull) return;
    if (key == 0 && kq < 2) *(LAS f32x4*)(PL + 1024 + 4 * kq) = (f32x4){al[0], al[1], al[2], al[3]};
    { const f32x4 a0 = *(const LAS f32x4*)(PL + 1024), a1 = *(const LAS f32x4*)(PL + 1028);
#pragma unroll
      for (int j = 0; j < 4; ++j) { w.o[0][j] *= a0.x; w.o[1][j] *= a0.y; w.o[2][j] *= a0.z; w.o[3][j] *= a0.w; w.o[4][j] *= a1.x; w.o[5][j] *= a1.y; w.o[6][j] *= a1.z; w.o[7][j] *= a1.w; } }
#pragma unroll 1
    for (int vh = 0; vh < 2; ++vh) {
    f32x4 vx[16];
#pragma unroll
    for (int kk = 0; kk < 16; ++kk) vx[kk] = __builtin_bit_cast(f32x4, __builtin_amdgcn_raw_buffer_load_b128(vrs, (int)voff, (vh * 16 + kk) * 4 * stride * 4, 0));
#pragma unroll
    for (int kk = 0; kk < 16; ++kk) { const int k = (vh * 16 + kk) * 4 + ksub;
        const f32x4 v = vx[kk];
        const f32x4 pa = *(const LAS f32x4*)(PL + k * 8), pb = *(const LAS f32x4*)(PL + k * 8 + 4);
#pragma unroll
        for (int j = 0; j < 4; ++j) { w.o[0][j] += pa.x * v[j]; w.o[1][j] += pa.y * v[j]; w.o[2][j] += pa.z * v[j]; w.o[3][j] += pa.w * v[j];
                                      w.o[4][j] += pb.x * v[j]; w.o[5][j] += pb.y * v[j]; w.o[6][j] += pb.z * v[j]; w.o[7][j] += pb.w * v[j]; } }
    }
}
template <int D>
__device__ __forceinline__ void dec_park(DecW<D>& w, LAS float* CBw, int lane) {
    constexpr int LPK = D / 4;
    const int key = lane & 15, kq = lane >> 4, d4 = lane % LPK, ksub = lane / LPK;
#pragma unroll
    for (int i = 0; i < 4; ++i) { float l = w.l[i];
        l = sum16_f32(l);
        w.l[i] = l; }
    if (key == 0 && kq < 2) { *(LAS f32x4*)(CBw + 4 * kq) = (f32x4){w.m[0], w.m[1], w.m[2], w.m[3]}; *(LAS f32x4*)(CBw + 8 + 4 * kq) = (f32x4){w.l[0], w.l[1], w.l[2], w.l[3]}; }
#pragma unroll
    for (int q = 0; q < 8; ++q) { f32x4 v = (f32x4){w.o[q][0], w.o[q][1], w.o[q][2], w.o[q][3]};
        if (LPK < 64) {
#pragma unroll
            for (int o = LPK; o < 64; o <<= 1) { if (o == 16) { v.x += xor16_f32(v.x); v.y += xor16_f32(v.y); v.z += xor16_f32(v.z); v.w += xor16_f32(v.w); }
                else { v.x += __shfl_xor(v.x, o); v.y += __shfl_xor(v.y, o); v.z += __shfl_xor(v.z, o); v.w += __shfl_xor(v.w, o); } } }
        if (ksub == 0) *(LAS f32x4*)(CBw + 16 + q * D + 4 * d4) = v; }
}
template <int D>
__device__ __forceinline__ void dec_combine(int tid, LAS float* CB, bf16* dst, int ldd) {
    constexpr int WSTR = 16 + 8 * D;
    for (int e = tid; e < 8 * D; e += NTHR) { const int q = e / D, d = e % D;
        float mt = -INFINITY;
#pragma unroll
        for (int w = 0; w < 8; ++w) mt = fmaxf(mt, CB[w * WSTR + q]);
        float num = 0.f, den = 0.f;
#pragma unroll
        for (int w = 0; w < 8; ++w) { const float mw = CB[w * WSTR + q]; const float f = (mw == -INFINITY) ? 0.f : fexp2(mw - mt); num += f * CB[w * WSTR + 16 + q * D + d]; den += f * CB[w * WSTR + 8 + q]; }
        dst[(size_t)q * ldd + d] = (bf16)f2bf(num / den); }
}
template <int D>
__device__ __forceinline__ void dec_load_q(bf16x8 (&qa)[D / 32], const bf16* Q, int ldq, int lane) {
    const int row = lane & 15, kq = lane >> 4;
#pragma unroll
    for (int ks = 0; ks < D / 32; ++ks) { v4u z = {0u, 0u, 0u, 0u}; if (row < 8) z = *(const v4u*)(Q + (size_t)row * ldq + 32 * ks + 8 * kq); qa[ks] = __builtin_bit_cast(bf16x8, z); }
}
constexpr int DEC_PL = 1040;
__device__ __forceinline__ void fox_sample_unit(const Frame& F, const Args& a, int u) {
    unsigned char* ws = a.ws; const int bs = u >> 3, h = u & 7;
    int ln = lane_id(); asm volatile("" : "+v"(ln));
    LAS float* PL = (LAS float*)F.lds + F.wave * DEC_PL; LAS float* CB = (LAS float*)F.lds + 8 * DEC_PL; constexpr int WSTR = 16 + 8 * 64;
    bf16x8 qa[2]; dec_load_q<64>(qa, (const bf16*)(ws + WS_QF) + (size_t)(TP + bs * LS) * 512 + h * 64, 512, ln);
    DecW<64> w; dec_init(w);
    {
        const int key = ln & 15; const float* lf = a.out + O_LFS + (size_t)(bs * LS) * 8 + h; float cn = 0.f;
#pragma unroll
        for (int j = 0; j < 8; ++j) { const float x = lf[j * 8]; cn += (j <= key) ? x : 0.f; }
        const float* Kb = a.out + O_FKS + (size_t)(bs * LS) * 512 + h * 64; const float* Vb = a.out + O_FVS + (size_t)(bs * LS) * 512 + h * 64;
        dec_chunk<64, 1, 1>(w, qa, Kb, Vb, 512, nullptr, -cn * LOG2E, PL, ln);
        if (F.wave != 0) {
#pragma unroll
            for (int i = 0; i < 4; ++i) w.l[i] = 0.f;
#pragma unroll
            for (int q = 0; q < 8; ++q)
#pragma unroll
                for (int j = 0; j < 4; ++j) w.o[q][j] = 0.f; }
    }
    const int* pt = (const int*)a.in[I_PT];
    float spx; { const float ptv = (ln < 16) ? ((const float*)(ws + WS_MISC + 2 * MiB))[(bs * 8 + h) * NPAGES + ln] : 0.f; float v = ptv;
#pragma unroll
        for (int o = 1; o < 16; o <<= 1) { const float t = __builtin_bit_cast(float, __builtin_amdgcn_ds_bpermute((ln + o) << 2, __builtin_bit_cast(int, v))); if (ln + o < 16) v += t; }
        spx = v - ptv; }
#if defined(OLD_FOXS)
#pragma unroll 1
    for (int pp = 0; pp < 4; ++pp) { const int p = F.wave * 2 + (pp >> 1), hf = pp & 1; const int pg = __builtin_amdgcn_readfirstlane(pt[bs * NPAGES + p]);
        const float* Kb = (const float*)a.in[I_CFK] + (((size_t)pg * PAGE + hf * 64) * 8 + h) * 64; const float* Vb = (const float*)a.in[I_CFV] + (((size_t)pg * PAGE + hf * 64) * 8 + h) * 64;
        dec_chunk<64, 4, 0>(w, qa, Kb, Vb, 512, (const float*)(ws + WS_SUF) + (size_t)(bs * 8 + h) * PASTL + p * PAGE + hf * 64, __builtin_bit_cast(float, __builtin_amdgcn_ds_bpermute(p << 2, __builtin_bit_cast(int, spx))), PL, ln); }
#else
#pragma unroll 1
    for (int pp = 1; pp >= 0; --pp) { const int p = pp ? (NPAGES - 1 - F.wave) : F.wave;
        const int pg = __builtin_amdgcn_readfirstlane(pt[bs * NPAGES + p]);
        const float* Kb = (const float*)a.in[I_CFK] + ((size_t)pg * PAGE * 8 + h) * 64; const float* Vb = (const float*)a.in[I_CFV] + ((size_t)pg * PAGE * 8 + h) * 64;
        dec_page_fox(w, qa, Kb, Vb, (const float*)(ws + WS_SUF) + (size_t)(bs * 8 + h) * PASTL + p * PAGE, __builtin_bit_cast(float, __builtin_amdgcn_ds_bpermute(p << 2, __builtin_bit_cast(int, spx))), PL, ln); }
#endif
    dec_park<64>(w, CB + F.wave * WSTR, ln);
    __syncthreads();
    dec_combine<64>(F.wave * 64 + ln, CB, (bf16*)(ws + WS_MERGED) + (size_t)(TP + bs * LS) * DM + h * 64, DM);
    __syncthreads();
}
__device__ __forceinline__ void cross_sample_unit(const Frame& F, const Args& a, int u) {
    unsigned char* ws = a.ws; const int bs = u >> 2, h = u & 3;
    LAS float* PL = (LAS float*)F.lds + F.wave * DEC_PL; LAS float* CB = (LAS float*)F.lds + 8 * DEC_PL; constexpr int WSTR = 16 + 8 * 256;
    bf16x8 qa[8]; dec_load_q<256>(qa, (const bf16*)(ws + WS_QC) + (size_t)(TP + bs * LS) * DM + h * 256, DM, F.lane);
    DecW<256> w; dec_init(w);
    const float* Kb = (const float*)a.in[I_CMK] + ((size_t)(bs * 256 + F.wave * 32) * 4 + h) * 256; const float* Vb = (const float*)a.in[I_CMV] + ((size_t)(bs * 256 + F.wave * 32) * 4 + h) * 256;
#pragma unroll 1
    for (int c = 0; c < 2; ++c) dec_chunk<256, 1, 0>(w, qa, Kb + (size_t)c * 16 * 1024, Vb + (size_t)c * 16 * 1024, 1024, nullptr, 0.f, PL, F.lane);
    dec_park<256>(w, CB + F.wave * WSTR, F.lane);
    __syncthreads();
    dec_combine<256>(F.tid, CB, (bf16*)(ws + WS_OC) + (size_t)(TP + bs * LS) * DM + h * 256, DM);
    __syncthreads();
}


__device__ __forceinline__ void gla_g3_unit(const Frame& F, const Args& a, int u) {
    unsigned char* ws = a.ws;
    const int b = u >> 9, h = (u >> 7) & 3, n = u & 127; const int row0 = b * SEQ + n * 64;
    LAS unsigned char* KIB = F.lds; LAS unsigned char* ATTB = F.lds + 34816; LAS unsigned char* QDB = F.lds + 44032;
    LAS unsigned char* VSB = F.lds + 53248; LAS unsigned char* SPB = F.lds + 73728; LAS float* OS = (LAS float*)(F.lds + 94208);
#pragma unroll
    for (int i = 0; i < 2; ++i) { const int c = F.tid + NTHR * i; *(LAS v4u*)(VSB + (c >> 4) * 320 + (c & 15) * 16) = *(const v4u*)((const bf16*)(ws + WS_GV) + (size_t)(row0 + (c >> 4)) * 512 + h * 128 + (c & 15) * 8); }
#pragma unroll
    for (int i = 0; i < 4; ++i) { const int c4 = F.tid + NTHR * i; const f32x4 sp = *(const f32x4*)((const float*)(ws + WS_GKV) + ((size_t)((b * 4 + h) * 128 + n) * 64) * 128 + 4 * c4);
        v2u o; o.x = pg8::cvt_pk_bf16(sp.x, sp.y); o.y = pg8::cvt_pk_bf16(sp.z, sp.w); *(LAS v2u*)(SPB + (c4 >> 5) * 320 + (c4 & 31) * 8) = o; }
#pragma unroll
    for (int i = 0; i < 2; ++i) { const int c4 = F.tid + NTHR * i, t = c4 >> 4, d4 = (c4 & 15) * 4; const size_t gi = (size_t)(row0 + t) * 256 + h * 64 + d4;
        const f32x4 bb = *(const f32x4*)((const float*)(ws + WS_BB) + gi);
        const v2u qq = *(const v2u*)((const bf16*)(ws + WS_GQ) + gi), kk = *(const v2u*)((const bf16*)(ws + WS_GK) + gi);
        v2u qo, ko; qo.x = pg8::cvt_pk_bf16(bflo(qq.x) * __expf(bb.x), bfhi(qq.x) * __expf(bb.y)); qo.y = pg8::cvt_pk_bf16(bflo(qq.y) * __expf(bb.z), bfhi(qq.y) * __expf(bb.w));
        ko.x = pg8::cvt_pk_bf16(bflo(kk.x) * __expf(-bb.x), bfhi(kk.x) * __expf(-bb.y)); ko.y = pg8::cvt_pk_bf16(bflo(kk.y) * __expf(-bb.z), bfhi(kk.y) * __expf(-bb.w));
        *(LAS v2u*)(QDB + t * 144 + d4 * 2) = qo; *(LAS v2u*)(KIB + t * 144 + d4 * 2) = ko; }
    __syncthreads();
    {
        const int lane = F.lane, r32 = lane & 31, hi = lane >> 5;
        if (F.wave < 4) { const int tb = F.wave >> 1, sb = F.wave & 1; f32x16 acc = {};
            if (sb <= tb) {
                const LAS unsigned char* qrow = QDB + (32 * tb + r32) * 144; const LAS unsigned char* krow = KIB + (32 * sb + r32) * 144;
#pragma unroll
                for (int ks = 0; ks < 4; ++ks) acc = __builtin_amdgcn_mfma_f32_32x32x16_bf16(row_frag(qrow, ks, hi), row_frag(krow, ks, hi), acc, 0, 0, 0);
            }
#pragma unroll
            for (int r = 0; r < 16; ++r) { const int t = 32 * tb + crow(r, hi), s2 = 32 * sb + r32; *(LAS unsigned short*)(ATTB + t * 144 + s2 * 2) = (unsigned short)f2bf(s2 <= t ? acc[r] : 0.f); }
        }
    }
    __syncthreads();
    {
        const int lane = F.lane, r32 = lane & 31, hi = lane >> 5, tb = F.wave >> 2, nb = F.wave & 3;
        const int trb = (4 * hi + ((lane & 15) >> 2)) * 320 + (16 * ((lane >> 4) & 1) + 4 * (lane & 3)) * 2 + 64 * nb;
        const LAS unsigned char* arow = ATTB + (32 * tb + r32) * 144; const LAS unsigned char* qrow = QDB + (32 * tb + r32) * 144;
        f32x16 acc = {};
#pragma unroll
        for (int ks = 0; ks < 4; ++ks) acc = __builtin_amdgcn_mfma_f32_32x32x16_bf16(row_frag(arow, ks, hi), tr_frag<320>(VSB + trb, ks), acc, 0, 0, 0);
#pragma unroll
        for (int ks = 0; ks < 4; ++ks) acc = __builtin_amdgcn_mfma_f32_32x32x16_bf16(row_frag(qrow, ks, hi), tr_frag<320>(SPB + trb, ks), acc, 0, 0, 0);
#pragma unroll
        for (int r = 0; r < 16; ++r) OS[(32 * tb + crow(r, hi)) * 128 + 32 * nb + r32] = acc[r];
    }
    __syncthreads();
#pragma unroll
    for (int rr = 0; rr < 8; ++rr) { const int t = F.wave * 8 + rr; const float v0 = OS[t * 128 + F.lane], v1 = OS[t * 128 + 64 + F.lane];
        const float r = rsqrtf(wave_sum(v0 * v0 + v1 * v1) * (1.f / 128.f) + EPS);
        const float* ggo = (const float*)a.in[I_GGO] + h * 128; const BfPtr gr = GLD(ws + WS_GR) + ((size_t)(row0 + t) * 512 + h * 128);
        bf16* mo = (bf16*)(ws + WS_MERGED) + (size_t)(row0 + t) * DM + 512 + h * 128;
        mo[F.lane] = (bf16)f2bf(v0 * r * ggo[F.lane] * silu(gr[F.lane])); mo[64 + F.lane] = (bf16)f2bf(v1 * r * ggo[64 + F.lane] * silu(gr[64 + F.lane])); }
    __syncthreads();
}

struct EpiSoftmaxP {
    static constexpr bool PERM = true, AFTER_DRAIN = true;
    const LAS unsigned long long* argp;
    __device__ __forceinline__ void fused(f32x4 (&acc)[2][2][4][2], const Unit&, int wr, int wc, int fr, int fq, PG8_LAS unsigned char* lds, int wid, int lane) const {
        LAS float* PM = (LAS float*)lds; LAS float* PS = PM + 1024;
        const int ub = (int)blockIdx.x; const int ldp = DM;
        bf16* P = (bf16*)((unsigned char*)ld_ptr(argp + N_INPUTS + 1) + WS_PC) + ((size_t)((ub >> 7) & 1) * SEQ + (ub & 31) * 256) * DM + ((ub >> 5) & 3) * 256;
        { int t2 = lane_id(); asm volatile("" : "+v"(t2)); fr = t2 & 15; fq = (t2 >> 4) & 3; }
#pragma unroll
        for (int ai = 0; ai < 2; ++ai)
#pragma unroll
            for (int m = 0; m < 4; ++m) { float mx = -INFINITY;
#pragma unroll
                for (int bj = 0; bj < 2; ++bj)
#pragma unroll
                    for (int n = 0; n < 2; ++n) { const f32x4 x = acc[ai][bj][m][n]; mx = fmaxf(mx, fmaxf(fmaxf(x[0], x[1]), fmaxf(x[2], x[3]))); }
                mx = fmaxf(mx, xor16_f32(mx)); mx = fmaxf(mx, __shfl_xor(mx, 32));
                if (fq == 0) PM[(ai * 128 + wr * 64 + m * 16 + fr) * 4 + wc] = mx; }
        asm volatile("s_waitcnt lgkmcnt(0)" ::: "memory"); __builtin_amdgcn_s_barrier(); asm volatile("" ::: "memory");
#pragma unroll
        for (int ai = 0; ai < 2; ++ai)
#pragma unroll
            for (int m = 0; m < 4; ++m) { const int r = ai * 128 + wr * 64 + m * 16 + fr; const f32x4 pm = *(const LAS f32x4*)(PM + r * 4);
                const float M = fmaxf(fmaxf(pm[0], pm[1]), fmaxf(pm[2], pm[3])); float s = 0.f;
#pragma unroll
                for (int bj = 0; bj < 2; ++bj)
#pragma unroll
                    for (int n = 0; n < 2; ++n) { f32x4 x = acc[ai][bj][m][n]; x[0] = fexp2(x[0] - M); x[1] = fexp2(x[1] - M); x[2] = fexp2(x[2] - M); x[3] = fexp2(x[3] - M); acc[ai][bj][m][n] = x; s += (x[0] + x[1]) + (x[2] + x[3]); }
                s += xor16_f32(s); s += __shfl_xor(s, 32);
                if (fq == 0) PS[r * 4 + wc] = s; }
        asm volatile("s_waitcnt lgkmcnt(0)" ::: "memory"); __builtin_amdgcn_s_barrier(); asm volatile("" ::: "memory");
#pragma unroll
        for (int ai = 0; ai < 2; ++ai)
#pragma unroll
            for (int m = 0; m < 4; ++m) { const int r = ai * 128 + wr * 64 + m * 16 + fr; const f32x4 ps = *(const LAS f32x4*)(PS + r * 4); const float inv = 1.f / ((ps[0] + ps[1]) + (ps[2] + ps[3]));
#pragma unroll
                for (int bj = 0; bj < 2; ++bj) { const f32x4 x0 = acc[ai][bj][m][0], x1 = acc[ai][bj][m][1];
                    v4u o; o.x = pg8::cvt_pk_bf16(x0[0] * inv, x0[1] * inv); o.y = pg8::cvt_pk_bf16(x0[2] * inv, x0[3] * inv); o.z = pg8::cvt_pk_bf16(x1[0] * inv, x1[1] * inv); o.w = pg8::cvt_pk_bf16(x1[2] * inv, x1[3] * inv);
                    *(v4u*)(P + (size_t)r * ldp + bj * 128 + wc * 32 + fq * 8) = o; } }
        asm volatile("s_waitcnt lgkmcnt(0)" ::: "memory"); __builtin_amdgcn_s_barrier(); asm volatile("" ::: "memory");
    }
};

__device__ __forceinline__ void rms_rows_phase(const Frame& F, const float* X, const float* g, bf16* H) {
    const int gw = F.vcu * NWAVES + F.wave, NGW = F.G * NWAVES;
    for (int m = gw; m < TA; m += NGW) rms_row_bf16(X + (size_t)m * DM, g, H + (size_t)m * DM, F.lane);
}

__device__ __forceinline__ unsigned f2sort(float f) { const unsigned u = __builtin_bit_cast(unsigned, f); return u ^ ((u >> 31) ? 0xFFFFFFFFu : 0x80000000u); }
__device__ __forceinline__ float sort2f(unsigned s) { const unsigned u = s ^ ((s >> 31) ? 0x80000000u : 0xFFFFFFFFu); return __builtin_bit_cast(float, u); }
__device__ __forceinline__ float gelu_tanh(float x) { const float y = 0.7978845608028654f * (x + 0.044715f * x * x * x); const float e = __expf(2.f * y); return 0.5f * x * (1.f + (1.f - 2.f / (e + 1.f))); }
__device__ __forceinline__ unsigned gmax16(unsigned v) { return max16_u32(v); }
typedef __bf16 bf16x2_t __attribute__((ext_vector_type(2)));
__device__ __forceinline__ float dot2bf(unsigned a, unsigned b, float c) {
#if __has_builtin(__builtin_amdgcn_fdot2_f32_bf16)
    return __builtin_amdgcn_fdot2_f32_bf16(__builtin_bit_cast(bf16x2_t, a), __builtin_bit_cast(bf16x2_t, b), c, false);
#else
    return c + bflo(a) * bflo(b) + bfhi(a) * bfhi(b);
#endif
}
template <bool SPLIT>
__device__ __forceinline__ void peer_token(const Frame& F, const Args& a, int row, LAS unsigned* TOPS, const LAS unsigned* CT, int half, LAS float* PART) {
    unsigned char* ws = a.ws; const int lane = lane_id(), grp = lane >> 4, j16 = lane & 15;
    const bf16* sc = (const bf16*)(ws + WS_SC) + (size_t)row * 2048;
#pragma unroll 1
    for (int bt = 0; bt < 4; ++bt) {
        const v4u xq = *(const v4u*)(sc + (bt * 4 + grp) * 128 + 8 * j16);
        unsigned k[8]; const float xs[8] = {bflo(xq.x), bfhi(xq.x), bflo(xq.y), bfhi(xq.y), bflo(xq.z), bfhi(xq.z), bflo(xq.w), bfhi(xq.w)};
#pragma unroll
        for (int e = 0; e < 8; ++e) k[e] = (f2sort(xs[e]) & ~127u) | (unsigned)(127 - (8 * j16 + e));
#define PEER_CE(i, j) { const unsigned hi_ = k[i] > k[j] ? k[i] : k[j], lo_ = k[i] > k[j] ? k[j] : k[i]; k[i] = hi_; k[j] = lo_; }
        PEER_CE(0, 1) PEER_CE(2, 3) PEER_CE(4, 5) PEER_CE(6, 7)
        PEER_CE(0, 2) PEER_CE(1, 3) PEER_CE(4, 6) PEER_CE(5, 7)
        PEER_CE(1, 2) PEER_CE(5, 6)
        PEER_CE(0, 4) PEER_CE(1, 5) PEER_CE(2, 6) PEER_CE(3, 7)
        PEER_CE(2, 4) PEER_CE(3, 5)
        PEER_CE(1, 2) PEER_CE(3, 4) PEER_CE(5, 6)
#undef PEER_CE
        unsigned mine = 0u;
#pragma unroll 1
        for (int r = 0; r < 16; ++r) {
            const unsigned m = gmax16(k[0]);
            if (j16 == r) mine = m;
            const bool won = (k[0] == m);
#pragma unroll
            for (int e = 0; e < 7; ++e) k[e] = won ? k[e + 1] : k[e];
            k[7] = won ? 0u : k[7];
        }
        TOPS[(bt * 4 + grp) * 16 + j16] = mine;
    }
    int ex[2]; float gx[2], sux[2];
#pragma unroll
    for (int ps = 0; ps < 2; ++ps) {
        const int hd = ps * 4 + grp; const LAS unsigned* T1 = TOPS + (2 * hd) * 16; const LAS unsigned* T2 = T1 + 16;
        const unsigned c0_ = CT[j16], c1_ = CT[j16 + 16], c2_ = CT[j16 + 32], c3_ = CT[j16 + 48];
        const int ci0 = c0_ & 255, cj0 = c0_ >> 8, ci1 = c1_ & 255, cj1 = c1_ >> 8, ci2 = c2_ & 255, cj2 = c2_ >> 8, ci3 = c3_ & 255, cj3 = c3_ >> 8; const bool cv3 = (j16 + 48) < 50;
        unsigned k[4];
        { const float s0 = sort2f(T1[ci0] & ~127u) + sort2f(T2[cj0] & ~127u), s1 = sort2f(T1[ci1] & ~127u) + sort2f(T2[cj1] & ~127u),
                      s2 = sort2f(T1[ci2] & ~127u) + sort2f(T2[cj2] & ~127u), s3 = sort2f(T1[ci3] & ~127u) + sort2f(T2[cj3] & ~127u);
          k[0] = (f2sort(s0) & ~127u) | (unsigned)(127 - j16); k[1] = (f2sort(s1) & ~127u) | (unsigned)(127 - (j16 + 16)); k[2] = (f2sort(s2) & ~127u) | (unsigned)(127 - (j16 + 32));
          k[3] = cv3 ? ((f2sort(s3) & ~127u) | (unsigned)(127 - (j16 + 48))) : 0u; }
#define PEER_CE(i, j) { const unsigned hi_ = k[i] > k[j] ? k[i] : k[j], lo_ = k[i] > k[j] ? k[j] : k[i]; k[i] = hi_; k[j] = lo_; }
        PEER_CE(0, 1) PEER_CE(2, 3) PEER_CE(0, 2) PEER_CE(1, 3) PEER_CE(1, 2)
#undef PEER_CE
        unsigned mine = 0u;
#pragma unroll 1
        for (int r = 0; r < 16; ++r) {
            const unsigned m = gmax16(k[0]);
            if (j16 == r) mine = m;
            const bool won = (k[0] == m);
            k[0] = won ? k[1] : k[0]; k[1] = won ? k[2] : k[1]; k[2] = won ? k[3] : k[2]; k[3] = won ? 0u : k[3];
        }
        const int c = 127 - (int)(mine & 127u);
        int ci, cj;
        if (c < 16) { ci = 0; cj = c; } else if (c < 24) { ci = 1; cj = c - 16; } else if (c < 29) { ci = 2; cj = c - 24; } else if (c < 33) { ci = 3; cj = c - 29; }
        else if (c < 36) { ci = 4; cj = c - 33; } else if (c < 38) { ci = 5; cj = c - 36; } else if (c < 40) { ci = 6; cj = c - 38; } else if (c < 42) { ci = 7; cj = c - 40; } else { ci = c - 34; cj = 0; }
        const int i1 = 127 - (int)(T1[ci] & 127u), i2 = 127 - (int)(T2[cj] & 127u);
        ex[ps] = i1 * 128 + i2;
        const float sv = sort2f(mine & ~127u); const float s0 = __shfl(sv, lane & 48);
        float ee = __expf(sv - s0); const float es = sum16_f32(ee);
        const float* rsc = (const float*)(ws + WS_MISC);
        sux[ps] = rsc[ex[ps]]; gx[ps] = ee / es * rsc[16384 + ex[ps]];
    }
    {
        unsigned k0 = ((unsigned)ex[0] << 7) | (unsigned)lane, k1 = ((unsigned)ex[1] << 7) | (unsigned)(64 + lane);
#pragma unroll
        for (int k = 2; k <= 128; k <<= 1) {
#pragma unroll
            for (int j = k >> 1; j > 0; j >>= 1) {
                if (j == 64) { const unsigned lo = k0 < k1 ? k0 : k1, hi = k0 < k1 ? k1 : k0; k0 = lo; k1 = hi; }
                else {
                    unsigned p0, p1;
                    if (j == 32) { p0 = (unsigned)__shfl_xor((int)k0, 32); p1 = (unsigned)__shfl_xor((int)k1, 32); }
                    else if (j == 16) { p0 = xchg_xor_u32<16>(k0); p1 = xchg_xor_u32<16>(k1); } else if (j == 8) { p0 = xchg_xor_u32<8>(k0); p1 = xchg_xor_u32<8>(k1); }
                    else if (j == 4) { p0 = xchg_xor_u32<4>(k0); p1 = xchg_xor_u32<4>(k1); } else if (j == 2) { p0 = xchg_xor_u32<2>(k0); p1 = xchg_xor_u32<2>(k1); }
                    else { p0 = xchg_xor_u32<1>(k0); p1 = xchg_xor_u32<1>(k1); }
                    const bool low = (lane & j) == 0; const bool asc0 = (lane & k) == 0, asc1 = ((64 + lane) & k) == 0;
                    const unsigned mn0 = k0 < p0 ? k0 : p0, mx0 = k0 < p0 ? p0 : k0, mn1 = k1 < p1 ? k1 : p1, mx1 = k1 < p1 ? p1 : k1;
                    k0 = (low == asc0) ? mn0 : mx0; k1 = (low == asc1) ? mn1 : mx1;
                }
            }
        }
        const int o0 = (int)(k0 & 127u), o1 = (int)(k1 & 127u);
        const float g0a = __shfl(gx[0], o0 & 63), g0b = __shfl(gx[1], o0 & 63), g1a = __shfl(gx[0], o1 & 63), g1b = __shfl(gx[1], o1 & 63);
        const float s0a = __shfl(sux[0], o0 & 63), s0b = __shfl(sux[1], o0 & 63), s1a = __shfl(sux[0], o1 & 63), s1b = __shfl(sux[1], o1 & 63);
        gx[0] = (o0 & 64) ? g0b : g0a; gx[1] = (o1 & 64) ? g1b : g1a; sux[0] = (o0 & 64) ? s0b : s0a; sux[1] = (o1 & 64) ? s1b : s1a;
        ex[0] = (int)(k0 >> 7); ex[1] = (int)(k1 >> 7);
    }
    const float rstd2 = rsqrtf(((const float*)(ws + WS_SS))[TA + row] * (1.f / 1024.f) + EPS);
    float hf[16];
    { const bf16* hb = (const bf16*)(ws + WS_HB) + (size_t)row * DM + 4 * lane;
#pragma unroll
      for (int q = 0; q < 4; ++q) { const v2u hq = *(const v2u*)(hb + 256 * q); hf[4 * q] = bflo(hq.x); hf[4 * q + 1] = bfhi(hq.x); hf[4 * q + 2] = bflo(hq.y); hf[4 * q + 3] = bfhi(hq.y); } }
    float oacc[16];
#pragma unroll
    for (int i = 0; i < 16; ++i) oacc[i] = 0.f;
    const unsigned char* U = ws + WS_U16; const unsigned char* V = ws + WS_V16;
    v4u ub[8], vbA[8], vbB[8];
    const int gbeg = SPLIT ? 8 * half : 0, gend = SPLIT ? 8 * half + 8 : 16;
    const int addr32 = (lane ^ 32) << 2;
#define PEER_LOAD(buf, TAB, g) do { const int kk_ = (g) * 8; const int exs_ = (kk_ < 64) ? ex[0] : ex[1]; \
        _Pragma("unroll") for (int i = 0; i < 8; ++i) { const int e_ = __builtin_amdgcn_readlane(exs_, (kk_ & 63) + i); buf[i] = *(const v4u*)(TAB + (size_t)e_ * DM + 16 * lane); } } while (0)
#define PEER_DOTS(buf, g, wout) do { const int kk_ = (g) * 8; const float gxs_ = (kk_ < 64) ? gx[0] : gx[1]; const float sus_ = (kk_ < 64) ? sux[0] : sux[1]; float av[8]; \
        _Pragma("unroll") for (int i = 0; i < 8; ++i) { float s = 0.f; \
            _Pragma("unroll") for (int q = 0; q < 4; ++q) { const f32x2 lo = __builtin_amdgcn_cvt_pk_f32_fp8((int)buf[i][q], false), hi = __builtin_amdgcn_cvt_pk_f32_fp8((int)buf[i][q], true); \
                s += lo.x * hf[4 * q]; s += lo.y * hf[4 * q + 1]; s += hi.x * hf[4 * q + 2]; s += hi.y * hf[4 * q + 3]; } \
            av[i] = s; } \
        const bool b5 = lane & 32, b4 = lane & 16, b3_ = lane & 8; float bq[4], cq[2], dq; \
        _Pragma("unroll") for (int i = 0; i < 4; ++i) bq[i] = (b5 ? av[4 + i] : av[i]) + __builtin_bit_cast(float, __builtin_amdgcn_ds_bpermute(addr32, __builtin_bit_cast(int, b5 ? av[i] : av[4 + i])));     \
        _Pragma("unroll") for (int i = 0; i < 2; ++i) cq[i] = (b4 ? bq[2 + i] : bq[i]) + xor16_f32(b4 ? bq[i] : bq[2 + i]); \
        dq = (b3_ ? cq[1] : cq[0]) + DPP_F(b3_ ? cq[0] : cq[1], DPP_MIR);        \
        dq = sum8_f32(dq); \
        const int src = (kk_ & 63) + (lane >> 3); \
        wout = __shfl(gxs_, src) * gelu_tanh(dq * __shfl(sus_, src) * rstd2); } while (0)
#define PEER_ACC(buf, wv) do { _Pragma("unroll") for (int i = 0; i < 8; ++i) { const float w = __builtin_bit_cast(float, __builtin_amdgcn_readlane(__builtin_bit_cast(int, wv), 8 * i)); \
        _Pragma("unroll") for (int q = 0; q < 4; ++q) { const f32x2 lo = __builtin_amdgcn_cvt_pk_f32_fp8((int)buf[i][q], false), hi = __builtin_amdgcn_cvt_pk_f32_fp8((int)buf[i][q], true); \
            oacc[4 * q] += w * lo.x; oacc[4 * q + 1] += w * lo.y; oacc[4 * q + 2] += w * hi.x; oacc[4 * q + 3] += w * hi.y; } } } while (0)
    PEER_LOAD(ub, U, gbeg); PEER_LOAD(vbA, V, gbeg);
#pragma unroll 1
    for (int g0 = gbeg; g0 < gend; g0 += 2) {
        float w0, w1;
        PEER_DOTS(ub, g0, w0);
        PEER_LOAD(ub, U, g0 + 1); PEER_LOAD(vbB, V, g0 + 1);
        PEER_ACC(vbA, w0);
        PEER_DOTS(ub, g0 + 1, w1);
        { const int gn = (g0 + 2 < gend) ? g0 + 2 : g0 + 1;
          PEER_LOAD(ub, U, gn); PEER_LOAD(vbA, V, gn); }
        PEER_ACC(vbB, w1);
    }
#undef PEER_LOAD
#undef PEER_DOTS
#undef PEER_ACC
    if (SPLIT) {
        if (half == 1) {
#pragma unroll
            for (int q = 0; q < 4; ++q) *(LAS f32x4*)(PART + 16 * lane + 4 * q) = (f32x4){oacc[4 * q], oacc[4 * q + 1], oacc[4 * q + 2], oacc[4 * q + 3]}; }
        __syncthreads();
        if (half == 1) return;
#pragma unroll
        for (int q = 0; q < 4; ++q) { const f32x4 p = *(const LAS f32x4*)(PART + 16 * lane + 4 * q); oacc[4 * q] += p.x; oacc[4 * q + 1] += p.y; oacc[4 * q + 2] += p.z; oacc[4 * q + 3] += p.w; }
    }
    asm volatile("" : "+s"(row)); const int lane2 = lane_id();
    const f32x4* x2 = (const f32x4*)((const float*)(ws + WS_X2) + (size_t)row * DM) + lane2;
    f32x4 xv[4]; float ss = 0.f;
#pragma unroll
    for (int q = 0; q < 4; ++q) { xv[q] = x2[64 * q]; xv[q].x += oacc[4 * q]; xv[q].y += oacc[4 * q + 1]; xv[q].z += oacc[4 * q + 2]; xv[q].w += oacc[4 * q + 3]; ss += (xv[q].x * xv[q].x + xv[q].y * xv[q].y) + (xv[q].z * xv[q].z + xv[q].w * xv[q].w); }
    const float r = rsqrtf(wave_sum(ss) * (1.f / DM) + EPS);
    const f32x4* gf = (const f32x4*)((const float*)a.in[I_GFIN]) + lane2;
    f32x4* y = (f32x4*)(row < TP ? a.out + O_YP + (size_t)row * DM : a.out + O_YS + (size_t)(row - TP) * DM) + lane2;
#pragma unroll
    for (int q = 0; q < 4; ++q) { const f32x4 g4 = gf[64 * q]; f32x4 o; o.x = xv[q].x * r * g4.x; o.y = xv[q].y * r * g4.y; o.z = xv[q].z * r * g4.z; o.w = xv[q].w * r * g4.w; y[64 * q] = o; }
}
__device__ __forceinline__ void cand_ij(int c, int& ci, int& cj) {
    if (c < 16) { ci = 0; cj = c; } else if (c < 24) { ci = 1; cj = c - 16; } else if (c < 29) { ci = 2; cj = c - 24; } else if (c < 33) { ci = 3; cj = c - 29; }
    else if (c < 36) { ci = 4; cj = c - 33; } else if (c < 38) { ci = 5; cj = c - 36; } else if (c < 40) { ci = 6; cj = c - 38; } else if (c < 42) { ci = 7; cj = c - 40; } else if (c < 50) { ci = c - 34; cj = 0; } else { ci = 0; cj = 0; }
}
__device__ __forceinline__ void peer_phase(const Frame& F, const Args& a) {
    LAS unsigned* TOPS = (LAS unsigned*)F.lds + F.wave * 256;
    LAS unsigned* CT = (LAS unsigned*)F.lds + 8 * 256 + 4 * 1024;
    if (F.tid < 64) { int ci, cj; cand_ij(F.tid, ci, cj); CT[F.tid] = (unsigned)ci | ((unsigned)cj << 8); }
    __syncthreads();
    const int gw = F.vcu * NWAVES + F.wave, NGW = F.G * NWAVES;
    const int nfull = TA / NGW, rem = TA - nfull * NGW;
#pragma unroll 1
    for (int i = 0; i < nfull; ++i) peer_token<false>(F, a, gw + i * NGW, TOPS, CT, 0, nullptr);
    if (rem == 4 * F.G) {
        __syncthreads();
        peer_token<true>(F, a, nfull * NGW + F.vcu * 4 + (F.wave >> 1), TOPS, CT, F.wave & 1, (LAS float*)F.lds + 8 * 256 + (F.wave >> 1) * 1024);
    } else {
        const int row = gw + nfull * NGW; if (row < TA) peer_token<false>(F, a, row, TOPS, CT, 0, nullptr);
    }
}


template <class EpiS>
__device__ __forceinline__ void skinny_tile(const Frame& F, const bf16* A, int lda, const bf16* Bt, int ldb, int tm, int tn, const EpiS& E) {
    const int lane = F.lane, fr = lane & 15, fq = lane >> 4, w = F.wave, lr = lane >> 3, lc = lane & 7;
    LAS unsigned char* SA = F.lds + w * 16384; LAS unsigned char* SB = SA + 8192;
    const bf16* ag = A + (size_t)(tm * 64 + lr) * lda + w * 128 + 8 * lc;
    const bf16* bg = Bt + (size_t)(tn * 64 + lr) * ldb + w * 128 + 8 * lc;
    f32x4 acc[4][4];
#pragma unroll
    for (int m = 0; m < 4; ++m)
#pragma unroll
        for (int n = 0; n < 4; ++n) acc[m][n] = (f32x4){0.f, 0.f, 0.f, 0.f};
    v4u ar[2][8], br[2][8];
#pragma unroll
    for (int kh = 0; kh < 2; ++kh)
#pragma unroll
        for (int i = 0; i < 8; ++i) { ar[kh][i] = *(const v4u*)(ag + (size_t)(8 * i) * lda + 64 * kh); br[kh][i] = *(const v4u*)(bg + (size_t)(8 * i) * ldb + 64 * kh); }
#pragma unroll
    for (int kh = 0; kh < 2; ++kh) {
#pragma unroll
        for (int i = 0; i < 8; ++i) { const int row = 8 * i + lr; *(LAS v4u*)(SA + row * 128 + ((lc ^ (row & 7)) << 4)) = ar[kh][i]; *(LAS v4u*)(SB + row * 128 + ((lc ^ (row & 7)) << 4)) = br[kh][i]; }
        bf16x8 af[4][2], bfr[4][2];
#pragma unroll
        for (int m = 0; m < 4; ++m)
#pragma unroll
            for (int ks = 0; ks < 2; ++ks) { const int row = 16 * m + fr; const int off = row * 128 + (((4 * ks + fq) ^ (row & 7)) << 4);
                af[m][ks] = *(const LAS bf16x8*)(SA + off); bfr[m][ks] = *(const LAS bf16x8*)(SB + off); }
#pragma unroll
        for (int ks = 0; ks < 2; ++ks)
#pragma unroll
            for (int m = 0; m < 4; ++m)
#pragma unroll
                for (int n = 0; n < 4; ++n) acc[m][n] = __builtin_amdgcn_mfma_f32_16x16x32_bf16(bfr[n][ks], af[m][ks], acc[m][n], 0, 0, 0);
        asm volatile("s_waitcnt lgkmcnt(0)" ::: "memory");
    }
    LAS float* PS = (LAS float*)F.lds + w * 4096;
#pragma unroll
    for (int m = 0; m < 4; ++m)
#pragma unroll
        for (int n = 0; n < 4; ++n) *(LAS f32x4*)(PS + (16 * m + fr) * 64 + 4 * ((4 * n + fq) ^ fr)) = acc[m][n];
    lds_barrier();
    {
        const int row = F.tid >> 3, c8 = (F.tid & 7) * 8; const LAS float* PR = (const LAS float*)F.lds + row * 64;
        const int ch0 = 4 * (((F.tid & 7) * 2) ^ (row & 15)), ch1 = 4 * (((F.tid & 7) * 2 + 1) ^ (row & 15));
        f32x4 s0 = *(const LAS f32x4*)(PR + ch0), s1 = *(const LAS f32x4*)(PR + ch1);
#pragma unroll
        for (int ww = 1; ww < 8; ++ww) { s0 += *(const LAS f32x4*)(PR + ww * 4096 + ch0); s1 += *(const LAS f32x4*)(PR + ww * 4096 + ch1); }
        float v[8] = {s0.x, s0.y, s0.z, s0.w, s1.x, s1.y, s1.z, s1.w};
        E(tm * 64 + row, tn * 64 + c8, v, F.tid);
    }
    lds_barrier();
}
struct EpiSk {
    float* d32; int ld32; bf16* d16; int ld16; float sc16;
    const float* res; int ldr;
    const float* gcol; float* ssq; const float* rsq;
    __device__ __forceinline__ void operator()(int row, int col, float (&v)[8], int tid) const {
        if (rsq) { const float rs = rsqrtf(rsq[row] * (1.f / 1024.f) + EPS);
#pragma unroll
            for (int i = 0; i < 8; ++i) v[i] *= rs; }
        if (res) { const f32x4 a = *(const f32x4*)(res + (size_t)row * ldr + col), b = *(const f32x4*)(res + (size_t)row * ldr + col + 4);
            v[0] += a.x; v[1] += a.y; v[2] += a.z; v[3] += a.w; v[4] += b.x; v[5] += b.y; v[6] += b.z; v[7] += b.w; }
        if (d32) { *(f32x4*)(d32 + (size_t)row * ld32 + col) = (f32x4){v[0], v[1], v[2], v[3]}; *(f32x4*)(d32 + (size_t)row * ld32 + col + 4) = (f32x4){v[4], v[5], v[6], v[7]}; }
        if (ssq) { float ss = 0.f;
#pragma unroll
            for (int i = 0; i < 8; ++i) ss += v[i] * v[i];
            ss = sum8_f32(ss);
            if ((tid & 7) == 0) atomicAdd(ssq + row, ss); }
        if (d16) { float w8[8];
#pragma unroll
            for (int i = 0; i < 8; ++i) w8[i] = v[i];
            if (gcol) { const f32x4 a = *(const f32x4*)(gcol + col), b = *(const f32x4*)(gcol + col + 4); w8[0] *= a.x; w8[1] *= a.y; w8[2] *= a.z; w8[3] *= a.w; w8[4] *= b.x; w8[5] *= b.y; w8[6] *= b.z; w8[7] *= b.w; }
            v4u o; o.x = pg8::cvt_pk_bf16(w8[0] * sc16, w8[1] * sc16); o.y = pg8::cvt_pk_bf16(w8[2] * sc16, w8[3] * sc16); o.z = pg8::cvt_pk_bf16(w8[4] * sc16, w8[5] * sc16); o.w = pg8::cvt_pk_bf16(w8[6] * sc16, w8[7] * sc16);
            *(v4u*)(d16 + (size_t)row * ld16 + col) = o; }
    }
};

#define SK_TM16(t) (4 * (((t) >> 5) >> 1) + (((t) & 31) >> 3))
#define SK_TN16(t) (8 * (((t) >> 5) & 1) + ((t) & 7))
#define SK_TM32(t) (4 * ((((t) & 255) >> 5) >> 1) + ((((t) & 31) + 32 * ((t) >> 8)) >> 4))
#define SK_TN32(t) (16 * ((((t) & 255) >> 5) & 1) + ((((t) & 31) + 32 * ((t) >> 8)) & 15))


#ifndef PH_MAX
#define PH_MAX 99
#endif
__global__ void __launch_bounds__(NTHR, 2) mega_fwd(Args args) {
    extern __shared__ __attribute__((aligned(16))) unsigned char lds_raw[];
    Frame F;
    F.lds = (LAS unsigned char*)lds_raw;
    F.wave = __builtin_amdgcn_readfirstlane((int)threadIdx.x >> 6); F.lane = lane_id(); F.tid = F.wave * 64 + F.lane;
    F.G = gridDim.x; { const int bx = blockIdx.x; F.vcu = (F.G % 8 == 0) ? (bx % 8) * (F.G / 8) + bx / 8 : bx; }
    volatile LAS unsigned* MISC = (volatile LAS unsigned*)(F.lds + MISC_OFF);
    LAS unsigned long long* ARGP = (LAS unsigned long long*)(F.lds + ARGS_OFF);
    for (int u = F.tid; u < (LDS_BYTES - LDSCTL_OFF) / 4; u += NTHR) ((LAS unsigned*)(F.lds + LDSCTL_OFF))[u] = 0u;
    __syncthreads();
    if (F.tid == 0) {
        ARGP[0] = (unsigned long long)args.in[0];
        ARGP[1] = (unsigned long long)args.in[1];
        ARGP[2] = (unsigned long long)args.in[2];
        ARGP[3] = (unsigned long long)args.in[3];
        ARGP[4] = (unsigned long long)args.in[4];
        ARGP[5] = (unsigned long long)args.in[5];
        ARGP[6] = (unsigned long long)args.in[6];
        ARGP[7] = (unsigned long long)args.in[7];
        ARGP[8] = (unsigned long long)args.in[8];
        ARGP[9] = (unsigned long long)args.in[9];
        ARGP[10] = (unsigned long long)args.in[10];
        ARGP[11] = (unsigned long long)args.in[11];
        ARGP[12] = (unsigned long long)args.in[12];
        ARGP[13] = (unsigned long long)args.in[13];
        ARGP[14] = (unsigned long long)args.in[14];
        ARGP[15] = (unsigned long long)args.in[15];
        ARGP[16] = (unsigned long long)args.in[16];
        ARGP[17] = (unsigned long long)args.in[17];
        ARGP[18] = (unsigned long long)args.in[18];
        ARGP[19] = (unsigned long long)args.in[19];
        ARGP[20] = (unsigned long long)args.in[20];
        ARGP[21] = (unsigned long long)args.in[21];
        ARGP[22] = (unsigned long long)args.in[22];
        ARGP[23] = (unsigned long long)args.in[23];
        ARGP[24] = (unsigned long long)args.in[24];
        ARGP[25] = (unsigned long long)args.in[25];
        ARGP[26] = (unsigned long long)args.in[26];
        ARGP[27] = (unsigned long long)args.in[27];
        ARGP[28] = (unsigned long long)args.in[28];
        ARGP[N_INPUTS] = (unsigned long long)args.out; ARGP[N_INPUTS + 1] = (unsigned long long)args.ws;
    }
    __syncthreads();
    { const XcdBarrier bar0 = xcd_barrier_post((unsigned*)((gu32*)(args.ws + WS_CTL) + CW_BAR), MISC + 8, F.wave); if (F.tid == 0) MISC[10] = bar0.x; }
    __syncthreads();
#define GRID_BAR() do { XcdBarrier bar_; bar_.bar = (unsigned*)((gu32*)((unsigned char*)ld_ptr(ARGP + N_INPUTS + 1) + WS_CTL) + CW_BAR); bar_.x = MISC[10]; bar_.st = MISC + 8; bar_.wave = F.wave; xcd_barrier(bar_); } while (0)
#define PHASE_ARGS const Args A = load_args(ARGP); unsigned char* const ws = A.ws; float* const out = A.out; (void)ws; (void)out; { int l_ = lane_id(); asm volatile("" : "+v"(l_)); F.lane = l_; F.tid = F.wave * 64 + l_; }

    { PHASE_ARGS;
    p0_prologue(F, A);
    }
    GRID_BAR();
#if defined(PROBE_BAR8)
    GRID_BAR(); GRID_BAR(); GRID_BAR(); GRID_BAR(); GRID_BAR(); GRID_BAR(); GRID_BAR(); GRID_BAR();
#endif
#if PH_MAX >= 1
    { PHASE_ARGS;
    {
        pg8::Gemm g{(const bf16*)(ws + WS_HB), (const bf16*)(ws + WS_WIN), DM, DM, DM};
        pg8::StaticOrder S; S.init(TA, N_IN, F.G, (int)blockIdx.x);
        EpiInProj E{out, ws, (const float*)A.in[I_BFF]};
        pg8::gemm_phase(F.lds, g, S, E, F.wave);
    }
    {
        const int off = (TA / 256) * (N_IN / 256) % F.G;
        pg8::Gemm g{(const bf16*)(ws + WS_MB), (const bf16*)(ws + WS_WMK), DM, DM, DM};
        pg8::StaticOrder S; S.init(512, DM, F.G, ((int)blockIdx.x + F.G - off) % F.G);
        EpiGen E{out + O_MKP, DM, (bf16*)(ws + WS_MK16), DM, 1.f, nullptr, nullptr, 0, 0, nullptr, nullptr, nullptr};
        pg8::gemm_phase(F.lds, g, S, E, F.wave);
    }
    {
        const int off = ((TA / 256) * (N_IN / 256) + 8) % F.G;
        pg8::Gemm g{(const bf16*)(ws + WS_MB), (const bf16*)(ws + WS_WMV), DM, DM, DM};
        pg8::StaticOrder S; S.init(512, DM, F.G, ((int)blockIdx.x + F.G - off) % F.G);
        EpiGen E{out + O_MVP, DM, nullptr, 0, 1.f, nullptr, nullptr, 0, 0, nullptr, nullptr, nullptr};
        pg8::gemm_phase(F.lds, g, S, E, F.wave);
    }
    {
        const int off = ((TA / 256) * (N_IN / 256) + 16) % F.G;
        pg8::Gemm g{(const bf16*)(ws + WS_WMV), (const bf16*)(ws + WS_MB), DM, DM, DM};
        pg8::StaticOrder S; S.init(DM, 512, F.G, ((int)blockIdx.x + F.G - off) % F.G);
        EpiGen E{nullptr, 0, (bf16*)(ws + WS_MVT16), 512, 1.f, nullptr, nullptr, 0, 0, nullptr, nullptr, nullptr};
        pg8::gemm_phase(F.lds, g, S, E, F.wave);
    }
    }
    GRID_BAR();
#endif
#if PH_MAX >= 2
    asm volatile("; ===PHASE 2===");
    { PHASE_ARGS;
    {
        const int gw = F.vcu * NWAVES + F.wave, NGW = F.G * NWAVES;
        if ((gw & 3) == 0) for (int it = gw >> 2; it < 512; it += NGW >> 2) fox_norms_item(F, (const bf16*)(ws + WS_QF), (const bf16*)(ws + WS_KF), out + O_LFP, (float*)(ws + WS_MISC + MiB), (float*)(ws + WS_KBIAS), (float*)(ws + WS_MISC + MiB + 65536), it);
        for (int it = gw; it < NB_S * NPAGES; it += NGW) fox_suffix_item(F, (const float*)A.in[I_CFL], (const int*)A.in[I_PT], (float*)(ws + WS_SUF), (float*)(ws + WS_MISC + 2 * MiB), it);
        for (int u = F.vcu; u < 1024; u += F.G) gla_g1_unit(F, A, u);
        for (int u = F.vcu; u < 512; u += F.G) gla_sample_unit(F, A, u);
    }
    }
    GRID_BAR();
#endif
#if PH_MAX >= 3
    asm volatile("; ===PHASE 3===");
    { PHASE_ARGS;
    gla_scan(F, A);
    __syncthreads();
    for (int i = F.vcu; i < 256; i += F.G) { const int bh = i >> 4, s = i & 15;
        fox_attn_unit(F, (const bf16*)(ws + WS_QF), (const bf16*)(ws + WS_KF), (const bf16*)(ws + WS_VF), (const float*)(ws + WS_KBIAS), (const float*)(ws + WS_MISC + MiB + 65536), (const float*)(ws + WS_MISC + MiB), (bf16*)(ws + WS_MERGED), bh >> 3, bh & 7, s);
        fox_attn_unit(F, (const bf16*)(ws + WS_QF), (const bf16*)(ws + WS_KF), (const bf16*)(ws + WS_VF), (const float*)(ws + WS_KBIAS), (const float*)(ws + WS_MISC + MiB + 65536), (const float*)(ws + WS_MISC + MiB), (bf16*)(ws + WS_MERGED), bh >> 3, bh & 7, 31 - s); }
    }
    GRID_BAR();
#endif
#if PH_MAX >= 4
    asm volatile("; ===PHASE 4===");
    { PHASE_ARGS;
    if (!(F.vcu & 1)) { for (int u = F.vcu; u < 1024; u += F.G) gla_g3_unit(F, A, u); }
    }
    { PHASE_ARGS;
    for (int u = F.vcu; u < 1024; u += F.G) fox_sample_unit(F, A, u);
    }
    { PHASE_ARGS;
    if (F.vcu & 1) { for (int u = F.vcu; u < 1024; u += F.G) gla_g3_unit(F, A, u); }
    }
    GRID_BAR();
#endif
#if PH_MAX >= 5
    asm volatile("; ===PHASE 5===");
    { PHASE_ARGS;
    {
        pg8::Gemm g{(const bf16*)(ws + WS_MERGED), (const bf16*)(ws + WS_WOUT), DM, DM, DM};
        pg8::StaticOrder S; S.init(TP, DM, F.G, (int)blockIdx.x);
        EpiGen E{(float*)(ws + WS_X1), DM, (bf16*)(ws + WS_HB), DM, 1.f, (const float*)A.in[I_XP], (const float*)A.in[I_XS], TP, DM, (const float*)A.in[I_GCROSS], (float*)(ws + WS_SS), nullptr};
        pg8::gemm_phase(F.lds, g, S, E, F.wave);
        __syncthreads();
        EpiSk Es{(float*)(ws + WS_X1) + (size_t)TP * DM, DM, (bf16*)(ws + WS_HB) + (size_t)TP * DM, DM, 1.f, (const float*)A.in[I_XS], DM, (const float*)A.in[I_GCROSS], (float*)(ws + WS_SS) + TP, nullptr};
        for (int t = F.vcu; t < 256; t += F.G) skinny_tile(F, (const bf16*)(ws + WS_MERGED) + (size_t)TP * DM, DM, (const bf16*)(ws + WS_WOUT), DM, SK_TM16(t), SK_TN16(t), Es);
    }
    }
    GRID_BAR();
#endif
#if PH_MAX >= 7
    asm volatile("; ===PHASE 7===");
    { PHASE_ARGS;
    {
        pg8::Gemm g{(const bf16*)(ws + WS_HB), (const bf16*)(ws + WS_WCQ), DM, DM, DM};
        pg8::StaticOrder S; S.init(TP, DM, F.G, (int)blockIdx.x);
        EpiGen E{nullptr, 0, (bf16*)(ws + WS_QC), DM, C2C, nullptr, nullptr, 0, 0, nullptr, nullptr, (const float*)(ws + WS_SS)};
        pg8::gemm_phase(F.lds, g, S, E, F.wave);
        __syncthreads();
        EpiSk Es{nullptr, 0, (bf16*)(ws + WS_QC) + (size_t)TP * DM, DM, C2C, nullptr, 0, nullptr, nullptr, (const float*)(ws + WS_SS) + TP};
        for (int t = F.vcu; t < 256; t += F.G) skinny_tile(F, (const bf16*)(ws + WS_HB) + (size_t)TP * DM, DM, (const bf16*)(ws + WS_WCQ), DM, SK_TM16(t), SK_TN16(t), Es);
    }
    }
    GRID_BAR();
#endif
#if PH_MAX >= 8
    asm volatile("; ===PHASE 8===");
    { PHASE_ARGS;
    {
        const int u = (int)blockIdx.x, b = (u >> 7) & 1, h = (u >> 5) & 3, pnl = u & 31;
        const size_t roff = ((size_t)b * SEQ + pnl * 256) * DM + h * 256;
        if (F.vcu & 1) { for (int v = F.vcu; v < 512; v += F.G) cross_sample_unit(F, A, v); }
        pg8::Gemm g{(const bf16*)(ws + WS_QC) + roff, (const bf16*)(ws + WS_MK16) + (size_t)(b * 256) * DM + h * 256, DM, DM, 256};
        pg8::SingleUnit S{u < 256 ? 1 : 0, {0, 0}};
        EpiSoftmaxP E{ARGP};
        pg8::gemm_phase(F.lds, g, S, E, F.wave);
        VM_WAIT(); __syncthreads();
        {
            pg8::Gemm g2{(const bf16*)(ws + WS_PC) + roff, (const bf16*)(ws + WS_MVT16) + (size_t)(h * 256) * 512 + b * 256, DM, 512, 256};
            EpiGen E2{nullptr, 0, (bf16*)(ws + WS_OC) + roff, DM, 1.f, nullptr, nullptr, 0, 0, nullptr, nullptr, nullptr};
            pg8::gemm_phase(F.lds, g2, S, E2, F.wave);
        }
        __syncthreads();
        if (!(F.vcu & 1)) { for (int v = F.vcu; v < 512; v += F.G) cross_sample_unit(F, A, v); }
    }
    }
    GRID_BAR();
#endif
#if PH_MAX >= 10
    asm volatile("; ===PHASE 10===");
    { PHASE_ARGS;
    {
        pg8::Gemm g{(const bf16*)(ws + WS_OC), (const bf16*)(ws + WS_WCO), DM, DM, DM};
        pg8::StaticOrder S; S.init(TP, DM, F.G, (int)blockIdx.x);
        EpiGen E{(float*)(ws + WS_X2), DM, (bf16*)(ws + WS_HB), DM, 1.f, (const float*)(ws + WS_X1), (const float*)(ws + WS_X1), TA, DM, (const float*)A.in[I_GFFN], (float*)(ws + WS_SS) + TA, nullptr};
        pg8::gemm_phase(F.lds, g, S, E, F.wave);
        __syncthreads();
        EpiSk Es{(float*)(ws + WS_X2) + (size_t)TP * DM, DM, (bf16*)(ws + WS_HB) + (size_t)TP * DM, DM, 1.f, (const float*)(ws + WS_X1) + (size_t)TP * DM, DM, (const float*)A.in[I_GFFN], (float*)(ws + WS_SS) + TA + TP, nullptr};
        for (int t = F.vcu; t < 256; t += F.G) skinny_tile(F, (const bf16*)(ws + WS_OC) + (size_t)TP * DM, DM, (const bf16*)(ws + WS_WCO), DM, SK_TM16(t), SK_TN16(t), Es);
    }
    }
    GRID_BAR();
#endif
#if PH_MAX >= 12
    asm volatile("; ===PHASE 12===");
    { PHASE_ARGS;
    {
        pg8::Gemm g{(const bf16*)(ws + WS_HB), (const bf16*)(ws + WS_WPK), DM, DM, DM};
        pg8::StaticOrder S; S.init(TP, 2048, F.G, (int)blockIdx.x);
        EpiGen E{nullptr, 0, (bf16*)(ws + WS_SC), 2048, 1.f, nullptr, nullptr, 0, 0, nullptr, nullptr, (const float*)(ws + WS_SS) + TA};
        pg8::gemm_phase(F.lds, g, S, E, F.wave);
        __syncthreads();
        EpiSk Es{nullptr, 0, (bf16*)(ws + WS_SC) + (size_t)TP * 2048, 2048, 1.f, nullptr, 0, nullptr, nullptr, (const float*)(ws + WS_SS) + TA + TP};
        for (int t = F.vcu; t < 512; t += F.G) skinny_tile(F, (const bf16*)(ws + WS_HB) + (size_t)TP * DM, DM, (const bf16*)(ws + WS_WPK), DM, SK_TM32(t), SK_TN32(t), Es);
    }
    }
    GRID_BAR();
#endif
#if PH_MAX >= 13
    asm volatile("; ===PHASE 13===");
    { PHASE_ARGS;
    peer_phase(F, A);
    }
#endif
#if PH_MAX < 13
    {   PHASE_ARGS;
        const int gw = F.vcu * NWAVES + F.wave, NGW = F.G * NWAVES;
        for (int m = gw; m < TA; m += NGW) {
            const float* x = m < TP ? (const float*)A.in[I_XP] + (size_t)m * DM : (const float*)A.in[I_XS] + (size_t)(m - TP) * DM;
            float* y = m < TP ? out + O_YP + (size_t)m * DM : out + O_YS + (size_t)(m - TP) * DM;
            for (int j = 0; j < 4; ++j) ((f32x4*)y)[F.lane + 64 * j] = ((const f32x4*)x)[F.lane + 64 * j];
        }
    }
#endif

}

extern "C" void kernel_launch(void* const* d_in, const int* in_sizes, int n_in, void* d_out, int out_size, void* d_ws, size_t ws_size, hipStream_t stream) {
    static int grid = 0;
    if (grid == 0) {
        if (n_in != N_INPUTS || (size_t)out_size != O_TOTAL || ws_size < WS_END) { fprintf(stderr, "kernel_launch: unexpected shapes (n_in %d out %d ws %zu)\n", n_in, out_size, ws_size); grid = -1; return; }
        int dev = 0, cus = 0, per_cu = 0;
        if (hipGetDevice(&dev) != hipSuccess || hipDeviceGetAttribute(&cus, hipDeviceAttributeMultiprocessorCount, dev) != hipSuccess) { grid = -1; return; }
        if (hipFuncSetAttribute((const void*)mega_fwd, hipFuncAttributeMaxDynamicSharedMemorySize, LDS_BYTES) != hipSuccess) { fprintf(stderr, "kernel_launch: hipFuncSetAttribute failed\n"); grid = -1; return; }
        if (hipOccupancyMaxActiveBlocksPerMultiprocessor(&per_cu, (const void*)mega_fwd, NTHR, LDS_BYTES) != hipSuccess || per_cu < 1)
            fprintf(stderr, "kernel_launch: occupancy query reports %d workgroups per CU\n", per_cu);
        (void)hipGetLastError();
        grid = cus;
        if (grid > 256) grid = 256;
    }
    if (grid < 0) return;
    if (hipMemsetAsync((char*)d_ws + WS_CTL, 0, CTL_ZERO_BYTES, stream) != hipSuccess) return;
    Args a{};
    for (int i = 0; i < N_INPUTS; ++i) a.in[i] = d_in[i];
    a.out = (float*)d_out; a.ws = (unsigned char*)d_ws;
    hipLaunchKernelGGL(mega_fwd, dim3(grid), dim3(NTHR), LDS_BYTES, stream, a);
    const hipError_t le = hipPeekAtLastError();
    if (le != hipSuccess) fprintf(stderr, "kernel_launch: launch failed: %s\n", hipGetErrorName(le));
}
```

```cpp
#define PH_MAX 13
#include <hip/hip_runtime.h>
#include <cstdio>
#include <cstdint>

namespace pg8 {
#define PG8_LAS __attribute__((address_space(3)))
typedef unsigned short bf16_t;
typedef short bf16x8 __attribute__((ext_vector_type(8)));
typedef float f32x4 __attribute__((ext_vector_type(4)));
typedef unsigned u32x4 __attribute__((ext_vector_type(4)));
typedef unsigned u32x2 __attribute__((ext_vector_type(2)));
constexpr int BM = 256, BK = 64, HALF = 128, HTB = HALF * BK * 2  , STAGE_BYTES = 8 * HTB, NXCD = 8, WGM = 8;

__host__ __device__ __forceinline__ int lds_byte(int r, int c) { const int st = (r >> 4) * 2 + (c >> 5), rr = r & 15, cc = c & 31, ob = rr * 64 + cc * 2; return st * 1024 + (ob ^ (((ob >> 9) & 1) << 5)); }
__host__ __device__ __forceinline__ void stage_rc(int b, int& R, int& C) { const int st = b / 1024, sb = b % 1024, swz = sb ^ (((sb >> 9) & 1) << 5); R = (st >> 1) * 16 + swz / 64; C = (st & 1) * 32 + (swz % 64) / 2; }

__host__ __device__ __forceinline__ int perm32(int rho) { const int n = rho >> 4, i = rho & 15; return 8 * (i >> 2) + 4 * n + (i & 3); }

struct Unit { int pm, pn; };
struct Gemm { const bf16_t* A; const bf16_t* Bt; int lda, ldb, K; };

struct StaticOrder {
    int nM, nN, nwg, G, c;
    __host__ __device__ void init(int M, int N, int G_, int c_) { nM = M / BM; nN = N / BM; nwg = nM * nN; G = G_; c = c_; }
    __host__ __device__ bool next(int i, Unit& u) const {
        const long L = (long)i * G + c; if (L >= nwg) return false;
        int wgid = (int)L; { const int q = nwg / NXCD, r = nwg % NXCD, xcd = wgid % NXCD, off = wgid / NXCD; wgid = (xcd < r ? xcd * (q + 1) : r * (q + 1) + (xcd - r) * q) + off; }
        const int nig = WGM * nN, gid = wgid / nig, fm = gid * WGM, gsz = (nM - fm) < WGM ? (nM - fm) : WGM;
        u.pm = fm + ((wgid % nig) % gsz); u.pn = (wgid % nig) / gsz; return true;
    }
};
struct SingleUnit {
    int has; Unit u0;
    __host__ __device__ bool next(int i, Unit& u) const { if (i != 0 || !has) return false; u = u0; return true; }
};

__device__ __forceinline__ unsigned cvt_pk_bf16(float lo, float hi) { unsigned r; asm volatile("v_cvt_pk_bf16_f32 %0, %1, %2" : "=v"(r) : "v"(lo), "v"(hi)); return r; }

template <class Epi, class Sched>
__device__ __forceinline__ void gemm_phase(PG8_LAS unsigned char* lds, const Gemm g, const Sched& S, const Epi& E, int wave_id) {
    int lane; asm volatile("v_mbcnt_lo_u32_b32 %0, -1, 0\n\tv_mbcnt_hi_u32_b32 %0, -1, %0" : "=v"(lane));
    const int wid = wave_id; const int tid = wid * 64 + lane; const int wr = wid >> 2, wc = wid & 3, fr = lane & 15, fq = lane >> 4;
    const int K = g.K, nt = K / BK;
    unsigned voffA[2], voffB[2];
#pragma unroll
    for (int i = 0; i < 2; ++i) { int R, C; stage_rc(tid * 16 + i * 8192, R, C);
        const int Rb = Epi::PERM ? ((R & ~31) + perm32(R & 31)) : R;
        voffA[i] = (unsigned)(R * g.lda + C) * 2u; voffB[i] = (unsigned)(Rb * g.ldb + C) * 2u; }
    const size_t kstep = (size_t)(BK * 2);
    const size_t hstepA = (size_t)HALF * g.lda * 2, hstepB = (size_t)HALF * g.ldb * 2;
    const size_t tstepA = 2 * hstepA, tstepB = 2 * hstepB;
    const unsigned ldsw = (unsigned)wid * 1024u;
    const int aoff = lds_byte(wr * 64 + fr, fq * 8), boff = lds_byte(wc * 32 + fr, fq * 8);
#define PG8_SA(b, h) (((b) * 2 + (h)) * HTB)
#define PG8_SB(b, h) ((4 + (b) * 2 + (h)) * HTB)
#define PG8_STAGE(bufoff, gbase, voff) do { _Pragma("unroll") for (int _i = 0; _i < 2; ++_i) \
        __builtin_amdgcn_global_load_lds((const unsigned*)((const char*)(gbase) + (voff)[_i]), (PG8_LAS unsigned*)(lds + (bufoff) + ldsw + _i * 8192), 16, 0, 0); } while (0)
#define PG8_LDA(dst, b, h) do { _Pragma("unroll") for (int m = 0; m < 4; ++m) _Pragma("unroll") for (int k = 0; k < 2; ++k) dst[m][k] = *(const PG8_LAS bf16x8*)(lds + PG8_SA(b, h) + aoff + m * 2048 + k * 1024); } while (0)
#define PG8_LDB(dst, b, h) do { _Pragma("unroll") for (int n = 0; n < 2; ++n) _Pragma("unroll") for (int k = 0; k < 2; ++k) dst[n][k] = *(const PG8_LAS bf16x8*)(lds + PG8_SB(b, h) + boff + n * 2048 + k * 1024); } while (0)
#define PG8_MMA(ai, bj, At, Bt) do { __builtin_amdgcn_s_setprio(1); _Pragma("unroll") for (int m = 0; m < 4; ++m) _Pragma("unroll") for (int n = 0; n < 2; ++n) _Pragma("unroll") for (int k = 0; k < 2; ++k) \
        acc[ai][bj][m][n] = __builtin_amdgcn_mfma_f32_16x16x32_bf16(Bt[n][k], At[m][k], acc[ai][bj][m][n], 0, 0, 0); __builtin_amdgcn_s_setprio(0); } while (0)
#define PG8_WAIT_V(n) asm volatile("s_waitcnt vmcnt(" #n ")" ::: "memory")
#define PG8_WAIT_L(n) asm volatile("s_waitcnt lgkmcnt(" #n ")" ::: "memory")
#define PG8_BAR __builtin_amdgcn_s_barrier()
#define PG8_SCHED __builtin_amdgcn_sched_barrier(0)
    Unit cur, nxt; int ui = 0;
    if (!S.next(0, cur)) return;
    f32x4 acc[2][2][4][2];
#pragma unroll
    for (int a = 0; a < 2; ++a)
#pragma unroll
        for (int b = 0; b < 2; ++b)
#pragma unroll
            for (int m = 0; m < 4; ++m)
#pragma unroll
                for (int n = 0; n < 2; ++n) acc[a][b][m][n] = (f32x4){0.f, 0.f, 0.f, 0.f};
    bf16x8 At[4][2], B0[2][2], B1[2][2];
    const char* cA = (const char*)g.A + (size_t)cur.pm * tstepA; const char* cB = (const char*)g.Bt + (size_t)cur.pn * tstepB;
    PG8_STAGE(PG8_SB(0, 0), cB, voffB); PG8_STAGE(PG8_SB(0, 1), cB + hstepB, voffB); PG8_STAGE(PG8_SA(0, 0), cA, voffA); PG8_STAGE(PG8_SA(0, 1), cA + hstepA, voffA);
    if (wr == 1) PG8_BAR;
    PG8_WAIT_V(2); PG8_BAR;
    PG8_STAGE(PG8_SB(1, 0), cB + kstep, voffB); PG8_STAGE(PG8_SA(1, 0), cA + kstep, voffA); PG8_STAGE(PG8_SB(1, 1), cB + hstepB + kstep, voffB);
    PG8_WAIT_V(6); PG8_BAR;
    for (;;) {
        const bool has_next = S.next(ui + 1, nxt);
        const char* nA = has_next ? (const char*)g.A + (size_t)nxt.pm * tstepA : cA; const char* nB = has_next ? (const char*)g.Bt + (size_t)nxt.pn * tstepB : cB;
        for (int t = 0; t < nt; t += 2) {
            const bool last = (t == nt - 2);
            const char* a1 = cA + (size_t)(t + 1) * kstep;
            const char* a2 = last ? nA : cA + (size_t)(t + 2) * kstep; const char* b2 = last ? nB : cB + (size_t)(t + 2) * kstep;
            const char* a3 = a2 + kstep; const char* b3 = b2 + kstep;
            PG8_LDB(B0, 0, 0); PG8_LDB(B1, 0, 1); PG8_SCHED; PG8_LDA(At, 0, 0); PG8_STAGE(PG8_SA(1, 1), a1 + hstepA, voffA);
            PG8_WAIT_V(8); PG8_WAIT_L(0); PG8_BAR; PG8_MMA(0, 0, At, B0); PG8_MMA(0, 1, At, B1); PG8_BAR; PG8_SCHED;
            PG8_LDA(At, 0, 1); PG8_STAGE(PG8_SB(0, 0), b2, voffB); PG8_STAGE(PG8_SB(0, 1), b2 + hstepB, voffB); PG8_STAGE(PG8_SA(0, 0), a2, voffA);
            PG8_WAIT_V(8); PG8_WAIT_L(0); PG8_BAR; PG8_MMA(1, 0, At, B0); PG8_MMA(1, 1, At, B1); PG8_BAR; PG8_SCHED;
            PG8_LDB(B0, 1, 0); PG8_LDB(B1, 1, 1); PG8_SCHED; PG8_LDA(At, 1, 0); PG8_STAGE(PG8_SA(0, 1), a2 + hstepA, voffA);
            PG8_WAIT_V(8); PG8_WAIT_L(0); PG8_BAR; PG8_MMA(0, 0, At, B0); PG8_MMA(0, 1, At, B1); PG8_BAR; PG8_SCHED;
            PG8_LDA(At, 1, 1); PG8_STAGE(PG8_SB(1, 0), b3, voffB); PG8_STAGE(PG8_SB(1, 1), b3 + hstepB, voffB); PG8_STAGE(PG8_SA(1, 0), a3, voffA);
            PG8_WAIT_V(8); PG8_WAIT_L(0); PG8_BAR; PG8_MMA(1, 0, At, B0); PG8_MMA(1, 1, At, B1); PG8_BAR; PG8_SCHED;
        }
        if (wr == 0) PG8_BAR;
        if constexpr (!Epi::AFTER_DRAIN) { E(acc, cur, wr, wc, fr, fq); }
        if (!has_next) break;
#pragma unroll
        for (int a = 0; a < 2; ++a)
#pragma unroll
            for (int b = 0; b < 2; ++b)
#pragma unroll
                for (int m = 0; m < 4; ++m)
#pragma unroll
                    for (int n = 0; n < 2; ++n) acc[a][b][m][n] = (f32x4){0.f, 0.f, 0.f, 0.f};
        cur = nxt; cA = nA; cB = nB; ++ui;
        if (wr == 1) PG8_BAR;
    }
    PG8_WAIT_V(0);
    PG8_BAR;
    if constexpr (Epi::AFTER_DRAIN) { E.fused(acc, cur, wr, wc, fr, fq, lds, wid, lane); }
#undef PG8_SA
#undef PG8_SB
#undef PG8_STAGE
#undef PG8_LDA
#undef PG8_LDB
#undef PG8_MMA
#undef PG8_WAIT_V
#undef PG8_WAIT_L
#undef PG8_BAR
#undef PG8_SCHED
}
}

#define GAS __attribute__((address_space(1)))
#define LAS __attribute__((address_space(3)))
typedef unsigned short bf16;
typedef unsigned v4u __attribute__((ext_vector_type(4)));
typedef unsigned v2u __attribute__((ext_vector_type(2)));
typedef float f32x4 __attribute__((ext_vector_type(4)));
typedef float f32x2 __attribute__((ext_vector_type(2)));
typedef float f32x16 __attribute__((ext_vector_type(16)));
typedef short bf16x8 __attribute__((ext_vector_type(8)));
typedef short s16x4 __attribute__((ext_vector_type(4)));
typedef GAS unsigned gu32;
#define RLX_AGENT __ATOMIC_RELAXED, __HIP_MEMORY_SCOPE_AGENT
#define LDS_WAIT() asm volatile("s_waitcnt lgkmcnt(0)" ::: "memory")
#define VM_WAIT() asm volatile("s_waitcnt vmcnt(0)" ::: "memory")
__device__ __forceinline__ unsigned f2bf(float f) { unsigned u = __builtin_bit_cast(unsigned, f); return (u + 0x7fffu + ((u >> 16) & 1u)) >> 16; }
__device__ __forceinline__ unsigned pk2(float lo, float hi) { return f2bf(lo) | (f2bf(hi) << 16); }
__device__ __forceinline__ float bf2f(unsigned short b) { return __builtin_bit_cast(float, (unsigned)b << 16); }
__device__ __forceinline__ float bflo(unsigned u) { return __builtin_bit_cast(float, u << 16); }
__device__ __forceinline__ float bfhi(unsigned u) { return __builtin_bit_cast(float, u & 0xffff0000u); }


typedef short v4i16_t __attribute__((ext_vector_type(4)));
__device__ __forceinline__ s16x4 lds_tr16(LAS unsigned char* p) { return __builtin_bit_cast(s16x4, __builtin_amdgcn_ds_read_tr16_b64_v4i16((LAS v4i16_t*)p)); }
__device__ __forceinline__ int crow(int r, int hi) { return (r & 3) + 8 * (r >> 2) + 4 * hi; }

#define DPP_I(v, ctrl) __builtin_amdgcn_update_dpp(0, (v), (ctrl), 0xF, 0xF, false)
#define DPP_F(v, ctrl) __builtin_bit_cast(float, __builtin_amdgcn_update_dpp(0, __builtin_bit_cast(int, (v)), (ctrl), 0xF, 0xF, false))
constexpr int DPP_X1 = 0xB1, DPP_X2 = 0x4E, DPP_HMIR = 0x141, DPP_MIR = 0x140;
__device__ __forceinline__ unsigned max16_u32(unsigned v) {
    unsigned t = (unsigned)DPP_I((int)v, DPP_X1); v = v > t ? v : t; t = (unsigned)DPP_I((int)v, DPP_X2); v = v > t ? v : t;
    t = (unsigned)DPP_I((int)v, DPP_HMIR); v = v > t ? v : t; t = (unsigned)DPP_I((int)v, DPP_MIR); v = v > t ? v : t; return v; }
__device__ __forceinline__ float sum8_f32(float v) { v += DPP_F(v, DPP_X1); v += DPP_F(v, DPP_X2); v += DPP_F(v, DPP_HMIR); return v; }
__device__ __forceinline__ float sum16_f32(float v) { v = sum8_f32(v); v += DPP_F(v, DPP_MIR); return v; }
__device__ __forceinline__ float max16_f32(float v) { v = fmaxf(v, DPP_F(v, DPP_X1)); v = fmaxf(v, DPP_F(v, DPP_X2)); v = fmaxf(v, DPP_F(v, DPP_HMIR)); v = fmaxf(v, DPP_F(v, DPP_MIR)); return v; }
__device__ __forceinline__ float xor16_f32(float v) { return __builtin_bit_cast(float, __builtin_amdgcn_ds_swizzle(__builtin_bit_cast(int, v), 0x1F | (16 << 10))); }
__device__ __forceinline__ float sum64_f32(float v) {
    v = sum16_f32(v); v += xor16_f32(v);
    return __builtin_bit_cast(float, __builtin_amdgcn_readlane(__builtin_bit_cast(int, v), 0)) + __builtin_bit_cast(float, __builtin_amdgcn_readlane(__builtin_bit_cast(int, v), 32)); }
template <int J> __device__ __forceinline__ unsigned xchg_xor_u32(unsigned v) {
    if constexpr (J == 1) return (unsigned)DPP_I((int)v, DPP_X1);
    else if constexpr (J == 2) return (unsigned)DPP_I((int)v, DPP_X2);
    else return (unsigned)__builtin_amdgcn_ds_swizzle((int)v, 0x1F | (J << 10)); }

template <int SB>
__device__ __forceinline__ bf16x8 tr_frag(LAS unsigned char* base, int ks) {
    const s16x4 lo = lds_tr16(base + ks * 16 * SB), hi4 = lds_tr16(base + ks * 16 * SB + 8 * SB);
    return (bf16x8){lo[0], lo[1], lo[2], lo[3], hi4[0], hi4[1], hi4[2], hi4[3]};
}
__device__ __forceinline__ bf16x8 row_frag(const LAS unsigned char* rowp, int ks, int hi) {
    const v2u lo = *(const LAS v2u*)(rowp + (16 * ks + 4 * hi) * 2), hi2 = *(const LAS v2u*)(rowp + (16 * ks + 8 + 4 * hi) * 2);
    return __builtin_bit_cast(bf16x8, (v4u){lo.x, lo.y, hi2.x, hi2.y});
}
__device__ __forceinline__ void lds_barrier() { asm volatile("s_waitcnt lgkmcnt(0)\n\ts_barrier" ::: "memory"); }

struct BfPtr { const unsigned short* p; __device__ __forceinline__ float operator[](size_t i) const { return __builtin_bit_cast(float, (unsigned)p[i] << 16); }
               __device__ __forceinline__ BfPtr operator+(size_t o) const { return BfPtr{p + o}; } };
#define GLD(ptr) (BfPtr{(const unsigned short*)(ptr)})

__device__ __forceinline__ int lane_id() { int r; asm volatile("v_mbcnt_lo_u32_b32 %0, -1, 0\n\tv_mbcnt_hi_u32_b32 %0, -1, %0" : "=v"(r)); return r; }
#define TID_IS_ZERO(wave_) ((wave_) == 0 && lane_id() == 0)
#define XB_TMO      128
#define XB_XCNT(j)  (256  + 64 * (j))
#define XB_XSUB(j)  (1280 + 64 * (j))
#define XB_XGEN(j)  (2304 + 64 * (j))
#define XB_TOP      3328
#define XB_TOPGEN   3392
#define XCD_BAR_WORDS 3456
#define XB_SPIN_CAP (1u << 18)

__device__ __forceinline__ unsigned xb_ld(unsigned* p)              { return __hip_atomic_load(p, __ATOMIC_RELAXED, __HIP_MEMORY_SCOPE_AGENT); }
__device__ __forceinline__ unsigned xb_add(unsigned* p, unsigned v) { return __hip_atomic_fetch_add(p, v, __ATOMIC_RELAXED, __HIP_MEMORY_SCOPE_AGENT); }
__device__ __forceinline__ unsigned xb_xcc_id() { return (unsigned)__builtin_amdgcn_s_getreg((3 << 11) | 20) & 0xFu; }
#define XB_SPIN(cond, bar) do { unsigned _sp = 0; while (cond) { __builtin_amdgcn_s_sleep(1); \
    if ((++_sp & 255u) == 0u) { if (xb_ld(&(bar)[XB_TMO])) break; if (_sp > XB_SPIN_CAP) { atomicAdd(&(bar)[XB_TMO], 1u); break; } } } } while (0)

struct XcdBarrier {
    unsigned* bar; unsigned x; int wave;
    volatile LAS unsigned* st;
};

__device__ __forceinline__ XcdBarrier xcd_barrier_post(unsigned* bar, volatile LAS unsigned* st, int wave) {
    XcdBarrier b; b.bar = bar; b.x = xb_xcc_id(); b.st = st; b.wave = wave;
    if (TID_IS_ZERO(wave)) (void)xb_add(&bar[XB_XCNT(b.x)], 1u);
    return b;
}
__device__ __forceinline__ void xcd_barrier_complete(unsigned* bar, unsigned x, unsigned& nloc, unsigned& nx) {
    const unsigned G = gridDim.x * gridDim.y * gridDim.z;
    unsigned sum, cnt, mine, sp = 0u;
    for (;;) {
        sum = 0u; cnt = 0u; mine = 0u;
#pragma unroll
        for (unsigned j = 0; j < 16; ++j) { const unsigned c = xb_ld(&bar[XB_XCNT(j)]); sum += c; cnt += (c > 0u) ? 1u : 0u; mine = (j == x) ? c : mine; }
        if (sum == G) break;
        __builtin_amdgcn_s_sleep(1);
        if ((++sp & 255u) == 0u) { if (xb_ld(&bar[XB_TMO])) break; if (sp > XB_SPIN_CAP) { atomicAdd(&bar[XB_TMO], 1u); break; } }
    }
    nloc = mine > 0u ? mine : 1u; nx = cnt > 0u ? cnt : 1u;
}

__device__ __forceinline__ void xcd_barrier(const XcdBarrier& b) {
    asm volatile("s_waitcnt vmcnt(0)" ::: "memory");
    __syncthreads();
    if (TID_IS_ZERO(b.wave)) {
        unsigned* bar = b.bar;
        __builtin_amdgcn_s_waitcnt(0);
        unsigned nloc = b.st[0], nx = b.st[1];
        if (nloc == 0u) { xcd_barrier_complete(bar, b.x, nloc, nx); b.st[0] = nloc; b.st[1] = nx; }
        const unsigned old = xb_add(&bar[XB_XSUB(b.x)], 1u);
        const unsigned gen = old / nloc;
        if (old + 1u == (gen + 1u) * nloc) {
            __builtin_amdgcn_fence(__ATOMIC_RELEASE, "agent");
            asm volatile("s_waitcnt vmcnt(0)" ::: "memory");
            const unsigned og = xb_add(&bar[XB_TOP], 1u);
            const unsigned tg = og / nx;
            if (og + 1u == (tg + 1u) * nx) xb_add(&bar[XB_TOPGEN], 1u);
            else XB_SPIN(xb_ld(&bar[XB_TOPGEN]) == tg, bar);
            __builtin_amdgcn_fence(__ATOMIC_ACQUIRE, "agent");
            xb_add(&bar[XB_XGEN(b.x)], 1u);
            asm volatile("s_waitcnt vmcnt(0)" ::: "memory");
        } else {
            XB_SPIN(xb_ld(&bar[XB_XGEN(b.x)]) == gen, bar);
            __builtin_amdgcn_fence(__ATOMIC_ACQUIRE, "agent");
            asm volatile("s_waitcnt vmcnt(0)" ::: "memory");
        }
    }
    __syncthreads();
}


constexpr int NWAVES = 8, NTHR = 512;
constexpr int DM = 1024, TP = 16384, TS = 1024, TA = TP + TS, SEQ = 8192, NB_P = 2, NB_S = 128, LS = 8;
constexpr int N_IN = 3328;
constexpr int PASTL = 2048, PAGE = 128, NPAGES = 16;
constexpr float EPS = 1e-6f;
constexpr float LOG2E = 1.4426950408889634f;
constexpr float C2F = 0.125f * LOG2E;
constexpr float C2C = 0.0625f * LOG2E;

enum { I_XP = 0, I_XS, I_CFK, I_CFV, I_CFL, I_SGLA, I_CMK, I_CMV, I_PT, I_MEMP, I_GMIX, I_WIN, I_BFF, I_WG2, I_BG, I_GGO, I_WOUT, I_GCROSS, I_GMEM,
       I_WMK, I_WMV, I_WCQ, I_WCO, I_GFFN, I_PWQ, I_PSK, I_PU, I_PV, I_GFIN, N_INPUTS };
constexpr size_t O_YP = 0, O_YS = 16777216, O_FKP = 17825792, O_FVP = 26214400, O_LFP = 34603008, O_GSP = 34734080, O_MKP = 34799616, O_MVP = 35323904,
                 O_FKS = 35848192, O_FVS = 36372480, O_LFS = 36896768, O_GSS = 36904960, O_TOTAL = 41099264;

constexpr size_t MiB = 1u << 20;
constexpr size_t WS_CTL = 0, CTL_ZERO_BYTES = 1 * MiB;
constexpr size_t WS_WIN = 2 * MiB, WS_WOUT = 10 * MiB, WS_WMK = 12 * MiB, WS_WMV = 14 * MiB, WS_WCQ = 16 * MiB, WS_WCO = 18 * MiB, WS_WPK = 20 * MiB;
constexpr size_t WS_MB = 24 * MiB, WS_MK16 = 25 * MiB, WS_MVT16 = 26 * MiB, WS_KBIAS = 27 * MiB, WS_GDEC = 28 * MiB, WS_GG = 29 * MiB;
constexpr size_t WS_U16 = 32 * MiB, WS_V16 = 64 * MiB, WS_HB = 96 * MiB, WS_QF = 132 * MiB, WS_KF = 150 * MiB, WS_VF = 168 * MiB;
constexpr size_t WS_GQ = 186 * MiB, WS_GK = 204 * MiB, WS_GV = 222 * MiB, WS_GR = 256 * MiB, WS_SUF = 290 * MiB, WS_GKV = 298 * MiB;
constexpr size_t WS_MERGED = 330 * MiB, WS_X1 = 364 * MiB, WS_X2 = 432 * MiB, WS_QC = 500 * MiB, WS_PC = 534 * MiB, WS_OC = 566 * MiB, WS_SC = 600 * MiB;
constexpr size_t WS_MISC = 736 * MiB, WS_SS = 740 * MiB  , WS_BB = 744 * MiB, WS_END = 800 * MiB;
constexpr int CW_BAR = 4096;

constexpr int RING_BYTES = 131072;
constexpr int LDSCTL_OFF = RING_BYTES, MISC_OFF = LDSCTL_OFF + 320;
constexpr int ARGS_OFF = MISC_OFF + 128;
constexpr int LDS_BYTES = 147456;

struct Args { const void* in[N_INPUTS]; float* out; unsigned char* ws; };

__device__ __forceinline__ const void* ld_ptr(const LAS unsigned long long* p) { const unsigned long long v = *p; const unsigned lo = __builtin_amdgcn_readfirstlane((unsigned)v), hi = __builtin_amdgcn_readfirstlane((unsigned)(v >> 32)); return (const void*)(const GAS char*)(((unsigned long long)hi << 32) | lo); }
__device__ __forceinline__ Args load_args(const LAS unsigned long long* ARGP) { Args A;
    A.in[0] = ld_ptr(ARGP + 0);
    A.in[1] = ld_ptr(ARGP + 1);
    A.in[2] = ld_ptr(ARGP + 2);
    A.in[3] = ld_ptr(ARGP + 3);
    A.in[4] = ld_ptr(ARGP + 4);
    A.in[5] = ld_ptr(ARGP + 5);
    A.in[6] = ld_ptr(ARGP + 6);
    A.in[7] = ld_ptr(ARGP + 7);
    A.in[8] = ld_ptr(ARGP + 8);
    A.in[9] = ld_ptr(ARGP + 9);
    A.in[10] = ld_ptr(ARGP + 10);
    A.in[11] = ld_ptr(ARGP + 11);
    A.in[12] = ld_ptr(ARGP + 12);
    A.in[13] = ld_ptr(ARGP + 13);
    A.in[14] = ld_ptr(ARGP + 14);
    A.in[15] = ld_ptr(ARGP + 15);
    A.in[16] = ld_ptr(ARGP + 16);
    A.in[17] = ld_ptr(ARGP + 17);
    A.in[18] = ld_ptr(ARGP + 18);
    A.in[19] = ld_ptr(ARGP + 19);
    A.in[20] = ld_ptr(ARGP + 20);
    A.in[21] = ld_ptr(ARGP + 21);
    A.in[22] = ld_ptr(ARGP + 22);
    A.in[23] = ld_ptr(ARGP + 23);
    A.in[24] = ld_ptr(ARGP + 24);
    A.in[25] = ld_ptr(ARGP + 25);
    A.in[26] = ld_ptr(ARGP + 26);
    A.in[27] = ld_ptr(ARGP + 27);
    A.in[28] = ld_ptr(ARGP + 28);
    A.out = (float*)ld_ptr(ARGP + N_INPUTS); A.ws = (unsigned char*)ld_ptr(ARGP + N_INPUTS + 1); return A; }
struct Frame {
    LAS unsigned char* lds;
    int tid, lane, wave, vcu, G;
};

__device__ __forceinline__ float wave_sum(float v) { return sum64_f32(v); }
__device__ __forceinline__ float log_sigmoid(float x) { return fminf(x, 0.f) - __logf(1.f + __expf(-fabsf(x))); }

__device__ __forceinline__ int win_src_col(int r) {
    if (r < 1536) return r;
    if (r < 1792) return 1544 + (r - 1536);
    if (r < 2048) return 1800 + (r - 1792);
    if (r < 2560) return 2056 + (r - 2048);
    if (r < 3072) return 2584 + (r - 2560);
    if (r < 3080) return 1536 + (r - 3072);
    if (r < 3096) return 2568 + (r - 3080);
    return -1;
}
template <bool WIN>
__device__ __forceinline__ void p0_transpose_item(const float* W, int ldw, int K, int nblk, bf16* WT, LAS float* scr, int item, int lane) {
    const int kb = item / nblk, nb = item % nblk, k0 = 64 * kb, n0 = 32 * nb;
    const int dr = n0 + (lane & 31); const int sc = WIN ? win_src_col(dr) : dr;
#pragma unroll 8
    for (int i = 0; i < 32; ++i) { const int kk = 2 * i + (lane >> 5); scr[kk * 33 + (lane & 31)] = (sc >= 0) ? W[(size_t)(k0 + kk) * ldw + sc] : 0.f; }
    LDS_WAIT(); asm volatile("" ::: "memory");
    const int c = lane & 7;
#pragma unroll
    for (int j = 0; j < 4; ++j) { const int n = (lane >> 3) + 8 * j; const LAS float* s = scr + (8 * c) * 33 + n;
        v4u o; o.x = pk2(s[0 * 33], s[1 * 33]); o.y = pk2(s[2 * 33], s[3 * 33]); o.z = pk2(s[4 * 33], s[5 * 33]); o.w = pk2(s[6 * 33], s[7 * 33]);
        *(GAS v4u*)(WT + (size_t)(n0 + n) * K + k0 + 8 * c) = o; }
    LDS_WAIT(); asm volatile("" ::: "memory");
}
__device__ __forceinline__ void rms_row_bf16(const float* xrow, const float* g, bf16* orow, int lane) {
    const f32x4* xr = (const f32x4*)xrow + lane; const f32x4* gr = (const f32x4*)g + lane;
    f32x4 v[4]; float s = 0.f;
#pragma unroll
    for (int j = 0; j < 4; ++j) { v[j] = xr[64 * j]; s += (v[j].x * v[j].x + v[j].y * v[j].y) + (v[j].z * v[j].z + v[j].w * v[j].w); }
    const float r = rsqrtf(wave_sum(s) * (1.f / DM) + EPS);
    v2u* o8 = (v2u*)orow + lane;
#pragma unroll
    for (int j = 0; j < 4; ++j) { const f32x4 gg = gr[64 * j]; v2u o; o.x = pk2(v[j].x * r * gg.x, v[j].y * r * gg.y); o.y = pk2(v[j].z * r * gg.z, v[j].w * r * gg.w); o8[64 * j] = o; }
}

using pg8::Unit;
struct EpiGen {
    static constexpr bool PERM = true, AFTER_DRAIN = false;
    float* d32; int ld32; bf16* d16; int ld16; float sc16;
    const float* r0; const float* r1; int rsplit; int ldr;
    const float* gcol;
    float* ssq;
    const float* rsq;
    __device__ __forceinline__ void operator()(const f32x4 (&acc)[2][2][4][2], const Unit& u, int wr, int wc, int fr, int fq) const {
        int row0 = u.pm * 256 + wr * 64 + fr, col0 = u.pn * 256 + wc * 32 + fq * 8;
        asm volatile("" : "+v"(row0), "+v"(col0));
#pragma unroll
        for (int ai = 0; ai < 2; ++ai)
#pragma unroll
            for (int m = 0; m < 4; ++m) { const int row = row0 + ai * 128 + m * 16;
                const float* rp = nullptr; if (r0) rp = (row < rsplit) ? r0 + (size_t)row * ldr : r1 + (size_t)(row - rsplit) * ldr;
                float rs = 1.f; if (rsq) rs = rsqrtf(rsq[row] * (1.f / 1024.f) + EPS);
                float ss = 0.f;
#pragma unroll
                for (int bj = 0; bj < 2; ++bj) { const int col = col0 + bj * 128; f32x4 v0 = acc[ai][bj][m][0], v1 = acc[ai][bj][m][1];
                    if (rsq) { v0[0] *= rs; v0[1] *= rs; v0[2] *= rs; v0[3] *= rs; v1[0] *= rs; v1[1] *= rs; v1[2] *= rs; v1[3] *= rs; }
                    if (r0) { v0 += *(const f32x4*)(rp + col); v1 += *(const f32x4*)(rp + col + 4); }
                    if (d32) { *(f32x4*)(d32 + (size_t)row * ld32 + col) = v0; *(f32x4*)(d32 + (size_t)row * ld32 + col + 4) = v1; }
                    if (ssq) ss += ((v0[0] * v0[0] + v0[1] * v0[1]) + (v0[2] * v0[2] + v0[3] * v0[3])) + ((v1[0] * v1[0] + v1[1] * v1[1]) + (v1[2] * v1[2] + v1[3] * v1[3]));
                    if (d16) { f32x4 w0 = v0, w1 = v1; if (gcol) { w0 = w0 * *(const f32x4*)(gcol + col); w1 = w1 * *(const f32x4*)(gcol + col + 4); }
                        v4u o; o.x = pg8::cvt_pk_bf16(w0[0] * sc16, w0[1] * sc16); o.y = pg8::cvt_pk_bf16(w0[2] * sc16, w0[3] * sc16); o.z = pg8::cvt_pk_bf16(w1[0] * sc16, w1[1] * sc16); o.w = pg8::cvt_pk_bf16(w1[2] * sc16, w1[3] * sc16);
                        *(v4u*)(d16 + (size_t)row * ld16 + col) = o; } }
                if (ssq) { ss += xor16_f32(ss); ss += __shfl_xor(ss, 32); if (fq == 0) atomicAdd(ssq + row, ss); } }
    }
};
struct EpiInProj {
    static constexpr bool PERM = true, AFTER_DRAIN = false;
    float* out; unsigned char* ws; const float* bff;
    __device__ __forceinline__ void operator()(const f32x4 (&acc)[2][2][4][2], const Unit& u, int wr, int wc, int fr, int fq) const {
        const int pn = u.pn; const bool smp = u.pm >= 64;
        int row0 = u.pm * 256 + wr * 64 + fr;
        int orow0 = (smp ? (u.pm - 64) * 256 : u.pm * 256) + wr * 64 + fr;
        asm volatile("" : "+v"(row0), "+v"(orow0));
        float* d32 = nullptr; int ld32 = 0; bool d32_grp = false; bf16* d16 = nullptr; int ld16 = 0; float s32 = 1.f, s16 = 1.f; int cb = 0;
        if (pn < 2) { d16 = (bf16*)(ws + WS_QF); ld16 = 512; s16 = C2F; cb = pn * 256; }
        else if (pn < 4) { d32 = out + (smp ? O_FKS : O_FKP); ld32 = 512; d32_grp = true; d16 = (bf16*)(ws + WS_KF); ld16 = 512; cb = (pn - 2) * 256; }
        else if (pn < 6) { d32 = out + (smp ? O_FVS : O_FVP); ld32 = 512; d32_grp = true; d16 = (bf16*)(ws + WS_VF); ld16 = 512; cb = (pn - 4) * 256; }
        else if (pn == 6) { d16 = (bf16*)(ws + WS_GQ); ld16 = 256; s16 = 0.125f; }
        else if (pn == 7) { d16 = (bf16*)(ws + WS_GK); ld16 = 256; }
        else if (pn < 10) { d16 = (bf16*)(ws + WS_GV); ld16 = 512; cb = (pn - 8) * 256; }
        else if (pn < 12) { d16 = (bf16*)(ws + WS_GR); ld16 = 512; cb = (pn - 10) * 256; }
        if (pn < 12) {
#pragma unroll
            for (int ai = 0; ai < 2; ++ai)
#pragma unroll
                for (int m = 0; m < 4; ++m) { const int row = row0 + ai * 128 + m * 16, orow = orow0 + ai * 128 + m * 16;
#pragma unroll
                    for (int bj = 0; bj < 2; ++bj) { const int col = cb + wc * 32 + fq * 8 + bj * 128; const f32x4 v0 = acc[ai][bj][m][0], v1 = acc[ai][bj][m][1];
                        if (d32) { float* dp = d32 + (size_t)(d32_grp ? orow : row) * ld32 + col; *(f32x4*)dp = v0 * s32; *(f32x4*)(dp + 4) = v1 * s32; }
                        if (d16) { v4u o; o.x = pg8::cvt_pk_bf16(v0[0] * s16, v0[1] * s16); o.y = pg8::cvt_pk_bf16(v0[2] * s16, v0[3] * s16); o.z = pg8::cvt_pk_bf16(v1[0] * s16, v1[1] * s16); o.w = pg8::cvt_pk_bf16(v1[2] * s16, v1[3] * s16);
                            *(v4u*)(d16 + (size_t)row * ld16 + col) = o; } } }
        } else {
            if (wc == 0) {
                float* lf = out + (smp ? O_LFS : O_LFP); float* ggp = (float*)(ws + WS_GG);
#pragma unroll
                for (int ai = 0; ai < 2; ++ai)
#pragma unroll
                    for (int m = 0; m < 4; ++m) { const int row = row0 + ai * 128 + m * 16, orow = orow0 + ai * 128 + m * 16;
#pragma unroll
                        for (int n = 0; n < 2; ++n) { const int col = fq * 8 + 4 * n; const f32x4 v = acc[ai][0][m][n];
                            if (col < 8) { f32x4 o; const f32x4 b = *(const f32x4*)(bff + col);
                                o[0] = log_sigmoid(v[0] + b[0]); o[1] = log_sigmoid(v[1] + b[1]); o[2] = log_sigmoid(v[2] + b[2]); o[3] = log_sigmoid(v[3] + b[3]);
                                *(f32x4*)(lf + (size_t)orow * 8 + col) = o; }
                            else if (col < 24) *(f32x4*)(ggp + (size_t)row * 16 + (col - 8)) = v; } }
            }
        }
    }
};


__device__ __forceinline__ void p0_prologue(const Frame& F, const Args& a) {
    unsigned char* ws = a.ws;
    LAS float* scr = (LAS float*)(F.lds + F.wave * 16384);
    const int gw = F.vcu * NWAVES + F.wave, NGW = F.G * NWAVES;
    constexpr int I_WINN = 16 * (N_IN / 32), I_SQ = 16 * 32;
    constexpr int NITEMS = I_WINN + 5 * I_SQ;
    for (int it = (gw + NGW / 2) % NGW; it < NITEMS; it += NGW) {
        int r = it;
        if (r < I_WINN) { p0_transpose_item<true>((const float*)a.in[I_WIN], 3096, DM, N_IN / 32, (bf16*)(ws + WS_WIN), scr, r, F.lane); continue; } r -= I_WINN;
        const int which = r / I_SQ; r -= which * I_SQ;
        const float* src = (const float*)(which == 0 ? a.in[I_WOUT] : which == 1 ? a.in[I_WMK] : which == 2 ? a.in[I_WMV] : which == 3 ? a.in[I_WCQ] : a.in[I_WCO]);
        bf16* dst = (bf16*)(ws + (which == 0 ? WS_WOUT : which == 1 ? WS_WMK : which == 2 ? WS_WMV : which == 3 ? WS_WCQ : WS_WCO));
        p0_transpose_item<false>(src, DM, DM, 32, dst, scr, r, F.lane);
    }
    { float* ssz = (float*)(ws + WS_SS); for (int i = F.vcu * NTHR + F.tid; i < 2 * TA; i += F.G * NTHR) ssz[i] = 0.f; }
    for (int m0 = gw * 2; m0 < TA + 512; m0 += NGW * 2) {
        const float* xr[2]; const float* gr[2]; bf16* orow[2];
#pragma unroll
        for (int j = 0; j < 2; ++j) { const int m = m0 + j;
            if (m < TP) { xr[j] = (const float*)a.in[I_XP] + (size_t)m * DM; gr[j] = (const float*)a.in[I_GMIX]; orow[j] = (bf16*)(ws + WS_HB) + (size_t)m * DM; }
            else if (m < TA) { xr[j] = (const float*)a.in[I_XS] + (size_t)(m - TP) * DM; gr[j] = (const float*)a.in[I_GMIX]; orow[j] = (bf16*)(ws + WS_HB) + (size_t)m * DM; }
            else { xr[j] = (const float*)a.in[I_MEMP] + (size_t)(m - TA) * DM; gr[j] = (const float*)a.in[I_GMEM]; orow[j] = (bf16*)(ws + WS_MB) + (size_t)(m - TA) * DM; } }
        f32x4 v[2][4]; float s[2];
#pragma unroll
        for (int j = 0; j < 2; ++j) { s[j] = 0.f;
#pragma unroll
            for (int q = 0; q < 4; ++q) v[j][q] = ((const f32x4*)xr[j])[F.lane + 64 * q]; }
#pragma unroll
        for (int j = 0; j < 2; ++j) {
#pragma unroll
            for (int q = 0; q < 4; ++q) s[j] += (v[j][q].x * v[j][q].x + v[j][q].y * v[j][q].y) + (v[j][q].z * v[j][q].z + v[j][q].w * v[j][q].w);
            const float r = rsqrtf(wave_sum(s[j]) * (1.f / DM) + EPS);
#pragma unroll
            for (int q = 0; q < 4; ++q) { const f32x4 gg = ((const f32x4*)gr[j])[F.lane + 64 * q]; v2u o; o.x = pk2(v[j][q].x * r * gg.x, v[j][q].y * r * gg.y); o.y = pk2(v[j][q].z * r * gg.z, v[j][q].w * r * gg.w); ((v2u*)orow[j])[F.lane + 64 * q] = o; } }
    }
    {
        for (int r0 = gw * 4; r0 < 2 * 16384; r0 += NGW * 4) {
            f32x4 x[4][4];
#pragma unroll
            for (int j = 0; j < 4; ++j) { const int r = r0 + j; const bool isv = r >= 16384; const int e = isv ? r - 16384 : r;
                const f32x4* s = (const f32x4*)((const float*)(isv ? a.in[I_PV] : a.in[I_PU]) + (size_t)e * DM) + F.lane;
#pragma unroll
                for (int q = 0; q < 4; ++q) x[j][q] = __builtin_nontemporal_load(s + 64 * q); }
#pragma unroll
            for (int j = 0; j < 4; ++j) { const int r = r0 + j; const bool isv = r >= 16384; const int e = isv ? r - 16384 : r; float am = 0.f;
#pragma unroll
                for (int q = 0; q < 4; ++q) am = fmaxf(am, fmaxf(fmaxf(fabsf(x[j][q].x), fabsf(x[j][q].y)), fmaxf(fabsf(x[j][q].z), fabsf(x[j][q].w))));
#pragma unroll
                for (int o = 1; o < 64; o <<= 1) am = fmaxf(am, __shfl_xor(am, o));
                const float inv = am > 0.f ? 448.f / am : 0.f;
                v4u o4;
#pragma unroll
                for (int q = 0; q < 4; ++q) { int pk = __builtin_amdgcn_cvt_pk_fp8_f32(x[j][q].x * inv, x[j][q].y * inv, 0, false); pk = __builtin_amdgcn_cvt_pk_fp8_f32(x[j][q].z * inv, x[j][q].w * inv, pk, true); o4[q] = (unsigned)pk; }
                *(v4u*)(ws + (isv ? WS_V16 : WS_U16) + (size_t)e * DM + 16 * F.lane) = o4;
                if (F.lane == 0) ((float*)(ws + WS_MISC))[r] = am * (1.f / 448.f); }
        }
    }
    __syncthreads();
    for (int it = blockIdx.x; it < 256; it += F.G) {
        const int c = it >> 4, kt = it & 15, half = c & 1;
        LAS unsigned char* SKB = F.lds; LAS unsigned char* WB = F.lds + 128 * 272;
        const float* sk = (const float*)a.in[I_PSK] + (size_t)half * 128 * 128; const float* wq = (const float*)a.in[I_PWQ] + (size_t)(kt * 64) * 2048 + c * 128;
#pragma unroll
        for (int i = 0; i < 8; ++i) { const int c4 = F.tid + NTHR * i; const f32x4 x = *(const f32x4*)(sk + 4 * c4);
            v2u o; o.x = pk2(x.x, x.y); o.y = pk2(x.z, x.w); *(LAS v2u*)(SKB + (c4 >> 5) * 272 + (c4 & 31) * 8) = o; }
#pragma unroll
        for (int i = 0; i < 4; ++i) { const int c4 = F.tid + NTHR * i; const f32x4 x = *(const f32x4*)(wq + (size_t)(c4 >> 5) * 2048 + (c4 & 31) * 4);
            v2u o; o.x = pk2(x.x, x.y); o.y = pk2(x.z, x.w); *(LAS v2u*)(WB + (c4 >> 5) * 272 + (c4 & 31) * 8) = o; }
        __syncthreads();
        {
            const int r32 = F.lane & 31, hi = F.lane >> 5, mb = F.wave >> 1, nb = F.wave & 1;
            const LAS unsigned char* arow = SKB + (32 * mb + r32) * 272; const LAS unsigned char* brow = WB + (32 * nb + r32) * 272;
            f32x16 acc = {};
#pragma unroll
            for (int ks = 0; ks < 8; ++ks) acc = __builtin_amdgcn_mfma_f32_32x32x16_bf16(row_frag(arow, ks, hi), row_frag(brow, ks, hi), acc, 0, 0, 0);
            bf16* wp = (bf16*)(ws + WS_WPK) + (size_t)(c * 128 + 32 * mb) * DM + kt * 64 + 32 * nb + r32;
#pragma unroll
            for (int r = 0; r < 16; ++r) wp[(size_t)crow(r, hi) * DM] = (bf16)f2bf(acc[r]);
        }
        __syncthreads();
    }
}


__device__ __forceinline__ void fox_prompt_cumsum(const Frame& F, const float* logf  , float* kbias, int b) {
    LAS float* WT = (LAS float*)F.lds;
    const int t0 = F.wave * 1024 + F.lane * 16;
    const f32x4* src = (const f32x4*)(logf + ((size_t)b * SEQ + t0) * 8);
    float s[8];
#pragma unroll
    for (int h = 0; h < 8; ++h) s[h] = 0.f;
#pragma unroll 4
    for (int i = 0; i < 16; ++i) { const f32x4 a = src[2 * i], c = src[2 * i + 1]; s[0] += a.x; s[1] += a.y; s[2] += a.z; s[3] += a.w; s[4] += c.x; s[5] += c.y; s[6] += c.z; s[7] += c.w; }
    float ex[8];
#pragma unroll
    for (int h = 0; h < 8; ++h) { float v = s[h];
#pragma unroll
        for (int o = 1; o < 64; o <<= 1) { const float t = __shfl_up(v, o); if (F.lane >= o) v += t; }
        ex[h] = v - s[h];
        if (F.lane == 63) WT[F.wave * 8 + h] = v; }
    __syncthreads();
#pragma unroll
    for (int h = 0; h < 8; ++h) { float c = 0.f; for (int w = 0; w < F.wave; ++w) c += WT[w * 8 + h]; ex[h] += c; }
    float* dst = kbias + (size_t)(b * 8) * SEQ + t0;
#pragma unroll 4
    for (int i = 0; i < 16; ++i) { const f32x4 a = src[2 * i], c = src[2 * i + 1];
        ex[0] += a.x; ex[1] += a.y; ex[2] += a.z; ex[3] += a.w; ex[4] += c.x; ex[5] += c.y; ex[6] += c.z; ex[7] += c.w;
#pragma unroll
        for (int h = 0; h < 8; ++h) dst[(size_t)h * SEQ + i] = -ex[h] * LOG2E; }
    __syncthreads();
}
__device__ __forceinline__ void fox_sample_suffix(const Frame& F, const float* cfl, const int* pt, float* suf, int bs) {
    float carry[8];
#pragma unroll
    for (int h = 0; h < 8; ++h) carry[h] = 0.f;
    const int mypg = pt[bs * NPAGES + (F.lane & 15)];
#pragma unroll 1
    for (int pb = NPAGES - 4; pb >= 0; pb -= 4) {
        f32x4 x[4][4];
#pragma unroll
        for (int j = 0; j < 4; ++j) { const int pg = __builtin_amdgcn_readlane(mypg, 0) * 0 + __shfl(mypg, pb + j); const f32x4* src = (const f32x4*)(cfl + ((size_t)pg * PAGE + 2 * F.lane) * 8);
            x[j][0] = src[0]; x[j][1] = src[1]; x[j][2] = src[2]; x[j][3] = src[3]; }
#pragma unroll
        for (int j = 3; j >= 0; --j) { const int p = pb + j;
            const float ra[8] = {x[j][0].x, x[j][0].y, x[j][0].z, x[j][0].w, x[j][1].x, x[j][1].y, x[j][1].z, x[j][1].w}, rb[8] = {x[j][2].x, x[j][2].y, x[j][2].z, x[j][2].w, x[j][3].x, x[j][3].y, x[j][3].z, x[j][3].w};
#pragma unroll
            for (int h = 0; h < 8; ++h) {
                const float ps = ra[h] + rb[h]; float v = ps;
#pragma unroll
                for (int o = 1; o < 64; o <<= 1) { const float t = __shfl_down(v, o); if (F.lane + o < 64) v += t; }
                const float exs = v - ps;
                float* d = suf + (size_t)(bs * 8 + h) * PASTL + p * PAGE + 2 * F.lane;
                *(f32x2*)d = (f32x2){(carry[h] + exs + rb[h]) * LOG2E, (carry[h] + exs) * LOG2E};
                carry[h] += __shfl(v, 0);
            }
        }
    }
}

__device__ __forceinline__ void gla_gate_tile(const Frame& F, const float* gg, const float* w2, const float* bg, int row0, int h, int nt, LAS float* LA, LAS float* GGS) {
    for (int e = F.tid; e < nt * 16; e += NTHR) GGS[e] = gg[(size_t)row0 * 16 + e];
    const int dk = F.tid & 63; float wc[16];
#pragma unroll
    for (int r = 0; r < 16; ++r) wc[r] = w2[r * 256 + h * 64 + dk];
    const float bb = bg[h * 64 + dk];
    __syncthreads();
    for (int t = F.tid >> 6; t < nt; t += 8) { float z = bb;
#pragma unroll
        for (int q = 0; q < 4; ++q) { const f32x4 g4 = *(const LAS f32x4*)(GGS + t * 16 + 4 * q); z += g4.x * wc[4 * q] + g4.y * wc[4 * q + 1] + g4.z * wc[4 * q + 2] + g4.w * wc[4 * q + 3]; }
        LA[t * 64 + dk] = log_sigmoid(z) * (1.f / 16.f); }
}
__device__ __forceinline__ void gla_cumsum64(const Frame& F, LAS float* LA, LAS float* SEG) {
    const int dk = F.lane, w = F.wave; float v[8]; float run = 0.f;
#pragma unroll
    for (int i = 0; i < 8; ++i) { run += LA[(8 * w + i) * 64 + dk]; v[i] = run; }
    SEG[w * 64 + dk] = run;
    __syncthreads();
    float pre = 0.f;
    for (int j = 0; j < w; ++j) pre += SEG[j * 64 + dk];
#pragma unroll
    for (int i = 0; i < 8; ++i) LA[(8 * w + i) * 64 + dk] = v[i] + pre;
    __syncthreads();
}
__device__ __forceinline__ void gla_g1_unit(const Frame& F, const Args& a, int u) {
    unsigned char* ws = a.ws;
    const int b = u >> 9, h = (u >> 7) & 3, n = u & 127; const int row0 = b * SEQ + n * 64;
    LAS float* LA = (LAS float*)F.lds; LAS float* SEG = LA + 4096; LAS float* GGS = SEG + 512; LAS unsigned char* KRB = F.lds + 22528; LAS unsigned char* VSB = F.lds + 34816;
    v4u vq[2];
#pragma unroll
    for (int i = 0; i < 2; ++i) { const int c = F.tid + NTHR * i; vq[i] = *(const v4u*)((const bf16*)(ws + WS_GV) + (size_t)(row0 + (c >> 4)) * 512 + h * 128 + (c & 15) * 8); }
    float gkv[8];
#pragma unroll
    for (int i = 0; i < 8; ++i) { const int e = F.tid + NTHR * i; gkv[i] = GLD(ws + WS_GK)[(size_t)(row0 + (e >> 6)) * 256 + h * 64 + (e & 63)]; }
    gla_gate_tile(F, (const float*)(ws + WS_GG), (const float*)a.in[I_WG2], (const float*)a.in[I_BG], row0, h, 64, LA, GGS);
#pragma unroll
    for (int i = 0; i < 2; ++i) { const int c = F.tid + NTHR * i; *(LAS v4u*)(VSB + (c >> 4) * 320 + (c & 15) * 16) = vq[i]; }
    __syncthreads();
    gla_cumsum64(F, LA, SEG);
    if (F.tid < 64) ((float*)(ws + WS_GDEC))[(size_t)((b * 4 + h) * 128 + n) * 64 + F.tid] = __expf(LA[63 * 64 + F.tid]);
    float* bbuf = (float*)(ws + WS_BB);
#pragma unroll
    for (int i = 0; i < 8; ++i) { const int e = F.tid + NTHR * i; const int t = e >> 6, dk = e & 63; const float bb = LA[e]; bbuf[(size_t)(row0 + t) * 256 + h * 64 + dk] = bb;
        *(LAS unsigned short*)(KRB + t * 192 + dk * 2) = (unsigned short)f2bf(gkv[i] * __expf(LA[63 * 64 + dk] - bb)); }
    __syncthreads();
    {
        const int lane = F.lane, r32 = lane & 31, hi = lane >> 5, mb = F.wave >> 2, nb = F.wave & 3;
        const int tb = (4 * hi + ((lane & 15) >> 2)), tc = (16 * ((lane >> 4) & 1) + 4 * (lane & 3)) * 2;
        LAS unsigned char* abase = KRB + tb * 192 + tc + 64 * mb; LAS unsigned char* bbase = VSB + tb * 320 + tc + 64 * nb;
        f32x16 acc = {};
#pragma unroll
        for (int ks = 0; ks < 4; ++ks) acc = __builtin_amdgcn_mfma_f32_32x32x16_bf16(tr_frag<192>(abase, ks), tr_frag<320>(bbase, ks), acc, 0, 0, 0);
        float* kv = (float*)(ws + WS_GKV) + ((size_t)((b * 4 + h) * 128 + n) * 64 + 32 * mb) * 128 + 32 * nb + r32;
#pragma unroll
        for (int r = 0; r < 16; ++r) kv[(size_t)crow(r, hi) * 128] = acc[r];
    }
    __syncthreads();
}
__device__ __forceinline__ void gla_scan(const Frame& F, const Args& a) {
    int tid = F.wave * 64 + lane_id(); asm volatile("" : "+v"(tid));
    if (tid >= 256) return;
    for (int e = F.vcu * 256 + tid; e < 65536; e += F.G * 256) {
    const int bh = e >> 13, dk = (e >> 7) & 63, dv = e & 127;
    float* kv = (float*)(a.ws + WS_GKV) + ((size_t)bh * 128 * 64 + dk) * 128 + dv; const float* dc = (const float*)(a.ws + WS_GDEC) + (size_t)bh * 128 * 64 + dk;
    float S = 0.f;
#pragma unroll 1
    for (int n0 = 0; n0 < 128; n0 += 32) { float kvv[32], dd[32];
#pragma unroll
        for (int j = 0; j < 32; ++j) { kvv[j] = kv[(size_t)(n0 + j) * 8192]; dd[j] = dc[(size_t)(n0 + j) * 64]; }
#pragma unroll
        for (int j = 0; j < 32; ++j) { kv[(size_t)(n0 + j) * 8192] = S; S = dd[j] * S + kvv[j]; } }
    a.out[O_GSP + (size_t)bh * 8192 + dk * 128 + dv] = S;
    }
}
__device__ __forceinline__ float silu(float x) { return x / (1.f + __expf(-x)); }
__device__ __forceinline__ void gla_sample_unit(const Frame& F, const Args& a, int u) {
    unsigned char* ws = a.ws;
    const int bs = u >> 2, h = u & 3; const int row0 = TP + bs * LS;
    LAS float* LA = (LAS float*)F.lds; LAS float* BL = LA + 512; LAS float* QD = BL + 64; LAS float* KI = QD + 512; LAS float* KR = KI + 512; LAS float* ATT = KR + 512; LAS float* OP = ATT + 64; LAS float* VS = OP + 4096;
    gla_gate_tile(F, (const float*)(ws + WS_GG), (const float*)a.in[I_WG2], (const float*)a.in[I_BG], row0, h, 8, LA, VS + 1024);
#pragma unroll
    for (int i = 0; i < 2; ++i) { const int e = F.tid + NTHR * i; VS[e] = GLD(ws + WS_GV)[(size_t)(row0 + (e >> 7)) * 512 + h * 128 + (e & 127)]; }
    __syncthreads();
    if (F.tid < 64) { float run = 0.f;
#pragma unroll
        for (int t = 0; t < 8; ++t) { run += LA[t * 64 + F.tid]; LA[t * 64 + F.tid] = run; } BL[F.tid] = run; }
    __syncthreads();
    { const int e = F.tid, t = e >> 6, dk = e & 63; const float bb = LA[e];
      const float q = GLD(ws + WS_GQ)[(size_t)(row0 + t) * 256 + h * 64 + dk], k = GLD(ws + WS_GK)[(size_t)(row0 + t) * 256 + h * 64 + dk];
      QD[e] = q * __expf(bb); KI[e] = k * __expf(-bb); KR[e] = k * __expf(BL[dk] - bb); }
    __syncthreads();
    if (F.tid < 64) { const int t = F.tid >> 3, s = F.tid & 7; float acc = 0.f;
        if (s <= t) { for (int dk = 0; dk < 64; ++dk) acc += QD[t * 64 + dk] * KI[s * 64 + dk]; }
        ATT[F.tid] = acc; }
    const int dv = F.tid & 127, dkg = F.tid >> 7;
    {
        const float* st = (const float*)a.in[I_SGLA] + ((size_t)(bs * 4 + h) * 64 + dkg * 16) * 128 + dv;
        float S0[16];
#pragma unroll
        for (int i = 0; i < 16; ++i) S0[i] = st[(size_t)i * 128];
#pragma unroll
        for (int t = 0; t < 8; ++t) { float o = 0.f;
#pragma unroll
            for (int i = 0; i < 16; ++i) o += QD[t * 64 + dkg * 16 + i] * S0[i];
            OP[(dkg * 8 + t) * 128 + dv] = o; }
        float* so = a.out + O_GSS + ((size_t)(bs * 4 + h) * 64 + dkg * 16) * 128 + dv;
#pragma unroll
        for (int i = 0; i < 16; ++i) { float sn = __expf(BL[dkg * 16 + i]) * S0[i];
#pragma unroll
            for (int t = 0; t < 8; ++t) sn += KR[t * 64 + dkg * 16 + i] * VS[t * 128 + dv];
            so[(size_t)i * 128] = sn; }
    }
    __syncthreads();
    {
        const int t = F.wave; float o[2]; float ss = 0.f;
#pragma unroll
        for (int j = 0; j < 2; ++j) { const int d = 2 * F.lane + j; float v = OP[(0 * 8 + t) * 128 + d] + OP[(1 * 8 + t) * 128 + d] + OP[(2 * 8 + t) * 128 + d] + OP[(3 * 8 + t) * 128 + d];
            for (int s = 0; s <= t; ++s) v += ATT[t * 8 + s] * VS[s * 128 + d];
            o[j] = v; ss += v * v; }
        const float r = rsqrtf(wave_sum(ss) * (1.f / 128.f) + EPS);
        const float* ggo = (const float*)a.in[I_GGO] + h * 128 + 2 * F.lane; const BfPtr gr = GLD(ws + WS_GR) + ((size_t)(row0 + t) * 512 + h * 128 + 2 * F.lane);
        const float y0 = o[0] * r * ggo[0] * silu(gr[0]), y1 = o[1] * r * ggo[1] * silu(gr[1]);
        *(unsigned*)((bf16*)(ws + WS_MERGED) + (size_t)(row0 + t) * DM + 512 + h * 128 + 2 * F.lane) = pk2(y0, y1);
    }
    __syncthreads();
}


__device__ __forceinline__ float fexp2(float x) { return __builtin_amdgcn_exp2f(x); }
constexpr float FOX_SKIP = 160.f;


__device__ __forceinline__ void fox_norms_item(const Frame& F, const bf16* QF, const bf16* KF, const float* logf, float* FN, float* LC, float* BT, int item) {
    const int bh = item >> 5, qb = item & 31, b = bh >> 3, h = bh & 7;
    float qm = 0.f, km = 0.f;
    const float* lp = logf + ((size_t)b * SEQ + qb * 256 + 4 * F.lane) * 8 + h;
    const float l0 = lp[0], l1 = lp[8], l2 = lp[16], l3 = lp[24];
#pragma unroll 8
    for (int i = 0; i < 32; ++i) { const size_t row = (size_t)b * SEQ + qb * 256 + i * 8 + (F.lane >> 3);
        const v4u q = *(const v4u*)(QF + row * 512 + h * 64 + (F.lane & 7) * 8), k = *(const v4u*)(KF + row * 512 + h * 64 + (F.lane & 7) * 8); float qs = 0.f, ks = 0.f;
#pragma unroll
        for (int j = 0; j < 4; ++j) { qs += bflo(q[j]) * bflo(q[j]) + bfhi(q[j]) * bfhi(q[j]); ks += bflo(k[j]) * bflo(k[j]) + bfhi(k[j]) * bfhi(k[j]); }
        qs = sum8_f32(qs); ks = sum8_f32(ks);
        qm = fmaxf(qm, qs); km = fmaxf(km, ks); }
#pragma unroll
    for (int o = 1; o < 64; o <<= 1) { qm = fmaxf(qm, __shfl_xor(qm, o)); km = fmaxf(km, __shfl_xor(km, o)); }
    const float c0 = l0, c1 = c0 + l1, c2 = c1 + l2, c3 = c2 + l3; float v = c3;
#pragma unroll
    for (int o = 1; o < 64; o <<= 1) { const float t = __shfl_up(v, o); if (F.lane >= o) v += t; }
    const float ex = v - c3;
    *(f32x4*)(LC + (size_t)bh * SEQ + qb * 256 + 4 * F.lane) = (f32x4){ex + c0, ex + c1, ex + c2, ex + c3};
    if (F.lane == 63) BT[item] = v;
    if (F.lane == 0) { FN[item * 2] = qm; FN[item * 2 + 1] = km; }
}
__device__ __forceinline__ void fox_suffix_item(const Frame& F, const float* cfl, const int* pt, float* SW, float* PTOT, int item) {
    const int bs = item >> 4, p = item & 15; const int pg = __builtin_amdgcn_readfirstlane(pt[item]);
    const f32x4* src = (const f32x4*)(cfl + ((size_t)pg * PAGE + 2 * F.lane) * 8);
    const f32x4 a0 = src[0], a1 = src[1], b0 = src[2], b1 = src[3];
    const float ra[8] = {a0.x, a0.y, a0.z, a0.w, a1.x, a1.y, a1.z, a1.w}, rb[8] = {b0.x, b0.y, b0.z, b0.w, b1.x, b1.y, b1.z, b1.w};
#pragma unroll
    for (int h = 0; h < 8; ++h) {
        const float ps = ra[h] + rb[h]; float v = ps;
#pragma unroll
        for (int o = 1; o < 64; o <<= 1) { const float t = __shfl_down(v, o); if (F.lane + o < 64) v += t; }
        const float exs = v - ps;
        *(f32x2*)(SW + (size_t)(bs * 8 + h) * PASTL + p * PAGE + 2 * F.lane) = (f32x2){exs + rb[h], exs};
        if (F.lane == 0) PTOT[(bs * 8 + h) * NPAGES + p] = v;
    }
}
__device__ __forceinline__ void fox_attn_unit(const Frame& F, const bf16* QF, const bf16* KF, const bf16* VF, const float* LC, const float* BT, const float* FN, bf16* merged, int b, int h, int qb) {
    int tid = F.wave * 64 + lane_id(); asm volatile("" : "+v"(tid));
    const int lane = tid & 63, r32 = lane & 31, hi = lane >> 5, wid = F.wave;
    const size_t rowbase = (size_t)b * SEQ; const int q0 = qb * 256;
    LAS unsigned char* Ks = F.lds; LAS unsigned char* Vs = F.lds + 8192; LAS float* KBs = (LAS float*)(F.lds + 20480); LAS float* WSF = (LAS float*)(F.lds + 20736) + wid * 32;
    const bf16* Qw = QF + (rowbase + q0 + wid * 32 + r32) * 512 + h * 64;
    bf16x8 qr[4];
#pragma unroll
    for (int d0 = 0; d0 < 4; ++d0) qr[d0] = *(const bf16x8*)(Qw + d0 * 16 + hi * 8);
    const float* lcp = LC + (size_t)(b * 8 + h) * SEQ;
    float pbx; { const float btv = (lane < 32) ? BT[(b * 8 + h) * 32 + lane] : 0.f; float v = btv;
#pragma unroll
        for (int o = 1; o < 64; o <<= 1) { const float t = __shfl_up(v, o); if (lane >= o) v += t; }
        pbx = v - btv; }
    const float cref = lcp[q0] + __shfl(pbx, qb);
#define FOX_KB(t_, pos_) (-LOG2E * ((lcp[pos_] + __shfl(pbx, (t_) >> 2)) - cref))
    const int NT = (q0 + 256) / 64;
    int t0 = 0;
    {
        float kn = (lane < 32) ? FN[((b * 8 + h) * 32 + lane) * 2 + 1] : 0.f;
#pragma unroll
        for (int o = 1; o < 64; o <<= 1) kn = fmaxf(kn, __shfl_xor(kn, o));
        const float qk2 = 2.f * sqrtf(FN[((b * 8 + h) * 32 + qb) * 2]) * sqrtf(kn) * 1.01f;
        const int nbefore = q0 / 64;
        int found = -1;
        for (int base = 0; base < nbefore && found < 0; base += 64) {
            const int tl = nbefore - 1 - base - lane;
            const int tlc = tl < 0 ? 0 : tl; const float kbl = -LOG2E * ((lcp[tlc * 64 + 63] + __shfl(pbx, tlc >> 2)) - cref);
            const bool dead = (tl >= 0) && (qk2 + kbl < -FOX_SKIP);
            const unsigned long long bm = __ballot(dead);
            if (bm) found = nbefore - 1 - base - (int)__builtin_ctzll(bm);
        }
        t0 = found + 1;
        t0 = __builtin_amdgcn_readfirstlane(t0);
    }
    const int kkey = tid >> 3, kch = tid & 7, vkey = tid >> 3, vch = tid & 7;
    const bf16* ksrc = KF + (rowbase + kkey) * 512 + h * 64 + kch * 8;
    const bf16* vsrc = VF + (rowbase + vkey) * 512 + h * 64 + vch * 8;
    v4u kreg[2], vreg[2]; float kbreg[2];
#pragma unroll
    for (int hb = 0; hb < 2; ++hb) { const int tt = (t0 + hb < NT) ? t0 + hb : t0;
        kreg[hb] = *(const v4u*)(ksrc + (size_t)tt * 64 * 512); vreg[hb] = *(const v4u*)(vsrc + (size_t)tt * 64 * 512); kbreg[hb] = FOX_KB(tt, tt * 64 + (tid & 63)); }
    float m_run = -INFINITY, l_run = 0.f; f32x16 o0 = {}, o1 = {};
    const int qpos = q0 + wid * 32 + r32;
    const int vbase = (4 * hi + ((lane & 15) >> 2)) * 192 + (16 * ((lane >> 4) & 1) + 4 * (lane & 3)) * 2;
    LAS unsigned char* const Ks0 = Ks; LAS unsigned char* const Vs0 = Vs; LAS float* const KBs0 = KBs;
    __syncthreads();
    for (int t2 = t0; t2 < NT; t2 += 2) {
#pragma unroll
      for (int hb = 0; hb < 2; ++hb) {
        const int t = t2 + hb;
        if (t < NT) {
        LAS unsigned char* const Ks = Ks0 + hb * 28672; LAS unsigned char* const Vs = Vs0 + hb * 28672; LAS float* const KBs = (LAS float*)((LAS unsigned char*)KBs0 + hb * 28672);
        *(LAS v4u*)(Ks + kkey * 128 + ((kch ^ (kkey & 7)) << 4)) = kreg[hb];            *(LAS v4u*)(Vs + vkey * 192 + vch * 16) = vreg[hb]; if (tid < 64) KBs[tid] = kbreg[hb];
        __syncthreads();
        if (t + 2 < NT) { kreg[hb] = *(const v4u*)(ksrc + (size_t)(t + 2) * 64 * 512); vreg[hb] = *(const v4u*)(vsrc + (size_t)(t + 2) * 64 * 512); kbreg[hb] = FOX_KB(t + 2, (t + 2) * 64 + (tid & 63)); }
        const int k0 = t * 64;
        if (k0 <= q0 + wid * 32 + 31) {
        f32x16 p0, p1;
#pragma unroll
        for (int g = 0; g < 4; ++g) { const f32x4 ba = *(const LAS f32x4*)(KBs + 8 * g + 4 * hi), bb = *(const LAS f32x4*)(KBs + 32 + 8 * g + 4 * hi);
#pragma unroll
            for (int i = 0; i < 4; ++i) { p0[4 * g + i] = ba[i]; p1[4 * g + i] = bb[i]; } }
#pragma unroll
        for (int d0 = 0; d0 < 4; ++d0) {
            const bf16x8 a0 = *(const LAS bf16x8*)(Ks + r32 * 128 + (((2 * d0 + hi) ^ (r32 & 7)) << 4)), a1 = *(const LAS bf16x8*)(Ks + (r32 + 32) * 128 + (((2 * d0 + hi) ^ (r32 & 7)) << 4));
            p0 = __builtin_amdgcn_mfma_f32_32x32x16_bf16(a0, qr[d0], p0, 0, 0, 0); p1 = __builtin_amdgcn_mfma_f32_32x32x16_bf16(a1, qr[d0], p1, 0, 0, 0);
        }
        if (k0 + 63 > q0 + wid * 32) {
#pragma unroll
            for (int r = 0; r < 16; ++r) { const int key = k0 + crow(r, hi); if (key > qpos) p0[r] = -INFINITY; if (key + 32 > qpos) p1[r] = -INFINITY; }
        }
        float mx = fmaxf(p0[0], p1[0]);
#pragma unroll
        for (int r = 1; r < 16; ++r) mx = fmaxf(mx, fmaxf(p0[r], p1[r]));
        mx = fmaxf(mx, __shfl_xor(mx, 32));
        const float m_new = fmaxf(m_run, mx), alpha = fexp2(m_run - m_new); m_run = m_new;
        float ls = 0.f;
#pragma unroll
        for (int r = 0; r < 16; ++r) { p0[r] = fexp2(p0[r] - m_new); p1[r] = fexp2(p1[r] - m_new); ls += p0[r] + p1[r]; }
        l_run = l_run * alpha + ls;
        if (__ballot(alpha != 1.f) != 0ull) {
            if (hi == 0) WSF[r32] = alpha;
#pragma unroll
            for (int g = 0; g < 4; ++g) { const f32x4 al = *(const LAS f32x4*)(WSF + 8 * g + 4 * hi);
#pragma unroll
                for (int i = 0; i < 4; ++i) { o0[4 * g + i] *= al[i]; o1[4 * g + i] *= al[i]; } }
        }
        v4u pw[4];
#pragma unroll
        for (int j = 0; j < 4; ++j) { pw[0][j] = pg8::cvt_pk_bf16(p0[2 * j], p0[2 * j + 1]); pw[1][j] = pg8::cvt_pk_bf16(p0[8 + 2 * j], p0[8 + 2 * j + 1]);
                                      pw[2][j] = pg8::cvt_pk_bf16(p1[2 * j], p1[2 * j + 1]); pw[3][j] = pg8::cvt_pk_bf16(p1[8 + 2 * j], p1[8 + 2 * j + 1]); }
#pragma unroll
        for (int ks = 0; ks < 4; ++ks) {
            const bf16x8 pa = __builtin_bit_cast(bf16x8, pw[ks]);
#pragma unroll
            for (int d0 = 0; d0 < 2; ++d0) {
                const s16x4 lo = lds_tr16(Vs + vbase + ks * 16 * 192 + d0 * 64), hi4 = lds_tr16(Vs + vbase + ks * 16 * 192 + 8 * 192 + d0 * 64);
                const bf16x8 vb = (bf16x8){lo[0], lo[1], lo[2], lo[3], hi4[0], hi4[1], hi4[2], hi4[3]};
                if (d0 == 0) o0 = __builtin_amdgcn_mfma_f32_32x32x16_bf16(pa, vb, o0, 0, 0, 0); else o1 = __builtin_amdgcn_mfma_f32_32x32x16_bf16(pa, vb, o1, 0, 0, 0);
            }
        }
        }
        }
      }
    }
    l_run += __shfl_xor(l_run, 32);
    if (hi == 0) WSF[r32] = 1.f / l_run;
    bf16* Ow = merged + (rowbase + q0 + wid * 32) * DM + h * 64 + r32;
#pragma unroll
    for (int g = 0; g < 4; ++g) { const f32x4 rl = *(const LAS f32x4*)(WSF + 8 * g + 4 * hi);
#pragma unroll
        for (int i = 0; i < 4; ++i) { const int r = 4 * g + i; const int row = crow(r, hi);
            Ow[(size_t)row * DM] = (bf16)f2bf(o0[r] * rl[i]); Ow[(size_t)row * DM + 32] = (bf16)f2bf(o1[r] * rl[i]); } }
    __syncthreads();
#undef FOX_KB
}

template <int D> struct DecW {
    static constexpr int KS = D / 32;
    static constexpr int LPK = D / 4;
    static constexpr int KPI = 64 / LPK;
    float m[4], l[4]; float o[8][4];
};
template <int D>
__device__ __forceinline__ void dec_init(DecW<D>& w) {
#pragma unroll
    for (int i = 0; i < 4; ++i) { w.m[i] = -INFINITY; w.l[i] = 0.f; }
#pragma unroll
    for (int q = 0; q < 8; ++q)
#pragma unroll
        for (int j = 0; j < 4; ++j) w.o[q][j] = 0.f;
}
template <int D, int NTILE, int MODE>
__device__ __forceinline__ void dec_chunk(DecW<D>& w, const bf16x8 (&qa)[D / 32], const float* Kb, const float* Vb, int stride, const float* bias, float nb, LAS float* PL, int lane) {
    constexpr int KS = D / 32, LPK = D / 4, KPI = 64 / LPK;
    constexpr int NK = (MODE == 1) ? 8 : NTILE * 16, NV = NK / KPI;
    const int key = lane & 15, kq = lane >> 4;
    const unsigned koff = (unsigned)(key * stride + 8 * kq) * 4u;
    const int d4 = lane % LPK, ksub = lane / LPK;
    const unsigned voff = (unsigned)(ksub * stride + 4 * d4) * 4u;
    f32x4 kx[NTILE][2 * KS], vx[NV];
#pragma unroll
    for (int t = 0; t < NTILE; ++t) { const char* kp = (const char*)(Kb + (size_t)t * 16 * stride) + koff;
#pragma unroll
        for (int ks = 0; ks < KS; ++ks) { kx[t][2 * ks] = *(const f32x4*)(kp + 128 * ks); kx[t][2 * ks + 1] = *(const f32x4*)(kp + 128 * ks + 16); } }
    constexpr int NVA = (NV >= 8) ? NV / 2 : NV;
#pragma unroll
    for (int kk = 0; kk < NVA; ++kk) vx[kk] = *(const f32x4*)((const char*)(Vb + (size_t)kk * KPI * stride) + voff);
    f32x4 s[NTILE];
#pragma unroll
    for (int t = 0; t < NTILE; ++t) {
        f32x4 acc = {0.f, 0.f, 0.f, 0.f};
#pragma unroll
        for (int ks = 0; ks < KS; ++ks) { const f32x4 x0 = kx[t][2 * ks], x1 = kx[t][2 * ks + 1];
            v4u kb; kb.x = pg8::cvt_pk_bf16(x0.x, x0.y); kb.y = pg8::cvt_pk_bf16(x0.z, x0.w); kb.z = pg8::cvt_pk_bf16(x1.x, x1.y); kb.w = pg8::cvt_pk_bf16(x1.z, x1.w);
            acc = __builtin_amdgcn_mfma_f32_16x16x32_bf16(qa[ks], __builtin_bit_cast(bf16x8, kb), acc, 0, 0, 0); }
        if (MODE == 0) { if (bias) { const float bv = (bias[t * 16 + key] + nb) * LOG2E; acc += bv; } }
        else { acc += nb;
#pragma unroll
            for (int i = 0; i < 4; ++i) if (key > 4 * kq + i || key >= 8) acc[i] = -INFINITY; }
        s[t] = acc;
    }
#pragma unroll
    for (int kk = NVA; kk < NV; ++kk) vx[kk] = *(const f32x4*)((const char*)(Vb + (size_t)kk * KPI * stride) + voff);
    f32x4 mc = s[0];
#pragma unroll
    for (int t = 1; t < NTILE; ++t) { mc.x = fmaxf(mc.x, s[t].x); mc.y = fmaxf(mc.y, s[t].y); mc.z = fmaxf(mc.z, s[t].z); mc.w = fmaxf(mc.w, s[t].w); }
    mc.x = max16_f32(mc.x); mc.y = max16_f32(mc.y); mc.z = max16_f32(mc.z); mc.w = max16_f32(mc.w);
    float al[4];
#pragma unroll
    for (int i = 0; i < 4; ++i) { const float mn = fmaxf(w.m[i], mc[i]); al[i] = (mn == -INFINITY) ? 1.f : fexp2(w.m[i] - mn); w.m[i] = mn; w.l[i] *= al[i]; }
#pragma unroll
    for (int t = 0; t < NTILE; ++t) { f32x4 p;
#pragma unroll
        for (int i = 0; i < 4; ++i) { p[i] = (w.m[i] == -INFINITY) ? 0.f : fexp2(s[t][i] - w.m[i]); w.l[i] += p[i]; }
        if (kq < 2) *(LAS f32x4*)(PL + (t * 16 + key) * 8 + 4 * kq) = p; }
    if (key == 0 && kq < 2) *(LAS f32x4*)(PL + 1024 + 4 * kq) = (f32x4){al[0], al[1], al[2], al[3]};
    { const f32x4 a0 = *(const LAS f32x4*)(PL + 1024), a1 = *(const LAS f32x4*)(PL + 1028);
#pragma unroll
      for (int j = 0; j < 4; ++j) { w.o[0][j] *= a0.x; w.o[1][j] *= a0.y; w.o[2][j] *= a0.z; w.o[3][j] *= a0.w; w.o[4][j] *= a1.x; w.o[5][j] *= a1.y; w.o[6][j] *= a1.z; w.o[7][j] *= a1.w; } }
#pragma unroll
    for (int kk = 0; kk < NV; ++kk) { const int k = kk * KPI + ksub;
        const f32x4 v = vx[kk];
        const f32x4 pa = *(const LAS f32x4*)(PL + k * 8), pb = *(const LAS f32x4*)(PL + k * 8 + 4);
#pragma unroll
        for (int j = 0; j < 4; ++j) { w.o[0][j] += pa.x * v[j]; w.o[1][j] += pa.y * v[j]; w.o[2][j] += pa.z * v[j]; w.o[3][j] += pa.w * v[j];
                                      w.o[4][j] += pb.x * v[j]; w.o[5][j] += pb.y * v[j]; w.o[6][j] += pb.z * v[j]; w.o[7][j] += pb.w * v[j]; } }
}
__device__ __forceinline__ void dec_page_fox(DecW<64>& w, const bf16x8 (&qa)[2], const float* Kb, const float* Vb, const float* bias, float boff, LAS float* PL, int lane) {
    constexpr int stride = 512;
    const int key = lane & 15, kq = lane >> 4;
    const unsigned koff = (unsigned)(key * stride + 8 * kq) * 4u;
    const int d4 = lane & 15, ksub = lane >> 4;
    const unsigned voff = (unsigned)(ksub * stride + 4 * d4) * 4u;
    const __amdgpu_buffer_rsrc_t krs = __builtin_amdgcn_make_buffer_rsrc((void*)Kb, 0, 0x7fffffff, 0x00020000);
    const __amdgpu_buffer_rsrc_t vrs = __builtin_amdgcn_make_buffer_rsrc((void*)Vb, 0, 0x7fffffff, 0x00020000);
    const __amdgpu_buffer_rsrc_t brs = __builtin_amdgcn_make_buffer_rsrc((void*)bias, 0, 0x7fffffff, 0x00020000);
    f32x4 s[8];
#pragma unroll
    for (int hb = 0; hb < 2; ++hb) {
        f32x4 kx[4][4];
#pragma unroll
        for (int t = 0; t < 4; ++t) { const int so = (hb * 4 + t) * 16 * stride * 4;
            kx[t][0] = __builtin_bit_cast(f32x4, __builtin_amdgcn_raw_buffer_load_b128(krs, (int)koff, so, 0)); kx[t][1] = __builtin_bit_cast(f32x4, __builtin_amdgcn_raw_buffer_load_b128(krs, (int)koff + 16, so, 0));
            kx[t][2] = __builtin_bit_cast(f32x4, __builtin_amdgcn_raw_buffer_load_b128(krs, (int)koff + 128, so, 0)); kx[t][3] = __builtin_bit_cast(f32x4, __builtin_amdgcn_raw_buffer_load_b128(krs, (int)koff + 144, so, 0)); }
#pragma unroll
        for (int t = 0; t < 4; ++t) {
            f32x4 acc = {0.f, 0.f, 0.f, 0.f};
#pragma unroll
            for (int ks = 0; ks < 2; ++ks) { const f32x4 x0 = kx[t][2 * ks], x1 = kx[t][2 * ks + 1];
                v4u kb; kb.x = pg8::cvt_pk_bf16(x0.x, x0.y); kb.y = pg8::cvt_pk_bf16(x0.z, x0.w); kb.z = pg8::cvt_pk_bf16(x1.x, x1.y); kb.w = pg8::cvt_pk_bf16(x1.z, x1.w);
                acc = __builtin_amdgcn_mfma_f32_16x16x32_bf16(qa[ks], __builtin_bit_cast(bf16x8, kb), acc, 0, 0, 0); }
            acc += (__builtin_bit_cast(float, __builtin_amdgcn_raw_buffer_load_b32(brs, key * 4, (hb * 4 + t) * 64, 0)) + boff) * LOG2E;
            s[hb * 4 + t] = acc;
        }
        asm volatile("" ::: "memory");
    }
    f32x4 mc = s[0];
#pragma unroll
    for (int t = 1; t < 8; ++t) { mc.x = fmaxf(mc.x, s[t].x); mc.y = fmaxf(mc.y, s[t].y); mc.z = fmaxf(mc.z, s[t].z); mc.w = fmaxf(mc.w, s[t].w); }
    mc.x = max16_f32(mc.x); mc.y = max16_f32(mc.y); mc.z = max16_f32(mc.z); mc.w = max16_f32(mc.w);
    float al[4];
#pragma unroll
    for (int i = 0; i < 4; ++i) { const float mn = fmaxf(w.m[i], mc[i]); al[i] = fexp2(w.m[i] - mn); w.m[i] = mn; w.l[i] *= al[i]; }
    bool nz = false;
#pragma unroll
    for (int t = 0; t < 8; ++t) { f32x4 p;
#pragma unroll
        for (int i = 0; i < 4; ++i) { p[i] = fexp2(s[t][i] - w.m[i]); w.l[i] += p[i]; nz = nz || (p[i] != 0.f); }
        if (kq < 2) *(LAS f32x4*)(PL + (t * 16 + key) * 8 + 4 * kq) = p; }
    if (__ballot(nz && kq < 2) == 0ull) return;
    if (key == 0 && kq < 2) *(LAS f32x4*)(PL + 1024 + 4 * kq) = (f32x4){al[0], al[1], al[2], al[3]};
    { const f32x4 a0 = *(const LAS f32x4*)(PL + 1024), a1 = *(const LAS f32x4*)(PL + 1028);
#pragma unroll
      for (int j = 0; j < 4; ++j) { w.o[0][j] *= a0.x; w.o[1][j] *= a0.y; w.o[2][j] *= a0.z; w.o[3][j] *= a0.w; w.o[4][j] *= a1.x; w.o[5][j] *= a1.y; w.o[6][j] *= a1.z; w.o[7][j] *= a1.w; } }
#pragma unroll 1
    for (int vh = 0; vh < 2; ++vh) {
    f32x4 vx[16];
#pragma unroll
    for (int kk = 0; kk < 16; ++kk) vx[kk] = __builtin_bit_cast(f32x4, __builtin_amdgcn_raw_buffer_load_b128(vrs, (int)voff, (vh * 16 + kk) * 4 * stride * 4, 0));
#pragma unroll
    for (int kk = 0; kk < 16; ++kk) { const int k = (vh * 16 + kk) * 4 + ksub;
        const f32x4 v = vx[kk];
        const f32x4 pa = *(const LAS f32x4*)(PL + k * 8), pb = *(const LAS f32x4*)(PL + k * 8 + 4);
#pragma unroll
        for (int j = 0; j < 4; ++j) { w.o[0][j] += pa.x * v[j]; w.o[1][j] += pa.y * v[j]; w.o[2][j] += pa.z * v[j]; w.o[3][j] += pa.w * v[j];
                                      w.o[4][j] += pb.x * v[j]; w.o[5][j] += pb.y * v[j]; w.o[6][j] += pb.z * v[j]; w.o[7][j] += pb.w * v[j]; } }
    }
}
template <int D>
__device__ __forceinline__ void dec_park(DecW<D>& w, LAS float* CBw, int lane) {
    constexpr int LPK = D / 4;
    const int key = lane & 15, kq = lane >> 4, d4 = lane % LPK, ksub = lane / LPK;
#pragma unroll
    for (int i = 0; i < 4; ++i) { float l = w.l[i];
        l = sum16_f32(l);
        w.l[i] = l; }
    if (key == 0 && kq < 2) { *(LAS f32x4*)(CBw + 4 * kq) = (f32x4){w.m[0], w.m[1], w.m[2], w.m[3]}; *(LAS f32x4*)(CBw + 8 + 4 * kq) = (f32x4){w.l[0], w.l[1], w.l[2], w.l[3]}; }
#pragma unroll
    for (int q = 0; q < 8; ++q) { f32x4 v = (f32x4){w.o[q][0], w.o[q][1], w.o[q][2], w.o[q][3]};
        if (LPK < 64) {
#pragma unroll
            for (int o = LPK; o < 64; o <<= 1) { if (o == 16) { v.x += xor16_f32(v.x); v.y += xor16_f32(v.y); v.z += xor16_f32(v.z); v.w += xor16_f32(v.w); }
                else { v.x += __shfl_xor(v.x, o); v.y += __shfl_xor(v.y, o); v.z += __shfl_xor(v.z, o); v.w += __shfl_xor(v.w, o); } } }
        if (ksub == 0) *(LAS f32x4*)(CBw + 16 + q * D + 4 * d4) = v; }
}
template <int D>
__device__ __forceinline__ void dec_combine(int tid, LAS float* CB, bf16* dst, int ldd) {
    constexpr int WSTR = 16 + 8 * D;
    for (int e = tid; e < 8 * D; e += NTHR) { const int q = e / D, d = e % D;
        float mt = -INFINITY;
#pragma unroll
        for (int w = 0; w < 8; ++w) mt = fmaxf(mt, CB[w * WSTR + q]);
        float num = 0.f, den = 0.f;
#pragma unroll
        for (int w = 0; w < 8; ++w) { const float mw = CB[w * WSTR + q]; const float f = (mw == -INFINITY) ? 0.f : fexp2(mw - mt); num += f * CB[w * WSTR + 16 + q * D + d]; den += f * CB[w * WSTR + 8 + q]; }
        dst[(size_t)q * ldd + d] = (bf16)f2bf(num / den); }
}
template <int D>
__device__ __forceinline__ void dec_load_q(bf16x8 (&qa)[D / 32], const bf16* Q, int ldq, int lane) {
    const int row = lane & 15, kq = lane >> 4;
#pragma unroll
    for (int ks = 0; ks < D / 32; ++ks) { v4u z = {0u, 0u, 0u, 0u}; if (row < 8) z = *(const v4u*)(Q + (size_t)row * ldq + 32 * ks + 8 * kq); qa[ks] = __builtin_bit_cast(bf16x8, z); }
}
constexpr int DEC_PL = 1040;
__device__ __forceinline__ void fox_sample_unit(const Frame& F, const Args& a, int u) {
    unsigned char* ws = a.ws; const int bs = u >> 3, h = u & 7;
    int ln = lane_id(); asm volatile("" : "+v"(ln));
    LAS float* PL = (LAS float*)F.lds + F.wave * DEC_PL; LAS float* CB = (LAS float*)F.lds + 8 * DEC_PL; constexpr int WSTR = 16 + 8 * 64;
    bf16x8 qa[2]; dec_load_q<64>(qa, (const bf16*)(ws + WS_QF) + (size_t)(TP + bs * LS) * 512 + h * 64, 512, ln);
    DecW<64> w; dec_init(w);
    {
        const int key = ln & 15; const float* lf = a.out + O_LFS + (size_t)(bs * LS) * 8 + h; float cn = 0.f;
#pragma unroll
        for (int j = 0; j < 8; ++j) { const float x = lf[j * 8]; cn += (j <= key) ? x : 0.f; }
        const float* Kb = a.out + O_FKS + (size_t)(bs * LS) * 512 + h * 64; const float* Vb = a.out + O_FVS + (size_t)(bs * LS) * 512 + h * 64;
        dec_chunk<64, 1, 1>(w, qa, Kb, Vb, 512, nullptr, -cn * LOG2E, PL, ln);
        if (F.wave != 0) {
#pragma unroll
            for (int i = 0; i < 4; ++i) w.l[i] = 0.f;
#pragma unroll
            for (int q = 0; q < 8; ++q)
#pragma unroll
                for (int j = 0; j < 4; ++j) w.o[q][j] = 0.f; }
    }
    const int* pt = (const int*)a.in[I_PT];
    float spx; { const float ptv = (ln < 16) ? ((const float*)(ws + WS_MISC + 2 * MiB))[(bs * 8 + h) * NPAGES + ln] : 0.f; float v = ptv;
#pragma unroll
        for (int o = 1; o < 16; o <<= 1) { const float t = __builtin_bit_cast(float, __builtin_amdgcn_ds_bpermute((ln + o) << 2, __builtin_bit_cast(int, v))); if (ln + o < 16) v += t; }
        spx = v - ptv; }
#if defined(OLD_FOXS)
#pragma unroll 1
    for (int pp = 0; pp < 4; ++pp) { const int p = F.wave * 2 + (pp >> 1), hf = pp & 1; const int pg = __builtin_amdgcn_readfirstlane(pt[bs * NPAGES + p]);
        const float* Kb = (const float*)a.in[I_CFK] + (((size_t)pg * PAGE + hf * 64) * 8 + h) * 64; const float* Vb = (const float*)a.in[I_CFV] + (((size_t)pg * PAGE + hf * 64) * 8 + h) * 64;
        dec_chunk<64, 4, 0>(w, qa, Kb, Vb, 512, (const float*)(ws + WS_SUF) + (size_t)(bs * 8 + h) * PASTL + p * PAGE + hf * 64, __builtin_bit_cast(float, __builtin_amdgcn_ds_bpermute(p << 2, __builtin_bit_cast(int, spx))), PL, ln); }
#else
#pragma unroll 1
    for (int pp = 1; pp >= 0; --pp) { const int p = pp ? (NPAGES - 1 - F.wave) : F.wave;
        const int pg = __builtin_amdgcn_readfirstlane(pt[bs * NPAGES + p]);
        const float* Kb = (const float*)a.in[I_CFK] + ((size_t)pg * PAGE * 8 + h) * 64; const float* Vb = (const float*)a.in[I_CFV] + ((size_t)pg * PAGE * 8 + h) * 64;
        dec_page_fox(w, qa, Kb, Vb, (const float*)(ws + WS_SUF) + (size_t)(bs * 8 + h) * PASTL + p * PAGE, __builtin_bit_cast(float, __builtin_amdgcn_ds_bpermute(p << 2, __builtin_bit_cast(int, spx))), PL, ln); }
#endif
    dec_park<64>(w, CB + F.wave * WSTR, ln);
    __syncthreads();
    dec_combine<64>(F.wave * 64 + ln, CB, (bf16*)(ws + WS_MERGED) + (size_t)(TP + bs * LS) * DM + h * 64, DM);
    __syncthreads();
}
__device__ __forceinline__ void cross_sample_unit(const Frame& F, const Args& a, int u) {
    unsigned char* ws = a.ws; const int bs = u >> 2, h = u & 3;
    LAS float* PL = (LAS float*)F.lds + F.wave * DEC_PL; LAS float* CB = (LAS float*)F.lds + 8 * DEC_PL; constexpr int WSTR = 16 + 8 * 256;
    bf16x8 qa[8]; dec_load_q<256>(qa, (const bf16*)(ws + WS_QC) + (size_t)(TP + bs * LS) * DM + h * 256, DM, F.lane);
    DecW<256> w; dec_init(w);
    const float* Kb = (const float*)a.in[I_CMK] + ((size_t)(bs * 256 + F.wave * 32) * 4 + h) * 256; const float* Vb = (const float*)a.in[I_CMV] + ((size_t)(bs * 256 + F.wave * 32) * 4 + h) * 256;
#pragma unroll 1
    for (int c = 0; c < 2; ++c) dec_chunk<256, 1, 0>(w, qa, Kb + (size_t)c * 16 * 1024, Vb + (size_t)c * 16 * 1024, 1024, nullptr, 0.f, PL, F.lane);
    dec_park<256>(w, CB + F.wave * WSTR, F.lane);
    __syncthreads();
    dec_combine<256>(F.tid, CB, (bf16*)(ws + WS_OC) + (size_t)(TP + bs * LS) * DM + h * 256, DM);
    __syncthreads();
}


__device__ __forceinline__ void gla_g3_unit(const Frame& F, const Args& a, int u) {
    unsigned char* ws = a.ws;
    const int b = u >> 9, h = (u >> 7) & 3, n = u & 127; const int row0 = b * SEQ + n * 64;
    LAS unsigned char* KIB = F.lds; LAS unsigned char* ATTB = F.lds + 34816; LAS unsigned char* QDB = F.lds + 44032;
    LAS unsigned char* VSB = F.lds + 53248; LAS unsigned char* SPB = F.lds + 73728; LAS float* OS = (LAS float*)(F.lds + 94208);
#pragma unroll
    for (int i = 0; i < 2; ++i) { const int c = F.tid + NTHR * i; *(LAS v4u*)(VSB + (c >> 4) * 320 + (c & 15) * 16) = *(const v4u*)((const bf16*)(ws + WS_GV) + (size_t)(row0 + (c >> 4)) * 512 + h * 128 + (c & 15) * 8); }
#pragma unroll
    for (int i = 0; i < 4; ++i) { const int c4 = F.tid + NTHR * i; const f32x4 sp = *(const f32x4*)((const float*)(ws + WS_GKV) + ((size_t)((b * 4 + h) * 128 + n) * 64) * 128 + 4 * c4);
        v2u o; o.x = pg8::cvt_pk_bf16(sp.x, sp.y); o.y = pg8::cvt_pk_bf16(sp.z, sp.w); *(LAS v2u*)(SPB + (c4 >> 5) * 320 + (c4 & 31) * 8) = o; }
#pragma unroll
    for (int i = 0; i < 2; ++i) { const int c4 = F.tid + NTHR * i, t = c4 >> 4, d4 = (c4 & 15) * 4; const size_t gi = (size_t)(row0 + t) * 256 + h * 64 + d4;
        const f32x4 bb = *(const f32x4*)((const float*)(ws + WS_BB) + gi);
        const v2u qq = *(const v2u*)((const bf16*)(ws + WS_GQ) + gi), kk = *(const v2u*)((const bf16*)(ws + WS_GK) + gi);
        v2u qo, ko; qo.x = pg8::cvt_pk_bf16(bflo(qq.x) * __expf(bb.x), bfhi(qq.x) * __expf(bb.y)); qo.y = pg8::cvt_pk_bf16(bflo(qq.y) * __expf(bb.z), bfhi(qq.y) * __expf(bb.w));
        ko.x = pg8::cvt_pk_bf16(bflo(kk.x) * __expf(-bb.x), bfhi(kk.x) * __expf(-bb.y)); ko.y = pg8::cvt_pk_bf16(bflo(kk.y) * __expf(-bb.z), bfhi(kk.y) * __expf(-bb.w));
        *(LAS v2u*)(QDB + t * 144 + d4 * 2) = qo; *(LAS v2u*)(KIB + t * 144 + d4 * 2) = ko; }
    float grv[8][2]; float gg0, gg1;
    { const float* ggo = (const float*)a.in[I_GGO] + h * 128; gg0 = ggo[F.lane]; gg1 = ggo[64 + F.lane];
#pragma unroll
      for (int rr = 0; rr < 8; ++rr) { const BfPtr gr = GLD(ws + WS_GR) + ((size_t)(row0 + F.wave * 8 + rr) * 512 + h * 128); grv[rr][0] = gr[F.lane]; grv[rr][1] = gr[64 + F.lane]; } }
    __syncthreads();
    {
        const int lane = F.lane, r32 = lane & 31, hi = lane >> 5;
        if (F.wave < 4) { const int tb = F.wave >> 1, sb = F.wave & 1; f32x16 acc = {};
            if (sb <= tb) {
                const LAS unsigned char* qrow = QDB + (32 * tb + r32) * 144; const LAS unsigned char* krow = KIB + (32 * sb + r32) * 144;
#pragma unroll
                for (int ks = 0; ks < 4; ++ks) acc = __builtin_amdgcn_mfma_f32_32x32x16_bf16(row_frag(qrow, ks, hi), row_frag(krow, ks, hi), acc, 0, 0, 0);
            }
#pragma unroll
            for (int r = 0; r < 16; ++r) { const int t = 32 * tb + crow(r, hi), s2 = 32 * sb + r32; *(LAS unsigned short*)(ATTB + t * 144 + s2 * 2) = (unsigned short)f2bf(s2 <= t ? acc[r] : 0.f); }
        }
    }
    __syncthreads();
    {
        const int lane = F.lane, r32 = lane & 31, hi = lane >> 5, tb = F.wave >> 2, nb = F.wave & 3;
        const int trb = (4 * hi + ((lane & 15) >> 2)) * 320 + (16 * ((lane >> 4) & 1) + 4 * (lane & 3)) * 2 + 64 * nb;
        const LAS unsigned char* arow = ATTB + (32 * tb + r32) * 144; const LAS unsigned char* qrow = QDB + (32 * tb + r32) * 144;
        f32x16 acc = {};
#pragma unroll
        for (int ks = 0; ks < 4; ++ks) acc = __builtin_amdgcn_mfma_f32_32x32x16_bf16(row_frag(arow, ks, hi), tr_frag<320>(VSB + trb, ks), acc, 0, 0, 0);
#pragma unroll
        for (int ks = 0; ks < 4; ++ks) acc = __builtin_amdgcn_mfma_f32_32x32x16_bf16(row_frag(qrow, ks, hi), tr_frag<320>(SPB + trb, ks), acc, 0, 0, 0);
#pragma unroll
        for (int r = 0; r < 16; ++r) OS[(32 * tb + crow(r, hi)) * 128 + 32 * nb + r32] = acc[r];
    }
    __syncthreads();
#pragma unroll
    for (int rr = 0; rr < 8; ++rr) { const int t = F.wave * 8 + rr; const float v0 = OS[t * 128 + F.lane], v1 = OS[t * 128 + 64 + F.lane];
        const float r = rsqrtf(wave_sum(v0 * v0 + v1 * v1) * (1.f / 128.f) + EPS);
        bf16* mo = (bf16*)(ws + WS_MERGED) + (size_t)(row0 + t) * DM + 512 + h * 128;
        mo[F.lane] = (bf16)f2bf(v0 * r * gg0 * silu(grv[rr][0])); mo[64 + F.lane] = (bf16)f2bf(v1 * r * gg1 * silu(grv[rr][1])); }
    __syncthreads();
}

struct EpiSoftmaxP {
    static constexpr bool PERM = true, AFTER_DRAIN = true;
    const LAS unsigned long long* argp;
    __device__ __forceinline__ void fused(f32x4 (&acc)[2][2][4][2], const Unit&, int wr, int wc, int fr, int fq, PG8_LAS unsigned char* lds, int wid, int lane) const {
        LAS float* PM = (LAS float*)lds; LAS float* PS = PM + 1024;
        const int ub = (int)blockIdx.x; const int ldp = DM;
        bf16* P = (bf16*)((unsigned char*)ld_ptr(argp + N_INPUTS + 1) + WS_PC) + ((size_t)((ub >> 7) & 1) * SEQ + (ub & 31) * 256) * DM + ((ub >> 5) & 3) * 256;
        { int t2 = lane_id(); asm volatile("" : "+v"(t2)); fr = t2 & 15; fq = (t2 >> 4) & 3; }
#pragma unroll
        for (int ai = 0; ai < 2; ++ai)
#pragma unroll
            for (int m = 0; m < 4; ++m) { float mx = -INFINITY;
#pragma unroll
                for (int bj = 0; bj < 2; ++bj)
#pragma unroll
                    for (int n = 0; n < 2; ++n) { const f32x4 x = acc[ai][bj][m][n]; mx = fmaxf(mx, fmaxf(fmaxf(x[0], x[1]), fmaxf(x[2], x[3]))); }
                mx = fmaxf(mx, xor16_f32(mx)); mx = fmaxf(mx, __shfl_xor(mx, 32));
                if (fq == 0) PM[(ai * 128 + wr * 64 + m * 16 + fr) * 4 + wc] = mx; }
        asm volatile("s_waitcnt lgkmcnt(0)" ::: "memory"); __builtin_amdgcn_s_barrier(); asm volatile("" ::: "memory");
#pragma unroll
        for (int ai = 0; ai < 2; ++ai)
#pragma unroll
            for (int m = 0; m < 4; ++m) { const int r = ai * 128 + wr * 64 + m * 16 + fr; const f32x4 pm = *(const LAS f32x4*)(PM + r * 4);
                const float M = fmaxf(fmaxf(pm[0], pm[1]), fmaxf(pm[2], pm[3])); float s = 0.f;
#pragma unroll
                for (int bj = 0; bj < 2; ++bj)
#pragma unroll
                    for (int n = 0; n < 2; ++n) { f32x4 x = acc[ai][bj][m][n]; x[0] = fexp2(x[0] - M); x[1] = fexp2(x[1] - M); x[2] = fexp2(x[2] - M); x[3] = fexp2(x[3] - M); acc[ai][bj][m][n] = x; s += (x[0] + x[1]) + (x[2] + x[3]); }
                s += xor16_f32(s); s += __shfl_xor(s, 32);
                if (fq == 0) PS[r * 4 + wc] = s; }
        asm volatile("s_waitcnt lgkmcnt(0)" ::: "memory"); __builtin_amdgcn_s_barrier(); asm volatile("" ::: "memory");
#pragma unroll
        for (int ai = 0; ai < 2; ++ai)
#pragma unroll
            for (int m = 0; m < 4; ++m) { const int r = ai * 128 + wr * 64 + m * 16 + fr; const f32x4 ps = *(const LAS f32x4*)(PS + r * 4); const float inv = 1.f / ((ps[0] + ps[1]) + (ps[2] + ps[3]));
#pragma unroll
                for (int bj = 0; bj < 2; ++bj) { const f32x4 x0 = acc[ai][bj][m][0], x1 = acc[ai][bj][m][1];
                    v4u o; o.x = pg8::cvt_pk_bf16(x0[0] * inv, x0[1] * inv); o.y = pg8::cvt_pk_bf16(x0[2] * inv, x0[3] * inv); o.z = pg8::cvt_pk_bf16(x1[0] * inv, x1[1] * inv); o.w = pg8::cvt_pk_bf16(x1[2] * inv, x1[3] * inv);
                    *(v4u*)(P + (size_t)r * ldp + bj * 128 + wc * 32 + fq * 8) = o; } }
        asm volatile("s_waitcnt lgkmcnt(0)" ::: "memory"); __builtin_amdgcn_s_barrier(); asm volatile("" ::: "memory");
    }
};

__device__ __forceinline__ void rms_rows_phase(const Frame& F, const float* X, const float* g, bf16* H) {
    const int gw = F.vcu * NWAVES + F.wave, NGW = F.G * NWAVES;
    for (int m = gw; m < TA; m += NGW) rms_row_bf16(X + (size_t)m * DM, g, H + (size_t)m * DM, F.lane);
}

__device__ __forceinline__ unsigned f2sort(float f) { const unsigned u = __builtin_bit_cast(unsigned, f); return u ^ ((u >> 31) ? 0xFFFFFFFFu : 0x80000000u); }
__device__ __forceinline__ float sort2f(unsigned s) { const unsigned u = s ^ ((s >> 31) ? 0x80000000u : 0xFFFFFFFFu); return __builtin_bit_cast(float, u); }
__device__ __forceinline__ float gelu_tanh(float x) { const float y = 0.7978845608028654f * (x + 0.044715f * x * x * x); const float e = __expf(2.f * y); return 0.5f * x * (1.f + (1.f - 2.f / (e + 1.f))); }
__device__ __forceinline__ unsigned gmax16(unsigned v) { return max16_u32(v); }
typedef __bf16 bf16x2_t __attribute__((ext_vector_type(2)));
__device__ __forceinline__ float dot2bf(unsigned a, unsigned b, float c) {
#if __has_builtin(__builtin_amdgcn_fdot2_f32_bf16)
    return __builtin_amdgcn_fdot2_f32_bf16(__builtin_bit_cast(bf16x2_t, a), __builtin_bit_cast(bf16x2_t, b), c, false);
#else
    return c + bflo(a) * bflo(b) + bfhi(a) * bfhi(b);
#endif
}
template <bool SPLIT>
__device__ __forceinline__ void peer_token(const Frame& F, const Args& a, int row, LAS unsigned* TOPS, const LAS unsigned* CT, int half, LAS float* PART) {
    unsigned char* ws = a.ws; const int lane = lane_id(), grp = lane >> 4, j16 = lane & 15;
    const bf16* sc = (const bf16*)(ws + WS_SC) + (size_t)row * 2048;
#pragma unroll 1
    for (int bt = 0; bt < 4; ++bt) {
        const v4u xq = *(const v4u*)(sc + (bt * 4 + grp) * 128 + 8 * j16);
        unsigned k[8]; const float xs[8] = {bflo(xq.x), bfhi(xq.x), bflo(xq.y), bfhi(xq.y), bflo(xq.z), bfhi(xq.z), bflo(xq.w), bfhi(xq.w)};
#pragma unroll
        for (int e = 0; e < 8; ++e) k[e] = (f2sort(xs[e]) & ~127u) | (unsigned)(127 - (8 * j16 + e));
#define PEER_CE(i, j) { const unsigned hi_ = k[i] > k[j] ? k[i] : k[j], lo_ = k[i] > k[j] ? k[j] : k[i]; k[i] = hi_; k[j] = lo_; }
        PEER_CE(0, 1) PEER_CE(2, 3) PEER_CE(4, 5) PEER_CE(6, 7)
        PEER_CE(0, 2) PEER_CE(1, 3) PEER_CE(4, 6) PEER_CE(5, 7)
        PEER_CE(1, 2) PEER_CE(5, 6)
        PEER_CE(0, 4) PEER_CE(1, 5) PEER_CE(2, 6) PEER_CE(3, 7)
        PEER_CE(2, 4) PEER_CE(3, 5)
        PEER_CE(1, 2) PEER_CE(3, 4) PEER_CE(5, 6)
#undef PEER_CE
        unsigned mine = 0u;
#pragma unroll 1
        for (int r = 0; r < 16; ++r) {
            const unsigned m = gmax16(k[0]);
            if (j16 == r) mine = m;
            const bool won = (k[0] == m);
#pragma unroll
            for (int e = 0; e < 7; ++e) k[e] = won ? k[e + 1] : k[e];
            k[7] = won ? 0u : k[7];
        }
        TOPS[(bt * 4 + grp) * 16 + j16] = mine;
    }
    int ex[2]; float gx[2], sux[2];
#pragma unroll
    for (int ps = 0; ps < 2; ++ps) {
        const int hd = ps * 4 + grp; const LAS unsigned* T1 = TOPS + (2 * hd) * 16; const LAS unsigned* T2 = T1 + 16;
        const unsigned c0_ = CT[j16], c1_ = CT[j16 + 16], c2_ = CT[j16 + 32], c3_ = CT[j16 + 48];
        const int ci0 = c0_ & 255, cj0 = c0_ >> 8, ci1 = c1_ & 255, cj1 = c1_ >> 8, ci2 = c2_ & 255, cj2 = c2_ >> 8, ci3 = c3_ & 255, cj3 = c3_ >> 8; const bool cv3 = (j16 + 48) < 50;
        unsigned k[4];
        { const float s0 = sort2f(T1[ci0] & ~127u) + sort2f(T2[cj0] & ~127u), s1 = sort2f(T1[ci1] & ~127u) + sort2f(T2[cj1] & ~127u),
                      s2 = sort2f(T1[ci2] & ~127u) + sort2f(T2[cj2] & ~127u), s3 = sort2f(T1[ci3] & ~127u) + sort2f(T2[cj3] & ~127u);
          k[0] = (f2sort(s0) & ~127u) | (unsigned)(127 - j16); k[1] = (f2sort(s1) & ~127u) | (unsigned)(127 - (j16 + 16)); k[2] = (f2sort(s2) & ~127u) | (unsigned)(127 - (j16 + 32));
          k[3] = cv3 ? ((f2sort(s3) & ~127u) | (unsigned)(127 - (j16 + 48))) : 0u; }
#define PEER_CE(i, j) { const unsigned hi_ = k[i] > k[j] ? k[i] : k[j], lo_ = k[i] > k[j] ? k[j] : k[i]; k[i] = hi_; k[j] = lo_; }
        PEER_CE(0, 1) PEER_CE(2, 3) PEER_CE(0, 2) PEER_CE(1, 3) PEER_CE(1, 2)
#undef PEER_CE
        unsigned mine = 0u;
#pragma unroll 1
        for (int r = 0; r < 16; ++r) {
            const unsigned m = gmax16(k[0]);
            if (j16 == r) mine = m;
            const bool won = (k[0] == m);
            k[0] = won ? k[1] : k[0]; k[1] = won ? k[2] : k[1]; k[2] = won ? k[3] : k[2]; k[3] = won ? 0u : k[3];
        }
        const int c = 127 - (int)(mine & 127u);
        int ci, cj;
        if (c < 16) { ci = 0; cj = c; } else if (c < 24) { ci = 1; cj = c - 16; } else if (c < 29) { ci = 2; cj = c - 24; } else if (c < 33) { ci = 3; cj = c - 29; }
        else if (c < 36) { ci = 4; cj = c - 33; } else if (c < 38) { ci = 5; cj = c - 36; } else if (c < 40) { ci = 6; cj = c - 38; } else if (c < 42) { ci = 7; cj = c - 40; } else { ci = c - 34; cj = 0; }
        const int i1 = 127 - (int)(T1[ci] & 127u), i2 = 127 - (int)(T2[cj] & 127u);
        ex[ps] = i1 * 128 + i2;
        const float sv = sort2f(mine & ~127u); const float s0 = __shfl(sv, lane & 48);
        float ee = __expf(sv - s0); const float es = sum16_f32(ee);
        const float* rsc = (const float*)(ws + WS_MISC);
        sux[ps] = rsc[ex[ps]]; gx[ps] = ee / es * rsc[16384 + ex[ps]];
    }
    {
        unsigned k0 = ((unsigned)ex[0] << 7) | (unsigned)lane, k1 = ((unsigned)ex[1] << 7) | (unsigned)(64 + lane);
#pragma unroll
        for (int k = 2; k <= 128; k <<= 1) {
#pragma unroll
            for (int j = k >> 1; j > 0; j >>= 1) {
                if (j == 64) { const unsigned lo = k0 < k1 ? k0 : k1, hi = k0 < k1 ? k1 : k0; k0 = lo; k1 = hi; }
                else {
                    unsigned p0, p1;
                    if (j == 32) { p0 = (unsigned)__shfl_xor((int)k0, 32); p1 = (unsigned)__shfl_xor((int)k1, 32); }
                    else if (j == 16) { p0 = xchg_xor_u32<16>(k0); p1 = xchg_xor_u32<16>(k1); } else if (j == 8) { p0 = xchg_xor_u32<8>(k0); p1 = xchg_xor_u32<8>(k1); }
                    else if (j == 4) { p0 = xchg_xor_u32<4>(k0); p1 = xchg_xor_u32<4>(k1); } else if (j == 2) { p0 = xchg_xor_u32<2>(k0); p1 = xchg_xor_u32<2>(k1); }
                    else { p0 = xchg_xor_u32<1>(k0); p1 = xchg_xor_u32<1>(k1); }
                    const bool low = (lane & j) == 0; const bool asc0 = (lane & k) == 0, asc1 = ((64 + lane) & k) == 0;
                    const unsigned mn0 = k0 < p0 ? k0 : p0, mx0 = k0 < p0 ? p0 : k0, mn1 = k1 < p1 ? k1 : p1, mx1 = k1 < p1 ? p1 : k1;
                    k0 = (low == asc0) ? mn0 : mx0; k1 = (low == asc1) ? mn1 : mx1;
                }
            }
        }
        const int o0 = (int)(k0 & 127u), o1 = (int)(k1 & 127u);
        const float g0a = __shfl(gx[0], o0 & 63), g0b = __shfl(gx[1], o0 & 63), g1a = __shfl(gx[0], o1 & 63), g1b = __shfl(gx[1], o1 & 63);
        const float s0a = __shfl(sux[0], o0 & 63), s0b = __shfl(sux[1], o0 & 63), s1a = __shfl(sux[0], o1 & 63), s1b = __shfl(sux[1], o1 & 63);
        gx[0] = (o0 & 64) ? g0b : g0a; gx[1] = (o1 & 64) ? g1b : g1a; sux[0] = (o0 & 64) ? s0b : s0a; sux[1] = (o1 & 64) ? s1b : s1a;
        ex[0] = (int)(k0 >> 7); ex[1] = (int)(k1 >> 7);
    }
    const float rstd2 = rsqrtf(((const float*)(ws + WS_SS))[TA + row] * (1.f / 1024.f) + EPS);
    float hf[16];
    { const bf16* hb = (const bf16*)(ws + WS_HB) + (size_t)row * DM + 4 * lane;
#pragma unroll
      for (int q = 0; q < 4; ++q) { const v2u hq = *(const v2u*)(hb + 256 * q); hf[4 * q] = bflo(hq.x); hf[4 * q + 1] = bfhi(hq.x); hf[4 * q + 2] = bflo(hq.y); hf[4 * q + 3] = bfhi(hq.y); } }
    float oacc[16];
#pragma unroll
    for (int i = 0; i < 16; ++i) oacc[i] = 0.f;
    const unsigned char* U = ws + WS_U16; const unsigned char* V = ws + WS_V16;
    v4u ub[8], vbA[8], vbB[8];
    const int gbeg = SPLIT ? 8 * half : 0, gend = SPLIT ? 8 * half + 8 : 16;
    const int addr32 = (lane ^ 32) << 2;
#define PEER_LOAD(buf, TAB, g) do { const int kk_ = (g) * 8; const int exs_ = (kk_ < 64) ? ex[0] : ex[1]; \
        _Pragma("unroll") for (int i = 0; i < 8; ++i) { const int e_ = __builtin_amdgcn_readlane(exs_, (kk_ & 63) + i); buf[i] = *(const v4u*)(TAB + (size_t)e_ * DM + 16 * lane); } } while (0)
#define PEER_DOTS(buf, g, wout) do { const int kk_ = (g) * 8; const float gxs_ = (kk_ < 64) ? gx[0] : gx[1]; const float sus_ = (kk_ < 64) ? sux[0] : sux[1]; float av[8]; \
        _Pragma("unroll") for (int i = 0; i < 8; ++i) { float s = 0.f; \
            _Pragma("unroll") for (int q = 0; q < 4; ++q) { const f32x2 lo = __builtin_amdgcn_cvt_pk_f32_fp8((int)buf[i][q], false), hi = __builtin_amdgcn_cvt_pk_f32_fp8((int)buf[i][q], true); \
                s += lo.x * hf[4 * q]; s += lo.y * hf[4 * q + 1]; s += hi.x * hf[4 * q + 2]; s += hi.y * hf[4 * q + 3]; } \
            av[i] = s; } \
        const bool b5 = lane & 32, b4 = lane & 16, b3_ = lane & 8; float bq[4], cq[2], dq; \
        _Pragma("unroll") for (int i = 0; i < 4; ++i) bq[i] = (b5 ? av[4 + i] : av[i]) + __builtin_bit_cast(float, __builtin_amdgcn_ds_bpermute(addr32, __builtin_bit_cast(int, b5 ? av[i] : av[4 + i])));     \
        _Pragma("unroll") for (int i = 0; i < 2; ++i) cq[i] = (b4 ? bq[2 + i] : bq[i]) + xor16_f32(b4 ? bq[i] : bq[2 + i]); \
        dq = (b3_ ? cq[1] : cq[0]) + DPP_F(b3_ ? cq[0] : cq[1], DPP_MIR);        \
        dq = sum8_f32(dq); \
        const int src = (kk_ & 63) + (lane >> 3); \
        wout = __shfl(gxs_, src) * gelu_tanh(dq * __shfl(sus_, src) * rstd2); } while (0)
#define PEER_ACC(buf, wv) do { _Pragma("unroll") for (int i = 0; i < 8; ++i) { const float w = __builtin_bit_cast(float, __builtin_amdgcn_readlane(__builtin_bit_cast(int, wv), 8 * i)); \
        _Pragma("unroll") for (int q = 0; q < 4; ++q) { const f32x2 lo = __builtin_amdgcn_cvt_pk_f32_fp8((int)buf[i][q], false), hi = __builtin_amdgcn_cvt_pk_f32_fp8((int)buf[i][q], true); \
            oacc[4 * q] += w * lo.x; oacc[4 * q + 1] += w * lo.y; oacc[4 * q + 2] += w * hi.x; oacc[4 * q + 3] += w * hi.y; } } } while (0)
    PEER_LOAD(ub, U, gbeg); PEER_LOAD(vbA, V, gbeg);
#pragma unroll 1
    for (int g0 = gbeg; g0 < gend; g0 += 2) {
        float w0, w1;
        PEER_DOTS(ub, g0, w0);
        PEER_LOAD(ub, U, g0 + 1); PEER_LOAD(vbB, V, g0 + 1);
        PEER_ACC(vbA, w0);
        PEER_DOTS(ub, g0 + 1, w1);
        { const int gn = (g0 + 2 < gend) ? g0 + 2 : g0 + 1;
          PEER_LOAD(ub, U, gn); PEER_LOAD(vbA, V, gn); }
        PEER_ACC(vbB, w1);
    }
#undef PEER_LOAD
#undef PEER_DOTS
#undef PEER_ACC
    if (SPLIT) {
        if (half == 1) {
#pragma unroll
            for (int q = 0; q < 4; ++q) *(LAS f32x4*)(PART + 16 * lane + 4 * q) = (f32x4){oacc[4 * q], oacc[4 * q + 1], oacc[4 * q + 2], oacc[4 * q + 3]}; }
        __syncthreads();
        if (half == 1) return;
#pragma unroll
        for (int q = 0; q < 4; ++q) { const f32x4 p = *(const LAS f32x4*)(PART + 16 * lane + 4 * q); oacc[4 * q] += p.x; oacc[4 * q + 1] += p.y; oacc[4 * q + 2] += p.z; oacc[4 * q + 3] += p.w; }
    }
    asm volatile("" : "+s"(row)); const int lane2 = lane_id();
    const f32x4* x2 = (const f32x4*)((const float*)(ws + WS_X2) + (size_t)row * DM) + lane2;
    f32x4 xv[4]; float ss = 0.f;
#pragma unroll
    for (int q = 0; q < 4; ++q) { xv[q] = x2[64 * q]; xv[q].x += oacc[4 * q]; xv[q].y += oacc[4 * q + 1]; xv[q].z += oacc[4 * q + 2]; xv[q].w += oacc[4 * q + 3]; ss += (xv[q].x * xv[q].x + xv[q].y * xv[q].y) + (xv[q].z * xv[q].z + xv[q].w * xv[q].w); }
    const float r = rsqrtf(wave_sum(ss) * (1.f / DM) + EPS);
    const f32x4* gf = (const f32x4*)((const float*)a.in[I_GFIN]) + lane2;
    f32x4* y = (f32x4*)(row < TP ? a.out + O_YP + (size_t)row * DM : a.out + O_YS + (size_t)(row - TP) * DM) + lane2;
#pragma unroll
    for (int q = 0; q < 4; ++q) { const f32x4 g4 = gf[64 * q]; f32x4 o; o.x = xv[q].x * r * g4.x; o.y = xv[q].y * r * g4.y; o.z = xv[q].z * r * g4.z; o.w = xv[q].w * r * g4.w; y[64 * q] = o; }
}
__device__ __forceinline__ void cand_ij(int c, int& ci, int& cj) {
    if (c < 16) { ci = 0; cj = c; } else if (c < 24) { ci = 1; cj = c - 16; } else if (c < 29) { ci = 2; cj = c - 24; } else if (c < 33) { ci = 3; cj = c - 29; }
    else if (c < 36) { ci = 4; cj = c - 33; } else if (c < 38) { ci = 5; cj = c - 36; } else if (c < 40) { ci = 6; cj = c - 38; } else if (c < 42) { ci = 7; cj = c - 40; } else if (c < 50) { ci = c - 34; cj = 0; } else { ci = 0; cj = 0; }
}
__device__ __forceinline__ void peer_phase(const Frame& F, const Args& a) {
    LAS unsigned* TOPS = (LAS unsigned*)F.lds + F.wave * 256;
    LAS unsigned* CT = (LAS unsigned*)F.lds + 8 * 256 + 4 * 1024;
    if (F.tid < 64) { int ci, cj; cand_ij(F.tid, ci, cj); CT[F.tid] = (unsigned)ci | ((unsigned)cj << 8); }
    __syncthreads();
    const int gw = F.vcu * NWAVES + F.wave, NGW = F.G * NWAVES;
    const int nfull = TA / NGW, rem = TA - nfull * NGW;
#pragma unroll 1
    for (int i = 0; i < nfull; ++i) peer_token<false>(F, a, gw + i * NGW, TOPS, CT, 0, nullptr);
    if (rem == 4 * F.G) {
        __syncthreads();
        peer_token<true>(F, a, nfull * NGW + F.vcu * 4 + (F.wave >> 1), TOPS, CT, F.wave & 1, (LAS float*)F.lds + 8 * 256 + (F.wave >> 1) * 1024);
    } else {
        const int row = gw + nfull * NGW; if (row < TA) peer_token<false>(F, a, row, TOPS, CT, 0, nullptr);
    }
}


template <class EpiS>
__device__ __forceinline__ void skinny_tile(const Frame& F, const bf16* A, int lda, const bf16* Bt, int ldb, int tm, int tn, const EpiS& E) {
    const int lane = F.lane, fr = lane & 15, fq = lane >> 4, w = F.wave, lr = lane >> 3, lc = lane & 7;
    LAS unsigned char* SA = F.lds + w * 16384; LAS unsigned char* SB = SA + 8192;
    const bf16* ag = A + (size_t)(tm * 64 + lr) * lda + w * 128 + 8 * lc;
    const bf16* bg = Bt + (size_t)(tn * 64 + lr) * ldb + w * 128 + 8 * lc;
    f32x4 acc[4][4];
#pragma unroll
    for (int m = 0; m < 4; ++m)
#pragma unroll
        for (int n = 0; n < 4; ++n) acc[m][n] = (f32x4){0.f, 0.f, 0.f, 0.f};
    v4u ar[2][8], br[2][8];
#pragma unroll
    for (int kh = 0; kh < 2; ++kh)
#pragma unroll
        for (int i = 0; i < 8; ++i) { ar[kh][i] = *(const v4u*)(ag + (size_t)(8 * i) * lda + 64 * kh); br[kh][i] = *(const v4u*)(bg + (size_t)(8 * i) * ldb + 64 * kh); }
#pragma unroll
    for (int kh = 0; kh < 2; ++kh) {
#pragma unroll
        for (int i = 0; i < 8; ++i) { const int row = 8 * i + lr; *(LAS v4u*)(SA + row * 128 + ((lc ^ (row & 7)) << 4)) = ar[kh][i]; *(LAS v4u*)(SB + row * 128 + ((lc ^ (row & 7)) << 4)) = br[kh][i]; }
        bf16x8 af[4][2], bfr[4][2];
#pragma unroll
        for (int m = 0; m < 4; ++m)
#pragma unroll
            for (int ks = 0; ks < 2; ++ks) { const int row = 16 * m + fr; const int off = row * 128 + (((4 * ks + fq) ^ (row & 7)) << 4);
                af[m][ks] = *(const LAS bf16x8*)(SA + off); bfr[m][ks] = *(const LAS bf16x8*)(SB + off); }
#pragma unroll
        for (int ks = 0; ks < 2; ++ks)
#pragma unroll
            for (int m = 0; m < 4; ++m)
#pragma unroll
                for (int n = 0; n < 4; ++n) acc[m][n] = __builtin_amdgcn_mfma_f32_16x16x32_bf16(bfr[n][ks], af[m][ks], acc[m][n], 0, 0, 0);
        asm volatile("s_waitcnt lgkmcnt(0)" ::: "memory");
    }
    LAS float* PS = (LAS float*)F.lds + w * 4096;
#pragma unroll
    for (int m = 0; m < 4; ++m)
#pragma unroll
        for (int n = 0; n < 4; ++n) *(LAS f32x4*)(PS + (16 * m + fr) * 64 + 4 * ((4 * n + fq) ^ fr)) = acc[m][n];
    lds_barrier();
    {
        const int row = F.tid >> 3, c8 = (F.tid & 7) * 8; const LAS float* PR = (const LAS float*)F.lds + row * 64;
        const int ch0 = 4 * (((F.tid & 7) * 2) ^ (row & 15)), ch1 = 4 * (((F.tid & 7) * 2 + 1) ^ (row & 15));
        f32x4 s0 = *(const LAS f32x4*)(PR + ch0), s1 = *(const LAS f32x4*)(PR + ch1);
#pragma unroll
        for (int ww = 1; ww < 8; ++ww) { s0 += *(const LAS f32x4*)(PR + ww * 4096 + ch0); s1 += *(const LAS f32x4*)(PR + ww * 4096 + ch1); }
        float v[8] = {s0.x, s0.y, s0.z, s0.w, s1.x, s1.y, s1.z, s1.w};
        E(tm * 64 + row, tn * 64 + c8, v, F.tid);
    }
    lds_barrier();
}
struct EpiSk {
    float* d32; int ld32; bf16* d16; int ld16; float sc16;
    const float* res; int ldr;
    const float* gcol; float* ssq; const float* rsq;
    __device__ __forceinline__ void operator()(int row, int col, float (&v)[8], int tid) const {
        if (rsq) { const float rs = rsqrtf(rsq[row] * (1.f / 1024.f) + EPS);
#pragma unroll
            for (int i = 0; i < 8; ++i) v[i] *= rs; }
        if (res) { const f32x4 a = *(const f32x4*)(res + (size_t)row * ldr + col), b = *(const f32x4*)(res + (size_t)row * ldr + col + 4);
            v[0] += a.x; v[1] += a.y; v[2] += a.z; v[3] += a.w; v[4] += b.x; v[5] += b.y; v[6] += b.z; v[7] += b.w; }
        if (d32) { *(f32x4*)(d32 + (size_t)row * ld32 + col) = (f32x4){v[0], v[1], v[2], v[3]}; *(f32x4*)(d32 + (size_t)row * ld32 + col + 4) = (f32x4){v[4], v[5], v[6], v[7]}; }
        if (ssq) { float ss = 0.f;
#pragma unroll
            for (int i = 0; i < 8; ++i) ss += v[i] * v[i];
            ss = sum8_f32(ss);
            if ((tid & 7) == 0) atomicAdd(ssq + row, ss); }
        if (d16) { float w8[8];
#pragma unroll
            for (int i = 0; i < 8; ++i) w8[i] = v[i];
            if (gcol) { const f32x4 a = *(const f32x4*)(gcol + col), b = *(const f32x4*)(gcol + col + 4); w8[0] *= a.x; w8[1] *= a.y; w8[2] *= a.z; w8[3] *= a.w; w8[4] *= b.x; w8[5] *= b.y; w8[6] *= b.z; w8[7] *= b.w; }
            v4u o; o.x = pg8::cvt_pk_bf16(w8[0] * sc16, w8[1] * sc16); o.y = pg8::cvt_pk_bf16(w8[2] * sc16, w8[3] * sc16); o.z = pg8::cvt_pk_bf16(w8[4] * sc16, w8[5] * sc16); o.w = pg8::cvt_pk_bf16(w8[6] * sc16, w8[7] * sc16);
            *(v4u*)(d16 + (size_t)row * ld16 + col) = o; }
    }
};

#define SK_TM16(t) (4 * (((t) >> 5) >> 1) + (((t) & 31) >> 3))
#define SK_TN16(t) (8 * (((t) >> 5) & 1) + ((t) & 7))
#define SK_TM32(t) (4 * ((((t) & 255) >> 5) >> 1) + ((((t) & 31) + 32 * ((t) >> 8)) >> 4))
#define SK_TN32(t) (16 * ((((t) & 255) >> 5) & 1) + ((((t) & 31) + 32 * ((t) >> 8)) & 15))


#ifndef PH_MAX
#define PH_MAX 99
#endif
__global__ void __launch_bounds__(NTHR, 2) mega_fwd(Args args) {
    extern __shared__ __attribute__((aligned(16))) unsigned char lds_raw[];
    Frame F;
    F.lds = (LAS unsigned char*)lds_raw;
    F.wave = __builtin_amdgcn_readfirstlane((int)threadIdx.x >> 6); F.lane = lane_id(); F.tid = F.wave * 64 + F.lane;
    F.G = gridDim.x; { const int bx = blockIdx.x; F.vcu = (F.G % 8 == 0) ? (bx % 8) * (F.G / 8) + bx / 8 : bx; }
    volatile LAS unsigned* MISC = (volatile LAS unsigned*)(F.lds + MISC_OFF);
    LAS unsigned long long* ARGP = (LAS unsigned long long*)(F.lds + ARGS_OFF);
    for (int u = F.tid; u < (LDS_BYTES - LDSCTL_OFF) / 4; u += NTHR) ((LAS unsigned*)(F.lds + LDSCTL_OFF))[u] = 0u;
    __syncthreads();
    if (F.tid == 0) {
        ARGP[0] = (unsigned long long)args.in[0];
        ARGP[1] = (unsigned long long)args.in[1];
        ARGP[2] = (unsigned long long)args.in[2];
        ARGP[3] = (unsigned long long)args.in[3];
        ARGP[4] = (unsigned long long)args.in[4];
        ARGP[5] = (unsigned long long)args.in[5];
        ARGP[6] = (unsigned long long)args.in[6];
        ARGP[7] = (unsigned long long)args.in[7];
        ARGP[8] = (unsigned long long)args.in[8];
        ARGP[9] = (unsigned long long)args.in[9];
        ARGP[10] = (unsigned long long)args.in[10];
        ARGP[11] = (unsigned long long)args.in[11];
        ARGP[12] = (unsigned long long)args.in[12];
        ARGP[13] = (unsigned long long)args.in[13];
        ARGP[14] = (unsigned long long)args.in[14];
        ARGP[15] = (unsigned long long)args.in[15];
        ARGP[16] = (unsigned long long)args.in[16];
        ARGP[17] = (unsigned long long)args.in[17];
        ARGP[18] = (unsigned long long)args.in[18];
        ARGP[19] = (unsigned long long)args.in[19];
        ARGP[20] = (unsigned long long)args.in[20];
        ARGP[21] = (unsigned long long)args.in[21];
        ARGP[22] = (unsigned long long)args.in[22];
        ARGP[23] = (unsigned long long)args.in[23];
        ARGP[24] = (unsigned long long)args.in[24];
        ARGP[25] = (unsigned long long)args.in[25];
        ARGP[26] = (unsigned long long)args.in[26];
        ARGP[27] = (unsigned long long)args.in[27];
        ARGP[28] = (unsigned long long)args.in[28];
        ARGP[N_INPUTS] = (unsigned long long)args.out; ARGP[N_INPUTS + 1] = (unsigned long long)args.ws;
    }
    __syncthreads();
    { const XcdBarrier bar0 = xcd_barrier_post((unsigned*)((gu32*)(args.ws + WS_CTL) + CW_BAR), MISC + 8, F.wave); if (F.tid == 0) MISC[10] = bar0.x; }
    __syncthreads();
#define GRID_BAR() do { XcdBarrier bar_; bar_.bar = (unsigned*)((gu32*)((unsigned char*)ld_ptr(ARGP + N_INPUTS + 1) + WS_CTL) + CW_BAR); bar_.x = MISC[10]; bar_.st = MISC + 8; bar_.wave = F.wave; xcd_barrier(bar_); } while (0)
#define PHASE_ARGS const Args A = load_args(ARGP); unsigned char* const ws = A.ws; float* const out = A.out; (void)ws; (void)out; { int l_ = lane_id(); asm volatile("" : "+v"(l_)); F.lane = l_; F.tid = F.wave * 64 + l_; }

    { PHASE_ARGS;
    p0_prologue(F, A);
    }
    GRID_BAR();
#if defined(PROBE_BAR8)
    GRID_BAR(); GRID_BAR(); GRID_BAR(); GRID_BAR(); GRID_BAR(); GRID_BAR(); GRID_BAR(); GRID_BAR();
#endif
#if PH_MAX >= 1
    { PHASE_ARGS;
    {
        pg8::Gemm g{(const bf16*)(ws + WS_HB), (const bf16*)(ws + WS_WIN), DM, DM, DM};
        pg8::StaticOrder S; S.init(TA, N_IN, F.G, (int)blockIdx.x);
        EpiInProj E{out, ws, (const float*)A.in[I_BFF]};
        pg8::gemm_phase(F.lds, g, S, E, F.wave);
    }
    {
        const int off = (TA / 256) * (N_IN / 256) % F.G;
        pg8::Gemm g{(const bf16*)(ws + WS_MB), (const bf16*)(ws + WS_WMK), DM, DM, DM};
        pg8::StaticOrder S; S.init(512, DM, F.G, ((int)blockIdx.x + F.G - off) % F.G);
        EpiGen E{out + O_MKP, DM, (bf16*)(ws + WS_MK16), DM, 1.f, nullptr, nullptr, 0, 0, nullptr, nullptr, nullptr};
        pg8::gemm_phase(F.lds, g, S, E, F.wave);
    }
    {
        const int off = ((TA / 256) * (N_IN / 256) + 8) % F.G;
        pg8::Gemm g{(const bf16*)(ws + WS_MB), (const bf16*)(ws + WS_WMV), DM, DM, DM};
        pg8::StaticOrder S; S.init(512, DM, F.G, ((int)blockIdx.x + F.G - off) % F.G);
        EpiGen E{out + O_MVP, DM, nullptr, 0, 1.f, nullptr, nullptr, 0, 0, nullptr, nullptr, nullptr};
        pg8::gemm_phase(F.lds, g, S, E, F.wave);
    }
    {
        const int off = ((TA / 256) * (N_IN / 256) + 16) % F.G;
        pg8::Gemm g{(const bf16*)(ws + WS_WMV), (const bf16*)(ws + WS_MB), DM, DM, DM};
        pg8::StaticOrder S; S.init(DM, 512, F.G, ((int)blockIdx.x + F.G - off) % F.G);
        EpiGen E{nullptr, 0, (bf16*)(ws + WS_MVT16), 512, 1.f, nullptr, nullptr, 0, 0, nullptr, nullptr, nullptr};
        pg8::gemm_phase(F.lds, g, S, E, F.wave);
    }
    }
    GRID_BAR();
#endif
#if PH_MAX >= 2
    asm volatile("; ===PHASE 2===");
    { PHASE_ARGS;
    {
        const int gw = F.vcu * NWAVES + F.wave, NGW = F.G * NWAVES;
        if ((gw & 3) == 0) for (int it = gw >> 2; it < 512; it += NGW >> 2) fox_norms_item(F, (const bf16*)(ws + WS_QF), (const bf16*)(ws + WS_KF), out + O_LFP, (float*)(ws + WS_MISC + MiB), (float*)(ws + WS_KBIAS), (float*)(ws + WS_MISC + MiB + 65536), it);
        for (int it = gw; it < NB_S * NPAGES; it += NGW) fox_suffix_item(F, (const float*)A.in[I_CFL], (const int*)A.in[I_PT], (float*)(ws + WS_SUF), (float*)(ws + WS_MISC + 2 * MiB), it);
        for (int u = F.vcu; u < 1024; u += F.G) gla_g1_unit(F, A, u);
        for (int u = F.vcu; u < 512; u += F.G) gla_sample_unit(F, A, u);
    }
    }
    GRID_BAR();
#endif
#if PH_MAX >= 3
    asm volatile("; ===PHASE 3===");
    { PHASE_ARGS;
    gla_scan(F, A);
    __syncthreads();
    for (int i = F.vcu; i < 256; i += F.G) { const int bh = i >> 4, s = i & 15;
        fox_attn_unit(F, (const bf16*)(ws + WS_QF), (const bf16*)(ws + WS_KF), (const bf16*)(ws + WS_VF), (const float*)(ws + WS_KBIAS), (const float*)(ws + WS_MISC + MiB + 65536), (const float*)(ws + WS_MISC + MiB), (bf16*)(ws + WS_MERGED), bh >> 3, bh & 7, s);
        fox_attn_unit(F, (const bf16*)(ws + WS_QF), (const bf16*)(ws + WS_KF), (const bf16*)(ws + WS_VF), (const float*)(ws + WS_KBIAS), (const float*)(ws + WS_MISC + MiB + 65536), (const float*)(ws + WS_MISC + MiB), (bf16*)(ws + WS_MERGED), bh >> 3, bh & 7, 31 - s); }
    }
    GRID_BAR();
#endif
#if PH_MAX >= 4
    asm volatile("; ===PHASE 4===");
    { PHASE_ARGS;
    if (!(F.vcu & 1)) { for (int u = F.vcu; u < 1024; u += F.G) gla_g3_unit(F, A, u); }
    }
    { PHASE_ARGS;
    for (int u = F.vcu; u < 1024; u += F.G) fox_sample_unit(F, A, u);
    }
    { PHASE_ARGS;
    if (F.vcu & 1) { for (int u = F.vcu; u < 1024; u += F.G) gla_g3_unit(F, A, u); }
    }
    GRID_BAR();
#endif
#if PH_MAX >= 5
    asm volatile("; ===PHASE 5===");
    { PHASE_ARGS;
    {
        pg8::Gemm g{(const bf16*)(ws + WS_MERGED), (const bf16*)(ws + WS_WOUT), DM, DM, DM};
        pg8::StaticOrder S; S.init(TP, DM, F.G, (int)blockIdx.x);
        EpiGen E{(float*)(ws + WS_X1), DM, (bf16*)(ws + WS_HB), DM, 1.f, (const float*)A.in[I_XP], (const float*)A.in[I_XS], TP, DM, (const float*)A.in[I_GCROSS], (float*)(ws + WS_SS), nullptr};
        pg8::gemm_phase(F.lds, g, S, E, F.wave);
        __syncthreads();
        EpiSk Es{(float*)(ws + WS_X1) + (size_t)TP * DM, DM, (bf16*)(ws + WS_HB) + (size_t)TP * DM, DM, 1.f, (const float*)A.in[I_XS], DM, (const float*)A.in[I_GCROSS], (float*)(ws + WS_SS) + TP, nullptr};
        for (int t = F.vcu; t < 256; t += F.G) skinny_tile(F, (const bf16*)(ws + WS_MERGED) + (size_t)TP * DM, DM, (const bf16*)(ws + WS_WOUT), DM, SK_TM16(t), SK_TN16(t), Es);
    }
    }
    GRID_BAR();
#endif
#if PH_MAX >= 7
    asm volatile("; ===PHASE 7===");
    { PHASE_ARGS;
    {
        pg8::Gemm g{(const bf16*)(ws + WS_HB), (const bf16*)(ws + WS_WCQ), DM, DM, DM};
        pg8::StaticOrder S; S.init(TP, DM, F.G, (int)blockIdx.x);
        EpiGen E{nullptr, 0, (bf16*)(ws + WS_QC), DM, C2C, nullptr, nullptr, 0, 0, nullptr, nullptr, (const float*)(ws + WS_SS)};
        pg8::gemm_phase(F.lds, g, S, E, F.wave);
        __syncthreads();
        EpiSk Es{nullptr, 0, (bf16*)(ws + WS_QC) + (size_t)TP * DM, DM, C2C, nullptr, 0, nullptr, nullptr, (const float*)(ws + WS_SS) + TP};
        for (int t = F.vcu; t < 256; t += F.G) skinny_tile(F, (const bf16*)(ws + WS_HB) + (size_t)TP * DM, DM, (const bf16*)(ws + WS_WCQ), DM, SK_TM16(t), SK_TN16(t), Es);
    }
    }
    GRID_BAR();
#endif
#if PH_MAX >= 8
    asm volatile("; ===PHASE 8===");
    { PHASE_ARGS;
    {
        const int u = (int)blockIdx.x, b = (u >> 7) & 1, h = (u >> 5) & 3, pnl = u & 31;
        const size_t roff = ((size_t)b * SEQ + pnl * 256) * DM + h * 256;
        if (F.vcu & 1) { for (int v = F.vcu; v < 512; v += F.G) cross_sample_unit(F, A, v); }
        pg8::Gemm g{(const bf16*)(ws + WS_QC) + roff, (const bf16*)(ws + WS_MK16) + (size_t)(b * 256) * DM + h * 256, DM, DM, 256};
        pg8::SingleUnit S{u < 256 ? 1 : 0, {0, 0}};
        EpiSoftmaxP E{ARGP};
        pg8::gemm_phase(F.lds, g, S, E, F.wave);
        VM_WAIT(); __syncthreads();
        {
            pg8::Gemm g2{(const bf16*)(ws + WS_PC) + roff, (const bf16*)(ws + WS_MVT16) + (size_t)(h * 256) * 512 + b * 256, DM, 512, 256};
            EpiGen E2{nullptr, 0, (bf16*)(ws + WS_OC) + roff, DM, 1.f, nullptr, nullptr, 0, 0, nullptr, nullptr, nullptr};
            pg8::gemm_phase(F.lds, g2, S, E2, F.wave);
        }
        __syncthreads();
        if (!(F.vcu & 1)) { for (int v = F.vcu; v < 512; v += F.G) cross_sample_unit(F, A, v); }
    }
    }
    GRID_BAR();
#endif
#if PH_MAX >= 10
    asm volatile("; ===PHASE 10===");
    { PHASE_ARGS;
    {
        pg8::Gemm g{(const bf16*)(ws + WS_OC), (const bf16*)(ws + WS_WCO), DM, DM, DM};
        pg8::StaticOrder S; S.init(TP, DM, F.G, (int)blockIdx.x);
        EpiGen E{(float*)(ws + WS_X2), DM, (bf16*)(ws + WS_HB), DM, 1.f, (const float*)(ws + WS_X1), (const float*)(ws + WS_X1), TA, DM, (const float*)A.in[I_GFFN], (float*)(ws + WS_SS) + TA, nullptr};
        pg8::gemm_phase(F.lds, g, S, E, F.wave);
        __syncthreads();
        EpiSk Es{(float*)(ws + WS_X2) + (size_t)TP * DM, DM, (bf16*)(ws + WS_HB) + (size_t)TP * DM, DM, 1.f, (const float*)(ws + WS_X1) + (size_t)TP * DM, DM, (const float*)A.in[I_GFFN], (float*)(ws + WS_SS) + TA + TP, nullptr};
        for (int t = F.vcu; t < 256; t += F.G) skinny_tile(F, (const bf16*)(ws + WS_OC) + (size_t)TP * DM, DM, (const bf16*)(ws + WS_WCO), DM, SK_TM16(t), SK_TN16(t), Es);
    }
    }
    GRID_BAR();
#endif
#if PH_MAX >= 12
    asm volatile("; ===PHASE 12===");
    { PHASE_ARGS;
    {
        pg8::Gemm g{(const bf16*)(ws + WS_HB), (const bf16*)(ws + WS_WPK), DM, DM, DM};
        pg8::StaticOrder S; S.init(TP, 2048, F.G, (int)blockIdx.x);
        EpiGen E{nullptr, 0, (bf16*)(ws + WS_SC), 2048, 1.f, nullptr, nullptr, 0, 0, nullptr, nullptr, (const float*)(ws + WS_SS) + TA};
        pg8::gemm_phase(F.lds, g, S, E, F.wave);
        __syncthreads();
        EpiSk Es{nullptr, 0, (bf16*)(ws + WS_SC) + (size_t)TP * 2048, 2048, 1.f, nullptr, 0, nullptr, nullptr, (const float*)(ws + WS_SS) + TA + TP};
        for (int t = F.vcu; t < 512; t += F.G) skinny_tile(F, (const bf16*)(ws + WS_HB) + (size_t)TP * DM, DM, (const bf16*)(ws + WS_WPK), DM, SK_TM32(t), SK_TN32(t), Es);
    }
    }
    GRID_BAR();
#endif
#if PH_MAX >= 13
    asm volatile("; ===PHASE 13===");
    { PHASE_ARGS;
    peer_phase(F, A);
    }
#endif
#if PH_MAX < 13
    {   PHASE_ARGS;
        const int gw = F.vcu * NWAVES + F.wave, NGW = F.G * NWAVES;
        for (int m = gw; m < TA; m += NGW) {
            const float* x = m < TP ? (const float*)A.in[I_XP] + (size_t)m * DM : (const float*)A.in[I_XS] + (size_t)(m - TP) * DM;
            float* y = m < TP ? out + O_YP + (size_t)m * DM : out + O_YS + (size_t)(m - TP) * DM;
            for (int j = 0; j < 4; ++j) ((f32x4*)y)[F.lane + 64 * j] = ((const f32x4*)x)[F.lane + 64 * j];
        }
    }
#endif

}

extern "C" void kernel_launch(void* const* d_in, const int* in_sizes, int n_in, void* d_out, int out_size, void* d_ws, size_t ws_size, hipStream_t stream) {
    static int grid = 0;
    if (grid == 0) {
        if (n_in != N_INPUTS || (size_t)out_size != O_TOTAL || ws_size < WS_END) { fprintf(stderr, "kernel_launch: unexpected shapes (n_in %d out %d ws %zu)\n", n_in, out_size, ws_size); grid = -1; return; }
        int dev = 0, cus = 0, per_cu = 0;
        if (hipGetDevice(&dev) != hipSuccess || hipDeviceGetAttribute(&cus, hipDeviceAttributeMultiprocessorCount, dev) != hipSuccess) { grid = -1; return; }
        if (hipFuncSetAttribute((const void*)mega_fwd, hipFuncAttributeMaxDynamicSharedMemorySize, LDS_BYTES) != hipSuccess) { fprintf(stderr, "kernel_launch: hipFuncSetAttribute failed\n"); grid = -1; return; }
        if (hipOccupancyMaxActiveBlocksPerMultiprocessor(&per_cu, (const void*)mega_fwd, NTHR, LDS_BYTES) != hipSuccess || per_cu < 1)
            fprintf(stderr, "kernel_launch: occupancy query reports %d workgroups per CU\n", per_cu);
        (void)hipGetLastError();
        grid = cus;
        if (grid > 256) grid = 256;
    }
    if (grid < 0) return;
    if (hipMemsetAsync((char*)d_ws + WS_CTL, 0, CTL_ZERO_BYTES, stream) != hipSuccess) return;
    Args a{};
    for (int i = 0; i < N_INPUTS; ++i) a.in[i] = d_in[i];
    a.out = (float*)d_out; a.ws = (unsigned char*)d_ws;
    hipLaunchKernelGGL(mega_fwd, dim3(grid), dim3(NTHR), LDS_BYTES, stream, a);
    const hipError_t le = hipPeekAtLastError();
    if (le != hipSuccess) fprintf(stderr, "kernel_launch: launch failed: %s\n", hipGetErrorName(le));
}
```

```cpp
#define PH_MAX 13
#include <hip/hip_runtime.h>
#include <cstdio>
#include <cstdint>

namespace pg8 {
#define PG8_LAS __attribute__((address_space(3)))
typedef unsigned short bf16_t;
typedef short bf16x8 __attribute__((ext_vector_type(8)));
typedef float f32x4 __attribute__((ext_vector_type(4)));
typedef unsigned u32x4 __attribute__((ext_vector_type(4)));
typedef unsigned u32x2 __attribute__((ext_vector_type(2)));
constexpr int BM = 256, BK = 64, HALF = 128, HTB = HALF * BK * 2  , STAGE_BYTES = 8 * HTB, NXCD = 8, WGM = 8;

__host__ __device__ __forceinline__ int lds_byte(int r, int c) { const int st = (r >> 4) * 2 + (c >> 5), rr = r & 15, cc = c & 31, ob = rr * 64 + cc * 2; return st * 1024 + (ob ^ (((ob >> 9) & 1) << 5)); }
__host__ __device__ __forceinline__ void stage_rc(int b, int& R, int& C) { const int st = b / 1024, sb = b % 1024, swz = sb ^ (((sb >> 9) & 1) << 5); R = (st >> 1) * 16 + swz / 64; C = (st & 1) * 32 + (swz % 64) / 2; }

__host__ __device__ __forceinline__ int perm32(int rho) { const int n = rho >> 4, i = rho & 15; return 8 * (i >> 2) + 4 * n + (i & 3); }

struct Unit { int pm, pn; };
struct Gemm { const bf16_t* A; const bf16_t* Bt; int lda, ldb, K; };

struct StaticOrder {
    int nM, nN, nwg, G, c;
    __host__ __device__ void init(int M, int N, int G_, int c_) { nM = M / BM; nN = N / BM; nwg = nM * nN; G = G_; c = c_; }
    __host__ __device__ bool next(int i, Unit& u) const {
        const long L = (long)i * G + c; if (L >= nwg) return false;
        int wgid = (int)L; { const int q = nwg / NXCD, r = nwg % NXCD, xcd = wgid % NXCD, off = wgid / NXCD; wgid = (xcd < r ? xcd * (q + 1) : r * (q + 1) + (xcd - r) * q) + off; }
        const int nig = WGM * nN, gid = wgid / nig, fm = gid * WGM, gsz = (nM - fm) < WGM ? (nM - fm) : WGM;
        u.pm = fm + ((wgid % nig) % gsz); u.pn = (wgid % nig) / gsz; return true;
    }
};
struct SingleUnit {
    int has; Unit u0;
    __host__ __device__ bool next(int i, Unit& u) const { if (i != 0 || !has) return false; u = u0; return true; }
};

__device__ __forceinline__ unsigned cvt_pk_bf16(float lo, float hi) { unsigned r; asm volatile("v_cvt_pk_bf16_f32 %0, %1, %2" : "=v"(r) : "v"(lo), "v"(hi)); return r; }

template <class Epi, class Sched>
__device__ __forceinline__ void gemm_phase(PG8_LAS unsigned char* lds, const Gemm g, const Sched& S, const Epi& E, int wave_id) {
    int lane; asm volatile("v_mbcnt_lo_u32_b32 %0, -1, 0\n\tv_mbcnt_hi_u32_b32 %0, -1, %0" : "=v"(lane));
    const int wid = wave_id; const int tid = wid * 64 + lane; const int wr = wid >> 2, wc = wid & 3, fr = lane & 15, fq = lane >> 4;
    const int K = g.K, nt = K / BK;
    unsigned voffA[2], voffB[2];
#pragma unroll
    for (int i = 0; i < 2; ++i) { int R, C; stage_rc(tid * 16 + i * 8192, R, C);
        const int Rb = Epi::PERM ? ((R & ~31) + perm32(R & 31)) : R;
        voffA[i] = (unsigned)(R * g.lda + C) * 2u; voffB[i] = (unsigned)(Rb * g.ldb + C) * 2u; }
    const size_t kstep = (size_t)(BK * 2);
    const size_t hstepA = (size_t)HALF * g.lda * 2, hstepB = (size_t)HALF * g.ldb * 2;
    const size_t tstepA = 2 * hstepA, tstepB = 2 * hstepB;
    const unsigned ldsw = (unsigned)wid * 1024u;
    const int aoff = lds_byte(wr * 64 + fr, fq * 8), boff = lds_byte(wc * 32 + fr, fq * 8);
#define PG8_SA(b, h) (((b) * 2 + (h)) * HTB)
#define PG8_SB(b, h) ((4 + (b) * 2 + (h)) * HTB)
#define PG8_STAGE(bufoff, gbase, voff) do { _Pragma("unroll") for (int _i = 0; _i < 2; ++_i) \
        __builtin_amdgcn_global_load_lds((const unsigned*)((const char*)(gbase) + (voff)[_i]), (PG8_LAS unsigned*)(lds + (bufoff) + ldsw + _i * 8192), 16, 0, 0); } while (0)
#define PG8_LDA(dst, b, h) do { _Pragma("unroll") for (int m = 0; m < 4; ++m) _Pragma("unroll") for (int k = 0; k < 2; ++k) dst[m][k] = *(const PG8_LAS bf16x8*)(lds + PG8_SA(b, h) + aoff + m * 2048 + k * 1024); } while (0)
#define PG8_LDB(dst, b, h) do { _Pragma("unroll") for (int n = 0; n < 2; ++n) _Pragma("unroll") for (int k = 0; k < 2; ++k) dst[n][k] = *(const PG8_LAS bf16x8*)(lds + PG8_SB(b, h) + boff + n * 2048 + k * 1024); } while (0)
#define PG8_MMA(ai, bj, At, Bt) do { __builtin_amdgcn_s_setprio(1); _Pragma("unroll") for (int m = 0; m < 4; ++m) _Pragma("unroll") for (int n = 0; n < 2; ++n) _Pragma("unroll") for (int k = 0; k < 2; ++k) \
        acc[ai][bj][m][n] = __builtin_amdgcn_mfma_f32_16x16x32_bf16(Bt[n][k], At[m][k], acc[ai][bj][m][n], 0, 0, 0); __builtin_amdgcn_s_setprio(0); } while (0)
#define PG8_WAIT_V(n) asm volatile("s_waitcnt vmcnt(" #n ")" ::: "memory")
#define PG8_WAIT_L(n) asm volatile("s_waitcnt lgkmcnt(" #n ")" ::: "memory")
#define PG8_BAR __builtin_amdgcn_s_barrier()
#define PG8_SCHED __builtin_amdgcn_sched_barrier(0)
    Unit cur, nxt; int ui = 0;
    if (!S.next(0, cur)) return;
    f32x4 acc[2][2][4][2];
#pragma unroll
    for (int a = 0; a < 2; ++a)
#pragma unroll
        for (int b = 0; b < 2; ++b)
#pragma unroll
            for (int m = 0; m < 4; ++m)
#pragma unroll
                for (int n = 0; n < 2; ++n) acc[a][b][m][n] = (f32x4){0.f, 0.f, 0.f, 0.f};
    bf16x8 At[4][2], B0[2][2], B1[2][2];
    const char* cA = (const char*)g.A + (size_t)cur.pm * tstepA; const char* cB = (const char*)g.Bt + (size_t)cur.pn * tstepB;
    PG8_STAGE(PG8_SB(0, 0), cB, voffB); PG8_STAGE(PG8_SB(0, 1), cB + hstepB, voffB); PG8_STAGE(PG8_SA(0, 0), cA, voffA); PG8_STAGE(PG8_SA(0, 1), cA + hstepA, voffA);
    if (wr == 1) PG8_BAR;
    PG8_WAIT_V(2); PG8_BAR;
    PG8_STAGE(PG8_SB(1, 0), cB + kstep, voffB); PG8_STAGE(PG8_SA(1, 0), cA + kstep, voffA); PG8_STAGE(PG8_SB(1, 1), cB + hstepB + kstep, voffB);
    PG8_WAIT_V(6); PG8_BAR;
    for (;;) {
        const bool has_next = S.next(ui + 1, nxt);
        const char* nA = has_next ? (const char*)g.A + (size_t)nxt.pm * tstepA : cA; const char* nB = has_next ? (const char*)g.Bt + (size_t)nxt.pn * tstepB : cB;
        for (int t = 0; t < nt; t += 2) {
            const bool last = (t == nt - 2);
            const char* a1 = cA + (size_t)(t + 1) * kstep;
            const char* a2 = last ? nA : cA + (size_t)(t + 2) * kstep; const char* b2 = last ? nB : cB + (size_t)(t + 2) * kstep;
            const char* a3 = a2 + kstep; const char* b3 = b2 + kstep;
            PG8_LDB(B0, 0, 0); PG8_LDB(B1, 0, 1); PG8_SCHED; PG8_LDA(At, 0, 0); PG8_STAGE(PG8_SA(1, 1), a1 + hstepA, voffA);
            PG8_WAIT_V(8); PG8_WAIT_L(0); PG8_BAR; PG8_MMA(0, 0, At, B0); PG8_MMA(0, 1, At, B1); PG8_BAR; PG8_SCHED;
            PG8_LDA(At, 0, 1); PG8_STAGE(PG8_SB(0, 0), b2, voffB); PG8_STAGE(PG8_SB(0, 1), b2 + hstepB, voffB); PG8_STAGE(PG8_SA(0, 0), a2, voffA);
            PG8_WAIT_V(8); PG8_WAIT_L(0); PG8_BAR; PG8_MMA(1, 0, At, B0); PG8_MMA(1, 1, At, B1); PG8_BAR; PG8_SCHED;
            PG8_LDB(B0, 1, 0); PG8_LDB(B1, 1, 1); PG8_SCHED; PG8_LDA(At, 1, 0); PG8_STAGE(PG8_SA(0, 1), a2 + hstepA, voffA);
            PG8_WAIT_V(8); PG8_WAIT_L(0); PG8_BAR; PG8_MMA(0, 0, At, B0); PG8_MMA(0, 1, At, B1); PG8_BAR; PG8_SCHED;
            PG8_LDA(At, 1, 1); PG8_STAGE(PG8_SB(1, 0), b3, voffB); PG8_STAGE(PG8_SB(1, 1), b3 + hstepB, voffB); PG8_STAGE(PG8_SA(1, 0), a3, voffA);
            PG8_WAIT_V(8); PG8_WAIT_L(0); PG8_BAR; PG8_MMA(1, 0, At, B0); PG8_MMA(1, 1, At, B1); PG8_BAR; PG8_SCHED;
        }
        if (wr == 0) PG8_BAR;
        if constexpr (!Epi::AFTER_DRAIN) { E(acc, cur, wr, wc, fr, fq); }
        if (!has_next) break;
#pragma unroll
        for (int a = 0; a < 2; ++a)
#pragma unroll
            for (int b = 0; b < 2; ++b)
#pragma unroll
                for (int m = 0; m < 4; ++m)
#pragma unroll
                    for (int n = 0; n < 2; ++n) acc[a][b][m][n] = (f32x4){0.f, 0.f, 0.f, 0.f};
        cur = nxt; cA = nA; cB = nB; ++ui;
        if (wr == 1) PG8_BAR;
    }
    PG8_WAIT_V(0);
    PG8_BAR;
    if constexpr (Epi::AFTER_DRAIN) { E.fused(acc, cur, wr, wc, fr, fq, lds, wid, lane); }
#undef PG8_SA
#undef PG8_SB
#undef PG8_STAGE
#undef PG8_LDA
#undef PG8_LDB
#undef PG8_MMA
#undef PG8_WAIT_V
#undef PG8_WAIT_L
#undef PG8_BAR
#undef PG8_SCHED
}
}

#define GAS __attribute__((address_space(1)))
#define LAS __attribute__((address_space(3)))
typedef unsigned short bf16;
typedef unsigned v4u __attribute__((ext_vector_type(4)));
typedef unsigned v2u __attribute__((ext_vector_type(2)));
typedef float f32x4 __attribute__((ext_vector_type(4)));
typedef float f32x2 __attribute__((ext_vector_type(2)));
typedef float f32x16 __attribute__((ext_vector_type(16)));
typedef short bf16x8 __attribute__((ext_vector_type(8)));
typedef short s16x4 __attribute__((ext_vector_type(4)));
typedef GAS unsigned gu32;
#define RLX_AGENT __ATOMIC_RELAXED, __HIP_MEMORY_SCOPE_AGENT
#define LDS_WAIT() asm volatile("s_waitcnt lgkmcnt(0)" ::: "memory")
#define VM_WAIT() asm volatile("s_waitcnt vmcnt(0)" ::: "memory")
__device__ __forceinline__ unsigned f2bf(float f) { unsigned u = __builtin_bit_cast(unsigned, f); return (u + 0x7fffu + ((u >> 16) & 1u)) >> 16; }
__device__ __forceinline__ unsigned pk2(float lo, float hi) { return f2bf(lo) | (f2bf(hi) << 16); }
__device__ __forceinline__ float bf2f(unsigned short b) { return __builtin_bit_cast(float, (unsigned)b << 16); }
__device__ __forceinline__ float bflo(unsigned u) { return __builtin_bit_cast(float, u << 16); }
__device__ __forceinline__ float bfhi(unsigned u) { return __builtin_bit_cast(float, u & 0xffff0000u); }


typedef short v4i16_t __attribute__((ext_vector_type(4)));
__device__ __forceinline__ s16x4 lds_tr16(LAS unsigned char* p) { return __builtin_bit_cast(s16x4, __builtin_amdgcn_ds_read_tr16_b64_v4i16((LAS v4i16_t*)p)); }
__device__ __forceinline__ int crow(int r, int hi) { return (r & 3) + 8 * (r >> 2) + 4 * hi; }

#define DPP_I(v, ctrl) __builtin_amdgcn_update_dpp(0, (v), (ctrl), 0xF, 0xF, false)
#define DPP_F(v, ctrl) __builtin_bit_cast(float, __builtin_amdgcn_update_dpp(0, __builtin_bit_cast(int, (v)), (ctrl), 0xF, 0xF, false))
constexpr int DPP_X1 = 0xB1, DPP_X2 = 0x4E, DPP_HMIR = 0x141, DPP_MIR = 0x140;
__device__ __forceinline__ unsigned max16_u32(unsigned v) {
    unsigned t = (unsigned)DPP_I((int)v, DPP_X1); v = v > t ? v : t; t = (unsigned)DPP_I((int)v, DPP_X2); v = v > t ? v : t;
    t = (unsigned)DPP_I((int)v, DPP_HMIR); v = v > t ? v : t; t = (unsigned)DPP_I((int)v, DPP_MIR); v = v > t ? v : t; return v; }
__device__ __forceinline__ float sum8_f32(float v) { v += DPP_F(v, DPP_X1); v += DPP_F(v, DPP_X2); v += DPP_F(v, DPP_HMIR); return v; }
__device__ __forceinline__ float sum16_f32(float v) { v = sum8_f32(v); v += DPP_F(v, DPP_MIR); return v; }
__device__ __forceinline__ float max16_f32(float v) { v = fmaxf(v, DPP_F(v, DPP_X1)); v = fmaxf(v, DPP_F(v, DPP_X2)); v = fmaxf(v, DPP_F(v, DPP_HMIR)); v = fmaxf(v, DPP_F(v, DPP_MIR)); return v; }
__device__ __forceinline__ float xor16_f32(float v) { return __builtin_bit_cast(float, __builtin_amdgcn_ds_swizzle(__builtin_bit_cast(int, v), 0x1F | (16 << 10))); }
__device__ __forceinline__ float sum64_f32(float v) {
    v = sum16_f32(v); v += xor16_f32(v);
    return __builtin_bit_cast(float, __builtin_amdgcn_readlane(__builtin_bit_cast(int, v), 0)) + __builtin_bit_cast(float, __builtin_amdgcn_readlane(__builtin_bit_cast(int, v), 32)); }
template <int J> __device__ __forceinline__ unsigned xchg_xor_u32(unsigned v) {
    if constexpr (J == 1) return (unsigned)DPP_I((int)v, DPP_X1);
    else if constexpr (J == 2) return (unsigned)DPP_I((int)v, DPP_X2);
    else return (unsigned)__builtin_amdgcn_ds_swizzle((int)v, 0x1F | (J << 10)); }

template <int SB>
__device__ __forceinline__ bf16x8 tr_frag(LAS unsigned char* base, int ks) {
    const s16x4 lo = lds_tr16(base + ks * 16 * SB), hi4 = lds_tr16(base + ks * 16 * SB + 8 * SB);
    return (bf16x8){lo[0], lo[1], lo[2], lo[3], hi4[0], hi4[1], hi4[2], hi4[3]};
}
__device__ __forceinline__ bf16x8 row_frag(const LAS unsigned char* rowp, int ks, int hi) {
    const v2u lo = *(const LAS v2u*)(rowp + (16 * ks + 4 * hi) * 2), hi2 = *(const LAS v2u*)(rowp + (16 * ks + 8 + 4 * hi) * 2);
    return __builtin_bit_cast(bf16x8, (v4u){lo.x, lo.y, hi2.x, hi2.y});
}
__device__ __forceinline__ void lds_barrier() { asm volatile("s_waitcnt lgkmcnt(0)\n\ts_barrier" ::: "memory"); }

struct BfPtr { const unsigned short* p; __device__ __forceinline__ float operator[](size_t i) const { return __builtin_bit_cast(float, (unsigned)p[i] << 16); }
               __device__ __forceinline__ BfPtr operator+(size_t o) const { return BfPtr{p + o}; } };
#define GLD(ptr) (BfPtr{(const unsigned short*)(ptr)})

__device__ __forceinline__ int lane_id() { int r; asm volatile("v_mbcnt_lo_u32_b32 %0, -1, 0\n\tv_mbcnt_hi_u32_b32 %0, -1, %0" : "=v"(r)); return r; }
#define TID_IS_ZERO(wave_) ((wave_) == 0 && lane_id() == 0)
#define XB_TMO      128
#define XB_XCNT(j)  (256  + 64 * (j))
#define XB_XSUB(j)  (1280 + 64 * (j))
#define XB_XGEN(j)  (2304 + 64 * (j))
#define XB_TOP      3328
#define XB_TOPGEN   3392
#define XCD_BAR_WORDS 3456
#define XB_SPIN_CAP (1u << 18)

__device__ __forceinline__ unsigned xb_ld(unsigned* p)              { return __hip_atomic_load(p, __ATOMIC_RELAXED, __HIP_MEMORY_SCOPE_AGENT); }
__device__ __forceinline__ unsigned xb_add(unsigned* p, unsigned v) { return __hip_atomic_fetch_add(p, v, __ATOMIC_RELAXED, __HIP_MEMORY_SCOPE_AGENT); }
__device__ __forceinline__ unsigned xb_xcc_id() { return (unsigned)__builtin_amdgcn_s_getreg((3 << 11) | 20) & 0xFu; }
#define XB_SPIN(cond, bar) do { unsigned _sp = 0; while (cond) { __builtin_amdgcn_s_sleep(1); \
    if ((++_sp & 255u) == 0u) { if (xb_ld(&(bar)[XB_TMO])) break; if (_sp > XB_SPIN_CAP) { atomicAdd(&(bar)[XB_TMO], 1u); break; } } } } while (0)

struct XcdBarrier {
    unsigned* bar; unsigned x; int wave;
    volatile LAS unsigned* st;
};

__device__ __forceinline__ XcdBarrier xcd_barrier_post(unsigned* bar, volatile LAS unsigned* st, int wave) {
    XcdBarrier b; b.bar = bar; b.x = xb_xcc_id(); b.st = st; b.wave = wave;
    if (TID_IS_ZERO(wave)) (void)xb_add(&bar[XB_XCNT(b.x)], 1u);
    return b;
}
__device__ __forceinline__ void xcd_barrier_complete(unsigned* bar, unsigned x, unsigned& nloc, unsigned& nx) {
    const unsigned G = gridDim.x * gridDim.y * gridDim.z;
    unsigned sum, cnt, mine, sp = 0u;
    for (;;) {
        sum = 0u; cnt = 0u; mine = 0u;
#pragma unroll
        for (unsigned j = 0; j < 16; ++j) { const unsigned c = xb_ld(&bar[XB_XCNT(j)]); sum += c; cnt += (c > 0u) ? 1u : 0u; mine = (j == x) ? c : mine; }
        if (sum == G) break;
        __builtin_amdgcn_s_sleep(1);
        if ((++sp & 255u) == 0u) { if (xb_ld(&bar[XB_TMO])) break; if (sp > XB_SPIN_CAP) { atomicAdd(&bar[XB_TMO], 1u); break; } }
    }
    nloc = mine > 0u ? mine : 1u; nx = cnt > 0u ? cnt : 1u;
}

__device__ __forceinline__ void xcd_barrier(const XcdBarrier& b) {
    asm volatile("s_waitcnt vmcnt(0)" ::: "memory");
    __syncthreads();
    if (TID_IS_ZERO(b.wave)) {
        unsigned* bar = b.bar;
        __builtin_amdgcn_s_waitcnt(0);
        unsigned nloc = b.st[0], nx = b.st[1];
        if (nloc == 0u) { xcd_barrier_complete(bar, b.x, nloc, nx); b.st[0] = nloc; b.st[1] = nx; }
        const unsigned old = xb_add(&bar[XB_XSUB(b.x)], 1u);
        const unsigned gen = old / nloc;
        if (old + 1u == (gen + 1u) * nloc) {
            __builtin_amdgcn_fence(__ATOMIC_RELEASE, "agent");
            asm volatile("s_waitcnt vmcnt(0)" ::: "memory");
            const unsigned og = xb_add(&bar[XB_TOP], 1u);
            const unsigned tg = og / nx;
            if (og + 1u == (tg + 1u) * nx) xb_add(&bar[XB_TOPGEN], 1u);
            else XB_SPIN(xb_ld(&bar[XB_TOPGEN]) == tg, bar);
            __builtin_amdgcn_fence(__ATOMIC_ACQUIRE, "agent");
            xb_add(&bar[XB_XGEN(b.x)], 1u);
            asm volatile("s_waitcnt vmcnt(0)" ::: "memory");
        } else {
            XB_SPIN(xb_ld(&bar[XB_XGEN(b.x)]) == gen, bar);
            __builtin_amdgcn_fence(__ATOMIC_ACQUIRE, "agent");
            asm volatile("s_waitcnt vmcnt(0)" ::: "memory");
        }
    }
    __syncthreads();
}


constexpr int NWAVES = 8, NTHR = 512;
constexpr int DM = 1024, TP = 16384, TS = 1024, TA = TP + TS, SEQ = 8192, NB_P = 2, NB_S = 128, LS = 8;
constexpr int N_IN = 3328;
constexpr int PASTL = 2048, PAGE = 128, NPAGES = 16;
constexpr float EPS = 1e-6f;
constexpr float LOG2E = 1.4426950408889634f;
constexpr float C2F = 0.125f * LOG2E;
constexpr float C2C = 0.0625f * LOG2E;

enum { I_XP = 0, I_XS, I_CFK, I_CFV, I_CFL, I_SGLA, I_CMK, I_CMV, I_PT, I_MEMP, I_GMIX, I_WIN, I_BFF, I_WG2, I_BG, I_GGO, I_WOUT, I_GCROSS, I_GMEM,
       I_WMK, I_WMV, I_WCQ, I_WCO, I_GFFN, I_PWQ, I_PSK, I_PU, I_PV, I_GFIN, N_INPUTS };
constexpr size_t O_YP = 0, O_YS = 16777216, O_FKP = 17825792, O_FVP = 26214400, O_LFP = 34603008, O_GSP = 34734080, O_MKP = 34799616, O_MVP = 35323904,
                 O_FKS = 35848192, O_FVS = 36372480, O_LFS = 36896768, O_GSS = 36904960, O_TOTAL = 41099264;

constexpr size_t MiB = 1u << 20;
constexpr size_t WS_CTL = 0, CTL_ZERO_BYTES = 1 * MiB;
constexpr size_t WS_WIN = 2 * MiB, WS_WOUT = 10 * MiB, WS_WMK = 12 * MiB, WS_WMV = 14 * MiB, WS_WCQ = 16 * MiB, WS_WCO = 18 * MiB, WS_WPK = 20 * MiB;
constexpr size_t WS_MB = 24 * MiB, WS_MK16 = 25 * MiB, WS_MVT16 = 26 * MiB, WS_KBIAS = 27 * MiB, WS_GDEC = 28 * MiB, WS_GG = 29 * MiB;
constexpr size_t WS_U16 = 32 * MiB, WS_V16 = 64 * MiB, WS_HB = 96 * MiB, WS_QF = 132 * MiB, WS_KF = 150 * MiB, WS_VF = 168 * MiB;
constexpr size_t WS_GQ = 186 * MiB, WS_GK = 204 * MiB, WS_GV = 222 * MiB, WS_GR = 256 * MiB, WS_SUF = 290 * MiB, WS_GKV = 298 * MiB;
constexpr size_t WS_MERGED = 330 * MiB, WS_X1 = 364 * MiB, WS_X2 = 432 * MiB, WS_QC = 500 * MiB, WS_PC = 534 * MiB, WS_OC = 566 * MiB, WS_SC = 600 * MiB;
constexpr size_t WS_MISC = 736 * MiB, WS_SS = 740 * MiB  , WS_BB = 744 * MiB, WS_END = 800 * MiB;
constexpr int CW_BAR = 4096;

constexpr int RING_BYTES = 131072;
constexpr int LDSCTL_OFF = RING_BYTES, MISC_OFF = LDSCTL_OFF + 320;
constexpr int ARGS_OFF = MISC_OFF + 128;
constexpr int LDS_BYTES = 147456;

struct Args { const void* in[N_INPUTS]; float* out; unsigned char* ws; };

__device__ __forceinline__ const void* ld_ptr(const LAS unsigned long long* p) { const unsigned long long v = *p; const unsigned lo = __builtin_amdgcn_readfirstlane((unsigned)v), hi = __builtin_amdgcn_readfirstlane((unsigned)(v >> 32)); return (const void*)(const GAS char*)(((unsigned long long)hi << 32) | lo); }
__device__ __forceinline__ Args load_args(const LAS unsigned long long* ARGP) { Args A;
    A.in[0] = ld_ptr(ARGP + 0);
    A.in[1] = ld_ptr(ARGP + 1);
    A.in[2] = ld_ptr(ARGP + 2);
    A.in[3] = ld_ptr(ARGP + 3);
    A.in[4] = ld_ptr(ARGP + 4);
    A.in[5] = ld_ptr(ARGP + 5);
    A.in[6] = ld_ptr(ARGP + 6);
    A.in[7] = ld_ptr(ARGP + 7);
    A.in[8] = ld_ptr(ARGP + 8);
    A.in[9] = ld_ptr(ARGP + 9);
    A.in[10] = ld_ptr(ARGP + 10);
    A.in[11] = ld_ptr(ARGP + 11);
    A.in[12] = ld_ptr(ARGP + 12);
    A.in[13] = ld_ptr(ARGP + 13);
    A.in[14] = ld_ptr(ARGP + 14);
    A.in[15] = ld_ptr(ARGP + 15);
    A.in[16] = ld_ptr(ARGP + 16);
    A.in[17] = ld_ptr(ARGP + 17);
    A.in[18] = ld_ptr(ARGP + 18);
    A.in[19] = ld_ptr(ARGP + 19);
    A.in[20] = ld_ptr(ARGP + 20);
    A.in[21] = ld_ptr(ARGP + 21);
    A.in[22] = ld_ptr(ARGP + 22);
    A.in[23] = ld_ptr(ARGP + 23);
    A.in[24] = ld_ptr(ARGP + 24);
    A.in[25] = ld_ptr(ARGP + 25);
    A.in[26] = ld_ptr(ARGP + 26);
    A.in[27] = ld_ptr(ARGP + 27);
    A.in[28] = ld_ptr(ARGP + 28);
    A.out = (float*)ld_ptr(ARGP + N_INPUTS); A.ws = (unsigned char*)ld_ptr(ARGP + N_INPUTS + 1); return A; }
struct Frame {
    LAS unsigned char* lds;
    int tid, lane, wave, vcu, G;
};

__device__ __forceinline__ float wave_sum(float v) { return sum64_f32(v); }
__device__ __forceinline__ float log_sigmoid(float x) { return fminf(x, 0.f) - __logf(1.f + __expf(-fabsf(x))); }

__device__ __forceinline__ int win_src_col(int r) {
    if (r < 1536) return r;
    if (r < 1792) return 1544 + (r - 1536);
    if (r < 2048) return 1800 + (r - 1792);
    if (r < 2560) return 2056 + (r - 2048);
    if (r < 3072) return 2584 + (r - 2560);
    if (r < 3080) return 1536 + (r - 3072);
    if (r < 3096) return 2568 + (r - 3080);
    return -1;
}
template <bool WIN>
__device__ __forceinline__ void p0_transpose_item(const float* W, int ldw, int K, int nblk, bf16* WT, LAS float* scr, int item, int lane) {
    const int kb = item / nblk, nb = item % nblk, k0 = 64 * kb, n0 = 32 * nb;
    const int dr = n0 + (lane & 31); const int sc = WIN ? win_src_col(dr) : dr;
#pragma unroll 8
    for (int i = 0; i < 32; ++i) { const int kk = 2 * i + (lane >> 5); scr[kk * 33 + (lane & 31)] = (sc >= 0) ? W[(size_t)(k0 + kk) * ldw + sc] : 0.f; }
    LDS_WAIT(); asm volatile("" ::: "memory");
    const int c = lane & 7;
#pragma unroll
    for (int j = 0; j < 4; ++j) { const int n = (lane >> 3) + 8 * j; const LAS float* s = scr + (8 * c) * 33 + n;
        v4u o; o.x = pk2(s[0 * 33], s[1 * 33]); o.y = pk2(s[2 * 33], s[3 * 33]); o.z = pk2(s[4 * 33], s[5 * 33]); o.w = pk2(s[6 * 33], s[7 * 33]);
        *(GAS v4u*)(WT + (size_t)(n0 + n) * K + k0 + 8 * c) = o; }
    LDS_WAIT(); asm volatile("" ::: "memory");
}
__device__ __forceinline__ void rms_row_bf16(const float* xrow, const float* g, bf16* orow, int lane) {
    const f32x4* xr = (const f32x4*)xrow + lane; const f32x4* gr = (const f32x4*)g + lane;
    f32x4 v[4]; float s = 0.f;
#pragma unroll
    for (int j = 0; j < 4; ++j) { v[j] = xr[64 * j]; s += (v[j].x * v[j].x + v[j].y * v[j].y) + (v[j].z * v[j].z + v[j].w * v[j].w); }
    const float r = rsqrtf(wave_sum(s) * (1.f / DM) + EPS);
    v2u* o8 = (v2u*)orow + lane;
#pragma unroll
    for (int j = 0; j < 4; ++j) { const f32x4 gg = gr[64 * j]; v2u o; o.x = pk2(v[j].x * r * gg.x, v[j].y * r * gg.y); o.y = pk2(v[j].z * r * gg.z, v[j].w * r * gg.w); o8[64 * j] = o; }
}

using pg8::Unit;
struct EpiGen {
    static constexpr bool PERM = true, AFTER_DRAIN = false;
    float* d32; int ld32; bf16* d16; int ld16; float sc16;
    const float* r0; const float* r1; int rsplit; int ldr;
    const float* gcol;
    float* ssq;
    const float* rsq;
    __device__ __forceinline__ void operator()(const f32x4 (&acc)[2][2][4][2], const Unit& u, int wr, int wc, int fr, int fq) const {
        int row0 = u.pm * 256 + wr * 64 + fr, col0 = u.pn * 256 + wc * 32 + fq * 8;
        asm volatile("" : "+v"(row0), "+v"(col0));
#pragma unroll
        for (int ai = 0; ai < 2; ++ai)
#pragma unroll
            for (int m = 0; m < 4; ++m) { const int row = row0 + ai * 128 + m * 16;
                const float* rp = nullptr; if (r0) rp = (row < rsplit) ? r0 + (size_t)row * ldr : r1 + (size_t)(row - rsplit) * ldr;
                float rs = 1.f; if (rsq) rs = rsqrtf(rsq[row] * (1.f / 1024.f) + EPS);
                float ss = 0.f;
#pragma unroll
                for (int bj = 0; bj < 2; ++bj) { const int col = col0 + bj * 128; f32x4 v0 = acc[ai][bj][m][0], v1 = acc[ai][bj][m][1];
                    if (rsq) { v0[0] *= rs; v0[1] *= rs; v0[2] *= rs; v0[3] *= rs; v1[0] *= rs; v1[1] *= rs; v1[2] *= rs; v1[3] *= rs; }
                    if (r0) { v0 += *(const f32x4*)(rp + col); v1 += *(const f32x4*)(rp + col + 4); }
                    if (d32) { *(f32x4*)(d32 + (size_t)row * ld32 + col) = v0; *(f32x4*)(d32 + (size_t)row * ld32 + col + 4) = v1; }
                    if (ssq) ss += ((v0[0] * v0[0] + v0[1] * v0[1]) + (v0[2] * v0[2] + v0[3] * v0[3])) + ((v1[0] * v1[0] + v1[1] * v1[1]) + (v1[2] * v1[2] + v1[3] * v1[3]));
                    if (d16) { f32x4 w0 = v0, w1 = v1; if (gcol) { w0 = w0 * *(const f32x4*)(gcol + col); w1 = w1 * *(const f32x4*)(gcol + col + 4); }
                        v4u o; o.x = pg8::cvt_pk_bf16(w0[0] * sc16, w0[1] * sc16); o.y = pg8::cvt_pk_bf16(w0[2] * sc16, w0[3] * sc16); o.z = pg8::cvt_pk_bf16(w1[0] * sc16, w1[1] * sc16); o.w = pg8::cvt_pk_bf16(w1[2] * sc16, w1[3] * sc16);
                        *(v4u*)(d16 + (size_t)row * ld16 + col) = o; } }
                if (ssq) { ss += xor16_f32(ss); ss += __shfl_xor(ss, 32); if (fq == 0) atomicAdd(ssq + row, ss); } }
    }
};
struct EpiInProj {
    static constexpr bool PERM = true, AFTER_DRAIN = false;
    float* out; unsigned char* ws; const float* bff;
    __device__ __forceinline__ void operator()(const f32x4 (&acc)[2][2][4][2], const Unit& u, int wr, int wc, int fr, int fq) const {
        const int pn = u.pn; const bool smp = u.pm >= 64;
        int row0 = u.pm * 256 + wr * 64 + fr;
        int orow0 = (smp ? (u.pm - 64) * 256 : u.pm * 256) + wr * 64 + fr;
        asm volatile("" : "+v"(row0), "+v"(orow0));
        float* d32 = nullptr; int ld32 = 0; bool d32_grp = false; bf16* d16 = nullptr; int ld16 = 0; float s32 = 1.f, s16 = 1.f; int cb = 0;
        if (pn < 2) { d16 = (bf16*)(ws + WS_QF); ld16 = 512; s16 = C2F; cb = pn * 256; }
        else if (pn < 4) { d32 = out + (smp ? O_FKS : O_FKP); ld32 = 512; d32_grp = true; d16 = (bf16*)(ws + WS_KF); ld16 = 512; cb = (pn - 2) * 256; }
        else if (pn < 6) { d32 = out + (smp ? O_FVS : O_FVP); ld32 = 512; d32_grp = true; d16 = (bf16*)(ws + WS_VF); ld16 = 512; cb = (pn - 4) * 256; }
        else if (pn == 6) { d16 = (bf16*)(ws + WS_GQ); ld16 = 256; s16 = 0.125f; }
        else if (pn == 7) { d16 = (bf16*)(ws + WS_GK); ld16 = 256; }
        else if (pn < 10) { d16 = (bf16*)(ws + WS_GV); ld16 = 512; cb = (pn - 8) * 256; }
        else if (pn < 12) { d16 = (bf16*)(ws + WS_GR); ld16 = 512; cb = (pn - 10) * 256; }
        if (pn < 12) {
#pragma unroll
            for (int ai = 0; ai < 2; ++ai)
#pragma unroll
                for (int m = 0; m < 4; ++m) { const int row = row0 + ai * 128 + m * 16, orow = orow0 + ai * 128 + m * 16;
#pragma unroll
                    for (int bj = 0; bj < 2; ++bj) { const int col = cb + wc * 32 + fq * 8 + bj * 128; const f32x4 v0 = acc[ai][bj][m][0], v1 = acc[ai][bj][m][1];
                        if (d32) { float* dp = d32 + (size_t)(d32_grp ? orow : row) * ld32 + col; *(f32x4*)dp = v0 * s32; *(f32x4*)(dp + 4) = v1 * s32; }
                        if (d16) { v4u o; o.x = pg8::cvt_pk_bf16(v0[0] * s16, v0[1] * s16); o.y = pg8::cvt_pk_bf16(v0[2] * s16, v0[3] * s16); o.z = pg8::cvt_pk_bf16(v1[0] * s16, v1[1] * s16); o.w = pg8::cvt_pk_bf16(v1[2] * s16, v1[3] * s16);
                            *(v4u*)(d16 + (size_t)row * ld16 + col) = o; } } }
        } else {
            if (wc == 0) {
                float* lf = out + (smp ? O_LFS : O_LFP); float* ggp = (float*)(ws + WS_GG);
#pragma unroll
                for (int ai = 0; ai < 2; ++ai)
#pragma unroll
                    for (int m = 0; m < 4; ++m) { const int row = row0 + ai * 128 + m * 16, orow = orow0 + ai * 128 + m * 16;
#pragma unroll
                        for (int n = 0; n < 2; ++n) { const int col = fq * 8 + 4 * n; const f32x4 v = acc[ai][0][m][n];
                            if (col < 8) { f32x4 o; const f32x4 b = *(const f32x4*)(bff + col);
                                o[0] = log_sigmoid(v[0] + b[0]); o[1] = log_sigmoid(v[1] + b[1]); o[2] = log_sigmoid(v[2] + b[2]); o[3] = log_sigmoid(v[3] + b[3]);
                                *(f32x4*)(lf + (size_t)orow * 8 + col) = o; }
                            else if (col < 24) *(f32x4*)(ggp + (size_t)row * 16 + (col - 8)) = v; } }
            }
        }
    }
};


__device__ __forceinline__ void p0_prologue(const Frame& F, const Args& a) {
    unsigned char* ws = a.ws;
    LAS float* scr = (LAS float*)(F.lds + F.wave * 16384);
    const int gw = F.vcu * NWAVES + F.wave, NGW = F.G * NWAVES;
    constexpr int I_WINN = 16 * (N_IN / 32), I_SQ = 16 * 32;
    constexpr int NITEMS = I_WINN + 5 * I_SQ;
    for (int it = (gw + NGW / 2) % NGW; it < NITEMS; it += NGW) {
        int r = it;
        if (r < I_WINN) { p0_transpose_item<true>((const float*)a.in[I_WIN], 3096, DM, N_IN / 32, (bf16*)(ws + WS_WIN), scr, r, F.lane); continue; } r -= I_WINN;
        const int which = r / I_SQ; r -= which * I_SQ;
        const float* src = (const float*)(which == 0 ? a.in[I_WOUT] : which == 1 ? a.in[I_WMK] : which == 2 ? a.in[I_WMV] : which == 3 ? a.in[I_WCQ] : a.in[I_WCO]);
        bf16* dst = (bf16*)(ws + (which == 0 ? WS_WOUT : which == 1 ? WS_WMK : which == 2 ? WS_WMV : which == 3 ? WS_WCQ : WS_WCO));
        p0_transpose_item<false>(src, DM, DM, 32, dst, scr, r, F.lane);
    }
    { float* ssz = (float*)(ws + WS_SS); for (int i = F.vcu * NTHR + F.tid; i < 2 * TA; i += F.G * NTHR) ssz[i] = 0.f; }
    for (int m0 = gw * 2; m0 < TA + 512; m0 += NGW * 2) {
        const float* xr[2]; const float* gr[2]; bf16* orow[2];
#pragma unroll
        for (int j = 0; j < 2; ++j) { const int m = m0 + j;
            if (m < TP) { xr[j] = (const float*)a.in[I_XP] + (size_t)m * DM; gr[j] = (const float*)a.in[I_GMIX]; orow[j] = (bf16*)(ws + WS_HB) + (size_t)m * DM; }
            else if (m < TA) { xr[j] = (const float*)a.in[I_XS] + (size_t)(m - TP) * DM; gr[j] = (const float*)a.in[I_GMIX]; orow[j] = (bf16*)(ws + WS_HB) + (size_t)m * DM; }
            else { xr[j] = (const float*)a.in[I_MEMP] + (size_t)(m - TA) * DM; gr[j] = (const float*)a.in[I_GMEM]; orow[j] = (bf16*)(ws + WS_MB) + (size_t)(m - TA) * DM; } }
        f32x4 v[2][4]; float s[2];
#pragma unroll
        for (int j = 0; j < 2; ++j) { s[j] = 0.f;
#pragma unroll
            for (int q = 0; q < 4; ++q) v[j][q] = ((const f32x4*)xr[j])[F.lane + 64 * q]; }
#pragma unroll
        for (int j = 0; j < 2; ++j) {
#pragma unroll
            for (int q = 0; q < 4; ++q) s[j] += (v[j][q].x * v[j][q].x + v[j][q].y * v[j][q].y) + (v[j][q].z * v[j][q].z + v[j][q].w * v[j][q].w);
            const float r = rsqrtf(wave_sum(s[j]) * (1.f / DM) + EPS);
#pragma unroll
            for (int q = 0; q < 4; ++q) { const f32x4 gg = ((const f32x4*)gr[j])[F.lane + 64 * q]; v2u o; o.x = pk2(v[j][q].x * r * gg.x, v[j][q].y * r * gg.y); o.y = pk2(v[j][q].z * r * gg.z, v[j][q].w * r * gg.w); ((v2u*)orow[j])[F.lane + 64 * q] = o; } }
    }
    {
        for (int r0 = gw * 4; r0 < 2 * 16384; r0 += NGW * 4) {
            f32x4 x[4][4];
#pragma unroll
            for (int j = 0; j < 4; ++j) { const int r = r0 + j; const bool isv = r >= 16384; const int e = isv ? r - 16384 : r;
                const f32x4* s = (const f32x4*)((const float*)(isv ? a.in[I_PV] : a.in[I_PU]) + (size_t)e * DM) + F.lane;
#pragma unroll
                for (int q = 0; q < 4; ++q) x[j][q] = __builtin_nontemporal_load(s + 64 * q); }
#pragma unroll
            for (int j = 0; j < 4; ++j) { const int r = r0 + j; const bool isv = r >= 16384; const int e = isv ? r - 16384 : r; float am = 0.f;
#pragma unroll
                for (int q = 0; q < 4; ++q) am = fmaxf(am, fmaxf(fmaxf(fabsf(x[j][q].x), fabsf(x[j][q].y)), fmaxf(fabsf(x[j][q].z), fabsf(x[j][q].w))));
#pragma unroll
                for (int o = 1; o < 64; o <<= 1) am = fmaxf(am, __shfl_xor(am, o));
                const float inv = am > 0.f ? 448.f / am : 0.f;
                v4u o4;
#pragma unroll
                for (int q = 0; q < 4; ++q) { int pk = __builtin_amdgcn_cvt_pk_fp8_f32(x[j][q].x * inv, x[j][q].y * inv, 0, false); pk = __builtin_amdgcn_cvt_pk_fp8_f32(x[j][q].z * inv, x[j][q].w * inv, pk, true); o4[q] = (unsigned)pk; }
                *(v4u*)(ws + (isv ? WS_V16 : WS_U16) + (size_t)e * DM + 16 * F.lane) = o4;
                if (F.lane == 0) ((float*)(ws + WS_MISC))[r] = am * (1.f / 448.f); }
        }
    }
    __syncthreads();
    for (int it = blockIdx.x; it < 256; it += F.G) {
        const int c = it >> 4, kt = it & 15, half = c & 1;
        LAS unsigned char* SKB = F.lds; LAS unsigned char* WB = F.lds + 128 * 272;
        const float* sk = (const float*)a.in[I_PSK] + (size_t)half * 128 * 128; const float* wq = (const float*)a.in[I_PWQ] + (size_t)(kt * 64) * 2048 + c * 128;
#pragma unroll
        for (int i = 0; i < 8; ++i) { const int c4 = F.tid + NTHR * i; const f32x4 x = *(const f32x4*)(sk + 4 * c4);
            v2u o; o.x = pk2(x.x, x.y); o.y = pk2(x.z, x.w); *(LAS v2u*)(SKB + (c4 >> 5) * 272 + (c4 & 31) * 8) = o; }
#pragma unroll
        for (int i = 0; i < 4; ++i) { const int c4 = F.tid + NTHR * i; const f32x4 x = *(const f32x4*)(wq + (size_t)(c4 >> 5) * 2048 + (c4 & 31) * 4);
            v2u o; o.x = pk2(x.x, x.y); o.y = pk2(x.z, x.w); *(LAS v2u*)(WB + (c4 >> 5) * 272 + (c4 & 31) * 8) = o; }
        __syncthreads();
        {
            const int r32 = F.lane & 31, hi = F.lane >> 5, mb = F.wave >> 1, nb = F.wave & 1;
            const LAS unsigned char* arow = SKB + (32 * mb + r32) * 272; const LAS unsigned char* brow = WB + (32 * nb + r32) * 272;
            f32x16 acc = {};
#pragma unroll
            for (int ks = 0; ks < 8; ++ks) acc = __builtin_amdgcn_mfma_f32_32x32x16_bf16(row_frag(arow, ks, hi), row_frag(brow, ks, hi), acc, 0, 0, 0);
            bf16* wp = (bf16*)(ws + WS_WPK) + (size_t)(c * 128 + 32 * mb) * DM + kt * 64 + 32 * nb + r32;
#pragma unroll
            for (int r = 0; r < 16; ++r) wp[(size_t)crow(r, hi) * DM] = (bf16)f2bf(acc[r]);
        }
        __syncthreads();
    }
}


__device__ __forceinline__ void fox_prompt_cumsum(const Frame& F, const float* logf  , float* kbias, int b) {
    LAS float* WT = (LAS float*)F.lds;
    const int t0 = F.wave * 1024 + F.lane * 16;
    const f32x4* src = (const f32x4*)(logf + ((size_t)b * SEQ + t0) * 8);
    float s[8];
#pragma unroll
    for (int h = 0; h < 8; ++h) s[h] = 0.f;
#pragma unroll 4
    for (int i = 0; i < 16; ++i) { const f32x4 a = src[2 * i], c = src[2 * i + 1]; s[0] += a.x; s[1] += a.y; s[2] += a.z; s[3] += a.w; s[4] += c.x; s[5] += c.y; s[6] += c.z; s[7] += c.w; }
    float ex[8];
#pragma unroll
    for (int h = 0; h < 8; ++h) { float v = s[h];
#pragma unroll
        for (int o = 1; o < 64; o <<= 1) { const float t = __shfl_up(v, o); if (F.lane >= o) v += t; }
        ex[h] = v - s[h];
        if (F.lane == 63) WT[F.wave * 8 + h] = v; }
    __syncthreads();
#pragma unroll
    for (int h = 0; h < 8; ++h) { float c = 0.f; for (int w = 0; w < F.wave; ++w) c += WT[w * 8 + h]; ex[h] += c; }
    float* dst = kbias + (size_t)(b * 8) * SEQ + t0;
#pragma unroll 4
    for (int i = 0; i < 16; ++i) { const f32x4 a = src[2 * i], c = src[2 * i + 1];
        ex[0] += a.x; ex[1] += a.y; ex[2] += a.z; ex[3] += a.w; ex[4] += c.x; ex[5] += c.y; ex[6] += c.z; ex[7] += c.w;
#pragma unroll
        for (int h = 0; h < 8; ++h) dst[(size_t)h * SEQ + i] = -ex[h] * LOG2E; }
    __syncthreads();
}
__device__ __forceinline__ void fox_sample_suffix(const Frame& F, const float* cfl, const int* pt, float* suf, int bs) {
    float carry[8];
#pragma unroll
    for (int h = 0; h < 8; ++h) carry[h] = 0.f;
    const int mypg = pt[bs * NPAGES + (F.lane & 15)];
#pragma unroll 1
    for (int pb = NPAGES - 4; pb >= 0; pb -= 4) {
        f32x4 x[4][4];
#pragma unroll
        for (int j = 0; j < 4; ++j) { const int pg = __builtin_amdgcn_readlane(mypg, 0) * 0 + __shfl(mypg, pb + j); const f32x4* src = (const f32x4*)(cfl + ((size_t)pg * PAGE + 2 * F.lane) * 8);
            x[j][0] = src[0]; x[j][1] = src[1]; x[j][2] = src[2]; x[j][3] = src[3]; }
#pragma unroll
        for (int j = 3; j >= 0; --j) { const int p = pb + j;
            const float ra[8] = {x[j][0].x, x[j][0].y, x[j][0].z, x[j][0].w, x[j][1].x, x[j][1].y, x[j][1].z, x[j][1].w}, rb[8] = {x[j][2].x, x[j][2].y, x[j][2].z, x[j][2].w, x[j][3].x, x[j][3].y, x[j][3].z, x[j][3].w};
#pragma unroll
            for (int h = 0; h < 8; ++h) {
                const float ps = ra[h] + rb[h]; float v = ps;
#pragma unroll
                for (int o = 1; o < 64; o <<= 1) { const float t = __shfl_down(v, o); if (F.lane + o < 64) v += t; }
                const float exs = v - ps;
                float* d = suf + (size_t)(bs * 8 + h) * PASTL + p * PAGE + 2 * F.lane;
                *(f32x2*)d = (f32x2){(carry[h] + exs + rb[h]) * LOG2E, (carry[h] + exs) * LOG2E};
                carry[h] += __shfl(v, 0);
            }
        }
    }
}

__device__ __forceinline__ void gla_gate_tile(const Frame& F, const float* gg, const float* w2, const float* bg, int row0, int h, int nt, LAS float* LA, LAS float* GGS) {
    for (int e = F.tid; e < nt * 16; e += NTHR) GGS[e] = gg[(size_t)row0 * 16 + e];
    const int dk = F.tid & 63; float wc[16];
#pragma unroll
    for (int r = 0; r < 16; ++r) wc[r] = w2[r * 256 + h * 64 + dk];
    const float bb = bg[h * 64 + dk];
    __syncthreads();
    for (int t = F.tid >> 6; t < nt; t += 8) { float z = bb;
#pragma unroll
        for (int q = 0; q < 4; ++q) { const f32x4 g4 = *(const LAS f32x4*)(GGS + t * 16 + 4 * q); z += g4.x * wc[4 * q] + g4.y * wc[4 * q + 1] + g4.z * wc[4 * q + 2] + g4.w * wc[4 * q + 3]; }
        LA[t * 64 + dk] = log_sigmoid(z) * (1.f / 16.f); }
}
__device__ __forceinline__ void gla_cumsum64(const Frame& F, LAS float* LA, LAS float* SEG) {
    const int dk = F.lane, w = F.wave; float v[8]; float run = 0.f;
#pragma unroll
    for (int i = 0; i < 8; ++i) { run += LA[(8 * w + i) * 64 + dk]; v[i] = run; }
    SEG[w * 64 + dk] = run;
    __syncthreads();
    float pre = 0.f;
    for (int j = 0; j < w; ++j) pre += SEG[j * 64 + dk];
#pragma unroll
    for (int i = 0; i < 8; ++i) LA[(8 * w + i) * 64 + dk] = v[i] + pre;
    __syncthreads();
}
__device__ __forceinline__ void gla_g1_unit(const Frame& F, const Args& a, int u) {
    unsigned char* ws = a.ws;
    const int b = u >> 9, h = (u >> 7) & 3, n = u & 127; const int row0 = b * SEQ + n * 64;
    LAS float* LA = (LAS float*)F.lds; LAS float* SEG = LA + 4096; LAS float* GGS = SEG + 512; LAS unsigned char* KRB = F.lds + 22528; LAS unsigned char* VSB = F.lds + 34816;
    v4u vq[2];
#pragma unroll
    for (int i = 0; i < 2; ++i) { const int c = F.tid + NTHR * i; vq[i] = *(const v4u*)((const bf16*)(ws + WS_GV) + (size_t)(row0 + (c >> 4)) * 512 + h * 128 + (c & 15) * 8); }
    float gkv[8];
#pragma unroll
    for (int i = 0; i < 8; ++i) { const int e = F.tid + NTHR * i; gkv[i] = GLD(ws + WS_GK)[(size_t)(row0 + (e >> 6)) * 256 + h * 64 + (e & 63)]; }
    gla_gate_tile(F, (const float*)(ws + WS_GG), (const float*)a.in[I_WG2], (const float*)a.in[I_BG], row0, h, 64, LA, GGS);
#pragma unroll
    for (int i = 0; i < 2; ++i) { const int c = F.tid + NTHR * i; *(LAS v4u*)(VSB + (c >> 4) * 320 + (c & 15) * 16) = vq[i]; }
    __syncthreads();
    gla_cumsum64(F, LA, SEG);
    if (F.tid < 64) ((float*)(ws + WS_GDEC))[(size_t)((b * 4 + h) * 128 + n) * 64 + F.tid] = __expf(LA[63 * 64 + F.tid]);
    float* bbuf = (float*)(ws + WS_BB);
#pragma unroll
    for (int i = 0; i < 8; ++i) { const int e = F.tid + NTHR * i; const int t = e >> 6, dk = e & 63; const float bb = LA[e]; bbuf[(size_t)(row0 + t) * 256 + h * 64 + dk] = bb;
        *(LAS unsigned short*)(KRB + t * 192 + dk * 2) = (unsigned short)f2bf(gkv[i] * __expf(LA[63 * 64 + dk] - bb)); }
    __syncthreads();
    {
        const int lane = F.lane, r32 = lane & 31, hi = lane >> 5, mb = F.wave >> 2, nb = F.wave & 3;
        const int tb = (4 * hi + ((lane & 15) >> 2)), tc = (16 * ((lane >> 4) & 1) + 4 * (lane & 3)) * 2;
        LAS unsigned char* abase = KRB + tb * 192 + tc + 64 * mb; LAS unsigned char* bbase = VSB + tb * 320 + tc + 64 * nb;
        f32x16 acc = {};
#pragma unroll
        for (int ks = 0; ks < 4; ++ks) acc = __builtin_amdgcn_mfma_f32_32x32x16_bf16(tr_frag<192>(abase, ks), tr_frag<320>(bbase, ks), acc, 0, 0, 0);
        float* kv = (float*)(ws + WS_GKV) + ((size_t)((b * 4 + h) * 128 + n) * 64 + 32 * mb) * 128 + 32 * nb + r32;
#pragma unroll
        for (int r = 0; r < 16; ++r) kv[(size_t)crow(r, hi) * 128] = acc[r];
    }
    __syncthreads();
}
__device__ __forceinline__ void gla_scan(const Frame& F, const Args& a) {
    int tid = F.wave * 64 + lane_id(); asm volatile("" : "+v"(tid));
    if (tid >= 256) return;
    for (int e = F.vcu * 256 + tid; e < 65536; e += F.G * 256) {
    const int bh = e >> 13, dk = (e >> 7) & 63, dv = e & 127;
    float* kv = (float*)(a.ws + WS_GKV) + ((size_t)bh * 128 * 64 + dk) * 128 + dv; const float* dc = (const float*)(a.ws + WS_GDEC) + (size_t)bh * 128 * 64 + dk;
    float S = 0.f;
#pragma unroll 1
    for (int n0 = 0; n0 < 128; n0 += 32) { float kvv[32], dd[32];
#pragma unroll
        for (int j = 0; j < 32; ++j) { kvv[j] = kv[(size_t)(n0 + j) * 8192]; dd[j] = dc[(size_t)(n0 + j) * 64]; }
#pragma unroll
        for (int j = 0; j < 32; ++j) { kv[(size_t)(n0 + j) * 8192] = S; S = dd[j] * S + kvv[j]; } }
    a.out[O_GSP + (size_t)bh * 8192 + dk * 128 + dv] = S;
    }
}
__device__ __forceinline__ float silu(float x) { return x / (1.f + __expf(-x)); }
__device__ __forceinline__ void gla_sample_unit(const Frame& F, const Args& a, int u) {
    unsigned char* ws = a.ws;
    const int bs = u >> 2, h = u & 3; const int row0 = TP + bs * LS;
    LAS float* LA = (LAS float*)F.lds; LAS float* BL = LA + 512; LAS float* QD = BL + 64; LAS float* KI = QD + 512; LAS float* KR = KI + 512; LAS float* ATT = KR + 512; LAS float* OP = ATT + 64; LAS float* VS = OP + 4096;
    gla_gate_tile(F, (const float*)(ws + WS_GG), (const float*)a.in[I_WG2], (const float*)a.in[I_BG], row0, h, 8, LA, VS + 1024);
#pragma unroll
    for (int i = 0; i < 2; ++i) { const int e = F.tid + NTHR * i; VS[e] = GLD(ws + WS_GV)[(size_t)(row0 + (e >> 7)) * 512 + h * 128 + (e & 127)]; }
    __syncthreads();
    if (F.tid < 64) { float run = 0.f;
#pragma unroll
        for (int t = 0; t < 8; ++t) { run += LA[t * 64 + F.tid]; LA[t * 64 + F.tid] = run; } BL[F.tid] = run; }
    __syncthreads();
    { const int e = F.tid, t = e >> 6, dk = e & 63; const float bb = LA[e];
      const float q = GLD(ws + WS_GQ)[(size_t)(row0 + t) * 256 + h * 64 + dk], k = GLD(ws + WS_GK)[(size_t)(row0 + t) * 256 + h * 64 + dk];
      QD[e] = q * __expf(bb); KI[e] = k * __expf(-bb); KR[e] = k * __expf(BL[dk] - bb); }
    __syncthreads();
    if (F.tid < 64) { const int t = F.tid >> 3, s = F.tid & 7; float acc = 0.f;
        if (s <= t) { for (int dk = 0; dk < 64; ++dk) acc += QD[t * 64 + dk] * KI[s * 64 + dk]; }
        ATT[F.tid] = acc; }
    const int dv = F.tid & 127, dkg = F.tid >> 7;
    {
        const float* st = (const float*)a.in[I_SGLA] + ((size_t)(bs * 4 + h) * 64 + dkg * 16) * 128 + dv;
        float S0[16];
#pragma unroll
        for (int i = 0; i < 16; ++i) S0[i] = st[(size_t)i * 128];
#pragma unroll
        for (int t = 0; t < 8; ++t) { float o = 0.f;
#pragma unroll
            for (int i = 0; i < 16; ++i) o += QD[t * 64 + dkg * 16 + i] * S0[i];
            OP[(dkg * 8 + t) * 128 + dv] = o; }
        float* so = a.out + O_GSS + ((size_t)(bs * 4 + h) * 64 + dkg * 16) * 128 + dv;
#pragma unroll
        for (int i = 0; i < 16; ++i) { float sn = __expf(BL[dkg * 16 + i]) * S0[i];
#pragma unroll
            for (int t = 0; t < 8; ++t) sn += KR[t * 64 + dkg * 16 + i] * VS[t * 128 + dv];
            so[(size_t)i * 128] = sn; }
    }
    __syncthreads();
    {
        const int t = F.wave; float o[2]; float ss = 0.f;
#pragma unroll
        for (int j = 0; j < 2; ++j) { const int d = 2 * F.lane + j; float v = OP[(0 * 8 + t) * 128 + d] + OP[(1 * 8 + t) * 128 + d] + OP[(2 * 8 + t) * 128 + d] + OP[(3 * 8 + t) * 128 + d];
            for (int s = 0; s <= t; ++s) v += ATT[t * 8 + s] * VS[s * 128 + d];
            o[j] = v; ss += v * v; }
        const float r = rsqrtf(wave_sum(ss) * (1.f / 128.f) + EPS);
        const float* ggo = (const float*)a.in[I_GGO] + h * 128 + 2 * F.lane; const BfPtr gr = GLD(ws + WS_GR) + ((size_t)(row0 + t) * 512 + h * 128 + 2 * F.lane);
        const float y0 = o[0] * r * ggo[0] * silu(gr[0]), y1 = o[1] * r * ggo[1] * silu(gr[1]);
        *(unsigned*)((bf16*)(ws + WS_MERGED) + (size_t)(row0 + t) * DM + 512 + h * 128 + 2 * F.lane) = pk2(y0, y1);
    }
    __syncthreads();
}


__device__ __forceinline__ float fexp2(float x) { return __builtin_amdgcn_exp2f(x); }
constexpr float FOX_SKIP = 160.f;


__device__ __forceinline__ void fox_norms_item(const Frame& F, const bf16* QF, const bf16* KF, const float* logf, float* FN, float* LC, float* BT, int item) {
    const int bh = item >> 5, qb = item & 31, b = bh >> 3, h = bh & 7;
    float qm = 0.f, km = 0.f;
    const float* lp = logf + ((size_t)b * SEQ + qb * 256 + 4 * F.lane) * 8 + h;
    const float l0 = lp[0], l1 = lp[8], l2 = lp[16], l3 = lp[24];
#pragma unroll 8
    for (int i = 0; i < 32; ++i) { const size_t row = (size_t)b * SEQ + qb * 256 + i * 8 + (F.lane >> 3);
        const v4u q = *(const v4u*)(QF + row * 512 + h * 64 + (F.lane & 7) * 8), k = *(const v4u*)(KF + row * 512 + h * 64 + (F.lane & 7) * 8); float qs = 0.f, ks = 0.f;
#pragma unroll
        for (int j = 0; j < 4; ++j) { qs += bflo(q[j]) * bflo(q[j]) + bfhi(q[j]) * bfhi(q[j]); ks += bflo(k[j]) * bflo(k[j]) + bfhi(k[j]) * bfhi(k[j]); }
        qs = sum8_f32(qs); ks = sum8_f32(ks);
        qm = fmaxf(qm, qs); km = fmaxf(km, ks); }
#pragma unroll
    for (int o = 1; o < 64; o <<= 1) { qm = fmaxf(qm, __shfl_xor(qm, o)); km = fmaxf(km, __shfl_xor(km, o)); }
    const float c0 = l0, c1 = c0 + l1, c2 = c1 + l2, c3 = c2 + l3; float v = c3;
#pragma unroll
    for (int o = 1; o < 64; o <<= 1) { const float t = __shfl_up(v, o); if (F.lane >= o) v += t; }
    const float ex = v - c3;
    *(f32x4*)(LC + (size_t)bh * SEQ + qb * 256 + 4 * F.lane) = (f32x4){ex + c0, ex + c1, ex + c2, ex + c3};
    if (F.lane == 63) BT[item] = v;
    if (F.lane == 0) { FN[item * 2] = qm; FN[item * 2 + 1] = km; }
}
__device__ __forceinline__ void fox_suffix_item(const Frame& F, const float* cfl, const int* pt, float* SW, float* PTOT, int item) {
    const int bs = item >> 4, p = item & 15; const int pg = __builtin_amdgcn_readfirstlane(pt[item]);
    const f32x4* src = (const f32x4*)(cfl + ((size_t)pg * PAGE + 2 * F.lane) * 8);
    const f32x4 a0 = src[0], a1 = src[1], b0 = src[2], b1 = src[3];
    const float ra[8] = {a0.x, a0.y, a0.z, a0.w, a1.x, a1.y, a1.z, a1.w}, rb[8] = {b0.x, b0.y, b0.z, b0.w, b1.x, b1.y, b1.z, b1.w};
#pragma unroll
    for (int h = 0; h < 8; ++h) {
        const float ps = ra[h] + rb[h]; float v = ps;
#pragma unroll
        for (int o = 1; o < 64; o <<= 1) { const float t = __shfl_down(v, o); if (F.lane + o < 64) v += t; }
        const float exs = v - ps;
        *(f32x2*)(SW + (size_t)(bs * 8 + h) * PASTL + p * PAGE + 2 * F.lane) = (f32x2){exs + rb[h], exs};
        if (F.lane == 0) PTOT[(bs * 8 + h) * NPAGES + p] = v;
    }
}
__device__ __forceinline__ void fox_attn_unit(const Frame& F, const bf16* QF, const bf16* KF, const bf16* VF, const float* LC, const float* BT, const float* FN, bf16* merged, int b, int h, int qb) {
    int tid = F.wave * 64 + lane_id(); asm volatile("" : "+v"(tid));
    const int lane = tid & 63, r32 = lane & 31, hi = lane >> 5, wid = F.wave;
    const size_t rowbase = (size_t)b * SEQ; const int q0 = qb * 256;
    LAS unsigned char* Ks = F.lds; LAS unsigned char* Vs = F.lds + 8192; LAS float* KBs = (LAS float*)(F.lds + 20480); LAS float* WSF = (LAS float*)(F.lds + 20736) + wid * 32;
    const bf16* Qw = QF + (rowbase + q0 + wid * 32 + r32) * 512 + h * 64;
    bf16x8 qr[4];
#pragma unroll
    for (int d0 = 0; d0 < 4; ++d0) qr[d0] = *(const bf16x8*)(Qw + d0 * 16 + hi * 8);
    const float* lcp = LC + (size_t)(b * 8 + h) * SEQ;
    const float btv = (lane < 32) ? BT[(b * 8 + h) * 32 + lane] : 0.f;
    const float lcq0 = lcp[q0];
    const float kn_raw = (lane < 32) ? FN[((b * 8 + h) * 32 + lane) * 2 + 1] : 0.f;
    const float fnq = FN[((b * 8 + h) * 32 + qb) * 2];
    const int tl0 = q0 / 64 - 1 - lane; const int tlc0 = tl0 < 0 ? 0 : tl0;
    const float lcs0 = lcp[tlc0 * 64 + 63];
    float pbx; { float v = btv;
#pragma unroll
        for (int o = 1; o < 64; o <<= 1) { const float t = __shfl_up(v, o); if (lane >= o) v += t; }
        pbx = v - btv; }
    const float cref = lcq0 + __shfl(pbx, qb);
#define FOX_KB(t_, pos_) (-LOG2E * ((lcp[pos_] + __shfl(pbx, (t_) >> 2)) - cref))
    const int NT = (q0 + 256) / 64;
    int t0 = 0;
    {
        float kn = kn_raw;
#pragma unroll
        for (int o = 1; o < 64; o <<= 1) kn = fmaxf(kn, __shfl_xor(kn, o));
        const float qk2 = 2.f * sqrtf(fnq) * sqrtf(kn) * 1.01f;
        const int nbefore = q0 / 64;
        int found = -1;
        for (int base = 0; base < nbefore && found < 0; base += 64) {
            const int tl = nbefore - 1 - base - lane;
            const int tlc = tl < 0 ? 0 : tl; const float lcv = (base == 0) ? lcs0 : lcp[tlc * 64 + 63]; const float kbl = -LOG2E * ((lcv + __shfl(pbx, tlc >> 2)) - cref);
            const bool dead = (tl >= 0) && (qk2 + kbl < -FOX_SKIP);
            const unsigned long long bm = __ballot(dead);
            if (bm) found = nbefore - 1 - base - (int)__builtin_ctzll(bm);
        }
        t0 = found + 1;
        t0 = __builtin_amdgcn_readfirstlane(t0);
    }
    const int kkey = tid >> 3, kch = tid & 7, vkey = tid >> 3, vch = tid & 7;
    const bf16* ksrc = KF + (rowbase + kkey) * 512 + h * 64 + kch * 8;
    const bf16* vsrc = VF + (rowbase + vkey) * 512 + h * 64 + vch * 8;
    v4u kreg[2], vreg[2]; float kbreg[2];
#pragma unroll
    for (int hb = 0; hb < 2; ++hb) { const int tt = (t0 + hb < NT) ? t0 + hb : t0;
        kreg[hb] = *(const v4u*)(ksrc + (size_t)tt * 64 * 512); vreg[hb] = *(const v4u*)(vsrc + (size_t)tt * 64 * 512); kbreg[hb] = FOX_KB(tt, tt * 64 + (tid & 63)); }
    float m_run = -INFINITY, l_run = 0.f; f32x16 o0 = {}, o1 = {};
    const int qpos = q0 + wid * 32 + r32;
    const int vbase = (4 * hi + ((lane & 15) >> 2)) * 192 + (16 * ((lane >> 4) & 1) + 4 * (lane & 3)) * 2;
    LAS unsigned char* const Ks0 = Ks; LAS unsigned char* const Vs0 = Vs; LAS float* const KBs0 = KBs;
    __syncthreads();
    for (int t2 = t0; t2 < NT; t2 += 2) {
#pragma unroll
      for (int hb = 0; hb < 2; ++hb) {
        const int t = t2 + hb;
        if (t < NT) {
        LAS unsigned char* const Ks = Ks0 + hb * 28672; LAS unsigned char* const Vs = Vs0 + hb * 28672; LAS float* const KBs = (LAS float*)((LAS unsigned char*)KBs0 + hb * 28672);
        *(LAS v4u*)(Ks + kkey * 128 + ((kch ^ (kkey & 7)) << 4)) = kreg[hb];            *(LAS v4u*)(Vs + vkey * 192 + vch * 16) = vreg[hb]; if (tid < 64) KBs[tid] = kbreg[hb];
        __syncthreads();
        if (t + 2 < NT) { kreg[hb] = *(const v4u*)(ksrc + (size_t)(t + 2) * 64 * 512); vreg[hb] = *(const v4u*)(vsrc + (size_t)(t + 2) * 64 * 512); kbreg[hb] = FOX_KB(t + 2, (t + 2) * 64 + (tid & 63)); }
        const int k0 = t * 64;
        if (k0 <= q0 + wid * 32 + 31) {
        f32x16 p0, p1;
#pragma unroll
        for (int g = 0; g < 4; ++g) { const f32x4 ba = *(const LAS f32x4*)(KBs + 8 * g + 4 * hi), bb = *(const LAS f32x4*)(KBs + 32 + 8 * g + 4 * hi);
#pragma unroll
            for (int i = 0; i < 4; ++i) { p0[4 * g + i] = ba[i]; p1[4 * g + i] = bb[i]; } }
#pragma unroll
        for (int d0 = 0; d0 < 4; ++d0) {
            const bf16x8 a0 = *(const LAS bf16x8*)(Ks + r32 * 128 + (((2 * d0 + hi) ^ (r32 & 7)) << 4)), a1 = *(const LAS bf16x8*)(Ks + (r32 + 32) * 128 + (((2 * d0 + hi) ^ (r32 & 7)) << 4));
            p0 = __builtin_amdgcn_mfma_f32_32x32x16_bf16(a0, qr[d0], p0, 0, 0, 0); p1 = __builtin_amdgcn_mfma_f32_32x32x16_bf16(a1, qr[d0], p1, 0, 0, 0);
        }
        if (k0 + 63 > q0 + wid * 32) {
#pragma unroll
            for (int r = 0; r < 16; ++r) { const int key = k0 + crow(r, hi); if (key > qpos) p0[r] = -INFINITY; if (key + 32 > qpos) p1[r] = -INFINITY; }
        }
        float mx = fmaxf(p0[0], p1[0]);
#pragma unroll
        for (int r = 1; r < 16; ++r) mx = fmaxf(mx, fmaxf(p0[r], p1[r]));
        mx = fmaxf(mx, __shfl_xor(mx, 32));
        const float m_new = fmaxf(m_run, mx), alpha = fexp2(m_run - m_new); m_run = m_new;
        float ls = 0.f;
#pragma unroll
        for (int r = 0; r < 16; ++r) { p0[r] = fexp2(p0[r] - m_new); p1[r] = fexp2(p1[r] - m_new); ls += p0[r] + p1[r]; }
        l_run = l_run * alpha + ls;
        if (__ballot(alpha != 1.f) != 0ull) {
            if (hi == 0) WSF[r32] = alpha;
#pragma unroll
            for (int g = 0; g < 4; ++g) { const f32x4 al = *(const LAS f32x4*)(WSF + 8 * g + 4 * hi);
#pragma unroll
                for (int i = 0; i < 4; ++i) { o0[4 * g + i] *= al[i]; o1[4 * g + i] *= al[i]; } }
        }
        v4u pw[4];
#pragma unroll
        for (int j = 0; j < 4; ++j) { pw[0][j] = pg8::cvt_pk_bf16(p0[2 * j], p0[2 * j + 1]); pw[1][j] = pg8::cvt_pk_bf16(p0[8 + 2 * j], p0[8 + 2 * j + 1]);
                                      pw[2][j] = pg8::cvt_pk_bf16(p1[2 * j], p1[2 * j + 1]); pw[3][j] = pg8::cvt_pk_bf16(p1[8 + 2 * j], p1[8 + 2 * j + 1]); }
#pragma unroll
        for (int ks = 0; ks < 4; ++ks) {
            const bf16x8 pa = __builtin_bit_cast(bf16x8, pw[ks]);
#pragma unroll
            for (int d0 = 0; d0 < 2; ++d0) {
                const s16x4 lo = lds_tr16(Vs + vbase + ks * 16 * 192 + d0 * 64), hi4 = lds_tr16(Vs + vbase + ks * 16 * 192 + 8 * 192 + d0 * 64);
                const bf16x8 vb = (bf16x8){lo[0], lo[1], lo[2], lo[3], hi4[0], hi4[1], hi4[2], hi4[3]};
                if (d0 == 0) o0 = __builtin_amdgcn_mfma_f32_32x32x16_bf16(pa, vb, o0, 0, 0, 0); else o1 = __builtin_amdgcn_mfma_f32_32x32x16_bf16(pa, vb, o1, 0, 0, 0);
            }
        }
        }
        }
      }
    }
    l_run += __shfl_xor(l_run, 32);
    if (hi == 0) WSF[r32] = 1.f / l_run;
    bf16* Ow = merged + (rowbase + q0 + wid * 32) * DM + h * 64 + r32;
#pragma unroll
    for (int g = 0; g < 4; ++g) { const f32x4 rl = *(const LAS f32x4*)(WSF + 8 * g + 4 * hi);
#pragma unroll
        for (int i = 0; i < 4; ++i) { const int r = 4 * g + i; const int row = crow(r, hi);
            Ow[(size_t)row * DM] = (bf16)f2bf(o0[r] * rl[i]); Ow[(size_t)row * DM + 32] = (bf16)f2bf(o1[r] * rl[i]); } }
    __syncthreads();
#undef FOX_KB
}

template <int D> struct DecW {
    static constexpr int KS = D / 32;
    static constexpr int LPK = D / 4;
    static constexpr int KPI = 64 / LPK;
    float m[4], l[4]; float o[8][4];
};
template <int D>
__device__ __forceinline__ void dec_init(DecW<D>& w) {
#pragma unroll
    for (int i = 0; i < 4; ++i) { w.m[i] = -INFINITY; w.l[i] = 0.f; }
#pragma unroll
    for (int q = 0; q < 8; ++q)
#pragma unroll
        for (int j = 0; j < 4; ++j) w.o[q][j] = 0.f;
}
template <int D, int NTILE, int MODE>
__device__ __forceinline__ void dec_chunk(DecW<D>& w, const bf16x8 (&qa)[D / 32], const float* Kb, const float* Vb, int stride, const float* bias, float nb, LAS float* PL, int lane) {
    constexpr int KS = D / 32, LPK = D / 4, KPI = 64 / LPK;
    constexpr int NK = (MODE == 1) ? 8 : NTILE * 16, NV = NK / KPI;
    const int key = lane & 15, kq = lane >> 4;
    const unsigned koff = (unsigned)(key * stride + 8 * kq) * 4u;
    const int d4 = lane % LPK, ksub = lane / LPK;
    const unsigned voff = (unsigned)(ksub * stride + 4 * d4) * 4u;
    f32x4 kx[NTILE][2 * KS], vx[NV];
#pragma unroll
    for (int t = 0; t < NTILE; ++t) { const char* kp = (const char*)(Kb + (size_t)t * 16 * stride) + koff;
#pragma unroll
        for (int ks = 0; ks < KS; ++ks) { kx[t][2 * ks] = *(const f32x4*)(kp + 128 * ks); kx[t][2 * ks + 1] = *(const f32x4*)(kp + 128 * ks + 16); } }
    constexpr int NVA = (NV >= 8) ? NV / 2 : NV;
#pragma unroll
    for (int kk = 0; kk < NVA; ++kk) vx[kk] = *(const f32x4*)((const char*)(Vb + (size_t)kk * KPI * stride) + voff);
    f32x4 s[NTILE];
#pragma unroll
    for (int t = 0; t < NTILE; ++t) {
        f32x4 acc = {0.f, 0.f, 0.f, 0.f};
#pragma unroll
        for (int ks = 0; ks < KS; ++ks) { const f32x4 x0 = kx[t][2 * ks], x1 = kx[t][2 * ks + 1];
            v4u kb; kb.x = pg8::cvt_pk_bf16(x0.x, x0.y); kb.y = pg8::cvt_pk_bf16(x0.z, x0.w); kb.z = pg8::cvt_pk_bf16(x1.x, x1.y); kb.w = pg8::cvt_pk_bf16(x1.z, x1.w);
            acc = __builtin_amdgcn_mfma_f32_16x16x32_bf16(qa[ks], __builtin_bit_cast(bf16x8, kb), acc, 0, 0, 0); }
        if (MODE == 0) { if (bias) { const float bv = (bias[t * 16 + key] + nb) * LOG2E; acc += bv; } }
        else { acc += nb;
#pragma unroll
            for (int i = 0; i < 4; ++i) if (key > 4 * kq + i || key >= 8) acc[i] = -INFINITY; }
        s[t] = acc;
    }
#pragma unroll
    for (int kk = NVA; kk < NV; ++kk) vx[kk] = *(const f32x4*)((const char*)(Vb + (size_t)kk * KPI * stride) + voff);
    f32x4 mc = s[0];
#pragma unroll
    for (int t = 1; t < NTILE; ++t) { mc.x = fmaxf(mc.x, s[t].x); mc.y = fmaxf(mc.y, s[t].y); mc.z = fmaxf(mc.z, s[t].z); mc.w = fmaxf(mc.w, s[t].w); }
    mc.x = max16_f32(mc.x); mc.y = max16_f32(mc.y); mc.z = max16_f32(mc.z); mc.w = max16_f32(mc.w);
    float al[4];
#pragma unroll
    for (int i = 0; i < 4; ++i) { const float mn = fmaxf(w.m[i], mc[i]); al[i] = (mn == -INFINITY) ? 1.f : fexp2(w.m[i] - mn); w.m[i] = mn; w.l[i] *= al[i]; }
#pragma unroll
    for (int t = 0; t < NTILE; ++t) { f32x4 p;
#pragma unroll
        for (int i = 0; i < 4; ++i) { p[i] = (w.m[i] == -INFINITY) ? 0.f : fexp2(s[t][i] - w.m[i]); w.l[i] += p[i]; }
        if (kq < 2) *(LAS f32x4*)(PL + (t * 16 + key) * 8 + 4 * kq) = p; }
    if (key == 0 && kq < 2) *(LAS f32x4*)(PL + 1024 + 4 * kq) = (f32x4){al[0], al[1], al[2], al[3]};
    { const f32x4 a0 = *(const LAS f32x4*)(PL + 1024), a1 = *(const LAS f32x4*)(PL + 1028);
#pragma unroll
      for (int j = 0; j < 4; ++j) { w.o[0][j] *= a0.x; w.o[1][j] *= a0.y; w.o[2][j] *= a0.z; w.o[3][j] *= a0.w; w.o[4][j] *= a1.x; w.o[5][j] *= a1.y; w.o[6][j] *= a1.z; w.o[7][j] *= a1.w; } }
#pragma unroll
    for (int kk = 0; kk < NV; ++kk) { const int k = kk * KPI + ksub;
        const f32x4 v = vx[kk];
        const f32x4 pa = *(const LAS f32x4*)(PL + k * 8), pb = *(const LAS f32x4*)(PL + k * 8 + 4);
#pragma unroll
        for (int j = 0; j < 4; ++j) { w.o[0][j] += pa.x * v[j]; w.o[1][j] += pa.y * v[j]; w.o[2][j] += pa.z * v[j]; w.o[3][j] += pa.w * v[j];
                                      w.o[4][j] += pb.x * v[j]; w.o[5][j] += pb.y * v[j]; w.o[6][j] += pb.z * v[j]; w.o[7][j] += pb.w * v[j]; } }
}
__device__ __forceinline__ void dec_page_fox(DecW<64>& w, const bf16x8 (&qa)[2], const float* Kb, const float* Vb, const float* bias, float boff, LAS float* PL, int lane) {
    constexpr int stride = 512;
    const int key = lane & 15, kq = lane >> 4;
    const unsigned koff = (unsigned)(key * stride + 8 * kq) * 4u;
    const int d4 = lane & 15, ksub = lane >> 4;
    const unsigned voff = (unsigned)(ksub * stride + 4 * d4) * 4u;
    const __amdgpu_buffer_rsrc_t krs = __builtin_amdgcn_make_buffer_rsrc((void*)Kb, 0, 0x7fffffff, 0x00020000);
    const __amdgpu_buffer_rsrc_t vrs = __builtin_amdgcn_make_buffer_rsrc((void*)Vb, 0, 0x7fffffff, 0x00020000);
    const __amdgpu_buffer_rsrc_t brs = __builtin_amdgcn_make_buffer_rsrc((void*)bias, 0, 0x7fffffff, 0x00020000);
    f32x4 s[8];
#pragma unroll
    for (int hb = 0; hb < 2; ++hb) {
        f32x4 kx[4][4];
#pragma unroll
        for (int t = 0; t < 4; ++t) { const int so = (hb * 4 + t) * 16 * stride * 4;
            kx[t][0] = __builtin_bit_cast(f32x4, __builtin_amdgcn_raw_buffer_load_b128(krs, (int)koff, so, 0)); kx[t][1] = __builtin_bit_cast(f32x4, __builtin_amdgcn_raw_buffer_load_b128(krs, (int)koff + 16, so, 0));
            kx[t][2] = __builtin_bit_cast(f32x4, __builtin_amdgcn_raw_buffer_load_b128(krs, (int)koff + 128, so, 0)); kx[t][3] = __builtin_bit_cast(f32x4, __builtin_amdgcn_raw_buffer_load_b128(krs, (int)koff + 144, so, 0)); }
#pragma unroll
        for (int t = 0; t < 4; ++t) {
            f32x4 acc = {0.f, 0.f, 0.f, 0.f};
#pragma unroll
            for (int ks = 0; ks < 2; ++ks) { const f32x4 x0 = kx[t][2 * ks], x1 = kx[t][2 * ks + 1];
                v4u kb; kb.x = pg8::cvt_pk_bf16(x0.x, x0.y); kb.y = pg8::cvt_pk_bf16(x0.z, x0.w); kb.z = pg8::cvt_pk_bf16(x1.x, x1.y); kb.w = pg8::cvt_pk_bf16(x1.z, x1.w);
                acc = __builtin_amdgcn_mfma_f32_16x16x32_bf16(qa[ks], __builtin_bit_cast(bf16x8, kb), acc, 0, 0, 0); }
            acc += (__builtin_bit_cast(float, __builtin_amdgcn_raw_buffer_load_b32(brs, key * 4, (hb * 4 + t) * 64, 0)) + boff) * LOG2E;
            s[hb * 4 + t] = acc;
        }
        asm volatile("" ::: "memory");
    }
    f32x4 mc = s[0];
#pragma unroll
    for (int t = 1; t < 8; ++t) { mc.x = fmaxf(mc.x, s[t].x); mc.y = fmaxf(mc.y, s[t].y); mc.z = fmaxf(mc.z, s[t].z); mc.w = fmaxf(mc.w, s[t].w); }
    mc.x = max16_f32(mc.x); mc.y = max16_f32(mc.y); mc.z = max16_f32(mc.z); mc.w = max16_f32(mc.w);
    float al[4];
#pragma unroll
    for (int i = 0; i < 4; ++i) { const float mn = fmaxf(w.m[i], mc[i]); al[i] = fexp2(w.m[i] - mn); w.m[i] = mn; w.l[i] *= al[i]; }
    bool nz = false;
#pragma unroll
    for (int t = 0; t < 8; ++t) { f32x4 p;
#pragma unroll
        for (int i = 0; i < 4; ++i) { p[i] = fexp2(s[t][i] - w.m[i]); w.l[i] += p[i]; nz = nz || (p[i] != 0.f); }
        if (kq < 2) *(LAS f32x4*)(PL + (t * 16 + key) * 8 + 4 * kq) = p; }
    if (__ballot(nz && kq < 2) == 0ull) return;
    if (key == 0 && kq < 2) *(LAS f32x4*)(PL + 1024 + 4 * kq) = (f32x4){al[0], al[1], al[2], al[3]};
    { const f32x4 a0 = *(const LAS f32x4*)(PL + 1024), a1 = *(const LAS f32x4*)(PL + 1028);
#pragma unroll
      for (int j = 0; j < 4; ++j) { w.o[0][j] *= a0.x; w.o[1][j] *= a0.y; w.o[2][j] *= a0.z; w.o[3][j] *= a0.w; w.o[4][j] *= a1.x; w.o[5][j] *= a1.y; w.o[6][j] *= a1.z; w.o[7][j] *= a1.w; } }
#pragma unroll 1
    for (int vh = 0; vh < 2; ++vh) {
    f32x4 vx[16];
#pragma unroll
    for (int kk = 0; kk < 16; ++kk) vx[kk] = __builtin_bit_cast(f32x4, __builtin_amdgcn_raw_buffer_load_b128(vrs, (int)voff, (vh * 16 + kk) * 4 * stride * 4, 0));
#pragma unroll
    for (int kk = 0; kk < 16; ++kk) { const int k = (vh * 16 + kk) * 4 + ksub;
        const f32x4 v = vx[kk];
        const f32x4 pa = *(const LAS f32x4*)(PL + k * 8), pb = *(const LAS f32x4*)(PL + k * 8 + 4);
#pragma unroll
        for (int j = 0; j < 4; ++j) { w.o[0][j] += pa.x * v[j]; w.o[1][j] += pa.y * v[j]; w.o[2][j] += pa.z * v[j]; w.o[3][j] += pa.w * v[j];
                                      w.o[4][j] += pb.x * v[j]; w.o[5][j] += pb.y * v[j]; w.o[6][j] += pb.z * v[j]; w.o[7][j] += pb.w * v[j]; } }
    }
}
template <int D>
__device__ __forceinline__ void dec_park(DecW<D>& w, LAS float* CBw, int lane) {
    constexpr int LPK = D / 4;
    const int key = lane & 15, kq = lane >> 4, d4 = lane % LPK, ksub = lane / LPK;
#pragma unroll
    for (int i = 0; i < 4; ++i) { float l = w.l[i];
        l = sum16_f32(l);
        w.l[i] = l; }
    if (key == 0 && kq < 2) { *(LAS f32x4*)(CBw + 4 * kq) = (f32x4){w.m[0], w.m[1], w.m[2], w.m[3]}; *(LAS f32x4*)(CBw + 8 + 4 * kq) = (f32x4){w.l[0], w.l[1], w.l[2], w.l[3]}; }
#pragma unroll
    for (int q = 0; q < 8; ++q) { f32x4 v = (f32x4){w.o[q][0], w.o[q][1], w.o[q][2], w.o[q][3]};
        if (LPK < 64) {
#pragma unroll
            for (int o = LPK; o < 64; o <<= 1) { if (o == 16) { v.x += xor16_f32(v.x); v.y += xor16_f32(v.y); v.z += xor16_f32(v.z); v.w += xor16_f32(v.w); }
                else { v.x += __shfl_xor(v.x, o); v.y += __shfl_xor(v.y, o); v.z += __shfl_xor(v.z, o); v.w += __shfl_xor(v.w, o); } } }
        if (ksub == 0) *(LAS f32x4*)(CBw + 16 + q * D + 4 * d4) = v; }
}
template <int D>
__device__ __forceinline__ void dec_combine(int tid, LAS float* CB, bf16* dst, int ldd) {
    constexpr int WSTR = 16 + 8 * D;
    for (int e = tid; e < 8 * D; e += NTHR) { const int q = e / D, d = e % D;
        float mt = -INFINITY;
#pragma unroll
        for (int w = 0; w < 8; ++w) mt = fmaxf(mt, CB[w * WSTR + q]);
        float num = 0.f, den = 0.f;
#pragma unroll
        for (int w = 0; w < 8; ++w) { const float mw = CB[w * WSTR + q]; const float f = (mw == -INFINITY) ? 0.f : fexp2(mw - mt); num += f * CB[w * WSTR + 16 + q * D + d]; den += f * CB[w * WSTR + 8 + q]; }
        dst[(size_t)q * ldd + d] = (bf16)f2bf(num / den); }
}
template <int D>
__device__ __forceinline__ void dec_load_q(bf16x8 (&qa)[D / 32], const bf16* Q, int ldq, int lane) {
    const int row = lane & 15, kq = lane >> 4;
#pragma unroll
    for (int ks = 0; ks < D / 32; ++ks) { v4u z = {0u, 0u, 0u, 0u}; if (row < 8) z = *(const v4u*)(Q + (size_t)row * ldq + 32 * ks + 8 * kq); qa[ks] = __builtin_bit_cast(bf16x8, z); }
}
constexpr int DEC_PL = 1040;
__device__ __forceinline__ void fox_sample_unit(const Frame& F, const Args& a, int u) {
    unsigned char* ws = a.ws; const int bs = u >> 3, h = u & 7;
    int ln = lane_id(); asm volatile("" : "+v"(ln));
    LAS float* PL = (LAS float*)F.lds + F.wave * DEC_PL; LAS float* CB = (LAS float*)F.lds + 8 * DEC_PL; constexpr int WSTR = 16 + 8 * 64;
    bf16x8 qa[2]; dec_load_q<64>(qa, (const bf16*)(ws + WS_QF) + (size_t)(TP + bs * LS) * 512 + h * 64, 512, ln);
    DecW<64> w; dec_init(w);
    {
        const int key = ln & 15; const float* lf = a.out + O_LFS + (size_t)(bs * LS) * 8 + h; float cn = 0.f;
#pragma unroll
        for (int j = 0; j < 8; ++j) { const float x = lf[j * 8]; cn += (j <= key) ? x : 0.f; }
        const float* Kb = a.out + O_FKS + (size_t)(bs * LS) * 512 + h * 64; const float* Vb = a.out + O_FVS + (size_t)(bs * LS) * 512 + h * 64;
        dec_chunk<64, 1, 1>(w, qa, Kb, Vb, 512, nullptr, -cn * LOG2E, PL, ln);
        if (F.wave != 0) {
#pragma unroll
            for (int i = 0; i < 4; ++i) w.l[i] = 0.f;
#pragma unroll
            for (int q = 0; q < 8; ++q)
#pragma unroll
                for (int j = 0; j < 4; ++j) w.o[q][j] = 0.f; }
    }
    const int* pt = (const int*)a.in[I_PT];
    float spx; { const float ptv = (ln < 16) ? ((const float*)(ws + WS_MISC + 2 * MiB))[(bs * 8 + h) * NPAGES + ln] : 0.f; float v = ptv;
#pragma unroll
        for (int o = 1; o < 16; o <<= 1) { const float t = __builtin_bit_cast(float, __builtin_amdgcn_ds_bpermute((ln + o) << 2, __builtin_bit_cast(int, v))); if (ln + o < 16) v += t; }
        spx = v - ptv; }
#if defined(OLD_FOXS)
#pragma unroll 1
    for (int pp = 0; pp < 4; ++pp) { const int p = F.wave * 2 + (pp >> 1), hf = pp & 1; const int pg = __builtin_amdgcn_readfirstlane(pt[bs * NPAGES + p]);
        const float* Kb = (const float*)a.in[I_CFK] + (((size_t)pg * PAGE + hf * 64) * 8 + h) * 64; const float* Vb = (const float*)a.in[I_CFV] + (((size_t)pg * PAGE + hf * 64) * 8 + h) * 64;
        dec_chunk<64, 4, 0>(w, qa, Kb, Vb, 512, (const float*)(ws + WS_SUF) + (size_t)(bs * 8 + h) * PASTL + p * PAGE + hf * 64, __builtin_bit_cast(float, __builtin_amdgcn_ds_bpermute(p << 2, __builtin_bit_cast(int, spx))), PL, ln); }
#else
#pragma unroll 1
    for (int pp = 1; pp >= 0; --pp) { const int p = pp ? (NPAGES - 1 - F.wave) : F.wave;
        const int pg = __builtin_amdgcn_readfirstlane(pt[bs * NPAGES + p]);
        const float* Kb = (const float*)a.in[I_CFK] + ((size_t)pg * PAGE * 8 + h) * 64; const float* Vb = (const float*)a.in[I_CFV] + ((size_t)pg * PAGE * 8 + h) * 64;
        dec_page_fox(w, qa, Kb, Vb, (const float*)(ws + WS_SUF) + (size_t)(bs * 8 + h) * PASTL + p * PAGE, __builtin_bit_cast(float, __builtin_amdgcn_ds_bpermute(p << 2, __builtin_bit_cast(int, spx))), PL, ln); }
#endif
    dec_park<64>(w, CB + F.wave * WSTR, ln);
    __syncthreads();
    dec_combine<64>(F.wave * 64 + ln, CB, (bf16*)(ws + WS_MERGED) + (size_t)(TP + bs * LS) * DM + h * 64, DM);
    __syncthreads();
}
__device__ __forceinline__ void cross_sample_unit(const Frame& F, const Args& a, int u) {
    unsigned char* ws = a.ws; const int bs = u >> 2, h = u & 3;
    LAS float* PL = (LAS float*)F.lds + F.wave * DEC_PL; LAS float* CB = (LAS float*)F.lds + 8 * DEC_PL; constexpr int WSTR = 16 + 8 * 256;
    bf16x8 qa[8]; dec_load_q<256>(qa, (const bf16*)(ws + WS_QC) + (size_t)(TP + bs * LS) * DM + h * 256, DM, F.lane);
    DecW<256> w; dec_init(w);
    const float* Kb = (const float*)a.in[I_CMK] + ((size_t)(bs * 256 + F.wave * 32) * 4 + h) * 256; const float* Vb = (const float*)a.in[I_CMV] + ((size_t)(bs * 256 + F.wave * 32) * 4 + h) * 256;
#pragma unroll 1
    for (int c = 0; c < 2; ++c) dec_chunk<256, 1, 0>(w, qa, Kb + (size_t)c * 16 * 1024, Vb + (size_t)c * 16 * 1024, 1024, nullptr, 0.f, PL, F.lane);
    dec_park<256>(w, CB + F.wave * WSTR, F.lane);
    __syncthreads();
    dec_combine<256>(F.tid, CB, (bf16*)(ws + WS_OC) + (size_t)(TP + bs * LS) * DM + h * 256, DM);
    __syncthreads();
}


__device__ __forceinline__ void gla_g3_unit(const Frame& F, const Args& a, int u) {
    unsigned char* ws = a.ws;
    const int b = u >> 9, h = (u >> 7) & 3, n = u & 127; const int row0 = b * SEQ + n * 64;
    LAS unsigned char* KIB = F.lds; LAS unsigned char* ATTB = F.lds + 34816; LAS unsigned char* QDB = F.lds + 44032;
    LAS unsigned char* VSB = F.lds + 53248; LAS unsigned char* SPB = F.lds + 73728; LAS float* OS = (LAS float*)(F.lds + 94208);
#pragma unroll
    for (int i = 0; i < 2; ++i) { const int c = F.tid + NTHR * i; *(LAS v4u*)(VSB + (c >> 4) * 320 + (c & 15) * 16) = *(const v4u*)((const bf16*)(ws + WS_GV) + (size_t)(row0 + (c >> 4)) * 512 + h * 128 + (c & 15) * 8); }
#pragma unroll
    for (int i = 0; i < 4; ++i) { const int c4 = F.tid + NTHR * i; const f32x4 sp = *(const f32x4*)((const float*)(ws + WS_GKV) + ((size_t)((b * 4 + h) * 128 + n) * 64) * 128 + 4 * c4);
        v2u o; o.x = pg8::cvt_pk_bf16(sp.x, sp.y); o.y = pg8::cvt_pk_bf16(sp.z, sp.w); *(LAS v2u*)(SPB + (c4 >> 5) * 320 + (c4 & 31) * 8) = o; }
#pragma unroll
    for (int i = 0; i < 2; ++i) { const int c4 = F.tid + NTHR * i, t = c4 >> 4, d4 = (c4 & 15) * 4; const size_t gi = (size_t)(row0 + t) * 256 + h * 64 + d4;
        const f32x4 bb = *(const f32x4*)((const float*)(ws + WS_BB) + gi);
        const v2u qq = *(const v2u*)((const bf16*)(ws + WS_GQ) + gi), kk = *(const v2u*)((const bf16*)(ws + WS_GK) + gi);
        v2u qo, ko; qo.x = pg8::cvt_pk_bf16(bflo(qq.x) * __expf(bb.x), bfhi(qq.x) * __expf(bb.y)); qo.y = pg8::cvt_pk_bf16(bflo(qq.y) * __expf(bb.z), bfhi(qq.y) * __expf(bb.w));
        ko.x = pg8::cvt_pk_bf16(bflo(kk.x) * __expf(-bb.x), bfhi(kk.x) * __expf(-bb.y)); ko.y = pg8::cvt_pk_bf16(bflo(kk.y) * __expf(-bb.z), bfhi(kk.y) * __expf(-bb.w));
        *(LAS v2u*)(QDB + t * 144 + d4 * 2) = qo; *(LAS v2u*)(KIB + t * 144 + d4 * 2) = ko; }
    float grv[8][2]; float gg0, gg1;
    { const float* ggo = (const float*)a.in[I_GGO] + h * 128; gg0 = ggo[F.lane]; gg1 = ggo[64 + F.lane];
#pragma unroll
      for (int rr = 0; rr < 8; ++rr) { const BfPtr gr = GLD(ws + WS_GR) + ((size_t)(row0 + F.wave * 8 + rr) * 512 + h * 128); grv[rr][0] = gr[F.lane]; grv[rr][1] = gr[64 + F.lane]; } }
    __syncthreads();
    {
        const int lane = F.lane, r32 = lane & 31, hi = lane >> 5;
        if (F.wave < 4) { const int tb = F.wave >> 1, sb = F.wave & 1; f32x16 acc = {};
            if (sb <= tb) {
                const LAS unsigned char* qrow = QDB + (32 * tb + r32) * 144; const LAS unsigned char* krow = KIB + (32 * sb + r32) * 144;
#pragma unroll
                for (int ks = 0; ks < 4; ++ks) acc = __builtin_amdgcn_mfma_f32_32x32x16_bf16(row_frag(qrow, ks, hi), row_frag(krow, ks, hi), acc, 0, 0, 0);
            }
#pragma unroll
            for (int r = 0; r < 16; ++r) { const int t = 32 * tb + crow(r, hi), s2 = 32 * sb + r32; *(LAS unsigned short*)(ATTB + t * 144 + s2 * 2) = (unsigned short)f2bf(s2 <= t ? acc[r] : 0.f); }
        }
    }
    __syncthreads();
    {
        const int lane = F.lane, r32 = lane & 31, hi = lane >> 5, tb = F.wave >> 2, nb = F.wave & 3;
        const int trb = (4 * hi + ((lane & 15) >> 2)) * 320 + (16 * ((lane >> 4) & 1) + 4 * (lane & 3)) * 2 + 64 * nb;
        const LAS unsigned char* arow = ATTB + (32 * tb + r32) * 144; const LAS unsigned char* qrow = QDB + (32 * tb + r32) * 144;
        f32x16 acc = {};
#pragma unroll
        for (int ks = 0; ks < 4; ++ks) acc = __builtin_amdgcn_mfma_f32_32x32x16_bf16(row_frag(arow, ks, hi), tr_frag<320>(VSB + trb, ks), acc, 0, 0, 0);
#pragma unroll
        for (int ks = 0; ks < 4; ++ks) acc = __builtin_amdgcn_mfma_f32_32x32x16_bf16(row_frag(qrow, ks, hi), tr_frag<320>(SPB + trb, ks), acc, 0, 0, 0);
#pragma unroll
        for (int r = 0; r < 16; ++r) OS[(32 * tb + crow(r, hi)) * 128 + 32 * nb + r32] = acc[r];
    }
    __syncthreads();
#pragma unroll
    for (int rr = 0; rr < 8; ++rr) { const int t = F.wave * 8 + rr; const float v0 = OS[t * 128 + F.lane], v1 = OS[t * 128 + 64 + F.lane];
        const float r = rsqrtf(wave_sum(v0 * v0 + v1 * v1) * (1.f / 128.f) + EPS);
        bf16* mo = (bf16*)(ws + WS_MERGED) + (size_t)(row0 + t) * DM + 512 + h * 128;
        mo[F.lane] = (bf16)f2bf(v0 * r * gg0 * silu(grv[rr][0])); mo[64 + F.lane] = (bf16)f2bf(v1 * r * gg1 * silu(grv[rr][1])); }
    __syncthreads();
}

struct EpiSoftmaxP {
    static constexpr bool PERM = true, AFTER_DRAIN = true;
    const LAS unsigned long long* argp;
    __device__ __forceinline__ void fused(f32x4 (&acc)[2][2][4][2], const Unit&, int wr, int wc, int fr, int fq, PG8_LAS unsigned char* lds, int wid, int lane) const {
        LAS float* PM = (LAS float*)lds; LAS float* PS = PM + 1024;
        const int ub = (int)blockIdx.x; const int ldp = DM;
        bf16* P = (bf16*)((unsigned char*)ld_ptr(argp + N_INPUTS + 1) + WS_PC) + ((size_t)((ub >> 7) & 1) * SEQ + (ub & 31) * 256) * DM + ((ub >> 5) & 3) * 256;
        { int t2 = lane_id(); asm volatile("" : "+v"(t2)); fr = t2 & 15; fq = (t2 >> 4) & 3; }
#pragma unroll
        for (int ai = 0; ai < 2; ++ai)
#pragma unroll
            for (int m = 0; m < 4; ++m) { float mx = -INFINITY;
#pragma unroll
                for (int bj = 0; bj < 2; ++bj)
#pragma unroll
                    for (int n = 0; n < 2; ++n) { const f32x4 x = acc[ai][bj][m][n]; mx = fmaxf(mx, fmaxf(fmaxf(x[0], x[1]), fmaxf(x[2], x[3]))); }
                mx = fmaxf(mx, xor16_f32(mx)); mx = fmaxf(mx, __shfl_xor(mx, 32));
                if (fq == 0) PM[(ai * 128 + wr * 64 + m * 16 + fr) * 4 + wc] = mx; }
        asm volatile("s_waitcnt lgkmcnt(0)" ::: "memory"); __builtin_amdgcn_s_barrier(); asm volatile("" ::: "memory");
#pragma unroll
        for (int ai = 0; ai < 2; ++ai)
#pragma unroll
            for (int m = 0; m < 4; ++m) { const int r = ai * 128 + wr * 64 + m * 16 + fr; const f32x4 pm = *(const LAS f32x4*)(PM + r * 4);
                const float M = fmaxf(fmaxf(pm[0], pm[1]), fmaxf(pm[2], pm[3])); float s = 0.f;
#pragma unroll
                for (int bj = 0; bj < 2; ++bj)
#pragma unroll
                    for (int n = 0; n < 2; ++n) { f32x4 x = acc[ai][bj][m][n]; x[0] = fexp2(x[0] - M); x[1] = fexp2(x[1] - M); x[2] = fexp2(x[2] - M); x[3] = fexp2(x[3] - M); acc[ai][bj][m][n] = x; s += (x[0] + x[1]) + (x[2] + x[3]); }
                s += xor16_f32(s); s += __shfl_xor(s, 32);
                if (fq == 0) PS[r * 4 + wc] = s; }
        asm volatile("s_waitcnt lgkmcnt(0)" ::: "memory"); __builtin_amdgcn_s_barrier(); asm volatile("" ::: "memory");
#pragma unroll
        for (int ai = 0; ai < 2; ++ai)
#pragma unroll
            for (int m = 0; m < 4; ++m) { const int r = ai * 128 + wr * 64 + m * 16 + fr; const f32x4 ps = *(const LAS f32x4*)(PS + r * 4); const float inv = 1.f / ((ps[0] + ps[1]) + (ps[2] + ps[3]));
#pragma unroll
                for (int bj = 0; bj < 2; ++bj) { const f32x4 x0 = acc[ai][bj][m][0], x1 = acc[ai][bj][m][1];
                    v4u o; o.x = pg8::cvt_pk_bf16(x0[0] * inv, x0[1] * inv); o.y = pg8::cvt_pk_bf16(x0[2] * inv, x0[3] * inv); o.z = pg8::cvt_pk_bf16(x1[0] * inv, x1[1] * inv); o.w = pg8::cvt_pk_bf16(x1[2] * inv, x1[3] * inv);
                    *(v4u*)(P + (size_t)r * ldp + bj * 128 + wc * 32 + fq * 8) = o; } }
        asm volatile("s_waitcnt lgkmcnt(0)" ::: "memory"); __builtin_amdgcn_s_barrier(); asm volatile("" ::: "memory");
    }
};

__device__ __forceinline__ void rms_rows_phase(const Frame& F, const float* X, const float* g, bf16* H) {
    const int gw = F.vcu * NWAVES + F.wave, NGW = F.G * NWAVES;
    for (int m = gw; m < TA; m += NGW) rms_row_bf16(X + (size_t)m * DM, g, H + (size_t)m * DM, F.lane);
}

__device__ __forceinline__ unsigned f2sort(float f) { const unsigned u = __builtin_bit_cast(unsigned, f); return u ^ ((u >> 31) ? 0xFFFFFFFFu : 0x80000000u); }
__device__ __forceinline__ float sort2f(unsigned s) { const unsigned u = s ^ ((s >> 31) ? 0x80000000u : 0xFFFFFFFFu); return __builtin_bit_cast(float, u); }
__device__ __forceinline__ float gelu_tanh(float x) { const float y = 0.7978845608028654f * (x + 0.044715f * x * x * x); const float e = __expf(2.f * y); return 0.5f * x * (1.f + (1.f - 2.f / (e + 1.f))); }
__device__ __forceinline__ unsigned gmax16(unsigned v) { return max16_u32(v); }
typedef __bf16 bf16x2_t __attribute__((ext_vector_type(2)));
__device__ __forceinline__ float dot2bf(unsigned a, unsigned b, float c) {
#if __has_builtin(__builtin_amdgcn_fdot2_f32_bf16)
    return __builtin_amdgcn_fdot2_f32_bf16(__builtin_bit_cast(bf16x2_t, a), __builtin_bit_cast(bf16x2_t, b), c, false);
#else
    return c + bflo(a) * bflo(b) + bfhi(a) * bfhi(b);
#endif
}
template <bool SPLIT>
__device__ __forceinline__ void peer_token(const Frame& F, const Args& a, int row, LAS unsigned* TOPS, const LAS unsigned* CT, int half, LAS float* PART) {
    unsigned char* ws = a.ws; const int lane = lane_id(), grp = lane >> 4, j16 = lane & 15;
    const bf16* sc = (const bf16*)(ws + WS_SC) + (size_t)row * 2048;
#pragma unroll 1
    for (int bt = 0; bt < 4; ++bt) {
        const v4u xq = *(const v4u*)(sc + (bt * 4 + grp) * 128 + 8 * j16);
        unsigned k[8]; const float xs[8] = {bflo(xq.x), bfhi(xq.x), bflo(xq.y), bfhi(xq.y), bflo(xq.z), bfhi(xq.z), bflo(xq.w), bfhi(xq.w)};
#pragma unroll
        for (int e = 0; e < 8; ++e) k[e] = (f2sort(xs[e]) & ~127u) | (unsigned)(127 - (8 * j16 + e));
#define PEER_CE(i, j) { const unsigned hi_ = k[i] > k[j] ? k[i] : k[j], lo_ = k[i] > k[j] ? k[j] : k[i]; k[i] = hi_; k[j] = lo_; }
        PEER_CE(0, 1) PEER_CE(2, 3) PEER_CE(4, 5) PEER_CE(6, 7)
        PEER_CE(0, 2) PEER_CE(1, 3) PEER_CE(4, 6) PEER_CE(5, 7)
        PEER_CE(1, 2) PEER_CE(5, 6)
        PEER_CE(0, 4) PEER_CE(1, 5) PEER_CE(2, 6) PEER_CE(3, 7)
        PEER_CE(2, 4) PEER_CE(3, 5)
        PEER_CE(1, 2) PEER_CE(3, 4) PEER_CE(5, 6)
#undef PEER_CE
        unsigned mine = 0u;
#pragma unroll 1
        for (int r = 0; r < 16; ++r) {
            const unsigned m = gmax16(k[0]);
            if (j16 == r) mine = m;
            const bool won = (k[0] == m);
#pragma unroll
            for (int e = 0; e < 7; ++e) k[e] = won ? k[e + 1] : k[e];
            k[7] = won ? 0u : k[7];
        }
        TOPS[(bt * 4 + grp) * 16 + j16] = mine;
    }
    int ex[2]; float gx[2], sux[2];
#pragma unroll
    for (int ps = 0; ps < 2; ++ps) {
        const int hd = ps * 4 + grp; const LAS unsigned* T1 = TOPS + (2 * hd) * 16; const LAS unsigned* T2 = T1 + 16;
        const unsigned c0_ = CT[j16], c1_ = CT[j16 + 16], c2_ = CT[j16 + 32], c3_ = CT[j16 + 48];
        const int ci0 = c0_ & 255, cj0 = c0_ >> 8, ci1 = c1_ & 255, cj1 = c1_ >> 8, ci2 = c2_ & 255, cj2 = c2_ >> 8, ci3 = c3_ & 255, cj3 = c3_ >> 8; const bool cv3 = (j16 + 48) < 50;
        unsigned k[4];
        { const float s0 = sort2f(T1[ci0] & ~127u) + sort2f(T2[cj0] & ~127u), s1 = sort2f(T1[ci1] & ~127u) + sort2f(T2[cj1] & ~127u),
                      s2 = sort2f(T1[ci2] & ~127u) + sort2f(T2[cj2] & ~127u), s3 = sort2f(T1[ci3] & ~127u) + sort2f(T2[cj3] & ~127u);
          k[0] = (f2sort(s0) & ~127u) | (unsigned)(127 - j16); k[1] = (f2sort(s1) & ~127u) | (unsigned)(127 - (j16 + 16)); k[2] = (f2sort(s2) & ~127u) | (unsigned)(127 - (j16 + 32));
          k[3] = cv3 ? ((f2sort(s3) & ~127u) | (unsigned)(127 - (j16 + 48))) : 0u; }
#define PEER_CE(i, j) { const unsigned hi_ = k[i] > k[j] ? k[i] : k[j], lo_ = k[i] > k[j] ? k[j] : k[i]; k[i] = hi_; k[j] = lo_; }
        PEER_CE(0, 1) PEER_CE(2, 3) PEER_CE(0, 2) PEER_CE(1, 3) PEER_CE(1, 2)
#undef PEER_CE
        unsigned mine = 0u;
#pragma unroll 1
        for (int r = 0; r < 16; ++r) {
            const unsigned m = gmax16(k[0]);
            if (j16 == r) mine = m;
            const bool won = (k[0] == m);
            k[0] = won ? k[1] : k[0]; k[1] = won ? k[2] : k[1]; k[2] = won ? k[3] : k[2]; k[3] = won ? 0u : k[3];
        }
        const int c = 127 - (int)(mine & 127u);
        int ci, cj;
        if (c < 16) { ci = 0; cj = c; } else if (c < 24) { ci = 1; cj = c - 16; } else if (c < 29) { ci = 2; cj = c - 24; } else if (c < 33) { ci = 3; cj = c - 29; }
        else if (c < 36) { ci = 4; cj = c - 33; } else if (c < 38) { ci = 5; cj = c - 36; } else if (c < 40) { ci = 6; cj = c - 38; } else if (c < 42) { ci = 7; cj = c - 40; } else { ci = c - 34; cj = 0; }
        const int i1 = 127 - (int)(T1[ci] & 127u), i2 = 127 - (int)(T2[cj] & 127u);
        ex[ps] = i1 * 128 + i2;
        const float sv = sort2f(mine & ~127u); const float s0 = __shfl(sv, lane & 48);
        float ee = __expf(sv - s0); const float es = sum16_f32(ee);
        const float* rsc = (const float*)(ws + WS_MISC);
        sux[ps] = rsc[ex[ps]]; gx[ps] = ee / es * rsc[16384 + ex[ps]];
    }
    {
        unsigned k0 = ((unsigned)ex[0] << 7) | (unsigned)lane, k1 = ((unsigned)ex[1] << 7) | (unsigned)(64 + lane);
#pragma unroll
        for (int k = 2; k <= 128; k <<= 1) {
#pragma unroll
            for (int j = k >> 1; j > 0; j >>= 1) {
                if (j == 64) { const unsigned lo = k0 < k1 ? k0 : k1, hi = k0 < k1 ? k1 : k0; k0 = lo; k1 = hi; }
                else {
                    unsigned p0, p1;
                    if (j == 32) { p0 = (unsigned)__shfl_xor((int)k0, 32); p1 = (unsigned)__shfl_xor((int)k1, 32); }
                    else if (j == 16) { p0 = xchg_xor_u32<16>(k0); p1 = xchg_xor_u32<16>(k1); } else if (j == 8) { p0 = xchg_xor_u32<8>(k0); p1 = xchg_xor_u32<8>(k1); }
                    else if (j == 4) { p0 = xchg_xor_u32<4>(k0); p1 = xchg_xor_u32<4>(k1); } else if (j == 2) { p0 = xchg_xor_u32<2>(k0); p1 = xchg_xor_u32<2>(k1); }
                    else { p0 = xchg_xor_u32<1>(k0); p1 = xchg_xor_u32<1>(k1); }
                    const bool low = (lane & j) == 0; const bool asc0 = (lane & k) == 0, asc1 = ((64 + lane) & k) == 0;
                    const unsigned mn0 = k0 < p0 ? k0 : p0, mx0 = k0 < p0 ? p0 : k0, mn1 = k1 < p1 ? k1 : p1, mx1 = k1 < p1 ? p1 : k1;
                    k0 = (low == asc0) ? mn0 : mx0; k1 = (low == asc1) ? mn1 : mx1;
                }
            }
        }
        const int o0 = (int)(k0 & 127u), o1 = (int)(k1 & 127u);
        const float g0a = __shfl(gx[0], o0 & 63), g0b = __shfl(gx[1], o0 & 63), g1a = __shfl(gx[0], o1 & 63), g1b = __shfl(gx[1], o1 & 63);
        const float s0a = __shfl(sux[0], o0 & 63), s0b = __shfl(sux[1], o0 & 63), s1a = __shfl(sux[0], o1 & 63), s1b = __shfl(sux[1], o1 & 63);
        gx[0] = (o0 & 64) ? g0b : g0a; gx[1] = (o1 & 64) ? g1b : g1a; sux[0] = (o0 & 64) ? s0b : s0a; sux[1] = (o1 & 64) ? s1b : s1a;
        ex[0] = (int)(k0 >> 7); ex[1] = (int)(k1 >> 7);
    }
    const float rstd2 = rsqrtf(((const float*)(ws + WS_SS))[TA + row] * (1.f / 1024.f) + EPS);
    float hf[16];
    { const bf16* hb = (const bf16*)(ws + WS_HB) + (size_t)row * DM + 4 * lane;
#pragma unroll
      for (int q = 0; q < 4; ++q) { const v2u hq = *(const v2u*)(hb + 256 * q); hf[4 * q] = bflo(hq.x); hf[4 * q + 1] = bfhi(hq.x); hf[4 * q + 2] = bflo(hq.y); hf[4 * q + 3] = bfhi(hq.y); } }
    float oacc[16];
#pragma unroll
    for (int i = 0; i < 16; ++i) oacc[i] = 0.f;
    const unsigned char* U = ws + WS_U16; const unsigned char* V = ws + WS_V16;
    v4u ub[8], vbA[8], vbB[8];
    const int gbeg = SPLIT ? 8 * half : 0, gend = SPLIT ? 8 * half + 8 : 16;
    const int addr32 = (lane ^ 32) << 2;
#define PEER_LOAD(buf, TAB, g) do { const int kk_ = (g) * 8; const int exs_ = (kk_ < 64) ? ex[0] : ex[1]; \
        _Pragma("unroll") for (int i = 0; i < 8; ++i) { const int e_ = __builtin_amdgcn_readlane(exs_, (kk_ & 63) + i); buf[i] = *(const v4u*)(TAB + (size_t)e_ * DM + 16 * lane); } } while (0)
#define PEER_DOTS(buf, g, wout) do { const int kk_ = (g) * 8; const float gxs_ = (kk_ < 64) ? gx[0] : gx[1]; const float sus_ = (kk_ < 64) ? sux[0] : sux[1]; float av[8]; \
        _Pragma("unroll") for (int i = 0; i < 8; ++i) { float s = 0.f; \
            _Pragma("unroll") for (int q = 0; q < 4; ++q) { const f32x2 lo = __builtin_amdgcn_cvt_pk_f32_fp8((int)buf[i][q], false), hi = __builtin_amdgcn_cvt_pk_f32_fp8((int)buf[i][q], true); \
                s += lo.x * hf[4 * q]; s += lo.y * hf[4 * q + 1]; s += hi.x * hf[4 * q + 2]; s += hi.y * hf[4 * q + 3]; } \
            av[i] = s; } \
        const bool b5 = lane & 32, b4 = lane & 16, b3_ = lane & 8; float bq[4], cq[2], dq; \
        _Pragma("unroll") for (int i = 0; i < 4; ++i) bq[i] = (b5 ? av[4 + i] : av[i]) + __builtin_bit_cast(float, __builtin_amdgcn_ds_bpermute(addr32, __builtin_bit_cast(int, b5 ? av[i] : av[4 + i])));     \
        _Pragma("unroll") for (int i = 0; i < 2; ++i) cq[i] = (b4 ? bq[2 + i] : bq[i]) + xor16_f32(b4 ? bq[i] : bq[2 + i]); \
        dq = (b3_ ? cq[1] : cq[0]) + DPP_F(b3_ ? cq[0] : cq[1], DPP_MIR);        \
        dq = sum8_f32(dq); \
        const int src = (kk_ & 63) + (lane >> 3); \
        wout = __shfl(gxs_, src) * gelu_tanh(dq * __shfl(sus_, src) * rstd2); } while (0)
#define PEER_ACC(buf, wv) do { _Pragma("unroll") for (int i = 0; i < 8; ++i) { const float w = __builtin_bit_cast(float, __builtin_amdgcn_readlane(__builtin_bit_cast(int, wv), 8 * i)); \
        _Pragma("unroll") for (int q = 0; q < 4; ++q) { const f32x2 lo = __builtin_amdgcn_cvt_pk_f32_fp8((int)buf[i][q], false), hi = __builtin_amdgcn_cvt_pk_f32_fp8((int)buf[i][q], true); \
            oacc[4 * q] += w * lo.x; oacc[4 * q + 1] += w * lo.y; oacc[4 * q + 2] += w * hi.x; oacc[4 * q + 3] += w * hi.y; } } } while (0)
    PEER_LOAD(ub, U, gbeg); PEER_LOAD(vbA, V, gbeg);
#pragma unroll 1
    for (int g0 = gbeg; g0 < gend; g0 += 2) {
        float w0, w1;
        PEER_DOTS(ub, g0, w0);
        PEER_LOAD(ub, U, g0 + 1); PEER_LOAD(vbB, V, g0 + 1);
        PEER_ACC(vbA, w0);
        PEER_DOTS(ub, g0 + 1, w1);
        { const int gn = (g0 + 2 < gend) ? g0 + 2 : g0 + 1;
          PEER_LOAD(ub, U, gn); PEER_LOAD(vbA, V, gn); }
        PEER_ACC(vbB, w1);
    }
#undef PEER_LOAD
#undef PEER_DOTS
#undef PEER_ACC
    if (SPLIT) {
        if (half == 1) {
#pragma unroll
            for (int q = 0; q < 4; ++q) *(LAS f32x4*)(PART + 16 * lane + 4 * q) = (f32x4){oacc[4 * q], oacc[4 * q + 1], oacc[4 * q + 2], oacc[4 * q + 3]}; }
        __syncthreads();
        if (half == 1) return;
#pragma unroll
        for (int q = 0; q < 4; ++q) { const f32x4 p = *(const LAS f32x4*)(PART + 16 * lane + 4 * q); oacc[4 * q] += p.x; oacc[4 * q + 1] += p.y; oacc[4 * q + 2] += p.z; oacc[4 * q + 3] += p.w; }
    }
    asm volatile("" : "+s"(row)); const int lane2 = lane_id();
    const f32x4* x2 = (const f32x4*)((const float*)(ws + WS_X2) + (size_t)row * DM) + lane2;
    f32x4 xv[4]; float ss = 0.f;
#pragma unroll
    for (int q = 0; q < 4; ++q) { xv[q] = x2[64 * q]; xv[q].x += oacc[4 * q]; xv[q].y += oacc[4 * q + 1]; xv[q].z += oacc[4 * q + 2]; xv[q].w += oacc[4 * q + 3]; ss += (xv[q].x * xv[q].x + xv[q].y * xv[q].y) + (xv[q].z * xv[q].z + xv[q].w * xv[q].w); }
    const float r = rsqrtf(wave_sum(ss) * (1.f / DM) + EPS);
    const f32x4* gf = (const f32x4*)((const float*)a.in[I_GFIN]) + lane2;
    f32x4* y = (f32x4*)(row < TP ? a.out + O_YP + (size_t)row * DM : a.out + O_YS + (size_t)(row - TP) * DM) + lane2;
#pragma unroll
    for (int q = 0; q < 4; ++q) { const f32x4 g4 = gf[64 * q]; f32x4 o; o.x = xv[q].x * r * g4.x; o.y = xv[q].y * r * g4.y; o.z = xv[q].z * r * g4.z; o.w = xv[q].w * r * g4.w; y[64 * q] = o; }
}
__device__ __forceinline__ void cand_ij(int c, int& ci, int& cj) {
    if (c < 16) { ci = 0; cj = c; } else if (c < 24) { ci = 1; cj = c - 16; } else if (c < 29) { ci = 2; cj = c - 24; } else if (c < 33) { ci = 3; cj = c - 29; }
    else if (c < 36) { ci = 4; cj = c - 33; } else if (c < 38) { ci = 5; cj = c - 36; } else if (c < 40) { ci = 6; cj = c - 38; } else if (c < 42) { ci = 7; cj = c - 40; } else if (c < 50) { ci = c - 34; cj = 0; } else { ci = 0; cj = 0; }
}
__device__ __forceinline__ void peer_phase(const Frame& F, const Args& a) {
    LAS unsigned* TOPS = (LAS unsigned*)F.lds + F.wave * 256;
    LAS unsigned* CT = (LAS unsigned*)F.lds + 8 * 256 + 4 * 1024;
    if (F.tid < 64) { int ci, cj; cand_ij(F.tid, ci, cj); CT[F.tid] = (unsigned)ci | ((unsigned)cj << 8); }
    __syncthreads();
    const int gw = F.vcu * NWAVES + F.wave, NGW = F.G * NWAVES;
    const int nfull = TA / NGW, rem = TA - nfull * NGW;
#pragma unroll 1
    for (int i = 0; i < nfull; ++i) peer_token<false>(F, a, gw + i * NGW, TOPS, CT, 0, nullptr);
    if (rem == 4 * F.G) {
        __syncthreads();
        peer_token<true>(F, a, nfull * NGW + F.vcu * 4 + (F.wave >> 1), TOPS, CT, F.wave & 1, (LAS float*)F.lds + 8 * 256 + (F.wave >> 1) * 1024);
    } else {
        const int row = gw + nfull * NGW; if (row < TA) peer_token<false>(F, a, row, TOPS, CT, 0, nullptr);
    }
}


template <class EpiS>
__device__ __forceinline__ void skinny_tile(const Frame& F, const bf16* A, int lda, const bf16* Bt, int ldb, int tm, int tn, const EpiS& E) {
    const int lane = F.lane, fr = lane & 15, fq = lane >> 4, w = F.wave, lr = lane >> 3, lc = lane & 7;
    LAS unsigned char* SA = F.lds + w * 16384; LAS unsigned char* SB = SA + 8192;
    const bf16* ag = A + (size_t)(tm * 64 + lr) * lda + w * 128 + 8 * lc;
    const bf16* bg = Bt + (size_t)(tn * 64 + lr) * ldb + w * 128 + 8 * lc;
    f32x4 acc[4][4];
#pragma unroll
    for (int m = 0; m < 4; ++m)
#pragma unroll
        for (int n = 0; n < 4; ++n) acc[m][n] = (f32x4){0.f, 0.f, 0.f, 0.f};
    v4u ar[2][8], br[2][8];
#pragma unroll
    for (int kh = 0; kh < 2; ++kh)
#pragma unroll
        for (int i = 0; i < 8; ++i) { ar[kh][i] = *(const v4u*)(ag + (size_t)(8 * i) * lda + 64 * kh); br[kh][i] = *(const v4u*)(bg + (size_t)(8 * i) * ldb + 64 * kh); }
#pragma unroll
    for (int kh = 0; kh < 2; ++kh) {
#pragma unroll
        for (int i = 0; i < 8; ++i) { const int row = 8 * i + lr; *(LAS v4u*)(SA + row * 128 + ((lc ^ (row & 7)) << 4)) = ar[kh][i]; *(LAS v4u*)(SB + row * 128 + ((lc ^ (row & 7)) << 4)) = br[kh][i]; }
        bf16x8 af[4][2], bfr[4][2];
#pragma unroll
        for (int m = 0; m < 4; ++m)
#pragma unroll
            for (int ks = 0; ks < 2; ++ks) { const int row = 16 * m + fr; const int off = row * 128 + (((4 * ks + fq) ^ (row & 7)) << 4);
                af[m][ks] = *(const LAS bf16x8*)(SA + off); bfr[m][ks] = *(const LAS bf16x8*)(SB + off); }
#pragma unroll
        for (int ks = 0; ks < 2; ++ks)
#pragma unroll
            for (int m = 0; m < 4; ++m)
#pragma unroll
                for (int n = 0; n < 4; ++n) acc[m][n] = __builtin_amdgcn_mfma_f32_16x16x32_bf16(bfr[n][ks], af[m][ks], acc[m][n], 0, 0, 0);
        asm volatile("s_waitcnt lgkmcnt(0)" ::: "memory");
    }
    LAS float* PS = (LAS float*)F.lds + w * 4096;
#pragma unroll
    for (int m = 0; m < 4; ++m)
#pragma unroll
        for (int n = 0; n < 4; ++n) *(LAS f32x4*)(PS + (16 * m + fr) * 64 + 4 * ((4 * n + fq) ^ fr)) = acc[m][n];
    lds_barrier();
    {
        const int row = F.tid >> 3, c8 = (F.tid & 7) * 8; const LAS float* PR = (const LAS float*)F.lds + row * 64;
        const int ch0 = 4 * (((F.tid & 7) * 2) ^ (row & 15)), ch1 = 4 * (((F.tid & 7) * 2 + 1) ^ (row & 15));
        f32x4 s0 = *(const LAS f32x4*)(PR + ch0), s1 = *(const LAS f32x4*)(PR + ch1);
#pragma unroll
        for (int ww = 1; ww < 8; ++ww) { s0 += *(const LAS f32x4*)(PR + ww * 4096 + ch0); s1 += *(const LAS f32x4*)(PR + ww * 4096 + ch1); }
        float v[8] = {s0.x, s0.y, s0.z, s0.w, s1.x, s1.y, s1.z, s1.w};
        E(tm * 64 + row, tn * 64 + c8, v, F.tid);
    }
    lds_barrier();
}
struct EpiSk {
    float* d32; int ld32; bf16* d16; int ld16; float sc16;
    const float* res; int ldr;
    const float* gcol; float* ssq; const float* rsq;
    __device__ __forceinline__ void operator()(int row, int col, float (&v)[8], int tid) const {
        if (rsq) { const float rs = rsqrtf(rsq[row] * (1.f / 1024.f) + EPS);
#pragma unroll
            for (int i = 0; i < 8; ++i) v[i] *= rs; }
        if (res) { const f32x4 a = *(const f32x4*)(res + (size_t)row * ldr + col), b = *(const f32x4*)(res + (size_t)row * ldr + col + 4);
            v[0] += a.x; v[1] += a.y; v[2] += a.z; v[3] += a.w; v[4] += b.x; v[5] += b.y; v[6] += b.z; v[7] += b.w; }
        if (d32) { *(f32x4*)(d32 + (size_t)row * ld32 + col) = (f32x4){v[0], v[1], v[2], v[3]}; *(f32x4*)(d32 + (size_t)row * ld32 + col + 4) = (f32x4){v[4], v[5], v[6], v[7]}; }
        if (ssq) { float ss = 0.f;
#pragma unroll
            for (int i = 0; i < 8; ++i) ss += v[i] * v[i];
            ss = sum8_f32(ss);
            if ((tid & 7) == 0) atomicAdd(ssq + row, ss); }
        if (d16) { float w8[8];
#pragma unroll
            for (int i = 0; i < 8; ++i) w8[i] = v[i];
            if (gcol) { const f32x4 a = *(const f32x4*)(gcol + col), b = *(const f32x4*)(gcol + col + 4); w8[0] *= a.x; w8[1] *= a.y; w8[2] *= a.z; w8[3] *= a.w; w8[4] *= b.x; w8[5] *= b.y; w8[6] *= b.z; w8[7] *= b.w; }
            v4u o; o.x = pg8::cvt_pk_bf16(w8[0] * sc16, w8[1] * sc16); o.y = pg8::cvt_pk_bf16(w8[2] * sc16, w8[3] * sc16); o.z = pg8::cvt_pk_bf16(w8[4] * sc16, w8[5] * sc16); o.w = pg8::cvt_pk_bf16(w8[6] * sc16, w8[7] * sc16);
            *(v4u*)(d16 + (size_t)row * ld16 + col) = o; }
    }
};

#define SK_TM16(t) (4 * (((t) >> 5) >> 1) + (((t) & 31) >> 3))
#define SK_TN16(t) (8 * (((t) >> 5) & 1) + ((t) & 7))
#define SK_TM32(t) (4 * ((((t) & 255) >> 5) >> 1) + ((((t) & 31) + 32 * ((t) >> 8)) >> 4))
#define SK_TN32(t) (16 * ((((t) & 255) >> 5) & 1) + ((((t) & 31) + 32 * ((t) >> 8)) & 15))


#ifndef PH_MAX
#define PH_MAX 99
#endif
__global__ void __launch_bounds__(NTHR, 2) mega_fwd(Args args) {
    extern __shared__ __attribute__((aligned(16))) unsigned char lds_raw[];
    Frame F;
    F.lds = (LAS unsigned char*)lds_raw;
    F.wave = __builtin_amdgcn_readfirstlane((int)threadIdx.x >> 6); F.lane = lane_id(); F.tid = F.wave * 64 + F.lane;
    F.G = gridDim.x; { const int bx = blockIdx.x; F.vcu = (F.G % 8 == 0) ? (bx % 8) * (F.G / 8) + bx / 8 : bx; }
    volatile LAS unsigned* MISC = (volatile LAS unsigned*)(F.lds + MISC_OFF);
    LAS unsigned long long* ARGP = (LAS unsigned long long*)(F.lds + ARGS_OFF);
    for (int u = F.tid; u < (LDS_BYTES - LDSCTL_OFF) / 4; u += NTHR) ((LAS unsigned*)(F.lds + LDSCTL_OFF))[u] = 0u;
    __syncthreads();
    if (F.tid == 0) {
        ARGP[0] = (unsigned long long)args.in[0];
        ARGP[1] = (unsigned long long)args.in[1];
        ARGP[2] = (unsigned long long)args.in[2];
        ARGP[3] = (unsigned long long)args.in[3];
        ARGP[4] = (unsigned long long)args.in[4];
        ARGP[5] = (unsigned long long)args.in[5];
        ARGP[6] = (unsigned long long)args.in[6];
        ARGP[7] = (unsigned long long)args.in[7];
        ARGP[8] = (unsigned long long)args.in[8];
        ARGP[9] = (unsigned long long)args.in[9];
        ARGP[10] = (unsigned long long)args.in[10];
        ARGP[11] = (unsigned long long)args.in[11];
        ARGP[12] = (unsigned long long)args.in[12];
        ARGP[13] = (unsigned long long)args.in[13];
        ARGP[14] = (unsigned long long)args.in[14];
        ARGP[15] = (unsigned long long)args.in[15];
        ARGP[16] = (unsigned long long)args.in[16];
        ARGP[17] = (unsigned long long)args.in[17];
        ARGP[18] = (unsigned long long)args.in[18];
        ARGP[19] = (unsigned long long)args.in[19];
        ARGP[20] = (unsigned long long)args.in[20];
        ARGP[21] = (unsigned long long)args.in[21];
        ARGP[22] = (unsigned long long)args.in[22];
        ARGP[23] = (unsigned long long)args.in[23];
        ARGP[24] = (unsigned long long)args.in[24];
        ARGP[25] = (unsigned long long)args.in[25];
        ARGP[26] = (unsigned long long)args.in[26];
        ARGP[27] = (unsigned long long)args.in[27];
        ARGP[28] = (unsigned long long)args.in[28];
        ARGP[N_INPUTS] = (unsigned long long)args.out; ARGP[N_INPUTS + 1] = (unsigned long long)args.ws;
    }
    __syncthreads();
    { const XcdBarrier bar0 = xcd_barrier_post((unsigned*)((gu32*)(args.ws + WS_CTL) + CW_BAR), MISC + 8, F.wave); if (F.tid == 0) MISC[10] = bar0.x; }
    __syncthreads();
#define GRID_BAR() do { XcdBarrier bar_; bar_.bar = (unsigned*)((gu32*)((unsigned char*)ld_ptr(ARGP + N_INPUTS + 1) + WS_CTL) + CW_BAR); bar_.x = MISC[10]; bar_.st = MISC + 8; bar_.wave = F.wave; xcd_barrier(bar_); } while (0)
#define PHASE_ARGS const Args A = load_args(ARGP); unsigned char* const ws = A.ws; float* const out = A.out; (void)ws; (void)out; { int l_ = lane_id(); asm volatile("" : "+v"(l_)); F.lane = l_; F.tid = F.wave * 64 + l_; }

    { PHASE_ARGS;
    p0_prologue(F, A);
    }
    GRID_BAR();
#if defined(PROBE_BAR8)
    GRID_BAR(); GRID_BAR(); GRID_BAR(); GRID_BAR(); GRID_BAR(); GRID_BAR(); GRID_BAR(); GRID_BAR();
#endif
#if PH_MAX >= 1
    { PHASE_ARGS;
    {
        pg8::Gemm g{(const bf16*)(ws + WS_HB), (const bf16*)(ws + WS_WIN), DM, DM, DM};
        pg8::StaticOrder S; S.init(TA, N_IN, F.G, (int)blockIdx.x);
        EpiInProj E{out, ws, (const float*)A.in[I_BFF]};
        pg8::gemm_phase(F.lds, g, S, E, F.wave);
    }
    {
        const int off = (TA / 256) * (N_IN / 256) % F.G;
        pg8::Gemm g{(const bf16*)(ws + WS_MB), (const bf16*)(ws + WS_WMK), DM, DM, DM};
        pg8::StaticOrder S; S.init(512, DM, F.G, ((int)blockIdx.x + F.G - off) % F.G);
        EpiGen E{out + O_MKP, DM, (bf16*)(ws + WS_MK16), DM, 1.f, nullptr, nullptr, 0, 0, nullptr, nullptr, nullptr};
        pg8::gemm_phase(F.lds, g, S, E, F.wave);
    }
    {
        const int off = ((TA / 256) * (N_IN / 256) + 8) % F.G;
        pg8::Gemm g{(const bf16*)(ws + WS_MB), (const bf16*)(ws + WS_WMV), DM, DM, DM};
        pg8::StaticOrder S; S.init(512, DM, F.G, ((int)blockIdx.x + F.G - off) % F.G);
        EpiGen E{out + O_MVP, DM, nullptr, 0, 1.f, nullptr, nullptr, 0, 0, nullptr, nullptr, nullptr};
        pg8::gemm_phase(F.lds, g, S, E, F.wave);
    }
    {
        const int off = ((TA / 256) * (N_IN / 256) + 16) % F.G;
        pg8::Gemm g{(const bf16*)(ws + WS_WMV), (const bf16*)(ws + WS_MB), DM, DM, DM};
        pg8::StaticOrder S; S.init(DM, 512, F.G, ((int)blockIdx.x + F.G - off) % F.G);
        EpiGen E{nullptr, 0, (bf16*)(ws + WS_MVT16), 512, 1.f, nullptr, nullptr, 0, 0, nullptr, nullptr, nullptr};
        pg8::gemm_phase(F.lds, g, S, E, F.wave);
    }
    }
    GRID_BAR();
#endif
#if PH_MAX >= 2
    asm volatile("; ===PHASE 2===");
    { PHASE_ARGS;
    {
        const int gw = F.vcu * NWAVES + F.wave, NGW = F.G * NWAVES;
        if ((gw & 3) == 0) for (int it = gw >> 2; it < 512; it += NGW >> 2) fox_norms_item(F, (const bf16*)(ws + WS_QF), (const bf16*)(ws + WS_KF), out + O_LFP, (float*)(ws + WS_MISC + MiB), (float*)(ws + WS_KBIAS), (float*)(ws + WS_MISC + MiB + 65536), it);
        for (int it = gw; it < NB_S * NPAGES; it += NGW) fox_suffix_item(F, (const float*)A.in[I_CFL], (const int*)A.in[I_PT], (float*)(ws + WS_SUF), (float*)(ws + WS_MISC + 2 * MiB), it);
        for (int u = F.vcu; u < 1024; u += F.G) gla_g1_unit(F, A, u);
        for (int u = F.vcu; u < 512; u += F.G) gla_sample_unit(F, A, u);
    }
    }
    GRID_BAR();
#endif
#if PH_MAX >= 3
    asm volatile("; ===PHASE 3===");
    { PHASE_ARGS;
    gla_scan(F, A);
    __syncthreads();
    for (int i = F.vcu; i < 256; i += F.G) { const int bh = i >> 4, s = i & 15;
        fox_attn_unit(F, (const bf16*)(ws + WS_QF), (const bf16*)(ws + WS_KF), (const bf16*)(ws + WS_VF), (const float*)(ws + WS_KBIAS), (const float*)(ws + WS_MISC + MiB + 65536), (const float*)(ws + WS_MISC + MiB), (bf16*)(ws + WS_MERGED), bh >> 3, bh & 7, s);
        fox_attn_unit(F, (const bf16*)(ws + WS_QF), (const bf16*)(ws + WS_KF), (const bf16*)(ws + WS_VF), (const float*)(ws + WS_KBIAS), (const float*)(ws + WS_MISC + MiB + 65536), (const float*)(ws + WS_MISC + MiB), (bf16*)(ws + WS_MERGED), bh >> 3, bh & 7, 31 - s); }
    }
    GRID_BAR();
#endif
#if PH_MAX >= 4
    asm volatile("; ===PHASE 4===");
    { PHASE_ARGS;
    if (!(F.vcu & 1)) { for (int u = F.vcu; u < 1024; u += F.G) gla_g3_unit(F, A, u); }
    }
    { PHASE_ARGS;
    for (int u = F.vcu; u < 1024; u += F.G) fox_sample_unit(F, A, u);
    }
    { PHASE_ARGS;
    if (F.vcu & 1) { for (int u = F.vcu; u < 1024; u += F.G) gla_g3_unit(F, A, u); }
    }
    GRID_BAR();
#endif
#if PH_MAX >= 5
    asm volatile("; ===PHASE 5===");
    { PHASE_ARGS;
    {
        pg8::Gemm g{(const bf16*)(ws + WS_MERGED), (const bf16*)(ws + WS_WOUT), DM, DM, DM};
        pg8::StaticOrder S; S.init(TP, DM, F.G, (int)blockIdx.x);
        EpiGen E{(float*)(ws + WS_X1), DM, (bf16*)(ws + WS_HB), DM, 1.f, (const float*)A.in[I_XP], (const float*)A.in[I_XS], TP, DM, (const float*)A.in[I_GCROSS], (float*)(ws + WS_SS), nullptr};
        pg8::gemm_phase(F.lds, g, S, E, F.wave);
        __syncthreads();
        EpiSk Es{(float*)(ws + WS_X1) + (size_t)TP * DM, DM, (bf16*)(ws + WS_HB) + (size_t)TP * DM, DM, 1.f, (const float*)A.in[I_XS], DM, (const float*)A.in[I_GCROSS], (float*)(ws + WS_SS) + TP, nullptr};
        for (int t = F.vcu; t < 256; t += F.G) skinny_tile(F, (const bf16*)(ws + WS_MERGED) + (size_t)TP * DM, DM, (const bf16*)(ws + WS_WOUT), DM, SK_TM16(t), SK_TN16(t), Es);
    }
    }
    GRID_BAR();
#endif
#if PH_MAX >= 7
    asm volatile("; ===PHASE 7===");
    { PHASE_ARGS;
    {
        pg8::Gemm g{(const bf16*)(ws + WS_HB), (const bf16*)(ws + WS_WCQ), DM, DM, DM};
        pg8::StaticOrder S; S.init(TP, DM, F.G, (int)blockIdx.x);
        EpiGen E{nullptr, 0, (bf16*)(ws + WS_QC), DM, C2C, nullptr, nullptr, 0, 0, nullptr, nullptr, (const float*)(ws + WS_SS)};
        pg8::gemm_phase(F.lds, g, S, E, F.wave);
        __syncthreads();
        EpiSk Es{nullptr, 0, (bf16*)(ws + WS_QC) + (size_t)TP * DM, DM, C2C, nullptr, 0, nullptr, nullptr, (const float*)(ws + WS_SS) + TP};
        for (int t = F.vcu; t < 256; t += F.G) skinny_tile(F, (const bf16*)(ws + WS_HB) + (size_t)TP * DM, DM, (const bf16*)(ws + WS_WCQ), DM, SK_TM16(t), SK_TN16(t), Es);
    }
    }
    GRID_BAR();
#endif
#if PH_MAX >= 8
    asm volatile("; ===PHASE 8===");
    { PHASE_ARGS;
    {
        const int u = (int)blockIdx.x, b = (u >> 7) & 1, h = (u >> 5) & 3, pnl = u & 31;
        const size_t roff = ((size_t)b * SEQ + pnl * 256) * DM + h * 256;
        if (F.vcu & 1) { for (int v = F.vcu; v < 512; v += F.G) cross_sample_unit(F, A, v); }
        pg8::Gemm g{(const bf16*)(ws + WS_QC) + roff, (const bf16*)(ws + WS_MK16) + (size_t)(b * 256) * DM + h * 256, DM, DM, 256};
        pg8::SingleUnit S{u < 256 ? 1 : 0, {0, 0}};
        EpiSoftmaxP E{ARGP};
        pg8::gemm_phase(F.lds, g, S, E, F.wave);
        VM_WAIT(); __syncthreads();
        {
            pg8::Gemm g2{(const bf16*)(ws + WS_PC) + roff, (const bf16*)(ws + WS_MVT16) + (size_t)(h * 256) * 512 + b * 256, DM, 512, 256};
            EpiGen E2{nullptr, 0, (bf16*)(ws + WS_OC) + roff, DM, 1.f, nullptr, nullptr, 0, 0, nullptr, nullptr, nullptr};
            pg8::gemm_phase(F.lds, g2, S, E2, F.wave);
        }
        __syncthreads();
        if (!(F.vcu & 1)) { for (int v = F.vcu; v < 512; v += F.G) cross_sample_unit(F, A, v); }
    }
    }
    GRID_BAR();
#endif
#if PH_MAX >= 10
    asm volatile("; ===PHASE 10===");
    { PHASE_ARGS;
    {
        pg8::Gemm g{(const bf16*)(ws + WS_OC), (const bf16*)(ws + WS_WCO), DM, DM, DM};
        pg8::StaticOrder S; S.init(TP, DM, F.G, (int)blockIdx.x);
        EpiGen E{(float*)(ws + WS_X2), DM, (bf16*)(ws + WS_HB), DM, 1.f, (const float*)(ws + WS_X1), (const float*)(ws + WS_X1), TA, DM, (const float*)A.in[I_GFFN], (float*)(ws + WS_SS) + TA, nullptr};
        pg8::gemm_phase(F.lds, g, S, E, F.wave);
        __syncthreads();
        EpiSk Es{(float*)(ws + WS_X2) + (size_t)TP * DM, DM, (bf16*)(ws + WS_HB) + (size_t)TP * DM, DM, 1.f, (const float*)(ws + WS_X1) + (size_t)TP * DM, DM, (const float*)A.in[I_GFFN], (float*)(ws + WS_SS) + TA + TP, nullptr};
        for (int t = F.vcu; t < 256; t += F.G) skinny_tile(F, (const bf16*)(ws + WS_OC) + (size_t)TP * DM, DM, (const bf16*)(ws + WS_WCO), DM, SK_TM16(t), SK_TN16(t), Es);
    }
    }
    GRID_BAR();
#endif
#if PH_MAX >= 12
    asm volatile("; ===PHASE 12===");
    { PHASE_ARGS;
    {
        pg8::Gemm g{(const bf16*)(ws + WS_HB), (const bf16*)(ws + WS_WPK), DM, DM, DM};
        pg8::StaticOrder S; S.init(TP, 2048, F.G, (int)blockIdx.x);
        EpiGen E{nullptr, 0, (bf16*)(ws + WS_SC), 2048, 1.f, nullptr, nullptr, 0, 0, nullptr, nullptr, (const float*)(ws + WS_SS) + TA};
        pg8::gemm_phase(F.lds, g, S, E, F.wave);
        __syncthreads();
        EpiSk Es{nullptr, 0, (bf16*)(ws + WS_SC) + (size_t)TP * 2048, 2048, 1.f, nullptr, 0, nullptr, nullptr, (const float*)(ws + WS_SS) + TA + TP};
        for (int t = F.vcu; t < 512; t += F.G) skinny_tile(F, (const bf16*)(ws + WS_HB) + (size_t)TP * DM, DM, (const bf16*)(ws + WS_WPK), DM, SK_TM32(t), SK_TN32(t), Es);
    }
    }
    GRID_BAR();
#endif
#if PH_MAX >= 13
    asm volatile("; ===PHASE 13===");
    { PHASE_ARGS;
    peer_phase(F, A);
    }
#endif
#if PH_MAX < 13
    {   PHASE_ARGS;
        const int gw = F.vcu * NWAVES + F.wave, NGW = F.G * NWAVES;
        for (int m = gw; m < TA; m += NGW) {
            const float* x = m < TP ? (const float*)A.in[I_XP] + (size_t)m * DM : (const float*)A.in[I_XS] + (size_t)(m - TP) * DM;
            float* y = m < TP ? out + O_YP + (size_t)m * DM : out + O_YS + (size_t)(m - TP) * DM;
            for (int j = 0; j < 4; ++j) ((f32x4*)y)[F.lane + 64 * j] = ((const f32x4*)x)[F.lane + 64 * j];
        }
    }
#endif

}

extern "C" void kernel_launch(void* const* d_in, const int* in_sizes, int n_in, void* d_out, int out_size, void* d_ws, size_t ws_size, hipStream_t stream) {
    static int grid = 0;
    if (grid == 0) {
        if (n_in != N_INPUTS || (size_t)out_size != O_TOTAL || ws_size < WS_END) { fprintf(stderr, "kernel_launch: unexpected shapes (n_in %d out %d ws %zu)\n", n_in, out_size, ws_size); grid = -1; return; }
        int dev = 0, cus = 0, per_cu = 0;
        if (hipGetDevice(&dev) != hipSuccess || hipDeviceGetAttribute(&cus, hipDeviceAttributeMultiprocessorCount, dev) != hipSuccess) { grid = -1; return; }
        if (hipFuncSetAttribute((const void*)mega_fwd, hipFuncAttributeMaxDynamicSharedMemorySize, LDS_BYTES) != hipSuccess) { fprintf(stderr, "kernel_launch: hipFuncSetAttribute failed\n"); grid = -1; return; }
        if (hipOccupancyMaxActiveBlocksPerMultiprocessor(&per_cu, (const void*)mega_fwd, NTHR, LDS_BYTES) != hipSuccess || per_cu < 1)
            fprintf(stderr, "kernel_launch: occupancy query reports %d workgroups per CU\n", per_cu);
        (void)hipGetLastError();
        grid = cus;
        if (grid > 256) grid = 256;
    }
    if (grid < 0) return;
    if (hipMemsetAsync((char*)d_ws + WS_CTL, 0, CTL_ZERO_BYTES, stream) != hipSuccess) return;
    Args a{};
    for (int i = 0; i < N_INPUTS; ++i) a.in[i] = d_in[i];
    a.out = (float*)d_out; a.ws = (unsigned char*)d_ws;
    hipLaunchKernelGGL(mega_fwd, dim3(grid), dim3(NTHR), LDS_BYTES, stream, a);
    const hipError_t le = hipPeekAtLastError();
    if (le != hipSuccess) fprintf(stderr, "kernel_launch: launch failed: %s\n", hipGetErrorName(le));
}
```
